# Optimizing an MI355X kernel written in HIP

```python
import math
import jax, jax.numpy as jnp
from jax import lax
import numpy as np

D_MODEL = 1024
BATCH = 4
SEQ = 4096
DEPTH = 2

RMS_EPS = 1e-6
NEG_INF = -1e30

POOL_WIDTH = D_MODEL // 2
POOL_WINDOWS = (2, 4, 8, 16)
POOL_GROUPS = len(POOL_WINDOWS)
POOL_GW = POOL_WIDTH // POOL_GROUPS
RWKV_HEAD_DIM = 64
RWKV_WIDTH = D_MODEL // 2
RWKV_HEADS = RWKV_WIDTH // RWKV_HEAD_DIM
DECAY_LORA = 32
AAA_LORA = 32
GATE_LORA = 96
RWKV_GN_EPS = 64e-5
NSA_HEAD_DIM = 64
NSA_WIDTH = D_MODEL
NSA_HEADS = NSA_WIDTH // NSA_HEAD_DIM
NSA_KV_HEADS = 4
NSA_GROUP = NSA_HEADS // NSA_KV_HEADS
NSA_KV_WIDTH = NSA_KV_HEADS * NSA_HEAD_DIM
N_NSA_BRANCHES = 3
CMP_BLOCK = 32
CMP_STRIDE = 16
CMP_HIDDEN = 256
SLC_BLOCK = 64
N_SELECT = 8
WINDOW = 512
NSA_Q_BLOCK = 64
FORCE_BONUS = 1e3
N_BUCKETS = 32
MAX_EXACT = 16
MAX_DISTANCE = 128
N_BRANCHES = 3
POOL_COLS = POOL_WIDTH
RWKV_COLS = 3 * RWKV_WIDTH + DECAY_LORA + AAA_LORA + GATE_LORA
NSA_COLS = NSA_WIDTH + 2 * N_NSA_BRANCHES * NSA_KV_WIDTH + N_NSA_BRANCHES * NSA_HEADS
IN_COLS = POOL_COLS + RWKV_COLS + NSA_COLS
BRANCH_ROWS = POOL_WIDTH + RWKV_WIDTH + NSA_WIDTH
N_GROUPS = 4
EXPERTS_PER_GROUP = 8
N_EXPERTS = N_GROUPS * EXPERTS_PER_GROUP
TOP_K_EXPERTS = 2
D_EXPERT = 256

kernel_name = 'hybrid_pool_rwkv7_nsa_hmoe_block'


def rms_norm(x, g):
    xf = x.astype(jnp.float32)
    y = xf * lax.rsqrt(jnp.mean(xf * xf, axis=-1, keepdims=True) + RMS_EPS)
    return (y * g).astype(x.dtype)


def split_cols(t, sizes):
    return jnp.split(t, [int(o) for o in np.cumsum(sizes)[:-1]], axis=-1)


def masked_softmax(logits, mask):
    lf = jnp.where(mask, logits.astype(jnp.float32), NEG_INF)
    return jax.nn.softmax(lf, axis=-1) * mask


def t5_bucket(dist):
    n = jnp.maximum(dist, 0)
    nf = jnp.maximum(n, 1).astype(jnp.float32)
    large = MAX_EXACT + (jnp.log(nf / MAX_EXACT) / math.log(MAX_DISTANCE / MAX_EXACT)
                         * (N_BUCKETS - MAX_EXACT)).astype(jnp.int32)
    large = jnp.minimum(large, N_BUCKETS - 1)
    return jnp.where(n < MAX_EXACT, n, large)


def pool_mixer(u, w_grp, scale):
    B, S, _ = u.shape
    uf = u.astype(jnp.float32)
    cs = jnp.concatenate([jnp.zeros((B, 1, POOL_WIDTH), jnp.float32), jnp.cumsum(uf, axis=1)], axis=1)
    t = jnp.arange(S)
    means = []
    for gi, win in enumerate(POOL_WINDOWS):
        c = cs[..., gi * POOL_GW:(gi + 1) * POOL_GW]
        lo = jnp.maximum(t + 1 - win, 0)
        cnt = (t + 1 - lo).astype(jnp.float32)
        means.append((c[:, t + 1] - c[:, lo]) / cnt[None, :, None])
    pooled = (jnp.stack(means, axis=2) - uf.reshape(B, S, POOL_GROUPS, POOL_GW)).astype(u.dtype)
    mixed = jnp.einsum('bsgc,gcd->bsgd', pooled, w_grp)
    return mixed.reshape(B, S, POOL_WIDTH) * scale


def rwkv7_mixer(u, mu, w0, w_up, a0, a_up, g_up, k_k, k_a, r_k, gn_w, gn_b):
    B, S, _ = u.shape
    H, N = RWKV_HEADS, RWKV_HEAD_DIM
    u_prev = jnp.pad(u, ((0, 0), (1, 0), (0, 0)))[:, :-1]
    u = u + (u_prev - u) * mu
    r, k, v, wd, ad, gd = split_cols(u, [RWKV_WIDTH] * 3 + [DECAY_LORA, AAA_LORA, GATE_LORA])
    w_log = -jax.nn.softplus(-(w0 + jnp.tanh(wd) @ w_up)) - 0.5
    decay = jnp.exp(-jnp.exp(w_log.astype(jnp.float32)))
    a = jax.nn.sigmoid(a0 + ad @ a_up)
    g = jax.nn.sigmoid(gd) @ g_up
    heads = lambda t: t.reshape(B, S, H, N).astype(jnp.float32)
    kk = heads(k * k_k)
    kk = kk / jnp.maximum(jnp.sqrt(jnp.sum(kk * kk, axis=-1, keepdims=True)), 1e-12)
    k = k * (1.0 + (a - 1.0) * k_a)
    r_h, k_h, v_h, w_h, a_h = heads(r), heads(k), heads(v), heads(decay), heads(a)

    def step(state, inp):
        r_t, w_t, k_t, v_t, kk_t, a_t = inp
        sa = jnp.einsum('bhvk,bhk->bhv', state, -kk_t)
        state = (state * w_t[:, :, None, :] + sa[..., None] * (kk_t * a_t)[:, :, None, :]
                 + v_t[..., None] * k_t[:, :, None, :])
        return state, jnp.einsum('bhvk,bhk->bhv', state, r_t)

    xs = tuple(jnp.moveaxis(t, 1, 0) for t in (r_h, w_h, k_h, v_h, kk, a_h))
    _, y = lax.scan(step, jnp.zeros((B, H, N, N), jnp.float32), xs)
    y = jnp.moveaxis(y, 0, 1)
    mean = jnp.mean(y, axis=-1, keepdims=True)
    var = jnp.mean(jnp.square(y - mean), axis=-1, keepdims=True)
    yn = (y - mean) * lax.rsqrt(var + RWKV_GN_EPS) * gn_w.reshape(H, N) + gn_b.reshape(H, N)
    bonus = jnp.sum(r_h * k_h * r_k, axis=-1, keepdims=True) * v_h
    return ((yn + bonus).reshape(B, S, RWKV_WIDTH) * g).astype(u.dtype)


def nsa_mixer(q, k_c, v_c, k_s, v_s, k_w, v_w, gate_logits, rel_bias,
              pos_k, w1_k, w2_k, pos_v, w1_v, w2_v):
    B, S, _ = q.shape
    G, Hg, dh = NSA_KV_HEADS, NSA_GROUP, NSA_HEAD_DIM
    qh = q.reshape(B, S, G, Hg, dh).transpose(0, 2, 3, 1, 4) * (dh ** -0.5)
    kv = lambda t: t.reshape(B, S, G, dh).transpose(0, 2, 1, 3)
    k_c, v_c, k_s, v_s, k_w, v_w = (kv(t) for t in (k_c, v_c, k_s, v_s, k_w, v_w))
    gates = jax.nn.sigmoid(gate_logits.reshape(B, S, G, Hg, N_NSA_BRANCHES)).transpose(0, 2, 3, 1, 4)

    n_cmp = (S - CMP_BLOCK) // CMP_STRIDE + 1
    cmp_start = np.arange(n_cmp) * CMP_STRIDE
    cmp_idx = cmp_start[:, None] + np.arange(CMP_BLOCK)[None, :]
    cmp_end = jnp.asarray(cmp_start + CMP_BLOCK - 1, jnp.int32)

    def compress(t, pos, w1, w2):
        blocks = (t[:, :, cmp_idx] + pos).reshape(B, G, n_cmp, CMP_BLOCK * dh)
        return jax.nn.gelu(blocks @ w1) @ w2

    kc_blk = compress(k_c, pos_k, w1_k, w2_k)
    vc_blk = compress(v_c, pos_v, w1_v, w2_v)

    n_slc = S // SLC_BLOCK
    n_sel = min(N_SELECT, n_slc)
    slc_start = np.arange(n_slc) * SLC_BLOCK
    overlap = jnp.asarray(((cmp_start[:, None] <= slc_start[None, :] + SLC_BLOCK - 1)
                           & (cmp_start[:, None] + CMP_BLOCK - 1 >= slc_start[None, :])).astype(np.float32))
    ks_blk = k_s.reshape(B, G, n_slc, SLC_BLOCK, dh)
    vs_blk = v_s.reshape(B, G, n_slc, SLC_BLOCK, dh)

    kw_pad = jnp.pad(k_w, ((0, 0), (0, 0), (WINDOW, 0), (0, 0)))
    vw_pad = jnp.pad(v_w, ((0, 0), (0, 0), (WINDOW, 0), (0, 0)))

    tbl_g = rel_bias.reshape(N_BUCKETS, G, Hg).transpose(1, 0, 2)
    b_idx = jnp.arange(B)[:, None, None, None]
    g_idx = jnp.arange(G)[None, :, None, None]

    def shared_bias(dist):
        return rel_bias[t5_bucket(dist)].reshape(dist.shape + (G, Hg)).transpose(2, 3, 0, 1)

    def block(i):
        q0 = i * NSA_Q_BLOCK
        t = q0 + jnp.arange(NSA_Q_BLOCK, dtype=jnp.int32)
        qb = lax.dynamic_slice_in_dim(qh, q0, NSA_Q_BLOCK, axis=3)
        gb = lax.dynamic_slice_in_dim(gates, q0, NSA_Q_BLOCK, axis=3)
        dist_c = t[:, None] - cmp_end[None, :]
        lc = jnp.einsum('bghqd,bgcd->bghqc', qb, kc_blk) + shared_bias(dist_c)
        pc = masked_softmax(lc, dist_c >= 0).astype(vc_blk.dtype)
        o_c = jnp.einsum('bghqc,bgcd->bghqd', pc, vc_blk)
        imp = jnp.einsum('bghqc,cn->bgqn', pc, overlap)
        blk = jnp.arange(n_slc)[None, :]
        cur = (t // SLC_BLOCK)[:, None]
        valid = blk <= cur
        forced = (blk == 0) | (blk == cur) | (blk == cur - 1)
        score = jnp.where(valid, imp + jnp.where(forced, FORCE_BONUS, 0.0), -1.0)
        top_val, top_idx = lax.top_k(score, n_sel)
        k_sel = ks_blk[b_idx, g_idx, top_idx].reshape(B, G, NSA_Q_BLOCK, n_sel * SLC_BLOCK, dh)
        v_sel = vs_blk[b_idx, g_idx, top_idx].reshape(B, G, NSA_Q_BLOCK, n_sel * SLC_BLOCK, dh)
        pos_s = (top_idx[..., None] * SLC_BLOCK + jnp.arange(SLC_BLOCK)).reshape(B, G, NSA_Q_BLOCK, n_sel * SLC_BLOCK)
        dist_s = t[None, None, :, None] - pos_s
        mask_s = jnp.repeat(top_val >= 0, SLC_BLOCK, axis=-1) & (dist_s >= 0)
        bias_s = tbl_g[g_idx, t5_bucket(dist_s)].transpose(0, 1, 4, 2, 3)
        ls = jnp.einsum('bghqd,bgqkd->bghqk', qb, k_sel) + bias_s
        ps = masked_softmax(ls, mask_s[:, :, None]).astype(v_sel.dtype)
        o_s = jnp.einsum('bghqk,bgqkd->bghqd', ps, v_sel)
        kwb = lax.dynamic_slice_in_dim(kw_pad, q0, NSA_Q_BLOCK + WINDOW, axis=2)
        vwb = lax.dynamic_slice_in_dim(vw_pad, q0, NSA_Q_BLOCK + WINDOW, axis=2)
        pos_w = q0 - WINDOW + jnp.arange(NSA_Q_BLOCK + WINDOW, dtype=jnp.int32)
        dist_w = t[:, None] - pos_w[None, :]
        mask_w = (dist_w >= 0) & (dist_w < WINDOW) & (pos_w[None, :] >= 0)
        lw = jnp.einsum('bghqd,bgkd->bghqk', qb, kwb) + shared_bias(dist_w)
        pw = masked_softmax(lw, mask_w).astype(vwb.dtype)
        o_w = jnp.einsum('bghqk,bgkd->bghqd', pw, vwb)
        return gb[..., 0:1] * o_c + gb[..., 1:2] * o_s + gb[..., 2:3] * o_w

    out = lax.map(block, jnp.arange(S // NSA_Q_BLOCK, dtype=jnp.int32))
    return out.transpose(1, 0, 4, 2, 3, 5).reshape(B, S, NSA_WIDTH)


def hier_moe(h, w_rg, b_rg, w_re, b_re, w_gate, w_up, w_down):
    B, S, _ = h.shape
    p_grp = jax.nn.softmax((h @ w_rg + b_rg).astype(jnp.float32), axis=-1)
    p_top, grp = lax.top_k(p_grp, 1)
    le = (h @ w_re + b_re).astype(jnp.float32).reshape(B, S, N_GROUPS, EXPERTS_PER_GROUP)
    le_g = jnp.sum(le * jax.nn.one_hot(grp[..., 0], N_GROUPS)[..., None], axis=2)
    e_val, e_idx = lax.top_k(le_g, TOP_K_EXPERTS)
    w_e = jax.nn.softmax(e_val, axis=-1) * p_top
    expert_id = grp * EXPERTS_PER_GROUP + e_idx
    combine = jnp.sum(jax.nn.one_hot(expert_id, N_EXPERTS) * w_e[..., None], axis=2).astype(h.dtype)
    y = jnp.zeros_like(h)
    for e in range(N_EXPERTS):
        hid = jax.nn.silu(h @ w_gate[e]) * (h @ w_up[e])
        y = y + combine[..., e:e + 1] * (hid @ w_down[e])
    return y


def setup_inputs(seed: int = 0) -> dict:
    key = jax.random.key(seed)
    keys = iter(jax.random.split(key, 48))
    L, D = DEPTH, D_MODEL

    def nrm(shape, scale):
        return jax.random.normal(next(keys), shape, jnp.float32) * scale

    def gain(shape):
        return 1.0 + nrm(shape, 0.1)

    branch_scale = jnp.concatenate([jnp.full((POOL_WIDTH,), POOL_WIDTH ** -0.5, jnp.float32),
                                    jnp.full((RWKV_WIDTH,), RWKV_WIDTH ** -0.5, jnp.float32),
                                    jnp.full((NSA_WIDTH,), NSA_WIDTH ** -0.5, jnp.float32)])
    return {
        'x': nrm((BATCH, SEQ, D), 1.0),
        'rel_bias': nrm((N_BUCKETS, NSA_HEADS), 0.5),
        'norm_mix': gain((L, D)),
        'w_in': nrm((L, D, IN_COLS), D ** -0.5),
        'pool_w': nrm((L, POOL_GROUPS, POOL_GW, POOL_GW), POOL_GW ** -0.5),
        'pool_scale': gain((L, POOL_WIDTH)),
        'rw_mu': jax.random.uniform(next(keys), (L, RWKV_COLS), jnp.float32),
        'rw_w0': nrm((L, RWKV_WIDTH), 0.5) + 0.5,
        'rw_w_up': nrm((L, DECAY_LORA, RWKV_WIDTH), DECAY_LORA ** -0.5),
        'rw_a0': nrm((L, RWKV_WIDTH), 0.5),
        'rw_a_up': nrm((L, AAA_LORA, RWKV_WIDTH), AAA_LORA ** -0.5),
        'rw_g_up': nrm((L, GATE_LORA, RWKV_WIDTH), GATE_LORA ** -0.5),
        'rw_k_k': gain((L, RWKV_WIDTH)),
        'rw_k_a': gain((L, RWKV_WIDTH)),
        'rw_r_k': nrm((L, RWKV_HEADS, RWKV_HEAD_DIM), 0.1),
        'rw_gn_w': gain((L, RWKV_WIDTH)),
        'rw_gn_b': nrm((L, RWKV_WIDTH), 0.02),
        'cmp_pos_k': nrm((L, CMP_BLOCK, NSA_HEAD_DIM), 0.5),
        'cmp_w1_k': nrm((L, CMP_BLOCK * NSA_HEAD_DIM, CMP_HIDDEN), (CMP_BLOCK * NSA_HEAD_DIM) ** -0.5),
        'cmp_w2_k': nrm((L, CMP_HIDDEN, NSA_HEAD_DIM), CMP_HIDDEN ** -0.5),
        'cmp_pos_v': nrm((L, CMP_BLOCK, NSA_HEAD_DIM), 0.5),
        'cmp_w1_v': nrm((L, CMP_BLOCK * NSA_HEAD_DIM, CMP_HIDDEN), (CMP_BLOCK * NSA_HEAD_DIM) ** -0.5),
        'cmp_w2_v': nrm((L, CMP_HIDDEN, NSA_HEAD_DIM), CMP_HIDDEN ** -0.5),
        'w_branch': nrm((L, BRANCH_ROWS, D), 1.0) * branch_scale[None, :, None],
        'w_merge': nrm((L, D, N_BRANCHES * D), D ** -0.5),
        'b_merge': nrm((L, N_BRANCHES * D), 0.1),
        'w_out': nrm((L, D, D), D ** -0.5),
        'norm_ffn': gain((L, D)),
        'w_router_grp': nrm((L, D, N_GROUPS), D ** -0.5),
        'b_router_grp': nrm((L, N_GROUPS), 0.01),
        'w_router_exp': nrm((L, D, N_EXPERTS), D ** -0.5),
        'b_router_exp': nrm((L, N_EXPERTS), 0.01),
        'w_exp_gate': nrm((L, N_EXPERTS, D, D_EXPERT), D ** -0.5),
        'w_exp_up': nrm((L, N_EXPERTS, D, D_EXPERT), D ** -0.5),
        'w_exp_down': nrm((L, N_EXPERTS, D_EXPERT, D), D_EXPERT ** -0.5),
        'norm_final': gain((D,)),
    }


def reference(x, rel_bias, norm_mix, w_in, pool_w, pool_scale, rw_mu, rw_w0, rw_w_up, rw_a0,
              rw_a_up, rw_g_up, rw_k_k, rw_k_a, rw_r_k, rw_gn_w, rw_gn_b, cmp_pos_k, cmp_w1_k,
              cmp_w2_k, cmp_pos_v, cmp_w1_v, cmp_w2_v, w_branch, w_merge, b_merge, w_out, norm_ffn,
              w_router_grp, b_router_grp, w_router_exp, b_router_exp, w_exp_gate, w_exp_up,
              w_exp_down, norm_final):
    B, S, D = x.shape
    for l in range(DEPTH):
        h = rms_norm(x, norm_mix[l])
        proj = h @ w_in[l]
        u_pool, u_rwkv, u_nsa = split_cols(proj, [POOL_COLS, RWKV_COLS, NSA_COLS])
        y_pool = pool_mixer(u_pool, pool_w[l], pool_scale[l])
        y_rwkv = rwkv7_mixer(u_rwkv, rw_mu[l], rw_w0[l], rw_w_up[l], rw_a0[l], rw_a_up[l], rw_g_up[l],
                             rw_k_k[l], rw_k_a[l], rw_r_k[l], rw_gn_w[l], rw_gn_b[l])
        q, k_c, v_c, k_s, v_s, k_w, v_w, g_nsa = split_cols(
            u_nsa, [NSA_WIDTH] + [NSA_KV_WIDTH] * (2 * N_NSA_BRANCHES) + [N_NSA_BRANCHES * NSA_HEADS])
        y_nsa = nsa_mixer(q, k_c, v_c, k_s, v_s, k_w, v_w, g_nsa, rel_bias,
                          cmp_pos_k[l], cmp_w1_k[l], cmp_w2_k[l], cmp_pos_v[l], cmp_w1_v[l], cmp_w2_v[l])
        wb = w_branch[l]
        br_pool = y_pool @ wb[:POOL_WIDTH]
        br_rwkv = y_rwkv @ wb[POOL_WIDTH:POOL_WIDTH + RWKV_WIDTH]
        br_nsa = y_nsa @ wb[POOL_WIDTH + RWKV_WIDTH:]
        gates = jax.nn.sigmoid(h @ w_merge[l] + b_merge[l]).reshape(B, S, N_BRANCHES, D)
        merged = gates[:, :, 0] * br_pool + gates[:, :, 1] * br_rwkv + gates[:, :, 2] * br_nsa
        x = x + merged @ w_out[l]
        h = rms_norm(x, norm_ffn[l])
        x = x + hier_moe(h, w_router_grp[l], b_router_grp[l], w_router_exp[l], b_router_exp[l],
                         w_exp_gate[l], w_exp_up[l], w_exp_down[l])
    return rms_norm(x, norm_final)
```

```cpp
#include <hip/hip_runtime.h>
#include <cstdio>
#include <cstdint>

#define DI __device__ __forceinline__
typedef unsigned short bf16_t;
typedef short bf16x8 __attribute__((ext_vector_type(8)));
typedef float f32x4 __attribute__((ext_vector_type(4)));
typedef unsigned u32x4 __attribute__((ext_vector_type(4)));
typedef unsigned u32x2 __attribute__((ext_vector_type(2)));

constexpr int NB = 4, SEQ = 4096, DM = 1024, NT = NB * SEQ, DEPTH = 2;
constexpr int IN_COLS = 4816;
constexpr int C_POOL = 0, C_RW = 512, C_R = 512, C_K = 1024, C_V = 1536, C_WD = 2048, C_AD = 2080, C_GD = 2112;
constexpr int C_Q = 2208, C_KC = 3232, C_VC = 3488, C_KS = 3744, C_VS = 4000, C_KW = 4256, C_VW = 4512, C_GATE = 4768;
constexpr int RWC = 1696;
constexpr int NCMP = 255;
constexpr int NTHREADS = 512;
constexpr int LDS_BYTES = 98304;

enum { I_X = 0, I_RELB, I_NMIX, I_WIN, I_POOLW, I_POOLS, I_MU, I_W0, I_WUP, I_A0, I_AUP, I_GUP, I_KK, I_KA, I_RK, I_GNW, I_GNB,
       I_CPK, I_CW1K, I_CW2K, I_CPV, I_CW1V, I_CW2V, I_WBR, I_WMG, I_BMG, I_WOUT, I_NFFN, I_WRG, I_BRG, I_WRE, I_BRE, I_EG, I_EU, I_ED, I_NFIN, N_IN };

constexpr size_t WS_CTL = 0;
constexpr size_t CTL_BYTES = 65536;
constexpr size_t WS_H = CTL_BYTES;
constexpr size_t WS_PROJ = WS_H + (size_t)NT * DM * 2;
constexpr size_t WS_F = WS_PROJ + (size_t)NT * IN_COLS * 2;
constexpr size_t PLANE = (size_t)NT * 512 * 2;
constexpr size_t WS_POOLED = WS_F + 6 * PLANE;
constexpr size_t WS_CMPH = WS_POOLED + PLANE;
constexpr size_t WS_CMPO = WS_CMPH + (size_t)2 * 4096 * 256 * 2;
constexpr size_t WS_POSB = WS_CMPO + (size_t)2 * 4096 * 64 * 4;
constexpr size_t WS_ROUTE = WS_POSB + 4096;
constexpr size_t WS_ENT = WS_ROUTE + (size_t)NT * 32;
constexpr size_t WS_END = WS_ENT + (size_t)2 * NT * 8;
constexpr size_t WS_HID = WS_PROJ;
constexpr size_t WS_Y = WS_PROJ + (size_t)2 * NT * 256 * 2;
static_assert(WS_Y + (size_t)2 * NT * 1024 * 2 <= WS_F, "alias");
constexpr int CW_BAR = 0;
constexpr int CW_CNT = 4096;
constexpr int CW_CUR = 4096 + 64;

#define XB_TMO      128
#define XB_XCNT(j)  (256  + 64 * (j))
#define XB_XSUB(j)  (1280 + 64 * (j))
#define XB_XGEN(j)  (2304 + 64 * (j))
#define XB_TOP      3328
#define XB_TOPGEN   3392
#define XCD_BAR_WORDS 3456
#define XB_SPIN_CAP (1u << 18)
#define LAS __attribute__((address_space(3)))

__device__ __forceinline__ unsigned xb_ld(unsigned* p)              { return __hip_atomic_load(p, __ATOMIC_RELAXED, __HIP_MEMORY_SCOPE_AGENT); }
__device__ __forceinline__ unsigned xb_add(unsigned* p, unsigned v) { return __hip_atomic_fetch_add(p, v, __ATOMIC_RELAXED, __HIP_MEMORY_SCOPE_AGENT); }
__device__ __forceinline__ unsigned xb_xcc_id() { return (unsigned)__builtin_amdgcn_s_getreg((3 << 11) | 20) & 0xFu; }
#define XB_SPIN(cond, bar) do { unsigned _sp = 0; while (cond) { __builtin_amdgcn_s_sleep(1); \
    if ((++_sp & 255u) == 0u) { if (xb_ld(&(bar)[XB_TMO])) break; if (_sp > XB_SPIN_CAP) { atomicAdd(&(bar)[XB_TMO], 1u); break; } } } } while (0)

struct XcdBarrier { unsigned* bar; unsigned x; volatile LAS unsigned* st; };

__device__ __forceinline__ XcdBarrier xcd_barrier_post(unsigned* bar, volatile LAS unsigned* st) {
    XcdBarrier b; b.bar = bar; b.x = xb_xcc_id(); b.st = st;
    if (threadIdx.x == 0) (void)xb_add(&bar[XB_XCNT(b.x)], 1u);
    return b;
}
__device__ __forceinline__ void xcd_barrier_complete(unsigned* bar, unsigned x, unsigned& nloc, unsigned& nx) {
    const unsigned G = gridDim.x * gridDim.y * gridDim.z;
    unsigned sum, cnt, mine, sp = 0u;
    for (;;) {
        sum = 0u; cnt = 0u; mine = 0u;
#pragma unroll
        for (unsigned j = 0; j < 16; ++j) { const unsigned c = xb_ld(&bar[XB_XCNT(j)]); sum += c; cnt += (c > 0u) ? 1u : 0u; mine = (j == x) ? c : mine; }
        if (sum == G) break;
        __builtin_amdgcn_s_sleep(1);
        if ((++sp & 255u) == 0u) { if (xb_ld(&bar[XB_TMO])) break; if (sp > XB_SPIN_CAP) { atomicAdd(&bar[XB_TMO], 1u); break; } }
    }
    nloc = mine > 0u ? mine : 1u; nx = cnt > 0u ? cnt : 1u;
}
__device__ __forceinline__ void xcd_barrier(const XcdBarrier& b) {
    asm volatile("s_waitcnt vmcnt(0)" ::: "memory");
    __syncthreads();
    if (threadIdx.x == 0) {
        unsigned* bar = b.bar;
        __builtin_amdgcn_s_waitcnt(0);
        unsigned nloc = b.st[0], nx = b.st[1];
        if (nloc == 0u) { xcd_barrier_complete(bar, b.x, nloc, nx); b.st[0] = nloc; b.st[1] = nx; }
        const unsigned old = xb_add(&bar[XB_XSUB(b.x)], 1u);
        const unsigned gen = old / nloc;
        if (old + 1u == (gen + 1u) * nloc) {
            __builtin_amdgcn_fence(__ATOMIC_RELEASE, "agent");
            asm volatile("s_waitcnt vmcnt(0)" ::: "memory");
            const unsigned og = xb_add(&bar[XB_TOP], 1u);
            const unsigned tg = og / nx;
            if (og + 1u == (tg + 1u) * nx) xb_add(&bar[XB_TOPGEN], 1u);
            else XB_SPIN(xb_ld(&bar[XB_TOPGEN]) == tg, bar);
            __builtin_amdgcn_fence(__ATOMIC_ACQUIRE, "agent");
            xb_add(&bar[XB_XGEN(b.x)], 1u);
            asm volatile("s_waitcnt vmcnt(0)" ::: "memory");
        } else {
            XB_SPIN(xb_ld(&bar[XB_XGEN(b.x)]) == gen, bar);
            __builtin_amdgcn_fence(__ATOMIC_ACQUIRE, "agent");
            asm volatile("s_waitcnt vmcnt(0)" ::: "memory");
        }
    }
    __syncthreads();
}

DI bf16_t f2bf(float x) { unsigned u = __float_as_uint(x); u += 0x7fffu + ((u >> 16) & 1u); return (bf16_t)(u >> 16); }
DI float bf2f(bf16_t b) { return __uint_as_float((unsigned)b << 16); }
DI unsigned pack2(float lo, float hi) { return (unsigned)f2bf(lo) | ((unsigned)f2bf(hi) << 16); }
DI float bflo(unsigned w) { return __uint_as_float(w << 16); }
DI float bfhi(unsigned w) { return __uint_as_float(w & 0xffff0000u); }
DI float wave_sum(float v) {
#pragma unroll
    for (int o = 32; o >= 1; o >>= 1) v += __shfl_xor(v, o);
    return v;
}
DI float wave_max(float v) {
#pragma unroll
    for (int o = 32; o >= 1; o >>= 1) v = fmaxf(v, __shfl_xor(v, o));
    return v;
}
DI float sigmoidf_(float x) { return 1.0f / (1.0f + __expf(-x)); }
DI int TID() { int t = threadIdx.x; asm volatile("" : "+v"(t)); return t; }
#define LDS_WAVE_SYNC() asm volatile("s_waitcnt lgkmcnt(0)" ::: "memory")

struct Params { const float* in[N_IN]; float* out; unsigned char* ws; int ph_lo, ph_hi; };

DI int t5_bucket(int n) {
    if (n < 16) return n;
    if (n >= 128) return 31;
    int b = 16;
    b += (n >= 19) + (n >= 21) + (n >= 24) + (n >= 27) + (n >= 31) + (n >= 35) + (n >= 40) + (n >= 46) + (n >= 52) + (n >= 59) + (n >= 67) + (n >= 77) + (n >= 87) + (n >= 99) + (n >= 113);
    return b;
}

constexpr int GS = 40;
struct ARow { const bf16_t* p; };
template <int AMODE>
DI u32x4 a_load(const ARow& r, int k) {
    if (r.p == nullptr) return (u32x4){0u, 0u, 0u, 0u};
    const bf16_t* q = (AMODE == 0) ? (r.p + k) : (r.p + (size_t)(k >> 6) * IN_COLS + (k & 63));
    return *(const u32x4*)q;
}
template <int AMODE>
DI void gemm_core(f32x4 (&acc)[2][4], const ARow& arow, const float* __restrict__ Bp, int ldb, int ncols_valid  , int K, bf16_t* sA, bf16_t* sB) {
    const int tid = TID(), lane = tid & 63, wave = tid >> 6, wm = wave >> 1, wn = wave & 1;
    const int ar = tid >> 2, ak = (tid & 3) * 8;
    const int bk = tid >> 4, bn = (tid & 15) * 8;
    const bool bok = bn < ncols_valid;
    u32x4 ra = a_load<AMODE>(arow, ak);
    f32x4 rb0 = (f32x4){0.f, 0.f, 0.f, 0.f}, rb1 = rb0;
    if (bok) { const float* q = Bp + (size_t)bk * ldb + bn; rb0 = *(const f32x4*)q; rb1 = *(const f32x4*)(q + 4); }
    const int nk = K / 32;
    for (int kt = 0; kt < nk; ++kt) {
        __syncthreads();
        *(u32x4*)(sA + ar * GS + ak) = ra;
        {
            bf16_t* d = sB + bn * GS + bk;
            d[0 * GS] = f2bf(rb0[0]); d[1 * GS] = f2bf(rb0[1]); d[2 * GS] = f2bf(rb0[2]); d[3 * GS] = f2bf(rb0[3]);
            d[4 * GS] = f2bf(rb1[0]); d[5 * GS] = f2bf(rb1[1]); d[6 * GS] = f2bf(rb1[2]); d[7 * GS] = f2bf(rb1[3]);
        }
        __syncthreads();
        if (kt + 1 < nk) {
            const int k0 = (kt + 1) * 32;
            ra = a_load<AMODE>(arow, k0 + ak);
            if (bok) { const float* q = Bp + (size_t)(k0 + bk) * ldb + bn; rb0 = *(const f32x4*)q; rb1 = *(const f32x4*)(q + 4); }
        }
        bf16x8 af[2], bfr[4];
#pragma unroll
        for (int mi = 0; mi < 2; ++mi) af[mi] = *(const bf16x8*)(sA + (wm * 32 + mi * 16 + (lane & 15)) * GS + (lane >> 4) * 8);
#pragma unroll
        for (int ni = 0; ni < 4; ++ni) bfr[ni] = *(const bf16x8*)(sB + (wn * 64 + ni * 16 + (lane & 15)) * GS + (lane >> 4) * 8);
#pragma unroll
        for (int mi = 0; mi < 2; ++mi)
#pragma unroll
            for (int ni = 0; ni < 4; ++ni) acc[mi][ni] = __builtin_amdgcn_mfma_f32_16x16x32_bf16(bfr[ni], af[mi], acc[mi][ni], 0, 0, 0);
    }
}
DI void acc_zero(f32x4 (&acc)[2][4]) {
#pragma unroll
    for (int i = 0; i < 2; ++i)
#pragma unroll
        for (int j = 0; j < 4; ++j) acc[i][j] = (f32x4){0.f, 0.f, 0.f, 0.f};
}
#define ACC_FOREACH(acc, body) do { const int _l = TID() & 63, _w = TID() >> 6; \
    _Pragma("unroll") for (int _mi = 0; _mi < 2; ++_mi) _Pragma("unroll") for (int _ni = 0; _ni < 4; ++_ni) { \
        const int r_ = (_w >> 1) * 32 + _mi * 16 + (_l & 15), c_ = (_w & 1) * 64 + _ni * 16 + (_l >> 4) * 4; f32x4& v_ = acc[_mi][_ni]; body } } while (0)

DI void store_bf4(bf16_t* p, f32x4 v) { u32x2 w; w.x = pack2(v[0], v[1]); w.y = pack2(v[2], v[3]); *(u32x2*)p = w; }

struct Ctx {
    const Params* P; unsigned char* ws; float* out; int l;
    bf16_t* H; bf16_t* PROJ; bf16_t* F; bf16_t* POOLED; bf16_t* MERGED; bf16_t* CMPH; float* CMPO; float* POSB; int* ROUTE; int* ENT; bf16_t* HID; bf16_t* Y; unsigned* ctl;
    DI const float* in(int i) const { return P->in[i]; }
};

DI void add_moe_rows(const Ctx& c, int row, int lane, f32x4 (&v)[4]) {
    const int* rt = c.ROUTE + (size_t)row * 8;
    const int p0 = rt[4], p1 = rt[5];
    const bf16_t* y0 = c.Y + (size_t)p0 * DM; const bf16_t* y1 = c.Y + (size_t)p1 * DM;
#pragma unroll
    for (int i = 0; i < 4; ++i) {
        const u32x2 a = *(const u32x2*)(y0 + i * 256 + lane * 4), b = *(const u32x2*)(y1 + i * 256 + lane * 4);
        v[i][0] += bflo(a.x) + bflo(b.x); v[i][1] += bfhi(a.x) + bfhi(b.x); v[i][2] += bflo(a.y) + bflo(b.y); v[i][3] += bfhi(a.y) + bfhi(b.y);
    }
}
DI void phase_norm1(const Ctx& c) {
    const int tid = TID(), lane = tid & 63, wave = tid >> 6;
    const float* gain = c.in(I_NMIX) + c.l * DM;
    const float* src = (c.l == 0) ? c.in(I_X) : c.out;
    for (int row = blockIdx.x * 8 + wave; row < NT; row += gridDim.x * 8) {
        f32x4 v[4];
#pragma unroll
        for (int i = 0; i < 4; ++i) v[i] = *(const f32x4*)(src + (size_t)row * DM + i * 256 + lane * 4);
        if (c.l > 0) {
            add_moe_rows(c, row, lane, v);
#pragma unroll
            for (int i = 0; i < 4; ++i) *(f32x4*)(c.out + (size_t)row * DM + i * 256 + lane * 4) = v[i];
        }
        float ss = 0.f;
#pragma unroll
        for (int i = 0; i < 4; ++i) ss += v[i][0] * v[i][0] + v[i][1] * v[i][1] + v[i][2] * v[i][2] + v[i][3] * v[i][3];
        ss = wave_sum(ss);
        const float rs = rsqrtf(ss * (1.0f / DM) + 1e-6f);
#pragma unroll
        for (int i = 0; i < 4; ++i) {
            const f32x4 g = *(const f32x4*)(gain + i * 256 + lane * 4);
            store_bf4(c.H + (size_t)row * DM + i * 256 + lane * 4, (f32x4){v[i][0] * rs * g[0], v[i][1] * rs * g[1], v[i][2] * rs * g[2], v[i][3] * rs * g[3]});
        }
    }
    for (int idx = blockIdx.x * 8 + wave; idx < 512; idx += gridDim.x * 8) {
        const int kv = idx >> 8, n = idx & 255;
        const float* pos = c.in(kv ? I_CPV : I_CPK) + (size_t)c.l * 2048;
        const float* w1 = c.in(kv ? I_CW1V : I_CW1K) + (size_t)c.l * 2048 * 256;
        float s = 0.f;
        for (int k = lane; k < 2048; k += 64) s += pos[k] * w1[(size_t)k * 256 + n];
        s = wave_sum(s);
        if (lane == 0) c.POSB[kv * 256 + n] = s;
    }
}

DI void phase_gemm1(const Ctx& c, bf16_t* sA, bf16_t* sB) {
    const int nM = NT / 128, nN = (IN_COLS + 127) / 128;
    const float* W = c.in(I_WIN) + (size_t)c.l * DM * IN_COLS;
    for (int tile = blockIdx.x; tile < nM * nN; tile += gridDim.x) {
        const int tm = tile % nM, tn = tile / nM, m0 = tm * 128, n0 = tn * 128;
        f32x4 acc[2][4]; acc_zero(acc);
        ARow ar{c.H + (size_t)(m0 + (TID() >> 2)) * DM};
        gemm_core<0>(acc, ar, W + n0, IN_COLS, IN_COLS - n0, DM, sA, sB);
        ACC_FOREACH(acc, { if (n0 + c_ < IN_COLS) store_bf4(c.PROJ + (size_t)(m0 + r_) * IN_COLS + n0 + c_, v_); });
    }
}

DI float gelu_tanh(float x) { const float u = 0.7978845608028654f * (x + 0.044715f * x * x * x); return 0.5f * x * (1.0f + tanhf(u)); }
DI float softplusf_(float x) { return (x > 20.f) ? x : log1pf(__expf(x)); }
DI void phase_prep(const Ctx& c, unsigned char* lds) {
    bf16_t* sA = (bf16_t*)lds; bf16_t* sB = sA + 128 * GS;
    const int tid = TID();
    const int n_cmp_items = 2 * 32 * 2;
    const int n_items = n_cmp_items + NT / 16;
    for (int item = blockIdx.x; item < n_items; item += gridDim.x) {
        if (item < n_cmp_items) {
            const int kv = item >> 6, tm = (item >> 1) & 31, tn = item & 1, m0 = tm * 128, n0 = tn * 128;
            const int R = m0 + (tid >> 2), bg = R >> 8, cb = R & 255, b = bg >> 2, g = bg & 3;
            ARow ar{(cb < NCMP) ? c.PROJ + (size_t)(b * SEQ + 16 * cb) * IN_COLS + (kv ? C_VC : C_KC) + g * 64 : nullptr};
            const float* W1 = c.in(kv ? I_CW1V : I_CW1K) + (size_t)c.l * 2048 * 256;
            f32x4 acc[2][4]; acc_zero(acc);
            gemm_core<1>(acc, ar, W1 + n0, 256, 256 - n0, 2048, sA, sB);
            const float* pb = c.POSB + kv * 256;
            ACC_FOREACH(acc, {
                const f32x4 bb = *(const f32x4*)(pb + n0 + c_);
                store_bf4(c.CMPH + ((size_t)kv * 4096 + m0 + r_) * 256 + n0 + c_, (f32x4){gelu_tanh(v_[0] + bb[0]), gelu_tanh(v_[1] + bb[1]), gelu_tanh(v_[2] + bb[2]), gelu_tanh(v_[3] + bb[3])}); });
        } else {
            const int t0 = (item - n_cmp_items) * 16;
            float* sl = (float*)lds;
            const float* mu = c.in(I_MU) + (size_t)c.l * RWC;
            __syncthreads();
            for (int idx = tid; idx < 16 * 160; idx += NTHREADS) {
                const int tk = idx / 160, i = idx % 160, t = t0 + tk, col = C_WD + i;
                const float u = bf2f(c.PROJ[(size_t)t * IN_COLS + col]);
                const float up = ((t & (SEQ - 1)) != 0) ? bf2f(c.PROJ[(size_t)(t - 1) * IN_COLS + col]) : 0.f;
                const float us = u + (up - u) * mu[col - C_RW];
                sl[idx] = (i < 32) ? tanhf(us) : ((i < 64) ? us : sigmoidf_(us));
            }
            __syncthreads();
            const int ch = tid;
            float z[16], aa[16], gg[16];
#pragma unroll
            for (int k = 0; k < 16; ++k) { z[k] = 0.f; aa[k] = 0.f; gg[k] = 0.f; }
            const float* wup = c.in(I_WUP) + (size_t)c.l * 32 * 512 + ch;
            const float* aup = c.in(I_AUP) + (size_t)c.l * 32 * 512 + ch;
            const float* gup = c.in(I_GUP) + (size_t)c.l * 96 * 512 + ch;
            for (int i = 0; i < 32; ++i) {
                const float w = wup[i * 512], a = aup[i * 512];
#pragma unroll
                for (int k = 0; k < 16; ++k) { z[k] += sl[k * 160 + i] * w; aa[k] += sl[k * 160 + 32 + i] * a; }
            }
            for (int i = 0; i < 96; ++i) {
                const float w = gup[i * 512];
#pragma unroll
                for (int k = 0; k < 16; ++k) gg[k] += sl[k * 160 + 64 + i] * w;
            }
            const float w0 = c.in(I_W0)[c.l * 512 + ch], a0 = c.in(I_A0)[c.l * 512 + ch];
            const float mur = mu[ch], muk = mu[512 + ch], muv = mu[1024 + ch];
            float pr = 0.f, pk = 0.f, pv = 0.f;
            if ((t0 & (SEQ - 1)) != 0) { const bf16_t* q = c.PROJ + (size_t)(t0 - 1) * IN_COLS; pr = bf2f(q[C_R + ch]); pk = bf2f(q[C_K + ch]); pv = bf2f(q[C_V + ch]); }
#pragma unroll
            for (int k = 0; k < 16; ++k) {
                const int t = t0 + k; const bf16_t* q = c.PROJ + (size_t)t * IN_COLS;
                const float ur = bf2f(q[C_R + ch]), uk = bf2f(q[C_K + ch]), uv = bf2f(q[C_V + ch]);
                const float r = ur + (pr - ur) * mur, kx = uk + (pk - uk) * muk, vx = uv + (pv - uv) * muv;
                pr = ur; pk = uk; pv = uv;
                const float wlog = -softplusf_(-(w0 + z[k])) - 0.5f;
                const float e = __expf(wlog);
                const float a = sigmoidf_(a0 + aa[k]);
                const size_t o = (size_t)t * 512 + ch;
                c.F[o] = f2bf(r); c.F[o + (size_t)NT * 512] = f2bf(kx); c.F[o + (size_t)2 * NT * 512] = f2bf(vx);
                c.F[o + (size_t)3 * NT * 512] = f2bf(e); c.F[o + (size_t)4 * NT * 512] = f2bf(a); c.F[o + (size_t)5 * NT * 512] = f2bf(gg[k]);
            }
            {
                const int gi = ch >> 7, win = 2 << gi;
#pragma unroll 1
                for (int k = 0; k < 16; ++k) {
                    const int t = t0 + k, s = t & (SEQ - 1);
                    const int lo = (s + 1 - win > 0) ? (s + 1 - win) : 0;
                    float sum = 0.f;
                    for (int j = lo; j <= s; ++j) sum += bf2f(c.PROJ[(size_t)(t - s + j) * IN_COLS + C_POOL + ch]);
                    const float self = bf2f(c.PROJ[(size_t)t * IN_COLS + C_POOL + ch]);
                    c.POOLED[(size_t)t * 512 + ch] = f2bf(sum / (float)(s + 1 - lo) - self);
                }
            }
        }
    }
}

DI void phase_poolgemm(const Ctx& c, bf16_t* sA, bf16_t* sB) {
    const int n_pool = (NT / 128) * 4, n_items = n_pool + 64;
    for (int item = blockIdx.x; item < n_items; item += gridDim.x) {
        f32x4 acc[2][4]; acc_zero(acc);
        if (item < n_pool) {
            const int tm = item >> 2, gi = item & 3, m0 = tm * 128;
            ARow ar{c.POOLED + (size_t)(m0 + (TID() >> 2)) * 512 + gi * 128};
            gemm_core<0>(acc, ar, c.in(I_POOLW) + ((size_t)c.l * 4 + gi) * 128 * 128, 128, 128, 128, sA, sB);
            const float* sc = c.in(I_POOLS) + c.l * 512 + gi * 128;
            __syncthreads();
            ACC_FOREACH(acc, { const f32x4 s = *(const f32x4*)(sc + c_);
                store_bf4(c.POOLED + (size_t)(m0 + r_) * 512 + gi * 128 + c_, (f32x4){v_[0] * s[0], v_[1] * s[1], v_[2] * s[2], v_[3] * s[3]}); });
        } else {
            const int it = item - n_pool, kv = it >> 5, tm = it & 31, m0 = tm * 128;
            ARow ar{c.CMPH + ((size_t)kv * 4096 + m0 + (TID() >> 2)) * 256};
            gemm_core<0>(acc, ar, c.in(kv ? I_CW2V : I_CW2K) + (size_t)c.l * 256 * 64, 64, 64, 256, sA, sB);
            ACC_FOREACH(acc, { if (c_ < 64) *(f32x4*)(c.CMPO + ((size_t)kv * 4096 + m0 + r_) * 64 + c_) = v_; });
        }
    }
}

constexpr int CH = 32;
DI void scan_item(const Ctx& c, int item, unsigned char* lds) {
    const int tid = TID(), lane = tid & 63, wave = tid >> 6;
    const int b = item >> 3, h = item & 7;
    float* s_an = (float*)lds;
    float* s_wr = s_an + CH * 64;
    float* s_w = s_wr + CH * 64;
    float* s_bb = s_w + CH * 64;
    float* s_kp = s_bb + CH * 64;
    float* s_v = s_kp + CH * 64;
    float* s_y = s_v + CH * 64;
    float* s_sc = s_y + CH * 64;
    const int row = tid >> 3, cg = tid & 7;
    float st[8];
#pragma unroll
    for (int i = 0; i < 8; ++i) st[i] = 0.f;
    const size_t PL = (size_t)NT * 512;
    const int chn = h * 64 + lane;
    const float kkw = c.in(I_KK)[c.l * 512 + chn], kaw = c.in(I_KA)[c.l * 512 + chn], rkw = c.in(I_RK)[c.l * 512 + chn];
    const float gnw = c.in(I_GNW)[c.l * 512 + chn], gnb = c.in(I_GNB)[c.l * 512 + chn];
    for (int ck = 0; ck < SEQ / CH; ++ck) {
        __syncthreads();
        for (int sidx = wave; sidx < CH; sidx += 8) {
            const size_t o = (size_t)(b * SEQ + ck * CH + sidx) * 512 + chn;
            const float r = bf2f(c.F[o]), k = bf2f(c.F[o + PL]), v = bf2f(c.F[o + 2 * PL]), e = bf2f(c.F[o + 3 * PL]), a = bf2f(c.F[o + 4 * PL]);
            const float w = __expf(-e);
            const float kx = k * kkw;
            const float ss = wave_sum(kx * kx);
            const float kk = kx / fmaxf(sqrtf(ss), 1e-12f);
            const float kp = k * (1.0f + (a - 1.0f) * kaw);
            const float bb = kk * a;
            const float br = wave_sum(bb * r), kr = wave_sum(kp * r), bon = wave_sum(r * kp * rkw);
            s_an[sidx * 64 + lane] = -kk; s_wr[sidx * 64 + lane] = w * r; s_w[sidx * 64 + lane] = w; s_bb[sidx * 64 + lane] = bb; s_kp[sidx * 64 + lane] = kp; s_v[sidx * 64 + lane] = v;
            if (lane == 0) { s_sc[sidx * 4 + 0] = br; s_sc[sidx * 4 + 1] = kr; s_sc[sidx * 4 + 2] = bon; }
        }
        __syncthreads();
#pragma unroll 2
        for (int sidx = 0; sidx < CH; ++sidx) {
            const f32x4 an0 = *(const f32x4*)(s_an + sidx * 64 + cg * 8), an1 = *(const f32x4*)(s_an + sidx * 64 + cg * 8 + 4);
            const f32x4 wr0 = *(const f32x4*)(s_wr + sidx * 64 + cg * 8), wr1 = *(const f32x4*)(s_wr + sidx * 64 + cg * 8 + 4);
            const f32x4 w0 = *(const f32x4*)(s_w + sidx * 64 + cg * 8), w1 = *(const f32x4*)(s_w + sidx * 64 + cg * 8 + 4);
            const f32x4 b0 = *(const f32x4*)(s_bb + sidx * 64 + cg * 8), b1 = *(const f32x4*)(s_bb + sidx * 64 + cg * 8 + 4);
            const f32x4 k0 = *(const f32x4*)(s_kp + sidx * 64 + cg * 8), k1 = *(const f32x4*)(s_kp + sidx * 64 + cg * 8 + 4);
            const float vv = s_v[sidx * 64 + row];
            const f32x4 sc = *(const f32x4*)(s_sc + sidx * 4);
            float sa = st[0] * an0[0] + st[1] * an0[1] + st[2] * an0[2] + st[3] * an0[3] + st[4] * an1[0] + st[5] * an1[1] + st[6] * an1[2] + st[7] * an1[3];
            float sr = st[0] * wr0[0] + st[1] * wr0[1] + st[2] * wr0[2] + st[3] * wr0[3] + st[4] * wr1[0] + st[5] * wr1[1] + st[6] * wr1[2] + st[7] * wr1[3];
            sa += __shfl_xor(sa, 1); sr += __shfl_xor(sr, 1);
            sa += __shfl_xor(sa, 2); sr += __shfl_xor(sr, 2);
            sa += __shfl_xor(sa, 4); sr += __shfl_xor(sr, 4);
            st[0] = st[0] * w0[0] + sa * b0[0] + vv * k0[0]; st[1] = st[1] * w0[1] + sa * b0[1] + vv * k0[1];
            st[2] = st[2] * w0[2] + sa * b0[2] + vv * k0[2]; st[3] = st[3] * w0[3] + sa * b0[3] + vv * k0[3];
            st[4] = st[4] * w1[0] + sa * b1[0] + vv * k1[0]; st[5] = st[5] * w1[1] + sa * b1[1] + vv * k1[1];
            st[6] = st[6] * w1[2] + sa * b1[2] + vv * k1[2]; st[7] = st[7] * w1[3] + sa * b1[3] + vv * k1[3];
            if (cg == 0) s_y[sidx * 64 + row] = sr + sa * sc[0] + vv * sc[1];
        }
        __syncthreads();
        for (int sidx = wave; sidx < CH; sidx += 8) {
            const float y = s_y[sidx * 64 + lane];
            const float mean = wave_sum(y) * (1.0f / 64.0f);
            const float d = y - mean;
            const float var = wave_sum(d * d) * (1.0f / 64.0f);
            const float yn = d * rsqrtf(var + 64e-5f) * gnw + gnb;
            const size_t o = (size_t)(b * SEQ + ck * CH + sidx) * 512 + chn;
            const float g = bf2f(c.F[o + 5 * PL]);
            c.F[o + 5 * PL] = f2bf((yn + s_sc[sidx * 4 + 2] * s_v[sidx * 64 + lane]) * g);
        }
    }
    __syncthreads();
}

struct Flash { float m[4], l[4], o[4]; };
DI void attn_blk(const bf16_t* kbase, const bf16_t* vbase, int pos0, int t, int lo, const float* qs, const float* biasT, float* pb, Flash& f, int lane) {
    const int pos = pos0 + lane; const bool ok = (pos <= t) && (pos >= lo);
    const bf16_t* kr = kbase + (size_t)pos * IN_COLS;
    float a0 = 0.f, a1 = 0.f, a2 = 0.f, a3 = 0.f;
    u32x4 kw[8];
#pragma unroll
    for (int dd = 0; dd < 8; ++dd) kw[dd] = *(const u32x4*)(kr + dd * 8);
#pragma unroll
    for (int dd = 0; dd < 8; ++dd) {
        const float* qsl = qs;
        const float kf[8] = {bflo(kw[dd].x), bfhi(kw[dd].x), bflo(kw[dd].y), bfhi(kw[dd].y), bflo(kw[dd].z), bfhi(kw[dd].z), bflo(kw[dd].w), bfhi(kw[dd].w)};
#pragma unroll
        for (int hh = 0; hh < 2; ++hh) {
            const f32x4 q0 = *(const f32x4*)(qsl + 0 * 64 + dd * 8 + hh * 4), q1 = *(const f32x4*)(qsl + 1 * 64 + dd * 8 + hh * 4);
            const f32x4 q2 = *(const f32x4*)(qsl + 2 * 64 + dd * 8 + hh * 4), q3 = *(const f32x4*)(qsl + 3 * 64 + dd * 8 + hh * 4);
#pragma unroll
            for (int j = 0; j < 4; ++j) { a0 += kf[hh * 4 + j] * q0[j]; a1 += kf[hh * 4 + j] * q1[j]; a2 += kf[hh * 4 + j] * q2[j]; a3 += kf[hh * 4 + j] * q3[j]; }
        }
        asm volatile("" : "+v"(a0), "+v"(a1), "+v"(a2), "+v"(a3) :: "memory");
    }
    int di = t - pos; di = di < 0 ? 0 : (di > 128 ? 128 : di);
    const f32x4 bias = *(const f32x4*)(biasT + di * 4);
    float lg[4] = {a0 + bias[0], a1 + bias[1], a2 + bias[2], a3 + bias[3]};
    float p[4];
#pragma unroll
    for (int h = 0; h < 4; ++h) {
        const float x = ok ? lg[h] : -INFINITY;
        const float bm = wave_max(x);
        const float mn = fmaxf(f.m[h], bm);
        float pe = 0.f, sc = 1.f;
        if (mn > -INFINITY) { pe = ok ? __expf(x - mn) : 0.f; sc = (f.m[h] > -INFINITY) ? __expf(f.m[h] - mn) : 0.f; }
        f.l[h] = f.l[h] * sc + wave_sum(pe); f.o[h] *= sc; f.m[h] = mn; p[h] = pe;
    }
    LDS_WAVE_SYNC();
    *(f32x4*)(pb + lane * 4) = (f32x4){p[0], p[1], p[2], p[3]};
    LDS_WAVE_SYNC();
    const bf16_t* vr = vbase + (size_t)pos0 * IN_COLS + lane;
#pragma unroll 4
    for (int j = 0; j < 64; ++j) {
        const f32x4 pp = *(const f32x4*)(pb + j * 4);
        const float v = bf2f(vr[(size_t)j * IN_COLS]);
        f.o[0] += pp[0] * v; f.o[1] += pp[1] * v; f.o[2] += pp[2] * v; f.o[3] += pp[3] * v;
    }
}
DI void flash_init(Flash& f) {
#pragma unroll
    for (int h = 0; h < 4; ++h) { f.m[h] = -INFINITY; f.l[h] = 0.f; f.o[h] = 0.f; }
}
DI void nsa_item(const Ctx& c, int item, unsigned char* lds) {
    const int tid = TID(), lane = tid & 63, wave = tid >> 6;
    const int b = item >> 11, g = (item >> 9) & 3, t = (item & 511) * 8 + wave;
    float* biasT = (float*)lds;
    float* wl = (float*)(lds + 4096) + wave * 1600;
    float* qs = wl; float* lg = wl + 256; float* pb = wl + 1280;
    __syncthreads();
    for (int i = tid; i < 129 * 4; i += NTHREADS) { const int d = i >> 2, h = i & 3; biasT[i] = c.in(I_RELB)[t5_bucket(d) * 16 + g * 4 + h]; }
    __syncthreads();
    const size_t row = (size_t)b * SEQ + t;
    bf16_t* prow = c.PROJ + row * IN_COLS;
#pragma unroll
    for (int h = 0; h < 4; ++h) qs[h * 64 + lane] = bf2f(prow[C_Q + (g * 4 + h) * 64 + lane]) * 0.125f;
    float gate[4][3];
#pragma unroll
    for (int h = 0; h < 4; ++h)
#pragma unroll
        for (int br = 0; br < 3; ++br) gate[h][br] = sigmoidf_(bf2f(prow[C_GATE + g * 12 + h * 3 + br]));
    LDS_WAVE_SYNC();
    const int nvis = (t >= 31) ? (((t - 31) >> 4) + 1 > NCMP ? NCMP : ((t - 31) >> 4) + 1) : 0;
    const float* kc = c.CMPO + ((size_t)0 * 4096 + (b * 4 + g) * 256) * 64;
    const float* vc = c.CMPO + ((size_t)1 * 4096 + (b * 4 + g) * 256) * 64;
    float oc[4] = {0.f, 0.f, 0.f, 0.f};
    float imp = 0.f;
    for (int ci = 0; ci < 4; ++ci) {
        const int cc = ci * 64 + lane; const bool ok = cc < nvis;
        float a0 = 0.f, a1 = 0.f, a2 = 0.f, a3 = 0.f;
        if (ci * 64 < nvis) {
            const float* kr = kc + (size_t)(cc < 256 ? cc : 255) * 64;
#pragma unroll 1
            for (int d4 = 0; d4 < 4; ++d4) {
                f32x4 kv[4];
#pragma unroll
                for (int u = 0; u < 4; ++u) kv[u] = *(const f32x4*)(kr + d4 * 16 + u * 4);
#pragma unroll
                for (int u = 0; u < 4; ++u) {
                    const int dd = d4 * 4 + u;
                    const float* qsl = qs;
                    const f32x4 q0 = *(const f32x4*)(qsl + dd * 4), q1 = *(const f32x4*)(qsl + 64 + dd * 4), q2 = *(const f32x4*)(qsl + 128 + dd * 4), q3 = *(const f32x4*)(qsl + 192 + dd * 4);
#pragma unroll
                    for (int j = 0; j < 4; ++j) { a0 += kv[u][j] * q0[j]; a1 += kv[u][j] * q1[j]; a2 += kv[u][j] * q2[j]; a3 += kv[u][j] * q3[j]; }
                    asm volatile("" : "+v"(a0), "+v"(a1), "+v"(a2), "+v"(a3) :: "memory");
                }
            }
        }
        int di = t - (16 * cc + 31); di = di < 0 ? 0 : (di > 128 ? 128 : di);
        const f32x4 bias = *(const f32x4*)(biasT + di * 4);
        *(f32x4*)(lg + cc * 4) = ok ? (f32x4){a0 + bias[0], a1 + bias[1], a2 + bias[2], a3 + bias[3]} : (f32x4){-INFINITY, -INFINITY, -INFINITY, -INFINITY};
    }
    LDS_WAVE_SYNC();
    if (nvis > 0) {
        float mx[4] = {-INFINITY, -INFINITY, -INFINITY, -INFINITY};
#pragma unroll
        for (int ci = 0; ci < 4; ++ci) { const f32x4 x = *(const f32x4*)(lg + (ci * 64 + lane) * 4);
#pragma unroll
            for (int h = 0; h < 4; ++h) mx[h] = fmaxf(mx[h], x[h]); }
#pragma unroll
        for (int h = 0; h < 4; ++h) mx[h] = wave_max(mx[h]);
        float sm[4] = {0.f, 0.f, 0.f, 0.f};
        f32x4 ex[4];
#pragma unroll
        for (int ci = 0; ci < 4; ++ci) { const f32x4 x = *(const f32x4*)(lg + (ci * 64 + lane) * 4);
#pragma unroll
            for (int h = 0; h < 4; ++h) { ex[ci][h] = (x[h] > -INFINITY) ? __expf(x[h] - mx[h]) : 0.f; sm[h] += ex[ci][h]; } }
#pragma unroll
        for (int h = 0; h < 4; ++h) sm[h] = 1.0f / wave_sum(sm[h]);
        LDS_WAVE_SYNC();
#pragma unroll
        for (int ci = 0; ci < 4; ++ci) *(f32x4*)(lg + (ci * 64 + lane) * 4) = (f32x4){ex[ci][0] * sm[0], ex[ci][1] * sm[1], ex[ci][2] * sm[2], ex[ci][3] * sm[3]};
        LDS_WAVE_SYNC();
        for (int cc = 0; cc < nvis; ++cc) {
            const f32x4 pp = *(const f32x4*)(lg + cc * 4);
            const float v = vc[(size_t)cc * 64 + lane];
            oc[0] += pp[0] * v; oc[1] += pp[1] * v; oc[2] += pp[2] * v; oc[3] += pp[3] * v;
        }
#pragma unroll
        for (int j = -1; j <= 3; ++j) { const int cc = 4 * lane + j; if (cc >= 0 && cc < NCMP) { const f32x4 pp = *(const f32x4*)(lg + cc * 4); imp += (pp[0] + pp[1]) + (pp[2] + pp[3]); } }
    }
    const int cur = t >> 6;
    float score;
    { const bool valid = lane <= cur; const bool forced = (lane == 0) || (lane == cur) || (lane == cur - 1); score = valid ? imp + (forced ? 1000.f : 0.f) : -1.0f; }
    int* selb = (int*)(pb + 256);
#pragma unroll 1
    for (int r = 0; r < 8; ++r) {
        const float mx = wave_max(score);
        const unsigned long long bal = __ballot(score == mx);
        const int win = __ffsll((long long)bal) - 1;
        if (lane == 0) selb[r] = (mx >= 0.f) ? win : -1;
        if (lane == win) score = -2.0f;
    }
    LDS_WAVE_SYNC();
    Flash fs; flash_init(fs);
    const bf16_t* pb_b = c.PROJ + (size_t)b * SEQ * IN_COLS + g * 64;
#pragma unroll 1
    for (int r = 0; r < 8; ++r) { const int sb = selb[r]; if (sb >= 0) attn_blk(pb_b + C_KS, pb_b + C_VS, sb * 64, t, 0, qs, biasT, pb, fs, lane); }
    Flash fw; flash_init(fw);
    const int lo = (t - 511 > 0) ? t - 511 : 0;
#pragma unroll 1
    for (int jb = lo >> 6; jb <= cur; ++jb) attn_blk(pb_b + C_KW, pb_b + C_VW, jb * 64, t, lo, qs, biasT, pb, fw, lane);
#pragma unroll
    for (int h = 0; h < 4; ++h) {
        const float y = gate[h][0] * oc[h] + gate[h][1] * fs.o[h] / fs.l[h] + gate[h][2] * fw.o[h] / fw.l[h];
        prow[C_Q + (g * 4 + h) * 64 + lane] = f2bf(y);
    }
}
DI void phase_mix(const Ctx& c, unsigned char* lds) {
    const int G = gridDim.x, bid = blockIdx.x;
    const int n_nsa = NB * 4 * (SEQ / 8);
    const bool split = G > 64;
    if (!split || bid < 32) for (int item = bid; item < 32; item += G) scan_item(c, item, lds);
    const int first = split ? bid - 32 : bid, stride = split ? G - 32 : G;
    if (first >= 0) for (int item = first; item < n_nsa; item += stride) nsa_item(c, item, lds);
}

DI void phase_merge(const Ctx& c, bf16_t* sA, bf16_t* sB) {
    const int nM = NT / 128, nN = DM / 128;
    const float* WM = c.in(I_WMG) + (size_t)c.l * DM * 3 * DM;
    const float* BM_ = c.in(I_BMG) + (size_t)c.l * 3 * DM;
    const float* WB = c.in(I_WBR) + (size_t)c.l * 2048 * DM;
    for (int tile = blockIdx.x; tile < nM * nN; tile += gridDim.x) {
        const int tm = tile % nM, tn = tile / nM, m0 = tm * 128, n0 = tn * 128;
        const int arow = m0 + (TID() >> 2);
        f32x4 mer[2][4]; acc_zero(mer);
#pragma unroll 1
        for (int i = 0; i < 3; ++i) {
            f32x4 ag[2][4]; acc_zero(ag);
            { ARow ar{c.H + (size_t)arow * DM}; gemm_core<0>(ag, ar, WM + i * DM + n0, 3 * DM, 128, DM, sA, sB); }
            f32x4 ab[2][4]; acc_zero(ab);
            if (i == 0) { ARow ar{c.POOLED + (size_t)arow * 512}; gemm_core<0>(ab, ar, WB + n0, DM, 128, 512, sA, sB); }
            else if (i == 1) { ARow ar{c.F + (size_t)5 * NT * 512 + (size_t)arow * 512}; gemm_core<0>(ab, ar, WB + (size_t)512 * DM + n0, DM, 128, 512, sA, sB); }
            else { ARow ar{c.PROJ + (size_t)arow * IN_COLS + C_Q}; gemm_core<0>(ab, ar, WB + (size_t)1024 * DM + n0, DM, 128, 1024, sA, sB); }
            const int lane = TID() & 63, wave = TID() >> 6;
#pragma unroll
            for (int mi = 0; mi < 2; ++mi)
#pragma unroll
                for (int ni = 0; ni < 4; ++ni) {
                    const int cc = (wave & 1) * 64 + ni * 16 + (lane >> 4) * 4;
                    const f32x4 bb = *(const f32x4*)(BM_ + i * DM + n0 + cc);
#pragma unroll
                    for (int j = 0; j < 4; ++j) mer[mi][ni][j] += sigmoidf_(ag[mi][ni][j] + bb[j]) * ab[mi][ni][j];
                }
        }
        ACC_FOREACH(mer, { store_bf4(c.MERGED + (size_t)(m0 + r_) * DM + n0 + c_, v_); });
    }
}

DI void phase_outp(const Ctx& c, bf16_t* sA, bf16_t* sB) {
    const int nM = NT / 128, nN = DM / 128;
    const float* W = c.in(I_WOUT) + (size_t)c.l * DM * DM;
    const float* xin = (c.l == 0) ? c.in(I_X) : c.out;
    for (int tile = blockIdx.x; tile < nM * nN; tile += gridDim.x) {
        const int tm = tile % nM, tn = tile / nM, m0 = tm * 128, n0 = tn * 128;
        f32x4 acc[2][4]; acc_zero(acc);
        ARow ar{c.MERGED + (size_t)(m0 + (TID() >> 2)) * DM};
        gemm_core<0>(acc, ar, W + n0, DM, 128, DM, sA, sB);
        ACC_FOREACH(acc, { const size_t o = (size_t)(m0 + r_) * DM + n0 + c_; const f32x4 x = *(const f32x4*)(xin + o); *(f32x4*)(c.out + o) = x + v_; });
    }
}

DI void phase_norm2(const Ctx& c) {
    const int tid = TID(), lane = tid & 63, wave = tid >> 6;
    const float* gain = c.in(I_NFFN) + c.l * DM;
    const float* wrg = c.in(I_WRG) + (size_t)c.l * DM * 4; const float* brg = c.in(I_BRG) + c.l * 4;
    const float* wre = c.in(I_WRE) + (size_t)c.l * DM * 32; const float* bre = c.in(I_BRE) + c.l * 32;
    unsigned* cnt = c.ctl + CW_CNT + c.l * 32;
    for (int row = blockIdx.x * 8 + wave; row < NT; row += gridDim.x * 8) {
        f32x4 v[4];
        float ss = 0.f;
#pragma unroll
        for (int i = 0; i < 4; ++i) { v[i] = *(const f32x4*)(c.out + (size_t)row * DM + i * 256 + lane * 4); ss += v[i][0] * v[i][0] + v[i][1] * v[i][1] + v[i][2] * v[i][2] + v[i][3] * v[i][3]; }
        ss = wave_sum(ss);
        const float rs = rsqrtf(ss * (1.0f / DM) + 1e-6f);
#pragma unroll
        for (int i = 0; i < 4; ++i) {
            const f32x4 g = *(const f32x4*)(gain + i * 256 + lane * 4);
            v[i] = (f32x4){v[i][0] * rs * g[0], v[i][1] * rs * g[1], v[i][2] * rs * g[2], v[i][3] * rs * g[3]};
            store_bf4(c.H + (size_t)row * DM + i * 256 + lane * 4, v[i]);
        }
        float lgp[4] = {0.f, 0.f, 0.f, 0.f};
#pragma unroll
        for (int i = 0; i < 4; ++i)
#pragma unroll
            for (int j = 0; j < 4; ++j) { const f32x4 w = *(const f32x4*)(wrg + (size_t)(i * 256 + lane * 4 + j) * 4); lgp[0] += v[i][j] * w[0]; lgp[1] += v[i][j] * w[1]; lgp[2] += v[i][j] * w[2]; lgp[3] += v[i][j] * w[3]; }
#pragma unroll
        for (int o = 0; o < 4; ++o) lgp[o] = wave_sum(lgp[o]) + brg[o];
        int grp = 0; float gm = lgp[0];
#pragma unroll
        for (int o = 1; o < 4; ++o) if (lgp[o] > gm) { gm = lgp[o]; grp = o; }
        float gs = 0.f;
#pragma unroll
        for (int o = 0; o < 4; ++o) gs += __expf(lgp[o] - gm);
        const float ptop = 1.0f / gs;
        float le[8] = {0.f, 0.f, 0.f, 0.f, 0.f, 0.f, 0.f, 0.f};
#pragma unroll
        for (int i = 0; i < 4; ++i)
#pragma unroll
            for (int j = 0; j < 4; ++j) {
                const float* wp = wre + (size_t)(i * 256 + lane * 4 + j) * 32 + grp * 8;
                const f32x4 w0 = *(const f32x4*)wp, w1 = *(const f32x4*)(wp + 4);
                le[0] += v[i][j] * w0[0]; le[1] += v[i][j] * w0[1]; le[2] += v[i][j] * w0[2]; le[3] += v[i][j] * w0[3];
                le[4] += v[i][j] * w1[0]; le[5] += v[i][j] * w1[1]; le[6] += v[i][j] * w1[2]; le[7] += v[i][j] * w1[3];
            }
#pragma unroll
        for (int o = 0; o < 8; ++o) le[o] = wave_sum(le[o]) + bre[grp * 8 + o];
        int i0 = 0; float v0 = le[0];
#pragma unroll
        for (int o = 1; o < 8; ++o) if (le[o] > v0) { v0 = le[o]; i0 = o; }
        int i1 = -1; float v1 = -INFINITY;
#pragma unroll
        for (int o = 0; o < 8; ++o) if (o != i0 && le[o] > v1) { v1 = le[o]; i1 = o; }
        const float e1 = __expf(v1 - v0), inv = 1.0f / (1.0f + e1);
        if (lane == 0) {
            int* rt = c.ROUTE + (size_t)row * 8;
            const int ex0 = grp * 8 + i0, ex1 = grp * 8 + i1;
            rt[0] = ex0; rt[1] = ex1; ((float*)rt)[2] = inv * ptop; ((float*)rt)[3] = e1 * inv * ptop;
            atomicAdd(cnt + ex0, 1u); atomicAdd(cnt + ex1, 1u);
        }
    }
}
DI void phase_route2(const Ctx& c, unsigned char* lds) {
    int* soff = (int*)lds;
    const unsigned* cnt = c.ctl + CW_CNT + c.l * 32;
    unsigned* cur = c.ctl + CW_CUR + c.l * 32;
    __syncthreads();
    if (TID() == 0) { int s = 0; for (int e = 0; e < 32; ++e) { soff[e] = s; s += (int)cnt[e]; } }
    __syncthreads();
    for (int t = blockIdx.x * NTHREADS + TID(); t < NT; t += gridDim.x * NTHREADS) {
        int* rt = c.ROUTE + (size_t)t * 8;
#pragma unroll
        for (int s = 0; s < 2; ++s) {
            const int e = rt[s];
            const int p = soff[e] + (int)atomicAdd(cur + e, 1u);
            rt[4 + s] = p;
            c.ENT[2 * p] = t; ((float*)c.ENT)[2 * p + 1] = ((const float*)rt)[2 + s];
        }
    }
}
DI void moe_tables(const Ctx& c, int* soff, int* stile, int ncol) {
    const unsigned* cnt = c.ctl + CW_CNT + c.l * 32;
    __syncthreads();
    if (TID() == 0) { int s = 0, tt = 0; for (int e = 0; e < 32; ++e) { soff[e] = s; stile[e] = tt; s += (int)cnt[e]; tt += (((int)cnt[e] + 127) >> 7) * ncol; } soff[32] = s; stile[32] = tt; }
    __syncthreads();
}
DI void phase_moe_up(const Ctx& c, unsigned char* lds) {
    bf16_t* sA = (bf16_t*)lds; bf16_t* sB = sA + 128 * GS; int* soff = (int*)(lds + 32768); int* stile = soff + 64;
    moe_tables(c, soff, stile, 2);
    const int total = stile[32];
    for (int item = blockIdx.x; item < total; item += gridDim.x) {
        int e = 0;
        for (int q = 1; q < 32; ++q) if (stile[q] <= item) e = q;
        const int loc = item - stile[e], tm = loc >> 1, tn = loc & 1, n0 = tn * 128;
        const int p0 = soff[e] + tm * 128, pend = soff[e + 1];
        const int pr = p0 + (TID() >> 2);
        ARow ar{(pr < pend) ? c.H + (size_t)c.ENT[2 * pr] * DM : nullptr};
        f32x4 ag[2][4], au[2][4]; acc_zero(ag); acc_zero(au);
        gemm_core<0>(ag, ar, c.in(I_EG) + ((size_t)c.l * 32 + e) * DM * 256 + n0, 256, 128, DM, sA, sB);
        gemm_core<0>(au, ar, c.in(I_EU) + ((size_t)c.l * 32 + e) * DM * 256 + n0, 256, 128, DM, sA, sB);
        const int lane = TID() & 63, wave = TID() >> 6;
#pragma unroll
        for (int mi = 0; mi < 2; ++mi)
#pragma unroll
            for (int ni = 0; ni < 4; ++ni) {
                const int r = (wave >> 1) * 32 + mi * 16 + (lane & 15), cc = (wave & 1) * 64 + ni * 16 + (lane >> 4) * 4;
                if (p0 + r < pend) {
                    f32x4 hv;
#pragma unroll
                    for (int j = 0; j < 4; ++j) { const float gq = ag[mi][ni][j]; hv[j] = gq * sigmoidf_(gq) * au[mi][ni][j]; }
                    store_bf4(c.HID + (size_t)(p0 + r) * 256 + n0 + cc, hv);
                }
            }
    }
}
DI void phase_moe_down(const Ctx& c, unsigned char* lds) {
    bf16_t* sA = (bf16_t*)lds; bf16_t* sB = sA + 128 * GS; int* soff = (int*)(lds + 32768); int* stile = soff + 64;
    moe_tables(c, soff, stile, 8);
    const int total = stile[32];
    for (int item = blockIdx.x; item < total; item += gridDim.x) {
        int e = 0;
        for (int q = 1; q < 32; ++q) if (stile[q] <= item) e = q;
        const int loc = item - stile[e], tm = loc >> 3, tn = loc & 7, n0 = tn * 128;
        const int p0 = soff[e] + tm * 128, pend = soff[e + 1];
        const int pr = p0 + (TID() >> 2);
        ARow ar{(pr < pend) ? c.HID + (size_t)pr * 256 : nullptr};
        f32x4 acc[2][4]; acc_zero(acc);
        gemm_core<0>(acc, ar, c.in(I_ED) + ((size_t)c.l * 32 + e) * 256 * DM + n0, DM, 128, 256, sA, sB);
        ACC_FOREACH(acc, { if (p0 + r_ < pend) { const float w = ((const float*)c.ENT)[2 * (p0 + r_) + 1];
            store_bf4(c.Y + (size_t)(p0 + r_) * DM + n0 + c_, (f32x4){v_[0] * w, v_[1] * w, v_[2] * w, v_[3] * w}); } });
    }
}
DI void phase_final(const Ctx& c) {
    const int tid = TID(), lane = tid & 63, wave = tid >> 6;
    const float* gain = c.in(I_NFIN);
    for (int row = blockIdx.x * 8 + wave; row < NT; row += gridDim.x * 8) {
        f32x4 v[4];
#pragma unroll
        for (int i = 0; i < 4; ++i) v[i] = *(const f32x4*)(c.out + (size_t)row * DM + i * 256 + lane * 4);
        add_moe_rows(c, row, lane, v);
        float ss = 0.f;
#pragma unroll
        for (int i = 0; i < 4; ++i) ss += v[i][0] * v[i][0] + v[i][1] * v[i][1] + v[i][2] * v[i][2] + v[i][3] * v[i][3];
        ss = wave_sum(ss);
        const float rs = rsqrtf(ss * (1.0f / DM) + 1e-6f);
#pragma unroll
        for (int i = 0; i < 4; ++i) {
            const f32x4 g = *(const f32x4*)(gain + i * 256 + lane * 4);
            *(f32x4*)(c.out + (size_t)row * DM + i * 256 + lane * 4) = (f32x4){v[i][0] * rs * g[0], v[i][1] * rs * g[1], v[i][2] * rs * g[2], v[i][3] * rs * g[3]};
        }
    }
}

constexpr int PH_PER_LAYER = 11, N_PHASES = DEPTH * PH_PER_LAYER + 1;
__global__ void __launch_bounds__(NTHREADS, 2) fwd_kernel(Params P) {
    extern __shared__ __attribute__((aligned(16))) unsigned char lds[];
    const int lo = P.ph_lo, hi = P.ph_hi;
    LAS unsigned* xbw = (LAS unsigned*)(lds + LDS_BYTES - 16);
    if (threadIdx.x == 0) { xbw[0] = 0u; xbw[1] = 0u; xbw[2] = 0u; xbw[3] = 0u; }
    __syncthreads();
    Ctx c; c.P = &P; c.ws = P.ws; c.out = P.out; c.l = 0;
    c.ctl = (unsigned*)(P.ws + WS_CTL);
    c.H = (bf16_t*)(P.ws + WS_H); c.PROJ = (bf16_t*)(P.ws + WS_PROJ); c.F = (bf16_t*)(P.ws + WS_F); c.POOLED = (bf16_t*)(P.ws + WS_POOLED);
    c.MERGED = (bf16_t*)(P.ws + WS_F); c.CMPH = (bf16_t*)(P.ws + WS_CMPH); c.CMPO = (float*)(P.ws + WS_CMPO); c.POSB = (float*)(P.ws + WS_POSB);
    c.ROUTE = (int*)(P.ws + WS_ROUTE); c.ENT = (int*)(P.ws + WS_ENT); c.HID = (bf16_t*)(P.ws + WS_HID); c.Y = (bf16_t*)(P.ws + WS_Y);
    XcdBarrier bar; bar.bar = c.ctl + CW_BAR; bar.x = 0; bar.st = (volatile LAS unsigned*)xbw;
    if (hi - lo > 1) bar = xcd_barrier_post(c.ctl + CW_BAR, (volatile LAS unsigned*)xbw);
    bf16_t* sA = (bf16_t*)lds; bf16_t* sB = sA + 128 * GS;
#define IN(k) (lo <= (k) && (k) < hi)
#define SEAM(k) do { if (IN(k) && IN((k) + 1)) xcd_barrier(bar); } while (0)
#pragma unroll 1
    for (int l = 0; l < DEPTH; ++l) {
        c.l = l; const int pb = l * PH_PER_LAYER;
        if (IN(pb + 0)) phase_norm1(c);
        SEAM(pb + 0);
        if (IN(pb + 1)) phase_gemm1(c, sA, sB);
        SEAM(pb + 1);
        if (IN(pb + 2)) phase_prep(c, lds);
        SEAM(pb + 2);
        if (IN(pb + 3)) phase_poolgemm(c, sA, sB);
        SEAM(pb + 3);
        if (IN(pb + 4)) phase_mix(c, lds);
        SEAM(pb + 4);
        if (IN(pb + 5)) phase_merge(c, sA, sB);
        SEAM(pb + 5);
        if (IN(pb + 6)) phase_outp(c, sA, sB);
        SEAM(pb + 6);
        if (IN(pb + 7)) phase_norm2(c);
        SEAM(pb + 7);
        if (IN(pb + 8)) phase_route2(c, lds);
        SEAM(pb + 8);
        if (IN(pb + 9)) phase_moe_up(c, lds);
        SEAM(pb + 9);
        if (IN(pb + 10)) phase_moe_down(c, lds);
        SEAM(pb + 10);
    }
    if (IN(N_PHASES - 1)) phase_final(c);
}

#ifndef MK_N_LAUNCHES
#define MK_N_LAUNCHES 1
#endif
extern "C" void kernel_launch(void* const* d_in, const int* in_sizes, int n_in, void* d_out, int out_size, void* d_ws, size_t ws_size, hipStream_t stream) {
    static int grid = 0;
    if (grid == 0) {
        if (n_in != N_IN || out_size != NT * DM || ws_size < WS_END) { fprintf(stderr, "kernel_launch: unexpected shapes n_in %d out %d ws %zu (need %zu)\n", n_in, out_size, ws_size, (size_t)WS_END); grid = -1; return; }
        int dev = 0, cus = 0, per_cu = 0;
        if (hipGetDevice(&dev) != hipSuccess || hipDeviceGetAttribute(&cus, hipDeviceAttributeMultiprocessorCount, dev) != hipSuccess) { grid = -1; return; }
        if (hipFuncSetAttribute((const void*)fwd_kernel, hipFuncAttributeMaxDynamicSharedMemorySize, LDS_BYTES) != hipSuccess) { fprintf(stderr, "kernel_launch: hipFuncSetAttribute failed\n"); grid = -1; return; }
        if (hipOccupancyMaxActiveBlocksPerMultiprocessor(&per_cu, (const void*)fwd_kernel, NTHREADS, LDS_BYTES) != hipSuccess || per_cu < 1) { fprintf(stderr, "kernel_launch: occupancy query says %d\n", per_cu); }
        (void)hipGetLastError();
        grid = cus;
    }
    if (grid < 0) return;
    if (hipMemsetAsync((char*)d_ws + WS_CTL, 0, CTL_BYTES, stream) != hipSuccess) return;
    Params p{};
    for (int i = 0; i < N_IN; ++i) p.in[i] = (const float*)d_in[i];
    p.out = (float*)d_out; p.ws = (unsigned char*)d_ws;
    if (MK_N_LAUNCHES == 1) {
        p.ph_lo = 0; p.ph_hi = N_PHASES;
        hipLaunchKernelGGL(fwd_kernel, dim3(grid), dim3(NTHREADS), LDS_BYTES, stream, p);
    } else {
        for (int k = 0; k < N_PHASES; ++k) { p.ph_lo = k; p.ph_hi = k + 1; hipLaunchKernelGGL(fwd_kernel, dim3(grid), dim3(NTHREADS), LDS_BYTES, stream, p); }
    }
}
```

```cpp
#include <hip/hip_runtime.h>
#include <cstdio>
#include <cstdint>

#define DI __device__ __forceinline__
typedef unsigned short bf16_t;
typedef short bf16x8 __attribute__((ext_vector_type(8)));
typedef float f32x4 __attribute__((ext_vector_type(4)));
typedef unsigned u32x4 __attribute__((ext_vector_type(4)));
typedef unsigned u32x2 __attribute__((ext_vector_type(2)));

constexpr int NB = 4, SEQ = 4096, DM = 1024, NT = NB * SEQ, DEPTH = 2;
constexpr int IN_COLS = 4816;
constexpr int C_POOL = 0, C_RW = 512, C_R = 512, C_K = 1024, C_V = 1536, C_WD = 2048, C_AD = 2080, C_GD = 2112;
constexpr int C_Q = 2208, C_KC = 3232, C_VC = 3488, C_KS = 3744, C_VS = 4000, C_KW = 4256, C_VW = 4512, C_GATE = 4768;
constexpr int RWC = 1696;
constexpr int NCMP = 255;
constexpr int NTHREADS = 512;
constexpr int LDS_BYTES = 98304;

enum { I_X = 0, I_RELB, I_NMIX, I_WIN, I_POOLW, I_POOLS, I_MU, I_W0, I_WUP, I_A0, I_AUP, I_GUP, I_KK, I_KA, I_RK, I_GNW, I_GNB,
       I_CPK, I_CW1K, I_CW2K, I_CPV, I_CW1V, I_CW2V, I_WBR, I_WMG, I_BMG, I_WOUT, I_NFFN, I_WRG, I_BRG, I_WRE, I_BRE, I_EG, I_EU, I_ED, I_NFIN, N_IN };

constexpr size_t WS_CTL = 0;
constexpr size_t CTL_BYTES = 65536;
constexpr size_t WS_H = CTL_BYTES;
constexpr size_t WS_PROJ = WS_H + (size_t)NT * DM * 2;
constexpr size_t WS_F = WS_PROJ + (size_t)NT * IN_COLS * 2;
constexpr size_t PLANE = (size_t)NT * 512 * 2;
constexpr size_t WS_POOLED = WS_F + 6 * PLANE;
constexpr size_t WS_CMPH = WS_POOLED + PLANE;
constexpr size_t WS_CMPO = WS_CMPH + (size_t)2 * 4096 * 256 * 2;
constexpr size_t WS_POSB = WS_CMPO + (size_t)2 * 4096 * 64 * 4;
constexpr size_t WS_ROUTE = WS_POSB + 4096;
constexpr size_t WS_ENT = WS_ROUTE + (size_t)NT * 32;
constexpr size_t WS_VT = WS_ENT + (size_t)2 * NT * 8;
constexpr size_t WS_KC = WS_VT + (size_t)2 * 16 * 64 * SEQ * 2;
constexpr size_t WS_VCT = WS_KC + (size_t)16 * 256 * 64 * 2;
constexpr size_t WS_END = WS_VCT + (size_t)16 * 64 * 256 * 2;
constexpr size_t WS_HID = WS_PROJ;
constexpr size_t WS_Y = WS_PROJ + (size_t)2 * NT * 256 * 2;
static_assert(WS_Y + (size_t)2 * NT * 1024 * 2 <= WS_F, "alias");
constexpr int CW_BAR = 0;
constexpr int CW_CNT = 4096;
constexpr int CW_CUR = 4096 + 64;
constexpr int CW_Q = 4096 + 128;

#define XB_TMO      128
#define XB_XCNT(j)  (256  + 64 * (j))
#define XB_XSUB(j)  (1280 + 64 * (j))
#define XB_XGEN(j)  (2304 + 64 * (j))
#define XB_TOP      3328
#define XB_TOPGEN   3392
#define XCD_BAR_WORDS 3456
#define XB_SPIN_CAP (1u << 18)
#define LAS __attribute__((address_space(3)))

__device__ __forceinline__ unsigned xb_ld(unsigned* p)              { return __hip_atomic_load(p, __ATOMIC_RELAXED, __HIP_MEMORY_SCOPE_AGENT); }
__device__ __forceinline__ unsigned xb_add(unsigned* p, unsigned v) { return __hip_atomic_fetch_add(p, v, __ATOMIC_RELAXED, __HIP_MEMORY_SCOPE_AGENT); }
__device__ __forceinline__ unsigned xb_xcc_id() { return (unsigned)__builtin_amdgcn_s_getreg((3 << 11) | 20) & 0xFu; }
#define XB_SPIN(cond, bar) do { unsigned _sp = 0; while (cond) { __builtin_amdgcn_s_sleep(1); \
    if ((++_sp & 255u) == 0u) { if (xb_ld(&(bar)[XB_TMO])) break; if (_sp > XB_SPIN_CAP) { atomicAdd(&(bar)[XB_TMO], 1u); break; } } } } while (0)

struct XcdBarrier { unsigned* bar; unsigned x; volatile LAS unsigned* st; };

__device__ __forceinline__ XcdBarrier xcd_barrier_post(unsigned* bar, volatile LAS unsigned* st) {
    XcdBarrier b; b.bar = bar; b.x = xb_xcc_id(); b.st = st;
    if (threadIdx.x == 0) (void)xb_add(&bar[XB_XCNT(b.x)], 1u);
    return b;
}
__device__ __forceinline__ void xcd_barrier_complete(unsigned* bar, unsigned x, unsigned& nloc, unsigned& nx) {
    const unsigned G = gridDim.x * gridDim.y * gridDim.z;
    unsigned sum, cnt, mine, sp = 0u;
    for (;;) {
        sum = 0u; cnt = 0u; mine = 0u;
#pragma unroll
        for (unsigned j = 0; j < 16; ++j) { const unsigned c = xb_ld(&bar[XB_XCNT(j)]); sum += c; cnt += (c > 0u) ? 1u : 0u; mine = (j == x) ? c : mine; }
        if (sum == G) break;
        __builtin_amdgcn_s_sleep(1);
        if ((++sp & 255u) == 0u) { if (xb_ld(&bar[XB_TMO])) break; if (sp > XB_SPIN_CAP) { atomicAdd(&bar[XB_TMO], 1u); break; } }
    }
    nloc = mine > 0u ? mine : 1u; nx = cnt > 0u ? cnt : 1u;
}
__device__ __forceinline__ void xcd_barrier(const XcdBarrier& b) {
    asm volatile("s_waitcnt vmcnt(0)" ::: "memory");
    __syncthreads();
    if (threadIdx.x == 0) {
        unsigned* bar = b.bar;
        __builtin_amdgcn_s_waitcnt(0);
        unsigned nloc = b.st[0], nx = b.st[1];
        if (nloc == 0u) { xcd_barrier_complete(bar, b.x, nloc, nx); b.st[0] = nloc; b.st[1] = nx; }
        const unsigned old = xb_add(&bar[XB_XSUB(b.x)], 1u);
        const unsigned gen = old / nloc;
        if (old + 1u == (gen + 1u) * nloc) {
            __builtin_amdgcn_fence(__ATOMIC_RELEASE, "agent");
            asm volatile("s_waitcnt vmcnt(0)" ::: "memory");
            const unsigned og = xb_add(&bar[XB_TOP], 1u);
            const unsigned tg = og / nx;
            if (og + 1u == (tg + 1u) * nx) xb_add(&bar[XB_TOPGEN], 1u);
            else XB_SPIN(xb_ld(&bar[XB_TOPGEN]) == tg, bar);
            __builtin_amdgcn_fence(__ATOMIC_ACQUIRE, "agent");
            xb_add(&bar[XB_XGEN(b.x)], 1u);
            asm volatile("s_waitcnt vmcnt(0)" ::: "memory");
        } else {
            XB_SPIN(xb_ld(&bar[XB_XGEN(b.x)]) == gen, bar);
            __builtin_amdgcn_fence(__ATOMIC_ACQUIRE, "agent");
            asm volatile("s_waitcnt vmcnt(0)" ::: "memory");
        }
    }
    __syncthreads();
}

DI bf16_t f2bf(float x) { unsigned u = __float_as_uint(x); u += 0x7fffu + ((u >> 16) & 1u); return (bf16_t)(u >> 16); }
DI float bf2f(bf16_t b) { return __uint_as_float((unsigned)b << 16); }
DI unsigned pack2(float lo, float hi) { return (unsigned)f2bf(lo) | ((unsigned)f2bf(hi) << 16); }
DI float bflo(unsigned w) { return __uint_as_float(w << 16); }
DI float bfhi(unsigned w) { return __uint_as_float(w & 0xffff0000u); }
DI float wave_sum(float v) {
#pragma unroll
    for (int o = 32; o >= 1; o >>= 1) v += __shfl_xor(v, o);
    return v;
}
DI float wave_max(float v) {
#pragma unroll
    for (int o = 32; o >= 1; o >>= 1) v = fmaxf(v, __shfl_xor(v, o));
    return v;
}
DI float sigmoidf_(float x) { return 1.0f / (1.0f + __expf(-x)); }
DI int TID() { int t = threadIdx.x; asm volatile("" : "+v"(t)); return t; }
#define LDS_WAVE_SYNC() asm volatile("s_waitcnt lgkmcnt(0)" ::: "memory")

struct Params { const float* in[N_IN]; float* out; unsigned char* ws; int ph_lo, ph_hi; };

DI int t5_bucket(int n) {
    if (n < 16) return n;
    if (n >= 128) return 31;
    int b = 16;
    b += (n >= 19) + (n >= 21) + (n >= 24) + (n >= 27) + (n >= 31) + (n >= 35) + (n >= 40) + (n >= 46) + (n >= 52) + (n >= 59) + (n >= 67) + (n >= 77) + (n >= 87) + (n >= 99) + (n >= 113);
    return b;
}

constexpr int GS = 40;
struct ARow { const bf16_t* p; };
template <int AMODE>
DI u32x4 a_load(const ARow& r, int k) {
    if (r.p == nullptr) return (u32x4){0u, 0u, 0u, 0u};
    const bf16_t* q = (AMODE == 0) ? (r.p + k) : (r.p + (size_t)(k >> 6) * IN_COLS + (k & 63));
    return *(const u32x4*)q;
}
template <int AMODE>
DI void gemm_core(f32x4 (&acc)[2][4], const ARow& arow, const float* __restrict__ Bp, int ldb, int ncols_valid  , int K, bf16_t* sA, bf16_t* sB) {
    const int tid = TID(), lane = tid & 63, wave = tid >> 6, wm = wave >> 1, wn = wave & 1;
    const int ar = tid >> 2, ak = (tid & 3) * 8;
    const int bk = tid >> 4, bn = (tid & 15) * 8;
    const bool bok = bn < ncols_valid;
    u32x4 ra = a_load<AMODE>(arow, ak);
    f32x4 rb0 = (f32x4){0.f, 0.f, 0.f, 0.f}, rb1 = rb0;
    if (bok) { const float* q = Bp + (size_t)bk * ldb + bn; rb0 = *(const f32x4*)q; rb1 = *(const f32x4*)(q + 4); }
    const int nk = K / 32;
    for (int kt = 0; kt < nk; ++kt) {
        __syncthreads();
        *(u32x4*)(sA + ar * GS + ak) = ra;
        {
            bf16_t* d = sB + bn * GS + bk;
            d[0 * GS] = f2bf(rb0[0]); d[1 * GS] = f2bf(rb0[1]); d[2 * GS] = f2bf(rb0[2]); d[3 * GS] = f2bf(rb0[3]);
            d[4 * GS] = f2bf(rb1[0]); d[5 * GS] = f2bf(rb1[1]); d[6 * GS] = f2bf(rb1[2]); d[7 * GS] = f2bf(rb1[3]);
        }
        __syncthreads();
        if (kt + 1 < nk) {
            const int k0 = (kt + 1) * 32;
            ra = a_load<AMODE>(arow, k0 + ak);
            if (bok) { const float* q = Bp + (size_t)(k0 + bk) * ldb + bn; rb0 = *(const f32x4*)q; rb1 = *(const f32x4*)(q + 4); }
        }
        bf16x8 af[2], bfr[4];
#pragma unroll
        for (int mi = 0; mi < 2; ++mi) af[mi] = *(const bf16x8*)(sA + (wm * 32 + mi * 16 + (lane & 15)) * GS + (lane >> 4) * 8);
#pragma unroll
        for (int ni = 0; ni < 4; ++ni) bfr[ni] = *(const bf16x8*)(sB + (wn * 64 + ni * 16 + (lane & 15)) * GS + (lane >> 4) * 8);
#pragma unroll
        for (int mi = 0; mi < 2; ++mi)
#pragma unroll
            for (int ni = 0; ni < 4; ++ni) acc[mi][ni] = __builtin_amdgcn_mfma_f32_16x16x32_bf16(bfr[ni], af[mi], acc[mi][ni], 0, 0, 0);
    }
}
DI void acc_zero(f32x4 (&acc)[2][4]) {
#pragma unroll
    for (int i = 0; i < 2; ++i)
#pragma unroll
        for (int j = 0; j < 4; ++j) acc[i][j] = (f32x4){0.f, 0.f, 0.f, 0.f};
}
#define ACC_FOREACH(acc, body) do { const int _l = TID() & 63, _w = TID() >> 6; \
    _Pragma("unroll") for (int _mi = 0; _mi < 2; ++_mi) _Pragma("unroll") for (int _ni = 0; _ni < 4; ++_ni) { \
        const int r_ = (_w >> 1) * 32 + _mi * 16 + (_l & 15), c_ = (_w & 1) * 64 + _ni * 16 + (_l >> 4) * 4; f32x4& v_ = acc[_mi][_ni]; body } } while (0)

DI void store_bf4(bf16_t* p, f32x4 v) { u32x2 w; w.x = pack2(v[0], v[1]); w.y = pack2(v[2], v[3]); *(u32x2*)p = w; }

struct Ctx {
    const Params* P; unsigned char* ws; float* out; int l;
    bf16_t* H; bf16_t* PROJ; bf16_t* F; bf16_t* POOLED; bf16_t* MERGED; bf16_t* CMPH; float* CMPO; float* POSB; int* ROUTE; int* ENT; bf16_t* HID; bf16_t* Y; bf16_t* VT; bf16_t* KC; bf16_t* VCT; unsigned* ctl;
    DI const float* in(int i) const { return P->in[i]; }
};

DI void add_moe_rows(const Ctx& c, int row, int lane, f32x4 (&v)[4]) {
    const int* rt = c.ROUTE + (size_t)row * 8;
    const int p0 = rt[4], p1 = rt[5];
    const bf16_t* y0 = c.Y + (size_t)p0 * DM; const bf16_t* y1 = c.Y + (size_t)p1 * DM;
#pragma unroll
    for (int i = 0; i < 4; ++i) {
        const u32x2 a = *(const u32x2*)(y0 + i * 256 + lane * 4), b = *(const u32x2*)(y1 + i * 256 + lane * 4);
        v[i][0] += bflo(a.x) + bflo(b.x); v[i][1] += bfhi(a.x) + bfhi(b.x); v[i][2] += bflo(a.y) + bflo(b.y); v[i][3] += bfhi(a.y) + bfhi(b.y);
    }
}
DI void phase_norm1(const Ctx& c) {
    const int tid = TID(), lane = tid & 63, wave = tid >> 6;
    const float* gain = c.in(I_NMIX) + c.l * DM;
    const float* src = (c.l == 0) ? c.in(I_X) : c.out;
    for (int row = blockIdx.x * 8 + wave; row < NT; row += gridDim.x * 8) {
        f32x4 v[4];
#pragma unroll
        for (int i = 0; i < 4; ++i) v[i] = *(const f32x4*)(src + (size_t)row * DM + i * 256 + lane * 4);
        if (c.l > 0) {
            add_moe_rows(c, row, lane, v);
#pragma unroll
            for (int i = 0; i < 4; ++i) *(f32x4*)(c.out + (size_t)row * DM + i * 256 + lane * 4) = v[i];
        }
        float ss = 0.f;
#pragma unroll
        for (int i = 0; i < 4; ++i) ss += v[i][0] * v[i][0] + v[i][1] * v[i][1] + v[i][2] * v[i][2] + v[i][3] * v[i][3];
        ss = wave_sum(ss);
        const float rs = rsqrtf(ss * (1.0f / DM) + 1e-6f);
#pragma unroll
        for (int i = 0; i < 4; ++i) {
            const f32x4 g = *(const f32x4*)(gain + i * 256 + lane * 4);
            store_bf4(c.H + (size_t)row * DM + i * 256 + lane * 4, (f32x4){v[i][0] * rs * g[0], v[i][1] * rs * g[1], v[i][2] * rs * g[2], v[i][3] * rs * g[3]});
        }
    }
    for (int idx = blockIdx.x * 8 + wave; idx < 512; idx += gridDim.x * 8) {
        const int kv = idx >> 8, n = idx & 255;
        const float* pos = c.in(kv ? I_CPV : I_CPK) + (size_t)c.l * 2048;
        const float* w1 = c.in(kv ? I_CW1V : I_CW1K) + (size_t)c.l * 2048 * 256;
        float s = 0.f;
        for (int k = lane; k < 2048; k += 64) s += pos[k] * w1[(size_t)k * 256 + n];
        s = wave_sum(s);
        if (lane == 0) c.POSB[kv * 256 + n] = s;
    }
}

DI void phase_gemm1(const Ctx& c, bf16_t* sA, bf16_t* sB) {
    const int nM = NT / 128, nN = (IN_COLS + 127) / 128;
    const float* W = c.in(I_WIN) + (size_t)c.l * DM * IN_COLS;
    for (int tile = blockIdx.x; tile < nM * nN; tile += gridDim.x) {
        const int tm = tile % nM, tn = tile / nM, m0 = tm * 128, n0 = tn * 128;
        f32x4 acc[2][4]; acc_zero(acc);
        ARow ar{c.H + (size_t)(m0 + (TID() >> 2)) * DM};
        gemm_core<0>(acc, ar, W + n0, IN_COLS, IN_COLS - n0, DM, sA, sB);
        ACC_FOREACH(acc, { if (n0 + c_ < IN_COLS) store_bf4(c.PROJ + (size_t)(m0 + r_) * IN_COLS + n0 + c_, v_); });
    }
}

DI float gelu_tanh(float x) { const float u = 0.7978845608028654f * (x + 0.044715f * x * x * x); return 0.5f * x * (1.0f + tanhf(u)); }
DI float softplusf_(float x) { return (x > 20.f) ? x : log1pf(__expf(x)); }
DI void phase_prep(const Ctx& c, unsigned char* lds) {
    bf16_t* sA = (bf16_t*)lds; bf16_t* sB = sA + 128 * GS;
    const int tid = TID();
    const int n_cmp_items = 2 * 32 * 2;
    const int n_prep = n_cmp_items + NT / 16;
    const int n_items = n_prep + 2048;
    for (int item = blockIdx.x; item < n_items; item += gridDim.x) {
        if (item < n_cmp_items) {
            const int kv = item >> 6, tm = (item >> 1) & 31, tn = item & 1, m0 = tm * 128, n0 = tn * 128;
            const int R = m0 + (tid >> 2), bg = R >> 8, cb = R & 255, b = bg >> 2, g = bg & 3;
            ARow ar{(cb < NCMP) ? c.PROJ + (size_t)(b * SEQ + 16 * cb) * IN_COLS + (kv ? C_VC : C_KC) + g * 64 : nullptr};
            const float* W1 = c.in(kv ? I_CW1V : I_CW1K) + (size_t)c.l * 2048 * 256;
            f32x4 acc[2][4]; acc_zero(acc);
            gemm_core<1>(acc, ar, W1 + n0, 256, 256 - n0, 2048, sA, sB);
            const float* pb = c.POSB + kv * 256;
            ACC_FOREACH(acc, {
                const f32x4 bb = *(const f32x4*)(pb + n0 + c_);
                store_bf4(c.CMPH + ((size_t)kv * 4096 + m0 + r_) * 256 + n0 + c_, (f32x4){gelu_tanh(v_[0] + bb[0]), gelu_tanh(v_[1] + bb[1]), gelu_tanh(v_[2] + bb[2]), gelu_tanh(v_[3] + bb[3])}); });
        } else if (item >= n_prep) {
            const int idx = item - n_prep, kind = idx >> 10, bgi = (idx >> 6) & 15, s0 = (idx & 63) * 64;
            bf16_t* T = (bf16_t*)lds;
            const int r = tid >> 3, seg = (tid & 7) * 8;
            const u32x4 w = *(const u32x4*)(c.PROJ + ((size_t)(bgi >> 2) * SEQ + s0 + r) * IN_COLS + (kind ? C_VW : C_VS) + (bgi & 3) * 64 + seg);
            __syncthreads();
            *(u32x4*)(T + r * 72 + seg) = w;
            __syncthreads();
            u32x4 o;
            o.x = (unsigned)T[(seg + 0) * 72 + r] | ((unsigned)T[(seg + 1) * 72 + r] << 16); o.y = (unsigned)T[(seg + 2) * 72 + r] | ((unsigned)T[(seg + 3) * 72 + r] << 16);
            o.z = (unsigned)T[(seg + 4) * 72 + r] | ((unsigned)T[(seg + 5) * 72 + r] << 16); o.w = (unsigned)T[(seg + 6) * 72 + r] | ((unsigned)T[(seg + 7) * 72 + r] << 16);
            *(u32x4*)(c.VT + (((size_t)kind * 16 + bgi) * 64 + r) * SEQ + s0 + seg) = o;
        } else {
            const int t0 = (item - n_cmp_items) * 16;
            float* sl = (float*)lds;
            const float* mu = c.in(I_MU) + (size_t)c.l * RWC;
            __syncthreads();
            for (int idx = tid; idx < 16 * 160; idx += NTHREADS) {
                const int tk = idx / 160, i = idx % 160, t = t0 + tk, col = C_WD + i;
                const float u = bf2f(c.PROJ[(size_t)t * IN_COLS + col]);
                const float up = ((t & (SEQ - 1)) != 0) ? bf2f(c.PROJ[(size_t)(t - 1) * IN_COLS + col]) : 0.f;
                const float us = u + (up - u) * mu[col - C_RW];
                sl[idx] = (i < 32) ? tanhf(us) : ((i < 64) ? us : sigmoidf_(us));
            }
            __syncthreads();
            const int ch = tid;
            float z[16], aa[16], gg[16];
#pragma unroll
            for (int k = 0; k < 16; ++k) { z[k] = 0.f; aa[k] = 0.f; gg[k] = 0.f; }
            const float* wup = c.in(I_WUP) + (size_t)c.l * 32 * 512 + ch;
            const float* aup = c.in(I_AUP) + (size_t)c.l * 32 * 512 + ch;
            const float* gup = c.in(I_GUP) + (size_t)c.l * 96 * 512 + ch;
            for (int i = 0; i < 32; ++i) {
                const float w = wup[i * 512], a = aup[i * 512];
#pragma unroll
                for (int k = 0; k < 16; ++k) { z[k] += sl[k * 160 + i] * w; aa[k] += sl[k * 160 + 32 + i] * a; }
            }
            for (int i = 0; i < 96; ++i) {
                const float w = gup[i * 512];
#pragma unroll
                for (int k = 0; k < 16; ++k) gg[k] += sl[k * 160 + 64 + i] * w;
            }
            const float w0 = c.in(I_W0)[c.l * 512 + ch], a0 = c.in(I_A0)[c.l * 512 + ch];
            const float mur = mu[ch], muk = mu[512 + ch], muv = mu[1024 + ch];
            float pr = 0.f, pk = 0.f, pv = 0.f;
            if ((t0 & (SEQ - 1)) != 0) { const bf16_t* q = c.PROJ + (size_t)(t0 - 1) * IN_COLS; pr = bf2f(q[C_R + ch]); pk = bf2f(q[C_K + ch]); pv = bf2f(q[C_V + ch]); }
#pragma unroll
            for (int k = 0; k < 16; ++k) {
                const int t = t0 + k; const bf16_t* q = c.PROJ + (size_t)t * IN_COLS;
                const float ur = bf2f(q[C_R + ch]), uk = bf2f(q[C_K + ch]), uv = bf2f(q[C_V + ch]);
                const float r = ur + (pr - ur) * mur, kx = uk + (pk - uk) * muk, vx = uv + (pv - uv) * muv;
                pr = ur; pk = uk; pv = uv;
                const float wlog = -softplusf_(-(w0 + z[k])) - 0.5f;
                const float e = __expf(wlog);
                const float a = sigmoidf_(a0 + aa[k]);
                const size_t o = (size_t)t * 512 + ch;
                c.F[o] = f2bf(r); c.F[o + (size_t)NT * 512] = f2bf(kx); c.F[o + (size_t)2 * NT * 512] = f2bf(vx);
                c.F[o + (size_t)3 * NT * 512] = f2bf(e); c.F[o + (size_t)4 * NT * 512] = f2bf(a); c.F[o + (size_t)5 * NT * 512] = f2bf(gg[k]);
            }
            {
                const int gi = ch >> 7, win = 2 << gi;
#pragma unroll 1
                for (int k = 0; k < 16; ++k) {
                    const int t = t0 + k, s = t & (SEQ - 1);
                    const int lo = (s + 1 - win > 0) ? (s + 1 - win) : 0;
                    float sum = 0.f;
                    for (int j = lo; j <= s; ++j) sum += bf2f(c.PROJ[(size_t)(t - s + j) * IN_COLS + C_POOL + ch]);
                    const float self = bf2f(c.PROJ[(size_t)t * IN_COLS + C_POOL + ch]);
                    c.POOLED[(size_t)t * 512 + ch] = f2bf(sum / (float)(s + 1 - lo) - self);
                }
            }
        }
    }
}

DI void phase_poolgemm(const Ctx& c, bf16_t* sA, bf16_t* sB) {
    const int n_pool = (NT / 128) * 4, n_items = n_pool + 64;
    for (int item = blockIdx.x; item < n_items; item += gridDim.x) {
        f32x4 acc[2][4]; acc_zero(acc);
        if (item < n_pool) {
            const int tm = item >> 2, gi = item & 3, m0 = tm * 128;
            ARow ar{c.POOLED + (size_t)(m0 + (TID() >> 2)) * 512 + gi * 128};
            gemm_core<0>(acc, ar, c.in(I_POOLW) + ((size_t)c.l * 4 + gi) * 128 * 128, 128, 128, 128, sA, sB);
            const float* sc = c.in(I_POOLS) + c.l * 512 + gi * 128;
            __syncthreads();
            ACC_FOREACH(acc, { const f32x4 s = *(const f32x4*)(sc + c_);
                store_bf4(c.POOLED + (size_t)(m0 + r_) * 512 + gi * 128 + c_, (f32x4){v_[0] * s[0], v_[1] * s[1], v_[2] * s[2], v_[3] * s[3]}); });
        } else {
            const int it = item - n_pool, kv = it >> 5, tm = it & 31, m0 = tm * 128;
            ARow ar{c.CMPH + ((size_t)kv * 4096 + m0 + (TID() >> 2)) * 256};
            gemm_core<0>(acc, ar, c.in(kv ? I_CW2V : I_CW2K) + (size_t)c.l * 256 * 64, 64, 64, 256, sA, sB);
            ACC_FOREACH(acc, { if (c_ < 64) { const int R = m0 + r_;
                if (kv == 0) store_bf4(c.KC + (size_t)R * 64 + c_, v_);
                else { bf16_t* q = c.VCT + ((size_t)(R >> 8) * 64 + c_) * 256 + (R & 255); q[0] = f2bf(v_[0]); q[256] = f2bf(v_[1]); q[512] = f2bf(v_[2]); q[768] = f2bf(v_[3]); } } });
        }
    }
}

constexpr int CH = 32;
DI void scan_item(const Ctx& c, int item, unsigned char* lds) {
    const int tid = TID(), lane = tid & 63, wave = tid >> 6;
    const int b = item >> 3, h = item & 7;
    float* s_an = (float*)lds;
    float* s_wr = s_an + CH * 64;
    float* s_w = s_wr + CH * 64;
    float* s_bb = s_w + CH * 64;
    float* s_kp = s_bb + CH * 64;
    float* s_v = s_kp + CH * 64;
    float* s_y = s_v + CH * 64;
    float* s_sc = s_y + CH * 64;
    const int row = tid >> 3, cg = tid & 7;
    float st[8];
#pragma unroll
    for (int i = 0; i < 8; ++i) st[i] = 0.f;
    const size_t PL = (size_t)NT * 512;
    const int chn = h * 64 + lane;
    const float kkw = c.in(I_KK)[c.l * 512 + chn], kaw = c.in(I_KA)[c.l * 512 + chn], rkw = c.in(I_RK)[c.l * 512 + chn];
    const float gnw = c.in(I_GNW)[c.l * 512 + chn], gnb = c.in(I_GNB)[c.l * 512 + chn];
    for (int ck = 0; ck < SEQ / CH; ++ck) {
        __syncthreads();
        for (int sidx = wave; sidx < CH; sidx += 8) {
            const size_t o = (size_t)(b * SEQ + ck * CH + sidx) * 512 + chn;
            const float r = bf2f(c.F[o]), k = bf2f(c.F[o + PL]), v = bf2f(c.F[o + 2 * PL]), e = bf2f(c.F[o + 3 * PL]), a = bf2f(c.F[o + 4 * PL]);
            const float w = __expf(-e);
            const float kx = k * kkw;
            const float ss = wave_sum(kx * kx);
            const float kk = kx / fmaxf(sqrtf(ss), 1e-12f);
            const float kp = k * (1.0f + (a - 1.0f) * kaw);
            const float bb = kk * a;
            const float br = wave_sum(bb * r), kr = wave_sum(kp * r), bon = wave_sum(r * kp * rkw);
            s_an[sidx * 64 + lane] = -kk; s_wr[sidx * 64 + lane] = w * r; s_w[sidx * 64 + lane] = w; s_bb[sidx * 64 + lane] = bb; s_kp[sidx * 64 + lane] = kp; s_v[sidx * 64 + lane] = v;
            if (lane == 0) { s_sc[sidx * 4 + 0] = br; s_sc[sidx * 4 + 1] = kr; s_sc[sidx * 4 + 2] = bon; }
        }
        __syncthreads();
#pragma unroll 2
        for (int sidx = 0; sidx < CH; ++sidx) {
            const f32x4 an0 = *(const f32x4*)(s_an + sidx * 64 + cg * 8), an1 = *(const f32x4*)(s_an + sidx * 64 + cg * 8 + 4);
            const f32x4 wr0 = *(const f32x4*)(s_wr + sidx * 64 + cg * 8), wr1 = *(const f32x4*)(s_wr + sidx * 64 + cg * 8 + 4);
            const f32x4 w0 = *(const f32x4*)(s_w + sidx * 64 + cg * 8), w1 = *(const f32x4*)(s_w + sidx * 64 + cg * 8 + 4);
            const f32x4 b0 = *(const f32x4*)(s_bb + sidx * 64 + cg * 8), b1 = *(const f32x4*)(s_bb + sidx * 64 + cg * 8 + 4);
            const f32x4 k0 = *(const f32x4*)(s_kp + sidx * 64 + cg * 8), k1 = *(const f32x4*)(s_kp + sidx * 64 + cg * 8 + 4);
            const float vv = s_v[sidx * 64 + row];
            const f32x4 sc = *(const f32x4*)(s_sc + sidx * 4);
            float sa = st[0] * an0[0] + st[1] * an0[1] + st[2] * an0[2] + st[3] * an0[3] + st[4] * an1[0] + st[5] * an1[1] + st[6] * an1[2] + st[7] * an1[3];
            float sr = st[0] * wr0[0] + st[1] * wr0[1] + st[2] * wr0[2] + st[3] * wr0[3] + st[4] * wr1[0] + st[5] * wr1[1] + st[6] * wr1[2] + st[7] * wr1[3];
            sa += __shfl_xor(sa, 1); sr += __shfl_xor(sr, 1);
            sa += __shfl_xor(sa, 2); sr += __shfl_xor(sr, 2);
            sa += __shfl_xor(sa, 4); sr += __shfl_xor(sr, 4);
            st[0] = st[0] * w0[0] + sa * b0[0] + vv * k0[0]; st[1] = st[1] * w0[1] + sa * b0[1] + vv * k0[1];
            st[2] = st[2] * w0[2] + sa * b0[2] + vv * k0[2]; st[3] = st[3] * w0[3] + sa * b0[3] + vv * k0[3];
            st[4] = st[4] * w1[0] + sa * b1[0] + vv * k1[0]; st[5] = st[5] * w1[1] + sa * b1[1] + vv * k1[1];
            st[6] = st[6] * w1[2] + sa * b1[2] + vv * k1[2]; st[7] = st[7] * w1[3] + sa * b1[3] + vv * k1[3];
            if (cg == 0) s_y[sidx * 64 + row] = sr + sa * sc[0] + vv * sc[1];
        }
        __syncthreads();
        for (int sidx = wave; sidx < CH; sidx += 8) {
            const float y = s_y[sidx * 64 + lane];
            const float mean = wave_sum(y) * (1.0f / 64.0f);
            const float d = y - mean;
            const float var = wave_sum(d * d) * (1.0f / 64.0f);
            const float yn = d * rsqrtf(var + 64e-5f) * gnw + gnb;
            const size_t o = (size_t)(b * SEQ + ck * CH + sidx) * 512 + chn;
            const float g = bf2f(c.F[o + 5 * PL]);
            c.F[o + 5 * PL] = f2bf((yn + s_sc[sidx * 4 + 2] * s_v[sidx * 64 + lane]) * g);
        }
    }
    __syncthreads();
}

constexpr int TS = 72;
constexpr int NSA_BIAS = 0;
constexpr int NSA_SELM = 2112;
constexpr int NSA_SCR = 2624;
constexpr int NSA_K0 = 4672;
constexpr int NSA_V0 = NSA_K0 + 2 * 64 * TS * 2;
constexpr int NSA_A = NSA_V0 + 2 * 64 * TS * 2;
constexpr int NSA_B = NSA_A + 16384;
constexpr int NSA_END = NSA_B + 16384;
static_assert(NSA_END <= LDS_BYTES - 16, "nsa lds");
static_assert(NSA_K0 % 16 == 0, "align");

struct NsaLane { int tq[2]; int h; float cbias; float m[2], l[2]; };

DI void nsa_prefetch(u32x4& rk, u32x4& rv, const bf16_t* kbase, int kstride, const bf16_t* vtbase, int vstride, int pos0, int tid) {
    const int r = tid >> 3, seg = (tid & 7) * 8;
    rk = *(const u32x4*)(kbase + (size_t)(pos0 + r) * kstride + seg);
    rv = *(const u32x4*)(vtbase + (size_t)r * vstride + pos0 + seg);
}
DI void nsa_store(unsigned char* lds, int buf, const u32x4& rk, const u32x4& rv, int tid) {
    const int r = tid >> 3, seg = (tid & 7) * 8;
    *(u32x4*)((bf16_t*)(lds + NSA_K0) + buf * 64 * TS + r * TS + seg) = rk;
    *(u32x4*)((bf16_t*)(lds + NSA_V0) + buf * 64 * TS + r * TS + seg) = rv;
}
DI void nsa_qk(f32x4 (&s)[2][4], const bf16_t* sK, const bf16x8 (&qf)[2][2], int lane) {
#pragma unroll
    for (int kt = 0; kt < 4; ++kt) {
#pragma unroll
        for (int ks = 0; ks < 2; ++ks) {
            const bf16x8 kf = *(const bf16x8*)(sK + (16 * kt + (lane & 15)) * TS + 32 * ks + (lane >> 4) * 8);
#pragma unroll
            for (int qi = 0; qi < 2; ++qi) s[qi][kt] = __builtin_amdgcn_mfma_f32_16x16x32_bf16(kf, qf[qi][ks], (ks == 0) ? (f32x4){0.f, 0.f, 0.f, 0.f} : s[qi][kt], 0, 0, 0);
        }
    }
}
template <int MODE>
DI void nsa_logits(float (&x)[4][4], const f32x4 (&s)[4], int tq, int h, float cbias, bool rowsel, int pos0, int qd, const float* biasT) {
#pragma unroll
    for (int kt = 0; kt < 4; ++kt)
#pragma unroll
        for (int i = 0; i < 4; ++i) {
            const int kk = pos0 + 16 * kt + 4 * qd + i;
            if (MODE == 1) { x[kt][i] = rowsel ? s[kt][i] + cbias : -INFINITY; }
            else {
                const int dist = (MODE == 0) ? (tq - 16 * kk - 31) : (tq - kk);
                bool ok = dist >= 0;
                if (MODE == 2) ok = ok && rowsel;
                if (MODE == 3) ok = ok && (dist < 512);
                const int di = dist < 0 ? 0 : (dist > 128 ? 128 : dist);
                const float bias = biasT[di * 4 + h];
                x[kt][i] = ok ? s[kt][i] + bias : -INFINITY;
            }
        }
}
DI float quad16_max(float v) { v = fmaxf(v, __shfl_xor(v, 16)); v = fmaxf(v, __shfl_xor(v, 32)); return v; }
DI float quad16_sum(float v) { v += __shfl_xor(v, 16); v += __shfl_xor(v, 32); return v; }
DI void nsa_softmax(const float (&x)[4][4], float& m, float& l, f32x4 (&O)[4], bf16x8 (&pf)[2]) {
    float mx = -INFINITY;
#pragma unroll
    for (int kt = 0; kt < 4; ++kt)
#pragma unroll
        for (int i = 0; i < 4; ++i) mx = fmaxf(mx, x[kt][i]);
    mx = quad16_max(mx);
    const float mn = fmaxf(m, mx);
    const float mu = (mn == -INFINITY) ? 0.f : mn;
    const float sc = __expf(m - mu);
    float p[4][4]; float ps = 0.f;
#pragma unroll
    for (int kt = 0; kt < 4; ++kt)
#pragma unroll
        for (int i = 0; i < 4; ++i) { p[kt][i] = __expf(x[kt][i] - mu); ps += p[kt][i]; }
    l = l * sc + ps; m = mn;
#pragma unroll
    for (int dt = 0; dt < 4; ++dt) O[dt] = O[dt] * sc;
#pragma unroll
    for (int ks = 0; ks < 2; ++ks) {
        u32x4 w; w.x = pack2(p[2 * ks][0], p[2 * ks][1]); w.y = pack2(p[2 * ks][2], p[2 * ks][3]); w.z = pack2(p[2 * ks + 1][0], p[2 * ks + 1][1]); w.w = pack2(p[2 * ks + 1][2], p[2 * ks + 1][3]);
        pf[ks] = __builtin_bit_cast(bf16x8, w);
    }
}
DI void nsa_pv(f32x4 (&O)[2][4], const bf16_t* sV, const bf16x8 (&pf)[2][2], int lane) {
    const int qd = lane >> 4;
#pragma unroll
    for (int dt = 0; dt < 4; ++dt)
#pragma unroll
        for (int ks = 0; ks < 2; ++ks) {
            const bf16_t* vp = sV + (16 * dt + (lane & 15)) * TS + 32 * ks + 4 * qd;
            const u32x2 a = *(const u32x2*)vp, b = *(const u32x2*)(vp + 16);
            u32x4 w; w.x = a.x; w.y = a.y; w.z = b.x; w.w = b.y;
            const bf16x8 vf = __builtin_bit_cast(bf16x8, w);
#pragma unroll
            for (int qi = 0; qi < 2; ++qi) O[qi][dt] = __builtin_amdgcn_mfma_f32_16x16x32_bf16(vf, pf[qi][ks], O[qi][dt], 0, 0, 0);
        }
}
template <int MODE>
DI void nsa_tile(f32x4 (&O)[2][4], NsaLane& L, const bf16x8 (&qf)[2][2], const unsigned char* lds, int buf, int pos0, bool sel0, bool sel1, int lane) {
    const bf16_t* sK = (const bf16_t*)(lds + NSA_K0) + buf * 64 * TS;
    const bf16_t* sV = (const bf16_t*)(lds + NSA_V0) + buf * 64 * TS;
    const float* biasT = (const float*)(lds + NSA_BIAS);
    f32x4 s[2][4];
    nsa_qk(s, sK, qf, lane);
    bf16x8 pf[2][2];
#pragma unroll
    for (int qi = 0; qi < 2; ++qi) {
        float x[4][4];
        nsa_logits<MODE>(x, s[qi], L.tq[qi], L.h, L.cbias, qi ? sel1 : sel0, pos0, lane >> 4, biasT);
        nsa_softmax(x, L.m[qi], L.l[qi], O[qi], pf[qi]);
    }
    nsa_pv(O, sV, pf, lane);
}
DI void nsa_flush(f32x4 (&Y)[2][4], f32x4 (&O)[2][4], NsaLane& L, const float (&gate)[2]) {
#pragma unroll
    for (int qi = 0; qi < 2; ++qi) {
        const float lt = quad16_sum(L.l[qi]);
        const float f = (lt > 0.f) ? gate[qi] / lt : 0.f;
#pragma unroll
        for (int dt = 0; dt < 4; ++dt) { Y[qi][dt] += O[qi][dt] * f; O[qi][dt] = (f32x4){0.f, 0.f, 0.f, 0.f}; }
    }
}
DI void nsa_item(const Ctx& c, int item, unsigned char* lds) {
    const int tid = TID(), lane = tid & 63, wave = tid >> 6, qd = lane >> 4;
    const int b = item >> 8, g = (item >> 6) & 3, qt = item & 63, t0 = qt * 64, cur = qt, bg = b * 4 + g;
    float* biasT = (float*)(lds + NSA_BIAS);
    unsigned long long* selm = (unsigned long long*)(lds + NSA_SELM);
    float* scr = (float*)(lds + NSA_SCR) + wave * 64;
    float* impA = (float*)(lds + NSA_A); float* impB = (float*)(lds + NSA_B);
    __syncthreads();
    for (int i = tid; i < 129 * 4; i += NTHREADS) { const int d = i >> 2, h = i & 3; biasT[i] = c.in(I_RELB)[t5_bucket(d) * 16 + g * 4 + h]; }
    for (int i = tid; i < 2 * 4096; i += NTHREADS) impA[i] = 0.f;
    NsaLane L; L.h = lane & 3;
    bf16x8 qf[2][2]; float gates[2][3];
    const bf16_t* pbat = c.PROJ + (size_t)b * SEQ * IN_COLS;
#pragma unroll
    for (int qi = 0; qi < 2; ++qi) {
        const int tl = 8 * wave + 4 * qi + ((lane & 15) >> 2);
        L.tq[qi] = t0 + tl;
        const bf16_t* prow = pbat + (size_t)L.tq[qi] * IN_COLS;
#pragma unroll
        for (int ks = 0; ks < 2; ++ks) {
            u32x4 w = *(const u32x4*)(prow + C_Q + (g * 4 + L.h) * 64 + 32 * ks + qd * 8);
            w.x = pack2(bflo(w.x) * 0.125f, bfhi(w.x) * 0.125f); w.y = pack2(bflo(w.y) * 0.125f, bfhi(w.y) * 0.125f);
            w.z = pack2(bflo(w.z) * 0.125f, bfhi(w.z) * 0.125f); w.w = pack2(bflo(w.w) * 0.125f, bfhi(w.w) * 0.125f);
            qf[qi][ks] = __builtin_bit_cast(bf16x8, w);
        }
#pragma unroll
        for (int br = 0; br < 3; ++br) gates[qi][br] = sigmoidf_(bf2f(prow[C_GATE + g * 12 + L.h * 3 + br]));
    }
    __syncthreads();
    L.cbias = biasT[128 * 4 + L.h];
    f32x4 O[2][4], Y[2][4];
#pragma unroll
    for (int qi = 0; qi < 2; ++qi)
#pragma unroll
        for (int dt = 0; dt < 4; ++dt) { O[qi][dt] = (f32x4){0.f, 0.f, 0.f, 0.f}; Y[qi][dt] = (f32x4){0.f, 0.f, 0.f, 0.f}; }
    u32x4 rk, rv;
    const int nvis_max = (t0 + 63 >= 31) ? ((t0 + 63 - 31) >> 4) + 1 : 0;
    const int ncb = (nvis_max + 63) >> 6;
    const bf16_t* kcb = c.KC + (size_t)bg * 256 * 64; const bf16_t* vcb = c.VCT + (size_t)bg * 64 * 256;
    L.m[0] = L.m[1] = -INFINITY; L.l[0] = L.l[1] = 0.f;
    if (ncb > 0) nsa_prefetch(rk, rv, kcb, 64, vcb, 256, 0, tid);
    for (int cb = 0; cb < ncb; ++cb) {
        nsa_store(lds, cb & 1, rk, rv, tid);
        __syncthreads();
        if (cb + 1 < ncb) nsa_prefetch(rk, rv, kcb, 64, vcb, 256, (cb + 1) * 64, tid);
        nsa_tile<0>(O, L, qf, lds, cb & 1, cb * 64, true, true, lane);
    }
    float mfin[2], linv[2];
#pragma unroll
    for (int qi = 0; qi < 2; ++qi) { mfin[qi] = L.m[qi]; const float lt = quad16_sum(L.l[qi]); linv[qi] = (lt > 0.f) ? 1.0f / lt : 0.f; }
    { const float gg[2] = {gates[0][0], gates[1][0]}; nsa_flush(Y, O, L, gg); }
    __syncthreads();
    if (ncb > 0) nsa_prefetch(rk, rv, kcb, 64, vcb, 256, 0, tid);
    for (int cb = 0; cb < ncb; ++cb) {
        nsa_store(lds, cb & 1, rk, rv, tid);
        __syncthreads();
        if (cb + 1 < ncb) nsa_prefetch(rk, rv, kcb, 64, vcb, 256, (cb + 1) * 64, tid);
        const bf16_t* sK = (const bf16_t*)(lds + NSA_K0) + (cb & 1) * 64 * TS;
        f32x4 s[2][4];
        nsa_qk(s, sK, qf, lane);
#pragma unroll
        for (int qi = 0; qi < 2; ++qi) {
            float x[4][4];
            nsa_logits<0>(x, s[qi], L.tq[qi], L.h, L.cbias, true, cb * 64, qd, biasT);
            const float mu = (mfin[qi] == -INFINITY) ? 0.f : mfin[qi];
#pragma unroll
            for (int kt = 0; kt < 4; ++kt) {
                float p3 = __expf(x[kt][3] - mu) * linv[qi];
                float pa = (__expf(x[kt][0] - mu) + __expf(x[kt][1] - mu) + __expf(x[kt][2] - mu)) * linv[qi] + p3;
                pa += __shfl_xor(pa, 1); p3 += __shfl_xor(p3, 1);
                pa += __shfl_xor(pa, 2); p3 += __shfl_xor(p3, 2);
                if (L.h == 0) { const int tl = 8 * wave + 4 * qi + ((lane & 15) >> 2), mi = 16 * cb + 4 * kt + qd; impA[tl * 64 + mi] = pa; impB[tl * 64 + mi] = p3; }
            }
        }
    }
    __syncthreads();
    for (int tl8 = 0; tl8 < 8; ++tl8) {
        const int tl = 8 * wave + tl8, n = lane;
        const bool cand = (n >= 1) && (n <= cur - 2);
        const float imp = cand ? impA[tl * 64 + n] + impB[tl * 64 + n - 1] : -1.0f;
        LDS_WAVE_SYNC();
        scr[n] = imp;
        LDS_WAVE_SYNC();
        int rank = 0;
#pragma unroll 4
        for (int q4 = 0; q4 < 16; ++q4) {
            const f32x4 o = *(const f32x4*)(scr + q4 * 4);
#pragma unroll
            for (int j = 0; j < 4; ++j) { const int n2 = q4 * 4 + j; rank += (o[j] > imp || (o[j] == imp && n2 < n)) ? 1 : 0; }
        }
        const bool forced = (n <= cur) && (n == 0 || n == cur || n == cur - 1);
        const unsigned long long msk = __ballot((cand && rank < 5) || forced);
        if (lane == 0) selm[tl] = msk;
    }
    __syncthreads();
    unsigned long long uni = selm[lane];
#pragma unroll
    for (int o = 32; o >= 1; o >>= 1) { const unsigned lo_ = __shfl_xor((unsigned)uni, o), hi_ = __shfl_xor((unsigned)(uni >> 32), o); uni |= ((unsigned long long)hi_ << 32) | lo_; }
    uni = ((unsigned long long)__builtin_amdgcn_readfirstlane((unsigned)(uni >> 32)) << 32) | (unsigned)__builtin_amdgcn_readfirstlane((unsigned)uni);
    unsigned long long sm[2];
#pragma unroll
    for (int qi = 0; qi < 2; ++qi) sm[qi] = selm[8 * wave + 4 * qi + ((lane & 15) >> 2)];
    const bf16_t* ksb = pbat + C_KS + g * 64; const bf16_t* vsb = c.VT + ((size_t)0 * 16 + bg) * 64 * SEQ;
    L.m[0] = L.m[1] = -INFINITY; L.l[0] = L.l[1] = 0.f;
    {
        unsigned long long rem = uni; int it = 0;
        int j = (int)__builtin_ctzll(rem); rem &= rem - 1;
        nsa_prefetch(rk, rv, ksb, IN_COLS, vsb, SEQ, j * 64, tid);
        for (;;) {
            nsa_store(lds, it & 1, rk, rv, tid);
            __syncthreads();
            const int jn = rem ? (int)__builtin_ctzll(rem) : -1;
            if (jn >= 0) { rem &= rem - 1; nsa_prefetch(rk, rv, ksb, IN_COLS, vsb, SEQ, jn * 64, tid); }
            const bool s0 = (sm[0] >> j) & 1ull, s1 = (sm[1] >> j) & 1ull;
            if (j <= cur - 3) nsa_tile<1>(O, L, qf, lds, it & 1, j * 64, s0, s1, lane);
            else nsa_tile<2>(O, L, qf, lds, it & 1, j * 64, s0, s1, lane);
            if (jn < 0) break;
            j = jn; ++it;
        }
    }
    { const float gg[2] = {gates[0][1], gates[1][1]}; nsa_flush(Y, O, L, gg); }
    const bf16_t* kwb = pbat + C_KW + g * 64; const bf16_t* vwb = c.VT + ((size_t)1 * 16 + bg) * 64 * SEQ;
    L.m[0] = L.m[1] = -INFINITY; L.l[0] = L.l[1] = 0.f;
    {
        const int j0 = (cur - 8 > 0) ? cur - 8 : 0;
        __syncthreads();
        nsa_prefetch(rk, rv, kwb, IN_COLS, vwb, SEQ, j0 * 64, tid);
        for (int j = j0; j <= cur; ++j) {
            nsa_store(lds, (j - j0) & 1, rk, rv, tid);
            __syncthreads();
            if (j + 1 <= cur) nsa_prefetch(rk, rv, kwb, IN_COLS, vwb, SEQ, (j + 1) * 64, tid);
            nsa_tile<3>(O, L, qf, lds, (j - j0) & 1, j * 64, true, true, lane);
        }
    }
    { const float gg[2] = {gates[0][2], gates[1][2]}; nsa_flush(Y, O, L, gg); }
#pragma unroll
    for (int qi = 0; qi < 2; ++qi) {
        bf16_t* yrow = c.PROJ + ((size_t)b * SEQ + L.tq[qi]) * IN_COLS + C_Q + (g * 4 + L.h) * 64;
#pragma unroll
        for (int dt = 0; dt < 4; ++dt) store_bf4(yrow + 16 * dt + 4 * qd, Y[qi][dt]);
    }
}
DI void phase_mix(const Ctx& c, unsigned char* lds) {
    const int G = gridDim.x, bid = blockIdx.x;
    const int n_nsa = NB * 4 * (SEQ / 64);
    const bool split = G > 64;
    if (!split || bid < 32) for (int item = bid; item < 32; item += G) scan_item(c, item, lds);
    if (!split || bid >= 32) {
        unsigned* ctr = c.ctl + CW_Q + c.l;
        volatile int* sitem = (volatile int*)(lds + LDS_BYTES - 32);
        for (;;) {
            __syncthreads();
            if (TID() == 0) *sitem = (int)atomicAdd(ctr, 1u);
            __syncthreads();
            const int k = *sitem;
            if (k >= n_nsa) break;
            const int qt = 63 - (k >> 4), bgi = k & 15;
            nsa_item(c, (bgi << 6) | qt, lds);
        }
    }
}

DI void phase_merge(const Ctx& c, bf16_t* sA, bf16_t* sB) {
    const int nM = NT / 128, nN = DM / 128;
    const float* WM = c.in(I_WMG) + (size_t)c.l * DM * 3 * DM;
    const float* BM_ = c.in(I_BMG) + (size_t)c.l * 3 * DM;
    const float* WB = c.in(I_WBR) + (size_t)c.l * 2048 * DM;
    for (int tile = blockIdx.x; tile < nM * nN; tile += gridDim.x) {
        const int tm = tile % nM, tn = tile / nM, m0 = tm * 128, n0 = tn * 128;
        const int arow = m0 + (TID() >> 2);
        f32x4 mer[2][4]; acc_zero(mer);
#pragma unroll 1
        for (int i = 0; i < 3; ++i) {
            f32x4 ag[2][4]; acc_zero(ag);
            { ARow ar{c.H + (size_t)arow * DM}; gemm_core<0>(ag, ar, WM + i * DM + n0, 3 * DM, 128, DM, sA, sB); }
            f32x4 ab[2][4]; acc_zero(ab);
            if (i == 0) { ARow ar{c.POOLED + (size_t)arow * 512}; gemm_core<0>(ab, ar, WB + n0, DM, 128, 512, sA, sB); }
            else if (i == 1) { ARow ar{c.F + (size_t)5 * NT * 512 + (size_t)arow * 512}; gemm_core<0>(ab, ar, WB + (size_t)512 * DM + n0, DM, 128, 512, sA, sB); }
            else { ARow ar{c.PROJ + (size_t)arow * IN_COLS + C_Q}; gemm_core<0>(ab, ar, WB + (size_t)1024 * DM + n0, DM, 128, 1024, sA, sB); }
            const int lane = TID() & 63, wave = TID() >> 6;
#pragma unroll
            for (int mi = 0; mi < 2; ++mi)
#pragma unroll
                for (int ni = 0; ni < 4; ++ni) {
                    const int cc = (wave & 1) * 64 + ni * 16 + (lane >> 4) * 4;
                    const f32x4 bb = *(const f32x4*)(BM_ + i * DM + n0 + cc);
#pragma unroll
                    for (int j = 0; j < 4; ++j) mer[mi][ni][j] += sigmoidf_(ag[mi][ni][j] + bb[j]) * ab[mi][ni][j];
                }
        }
        ACC_FOREACH(mer, { store_bf4(c.MERGED + (size_t)(m0 + r_) * DM + n0 + c_, v_); });
    }
}

DI void phase_outp(const Ctx& c, bf16_t* sA, bf16_t* sB) {
    const int nM = NT / 128, nN = DM / 128;
    const float* W = c.in(I_WOUT) + (size_t)c.l * DM * DM;
    const float* xin = (c.l == 0) ? c.in(I_X) : c.out;
    for (int tile = blockIdx.x; tile < nM * nN; tile += gridDim.x) {
        const int tm = tile % nM, tn = tile / nM, m0 = tm * 128, n0 = tn * 128;
        f32x4 acc[2][4]; acc_zero(acc);
        ARow ar{c.MERGED + (size_t)(m0 + (TID() >> 2)) * DM};
        gemm_core<0>(acc, ar, W + n0, DM, 128, DM, sA, sB);
        ACC_FOREACH(acc, { const size_t o = (size_t)(m0 + r_) * DM + n0 + c_; const f32x4 x = *(const f32x4*)(xin + o); *(f32x4*)(c.out + o) = x + v_; });
    }
}

DI void phase_norm2(const Ctx& c) {
    const int tid = TID(), lane = tid & 63, wave = tid >> 6;
    const float* gain = c.in(I_NFFN) + c.l * DM;
    const float* wrg = c.in(I_WRG) + (size_t)c.l * DM * 4; const float* brg = c.in(I_BRG) + c.l * 4;
    const float* wre = c.in(I_WRE) + (size_t)c.l * DM * 32; const float* bre = c.in(I_BRE) + c.l * 32;
    unsigned* cnt = c.ctl + CW_CNT + c.l * 32;
    for (int row = blockIdx.x * 8 + wave; row < NT; row += gridDim.x * 8) {
        f32x4 v[4];
        float ss = 0.f;
#pragma unroll
        for (int i = 0; i < 4; ++i) { v[i] = *(const f32x4*)(c.out + (size_t)row * DM + i * 256 + lane * 4); ss += v[i][0] * v[i][0] + v[i][1] * v[i][1] + v[i][2] * v[i][2] + v[i][3] * v[i][3]; }
        ss = wave_sum(ss);
        const float rs = rsqrtf(ss * (1.0f / DM) + 1e-6f);
#pragma unroll
        for (int i = 0; i < 4; ++i) {
            const f32x4 g = *(const f32x4*)(gain + i * 256 + lane * 4);
            v[i] = (f32x4){v[i][0] * rs * g[0], v[i][1] * rs * g[1], v[i][2] * rs * g[2], v[i][3] * rs * g[3]};
            store_bf4(c.H + (size_t)row * DM + i * 256 + lane * 4, v[i]);
        }
        float lgp[4] = {0.f, 0.f, 0.f, 0.f};
#pragma unroll
        for (int i = 0; i < 4; ++i)
#pragma unroll
            for (int j = 0; j < 4; ++j) { const f32x4 w = *(const f32x4*)(wrg + (size_t)(i * 256 + lane * 4 + j) * 4); lgp[0] += v[i][j] * w[0]; lgp[1] += v[i][j] * w[1]; lgp[2] += v[i][j] * w[2]; lgp[3] += v[i][j] * w[3]; }
#pragma unroll
        for (int o = 0; o < 4; ++o) lgp[o] = wave_sum(lgp[o]) + brg[o];
        int grp = 0; float gm = lgp[0];
#pragma unroll
        for (int o = 1; o < 4; ++o) if (lgp[o] > gm) { gm = lgp[o]; grp = o; }
        float gs = 0.f;
#pragma unroll
        for (int o = 0; o < 4; ++o) gs += __expf(lgp[o] - gm);
        const float ptop = 1.0f / gs;
        float le[8] = {0.f, 0.f, 0.f, 0.f, 0.f, 0.f, 0.f, 0.f};
#pragma unroll
        for (int i = 0; i < 4; ++i)
#pragma unroll
            for (int j = 0; j < 4; ++j) {
                const float* wp = wre + (size_t)(i * 256 + lane * 4 + j) * 32 + grp * 8;
                const f32x4 w0 = *(const f32x4*)wp, w1 = *(const f32x4*)(wp + 4);
                le[0] += v[i][j] * w0[0]; le[1] += v[i][j] * w0[1]; le[2] += v[i][j] * w0[2]; le[3] += v[i][j] * w0[3];
                le[4] += v[i][j] * w1[0]; le[5] += v[i][j] * w1[1]; le[6] += v[i][j] * w1[2]; le[7] += v[i][j] * w1[3];
            }
#pragma unroll
        for (int o = 0; o < 8; ++o) le[o] = wave_sum(le[o]) + bre[grp * 8 + o];
        int i0 = 0; float v0 = le[0];
#pragma unroll
        for (int o = 1; o < 8; ++o) if (le[o] > v0) { v0 = le[o]; i0 = o; }
        int i1 = -1; float v1 = -INFINITY;
#pragma unroll
        for (int o = 0; o < 8; ++o) if (o != i0 && le[o] > v1) { v1 = le[o]; i1 = o; }
        const float e1 = __expf(v1 - v0), inv = 1.0f / (1.0f + e1);
        if (lane == 0) {
            int* rt = c.ROUTE + (size_t)row * 8;
            const int ex0 = grp * 8 + i0, ex1 = grp * 8 + i1;
            rt[0] = ex0; rt[1] = ex1; ((float*)rt)[2] = inv * ptop; ((float*)rt)[3] = e1 * inv * ptop;
            atomicAdd(cnt + ex0, 1u); atomicAdd(cnt + ex1, 1u);
        }
    }
}
DI void phase_route2(const Ctx& c, unsigned char* lds) {
    int* soff = (int*)lds;
    const unsigned* cnt = c.ctl + CW_CNT + c.l * 32;
    unsigned* cur = c.ctl + CW_CUR + c.l * 32;
    __syncthreads();
    if (TID() == 0) { int s = 0; for (int e = 0; e < 32; ++e) { soff[e] = s; s += (int)cnt[e]; } }
    __syncthreads();
    for (int t = blockIdx.x * NTHREADS + TID(); t < NT; t += gridDim.x * NTHREADS) {
        int* rt = c.ROUTE + (size_t)t * 8;
#pragma unroll
        for (int s = 0; s < 2; ++s) {
            const int e = rt[s];
            const int p = soff[e] + (int)atomicAdd(cur + e, 1u);
            rt[4 + s] = p;
            c.ENT[2 * p] = t; ((float*)c.ENT)[2 * p + 1] = ((const float*)rt)[2 + s];
        }
    }
}
DI void moe_tables(const Ctx& c, int* soff, int* stile, int ncol) {
    const unsigned* cnt = c.ctl + CW_CNT + c.l * 32;
    __syncthreads();
    if (TID() == 0) { int s = 0, tt = 0; for (int e = 0; e < 32; ++e) { soff[e] = s; stile[e] = tt; s += (int)cnt[e]; tt += (((int)cnt[e] + 127) >> 7) * ncol; } soff[32] = s; stile[32] = tt; }
    __syncthreads();
}
DI void phase_moe_up(const Ctx& c, unsigned char* lds) {
    bf16_t* sA = (bf16_t*)lds; bf16_t* sB = sA + 128 * GS; int* soff = (int*)(lds + 32768); int* stile = soff + 64;
    moe_tables(c, soff, stile, 2);
    const int total = stile[32];
    for (int item = blockIdx.x; item < total; item += gridDim.x) {
        int e = 0;
        for (int q = 1; q < 32; ++q) if (stile[q] <= item) e = q;
        const int loc = item - stile[e], tm = loc >> 1, tn = loc & 1, n0 = tn * 128;
        const int p0 = soff[e] + tm * 128, pend = soff[e + 1];
        const int pr = p0 + (TID() >> 2);
        ARow ar{(pr < pend) ? c.H + (size_t)c.ENT[2 * pr] * DM : nullptr};
        f32x4 ag[2][4], au[2][4]; acc_zero(ag); acc_zero(au);
        gemm_core<0>(ag, ar, c.in(I_EG) + ((size_t)c.l * 32 + e) * DM * 256 + n0, 256, 128, DM, sA, sB);
        gemm_core<0>(au, ar, c.in(I_EU) + ((size_t)c.l * 32 + e) * DM * 256 + n0, 256, 128, DM, sA, sB);
        const int lane = TID() & 63, wave = TID() >> 6;
#pragma unroll
        for (int mi = 0; mi < 2; ++mi)
#pragma unroll
            for (int ni = 0; ni < 4; ++ni) {
                const int r = (wave >> 1) * 32 + mi * 16 + (lane & 15), cc = (wave & 1) * 64 + ni * 16 + (lane >> 4) * 4;
                if (p0 + r < pend) {
                    f32x4 hv;
#pragma unroll
                    for (int j = 0; j < 4; ++j) { const float gq = ag[mi][ni][j]; hv[j] = gq * sigmoidf_(gq) * au[mi][ni][j]; }
                    store_bf4(c.HID + (size_t)(p0 + r) * 256 + n0 + cc, hv);
                }
            }
    }
}
DI void phase_moe_down(const Ctx& c, unsigned char* lds) {
    bf16_t* sA = (bf16_t*)lds; bf16_t* sB = sA + 128 * GS; int* soff = (int*)(lds + 32768); int* stile = soff + 64;
    moe_tables(c, soff, stile, 8);
    const int total = stile[32];
    for (int item = blockIdx.x; item < total; item += gridDim.x) {
        int e = 0;
        for (int q = 1; q < 32; ++q) if (stile[q] <= item) e = q;
        const int loc = item - stile[e], tm = loc >> 3, tn = loc & 7, n0 = tn * 128;
        const int p0 = soff[e] + tm * 128, pend = soff[e + 1];
        const int pr = p0 + (TID() >> 2);
        ARow ar{(pr < pend) ? c.HID + (size_t)pr * 256 : nullptr};
        f32x4 acc[2][4]; acc_zero(acc);
        gemm_core<0>(acc, ar, c.in(I_ED) + ((size_t)c.l * 32 + e) * 256 * DM + n0, DM, 128, 256, sA, sB);
        ACC_FOREACH(acc, { if (p0 + r_ < pend) { const float w = ((const float*)c.ENT)[2 * (p0 + r_) + 1];
            store_bf4(c.Y + (size_t)(p0 + r_) * DM + n0 + c_, (f32x4){v_[0] * w, v_[1] * w, v_[2] * w, v_[3] * w}); } });
    }
}
DI void phase_final(const Ctx& c) {
    const int tid = TID(), lane = tid & 63, wave = tid >> 6;
    const float* gain = c.in(I_NFIN);
    for (int row = blockIdx.x * 8 + wave; row < NT; row += gridDim.x * 8) {
        f32x4 v[4];
#pragma unroll
        for (int i = 0; i < 4; ++i) v[i] = *(const f32x4*)(c.out + (size_t)row * DM + i * 256 + lane * 4);
        add_moe_rows(c, row, lane, v);
        float ss = 0.f;
#pragma unroll
        for (int i = 0; i < 4; ++i) ss += v[i][0] * v[i][0] + v[i][1] * v[i][1] + v[i][2] * v[i][2] + v[i][3] * v[i][3];
        ss = wave_sum(ss);
        const float rs = rsqrtf(ss * (1.0f / DM) + 1e-6f);
#pragma unroll
        for (int i = 0; i < 4; ++i) {
            const f32x4 g = *(const f32x4*)(gain + i * 256 + lane * 4);
            *(f32x4*)(c.out + (size_t)row * DM + i * 256 + lane * 4) = (f32x4){v[i][0] * rs * g[0], v[i][1] * rs * g[1], v[i][2] * rs * g[2], v[i][3] * rs * g[3]};
        }
    }
}

constexpr int PH_PER_LAYER = 11, N_PHASES = DEPTH * PH_PER_LAYER + 1;
__global__ void __launch_bounds__(NTHREADS, 2) fwd_kernel(Params P) {
    extern __shared__ __attribute__((aligned(16))) unsigned char lds[];
    const int lo = P.ph_lo, hi = P.ph_hi;
    LAS unsigned* xbw = (LAS unsigned*)(lds + LDS_BYTES - 16);
    if (threadIdx.x == 0) { xbw[0] = 0u; xbw[1] = 0u; xbw[2] = 0u; xbw[3] = 0u; }
    __syncthreads();
    Ctx c; c.P = &P; c.ws = P.ws; c.out = P.out; c.l = 0;
    c.ctl = (unsigned*)(P.ws + WS_CTL);
    c.H = (bf16_t*)(P.ws + WS_H); c.PROJ = (bf16_t*)(P.ws + WS_PROJ); c.F = (bf16_t*)(P.ws + WS_F); c.POOLED = (bf16_t*)(P.ws + WS_POOLED);
    c.MERGED = (bf16_t*)(P.ws + WS_F); c.CMPH = (bf16_t*)(P.ws + WS_CMPH); c.CMPO = (float*)(P.ws + WS_CMPO); c.POSB = (float*)(P.ws + WS_POSB);
    c.ROUTE = (int*)(P.ws + WS_ROUTE); c.ENT = (int*)(P.ws + WS_ENT); c.HID = (bf16_t*)(P.ws + WS_HID); c.Y = (bf16_t*)(P.ws + WS_Y);
    c.VT = (bf16_t*)(P.ws + WS_VT); c.KC = (bf16_t*)(P.ws + WS_KC); c.VCT = (bf16_t*)(P.ws + WS_VCT);
    XcdBarrier bar; bar.bar = c.ctl + CW_BAR; bar.x = 0; bar.st = (volatile LAS unsigned*)xbw;
    if (hi - lo > 1) bar = xcd_barrier_post(c.ctl + CW_BAR, (volatile LAS unsigned*)xbw);
    bf16_t* sA = (bf16_t*)lds; bf16_t* sB = sA + 128 * GS;
#define IN(k) (lo <= (k) && (k) < hi)
#define SEAM(k) do { if (IN(k) && IN((k) + 1)) xcd_barrier(bar); } while (0)
#pragma unroll 1
    for (int l = 0; l < DEPTH; ++l) {
        c.l = l; const int pb = l * PH_PER_LAYER;
        if (IN(pb + 0)) phase_norm1(c);
        SEAM(pb + 0);
        if (IN(pb + 1)) phase_gemm1(c, sA, sB);
        SEAM(pb + 1);
        if (IN(pb + 2)) phase_prep(c, lds);
        SEAM(pb + 2);
        if (IN(pb + 3)) phase_poolgemm(c, sA, sB);
        SEAM(pb + 3);
        if (IN(pb + 4)) phase_mix(c, lds);
        SEAM(pb + 4);
        if (IN(pb + 5)) phase_merge(c, sA, sB);
        SEAM(pb + 5);
        if (IN(pb + 6)) phase_outp(c, sA, sB);
        SEAM(pb + 6);
        if (IN(pb + 7)) phase_norm2(c);
        SEAM(pb + 7);
        if (IN(pb + 8)) phase_route2(c, lds);
        SEAM(pb + 8);
        if (IN(pb + 9)) phase_moe_up(c, lds);
        SEAM(pb + 9);
        if (IN(pb + 10)) phase_moe_down(c, lds);
        SEAM(pb + 10);
    }
    if (IN(N_PHASES - 1)) phase_final(c);
}

#ifndef MK_N_LAUNCHES
#define MK_N_LAUNCHES 1
#endif
extern "C" void kernel_launch(void* const* d_in, const int* in_sizes, int n_in, void* d_out, int out_size, void* d_ws, size_t ws_size, hipStream_t stream) {
    static int grid = 0;
    if (grid == 0) {
        if (n_in != N_IN || out_size != NT * DM || ws_size < WS_END) { fprintf(stderr, "kernel_launch: unexpected shapes n_in %d out %d ws %zu (need %zu)\n", n_in, out_size, ws_size, (size_t)WS_END); grid = -1; return; }
        int dev = 0, cus = 0, per_cu = 0;
        if (hipGetDevice(&dev) != hipSuccess || hipDeviceGetAttribute(&cus, hipDeviceAttributeMultiprocessorCount, dev) != hipSuccess) { grid = -1; return; }
        if (hipFuncSetAttribute((const void*)fwd_kernel, hipFuncAttributeMaxDynamicSharedMemorySize, LDS_BYTES) != hipSuccess) { fprintf(stderr, "kernel_launch: hipFuncSetAttribute failed\n"); grid = -1; return; }
        if (hipOccupancyMaxActiveBlocksPerMultiprocessor(&per_cu, (const void*)fwd_kernel, NTHREADS, LDS_BYTES) != hipSuccess || per_cu < 1) { fprintf(stderr, "kernel_launch: occupancy query says %d\n", per_cu); }
        (void)hipGetLastError();
        grid = cus;
    }
    if (grid < 0) return;
    if (hipMemsetAsync((char*)d_ws + WS_CTL, 0, CTL_BYTES, stream) != hipSuccess) return;
    Params p{};
    for (int i = 0; i < N_IN; ++i) p.in[i] = (const float*)d_in[i];
    p.out = (float*)d_out; p.ws = (unsigned char*)d_ws;
    if (MK_N_LAUNCHES == 1) {
        p.ph_lo = 0; p.ph_hi = N_PHASES;
        hipLaunchKernelGGL(fwd_kernel, dim3(grid), dim3(NTHREADS), LDS_BYTES, stream, p);
    } else {
        for (int k = 0; k < N_PHASES; ++k) { p.ph_lo = k; p.ph_hi = k + 1; hipLaunchKernelGGL(fwd_kernel, dim3(grid), dim3(NTHREADS), LDS_BYTES, stream, p); }
    }
}
```

```cpp
#include <hip/hip_runtime.h>
#include <cstdio>
#include <cstdint>

#define DI __device__ __forceinline__
typedef unsigned short bf16_t;
typedef short bf16x8 __attribute__((ext_vector_type(8)));
typedef float f32x4 __attribute__((ext_vector_type(4)));
typedef unsigned u32x4 __attribute__((ext_vector_type(4)));
typedef unsigned u32x2 __attribute__((ext_vector_type(2)));

constexpr int NB = 4, SEQ = 4096, DM = 1024, NT = NB * SEQ, DEPTH = 2;
constexpr int IN_COLS = 4816;
constexpr int C_POOL = 0, C_RW = 512, C_R = 512, C_K = 1024, C_V = 1536, C_WD = 2048, C_AD = 2080, C_GD = 2112;
constexpr int C_Q = 2208, C_KC = 3232, C_VC = 3488, C_KS = 3744, C_VS = 4000, C_KW = 4256, C_VW = 4512, C_GATE = 4768;
constexpr int RWC = 1696;
constexpr int NCMP = 255;
constexpr int NTHREADS = 512;
constexpr int LDS_BYTES = 114688;

enum { I_X = 0, I_RELB, I_NMIX, I_WIN, I_POOLW, I_POOLS, I_MU, I_W0, I_WUP, I_A0, I_AUP, I_GUP, I_KK, I_KA, I_RK, I_GNW, I_GNB,
       I_CPK, I_CW1K, I_CW2K, I_CPV, I_CW1V, I_CW2V, I_WBR, I_WMG, I_BMG, I_WOUT, I_NFFN, I_WRG, I_BRG, I_WRE, I_BRE, I_EG, I_EU, I_ED, I_NFIN, N_IN };

constexpr size_t WS_CTL = 0;
constexpr size_t CTL_BYTES = 65536;
constexpr size_t WS_H = CTL_BYTES;
constexpr size_t WS_PROJ = WS_H + (size_t)NT * DM * 2;
constexpr size_t WS_F = WS_PROJ + (size_t)NT * IN_COLS * 2;
constexpr size_t PLANE = (size_t)NT * 512 * 2;
constexpr size_t WS_POOLED = WS_F + 6 * PLANE;
constexpr size_t WS_CMPH = WS_POOLED + PLANE;
constexpr size_t WS_CMPO = WS_CMPH + (size_t)2 * 4096 * 256 * 2;
constexpr size_t WS_POSB = WS_CMPO + (size_t)2 * 4096 * 64 * 4;
constexpr size_t WS_ROUTE = WS_POSB + 4096;
constexpr size_t WS_ENT = WS_ROUTE + (size_t)NT * 32;
constexpr size_t WS_VT = WS_ENT + (size_t)2 * NT * 8;
constexpr size_t WS_KC = WS_VT + (size_t)2 * 16 * 64 * SEQ * 2;
constexpr size_t WS_VCT = WS_KC + (size_t)16 * 256 * 64 * 2;
constexpr size_t WS_YRAW = WS_VCT + (size_t)16 * 64 * 256 * 2;
constexpr size_t WS_BON = WS_YRAW + (size_t)NT * 512 * 2;
constexpr size_t WS_SMALLW = WS_BON + (size_t)NT * 8 * 4;
constexpr size_t WS_END = WS_SMALLW + 262144;
constexpr size_t WS_WT_IN = WS_F;
constexpr size_t WS_WT_C1 = WS_CMPO;
constexpr size_t WS_WT_C2 = WS_SMALLW;
constexpr size_t WS_WT_POOL = WS_SMALLW + 131072;
constexpr size_t WS_WT_MG = WS_VT;
constexpr size_t WS_WT_BR = WS_VT + (size_t)3072 * 1024 * 2;
constexpr size_t WS_WT_OUT = WS_CMPH;
constexpr size_t WS_EG = WS_F + 2 * PLANE;
constexpr size_t WS_EU = WS_EG + (size_t)32 * 256 * 1024 * 2;
constexpr size_t WS_ED = WS_EU + (size_t)32 * 256 * 1024 * 2;
static_assert(WS_ED + (size_t)32 * 1024 * 256 * 2 <= WS_F + 6 * PLANE, "expert alias");
static_assert(WS_WT_BR + (size_t)2048 * 1024 * 2 <= WS_VT + (size_t)2 * 16 * 64 * SEQ * 2, "merge alias");
static_assert((size_t)4864 * 1024 * 2 <= 6 * PLANE, "w_in alias");
constexpr size_t WS_HID = WS_PROJ;
constexpr size_t WS_Y = WS_PROJ + (size_t)2 * NT * 256 * 2;
static_assert(WS_Y + (size_t)2 * NT * 1024 * 2 <= WS_F, "alias");
constexpr int CW_BAR = 0;
constexpr int CW_CNT = 4096;
constexpr int CW_CUR = 4096 + 64;
constexpr int CW_Q = 4096 + 128;

#define XB_TMO      128
#define XB_XCNT(j)  (256  + 64 * (j))
#define XB_XSUB(j)  (1280 + 64 * (j))
#define XB_XGEN(j)  (2304 + 64 * (j))
#define XB_TOP      3328
#define XB_TOPGEN   3392
#define XCD_BAR_WORDS 3456
#define XB_SPIN_CAP (1u << 18)
#define LAS __attribute__((address_space(3)))

__device__ __forceinline__ unsigned xb_ld(unsigned* p)              { return __hip_atomic_load(p, __ATOMIC_RELAXED, __HIP_MEMORY_SCOPE_AGENT); }
__device__ __forceinline__ unsigned xb_add(unsigned* p, unsigned v) { return __hip_atomic_fetch_add(p, v, __ATOMIC_RELAXED, __HIP_MEMORY_SCOPE_AGENT); }
__device__ __forceinline__ unsigned xb_xcc_id() { return (unsigned)__builtin_amdgcn_s_getreg((3 << 11) | 20) & 0xFu; }
#define XB_SPIN(cond, bar) do { unsigned _sp = 0; while (cond) { __builtin_amdgcn_s_sleep(1); \
    if ((++_sp & 255u) == 0u) { if (xb_ld(&(bar)[XB_TMO])) break; if (_sp > XB_SPIN_CAP) { atomicAdd(&(bar)[XB_TMO], 1u); break; } } } } while (0)

struct XcdBarrier { unsigned* bar; unsigned x; volatile LAS unsigned* st; };

__device__ __forceinline__ XcdBarrier xcd_barrier_post(unsigned* bar, volatile LAS unsigned* st) {
    XcdBarrier b; b.bar = bar; b.x = xb_xcc_id(); b.st = st;
    if (threadIdx.x == 0) (void)xb_add(&bar[XB_XCNT(b.x)], 1u);
    return b;
}
__device__ __forceinline__ void xcd_barrier_complete(unsigned* bar, unsigned x, unsigned& nloc, unsigned& nx) {
    const unsigned G = gridDim.x * gridDim.y * gridDim.z;
    unsigned sum, cnt, mine, sp = 0u;
    for (;;) {
        sum = 0u; cnt = 0u; mine = 0u;
#pragma unroll
        for (unsigned j = 0; j < 16; ++j) { const unsigned c = xb_ld(&bar[XB_XCNT(j)]); sum += c; cnt += (c > 0u) ? 1u : 0u; mine = (j == x) ? c : mine; }
        if (sum == G) break;
        __builtin_amdgcn_s_sleep(1);
        if ((++sp & 255u) == 0u) { if (xb_ld(&bar[XB_TMO])) break; if (sp > XB_SPIN_CAP) { atomicAdd(&bar[XB_TMO], 1u); break; } }
    }
    nloc = mine > 0u ? mine : 1u; nx = cnt > 0u ? cnt : 1u;
}
__device__ __forceinline__ void xcd_barrier(const XcdBarrier& b) {
    asm volatile("s_waitcnt vmcnt(0)" ::: "memory");
    __syncthreads();
    if (threadIdx.x == 0) {
        unsigned* bar = b.bar;
        __builtin_amdgcn_s_waitcnt(0);
        unsigned nloc = b.st[0], nx = b.st[1];
        if (nloc == 0u) { xcd_barrier_complete(bar, b.x, nloc, nx); b.st[0] = nloc; b.st[1] = nx; }
        const unsigned old = xb_add(&bar[XB_XSUB(b.x)], 1u);
        const unsigned gen = old / nloc;
        if (old + 1u == (gen + 1u) * nloc) {
            __builtin_amdgcn_fence(__ATOMIC_RELEASE, "agent");
            asm volatile("s_waitcnt vmcnt(0)" ::: "memory");
            const unsigned og = xb_add(&bar[XB_TOP], 1u);
            const unsigned tg = og / nx;
            if (og + 1u == (tg + 1u) * nx) xb_add(&bar[XB_TOPGEN], 1u);
            else XB_SPIN(xb_ld(&bar[XB_TOPGEN]) == tg, bar);
            __builtin_amdgcn_fence(__ATOMIC_ACQUIRE, "agent");
            xb_add(&bar[XB_XGEN(b.x)], 1u);
            asm volatile("s_waitcnt vmcnt(0)" ::: "memory");
        } else {
            XB_SPIN(xb_ld(&bar[XB_XGEN(b.x)]) == gen, bar);
            __builtin_amdgcn_fence(__ATOMIC_ACQUIRE, "agent");
            asm volatile("s_waitcnt vmcnt(0)" ::: "memory");
        }
    }
    __syncthreads();
}

DI bf16_t f2bf(float x) { unsigned u = __float_as_uint(x); u += 0x7fffu + ((u >> 16) & 1u); return (bf16_t)(u >> 16); }
DI float bf2f(bf16_t b) { return __uint_as_float((unsigned)b << 16); }
DI unsigned pack2(float lo, float hi) { return (unsigned)f2bf(lo) | ((unsigned)f2bf(hi) << 16); }
DI float bflo(unsigned w) { return __uint_as_float(w << 16); }
DI float bfhi(unsigned w) { return __uint_as_float(w & 0xffff0000u); }
DI float wave_sum(float v) {
#pragma unroll
    for (int o = 32; o >= 1; o >>= 1) v += __shfl_xor(v, o);
    return v;
}
DI float wave_max(float v) {
#pragma unroll
    for (int o = 32; o >= 1; o >>= 1) v = fmaxf(v, __shfl_xor(v, o));
    return v;
}
DI float sigmoidf_(float x) { return 1.0f / (1.0f + __expf(-x)); }
DI int TID() { int t = threadIdx.x; asm volatile("" : "+v"(t)); return t; }
#define LDS_WAVE_SYNC() asm volatile("s_waitcnt lgkmcnt(0)" ::: "memory")

struct Params { const float* in[N_IN]; float* out; unsigned char* ws; int ph_lo, ph_hi; };

DI int t5_bucket(int n) {
    if (n < 16) return n;
    if (n >= 128) return 31;
    int b = 16;
    b += (n >= 19) + (n >= 21) + (n >= 24) + (n >= 27) + (n >= 31) + (n >= 35) + (n >= 40) + (n >= 46) + (n >= 52) + (n >= 59) + (n >= 67) + (n >= 77) + (n >= 87) + (n >= 99) + (n >= 113);
    return b;
}

constexpr int GS = 72;
constexpr int G_A = 0, G_B = 256 * GS * 2, G_STAGE = (256 + 128) * GS * 2;
static_assert(2 * G_STAGE <= LDS_BYTES - 64, "gemm lds");
struct ARows { const bf16_t* p[4]; };
template <int AMODE>
DI void g_load(u32x4 (&ra)[4], u32x4 (&rb)[2], const ARows& ar, const bf16_t* bt, int ldb, int k0, int tid) {
    const int kseg = (tid & 7) * 8;
#pragma unroll
    for (int i = 0; i < 4; ++i) {
        ra[i] = (u32x4){0u, 0u, 0u, 0u};
        if (ar.p[i] != nullptr) ra[i] = *(const u32x4*)((AMODE == 0) ? (ar.p[i] + k0 + kseg) : (ar.p[i] + (size_t)(k0 >> 6) * IN_COLS + kseg));
    }
#pragma unroll
    for (int i = 0; i < 2; ++i) rb[i] = *(const u32x4*)(bt + (size_t)((tid >> 3) + 64 * i) * ldb + k0 + kseg);
}
DI void g_store(unsigned char* st, const u32x4 (&ra)[4], const u32x4 (&rb)[2], int tid) {
    const int r = tid >> 3, kseg = (tid & 7) * 8;
#pragma unroll
    for (int i = 0; i < 4; ++i) *(u32x4*)((bf16_t*)(st + G_A) + (r + 64 * i) * GS + kseg) = ra[i];
#pragma unroll
    for (int i = 0; i < 2; ++i) *(u32x4*)((bf16_t*)(st + G_B) + (r + 64 * i) * GS + kseg) = rb[i];
}
DI void g_compute(f32x4 (&acc)[4][4], const unsigned char* st, int lane, int wm, int wn) {
    const bf16_t* sA = (const bf16_t*)(st + G_A) + (wm * 64 + (lane & 15)) * GS + (lane >> 4) * 8;
    const bf16_t* sB = (const bf16_t*)(st + G_B) + (wn * 64 + (lane & 15)) * GS + (lane >> 4) * 8;
#pragma unroll
    for (int ks = 0; ks < 2; ++ks) {
        bf16x8 af[4], bfr[4];
#pragma unroll
        for (int i = 0; i < 4; ++i) { af[i] = *(const bf16x8*)(sA + i * 16 * GS + ks * 32); bfr[i] = *(const bf16x8*)(sB + i * 16 * GS + ks * 32); }
#pragma unroll
        for (int mi = 0; mi < 4; ++mi)
#pragma unroll
            for (int ni = 0; ni < 4; ++ni) acc[mi][ni] = __builtin_amdgcn_mfma_f32_16x16x32_bf16(bfr[ni], af[mi], acc[mi][ni], 0, 0, 0);
    }
}
template <int AMODE>
DI void gemm_core(f32x4 (&acc)[4][4], const ARows& ar, const bf16_t* bt  , int ldb, int K, unsigned char* lds) {
    const int tid = TID(), lane = tid & 63, wave = tid >> 6, wm = wave >> 1, wn = wave & 1;
    const int nk = K >> 6;
    unsigned char* s0 = lds; unsigned char* s1 = lds + G_STAGE;
    u32x4 ra0[4], rb0[2], ra1[4], rb1[2];
    g_load<AMODE>(ra0, rb0, ar, bt, ldb, 0, tid);
    if (nk > 1) g_load<AMODE>(ra1, rb1, ar, bt, ldb, 64, tid);
    __syncthreads();
    g_store(s0, ra0, rb0, tid);
    if (nk > 2) g_load<AMODE>(ra0, rb0, ar, bt, ldb, 128, tid);
    __syncthreads();
    for (int kt = 0; kt < nk; kt += 2) {
        if (kt + 1 < nk) { g_store(s1, ra1, rb1, tid); if (kt + 3 < nk) g_load<AMODE>(ra1, rb1, ar, bt, ldb, (kt + 3) * 64, tid); }
        g_compute(acc, s0, lane, wm, wn);
        __syncthreads();
        if (kt + 1 >= nk) break;
        if (kt + 2 < nk) { g_store(s0, ra0, rb0, tid); if (kt + 4 < nk) g_load<AMODE>(ra0, rb0, ar, bt, ldb, (kt + 4) * 64, tid); }
        g_compute(acc, s1, lane, wm, wn);
        __syncthreads();
    }
}
DI void acc_zero(f32x4 (&acc)[4][4]) {
#pragma unroll
    for (int i = 0; i < 4; ++i)
#pragma unroll
        for (int j = 0; j < 4; ++j) acc[i][j] = (f32x4){0.f, 0.f, 0.f, 0.f};
}
#define ACC_FOREACH(acc, body) do { const int _l = TID() & 63, _w = TID() >> 6; \
    _Pragma("unroll") for (int _mi = 0; _mi < 4; ++_mi) _Pragma("unroll") for (int _ni = 0; _ni < 4; ++_ni) { \
        const int r_ = (_w >> 1) * 64 + _mi * 16 + (_l & 15), c_ = (_w & 1) * 64 + _ni * 16 + (_l >> 4) * 4; f32x4& v_ = acc[_mi][_ni]; body } } while (0)
DI ARows plain_rows(const bf16_t* base, size_t ld, int m0, int tid) { ARows a;
#pragma unroll
    for (int i = 0; i < 4; ++i) a.p[i] = base + (size_t)(m0 + (tid >> 3) + 64 * i) * ld;
    return a; }

DI void store_bf4(bf16_t* p, f32x4 v) { u32x2 w; w.x = pack2(v[0], v[1]); w.y = pack2(v[2], v[3]); *(u32x2*)p = w; }

DI void convert_tile(const float* src, int ld, int N, int K, bf16_t* dst, int tile, unsigned char* lds) {
    const int tid = TID();
    const int nkt = K >> 6, tk = tile % nkt, tn = tile / nkt, k0 = tk * 64, n0 = tn * 64;
    bf16_t* T = (bf16_t*)lds;
    const int r = tid >> 3, seg = (tid & 7) * 8;
    f32x4 a = (f32x4){0.f, 0.f, 0.f, 0.f}, b = a;
    if (n0 + seg < N) { const float* q = src + (size_t)(k0 + r) * ld + n0 + seg; a = *(const f32x4*)q; b = *(const f32x4*)(q + 4); }
    __syncthreads();
    { u32x4 w; w.x = pack2(a[0], a[1]); w.y = pack2(a[2], a[3]); w.z = pack2(b[0], b[1]); w.w = pack2(b[2], b[3]); *(u32x4*)(T + r * 72 + seg) = w; }
    __syncthreads();
    u32x4 o;
    o.x = (unsigned)T[(seg + 0) * 72 + r] | ((unsigned)T[(seg + 1) * 72 + r] << 16); o.y = (unsigned)T[(seg + 2) * 72 + r] | ((unsigned)T[(seg + 3) * 72 + r] << 16);
    o.z = (unsigned)T[(seg + 4) * 72 + r] | ((unsigned)T[(seg + 5) * 72 + r] << 16); o.w = (unsigned)T[(seg + 6) * 72 + r] | ((unsigned)T[(seg + 7) * 72 + r] << 16);
    *(u32x4*)(dst + (size_t)(n0 + r) * K + k0 + seg) = o;
}

struct Ctx {
    const Params* P; unsigned char* ws; float* out; int l;
    bf16_t* H; bf16_t* PROJ; bf16_t* F; bf16_t* POOLED; bf16_t* MERGED; bf16_t* CMPH; float* CMPO; float* POSB; int* ROUTE; int* ENT; bf16_t* HID; bf16_t* Y; bf16_t* VT; bf16_t* KC; bf16_t* VCT; bf16_t* YRAW; float* BON; unsigned* ctl;
    DI const float* in(int i) const { return P->in[i]; }
};

DI void add_moe_rows(const Ctx& c, int row, int lane, f32x4 (&v)[4]) {
    const int* rt = c.ROUTE + (size_t)row * 8;
    const int p0 = rt[4], p1 = rt[5];
    const bf16_t* y0 = c.Y + (size_t)p0 * DM; const bf16_t* y1 = c.Y + (size_t)p1 * DM;
#pragma unroll
    for (int i = 0; i < 4; ++i) {
        const u32x2 a = *(const u32x2*)(y0 + i * 256 + lane * 4), b = *(const u32x2*)(y1 + i * 256 + lane * 4);
        v[i][0] += bflo(a.x) + bflo(b.x); v[i][1] += bfhi(a.x) + bfhi(b.x); v[i][2] += bflo(a.y) + bflo(b.y); v[i][3] += bfhi(a.y) + bfhi(b.y);
    }
}
DI void phase_norm1(const Ctx& c, unsigned char* lds) {
    const int tid = TID(), lane = tid & 63, wave = tid >> 6;
    const float* gain = c.in(I_NMIX) + c.l * DM;
    const float* src = (c.l == 0) ? c.in(I_X) : c.out;
    for (int row = blockIdx.x * 8 + wave; row < NT; row += gridDim.x * 8) {
        f32x4 v[4];
#pragma unroll
        for (int i = 0; i < 4; ++i) v[i] = *(const f32x4*)(src + (size_t)row * DM + i * 256 + lane * 4);
        if (c.l > 0) {
            add_moe_rows(c, row, lane, v);
#pragma unroll
            for (int i = 0; i < 4; ++i) *(f32x4*)(c.out + (size_t)row * DM + i * 256 + lane * 4) = v[i];
        }
        float ss = 0.f;
#pragma unroll
        for (int i = 0; i < 4; ++i) ss += v[i][0] * v[i][0] + v[i][1] * v[i][1] + v[i][2] * v[i][2] + v[i][3] * v[i][3];
        ss = wave_sum(ss);
        const float rs = rsqrtf(ss * (1.0f / DM) + 1e-6f);
#pragma unroll
        for (int i = 0; i < 4; ++i) {
            const f32x4 g = *(const f32x4*)(gain + i * 256 + lane * 4);
            store_bf4(c.H + (size_t)row * DM + i * 256 + lane * 4, (f32x4){v[i][0] * rs * g[0], v[i][1] * rs * g[1], v[i][2] * rs * g[2], v[i][3] * rs * g[3]});
        }
    }
    for (int idx = blockIdx.x * 8 + wave; idx < 512; idx += gridDim.x * 8) {
        const int kv = idx >> 8, n = idx & 255;
        const float* pos = c.in(kv ? I_CPV : I_CPK) + (size_t)c.l * 2048;
        const float* w1 = c.in(kv ? I_CW1V : I_CW1K) + (size_t)c.l * 2048 * 256;
        float s = 0.f;
        for (int k = lane; k < 2048; k += 64) s += pos[k] * w1[(size_t)k * 256 + n];
        s = wave_sum(s);
        if (lane == 0) c.POSB[kv * 256 + n] = s;
    }
    for (int it = blockIdx.x; it < 1216 + 256 + 16 + 16; it += gridDim.x) {
        if (it < 1216) convert_tile(c.in(I_WIN) + (size_t)c.l * DM * IN_COLS, IN_COLS, IN_COLS, DM, (bf16_t*)(c.ws + WS_WT_IN), it, lds);
        else if (it < 1216 + 256) { const int j = it - 1216, kv = j >> 7; convert_tile(c.in(kv ? I_CW1V : I_CW1K) + (size_t)c.l * 2048 * 256, 256, 256, 2048, (bf16_t*)(c.ws + WS_WT_C1) + (size_t)kv * 256 * 2048, j & 127, lds); }
        else if (it < 1216 + 256 + 16) { const int j = it - 1472, kv = j >> 3; convert_tile(c.in(kv ? I_CW2V : I_CW2K) + (size_t)c.l * 256 * 64, 64, 64, 256, (bf16_t*)(c.ws + WS_WT_C2) + (size_t)kv * 128 * 256, j & 7, lds); }
        else { const int j = it - 1488, gi = j >> 2; convert_tile(c.in(I_POOLW) + ((size_t)c.l * 4 + gi) * 128 * 128, 128, 128, 128, (bf16_t*)(c.ws + WS_WT_POOL) + (size_t)gi * 128 * 128, j & 3, lds); }
    }
}

DI void phase_gemm1(const Ctx& c, unsigned char* lds) {
    const int nM = NT / 256, nN = (IN_COLS + 127) / 128;
    const bf16_t* WT = (const bf16_t*)(c.ws + WS_WT_IN);
    for (int tile = blockIdx.x; tile < nM * nN; tile += gridDim.x) {
        const int tm = tile % nM, tn = tile / nM, m0 = tm * 256, n0 = tn * 128;
        f32x4 acc[4][4]; acc_zero(acc);
        const ARows ar = plain_rows(c.H, DM, m0, TID());
        gemm_core<0>(acc, ar, WT + (size_t)n0 * DM, DM, DM, lds);
        ACC_FOREACH(acc, { if (n0 + c_ < IN_COLS) store_bf4(c.PROJ + (size_t)(m0 + r_) * IN_COLS + n0 + c_, v_); });
    }
}

DI float gelu_tanh(float x) { const float u = 0.7978845608028654f * (x + 0.044715f * x * x * x); const float e = __expf(2.0f * u); return x * (1.0f - 1.0f / (e + 1.0f)); }
DI float softplusf_(float x) { return (x > 20.f) ? x : __logf(1.0f + __expf(x)); }
DI float tanhf_(float x) { const float e = __expf(2.0f * x); return 1.0f - 2.0f / (e + 1.0f); }
DI void phase_prep(const Ctx& c, unsigned char* lds) {
    const int tid = TID();
    const int n_cmp_items = 2 * 16 * 2;
    const int n_prep = n_cmp_items + NT / 16;
    const int n_items = n_prep + 2048;
    for (int item = blockIdx.x; item < n_items; item += gridDim.x) {
        if (item < n_cmp_items) {
            const int kv = item >> 5, bgi = (item >> 1) & 15, tn = item & 1, m0 = bgi * 256, n0 = tn * 128;
            ARows ar;
#pragma unroll
            for (int i = 0; i < 4; ++i) { const int cb = (tid >> 3) + 64 * i;
                ar.p[i] = (cb < NCMP) ? c.PROJ + ((size_t)(bgi >> 2) * SEQ + 16 * cb) * IN_COLS + (kv ? C_VC : C_KC) + (bgi & 3) * 64 : nullptr; }
            f32x4 acc[4][4]; acc_zero(acc);
            gemm_core<1>(acc, ar, (const bf16_t*)(c.ws + WS_WT_C1) + ((size_t)kv * 256 + n0) * 2048, 2048, 2048, lds);
            const float* pb = c.POSB + kv * 256;
            ACC_FOREACH(acc, {
                const f32x4 bb = *(const f32x4*)(pb + n0 + c_);
                store_bf4(c.CMPH + ((size_t)kv * 4096 + m0 + r_) * 256 + n0 + c_, (f32x4){gelu_tanh(v_[0] + bb[0]), gelu_tanh(v_[1] + bb[1]), gelu_tanh(v_[2] + bb[2]), gelu_tanh(v_[3] + bb[3])}); });
        } else if (item >= n_prep) {
            const int idx = item - n_prep, kind = idx >> 10, bgi = (idx >> 6) & 15, s0 = (idx & 63) * 64;
            bf16_t* T = (bf16_t*)lds;
            const int r = tid >> 3, seg = (tid & 7) * 8;
            const u32x4 w = *(const u32x4*)(c.PROJ + ((size_t)(bgi >> 2) * SEQ + s0 + r) * IN_COLS + (kind ? C_VW : C_VS) + (bgi & 3) * 64 + seg);
            __syncthreads();
            *(u32x4*)(T + r * 72 + seg) = w;
            __syncthreads();
            u32x4 o;
            o.x = (unsigned)T[(seg + 0) * 72 + r] | ((unsigned)T[(seg + 1) * 72 + r] << 16); o.y = (unsigned)T[(seg + 2) * 72 + r] | ((unsigned)T[(seg + 3) * 72 + r] << 16);
            o.z = (unsigned)T[(seg + 4) * 72 + r] | ((unsigned)T[(seg + 5) * 72 + r] << 16); o.w = (unsigned)T[(seg + 6) * 72 + r] | ((unsigned)T[(seg + 7) * 72 + r] << 16);
            *(u32x4*)(c.VT + (((size_t)kind * 16 + bgi) * 64 + r) * SEQ + s0 + seg) = o;
        } else {
            const int t0 = (item - n_cmp_items) * 16;
            float* sl = (float*)lds;
            const float* mu = c.in(I_MU) + (size_t)c.l * RWC;
            __syncthreads();
            for (int idx = tid; idx < 16 * 160; idx += NTHREADS) {
                const int tk = idx / 160, i = idx % 160, t = t0 + tk, col = C_WD + i;
                const float u = bf2f(c.PROJ[(size_t)t * IN_COLS + col]);
                const float up = ((t & (SEQ - 1)) != 0) ? bf2f(c.PROJ[(size_t)(t - 1) * IN_COLS + col]) : 0.f;
                const float us = u + (up - u) * mu[col - C_RW];
                sl[idx] = (i < 32) ? tanhf_(us) : ((i < 64) ? us : sigmoidf_(us));
            }
            __syncthreads();
            const int ch = tid;
            float z[16], aa[16], gg[16];
#pragma unroll
            for (int k = 0; k < 16; ++k) { z[k] = 0.f; aa[k] = 0.f; gg[k] = 0.f; }
            const float* wup = c.in(I_WUP) + (size_t)c.l * 32 * 512 + ch;
            const float* aup = c.in(I_AUP) + (size_t)c.l * 32 * 512 + ch;
            const float* gup = c.in(I_GUP) + (size_t)c.l * 96 * 512 + ch;
            for (int i = 0; i < 32; ++i) {
                const float w = wup[i * 512], a = aup[i * 512];
#pragma unroll
                for (int k = 0; k < 16; ++k) { z[k] += sl[k * 160 + i] * w; aa[k] += sl[k * 160 + 32 + i] * a; }
            }
            for (int i = 0; i < 96; ++i) {
                const float w = gup[i * 512];
#pragma unroll
                for (int k = 0; k < 16; ++k) gg[k] += sl[k * 160 + 64 + i] * w;
            }
            const float w0 = c.in(I_W0)[c.l * 512 + ch], a0 = c.in(I_A0)[c.l * 512 + ch];
            const float mur = mu[ch], muk = mu[512 + ch], muv = mu[1024 + ch];
            float pr = 0.f, pk = 0.f, pv = 0.f;
            if ((t0 & (SEQ - 1)) != 0) { const bf16_t* q = c.PROJ + (size_t)(t0 - 1) * IN_COLS; pr = bf2f(q[C_R + ch]); pk = bf2f(q[C_K + ch]); pv = bf2f(q[C_V + ch]); }
#pragma unroll
            for (int k = 0; k < 16; ++k) {
                const int t = t0 + k; const bf16_t* q = c.PROJ + (size_t)t * IN_COLS;
                const float ur = bf2f(q[C_R + ch]), uk = bf2f(q[C_K + ch]), uv = bf2f(q[C_V + ch]);
                const float r = ur + (pr - ur) * mur, kx = uk + (pk - uk) * muk, vx = uv + (pv - uv) * muv;
                pr = ur; pk = uk; pv = uv;
                const float wlog = -softplusf_(-(w0 + z[k])) - 0.5f;
                const float e = __expf(wlog);
                const float a = sigmoidf_(a0 + aa[k]);
                const size_t o = (size_t)t * 512 + ch;
                c.F[o] = f2bf(r); c.F[o + (size_t)NT * 512] = f2bf(kx); c.F[o + (size_t)2 * NT * 512] = f2bf(vx);
                c.F[o + (size_t)3 * NT * 512] = f2bf(e); c.F[o + (size_t)4 * NT * 512] = f2bf(a); c.F[o + (size_t)5 * NT * 512] = f2bf(gg[k]);
            }
            {
                const int gi = ch >> 7, win = 2 << gi;
#pragma unroll 1
                for (int k = 0; k < 16; ++k) {
                    const int t = t0 + k, s = t & (SEQ - 1);
                    const int lo = (s + 1 - win > 0) ? (s + 1 - win) : 0;
                    float sum = 0.f;
                    for (int j = lo; j <= s; ++j) sum += bf2f(c.PROJ[(size_t)(t - s + j) * IN_COLS + C_POOL + ch]);
                    const float self = bf2f(c.PROJ[(size_t)t * IN_COLS + C_POOL + ch]);
                    c.POOLED[(size_t)t * 512 + ch] = f2bf(sum / (float)(s + 1 - lo) - self);
                }
            }
        }
    }
}

DI void phase_poolgemm(const Ctx& c, unsigned char* lds) {
    const int n_pool = (NT / 256) * 4, n_items = n_pool + 32;
    for (int item = blockIdx.x; item < n_items; item += gridDim.x) {
        f32x4 acc[4][4]; acc_zero(acc);
        if (item < n_pool) {
            const int tm = item >> 2, gi = item & 3, m0 = tm * 256;
            const ARows ar = plain_rows(c.POOLED + gi * 128, 512, m0, TID());
            gemm_core<0>(acc, ar, (const bf16_t*)(c.ws + WS_WT_POOL) + (size_t)gi * 128 * 128, 128, 128, lds);
            const float* sc = c.in(I_POOLS) + c.l * 512 + gi * 128;
            ACC_FOREACH(acc, { const f32x4 s = *(const f32x4*)(sc + c_);
                store_bf4(c.POOLED + (size_t)(m0 + r_) * 512 + gi * 128 + c_, (f32x4){v_[0] * s[0], v_[1] * s[1], v_[2] * s[2], v_[3] * s[3]}); });
        } else {
            const int it = item - n_pool, kv = it >> 4, tm = it & 15, m0 = tm * 256;
            const ARows ar = plain_rows(c.CMPH + (size_t)kv * 4096 * 256, 256, m0, TID());
            gemm_core<0>(acc, ar, (const bf16_t*)(c.ws + WS_WT_C2) + (size_t)kv * 128 * 256, 256, 256, lds);
            ACC_FOREACH(acc, { if (c_ < 64) { const int R = m0 + r_;
                if (kv == 0) store_bf4(c.KC + (size_t)R * 64 + c_, v_);
                else { bf16_t* q = c.VCT + ((size_t)(R >> 8) * 64 + c_) * 256 + (R & 255); q[0] = f2bf(v_[0]); q[256] = f2bf(v_[1]); q[512] = f2bf(v_[2]); q[768] = f2bf(v_[3]); } } });
        }
    }
}

constexpr int SCH = 32;
constexpr int SB_AN = 0, SB_WR = SCH * 64 * 4, SB_W = 2 * SCH * 64 * 4, SB_BB = 3 * SCH * 64 * 4, SB_KP = 4 * SCH * 64 * 4;
constexpr int SB_V = 5 * SCH * 64 * 4;
constexpr int SB_SC = SB_V + SCH * 16 * 4;
constexpr int SB_Y = SB_SC + SCH * 2 * 4;
constexpr int SB_BYTES = SB_Y + SCH * 16 * 4;
static_assert(2 * SB_BYTES <= LDS_BYTES - 64, "scan lds");
typedef float f32x2 __attribute__((ext_vector_type(2)));
#define DPP_MOV(v, ctrl) __builtin_bit_cast(float, __builtin_amdgcn_update_dpp(0, __builtin_bit_cast(int, (v)), (ctrl), 0xF, 0xF, true))
DI float row8_sum(float v) { v += DPP_MOV(v, 0xB1); v += DPP_MOV(v, 0x4E); v += DPP_MOV(v, 0x141); return v; }

DI void scan_prep(const Ctx& c, unsigned char* sb, int b, int h, int rq, int ck, int pw, int npw, int lane, float kkw, float kaw, float rkw) {
    const size_t PL = (size_t)NT * 512;
    float* an = (float*)(sb + SB_AN); float* wr = (float*)(sb + SB_WR); float* w_ = (float*)(sb + SB_W); float* bb_ = (float*)(sb + SB_BB); float* kp_ = (float*)(sb + SB_KP);
    float* vv = (float*)(sb + SB_V); float* sc = (float*)(sb + SB_SC);
#pragma unroll 2
    for (int st = pw; st < SCH; st += npw) {
        const int t = ck * SCH + st;
        const size_t o = ((size_t)b * SEQ + t) * 512 + h * 64 + lane;
        const float r = bf2f(c.F[o]), k = bf2f(c.F[o + PL]), v = bf2f(c.F[o + 2 * PL]), e = bf2f(c.F[o + 3 * PL]), a = bf2f(c.F[o + 4 * PL]);
        const float w = __expf(-e);
        const float kx = k * kkw;
        const float ss = wave_sum(kx * kx);
        const float kk = kx / fmaxf(sqrtf(ss), 1e-12f);
        const float kp = k * (1.0f + (a - 1.0f) * kaw);
        const float bb = kk * a;
        const float br = wave_sum(bb * r), kr = wave_sum(kp * r);
        an[st * 64 + lane] = -kk; wr[st * 64 + lane] = w * r; w_[st * 64 + lane] = w; bb_[st * 64 + lane] = bb; kp_[st * 64 + lane] = kp;
        if ((lane >> 4) == rq) vv[st * 16 + (lane & 15)] = v;
        if (lane == 0) { sc[st * 2] = br; sc[st * 2 + 1] = kr; }
        if (rq == 0) { const float bon = wave_sum(r * kp * rkw); if (lane == 0) c.BON[((size_t)b * SEQ + t) * 8 + h] = bon; }
    }
}
DI void scan_item(const Ctx& c, int item, unsigned char* lds) {
    const int tid = TID(), lane = tid & 63, wave = tid >> 6;
    const int b = item >> 5, h = (item >> 2) & 7, rq = item & 3;
    const int chn = h * 64 + lane;
    const float kkw = c.in(I_KK)[c.l * 512 + chn], kaw = c.in(I_KA)[c.l * 512 + chn], rkw = c.in(I_RK)[c.l * 512 + chn];
    const int rowl = (tid & 127) >> 3, cg = tid & 7;
    f32x2 st[4];
#pragma unroll
    for (int i = 0; i < 4; ++i) st[i] = (f32x2){0.f, 0.f};
    __syncthreads();
    scan_prep(c, lds, b, h, rq, 0, wave, 8, lane, kkw, kaw, rkw);
    __syncthreads();
    constexpr int NCK = SEQ / SCH;
    for (int ck = 0; ck < NCK; ++ck) {
        unsigned char* sb = lds + (ck & 1) * SB_BYTES;
        if (wave < 2) {
            const float* an = (const float*)(sb + SB_AN) + cg * 8; const float* wr = (const float*)(sb + SB_WR) + cg * 8; const float* w_ = (const float*)(sb + SB_W) + cg * 8;
            const float* bb_ = (const float*)(sb + SB_BB) + cg * 8; const float* kp_ = (const float*)(sb + SB_KP) + cg * 8;
            const float* vv = (const float*)(sb + SB_V) + rowl; const float* sc = (const float*)(sb + SB_SC); float* yb = (float*)(sb + SB_Y) + rowl;
#pragma unroll 4
            for (int s = 0; s < SCH; ++s) {
                const f32x4 a0 = *(const f32x4*)(an + s * 64), a1 = *(const f32x4*)(an + s * 64 + 4);
                const f32x4 r0 = *(const f32x4*)(wr + s * 64), r1 = *(const f32x4*)(wr + s * 64 + 4);
                const f32x4 w0 = *(const f32x4*)(w_ + s * 64), w1 = *(const f32x4*)(w_ + s * 64 + 4);
                const f32x4 b0 = *(const f32x4*)(bb_ + s * 64), b1 = *(const f32x4*)(bb_ + s * 64 + 4);
                const f32x4 k0 = *(const f32x4*)(kp_ + s * 64), k1 = *(const f32x4*)(kp_ + s * 64 + 4);
                const float v = vv[s * 16];
                const f32x2 bk = *(const f32x2*)(sc + s * 2);
                f32x2 da = st[0] * (f32x2){a0[0], a0[1]}; f32x2 dr = st[0] * (f32x2){r0[0], r0[1]};
                da += st[1] * (f32x2){a0[2], a0[3]}; dr += st[1] * (f32x2){r0[2], r0[3]};
                da += st[2] * (f32x2){a1[0], a1[1]}; dr += st[2] * (f32x2){r1[0], r1[1]};
                da += st[3] * (f32x2){a1[2], a1[3]}; dr += st[3] * (f32x2){r1[2], r1[3]};
                const float sa = row8_sum(da[0] + da[1]);
                const float sr = row8_sum(dr[0] + dr[1]);
                const f32x2 sa2 = (f32x2){sa, sa}, v2 = (f32x2){v, v};
                st[0] = st[0] * (f32x2){w0[0], w0[1]} + sa2 * (f32x2){b0[0], b0[1]} + v2 * (f32x2){k0[0], k0[1]};
                st[1] = st[1] * (f32x2){w0[2], w0[3]} + sa2 * (f32x2){b0[2], b0[3]} + v2 * (f32x2){k0[2], k0[3]};
                st[2] = st[2] * (f32x2){w1[0], w1[1]} + sa2 * (f32x2){b1[0], b1[1]} + v2 * (f32x2){k1[0], k1[1]};
                st[3] = st[3] * (f32x2){w1[2], w1[3]} + sa2 * (f32x2){b1[2], b1[3]} + v2 * (f32x2){k1[2], k1[3]};
                if (cg == 0) yb[s * 16] = sr + sa * bk[0] + v * bk[1];
            }
        } else {
            const int pt = tid - 128;
            if (ck > 0) {
                const float* yb = (const float*)(lds + ((ck - 1) & 1) * SB_BYTES + SB_Y);
                for (int idx = pt; idx < SCH * 16; idx += 384) {
                    const int s = idx >> 4, j = idx & 15;
                    c.YRAW[((size_t)b * SEQ + (ck - 1) * SCH + s) * 512 + h * 64 + rq * 16 + j] = f2bf(yb[idx]);
                }
            }
            if (ck + 1 < NCK) scan_prep(c, lds + ((ck + 1) & 1) * SB_BYTES, b, h, rq, ck + 1, wave - 2, 6, lane, kkw, kaw, rkw);
        }
        __syncthreads();
    }
    {
        const float* yb = (const float*)(lds + ((NCK - 1) & 1) * SB_BYTES + SB_Y);
        for (int idx = tid; idx < SCH * 16; idx += NTHREADS) {
            const int s = idx >> 4, j = idx & 15;
            c.YRAW[((size_t)b * SEQ + (NCK - 1) * SCH + s) * 512 + h * 64 + rq * 16 + j] = f2bf(yb[idx]);
        }
    }
    __syncthreads();
}
DI void phase_rwkv_post(const Ctx& c, unsigned char* lds) {
    const int tid = TID(), lane = tid & 63, wave = tid >> 6;
    const size_t PL = (size_t)NT * 512;
    for (int idx = blockIdx.x * 8 + wave; idx < NT * 8; idx += gridDim.x * 8) {
        const int t = idx >> 3, h = idx & 7, chn = h * 64 + lane;
        const size_t o = (size_t)t * 512 + chn;
        const float y = bf2f(c.YRAW[o]);
        const float mean = wave_sum(y) * (1.0f / 64.0f);
        const float d = y - mean;
        const float var = wave_sum(d * d) * (1.0f / 64.0f);
        const float yn = d * rsqrtf(var + 64e-5f) * c.in(I_GNW)[c.l * 512 + chn] + c.in(I_GNB)[c.l * 512 + chn];
        const float v = bf2f(c.F[o + 2 * PL]), g = bf2f(c.F[o + 5 * PL]);
        c.F[o + 5 * PL] = f2bf((yn + c.BON[idx] * v) * g);
    }
    for (int it = blockIdx.x; it < 768 + 128 + 128 + 256 + 256; it += gridDim.x) {
        const float* WB = c.in(I_WBR) + (size_t)c.l * 2048 * DM; bf16_t* BR = (bf16_t*)(c.ws + WS_WT_BR);
        if (it < 768) convert_tile(c.in(I_WMG) + (size_t)c.l * DM * 3 * DM, 3 * DM, 3 * DM, DM, (bf16_t*)(c.ws + WS_WT_MG), it, lds);
        else if (it < 896) convert_tile(WB, DM, DM, 512, BR, it - 768, lds);
        else if (it < 1024) convert_tile(WB + (size_t)512 * DM, DM, DM, 512, BR + (size_t)1024 * 512, it - 896, lds);
        else if (it < 1280) convert_tile(WB + (size_t)1024 * DM, DM, DM, 1024, BR + (size_t)2048 * 512, it - 1024, lds);
        else convert_tile(c.in(I_WOUT) + (size_t)c.l * DM * DM, DM, DM, DM, (bf16_t*)(c.ws + WS_WT_OUT), it - 1280, lds);
    }
}
constexpr int TS = 72;
constexpr int NSA_BIAS = 0;
constexpr int NSA_SELM = 2112;
constexpr int NSA_SCR = 2624;
constexpr int NSA_K0 = 4672;
constexpr int NSA_V0 = NSA_K0 + 2 * 64 * TS * 2;
constexpr int NSA_A = NSA_V0 + 2 * 64 * TS * 2;
constexpr int NSA_B = NSA_A + 16384;
constexpr int NSA_END = NSA_B + 16384;
static_assert(NSA_END <= LDS_BYTES - 16, "nsa lds");
static_assert(NSA_K0 % 16 == 0, "align");

struct NsaLane { int tq[2]; int h; float cbias; float m[2], l[2]; };

DI void nsa_prefetch(u32x4& rk, u32x4& rv, const bf16_t* kbase, int kstride, const bf16_t* vtbase, int vstride, int pos0, int tid) {
    const int r = tid >> 3, seg = (tid & 7) * 8;
    rk = *(const u32x4*)(kbase + (size_t)(pos0 + r) * kstride + seg);
    rv = *(const u32x4*)(vtbase + (size_t)r * vstride + pos0 + seg);
}
DI void nsa_store(unsigned char* lds, int buf, const u32x4& rk, const u32x4& rv, int tid) {
    const int r = tid >> 3, seg = (tid & 7) * 8;
    *(u32x4*)((bf16_t*)(lds + NSA_K0) + buf * 64 * TS + r * TS + seg) = rk;
    *(u32x4*)((bf16_t*)(lds + NSA_V0) + buf * 64 * TS + r * TS + seg) = rv;
}
DI void nsa_qk(f32x4 (&s)[2][4], const bf16_t* sK, const bf16x8 (&qf)[2][2], int lane) {
#pragma unroll
    for (int kt = 0; kt < 4; ++kt) {
#pragma unroll
        for (int ks = 0; ks < 2; ++ks) {
            const bf16x8 kf = *(const bf16x8*)(sK + (16 * kt + (lane & 15)) * TS + 32 * ks + (lane >> 4) * 8);
#pragma unroll
            for (int qi = 0; qi < 2; ++qi) s[qi][kt] = __builtin_amdgcn_mfma_f32_16x16x32_bf16(kf, qf[qi][ks], (ks == 0) ? (f32x4){0.f, 0.f, 0.f, 0.f} : s[qi][kt], 0, 0, 0);
        }
    }
}
template <int MODE>
DI void nsa_logits(float (&x)[4][4], const f32x4 (&s)[4], int tq, int h, float cbias, bool rowsel, int pos0, int qd, const float* biasT) {
#pragma unroll
    for (int kt = 0; kt < 4; ++kt)
#pragma unroll
        for (int i = 0; i < 4; ++i) {
            const int kk = pos0 + 16 * kt + 4 * qd + i;
            if (MODE == 1) { x[kt][i] = rowsel ? s[kt][i] + cbias : -INFINITY; }
            else {
                const int dist = (MODE == 0) ? (tq - 16 * kk - 31) : (tq - kk);
                bool ok = dist >= 0;
                if (MODE == 2) ok = ok && rowsel;
                if (MODE == 3) ok = ok && (dist < 512);
                const int di = dist < 0 ? 0 : (dist > 128 ? 128 : dist);
                const float bias = biasT[di * 4 + h];
                x[kt][i] = ok ? s[kt][i] + bias : -INFINITY;
            }
        }
}
DI float quad16_max(float v) { v = fmaxf(v, __shfl_xor(v, 16)); v = fmaxf(v, __shfl_xor(v, 32)); return v; }
DI float quad16_sum(float v) { v += __shfl_xor(v, 16); v += __shfl_xor(v, 32); return v; }
DI void nsa_softmax(const float (&x)[4][4], float& m, float& l, f32x4 (&O)[4], bf16x8 (&pf)[2]) {
    float mx = -INFINITY;
#pragma unroll
    for (int kt = 0; kt < 4; ++kt)
#pragma unroll
        for (int i = 0; i < 4; ++i) mx = fmaxf(mx, x[kt][i]);
    mx = quad16_max(mx);
    const float mn = fmaxf(m, mx);
    const float mu = (mn == -INFINITY) ? 0.f : mn;
    const float sc = __expf(m - mu);
    float p[4][4]; float ps = 0.f;
#pragma unroll
    for (int kt = 0; kt < 4; ++kt)
#pragma unroll
        for (int i = 0; i < 4; ++i) { p[kt][i] = __expf(x[kt][i] - mu); ps += p[kt][i]; }
    l = l * sc + ps; m = mn;
#pragma unroll
    for (int dt = 0; dt < 4; ++dt) O[dt] = O[dt] * sc;
#pragma unroll
    for (int ks = 0; ks < 2; ++ks) {
        u32x4 w; w.x = pack2(p[2 * ks][0], p[2 * ks][1]); w.y = pack2(p[2 * ks][2], p[2 * ks][3]); w.z = pack2(p[2 * ks + 1][0], p[2 * ks + 1][1]); w.w = pack2(p[2 * ks + 1][2], p[2 * ks + 1][3]);
        pf[ks] = __builtin_bit_cast(bf16x8, w);
    }
}
DI void nsa_pv(f32x4 (&O)[2][4], const bf16_t* sV, const bf16x8 (&pf)[2][2], int lane) {
    const int qd = lane >> 4;
#pragma unroll
    for (int dt = 0; dt < 4; ++dt)
#pragma unroll
        for (int ks = 0; ks < 2; ++ks) {
            const bf16_t* vp = sV + (16 * dt + (lane & 15)) * TS + 32 * ks + 4 * qd;
            const u32x2 a = *(const u32x2*)vp, b = *(const u32x2*)(vp + 16);
            u32x4 w; w.x = a.x; w.y = a.y; w.z = b.x; w.w = b.y;
            const bf16x8 vf = __builtin_bit_cast(bf16x8, w);
#pragma unroll
            for (int qi = 0; qi < 2; ++qi) O[qi][dt] = __builtin_amdgcn_mfma_f32_16x16x32_bf16(vf, pf[qi][ks], O[qi][dt], 0, 0, 0);
        }
}
template <int MODE>
DI void nsa_tile(f32x4 (&O)[2][4], NsaLane& L, const bf16x8 (&qf)[2][2], const unsigned char* lds, int buf, int pos0, bool sel0, bool sel1, int lane) {
    const bf16_t* sK = (const bf16_t*)(lds + NSA_K0) + buf * 64 * TS;
    const bf16_t* sV = (const bf16_t*)(lds + NSA_V0) + buf * 64 * TS;
    const float* biasT = (const float*)(lds + NSA_BIAS);
    f32x4 s[2][4];
    nsa_qk(s, sK, qf, lane);
    bf16x8 pf[2][2];
#pragma unroll
    for (int qi = 0; qi < 2; ++qi) {
        float x[4][4];
        nsa_logits<MODE>(x, s[qi], L.tq[qi], L.h, L.cbias, qi ? sel1 : sel0, pos0, lane >> 4, biasT);
        nsa_softmax(x, L.m[qi], L.l[qi], O[qi], pf[qi]);
    }
    nsa_pv(O, sV, pf, lane);
}
DI void nsa_flush(f32x4 (&Y)[2][4], f32x4 (&O)[2][4], NsaLane& L, const float (&gate)[2]) {
#pragma unroll
    for (int qi = 0; qi < 2; ++qi) {
        const float lt = quad16_sum(L.l[qi]);
        const float f = (lt > 0.f) ? gate[qi] / lt : 0.f;
#pragma unroll
        for (int dt = 0; dt < 4; ++dt) { Y[qi][dt] += O[qi][dt] * f; O[qi][dt] = (f32x4){0.f, 0.f, 0.f, 0.f}; }
    }
}
DI void nsa_item(const Ctx& c, int item, unsigned char* lds) {
    const int tid = TID(), lane = tid & 63, wave = tid >> 6, qd = lane >> 4;
    const int b = item >> 8, g = (item >> 6) & 3, qt = item & 63, t0 = qt * 64, cur = qt, bg = b * 4 + g;
    float* biasT = (float*)(lds + NSA_BIAS);
    unsigned long long* selm = (unsigned long long*)(lds + NSA_SELM);
    float* scr = (float*)(lds + NSA_SCR) + wave * 64;
    float* impA = (float*)(lds + NSA_A); float* impB = (float*)(lds + NSA_B);
    __syncthreads();
    for (int i = tid; i < 129 * 4; i += NTHREADS) { const int d = i >> 2, h = i & 3; biasT[i] = c.in(I_RELB)[t5_bucket(d) * 16 + g * 4 + h]; }
    for (int i = tid; i < 2 * 4096; i += NTHREADS) impA[i] = 0.f;
    NsaLane L; L.h = lane & 3;
    bf16x8 qf[2][2]; float gates[2][3];
    const bf16_t* pbat = c.PROJ + (size_t)b * SEQ * IN_COLS;
#pragma unroll
    for (int qi = 0; qi < 2; ++qi) {
        const int tl = 8 * wave + 4 * qi + ((lane & 15) >> 2);
        L.tq[qi] = t0 + tl;
        const bf16_t* prow = pbat + (size_t)L.tq[qi] * IN_COLS;
#pragma unroll
        for (int ks = 0; ks < 2; ++ks) {
            u32x4 w = *(const u32x4*)(prow + C_Q + (g * 4 + L.h) * 64 + 32 * ks + qd * 8);
            w.x = pack2(bflo(w.x) * 0.125f, bfhi(w.x) * 0.125f); w.y = pack2(bflo(w.y) * 0.125f, bfhi(w.y) * 0.125f);
            w.z = pack2(bflo(w.z) * 0.125f, bfhi(w.z) * 0.125f); w.w = pack2(bflo(w.w) * 0.125f, bfhi(w.w) * 0.125f);
            qf[qi][ks] = __builtin_bit_cast(bf16x8, w);
        }
#pragma unroll
        for (int br = 0; br < 3; ++br) gates[qi][br] = sigmoidf_(bf2f(prow[C_GATE + g * 12 + L.h * 3 + br]));
    }
    __syncthreads();
    L.cbias = biasT[128 * 4 + L.h];
    f32x4 O[2][4], Y[2][4];
#pragma unroll
    for (int qi = 0; qi < 2; ++qi)
#pragma unroll
        for (int dt = 0; dt < 4; ++dt) { O[qi][dt] = (f32x4){0.f, 0.f, 0.f, 0.f}; Y[qi][dt] = (f32x4){0.f, 0.f, 0.f, 0.f}; }
    u32x4 rk, rv;
    const int nvis_max = (t0 + 63 >= 31) ? ((t0 + 63 - 31) >> 4) + 1 : 0;
    const int ncb = (nvis_max + 63) >> 6;
    const bf16_t* kcb = c.KC + (size_t)bg * 256 * 64; const bf16_t* vcb = c.VCT + (size_t)bg * 64 * 256;
    L.m[0] = L.m[1] = -INFINITY; L.l[0] = L.l[1] = 0.f;
    if (ncb > 0) nsa_prefetch(rk, rv, kcb, 64, vcb, 256, 0, tid);
    for (int cb = 0; cb < ncb; ++cb) {
        nsa_store(lds, cb & 1, rk, rv, tid);
        __syncthreads();
        if (cb + 1 < ncb) nsa_prefetch(rk, rv, kcb, 64, vcb, 256, (cb + 1) * 64, tid);
        nsa_tile<0>(O, L, qf, lds, cb & 1, cb * 64, true, true, lane);
    }
    float mfin[2], linv[2];
#pragma unroll
    for (int qi = 0; qi < 2; ++qi) { mfin[qi] = L.m[qi]; const float lt = quad16_sum(L.l[qi]); linv[qi] = (lt > 0.f) ? 1.0f / lt : 0.f; }
    { const float gg[2] = {gates[0][0], gates[1][0]}; nsa_flush(Y, O, L, gg); }
    __syncthreads();
    if (ncb > 0) nsa_prefetch(rk, rv, kcb, 64, vcb, 256, 0, tid);
    for (int cb = 0; cb < ncb; ++cb) {
        nsa_store(lds, cb & 1, rk, rv, tid);
        __syncthreads();
        if (cb + 1 < ncb) nsa_prefetch(rk, rv, kcb, 64, vcb, 256, (cb + 1) * 64, tid);
        const bf16_t* sK = (const bf16_t*)(lds + NSA_K0) + (cb & 1) * 64 * TS;
        f32x4 s[2][4];
        nsa_qk(s, sK, qf, lane);
#pragma unroll
        for (int qi = 0; qi < 2; ++qi) {
            float x[4][4];
            nsa_logits<0>(x, s[qi], L.tq[qi], L.h, L.cbias, true, cb * 64, qd, biasT);
            const float mu = (mfin[qi] == -INFINITY) ? 0.f : mfin[qi];
#pragma unroll
            for (int kt = 0; kt < 4; ++kt) {
                float p3 = __expf(x[kt][3] - mu) * linv[qi];
                float pa = (__expf(x[kt][0] - mu) + __expf(x[kt][1] - mu) + __expf(x[kt][2] - mu)) * linv[qi] + p3;
                pa += __shfl_xor(pa, 1); p3 += __shfl_xor(p3, 1);
                pa += __shfl_xor(pa, 2); p3 += __shfl_xor(p3, 2);
                if (L.h == 0) { const int tl = 8 * wave + 4 * qi + ((lane & 15) >> 2), mi = 16 * cb + 4 * kt + qd; impA[tl * 64 + mi] = pa; impB[tl * 64 + mi] = p3; }
            }
        }
    }
    __syncthreads();
    for (int tl8 = 0; tl8 < 8; ++tl8) {
        const int tl = 8 * wave + tl8, n = lane;
        const bool cand = (n >= 1) && (n <= cur - 2);
        const float imp = cand ? impA[tl * 64 + n] + impB[tl * 64 + n - 1] : -1.0f;
        LDS_WAVE_SYNC();
        scr[n] = imp;
        LDS_WAVE_SYNC();
        int rank = 0;
#pragma unroll 4
        for (int q4 = 0; q4 < 16; ++q4) {
            const f32x4 o = *(const f32x4*)(scr + q4 * 4);
#pragma unroll
            for (int j = 0; j < 4; ++j) { const int n2 = q4 * 4 + j; rank += (o[j] > imp || (o[j] == imp && n2 < n)) ? 1 : 0; }
        }
        const bool forced = (n <= cur) && (n == 0 || n == cur || n == cur - 1);
        const unsigned long long msk = __ballot((cand && rank < 5) || forced);
        if (lane == 0) selm[tl] = msk;
    }
    __syncthreads();
    unsigned long long uni = selm[lane];
#pragma unroll
    for (int o = 32; o >= 1; o >>= 1) { const unsigned lo_ = __shfl_xor((unsigned)uni, o), hi_ = __shfl_xor((unsigned)(uni >> 32), o); uni |= ((unsigned long long)hi_ << 32) | lo_; }
    uni = ((unsigned long long)__builtin_amdgcn_readfirstlane((unsigned)(uni >> 32)) << 32) | (unsigned)__builtin_amdgcn_readfirstlane((unsigned)uni);
    unsigned long long sm[2];
#pragma unroll
    for (int qi = 0; qi < 2; ++qi) sm[qi] = selm[8 * wave + 4 * qi + ((lane & 15) >> 2)];
    const bf16_t* ksb = pbat + C_KS + g * 64; const bf16_t* vsb = c.VT + ((size_t)0 * 16 + bg) * 64 * SEQ;
    L.m[0] = L.m[1] = -INFINITY; L.l[0] = L.l[1] = 0.f;
    {
        unsigned long long rem = uni; int it = 0;
        int j = (int)__builtin_ctzll(rem); rem &= rem - 1;
        nsa_prefetch(rk, rv, ksb, IN_COLS, vsb, SEQ, j * 64, tid);
        for (;;) {
            nsa_store(lds, it & 1, rk, rv, tid);
            __syncthreads();
            const int jn = rem ? (int)__builtin_ctzll(rem) : -1;
            if (jn >= 0) { rem &= rem - 1; nsa_prefetch(rk, rv, ksb, IN_COLS, vsb, SEQ, jn * 64, tid); }
            const bool s0 = (sm[0] >> j) & 1ull, s1 = (sm[1] >> j) & 1ull;
            if (j <= cur - 3) nsa_tile<1>(O, L, qf, lds, it & 1, j * 64, s0, s1, lane);
            else nsa_tile<2>(O, L, qf, lds, it & 1, j * 64, s0, s1, lane);
            if (jn < 0) break;
            j = jn; ++it;
        }
    }
    { const float gg[2] = {gates[0][1], gates[1][1]}; nsa_flush(Y, O, L, gg); }
    const bf16_t* kwb = pbat + C_KW + g * 64; const bf16_t* vwb = c.VT + ((size_t)1 * 16 + bg) * 64 * SEQ;
    L.m[0] = L.m[1] = -INFINITY; L.l[0] = L.l[1] = 0.f;
    {
        const int j0 = (cur - 8 > 0) ? cur - 8 : 0;
        __syncthreads();
        nsa_prefetch(rk, rv, kwb, IN_COLS, vwb, SEQ, j0 * 64, tid);
        for (int j = j0; j <= cur; ++j) {
            nsa_store(lds, (j - j0) & 1, rk, rv, tid);
            __syncthreads();
            if (j + 1 <= cur) nsa_prefetch(rk, rv, kwb, IN_COLS, vwb, SEQ, (j + 1) * 64, tid);
            nsa_tile<3>(O, L, qf, lds, (j - j0) & 1, j * 64, true, true, lane);
        }
    }
    { const float gg[2] = {gates[0][2], gates[1][2]}; nsa_flush(Y, O, L, gg); }
#pragma unroll
    for (int qi = 0; qi < 2; ++qi) {
        bf16_t* yrow = c.PROJ + ((size_t)b * SEQ + L.tq[qi]) * IN_COLS + C_Q + (g * 4 + L.h) * 64;
#pragma unroll
        for (int dt = 0; dt < 4; ++dt) store_bf4(yrow + 16 * dt + 4 * qd, Y[qi][dt]);
    }
}
DI void phase_mix(const Ctx& c, unsigned char* lds) {
    const int G = gridDim.x, bid = blockIdx.x;
    const int n_nsa = NB * 4 * (SEQ / 64), n_scan = NB * 8 * 4;
    const bool split = G >= 2 * n_scan;
    if (split) { if (bid < n_scan) scan_item(c, bid, lds); }
    else for (int item = bid; item < n_scan; item += G) scan_item(c, item, lds);
    unsigned* ctr = c.ctl + CW_Q + c.l;
    volatile int* sitem = (volatile int*)(lds + LDS_BYTES - 32);
    for (;;) {
        __syncthreads();
        if (TID() == 0) *sitem = (int)atomicAdd(ctr, 1u);
        __syncthreads();
        const int k = *sitem;
        if (k >= n_nsa) break;
        const int qt = 63 - (k >> 4), bgi = k & 15;
        nsa_item(c, (bgi << 6) | qt, lds);
    }
}

DI void phase_merge(const Ctx& c, unsigned char* lds) {
    const int nM = NT / 256, nN = DM / 128;
    const bf16_t* WM = (const bf16_t*)(c.ws + WS_WT_MG);
    const bf16_t* BR = (const bf16_t*)(c.ws + WS_WT_BR);
    const float* BM_ = c.in(I_BMG) + (size_t)c.l * 3 * DM;
    bf16_t* TMP = c.YRAW + (size_t)blockIdx.x * 256 * 128;
    for (int tile = blockIdx.x; tile < nM * nN; tile += gridDim.x) {
        const int tm = tile % nM, tn = tile / nM, m0 = tm * 256, n0 = tn * 128;
#pragma unroll 1
        for (int i = 0; i < 3; ++i) {
            {
                f32x4 ag[4][4]; acc_zero(ag);
                const ARows ar = plain_rows(c.H, DM, m0, TID());
                gemm_core<0>(ag, ar, WM + (size_t)(i * DM + n0) * DM, DM, DM, lds);
                ACC_FOREACH(ag, { const f32x4 bb = *(const f32x4*)(BM_ + i * DM + n0 + c_);
                    store_bf4(TMP + r_ * 128 + c_, (f32x4){sigmoidf_(v_[0] + bb[0]), sigmoidf_(v_[1] + bb[1]), sigmoidf_(v_[2] + bb[2]), sigmoidf_(v_[3] + bb[3])}); });
            }
            f32x4 ab[4][4]; acc_zero(ab);
            if (i == 0) { const ARows ar = plain_rows(c.POOLED, 512, m0, TID()); gemm_core<0>(ab, ar, BR + (size_t)n0 * 512, 512, 512, lds); }
            else if (i == 1) { const ARows ar = plain_rows(c.F + (size_t)5 * NT * 512, 512, m0, TID()); gemm_core<0>(ab, ar, BR + (size_t)1024 * 512 + (size_t)n0 * 512, 512, 512, lds); }
            else { const ARows ar = plain_rows(c.PROJ + C_Q, IN_COLS, m0, TID()); gemm_core<0>(ab, ar, BR + (size_t)2048 * 512 + (size_t)n0 * 1024, 1024, 1024, lds); }
            ACC_FOREACH(ab, {
                bf16_t* q = c.MERGED + (size_t)(m0 + r_) * DM + n0 + c_;
                const u32x2 gv = *(const u32x2*)(TMP + r_ * 128 + c_);
                f32x4 m4 = ((f32x4){0.f, 0.f, 0.f, 0.f});
                if (i > 0) { const u32x2 pv = *(const u32x2*)q; m4 = ((f32x4){bflo(pv.x), bfhi(pv.x), bflo(pv.y), bfhi(pv.y)}); }
                m4[0] += bflo(gv.x) * v_[0]; m4[1] += bfhi(gv.x) * v_[1]; m4[2] += bflo(gv.y) * v_[2]; m4[3] += bfhi(gv.y) * v_[3];
                store_bf4(q, m4); });
        }
    }
}

DI void phase_outp(const Ctx& c, unsigned char* lds) {
    const int nM = NT / 256, nN = DM / 128;
    const bf16_t* W = (const bf16_t*)(c.ws + WS_WT_OUT);
    const float* xin = (c.l == 0) ? c.in(I_X) : c.out;
    for (int tile = blockIdx.x; tile < nM * nN; tile += gridDim.x) {
        const int tm = tile % nM, tn = tile / nM, m0 = tm * 256, n0 = tn * 128;
        f32x4 acc[4][4]; acc_zero(acc);
        const ARows ar = plain_rows(c.MERGED, DM, m0, TID());
        gemm_core<0>(acc, ar, W + (size_t)n0 * DM, DM, DM, lds);
        ACC_FOREACH(acc, { const size_t o = (size_t)(m0 + r_) * DM + n0 + c_; const f32x4 x = *(const f32x4*)(xin + o); *(f32x4*)(c.out + o) = x + v_; });
    }
    for (int it = blockIdx.x; it < 3 * 32 * 64; it += gridDim.x) {
        const int mat = it / 2048, e = (it >> 6) & 31, tl = it & 63;
        if (mat == 0) convert_tile(c.in(I_EG) + ((size_t)c.l * 32 + e) * DM * 256, 256, 256, DM, (bf16_t*)(c.ws + WS_EG) + (size_t)e * 256 * DM, tl, lds);
        else if (mat == 1) convert_tile(c.in(I_EU) + ((size_t)c.l * 32 + e) * DM * 256, 256, 256, DM, (bf16_t*)(c.ws + WS_EU) + (size_t)e * 256 * DM, tl, lds);
        else convert_tile(c.in(I_ED) + ((size_t)c.l * 32 + e) * 256 * DM, DM, DM, 256, (bf16_t*)(c.ws + WS_ED) + (size_t)e * DM * 256, tl, lds);
    }
}

DI void phase_norm2(const Ctx& c) {
    const int tid = TID(), lane = tid & 63, wave = tid >> 6;
    const float* gain = c.in(I_NFFN) + c.l * DM;
    const float* wrg = c.in(I_WRG) + (size_t)c.l * DM * 4; const float* brg = c.in(I_BRG) + c.l * 4;
    const float* wre = c.in(I_WRE) + (size_t)c.l * DM * 32; const float* bre = c.in(I_BRE) + c.l * 32;
    unsigned* cnt = c.ctl + CW_CNT + c.l * 32;
    for (int row = blockIdx.x * 8 + wave; row < NT; row += gridDim.x * 8) {
        f32x4 v[4];
        float ss = 0.f;
#pragma unroll
        for (int i = 0; i < 4; ++i) { v[i] = *(const f32x4*)(c.out + (size_t)row * DM + i * 256 + lane * 4); ss += v[i][0] * v[i][0] + v[i][1] * v[i][1] + v[i][2] * v[i][2] + v[i][3] * v[i][3]; }
        ss = wave_sum(ss);
        const float rs = rsqrtf(ss * (1.0f / DM) + 1e-6f);
#pragma unroll
        for (int i = 0; i < 4; ++i) {
            const f32x4 g = *(const f32x4*)(gain + i * 256 + lane * 4);
            v[i] = (f32x4){v[i][0] * rs * g[0], v[i][1] * rs * g[1], v[i][2] * rs * g[2], v[i][3] * rs * g[3]};
            store_bf4(c.H + (size_t)row * DM + i * 256 + lane * 4, v[i]);
        }
        float lgp[4] = {0.f, 0.f, 0.f, 0.f};
#pragma unroll
        for (int i = 0; i < 4; ++i)
#pragma unroll
            for (int j = 0; j < 4; ++j) { const f32x4 w = *(const f32x4*)(wrg + (size_t)(i * 256 + lane * 4 + j) * 4); lgp[0] += v[i][j] * w[0]; lgp[1] += v[i][j] * w[1]; lgp[2] += v[i][j] * w[2]; lgp[3] += v[i][j] * w[3]; }
#pragma unroll
        for (int o = 0; o < 4; ++o) lgp[o] = wave_sum(lgp[o]) + brg[o];
        int grp = 0; float gm = lgp[0];
#pragma unroll
        for (int o = 1; o < 4; ++o) if (lgp[o] > gm) { gm = lgp[o]; grp = o; }
        float gs = 0.f;
#pragma unroll
        for (int o = 0; o < 4; ++o) gs += __expf(lgp[o] - gm);
        const float ptop = 1.0f / gs;
        float le[8] = {0.f, 0.f, 0.f, 0.f, 0.f, 0.f, 0.f, 0.f};
#pragma unroll
        for (int i = 0; i < 4; ++i)
#pragma unroll
            for (int j = 0; j < 4; ++j) {
                const float* wp = wre + (size_t)(i * 256 + lane * 4 + j) * 32 + grp * 8;
                const f32x4 w0 = *(const f32x4*)wp, w1 = *(const f32x4*)(wp + 4);
                le[0] += v[i][j] * w0[0]; le[1] += v[i][j] * w0[1]; le[2] += v[i][j] * w0[2]; le[3] += v[i][j] * w0[3];
                le[4] += v[i][j] * w1[0]; le[5] += v[i][j] * w1[1]; le[6] += v[i][j] * w1[2]; le[7] += v[i][j] * w1[3];
            }
#pragma unroll
        for (int o = 0; o < 8; ++o) le[o] = wave_sum(le[o]) + bre[grp * 8 + o];
        int i0 = 0; float v0 = le[0];
#pragma unroll
        for (int o = 1; o < 8; ++o) if (le[o] > v0) { v0 = le[o]; i0 = o; }
        int i1 = -1; float v1 = -INFINITY;
#pragma unroll
        for (int o = 0; o < 8; ++o) if (o != i0 && le[o] > v1) { v1 = le[o]; i1 = o; }
        const float e1 = __expf(v1 - v0), inv = 1.0f / (1.0f + e1);
        if (lane == 0) {
            int* rt = c.ROUTE + (size_t)row * 8;
            const int ex0 = grp * 8 + i0, ex1 = grp * 8 + i1;
            rt[0] = ex0; rt[1] = ex1; ((float*)rt)[2] = inv * ptop; ((float*)rt)[3] = e1 * inv * ptop;
            atomicAdd(cnt + ex0, 1u); atomicAdd(cnt + ex1, 1u);
        }
    }
}
DI void phase_route2(const Ctx& c, unsigned char* lds) {
    int* soff = (int*)lds;
    const unsigned* cnt = c.ctl + CW_CNT + c.l * 32;
    unsigned* cur = c.ctl + CW_CUR + c.l * 32;
    __syncthreads();
    if (TID() == 0) { int s = 0; for (int e = 0; e < 32; ++e) { soff[e] = s; s += (int)cnt[e]; } }
    __syncthreads();
    for (int t = blockIdx.x * NTHREADS + TID(); t < NT; t += gridDim.x * NTHREADS) {
        int* rt = c.ROUTE + (size_t)t * 8;
#pragma unroll
        for (int s = 0; s < 2; ++s) {
            const int e = rt[s];
            const int p = soff[e] + (int)atomicAdd(cur + e, 1u);
            rt[4 + s] = p;
            c.ENT[2 * p] = t; ((float*)c.ENT)[2 * p + 1] = ((const float*)rt)[2 + s];
        }
    }
}
DI void moe_tables(const Ctx& c, int* soff, int* stile, int ncol) {
    const unsigned* cnt = c.ctl + CW_CNT + c.l * 32;
    __syncthreads();
    if (TID() == 0) { int s = 0, tt = 0; for (int e = 0; e < 32; ++e) { soff[e] = s; stile[e] = tt; s += (int)cnt[e]; tt += (((int)cnt[e] + 255) >> 8) * ncol; } soff[32] = s; stile[32] = tt; }
    __syncthreads();
}
DI void phase_moe_up(const Ctx& c, unsigned char* lds) {
    int* soff = (int*)(lds + 2 * G_STAGE); int* stile = soff + 64;
    moe_tables(c, soff, stile, 2);
    const int total = stile[32];
    for (int item = blockIdx.x; item < total; item += gridDim.x) {
        int e = 0;
        for (int q = 1; q < 32; ++q) if (stile[q] <= item) e = q;
        const int loc = item - stile[e], tm = loc >> 1, tn = loc & 1, n0 = tn * 128;
        const int p0 = soff[e] + tm * 256, pend = soff[e + 1];
        ARows ar;
#pragma unroll
        for (int i = 0; i < 4; ++i) { const int pr = p0 + (TID() >> 3) + 64 * i; ar.p[i] = (pr < pend) ? c.H + (size_t)c.ENT[2 * pr] * DM : nullptr; }
        {
            f32x4 ag[4][4]; acc_zero(ag);
            gemm_core<0>(ag, ar, (const bf16_t*)(c.ws + WS_EG) + ((size_t)e * 256 + n0) * DM, DM, DM, lds);
            ACC_FOREACH(ag, { if (p0 + r_ < pend) store_bf4(c.HID + (size_t)(p0 + r_) * 256 + n0 + c_, (f32x4){v_[0] * sigmoidf_(v_[0]), v_[1] * sigmoidf_(v_[1]), v_[2] * sigmoidf_(v_[2]), v_[3] * sigmoidf_(v_[3])}); });
        }
        f32x4 au[4][4]; acc_zero(au);
        gemm_core<0>(au, ar, (const bf16_t*)(c.ws + WS_EU) + ((size_t)e * 256 + n0) * DM, DM, DM, lds);
        ACC_FOREACH(au, { if (p0 + r_ < pend) { bf16_t* q = c.HID + (size_t)(p0 + r_) * 256 + n0 + c_; const u32x2 sv = *(const u32x2*)q;
            store_bf4(q, (f32x4){bflo(sv.x) * v_[0], bfhi(sv.x) * v_[1], bflo(sv.y) * v_[2], bfhi(sv.y) * v_[3]}); } });
    }
}
DI void phase_moe_down(const Ctx& c, unsigned char* lds) {
    int* soff = (int*)(lds + 2 * G_STAGE); int* stile = soff + 64;
    moe_tables(c, soff, stile, 8);
    const int total = stile[32];
    for (int item = blockIdx.x; item < total; item += gridDim.x) {
        int e = 0;
        for (int q = 1; q < 32; ++q) if (stile[q] <= item) e = q;
        const int loc = item - stile[e], tm = loc >> 3, tn = loc & 7, n0 = tn * 128;
        const int p0 = soff[e] + tm * 256, pend = soff[e + 1];
        ARows ar;
#pragma unroll
        for (int i = 0; i < 4; ++i) { const int pr = p0 + (TID() >> 3) + 64 * i; ar.p[i] = (pr < pend) ? c.HID + (size_t)pr * 256 : nullptr; }
        f32x4 acc[4][4]; acc_zero(acc);
        gemm_core<0>(acc, ar, (const bf16_t*)(c.ws + WS_ED) + ((size_t)e * DM + n0) * 256, 256, 256, lds);
        ACC_FOREACH(acc, { if (p0 + r_ < pend) { const float w = ((const float*)c.ENT)[2 * (p0 + r_) + 1];
            store_bf4(c.Y + (size_t)(p0 + r_) * DM + n0 + c_, (f32x4){v_[0] * w, v_[1] * w, v_[2] * w, v_[3] * w}); } });
    }
}
DI void phase_final(const Ctx& c) {
    const int tid = TID(), lane = tid & 63, wave = tid >> 6;
    const float* gain = c.in(I_NFIN);
    for (int row = blockIdx.x * 8 + wave; row < NT; row += gridDim.x * 8) {
        f32x4 v[4];
#pragma unroll
        for (int i = 0; i < 4; ++i) v[i] = *(const f32x4*)(c.out + (size_t)row * DM + i * 256 + lane * 4);
        add_moe_rows(c, row, lane, v);
        float ss = 0.f;
#pragma unroll
        for (int i = 0; i < 4; ++i) ss += v[i][0] * v[i][0] + v[i][1] * v[i][1] + v[i][2] * v[i][2] + v[i][3] * v[i][3];
        ss = wave_sum(ss);
        const float rs = rsqrtf(ss * (1.0f / DM) + 1e-6f);
#pragma unroll
        for (int i = 0; i < 4; ++i) {
            const f32x4 g = *(const f32x4*)(gain + i * 256 + lane * 4);
            *(f32x4*)(c.out + (size_t)row * DM + i * 256 + lane * 4) = (f32x4){v[i][0] * rs * g[0], v[i][1] * rs * g[1], v[i][2] * rs * g[2], v[i][3] * rs * g[3]};
        }
    }
}

constexpr int PH_PER_LAYER = 12, N_PHASES = DEPTH * PH_PER_LAYER + 1;
__global__ void __launch_bounds__(NTHREADS, 2) fwd_kernel(Params P) {
    extern __shared__ __attribute__((aligned(16))) unsigned char lds[];
    const int lo = P.ph_lo, hi = P.ph_hi;
    LAS unsigned* xbw = (LAS unsigned*)(lds + LDS_BYTES - 16);
    if (threadIdx.x == 0) { xbw[0] = 0u; xbw[1] = 0u; xbw[2] = 0u; xbw[3] = 0u; }
    __syncthreads();
    Ctx c; c.P = &P; c.ws = P.ws; c.out = P.out; c.l = 0;
    c.ctl = (unsigned*)(P.ws + WS_CTL);
    c.H = (bf16_t*)(P.ws + WS_H); c.PROJ = (bf16_t*)(P.ws + WS_PROJ); c.F = (bf16_t*)(P.ws + WS_F); c.POOLED = (bf16_t*)(P.ws + WS_POOLED);
    c.MERGED = (bf16_t*)(P.ws + WS_F); c.CMPH = (bf16_t*)(P.ws + WS_CMPH); c.CMPO = (float*)(P.ws + WS_CMPO); c.POSB = (float*)(P.ws + WS_POSB);
    c.ROUTE = (int*)(P.ws + WS_ROUTE); c.ENT = (int*)(P.ws + WS_ENT); c.HID = (bf16_t*)(P.ws + WS_HID); c.Y = (bf16_t*)(P.ws + WS_Y);
    c.VT = (bf16_t*)(P.ws + WS_VT); c.KC = (bf16_t*)(P.ws + WS_KC); c.VCT = (bf16_t*)(P.ws + WS_VCT); c.YRAW = (bf16_t*)(P.ws + WS_YRAW); c.BON = (float*)(P.ws + WS_BON);
    XcdBarrier bar; bar.bar = c.ctl + CW_BAR; bar.x = 0; bar.st = (volatile LAS unsigned*)xbw;
    if (hi - lo > 1) bar = xcd_barrier_post(c.ctl + CW_BAR, (volatile LAS unsigned*)xbw);
#define IN(k) (lo <= (k) && (k) < hi)
#define SEAM(k) do { if (IN(k) && IN((k) + 1)) xcd_barrier(bar); } while (0)
#pragma unroll 1
    for (int l = 0; l < DEPTH; ++l) {
        c.l = l; const int pb = l * PH_PER_LAYER;
        if (IN(pb + 0)) phase_norm1(c, lds);
        SEAM(pb + 0);
        if (IN(pb + 1)) phase_gemm1(c, lds);
        SEAM(pb + 1);
        if (IN(pb + 2)) phase_prep(c, lds);
        SEAM(pb + 2);
        if (IN(pb + 3)) phase_poolgemm(c, lds);
        SEAM(pb + 3);
        if (IN(pb + 4)) phase_mix(c, lds);
        SEAM(pb + 4);
        if (IN(pb + 5)) phase_rwkv_post(c, lds);
        SEAM(pb + 5);
        if (IN(pb + 6)) phase_merge(c, lds);
        SEAM(pb + 6);
        if (IN(pb + 7)) phase_outp(c, lds);
        SEAM(pb + 7);
        if (IN(pb + 8)) phase_norm2(c);
        SEAM(pb + 8);
        if (IN(pb + 9)) phase_route2(c, lds);
        SEAM(pb + 9);
        if (IN(pb + 10)) phase_moe_up(c, lds);
        SEAM(pb + 10);
        if (IN(pb + 11)) phase_moe_down(c, lds);
        SEAM(pb + 11);
    }
    if (IN(N_PHASES - 1)) phase_final(c);
}

#ifndef MK_N_LAUNCHES
#define MK_N_LAUNCHES 1
#endif
extern "C" void kernel_launch(void* const* d_in, const int* in_sizes, int n_in, void* d_out, int out_size, void* d_ws, size_t ws_size, hipStream_t stream) {
    static int grid = 0;
    if (grid == 0) {
        if (n_in != N_IN || out_size != NT * DM || ws_size < WS_END) { fprintf(stderr, "kernel_launch: unexpected shapes n_in %d out %d ws %zu (need %zu)\n", n_in, out_size, ws_size, (size_t)WS_END); grid = -1; return; }
        int dev = 0, cus = 0, per_cu = 0;
        if (hipGetDevice(&dev) != hipSuccess || hipDeviceGetAttribute(&cus, hipDeviceAttributeMultiprocessorCount, dev) != hipSuccess) { grid = -1; return; }
        if (hipFuncSetAttribute((const void*)fwd_kernel, hipFuncAttributeMaxDynamicSharedMemorySize, LDS_BYTES) != hipSuccess) { fprintf(stderr, "kernel_launch: hipFuncSetAttribute failed\n"); grid = -1; return; }
        if (hipOccupancyMaxActiveBlocksPerMultiprocessor(&per_cu, (const void*)fwd_kernel, NTHREADS, LDS_BYTES) != hipSuccess || per_cu < 1) { fprintf(stderr, "kernel_launch: occupancy query says %d\n", per_cu); }
        (void)hipGetLastError();
        grid = cus;
    }
    if (grid < 0) return;
    if (hipMemsetAsync((char*)d_ws + WS_CTL, 0, CTL_BYTES, stream) != hipSuccess) return;
    Params p{};
    for (int i = 0; i < N_IN; ++i) p.in[i] = (const float*)d_in[i];
    p.out = (float*)d_out; p.ws = (unsigned char*)d_ws;
    if (MK_N_LAUNCHES == 1) {
        p.ph_lo = 0; p.ph_hi = N_PHASES;
        hipLaunchKernelGGL(fwd_kernel, dim3(grid), dim3(NTHREADS), LDS_BYTES, stream, p);
    } else {
        for (int k = 0; k < N_PHASES; ++k) { p.ph_lo = k; p.ph_hi = k + 1; hipLaunchKernelGGL(fwd_kernel, dim3(grid), dim3(NTHREADS), LDS_BYTES, stream, p); }
    }
}
```

```cpp
#include <hip/hip_runtime.h>
#include <cstdio>
#include <cstdint>

#define DI __device__ __forceinline__
typedef unsigned short bf16_t;
typedef short bf16x8 __attribute__((ext_vector_type(8)));
typedef float f32x4 __attribute__((ext_vector_type(4)));
typedef unsigned u32x4 __attribute__((ext_vector_type(4)));
typedef unsigned u32x2 __attribute__((ext_vector_type(2)));

constexpr int NB = 4, SEQ = 4096, DM = 1024, NT = NB * SEQ, DEPTH = 2;
constexpr int IN_COLS = 4816;
constexpr int C_POOL = 0, C_RW = 512, C_R = 512, C_K = 1024, C_V = 1536, C_WD = 2048, C_AD = 2080, C_GD = 2112;
constexpr int C_Q = 2208, C_KC = 3232, C_VC = 3488, C_KS = 3744, C_VS = 4000, C_KW = 4256, C_VW = 4512, C_GATE = 4768;
constexpr int RWC = 1696;
constexpr int NCMP = 255;
constexpr int NTHREADS = 512;
constexpr int LDS_BYTES = 114688;

enum { I_X = 0, I_RELB, I_NMIX, I_WIN, I_POOLW, I_POOLS, I_MU, I_W0, I_WUP, I_A0, I_AUP, I_GUP, I_KK, I_KA, I_RK, I_GNW, I_GNB,
       I_CPK, I_CW1K, I_CW2K, I_CPV, I_CW1V, I_CW2V, I_WBR, I_WMG, I_BMG, I_WOUT, I_NFFN, I_WRG, I_BRG, I_WRE, I_BRE, I_EG, I_EU, I_ED, I_NFIN, N_IN };

constexpr size_t WS_CTL = 0;
constexpr size_t CTL_BYTES = 65536;
constexpr size_t WS_H = CTL_BYTES;
constexpr size_t WS_PROJ = WS_H + (size_t)NT * DM * 2;
constexpr size_t WS_F = WS_PROJ + (size_t)NT * IN_COLS * 2;
constexpr size_t PLANE = (size_t)NT * 512 * 2;
constexpr size_t WS_POOLED = WS_F + 6 * PLANE;
constexpr size_t WS_CMPH = WS_POOLED + PLANE;
constexpr size_t WS_CMPO = WS_CMPH + (size_t)2 * 4096 * 256 * 2;
constexpr size_t WS_POSB = WS_CMPO + (size_t)2 * 4096 * 64 * 4;
constexpr size_t WS_ROUTE = WS_POSB + 4096;
constexpr size_t WS_ENT = WS_ROUTE + (size_t)NT * 32;
constexpr size_t WS_VT = WS_ENT + (size_t)2 * NT * 8;
constexpr size_t WS_KC = WS_VT + (size_t)2 * 16 * 64 * SEQ * 2;
constexpr size_t WS_VCT = WS_KC + (size_t)16 * 256 * 64 * 2;
constexpr size_t WS_YRAW = WS_VCT + (size_t)16 * 64 * 256 * 2;
constexpr size_t WS_BON = WS_YRAW + (size_t)NT * 512 * 2;
constexpr size_t WS_SMALLW = WS_BON + (size_t)NT * 8 * 4;
constexpr size_t WS_END = WS_SMALLW + 262144;
constexpr size_t WS_WT_IN = WS_F;
constexpr size_t WS_WT_C1 = WS_CMPO;
constexpr size_t WS_WT_C2 = WS_SMALLW;
constexpr size_t WS_WT_POOL = WS_SMALLW + 131072;
constexpr size_t WS_WT_MG = WS_VT;
constexpr size_t WS_WT_BR = WS_VT + (size_t)3072 * 1024 * 2;
constexpr size_t WS_WT_OUT = WS_CMPH;
constexpr size_t WS_EG = WS_F + 2 * PLANE;
constexpr size_t WS_EU = WS_EG + (size_t)32 * 256 * 1024 * 2;
constexpr size_t WS_ED = WS_EU + (size_t)32 * 256 * 1024 * 2;
static_assert(WS_ED + (size_t)32 * 1024 * 256 * 2 <= WS_F + 6 * PLANE, "expert alias");
static_assert(WS_WT_BR + (size_t)2048 * 1024 * 2 <= WS_VT + (size_t)2 * 16 * 64 * SEQ * 2, "merge alias");
static_assert((size_t)4864 * 1024 * 2 <= 6 * PLANE, "w_in alias");
constexpr size_t WS_HID = WS_PROJ;
constexpr size_t WS_Y = WS_PROJ + (size_t)2 * NT * 256 * 2;
static_assert(WS_Y + (size_t)2 * NT * 1024 * 2 <= WS_F, "alias");
constexpr int CW_BAR = 0;
constexpr int CW_CNT = 4096;
constexpr int CW_CUR = 4096 + 64;
constexpr int CW_Q = 4096 + 128;

#define XB_TMO      128
#define XB_XCNT(j)  (256  + 64 * (j))
#define XB_XSUB(j)  (1280 + 64 * (j))
#define XB_XGEN(j)  (2304 + 64 * (j))
#define XB_TOP      3328
#define XB_TOPGEN   3392
#define XCD_BAR_WORDS 3456
#define XB_SPIN_CAP (1u << 18)
#define LAS __attribute__((address_space(3)))

__device__ __forceinline__ unsigned xb_ld(unsigned* p)              { return __hip_atomic_load(p, __ATOMIC_RELAXED, __HIP_MEMORY_SCOPE_AGENT); }
__device__ __forceinline__ unsigned xb_add(unsigned* p, unsigned v) { return __hip_atomic_fetch_add(p, v, __ATOMIC_RELAXED, __HIP_MEMORY_SCOPE_AGENT); }
__device__ __forceinline__ unsigned xb_xcc_id() { return (unsigned)__builtin_amdgcn_s_getreg((3 << 11) | 20) & 0xFu; }
#define XB_SPIN(cond, bar) do { unsigned _sp = 0; while (cond) { __builtin_amdgcn_s_sleep(1); \
    if ((++_sp & 255u) == 0u) { if (xb_ld(&(bar)[XB_TMO])) break; if (_sp > XB_SPIN_CAP) { atomicAdd(&(bar)[XB_TMO], 1u); break; } } } } while (0)

struct XcdBarrier { unsigned* bar; unsigned x; volatile LAS unsigned* st; };

__device__ __forceinline__ XcdBarrier xcd_barrier_post(unsigned* bar, volatile LAS unsigned* st) {
    XcdBarrier b; b.bar = bar; b.x = xb_xcc_id(); b.st = st;
    if (threadIdx.x == 0) (void)xb_add(&bar[XB_XCNT(b.x)], 1u);
    return b;
}
__device__ __forceinline__ void xcd_barrier_complete(unsigned* bar, unsigned x, unsigned& nloc, unsigned& nx) {
    const unsigned G = gridDim.x * gridDim.y * gridDim.z;
    unsigned sum, cnt, mine, sp = 0u;
    for (;;) {
        sum = 0u; cnt = 0u; mine = 0u;
#pragma unroll
        for (unsigned j = 0; j < 16; ++j) { const unsigned c = xb_ld(&bar[XB_XCNT(j)]); sum += c; cnt += (c > 0u) ? 1u : 0u; mine = (j == x) ? c : mine; }
        if (sum == G) break;
        __builtin_amdgcn_s_sleep(1);
        if ((++sp & 255u) == 0u) { if (xb_ld(&bar[XB_TMO])) break; if (sp > XB_SPIN_CAP) { atomicAdd(&bar[XB_TMO], 1u); break; } }
    }
    nloc = mine > 0u ? mine : 1u; nx = cnt > 0u ? cnt : 1u;
}
__device__ __forceinline__ void xcd_barrier(const XcdBarrier& b) {
    asm volatile("s_waitcnt vmcnt(0)" ::: "memory");
    __syncthreads();
    if (threadIdx.x == 0) {
        unsigned* bar = b.bar;
        __builtin_amdgcn_s_waitcnt(0);
        unsigned nloc = b.st[0], nx = b.st[1];
        if (nloc == 0u) { xcd_barrier_complete(bar, b.x, nloc, nx); b.st[0] = nloc; b.st[1] = nx; }
        const unsigned old = xb_add(&bar[XB_XSUB(b.x)], 1u);
        const unsigned gen = old / nloc;
        if (old + 1u == (gen + 1u) * nloc) {
            __builtin_amdgcn_fence(__ATOMIC_RELEASE, "agent");
            asm volatile("s_waitcnt vmcnt(0)" ::: "memory");
            const unsigned og = xb_add(&bar[XB_TOP], 1u);
            const unsigned tg = og / nx;
            if (og + 1u == (tg + 1u) * nx) xb_add(&bar[XB_TOPGEN], 1u);
            else XB_SPIN(xb_ld(&bar[XB_TOPGEN]) == tg, bar);
            __builtin_amdgcn_fence(__ATOMIC_ACQUIRE, "agent");
            xb_add(&bar[XB_XGEN(b.x)], 1u);
            asm volatile("s_waitcnt vmcnt(0)" ::: "memory");
        } else {
            XB_SPIN(xb_ld(&bar[XB_XGEN(b.x)]) == gen, bar);
            __builtin_amdgcn_fence(__ATOMIC_ACQUIRE, "agent");
            asm volatile("s_waitcnt vmcnt(0)" ::: "memory");
        }
    }
    __syncthreads();
}

DI bf16_t f2bf(float x) { unsigned u = __float_as_uint(x); u += 0x7fffu + ((u >> 16) & 1u); return (bf16_t)(u >> 16); }
DI float bf2f(bf16_t b) { return __uint_as_float((unsigned)b << 16); }
DI unsigned pack2(float lo, float hi) { unsigned r; asm("v_cvt_pk_bf16_f32 %0, %1, %2" : "=v"(r) : "v"(lo), "v"(hi)); return r; }
DI float bflo(unsigned w) { return __uint_as_float(w << 16); }
DI float bfhi(unsigned w) { return __uint_as_float(w & 0xffff0000u); }
DI float wave_sum(float v) {
#pragma unroll
    for (int o = 32; o >= 1; o >>= 1) v += __shfl_xor(v, o);
    return v;
}
DI float wave_max(float v) {
#pragma unroll
    for (int o = 32; o >= 1; o >>= 1) v = fmaxf(v, __shfl_xor(v, o));
    return v;
}
DI float sigmoidf_(float x) { return 1.0f / (1.0f + __expf(-x)); }
DI int TID() { int t = threadIdx.x; asm volatile("" : "+v"(t)); return t; }
#define LDS_WAVE_SYNC() asm volatile("s_waitcnt lgkmcnt(0)" ::: "memory")

struct Params { const float* in[N_IN]; float* out; unsigned char* ws; int ph_lo, ph_hi; };

DI int t5_bucket(int n) {
    if (n < 16) return n;
    if (n >= 128) return 31;
    int b = 16;
    b += (n >= 19) + (n >= 21) + (n >= 24) + (n >= 27) + (n >= 31) + (n >= 35) + (n >= 40) + (n >= 46) + (n >= 52) + (n >= 59) + (n >= 67) + (n >= 77) + (n >= 87) + (n >= 99) + (n >= 113);
    return b;
}

constexpr int GS = 72;
constexpr int G_A = 0, G_B = 256 * GS * 2, G_STAGE = (256 + 128) * GS * 2;
static_assert(2 * G_STAGE <= LDS_BYTES - 64, "gemm lds");
struct ARows { const bf16_t* p[4]; };
template <int AMODE>
DI void g_load(u32x4 (&ra)[4], u32x4 (&rb)[2], const ARows& ar, const bf16_t* bt, int ldb, int k0, int tid) {
    const int kseg = (tid & 7) * 8;
#pragma unroll
    for (int i = 0; i < 4; ++i) {
        ra[i] = (u32x4){0u, 0u, 0u, 0u};
        if (ar.p[i] != nullptr) ra[i] = *(const u32x4*)((AMODE == 0) ? (ar.p[i] + k0 + kseg) : (ar.p[i] + (size_t)(k0 >> 6) * IN_COLS + kseg));
    }
#pragma unroll
    for (int i = 0; i < 2; ++i) rb[i] = *(const u32x4*)(bt + (size_t)((tid >> 3) + 64 * i) * ldb + k0 + kseg);
}
DI void g_store(unsigned char* st, const u32x4 (&ra)[4], const u32x4 (&rb)[2], int tid) {
    const int r = tid >> 3, kseg = (tid & 7) * 8;
#pragma unroll
    for (int i = 0; i < 4; ++i) *(u32x4*)((bf16_t*)(st + G_A) + (r + 64 * i) * GS + kseg) = ra[i];
#pragma unroll
    for (int i = 0; i < 2; ++i) *(u32x4*)((bf16_t*)(st + G_B) + (r + 64 * i) * GS + kseg) = rb[i];
}
DI void g_compute(f32x4 (&acc)[4][4], const unsigned char* st, int lane, int wm, int wn) {
    const bf16_t* sA = (const bf16_t*)(st + G_A) + (wm * 64 + (lane & 15)) * GS + (lane >> 4) * 8;
    const bf16_t* sB = (const bf16_t*)(st + G_B) + (wn * 64 + (lane & 15)) * GS + (lane >> 4) * 8;
#pragma unroll
    for (int ks = 0; ks < 2; ++ks) {
        bf16x8 af[4], bfr[4];
#pragma unroll
        for (int i = 0; i < 4; ++i) { af[i] = *(const bf16x8*)(sA + i * 16 * GS + ks * 32); bfr[i] = *(const bf16x8*)(sB + i * 16 * GS + ks * 32); }
#pragma unroll
        for (int mi = 0; mi < 4; ++mi)
#pragma unroll
            for (int ni = 0; ni < 4; ++ni) acc[mi][ni] = __builtin_amdgcn_mfma_f32_16x16x32_bf16(bfr[ni], af[mi], acc[mi][ni], 0, 0, 0);
    }
}
template <int AMODE>
DI void gemm_core(f32x4 (&acc)[4][4], const ARows& ar, const bf16_t* bt  , int ldb, int K, unsigned char* lds) {
    const int tid = TID(), lane = tid & 63, wave = tid >> 6, wm = wave >> 1, wn = wave & 1;
    const int nk = K >> 6;
    unsigned char* s0 = lds; unsigned char* s1 = lds + G_STAGE;
    u32x4 ra0[4], rb0[2], ra1[4], rb1[2];
    g_load<AMODE>(ra0, rb0, ar, bt, ldb, 0, tid);
    if (nk > 1) g_load<AMODE>(ra1, rb1, ar, bt, ldb, 64, tid);
    __syncthreads();
    g_store(s0, ra0, rb0, tid);
    if (nk > 2) g_load<AMODE>(ra0, rb0, ar, bt, ldb, 128, tid);
    __syncthreads();
    for (int kt = 0; kt < nk; kt += 2) {
        if (kt + 1 < nk) { g_store(s1, ra1, rb1, tid); if (kt + 3 < nk) g_load<AMODE>(ra1, rb1, ar, bt, ldb, (kt + 3) * 64, tid); }
        g_compute(acc, s0, lane, wm, wn);
        __syncthreads();
        if (kt + 1 >= nk) break;
        if (kt + 2 < nk) { g_store(s0, ra0, rb0, tid); if (kt + 4 < nk) g_load<AMODE>(ra0, rb0, ar, bt, ldb, (kt + 4) * 64, tid); }
        g_compute(acc, s1, lane, wm, wn);
        __syncthreads();
    }
}
DI void acc_zero(f32x4 (&acc)[4][4]) {
#pragma unroll
    for (int i = 0; i < 4; ++i)
#pragma unroll
        for (int j = 0; j < 4; ++j) acc[i][j] = (f32x4){0.f, 0.f, 0.f, 0.f};
}
#define ACC_FOREACH(acc, body) do { const int _l = TID() & 63, _w = TID() >> 6; \
    _Pragma("unroll") for (int _mi = 0; _mi < 4; ++_mi) _Pragma("unroll") for (int _ni = 0; _ni < 4; ++_ni) { \
        const int r_ = (_w >> 1) * 64 + _mi * 16 + (_l & 15), c_ = (_w & 1) * 64 + _ni * 16 + (_l >> 4) * 4; f32x4& v_ = acc[_mi][_ni]; body } } while (0)
DI ARows plain_rows(const bf16_t* base, size_t ld, int m0, int tid) { ARows a;
#pragma unroll
    for (int i = 0; i < 4; ++i) a.p[i] = base + (size_t)(m0 + (tid >> 3) + 64 * i) * ld;
    return a; }

DI void store_bf4(bf16_t* p, f32x4 v) { u32x2 w; w.x = pack2(v[0], v[1]); w.y = pack2(v[2], v[3]); *(u32x2*)p = w; }

DI void convert_tile(const float* src, int ld, int N, int K, bf16_t* dst, int tile, unsigned char* lds) {
    const int tid = TID();
    const int nkt = K >> 6, tk = tile % nkt, tn = tile / nkt, k0 = tk * 64, n0 = tn * 64;
    bf16_t* T = (bf16_t*)lds;
    const int r = tid >> 3, seg = (tid & 7) * 8;
    f32x4 a = (f32x4){0.f, 0.f, 0.f, 0.f}, b = a;
    if (n0 + seg < N) { const float* q = src + (size_t)(k0 + r) * ld + n0 + seg; a = *(const f32x4*)q; b = *(const f32x4*)(q + 4); }
    __syncthreads();
    { u32x4 w; w.x = pack2(a[0], a[1]); w.y = pack2(a[2], a[3]); w.z = pack2(b[0], b[1]); w.w = pack2(b[2], b[3]); *(u32x4*)(T + r * 72 + seg) = w; }
    __syncthreads();
    u32x4 o;
    o.x = (unsigned)T[(seg + 0) * 72 + r] | ((unsigned)T[(seg + 1) * 72 + r] << 16); o.y = (unsigned)T[(seg + 2) * 72 + r] | ((unsigned)T[(seg + 3) * 72 + r] << 16);
    o.z = (unsigned)T[(seg + 4) * 72 + r] | ((unsigned)T[(seg + 5) * 72 + r] << 16); o.w = (unsigned)T[(seg + 6) * 72 + r] | ((unsigned)T[(seg + 7) * 72 + r] << 16);
    *(u32x4*)(dst + (size_t)(n0 + r) * K + k0 + seg) = o;
}

struct Ctx {
    const Params* P; unsigned char* ws; float* out; int l;
    bf16_t* H; bf16_t* PROJ; bf16_t* F; bf16_t* POOLED; bf16_t* MERGED; bf16_t* CMPH; float* CMPO; float* POSB; int* ROUTE; int* ENT; bf16_t* HID; bf16_t* Y; bf16_t* VT; bf16_t* KC; bf16_t* VCT; bf16_t* YRAW; float* BON; unsigned* ctl;
    DI const float* in(int i) const { return P->in[i]; }
};

DI void add_moe_rows(const Ctx& c, int row, int lane, f32x4 (&v)[4]) {
    const int* rt = c.ROUTE + (size_t)row * 8;
    const int p0 = rt[4], p1 = rt[5];
    const bf16_t* y0 = c.Y + (size_t)p0 * DM; const bf16_t* y1 = c.Y + (size_t)p1 * DM;
#pragma unroll
    for (int i = 0; i < 4; ++i) {
        const u32x2 a = *(const u32x2*)(y0 + i * 256 + lane * 4), b = *(const u32x2*)(y1 + i * 256 + lane * 4);
        v[i][0] += bflo(a.x) + bflo(b.x); v[i][1] += bfhi(a.x) + bfhi(b.x); v[i][2] += bflo(a.y) + bflo(b.y); v[i][3] += bfhi(a.y) + bfhi(b.y);
    }
}
DI void phase_norm1(const Ctx& c, unsigned char* lds) {
    const int tid = TID(), lane = tid & 63, wave = tid >> 6;
    const float* gain = c.in(I_NMIX) + c.l * DM;
    const float* src = (c.l == 0) ? c.in(I_X) : c.out;
    for (int row = blockIdx.x * 8 + wave; row < NT; row += gridDim.x * 8) {
        f32x4 v[4];
#pragma unroll
        for (int i = 0; i < 4; ++i) v[i] = *(const f32x4*)(src + (size_t)row * DM + i * 256 + lane * 4);
        if (c.l > 0) {
            add_moe_rows(c, row, lane, v);
#pragma unroll
            for (int i = 0; i < 4; ++i) *(f32x4*)(c.out + (size_t)row * DM + i * 256 + lane * 4) = v[i];
        }
        float ss = 0.f;
#pragma unroll
        for (int i = 0; i < 4; ++i) ss += v[i][0] * v[i][0] + v[i][1] * v[i][1] + v[i][2] * v[i][2] + v[i][3] * v[i][3];
        ss = wave_sum(ss);
        const float rs = rsqrtf(ss * (1.0f / DM) + 1e-6f);
#pragma unroll
        for (int i = 0; i < 4; ++i) {
            const f32x4 g = *(const f32x4*)(gain + i * 256 + lane * 4);
            store_bf4(c.H + (size_t)row * DM + i * 256 + lane * 4, (f32x4){v[i][0] * rs * g[0], v[i][1] * rs * g[1], v[i][2] * rs * g[2], v[i][3] * rs * g[3]});
        }
    }
    for (int idx = blockIdx.x * 8 + wave; idx < 512; idx += gridDim.x * 8) {
        const int kv = idx >> 8, n = idx & 255;
        const float* pos = c.in(kv ? I_CPV : I_CPK) + (size_t)c.l * 2048;
        const float* w1 = c.in(kv ? I_CW1V : I_CW1K) + (size_t)c.l * 2048 * 256;
        float s = 0.f;
        for (int k = lane; k < 2048; k += 64) s += pos[k] * w1[(size_t)k * 256 + n];
        s = wave_sum(s);
        if (lane == 0) c.POSB[kv * 256 + n] = s;
    }
    for (int it = blockIdx.x; it < 1216 + 256 + 16 + 16; it += gridDim.x) {
        if (it < 1216) convert_tile(c.in(I_WIN) + (size_t)c.l * DM * IN_COLS, IN_COLS, IN_COLS, DM, (bf16_t*)(c.ws + WS_WT_IN), it, lds);
        else if (it < 1216 + 256) { const int j = it - 1216, kv = j >> 7; convert_tile(c.in(kv ? I_CW1V : I_CW1K) + (size_t)c.l * 2048 * 256, 256, 256, 2048, (bf16_t*)(c.ws + WS_WT_C1) + (size_t)kv * 256 * 2048, j & 127, lds); }
        else if (it < 1216 + 256 + 16) { const int j = it - 1472, kv = j >> 3; convert_tile(c.in(kv ? I_CW2V : I_CW2K) + (size_t)c.l * 256 * 64, 64, 64, 256, (bf16_t*)(c.ws + WS_WT_C2) + (size_t)kv * 128 * 256, j & 7, lds); }
        else { const int j = it - 1488, gi = j >> 2; convert_tile(c.in(I_POOLW) + ((size_t)c.l * 4 + gi) * 128 * 128, 128, 128, 128, (bf16_t*)(c.ws + WS_WT_POOL) + (size_t)gi * 128 * 128, j & 3, lds); }
    }
}

DI void phase_gemm1(const Ctx& c, unsigned char* lds) {
    const int nM = NT / 256, nN = (IN_COLS + 127) / 128;
    const bf16_t* WT = (const bf16_t*)(c.ws + WS_WT_IN);
    for (int tile = blockIdx.x; tile < nM * nN; tile += gridDim.x) {
        const int tm = tile % nM, tn = tile / nM, m0 = tm * 256, n0 = tn * 128;
        f32x4 acc[4][4]; acc_zero(acc);
        const ARows ar = plain_rows(c.H, DM, m0, TID());
        gemm_core<0>(acc, ar, WT + (size_t)n0 * DM, DM, DM, lds);
        ACC_FOREACH(acc, { if (n0 + c_ < IN_COLS) store_bf4(c.PROJ + (size_t)(m0 + r_) * IN_COLS + n0 + c_, v_); });
    }
}

DI float gelu_tanh(float x) { const float u = 0.7978845608028654f * (x + 0.044715f * x * x * x); const float e = __expf(2.0f * u); return x * (1.0f - 1.0f / (e + 1.0f)); }
DI float softplusf_(float x) { return (x > 20.f) ? x : __logf(1.0f + __expf(x)); }
DI float tanhf_(float x) { const float e = __expf(2.0f * x); return 1.0f - 2.0f / (e + 1.0f); }
DI void phase_prep(const Ctx& c, unsigned char* lds) {
    const int tid = TID();
    const int n_cmp_items = 2 * 16 * 2;
    const int n_prep = n_cmp_items + NT / 16;
    const int n_items = n_prep + 2048;
    for (int item = blockIdx.x; item < n_items; item += gridDim.x) {
        if (item < n_cmp_items) {
            const int kv = item >> 5, bgi = (item >> 1) & 15, tn = item & 1, m0 = bgi * 256, n0 = tn * 128;
            ARows ar;
#pragma unroll
            for (int i = 0; i < 4; ++i) { const int cb = (tid >> 3) + 64 * i;
                ar.p[i] = (cb < NCMP) ? c.PROJ + ((size_t)(bgi >> 2) * SEQ + 16 * cb) * IN_COLS + (kv ? C_VC : C_KC) + (bgi & 3) * 64 : nullptr; }
            f32x4 acc[4][4]; acc_zero(acc);
            gemm_core<1>(acc, ar, (const bf16_t*)(c.ws + WS_WT_C1) + ((size_t)kv * 256 + n0) * 2048, 2048, 2048, lds);
            const float* pb = c.POSB + kv * 256;
            ACC_FOREACH(acc, {
                const f32x4 bb = *(const f32x4*)(pb + n0 + c_);
                store_bf4(c.CMPH + ((size_t)kv * 4096 + m0 + r_) * 256 + n0 + c_, (f32x4){gelu_tanh(v_[0] + bb[0]), gelu_tanh(v_[1] + bb[1]), gelu_tanh(v_[2] + bb[2]), gelu_tanh(v_[3] + bb[3])}); });
        } else if (item >= n_prep) {
            const int idx = item - n_prep, kind = idx >> 10, bgi = (idx >> 6) & 15, s0 = (idx & 63) * 64;
            bf16_t* T = (bf16_t*)lds;
            const int r = tid >> 3, seg = (tid & 7) * 8;
            const u32x4 w = *(const u32x4*)(c.PROJ + ((size_t)(bgi >> 2) * SEQ + s0 + r) * IN_COLS + (kind ? C_VW : C_VS) + (bgi & 3) * 64 + seg);
            __syncthreads();
            *(u32x4*)(T + r * 72 + seg) = w;
            __syncthreads();
            u32x4 o;
            o.x = (unsigned)T[(seg + 0) * 72 + r] | ((unsigned)T[(seg + 1) * 72 + r] << 16); o.y = (unsigned)T[(seg + 2) * 72 + r] | ((unsigned)T[(seg + 3) * 72 + r] << 16);
            o.z = (unsigned)T[(seg + 4) * 72 + r] | ((unsigned)T[(seg + 5) * 72 + r] << 16); o.w = (unsigned)T[(seg + 6) * 72 + r] | ((unsigned)T[(seg + 7) * 72 + r] << 16);
            *(u32x4*)(c.VT + (((size_t)kind * 16 + bgi) * 64 + r) * SEQ + s0 + seg) = o;
        } else {
            const int t0 = (item - n_cmp_items) * 16;
            float* sl = (float*)lds;
            const float* mu = c.in(I_MU) + (size_t)c.l * RWC;
            __syncthreads();
            for (int idx = tid; idx < 16 * 160; idx += NTHREADS) {
                const int tk = idx / 160, i = idx % 160, t = t0 + tk, col = C_WD + i;
                const float u = bf2f(c.PROJ[(size_t)t * IN_COLS + col]);
                const float up = ((t & (SEQ - 1)) != 0) ? bf2f(c.PROJ[(size_t)(t - 1) * IN_COLS + col]) : 0.f;
                const float us = u + (up - u) * mu[col - C_RW];
                sl[idx] = (i < 32) ? tanhf_(us) : ((i < 64) ? us : sigmoidf_(us));
            }
            __syncthreads();
            const int ch = tid;
            float z[16], aa[16], gg[16];
#pragma unroll
            for (int k = 0; k < 16; ++k) { z[k] = 0.f; aa[k] = 0.f; gg[k] = 0.f; }
            const float* wup = c.in(I_WUP) + (size_t)c.l * 32 * 512 + ch;
            const float* aup = c.in(I_AUP) + (size_t)c.l * 32 * 512 + ch;
            const float* gup = c.in(I_GUP) + (size_t)c.l * 96 * 512 + ch;
            for (int i = 0; i < 32; ++i) {
                const float w = wup[i * 512], a = aup[i * 512];
#pragma unroll
                for (int k = 0; k < 16; ++k) { z[k] += sl[k * 160 + i] * w; aa[k] += sl[k * 160 + 32 + i] * a; }
            }
            for (int i = 0; i < 96; ++i) {
                const float w = gup[i * 512];
#pragma unroll
                for (int k = 0; k < 16; ++k) gg[k] += sl[k * 160 + 64 + i] * w;
            }
            const float w0 = c.in(I_W0)[c.l * 512 + ch], a0 = c.in(I_A0)[c.l * 512 + ch];
            const float mur = mu[ch], muk = mu[512 + ch], muv = mu[1024 + ch];
            float pr = 0.f, pk = 0.f, pv = 0.f;
            if ((t0 & (SEQ - 1)) != 0) { const bf16_t* q = c.PROJ + (size_t)(t0 - 1) * IN_COLS; pr = bf2f(q[C_R + ch]); pk = bf2f(q[C_K + ch]); pv = bf2f(q[C_V + ch]); }
#pragma unroll
            for (int k = 0; k < 16; ++k) {
                const int t = t0 + k; const bf16_t* q = c.PROJ + (size_t)t * IN_COLS;
                const float ur = bf2f(q[C_R + ch]), uk = bf2f(q[C_K + ch]), uv = bf2f(q[C_V + ch]);
                const float r = ur + (pr - ur) * mur, kx = uk + (pk - uk) * muk, vx = uv + (pv - uv) * muv;
                pr = ur; pk = uk; pv = uv;
                const float wlog = -softplusf_(-(w0 + z[k])) - 0.5f;
                const float e = __expf(wlog);
                const float a = sigmoidf_(a0 + aa[k]);
                const size_t o = (size_t)t * 512 + ch;
                c.F[o] = f2bf(r); c.F[o + (size_t)NT * 512] = f2bf(kx); c.F[o + (size_t)2 * NT * 512] = f2bf(vx);
                c.F[o + (size_t)3 * NT * 512] = f2bf(e); c.F[o + (size_t)4 * NT * 512] = f2bf(a); c.F[o + (size_t)5 * NT * 512] = f2bf(gg[k]);
            }
            {
                const int gi = ch >> 7, win = 2 << gi;
#pragma unroll 1
                for (int k = 0; k < 16; ++k) {
                    const int t = t0 + k, s = t & (SEQ - 1);
                    const int lo = (s + 1 - win > 0) ? (s + 1 - win) : 0;
                    float sum = 0.f;
                    for (int j = lo; j <= s; ++j) sum += bf2f(c.PROJ[(size_t)(t - s + j) * IN_COLS + C_POOL + ch]);
                    const float self = bf2f(c.PROJ[(size_t)t * IN_COLS + C_POOL + ch]);
                    c.POOLED[(size_t)t * 512 + ch] = f2bf(sum / (float)(s + 1 - lo) - self);
                }
            }
        }
    }
}

DI void phase_poolgemm(const Ctx& c, unsigned char* lds) {
    const int n_pool = (NT / 256) * 4, n_items = n_pool + 32;
    for (int item = blockIdx.x; item < n_items; item += gridDim.x) {
        f32x4 acc[4][4]; acc_zero(acc);
        if (item < n_pool) {
            const int tm = item >> 2, gi = item & 3, m0 = tm * 256;
            const ARows ar = plain_rows(c.POOLED + gi * 128, 512, m0, TID());
            gemm_core<0>(acc, ar, (const bf16_t*)(c.ws + WS_WT_POOL) + (size_t)gi * 128 * 128, 128, 128, lds);
            const float* sc = c.in(I_POOLS) + c.l * 512 + gi * 128;
            ACC_FOREACH(acc, { const f32x4 s = *(const f32x4*)(sc + c_);
                store_bf4(c.POOLED + (size_t)(m0 + r_) * 512 + gi * 128 + c_, (f32x4){v_[0] * s[0], v_[1] * s[1], v_[2] * s[2], v_[3] * s[3]}); });
        } else {
            const int it = item - n_pool, kv = it >> 4, tm = it & 15, m0 = tm * 256;
            const ARows ar = plain_rows(c.CMPH + (size_t)kv * 4096 * 256, 256, m0, TID());
            gemm_core<0>(acc, ar, (const bf16_t*)(c.ws + WS_WT_C2) + (size_t)kv * 128 * 256, 256, 256, lds);
            ACC_FOREACH(acc, { if (c_ < 64) { const int R = m0 + r_;
                if (kv == 0) store_bf4(c.KC + (size_t)R * 64 + c_, v_);
                else { bf16_t* q = c.VCT + ((size_t)(R >> 8) * 64 + c_) * 256 + (R & 255); q[0] = f2bf(v_[0]); q[256] = f2bf(v_[1]); q[512] = f2bf(v_[2]); q[768] = f2bf(v_[3]); } } });
        }
    }
}

constexpr int SCH = 32;
constexpr int SB_AN = 0, SB_WR = SCH * 64 * 4, SB_W = 2 * SCH * 64 * 4, SB_BB = 3 * SCH * 64 * 4, SB_KP = 4 * SCH * 64 * 4;
constexpr int SB_V = 5 * SCH * 64 * 4;
constexpr int SB_SC = SB_V + SCH * 16 * 4;
constexpr int SB_Y = SB_SC + SCH * 2 * 4;
constexpr int SB_BYTES = SB_Y + SCH * 16 * 4;
static_assert(2 * SB_BYTES <= LDS_BYTES - 64, "scan lds");
typedef float f32x2 __attribute__((ext_vector_type(2)));
#define DPP_MOV(v, ctrl) __builtin_bit_cast(float, __builtin_amdgcn_update_dpp(0, __builtin_bit_cast(int, (v)), (ctrl), 0xF, 0xF, true))
DI float row8_sum(float v) { v += DPP_MOV(v, 0xB1); v += DPP_MOV(v, 0x4E); v += DPP_MOV(v, 0x141); return v; }

DI float wave_sum_dpp(float v) {
    v += DPP_MOV(v, 0xB1); v += DPP_MOV(v, 0x4E); v += DPP_MOV(v, 0x141); v += DPP_MOV(v, 0x140);
    return __builtin_bit_cast(float, __builtin_amdgcn_readlane(__builtin_bit_cast(int, v), 0)) + __builtin_bit_cast(float, __builtin_amdgcn_readlane(__builtin_bit_cast(int, v), 16)) +
        (__builtin_bit_cast(float, __builtin_amdgcn_readlane(__builtin_bit_cast(int, v), 32)) + __builtin_bit_cast(float, __builtin_amdgcn_readlane(__builtin_bit_cast(int, v), 48)));
}
DI void scan_prep(const Ctx& c, unsigned char* sb, int b, int h, int rq, int ck, int pw, int npw, int lane, float kkw, float kaw, float rkw) {
    const size_t PL = (size_t)NT * 512;
    float* an = (float*)(sb + SB_AN); float* wr = (float*)(sb + SB_WR); float* w_ = (float*)(sb + SB_W); float* bb_ = (float*)(sb + SB_BB); float* kp_ = (float*)(sb + SB_KP);
    float* vv = (float*)(sb + SB_V); float* sc = (float*)(sb + SB_SC);
#pragma unroll 3
    for (int st = pw; st < SCH; st += npw) {
        const int t = ck * SCH + st;
        const size_t o = ((size_t)b * SEQ + t) * 512 + h * 64 + lane;
        const float r = bf2f(c.F[o]), k = bf2f(c.F[o + PL]), v = bf2f(c.F[o + 2 * PL]), e = bf2f(c.F[o + 3 * PL]), a = bf2f(c.F[o + 4 * PL]);
        const float w = __expf(-e);
        const float kx = k * kkw;
        const float kp = k * (1.0f + (a - 1.0f) * kaw);
        const float ss = wave_sum_dpp(kx * kx), s2 = wave_sum_dpp(kx * a * r), kr = wave_sum_dpp(kp * r);
        const float inv = 1.0f / fmaxf(sqrtf(ss), 1e-12f);
        const float kk = kx * inv;
        an[st * 64 + lane] = -kk; wr[st * 64 + lane] = w * r; w_[st * 64 + lane] = w; bb_[st * 64 + lane] = kk * a; kp_[st * 64 + lane] = kp;
        if ((lane >> 4) == rq) vv[st * 16 + (lane & 15)] = v;
        if (lane == 0) { sc[st * 2] = s2 * inv; sc[st * 2 + 1] = kr; }
        if (rq == 0) { const float bon = wave_sum_dpp(r * kp * rkw); if (lane == 0) c.BON[((size_t)b * SEQ + t) * 8 + h] = bon; }
    }
}
DI void scan_item(const Ctx& c, int item, unsigned char* lds) {
    const int tid = TID(), lane = tid & 63, wave = tid >> 6;
    const int b = item >> 5, h = (item >> 2) & 7, rq = item & 3;
    const int chn = h * 64 + lane;
    const float kkw = c.in(I_KK)[c.l * 512 + chn], kaw = c.in(I_KA)[c.l * 512 + chn], rkw = c.in(I_RK)[c.l * 512 + chn];
    const int rowl = (tid & 127) >> 3, cg = tid & 7;
    f32x2 st[4];
#pragma unroll
    for (int i = 0; i < 4; ++i) st[i] = (f32x2){0.f, 0.f};
    __syncthreads();
    scan_prep(c, lds, b, h, rq, 0, wave, 8, lane, kkw, kaw, rkw);
    __syncthreads();
    constexpr int NCK = SEQ / SCH;
    for (int ck = 0; ck < NCK; ++ck) {
        unsigned char* sb = lds + (ck & 1) * SB_BYTES;
        if (wave < 2) {
            const float* an = (const float*)(sb + SB_AN) + cg * 8; const float* wr = (const float*)(sb + SB_WR) + cg * 8; const float* w_ = (const float*)(sb + SB_W) + cg * 8;
            const float* bb_ = (const float*)(sb + SB_BB) + cg * 8; const float* kp_ = (const float*)(sb + SB_KP) + cg * 8;
            const float* vv = (const float*)(sb + SB_V) + rowl; const float* sc = (const float*)(sb + SB_SC); float* yb = (float*)(sb + SB_Y) + rowl;
            f32x4 a0 = *(const f32x4*)(an), a1 = *(const f32x4*)(an + 4), r0 = *(const f32x4*)(wr), r1 = *(const f32x4*)(wr + 4);
            f32x4 w0 = *(const f32x4*)(w_), w1 = *(const f32x4*)(w_ + 4), b0 = *(const f32x4*)(bb_), b1 = *(const f32x4*)(bb_ + 4);
            f32x4 k0 = *(const f32x4*)(kp_), k1 = *(const f32x4*)(kp_ + 4);
            float v = vv[0]; f32x2 bk = *(const f32x2*)(sc);
#pragma unroll 2
            for (int s = 0; s < SCH; ++s) {
                const int sn = (s + 1 < SCH) ? s + 1 : s;
                const f32x4 na0 = *(const f32x4*)(an + sn * 64), na1 = *(const f32x4*)(an + sn * 64 + 4), nr0 = *(const f32x4*)(wr + sn * 64), nr1 = *(const f32x4*)(wr + sn * 64 + 4);
                const f32x4 nw0 = *(const f32x4*)(w_ + sn * 64), nw1 = *(const f32x4*)(w_ + sn * 64 + 4), nb0 = *(const f32x4*)(bb_ + sn * 64), nb1 = *(const f32x4*)(bb_ + sn * 64 + 4);
                const f32x4 nk0 = *(const f32x4*)(kp_ + sn * 64), nk1 = *(const f32x4*)(kp_ + sn * 64 + 4);
                const float nv = vv[sn * 16]; const f32x2 nbk = *(const f32x2*)(sc + sn * 2);
                f32x2 da = st[0] * (f32x2){a0[0], a0[1]}; f32x2 dr = st[0] * (f32x2){r0[0], r0[1]};
                da += st[1] * (f32x2){a0[2], a0[3]}; dr += st[1] * (f32x2){r0[2], r0[3]};
                da += st[2] * (f32x2){a1[0], a1[1]}; dr += st[2] * (f32x2){r1[0], r1[1]};
                da += st[3] * (f32x2){a1[2], a1[3]}; dr += st[3] * (f32x2){r1[2], r1[3]};
                float sa = da[0] + da[1], sr = dr[0] + dr[1];
                sa += DPP_MOV(sa, 0xB1); sr += DPP_MOV(sr, 0xB1);
                sa += DPP_MOV(sa, 0x4E); sr += DPP_MOV(sr, 0x4E);
                sa += DPP_MOV(sa, 0x141); sr += DPP_MOV(sr, 0x141);
                const f32x2 sa2 = (f32x2){sa, sa}, v2 = (f32x2){v, v};
                st[0] = st[0] * (f32x2){w0[0], w0[1]} + sa2 * (f32x2){b0[0], b0[1]} + v2 * (f32x2){k0[0], k0[1]};
                st[1] = st[1] * (f32x2){w0[2], w0[3]} + sa2 * (f32x2){b0[2], b0[3]} + v2 * (f32x2){k0[2], k0[3]};
                st[2] = st[2] * (f32x2){w1[0], w1[1]} + sa2 * (f32x2){b1[0], b1[1]} + v2 * (f32x2){k1[0], k1[1]};
                st[3] = st[3] * (f32x2){w1[2], w1[3]} + sa2 * (f32x2){b1[2], b1[3]} + v2 * (f32x2){k1[2], k1[3]};
                yb[s * 16] = sr + sa * bk[0] + v * bk[1];
                a0 = na0; a1 = na1; r0 = nr0; r1 = nr1; w0 = nw0; w1 = nw1; b0 = nb0; b1 = nb1; k0 = nk0; k1 = nk1; v = nv; bk = nbk;
            }
        } else {
            const int pt = tid - 128;
            if (ck > 0) {
                const float* yb = (const float*)(lds + ((ck - 1) & 1) * SB_BYTES + SB_Y);
                for (int idx = pt; idx < SCH * 16; idx += 384) {
                    const int s = idx >> 4, j = idx & 15;
                    c.YRAW[((size_t)b * SEQ + (ck - 1) * SCH + s) * 512 + h * 64 + rq * 16 + j] = f2bf(yb[idx]);
                }
            }
            if (ck + 1 < NCK) scan_prep(c, lds + ((ck + 1) & 1) * SB_BYTES, b, h, rq, ck + 1, wave - 2, 6, lane, kkw, kaw, rkw);
        }
        __syncthreads();
    }
    {
        const float* yb = (const float*)(lds + ((NCK - 1) & 1) * SB_BYTES + SB_Y);
        for (int idx = tid; idx < SCH * 16; idx += NTHREADS) {
            const int s = idx >> 4, j = idx & 15;
            c.YRAW[((size_t)b * SEQ + (NCK - 1) * SCH + s) * 512 + h * 64 + rq * 16 + j] = f2bf(yb[idx]);
        }
    }
    __syncthreads();
}
DI void phase_rwkv_post(const Ctx& c, unsigned char* lds) {
    const int tid = TID(), lane = tid & 63, wave = tid >> 6;
    const size_t PL = (size_t)NT * 512;
    for (int idx = blockIdx.x * 8 + wave; idx < NT * 8; idx += gridDim.x * 8) {
        const int t = idx >> 3, h = idx & 7, chn = h * 64 + lane;
        const size_t o = (size_t)t * 512 + chn;
        const float y = bf2f(c.YRAW[o]);
        const float mean = wave_sum(y) * (1.0f / 64.0f);
        const float d = y - mean;
        const float var = wave_sum(d * d) * (1.0f / 64.0f);
        const float yn = d * rsqrtf(var + 64e-5f) * c.in(I_GNW)[c.l * 512 + chn] + c.in(I_GNB)[c.l * 512 + chn];
        const float v = bf2f(c.F[o + 2 * PL]), g = bf2f(c.F[o + 5 * PL]);
        c.F[o + 5 * PL] = f2bf((yn + c.BON[idx] * v) * g);
    }
    for (int it = blockIdx.x; it < 768 + 128 + 128 + 256 + 256; it += gridDim.x) {
        const float* WB = c.in(I_WBR) + (size_t)c.l * 2048 * DM; bf16_t* BR = (bf16_t*)(c.ws + WS_WT_BR);
        if (it < 768) convert_tile(c.in(I_WMG) + (size_t)c.l * DM * 3 * DM, 3 * DM, 3 * DM, DM, (bf16_t*)(c.ws + WS_WT_MG), it, lds);
        else if (it < 896) convert_tile(WB, DM, DM, 512, BR, it - 768, lds);
        else if (it < 1024) convert_tile(WB + (size_t)512 * DM, DM, DM, 512, BR + (size_t)1024 * 512, it - 896, lds);
        else if (it < 1280) convert_tile(WB + (size_t)1024 * DM, DM, DM, 1024, BR + (size_t)2048 * 512, it - 1024, lds);
        else convert_tile(c.in(I_WOUT) + (size_t)c.l * DM * DM, DM, DM, DM, (bf16_t*)(c.ws + WS_WT_OUT), it - 1280, lds);
    }
}
constexpr int TS = 72;
constexpr int NSA_BIAS = 0;
constexpr int NSA_SELM = 2112;
constexpr int NSA_SCR = 2624;
constexpr int NSA_K0 = 4672;
constexpr int NSA_V0 = NSA_K0 + 2 * 64 * TS * 2;
constexpr int NSA_A = NSA_V0 + 2 * 64 * TS * 2;
constexpr int NSA_B = NSA_A + 16384;
constexpr int NSA_END = NSA_B + 16384;
static_assert(NSA_END <= LDS_BYTES - 16, "nsa lds");
static_assert(NSA_K0 % 16 == 0, "align");

struct NsaLane { int tq[2]; int h; float cbias; float m[2], l[2]; };

DI void nsa_prefetch(u32x4& rk, u32x4& rv, const bf16_t* kbase, int kstride, const bf16_t* vtbase, int vstride, int pos0, int tid) {
    const int r = tid >> 3, seg = (tid & 7) * 8;
    rk = *(const u32x4*)(kbase + (size_t)(pos0 + r) * kstride + seg);
    rv = *(const u32x4*)(vtbase + (size_t)r * vstride + pos0 + seg);
}
DI void nsa_store(unsigned char* lds, int buf, const u32x4& rk, const u32x4& rv, int tid) {
    const int r = tid >> 3, seg = (tid & 7) * 8;
    *(u32x4*)((bf16_t*)(lds + NSA_K0) + buf * 64 * TS + r * TS + seg) = rk;
    *(u32x4*)((bf16_t*)(lds + NSA_V0) + buf * 64 * TS + r * TS + seg) = rv;
}
DI void nsa_qk(f32x4 (&s)[2][4], const bf16_t* sK, const bf16x8 (&qf)[2][2], int lane) {
#pragma unroll
    for (int kt = 0; kt < 4; ++kt) {
#pragma unroll
        for (int ks = 0; ks < 2; ++ks) {
            const bf16x8 kf = *(const bf16x8*)(sK + (16 * kt + (lane & 15)) * TS + 32 * ks + (lane >> 4) * 8);
#pragma unroll
            for (int qi = 0; qi < 2; ++qi) s[qi][kt] = __builtin_amdgcn_mfma_f32_16x16x32_bf16(kf, qf[qi][ks], (ks == 0) ? (f32x4){0.f, 0.f, 0.f, 0.f} : s[qi][kt], 0, 0, 0);
        }
    }
}
template <int MODE>
DI void nsa_logits(float (&x)[4][4], const f32x4 (&s)[4], int tq, int h, float cbias, bool rowsel, int pos0, int qd, const float* biasT) {
#pragma unroll
    for (int kt = 0; kt < 4; ++kt)
#pragma unroll
        for (int i = 0; i < 4; ++i) {
            const int kk = pos0 + 16 * kt + 4 * qd + i;
            if (MODE == 1) { x[kt][i] = rowsel ? s[kt][i] + cbias : -INFINITY; }
            else {
                const int dist = (MODE == 0) ? (tq - 16 * kk - 31) : (tq - kk);
                bool ok = dist >= 0;
                if (MODE == 2) ok = ok && rowsel;
                if (MODE == 3) ok = ok && (dist < 512);
                const int di = dist < 0 ? 0 : (dist > 128 ? 128 : dist);
                float bias = biasT[di * 4 + h];
                asm volatile("" : "+v"(bias));
                x[kt][i] = ok ? s[kt][i] + bias : -INFINITY;
            }
        }
}
DI float quad16_max(float v) { v = fmaxf(v, __shfl_xor(v, 16)); v = fmaxf(v, __shfl_xor(v, 32)); return v; }
DI float quad16_sum(float v) { v += __shfl_xor(v, 16); v += __shfl_xor(v, 32); return v; }
DI void nsa_softmax(const float (&x)[4][4], float& m, float& l, f32x4 (&O)[4], bf16x8 (&pf)[2]) {
    float mx = -INFINITY;
#pragma unroll
    for (int kt = 0; kt < 4; ++kt)
#pragma unroll
        for (int i = 0; i < 4; ++i) mx = fmaxf(mx, x[kt][i]);
    mx = quad16_max(mx);
    const float mn = fmaxf(m, mx);
    const float mu = (mn == -INFINITY) ? 0.f : mn;
    const float mu2 = mu * 1.4426950408889634f;
    const float sc = __builtin_amdgcn_exp2f(__builtin_fmaf(m, 1.4426950408889634f, -mu2));
    float p[4][4]; float ps = 0.f;
#pragma unroll
    for (int kt = 0; kt < 4; ++kt)
#pragma unroll
        for (int i = 0; i < 4; ++i) { p[kt][i] = __builtin_amdgcn_exp2f(__builtin_fmaf(x[kt][i], 1.4426950408889634f, -mu2)); ps += p[kt][i]; }
    l = l * sc + ps; m = mn;
#pragma unroll
    for (int dt = 0; dt < 4; ++dt) O[dt] = O[dt] * sc;
#pragma unroll
    for (int ks = 0; ks < 2; ++ks) {
        u32x4 w; w.x = pack2(p[2 * ks][0], p[2 * ks][1]); w.y = pack2(p[2 * ks][2], p[2 * ks][3]); w.z = pack2(p[2 * ks + 1][0], p[2 * ks + 1][1]); w.w = pack2(p[2 * ks + 1][2], p[2 * ks + 1][3]);
        pf[ks] = __builtin_bit_cast(bf16x8, w);
    }
}
DI void nsa_pv(f32x4 (&O)[2][4], const bf16_t* sV, const bf16x8 (&pf)[2][2], int lane) {
    const int qd = lane >> 4;
#pragma unroll
    for (int dt = 0; dt < 4; ++dt)
#pragma unroll
        for (int ks = 0; ks < 2; ++ks) {
            const bf16_t* vp = sV + (16 * dt + (lane & 15)) * TS + 32 * ks + 4 * qd;
            const u32x2 a = *(const u32x2*)vp, b = *(const u32x2*)(vp + 16);
            u32x4 w; w.x = a.x; w.y = a.y; w.z = b.x; w.w = b.y;
            const bf16x8 vf = __builtin_bit_cast(bf16x8, w);
#pragma unroll
            for (int qi = 0; qi < 2; ++qi) O[qi][dt] = __builtin_amdgcn_mfma_f32_16x16x32_bf16(vf, pf[qi][ks], O[qi][dt], 0, 0, 0);
        }
}
template <int MODE>
DI void nsa_tile(f32x4 (&O)[2][4], NsaLane& L, const bf16x8 (&qf)[2][2], const unsigned char* lds, int buf, int pos0, bool sel0, bool sel1, int lane) {
    const bf16_t* sK = (const bf16_t*)(lds + NSA_K0) + buf * 64 * TS;
    const bf16_t* sV = (const bf16_t*)(lds + NSA_V0) + buf * 64 * TS;
    const float* biasT = (const float*)(lds + NSA_BIAS);
    f32x4 s[2][4];
    nsa_qk(s, sK, qf, lane);
    bf16x8 pf[2][2];
#pragma unroll
    for (int qi = 0; qi < 2; ++qi) {
        float x[4][4];
        nsa_logits<MODE>(x, s[qi], L.tq[qi], L.h, L.cbias, qi ? sel1 : sel0, pos0, lane >> 4, biasT);
        nsa_softmax(x, L.m[qi], L.l[qi], O[qi], pf[qi]);
    }
    nsa_pv(O, sV, pf, lane);
}
DI void nsa_flush(f32x4 (&Y)[2][4], f32x4 (&O)[2][4], NsaLane& L, const float (&gate)[2]) {
#pragma unroll
    for (int qi = 0; qi < 2; ++qi) {
        const float lt = quad16_sum(L.l[qi]);
        const float f = (lt > 0.f) ? gate[qi] / lt : 0.f;
#pragma unroll
        for (int dt = 0; dt < 4; ++dt) { Y[qi][dt] += O[qi][dt] * f; O[qi][dt] = (f32x4){0.f, 0.f, 0.f, 0.f}; }
    }
}
DI void nsa_item(const Ctx& c, int item, unsigned char* lds) {
    const int tid = TID(), lane = tid & 63, wave = tid >> 6, qd = lane >> 4;
    const int b = item >> 8, g = (item >> 6) & 3, qt = item & 63, t0 = qt * 64, cur = qt, bg = b * 4 + g;
    float* biasT = (float*)(lds + NSA_BIAS);
    unsigned long long* selm = (unsigned long long*)(lds + NSA_SELM);
    float* scr = (float*)(lds + NSA_SCR) + wave * 64;
    float* impA = (float*)(lds + NSA_A); float* impB = (float*)(lds + NSA_B);
    __syncthreads();
    for (int i = tid; i < 129 * 4; i += NTHREADS) { const int d = i >> 2, h = i & 3; biasT[i] = c.in(I_RELB)[t5_bucket(d) * 16 + g * 4 + h]; }
    for (int i = tid; i < 2 * 4096; i += NTHREADS) impA[i] = 0.f;
    NsaLane L; L.h = lane & 3;
    bf16x8 qf[2][2]; float gates[2][3];
    const bf16_t* pbat = c.PROJ + (size_t)b * SEQ * IN_COLS;
#pragma unroll
    for (int qi = 0; qi < 2; ++qi) {
        const int tl = 8 * wave + 4 * qi + ((lane & 15) >> 2);
        L.tq[qi] = t0 + tl;
        const bf16_t* prow = pbat + (size_t)L.tq[qi] * IN_COLS;
#pragma unroll
        for (int ks = 0; ks < 2; ++ks) {
            u32x4 w = *(const u32x4*)(prow + C_Q + (g * 4 + L.h) * 64 + 32 * ks + qd * 8);
            w.x = pack2(bflo(w.x) * 0.125f, bfhi(w.x) * 0.125f); w.y = pack2(bflo(w.y) * 0.125f, bfhi(w.y) * 0.125f);
            w.z = pack2(bflo(w.z) * 0.125f, bfhi(w.z) * 0.125f); w.w = pack2(bflo(w.w) * 0.125f, bfhi(w.w) * 0.125f);
            qf[qi][ks] = __builtin_bit_cast(bf16x8, w);
        }
#pragma unroll
        for (int br = 0; br < 3; ++br) gates[qi][br] = sigmoidf_(bf2f(prow[C_GATE + g * 12 + L.h * 3 + br]));
    }
    __syncthreads();
    L.cbias = biasT[128 * 4 + L.h];
    f32x4 O[2][4], Y[2][4];
#pragma unroll
    for (int qi = 0; qi < 2; ++qi)
#pragma unroll
        for (int dt = 0; dt < 4; ++dt) { O[qi][dt] = (f32x4){0.f, 0.f, 0.f, 0.f}; Y[qi][dt] = (f32x4){0.f, 0.f, 0.f, 0.f}; }
    u32x4 rk, rv;
    const int nvis_max = (t0 + 63 >= 31) ? ((t0 + 63 - 31) >> 4) + 1 : 0;
    const int ncb = (nvis_max + 63) >> 6;
    const bf16_t* kcb = c.KC + (size_t)bg * 256 * 64; const bf16_t* vcb = c.VCT + (size_t)bg * 64 * 256;
    L.m[0] = L.m[1] = -INFINITY; L.l[0] = L.l[1] = 0.f;
    if (ncb > 0) nsa_prefetch(rk, rv, kcb, 64, vcb, 256, 0, tid);
    for (int cb = 0; cb < ncb; ++cb) {
        nsa_store(lds, cb & 1, rk, rv, tid);
        __syncthreads();
        if (cb + 1 < ncb) nsa_prefetch(rk, rv, kcb, 64, vcb, 256, (cb + 1) * 64, tid);
        if (16 * (cb * 64 + 63) + 31 + 128 <= t0) nsa_tile<1>(O, L, qf, lds, cb & 1, cb * 64, true, true, lane);
        else nsa_tile<0>(O, L, qf, lds, cb & 1, cb * 64, true, true, lane);
    }
    float mfin[2], linv[2];
#pragma unroll
    for (int qi = 0; qi < 2; ++qi) { mfin[qi] = L.m[qi]; const float lt = quad16_sum(L.l[qi]); linv[qi] = (lt > 0.f) ? 1.0f / lt : 0.f; }
    { const float gg[2] = {gates[0][0], gates[1][0]}; nsa_flush(Y, O, L, gg); }
    __syncthreads();
    if (ncb > 0) nsa_prefetch(rk, rv, kcb, 64, vcb, 256, 0, tid);
    for (int cb = 0; cb < ncb; ++cb) {
        nsa_store(lds, cb & 1, rk, rv, tid);
        __syncthreads();
        if (cb + 1 < ncb) nsa_prefetch(rk, rv, kcb, 64, vcb, 256, (cb + 1) * 64, tid);
        const bf16_t* sK = (const bf16_t*)(lds + NSA_K0) + (cb & 1) * 64 * TS;
        f32x4 s[2][4];
        nsa_qk(s, sK, qf, lane);
#pragma unroll
        for (int qi = 0; qi < 2; ++qi) {
            float x[4][4];
            nsa_logits<0>(x, s[qi], L.tq[qi], L.h, L.cbias, true, cb * 64, qd, biasT);
            const float mu = (mfin[qi] == -INFINITY) ? 0.f : mfin[qi];
#pragma unroll
            for (int kt = 0; kt < 4; ++kt) {
                float p3 = __expf(x[kt][3] - mu) * linv[qi];
                float pa = (__expf(x[kt][0] - mu) + __expf(x[kt][1] - mu) + __expf(x[kt][2] - mu)) * linv[qi] + p3;
                pa += __shfl_xor(pa, 1); p3 += __shfl_xor(p3, 1);
                pa += __shfl_xor(pa, 2); p3 += __shfl_xor(p3, 2);
                if (L.h == 0) { const int tl = 8 * wave + 4 * qi + ((lane & 15) >> 2), mi = 16 * cb + 4 * kt + qd; impA[tl * 64 + mi] = pa; impB[tl * 64 + mi] = p3; }
            }
        }
    }
    __syncthreads();
    for (int tl8 = 0; tl8 < 8; ++tl8) {
        const int tl = 8 * wave + tl8, n = lane;
        const bool cand = (n >= 1) && (n <= cur - 2);
        const float imp = cand ? impA[tl * 64 + n] + impB[tl * 64 + n - 1] : -1.0f;
        LDS_WAVE_SYNC();
        scr[n] = imp;
        LDS_WAVE_SYNC();
        int rank = 0;
#pragma unroll 4
        for (int q4 = 0; q4 < 16; ++q4) {
            const f32x4 o = *(const f32x4*)(scr + q4 * 4);
#pragma unroll
            for (int j = 0; j < 4; ++j) { const int n2 = q4 * 4 + j; rank += (o[j] > imp || (o[j] == imp && n2 < n)) ? 1 : 0; }
        }
        const bool forced = (n <= cur) && (n == 0 || n == cur || n == cur - 1);
        const unsigned long long msk = __ballot((cand && rank < 5) || forced);
        if (lane == 0) selm[tl] = msk;
    }
    __syncthreads();
    unsigned long long uni = selm[lane];
#pragma unroll
    for (int o = 32; o >= 1; o >>= 1) { const unsigned lo_ = __shfl_xor((unsigned)uni, o), hi_ = __shfl_xor((unsigned)(uni >> 32), o); uni |= ((unsigned long long)hi_ << 32) | lo_; }
    uni = ((unsigned long long)__builtin_amdgcn_readfirstlane((unsigned)(uni >> 32)) << 32) | (unsigned)__builtin_amdgcn_readfirstlane((unsigned)uni);
    unsigned long long sm[2];
#pragma unroll
    for (int qi = 0; qi < 2; ++qi) sm[qi] = selm[8 * wave + 4 * qi + ((lane & 15) >> 2)];
    const bf16_t* ksb = pbat + C_KS + g * 64; const bf16_t* vsb = c.VT + ((size_t)0 * 16 + bg) * 64 * SEQ;
    L.m[0] = L.m[1] = -INFINITY; L.l[0] = L.l[1] = 0.f;
    {
        unsigned long long rem = uni; int it = 0;
        int j = (int)__builtin_ctzll(rem); rem &= rem - 1;
        nsa_prefetch(rk, rv, ksb, IN_COLS, vsb, SEQ, j * 64, tid);
        for (;;) {
            nsa_store(lds, it & 1, rk, rv, tid);
            __syncthreads();
            const int jn = rem ? (int)__builtin_ctzll(rem) : -1;
            if (jn >= 0) { rem &= rem - 1; nsa_prefetch(rk, rv, ksb, IN_COLS, vsb, SEQ, jn * 64, tid); }
            const bool s0 = (sm[0] >> j) & 1ull, s1 = (sm[1] >> j) & 1ull;
            if (j <= cur - 3) nsa_tile<1>(O, L, qf, lds, it & 1, j * 64, s0, s1, lane);
            else nsa_tile<2>(O, L, qf, lds, it & 1, j * 64, s0, s1, lane);
            if (jn < 0) break;
            j = jn; ++it;
        }
    }
    { const float gg[2] = {gates[0][1], gates[1][1]}; nsa_flush(Y, O, L, gg); }
    const bf16_t* kwb = pbat + C_KW + g * 64; const bf16_t* vwb = c.VT + ((size_t)1 * 16 + bg) * 64 * SEQ;
    L.m[0] = L.m[1] = -INFINITY; L.l[0] = L.l[1] = 0.f;
    {
        const int j0 = (cur - 8 > 0) ? cur - 8 : 0;
        __syncthreads();
        nsa_prefetch(rk, rv, kwb, IN_COLS, vwb, SEQ, j0 * 64, tid);
        for (int j = j0; j <= cur; ++j) {
            nsa_store(lds, (j - j0) & 1, rk, rv, tid);
            __syncthreads();
            if (j + 1 <= cur) nsa_prefetch(rk, rv, kwb, IN_COLS, vwb, SEQ, (j + 1) * 64, tid);
            if (cur - j >= 3 && cur - j <= 7) nsa_tile<1>(O, L, qf, lds, (j - j0) & 1, j * 64, true, true, lane);
            else nsa_tile<3>(O, L, qf, lds, (j - j0) & 1, j * 64, true, true, lane);
        }
    }
    { const float gg[2] = {gates[0][2], gates[1][2]}; nsa_flush(Y, O, L, gg); }
#pragma unroll
    for (int qi = 0; qi < 2; ++qi) {
        bf16_t* yrow = c.PROJ + ((size_t)b * SEQ + L.tq[qi]) * IN_COLS + C_Q + (g * 4 + L.h) * 64;
#pragma unroll
        for (int dt = 0; dt < 4; ++dt) store_bf4(yrow + 16 * dt + 4 * qd, Y[qi][dt]);
    }
}
DI void phase_mix(const Ctx& c, unsigned char* lds) {
    const int G = gridDim.x, bid = blockIdx.x;
    const int n_nsa = NB * 4 * (SEQ / 64), n_scan = NB * 8 * 4;
    const bool split = G >= 2 * n_scan;
    if (split) { if (bid < n_scan) scan_item(c, bid, lds); }
    else for (int item = bid; item < n_scan; item += G) scan_item(c, item, lds);
    unsigned* ctr = c.ctl + CW_Q + c.l;
    volatile int* sitem = (volatile int*)(lds + LDS_BYTES - 32);
    for (;;) {
        __syncthreads();
        if (TID() == 0) *sitem = (int)atomicAdd(ctr, 1u);
        __syncthreads();
        const int k = *sitem;
        if (k >= n_nsa) break;
        const int qt = 63 - (k >> 4), bgi = k & 15;
        nsa_item(c, (bgi << 6) | qt, lds);
    }
}

DI void phase_merge(const Ctx& c, unsigned char* lds) {
    const int nM = NT / 256, nN = DM / 128;
    const bf16_t* WM = (const bf16_t*)(c.ws + WS_WT_MG);
    const bf16_t* BR = (const bf16_t*)(c.ws + WS_WT_BR);
    const float* BM_ = c.in(I_BMG) + (size_t)c.l * 3 * DM;
    bf16_t* TMP = c.YRAW + (size_t)blockIdx.x * 256 * 128;
    for (int tile = blockIdx.x; tile < nM * nN; tile += gridDim.x) {
        const int tm = tile % nM, tn = tile / nM, m0 = tm * 256, n0 = tn * 128;
#pragma unroll 1
        for (int i = 0; i < 3; ++i) {
            {
                f32x4 ag[4][4]; acc_zero(ag);
                const ARows ar = plain_rows(c.H, DM, m0, TID());
                gemm_core<0>(ag, ar, WM + (size_t)(i * DM + n0) * DM, DM, DM, lds);
                ACC_FOREACH(ag, { const f32x4 bb = *(const f32x4*)(BM_ + i * DM + n0 + c_);
                    store_bf4(TMP + r_ * 128 + c_, (f32x4){sigmoidf_(v_[0] + bb[0]), sigmoidf_(v_[1] + bb[1]), sigmoidf_(v_[2] + bb[2]), sigmoidf_(v_[3] + bb[3])}); });
            }
            f32x4 ab[4][4]; acc_zero(ab);
            if (i == 0) { const ARows ar = plain_rows(c.POOLED, 512, m0, TID()); gemm_core<0>(ab, ar, BR + (size_t)n0 * 512, 512, 512, lds); }
            else if (i == 1) { const ARows ar = plain_rows(c.F + (size_t)5 * NT * 512, 512, m0, TID()); gemm_core<0>(ab, ar, BR + (size_t)1024 * 512 + (size_t)n0 * 512, 512, 512, lds); }
            else { const ARows ar = plain_rows(c.PROJ + C_Q, IN_COLS, m0, TID()); gemm_core<0>(ab, ar, BR + (size_t)2048 * 512 + (size_t)n0 * 1024, 1024, 1024, lds); }
            ACC_FOREACH(ab, {
                bf16_t* q = c.MERGED + (size_t)(m0 + r_) * DM + n0 + c_;
                const u32x2 gv = *(const u32x2*)(TMP + r_ * 128 + c_);
                f32x4 m4 = ((f32x4){0.f, 0.f, 0.f, 0.f});
                if (i > 0) { const u32x2 pv = *(const u32x2*)q; m4 = ((f32x4){bflo(pv.x), bfhi(pv.x), bflo(pv.y), bfhi(pv.y)}); }
                m4[0] += bflo(gv.x) * v_[0]; m4[1] += bfhi(gv.x) * v_[1]; m4[2] += bflo(gv.y) * v_[2]; m4[3] += bfhi(gv.y) * v_[3];
                store_bf4(q, m4); });
        }
    }
}

DI void phase_outp(const Ctx& c, unsigned char* lds) {
    const int nM = NT / 256, nN = DM / 128;
    const bf16_t* W = (const bf16_t*)(c.ws + WS_WT_OUT);
    const float* xin = (c.l == 0) ? c.in(I_X) : c.out;
    for (int tile = blockIdx.x; tile < nM * nN; tile += gridDim.x) {
        const int tm = tile % nM, tn = tile / nM, m0 = tm * 256, n0 = tn * 128;
        f32x4 acc[4][4]; acc_zero(acc);
        const ARows ar = plain_rows(c.MERGED, DM, m0, TID());
        gemm_core<0>(acc, ar, W + (size_t)n0 * DM, DM, DM, lds);
        ACC_FOREACH(acc, { const size_t o = (size_t)(m0 + r_) * DM + n0 + c_; const f32x4 x = *(const f32x4*)(xin + o); *(f32x4*)(c.out + o) = x + v_; });
    }
    for (int it = blockIdx.x; it < 3 * 32 * 64; it += gridDim.x) {
        const int mat = it / 2048, e = (it >> 6) & 31, tl = it & 63;
        if (mat == 0) convert_tile(c.in(I_EG) + ((size_t)c.l * 32 + e) * DM * 256, 256, 256, DM, (bf16_t*)(c.ws + WS_EG) + (size_t)e * 256 * DM, tl, lds);
        else if (mat == 1) convert_tile(c.in(I_EU) + ((size_t)c.l * 32 + e) * DM * 256, 256, 256, DM, (bf16_t*)(c.ws + WS_EU) + (size_t)e * 256 * DM, tl, lds);
        else convert_tile(c.in(I_ED) + ((size_t)c.l * 32 + e) * 256 * DM, DM, DM, 256, (bf16_t*)(c.ws + WS_ED) + (size_t)e * DM * 256, tl, lds);
    }
}

DI void phase_norm2(const Ctx& c) {
    const int tid = TID(), lane = tid & 63, wave = tid >> 6;
    const float* gain = c.in(I_NFFN) + c.l * DM;
    const float* wrg = c.in(I_WRG) + (size_t)c.l * DM * 4; const float* brg = c.in(I_BRG) + c.l * 4;
    const float* wre = c.in(I_WRE) + (size_t)c.l * DM * 32; const float* bre = c.in(I_BRE) + c.l * 32;
    unsigned* cnt = c.ctl + CW_CNT + c.l * 32;
    for (int row = blockIdx.x * 8 + wave; row < NT; row += gridDim.x * 8) {
        f32x4 v[4];
        float ss = 0.f;
#pragma unroll
        for (int i = 0; i < 4; ++i) { v[i] = *(const f32x4*)(c.out + (size_t)row * DM + i * 256 + lane * 4); ss += v[i][0] * v[i][0] + v[i][1] * v[i][1] + v[i][2] * v[i][2] + v[i][3] * v[i][3]; }
        ss = wave_sum(ss);
        const float rs = rsqrtf(ss * (1.0f / DM) + 1e-6f);
#pragma unroll
        for (int i = 0; i < 4; ++i) {
            const f32x4 g = *(const f32x4*)(gain + i * 256 + lane * 4);
            v[i] = (f32x4){v[i][0] * rs * g[0], v[i][1] * rs * g[1], v[i][2] * rs * g[2], v[i][3] * rs * g[3]};
            store_bf4(c.H + (size_t)row * DM + i * 256 + lane * 4, v[i]);
        }
        float lgp[4] = {0.f, 0.f, 0.f, 0.f};
#pragma unroll
        for (int i = 0; i < 4; ++i)
#pragma unroll
            for (int j = 0; j < 4; ++j) { const f32x4 w = *(const f32x4*)(wrg + (size_t)(i * 256 + lane * 4 + j) * 4); lgp[0] += v[i][j] * w[0]; lgp[1] += v[i][j] * w[1]; lgp[2] += v[i][j] * w[2]; lgp[3] += v[i][j] * w[3]; }
#pragma unroll
        for (int o = 0; o < 4; ++o) lgp[o] = wave_sum(lgp[o]) + brg[o];
        int grp = 0; float gm = lgp[0];
#pragma unroll
        for (int o = 1; o < 4; ++o) if (lgp[o] > gm) { gm = lgp[o]; grp = o; }
        float gs = 0.f;
#pragma unroll
        for (int o = 0; o < 4; ++o) gs += __expf(lgp[o] - gm);
        const float ptop = 1.0f / gs;
        float le[8] = {0.f, 0.f, 0.f, 0.f, 0.f, 0.f, 0.f, 0.f};
#pragma unroll
        for (int i = 0; i < 4; ++i)
#pragma unroll
            for (int j = 0; j < 4; ++j) {
                const float* wp = wre + (size_t)(i * 256 + lane * 4 + j) * 32 + grp * 8;
                const f32x4 w0 = *(const f32x4*)wp, w1 = *(const f32x4*)(wp + 4);
                le[0] += v[i][j] * w0[0]; le[1] += v[i][j] * w0[1]; le[2] += v[i][j] * w0[2]; le[3] += v[i][j] * w0[3];
                le[4] += v[i][j] * w1[0]; le[5] += v[i][j] * w1[1]; le[6] += v[i][j] * w1[2]; le[7] += v[i][j] * w1[3];
            }
#pragma unroll
        for (int o = 0; o < 8; ++o) le[o] = wave_sum(le[o]) + bre[grp * 8 + o];
        int i0 = 0; float v0 = le[0];
#pragma unroll
        for (int o = 1; o < 8; ++o) if (le[o] > v0) { v0 = le[o]; i0 = o; }
        int i1 = -1; float v1 = -INFINITY;
#pragma unroll
        for (int o = 0; o < 8; ++o) if (o != i0 && le[o] > v1) { v1 = le[o]; i1 = o; }
        const float e1 = __expf(v1 - v0), inv = 1.0f / (1.0f + e1);
        if (lane == 0) {
            int* rt = c.ROUTE + (size_t)row * 8;
            const int ex0 = grp * 8 + i0, ex1 = grp * 8 + i1;
            rt[0] = ex0; rt[1] = ex1; ((float*)rt)[2] = inv * ptop; ((float*)rt)[3] = e1 * inv * ptop;
            atomicAdd(cnt + ex0, 1u); atomicAdd(cnt + ex1, 1u);
        }
    }
}
DI void phase_route2(const Ctx& c, unsigned char* lds) {
    int* soff = (int*)lds;
    const unsigned* cnt = c.ctl + CW_CNT + c.l * 32;
    unsigned* cur = c.ctl + CW_CUR + c.l * 32;
    __syncthreads();
    if (TID() == 0) { int s = 0; for (int e = 0; e < 32; ++e) { soff[e] = s; s += (int)cnt[e]; } }
    __syncthreads();
    for (int t = blockIdx.x * NTHREADS + TID(); t < NT; t += gridDim.x * NTHREADS) {
        int* rt = c.ROUTE + (size_t)t * 8;
#pragma unroll
        for (int s = 0; s < 2; ++s) {
            const int e = rt[s];
            const int p = soff[e] + (int)atomicAdd(cur + e, 1u);
            rt[4 + s] = p;
            c.ENT[2 * p] = t; ((float*)c.ENT)[2 * p + 1] = ((const float*)rt)[2 + s];
        }
    }
}
DI void moe_tables(const Ctx& c, int* soff, int* stile, int ncol) {
    const unsigned* cnt = c.ctl + CW_CNT + c.l * 32;
    __syncthreads();
    if (TID() == 0) { int s = 0, tt = 0; for (int e = 0; e < 32; ++e) { soff[e] = s; stile[e] = tt; s += (int)cnt[e]; tt += (((int)cnt[e] + 255) >> 8) * ncol; } soff[32] = s; stile[32] = tt; }
    __syncthreads();
}
DI void phase_moe_up(const Ctx& c, unsigned char* lds) {
    int* soff = (int*)(lds + 2 * G_STAGE); int* stile = soff + 64;
    moe_tables(c, soff, stile, 2);
    const int total = stile[32];
    for (int item = blockIdx.x; item < total; item += gridDim.x) {
        int e = 0;
        for (int q = 1; q < 32; ++q) if (stile[q] <= item) e = q;
        const int loc = item - stile[e], tm = loc >> 1, tn = loc & 1, n0 = tn * 128;
        const int p0 = soff[e] + tm * 256, pend = soff[e + 1];
        ARows ar;
#pragma unroll
        for (int i = 0; i < 4; ++i) { const int pr = p0 + (TID() >> 3) + 64 * i; ar.p[i] = (pr < pend) ? c.H + (size_t)c.ENT[2 * pr] * DM : nullptr; }
        {
            f32x4 ag[4][4]; acc_zero(ag);
            gemm_core<0>(ag, ar, (const bf16_t*)(c.ws + WS_EG) + ((size_t)e * 256 + n0) * DM, DM, DM, lds);
            ACC_FOREACH(ag, { if (p0 + r_ < pend) store_bf4(c.HID + (size_t)(p0 + r_) * 256 + n0 + c_, (f32x4){v_[0] * sigmoidf_(v_[0]), v_[1] * sigmoidf_(v_[1]), v_[2] * sigmoidf_(v_[2]), v_[3] * sigmoidf_(v_[3])}); });
        }
        f32x4 au[4][4]; acc_zero(au);
        gemm_core<0>(au, ar, (const bf16_t*)(c.ws + WS_EU) + ((size_t)e * 256 + n0) * DM, DM, DM, lds);
        ACC_FOREACH(au, { if (p0 + r_ < pend) { bf16_t* q = c.HID + (size_t)(p0 + r_) * 256 + n0 + c_; const u32x2 sv = *(const u32x2*)q;
            store_bf4(q, (f32x4){bflo(sv.x) * v_[0], bfhi(sv.x) * v_[1], bflo(sv.y) * v_[2], bfhi(sv.y) * v_[3]}); } });
    }
}
DI void phase_moe_down(const Ctx& c, unsigned char* lds) {
    int* soff = (int*)(lds + 2 * G_STAGE); int* stile = soff + 64;
    moe_tables(c, soff, stile, 8);
    const int total = stile[32];
    for (int item = blockIdx.x; item < total; item += gridDim.x) {
        int e = 0;
        for (int q = 1; q < 32; ++q) if (stile[q] <= item) e = q;
        const int loc = item - stile[e], tm = loc >> 3, tn = loc & 7, n0 = tn * 128;
        const int p0 = soff[e] + tm * 256, pend = soff[e + 1];
        ARows ar;
#pragma unroll
        for (int i = 0; i < 4; ++i) { const int pr = p0 + (TID() >> 3) + 64 * i; ar.p[i] = (pr < pend) ? c.HID + (size_t)pr * 256 : nullptr; }
        f32x4 acc[4][4]; acc_zero(acc);
        gemm_core<0>(acc, ar, (const bf16_t*)(c.ws + WS_ED) + ((size_t)e * DM + n0) * 256, 256, 256, lds);
        ACC_FOREACH(acc, { if (p0 + r_ < pend) { const float w = ((const float*)c.ENT)[2 * (p0 + r_) + 1];
            store_bf4(c.Y + (size_t)(p0 + r_) * DM + n0 + c_, (f32x4){v_[0] * w, v_[1] * w, v_[2] * w, v_[3] * w}); } });
    }
}
DI void phase_final(const Ctx& c) {
    const int tid = TID(), lane = tid & 63, wave = tid >> 6;
    const float* gain = c.in(I_NFIN);
    for (int row = blockIdx.x * 8 + wave; row < NT; row += gridDim.x * 8) {
        f32x4 v[4];
#pragma unroll
        for (int i = 0; i < 4; ++i) v[i] = *(const f32x4*)(c.out + (size_t)row * DM + i * 256 + lane * 4);
        add_moe_rows(c, row, lane, v);
        float ss = 0.f;
#pragma unroll
        for (int i = 0; i < 4; ++i) ss += v[i][0] * v[i][0] + v[i][1] * v[i][1] + v[i][2] * v[i][2] + v[i][3] * v[i][3];
        ss = wave_sum(ss);
        const float rs = rsqrtf(ss * (1.0f / DM) + 1e-6f);
#pragma unroll
        for (int i = 0; i < 4; ++i) {
            const f32x4 g = *(const f32x4*)(gain + i * 256 + lane * 4);
            *(f32x4*)(c.out + (size_t)row * DM + i * 256 + lane * 4) = (f32x4){v[i][0] * rs * g[0], v[i][1] * rs * g[1], v[i][2] * rs * g[2], v[i][3] * rs * g[3]};
        }
    }
}

constexpr int PH_PER_LAYER = 12, N_PHASES = DEPTH * PH_PER_LAYER + 1;
__global__ void __launch_bounds__(NTHREADS, 2) fwd_kernel(Params P) {
    extern __shared__ __attribute__((aligned(16))) unsigned char lds[];
    const int lo = P.ph_lo, hi = P.ph_hi;
    LAS unsigned* xbw = (LAS unsigned*)(lds + LDS_BYTES - 16);
    if (threadIdx.x == 0) { xbw[0] = 0u; xbw[1] = 0u; xbw[2] = 0u; xbw[3] = 0u; }
    __syncthreads();
    Ctx c; c.P = &P; c.ws = P.ws; c.out = P.out; c.l = 0;
    c.ctl = (unsigned*)(P.ws + WS_CTL);
    c.H = (bf16_t*)(P.ws + WS_H); c.PROJ = (bf16_t*)(P.ws + WS_PROJ); c.F = (bf16_t*)(P.ws + WS_F); c.POOLED = (bf16_t*)(P.ws + WS_POOLED);
    c.MERGED = (bf16_t*)(P.ws + WS_F); c.CMPH = (bf16_t*)(P.ws + WS_CMPH); c.CMPO = (float*)(P.ws + WS_CMPO); c.POSB = (float*)(P.ws + WS_POSB);
    c.ROUTE = (int*)(P.ws + WS_ROUTE); c.ENT = (int*)(P.ws + WS_ENT); c.HID = (bf16_t*)(P.ws + WS_HID); c.Y = (bf16_t*)(P.ws + WS_Y);
    c.VT = (bf16_t*)(P.ws + WS_VT); c.KC = (bf16_t*)(P.ws + WS_KC); c.VCT = (bf16_t*)(P.ws + WS_VCT); c.YRAW = (bf16_t*)(P.ws + WS_YRAW); c.BON = (float*)(P.ws + WS_BON);
    XcdBarrier bar; bar.bar = c.ctl + CW_BAR; bar.x = 0; bar.st = (volatile LAS unsigned*)xbw;
    if (hi - lo > 1) bar = xcd_barrier_post(c.ctl + CW_BAR, (volatile LAS unsigned*)xbw);
#define IN(k) (lo <= (k) && (k) < hi)
#define SEAM(k) do { if (IN(k) && IN((k) + 1)) xcd_barrier(bar); } while (0)
#pragma unroll 1
    for (int l = 0; l < DEPTH; ++l) {
        c.l = l; const int pb = l * PH_PER_LAYER;
        if (IN(pb + 0)) phase_norm1(c, lds);
        SEAM(pb + 0);
        if (IN(pb + 1)) phase_gemm1(c, lds);
        SEAM(pb + 1);
        if (IN(pb + 2)) phase_prep(c, lds);
        SEAM(pb + 2);
        if (IN(pb + 3)) phase_poolgemm(c, lds);
        SEAM(pb + 3);
        if (IN(pb + 4)) phase_mix(c, lds);
        SEAM(pb + 4);
        if (IN(pb + 5)) phase_rwkv_post(c, lds);
        SEAM(pb + 5);
        if (IN(pb + 6)) phase_merge(c, lds);
        SEAM(pb + 6);
        if (IN(pb + 7)) phase_outp(c, lds);
        SEAM(pb + 7);
        if (IN(pb + 8)) phase_norm2(c);
        SEAM(pb + 8);
        if (IN(pb + 9)) phase_route2(c, lds);
        SEAM(pb + 9);
        if (IN(pb + 10)) phase_moe_up(c, lds);
        SEAM(pb + 10);
        if (IN(pb + 11)) phase_moe_down(c, lds);
        SEAM(pb + 11);
    }
    if (IN(N_PHASES - 1)) phase_final(c);
}

#ifndef MK_N_LAUNCHES
#define MK_N_LAUNCHES 1
#endif
extern "C" void kernel_launch(void* const* d_in, const int* in_sizes, int n_in, void* d_out, int out_size, void* d_ws, size_t ws_size, hipStream_t stream) {
    static int grid = 0;
    if (grid == 0) {
        if (n_in != N_IN || out_size != NT * DM || ws_size < WS_END) { fprintf(stderr, "kernel_launch: unexpected shapes n_in %d out %d ws %zu (need %zu)\n", n_in, out_size, ws_size, (size_t)WS_END); grid = -1; return; }
        int dev = 0, cus = 0, per_cu = 0;
        if (hipGetDevice(&dev) != hipSuccess || hipDeviceGetAttribute(&cus, hipDeviceAttributeMultiprocessorCount, dev) != hipSuccess) { grid = -1; return; }
        if (hipFuncSetAttribute((const void*)fwd_kernel, hipFuncAttributeMaxDynamicSharedMemorySize, LDS_BYTES) != hipSuccess) { fprintf(stderr, "kernel_launch: hipFuncSetAttribute failed\n"); grid = -1; return; }
        if (hipOccupancyMaxActiveBlocksPerMultiprocessor(&per_cu, (const void*)fwd_kernel, NTHREADS, LDS_BYTES) != hipSuccess || per_cu < 1) { fprintf(stderr, "kernel_launch: occupancy query says %d\n", per_cu); }
        (void)hipGetLastError();
        grid = cus;
    }
    if (grid < 0) return;
    if (hipMemsetAsync((char*)d_ws + WS_CTL, 0, CTL_BYTES, stream) != hipSuccess) return;
    Params p{};
    for (int i = 0; i < N_IN; ++i) p.in[i] = (const float*)d_in[i];
    p.out = (float*)d_out; p.ws = (unsigned char*)d_ws;
    if (MK_N_LAUNCHES == 1) {
        p.ph_lo = 0; p.ph_hi = N_PHASES;
        hipLaunchKernelGGL(fwd_kernel, dim3(grid), dim3(NTHREADS), LDS_BYTES, stream, p);
    } else {
        for (int k = 0; k < N_PHASES; ++k) { p.ph_lo = k; p.ph_hi = k + 1; hipLaunchKernelGGL(fwd_kernel, dim3(grid), dim3(NTHREADS), LDS_BYTES, stream, p); }
    }
}
```

```cpp
#include <hip/hip_runtime.h>
#include <cstdio>
#include <cstdint>

#define DI __device__ __forceinline__
typedef unsigned short bf16_t;
typedef short bf16x8 __attribute__((ext_vector_type(8)));
typedef float f32x4 __attribute__((ext_vector_type(4)));
typedef unsigned u32x4 __attribute__((ext_vector_type(4)));
typedef unsigned u32x2 __attribute__((ext_vector_type(2)));

constexpr int NB = 4, SEQ = 4096, DM = 1024, NT = NB * SEQ, DEPTH = 2;
constexpr int IN_COLS = 4816;
constexpr int C_POOL = 0, C_RW = 512, C_R = 512, C_K = 1024, C_V = 1536, C_WD = 2048, C_AD = 2080, C_GD = 2112;
constexpr int C_Q = 2208, C_KC = 3232, C_VC = 3488, C_KS = 3744, C_VS = 4000, C_KW = 4256, C_VW = 4512, C_GATE = 4768;
constexpr int RWC = 1696;
constexpr int NCMP = 255;
constexpr int NTHREADS = 512;
constexpr int LDS_BYTES = 114688;

enum { I_X = 0, I_RELB, I_NMIX, I_WIN, I_POOLW, I_POOLS, I_MU, I_W0, I_WUP, I_A0, I_AUP, I_GUP, I_KK, I_KA, I_RK, I_GNW, I_GNB,
       I_CPK, I_CW1K, I_CW2K, I_CPV, I_CW1V, I_CW2V, I_WBR, I_WMG, I_BMG, I_WOUT, I_NFFN, I_WRG, I_BRG, I_WRE, I_BRE, I_EG, I_EU, I_ED, I_NFIN, N_IN };

constexpr size_t WS_CTL = 0;
constexpr size_t CTL_BYTES = 65536;
constexpr size_t WS_H = CTL_BYTES;
constexpr size_t WS_PROJ = WS_H + (size_t)NT * DM * 2;
constexpr size_t WS_F = WS_PROJ + (size_t)NT * IN_COLS * 2;
constexpr size_t PLANE = (size_t)NT * 512 * 2;
constexpr size_t WS_POOLED = WS_F + 6 * PLANE;
constexpr size_t WS_CMPH = WS_POOLED + PLANE;
constexpr size_t WS_CMPO = WS_CMPH + (size_t)2 * 4096 * 256 * 2;
constexpr size_t WS_POSB = WS_CMPO + (size_t)2 * 4096 * 64 * 4;
constexpr size_t WS_ROUTE = WS_POSB + 4096;
constexpr size_t WS_ENT = WS_ROUTE + (size_t)NT * 32;
constexpr size_t WS_VT = WS_ENT + (size_t)2 * NT * 8;
constexpr size_t WS_KC = WS_VT + (size_t)2 * 16 * 64 * SEQ * 2;
constexpr size_t WS_VCT = WS_KC + (size_t)16 * 256 * 64 * 2;
constexpr size_t WS_YRAW = WS_VCT + (size_t)16 * 64 * 256 * 2;
constexpr size_t WS_BON = WS_YRAW + (size_t)NT * 512 * 2;
constexpr size_t WS_SMALLW = WS_BON + (size_t)NT * 8 * 16;
constexpr size_t WS_END = WS_SMALLW + 262144;
constexpr size_t WS_WT_IN = WS_F;
constexpr size_t WS_WT_C1 = WS_CMPO;
constexpr size_t WS_WT_C2 = WS_SMALLW;
constexpr size_t WS_WT_POOL = WS_SMALLW + 131072;
constexpr size_t WS_WT_MG = WS_VT;
constexpr size_t WS_WT_BR = WS_VT + (size_t)3072 * 1024 * 2;
constexpr size_t WS_WT_OUT = WS_CMPH;
constexpr size_t WS_EG = WS_F + 2 * PLANE;
constexpr size_t WS_EU = WS_EG + (size_t)32 * 256 * 1024 * 2;
constexpr size_t WS_ED = WS_EU + (size_t)32 * 256 * 1024 * 2;
static_assert(WS_ED + (size_t)32 * 1024 * 256 * 2 <= WS_F + 6 * PLANE, "expert alias");
static_assert(WS_WT_BR + (size_t)2048 * 1024 * 2 <= WS_VT + (size_t)2 * 16 * 64 * SEQ * 2, "merge alias");
static_assert((size_t)4864 * 1024 * 2 <= 6 * PLANE, "w_in alias");
constexpr size_t WS_HID = WS_PROJ;
constexpr size_t WS_Y = WS_PROJ + (size_t)2 * NT * 256 * 2;
static_assert(WS_Y + (size_t)2 * NT * 1024 * 2 <= WS_F, "alias");
constexpr int CW_BAR = 0;
constexpr int CW_CNT = 4096;
constexpr int CW_CUR = 4096 + 64;
constexpr int CW_Q = 4096 + 128;

#define XB_TMO      128
#define XB_XCNT(j)  (256  + 64 * (j))
#define XB_XSUB(j)  (1280 + 64 * (j))
#define XB_XGEN(j)  (2304 + 64 * (j))
#define XB_TOP      3328
#define XB_TOPGEN   3392
#define XCD_BAR_WORDS 3456
#define XB_SPIN_CAP (1u << 18)
#define LAS __attribute__((address_space(3)))

__device__ __forceinline__ unsigned xb_ld(unsigned* p)              { return __hip_atomic_load(p, __ATOMIC_RELAXED, __HIP_MEMORY_SCOPE_AGENT); }
__device__ __forceinline__ unsigned xb_add(unsigned* p, unsigned v) { return __hip_atomic_fetch_add(p, v, __ATOMIC_RELAXED, __HIP_MEMORY_SCOPE_AGENT); }
__device__ __forceinline__ unsigned xb_xcc_id() { return (unsigned)__builtin_amdgcn_s_getreg((3 << 11) | 20) & 0xFu; }
#define XB_SPIN(cond, bar) do { unsigned _sp = 0; while (cond) { __builtin_amdgcn_s_sleep(1); \
    if ((++_sp & 255u) == 0u) { if (xb_ld(&(bar)[XB_TMO])) break; if (_sp > XB_SPIN_CAP) { atomicAdd(&(bar)[XB_TMO], 1u); break; } } } } while (0)

struct XcdBarrier { unsigned* bar; unsigned x; volatile LAS unsigned* st; };

__device__ __forceinline__ XcdBarrier xcd_barrier_post(unsigned* bar, volatile LAS unsigned* st) {
    XcdBarrier b; b.bar = bar; b.x = xb_xcc_id(); b.st = st;
    if (threadIdx.x == 0) (void)xb_add(&bar[XB_XCNT(b.x)], 1u);
    return b;
}
__device__ __forceinline__ void xcd_barrier_complete(unsigned* bar, unsigned x, unsigned& nloc, unsigned& nx) {
    const unsigned G = gridDim.x * gridDim.y * gridDim.z;
    unsigned sum, cnt, mine, sp = 0u;
    for (;;) {
        sum = 0u; cnt = 0u; mine = 0u;
#pragma unroll
        for (unsigned j = 0; j < 16; ++j) { const unsigned c = xb_ld(&bar[XB_XCNT(j)]); sum += c; cnt += (c > 0u) ? 1u : 0u; mine = (j == x) ? c : mine; }
        if (sum == G) break;
        __builtin_amdgcn_s_sleep(1);
        if ((++sp & 255u) == 0u) { if (xb_ld(&bar[XB_TMO])) break; if (sp > XB_SPIN_CAP) { atomicAdd(&bar[XB_TMO], 1u); break; } }
    }
    nloc = mine > 0u ? mine : 1u; nx = cnt > 0u ? cnt : 1u;
}
__device__ __forceinline__ void xcd_barrier(const XcdBarrier& b) {
    asm volatile("s_waitcnt vmcnt(0)" ::: "memory");
    __syncthreads();
    if (threadIdx.x == 0) {
        unsigned* bar = b.bar;
        __builtin_amdgcn_s_waitcnt(0);
        unsigned nloc = b.st[0], nx = b.st[1];
        if (nloc == 0u) { xcd_barrier_complete(bar, b.x, nloc, nx); b.st[0] = nloc; b.st[1] = nx; }
        const unsigned old = xb_add(&bar[XB_XSUB(b.x)], 1u);
        const unsigned gen = old / nloc;
        if (old + 1u == (gen + 1u) * nloc) {
            __builtin_amdgcn_fence(__ATOMIC_RELEASE, "agent");
            asm volatile("s_waitcnt vmcnt(0)" ::: "memory");
            const unsigned og = xb_add(&bar[XB_TOP], 1u);
            const unsigned tg = og / nx;
            if (og + 1u == (tg + 1u) * nx) xb_add(&bar[XB_TOPGEN], 1u);
            else XB_SPIN(xb_ld(&bar[XB_TOPGEN]) == tg, bar);
            __builtin_amdgcn_fence(__ATOMIC_ACQUIRE, "agent");
            xb_add(&bar[XB_XGEN(b.x)], 1u);
            asm volatile("s_waitcnt vmcnt(0)" ::: "memory");
        } else {
            XB_SPIN(xb_ld(&bar[XB_XGEN(b.x)]) == gen, bar);
            __builtin_amdgcn_fence(__ATOMIC_ACQUIRE, "agent");
            asm volatile("s_waitcnt vmcnt(0)" ::: "memory");
        }
    }
    __syncthreads();
}

DI bf16_t f2bf(float x) { unsigned u = __float_as_uint(x); u += 0x7fffu + ((u >> 16) & 1u); return (bf16_t)(u >> 16); }
DI float bf2f(bf16_t b) { return __uint_as_float((unsigned)b << 16); }
DI unsigned pack2(float lo, float hi) { unsigned r; asm("v_cvt_pk_bf16_f32 %0, %1, %2" : "=v"(r) : "v"(lo), "v"(hi)); return r; }
DI float bflo(unsigned w) { return __uint_as_float(w << 16); }
DI float bfhi(unsigned w) { return __uint_as_float(w & 0xffff0000u); }
DI float wave_sum(float v) {
#pragma unroll
    for (int o = 32; o >= 1; o >>= 1) v += __shfl_xor(v, o);
    return v;
}
DI float wave_max(float v) {
#pragma unroll
    for (int o = 32; o >= 1; o >>= 1) v = fmaxf(v, __shfl_xor(v, o));
    return v;
}
DI float sigmoidf_(float x) { return __builtin_amdgcn_rcpf(1.0f + __expf(-x)); }
DI int TID() { int t = threadIdx.x; asm volatile("" : "+v"(t)); return t; }
#define LDS_WAVE_SYNC() asm volatile("s_waitcnt lgkmcnt(0)" ::: "memory")

#define DPP_MOV(v, ctrl) __builtin_bit_cast(float, __builtin_amdgcn_update_dpp(0, __builtin_bit_cast(int, (v)), (ctrl), 0xF, 0xF, true))
DI float wave_sum_dpp(float v) {
    v += DPP_MOV(v, 0xB1); v += DPP_MOV(v, 0x4E); v += DPP_MOV(v, 0x141); v += DPP_MOV(v, 0x140);
    return __builtin_bit_cast(float, __builtin_amdgcn_readlane(__builtin_bit_cast(int, v), 0)) + __builtin_bit_cast(float, __builtin_amdgcn_readlane(__builtin_bit_cast(int, v), 16)) +
        (__builtin_bit_cast(float, __builtin_amdgcn_readlane(__builtin_bit_cast(int, v), 32)) + __builtin_bit_cast(float, __builtin_amdgcn_readlane(__builtin_bit_cast(int, v), 48)));
}
struct Params { const float* in[N_IN]; float* out; unsigned char* ws; int ph_lo, ph_hi; };

DI int t5_bucket(int n) {
    if (n < 16) return n;
    if (n >= 128) return 31;
    int b = 16;
    b += (n >= 19) + (n >= 21) + (n >= 24) + (n >= 27) + (n >= 31) + (n >= 35) + (n >= 40) + (n >= 46) + (n >= 52) + (n >= 59) + (n >= 67) + (n >= 77) + (n >= 87) + (n >= 99) + (n >= 113);
    return b;
}

constexpr int GS = 72;
constexpr int G_A = 0, G_B = 256 * GS * 2, G_STAGE = (256 + 128) * GS * 2;
static_assert(2 * G_STAGE <= LDS_BYTES - 64, "gemm lds");
struct ARows { const bf16_t* p[4]; };
template <int AMODE>
DI void g_load(u32x4 (&ra)[4], u32x4 (&rb)[2], const ARows& ar, const bf16_t* bt, int ldb, int k0, int tid) {
    const int kseg = (tid & 7) * 8;
#pragma unroll
    for (int i = 0; i < 4; ++i) {
        ra[i] = (u32x4){0u, 0u, 0u, 0u};
        if (ar.p[i] != nullptr) ra[i] = *(const u32x4*)((AMODE == 0) ? (ar.p[i] + k0 + kseg) : (ar.p[i] + (size_t)(k0 >> 6) * IN_COLS + kseg));
    }
#pragma unroll
    for (int i = 0; i < 2; ++i) rb[i] = *(const u32x4*)(bt + (size_t)((tid >> 3) + 64 * i) * ldb + k0 + kseg);
}
DI void g_store(unsigned char* st, const u32x4 (&ra)[4], const u32x4 (&rb)[2], int tid) {
    const int r = tid >> 3, kseg = (tid & 7) * 8;
#pragma unroll
    for (int i = 0; i < 4; ++i) *(u32x4*)((bf16_t*)(st + G_A) + (r + 64 * i) * GS + kseg) = ra[i];
#pragma unroll
    for (int i = 0; i < 2; ++i) *(u32x4*)((bf16_t*)(st + G_B) + (r + 64 * i) * GS + kseg) = rb[i];
}
DI void g_compute(f32x4 (&acc)[4][4], const unsigned char* st, int lane, int wm, int wn) {
    const bf16_t* sA = (const bf16_t*)(st + G_A) + (wm * 64 + (lane & 15)) * GS + (lane >> 4) * 8;
    const bf16_t* sB = (const bf16_t*)(st + G_B) + (wn * 64 + (lane & 15)) * GS + (lane >> 4) * 8;
#pragma unroll
    for (int ks = 0; ks < 2; ++ks) {
        bf16x8 af[4], bfr[4];
#pragma unroll
        for (int i = 0; i < 4; ++i) { af[i] = *(const bf16x8*)(sA + i * 16 * GS + ks * 32); bfr[i] = *(const bf16x8*)(sB + i * 16 * GS + ks * 32); }
#pragma unroll
        for (int mi = 0; mi < 4; ++mi)
#pragma unroll
            for (int ni = 0; ni < 4; ++ni) acc[mi][ni] = __builtin_amdgcn_mfma_f32_16x16x32_bf16(bfr[ni], af[mi], acc[mi][ni], 0, 0, 0);
    }
}
template <int AMODE>
DI void gemm_core(f32x4 (&acc)[4][4], const ARows& ar, const bf16_t* bt  , int ldb, int K, unsigned char* lds) {
    const int tid = TID(), lane = tid & 63, wave = tid >> 6, wm = wave >> 1, wn = wave & 1;
    const int nk = K >> 6;
    unsigned char* s0 = lds; unsigned char* s1 = lds + G_STAGE;
    u32x4 ra0[4], rb0[2], ra1[4], rb1[2];
    g_load<AMODE>(ra0, rb0, ar, bt, ldb, 0, tid);
    if (nk > 1) g_load<AMODE>(ra1, rb1, ar, bt, ldb, 64, tid);
    __syncthreads();
    g_store(s0, ra0, rb0, tid);
    if (nk > 2) g_load<AMODE>(ra0, rb0, ar, bt, ldb, 128, tid);
    __syncthreads();
    for (int kt = 0; kt < nk; kt += 2) {
        if (kt + 1 < nk) { g_store(s1, ra1, rb1, tid); if (kt + 3 < nk) g_load<AMODE>(ra1, rb1, ar, bt, ldb, (kt + 3) * 64, tid); }
        g_compute(acc, s0, lane, wm, wn);
        __syncthreads();
        if (kt + 1 >= nk) break;
        if (kt + 2 < nk) { g_store(s0, ra0, rb0, tid); if (kt + 4 < nk) g_load<AMODE>(ra0, rb0, ar, bt, ldb, (kt + 4) * 64, tid); }
        g_compute(acc, s1, lane, wm, wn);
        __syncthreads();
    }
}
DI void acc_zero(f32x4 (&acc)[4][4]) {
#pragma unroll
    for (int i = 0; i < 4; ++i)
#pragma unroll
        for (int j = 0; j < 4; ++j) acc[i][j] = (f32x4){0.f, 0.f, 0.f, 0.f};
}
#define ACC_FOREACH(acc, body) do { const int _l = TID() & 63, _w = TID() >> 6; \
    _Pragma("unroll") for (int _mi = 0; _mi < 4; ++_mi) _Pragma("unroll") for (int _ni = 0; _ni < 4; ++_ni) { \
        const int r_ = (_w >> 1) * 64 + _mi * 16 + (_l & 15), c_ = (_w & 1) * 64 + _ni * 16 + (_l >> 4) * 4; f32x4& v_ = acc[_mi][_ni]; body } } while (0)
DI ARows plain_rows(const bf16_t* base, size_t ld, int m0, int tid) { ARows a;
#pragma unroll
    for (int i = 0; i < 4; ++i) a.p[i] = base + (size_t)(m0 + (tid >> 3) + 64 * i) * ld;
    return a; }

DI void store_bf4(bf16_t* p, f32x4 v) { u32x2 w; w.x = pack2(v[0], v[1]); w.y = pack2(v[2], v[3]); *(u32x2*)p = w; }

DI void convert_tile(const float* src, int ld, int N, int K, bf16_t* dst, int tile, unsigned char* lds) {
    const int tid = TID();
    const int nkt = K >> 6, tk = tile % nkt, tn = tile / nkt, k0 = tk * 64, n0 = tn * 64;
    bf16_t* T = (bf16_t*)lds;
    const int r = tid >> 3, seg = (tid & 7) * 8;
    f32x4 a = (f32x4){0.f, 0.f, 0.f, 0.f}, b = a;
    if (n0 + seg < N) { const float* q = src + (size_t)(k0 + r) * ld + n0 + seg; a = *(const f32x4*)q; b = *(const f32x4*)(q + 4); }
    __syncthreads();
    { u32x4 w; w.x = pack2(a[0], a[1]); w.y = pack2(a[2], a[3]); w.z = pack2(b[0], b[1]); w.w = pack2(b[2], b[3]); *(u32x4*)(T + r * 72 + seg) = w; }
    __syncthreads();
    u32x4 o;
    o.x = (unsigned)T[(seg + 0) * 72 + r] | ((unsigned)T[(seg + 1) * 72 + r] << 16); o.y = (unsigned)T[(seg + 2) * 72 + r] | ((unsigned)T[(seg + 3) * 72 + r] << 16);
    o.z = (unsigned)T[(seg + 4) * 72 + r] | ((unsigned)T[(seg + 5) * 72 + r] << 16); o.w = (unsigned)T[(seg + 6) * 72 + r] | ((unsigned)T[(seg + 7) * 72 + r] << 16);
    *(u32x4*)(dst + (size_t)(n0 + r) * K + k0 + seg) = o;
}

struct Ctx {
    const Params* P; unsigned char* ws; float* out; int l;
    bf16_t* H; bf16_t* PROJ; bf16_t* F; bf16_t* POOLED; bf16_t* MERGED; bf16_t* CMPH; float* CMPO; float* POSB; int* ROUTE; int* ENT; bf16_t* HID; bf16_t* Y; bf16_t* VT; bf16_t* KC; bf16_t* VCT; bf16_t* YRAW; float* BON; unsigned* ctl;
    DI const float* in(int i) const { return P->in[i]; }
};

DI void add_moe_rows(const Ctx& c, int row, int lane, f32x4 (&v)[4]) {
    const int* rt = c.ROUTE + (size_t)row * 8;
    const int p0 = rt[4], p1 = rt[5];
    const bf16_t* y0 = c.Y + (size_t)p0 * DM; const bf16_t* y1 = c.Y + (size_t)p1 * DM;
#pragma unroll
    for (int i = 0; i < 4; ++i) {
        const u32x2 a = *(const u32x2*)(y0 + i * 256 + lane * 4), b = *(const u32x2*)(y1 + i * 256 + lane * 4);
        v[i][0] += bflo(a.x) + bflo(b.x); v[i][1] += bfhi(a.x) + bfhi(b.x); v[i][2] += bflo(a.y) + bflo(b.y); v[i][3] += bfhi(a.y) + bfhi(b.y);
    }
}
DI void phase_norm1(const Ctx& c, unsigned char* lds) {
    const int tid = TID(), lane = tid & 63, wave = tid >> 6;
    const float* gain = c.in(I_NMIX) + c.l * DM;
    const float* src = (c.l == 0) ? c.in(I_X) : c.out;
    for (int row = blockIdx.x * 8 + wave; row < NT; row += gridDim.x * 8) {
        f32x4 v[4];
#pragma unroll
        for (int i = 0; i < 4; ++i) v[i] = *(const f32x4*)(src + (size_t)row * DM + i * 256 + lane * 4);
        if (c.l > 0) {
            add_moe_rows(c, row, lane, v);
#pragma unroll
            for (int i = 0; i < 4; ++i) *(f32x4*)(c.out + (size_t)row * DM + i * 256 + lane * 4) = v[i];
        }
        float ss = 0.f;
#pragma unroll
        for (int i = 0; i < 4; ++i) ss += v[i][0] * v[i][0] + v[i][1] * v[i][1] + v[i][2] * v[i][2] + v[i][3] * v[i][3];
        ss = wave_sum(ss);
        const float rs = rsqrtf(ss * (1.0f / DM) + 1e-6f);
#pragma unroll
        for (int i = 0; i < 4; ++i) {
            const f32x4 g = *(const f32x4*)(gain + i * 256 + lane * 4);
            store_bf4(c.H + (size_t)row * DM + i * 256 + lane * 4, (f32x4){v[i][0] * rs * g[0], v[i][1] * rs * g[1], v[i][2] * rs * g[2], v[i][3] * rs * g[3]});
        }
    }
    for (int idx = blockIdx.x * 8 + wave; idx < 512; idx += gridDim.x * 8) {
        const int kv = idx >> 8, n = idx & 255;
        const float* pos = c.in(kv ? I_CPV : I_CPK) + (size_t)c.l * 2048;
        const float* w1 = c.in(kv ? I_CW1V : I_CW1K) + (size_t)c.l * 2048 * 256;
        float s = 0.f;
        for (int k = lane; k < 2048; k += 64) s += pos[k] * w1[(size_t)k * 256 + n];
        s = wave_sum(s);
        if (lane == 0) c.POSB[kv * 256 + n] = s;
    }
    for (int it = blockIdx.x; it < 1216 + 256 + 16 + 16; it += gridDim.x) {
        if (it < 1216) convert_tile(c.in(I_WIN) + (size_t)c.l * DM * IN_COLS, IN_COLS, IN_COLS, DM, (bf16_t*)(c.ws + WS_WT_IN), it, lds);
        else if (it < 1216 + 256) { const int j = it - 1216, kv = j >> 7; convert_tile(c.in(kv ? I_CW1V : I_CW1K) + (size_t)c.l * 2048 * 256, 256, 256, 2048, (bf16_t*)(c.ws + WS_WT_C1) + (size_t)kv * 256 * 2048, j & 127, lds); }
        else if (it < 1216 + 256 + 16) { const int j = it - 1472, kv = j >> 3; convert_tile(c.in(kv ? I_CW2V : I_CW2K) + (size_t)c.l * 256 * 64, 64, 64, 256, (bf16_t*)(c.ws + WS_WT_C2) + (size_t)kv * 128 * 256, j & 7, lds); }
        else { const int j = it - 1488, gi = j >> 2; convert_tile(c.in(I_POOLW) + ((size_t)c.l * 4 + gi) * 128 * 128, 128, 128, 128, (bf16_t*)(c.ws + WS_WT_POOL) + (size_t)gi * 128 * 128, j & 3, lds); }
    }
}

DI void phase_gemm1(const Ctx& c, unsigned char* lds) {
    const int nM = NT / 256, nN = (IN_COLS + 127) / 128;
    const bf16_t* WT = (const bf16_t*)(c.ws + WS_WT_IN);
    for (int tile = blockIdx.x; tile < nM * nN; tile += gridDim.x) {
        const int tm = tile % nM, tn = tile / nM, m0 = tm * 256, n0 = tn * 128;
        f32x4 acc[4][4]; acc_zero(acc);
        const ARows ar = plain_rows(c.H, DM, m0, TID());
        gemm_core<0>(acc, ar, WT + (size_t)n0 * DM, DM, DM, lds);
        ACC_FOREACH(acc, { if (n0 + c_ < IN_COLS) store_bf4(c.PROJ + (size_t)(m0 + r_) * IN_COLS + n0 + c_, v_); });
    }
}

DI float gelu_tanh(float x) { const float u = 0.7978845608028654f * (x + 0.044715f * x * x * x); const float e = __expf(2.0f * u); return x * (1.0f - __builtin_amdgcn_rcpf(e + 1.0f)); }
DI float softplusf_(float x) { return (x > 20.f) ? x : __logf(1.0f + __expf(x)); }
DI float tanhf_(float x) { const float e = __expf(2.0f * x); return 1.0f - 2.0f * __builtin_amdgcn_rcpf(e + 1.0f); }
template <int WIN>
DI void pool_emit(const Ctx& c, const float (&pv)[31], int t0, int s0, int ch) {
#pragma unroll
    for (int k = 0; k < 16; ++k) {
        float sum = 0.f;
#pragma unroll
        for (int j = 0; j < WIN; ++j) sum += pv[15 + k - j];
        const int s = s0 + k, cnt = (s + 1 < WIN) ? s + 1 : WIN;
        c.POOLED[(size_t)(t0 + k) * 512 + ch] = f2bf(sum / (float)cnt - pv[15 + k]);
    }
}
DI void phase_prep(const Ctx& c, unsigned char* lds) {
    const int tid = TID();
    const int n_cmp_items = 2 * 16 * 2;
    const int n_prep = n_cmp_items + NT / 16;
    const int n_items = n_prep + 2048;
    for (int item = blockIdx.x; item < n_items; item += gridDim.x) {
        if (item < n_cmp_items) {
            const int kv = item >> 5, bgi = (item >> 1) & 15, tn = item & 1, m0 = bgi * 256, n0 = tn * 128;
            ARows ar;
#pragma unroll
            for (int i = 0; i < 4; ++i) { const int cb = (tid >> 3) + 64 * i;
                ar.p[i] = (cb < NCMP) ? c.PROJ + ((size_t)(bgi >> 2) * SEQ + 16 * cb) * IN_COLS + (kv ? C_VC : C_KC) + (bgi & 3) * 64 : nullptr; }
            f32x4 acc[4][4]; acc_zero(acc);
            gemm_core<1>(acc, ar, (const bf16_t*)(c.ws + WS_WT_C1) + ((size_t)kv * 256 + n0) * 2048, 2048, 2048, lds);
            const float* pb = c.POSB + kv * 256;
            ACC_FOREACH(acc, {
                const f32x4 bb = *(const f32x4*)(pb + n0 + c_);
                store_bf4(c.CMPH + ((size_t)kv * 4096 + m0 + r_) * 256 + n0 + c_, (f32x4){gelu_tanh(v_[0] + bb[0]), gelu_tanh(v_[1] + bb[1]), gelu_tanh(v_[2] + bb[2]), gelu_tanh(v_[3] + bb[3])}); });
        } else if (item >= n_prep) {
            const int idx = item - n_prep, kind = idx >> 10, bgi = (idx >> 6) & 15, s0 = (idx & 63) * 64;
            bf16_t* T = (bf16_t*)lds;
            const int r = tid >> 3, seg = (tid & 7) * 8;
            const u32x4 w = *(const u32x4*)(c.PROJ + ((size_t)(bgi >> 2) * SEQ + s0 + r) * IN_COLS + (kind ? C_VW : C_VS) + (bgi & 3) * 64 + seg);
            __syncthreads();
            *(u32x4*)(T + r * 72 + seg) = w;
            __syncthreads();
            u32x4 o;
            o.x = (unsigned)T[(seg + 0) * 72 + r] | ((unsigned)T[(seg + 1) * 72 + r] << 16); o.y = (unsigned)T[(seg + 2) * 72 + r] | ((unsigned)T[(seg + 3) * 72 + r] << 16);
            o.z = (unsigned)T[(seg + 4) * 72 + r] | ((unsigned)T[(seg + 5) * 72 + r] << 16); o.w = (unsigned)T[(seg + 6) * 72 + r] | ((unsigned)T[(seg + 7) * 72 + r] << 16);
            *(u32x4*)(c.VT + (((size_t)kind * 16 + bgi) * 64 + r) * SEQ + s0 + seg) = o;
        } else {
            const int t0 = (item - n_cmp_items) * 16;
            float* sl = (float*)lds;
            const float* mu = c.in(I_MU) + (size_t)c.l * RWC;
            __syncthreads();
            for (int idx = tid; idx < 16 * 160; idx += NTHREADS) {
                const int tk = idx / 160, i = idx % 160, t = t0 + tk, col = C_WD + i;
                const float u = bf2f(c.PROJ[(size_t)t * IN_COLS + col]);
                const float up = ((t & (SEQ - 1)) != 0) ? bf2f(c.PROJ[(size_t)(t - 1) * IN_COLS + col]) : 0.f;
                const float us = u + (up - u) * mu[col - C_RW];
                sl[idx] = (i < 32) ? tanhf_(us) : ((i < 64) ? us : sigmoidf_(us));
            }
            __syncthreads();
            const int ch = tid;
            float z[16], aa[16], gg[16];
#pragma unroll
            for (int k = 0; k < 16; ++k) { z[k] = 0.f; aa[k] = 0.f; gg[k] = 0.f; }
            const float* wup = c.in(I_WUP) + (size_t)c.l * 32 * 512 + ch;
            const float* aup = c.in(I_AUP) + (size_t)c.l * 32 * 512 + ch;
            const float* gup = c.in(I_GUP) + (size_t)c.l * 96 * 512 + ch;
            for (int i = 0; i < 32; ++i) {
                const float w = wup[i * 512], a = aup[i * 512];
#pragma unroll
                for (int k = 0; k < 16; ++k) { z[k] += sl[k * 160 + i] * w; aa[k] += sl[k * 160 + 32 + i] * a; }
            }
            for (int i = 0; i < 96; ++i) {
                const float w = gup[i * 512];
#pragma unroll
                for (int k = 0; k < 16; ++k) gg[k] += sl[k * 160 + 64 + i] * w;
            }
            const float w0 = c.in(I_W0)[c.l * 512 + ch], a0 = c.in(I_A0)[c.l * 512 + ch];
            const float kkw_ = c.in(I_KK)[c.l * 512 + ch], kaw_ = c.in(I_KA)[c.l * 512 + ch], rkw_ = c.in(I_RK)[c.l * 512 + ch];
            const float mur = mu[ch], muk = mu[512 + ch], muv = mu[1024 + ch];
            float pr = 0.f, pk = 0.f, pv = 0.f;
            if ((t0 & (SEQ - 1)) != 0) { const bf16_t* q = c.PROJ + (size_t)(t0 - 1) * IN_COLS; pr = bf2f(q[C_R + ch]); pk = bf2f(q[C_K + ch]); pv = bf2f(q[C_V + ch]); }
#pragma unroll
            for (int k = 0; k < 16; ++k) {
                const int t = t0 + k; const bf16_t* q = c.PROJ + (size_t)t * IN_COLS;
                const float ur = bf2f(q[C_R + ch]), uk = bf2f(q[C_K + ch]), uv = bf2f(q[C_V + ch]);
                const float r = ur + (pr - ur) * mur, kx = uk + (pk - uk) * muk, vx = uv + (pv - uv) * muv;
                pr = ur; pk = uk; pv = uv;
                if ((k & 3) == 3) { asm volatile("" ::: "memory"); __builtin_amdgcn_sched_barrier(0); }
                const float wlog = -softplusf_(-(w0 + z[k])) - 0.5f;
                const float e = __expf(wlog);
                const float a = sigmoidf_(a0 + aa[k]);
                const size_t o = (size_t)t * 512 + ch;
                {
                    const float kxn = kx * kkw_, kp = kx * (1.0f + (a - 1.0f) * kaw_);
                    const float ss = wave_sum_dpp(kxn * kxn);
                    const float inv = __builtin_amdgcn_rsqf(fmaxf(ss, 1e-24f));
                    const float br = wave_sum_dpp(kxn * inv * a * r), kr = wave_sum_dpp(kp * r), bon = wave_sum_dpp(r * kp * rkw_);
                    if ((tid & 63) == 0) *(f32x4*)(c.BON + ((size_t)t * 8 + (tid >> 6)) * 4) = (f32x4){inv, br, kr, bon};
                }
                c.F[o] = f2bf(r); c.F[o + (size_t)NT * 512] = f2bf(kx); c.F[o + (size_t)2 * NT * 512] = f2bf(vx);
                c.F[o + (size_t)3 * NT * 512] = f2bf(e); c.F[o + (size_t)4 * NT * 512] = f2bf(a); c.F[o + (size_t)5 * NT * 512] = f2bf(gg[k]);
            }
            asm volatile("" ::: "memory"); __builtin_amdgcn_sched_barrier(0);
            {
                const int gi = ch >> 7;
                const int s0 = t0 & (SEQ - 1);
                float pv[31];
#pragma unroll
                for (int i = 0; i < 31; ++i) pv[i] = (s0 - 15 + i >= 0) ? bf2f(c.PROJ[(size_t)(t0 - 15 + i) * IN_COLS + C_POOL + ch]) : 0.f;
                if (gi == 0) pool_emit<2>(c, pv, t0, s0, ch);
                else if (gi == 1) pool_emit<4>(c, pv, t0, s0, ch);
                else if (gi == 2) pool_emit<8>(c, pv, t0, s0, ch);
                else pool_emit<16>(c, pv, t0, s0, ch);
            }
        }
    }
}

DI void phase_poolgemm(const Ctx& c, unsigned char* lds) {
    const int n_pool = (NT / 256) * 4, n_items = n_pool + 32;
    for (int item = blockIdx.x; item < n_items; item += gridDim.x) {
        f32x4 acc[4][4]; acc_zero(acc);
        if (item < n_pool) {
            const int tm = item >> 2, gi = item & 3, m0 = tm * 256;
            const ARows ar = plain_rows(c.POOLED + gi * 128, 512, m0, TID());
            gemm_core<0>(acc, ar, (const bf16_t*)(c.ws + WS_WT_POOL) + (size_t)gi * 128 * 128, 128, 128, lds);
            const float* sc = c.in(I_POOLS) + c.l * 512 + gi * 128;
            ACC_FOREACH(acc, { const f32x4 s = *(const f32x4*)(sc + c_);
                store_bf4(c.POOLED + (size_t)(m0 + r_) * 512 + gi * 128 + c_, (f32x4){v_[0] * s[0], v_[1] * s[1], v_[2] * s[2], v_[3] * s[3]}); });
        } else {
            const int it = item - n_pool, kv = it >> 4, tm = it & 15, m0 = tm * 256;
            const ARows ar = plain_rows(c.CMPH + (size_t)kv * 4096 * 256, 256, m0, TID());
            gemm_core<0>(acc, ar, (const bf16_t*)(c.ws + WS_WT_C2) + (size_t)kv * 128 * 256, 256, 256, lds);
            ACC_FOREACH(acc, { if (c_ < 64) { const int R = m0 + r_;
                if (kv == 0) store_bf4(c.KC + (size_t)R * 64 + c_, v_);
                else { bf16_t* q = c.VCT + ((size_t)(R >> 8) * 64 + c_) * 256 + (R & 255); q[0] = f2bf(v_[0]); q[256] = f2bf(v_[1]); q[512] = f2bf(v_[2]); q[768] = f2bf(v_[3]); } } });
        }
    }
}

constexpr int SCH = 32;
constexpr int SB_AN = 0, SB_WR = SCH * 64 * 4, SB_W = 2 * SCH * 64 * 4, SB_BB = 3 * SCH * 64 * 4, SB_KP = 4 * SCH * 64 * 4;
constexpr int SB_V = 5 * SCH * 64 * 4;
constexpr int SB_SC = SB_V + SCH * 16 * 4;
constexpr int SB_Y = SB_SC + SCH * 2 * 4;
constexpr int SB_BYTES = SB_Y + SCH * 16 * 4;
static_assert(2 * SB_BYTES <= LDS_BYTES - 64, "scan lds");
typedef float f32x2 __attribute__((ext_vector_type(2)));
DI float row8_sum(float v) { v += DPP_MOV(v, 0xB1); v += DPP_MOV(v, 0x4E); v += DPP_MOV(v, 0x141); return v; }

constexpr int NPW = 6, NJ = (SCH + NPW - 1) / NPW;
struct PrepRegs { bf16_t r[NJ], k[NJ], v[NJ], e[NJ], a[NJ]; float s0[NJ], s1[NJ], s2[NJ]; };
DI void prep_load(PrepRegs& R, const Ctx& c, int b, int h, int ck, int pw, int lane) {
    const size_t PL = (size_t)NT * 512;
    const size_t tb = (size_t)b * SEQ + ck * SCH;
    const size_t o0 = tb * 512 + h * 64 + lane;
#pragma unroll
    for (int j = 0; j < NJ; ++j) {
        const int st = pw + NPW * j;
        if (st < SCH) { const size_t o = o0 + (size_t)st * 512; R.r[j] = c.F[o]; R.k[j] = c.F[o + PL]; R.v[j] = c.F[o + 2 * PL]; R.e[j] = c.F[o + 3 * PL]; R.a[j] = c.F[o + 4 * PL];
            const float* sp = c.BON + ((tb + st) * 8 + h) * 4; R.s0[j] = sp[0]; R.s1[j] = sp[1]; R.s2[j] = sp[2]; }
    }
}
DI void prep_store(const PrepRegs& R, unsigned char* sb, int rq, int pw, int lane, float kkw, float kaw) {
    float* an = (float*)(sb + SB_AN); float* wr = (float*)(sb + SB_WR); float* w_ = (float*)(sb + SB_W); float* bb_ = (float*)(sb + SB_BB); float* kp_ = (float*)(sb + SB_KP);
    float* vv = (float*)(sb + SB_V); float* sc = (float*)(sb + SB_SC);
#pragma unroll
    for (int j = 0; j < NJ; ++j) {
        const int st = pw + NPW * j;
        if (st < SCH) {
            const float r = bf2f(R.r[j]), k = bf2f(R.k[j]), v = bf2f(R.v[j]), e = bf2f(R.e[j]), a = bf2f(R.a[j]);
            const float w = __expf(-e);
            const float kk = k * kkw * R.s0[j];
            const float kp = k * (1.0f + (a - 1.0f) * kaw);
            an[st * 64 + lane] = -kk; wr[st * 64 + lane] = w * r; w_[st * 64 + lane] = w; bb_[st * 64 + lane] = kk * a; kp_[st * 64 + lane] = kp;
            if ((lane >> 4) == rq) vv[st * 16 + (lane & 15)] = v;
            if (lane == 0) { sc[st * 2] = R.s1[j]; sc[st * 2 + 1] = R.s2[j]; }
        }
    }
}
DI void scan_item(const Ctx& c, int item, unsigned char* lds) {
    const int tid = TID(), lane = tid & 63, wave = tid >> 6;
    const int b = item >> 5, h = (item >> 2) & 7, rq = item & 3;
    const int chn = h * 64 + lane;
    const float kkw = c.in(I_KK)[c.l * 512 + chn], kaw = c.in(I_KA)[c.l * 512 + chn];
    const int rowl = (tid & 127) >> 3, cg = tid & 7;
    f32x2 st[4];
#pragma unroll
    for (int i = 0; i < 4; ++i) st[i] = (f32x2){0.f, 0.f};
    constexpr int NCK = SEQ / SCH;
    PrepRegs R;
    __syncthreads();
    if (wave >= 2) { prep_load(R, c, b, h, 0, wave - 2, lane); prep_store(R, lds, rq, wave - 2, lane, kkw, kaw); prep_load(R, c, b, h, 1, wave - 2, lane); }
    __syncthreads();
    for (int ck = 0; ck < NCK; ++ck) {
        unsigned char* sb = lds + (ck & 1) * SB_BYTES;
        if (wave < 2) {
            const float* an = (const float*)(sb + SB_AN) + cg * 8; const float* wr = (const float*)(sb + SB_WR) + cg * 8; const float* w_ = (const float*)(sb + SB_W) + cg * 8;
            const float* bb_ = (const float*)(sb + SB_BB) + cg * 8; const float* kp_ = (const float*)(sb + SB_KP) + cg * 8;
            const float* vv = (const float*)(sb + SB_V) + rowl; const float* sc = (const float*)(sb + SB_SC); float* yb = (float*)(sb + SB_Y) + rowl;
            f32x4 a0 = *(const f32x4*)(an), a1 = *(const f32x4*)(an + 4), r0 = *(const f32x4*)(wr), r1 = *(const f32x4*)(wr + 4);
            f32x4 w0 = *(const f32x4*)(w_), w1 = *(const f32x4*)(w_ + 4), b0 = *(const f32x4*)(bb_), b1 = *(const f32x4*)(bb_ + 4);
            f32x4 k0 = *(const f32x4*)(kp_), k1 = *(const f32x4*)(kp_ + 4);
            float v = vv[0]; f32x2 bk = *(const f32x2*)(sc);
#pragma unroll 2
            for (int s = 0; s < SCH; ++s) {
                const int sn = (s + 1 < SCH) ? s + 1 : s;
                const f32x4 na0 = *(const f32x4*)(an + sn * 64), na1 = *(const f32x4*)(an + sn * 64 + 4), nr0 = *(const f32x4*)(wr + sn * 64), nr1 = *(const f32x4*)(wr + sn * 64 + 4);
                const f32x4 nw0 = *(const f32x4*)(w_ + sn * 64), nw1 = *(const f32x4*)(w_ + sn * 64 + 4), nb0 = *(const f32x4*)(bb_ + sn * 64), nb1 = *(const f32x4*)(bb_ + sn * 64 + 4);
                const f32x4 nk0 = *(const f32x4*)(kp_ + sn * 64), nk1 = *(const f32x4*)(kp_ + sn * 64 + 4);
                const float nv = vv[sn * 16]; const f32x2 nbk = *(const f32x2*)(sc + sn * 2);
                f32x2 da = st[0] * (f32x2){a0[0], a0[1]}; f32x2 dr = st[0] * (f32x2){r0[0], r0[1]};
                da += st[1] * (f32x2){a0[2], a0[3]}; dr += st[1] * (f32x2){r0[2], r0[3]};
                da += st[2] * (f32x2){a1[0], a1[1]}; dr += st[2] * (f32x2){r1[0], r1[1]};
                da += st[3] * (f32x2){a1[2], a1[3]}; dr += st[3] * (f32x2){r1[2], r1[3]};
                float sa = da[0] + da[1], sr = dr[0] + dr[1];
                sa += DPP_MOV(sa, 0xB1); sr += DPP_MOV(sr, 0xB1);
                sa += DPP_MOV(sa, 0x4E); sr += DPP_MOV(sr, 0x4E);
                sa += DPP_MOV(sa, 0x141); sr += DPP_MOV(sr, 0x141);
                const f32x2 sa2 = (f32x2){sa, sa}, v2 = (f32x2){v, v};
                st[0] = st[0] * (f32x2){w0[0], w0[1]} + sa2 * (f32x2){b0[0], b0[1]} + v2 * (f32x2){k0[0], k0[1]};
                st[1] = st[1] * (f32x2){w0[2], w0[3]} + sa2 * (f32x2){b0[2], b0[3]} + v2 * (f32x2){k0[2], k0[3]};
                st[2] = st[2] * (f32x2){w1[0], w1[1]} + sa2 * (f32x2){b1[0], b1[1]} + v2 * (f32x2){k1[0], k1[1]};
                st[3] = st[3] * (f32x2){w1[2], w1[3]} + sa2 * (f32x2){b1[2], b1[3]} + v2 * (f32x2){k1[2], k1[3]};
                yb[s * 16] = sr + sa * bk[0] + v * bk[1];
                a0 = na0; a1 = na1; r0 = nr0; r1 = nr1; w0 = nw0; w1 = nw1; b0 = nb0; b1 = nb1; k0 = nk0; k1 = nk1; v = nv; bk = nbk;
            }
        } else {
            const int pt = tid - 128;
            if (ck + 1 < NCK) prep_store(R, lds + ((ck + 1) & 1) * SB_BYTES, rq, wave - 2, lane, kkw, kaw);
            if (ck + 2 < NCK) prep_load(R, c, b, h, ck + 2, wave - 2, lane);
            if (ck > 0) {
                const float* yb = (const float*)(lds + ((ck - 1) & 1) * SB_BYTES + SB_Y);
                for (int idx = pt; idx < SCH * 16; idx += 384) {
                    const int s = idx >> 4, j = idx & 15;
                    c.YRAW[((size_t)b * SEQ + (ck - 1) * SCH + s) * 512 + h * 64 + rq * 16 + j] = f2bf(yb[idx]);
                }
            }
        }
        asm volatile("s_waitcnt lgkmcnt(0)" ::: "memory"); __builtin_amdgcn_s_barrier(); asm volatile("" ::: "memory");
    }
    {
        const float* yb = (const float*)(lds + ((NCK - 1) & 1) * SB_BYTES + SB_Y);
        for (int idx = tid; idx < SCH * 16; idx += NTHREADS) {
            const int s = idx >> 4, j = idx & 15;
            c.YRAW[((size_t)b * SEQ + (NCK - 1) * SCH + s) * 512 + h * 64 + rq * 16 + j] = f2bf(yb[idx]);
        }
    }
    __syncthreads();
}
DI void phase_rwkv_post(const Ctx& c, unsigned char* lds) {
    const int tid = TID(), lane = tid & 63, wave = tid >> 6;
    const size_t PL = (size_t)NT * 512;
    for (int idx = blockIdx.x * 8 + wave; idx < NT * 8; idx += gridDim.x * 8) {
        const int t = idx >> 3, h = idx & 7, chn = h * 64 + lane;
        const size_t o = (size_t)t * 512 + chn;
        const float y = bf2f(c.YRAW[o]);
        const float mean = wave_sum(y) * (1.0f / 64.0f);
        const float d = y - mean;
        const float var = wave_sum(d * d) * (1.0f / 64.0f);
        const float yn = d * rsqrtf(var + 64e-5f) * c.in(I_GNW)[c.l * 512 + chn] + c.in(I_GNB)[c.l * 512 + chn];
        const float v = bf2f(c.F[o + 2 * PL]), g = bf2f(c.F[o + 5 * PL]);
        c.F[o + 5 * PL] = f2bf((yn + c.BON[(size_t)idx * 4 + 3] * v) * g);
    }
    for (int it = blockIdx.x; it < 768 + 128 + 128 + 256 + 256; it += gridDim.x) {
        const float* WB = c.in(I_WBR) + (size_t)c.l * 2048 * DM; bf16_t* BR = (bf16_t*)(c.ws + WS_WT_BR);
        if (it < 768) convert_tile(c.in(I_WMG) + (size_t)c.l * DM * 3 * DM, 3 * DM, 3 * DM, DM, (bf16_t*)(c.ws + WS_WT_MG), it, lds);
        else if (it < 896) convert_tile(WB, DM, DM, 512, BR, it - 768, lds);
        else if (it < 1024) convert_tile(WB + (size_t)512 * DM, DM, DM, 512, BR + (size_t)1024 * 512, it - 896, lds);
        else if (it < 1280) convert_tile(WB + (size_t)1024 * DM, DM, DM, 1024, BR + (size_t)2048 * 512, it - 1024, lds);
        else convert_tile(c.in(I_WOUT) + (size_t)c.l * DM * DM, DM, DM, DM, (bf16_t*)(c.ws + WS_WT_OUT), it - 1280, lds);
    }
}
constexpr int TS = 72;
constexpr int NSA_BIAS = 0;
constexpr int NSA_SELM = 2112;
constexpr int NSA_SCR = 2624;
constexpr int NSA_K0 = 4672;
constexpr int NSA_V0 = NSA_K0 + 2 * 64 * TS * 2;
constexpr int NSA_A = NSA_V0 + 2 * 64 * TS * 2;
constexpr int NSA_B = NSA_A + 16384;
constexpr int NSA_END = NSA_B + 16384;
static_assert(NSA_END <= LDS_BYTES - 16, "nsa lds");
static_assert(NSA_K0 % 16 == 0, "align");

struct NsaLane { int tq[2]; int h; float cbias; float m[2], l[2]; };

DI void nsa_prefetch(u32x4& rk, u32x4& rv, const bf16_t* kbase, int kstride, const bf16_t* vtbase, int vstride, int pos0, int tid) {
    const int r = tid >> 3, seg = (tid & 7) * 8;
    rk = *(const u32x4*)(kbase + (size_t)(pos0 + r) * kstride + seg);
    rv = *(const u32x4*)(vtbase + (size_t)r * vstride + pos0 + seg);
}
DI void nsa_store(unsigned char* lds, int buf, const u32x4& rk, const u32x4& rv, int tid) {
    const int r = tid >> 3, seg = (tid & 7) * 8;
    *(u32x4*)((bf16_t*)(lds + NSA_K0) + buf * 64 * TS + r * TS + seg) = rk;
    *(u32x4*)((bf16_t*)(lds + NSA_V0) + buf * 64 * TS + r * TS + seg) = rv;
}
DI void nsa_qk(f32x4 (&s)[2][4], const bf16_t* sK, const bf16x8 (&qf)[2][2], int lane) {
#pragma unroll
    for (int kt = 0; kt < 4; ++kt) {
#pragma unroll
        for (int ks = 0; ks < 2; ++ks) {
            const bf16x8 kf = *(const bf16x8*)(sK + (16 * kt + (lane & 15)) * TS + 32 * ks + (lane >> 4) * 8);
#pragma unroll
            for (int qi = 0; qi < 2; ++qi) s[qi][kt] = __builtin_amdgcn_mfma_f32_16x16x32_bf16(kf, qf[qi][ks], (ks == 0) ? (f32x4){0.f, 0.f, 0.f, 0.f} : s[qi][kt], 0, 0, 0);
        }
    }
}
template <int MODE>
DI void nsa_logits(float (&x)[4][4], const f32x4 (&s)[4], int tq, int h, float cbias, bool rowsel, int pos0, int qd, const float* biasT) {
#pragma unroll
    for (int kt = 0; kt < 4; ++kt)
#pragma unroll
        for (int i = 0; i < 4; ++i) {
            const int kk = pos0 + 16 * kt + 4 * qd + i;
            if (MODE == 1) { x[kt][i] = rowsel ? s[kt][i] + cbias : -INFINITY; }
            else {
                const int dist = (MODE == 0) ? (tq - 16 * kk - 31) : (tq - kk);
                bool ok = dist >= 0;
                if (MODE == 2) ok = ok && rowsel;
                if (MODE == 3) ok = ok && (dist < 512);
                const int di = dist < 0 ? 0 : (dist > 128 ? 128 : dist);
                float bias = biasT[di * 4 + h];
                asm volatile("" : "+v"(bias));
                x[kt][i] = ok ? s[kt][i] + bias : -INFINITY;
            }
        }
}
DI float quad16_max(float v) { v = fmaxf(v, __shfl_xor(v, 16)); v = fmaxf(v, __shfl_xor(v, 32)); return v; }
DI float quad16_sum(float v) { v += __shfl_xor(v, 16); v += __shfl_xor(v, 32); return v; }
DI void nsa_softmax(const float (&x)[4][4], float& m, float& l, f32x4 (&O)[4], bf16x8 (&pf)[2]) {
    float mx = -INFINITY;
#pragma unroll
    for (int kt = 0; kt < 4; ++kt)
#pragma unroll
        for (int i = 0; i < 4; ++i) mx = fmaxf(mx, x[kt][i]);
    mx = quad16_max(mx);
    const float mn = fmaxf(m, mx);
    const float mu = (mn == -INFINITY) ? 0.f : mn;
    const float mu2 = mu * 1.4426950408889634f;
    const float sc = __builtin_amdgcn_exp2f(__builtin_fmaf(m, 1.4426950408889634f, -mu2));
    float p[4][4]; float ps = 0.f;
#pragma unroll
    for (int kt = 0; kt < 4; ++kt)
#pragma unroll
        for (int i = 0; i < 4; ++i) { p[kt][i] = __builtin_amdgcn_exp2f(__builtin_fmaf(x[kt][i], 1.4426950408889634f, -mu2)); ps += p[kt][i]; }
    l = l * sc + ps; m = mn;
#pragma unroll
    for (int dt = 0; dt < 4; ++dt) O[dt] = O[dt] * sc;
#pragma unroll
    for (int ks = 0; ks < 2; ++ks) {
        u32x4 w; w.x = pack2(p[2 * ks][0], p[2 * ks][1]); w.y = pack2(p[2 * ks][2], p[2 * ks][3]); w.z = pack2(p[2 * ks + 1][0], p[2 * ks + 1][1]); w.w = pack2(p[2 * ks + 1][2], p[2 * ks + 1][3]);
        pf[ks] = __builtin_bit_cast(bf16x8, w);
    }
}
DI void nsa_pv(f32x4 (&O)[2][4], const bf16_t* sV, const bf16x8 (&pf)[2][2], int lane) {
    const int qd = lane >> 4;
#pragma unroll
    for (int dt = 0; dt < 4; ++dt)
#pragma unroll
        for (int ks = 0; ks < 2; ++ks) {
            const bf16_t* vp = sV + (16 * dt + (lane & 15)) * TS + 32 * ks + 4 * qd;
            const u32x2 a = *(const u32x2*)vp, b = *(const u32x2*)(vp + 16);
            u32x4 w; w.x = a.x; w.y = a.y; w.z = b.x; w.w = b.y;
            const bf16x8 vf = __builtin_bit_cast(bf16x8, w);
#pragma unroll
            for (int qi = 0; qi < 2; ++qi) O[qi][dt] = __builtin_amdgcn_mfma_f32_16x16x32_bf16(vf, pf[qi][ks], O[qi][dt], 0, 0, 0);
        }
}
template <int MODE>
DI void nsa_tile(f32x4 (&O)[2][4], NsaLane& L, const bf16x8 (&qf)[2][2], const unsigned char* lds, int buf, int pos0, bool sel0, bool sel1, int lane) {
    const bf16_t* sK = (const bf16_t*)(lds + NSA_K0) + buf * 64 * TS;
    const bf16_t* sV = (const bf16_t*)(lds + NSA_V0) + buf * 64 * TS;
    const float* biasT = (const float*)(lds + NSA_BIAS);
    f32x4 s[2][4];
    nsa_qk(s, sK, qf, lane);
    bf16x8 pf[2][2];
#pragma unroll
    for (int qi = 0; qi < 2; ++qi) {
        float x[4][4];
        nsa_logits<MODE>(x, s[qi], L.tq[qi], L.h, L.cbias, qi ? sel1 : sel0, pos0, lane >> 4, biasT);
        nsa_softmax(x, L.m[qi], L.l[qi], O[qi], pf[qi]);
    }
    nsa_pv(O, sV, pf, lane);
}
DI void nsa_flush(f32x4 (&Y)[2][4], f32x4 (&O)[2][4], NsaLane& L, const float (&gate)[2]) {
#pragma unroll
    for (int qi = 0; qi < 2; ++qi) {
        const float lt = quad16_sum(L.l[qi]);
        const float f = (lt > 0.f) ? gate[qi] * __builtin_amdgcn_rcpf(lt) : 0.f;
#pragma unroll
        for (int dt = 0; dt < 4; ++dt) { Y[qi][dt] += O[qi][dt] * f; O[qi][dt] = (f32x4){0.f, 0.f, 0.f, 0.f}; }
    }
}
DI void nsa_item(const Ctx& c, int item, unsigned char* lds) {
    const int tid = TID(), lane = tid & 63, wave = tid >> 6, qd = lane >> 4;
    const int b = item >> 8, g = (item >> 6) & 3, qt = item & 63, t0 = qt * 64, cur = qt, bg = b * 4 + g;
    float* biasT = (float*)(lds + NSA_BIAS);
    unsigned long long* selm = (unsigned long long*)(lds + NSA_SELM);
    float* scr = (float*)(lds + NSA_SCR) + wave * 64;
    float* impA = (float*)(lds + NSA_A); float* impB = (float*)(lds + NSA_B);
    __syncthreads();
    for (int i = tid; i < 129 * 4; i += NTHREADS) { const int d = i >> 2, h = i & 3; biasT[i] = c.in(I_RELB)[t5_bucket(d) * 16 + g * 4 + h]; }
    for (int i = tid; i < 2 * 4096; i += NTHREADS) impA[i] = 0.f;
    NsaLane L; L.h = lane & 3;
    bf16x8 qf[2][2]; float gates[2][3];
    const bf16_t* pbat = c.PROJ + (size_t)b * SEQ * IN_COLS;
#pragma unroll
    for (int qi = 0; qi < 2; ++qi) {
        const int tl = 8 * wave + 4 * qi + ((lane & 15) >> 2);
        L.tq[qi] = t0 + tl;
        const bf16_t* prow = pbat + (size_t)L.tq[qi] * IN_COLS;
#pragma unroll
        for (int ks = 0; ks < 2; ++ks) {
            u32x4 w = *(const u32x4*)(prow + C_Q + (g * 4 + L.h) * 64 + 32 * ks + qd * 8);
            w.x = pack2(bflo(w.x) * 0.125f, bfhi(w.x) * 0.125f); w.y = pack2(bflo(w.y) * 0.125f, bfhi(w.y) * 0.125f);
            w.z = pack2(bflo(w.z) * 0.125f, bfhi(w.z) * 0.125f); w.w = pack2(bflo(w.w) * 0.125f, bfhi(w.w) * 0.125f);
            qf[qi][ks] = __builtin_bit_cast(bf16x8, w);
        }
#pragma unroll
        for (int br = 0; br < 3; ++br) gates[qi][br] = sigmoidf_(bf2f(prow[C_GATE + g * 12 + L.h * 3 + br]));
    }
    __syncthreads();
    L.cbias = biasT[128 * 4 + L.h];
    f32x4 O[2][4], Y[2][4];
#pragma unroll
    for (int qi = 0; qi < 2; ++qi)
#pragma unroll
        for (int dt = 0; dt < 4; ++dt) { O[qi][dt] = (f32x4){0.f, 0.f, 0.f, 0.f}; Y[qi][dt] = (f32x4){0.f, 0.f, 0.f, 0.f}; }
    u32x4 rk, rv;
    const int nvis_max = (t0 + 63 >= 31) ? ((t0 + 63 - 31) >> 4) + 1 : 0;
    const int ncb = (nvis_max + 63) >> 6;
    const bf16_t* kcb = c.KC + (size_t)bg * 256 * 64; const bf16_t* vcb = c.VCT + (size_t)bg * 64 * 256;
    L.m[0] = L.m[1] = -INFINITY; L.l[0] = L.l[1] = 0.f;
    if (ncb > 0) nsa_prefetch(rk, rv, kcb, 64, vcb, 256, 0, tid);
    for (int cb = 0; cb < ncb; ++cb) {
        nsa_store(lds, cb & 1, rk, rv, tid);
        __syncthreads();
        if (cb + 1 < ncb) nsa_prefetch(rk, rv, kcb, 64, vcb, 256, (cb + 1) * 64, tid);
        if (16 * (cb * 64 + 63) + 31 + 128 <= t0) nsa_tile<1>(O, L, qf, lds, cb & 1, cb * 64, true, true, lane);
        else nsa_tile<0>(O, L, qf, lds, cb & 1, cb * 64, true, true, lane);
    }
    float mfin[2], linv[2];
#pragma unroll
    for (int qi = 0; qi < 2; ++qi) { mfin[qi] = L.m[qi]; const float lt = quad16_sum(L.l[qi]); linv[qi] = (lt > 0.f) ? __builtin_amdgcn_rcpf(lt) : 0.f; }
    { const float gg[2] = {gates[0][0], gates[1][0]}; nsa_flush(Y, O, L, gg); }
    __syncthreads();
    if (ncb > 0) nsa_prefetch(rk, rv, kcb, 64, vcb, 256, 0, tid);
    for (int cb = 0; cb < ncb; ++cb) {
        nsa_store(lds, cb & 1, rk, rv, tid);
        __syncthreads();
        if (cb + 1 < ncb) nsa_prefetch(rk, rv, kcb, 64, vcb, 256, (cb + 1) * 64, tid);
        const bf16_t* sK = (const bf16_t*)(lds + NSA_K0) + (cb & 1) * 64 * TS;
        f32x4 s[2][4];
        nsa_qk(s, sK, qf, lane);
#pragma unroll
        for (int qi = 0; qi < 2; ++qi) {
            float x[4][4];
            nsa_logits<0>(x, s[qi], L.tq[qi], L.h, L.cbias, true, cb * 64, qd, biasT);
            const float mu = (mfin[qi] == -INFINITY) ? 0.f : mfin[qi];
#pragma unroll
            for (int kt = 0; kt < 4; ++kt) {
                float p3 = __expf(x[kt][3] - mu) * linv[qi];
                float pa = (__expf(x[kt][0] - mu) + __expf(x[kt][1] - mu) + __expf(x[kt][2] - mu)) * linv[qi] + p3;
                pa += __shfl_xor(pa, 1); p3 += __shfl_xor(p3, 1);
                pa += __shfl_xor(pa, 2); p3 += __shfl_xor(p3, 2);
                if (L.h == 0) { const int tl = 8 * wave + 4 * qi + ((lane & 15) >> 2), mi = 16 * cb + 4 * kt + qd; impA[tl * 64 + mi] = pa; impB[tl * 64 + mi] = p3; }
            }
        }
    }
    __syncthreads();
    for (int tl8 = 0; tl8 < 8; ++tl8) {
        const int tl = 8 * wave + tl8, n = lane;
        const bool cand = (n >= 1) && (n <= cur - 2);
        const float imp = cand ? impA[tl * 64 + n] + impB[tl * 64 + n - 1] : -1.0f;
        LDS_WAVE_SYNC();
        scr[n] = imp;
        LDS_WAVE_SYNC();
        int rank = 0;
#pragma unroll 4
        for (int q4 = 0; q4 < 16; ++q4) {
            const f32x4 o = *(const f32x4*)(scr + q4 * 4);
#pragma unroll
            for (int j = 0; j < 4; ++j) { const int n2 = q4 * 4 + j; rank += (o[j] > imp || (o[j] == imp && n2 < n)) ? 1 : 0; }
        }
        const bool forced = (n <= cur) && (n == 0 || n == cur || n == cur - 1);
        const unsigned long long msk = __ballot((cand && rank < 5) || forced);
        if (lane == 0) selm[tl] = msk;
    }
    __syncthreads();
    unsigned long long uni = selm[lane];
#pragma unroll
    for (int o = 32; o >= 1; o >>= 1) { const unsigned lo_ = __shfl_xor((unsigned)uni, o), hi_ = __shfl_xor((unsigned)(uni >> 32), o); uni |= ((unsigned long long)hi_ << 32) | lo_; }
    uni = ((unsigned long long)__builtin_amdgcn_readfirstlane((unsigned)(uni >> 32)) << 32) | (unsigned)__builtin_amdgcn_readfirstlane((unsigned)uni);
    unsigned long long sm[2];
#pragma unroll
    for (int qi = 0; qi < 2; ++qi) sm[qi] = selm[8 * wave + 4 * qi + ((lane & 15) >> 2)];
    const bf16_t* ksb = pbat + C_KS + g * 64; const bf16_t* vsb = c.VT + ((size_t)0 * 16 + bg) * 64 * SEQ;
    L.m[0] = L.m[1] = -INFINITY; L.l[0] = L.l[1] = 0.f;
    {
        unsigned long long rem = uni; int it = 0;
        int j = (int)__builtin_ctzll(rem); rem &= rem - 1;
        nsa_prefetch(rk, rv, ksb, IN_COLS, vsb, SEQ, j * 64, tid);
        for (;;) {
            nsa_store(lds, it & 1, rk, rv, tid);
            __syncthreads();
            const int jn = rem ? (int)__builtin_ctzll(rem) : -1;
            if (jn >= 0) { rem &= rem - 1; nsa_prefetch(rk, rv, ksb, IN_COLS, vsb, SEQ, jn * 64, tid); }
            const bool s0 = (sm[0] >> j) & 1ull, s1 = (sm[1] >> j) & 1ull;
            if (j <= cur - 3) nsa_tile<1>(O, L, qf, lds, it & 1, j * 64, s0, s1, lane);
            else nsa_tile<2>(O, L, qf, lds, it & 1, j * 64, s0, s1, lane);
            if (jn < 0) break;
            j = jn; ++it;
        }
    }
    { const float gg[2] = {gates[0][1], gates[1][1]}; nsa_flush(Y, O, L, gg); }
    const bf16_t* kwb = pbat + C_KW + g * 64; const bf16_t* vwb = c.VT + ((size_t)1 * 16 + bg) * 64 * SEQ;
    L.m[0] = L.m[1] = -INFINITY; L.l[0] = L.l[1] = 0.f;
    {
        const int j0 = (cur - 8 > 0) ? cur - 8 : 0;
        __syncthreads();
        nsa_prefetch(rk, rv, kwb, IN_COLS, vwb, SEQ, j0 * 64, tid);
        for (int j = j0; j <= cur; ++j) {
            nsa_store(lds, (j - j0) & 1, rk, rv, tid);
            __syncthreads();
            if (j + 1 <= cur) nsa_prefetch(rk, rv, kwb, IN_COLS, vwb, SEQ, (j + 1) * 64, tid);
            if (cur - j >= 3 && cur - j <= 7) nsa_tile<1>(O, L, qf, lds, (j - j0) & 1, j * 64, true, true, lane);
            else nsa_tile<3>(O, L, qf, lds, (j - j0) & 1, j * 64, true, true, lane);
        }
    }
    { const float gg[2] = {gates[0][2], gates[1][2]}; nsa_flush(Y, O, L, gg); }
#pragma unroll
    for (int qi = 0; qi < 2; ++qi) {
        bf16_t* yrow = c.PROJ + ((size_t)b * SEQ + L.tq[qi]) * IN_COLS + C_Q + (g * 4 + L.h) * 64;
#pragma unroll
        for (int dt = 0; dt < 4; ++dt) store_bf4(yrow + 16 * dt + 4 * qd, Y[qi][dt]);
    }
}
DI void phase_mix(const Ctx& c, unsigned char* lds) {
    const int G = gridDim.x, bid = blockIdx.x;
    const int n_nsa = NB * 4 * (SEQ / 64), n_scan = NB * 8 * 4;
    const bool split = G >= 2 * n_scan;
    if (split) { if (bid < n_scan) scan_item(c, bid, lds); }
    else for (int item = bid; item < n_scan; item += G) scan_item(c, item, lds);
    unsigned* ctr = c.ctl + CW_Q + c.l;
    volatile int* sitem = (volatile int*)(lds + LDS_BYTES - 32);
    for (;;) {
        __syncthreads();
        if (TID() == 0) *sitem = (int)atomicAdd(ctr, 1u);
        __syncthreads();
        const int k = *sitem;
        if (k >= n_nsa) break;
        const int qt = 63 - (k >> 4), bgi = k & 15;
        nsa_item(c, (bgi << 6) | qt, lds);
    }
}

DI void phase_merge(const Ctx& c, unsigned char* lds) {
    const int nM = NT / 256, nN = DM / 128;
    const bf16_t* WM = (const bf16_t*)(c.ws + WS_WT_MG);
    const bf16_t* BR = (const bf16_t*)(c.ws + WS_WT_BR);
    const float* BM_ = c.in(I_BMG) + (size_t)c.l * 3 * DM;
    bf16_t* TMP = c.YRAW + (size_t)blockIdx.x * 256 * 128;
    for (int tile = blockIdx.x; tile < nM * nN; tile += gridDim.x) {
        const int tm = tile % nM, tn = tile / nM, m0 = tm * 256, n0 = tn * 128;
#pragma unroll 1
        for (int i = 0; i < 3; ++i) {
            {
                f32x4 ag[4][4]; acc_zero(ag);
                const ARows ar = plain_rows(c.H, DM, m0, TID());
                gemm_core<0>(ag, ar, WM + (size_t)(i * DM + n0) * DM, DM, DM, lds);
                ACC_FOREACH(ag, { const f32x4 bb = *(const f32x4*)(BM_ + i * DM + n0 + c_);
                    store_bf4(TMP + r_ * 128 + c_, (f32x4){sigmoidf_(v_[0] + bb[0]), sigmoidf_(v_[1] + bb[1]), sigmoidf_(v_[2] + bb[2]), sigmoidf_(v_[3] + bb[3])}); });
            }
            f32x4 ab[4][4]; acc_zero(ab);
            if (i == 0) { const ARows ar = plain_rows(c.POOLED, 512, m0, TID()); gemm_core<0>(ab, ar, BR + (size_t)n0 * 512, 512, 512, lds); }
            else if (i == 1) { const ARows ar = plain_rows(c.F + (size_t)5 * NT * 512, 512, m0, TID()); gemm_core<0>(ab, ar, BR + (size_t)1024 * 512 + (size_t)n0 * 512, 512, 512, lds); }
            else { const ARows ar = plain_rows(c.PROJ + C_Q, IN_COLS, m0, TID()); gemm_core<0>(ab, ar, BR + (size_t)2048 * 512 + (size_t)n0 * 1024, 1024, 1024, lds); }
            ACC_FOREACH(ab, {
                bf16_t* q = c.MERGED + (size_t)(m0 + r_) * DM + n0 + c_;
                const u32x2 gv = *(const u32x2*)(TMP + r_ * 128 + c_);
                f32x4 m4 = ((f32x4){0.f, 0.f, 0.f, 0.f});
                if (i > 0) { const u32x2 pv = *(const u32x2*)q; m4 = ((f32x4){bflo(pv.x), bfhi(pv.x), bflo(pv.y), bfhi(pv.y)}); }
                m4[0] += bflo(gv.x) * v_[0]; m4[1] += bfhi(gv.x) * v_[1]; m4[2] += bflo(gv.y) * v_[2]; m4[3] += bfhi(gv.y) * v_[3];
                store_bf4(q, m4); });
        }
    }
}

DI void phase_outp(const Ctx& c, unsigned char* lds) {
    const int nM = NT / 256, nN = DM / 128;
    const bf16_t* W = (const bf16_t*)(c.ws + WS_WT_OUT);
    const float* xin = (c.l == 0) ? c.in(I_X) : c.out;
    for (int tile = blockIdx.x; tile < nM * nN; tile += gridDim.x) {
        const int tm = tile % nM, tn = tile / nM, m0 = tm * 256, n0 = tn * 128;
        f32x4 acc[4][4]; acc_zero(acc);
        const ARows ar = plain_rows(c.MERGED, DM, m0, TID());
        gemm_core<0>(acc, ar, W + (size_t)n0 * DM, DM, DM, lds);
        ACC_FOREACH(acc, { const size_t o = (size_t)(m0 + r_) * DM + n0 + c_; const f32x4 x = *(const f32x4*)(xin + o); *(f32x4*)(c.out + o) = x + v_; });
    }
    for (int it = blockIdx.x; it < 3 * 32 * 64; it += gridDim.x) {
        const int mat = it / 2048, e = (it >> 6) & 31, tl = it & 63;
        if (mat == 0) convert_tile(c.in(I_EG) + ((size_t)c.l * 32 + e) * DM * 256, 256, 256, DM, (bf16_t*)(c.ws + WS_EG) + (size_t)e * 256 * DM, tl, lds);
        else if (mat == 1) convert_tile(c.in(I_EU) + ((size_t)c.l * 32 + e) * DM * 256, 256, 256, DM, (bf16_t*)(c.ws + WS_EU) + (size_t)e * 256 * DM, tl, lds);
        else convert_tile(c.in(I_ED) + ((size_t)c.l * 32 + e) * 256 * DM, DM, DM, 256, (bf16_t*)(c.ws + WS_ED) + (size_t)e * DM * 256, tl, lds);
    }
}

DI void phase_norm2(const Ctx& c) {
    const int tid = TID(), lane = tid & 63, wave = tid >> 6;
    const float* gain = c.in(I_NFFN) + c.l * DM;
    const float* wrg = c.in(I_WRG) + (size_t)c.l * DM * 4; const float* brg = c.in(I_BRG) + c.l * 4;
    const float* wre = c.in(I_WRE) + (size_t)c.l * DM * 32; const float* bre = c.in(I_BRE) + c.l * 32;
    unsigned* cnt = c.ctl + CW_CNT + c.l * 32;
    for (int row = blockIdx.x * 8 + wave; row < NT; row += gridDim.x * 8) {
        f32x4 v[4];
        float ss = 0.f;
#pragma unroll
        for (int i = 0; i < 4; ++i) { v[i] = *(const f32x4*)(c.out + (size_t)row * DM + i * 256 + lane * 4); ss += v[i][0] * v[i][0] + v[i][1] * v[i][1] + v[i][2] * v[i][2] + v[i][3] * v[i][3]; }
        ss = wave_sum(ss);
        const float rs = rsqrtf(ss * (1.0f / DM) + 1e-6f);
#pragma unroll
        for (int i = 0; i < 4; ++i) {
            const f32x4 g = *(const f32x4*)(gain + i * 256 + lane * 4);
            v[i] = (f32x4){v[i][0] * rs * g[0], v[i][1] * rs * g[1], v[i][2] * rs * g[2], v[i][3] * rs * g[3]};
            store_bf4(c.H + (size_t)row * DM + i * 256 + lane * 4, v[i]);
        }
        float lgp[4] = {0.f, 0.f, 0.f, 0.f};
#pragma unroll
        for (int i = 0; i < 4; ++i)
#pragma unroll
            for (int j = 0; j < 4; ++j) { const f32x4 w = *(const f32x4*)(wrg + (size_t)(i * 256 + lane * 4 + j) * 4); lgp[0] += v[i][j] * w[0]; lgp[1] += v[i][j] * w[1]; lgp[2] += v[i][j] * w[2]; lgp[3] += v[i][j] * w[3]; }
#pragma unroll
        for (int o = 0; o < 4; ++o) lgp[o] = wave_sum(lgp[o]) + brg[o];
        int grp = 0; float gm = lgp[0];
#pragma unroll
        for (int o = 1; o < 4; ++o) if (lgp[o] > gm) { gm = lgp[o]; grp = o; }
        float gs = 0.f;
#pragma unroll
        for (int o = 0; o < 4; ++o) gs += __expf(lgp[o] - gm);
        const float ptop = 1.0f / gs;
        float le[8] = {0.f, 0.f, 0.f, 0.f, 0.f, 0.f, 0.f, 0.f};
#pragma unroll
        for (int i = 0; i < 4; ++i)
#pragma unroll
            for (int j = 0; j < 4; ++j) {
                const float* wp = wre + (size_t)(i * 256 + lane * 4 + j) * 32 + grp * 8;
                const f32x4 w0 = *(const f32x4*)wp, w1 = *(const f32x4*)(wp + 4);
                le[0] += v[i][j] * w0[0]; le[1] += v[i][j] * w0[1]; le[2] += v[i][j] * w0[2]; le[3] += v[i][j] * w0[3];
                le[4] += v[i][j] * w1[0]; le[5] += v[i][j] * w1[1]; le[6] += v[i][j] * w1[2]; le[7] += v[i][j] * w1[3];
            }
#pragma unroll
        for (int o = 0; o < 8; ++o) le[o] = wave_sum(le[o]) + bre[grp * 8 + o];
        int i0 = 0; float v0 = le[0];
#pragma unroll
        for (int o = 1; o < 8; ++o) if (le[o] > v0) { v0 = le[o]; i0 = o; }
        int i1 = -1; float v1 = -INFINITY;
#pragma unroll
        for (int o = 0; o < 8; ++o) if (o != i0 && le[o] > v1) { v1 = le[o]; i1 = o; }
        const float e1 = __expf(v1 - v0), inv = 1.0f / (1.0f + e1);
        if (lane == 0) {
            int* rt = c.ROUTE + (size_t)row * 8;
            const int ex0 = grp * 8 + i0, ex1 = grp * 8 + i1;
            rt[0] = ex0; rt[1] = ex1; ((float*)rt)[2] = inv * ptop; ((float*)rt)[3] = e1 * inv * ptop;
            atomicAdd(cnt + ex0, 1u); atomicAdd(cnt + ex1, 1u);
        }
    }
}
DI void phase_route2(const Ctx& c, unsigned char* lds) {
    int* soff = (int*)lds;
    const unsigned* cnt = c.ctl + CW_CNT + c.l * 32;
    unsigned* cur = c.ctl + CW_CUR + c.l * 32;
    __syncthreads();
    if (TID() == 0) { int s = 0; for (int e = 0; e < 32; ++e) { soff[e] = s; s += (int)cnt[e]; } }
    __syncthreads();
    for (int t = blockIdx.x * NTHREADS + TID(); t < NT; t += gridDim.x * NTHREADS) {
        int* rt = c.ROUTE + (size_t)t * 8;
#pragma unroll
        for (int s = 0; s < 2; ++s) {
            const int e = rt[s];
            const int p = soff[e] + (int)atomicAdd(cur + e, 1u);
            rt[4 + s] = p;
            c.ENT[2 * p] = t; ((float*)c.ENT)[2 * p + 1] = ((const float*)rt)[2 + s];
        }
    }
}
DI void moe_tables(const Ctx& c, int* soff, int* stile, int ncol) {
    const unsigned* cnt = c.ctl + CW_CNT + c.l * 32;
    __syncthreads();
    if (TID() == 0) { int s = 0, tt = 0; for (int e = 0; e < 32; ++e) { soff[e] = s; stile[e] = tt; s += (int)cnt[e]; tt += (((int)cnt[e] + 255) >> 8) * ncol; } soff[32] = s; stile[32] = tt; }
    __syncthreads();
}
DI void phase_moe_up(const Ctx& c, unsigned char* lds) {
    int* soff = (int*)(lds + 2 * G_STAGE); int* stile = soff + 64;
    moe_tables(c, soff, stile, 2);
    const int total = stile[32];
    for (int item = blockIdx.x; item < total; item += gridDim.x) {
        int e = 0;
        for (int q = 1; q < 32; ++q) if (stile[q] <= item) e = q;
        const int loc = item - stile[e], tm = loc >> 1, tn = loc & 1, n0 = tn * 128;
        const int p0 = soff[e] + tm * 256, pend = soff[e + 1];
        ARows ar;
#pragma unroll
        for (int i = 0; i < 4; ++i) { const int pr = p0 + (TID() >> 3) + 64 * i; ar.p[i] = (pr < pend) ? c.H + (size_t)c.ENT[2 * pr] * DM : nullptr; }
        {
            f32x4 ag[4][4]; acc_zero(ag);
            gemm_core<0>(ag, ar, (const bf16_t*)(c.ws + WS_EG) + ((size_t)e * 256 + n0) * DM, DM, DM, lds);
            ACC_FOREACH(ag, { if (p0 + r_ < pend) store_bf4(c.HID + (size_t)(p0 + r_) * 256 + n0 + c_, (f32x4){v_[0] * sigmoidf_(v_[0]), v_[1] * sigmoidf_(v_[1]), v_[2] * sigmoidf_(v_[2]), v_[3] * sigmoidf_(v_[3])}); });
        }
        f32x4 au[4][4]; acc_zero(au);
        gemm_core<0>(au, ar, (const bf16_t*)(c.ws + WS_EU) + ((size_t)e * 256 + n0) * DM, DM, DM, lds);
        ACC_FOREACH(au, { if (p0 + r_ < pend) { bf16_t* q = c.HID + (size_t)(p0 + r_) * 256 + n0 + c_; const u32x2 sv = *(const u32x2*)q;
            store_bf4(q, (f32x4){bflo(sv.x) * v_[0], bfhi(sv.x) * v_[1], bflo(sv.y) * v_[2], bfhi(sv.y) * v_[3]}); } });
    }
}
DI void phase_moe_down(const Ctx& c, unsigned char* lds) {
    int* soff = (int*)(lds + 2 * G_STAGE); int* stile = soff + 64;
    moe_tables(c, soff, stile, 8);
    const int total = stile[32];
    for (int item = blockIdx.x; item < total; item += gridDim.x) {
        int e = 0;
        for (int q = 1; q < 32; ++q) if (stile[q] <= item) e = q;
        const int loc = item - stile[e], tm = loc >> 3, tn = loc & 7, n0 = tn * 128;
        const int p0 = soff[e] + tm * 256, pend = soff[e + 1];
        ARows ar;
#pragma unroll
        for (int i = 0; i < 4; ++i) { const int pr = p0 + (TID() >> 3) + 64 * i; ar.p[i] = (pr < pend) ? c.HID + (size_t)pr * 256 : nullptr; }
        f32x4 acc[4][4]; acc_zero(acc);
        gemm_core<0>(acc, ar, (const bf16_t*)(c.ws + WS_ED) + ((size_t)e * DM + n0) * 256, 256, 256, lds);
        ACC_FOREACH(acc, { if (p0 + r_ < pend) { const float w = ((const float*)c.ENT)[2 * (p0 + r_) + 1];
            store_bf4(c.Y + (size_t)(p0 + r_) * DM + n0 + c_, (f32x4){v_[0] * w, v_[1] * w, v_[2] * w, v_[3] * w}); } });
    }
}
DI void phase_final(const Ctx& c) {
    const int tid = TID(), lane = tid & 63, wave = tid >> 6;
    const float* gain = c.in(I_NFIN);
    for (int row = blockIdx.x * 8 + wave; row < NT; row += gridDim.x * 8) {
        f32x4 v[4];
#pragma unroll
        for (int i = 0; i < 4; ++i) v[i] = *(const f32x4*)(c.out + (size_t)row * DM + i * 256 + lane * 4);
        add_moe_rows(c, row, lane, v);
        float ss = 0.f;
#pragma unroll
        for (int i = 0; i < 4; ++i) ss += v[i][0] * v[i][0] + v[i][1] * v[i][1] + v[i][2] * v[i][2] + v[i][3] * v[i][3];
        ss = wave_sum(ss);
        const float rs = rsqrtf(ss * (1.0f / DM) + 1e-6f);
#pragma unroll
        for (int i = 0; i < 4; ++i) {
            const f32x4 g = *(const f32x4*)(gain + i * 256 + lane * 4);
            *(f32x4*)(c.out + (size_t)row * DM + i * 256 + lane * 4) = (f32x4){v[i][0] * rs * g[0], v[i][1] * rs * g[1], v[i][2] * rs * g[2], v[i][3] * rs * g[3]};
        }
    }
}

constexpr int PH_PER_LAYER = 12, N_PHASES = DEPTH * PH_PER_LAYER + 1;
__global__ void __launch_bounds__(NTHREADS, 2) fwd_kernel(Params P) {
    extern __shared__ __attribute__((aligned(16))) unsigned char lds[];
    const int lo = P.ph_lo, hi = P.ph_hi;
    LAS unsigned* xbw = (LAS unsigned*)(lds + LDS_BYTES - 16);
    if (threadIdx.x == 0) { xbw[0] = 0u; xbw[1] = 0u; xbw[2] = 0u; xbw[3] = 0u; }
    __syncthreads();
    Ctx c; c.P = &P; c.ws = P.ws; c.out = P.out; c.l = 0;
    c.ctl = (unsigned*)(P.ws + WS_CTL);
    c.H = (bf16_t*)(P.ws + WS_H); c.PROJ = (bf16_t*)(P.ws + WS_PROJ); c.F = (bf16_t*)(P.ws + WS_F); c.POOLED = (bf16_t*)(P.ws + WS_POOLED);
    c.MERGED = (bf16_t*)(P.ws + WS_F); c.CMPH = (bf16_t*)(P.ws + WS_CMPH); c.CMPO = (float*)(P.ws + WS_CMPO); c.POSB = (float*)(P.ws + WS_POSB);
    c.ROUTE = (int*)(P.ws + WS_ROUTE); c.ENT = (int*)(P.ws + WS_ENT); c.HID = (bf16_t*)(P.ws + WS_HID); c.Y = (bf16_t*)(P.ws + WS_Y);
    c.VT = (bf16_t*)(P.ws + WS_VT); c.KC = (bf16_t*)(P.ws + WS_KC); c.VCT = (bf16_t*)(P.ws + WS_VCT); c.YRAW = (bf16_t*)(P.ws + WS_YRAW); c.BON = (float*)(P.ws + WS_BON);
    XcdBarrier bar; bar.bar = c.ctl + CW_BAR; bar.x = 0; bar.st = (volatile LAS unsigned*)xbw;
    if (hi - lo > 1) bar = xcd_barrier_post(c.ctl + CW_BAR, (volatile LAS unsigned*)xbw);
#define IN(k) (lo <= (k) && (k) < hi)
#define SEAM(k) do { if (IN(k) && IN((k) + 1)) xcd_barrier(bar); } while (0)
#pragma unroll 1
    for (int l = 0; l < DEPTH; ++l) {
        c.l = l; const int pb = l * PH_PER_LAYER;
        if (IN(pb + 0)) phase_norm1(c, lds);
        SEAM(pb + 0);
        if (IN(pb + 1)) phase_gemm1(c, lds);
        SEAM(pb + 1);
        if (IN(pb + 2)) phase_prep(c, lds);
        SEAM(pb + 2);
        if (IN(pb + 3)) phase_poolgemm(c, lds);
        SEAM(pb + 3);
        if (IN(pb + 4)) phase_mix(c, lds);
        SEAM(pb + 4);
        if (IN(pb + 5)) phase_rwkv_post(c, lds);
        SEAM(pb + 5);
        if (IN(pb + 6)) phase_merge(c, lds);
        SEAM(pb + 6);
        if (IN(pb + 7)) phase_outp(c, lds);
        SEAM(pb + 7);
        if (IN(pb + 8)) phase_norm2(c);
        SEAM(pb + 8);
        if (IN(pb + 9)) phase_route2(c, lds);
        SEAM(pb + 9);
        if (IN(pb + 10)) phase_moe_up(c, lds);
        SEAM(pb + 10);
        if (IN(pb + 11)) phase_moe_down(c, lds);
        SEAM(pb + 11);
    }
    if (IN(N_PHASES - 1)) phase_final(c);
}

#ifndef MK_N_LAUNCHES
#define MK_N_LAUNCHES 1
#endif
extern "C" void kernel_launch(void* const* d_in, const int* in_sizes, int n_in, void* d_out, int out_size, void* d_ws, size_t ws_size, hipStream_t stream) {
    static int grid = 0;
    if (grid == 0) {
        if (n_in != N_IN || out_size != NT * DM || ws_size < WS_END) { fprintf(stderr, "kernel_launch: unexpected shapes n_in %d out %d ws %zu (need %zu)\n", n_in, out_size, ws_size, (size_t)WS_END); grid = -1; return; }
        int dev = 0, cus = 0, per_cu = 0;
        if (hipGetDevice(&dev) != hipSuccess || hipDeviceGetAttribute(&cus, hipDeviceAttributeMultiprocessorCount, dev) != hipSuccess) { grid = -1; return; }
        if (hipFuncSetAttribute((const void*)fwd_kernel, hipFuncAttributeMaxDynamicSharedMemorySize, LDS_BYTES) != hipSuccess) { fprintf(stderr, "kernel_launch: hipFuncSetAttribute failed\n"); grid = -1; return; }
        if (hipOccupancyMaxActiveBlocksPerMultiprocessor(&per_cu, (const void*)fwd_kernel, NTHREADS, LDS_BYTES) != hipSuccess || per_cu < 1) { fprintf(stderr, "kernel_launch: occupancy query says %d\n", per_cu); }
        (void)hipGetLastError();
        grid = cus;
    }
    if (grid < 0) return;
    if (hipMemsetAsync((char*)d_ws + WS_CTL, 0, CTL_BYTES, stream) != hipSuccess) return;
    Params p{};
    for (int i = 0; i < N_IN; ++i) p.in[i] = (const float*)d_in[i];
    p.out = (float*)d_out; p.ws = (unsigned char*)d_ws;
    if (MK_N_LAUNCHES == 1) {
        p.ph_lo = 0; p.ph_hi = N_PHASES;
        hipLaunchKernelGGL(fwd_kernel, dim3(grid), dim3(NTHREADS), LDS_BYTES, stream, p);
    } else {
        for (int k = 0; k < N_PHASES; ++k) { p.ph_lo = k; p.ph_hi = k + 1; hipLaunchKernelGGL(fwd_kernel, dim3(grid), dim3(NTHREADS), LDS_BYTES, stream, p); }
    }
}
```

```cpp
#include <hip/hip_runtime.h>
#include <cstdio>
#include <cstdint>

#define DI __device__ __forceinline__
typedef unsigned short bf16_t;
typedef short bf16x8 __attribute__((ext_vector_type(8)));
typedef float f32x4 __attribute__((ext_vector_type(4)));
typedef unsigned u32x4 __attribute__((ext_vector_type(4)));
typedef unsigned u32x2 __attribute__((ext_vector_type(2)));

constexpr int NB = 4, SEQ = 4096, DM = 1024, NT = NB * SEQ, DEPTH = 2;
constexpr int IN_COLS = 4816;
constexpr int C_POOL = 0, C_RW = 512, C_R = 512, C_K = 1024, C_V = 1536, C_WD = 2048, C_AD = 2080, C_GD = 2112;
constexpr int C_Q = 2208, C_KC = 3232, C_VC = 3488, C_KS = 3744, C_VS = 4000, C_KW = 4256, C_VW = 4512, C_GATE = 4768;
constexpr int RWC = 1696;
constexpr int NCMP = 255;
constexpr int NTHREADS = 512;
constexpr int LDS_BYTES = 114688;

enum { I_X = 0, I_RELB, I_NMIX, I_WIN, I_POOLW, I_POOLS, I_MU, I_W0, I_WUP, I_A0, I_AUP, I_GUP, I_KK, I_KA, I_RK, I_GNW, I_GNB,
       I_CPK, I_CW1K, I_CW2K, I_CPV, I_CW1V, I_CW2V, I_WBR, I_WMG, I_BMG, I_WOUT, I_NFFN, I_WRG, I_BRG, I_WRE, I_BRE, I_EG, I_EU, I_ED, I_NFIN, N_IN };

constexpr size_t WS_CTL = 0;
constexpr size_t CTL_BYTES = 65536;
constexpr size_t WS_H = CTL_BYTES;
constexpr size_t WS_PROJ = WS_H + (size_t)NT * DM * 2;
constexpr size_t WS_F = WS_PROJ + (size_t)NT * IN_COLS * 2;
constexpr size_t PLANE = (size_t)NT * 512 * 2;
constexpr size_t WS_POOLED = WS_F + 6 * PLANE;
constexpr size_t WS_CMPH = WS_POOLED + PLANE;
constexpr size_t WS_CMPO = WS_CMPH + (size_t)2 * 4096 * 256 * 2;
constexpr size_t WS_POSB = WS_CMPO + (size_t)2 * 4096 * 64 * 4;
constexpr size_t WS_ROUTE = WS_POSB + 4096;
constexpr size_t WS_ENT = WS_ROUTE + (size_t)NT * 32;
constexpr size_t WS_VT = WS_ENT + (size_t)2 * NT * 8;
constexpr size_t WS_KC = WS_VT + (size_t)2 * 16 * 64 * SEQ * 2;
constexpr size_t WS_VCT = WS_KC + (size_t)16 * 256 * 64 * 2;
constexpr size_t WS_YRAW = WS_VCT + (size_t)16 * 64 * 256 * 2;
constexpr size_t WS_BON = WS_YRAW + (size_t)NT * 512 * 2;
constexpr size_t WS_SMALLW = WS_BON + (size_t)NT * 8 * 16;
constexpr size_t WS_END = WS_SMALLW + 262144;
constexpr size_t WS_WT_IN = WS_F;
constexpr size_t WS_WT_C1 = WS_CMPO;
constexpr size_t WS_WT_C2 = WS_SMALLW;
constexpr size_t WS_WT_POOL = WS_SMALLW + 131072;
constexpr size_t WS_WT_MG = WS_VT;
constexpr size_t WS_WT_BR = WS_VT + (size_t)3072 * 1024 * 2;
constexpr size_t WS_WT_OUT = WS_CMPH;
constexpr size_t WS_EG = WS_F + 2 * PLANE;
constexpr size_t WS_EU = WS_EG + (size_t)32 * 256 * 1024 * 2;
constexpr size_t WS_ED = WS_EU + (size_t)32 * 256 * 1024 * 2;
static_assert(WS_ED + (size_t)32 * 1024 * 256 * 2 <= WS_F + 6 * PLANE, "expert alias");
static_assert(WS_WT_BR + (size_t)2048 * 1024 * 2 <= WS_VT + (size_t)2 * 16 * 64 * SEQ * 2, "merge alias");
static_assert((size_t)4864 * 1024 * 2 <= 6 * PLANE, "w_in alias");
constexpr size_t WS_HID = WS_PROJ;
constexpr size_t WS_Y = WS_PROJ + (size_t)2 * NT * 256 * 2;
static_assert(WS_Y + (size_t)2 * NT * 1024 * 2 <= WS_F, "alias");
constexpr int CW_BAR = 0;
constexpr int CW_CNT = 4096;
constexpr int CW_CUR = 4096 + 64;
constexpr int CW_Q = 4096 + 128;

#define XB_TMO      128
#define XB_XCNT(j)  (256  + 64 * (j))
#define XB_XSUB(j)  (1280 + 64 * (j))
#define XB_XGEN(j)  (2304 + 64 * (j))
#define XB_TOP      3328
#define XB_TOPGEN   3392
#define XCD_BAR_WORDS 3456
#define XB_SPIN_CAP (1u << 18)
#define LAS __attribute__((address_space(3)))

__device__ __forceinline__ unsigned xb_ld(unsigned* p)              { return __hip_atomic_load(p, __ATOMIC_RELAXED, __HIP_MEMORY_SCOPE_AGENT); }
__device__ __forceinline__ unsigned xb_add(unsigned* p, unsigned v) { return __hip_atomic_fetch_add(p, v, __ATOMIC_RELAXED, __HIP_MEMORY_SCOPE_AGENT); }
__device__ __forceinline__ unsigned xb_xcc_id() { return (unsigned)__builtin_amdgcn_s_getreg((3 << 11) | 20) & 0xFu; }
#define XB_SPIN(cond, bar) do { unsigned _sp = 0; while (cond) { __builtin_amdgcn_s_sleep(1); \
    if ((++_sp & 255u) == 0u) { if (xb_ld(&(bar)[XB_TMO])) break; if (_sp > XB_SPIN_CAP) { atomicAdd(&(bar)[XB_TMO], 1u); break; } } } } while (0)

struct XcdBarrier { unsigned* bar; unsigned x; volatile LAS unsigned* st; };

__device__ __forceinline__ XcdBarrier xcd_barrier_post(unsigned* bar, volatile LAS unsigned* st) {
    XcdBarrier b; b.bar = bar; b.x = xb_xcc_id(); b.st = st;
    if (threadIdx.x == 0) (void)xb_add(&bar[XB_XCNT(b.x)], 1u);
    return b;
}
__device__ __forceinline__ void xcd_barrier_complete(unsigned* bar, unsigned x, unsigned& nloc, unsigned& nx) {
    const unsigned G = gridDim.x * gridDim.y * gridDim.z;
    unsigned sum, cnt, mine, sp = 0u;
    for (;;) {
        sum = 0u; cnt = 0u; mine = 0u;
#pragma unroll
        for (unsigned j = 0; j < 16; ++j) { const unsigned c = xb_ld(&bar[XB_XCNT(j)]); sum += c; cnt += (c > 0u) ? 1u : 0u; mine = (j == x) ? c : mine; }
        if (sum == G) break;
        __builtin_amdgcn_s_sleep(1);
        if ((++sp & 255u) == 0u) { if (xb_ld(&bar[XB_TMO])) break; if (sp > XB_SPIN_CAP) { atomicAdd(&bar[XB_TMO], 1u); break; } }
    }
    nloc = mine > 0u ? mine : 1u; nx = cnt > 0u ? cnt : 1u;
}
__device__ __forceinline__ void xcd_barrier(const XcdBarrier& b) {
    asm volatile("s_waitcnt vmcnt(0)" ::: "memory");
    __syncthreads();
    if (threadIdx.x == 0) {
        unsigned* bar = b.bar;
        __builtin_amdgcn_s_waitcnt(0);
        unsigned nloc = b.st[0], nx = b.st[1];
        if (nloc == 0u) { xcd_barrier_complete(bar, b.x, nloc, nx); b.st[0] = nloc; b.st[1] = nx; }
        const unsigned old = xb_add(&bar[XB_XSUB(b.x)], 1u);
        const unsigned gen = old / nloc;
        if (old + 1u == (gen + 1u) * nloc) {
            __builtin_amdgcn_fence(__ATOMIC_RELEASE, "agent");
            asm volatile("s_waitcnt vmcnt(0)" ::: "memory");
            const unsigned og = xb_add(&bar[XB_TOP], 1u);
            const unsigned tg = og / nx;
            if (og + 1u == (tg + 1u) * nx) xb_add(&bar[XB_TOPGEN], 1u);
            else XB_SPIN(xb_ld(&bar[XB_TOPGEN]) == tg, bar);
            __builtin_amdgcn_fence(__ATOMIC_ACQUIRE, "agent");
            xb_add(&bar[XB_XGEN(b.x)], 1u);
            asm volatile("s_waitcnt vmcnt(0)" ::: "memory");
        } else {
            XB_SPIN(xb_ld(&bar[XB_XGEN(b.x)]) == gen, bar);
            __builtin_amdgcn_fence(__ATOMIC_ACQUIRE, "agent");
            asm volatile("s_waitcnt vmcnt(0)" ::: "memory");
        }
    }
    __syncthreads();
}

DI bf16_t f2bf(float x) { unsigned u = __float_as_uint(x); u += 0x7fffu + ((u >> 16) & 1u); return (bf16_t)(u >> 16); }
DI float bf2f(bf16_t b) { return __uint_as_float((unsigned)b << 16); }
DI unsigned pack2(float lo, float hi) { unsigned r; asm("v_cvt_pk_bf16_f32 %0, %1, %2" : "=v"(r) : "v"(lo), "v"(hi)); return r; }
DI float bflo(unsigned w) { return __uint_as_float(w << 16); }
DI float bfhi(unsigned w) { return __uint_as_float(w & 0xffff0000u); }
DI float wave_sum(float v) {
#pragma unroll
    for (int o = 32; o >= 1; o >>= 1) v += __shfl_xor(v, o);
    return v;
}
DI float wave_max(float v) {
#pragma unroll
    for (int o = 32; o >= 1; o >>= 1) v = fmaxf(v, __shfl_xor(v, o));
    return v;
}
DI float sigmoidf_(float x) { return __builtin_amdgcn_rcpf(1.0f + __expf(-x)); }
DI int TID() { int t = threadIdx.x; asm volatile("" : "+v"(t)); return t; }
#define LDS_WAVE_SYNC() asm volatile("s_waitcnt lgkmcnt(0)" ::: "memory")

#define DPP_MOV(v, ctrl) __builtin_bit_cast(float, __builtin_amdgcn_update_dpp(0, __builtin_bit_cast(int, (v)), (ctrl), 0xF, 0xF, true))
DI float wave_sum_dpp(float v) {
    v += DPP_MOV(v, 0xB1); v += DPP_MOV(v, 0x4E); v += DPP_MOV(v, 0x141); v += DPP_MOV(v, 0x140);
    return __builtin_bit_cast(float, __builtin_amdgcn_readlane(__builtin_bit_cast(int, v), 0)) + __builtin_bit_cast(float, __builtin_amdgcn_readlane(__builtin_bit_cast(int, v), 16)) +
        (__builtin_bit_cast(float, __builtin_amdgcn_readlane(__builtin_bit_cast(int, v), 32)) + __builtin_bit_cast(float, __builtin_amdgcn_readlane(__builtin_bit_cast(int, v), 48)));
}
struct Params { const float* in[N_IN]; float* out; unsigned char* ws; int ph_lo, ph_hi; };

DI int t5_bucket(int n) {
    if (n < 16) return n;
    if (n >= 128) return 31;
    int b = 16;
    b += (n >= 19) + (n >= 21) + (n >= 24) + (n >= 27) + (n >= 31) + (n >= 35) + (n >= 40) + (n >= 46) + (n >= 52) + (n >= 59) + (n >= 67) + (n >= 77) + (n >= 87) + (n >= 99) + (n >= 113);
    return b;
}

constexpr int GS = 72;
constexpr int G_A = 0, G_B = 256 * GS * 2, G_STAGE = (256 + 128) * GS * 2;
static_assert(2 * G_STAGE <= LDS_BYTES - 64, "gemm lds");
struct ARows { const bf16_t* p[4]; };
template <int AMODE>
DI void g_load(u32x4 (&ra)[4], u32x4 (&rb)[2], const ARows& ar, const bf16_t* bt, int ldb, int k0, int tid) {
    const int kseg = (tid & 7) * 8;
#pragma unroll
    for (int i = 0; i < 4; ++i) {
        ra[i] = (u32x4){0u, 0u, 0u, 0u};
        if (ar.p[i] != nullptr) ra[i] = *(const u32x4*)((AMODE == 0) ? (ar.p[i] + k0 + kseg) : (ar.p[i] + (size_t)(k0 >> 6) * IN_COLS + kseg));
    }
#pragma unroll
    for (int i = 0; i < 2; ++i) rb[i] = *(const u32x4*)(bt + (size_t)((tid >> 3) + 64 * i) * ldb + k0 + kseg);
}
DI void g_store(unsigned char* st, const u32x4 (&ra)[4], const u32x4 (&rb)[2], int tid) {
    const int r = tid >> 3, kseg = (tid & 7) * 8;
#pragma unroll
    for (int i = 0; i < 4; ++i) *(u32x4*)((bf16_t*)(st + G_A) + (r + 64 * i) * GS + kseg) = ra[i];
#pragma unroll
    for (int i = 0; i < 2; ++i) *(u32x4*)((bf16_t*)(st + G_B) + (r + 64 * i) * GS + kseg) = rb[i];
}
DI void g_compute(f32x4 (&acc)[4][4], const unsigned char* st, int lane, int wm, int wn) {
    const bf16_t* sA = (const bf16_t*)(st + G_A) + (wm * 64 + (lane & 15)) * GS + (lane >> 4) * 8;
    const bf16_t* sB = (const bf16_t*)(st + G_B) + (wn * 64 + (lane & 15)) * GS + (lane >> 4) * 8;
#pragma unroll
    for (int ks = 0; ks < 2; ++ks) {
        bf16x8 af[4], bfr[4];
#pragma unroll
        for (int i = 0; i < 4; ++i) { af[i] = *(const bf16x8*)(sA + i * 16 * GS + ks * 32); bfr[i] = *(const bf16x8*)(sB + i * 16 * GS + ks * 32); }
#pragma unroll
        for (int mi = 0; mi < 4; ++mi)
#pragma unroll
            for (int ni = 0; ni < 4; ++ni) acc[mi][ni] = __builtin_amdgcn_mfma_f32_16x16x32_bf16(bfr[ni], af[mi], acc[mi][ni], 0, 0, 0);
    }
}
template <int AMODE>
DI void gemm_core(f32x4 (&acc)[4][4], const ARows& ar, const bf16_t* bt  , int ldb, int K, unsigned char* lds) {
    const int tid = TID(), lane = tid & 63, wave = tid >> 6, wm = wave >> 1, wn = wave & 1;
    const int nk = K >> 6;
    unsigned char* s0 = lds; unsigned char* s1 = lds + G_STAGE;
    u32x4 ra0[4], rb0[2], ra1[4], rb1[2];
    g_load<AMODE>(ra0, rb0, ar, bt, ldb, 0, tid);
    if (nk > 1) g_load<AMODE>(ra1, rb1, ar, bt, ldb, 64, tid);
    __syncthreads();
    g_store(s0, ra0, rb0, tid);
    if (nk > 2) g_load<AMODE>(ra0, rb0, ar, bt, ldb, 128, tid);
    __syncthreads();
    for (int kt = 0; kt < nk; kt += 2) {
        if (kt + 1 < nk) { g_store(s1, ra1, rb1, tid); if (kt + 3 < nk) g_load<AMODE>(ra1, rb1, ar, bt, ldb, (kt + 3) * 64, tid); }
        g_compute(acc, s0, lane, wm, wn);
        __syncthreads();
        if (kt + 1 >= nk) break;
        if (kt + 2 < nk) { g_store(s0, ra0, rb0, tid); if (kt + 4 < nk) g_load<AMODE>(ra0, rb0, ar, bt, ldb, (kt + 4) * 64, tid); }
        g_compute(acc, s1, lane, wm, wn);
        __syncthreads();
    }
}
DI void acc_zero(f32x4 (&acc)[4][4]) {
#pragma unroll
    for (int i = 0; i < 4; ++i)
#pragma unroll
        for (int j = 0; j < 4; ++j) acc[i][j] = (f32x4){0.f, 0.f, 0.f, 0.f};
}
#define ACC_FOREACH(acc, body) do { const int _l = TID() & 63, _w = TID() >> 6; \
    _Pragma("unroll") for (int _mi = 0; _mi < 4; ++_mi) _Pragma("unroll") for (int _ni = 0; _ni < 4; ++_ni) { \
        const int r_ = (_w >> 1) * 64 + _mi * 16 + (_l & 15), c_ = (_w & 1) * 64 + _ni * 16 + (_l >> 4) * 4; f32x4& v_ = acc[_mi][_ni]; body } } while (0)
DI ARows plain_rows(const bf16_t* base, size_t ld, int m0, int tid) { ARows a;
#pragma unroll
    for (int i = 0; i < 4; ++i) a.p[i] = base + (size_t)(m0 + (tid >> 3) + 64 * i) * ld;
    return a; }

DI void store_bf4(bf16_t* p, f32x4 v) { u32x2 w; w.x = pack2(v[0], v[1]); w.y = pack2(v[2], v[3]); *(u32x2*)p = w; }

DI void convert_tile(const float* src, int ld, int N, int K, bf16_t* dst, int tile, unsigned char* lds) {
    const int tid = TID();
    const int nkt = K >> 6, tk = tile % nkt, tn = tile / nkt, k0 = tk * 64, n0 = tn * 64;
    bf16_t* T = (bf16_t*)lds;
    const int r = tid >> 3, seg = (tid & 7) * 8;
    f32x4 a = (f32x4){0.f, 0.f, 0.f, 0.f}, b = a;
    if (n0 + seg < N) { const float* q = src + (size_t)(k0 + r) * ld + n0 + seg; a = *(const f32x4*)q; b = *(const f32x4*)(q + 4); }
    __syncthreads();
    { u32x4 w; w.x = pack2(a[0], a[1]); w.y = pack2(a[2], a[3]); w.z = pack2(b[0], b[1]); w.w = pack2(b[2], b[3]); *(u32x4*)(T + r * 72 + seg) = w; }
    __syncthreads();
    u32x4 o;
    o.x = (unsigned)T[(seg + 0) * 72 + r] | ((unsigned)T[(seg + 1) * 72 + r] << 16); o.y = (unsigned)T[(seg + 2) * 72 + r] | ((unsigned)T[(seg + 3) * 72 + r] << 16);
    o.z = (unsigned)T[(seg + 4) * 72 + r] | ((unsigned)T[(seg + 5) * 72 + r] << 16); o.w = (unsigned)T[(seg + 6) * 72 + r] | ((unsigned)T[(seg + 7) * 72 + r] << 16);
    *(u32x4*)(dst + (size_t)(n0 + r) * K + k0 + seg) = o;
}

struct Ctx {
    const Params* P; unsigned char* ws; float* out; int l;
    bf16_t* H; bf16_t* PROJ; bf16_t* F; bf16_t* POOLED; bf16_t* MERGED; bf16_t* CMPH; float* CMPO; float* POSB; int* ROUTE; int* ENT; bf16_t* HID; bf16_t* Y; bf16_t* VT; bf16_t* KC; bf16_t* VCT; bf16_t* YRAW; float* BON; unsigned* ctl;
    DI const float* in(int i) const { return P->in[i]; }
};

DI void add_moe_rows(const Ctx& c, int row, int lane, f32x4 (&v)[4]) {
    const int* rt = c.ROUTE + (size_t)row * 8;
    const int p0 = rt[4], p1 = rt[5];
    const bf16_t* y0 = c.Y + (size_t)p0 * DM; const bf16_t* y1 = c.Y + (size_t)p1 * DM;
#pragma unroll
    for (int i = 0; i < 4; ++i) {
        const u32x2 a = *(const u32x2*)(y0 + i * 256 + lane * 4), b = *(const u32x2*)(y1 + i * 256 + lane * 4);
        v[i][0] += bflo(a.x) + bflo(b.x); v[i][1] += bfhi(a.x) + bfhi(b.x); v[i][2] += bflo(a.y) + bflo(b.y); v[i][3] += bfhi(a.y) + bfhi(b.y);
    }
}
DI void phase_norm1(const Ctx& c, unsigned char* lds) {
    const int tid = TID(), lane = tid & 63, wave = tid >> 6;
    const float* gain = c.in(I_NMIX) + c.l * DM;
    const float* src = (c.l == 0) ? c.in(I_X) : c.out;
    for (int row = blockIdx.x * 8 + wave; row < NT; row += gridDim.x * 8) {
        f32x4 v[4];
#pragma unroll
        for (int i = 0; i < 4; ++i) v[i] = *(const f32x4*)(src + (size_t)row * DM + i * 256 + lane * 4);
        if (c.l > 0) {
            add_moe_rows(c, row, lane, v);
#pragma unroll
            for (int i = 0; i < 4; ++i) *(f32x4*)(c.out + (size_t)row * DM + i * 256 + lane * 4) = v[i];
        }
        float ss = 0.f;
#pragma unroll
        for (int i = 0; i < 4; ++i) ss += v[i][0] * v[i][0] + v[i][1] * v[i][1] + v[i][2] * v[i][2] + v[i][3] * v[i][3];
        ss = wave_sum_dpp(ss);
        const float rs = rsqrtf(ss * (1.0f / DM) + 1e-6f);
#pragma unroll
        for (int i = 0; i < 4; ++i) {
            const f32x4 g = *(const f32x4*)(gain + i * 256 + lane * 4);
            store_bf4(c.H + (size_t)row * DM + i * 256 + lane * 4, (f32x4){v[i][0] * rs * g[0], v[i][1] * rs * g[1], v[i][2] * rs * g[2], v[i][3] * rs * g[3]});
        }
    }
    for (int idx = blockIdx.x * 8 + wave; idx < 512; idx += gridDim.x * 8) {
        const int kv = idx >> 8, n = idx & 255;
        const float* pos = c.in(kv ? I_CPV : I_CPK) + (size_t)c.l * 2048;
        const float* w1 = c.in(kv ? I_CW1V : I_CW1K) + (size_t)c.l * 2048 * 256;
        float s = 0.f;
        for (int k = lane; k < 2048; k += 64) s += pos[k] * w1[(size_t)k * 256 + n];
        s = wave_sum_dpp(s);
        if (lane == 0) c.POSB[kv * 256 + n] = s;
    }
    for (int it = blockIdx.x; it < 1216 + 256 + 16 + 16; it += gridDim.x) {
        if (it < 1216) convert_tile(c.in(I_WIN) + (size_t)c.l * DM * IN_COLS, IN_COLS, IN_COLS, DM, (bf16_t*)(c.ws + WS_WT_IN), it, lds);
        else if (it < 1216 + 256) { const int j = it - 1216, kv = j >> 7; convert_tile(c.in(kv ? I_CW1V : I_CW1K) + (size_t)c.l * 2048 * 256, 256, 256, 2048, (bf16_t*)(c.ws + WS_WT_C1) + (size_t)kv * 256 * 2048, j & 127, lds); }
        else if (it < 1216 + 256 + 16) { const int j = it - 1472, kv = j >> 3; convert_tile(c.in(kv ? I_CW2V : I_CW2K) + (size_t)c.l * 256 * 64, 64, 64, 256, (bf16_t*)(c.ws + WS_WT_C2) + (size_t)kv * 128 * 256, j & 7, lds); }
        else { const int j = it - 1488, gi = j >> 2; convert_tile(c.in(I_POOLW) + ((size_t)c.l * 4 + gi) * 128 * 128, 128, 128, 128, (bf16_t*)(c.ws + WS_WT_POOL) + (size_t)gi * 128 * 128, j & 3, lds); }
    }
}

DI void phase_gemm1(const Ctx& c, unsigned char* lds) {
    const int nM = NT / 256, nN = (IN_COLS + 127) / 128;
    const bf16_t* WT = (const bf16_t*)(c.ws + WS_WT_IN);
    for (int tile = blockIdx.x; tile < nM * nN; tile += gridDim.x) {
        const int tm = tile % nM, tn = tile / nM, m0 = tm * 256, n0 = tn * 128;
        f32x4 acc[4][4]; acc_zero(acc);
        const ARows ar = plain_rows(c.H, DM, m0, TID());
        gemm_core<0>(acc, ar, WT + (size_t)n0 * DM, DM, DM, lds);
        ACC_FOREACH(acc, { if (n0 + c_ < IN_COLS) store_bf4(c.PROJ + (size_t)(m0 + r_) * IN_COLS + n0 + c_, v_); });
    }
}

DI float gelu_tanh(float x) { const float u = 0.7978845608028654f * (x + 0.044715f * x * x * x); const float e = __expf(2.0f * u); return x * (1.0f - __builtin_amdgcn_rcpf(e + 1.0f)); }
DI float softplusf_(float x) { return (x > 20.f) ? x : __logf(1.0f + __expf(x)); }
DI float tanhf_(float x) { const float e = __expf(2.0f * x); return 1.0f - 2.0f * __builtin_amdgcn_rcpf(e + 1.0f); }
template <int WIN>
DI void pool_emit(const Ctx& c, const float (&pv)[31], int t0, int s0, int ch) {
#pragma unroll
    for (int k = 0; k < 16; ++k) {
        float sum = 0.f;
#pragma unroll
        for (int j = 0; j < WIN; ++j) sum += pv[15 + k - j];
        const int s = s0 + k, cnt = (s + 1 < WIN) ? s + 1 : WIN;
        c.POOLED[(size_t)(t0 + k) * 512 + ch] = f2bf(sum / (float)cnt - pv[15 + k]);
    }
}
DI void phase_prep(const Ctx& c, unsigned char* lds) {
    const int tid = TID();
    const int n_cmp_items = 2 * 16 * 2;
    const int n_prep = n_cmp_items + NT / 16;
    const int n_items = n_prep + 2048;
    for (int item = blockIdx.x; item < n_items; item += gridDim.x) {
        if (item < n_cmp_items) {
            const int kv = item >> 5, bgi = (item >> 1) & 15, tn = item & 1, m0 = bgi * 256, n0 = tn * 128;
            ARows ar;
#pragma unroll
            for (int i = 0; i < 4; ++i) { const int cb = (tid >> 3) + 64 * i;
                ar.p[i] = (cb < NCMP) ? c.PROJ + ((size_t)(bgi >> 2) * SEQ + 16 * cb) * IN_COLS + (kv ? C_VC : C_KC) + (bgi & 3) * 64 : nullptr; }
            f32x4 acc[4][4]; acc_zero(acc);
            gemm_core<1>(acc, ar, (const bf16_t*)(c.ws + WS_WT_C1) + ((size_t)kv * 256 + n0) * 2048, 2048, 2048, lds);
            const float* pb = c.POSB + kv * 256;
            ACC_FOREACH(acc, {
                const f32x4 bb = *(const f32x4*)(pb + n0 + c_);
                store_bf4(c.CMPH + ((size_t)kv * 4096 + m0 + r_) * 256 + n0 + c_, (f32x4){gelu_tanh(v_[0] + bb[0]), gelu_tanh(v_[1] + bb[1]), gelu_tanh(v_[2] + bb[2]), gelu_tanh(v_[3] + bb[3])}); });
        } else if (item >= n_prep) {
            const int idx = item - n_prep, kind = idx >> 10, bgi = (idx >> 6) & 15, s0 = (idx & 63) * 64;
            bf16_t* T = (bf16_t*)lds;
            const int r = tid >> 3, seg = (tid & 7) * 8;
            const u32x4 w = *(const u32x4*)(c.PROJ + ((size_t)(bgi >> 2) * SEQ + s0 + r) * IN_COLS + (kind ? C_VW : C_VS) + (bgi & 3) * 64 + seg);
            __syncthreads();
            *(u32x4*)(T + r * 72 + seg) = w;
            __syncthreads();
            u32x4 o;
            o.x = (unsigned)T[(seg + 0) * 72 + r] | ((unsigned)T[(seg + 1) * 72 + r] << 16); o.y = (unsigned)T[(seg + 2) * 72 + r] | ((unsigned)T[(seg + 3) * 72 + r] << 16);
            o.z = (unsigned)T[(seg + 4) * 72 + r] | ((unsigned)T[(seg + 5) * 72 + r] << 16); o.w = (unsigned)T[(seg + 6) * 72 + r] | ((unsigned)T[(seg + 7) * 72 + r] << 16);
            *(u32x4*)(c.VT + (((size_t)kind * 16 + bgi) * 64 + r) * SEQ + s0 + seg) = o;
        } else {
            const int t0 = (item - n_cmp_items) * 16;
            float* sl = (float*)lds;
            const float* mu = c.in(I_MU) + (size_t)c.l * RWC;
            __syncthreads();
            for (int idx = tid; idx < 16 * 160; idx += NTHREADS) {
                const int tk = idx / 160, i = idx % 160, t = t0 + tk, col = C_WD + i;
                const float u = bf2f(c.PROJ[(size_t)t * IN_COLS + col]);
                const float up = ((t & (SEQ - 1)) != 0) ? bf2f(c.PROJ[(size_t)(t - 1) * IN_COLS + col]) : 0.f;
                const float us = u + (up - u) * mu[col - C_RW];
                sl[idx] = (i < 32) ? tanhf_(us) : ((i < 64) ? us : sigmoidf_(us));
            }
            __syncthreads();
            const int ch = tid;
            float z[16], aa[16], gg[16];
#pragma unroll
            for (int k = 0; k < 16; ++k) { z[k] = 0.f; aa[k] = 0.f; gg[k] = 0.f; }
            const float* wup = c.in(I_WUP) + (size_t)c.l * 32 * 512 + ch;
            const float* aup = c.in(I_AUP) + (size_t)c.l * 32 * 512 + ch;
            const float* gup = c.in(I_GUP) + (size_t)c.l * 96 * 512 + ch;
#pragma unroll 1
            for (int i0 = 0; i0 < 32; i0 += 8) {
                float wv[8], av[8];
#pragma unroll
                for (int u = 0; u < 8; ++u) { wv[u] = wup[(i0 + u) * 512]; av[u] = aup[(i0 + u) * 512]; }
#pragma unroll
                for (int u = 0; u < 8; ++u)
#pragma unroll
                    for (int k = 0; k < 16; ++k) { z[k] += sl[k * 160 + i0 + u] * wv[u]; aa[k] += sl[k * 160 + 32 + i0 + u] * av[u]; }
            }
#pragma unroll 1
            for (int i0 = 0; i0 < 96; i0 += 8) {
                float wv[8];
#pragma unroll
                for (int u = 0; u < 8; ++u) wv[u] = gup[(i0 + u) * 512];
#pragma unroll
                for (int u = 0; u < 8; ++u)
#pragma unroll
                    for (int k = 0; k < 16; ++k) gg[k] += sl[k * 160 + 64 + i0 + u] * wv[u];
            }
            const float w0 = c.in(I_W0)[c.l * 512 + ch], a0 = c.in(I_A0)[c.l * 512 + ch];
            const float kkw_ = c.in(I_KK)[c.l * 512 + ch], kaw_ = c.in(I_KA)[c.l * 512 + ch], rkw_ = c.in(I_RK)[c.l * 512 + ch];
            const float mur = mu[ch], muk = mu[512 + ch], muv = mu[1024 + ch];
            float pr = 0.f, pk = 0.f, pv = 0.f;
            if ((t0 & (SEQ - 1)) != 0) { const bf16_t* q = c.PROJ + (size_t)(t0 - 1) * IN_COLS; pr = bf2f(q[C_R + ch]); pk = bf2f(q[C_K + ch]); pv = bf2f(q[C_V + ch]); }
#pragma unroll
            for (int k = 0; k < 16; ++k) {
                const int t = t0 + k; const bf16_t* q = c.PROJ + (size_t)t * IN_COLS;
                const float ur = bf2f(q[C_R + ch]), uk = bf2f(q[C_K + ch]), uv = bf2f(q[C_V + ch]);
                const float r = ur + (pr - ur) * mur, kx = uk + (pk - uk) * muk, vx = uv + (pv - uv) * muv;
                pr = ur; pk = uk; pv = uv;
                if ((k & 3) == 3) { asm volatile("" ::: "memory"); __builtin_amdgcn_sched_barrier(0); }
                const float wlog = -softplusf_(-(w0 + z[k])) - 0.5f;
                const float e = __expf(wlog);
                const float a = sigmoidf_(a0 + aa[k]);
                const size_t o = (size_t)t * 512 + ch;
                {
                    const float kxn = kx * kkw_, kp = kx * (1.0f + (a - 1.0f) * kaw_);
                    const float ss = wave_sum_dpp(kxn * kxn);
                    const float inv = __builtin_amdgcn_rsqf(fmaxf(ss, 1e-24f));
                    const float br = wave_sum_dpp(kxn * inv * a * r), kr = wave_sum_dpp(kp * r), bon = wave_sum_dpp(r * kp * rkw_);
                    if ((tid & 63) == 0) *(f32x4*)(c.BON + ((size_t)t * 8 + (tid >> 6)) * 4) = (f32x4){inv, br, kr, bon};
                }
                c.F[o] = f2bf(r); c.F[o + (size_t)NT * 512] = f2bf(kx); c.F[o + (size_t)2 * NT * 512] = f2bf(vx);
                c.F[o + (size_t)3 * NT * 512] = f2bf(e); c.F[o + (size_t)4 * NT * 512] = f2bf(a); c.F[o + (size_t)5 * NT * 512] = f2bf(gg[k]);
            }
            asm volatile("" ::: "memory"); __builtin_amdgcn_sched_barrier(0);
            {
                const int gi = ch >> 7;
                const int s0 = t0 & (SEQ - 1);
                float pv[31];
#pragma unroll
                for (int i = 0; i < 31; ++i) pv[i] = (s0 - 15 + i >= 0) ? bf2f(c.PROJ[(size_t)(t0 - 15 + i) * IN_COLS + C_POOL + ch]) : 0.f;
                if (gi == 0) pool_emit<2>(c, pv, t0, s0, ch);
                else if (gi == 1) pool_emit<4>(c, pv, t0, s0, ch);
                else if (gi == 2) pool_emit<8>(c, pv, t0, s0, ch);
                else pool_emit<16>(c, pv, t0, s0, ch);
            }
        }
    }
}

DI void phase_poolgemm(const Ctx& c, unsigned char* lds) {
    const int n_pool = (NT / 256) * 4, n_items = n_pool + 32;
    for (int item = blockIdx.x; item < n_items; item += gridDim.x) {
        f32x4 acc[4][4]; acc_zero(acc);
        if (item < n_pool) {
            const int tm = item >> 2, gi = item & 3, m0 = tm * 256;
            const ARows ar = plain_rows(c.POOLED + gi * 128, 512, m0, TID());
            gemm_core<0>(acc, ar, (const bf16_t*)(c.ws + WS_WT_POOL) + (size_t)gi * 128 * 128, 128, 128, lds);
            const float* sc = c.in(I_POOLS) + c.l * 512 + gi * 128;
            ACC_FOREACH(acc, { const f32x4 s = *(const f32x4*)(sc + c_);
                store_bf4(c.POOLED + (size_t)(m0 + r_) * 512 + gi * 128 + c_, (f32x4){v_[0] * s[0], v_[1] * s[1], v_[2] * s[2], v_[3] * s[3]}); });
        } else {
            const int it = item - n_pool, kv = it >> 4, tm = it & 15, m0 = tm * 256;
            const ARows ar = plain_rows(c.CMPH + (size_t)kv * 4096 * 256, 256, m0, TID());
            gemm_core<0>(acc, ar, (const bf16_t*)(c.ws + WS_WT_C2) + (size_t)kv * 128 * 256, 256, 256, lds);
            ACC_FOREACH(acc, { if (c_ < 64) { const int R = m0 + r_;
                if (kv == 0) store_bf4(c.KC + (size_t)R * 64 + c_, v_);
                else { bf16_t* q = c.VCT + ((size_t)(R >> 8) * 64 + c_) * 256 + (R & 255); q[0] = f2bf(v_[0]); q[256] = f2bf(v_[1]); q[512] = f2bf(v_[2]); q[768] = f2bf(v_[3]); } } });
        }
    }
}

constexpr int SCH = 32;
constexpr int SB_AN = 0, SB_WR = SCH * 64 * 4, SB_W = 2 * SCH * 64 * 4, SB_BB = 3 * SCH * 64 * 4, SB_KP = 4 * SCH * 64 * 4;
constexpr int SB_V = 5 * SCH * 64 * 4;
constexpr int SB_SC = SB_V + SCH * 16 * 4;
constexpr int SB_Y = SB_SC + SCH * 2 * 4;
constexpr int SB_BYTES = SB_Y + SCH * 16 * 4;
static_assert(2 * SB_BYTES <= LDS_BYTES - 64, "scan lds");
typedef float f32x2 __attribute__((ext_vector_type(2)));
DI float row8_sum(float v) { v += DPP_MOV(v, 0xB1); v += DPP_MOV(v, 0x4E); v += DPP_MOV(v, 0x141); return v; }

constexpr int NPW = 6, NJ = (SCH + NPW - 1) / NPW;
struct PrepRegs { bf16_t r[NJ], k[NJ], v[NJ], e[NJ], a[NJ]; float s0[NJ], s1[NJ], s2[NJ]; };
DI void prep_load(PrepRegs& R, const Ctx& c, int b, int h, int ck, int pw, int lane) {
    const size_t PL = (size_t)NT * 512;
    const size_t tb = (size_t)b * SEQ + ck * SCH;
    const size_t o0 = tb * 512 + h * 64 + lane;
#pragma unroll
    for (int j = 0; j < NJ; ++j) {
        const int st = pw + NPW * j;
        if (st < SCH) { const size_t o = o0 + (size_t)st * 512; R.r[j] = c.F[o]; R.k[j] = c.F[o + PL]; R.v[j] = c.F[o + 2 * PL]; R.e[j] = c.F[o + 3 * PL]; R.a[j] = c.F[o + 4 * PL];
            const float* sp = c.BON + ((tb + st) * 8 + h) * 4; R.s0[j] = sp[0]; R.s1[j] = sp[1]; R.s2[j] = sp[2]; }
    }
}
DI void prep_store(const PrepRegs& R, unsigned char* sb, int rq, int pw, int lane, float kkw, float kaw) {
    float* an = (float*)(sb + SB_AN); float* wr = (float*)(sb + SB_WR); float* w_ = (float*)(sb + SB_W); float* bb_ = (float*)(sb + SB_BB); float* kp_ = (float*)(sb + SB_KP);
    float* vv = (float*)(sb + SB_V); float* sc = (float*)(sb + SB_SC);
#pragma unroll
    for (int j = 0; j < NJ; ++j) {
        const int st = pw + NPW * j;
        if (st < SCH) {
            const float r = bf2f(R.r[j]), k = bf2f(R.k[j]), v = bf2f(R.v[j]), e = bf2f(R.e[j]), a = bf2f(R.a[j]);
            const float w = __expf(-e);
            const float kk = k * kkw * R.s0[j];
            const float kp = k * (1.0f + (a - 1.0f) * kaw);
            an[st * 64 + lane] = -kk; wr[st * 64 + lane] = w * r; w_[st * 64 + lane] = w; bb_[st * 64 + lane] = kk * a; kp_[st * 64 + lane] = kp;
            if ((lane >> 4) == rq) vv[st * 16 + (lane & 15)] = v;
            if (lane == 0) { sc[st * 2] = R.s1[j]; sc[st * 2 + 1] = R.s2[j]; }
        }
    }
}
DI void scan_item(const Ctx& c, int item, unsigned char* lds) {
    const int tid = TID(), lane = tid & 63, wave = tid >> 6;
    const int b = item >> 5, h = (item >> 2) & 7, rq = item & 3;
    const int chn = h * 64 + lane;
    const float kkw = c.in(I_KK)[c.l * 512 + chn], kaw = c.in(I_KA)[c.l * 512 + chn];
    const int rowl = (tid & 127) >> 3, cg = tid & 7;
    f32x2 st[4];
#pragma unroll
    for (int i = 0; i < 4; ++i) st[i] = (f32x2){0.f, 0.f};
    constexpr int NCK = SEQ / SCH;
    PrepRegs R;
    __syncthreads();
    if (wave >= 2) { prep_load(R, c, b, h, 0, wave - 2, lane); prep_store(R, lds, rq, wave - 2, lane, kkw, kaw); prep_load(R, c, b, h, 1, wave - 2, lane); }
    __syncthreads();
    for (int ck = 0; ck < NCK; ++ck) {
        unsigned char* sb = lds + (ck & 1) * SB_BYTES;
        if (wave < 2) {
            const float* an = (const float*)(sb + SB_AN) + cg * 8; const float* wr = (const float*)(sb + SB_WR) + cg * 8; const float* w_ = (const float*)(sb + SB_W) + cg * 8;
            const float* bb_ = (const float*)(sb + SB_BB) + cg * 8; const float* kp_ = (const float*)(sb + SB_KP) + cg * 8;
            const float* vv = (const float*)(sb + SB_V) + rowl; const float* sc = (const float*)(sb + SB_SC); float* yb = (float*)(sb + SB_Y) + rowl;
            f32x4 a0 = *(const f32x4*)(an), a1 = *(const f32x4*)(an + 4), r0 = *(const f32x4*)(wr), r1 = *(const f32x4*)(wr + 4);
            f32x4 w0 = *(const f32x4*)(w_), w1 = *(const f32x4*)(w_ + 4), b0 = *(const f32x4*)(bb_), b1 = *(const f32x4*)(bb_ + 4);
            f32x4 k0 = *(const f32x4*)(kp_), k1 = *(const f32x4*)(kp_ + 4);
            float v = vv[0]; f32x2 bk = *(const f32x2*)(sc);
#pragma unroll 2
            for (int s = 0; s < SCH; ++s) {
                const int sn = (s + 1 < SCH) ? s + 1 : s;
                const f32x4 na0 = *(const f32x4*)(an + sn * 64), na1 = *(const f32x4*)(an + sn * 64 + 4), nr0 = *(const f32x4*)(wr + sn * 64), nr1 = *(const f32x4*)(wr + sn * 64 + 4);
                const f32x4 nw0 = *(const f32x4*)(w_ + sn * 64), nw1 = *(const f32x4*)(w_ + sn * 64 + 4), nb0 = *(const f32x4*)(bb_ + sn * 64), nb1 = *(const f32x4*)(bb_ + sn * 64 + 4);
                const f32x4 nk0 = *(const f32x4*)(kp_ + sn * 64), nk1 = *(const f32x4*)(kp_ + sn * 64 + 4);
                const float nv = vv[sn * 16]; const f32x2 nbk = *(const f32x2*)(sc + sn * 2);
                f32x2 da = st[0] * (f32x2){a0[0], a0[1]}; f32x2 dr = st[0] * (f32x2){r0[0], r0[1]};
                da += st[1] * (f32x2){a0[2], a0[3]}; dr += st[1] * (f32x2){r0[2], r0[3]};
                da += st[2] * (f32x2){a1[0], a1[1]}; dr += st[2] * (f32x2){r1[0], r1[1]};
                da += st[3] * (f32x2){a1[2], a1[3]}; dr += st[3] * (f32x2){r1[2], r1[3]};
                float sa = da[0] + da[1], sr = dr[0] + dr[1];
                sa += DPP_MOV(sa, 0xB1); sr += DPP_MOV(sr, 0xB1);
                sa += DPP_MOV(sa, 0x4E); sr += DPP_MOV(sr, 0x4E);
                sa += DPP_MOV(sa, 0x141); sr += DPP_MOV(sr, 0x141);
                const f32x2 sa2 = (f32x2){sa, sa}, v2 = (f32x2){v, v};
                st[0] = st[0] * (f32x2){w0[0], w0[1]} + sa2 * (f32x2){b0[0], b0[1]} + v2 * (f32x2){k0[0], k0[1]};
                st[1] = st[1] * (f32x2){w0[2], w0[3]} + sa2 * (f32x2){b0[2], b0[3]} + v2 * (f32x2){k0[2], k0[3]};
                st[2] = st[2] * (f32x2){w1[0], w1[1]} + sa2 * (f32x2){b1[0], b1[1]} + v2 * (f32x2){k1[0], k1[1]};
                st[3] = st[3] * (f32x2){w1[2], w1[3]} + sa2 * (f32x2){b1[2], b1[3]} + v2 * (f32x2){k1[2], k1[3]};
                yb[s * 16] = sr + sa * bk[0] + v * bk[1];
                a0 = na0; a1 = na1; r0 = nr0; r1 = nr1; w0 = nw0; w1 = nw1; b0 = nb0; b1 = nb1; k0 = nk0; k1 = nk1; v = nv; bk = nbk;
            }
        } else {
            const int pt = tid - 128;
            if (ck + 1 < NCK) prep_store(R, lds + ((ck + 1) & 1) * SB_BYTES, rq, wave - 2, lane, kkw, kaw);
            if (ck + 2 < NCK) prep_load(R, c, b, h, ck + 2, wave - 2, lane);
            if (ck > 0) {
                const float* yb = (const float*)(lds + ((ck - 1) & 1) * SB_BYTES + SB_Y);
                for (int idx = pt; idx < SCH * 16; idx += 384) {
                    const int s = idx >> 4, j = idx & 15;
                    c.YRAW[((size_t)b * SEQ + (ck - 1) * SCH + s) * 512 + h * 64 + rq * 16 + j] = f2bf(yb[idx]);
                }
            }
        }
        asm volatile("s_waitcnt lgkmcnt(0)" ::: "memory"); __builtin_amdgcn_s_barrier(); asm volatile("" ::: "memory");
    }
    {
        const float* yb = (const float*)(lds + ((NCK - 1) & 1) * SB_BYTES + SB_Y);
        for (int idx = tid; idx < SCH * 16; idx += NTHREADS) {
            const int s = idx >> 4, j = idx & 15;
            c.YRAW[((size_t)b * SEQ + (NCK - 1) * SCH + s) * 512 + h * 64 + rq * 16 + j] = f2bf(yb[idx]);
        }
    }
    __syncthreads();
}
DI void phase_rwkv_post(const Ctx& c, unsigned char* lds) {
    const int tid = TID(), lane = tid & 63, wave = tid >> 6;
    const size_t PL = (size_t)NT * 512;
    for (int idx = blockIdx.x * 8 + wave; idx < NT * 8; idx += gridDim.x * 8) {
        const int t = idx >> 3, h = idx & 7, chn = h * 64 + lane;
        const size_t o = (size_t)t * 512 + chn;
        const float y = bf2f(c.YRAW[o]);
        const float mean = wave_sum_dpp(y) * (1.0f / 64.0f);
        const float d = y - mean;
        const float var = wave_sum_dpp(d * d) * (1.0f / 64.0f);
        const float yn = d * rsqrtf(var + 64e-5f) * c.in(I_GNW)[c.l * 512 + chn] + c.in(I_GNB)[c.l * 512 + chn];
        const float v = bf2f(c.F[o + 2 * PL]), g = bf2f(c.F[o + 5 * PL]);
        c.F[o + 5 * PL] = f2bf((yn + c.BON[(size_t)idx * 4 + 3] * v) * g);
    }
    for (int it = blockIdx.x; it < 768 + 128 + 128 + 256 + 256; it += gridDim.x) {
        const float* WB = c.in(I_WBR) + (size_t)c.l * 2048 * DM; bf16_t* BR = (bf16_t*)(c.ws + WS_WT_BR);
        if (it < 768) convert_tile(c.in(I_WMG) + (size_t)c.l * DM * 3 * DM, 3 * DM, 3 * DM, DM, (bf16_t*)(c.ws + WS_WT_MG), it, lds);
        else if (it < 896) convert_tile(WB, DM, DM, 512, BR, it - 768, lds);
        else if (it < 1024) convert_tile(WB + (size_t)512 * DM, DM, DM, 512, BR + (size_t)1024 * 512, it - 896, lds);
        else if (it < 1280) convert_tile(WB + (size_t)1024 * DM, DM, DM, 1024, BR + (size_t)2048 * 512, it - 1024, lds);
        else convert_tile(c.in(I_WOUT) + (size_t)c.l * DM * DM, DM, DM, DM, (bf16_t*)(c.ws + WS_WT_OUT), it - 1280, lds);
    }
}
constexpr int TS = 72;
constexpr int NSA_BIAS = 0;
constexpr int NSA_SELM = 2112;
constexpr int NSA_SCR = 2624;
constexpr int NSA_K0 = 4672;
constexpr int NSA_V0 = NSA_K0 + 2 * 64 * TS * 2;
constexpr int NSA_A = NSA_V0 + 2 * 64 * TS * 2;
constexpr int NSA_B = NSA_A + 16384;
constexpr int NSA_END = NSA_B + 16384;
static_assert(NSA_END <= LDS_BYTES - 16, "nsa lds");
static_assert(NSA_K0 % 16 == 0, "align");

struct NsaLane { int tq[2]; int h; float cbias; float m[2], l[2]; };

DI void nsa_prefetch(u32x4& rk, u32x4& rv, const bf16_t* kbase, int kstride, const bf16_t* vtbase, int vstride, int pos0, int tid) {
    const int r = tid >> 3, seg = (tid & 7) * 8;
    rk = *(const u32x4*)(kbase + (size_t)(pos0 + r) * kstride + seg);
    rv = *(const u32x4*)(vtbase + (size_t)r * vstride + pos0 + seg);
}
DI void nsa_store(unsigned char* lds, int buf, const u32x4& rk, const u32x4& rv, int tid) {
    const int r = tid >> 3, seg = (tid & 7) * 8;
    *(u32x4*)((bf16_t*)(lds + NSA_K0) + buf * 64 * TS + r * TS + seg) = rk;
    *(u32x4*)((bf16_t*)(lds + NSA_V0) + buf * 64 * TS + r * TS + seg) = rv;
}
template <int QM = 3>
DI void nsa_qk(f32x4 (&s)[2][4], const bf16_t* sK, const bf16x8 (&qf)[2][2], int lane) {
#pragma unroll
    for (int kt = 0; kt < 4; ++kt) {
#pragma unroll
        for (int ks = 0; ks < 2; ++ks) {
            const bf16x8 kf = *(const bf16x8*)(sK + (16 * kt + (lane & 15)) * TS + 32 * ks + (lane >> 4) * 8);
#pragma unroll
            for (int qi = 0; qi < 2; ++qi) if ((QM >> qi) & 1) s[qi][kt] = __builtin_amdgcn_mfma_f32_16x16x32_bf16(kf, qf[qi][ks], (ks == 0) ? (f32x4){0.f, 0.f, 0.f, 0.f} : s[qi][kt], 0, 0, 0);
        }
    }
}
template <int MODE>
DI void nsa_logits(float (&x)[4][4], const f32x4 (&s)[4], int tq, int h, float cbias, bool rowsel, int pos0, int qd, const float* biasT) {
#pragma unroll
    for (int kt = 0; kt < 4; ++kt)
#pragma unroll
        for (int i = 0; i < 4; ++i) {
            const int kk = pos0 + 16 * kt + 4 * qd + i;
            if (MODE == 1) { x[kt][i] = rowsel ? s[kt][i] + cbias : -INFINITY; }
            else {
                const int dist = (MODE == 0) ? (tq - 16 * kk - 31) : (tq - kk);
                bool ok = dist >= 0;
                if (MODE == 2) ok = ok && rowsel;
                if (MODE == 3) ok = ok && (dist < 512);
                const int di = dist < 0 ? 0 : (dist > 128 ? 128 : dist);
                float bias = biasT[di * 4 + h];
                asm volatile("" : "+v"(bias));
                x[kt][i] = ok ? s[kt][i] + bias : -INFINITY;
            }
        }
}
DI float quad16_max(float v) { v = fmaxf(v, __shfl_xor(v, 16)); v = fmaxf(v, __shfl_xor(v, 32)); return v; }
DI float quad16_sum(float v) { v += __shfl_xor(v, 16); v += __shfl_xor(v, 32); return v; }
DI void nsa_softmax(const float (&x)[4][4], float& m, float& l, f32x4 (&O)[4], bf16x8 (&pf)[2]) {
    float mx = -INFINITY;
#pragma unroll
    for (int kt = 0; kt < 4; ++kt)
#pragma unroll
        for (int i = 0; i < 4; ++i) mx = fmaxf(mx, x[kt][i]);
    mx = quad16_max(mx);
    const float mn = fmaxf(m, mx);
    const float mu = (mn == -INFINITY) ? 0.f : mn;
    const float mu2 = mu * 1.4426950408889634f;
    const float sc = __builtin_amdgcn_exp2f(__builtin_fmaf(m, 1.4426950408889634f, -mu2));
    float p[4][4]; float ps = 0.f;
#pragma unroll
    for (int kt = 0; kt < 4; ++kt)
#pragma unroll
        for (int i = 0; i < 4; ++i) { p[kt][i] = __builtin_amdgcn_exp2f(__builtin_fmaf(x[kt][i], 1.4426950408889634f, -mu2)); ps += p[kt][i]; }
    l = l * sc + ps; m = mn;
#pragma unroll
    for (int dt = 0; dt < 4; ++dt) O[dt] = O[dt] * sc;
#pragma unroll
    for (int ks = 0; ks < 2; ++ks) {
        u32x4 w; w.x = pack2(p[2 * ks][0], p[2 * ks][1]); w.y = pack2(p[2 * ks][2], p[2 * ks][3]); w.z = pack2(p[2 * ks + 1][0], p[2 * ks + 1][1]); w.w = pack2(p[2 * ks + 1][2], p[2 * ks + 1][3]);
        pf[ks] = __builtin_bit_cast(bf16x8, w);
    }
}
template <int QM = 3>
DI void nsa_pv(f32x4 (&O)[2][4], const bf16_t* sV, const bf16x8 (&pf)[2][2], int lane) {
    const int qd = lane >> 4;
#pragma unroll
    for (int dt = 0; dt < 4; ++dt)
#pragma unroll
        for (int ks = 0; ks < 2; ++ks) {
            const bf16_t* vp = sV + (16 * dt + (lane & 15)) * TS + 32 * ks + 4 * qd;
            const u32x2 a = *(const u32x2*)vp, b = *(const u32x2*)(vp + 16);
            u32x4 w; w.x = a.x; w.y = a.y; w.z = b.x; w.w = b.y;
            const bf16x8 vf = __builtin_bit_cast(bf16x8, w);
#pragma unroll
            for (int qi = 0; qi < 2; ++qi) if ((QM >> qi) & 1) O[qi][dt] = __builtin_amdgcn_mfma_f32_16x16x32_bf16(vf, pf[qi][ks], O[qi][dt], 0, 0, 0);
        }
}
template <int MODE, int QM = 3>
DI void nsa_tile(f32x4 (&O)[2][4], NsaLane& L, const bf16x8 (&qf)[2][2], const unsigned char* lds, int buf, int pos0, bool sel0, bool sel1, int lane) {
    const bf16_t* sK = (const bf16_t*)(lds + NSA_K0) + buf * 64 * TS;
    const bf16_t* sV = (const bf16_t*)(lds + NSA_V0) + buf * 64 * TS;
    const float* biasT = (const float*)(lds + NSA_BIAS);
    f32x4 s[2][4];
    nsa_qk<QM>(s, sK, qf, lane);
    bf16x8 pf[2][2];
#pragma unroll
    for (int qi = 0; qi < 2; ++qi) if ((QM >> qi) & 1) {
        float x[4][4];
        nsa_logits<MODE>(x, s[qi], L.tq[qi], L.h, L.cbias, qi ? sel1 : sel0, pos0, lane >> 4, biasT);
        nsa_softmax(x, L.m[qi], L.l[qi], O[qi], pf[qi]);
    }
    nsa_pv<QM>(O, sV, pf, lane);
}
template <int MODE>
DI void nsa_tile_sel(f32x4 (&O)[2][4], NsaLane& L, const bf16x8 (&qf)[2][2], const unsigned char* lds, int buf, int pos0, bool sel0, bool sel1, int lane) {
    const bool a0 = __ballot(sel0) != 0ull, a1 = __ballot(sel1) != 0ull;
    if (a0 || a1) nsa_tile<MODE, 3>(O, L, qf, lds, buf, pos0, sel0, sel1, lane);
}
DI void nsa_flush(f32x4 (&Y)[2][4], f32x4 (&O)[2][4], NsaLane& L, const float (&gate)[2]) {
#pragma unroll
    for (int qi = 0; qi < 2; ++qi) {
        const float lt = quad16_sum(L.l[qi]);
        const float f = (lt > 0.f) ? gate[qi] * __builtin_amdgcn_rcpf(lt) : 0.f;
#pragma unroll
        for (int dt = 0; dt < 4; ++dt) { Y[qi][dt] += O[qi][dt] * f; O[qi][dt] = (f32x4){0.f, 0.f, 0.f, 0.f}; }
    }
}
DI void nsa_item(const Ctx& c, int item, unsigned char* lds) {
    const int tid = TID(), lane = tid & 63, wave = tid >> 6, qd = lane >> 4;
    const int b = item >> 8, g = (item >> 6) & 3, qt = item & 63, t0 = qt * 64, cur = qt, bg = b * 4 + g;
    float* biasT = (float*)(lds + NSA_BIAS);
    unsigned long long* selm = (unsigned long long*)(lds + NSA_SELM);
    float* scr = (float*)(lds + NSA_SCR) + wave * 64;
    float* impA = (float*)(lds + NSA_A); float* impB = (float*)(lds + NSA_B);
    __syncthreads();
    for (int i = tid; i < 129 * 4; i += NTHREADS) { const int d = i >> 2, h = i & 3; biasT[i] = c.in(I_RELB)[t5_bucket(d) * 16 + g * 4 + h]; }
    for (int i = tid; i < 2 * 4096; i += NTHREADS) impA[i] = 0.f;
    NsaLane L; L.h = lane & 3;
    bf16x8 qf[2][2]; float gates[2][3];
    const bf16_t* pbat = c.PROJ + (size_t)b * SEQ * IN_COLS;
#pragma unroll
    for (int qi = 0; qi < 2; ++qi) {
        const int tl = 8 * wave + 4 * qi + ((lane & 15) >> 2);
        L.tq[qi] = t0 + tl;
        const bf16_t* prow = pbat + (size_t)L.tq[qi] * IN_COLS;
#pragma unroll
        for (int ks = 0; ks < 2; ++ks) {
            u32x4 w = *(const u32x4*)(prow + C_Q + (g * 4 + L.h) * 64 + 32 * ks + qd * 8);
            w.x = pack2(bflo(w.x) * 0.125f, bfhi(w.x) * 0.125f); w.y = pack2(bflo(w.y) * 0.125f, bfhi(w.y) * 0.125f);
            w.z = pack2(bflo(w.z) * 0.125f, bfhi(w.z) * 0.125f); w.w = pack2(bflo(w.w) * 0.125f, bfhi(w.w) * 0.125f);
            qf[qi][ks] = __builtin_bit_cast(bf16x8, w);
        }
#pragma unroll
        for (int br = 0; br < 3; ++br) gates[qi][br] = sigmoidf_(bf2f(prow[C_GATE + g * 12 + L.h * 3 + br]));
    }
    __syncthreads();
    L.cbias = biasT[128 * 4 + L.h];
    f32x4 O[2][4], Y[2][4];
#pragma unroll
    for (int qi = 0; qi < 2; ++qi)
#pragma unroll
        for (int dt = 0; dt < 4; ++dt) { O[qi][dt] = (f32x4){0.f, 0.f, 0.f, 0.f}; Y[qi][dt] = (f32x4){0.f, 0.f, 0.f, 0.f}; }
    u32x4 rk, rv;
    const int nvis_max = (t0 + 63 >= 31) ? ((t0 + 63 - 31) >> 4) + 1 : 0;
    const int ncb = (nvis_max + 63) >> 6;
    const bf16_t* kcb = c.KC + (size_t)bg * 256 * 64; const bf16_t* vcb = c.VCT + (size_t)bg * 64 * 256;
    L.m[0] = L.m[1] = -INFINITY; L.l[0] = L.l[1] = 0.f;
    if (ncb > 0) nsa_prefetch(rk, rv, kcb, 64, vcb, 256, 0, tid);
    for (int cb = 0; cb < ncb; ++cb) {
        nsa_store(lds, cb & 1, rk, rv, tid);
        __syncthreads();
        if (cb + 1 < ncb) nsa_prefetch(rk, rv, kcb, 64, vcb, 256, (cb + 1) * 64, tid);
        if (16 * (cb * 64 + 63) + 31 + 128 <= t0) nsa_tile<1>(O, L, qf, lds, cb & 1, cb * 64, true, true, lane);
        else nsa_tile<0>(O, L, qf, lds, cb & 1, cb * 64, true, true, lane);
    }
    float mfin[2], linv[2];
#pragma unroll
    for (int qi = 0; qi < 2; ++qi) { mfin[qi] = L.m[qi]; const float lt = quad16_sum(L.l[qi]); linv[qi] = (lt > 0.f) ? __builtin_amdgcn_rcpf(lt) : 0.f; }
    { const float gg[2] = {gates[0][0], gates[1][0]}; nsa_flush(Y, O, L, gg); }
    __syncthreads();
    if (ncb > 0) nsa_prefetch(rk, rv, kcb, 64, vcb, 256, 0, tid);
    for (int cb = 0; cb < ncb; ++cb) {
        nsa_store(lds, cb & 1, rk, rv, tid);
        __syncthreads();
        if (cb + 1 < ncb) nsa_prefetch(rk, rv, kcb, 64, vcb, 256, (cb + 1) * 64, tid);
        const bf16_t* sK = (const bf16_t*)(lds + NSA_K0) + (cb & 1) * 64 * TS;
        f32x4 s[2][4];
        nsa_qk(s, sK, qf, lane);
#pragma unroll
        for (int qi = 0; qi < 2; ++qi) {
            float x[4][4];
            nsa_logits<0>(x, s[qi], L.tq[qi], L.h, L.cbias, true, cb * 64, qd, biasT);
            const float mu = (mfin[qi] == -INFINITY) ? 0.f : mfin[qi];
#pragma unroll
            for (int kt = 0; kt < 4; ++kt) {
                float p3 = __expf(x[kt][3] - mu) * linv[qi];
                float pa = (__expf(x[kt][0] - mu) + __expf(x[kt][1] - mu) + __expf(x[kt][2] - mu)) * linv[qi] + p3;
                pa += __shfl_xor(pa, 1); p3 += __shfl_xor(p3, 1);
                pa += __shfl_xor(pa, 2); p3 += __shfl_xor(p3, 2);
                if (L.h == 0) { const int tl = 8 * wave + 4 * qi + ((lane & 15) >> 2), mi = 16 * cb + 4 * kt + qd; impA[tl * 64 + mi] = pa; impB[tl * 64 + mi] = p3; }
            }
        }
    }
    __syncthreads();
    for (int tl8 = 0; tl8 < 8; ++tl8) {
        const int tl = 8 * wave + tl8, n = lane;
        const bool cand = (n >= 1) && (n <= cur - 2);
        const float imp = cand ? impA[tl * 64 + n] + impB[tl * 64 + n - 1] : -1.0f;
        LDS_WAVE_SYNC();
        scr[n] = imp;
        LDS_WAVE_SYNC();
        int rank = 0;
#pragma unroll 4
        for (int q4 = 0; q4 < 16; ++q4) {
            const f32x4 o = *(const f32x4*)(scr + q4 * 4);
#pragma unroll
            for (int j = 0; j < 4; ++j) { const int n2 = q4 * 4 + j; rank += (o[j] > imp || (o[j] == imp && n2 < n)) ? 1 : 0; }
        }
        const bool forced = (n <= cur) && (n == 0 || n == cur || n == cur - 1);
        const unsigned long long msk = __ballot((cand && rank < 5) || forced);
        if (lane == 0) selm[tl] = msk;
    }
    __syncthreads();
    unsigned long long uni = selm[lane];
#pragma unroll
    for (int o = 32; o >= 1; o >>= 1) { const unsigned lo_ = __shfl_xor((unsigned)uni, o), hi_ = __shfl_xor((unsigned)(uni >> 32), o); uni |= ((unsigned long long)hi_ << 32) | lo_; }
    uni = ((unsigned long long)__builtin_amdgcn_readfirstlane((unsigned)(uni >> 32)) << 32) | (unsigned)__builtin_amdgcn_readfirstlane((unsigned)uni);
    unsigned long long sm[2];
#pragma unroll
    for (int qi = 0; qi < 2; ++qi) sm[qi] = selm[8 * wave + 4 * qi + ((lane & 15) >> 2)];
    const bf16_t* ksb = pbat + C_KS + g * 64; const bf16_t* vsb = c.VT + ((size_t)0 * 16 + bg) * 64 * SEQ;
    L.m[0] = L.m[1] = -INFINITY; L.l[0] = L.l[1] = 0.f;
    {
        unsigned long long rem = uni; int it = 0;
        int j = (int)__builtin_ctzll(rem); rem &= rem - 1;
        nsa_prefetch(rk, rv, ksb, IN_COLS, vsb, SEQ, j * 64, tid);
        for (;;) {
            nsa_store(lds, it & 1, rk, rv, tid);
            __syncthreads();
            const int jn = rem ? (int)__builtin_ctzll(rem) : -1;
            if (jn >= 0) { rem &= rem - 1; nsa_prefetch(rk, rv, ksb, IN_COLS, vsb, SEQ, jn * 64, tid); }
            const bool s0 = (sm[0] >> j) & 1ull, s1 = (sm[1] >> j) & 1ull;
            if (j <= cur - 3) nsa_tile_sel<1>(O, L, qf, lds, it & 1, j * 64, s0, s1, lane);
            else nsa_tile_sel<2>(O, L, qf, lds, it & 1, j * 64, s0, s1, lane);
            if (jn < 0) break;
            j = jn; ++it;
        }
    }
    { const float gg[2] = {gates[0][1], gates[1][1]}; nsa_flush(Y, O, L, gg); }
    const bf16_t* kwb = pbat + C_KW + g * 64; const bf16_t* vwb = c.VT + ((size_t)1 * 16 + bg) * 64 * SEQ;
    L.m[0] = L.m[1] = -INFINITY; L.l[0] = L.l[1] = 0.f;
    {
        const int j0 = (cur - 8 > 0) ? cur - 8 : 0;
        __syncthreads();
        nsa_prefetch(rk, rv, kwb, IN_COLS, vwb, SEQ, j0 * 64, tid);
        for (int j = j0; j <= cur; ++j) {
            nsa_store(lds, (j - j0) & 1, rk, rv, tid);
            __syncthreads();
            if (j + 1 <= cur) nsa_prefetch(rk, rv, kwb, IN_COLS, vwb, SEQ, (j + 1) * 64, tid);
            if (cur - j >= 3 && cur - j <= 7) nsa_tile<1>(O, L, qf, lds, (j - j0) & 1, j * 64, true, true, lane);
            else nsa_tile<3>(O, L, qf, lds, (j - j0) & 1, j * 64, true, true, lane);
        }
    }
    { const float gg[2] = {gates[0][2], gates[1][2]}; nsa_flush(Y, O, L, gg); }
#pragma unroll
    for (int qi = 0; qi < 2; ++qi) {
        bf16_t* yrow = c.PROJ + ((size_t)b * SEQ + L.tq[qi]) * IN_COLS + C_Q + (g * 4 + L.h) * 64;
#pragma unroll
        for (int dt = 0; dt < 4; ++dt) store_bf4(yrow + 16 * dt + 4 * qd, Y[qi][dt]);
    }
}
DI void phase_mix(const Ctx& c, unsigned char* lds) {
    const int G = gridDim.x, bid = blockIdx.x;
    const int n_nsa = NB * 4 * (SEQ / 64), n_scan = NB * 8 * 4;
    const bool split = G >= 2 * n_scan;
    if (split) { if (bid < n_scan) scan_item(c, bid, lds); }
    else for (int item = bid; item < n_scan; item += G) scan_item(c, item, lds);
    unsigned* ctr = c.ctl + CW_Q + c.l;
    volatile int* sitem = (volatile int*)(lds + LDS_BYTES - 32);
    for (;;) {
        __syncthreads();
        if (TID() == 0) *sitem = (int)atomicAdd(ctr, 1u);
        __syncthreads();
        const int k = *sitem;
        if (k >= n_nsa) break;
        const int qt = 63 - (k >> 4), bgi = k & 15;
        nsa_item(c, (bgi << 6) | qt, lds);
    }
}

DI void phase_merge(const Ctx& c, unsigned char* lds) {
    const int nM = NT / 256, nN = DM / 128;
    const bf16_t* WM = (const bf16_t*)(c.ws + WS_WT_MG);
    const bf16_t* BR = (const bf16_t*)(c.ws + WS_WT_BR);
    const float* BM_ = c.in(I_BMG) + (size_t)c.l * 3 * DM;
    bf16_t* TMP = c.YRAW + (size_t)blockIdx.x * 256 * 128;
    for (int tile = blockIdx.x; tile < nM * nN; tile += gridDim.x) {
        const int tm = tile % nM, tn = tile / nM, m0 = tm * 256, n0 = tn * 128;
#pragma unroll 1
        for (int i = 0; i < 3; ++i) {
            {
                f32x4 ag[4][4]; acc_zero(ag);
                const ARows ar = plain_rows(c.H, DM, m0, TID());
                gemm_core<0>(ag, ar, WM + (size_t)(i * DM + n0) * DM, DM, DM, lds);
                ACC_FOREACH(ag, { const f32x4 bb = *(const f32x4*)(BM_ + i * DM + n0 + c_);
                    store_bf4(TMP + r_ * 128 + c_, (f32x4){sigmoidf_(v_[0] + bb[0]), sigmoidf_(v_[1] + bb[1]), sigmoidf_(v_[2] + bb[2]), sigmoidf_(v_[3] + bb[3])}); });
            }
            f32x4 ab[4][4]; acc_zero(ab);
            if (i == 0) { const ARows ar = plain_rows(c.POOLED, 512, m0, TID()); gemm_core<0>(ab, ar, BR + (size_t)n0 * 512, 512, 512, lds); }
            else if (i == 1) { const ARows ar = plain_rows(c.F + (size_t)5 * NT * 512, 512, m0, TID()); gemm_core<0>(ab, ar, BR + (size_t)1024 * 512 + (size_t)n0 * 512, 512, 512, lds); }
            else { const ARows ar = plain_rows(c.PROJ + C_Q, IN_COLS, m0, TID()); gemm_core<0>(ab, ar, BR + (size_t)2048 * 512 + (size_t)n0 * 1024, 1024, 1024, lds); }
            ACC_FOREACH(ab, {
                bf16_t* q = c.MERGED + (size_t)(m0 + r_) * DM + n0 + c_;
                const u32x2 gv = *(const u32x2*)(TMP + r_ * 128 + c_);
                f32x4 m4 = ((f32x4){0.f, 0.f, 0.f, 0.f});
                if (i > 0) { const u32x2 pv = *(const u32x2*)q; m4 = ((f32x4){bflo(pv.x), bfhi(pv.x), bflo(pv.y), bfhi(pv.y)}); }
                m4[0] += bflo(gv.x) * v_[0]; m4[1] += bfhi(gv.x) * v_[1]; m4[2] += bflo(gv.y) * v_[2]; m4[3] += bfhi(gv.y) * v_[3];
                store_bf4(q, m4); });
        }
    }
}

DI void phase_outp(const Ctx& c, unsigned char* lds) {
    const int nM = NT / 256, nN = DM / 128;
    const bf16_t* W = (const bf16_t*)(c.ws + WS_WT_OUT);
    const float* xin = (c.l == 0) ? c.in(I_X) : c.out;
    for (int tile = blockIdx.x; tile < nM * nN; tile += gridDim.x) {
        const int tm = tile % nM, tn = tile / nM, m0 = tm * 256, n0 = tn * 128;
        f32x4 acc[4][4]; acc_zero(acc);
        const ARows ar = plain_rows(c.MERGED, DM, m0, TID());
        gemm_core<0>(acc, ar, W + (size_t)n0 * DM, DM, DM, lds);
        ACC_FOREACH(acc, { const size_t o = (size_t)(m0 + r_) * DM + n0 + c_; const f32x4 x = *(const f32x4*)(xin + o); *(f32x4*)(c.out + o) = x + v_; });
    }
    for (int it = blockIdx.x; it < 3 * 32 * 64; it += gridDim.x) {
        const int mat = it / 2048, e = (it >> 6) & 31, tl = it & 63;
        if (mat == 0) convert_tile(c.in(I_EG) + ((size_t)c.l * 32 + e) * DM * 256, 256, 256, DM, (bf16_t*)(c.ws + WS_EG) + (size_t)e * 256 * DM, tl, lds);
        else if (mat == 1) convert_tile(c.in(I_EU) + ((size_t)c.l * 32 + e) * DM * 256, 256, 256, DM, (bf16_t*)(c.ws + WS_EU) + (size_t)e * 256 * DM, tl, lds);
        else convert_tile(c.in(I_ED) + ((size_t)c.l * 32 + e) * 256 * DM, DM, DM, 256, (bf16_t*)(c.ws + WS_ED) + (size_t)e * DM * 256, tl, lds);
    }
}

DI void phase_norm2(const Ctx& c) {
    const int tid = TID(), lane = tid & 63, wave = tid >> 6;
    const float* gain = c.in(I_NFFN) + c.l * DM;
    const float* wrg = c.in(I_WRG) + (size_t)c.l * DM * 4; const float* brg = c.in(I_BRG) + c.l * 4;
    const float* wre = c.in(I_WRE) + (size_t)c.l * DM * 32; const float* bre = c.in(I_BRE) + c.l * 32;
    unsigned* cnt = c.ctl + CW_CNT + c.l * 32;
    for (int row = blockIdx.x * 8 + wave; row < NT; row += gridDim.x * 8) {
        f32x4 v[4];
        float ss = 0.f;
#pragma unroll
        for (int i = 0; i < 4; ++i) { v[i] = *(const f32x4*)(c.out + (size_t)row * DM + i * 256 + lane * 4); ss += v[i][0] * v[i][0] + v[i][1] * v[i][1] + v[i][2] * v[i][2] + v[i][3] * v[i][3]; }
        ss = wave_sum_dpp(ss);
        const float rs = rsqrtf(ss * (1.0f / DM) + 1e-6f);
#pragma unroll
        for (int i = 0; i < 4; ++i) {
            const f32x4 g = *(const f32x4*)(gain + i * 256 + lane * 4);
            v[i] = (f32x4){v[i][0] * rs * g[0], v[i][1] * rs * g[1], v[i][2] * rs * g[2], v[i][3] * rs * g[3]};
            store_bf4(c.H + (size_t)row * DM + i * 256 + lane * 4, v[i]);
        }
        float lgp[4] = {0.f, 0.f, 0.f, 0.f};
#pragma unroll
        for (int i = 0; i < 4; ++i)
#pragma unroll
            for (int j = 0; j < 4; ++j) { const f32x4 w = *(const f32x4*)(wrg + (size_t)(i * 256 + lane * 4 + j) * 4); lgp[0] += v[i][j] * w[0]; lgp[1] += v[i][j] * w[1]; lgp[2] += v[i][j] * w[2]; lgp[3] += v[i][j] * w[3]; }
#pragma unroll
        for (int o = 0; o < 4; ++o) lgp[o] = wave_sum_dpp(lgp[o]) + brg[o];
        int grp = 0; float gm = lgp[0];
#pragma unroll
        for (int o = 1; o < 4; ++o) if (lgp[o] > gm) { gm = lgp[o]; grp = o; }
        float gs = 0.f;
#pragma unroll
        for (int o = 0; o < 4; ++o) gs += __expf(lgp[o] - gm);
        const float ptop = 1.0f / gs;
        float le[8] = {0.f, 0.f, 0.f, 0.f, 0.f, 0.f, 0.f, 0.f};
#pragma unroll
        for (int i = 0; i < 4; ++i)
#pragma unroll
            for (int j = 0; j < 4; ++j) {
                const float* wp = wre + (size_t)(i * 256 + lane * 4 + j) * 32 + grp * 8;
                const f32x4 w0 = *(const f32x4*)wp, w1 = *(const f32x4*)(wp + 4);
                le[0] += v[i][j] * w0[0]; le[1] += v[i][j] * w0[1]; le[2] += v[i][j] * w0[2]; le[3] += v[i][j] * w0[3];
                le[4] += v[i][j] * w1[0]; le[5] += v[i][j] * w1[1]; le[6] += v[i][j] * w1[2]; le[7] += v[i][j] * w1[3];
            }
#pragma unroll
        for (int o = 0; o < 8; ++o) le[o] = wave_sum_dpp(le[o]) + bre[grp * 8 + o];
        int i0 = 0; float v0 = le[0];
#pragma unroll
        for (int o = 1; o < 8; ++o) if (le[o] > v0) { v0 = le[o]; i0 = o; }
        int i1 = -1; float v1 = -INFINITY;
#pragma unroll
        for (int o = 0; o < 8; ++o) if (o != i0 && le[o] > v1) { v1 = le[o]; i1 = o; }
        const float e1 = __expf(v1 - v0), inv = 1.0f / (1.0f + e1);
        if (lane == 0) {
            int* rt = c.ROUTE + (size_t)row * 8;
            const int ex0 = grp * 8 + i0, ex1 = grp * 8 + i1;
            rt[0] = ex0; rt[1] = ex1; ((float*)rt)[2] = inv * ptop; ((float*)rt)[3] = e1 * inv * ptop;
            atomicAdd(cnt + ex0, 1u); atomicAdd(cnt + ex1, 1u);
        }
    }
}
DI void phase_route2(const Ctx& c, unsigned char* lds) {
    int* soff = (int*)lds;
    const unsigned* cnt = c.ctl + CW_CNT + c.l * 32;
    unsigned* cur = c.ctl + CW_CUR + c.l * 32;
    __syncthreads();
    if (TID() == 0) { int s = 0; for (int e = 0; e < 32; ++e) { soff[e] = s; s += (int)cnt[e]; } }
    __syncthreads();
    for (int t = blockIdx.x * NTHREADS + TID(); t < NT; t += gridDim.x * NTHREADS) {
        int* rt = c.ROUTE + (size_t)t * 8;
#pragma unroll
        for (int s = 0; s < 2; ++s) {
            const int e = rt[s];
            const int p = soff[e] + (int)atomicAdd(cur + e, 1u);
            rt[4 + s] = p;
            c.ENT[2 * p] = t; ((float*)c.ENT)[2 * p + 1] = ((const float*)rt)[2 + s];
        }
    }
}
DI void moe_tables(const Ctx& c, int* soff, int* stile, int ncol) {
    const unsigned* cnt = c.ctl + CW_CNT + c.l * 32;
    __syncthreads();
    if (TID() == 0) { int s = 0, tt = 0; for (int e = 0; e < 32; ++e) { soff[e] = s; stile[e] = tt; s += (int)cnt[e]; tt += (((int)cnt[e] + 255) >> 8) * ncol; } soff[32] = s; stile[32] = tt; }
    __syncthreads();
}
DI void phase_moe_up(const Ctx& c, unsigned char* lds) {
    int* soff = (int*)(lds + 2 * G_STAGE); int* stile = soff + 64;
    moe_tables(c, soff, stile, 2);
    const int total = stile[32];
    for (int item = blockIdx.x; item < total; item += gridDim.x) {
        int e = 0;
        for (int q = 1; q < 32; ++q) if (stile[q] <= item) e = q;
        const int loc = item - stile[e], tm = loc >> 1, tn = loc & 1, n0 = tn * 128;
        const int p0 = soff[e] + tm * 256, pend = soff[e + 1];
        ARows ar;
#pragma unroll
        for (int i = 0; i < 4; ++i) { const int pr = p0 + (TID() >> 3) + 64 * i; ar.p[i] = (pr < pend) ? c.H + (size_t)c.ENT[2 * pr] * DM : nullptr; }
        {
            f32x4 ag[4][4]; acc_zero(ag);
            gemm_core<0>(ag, ar, (const bf16_t*)(c.ws + WS_EG) + ((size_t)e * 256 + n0) * DM, DM, DM, lds);
            ACC_FOREACH(ag, { if (p0 + r_ < pend) store_bf4(c.HID + (size_t)(p0 + r_) * 256 + n0 + c_, (f32x4){v_[0] * sigmoidf_(v_[0]), v_[1] * sigmoidf_(v_[1]), v_[2] * sigmoidf_(v_[2]), v_[3] * sigmoidf_(v_[3])}); });
        }
        f32x4 au[4][4]; acc_zero(au);
        gemm_core<0>(au, ar, (const bf16_t*)(c.ws + WS_EU) + ((size_t)e * 256 + n0) * DM, DM, DM, lds);
        ACC_FOREACH(au, { if (p0 + r_ < pend) { bf16_t* q = c.HID + (size_t)(p0 + r_) * 256 + n0 + c_; const u32x2 sv = *(const u32x2*)q;
            store_bf4(q, (f32x4){bflo(sv.x) * v_[0], bfhi(sv.x) * v_[1], bflo(sv.y) * v_[2], bfhi(sv.y) * v_[3]}); } });
    }
}
DI void phase_moe_down(const Ctx& c, unsigned char* lds) {
    int* soff = (int*)(lds + 2 * G_STAGE); int* stile = soff + 64;
    moe_tables(c, soff, stile, 8);
    const int total = stile[32];
    for (int item = blockIdx.x; item < total; item += gridDim.x) {
        int e = 0;
        for (int q = 1; q < 32; ++q) if (stile[q] <= item) e = q;
        const int loc = item - stile[e], tm = loc >> 3, tn = loc & 7, n0 = tn * 128;
        const int p0 = soff[e] + tm * 256, pend = soff[e + 1];
        ARows ar;
#pragma unroll
        for (int i = 0; i < 4; ++i) { const int pr = p0 + (TID() >> 3) + 64 * i; ar.p[i] = (pr < pend) ? c.HID + (size_t)pr * 256 : nullptr; }
        f32x4 acc[4][4]; acc_zero(acc);
        gemm_core<0>(acc, ar, (const bf16_t*)(c.ws + WS_ED) + ((size_t)e * DM + n0) * 256, 256, 256, lds);
        ACC_FOREACH(acc, { if (p0 + r_ < pend) { const float w = ((const float*)c.ENT)[2 * (p0 + r_) + 1];
            store_bf4(c.Y + (size_t)(p0 + r_) * DM + n0 + c_, (f32x4){v_[0] * w, v_[1] * w, v_[2] * w, v_[3] * w}); } });
    }
}
DI void phase_final(const Ctx& c) {
    const int tid = TID(), lane = tid & 63, wave = tid >> 6;
    const float* gain = c.in(I_NFIN);
    for (int row = blockIdx.x * 8 + wave; row < NT; row += gridDim.x * 8) {
        f32x4 v[4];
#pragma unroll
        for (int i = 0; i < 4; ++i) v[i] = *(const f32x4*)(c.out + (size_t)row * DM + i * 256 + lane * 4);
        add_moe_rows(c, row, lane, v);
        float ss = 0.f;
#pragma unroll
        for (int i = 0; i < 4; ++i) ss += v[i][0] * v[i][0] + v[i][1] * v[i][1] + v[i][2] * v[i][2] + v[i][3] * v[i][3];
        ss = wave_sum_dpp(ss);
        const float rs = rsqrtf(ss * (1.0f / DM) + 1e-6f);
#pragma unroll
        for (int i = 0; i < 4; ++i) {
            const f32x4 g = *(const f32x4*)(gain + i * 256 + lane * 4);
            *(f32x4*)(c.out + (size_t)row * DM + i * 256 + lane * 4) = (f32x4){v[i][0] * rs * g[0], v[i][1] * rs * g[1], v[i][2] * rs * g[2], v[i][3] * rs * g[3]};
        }
    }
}

constexpr int PH_PER_LAYER = 12, N_PHASES = DEPTH * PH_PER_LAYER + 1;
__global__ void __launch_bounds__(NTHREADS, 2) fwd_kernel(Params P) {
    extern __shared__ __attribute__((aligned(16))) unsigned char lds[];
    const int lo = P.ph_lo, hi = P.ph_hi;
    LAS unsigned* xbw = (LAS unsigned*)(lds + LDS_BYTES - 16);
    if (threadIdx.x == 0) { xbw[0] = 0u; xbw[1] = 0u; xbw[2] = 0u; xbw[3] = 0u; }
    __syncthreads();
    Ctx c; c.P = &P; c.ws = P.ws; c.out = P.out; c.l = 0;
    c.ctl = (unsigned*)(P.ws + WS_CTL);
    c.H = (bf16_t*)(P.ws + WS_H); c.PROJ = (bf16_t*)(P.ws + WS_PROJ); c.F = (bf16_t*)(P.ws + WS_F); c.POOLED = (bf16_t*)(P.ws + WS_POOLED);
    c.MERGED = (bf16_t*)(P.ws + WS_F); c.CMPH = (bf16_t*)(P.ws + WS_CMPH); c.CMPO = (float*)(P.ws + WS_CMPO); c.POSB = (float*)(P.ws + WS_POSB);
    c.ROUTE = (int*)(P.ws + WS_ROUTE); c.ENT = (int*)(P.ws + WS_ENT); c.HID = (bf16_t*)(P.ws + WS_HID); c.Y = (bf16_t*)(P.ws + WS_Y);
    c.VT = (bf16_t*)(P.ws + WS_VT); c.KC = (bf16_t*)(P.ws + WS_KC); c.VCT = (bf16_t*)(P.ws + WS_VCT); c.YRAW = (bf16_t*)(P.ws + WS_YRAW); c.BON = (float*)(P.ws + WS_BON);
    XcdBarrier bar; bar.bar = c.ctl + CW_BAR; bar.x = 0; bar.st = (volatile LAS unsigned*)xbw;
    if (hi - lo > 1) bar = xcd_barrier_post(c.ctl + CW_BAR, (volatile LAS unsigned*)xbw);
#define IN(k) (lo <= (k) && (k) < hi)
#define SEAM(k) do { if (IN(k) && IN((k) + 1)) xcd_barrier(bar); } while (0)
#pragma unroll 1
    for (int l = 0; l < DEPTH; ++l) {
        c.l = l; const int pb = l * PH_PER_LAYER;
        if (IN(pb + 0)) phase_norm1(c, lds);
        SEAM(pb + 0);
        if (IN(pb + 1)) phase_gemm1(c, lds);
        SEAM(pb + 1);
        if (IN(pb + 2)) phase_prep(c, lds);
        SEAM(pb + 2);
        if (IN(pb + 3)) phase_poolgemm(c, lds);
        SEAM(pb + 3);
        if (IN(pb + 4)) phase_mix(c, lds);
        SEAM(pb + 4);
        if (IN(pb + 5)) phase_rwkv_post(c, lds);
        SEAM(pb + 5);
        if (IN(pb + 6)) phase_merge(c, lds);
        SEAM(pb + 6);
        if (IN(pb + 7)) phase_outp(c, lds);
        SEAM(pb + 7);
        if (IN(pb + 8)) phase_norm2(c);
        SEAM(pb + 8);
        if (IN(pb + 9)) phase_route2(c, lds);
        SEAM(pb + 9);
        if (IN(pb + 10)) phase_moe_up(c, lds);
        SEAM(pb + 10);
        if (IN(pb + 11)) phase_moe_down(c, lds);
        SEAM(pb + 11);
    }
    if (IN(N_PHASES - 1)) phase_final(c);
}

#ifndef MK_N_LAUNCHES
#define MK_N_LAUNCHES 1
#endif
extern "C" void kernel_launch(void* const* d_in, const int* in_sizes, int n_in, void* d_out, int out_size, void* d_ws, size_t ws_size, hipStream_t stream) {
    static int grid = 0;
    if (grid == 0) {
        if (n_in != N_IN || out_size != NT * DM || ws_size < WS_END) { fprintf(stderr, "kernel_launch: unexpected shapes n_in %d out %d ws %zu (need %zu)\n", n_in, out_size, ws_size, (size_t)WS_END); grid = -1; return; }
        int dev = 0, cus = 0, per_cu = 0;
        if (hipGetDevice(&dev) != hipSuccess || hipDeviceGetAttribute(&cus, hipDeviceAttributeMultiprocessorCount, dev) != hipSuccess) { grid = -1; return; }
        if (hipFuncSetAttribute((const void*)fwd_kernel, hipFuncAttributeMaxDynamicSharedMemorySize, LDS_BYTES) != hipSuccess) { fprintf(stderr, "kernel_launch: hipFuncSetAttribute failed\n"); grid = -1; return; }
        if (hipOccupancyMaxActiveBlocksPerMultiprocessor(&per_cu, (const void*)fwd_kernel, NTHREADS, LDS_BYTES) != hipSuccess || per_cu < 1) { fprintf(stderr, "kernel_launch: occupancy query says %d\n", per_cu); }
        (void)hipGetLastError();
        grid = cus;
    }
    if (grid < 0) return;
    if (hipMemsetAsync((char*)d_ws + WS_CTL, 0, CTL_BYTES, stream) != hipSuccess) return;
    Params p{};
    for (int i = 0; i < N_IN; ++i) p.in[i] = (const float*)d_in[i];
    p.out = (float*)d_out; p.ws = (unsigned char*)d_ws;
    if (MK_N_LAUNCHES == 1) {
        p.ph_lo = 0; p.ph_hi = N_PHASES;
        hipLaunchKernelGGL(fwd_kernel, dim3(grid), dim3(NTHREADS), LDS_BYTES, stream, p);
    } else {
        for (int k = 0; k < N_PHASES; ++k) { p.ph_lo = k; p.ph_hi = k + 1; hipLaunchKernelGGL(fwd_kernel, dim3(grid), dim3(NTHREADS), LDS_BYTES, stream, p); }
    }
}
```

```cpp
#include <hip/hip_runtime.h>
#include <cstdio>
#include <cstdint>

#define DI __device__ __forceinline__
typedef unsigned short bf16_t;
typedef short bf16x8 __attribute__((ext_vector_type(8)));
typedef float f32x4 __attribute__((ext_vector_type(4)));
typedef unsigned u32x4 __attribute__((ext_vector_type(4)));
typedef unsigned u32x2 __attribute__((ext_vector_type(2)));

constexpr int NB = 4, SEQ = 4096, DM = 1024, NT = NB * SEQ, DEPTH = 2;
constexpr int IN_COLS = 4816;
constexpr int C_POOL = 0, C_RW = 512, C_R = 512, C_K = 1024, C_V = 1536, C_WD = 2048, C_AD = 2080, C_GD = 2112;
constexpr int C_Q = 2208, C_KC = 3232, C_VC = 3488, C_KS = 3744, C_VS = 4000, C_KW = 4256, C_VW = 4512, C_GATE = 4768;
constexpr int RWC = 1696;
constexpr int NCMP = 255;
constexpr int NTHREADS = 512;
constexpr int LDS_BYTES = 114688;

enum { I_X = 0, I_RELB, I_NMIX, I_WIN, I_POOLW, I_POOLS, I_MU, I_W0, I_WUP, I_A0, I_AUP, I_GUP, I_KK, I_KA, I_RK, I_GNW, I_GNB,
       I_CPK, I_CW1K, I_CW2K, I_CPV, I_CW1V, I_CW2V, I_WBR, I_WMG, I_BMG, I_WOUT, I_NFFN, I_WRG, I_BRG, I_WRE, I_BRE, I_EG, I_EU, I_ED, I_NFIN, N_IN };

constexpr size_t WS_CTL = 0;
constexpr size_t CTL_BYTES = 65536;
constexpr size_t WS_H = CTL_BYTES;
constexpr size_t WS_PROJ = WS_H + (size_t)NT * DM * 2;
constexpr size_t WS_F = WS_PROJ + (size_t)NT * IN_COLS * 2;
constexpr size_t PLANE = (size_t)NT * 512 * 2;
constexpr size_t WS_POOLED = WS_F + 6 * PLANE;
constexpr size_t WS_CMPH = WS_POOLED + PLANE;
constexpr size_t WS_CMPO = WS_CMPH + (size_t)2 * 4096 * 256 * 2;
constexpr size_t WS_POSB = WS_CMPO + (size_t)2 * 4096 * 64 * 4;
constexpr size_t WS_ROUTE = WS_POSB + 4096;
constexpr size_t WS_ENT = WS_ROUTE + (size_t)NT * 32;
constexpr size_t WS_VT = WS_ENT + (size_t)2 * NT * 8;
constexpr size_t WS_KC = WS_VT + (size_t)2 * 16 * 64 * SEQ * 2;
constexpr size_t WS_VCT = WS_KC + (size_t)16 * 256 * 64 * 2;
constexpr size_t WS_YRAW = WS_VCT + (size_t)16 * 64 * 256 * 2;
constexpr size_t WS_BON = WS_YRAW + (size_t)NT * 512 * 2;
constexpr size_t WS_SMALLW = WS_BON + (size_t)NT * 8 * 16;
constexpr size_t WS_END = WS_SMALLW + 262144;
constexpr size_t WS_WT_IN = WS_F;
constexpr size_t WS_WT_C1 = WS_CMPO;
constexpr size_t WS_WT_C2 = WS_SMALLW;
constexpr size_t WS_WT_POOL = WS_SMALLW + 131072;
constexpr size_t WS_WT_MG = WS_VT;
constexpr size_t WS_WT_BR = WS_VT + (size_t)3072 * 1024 * 2;
constexpr size_t WS_WT_OUT = WS_CMPH;
constexpr size_t WS_EG = WS_F + 2 * PLANE;
constexpr size_t WS_EU = WS_EG + (size_t)32 * 256 * 1024 * 2;
constexpr size_t WS_ED = WS_EU + (size_t)32 * 256 * 1024 * 2;
static_assert(WS_ED + (size_t)32 * 1024 * 256 * 2 <= WS_F + 6 * PLANE, "expert alias");
static_assert(WS_WT_BR + (size_t)2048 * 1024 * 2 <= WS_VT + (size_t)2 * 16 * 64 * SEQ * 2, "merge alias");
static_assert((size_t)4864 * 1024 * 2 <= 6 * PLANE, "w_in alias");
constexpr size_t WS_HID = WS_PROJ;
constexpr size_t WS_Y = WS_PROJ + (size_t)2 * NT * 256 * 2;
static_assert(WS_Y + (size_t)2 * NT * 1024 * 2 <= WS_F, "alias");
constexpr int CW_BAR = 0;
constexpr int CW_CNT = 4096;
constexpr int CW_CUR = 4096 + 64;
constexpr int CW_Q = 4096 + 128;

#define XB_TMO      128
#define XB_XCNT(j)  (256  + 64 * (j))
#define XB_XSUB(j)  (1280 + 64 * (j))
#define XB_XGEN(j)  (2304 + 64 * (j))
#define XB_TOP      3328
#define XB_TOPGEN   3392
#define XCD_BAR_WORDS 3456
#define XB_SPIN_CAP (1u << 18)
#define LAS __attribute__((address_space(3)))

__device__ __forceinline__ unsigned xb_ld(unsigned* p)              { return __hip_atomic_load(p, __ATOMIC_RELAXED, __HIP_MEMORY_SCOPE_AGENT); }
__device__ __forceinline__ unsigned xb_add(unsigned* p, unsigned v) { return __hip_atomic_fetch_add(p, v, __ATOMIC_RELAXED, __HIP_MEMORY_SCOPE_AGENT); }
__device__ __forceinline__ unsigned xb_xcc_id() { return (unsigned)__builtin_amdgcn_s_getreg((3 << 11) | 20) & 0xFu; }
#define XB_SPIN(cond, bar) do { unsigned _sp = 0; while (cond) { __builtin_amdgcn_s_sleep(1); \
    if ((++_sp & 255u) == 0u) { if (xb_ld(&(bar)[XB_TMO])) break; if (_sp > XB_SPIN_CAP) { atomicAdd(&(bar)[XB_TMO], 1u); break; } } } } while (0)

struct XcdBarrier { unsigned* bar; unsigned x; volatile LAS unsigned* st; };

__device__ __forceinline__ XcdBarrier xcd_barrier_post(unsigned* bar, volatile LAS unsigned* st) {
    XcdBarrier b; b.bar = bar; b.x = xb_xcc_id(); b.st = st;
    if (threadIdx.x == 0) (void)xb_add(&bar[XB_XCNT(b.x)], 1u);
    return b;
}
__device__ __forceinline__ void xcd_barrier_complete(unsigned* bar, unsigned x, unsigned& nloc, unsigned& nx) {
    const unsigned G = gridDim.x * gridDim.y * gridDim.z;
    unsigned sum, cnt, mine, sp = 0u;
    for (;;) {
        sum = 0u; cnt = 0u; mine = 0u;
#pragma unroll
        for (unsigned j = 0; j < 16; ++j) { const unsigned c = xb_ld(&bar[XB_XCNT(j)]); sum += c; cnt += (c > 0u) ? 1u : 0u; mine = (j == x) ? c : mine; }
        if (sum == G) break;
        __builtin_amdgcn_s_sleep(1);
        if ((++sp & 255u) == 0u) { if (xb_ld(&bar[XB_TMO])) break; if (sp > XB_SPIN_CAP) { atomicAdd(&bar[XB_TMO], 1u); break; } }
    }
    nloc = mine > 0u ? mine : 1u; nx = cnt > 0u ? cnt : 1u;
}
__device__ __forceinline__ void xcd_barrier(const XcdBarrier& b) {
    asm volatile("s_waitcnt vmcnt(0)" ::: "memory");
    __syncthreads();
    if (threadIdx.x == 0) {
        unsigned* bar = b.bar;
        __builtin_amdgcn_s_waitcnt(0);
        unsigned nloc = b.st[0], nx = b.st[1];
        if (nloc == 0u) { xcd_barrier_complete(bar, b.x, nloc, nx); b.st[0] = nloc; b.st[1] = nx; }
        const unsigned old = xb_add(&bar[XB_XSUB(b.x)], 1u);
        const unsigned gen = old / nloc;
        if (old + 1u == (gen + 1u) * nloc) {
            __builtin_amdgcn_fence(__ATOMIC_RELEASE, "agent");
            asm volatile("s_waitcnt vmcnt(0)" ::: "memory");
            const unsigned og = xb_add(&bar[XB_TOP], 1u);
            const unsigned tg = og / nx;
            if (og + 1u == (tg + 1u) * nx) xb_add(&bar[XB_TOPGEN], 1u);
            else XB_SPIN(xb_ld(&bar[XB_TOPGEN]) == tg, bar);
            __builtin_amdgcn_fence(__ATOMIC_ACQUIRE, "agent");
            xb_add(&bar[XB_XGEN(b.x)], 1u);
            asm volatile("s_waitcnt vmcnt(0)" ::: "memory");
        } else {
            XB_SPIN(xb_ld(&bar[XB_XGEN(b.x)]) == gen, bar);
            __builtin_amdgcn_fence(__ATOMIC_ACQUIRE, "agent");
            asm volatile("s_waitcnt vmcnt(0)" ::: "memory");
        }
    }
    __syncthreads();
}

DI bf16_t f2bf(float x) { unsigned u = __float_as_uint(x); u += 0x7fffu + ((u >> 16) & 1u); return (bf16_t)(u >> 16); }
DI float bf2f(bf16_t b) { return __uint_as_float((unsigned)b << 16); }
typedef __bf16 bf16v2_t __attribute__((ext_vector_type(2)));
typedef float f32v2_t __attribute__((ext_vector_type(2)));
DI unsigned pack2(float lo, float hi) { const f32v2_t v = {lo, hi}; const bf16v2_t b = __builtin_convertvector(v, bf16v2_t); return __builtin_bit_cast(unsigned, b); }
DI float bflo(unsigned w) { return __uint_as_float(w << 16); }
DI float bfhi(unsigned w) { return __uint_as_float(w & 0xffff0000u); }
DI float wave_sum(float v) {
#pragma unroll
    for (int o = 32; o >= 1; o >>= 1) v += __shfl_xor(v, o);
    return v;
}
DI float wave_max(float v) {
#pragma unroll
    for (int o = 32; o >= 1; o >>= 1) v = fmaxf(v, __shfl_xor(v, o));
    return v;
}
DI float sigmoidf_(float x) { return __builtin_amdgcn_rcpf(1.0f + __expf(-x)); }
DI int TID() { int t = threadIdx.x; asm volatile("" : "+v"(t)); return t; }
#define LDS_WAVE_SYNC() asm volatile("s_waitcnt lgkmcnt(0)" ::: "memory")

#define DPP_MOV(v, ctrl) __builtin_bit_cast(float, __builtin_amdgcn_update_dpp(0, __builtin_bit_cast(int, (v)), (ctrl), 0xF, 0xF, true))
DI float wave_sum_dpp(float v) {
    v += DPP_MOV(v, 0xB1); v += DPP_MOV(v, 0x4E); v += DPP_MOV(v, 0x141); v += DPP_MOV(v, 0x140);
    return __builtin_bit_cast(float, __builtin_amdgcn_readlane(__builtin_bit_cast(int, v), 0)) + __builtin_bit_cast(float, __builtin_amdgcn_readlane(__builtin_bit_cast(int, v), 16)) +
        (__builtin_bit_cast(float, __builtin_amdgcn_readlane(__builtin_bit_cast(int, v), 32)) + __builtin_bit_cast(float, __builtin_amdgcn_readlane(__builtin_bit_cast(int, v), 48)));
}
struct Params { const float* in[N_IN]; float* out; unsigned char* ws; int ph_lo, ph_hi; };

DI int t5_bucket(int n) {
    if (n < 16) return n;
    if (n >= 128) return 31;
    int b = 16;
    b += (n >= 19) + (n >= 21) + (n >= 24) + (n >= 27) + (n >= 31) + (n >= 35) + (n >= 40) + (n >= 46) + (n >= 52) + (n >= 59) + (n >= 67) + (n >= 77) + (n >= 87) + (n >= 99) + (n >= 113);
    return b;
}

constexpr int GS = 72;
constexpr int G_A = 0, G_B = 256 * GS * 2, G_STAGE = (256 + 128) * GS * 2;
static_assert(2 * G_STAGE <= LDS_BYTES - 64, "gemm lds");
struct ARows { const bf16_t* p[4]; };
template <int AMODE>
DI void g_load(u32x4 (&ra)[4], u32x4 (&rb)[2], const ARows& ar, const bf16_t* bt, int ldb, int k0, int tid) {
    const int kseg = (tid & 7) * 8;
#pragma unroll
    for (int i = 0; i < 4; ++i) {
        ra[i] = (u32x4){0u, 0u, 0u, 0u};
        if (ar.p[i] != nullptr) ra[i] = *(const u32x4*)((AMODE == 0) ? (ar.p[i] + k0 + kseg) : (ar.p[i] + (size_t)(k0 >> 6) * IN_COLS + kseg));
    }
#pragma unroll
    for (int i = 0; i < 2; ++i) rb[i] = *(const u32x4*)(bt + (size_t)((tid >> 3) + 64 * i) * ldb + k0 + kseg);
}
DI void g_store(unsigned char* st, const u32x4 (&ra)[4], const u32x4 (&rb)[2], int tid) {
    const int r = tid >> 3, kseg = (tid & 7) * 8;
#pragma unroll
    for (int i = 0; i < 4; ++i) *(u32x4*)((bf16_t*)(st + G_A) + (r + 64 * i) * GS + kseg) = ra[i];
#pragma unroll
    for (int i = 0; i < 2; ++i) *(u32x4*)((bf16_t*)(st + G_B) + (r + 64 * i) * GS + kseg) = rb[i];
}
DI void g_compute(f32x4 (&acc)[4][4], const unsigned char* st, int lane, int wm, int wn) {
    const bf16_t* sA = (const bf16_t*)(st + G_A) + (wm * 64 + (lane & 15)) * GS + (lane >> 4) * 8;
    const bf16_t* sB = (const bf16_t*)(st + G_B) + (wn * 64 + (lane & 15)) * GS + (lane >> 4) * 8;
    bf16x8 bcur[4], bnxt[4], a0, a1, a2;
#pragma unroll
    for (int i = 0; i < 4; ++i) bcur[i] = *(const bf16x8*)(sB + i * 16 * GS);
    a0 = *(const bf16x8*)(sA);
    a1 = *(const bf16x8*)(sA + 16 * GS);
#define G_AFRAG(s) (*(const bf16x8*)(sA + ((s) & 3) * 16 * GS + ((s) >> 2) * 32))
#define G_GROUP(s, acur, anew) do { \
        if ((s) + 2 < 8) anew = G_AFRAG((s) + 2); \
        if ((s) < 4) bnxt[(s) & 3] = *(const bf16x8*)(sB + ((s) & 3) * 16 * GS + 32); \
        __builtin_amdgcn_sched_barrier(0); \
        _Pragma("unroll") for (int ni = 0; ni < 4; ++ni) acc[(s) & 3][ni] = __builtin_amdgcn_mfma_f32_16x16x32_bf16(((s) < 4 ? bcur[ni] : bnxt[ni]), acur, acc[(s) & 3][ni], 0, 0, 0); \
        __builtin_amdgcn_sched_barrier(0); } while (0)
    G_GROUP(0, a0, a2); G_GROUP(1, a1, a0); G_GROUP(2, a2, a1); G_GROUP(3, a0, a2);
    G_GROUP(4, a1, a0); G_GROUP(5, a2, a1); G_GROUP(6, a0, a2); G_GROUP(7, a1, a0);
#undef G_GROUP
#undef G_AFRAG
}
#define LDS_BARRIER() do { asm volatile("s_waitcnt lgkmcnt(0)" ::: "memory"); __builtin_amdgcn_s_barrier(); asm volatile("" ::: "memory"); } while (0)
template <int AMODE>
DI void gemm_core(f32x4 (&acc)[4][4], const ARows& ar, const bf16_t* bt  , int ldb, int K, unsigned char* lds) {
    const int tid = TID(), lane = tid & 63, wave = tid >> 6, wm = wave >> 1, wn = wave & 1;
    const int nk = K >> 6;
    unsigned char* s0 = lds; unsigned char* s1 = lds + G_STAGE;
    u32x4 ra0[4], rb0[2], ra1[4], rb1[2];
    g_load<AMODE>(ra0, rb0, ar, bt, ldb, 0, tid);
    g_load<AMODE>(ra1, rb1, ar, bt, ldb, 64, tid);
    __syncthreads();
    g_store(s0, ra0, rb0, tid);
    g_load<AMODE>(ra0, rb0, ar, bt, ldb, (nk > 2 ? 2 : nk - 1) * 64, tid);
    LDS_BARRIER();
    for (int kt = 0; kt < nk; kt += 2) {
        g_store(s1, ra1, rb1, tid);
        { const int kn = (kt + 3 < nk) ? kt + 3 : nk - 1; g_load<AMODE>(ra1, rb1, ar, bt, ldb, kn * 64, tid); }
        g_compute(acc, s0, lane, wm, wn);
        LDS_BARRIER();
        g_store(s0, ra0, rb0, tid);
        { const int kn = (kt + 4 < nk) ? kt + 4 : nk - 1; g_load<AMODE>(ra0, rb0, ar, bt, ldb, kn * 64, tid); }
        g_compute(acc, s1, lane, wm, wn);
        LDS_BARRIER();
    }
}
DI void acc_zero(f32x4 (&acc)[4][4]) {
#pragma unroll
    for (int i = 0; i < 4; ++i)
#pragma unroll
        for (int j = 0; j < 4; ++j) acc[i][j] = (f32x4){0.f, 0.f, 0.f, 0.f};
}
#define ACC_FOREACH(acc, body) do { const int _l = TID() & 63, _w = TID() >> 6; \
    _Pragma("unroll") for (int _mi = 0; _mi < 4; ++_mi) _Pragma("unroll") for (int _ni = 0; _ni < 4; ++_ni) { \
        const int r_ = (_w >> 1) * 64 + _mi * 16 + (_l & 15), c_ = (_w & 1) * 64 + _ni * 16 + (_l >> 4) * 4; f32x4& v_ = acc[_mi][_ni]; body } } while (0)
DI ARows plain_rows(const bf16_t* base, size_t ld, int m0, int tid) { ARows a;
#pragma unroll
    for (int i = 0; i < 4; ++i) a.p[i] = base + (size_t)(m0 + (tid >> 3) + 64 * i) * ld;
    return a; }

DI void store_bf4(bf16_t* p, f32x4 v) { u32x2 w; w.x = pack2(v[0], v[1]); w.y = pack2(v[2], v[3]); *(u32x2*)p = w; }

DI void convert_tile4(const float* src, int ld, int N, int K, bf16_t* dst, int tile0, unsigned char* lds) {
    const int tid = TID();
    const int nkt = K >> 6;
    const int r = tid >> 3, seg = (tid & 7) * 8;
    f32x4 a[4], b[4];
#pragma unroll
    for (int u = 0; u < 4; ++u) {
        const int tile = tile0 + u, k0 = (tile % nkt) * 64, n0 = (tile / nkt) * 64;
        a[u] = (f32x4){0.f, 0.f, 0.f, 0.f}; b[u] = a[u];
        if (n0 + seg < N) { const float* q = src + (size_t)(k0 + r) * ld + n0 + seg; a[u] = *(const f32x4*)q; b[u] = *(const f32x4*)(q + 4); }
    }
    __syncthreads();
#pragma unroll
    for (int u = 0; u < 4; ++u) { bf16_t* T = (bf16_t*)lds + u * 64 * 72;
        u32x4 w; w.x = pack2(a[u][0], a[u][1]); w.y = pack2(a[u][2], a[u][3]); w.z = pack2(b[u][0], b[u][1]); w.w = pack2(b[u][2], b[u][3]); *(u32x4*)(T + r * 72 + seg) = w; }
    __syncthreads();
#pragma unroll
    for (int u = 0; u < 4; ++u) { const bf16_t* T = (const bf16_t*)lds + u * 64 * 72;
        const int tile = tile0 + u, k0 = (tile % nkt) * 64, n0 = (tile / nkt) * 64;
        u32x4 o;
        o.x = (unsigned)T[(seg + 0) * 72 + r] | ((unsigned)T[(seg + 1) * 72 + r] << 16); o.y = (unsigned)T[(seg + 2) * 72 + r] | ((unsigned)T[(seg + 3) * 72 + r] << 16);
        o.z = (unsigned)T[(seg + 4) * 72 + r] | ((unsigned)T[(seg + 5) * 72 + r] << 16); o.w = (unsigned)T[(seg + 6) * 72 + r] | ((unsigned)T[(seg + 7) * 72 + r] << 16);
        *(u32x4*)(dst + (size_t)(n0 + r) * K + k0 + seg) = o; }
}
struct Ctx {
    const Params* P; unsigned char* ws; float* out; int l;
    bf16_t* H; bf16_t* PROJ; bf16_t* F; bf16_t* POOLED; bf16_t* MERGED; bf16_t* CMPH; float* CMPO; float* POSB; int* ROUTE; int* ENT; bf16_t* HID; bf16_t* Y; bf16_t* VT; bf16_t* KC; bf16_t* VCT; bf16_t* YRAW; float* BON; unsigned* ctl;
    DI const float* in(int i) const { return P->in[i]; }
};

DI void add_moe_rows(const Ctx& c, int row, int lane, f32x4 (&v)[4]) {
    const int* rt = c.ROUTE + (size_t)row * 8;
    const int p0 = rt[4], p1 = rt[5];
    const bf16_t* y0 = c.Y + (size_t)p0 * DM; const bf16_t* y1 = c.Y + (size_t)p1 * DM;
#pragma unroll
    for (int i = 0; i < 4; ++i) {
        const u32x2 a = *(const u32x2*)(y0 + i * 256 + lane * 4), b = *(const u32x2*)(y1 + i * 256 + lane * 4);
        v[i][0] += bflo(a.x) + bflo(b.x); v[i][1] += bfhi(a.x) + bfhi(b.x); v[i][2] += bflo(a.y) + bflo(b.y); v[i][3] += bfhi(a.y) + bfhi(b.y);
    }
}
DI void phase_norm1(const Ctx& c, unsigned char* lds) {
    const int tid = TID(), lane = tid & 63, wave = tid >> 6;
    const float* gain = c.in(I_NMIX) + c.l * DM;
    const float* src = (c.l == 0) ? c.in(I_X) : c.out;
    for (int row = blockIdx.x * 8 + wave; row < NT; row += gridDim.x * 8) {
        f32x4 v[4];
#pragma unroll
        for (int i = 0; i < 4; ++i) v[i] = *(const f32x4*)(src + (size_t)row * DM + i * 256 + lane * 4);
        if (c.l > 0) {
            add_moe_rows(c, row, lane, v);
#pragma unroll
            for (int i = 0; i < 4; ++i) *(f32x4*)(c.out + (size_t)row * DM + i * 256 + lane * 4) = v[i];
        }
        float ss = 0.f;
#pragma unroll
        for (int i = 0; i < 4; ++i) ss += v[i][0] * v[i][0] + v[i][1] * v[i][1] + v[i][2] * v[i][2] + v[i][3] * v[i][3];
        ss = wave_sum_dpp(ss);
        const float rs = rsqrtf(ss * (1.0f / DM) + 1e-6f);
#pragma unroll
        for (int i = 0; i < 4; ++i) {
            const f32x4 g = *(const f32x4*)(gain + i * 256 + lane * 4);
            store_bf4(c.H + (size_t)row * DM + i * 256 + lane * 4, (f32x4){v[i][0] * rs * g[0], v[i][1] * rs * g[1], v[i][2] * rs * g[2], v[i][3] * rs * g[3]});
        }
    }
    for (int idx = blockIdx.x * 8 + wave; idx < 512; idx += gridDim.x * 8) {
        const int kv = idx >> 8, n = idx & 255;
        const float* pos = c.in(kv ? I_CPV : I_CPK) + (size_t)c.l * 2048;
        const float* w1 = c.in(kv ? I_CW1V : I_CW1K) + (size_t)c.l * 2048 * 256;
        float s = 0.f;
        for (int k = lane; k < 2048; k += 64) s += pos[k] * w1[(size_t)k * 256 + n];
        s = wave_sum_dpp(s);
        if (lane == 0) c.POSB[kv * 256 + n] = s;
    }
    for (int it = blockIdx.x * 4; it < 1216 + 256 + 16 + 16; it += gridDim.x * 4) {
        if (it < 1216) convert_tile4(c.in(I_WIN) + (size_t)c.l * DM * IN_COLS, IN_COLS, IN_COLS, DM, (bf16_t*)(c.ws + WS_WT_IN), it, lds);
        else if (it < 1216 + 256) { const int j = it - 1216, kv = j >> 7; convert_tile4(c.in(kv ? I_CW1V : I_CW1K) + (size_t)c.l * 2048 * 256, 256, 256, 2048, (bf16_t*)(c.ws + WS_WT_C1) + (size_t)kv * 256 * 2048, j & 127, lds); }
        else if (it < 1216 + 256 + 16) { const int j = it - 1472, kv = j >> 3; convert_tile4(c.in(kv ? I_CW2V : I_CW2K) + (size_t)c.l * 256 * 64, 64, 64, 256, (bf16_t*)(c.ws + WS_WT_C2) + (size_t)kv * 128 * 256, j & 7, lds); }
        else { const int j = it - 1488, gi = j >> 2; convert_tile4(c.in(I_POOLW) + ((size_t)c.l * 4 + gi) * 128 * 128, 128, 128, 128, (bf16_t*)(c.ws + WS_WT_POOL) + (size_t)gi * 128 * 128, 0, lds); }
    }
}

DI bool xcd_unit(int it, int nN, int& tm, int& tn) {
    const int G = gridDim.x;
    if ((G & 7) != 0 || G < 8) { const int u = it * G + blockIdx.x; if (u >= 64 * nN) return false; tm = u % 64; tn = u / 64; return true; }
    const int x = blockIdx.x & 7, i = blockIdx.x >> 3, per = G >> 3;
    const int u = it * per + i;
    if (u >= 8 * nN) return false;
    tm = x * 8 + (u & 7); tn = u >> 3; return true;
}
DI void phase_gemm1(const Ctx& c, unsigned char* lds) {
    const int nM = NT / 256, nN = (IN_COLS + 127) / 128;
    const bf16_t* WT = (const bf16_t*)(c.ws + WS_WT_IN);
    for (int it = 0;; ++it) {
        int tm, tn; if (!xcd_unit(it, nN, tm, tn)) break;
        const int m0 = tm * 256, n0 = tn * 128;
        f32x4 acc[4][4]; acc_zero(acc);
        const ARows ar = plain_rows(c.H, DM, m0, TID());
        gemm_core<0>(acc, ar, WT + (size_t)n0 * DM, DM, DM, lds);
        ACC_FOREACH(acc, { if (n0 + c_ < IN_COLS) store_bf4(c.PROJ + (size_t)(m0 + r_) * IN_COLS + n0 + c_, v_); });
    }
}

DI float gelu_tanh(float x) { const float u = 0.7978845608028654f * (x + 0.044715f * x * x * x); const float e = __expf(2.0f * u); return x * (1.0f - __builtin_amdgcn_rcpf(e + 1.0f)); }
DI float softplusf_(float x) { return (x > 20.f) ? x : __logf(1.0f + __expf(x)); }
DI float tanhf_(float x) { const float e = __expf(2.0f * x); return 1.0f - 2.0f * __builtin_amdgcn_rcpf(e + 1.0f); }
constexpr int TKP = 8;
template <int WIN>
DI void pool_emit(const Ctx& c, const float (&pv)[TKP + 15], int t0, int s0, int ch) {
#pragma unroll
    for (int k = 0; k < TKP; ++k) {
        float sum = 0.f;
#pragma unroll
        for (int j = 0; j < WIN; ++j) sum += pv[15 + k - j];
        const int s = s0 + k, cnt = (s + 1 < WIN) ? s + 1 : WIN;
        c.POOLED[(size_t)(t0 + k) * 512 + ch] = f2bf(sum / (float)cnt - pv[15 + k]);
    }
}
DI void phase_prep(const Ctx& c, unsigned char* lds) {
    const int n_cmp_items = 2 * 16 * 2;
    for (int item = (int)gridDim.x - 1 - (int)blockIdx.x; item < n_cmp_items; item += gridDim.x) {
        const int tid = TID();
        const int kv = item >> 5, bgi = (item >> 1) & 15, tn = item & 1, m0 = bgi * 256, n0 = tn * 128;
        ARows ar;
#pragma unroll
        for (int i = 0; i < 4; ++i) { const int cb = (tid >> 3) + 64 * i;
            ar.p[i] = (cb < NCMP) ? c.PROJ + ((size_t)(bgi >> 2) * SEQ + 16 * cb) * IN_COLS + (kv ? C_VC : C_KC) + (bgi & 3) * 64 : nullptr; }
        f32x4 acc[4][4]; acc_zero(acc);
        gemm_core<1>(acc, ar, (const bf16_t*)(c.ws + WS_WT_C1) + ((size_t)kv * 256 + n0) * 2048, 2048, 2048, lds);
        const float* pb = c.POSB + kv * 256;
        ACC_FOREACH(acc, {
            const f32x4 bb = *(const f32x4*)(pb + n0 + c_);
            store_bf4(c.CMPH + ((size_t)kv * 4096 + m0 + r_) * 256 + n0 + c_, (f32x4){gelu_tanh(v_[0] + bb[0]), gelu_tanh(v_[1] + bb[1]), gelu_tanh(v_[2] + bb[2]), gelu_tanh(v_[3] + bb[3])}); });
    }
    const int tid = TID();
    const int n_prep = n_cmp_items + NT / TKP;
    const int n_items = n_prep + 2048;
    for (int item = n_cmp_items + blockIdx.x; item < n_items; item += gridDim.x) {
        if (item >= n_prep) {
            const int idx = item - n_prep, kind = idx >> 10, bgi = (idx >> 6) & 15, s0 = (idx & 63) * 64;
            bf16_t* T = (bf16_t*)lds;
            const int r = tid >> 3, seg = (tid & 7) * 8;
            const u32x4 w = *(const u32x4*)(c.PROJ + ((size_t)(bgi >> 2) * SEQ + s0 + r) * IN_COLS + (kind ? C_VW : C_VS) + (bgi & 3) * 64 + seg);
            __syncthreads();
            *(u32x4*)(T + r * 72 + seg) = w;
            __syncthreads();
            u32x4 o;
            o.x = (unsigned)T[(seg + 0) * 72 + r] | ((unsigned)T[(seg + 1) * 72 + r] << 16); o.y = (unsigned)T[(seg + 2) * 72 + r] | ((unsigned)T[(seg + 3) * 72 + r] << 16);
            o.z = (unsigned)T[(seg + 4) * 72 + r] | ((unsigned)T[(seg + 5) * 72 + r] << 16); o.w = (unsigned)T[(seg + 6) * 72 + r] | ((unsigned)T[(seg + 7) * 72 + r] << 16);
            *(u32x4*)(c.VT + (((size_t)kind * 16 + bgi) * 64 + r) * SEQ + s0 + seg) = o;
        } else {
            const int t0 = (item - n_cmp_items) * TKP;
            float* sl = (float*)lds;
            const float* mu = c.in(I_MU) + (size_t)c.l * RWC;
            __syncthreads();
            for (int idx = tid; idx < TKP * 160; idx += NTHREADS) {
                const int tk = idx / 160, i = idx % 160, t = t0 + tk, col = C_WD + i;
                const float u = bf2f(c.PROJ[(size_t)t * IN_COLS + col]);
                const float up = ((t & (SEQ - 1)) != 0) ? bf2f(c.PROJ[(size_t)(t - 1) * IN_COLS + col]) : 0.f;
                const float us = u + (up - u) * mu[col - C_RW];
                sl[idx] = (i < 32) ? tanhf_(us) : ((i < 64) ? us : sigmoidf_(us));
            }
            __syncthreads();
            const int ch = tid;
            float z[TKP], aa[TKP], gg[TKP];
#pragma unroll
            for (int k = 0; k < TKP; ++k) { z[k] = 0.f; aa[k] = 0.f; gg[k] = 0.f; }
            const float* wup = c.in(I_WUP) + (size_t)c.l * 32 * 512 + ch;
            const float* aup = c.in(I_AUP) + (size_t)c.l * 32 * 512 + ch;
            const float* gup = c.in(I_GUP) + (size_t)c.l * 96 * 512 + ch;
#pragma unroll 1
            for (int i0 = 0; i0 < 32; i0 += 4) {
                float wv[4], av[4];
#pragma unroll
                for (int u = 0; u < 4; ++u) { wv[u] = wup[(i0 + u) * 512]; av[u] = aup[(i0 + u) * 512]; }
#pragma unroll
                for (int u = 0; u < 4; ++u)
#pragma unroll
                    for (int k = 0; k < TKP; ++k) { z[k] += sl[k * 160 + i0 + u] * wv[u]; aa[k] += sl[k * 160 + 32 + i0 + u] * av[u]; }
            }
#pragma unroll 1
            for (int i0 = 0; i0 < 96; i0 += 8) {
                float wv[8];
#pragma unroll
                for (int u = 0; u < 8; ++u) wv[u] = gup[(i0 + u) * 512];
#pragma unroll
                for (int u = 0; u < 8; ++u)
#pragma unroll
                    for (int k = 0; k < TKP; ++k) gg[k] += sl[k * 160 + 64 + i0 + u] * wv[u];
            }
            const float w0 = c.in(I_W0)[c.l * 512 + ch], a0 = c.in(I_A0)[c.l * 512 + ch];
            const float kkw_ = c.in(I_KK)[c.l * 512 + ch], kaw_ = c.in(I_KA)[c.l * 512 + ch], rkw_ = c.in(I_RK)[c.l * 512 + ch];
            const float mur = mu[ch], muk = mu[512 + ch], muv = mu[1024 + ch];
            float pr = 0.f, pk = 0.f, pv = 0.f;
            if ((t0 & (SEQ - 1)) != 0) { const bf16_t* q = c.PROJ + (size_t)(t0 - 1) * IN_COLS; pr = bf2f(q[C_R + ch]); pk = bf2f(q[C_K + ch]); pv = bf2f(q[C_V + ch]); }
#pragma unroll
            for (int k = 0; k < TKP; ++k) {
                const int t = t0 + k; const bf16_t* q = c.PROJ + (size_t)t * IN_COLS;
                const float ur = bf2f(q[C_R + ch]), uk = bf2f(q[C_K + ch]), uv = bf2f(q[C_V + ch]);
                const float r = ur + (pr - ur) * mur, kx = uk + (pk - uk) * muk, vx = uv + (pv - uv) * muv;
                pr = ur; pk = uk; pv = uv;
                if ((k & 3) == 3) { asm volatile("" ::: "memory"); __builtin_amdgcn_sched_barrier(0); }
                const float wlog = -softplusf_(-(w0 + z[k])) - 0.5f;
                const float e = __expf(wlog);
                const float a = sigmoidf_(a0 + aa[k]);
                const size_t o = (size_t)t * 512 + ch;
                {
                    const float kxn = kx * kkw_, kp = kx * (1.0f + (a - 1.0f) * kaw_);
                    const float ss = wave_sum_dpp(kxn * kxn);
                    const float inv = __builtin_amdgcn_rsqf(fmaxf(ss, 1e-24f));
                    const float br = wave_sum_dpp(kxn * inv * a * r), kr = wave_sum_dpp(kp * r), bon = wave_sum_dpp(r * kp * rkw_);
                    if ((tid & 63) == 0) *(f32x4*)(c.BON + ((size_t)t * 8 + (tid >> 6)) * 4) = (f32x4){inv, br, kr, bon};
                }
                c.F[o] = f2bf(r); c.F[o + (size_t)NT * 512] = f2bf(kx); c.F[o + (size_t)2 * NT * 512] = f2bf(vx);
                c.F[o + (size_t)3 * NT * 512] = f2bf(e); c.F[o + (size_t)4 * NT * 512] = f2bf(a); c.F[o + (size_t)5 * NT * 512] = f2bf(gg[k]);
            }
            asm volatile("" ::: "memory"); __builtin_amdgcn_sched_barrier(0);
            {
                const int gi = ch >> 7;
                const int s0 = t0 & (SEQ - 1);
                float pv[TKP + 15];
#pragma unroll
                for (int i = 0; i < TKP + 15; ++i) pv[i] = (s0 - 15 + i >= 0) ? bf2f(c.PROJ[(size_t)(t0 - 15 + i) * IN_COLS + C_POOL + ch]) : 0.f;
                if (gi == 0) pool_emit<2>(c, pv, t0, s0, ch);
                else if (gi == 1) pool_emit<4>(c, pv, t0, s0, ch);
                else if (gi == 2) pool_emit<8>(c, pv, t0, s0, ch);
                else pool_emit<16>(c, pv, t0, s0, ch);
            }
        }
    }
}

DI void phase_poolgemm(const Ctx& c, unsigned char* lds) {
    const int n_pool = (NT / 256) * 4, n_items = n_pool + 32;
    for (int item = blockIdx.x; item < n_items; item += gridDim.x) {
        f32x4 acc[4][4]; acc_zero(acc);
        if (item < n_pool) {
            const int tm = item >> 2, gi = item & 3, m0 = tm * 256;
            const ARows ar = plain_rows(c.POOLED + gi * 128, 512, m0, TID());
            gemm_core<0>(acc, ar, (const bf16_t*)(c.ws + WS_WT_POOL) + (size_t)gi * 128 * 128, 128, 128, lds);
            const float* sc = c.in(I_POOLS) + c.l * 512 + gi * 128;
            ACC_FOREACH(acc, { const f32x4 s = *(const f32x4*)(sc + c_);
                store_bf4(c.POOLED + (size_t)(m0 + r_) * 512 + gi * 128 + c_, (f32x4){v_[0] * s[0], v_[1] * s[1], v_[2] * s[2], v_[3] * s[3]}); });
        } else {
            const int it = item - n_pool, kv = it >> 4, tm = it & 15, m0 = tm * 256;
            const ARows ar = plain_rows(c.CMPH + (size_t)kv * 4096 * 256, 256, m0, TID());
            gemm_core<0>(acc, ar, (const bf16_t*)(c.ws + WS_WT_C2) + (size_t)kv * 128 * 256, 256, 256, lds);
            ACC_FOREACH(acc, { if (c_ < 64) { const int R = m0 + r_;
                if (kv == 0) store_bf4(c.KC + (size_t)R * 64 + c_, v_);
                else { bf16_t* q = c.VCT + ((size_t)(R >> 8) * 64 + c_) * 256 + (R & 255); q[0] = f2bf(v_[0]); q[256] = f2bf(v_[1]); q[512] = f2bf(v_[2]); q[768] = f2bf(v_[3]); } } });
        }
    }
}

constexpr int SCH = 32;
constexpr int SB_AN = 0, SB_WR = SCH * 64 * 4, SB_W = 2 * SCH * 64 * 4, SB_BB = 3 * SCH * 64 * 4, SB_KP = 4 * SCH * 64 * 4;
constexpr int SB_V = 5 * SCH * 64 * 4;
constexpr int SB_SC = SB_V + SCH * 16 * 4;
constexpr int SB_Y = SB_SC + SCH * 2 * 4;
constexpr int SB_BYTES = SB_Y + SCH * 16 * 4;
static_assert(2 * SB_BYTES <= LDS_BYTES - 64, "scan lds");
typedef float f32x2 __attribute__((ext_vector_type(2)));
DI float row8_sum(float v) { v += DPP_MOV(v, 0xB1); v += DPP_MOV(v, 0x4E); v += DPP_MOV(v, 0x141); return v; }

constexpr int NPW = 6, NJ = (SCH + NPW - 1) / NPW;
struct PrepRegs { bf16_t r[NJ], k[NJ], v[NJ], e[NJ], a[NJ]; float s0[NJ], s1[NJ], s2[NJ]; };
DI void prep_load(PrepRegs& R, const Ctx& c, int b, int h, int ck, int pw, int lane) {
    const size_t PL = (size_t)NT * 512;
    const size_t tb = (size_t)b * SEQ + ck * SCH;
    const size_t o0 = tb * 512 + h * 64 + lane;
#pragma unroll
    for (int j = 0; j < NJ; ++j) {
        const int st = pw + NPW * j;
        if (st < SCH) { const size_t o = o0 + (size_t)st * 512; R.r[j] = c.F[o]; R.k[j] = c.F[o + PL]; R.v[j] = c.F[o + 2 * PL]; R.e[j] = c.F[o + 3 * PL]; R.a[j] = c.F[o + 4 * PL];
            const float* sp = c.BON + ((tb + st) * 8 + h) * 4; R.s0[j] = sp[0]; R.s1[j] = sp[1]; R.s2[j] = sp[2]; }
    }
}
DI void prep_store(const PrepRegs& R, unsigned char* sb, int rq, int pw, int lane, float kkw, float kaw) {
    float* an = (float*)(sb + SB_AN); float* wr = (float*)(sb + SB_WR); float* w_ = (float*)(sb + SB_W); float* bb_ = (float*)(sb + SB_BB); float* kp_ = (float*)(sb + SB_KP);
    float* vv = (float*)(sb + SB_V); float* sc = (float*)(sb + SB_SC);
#pragma unroll
    for (int j = 0; j < NJ; ++j) {
        const int st = pw + NPW * j;
        if (st < SCH) {
            const float r = bf2f(R.r[j]), k = bf2f(R.k[j]), v = bf2f(R.v[j]), e = bf2f(R.e[j]), a = bf2f(R.a[j]);
            const float w = __expf(-e);
            const float kk = k * kkw * R.s0[j];
            const float kp = k * (1.0f + (a - 1.0f) * kaw);
            an[st * 64 + lane] = -kk; wr[st * 64 + lane] = w * r; w_[st * 64 + lane] = w; bb_[st * 64 + lane] = kk * a; kp_[st * 64 + lane] = kp;
            if ((lane >> 4) == rq) vv[st * 16 + (lane & 15)] = v;
            if (lane == 0) { sc[st * 2] = R.s1[j]; sc[st * 2 + 1] = R.s2[j]; }
        }
    }
}
DI void scan_item(const Ctx& c, int item, unsigned char* lds) {
    const int tid = TID(), lane = tid & 63, wave = tid >> 6;
    const int b = item >> 5, h = (item >> 2) & 7, rq = item & 3;
    const int chn = h * 64 + lane;
    const float kkw = c.in(I_KK)[c.l * 512 + chn], kaw = c.in(I_KA)[c.l * 512 + chn];
    const int rowl = (tid & 127) >> 3, cg = tid & 7;
    f32x2 st[4];
#pragma unroll
    for (int i = 0; i < 4; ++i) st[i] = (f32x2){0.f, 0.f};
    constexpr int NCK = SEQ / SCH;
    PrepRegs R;
    __syncthreads();
    if (wave >= 2) { prep_load(R, c, b, h, 0, wave - 2, lane); prep_store(R, lds, rq, wave - 2, lane, kkw, kaw); prep_load(R, c, b, h, 1, wave - 2, lane); }
    __syncthreads();
    for (int ck = 0; ck < NCK; ++ck) {
        unsigned char* sb = lds + (ck & 1) * SB_BYTES;
        if (wave < 2) {
            const float* an = (const float*)(sb + SB_AN) + cg * 8; const float* wr = (const float*)(sb + SB_WR) + cg * 8; const float* w_ = (const float*)(sb + SB_W) + cg * 8;
            const float* bb_ = (const float*)(sb + SB_BB) + cg * 8; const float* kp_ = (const float*)(sb + SB_KP) + cg * 8;
            const float* vv = (const float*)(sb + SB_V) + rowl; const float* sc = (const float*)(sb + SB_SC); float* yb = (float*)(sb + SB_Y) + rowl;
            f32x4 a0 = *(const f32x4*)(an), a1 = *(const f32x4*)(an + 4), r0 = *(const f32x4*)(wr), r1 = *(const f32x4*)(wr + 4);
            f32x4 w0 = *(const f32x4*)(w_), w1 = *(const f32x4*)(w_ + 4), b0 = *(const f32x4*)(bb_), b1 = *(const f32x4*)(bb_ + 4);
            f32x4 k0 = *(const f32x4*)(kp_), k1 = *(const f32x4*)(kp_ + 4);
            float v = vv[0]; f32x2 bk = *(const f32x2*)(sc);
#pragma unroll 2
            for (int s = 0; s < SCH; ++s) {
                const int sn = (s + 1 < SCH) ? s + 1 : s;
                const f32x4 na0 = *(const f32x4*)(an + sn * 64), na1 = *(const f32x4*)(an + sn * 64 + 4), nr0 = *(const f32x4*)(wr + sn * 64), nr1 = *(const f32x4*)(wr + sn * 64 + 4);
                const f32x4 nw0 = *(const f32x4*)(w_ + sn * 64), nw1 = *(const f32x4*)(w_ + sn * 64 + 4), nb0 = *(const f32x4*)(bb_ + sn * 64), nb1 = *(const f32x4*)(bb_ + sn * 64 + 4);
                const f32x4 nk0 = *(const f32x4*)(kp_ + sn * 64), nk1 = *(const f32x4*)(kp_ + sn * 64 + 4);
                const float nv = vv[sn * 16]; const f32x2 nbk = *(const f32x2*)(sc + sn * 2);
                f32x2 da = st[0] * (f32x2){a0[0], a0[1]}; f32x2 dr = st[0] * (f32x2){r0[0], r0[1]};
                da += st[1] * (f32x2){a0[2], a0[3]}; dr += st[1] * (f32x2){r0[2], r0[3]};
                da += st[2] * (f32x2){a1[0], a1[1]}; dr += st[2] * (f32x2){r1[0], r1[1]};
                da += st[3] * (f32x2){a1[2], a1[3]}; dr += st[3] * (f32x2){r1[2], r1[3]};
                float sa = da[0] + da[1], sr = dr[0] + dr[1];
                sa += DPP_MOV(sa, 0xB1); sr += DPP_MOV(sr, 0xB1);
                sa += DPP_MOV(sa, 0x4E); sr += DPP_MOV(sr, 0x4E);
                sa += DPP_MOV(sa, 0x141); sr += DPP_MOV(sr, 0x141);
                const f32x2 sa2 = (f32x2){sa, sa}, v2 = (f32x2){v, v};
                st[0] = st[0] * (f32x2){w0[0], w0[1]} + sa2 * (f32x2){b0[0], b0[1]} + v2 * (f32x2){k0[0], k0[1]};
                st[1] = st[1] * (f32x2){w0[2], w0[3]} + sa2 * (f32x2){b0[2], b0[3]} + v2 * (f32x2){k0[2], k0[3]};
                st[2] = st[2] * (f32x2){w1[0], w1[1]} + sa2 * (f32x2){b1[0], b1[1]} + v2 * (f32x2){k1[0], k1[1]};
                st[3] = st[3] * (f32x2){w1[2], w1[3]} + sa2 * (f32x2){b1[2], b1[3]} + v2 * (f32x2){k1[2], k1[3]};
                yb[s * 16] = sr + sa * bk[0] + v * bk[1];
                a0 = na0; a1 = na1; r0 = nr0; r1 = nr1; w0 = nw0; w1 = nw1; b0 = nb0; b1 = nb1; k0 = nk0; k1 = nk1; v = nv; bk = nbk;
            }
        } else {
            const int pt = tid - 128;
            if (ck + 1 < NCK) prep_store(R, lds + ((ck + 1) & 1) * SB_BYTES, rq, wave - 2, lane, kkw, kaw);
            if (ck + 2 < NCK) prep_load(R, c, b, h, ck + 2, wave - 2, lane);
            if (ck > 0) {
                const float* yb = (const float*)(lds + ((ck - 1) & 1) * SB_BYTES + SB_Y);
                for (int idx = pt; idx < SCH * 16; idx += 384) {
                    const int s = idx >> 4, j = idx & 15;
                    c.YRAW[((size_t)b * SEQ + (ck - 1) * SCH + s) * 512 + h * 64 + rq * 16 + j] = f2bf(yb[idx]);
                }
            }
        }
        asm volatile("s_waitcnt lgkmcnt(0)" ::: "memory"); __builtin_amdgcn_s_barrier(); asm volatile("" ::: "memory");
    }
    {
        const float* yb = (const float*)(lds + ((NCK - 1) & 1) * SB_BYTES + SB_Y);
        for (int idx = tid; idx < SCH * 16; idx += NTHREADS) {
            const int s = idx >> 4, j = idx & 15;
            c.YRAW[((size_t)b * SEQ + (NCK - 1) * SCH + s) * 512 + h * 64 + rq * 16 + j] = f2bf(yb[idx]);
        }
    }
    __syncthreads();
}
DI void phase_rwkv_post(const Ctx& c, unsigned char* lds) {
    const int tid = TID(), lane = tid & 63, wave = tid >> 6;
    const size_t PL = (size_t)NT * 512;
    for (int t = blockIdx.x * 8 + wave; t < NT; t += gridDim.x * 8) {
        bf16_t ry[8], rv[8], rg[8]; float bon[8], gw[8], gb[8];
#pragma unroll
        for (int h = 0; h < 8; ++h) { const size_t o = (size_t)t * 512 + h * 64 + lane; ry[h] = c.YRAW[o]; rv[h] = c.F[o + 2 * PL]; rg[h] = c.F[o + 5 * PL]; bon[h] = c.BON[((size_t)t * 8 + h) * 4 + 3];
            gw[h] = c.in(I_GNW)[c.l * 512 + h * 64 + lane]; gb[h] = c.in(I_GNB)[c.l * 512 + h * 64 + lane]; }
#pragma unroll
        for (int h = 0; h < 8; ++h) {
            const float y = bf2f(ry[h]);
            const float mean = wave_sum_dpp(y) * (1.0f / 64.0f);
            const float d = y - mean;
            const float var = wave_sum_dpp(d * d) * (1.0f / 64.0f);
            const float yn = d * rsqrtf(var + 64e-5f) * gw[h] + gb[h];
            c.F[(size_t)t * 512 + h * 64 + lane + 5 * PL] = f2bf((yn + bon[h] * bf2f(rv[h])) * bf2f(rg[h]));
        }
    }
    for (int it = blockIdx.x * 4; it < 768 + 128 + 128 + 256 + 256; it += gridDim.x * 4) {
        const float* WB = c.in(I_WBR) + (size_t)c.l * 2048 * DM; bf16_t* BR = (bf16_t*)(c.ws + WS_WT_BR);
        if (it < 768) convert_tile4(c.in(I_WMG) + (size_t)c.l * DM * 3 * DM, 3 * DM, 3 * DM, DM, (bf16_t*)(c.ws + WS_WT_MG), it, lds);
        else if (it < 896) convert_tile4(WB, DM, DM, 512, BR, it - 768, lds);
        else if (it < 1024) convert_tile4(WB + (size_t)512 * DM, DM, DM, 512, BR + (size_t)1024 * 512, it - 896, lds);
        else if (it < 1280) convert_tile4(WB + (size_t)1024 * DM, DM, DM, 1024, BR + (size_t)2048 * 512, it - 1024, lds);
        else convert_tile4(c.in(I_WOUT) + (size_t)c.l * DM * DM, DM, DM, DM, (bf16_t*)(c.ws + WS_WT_OUT), it - 1280, lds);
    }
}
constexpr int TS = 72;
constexpr int NSA_BIAS = 0;
constexpr int NSA_SELM = 2112;
constexpr int NSA_SCR = 2624;
constexpr int NSA_K0 = 4672;
constexpr int NSA_V0 = NSA_K0 + 2 * 64 * TS * 2;
constexpr int NSA_A = NSA_V0 + 2 * 64 * TS * 2;
constexpr int NSA_B = NSA_A + 16384;
constexpr int NSA_END = NSA_B + 16384;
static_assert(NSA_END <= LDS_BYTES - 16, "nsa lds");
static_assert(NSA_K0 % 16 == 0, "align");

struct NsaLane { int tq[2]; int h; float cbias; float m[2], l[2]; };

DI void nsa_prefetch(u32x4& rk, u32x4& rv, const bf16_t* kbase, int kstride, const bf16_t* vtbase, int vstride, int pos0, int tid) {
    const int r = tid >> 3, seg = (tid & 7) * 8;
    rk = *(const u32x4*)(kbase + (size_t)(pos0 + r) * kstride + seg);
    rv = *(const u32x4*)(vtbase + (size_t)r * vstride + pos0 + seg);
}
DI void nsa_store(unsigned char* lds, int buf, const u32x4& rk, const u32x4& rv, int tid) {
    const int r = tid >> 3, seg = (tid & 7) * 8;
    *(u32x4*)((bf16_t*)(lds + NSA_K0) + buf * 64 * TS + r * TS + seg) = rk;
    *(u32x4*)((bf16_t*)(lds + NSA_V0) + buf * 64 * TS + r * TS + seg) = rv;
}
template <int QM = 3>
DI void nsa_qk(f32x4 (&s)[2][4], const bf16_t* sK, const bf16x8 (&qf)[2][2], int lane) {
#pragma unroll
    for (int kt = 0; kt < 4; ++kt) {
#pragma unroll
        for (int ks = 0; ks < 2; ++ks) {
            const bf16x8 kf = *(const bf16x8*)(sK + (16 * kt + (lane & 15)) * TS + 32 * ks + (lane >> 4) * 8);
#pragma unroll
            for (int qi = 0; qi < 2; ++qi) if ((QM >> qi) & 1) s[qi][kt] = __builtin_amdgcn_mfma_f32_16x16x32_bf16(kf, qf[qi][ks], (ks == 0) ? (f32x4){0.f, 0.f, 0.f, 0.f} : s[qi][kt], 0, 0, 0);
        }
    }
}
template <int MODE>
DI void nsa_logits(float (&x)[4][4], const f32x4 (&s)[4], int tq, int h, float cbias, bool rowsel, int pos0, int qd, const float* biasT) {
#pragma unroll
    for (int kt = 0; kt < 4; ++kt)
#pragma unroll
        for (int i = 0; i < 4; ++i) {
            const int kk = pos0 + 16 * kt + 4 * qd + i;
            if (MODE == 1) { x[kt][i] = rowsel ? s[kt][i] + cbias : -INFINITY; }
            else {
                const int dist = (MODE == 0) ? (tq - 16 * kk - 31) : (tq - kk);
                bool ok = dist >= 0;
                if (MODE == 2) ok = ok && rowsel;
                if (MODE == 3) ok = ok && (dist < 512);
                const int di = dist < 0 ? 0 : (dist > 128 ? 128 : dist);
                float bias = biasT[di * 4 + h];
                asm volatile("" : "+v"(bias));
                x[kt][i] = ok ? s[kt][i] + bias : -INFINITY;
            }
        }
}
DI float quad16_max(float v) { v = fmaxf(v, __shfl_xor(v, 16)); v = fmaxf(v, __shfl_xor(v, 32)); return v; }
DI float quad16_sum(float v) { v += __shfl_xor(v, 16); v += __shfl_xor(v, 32); return v; }
DI void nsa_softmax(const float (&x)[4][4], float& m, float& l, f32x4 (&O)[4], bf16x8 (&pf)[2]) {
    float mx = -INFINITY;
#pragma unroll
    for (int kt = 0; kt < 4; ++kt)
#pragma unroll
        for (int i = 0; i < 4; ++i) mx = fmaxf(mx, x[kt][i]);
    mx = quad16_max(mx);
    const float mn = fmaxf(m, mx);
    const float mu = (mn == -INFINITY) ? 0.f : mn;
    const float mu2 = mu * 1.4426950408889634f;
    const float sc = __builtin_amdgcn_exp2f(__builtin_fmaf(m, 1.4426950408889634f, -mu2));
    float p[4][4]; float ps = 0.f;
#pragma unroll
    for (int kt = 0; kt < 4; ++kt)
#pragma unroll
        for (int i = 0; i < 4; ++i) { p[kt][i] = __builtin_amdgcn_exp2f(__builtin_fmaf(x[kt][i], 1.4426950408889634f, -mu2)); ps += p[kt][i]; }
    l = l * sc + ps; m = mn;
#pragma unroll
    for (int dt = 0; dt < 4; ++dt) O[dt] = O[dt] * sc;
#pragma unroll
    for (int ks = 0; ks < 2; ++ks) {
        u32x4 w; w.x = pack2(p[2 * ks][0], p[2 * ks][1]); w.y = pack2(p[2 * ks][2], p[2 * ks][3]); w.z = pack2(p[2 * ks + 1][0], p[2 * ks + 1][1]); w.w = pack2(p[2 * ks + 1][2], p[2 * ks + 1][3]);
        pf[ks] = __builtin_bit_cast(bf16x8, w);
    }
}
template <int QM = 3>
DI void nsa_pv(f32x4 (&O)[2][4], const bf16_t* sV, const bf16x8 (&pf)[2][2], int lane) {
    const int qd = lane >> 4;
#pragma unroll
    for (int dt = 0; dt < 4; ++dt)
#pragma unroll
        for (int ks = 0; ks < 2; ++ks) {
            const bf16_t* vp = sV + (16 * dt + (lane & 15)) * TS + 32 * ks + 4 * qd;
            const u32x2 a = *(const u32x2*)vp, b = *(const u32x2*)(vp + 16);
            u32x4 w; w.x = a.x; w.y = a.y; w.z = b.x; w.w = b.y;
            const bf16x8 vf = __builtin_bit_cast(bf16x8, w);
#pragma unroll
            for (int qi = 0; qi < 2; ++qi) if ((QM >> qi) & 1) O[qi][dt] = __builtin_amdgcn_mfma_f32_16x16x32_bf16(vf, pf[qi][ks], O[qi][dt], 0, 0, 0);
        }
}
template <int MODE, int QM = 3>
DI void nsa_tile(f32x4 (&O)[2][4], NsaLane& L, const bf16x8 (&qf)[2][2], const unsigned char* lds, int buf, int pos0, bool sel0, bool sel1, int lane) {
    const bf16_t* sK = (const bf16_t*)(lds + NSA_K0) + buf * 64 * TS;
    const bf16_t* sV = (const bf16_t*)(lds + NSA_V0) + buf * 64 * TS;
    const float* biasT = (const float*)(lds + NSA_BIAS);
    f32x4 s[2][4];
    nsa_qk<QM>(s, sK, qf, lane);
    bf16x8 pf[2][2];
#pragma unroll
    for (int qi = 0; qi < 2; ++qi) if ((QM >> qi) & 1) {
        float x[4][4];
        nsa_logits<MODE>(x, s[qi], L.tq[qi], L.h, L.cbias, qi ? sel1 : sel0, pos0, lane >> 4, biasT);
        nsa_softmax(x, L.m[qi], L.l[qi], O[qi], pf[qi]);
    }
    nsa_pv<QM>(O, sV, pf, lane);
}
template <int MODE>
DI void nsa_tile_sel(f32x4 (&O)[2][4], NsaLane& L, const bf16x8 (&qf)[2][2], const unsigned char* lds, int buf, int pos0, bool sel0, bool sel1, int lane) {
    const bool a0 = __ballot(sel0) != 0ull, a1 = __ballot(sel1) != 0ull;
    if (a0 && a1) nsa_tile<MODE, 3>(O, L, qf, lds, buf, pos0, sel0, sel1, lane);
    else if (a0) nsa_tile<MODE, 1>(O, L, qf, lds, buf, pos0, sel0, sel1, lane);
    else if (a1) nsa_tile<MODE, 2>(O, L, qf, lds, buf, pos0, sel0, sel1, lane);
}
DI void nsa_flush(f32x4 (&Y)[2][4], f32x4 (&O)[2][4], NsaLane& L, const float (&gate)[2]) {
#pragma unroll
    for (int qi = 0; qi < 2; ++qi) {
        const float lt = quad16_sum(L.l[qi]);
        const float f = (lt > 0.f) ? gate[qi] * __builtin_amdgcn_rcpf(lt) : 0.f;
#pragma unroll
        for (int dt = 0; dt < 4; ++dt) { Y[qi][dt] += O[qi][dt] * f; O[qi][dt] = (f32x4){0.f, 0.f, 0.f, 0.f}; }
    }
}
DI void nsa_item(const Ctx& c, int item, unsigned char* lds) {
    const int tid = TID(), lane = tid & 63, wave = tid >> 6, qd = lane >> 4;
    const int b = item >> 8, g = (item >> 6) & 3, qt = item & 63, t0 = qt * 64, cur = qt, bg = b * 4 + g;
    float* biasT = (float*)(lds + NSA_BIAS);
    unsigned long long* selm = (unsigned long long*)(lds + NSA_SELM);
    float* scr = (float*)(lds + NSA_SCR) + wave * 64;
    float* impA = (float*)(lds + NSA_A); float* impB = (float*)(lds + NSA_B);
    __syncthreads();
    for (int i = tid; i < 129 * 4; i += NTHREADS) { const int d = i >> 2, h = i & 3; biasT[i] = c.in(I_RELB)[t5_bucket(d) * 16 + g * 4 + h]; }
    for (int i = tid; i < 2 * 4096; i += NTHREADS) impA[i] = 0.f;
    NsaLane L; L.h = lane & 3;
    bf16x8 qf[2][2]; float gates[2][3];
    const bf16_t* pbat = c.PROJ + (size_t)b * SEQ * IN_COLS;
#pragma unroll
    for (int qi = 0; qi < 2; ++qi) {
        const int tl = 8 * wave + 4 * qi + ((lane & 15) >> 2);
        L.tq[qi] = t0 + tl;
        const bf16_t* prow = pbat + (size_t)L.tq[qi] * IN_COLS;
#pragma unroll
        for (int ks = 0; ks < 2; ++ks) {
            u32x4 w = *(const u32x4*)(prow + C_Q + (g * 4 + L.h) * 64 + 32 * ks + qd * 8);
            w.x = pack2(bflo(w.x) * 0.125f, bfhi(w.x) * 0.125f); w.y = pack2(bflo(w.y) * 0.125f, bfhi(w.y) * 0.125f);
            w.z = pack2(bflo(w.z) * 0.125f, bfhi(w.z) * 0.125f); w.w = pack2(bflo(w.w) * 0.125f, bfhi(w.w) * 0.125f);
            qf[qi][ks] = __builtin_bit_cast(bf16x8, w);
        }
#pragma unroll
        for (int br = 0; br < 3; ++br) gates[qi][br] = sigmoidf_(bf2f(prow[C_GATE + g * 12 + L.h * 3 + br]));
    }
    __syncthreads();
    L.cbias = biasT[128 * 4 + L.h];
    f32x4 O[2][4], Y[2][4];
#pragma unroll
    for (int qi = 0; qi < 2; ++qi)
#pragma unroll
        for (int dt = 0; dt < 4; ++dt) { O[qi][dt] = (f32x4){0.f, 0.f, 0.f, 0.f}; Y[qi][dt] = (f32x4){0.f, 0.f, 0.f, 0.f}; }
    u32x4 rk, rv;
    const int nvis_max = (t0 + 63 >= 31) ? ((t0 + 63 - 31) >> 4) + 1 : 0;
    const int ncb = (nvis_max + 63) >> 6;
    const bf16_t* kcb = c.KC + (size_t)bg * 256 * 64; const bf16_t* vcb = c.VCT + (size_t)bg * 64 * 256;
    L.m[0] = L.m[1] = -INFINITY; L.l[0] = L.l[1] = 0.f;
    if (ncb > 0) nsa_prefetch(rk, rv, kcb, 64, vcb, 256, 0, tid);
    for (int cb = 0; cb < ncb; ++cb) {
        nsa_store(lds, cb & 1, rk, rv, tid);
        __syncthreads();
        if (cb + 1 < ncb) nsa_prefetch(rk, rv, kcb, 64, vcb, 256, (cb + 1) * 64, tid);
        if (16 * (cb * 64 + 63) + 31 + 128 <= t0) nsa_tile<1>(O, L, qf, lds, cb & 1, cb * 64, true, true, lane);
        else nsa_tile<0>(O, L, qf, lds, cb & 1, cb * 64, true, true, lane);
    }
    float mfin[2], linv[2];
#pragma unroll
    for (int qi = 0; qi < 2; ++qi) { mfin[qi] = L.m[qi]; const float lt = quad16_sum(L.l[qi]); linv[qi] = (lt > 0.f) ? __builtin_amdgcn_rcpf(lt) : 0.f; }
    { const float gg[2] = {gates[0][0], gates[1][0]}; nsa_flush(Y, O, L, gg); }
    __syncthreads();
    if (ncb > 0) nsa_prefetch(rk, rv, kcb, 64, vcb, 256, 0, tid);
    for (int cb = 0; cb < ncb; ++cb) {
        nsa_store(lds, cb & 1, rk, rv, tid);
        __syncthreads();
        if (cb + 1 < ncb) nsa_prefetch(rk, rv, kcb, 64, vcb, 256, (cb + 1) * 64, tid);
        const bf16_t* sK = (const bf16_t*)(lds + NSA_K0) + (cb & 1) * 64 * TS;
        f32x4 s[2][4];
        nsa_qk(s, sK, qf, lane);
#pragma unroll
        for (int qi = 0; qi < 2; ++qi) {
            float x[4][4];
            nsa_logits<0>(x, s[qi], L.tq[qi], L.h, L.cbias, true, cb * 64, qd, biasT);
            const float mu = (mfin[qi] == -INFINITY) ? 0.f : mfin[qi];
#pragma unroll
            for (int kt = 0; kt < 4; ++kt) {
                float p3 = __expf(x[kt][3] - mu) * linv[qi];
                float pa = (__expf(x[kt][0] - mu) + __expf(x[kt][1] - mu) + __expf(x[kt][2] - mu)) * linv[qi] + p3;
                pa += __shfl_xor(pa, 1); p3 += __shfl_xor(p3, 1);
                pa += __shfl_xor(pa, 2); p3 += __shfl_xor(p3, 2);
                if (L.h == 0) { const int tl = 8 * wave + 4 * qi + ((lane & 15) >> 2), mi = 16 * cb + 4 * kt + qd; impA[tl * 64 + mi] = pa; impB[tl * 64 + mi] = p3; }
            }
        }
    }
    __syncthreads();
    for (int tl8 = 0; tl8 < 8; ++tl8) {
        const int tl = 8 * wave + tl8, n = lane;
        const bool cand = (n >= 1) && (n <= cur - 2);
        const float imp = cand ? impA[tl * 64 + n] + impB[tl * 64 + n - 1] : -1.0f;
        LDS_WAVE_SYNC();
        scr[n] = imp;
        LDS_WAVE_SYNC();
        int rank = 0;
#pragma unroll 4
        for (int q4 = 0; q4 < 16; ++q4) {
            const f32x4 o = *(const f32x4*)(scr + q4 * 4);
#pragma unroll
            for (int j = 0; j < 4; ++j) { const int n2 = q4 * 4 + j; rank += (o[j] > imp || (o[j] == imp && n2 < n)) ? 1 : 0; }
        }
        const bool forced = (n <= cur) && (n == 0 || n == cur || n == cur - 1);
        const unsigned long long msk = __ballot((cand && rank < 5) || forced);
        if (lane == 0) selm[tl] = msk;
    }
    __syncthreads();
    unsigned long long uni = selm[lane];
#pragma unroll
    for (int o = 32; o >= 1; o >>= 1) { const unsigned lo_ = __shfl_xor((unsigned)uni, o), hi_ = __shfl_xor((unsigned)(uni >> 32), o); uni |= ((unsigned long long)hi_ << 32) | lo_; }
    uni = ((unsigned long long)__builtin_amdgcn_readfirstlane((unsigned)(uni >> 32)) << 32) | (unsigned)__builtin_amdgcn_readfirstlane((unsigned)uni);
    unsigned long long sm[2];
#pragma unroll
    for (int qi = 0; qi < 2; ++qi) sm[qi] = selm[8 * wave + 4 * qi + ((lane & 15) >> 2)];
    const bf16_t* ksb = pbat + C_KS + g * 64; const bf16_t* vsb = c.VT + ((size_t)0 * 16 + bg) * 64 * SEQ;
    L.m[0] = L.m[1] = -INFINITY; L.l[0] = L.l[1] = 0.f;
    {
        unsigned long long rem = uni; int it = 0;
        int j = (int)__builtin_ctzll(rem); rem &= rem - 1;
        nsa_prefetch(rk, rv, ksb, IN_COLS, vsb, SEQ, j * 64, tid);
        for (;;) {
            nsa_store(lds, it & 1, rk, rv, tid);
            __syncthreads();
            const int jn = rem ? (int)__builtin_ctzll(rem) : -1;
            if (jn >= 0) { rem &= rem - 1; nsa_prefetch(rk, rv, ksb, IN_COLS, vsb, SEQ, jn * 64, tid); }
            const bool s0 = (sm[0] >> j) & 1ull, s1 = (sm[1] >> j) & 1ull;
            if (j <= cur - 3) nsa_tile_sel<1>(O, L, qf, lds, it & 1, j * 64, s0, s1, lane);
            else nsa_tile_sel<2>(O, L, qf, lds, it & 1, j * 64, s0, s1, lane);
            if (jn < 0) break;
            j = jn; ++it;
        }
    }
    { const float gg[2] = {gates[0][1], gates[1][1]}; nsa_flush(Y, O, L, gg); }
    const bf16_t* kwb = pbat + C_KW + g * 64; const bf16_t* vwb = c.VT + ((size_t)1 * 16 + bg) * 64 * SEQ;
    L.m[0] = L.m[1] = -INFINITY; L.l[0] = L.l[1] = 0.f;
    {
        const int j0 = (cur - 8 > 0) ? cur - 8 : 0;
        __syncthreads();
        nsa_prefetch(rk, rv, kwb, IN_COLS, vwb, SEQ, j0 * 64, tid);
        for (int j = j0; j <= cur; ++j) {
            nsa_store(lds, (j - j0) & 1, rk, rv, tid);
            __syncthreads();
            if (j + 1 <= cur) nsa_prefetch(rk, rv, kwb, IN_COLS, vwb, SEQ, (j + 1) * 64, tid);
            if (cur - j >= 3 && cur - j <= 7) nsa_tile<1>(O, L, qf, lds, (j - j0) & 1, j * 64, true, true, lane);
            else nsa_tile<3>(O, L, qf, lds, (j - j0) & 1, j * 64, true, true, lane);
        }
    }
    { const float gg[2] = {gates[0][2], gates[1][2]}; nsa_flush(Y, O, L, gg); }
#pragma unroll
    for (int qi = 0; qi < 2; ++qi) {
        bf16_t* yrow = c.PROJ + ((size_t)b * SEQ + L.tq[qi]) * IN_COLS + C_Q + (g * 4 + L.h) * 64;
#pragma unroll
        for (int dt = 0; dt < 4; ++dt) store_bf4(yrow + 16 * dt + 4 * qd, Y[qi][dt]);
    }
}
DI void phase_mix(const Ctx& c, unsigned char* lds) {
    const int G = gridDim.x, bid = blockIdx.x;
    const int n_nsa = NB * 4 * (SEQ / 64), n_scan = NB * 8 * 4;
    const bool split = G >= 2 * n_scan;
    if (split) { if (bid < n_scan) scan_item(c, bid, lds); }
    else for (int item = bid; item < n_scan; item += G) scan_item(c, item, lds);
    unsigned* ctr = c.ctl + CW_Q + c.l;
    volatile int* sitem = (volatile int*)(lds + LDS_BYTES - 32);
    for (;;) {
        __syncthreads();
        if (TID() == 0) *sitem = (int)atomicAdd(ctr, 1u);
        __syncthreads();
        const int k = *sitem;
        if (k >= n_nsa) break;
        const int qt = 63 - (k >> 4), bgi = k & 15;
        nsa_item(c, (bgi << 6) | qt, lds);
    }
}

DI void phase_merge(const Ctx& c, unsigned char* lds) {
    const int nM = NT / 256, nN = DM / 128;
    const bf16_t* WM = (const bf16_t*)(c.ws + WS_WT_MG);
    const bf16_t* BR = (const bf16_t*)(c.ws + WS_WT_BR);
    const float* BM_ = c.in(I_BMG) + (size_t)c.l * 3 * DM;
    bf16_t* TMP = c.YRAW + (size_t)blockIdx.x * 256 * 128;
    for (int it = 0;; ++it) {
        int tm, tn; if (!xcd_unit(it, nN, tm, tn)) break;
        const int m0 = tm * 256, n0 = tn * 128;
#pragma unroll 1
        for (int i = 0; i < 3; ++i) {
            {
                f32x4 ag[4][4]; acc_zero(ag);
                const ARows ar = plain_rows(c.H, DM, m0, TID());
                gemm_core<0>(ag, ar, WM + (size_t)(i * DM + n0) * DM, DM, DM, lds);
                ACC_FOREACH(ag, { const f32x4 bb = *(const f32x4*)(BM_ + i * DM + n0 + c_);
                    store_bf4(TMP + r_ * 128 + c_, (f32x4){sigmoidf_(v_[0] + bb[0]), sigmoidf_(v_[1] + bb[1]), sigmoidf_(v_[2] + bb[2]), sigmoidf_(v_[3] + bb[3])}); });
            }
            f32x4 ab[4][4]; acc_zero(ab);
            if (i == 0) { const ARows ar = plain_rows(c.POOLED, 512, m0, TID()); gemm_core<0>(ab, ar, BR + (size_t)n0 * 512, 512, 512, lds); }
            else if (i == 1) { const ARows ar = plain_rows(c.F + (size_t)5 * NT * 512, 512, m0, TID()); gemm_core<0>(ab, ar, BR + (size_t)1024 * 512 + (size_t)n0 * 512, 512, 512, lds); }
            else { const ARows ar = plain_rows(c.PROJ + C_Q, IN_COLS, m0, TID()); gemm_core<0>(ab, ar, BR + (size_t)2048 * 512 + (size_t)n0 * 1024, 1024, 1024, lds); }
            ACC_FOREACH(ab, {
                bf16_t* q = c.MERGED + (size_t)(m0 + r_) * DM + n0 + c_;
                const u32x2 gv = *(const u32x2*)(TMP + r_ * 128 + c_);
                f32x4 m4 = ((f32x4){0.f, 0.f, 0.f, 0.f});
                if (i > 0) { const u32x2 pv = *(const u32x2*)q; m4 = ((f32x4){bflo(pv.x), bfhi(pv.x), bflo(pv.y), bfhi(pv.y)}); }
                m4[0] += bflo(gv.x) * v_[0]; m4[1] += bfhi(gv.x) * v_[1]; m4[2] += bflo(gv.y) * v_[2]; m4[3] += bfhi(gv.y) * v_[3];
                store_bf4(q, m4); });
        }
    }
}

DI void phase_outp(const Ctx& c, unsigned char* lds) {
    const int nM = NT / 256, nN = DM / 128;
    const bf16_t* W = (const bf16_t*)(c.ws + WS_WT_OUT);
    const float* xin = (c.l == 0) ? c.in(I_X) : c.out;
    for (int it = 0;; ++it) {
        int tm, tn; if (!xcd_unit(it, nN, tm, tn)) break;
        const int m0 = tm * 256, n0 = tn * 128;
        f32x4 acc[4][4]; acc_zero(acc);
        const ARows ar = plain_rows(c.MERGED, DM, m0, TID());
        gemm_core<0>(acc, ar, W + (size_t)n0 * DM, DM, DM, lds);
        ACC_FOREACH(acc, { const size_t o = (size_t)(m0 + r_) * DM + n0 + c_; const f32x4 x = *(const f32x4*)(xin + o); *(f32x4*)(c.out + o) = x + v_; });
    }
    for (int it = blockIdx.x * 4; it < 3 * 32 * 64; it += gridDim.x * 4) {
        const int mat = it / 2048, e = (it >> 6) & 31, tl = it & 63;
        if (mat == 0) convert_tile4(c.in(I_EG) + ((size_t)c.l * 32 + e) * DM * 256, 256, 256, DM, (bf16_t*)(c.ws + WS_EG) + (size_t)e * 256 * DM, tl, lds);
        else if (mat == 1) convert_tile4(c.in(I_EU) + ((size_t)c.l * 32 + e) * DM * 256, 256, 256, DM, (bf16_t*)(c.ws + WS_EU) + (size_t)e * 256 * DM, tl, lds);
        else convert_tile4(c.in(I_ED) + ((size_t)c.l * 32 + e) * 256 * DM, DM, DM, 256, (bf16_t*)(c.ws + WS_ED) + (size_t)e * DM * 256, tl, lds);
    }
}

DI void phase_norm2(const Ctx& c) {
    const int tid = TID(), lane = tid & 63, wave = tid >> 6;
    const float* gain = c.in(I_NFFN) + c.l * DM;
    const float* wrg = c.in(I_WRG) + (size_t)c.l * DM * 4; const float* brg = c.in(I_BRG) + c.l * 4;
    const float* wre = c.in(I_WRE) + (size_t)c.l * DM * 32; const float* bre = c.in(I_BRE) + c.l * 32;
    unsigned* cnt = c.ctl + CW_CNT + c.l * 32;
    for (int row = blockIdx.x * 8 + wave; row < NT; row += gridDim.x * 8) {
        f32x4 v[4];
        float ss = 0.f;
#pragma unroll
        for (int i = 0; i < 4; ++i) { v[i] = *(const f32x4*)(c.out + (size_t)row * DM + i * 256 + lane * 4); ss += v[i][0] * v[i][0] + v[i][1] * v[i][1] + v[i][2] * v[i][2] + v[i][3] * v[i][3]; }
        ss = wave_sum_dpp(ss);
        const float rs = rsqrtf(ss * (1.0f / DM) + 1e-6f);
#pragma unroll
        for (int i = 0; i < 4; ++i) {
            const f32x4 g = *(const f32x4*)(gain + i * 256 + lane * 4);
            v[i] = (f32x4){v[i][0] * rs * g[0], v[i][1] * rs * g[1], v[i][2] * rs * g[2], v[i][3] * rs * g[3]};
            store_bf4(c.H + (size_t)row * DM + i * 256 + lane * 4, v[i]);
        }
        float lgp[4] = {0.f, 0.f, 0.f, 0.f};
#pragma unroll
        for (int i = 0; i < 4; ++i)
#pragma unroll
            for (int j = 0; j < 4; ++j) { const f32x4 w = *(const f32x4*)(wrg + (size_t)(i * 256 + lane * 4 + j) * 4); lgp[0] += v[i][j] * w[0]; lgp[1] += v[i][j] * w[1]; lgp[2] += v[i][j] * w[2]; lgp[3] += v[i][j] * w[3]; }
#pragma unroll
        for (int o = 0; o < 4; ++o) lgp[o] = wave_sum_dpp(lgp[o]) + brg[o];
        int grp = 0; float gm = lgp[0];
#pragma unroll
        for (int o = 1; o < 4; ++o) if (lgp[o] > gm) { gm = lgp[o]; grp = o; }
        float gs = 0.f;
#pragma unroll
        for (int o = 0; o < 4; ++o) gs += __expf(lgp[o] - gm);
        const float ptop = 1.0f / gs;
        float le[8] = {0.f, 0.f, 0.f, 0.f, 0.f, 0.f, 0.f, 0.f};
#pragma unroll
        for (int i = 0; i < 4; ++i)
#pragma unroll
            for (int j = 0; j < 4; ++j) {
                const float* wp = wre + (size_t)(i * 256 + lane * 4 + j) * 32 + grp * 8;
                const f32x4 w0 = *(const f32x4*)wp, w1 = *(const f32x4*)(wp + 4);
                le[0] += v[i][j] * w0[0]; le[1] += v[i][j] * w0[1]; le[2] += v[i][j] * w0[2]; le[3] += v[i][j] * w0[3];
                le[4] += v[i][j] * w1[0]; le[5] += v[i][j] * w1[1]; le[6] += v[i][j] * w1[2]; le[7] += v[i][j] * w1[3];
            }
#pragma unroll
        for (int o = 0; o < 8; ++o) le[o] = wave_sum_dpp(le[o]) + bre[grp * 8 + o];
        int i0 = 0; float v0 = le[0];
#pragma unroll
        for (int o = 1; o < 8; ++o) if (le[o] > v0) { v0 = le[o]; i0 = o; }
        int i1 = -1; float v1 = -INFINITY;
#pragma unroll
        for (int o = 0; o < 8; ++o) if (o != i0 && le[o] > v1) { v1 = le[o]; i1 = o; }
        const float e1 = __expf(v1 - v0), inv = 1.0f / (1.0f + e1);
        if (lane == 0) {
            int* rt = c.ROUTE + (size_t)row * 8;
            const int ex0 = grp * 8 + i0, ex1 = grp * 8 + i1;
            rt[0] = ex0; rt[1] = ex1; ((float*)rt)[2] = inv * ptop; ((float*)rt)[3] = e1 * inv * ptop;
            atomicAdd(cnt + ex0, 1u); atomicAdd(cnt + ex1, 1u);
        }
    }
}
DI void phase_route2(const Ctx& c, unsigned char* lds) {
    int* soff = (int*)lds;
    const unsigned* cnt = c.ctl + CW_CNT + c.l * 32;
    unsigned* cur = c.ctl + CW_CUR + c.l * 32;
    __syncthreads();
    if (TID() == 0) { int s = 0; for (int e = 0; e < 32; ++e) { soff[e] = s; s += (int)cnt[e]; } }
    __syncthreads();
    for (int t = blockIdx.x * NTHREADS + TID(); t < NT; t += gridDim.x * NTHREADS) {
        int* rt = c.ROUTE + (size_t)t * 8;
#pragma unroll
        for (int s = 0; s < 2; ++s) {
            const int e = rt[s];
            const int p = soff[e] + (int)atomicAdd(cur + e, 1u);
            rt[4 + s] = p;
            c.ENT[2 * p] = t; ((float*)c.ENT)[2 * p + 1] = ((const float*)rt)[2 + s];
        }
    }
}
DI void moe_tables(const Ctx& c, int* soff, int* stile, int ncol) {
    const unsigned* cnt = c.ctl + CW_CNT + c.l * 32;
    __syncthreads();
    if (TID() == 0) { int s = 0, tt = 0; for (int e = 0; e < 32; ++e) { soff[e] = s; stile[e] = tt; s += (int)cnt[e]; tt += (((int)cnt[e] + 255) >> 8) * ncol; } soff[32] = s; stile[32] = tt; }
    __syncthreads();
}
DI void phase_moe_up(const Ctx& c, unsigned char* lds) {
    int* soff = (int*)(lds + 2 * G_STAGE); int* stile = soff + 64;
    moe_tables(c, soff, stile, 2);
    const int total = stile[32];
    for (int item = blockIdx.x; item < total; item += gridDim.x) {
        int e = 0;
        for (int q = 1; q < 32; ++q) if (stile[q] <= item) e = q;
        const int loc = item - stile[e], tm = loc >> 1, tn = loc & 1, n0 = tn * 128;
        const int p0 = soff[e] + tm * 256, pend = soff[e + 1];
        ARows ar;
#pragma unroll
        for (int i = 0; i < 4; ++i) { const int pr = p0 + (TID() >> 3) + 64 * i; ar.p[i] = (pr < pend) ? c.H + (size_t)c.ENT[2 * pr] * DM : nullptr; }
        {
            f32x4 ag[4][4]; acc_zero(ag);
            gemm_core<0>(ag, ar, (const bf16_t*)(c.ws + WS_EG) + ((size_t)e * 256 + n0) * DM, DM, DM, lds);
            ACC_FOREACH(ag, { if (p0 + r_ < pend) store_bf4(c.HID + (size_t)(p0 + r_) * 256 + n0 + c_, (f32x4){v_[0] * sigmoidf_(v_[0]), v_[1] * sigmoidf_(v_[1]), v_[2] * sigmoidf_(v_[2]), v_[3] * sigmoidf_(v_[3])}); });
        }
        f32x4 au[4][4]; acc_zero(au);
        gemm_core<0>(au, ar, (const bf16_t*)(c.ws + WS_EU) + ((size_t)e * 256 + n0) * DM, DM, DM, lds);
        ACC_FOREACH(au, { if (p0 + r_ < pend) { bf16_t* q = c.HID + (size_t)(p0 + r_) * 256 + n0 + c_; const u32x2 sv = *(const u32x2*)q;
            store_bf4(q, (f32x4){bflo(sv.x) * v_[0], bfhi(sv.x) * v_[1], bflo(sv.y) * v_[2], bfhi(sv.y) * v_[3]}); } });
    }
}
DI void phase_moe_down(const Ctx& c, unsigned char* lds) {
    int* soff = (int*)(lds + 2 * G_STAGE); int* stile = soff + 64;
    moe_tables(c, soff, stile, 8);
    const int total = stile[32];
    for (int item = blockIdx.x; item < total; item += gridDim.x) {
        int e = 0;
        for (int q = 1; q < 32; ++q) if (stile[q] <= item) e = q;
        const int loc = item - stile[e], tm = loc >> 3, tn = loc & 7, n0 = tn * 128;
        const int p0 = soff[e] + tm * 256, pend = soff[e + 1];
        ARows ar;
#pragma unroll
        for (int i = 0; i < 4; ++i) { const int pr = p0 + (TID() >> 3) + 64 * i; ar.p[i] = (pr < pend) ? c.HID + (size_t)pr * 256 : nullptr; }
        f32x4 acc[4][4]; acc_zero(acc);
        gemm_core<0>(acc, ar, (const bf16_t*)(c.ws + WS_ED) + ((size_t)e * DM + n0) * 256, 256, 256, lds);
        ACC_FOREACH(acc, { if (p0 + r_ < pend) { const float w = ((const float*)c.ENT)[2 * (p0 + r_) + 1];
            store_bf4(c.Y + (size_t)(p0 + r_) * DM + n0 + c_, (f32x4){v_[0] * w, v_[1] * w, v_[2] * w, v_[3] * w}); } });
    }
}
DI void phase_final(const Ctx& c) {
    const int tid = TID(), lane = tid & 63, wave = tid >> 6;
    const float* gain = c.in(I_NFIN);
    for (int row = blockIdx.x * 8 + wave; row < NT; row += gridDim.x * 8) {
        f32x4 v[4];
#pragma unroll
        for (int i = 0; i < 4; ++i) v[i] = *(const f32x4*)(c.out + (size_t)row * DM + i * 256 + lane * 4);
        add_moe_rows(c, row, lane, v);
        float ss = 0.f;
#pragma unroll
        for (int i = 0; i < 4; ++i) ss += v[i][0] * v[i][0] + v[i][1] * v[i][1] + v[i][2] * v[i][2] + v[i][3] * v[i][3];
        ss = wave_sum_dpp(ss);
        const float rs = rsqrtf(ss * (1.0f / DM) + 1e-6f);
#pragma unroll
        for (int i = 0; i < 4; ++i) {
            const f32x4 g = *(const f32x4*)(gain + i * 256 + lane * 4);
            *(f32x4*)(c.out + (size_t)row * DM + i * 256 + lane * 4) = (f32x4){v[i][0] * rs * g[0], v[i][1] * rs * g[1], v[i][2] * rs * g[2], v[i][3] * rs * g[3]};
        }
    }
}

constexpr int PH_PER_LAYER = 12, N_PHASES = DEPTH * PH_PER_LAYER + 1;
__global__ void __launch_bounds__(NTHREADS, 2) fwd_kernel(Params P) {
    extern __shared__ __attribute__((aligned(16))) unsigned char lds[];
    const int lo = P.ph_lo, hi = P.ph_hi;
    LAS unsigned* xbw = (LAS unsigned*)(lds + LDS_BYTES - 16);
    if (threadIdx.x == 0) { xbw[0] = 0u; xbw[1] = 0u; xbw[2] = 0u; xbw[3] = 0u; }
    __syncthreads();
    Ctx c; c.P = &P; c.ws = P.ws; c.out = P.out; c.l = 0;
    c.ctl = (unsigned*)(P.ws + WS_CTL);
    c.H = (bf16_t*)(P.ws + WS_H); c.PROJ = (bf16_t*)(P.ws + WS_PROJ); c.F = (bf16_t*)(P.ws + WS_F); c.POOLED = (bf16_t*)(P.ws + WS_POOLED);
    c.MERGED = (bf16_t*)(P.ws + WS_F); c.CMPH = (bf16_t*)(P.ws + WS_CMPH); c.CMPO = (float*)(P.ws + WS_CMPO); c.POSB = (float*)(P.ws + WS_POSB);
    c.ROUTE = (int*)(P.ws + WS_ROUTE); c.ENT = (int*)(P.ws + WS_ENT); c.HID = (bf16_t*)(P.ws + WS_HID); c.Y = (bf16_t*)(P.ws + WS_Y);
    c.VT = (bf16_t*)(P.ws + WS_VT); c.KC = (bf16_t*)(P.ws + WS_KC); c.VCT = (bf16_t*)(P.ws + WS_VCT); c.YRAW = (bf16_t*)(P.ws + WS_YRAW); c.BON = (float*)(P.ws + WS_BON);
    XcdBarrier bar; bar.bar = c.ctl + CW_BAR; bar.x = 0; bar.st = (volatile LAS unsigned*)xbw;
    if (hi - lo > 1) bar = xcd_barrier_post(c.ctl + CW_BAR, (volatile LAS unsigned*)xbw);
#define IN(k) (lo <= (k) && (k) < hi)
#define SEAM(k) do { if (IN(k) && IN((k) + 1)) xcd_barrier(bar); } while (0)
#pragma unroll 1
    for (int l = 0; l < DEPTH; ++l) {
        c.l = l; const int pb = l * PH_PER_LAYER;
        if (IN(pb + 0)) phase_norm1(c, lds);
        SEAM(pb + 0);
        if (IN(pb + 1)) phase_gemm1(c, lds);
        SEAM(pb + 1);
        if (IN(pb + 2)) phase_prep(c, lds);
        SEAM(pb + 2);
        if (IN(pb + 3)) phase_poolgemm(c, lds);
        SEAM(pb + 3);
        if (IN(pb + 4)) phase_mix(c, lds);
        SEAM(pb + 4);
        if (IN(pb + 5)) phase_rwkv_post(c, lds);
        SEAM(pb + 5);
        if (IN(pb + 6)) phase_merge(c, lds);
        SEAM(pb + 6);
        if (IN(pb + 7)) phase_outp(c, lds);
        SEAM(pb + 7);
        if (IN(pb + 8)) phase_norm2(c);
        SEAM(pb + 8);
        if (IN(pb + 9)) phase_route2(c, lds);
        SEAM(pb + 9);
        if (IN(pb + 10)) phase_moe_up(c, lds);
        SEAM(pb + 10);
        if (IN(pb + 11)) phase_moe_down(c, lds);
        SEAM(pb + 11);
    }
    if (IN(N_PHASES - 1)) phase_final(c);
}

#ifndef MK_N_LAUNCHES
#define MK_N_LAUNCHES 1
#endif
extern "C" void kernel_launch(void* const* d_in, const int* in_sizes, int n_in, void* d_out, int out_size, void* d_ws, size_t ws_size, hipStream_t stream) {
    static int grid = 0;
    if (grid == 0) {
        if (n_in != N_IN || out_size != NT * DM || ws_size < WS_END) { fprintf(stderr, "kernel_launch: unexpected shapes n_in %d out %d ws %zu (need %zu)\n", n_in, out_size, ws_size, (size_t)WS_END); grid = -1; return; }
        int dev = 0, cus = 0, per_cu = 0;
        if (hipGetDevice(&dev) != hipSuccess || hipDeviceGetAttribute(&cus, hipDeviceAttributeMultiprocessorCount, dev) != hipSuccess) { grid = -1; return; }
        if (hipFuncSetAttribute((const void*)fwd_kernel, hipFuncAttributeMaxDynamicSharedMemorySize, LDS_BYTES) != hipSuccess) { fprintf(stderr, "kernel_launch: hipFuncSetAttribute failed\n"); grid = -1; return; }
        if (hipOccupancyMaxActiveBlocksPerMultiprocessor(&per_cu, (const void*)fwd_kernel, NTHREADS, LDS_BYTES) != hipSuccess || per_cu < 1) { fprintf(stderr, "kernel_launch: occupancy query says %d\n", per_cu); }
        (void)hipGetLastError();
        grid = cus;
    }
    if (grid < 0) return;
    if (hipMemsetAsync((char*)d_ws + WS_CTL, 0, CTL_BYTES, stream) != hipSuccess) return;
    Params p{};
    for (int i = 0; i < N_IN; ++i) p.in[i] = (const float*)d_in[i];
    p.out = (float*)d_out; p.ws = (unsigned char*)d_ws;
    if (MK_N_LAUNCHES == 1) {
        p.ph_lo = 0; p.ph_hi = N_PHASES;
        hipLaunchKernelGGL(fwd_kernel, dim3(grid), dim3(NTHREADS), LDS_BYTES, stream, p);
    } else {
        for (int k = 0; k < N_PHASES; ++k) { p.ph_lo = k; p.ph_hi = k + 1; hipLaunchKernelGGL(fwd_kernel, dim3(grid), dim3(NTHREADS), LDS_BYTES, stream, p); }
    }
}
```

```cpp
#include <hip/hip_runtime.h>
#include <cstdio>
#include <cstdint>

#define DI __device__ __forceinline__
typedef unsigned short bf16_t;
typedef short bf16x8 __attribute__((ext_vector_type(8)));
typedef float f32x4 __attribute__((ext_vector_type(4)));
typedef unsigned u32x4 __attribute__((ext_vector_type(4)));
typedef unsigned u32x2 __attribute__((ext_vector_type(2)));

constexpr int NB = 4, SEQ = 4096, DM = 1024, NT = NB * SEQ, DEPTH = 2;
constexpr int IN_COLS = 4816;
constexpr int C_POOL = 0, C_RW = 512, C_R = 512, C_K = 1024, C_V = 1536, C_WD = 2048, C_AD = 2080, C_GD = 2112;
constexpr int C_Q = 2208, C_KC = 3232, C_VC = 3488, C_KS = 3744, C_VS = 4000, C_KW = 4256, C_VW = 4512, C_GATE = 4768;
constexpr int RWC = 1696;
constexpr int NCMP = 255;
constexpr int NTHREADS = 512;
constexpr int LDS_BYTES = 114688;

enum { I_X = 0, I_RELB, I_NMIX, I_WIN, I_POOLW, I_POOLS, I_MU, I_W0, I_WUP, I_A0, I_AUP, I_GUP, I_KK, I_KA, I_RK, I_GNW, I_GNB,
       I_CPK, I_CW1K, I_CW2K, I_CPV, I_CW1V, I_CW2V, I_WBR, I_WMG, I_BMG, I_WOUT, I_NFFN, I_WRG, I_BRG, I_WRE, I_BRE, I_EG, I_EU, I_ED, I_NFIN, N_IN };

constexpr size_t WS_CTL = 0;
constexpr size_t CTL_BYTES = 65536;
constexpr size_t WS_H = CTL_BYTES;
constexpr size_t WS_PROJ = WS_H + (size_t)NT * DM * 2;
constexpr size_t WS_F = WS_PROJ + (size_t)NT * IN_COLS * 2;
constexpr size_t PLANE = (size_t)NT * 512 * 2;
constexpr size_t WS_POOLED = WS_F + 6 * PLANE;
constexpr size_t WS_CMPH = WS_POOLED + PLANE;
constexpr size_t WS_CMPO = WS_CMPH + (size_t)2 * 4096 * 256 * 2;
constexpr size_t WS_POSB = WS_CMPO + (size_t)2 * 4096 * 64 * 4;
constexpr size_t WS_ROUTE = WS_POSB + 4096;
constexpr size_t WS_ENT = WS_ROUTE + (size_t)NT * 32;
constexpr size_t WS_VT = WS_ENT + (size_t)2 * NT * 8;
constexpr size_t WS_KC = WS_VT + (size_t)2 * 16 * 64 * SEQ * 2;
constexpr size_t WS_VCT = WS_KC + (size_t)16 * 256 * 64 * 2;
constexpr size_t WS_YRAW = WS_VCT + (size_t)16 * 64 * 256 * 2;
constexpr size_t WS_BON = WS_YRAW + (size_t)NT * 512 * 2;
constexpr size_t WS_SMALLW = WS_BON + (size_t)NT * 8 * 16;
constexpr size_t WS_END = WS_SMALLW + 262144;
constexpr size_t WS_WT_IN = WS_F;
constexpr size_t WS_WT_C1 = WS_CMPO;
constexpr size_t WS_WT_C2 = WS_SMALLW;
constexpr size_t WS_WT_POOL = WS_SMALLW + 131072;
constexpr size_t WS_WT_MG = WS_VT;
constexpr size_t WS_WT_BR = WS_VT + (size_t)3072 * 1024 * 2;
constexpr size_t WS_WT_OUT = WS_CMPH;
constexpr size_t WS_EG = WS_F + 2 * PLANE;
constexpr size_t WS_EU = WS_EG + (size_t)32 * 256 * 1024 * 2;
constexpr size_t WS_ED = WS_EU + (size_t)32 * 256 * 1024 * 2;
static_assert(WS_ED + (size_t)32 * 1024 * 256 * 2 <= WS_F + 6 * PLANE, "expert alias");
static_assert(WS_WT_BR + (size_t)2048 * 1024 * 2 <= WS_VT + (size_t)2 * 16 * 64 * SEQ * 2, "merge alias");
static_assert((size_t)4864 * 1024 * 2 <= 6 * PLANE, "w_in alias");
constexpr size_t WS_HID = WS_PROJ;
constexpr size_t WS_Y = WS_PROJ + (size_t)2 * NT * 256 * 2;
static_assert(WS_Y + (size_t)2 * NT * 1024 * 2 <= WS_F, "alias");
constexpr int CW_BAR = 0;
constexpr int CW_CNT = 4096;
constexpr int CW_CUR = 4096 + 64;
constexpr int CW_Q = 4096 + 128;

#define XB_TMO      128
#define XB_XCNT(j)  (256  + 64 * (j))
#define XB_XSUB(j)  (1280 + 64 * (j))
#define XB_XGEN(j)  (2304 + 64 * (j))
#define XB_TOP      3328
#define XB_TOPGEN   3392
#define XCD_BAR_WORDS 3456
#define XB_SPIN_CAP (1u << 18)
#define LAS __attribute__((address_space(3)))

__device__ __forceinline__ unsigned xb_ld(unsigned* p)              { return __hip_atomic_load(p, __ATOMIC_RELAXED, __HIP_MEMORY_SCOPE_AGENT); }
__device__ __forceinline__ unsigned xb_add(unsigned* p, unsigned v) { return __hip_atomic_fetch_add(p, v, __ATOMIC_RELAXED, __HIP_MEMORY_SCOPE_AGENT); }
__device__ __forceinline__ unsigned xb_xcc_id() { return (unsigned)__builtin_amdgcn_s_getreg((3 << 11) | 20) & 0xFu; }
#define XB_SPIN(cond, bar) do { unsigned _sp = 0; while (cond) { __builtin_amdgcn_s_sleep(1); \
    if ((++_sp & 255u) == 0u) { if (xb_ld(&(bar)[XB_TMO])) break; if (_sp > XB_SPIN_CAP) { atomicAdd(&(bar)[XB_TMO], 1u); break; } } } } while (0)

struct XcdBarrier { unsigned* bar; unsigned x; volatile LAS unsigned* st; };

__device__ __forceinline__ XcdBarrier xcd_barrier_post(unsigned* bar, volatile LAS unsigned* st) {
    XcdBarrier b; b.bar = bar; b.x = xb_xcc_id(); b.st = st;
    if (threadIdx.x == 0) (void)xb_add(&bar[XB_XCNT(b.x)], 1u);
    return b;
}
__device__ __forceinline__ void xcd_barrier_complete(unsigned* bar, unsigned x, unsigned& nloc, unsigned& nx) {
    const unsigned G = gridDim.x * gridDim.y * gridDim.z;
    unsigned sum, cnt, mine, sp = 0u;
    for (;;) {
        sum = 0u; cnt = 0u; mine = 0u;
#pragma unroll
        for (unsigned j = 0; j < 16; ++j) { const unsigned c = xb_ld(&bar[XB_XCNT(j)]); sum += c; cnt += (c > 0u) ? 1u : 0u; mine = (j == x) ? c : mine; }
        if (sum == G) break;
        __builtin_amdgcn_s_sleep(1);
        if ((++sp & 255u) == 0u) { if (xb_ld(&bar[XB_TMO])) break; if (sp > XB_SPIN_CAP) { atomicAdd(&bar[XB_TMO], 1u); break; } }
    }
    nloc = mine > 0u ? mine : 1u; nx = cnt > 0u ? cnt : 1u;
}
__device__ __forceinline__ void xcd_barrier(const XcdBarrier& b) {
    asm volatile("s_waitcnt vmcnt(0)" ::: "memory");
    __syncthreads();
    if (threadIdx.x == 0) {
        unsigned* bar = b.bar;
        __builtin_amdgcn_s_waitcnt(0);
        unsigned nloc = b.st[0], nx = b.st[1];
        if (nloc == 0u) { xcd_barrier_complete(bar, b.x, nloc, nx); b.st[0] = nloc; b.st[1] = nx; }
        const unsigned old = xb_add(&bar[XB_XSUB(b.x)], 1u);
        const unsigned gen = old / nloc;
        if (old + 1u == (gen + 1u) * nloc) {
            __builtin_amdgcn_fence(__ATOMIC_RELEASE, "agent");
            asm volatile("s_waitcnt vmcnt(0)" ::: "memory");
            const unsigned og = xb_add(&bar[XB_TOP], 1u);
            const unsigned tg = og / nx;
            if (og + 1u == (tg + 1u) * nx) xb_add(&bar[XB_TOPGEN], 1u);
            else XB_SPIN(xb_ld(&bar[XB_TOPGEN]) == tg, bar);
            __builtin_amdgcn_fence(__ATOMIC_ACQUIRE, "agent");
            xb_add(&bar[XB_XGEN(b.x)], 1u);
            asm volatile("s_waitcnt vmcnt(0)" ::: "memory");
        } else {
            XB_SPIN(xb_ld(&bar[XB_XGEN(b.x)]) == gen, bar);
            __builtin_amdgcn_fence(__ATOMIC_ACQUIRE, "agent");
            asm volatile("s_waitcnt vmcnt(0)" ::: "memory");
        }
    }
    __syncthreads();
}

DI bf16_t f2bf(float x) { unsigned u = __float_as_uint(x); u += 0x7fffu + ((u >> 16) & 1u); return (bf16_t)(u >> 16); }
DI float bf2f(bf16_t b) { return __uint_as_float((unsigned)b << 16); }
typedef __bf16 bf16v2_t __attribute__((ext_vector_type(2)));
typedef float f32v2_t __attribute__((ext_vector_type(2)));
DI unsigned pack2(float lo, float hi) { const f32v2_t v = {lo, hi}; const bf16v2_t b = __builtin_convertvector(v, bf16v2_t); return __builtin_bit_cast(unsigned, b); }
DI float bflo(unsigned w) { return __uint_as_float(w << 16); }
DI float bfhi(unsigned w) { return __uint_as_float(w & 0xffff0000u); }
DI float wave_sum(float v) {
#pragma unroll
    for (int o = 32; o >= 1; o >>= 1) v += __shfl_xor(v, o);
    return v;
}
DI float wave_max(float v) {
#pragma unroll
    for (int o = 32; o >= 1; o >>= 1) v = fmaxf(v, __shfl_xor(v, o));
    return v;
}
DI float sigmoidf_(float x) { return __builtin_amdgcn_rcpf(1.0f + __expf(-x)); }
DI int TID() { int t = threadIdx.x; asm volatile("" : "+v"(t)); return t; }
#define LDS_WAVE_SYNC() asm volatile("s_waitcnt lgkmcnt(0)" ::: "memory")

#define DPP_MOV(v, ctrl) __builtin_bit_cast(float, __builtin_amdgcn_update_dpp(0, __builtin_bit_cast(int, (v)), (ctrl), 0xF, 0xF, true))
DI float wave_sum_dpp(float v) {
    v += DPP_MOV(v, 0xB1); v += DPP_MOV(v, 0x4E); v += DPP_MOV(v, 0x141); v += DPP_MOV(v, 0x140);
    return __builtin_bit_cast(float, __builtin_amdgcn_readlane(__builtin_bit_cast(int, v), 0)) + __builtin_bit_cast(float, __builtin_amdgcn_readlane(__builtin_bit_cast(int, v), 16)) +
        (__builtin_bit_cast(float, __builtin_amdgcn_readlane(__builtin_bit_cast(int, v), 32)) + __builtin_bit_cast(float, __builtin_amdgcn_readlane(__builtin_bit_cast(int, v), 48)));
}
struct Params { const float* in[N_IN]; float* out; unsigned char* ws; int ph_lo, ph_hi; };

DI int t5_bucket(int n) {
    if (n < 16) return n;
    if (n >= 128) return 31;
    int b = 16;
    b += (n >= 19) + (n >= 21) + (n >= 24) + (n >= 27) + (n >= 31) + (n >= 35) + (n >= 40) + (n >= 46) + (n >= 52) + (n >= 59) + (n >= 67) + (n >= 77) + (n >= 87) + (n >= 99) + (n >= 113);
    return b;
}

constexpr int G_A = 0, G_B = 256 * 64 * 2, G_STAGE = (256 + 128) * 64 * 2;
static_assert(2 * G_STAGE <= LDS_BYTES - 64, "gemm lds");
DI int g_off(int r, int c) { return ((r >> 4) * 2 + (c >> 5)) * 1024 + ((((r & 15) * 64) + (c & 31) * 2) ^ ((((r & 15) >> 3) & 1) << 5)); }
struct ARows { const bf16_t* p[4]; };
template <int AMODE>
DI void g_load(u32x4 (&ra)[4], u32x4 (&rb)[2], const ARows& ar, const bf16_t* bt, int ldb, int k0, int tid) {
    const int kseg = (tid & 7) * 8;
#pragma unroll
    for (int i = 0; i < 4; ++i) {
        ra[i] = (u32x4){0u, 0u, 0u, 0u};
        if (ar.p[i] != nullptr) ra[i] = *(const u32x4*)((AMODE == 0) ? (ar.p[i] + k0 + kseg) : (ar.p[i] + (size_t)(k0 >> 6) * IN_COLS + kseg));
    }
#pragma unroll
    for (int i = 0; i < 2; ++i) rb[i] = *(const u32x4*)(bt + (size_t)((tid >> 3) + 64 * i) * ldb + k0 + kseg);
}
DI void g_store(unsigned char* st, const u32x4 (&ra)[4], const u32x4 (&rb)[2], int tid) {
    const int off = g_off(tid >> 3, (tid & 7) * 8);
#pragma unroll
    for (int i = 0; i < 4; ++i) *(u32x4*)(st + G_A + off + i * 8192) = ra[i];
#pragma unroll
    for (int i = 0; i < 2; ++i) *(u32x4*)(st + G_B + off + i * 8192) = rb[i];
}
DI void g_compute(f32x4 (&acc)[4][4], const unsigned char* st, int lane, int wm, int wn) {
    const int lo = ((lane & 15) * 64 + (lane >> 4) * 16) ^ ((((lane & 15) >> 3) & 1) << 5);
    const unsigned char* sA = st + G_A + wm * 8192 + lo;
    const unsigned char* sB = st + G_B + wn * 8192 + lo;
    bf16x8 bcur[4], bnxt[4], a0, a1, a2;
#pragma unroll
    for (int i = 0; i < 4; ++i) bcur[i] = *(const bf16x8*)(sB + i * 2048);
    a0 = *(const bf16x8*)(sA);
    a1 = *(const bf16x8*)(sA + 2048);
#define G_AFRAG(s) (*(const bf16x8*)(sA + ((s) & 3) * 2048 + ((s) >> 2) * 1024))
#define G_GROUP(s, acur, anew) do { \
        if ((s) + 2 < 8) anew = G_AFRAG((s) + 2); \
        if ((s) < 4) bnxt[(s) & 3] = *(const bf16x8*)(sB + ((s) & 3) * 2048 + 1024); \
        __builtin_amdgcn_sched_barrier(0); \
        _Pragma("unroll") for (int ni = 0; ni < 4; ++ni) acc[(s) & 3][ni] = __builtin_amdgcn_mfma_f32_16x16x32_bf16(((s) < 4 ? bcur[ni] : bnxt[ni]), acur, acc[(s) & 3][ni], 0, 0, 0); \
        __builtin_amdgcn_sched_barrier(0); } while (0)
    G_GROUP(0, a0, a2); G_GROUP(1, a1, a0); G_GROUP(2, a2, a1); G_GROUP(3, a0, a2);
    G_GROUP(4, a1, a0); G_GROUP(5, a2, a1); G_GROUP(6, a0, a2); G_GROUP(7, a1, a0);
#undef G_GROUP
#undef G_AFRAG
}
#define LDS_BARRIER() do { asm volatile("s_waitcnt lgkmcnt(0)" ::: "memory"); __builtin_amdgcn_s_barrier(); asm volatile("" ::: "memory"); } while (0)
template <int AMODE>
DI void gemm_core(f32x4 (&acc)[4][4], const ARows& ar, const bf16_t* bt  , int ldb, int K, unsigned char* lds) {
    const int tid = TID(), lane = tid & 63, wave = tid >> 6, wm = wave >> 1, wn = wave & 1;
    const int nk = K >> 6;
    unsigned char* s0 = lds; unsigned char* s1 = lds + G_STAGE;
    u32x4 ra0[4], rb0[2], ra1[4], rb1[2];
    g_load<AMODE>(ra0, rb0, ar, bt, ldb, 0, tid);
    g_load<AMODE>(ra1, rb1, ar, bt, ldb, 64, tid);
    __syncthreads();
    g_store(s0, ra0, rb0, tid);
    g_load<AMODE>(ra0, rb0, ar, bt, ldb, (nk > 2 ? 2 : nk - 1) * 64, tid);
    LDS_BARRIER();
    for (int kt = 0; kt < nk; kt += 2) {
        g_store(s1, ra1, rb1, tid);
        { const int kn = (kt + 3 < nk) ? kt + 3 : nk - 1; g_load<AMODE>(ra1, rb1, ar, bt, ldb, kn * 64, tid); }
        g_compute(acc, s0, lane, wm, wn);
        LDS_BARRIER();
        g_store(s0, ra0, rb0, tid);
        { const int kn = (kt + 4 < nk) ? kt + 4 : nk - 1; g_load<AMODE>(ra0, rb0, ar, bt, ldb, kn * 64, tid); }
        g_compute(acc, s1, lane, wm, wn);
        LDS_BARRIER();
    }
}
DI void acc_zero(f32x4 (&acc)[4][4]) {
#pragma unroll
    for (int i = 0; i < 4; ++i)
#pragma unroll
        for (int j = 0; j < 4; ++j) acc[i][j] = (f32x4){0.f, 0.f, 0.f, 0.f};
}
#define ACC_FOREACH(acc, body) do { const int _l = TID() & 63, _w = TID() >> 6; \
    _Pragma("unroll") for (int _mi = 0; _mi < 4; ++_mi) _Pragma("unroll") for (int _ni = 0; _ni < 4; ++_ni) { \
        const int r_ = (_w >> 1) * 64 + _mi * 16 + (_l & 15), c_ = (_w & 1) * 64 + _ni * 16 + (_l >> 4) * 4; f32x4& v_ = acc[_mi][_ni]; body } } while (0)
DI ARows plain_rows(const bf16_t* base, size_t ld, int m0, int tid) { ARows a;
#pragma unroll
    for (int i = 0; i < 4; ++i) a.p[i] = base + (size_t)(m0 + (tid >> 3) + 64 * i) * ld;
    return a; }

DI void store_bf4(bf16_t* p, f32x4 v) { u32x2 w; w.x = pack2(v[0], v[1]); w.y = pack2(v[2], v[3]); *(u32x2*)p = w; }

DI void convert_tile4(const float* src, int ld, int N, int K, bf16_t* dst, int tile0, unsigned char* lds) {
    const int tid = TID();
    const int nkt = K >> 6;
    const int r = tid >> 3, seg = (tid & 7) * 8;
    f32x4 a[4], b[4];
#pragma unroll
    for (int u = 0; u < 4; ++u) {
        const int tile = tile0 + u, k0 = (tile % nkt) * 64, n0 = (tile / nkt) * 64;
        a[u] = (f32x4){0.f, 0.f, 0.f, 0.f}; b[u] = a[u];
        if (n0 + seg < N) { const float* q = src + (size_t)(k0 + r) * ld + n0 + seg; a[u] = *(const f32x4*)q; b[u] = *(const f32x4*)(q + 4); }
    }
    __syncthreads();
#pragma unroll
    for (int u = 0; u < 4; ++u) { bf16_t* T = (bf16_t*)lds + u * 64 * 72;
        u32x4 w; w.x = pack2(a[u][0], a[u][1]); w.y = pack2(a[u][2], a[u][3]); w.z = pack2(b[u][0], b[u][1]); w.w = pack2(b[u][2], b[u][3]); *(u32x4*)(T + r * 72 + seg) = w; }
    __syncthreads();
#pragma unroll
    for (int u = 0; u < 4; ++u) { const bf16_t* T = (const bf16_t*)lds + u * 64 * 72;
        const int tile = tile0 + u, k0 = (tile % nkt) * 64, n0 = (tile / nkt) * 64;
        u32x4 o;
        o.x = (unsigned)T[(seg + 0) * 72 + r] | ((unsigned)T[(seg + 1) * 72 + r] << 16); o.y = (unsigned)T[(seg + 2) * 72 + r] | ((unsigned)T[(seg + 3) * 72 + r] << 16);
        o.z = (unsigned)T[(seg + 4) * 72 + r] | ((unsigned)T[(seg + 5) * 72 + r] << 16); o.w = (unsigned)T[(seg + 6) * 72 + r] | ((unsigned)T[(seg + 7) * 72 + r] << 16);
        *(u32x4*)(dst + (size_t)(n0 + r) * K + k0 + seg) = o; }
}
struct Ctx {
    const Params* P; unsigned char* ws; float* out; int l;
    bf16_t* H; bf16_t* PROJ; bf16_t* F; bf16_t* POOLED; bf16_t* MERGED; bf16_t* CMPH; float* CMPO; float* POSB; int* ROUTE; int* ENT; bf16_t* HID; bf16_t* Y; bf16_t* VT; bf16_t* KC; bf16_t* VCT; bf16_t* YRAW; float* BON; unsigned* ctl;
    DI const float* in(int i) const { return P->in[i]; }
};

DI void add_moe_rows(const Ctx& c, int row, int lane, f32x4 (&v)[4]) {
    const int* rt = c.ROUTE + (size_t)row * 8;
    const int p0 = rt[4], p1 = rt[5];
    const bf16_t* y0 = c.Y + (size_t)p0 * DM; const bf16_t* y1 = c.Y + (size_t)p1 * DM;
#pragma unroll
    for (int i = 0; i < 4; ++i) {
        const u32x2 a = *(const u32x2*)(y0 + i * 256 + lane * 4), b = *(const u32x2*)(y1 + i * 256 + lane * 4);
        v[i][0] += bflo(a.x) + bflo(b.x); v[i][1] += bfhi(a.x) + bfhi(b.x); v[i][2] += bflo(a.y) + bflo(b.y); v[i][3] += bfhi(a.y) + bfhi(b.y);
    }
}
DI void phase_norm1(const Ctx& c, unsigned char* lds) {
    const int tid = TID(), lane = tid & 63, wave = tid >> 6;
    const float* gain = c.in(I_NMIX) + c.l * DM;
    const float* src = (c.l == 0) ? c.in(I_X) : c.out;
    for (int row = blockIdx.x * 8 + wave; row < NT; row += gridDim.x * 8) {
        f32x4 v[4];
#pragma unroll
        for (int i = 0; i < 4; ++i) v[i] = *(const f32x4*)(src + (size_t)row * DM + i * 256 + lane * 4);
        if (c.l > 0) {
            add_moe_rows(c, row, lane, v);
#pragma unroll
            for (int i = 0; i < 4; ++i) *(f32x4*)(c.out + (size_t)row * DM + i * 256 + lane * 4) = v[i];
        }
        float ss = 0.f;
#pragma unroll
        for (int i = 0; i < 4; ++i) ss += v[i][0] * v[i][0] + v[i][1] * v[i][1] + v[i][2] * v[i][2] + v[i][3] * v[i][3];
        ss = wave_sum_dpp(ss);
        const float rs = rsqrtf(ss * (1.0f / DM) + 1e-6f);
#pragma unroll
        for (int i = 0; i < 4; ++i) {
            const f32x4 g = *(const f32x4*)(gain + i * 256 + lane * 4);
            store_bf4(c.H + (size_t)row * DM + i * 256 + lane * 4, (f32x4){v[i][0] * rs * g[0], v[i][1] * rs * g[1], v[i][2] * rs * g[2], v[i][3] * rs * g[3]});
        }
    }
    for (int idx = blockIdx.x * 8 + wave; idx < 512; idx += gridDim.x * 8) {
        const int kv = idx >> 8, n = idx & 255;
        const float* pos = c.in(kv ? I_CPV : I_CPK) + (size_t)c.l * 2048;
        const float* w1 = c.in(kv ? I_CW1V : I_CW1K) + (size_t)c.l * 2048 * 256;
        float s = 0.f;
        for (int k = lane; k < 2048; k += 64) s += pos[k] * w1[(size_t)k * 256 + n];
        s = wave_sum_dpp(s);
        if (lane == 0) c.POSB[kv * 256 + n] = s;
    }
    for (int it = blockIdx.x * 4; it < 1216 + 256 + 16 + 16; it += gridDim.x * 4) {
        if (it < 1216) convert_tile4(c.in(I_WIN) + (size_t)c.l * DM * IN_COLS, IN_COLS, IN_COLS, DM, (bf16_t*)(c.ws + WS_WT_IN), it, lds);
        else if (it < 1216 + 256) { const int j = it - 1216, kv = j >> 7; convert_tile4(c.in(kv ? I_CW1V : I_CW1K) + (size_t)c.l * 2048 * 256, 256, 256, 2048, (bf16_t*)(c.ws + WS_WT_C1) + (size_t)kv * 256 * 2048, j & 127, lds); }
        else if (it < 1216 + 256 + 16) { const int j = it - 1472, kv = j >> 3; convert_tile4(c.in(kv ? I_CW2V : I_CW2K) + (size_t)c.l * 256 * 64, 64, 64, 256, (bf16_t*)(c.ws + WS_WT_C2) + (size_t)kv * 128 * 256, j & 7, lds); }
        else { const int j = it - 1488, gi = j >> 2; convert_tile4(c.in(I_POOLW) + ((size_t)c.l * 4 + gi) * 128 * 128, 128, 128, 128, (bf16_t*)(c.ws + WS_WT_POOL) + (size_t)gi * 128 * 128, 0, lds); }
    }
}

constexpr int EPS = 136;
DI void tile_store_bf16(f32x4 (&acc)[4][4], bf16_t* out, size_t ld, int nrows, int ncols, unsigned char* lds) {
    bf16_t* T = (bf16_t*)lds;
    const int tid = TID();
    __syncthreads();
    ACC_FOREACH(acc, { store_bf4(T + r_ * EPS + c_, v_); });
    __syncthreads();
#pragma unroll
    for (int i = 0; i < 8; ++i) {
        const int ch = tid + i * NTHREADS, r = ch >> 4, cc = (ch & 15) * 8;
        if (r < nrows && cc < ncols) *(u32x4*)(out + (size_t)r * ld + cc) = *(const u32x4*)(T + r * EPS + cc);
    }
}
DI bool xcd_unit(int it, int nN, int& tm, int& tn) {
    const int G = gridDim.x;
    if ((G & 7) != 0 || G < 8) { const int u = it * G + blockIdx.x; if (u >= 64 * nN) return false; tm = u % 64; tn = u / 64; return true; }
    const int x = blockIdx.x & 7, i = blockIdx.x >> 3, per = G >> 3;
    const int u = it * per + i;
    if (u >= 8 * nN) return false;
    tm = x * 8 + (u & 7); tn = u >> 3; return true;
}
DI void phase_gemm1(const Ctx& c, unsigned char* lds) {
    const int nM = NT / 256, nN = (IN_COLS + 127) / 128;
    const bf16_t* WT = (const bf16_t*)(c.ws + WS_WT_IN);
    for (int it = 0;; ++it) {
        int tm, tn; if (!xcd_unit(it, nN, tm, tn)) break;
        const int m0 = tm * 256, n0 = tn * 128;
        f32x4 acc[4][4]; acc_zero(acc);
        const ARows ar = plain_rows(c.H, DM, m0, TID());
        gemm_core<0>(acc, ar, WT + (size_t)n0 * DM, DM, DM, lds);
        tile_store_bf16(acc, c.PROJ + (size_t)m0 * IN_COLS + n0, IN_COLS, 256, (IN_COLS - n0 < 128) ? IN_COLS - n0 : 128, lds);
    }
}

DI float gelu_tanh(float x) { const float u = 0.7978845608028654f * (x + 0.044715f * x * x * x); const float e = __expf(2.0f * u); return x * (1.0f - __builtin_amdgcn_rcpf(e + 1.0f)); }
DI float softplusf_(float x) { return (x > 20.f) ? x : __logf(1.0f + __expf(x)); }
DI float tanhf_(float x) { const float e = __expf(2.0f * x); return 1.0f - 2.0f * __builtin_amdgcn_rcpf(e + 1.0f); }
constexpr int TKP = 8;
template <int WIN>
DI void pool_emit(const Ctx& c, const float (&pv)[TKP + 15], int t0, int s0, int ch) {
#pragma unroll
    for (int k = 0; k < TKP; ++k) {
        float sum = 0.f;
#pragma unroll
        for (int j = 0; j < WIN; ++j) sum += pv[15 + k - j];
        const int s = s0 + k, cnt = (s + 1 < WIN) ? s + 1 : WIN;
        c.POOLED[(size_t)(t0 + k) * 512 + ch] = f2bf(sum / (float)cnt - pv[15 + k]);
    }
}
DI void phase_prep(const Ctx& c, unsigned char* lds) {
    const int n_cmp_items = 2 * 16 * 2;
    for (int item = (int)gridDim.x - 1 - (int)blockIdx.x; item < n_cmp_items; item += gridDim.x) {
        const int tid = TID();
        const int kv = item >> 5, bgi = (item >> 1) & 15, tn = item & 1, m0 = bgi * 256, n0 = tn * 128;
        ARows ar;
#pragma unroll
        for (int i = 0; i < 4; ++i) { const int cb = (tid >> 3) + 64 * i;
            ar.p[i] = (cb < NCMP) ? c.PROJ + ((size_t)(bgi >> 2) * SEQ + 16 * cb) * IN_COLS + (kv ? C_VC : C_KC) + (bgi & 3) * 64 : nullptr; }
        f32x4 acc[4][4]; acc_zero(acc);
        gemm_core<1>(acc, ar, (const bf16_t*)(c.ws + WS_WT_C1) + ((size_t)kv * 256 + n0) * 2048, 2048, 2048, lds);
        const float* pb = c.POSB + kv * 256;
        ACC_FOREACH(acc, {
            const f32x4 bb = *(const f32x4*)(pb + n0 + c_);
            store_bf4(c.CMPH + ((size_t)kv * 4096 + m0 + r_) * 256 + n0 + c_, (f32x4){gelu_tanh(v_[0] + bb[0]), gelu_tanh(v_[1] + bb[1]), gelu_tanh(v_[2] + bb[2]), gelu_tanh(v_[3] + bb[3])}); });
    }
    const int tid = TID();
    const int n_prep = n_cmp_items + NT / TKP;
    const int n_items = n_prep + 2048;
    for (int item = n_cmp_items + blockIdx.x; item < n_items; item += gridDim.x) {
        if (item >= n_prep) {
            const int idx = item - n_prep, kind = idx >> 10, bgi = (idx >> 6) & 15, s0 = (idx & 63) * 64;
            bf16_t* T = (bf16_t*)lds;
            const int r = tid >> 3, seg = (tid & 7) * 8;
            const u32x4 w = *(const u32x4*)(c.PROJ + ((size_t)(bgi >> 2) * SEQ + s0 + r) * IN_COLS + (kind ? C_VW : C_VS) + (bgi & 3) * 64 + seg);
            __syncthreads();
            *(u32x4*)(T + r * 72 + seg) = w;
            __syncthreads();
            u32x4 o;
            o.x = (unsigned)T[(seg + 0) * 72 + r] | ((unsigned)T[(seg + 1) * 72 + r] << 16); o.y = (unsigned)T[(seg + 2) * 72 + r] | ((unsigned)T[(seg + 3) * 72 + r] << 16);
            o.z = (unsigned)T[(seg + 4) * 72 + r] | ((unsigned)T[(seg + 5) * 72 + r] << 16); o.w = (unsigned)T[(seg + 6) * 72 + r] | ((unsigned)T[(seg + 7) * 72 + r] << 16);
            *(u32x4*)(c.VT + (((size_t)kind * 16 + bgi) * 64 + r) * SEQ + s0 + seg) = o;
        } else {
            const int t0 = (item - n_cmp_items) * TKP;
            float* sl = (float*)lds;
            const float* mu = c.in(I_MU) + (size_t)c.l * RWC;
            __syncthreads();
            for (int idx = tid; idx < TKP * 160; idx += NTHREADS) {
                const int tk = idx / 160, i = idx % 160, t = t0 + tk, col = C_WD + i;
                const float u = bf2f(c.PROJ[(size_t)t * IN_COLS + col]);
                const float up = ((t & (SEQ - 1)) != 0) ? bf2f(c.PROJ[(size_t)(t - 1) * IN_COLS + col]) : 0.f;
                const float us = u + (up - u) * mu[col - C_RW];
                sl[idx] = (i < 32) ? tanhf_(us) : ((i < 64) ? us : sigmoidf_(us));
            }
            __syncthreads();
            const int ch = tid;
            float z[TKP], aa[TKP], gg[TKP];
#pragma unroll
            for (int k = 0; k < TKP; ++k) { z[k] = 0.f; aa[k] = 0.f; gg[k] = 0.f; }
            const float* wup = c.in(I_WUP) + (size_t)c.l * 32 * 512 + ch;
            const float* aup = c.in(I_AUP) + (size_t)c.l * 32 * 512 + ch;
            const float* gup = c.in(I_GUP) + (size_t)c.l * 96 * 512 + ch;
#pragma unroll 1
            for (int i0 = 0; i0 < 32; i0 += 4) {
                float wv[4], av[4];
#pragma unroll
                for (int u = 0; u < 4; ++u) { wv[u] = wup[(i0 + u) * 512]; av[u] = aup[(i0 + u) * 512]; }
#pragma unroll
                for (int u = 0; u < 4; ++u)
#pragma unroll
                    for (int k = 0; k < TKP; ++k) { z[k] += sl[k * 160 + i0 + u] * wv[u]; aa[k] += sl[k * 160 + 32 + i0 + u] * av[u]; }
            }
#pragma unroll 1
            for (int i0 = 0; i0 < 96; i0 += 8) {
                float wv[8];
#pragma unroll
                for (int u = 0; u < 8; ++u) wv[u] = gup[(i0 + u) * 512];
#pragma unroll
                for (int u = 0; u < 8; ++u)
#pragma unroll
                    for (int k = 0; k < TKP; ++k) gg[k] += sl[k * 160 + 64 + i0 + u] * wv[u];
            }
            const float w0 = c.in(I_W0)[c.l * 512 + ch], a0 = c.in(I_A0)[c.l * 512 + ch];
            const float kkw_ = c.in(I_KK)[c.l * 512 + ch], kaw_ = c.in(I_KA)[c.l * 512 + ch], rkw_ = c.in(I_RK)[c.l * 512 + ch];
            const float mur = mu[ch], muk = mu[512 + ch], muv = mu[1024 + ch];
            float pr = 0.f, pk = 0.f, pv = 0.f;
            if ((t0 & (SEQ - 1)) != 0) { const bf16_t* q = c.PROJ + (size_t)(t0 - 1) * IN_COLS; pr = bf2f(q[C_R + ch]); pk = bf2f(q[C_K + ch]); pv = bf2f(q[C_V + ch]); }
#pragma unroll
            for (int k = 0; k < TKP; ++k) {
                const int t = t0 + k; const bf16_t* q = c.PROJ + (size_t)t * IN_COLS;
                const float ur = bf2f(q[C_R + ch]), uk = bf2f(q[C_K + ch]), uv = bf2f(q[C_V + ch]);
                const float r = ur + (pr - ur) * mur, kx = uk + (pk - uk) * muk, vx = uv + (pv - uv) * muv;
                pr = ur; pk = uk; pv = uv;
                if ((k & 3) == 3) { asm volatile("" ::: "memory"); __builtin_amdgcn_sched_barrier(0); }
                const float wlog = -softplusf_(-(w0 + z[k])) - 0.5f;
                const float e = __expf(wlog);
                const float a = sigmoidf_(a0 + aa[k]);
                const size_t o = (size_t)t * 512 + ch;
                {
                    const float kxn = kx * kkw_, kp = kx * (1.0f + (a - 1.0f) * kaw_);
                    const float ss = wave_sum_dpp(kxn * kxn);
                    const float inv = __builtin_amdgcn_rsqf(fmaxf(ss, 1e-24f));
                    const float br = wave_sum_dpp(kxn * inv * a * r), kr = wave_sum_dpp(kp * r), bon = wave_sum_dpp(r * kp * rkw_);
                    if ((tid & 63) == 0) *(f32x4*)(c.BON + ((size_t)t * 8 + (tid >> 6)) * 4) = (f32x4){inv, br, kr, bon};
                }
                c.F[o] = f2bf(r); c.F[o + (size_t)NT * 512] = f2bf(kx); c.F[o + (size_t)2 * NT * 512] = f2bf(vx);
                c.F[o + (size_t)3 * NT * 512] = f2bf(e); c.F[o + (size_t)4 * NT * 512] = f2bf(a); c.F[o + (size_t)5 * NT * 512] = f2bf(gg[k]);
            }
            asm volatile("" ::: "memory"); __builtin_amdgcn_sched_barrier(0);
            {
                const int gi = ch >> 7;
                const int s0 = t0 & (SEQ - 1);
                float pv[TKP + 15];
#pragma unroll
                for (int i = 0; i < TKP + 15; ++i) pv[i] = (s0 - 15 + i >= 0) ? bf2f(c.PROJ[(size_t)(t0 - 15 + i) * IN_COLS + C_POOL + ch]) : 0.f;
                if (gi == 0) pool_emit<2>(c, pv, t0, s0, ch);
                else if (gi == 1) pool_emit<4>(c, pv, t0, s0, ch);
                else if (gi == 2) pool_emit<8>(c, pv, t0, s0, ch);
                else pool_emit<16>(c, pv, t0, s0, ch);
            }
        }
    }
}

DI void phase_poolgemm(const Ctx& c, unsigned char* lds) {
    const int n_pool = (NT / 256) * 4, n_items = n_pool + 32;
    for (int item = blockIdx.x; item < n_items; item += gridDim.x) {
        f32x4 acc[4][4]; acc_zero(acc);
        if (item < n_pool) {
            const int tm = item >> 2, gi = item & 3, m0 = tm * 256;
            const ARows ar = plain_rows(c.POOLED + gi * 128, 512, m0, TID());
            gemm_core<0>(acc, ar, (const bf16_t*)(c.ws + WS_WT_POOL) + (size_t)gi * 128 * 128, 128, 128, lds);
            const float* sc = c.in(I_POOLS) + c.l * 512 + gi * 128;
            ACC_FOREACH(acc, { const f32x4 s = *(const f32x4*)(sc + c_);
                store_bf4(c.POOLED + (size_t)(m0 + r_) * 512 + gi * 128 + c_, (f32x4){v_[0] * s[0], v_[1] * s[1], v_[2] * s[2], v_[3] * s[3]}); });
        } else {
            const int it = item - n_pool, kv = it >> 4, tm = it & 15, m0 = tm * 256;
            const ARows ar = plain_rows(c.CMPH + (size_t)kv * 4096 * 256, 256, m0, TID());
            gemm_core<0>(acc, ar, (const bf16_t*)(c.ws + WS_WT_C2) + (size_t)kv * 128 * 256, 256, 256, lds);
            ACC_FOREACH(acc, { if (c_ < 64) { const int R = m0 + r_;
                if (kv == 0) store_bf4(c.KC + (size_t)R * 64 + c_, v_);
                else { bf16_t* q = c.VCT + ((size_t)(R >> 8) * 64 + c_) * 256 + (R & 255); q[0] = f2bf(v_[0]); q[256] = f2bf(v_[1]); q[512] = f2bf(v_[2]); q[768] = f2bf(v_[3]); } } });
        }
    }
}

constexpr int SCH = 32;
constexpr int SB_AN = 0, SB_WR = SCH * 64 * 4, SB_W = 2 * SCH * 64 * 4, SB_BB = 3 * SCH * 64 * 4, SB_KP = 4 * SCH * 64 * 4;
constexpr int SB_V = 5 * SCH * 64 * 4;
constexpr int SB_SC = SB_V + SCH * 16 * 4;
constexpr int SB_Y = SB_SC + SCH * 2 * 4;
constexpr int SB_BYTES = SB_Y + SCH * 16 * 4;
static_assert(2 * SB_BYTES <= LDS_BYTES - 64, "scan lds");
typedef float f32x2 __attribute__((ext_vector_type(2)));
DI float row8_sum(float v) { v += DPP_MOV(v, 0xB1); v += DPP_MOV(v, 0x4E); v += DPP_MOV(v, 0x141); return v; }

constexpr int NPW = 6, NJ = (SCH + NPW - 1) / NPW;
struct PrepRegs { bf16_t r[NJ], k[NJ], v[NJ], e[NJ], a[NJ]; float s0[NJ], s1[NJ], s2[NJ]; };
DI void prep_load(PrepRegs& R, const Ctx& c, int b, int h, int ck, int pw, int lane) {
    const size_t PL = (size_t)NT * 512;
    const size_t tb = (size_t)b * SEQ + ck * SCH;
    const size_t o0 = tb * 512 + h * 64 + lane;
#pragma unroll
    for (int j = 0; j < NJ; ++j) {
        const int st = pw + NPW * j;
        if (st < SCH) { const size_t o = o0 + (size_t)st * 512; R.r[j] = c.F[o]; R.k[j] = c.F[o + PL]; R.v[j] = c.F[o + 2 * PL]; R.e[j] = c.F[o + 3 * PL]; R.a[j] = c.F[o + 4 * PL];
            const float* sp = c.BON + ((tb + st) * 8 + h) * 4; R.s0[j] = sp[0]; R.s1[j] = sp[1]; R.s2[j] = sp[2]; }
    }
}
DI void prep_store(const PrepRegs& R, unsigned char* sb, int rq, int pw, int lane, float kkw, float kaw) {
    float* an = (float*)(sb + SB_AN); float* wr = (float*)(sb + SB_WR); float* w_ = (float*)(sb + SB_W); float* bb_ = (float*)(sb + SB_BB); float* kp_ = (float*)(sb + SB_KP);
    float* vv = (float*)(sb + SB_V); float* sc = (float*)(sb + SB_SC);
#pragma unroll
    for (int j = 0; j < NJ; ++j) {
        const int st = pw + NPW * j;
        if (st < SCH) {
            const float r = bf2f(R.r[j]), k = bf2f(R.k[j]), v = bf2f(R.v[j]), e = bf2f(R.e[j]), a = bf2f(R.a[j]);
            const float w = __expf(-e);
            const float kk = k * kkw * R.s0[j];
            const float kp = k * (1.0f + (a - 1.0f) * kaw);
            an[st * 64 + lane] = -kk; wr[st * 64 + lane] = w * r; w_[st * 64 + lane] = w; bb_[st * 64 + lane] = kk * a; kp_[st * 64 + lane] = kp;
            if ((lane >> 4) == rq) vv[st * 16 + (lane & 15)] = v;
            if (lane == 0) { sc[st * 2] = R.s1[j]; sc[st * 2 + 1] = R.s2[j]; }
        }
    }
}
DI void scan_item(const Ctx& c, int item, unsigned char* lds) {
    const int tid = TID(), lane = tid & 63, wave = tid >> 6;
    const int b = item >> 5, h = (item >> 2) & 7, rq = item & 3;
    const int chn = h * 64 + lane;
    const float kkw = c.in(I_KK)[c.l * 512 + chn], kaw = c.in(I_KA)[c.l * 512 + chn];
    const int rowl = (tid & 127) >> 3, cg = tid & 7;
    f32x2 st[4];
#pragma unroll
    for (int i = 0; i < 4; ++i) st[i] = (f32x2){0.f, 0.f};
    constexpr int NCK = SEQ / SCH;
    PrepRegs R;
    __syncthreads();
    if (wave >= 2) { prep_load(R, c, b, h, 0, wave - 2, lane); prep_store(R, lds, rq, wave - 2, lane, kkw, kaw); prep_load(R, c, b, h, 1, wave - 2, lane); }
    __syncthreads();
    for (int ck = 0; ck < NCK; ++ck) {
        unsigned char* sb = lds + (ck & 1) * SB_BYTES;
        if (wave < 2) {
            const float* an = (const float*)(sb + SB_AN) + cg * 8; const float* wr = (const float*)(sb + SB_WR) + cg * 8; const float* w_ = (const float*)(sb + SB_W) + cg * 8;
            const float* bb_ = (const float*)(sb + SB_BB) + cg * 8; const float* kp_ = (const float*)(sb + SB_KP) + cg * 8;
            const float* vv = (const float*)(sb + SB_V) + rowl; const float* sc = (const float*)(sb + SB_SC); float* yb = (float*)(sb + SB_Y) + rowl;
            f32x4 a0 = *(const f32x4*)(an), a1 = *(const f32x4*)(an + 4), r0 = *(const f32x4*)(wr), r1 = *(const f32x4*)(wr + 4);
            f32x4 w0 = *(const f32x4*)(w_), w1 = *(const f32x4*)(w_ + 4), b0 = *(const f32x4*)(bb_), b1 = *(const f32x4*)(bb_ + 4);
            f32x4 k0 = *(const f32x4*)(kp_), k1 = *(const f32x4*)(kp_ + 4);
            float v = vv[0]; f32x2 bk = *(const f32x2*)(sc);
#pragma unroll 2
            for (int s = 0; s < SCH; ++s) {
                const int sn = (s + 1 < SCH) ? s + 1 : s;
                const f32x4 na0 = *(const f32x4*)(an + sn * 64), na1 = *(const f32x4*)(an + sn * 64 + 4), nr0 = *(const f32x4*)(wr + sn * 64), nr1 = *(const f32x4*)(wr + sn * 64 + 4);
                const f32x4 nw0 = *(const f32x4*)(w_ + sn * 64), nw1 = *(const f32x4*)(w_ + sn * 64 + 4), nb0 = *(const f32x4*)(bb_ + sn * 64), nb1 = *(const f32x4*)(bb_ + sn * 64 + 4);
                const f32x4 nk0 = *(const f32x4*)(kp_ + sn * 64), nk1 = *(const f32x4*)(kp_ + sn * 64 + 4);
                const float nv = vv[sn * 16]; const f32x2 nbk = *(const f32x2*)(sc + sn * 2);
                f32x2 da = st[0] * (f32x2){a0[0], a0[1]}; f32x2 dr = st[0] * (f32x2){r0[0], r0[1]};
                da += st[1] * (f32x2){a0[2], a0[3]}; dr += st[1] * (f32x2){r0[2], r0[3]};
                da += st[2] * (f32x2){a1[0], a1[1]}; dr += st[2] * (f32x2){r1[0], r1[1]};
                da += st[3] * (f32x2){a1[2], a1[3]}; dr += st[3] * (f32x2){r1[2], r1[3]};
                float sa = da[0] + da[1], sr = dr[0] + dr[1];
                sa += DPP_MOV(sa, 0xB1); sr += DPP_MOV(sr, 0xB1);
                sa += DPP_MOV(sa, 0x4E); sr += DPP_MOV(sr, 0x4E);
                sa += DPP_MOV(sa, 0x141); sr += DPP_MOV(sr, 0x141);
                const f32x2 sa2 = (f32x2){sa, sa}, v2 = (f32x2){v, v};
                st[0] = st[0] * (f32x2){w0[0], w0[1]} + sa2 * (f32x2){b0[0], b0[1]} + v2 * (f32x2){k0[0], k0[1]};
                st[1] = st[1] * (f32x2){w0[2], w0[3]} + sa2 * (f32x2){b0[2], b0[3]} + v2 * (f32x2){k0[2], k0[3]};
                st[2] = st[2] * (f32x2){w1[0], w1[1]} + sa2 * (f32x2){b1[0], b1[1]} + v2 * (f32x2){k1[0], k1[1]};
                st[3] = st[3] * (f32x2){w1[2], w1[3]} + sa2 * (f32x2){b1[2], b1[3]} + v2 * (f32x2){k1[2], k1[3]};
                yb[s * 16] = sr + sa * bk[0] + v * bk[1];
                a0 = na0; a1 = na1; r0 = nr0; r1 = nr1; w0 = nw0; w1 = nw1; b0 = nb0; b1 = nb1; k0 = nk0; k1 = nk1; v = nv; bk = nbk;
            }
        } else {
            const int pt = tid - 128;
            if (ck + 1 < NCK) prep_store(R, lds + ((ck + 1) & 1) * SB_BYTES, rq, wave - 2, lane, kkw, kaw);
            if (ck + 2 < NCK) prep_load(R, c, b, h, ck + 2, wave - 2, lane);
            if (ck > 0) {
                const float* yb = (const float*)(lds + ((ck - 1) & 1) * SB_BYTES + SB_Y);
                for (int idx = pt; idx < SCH * 16; idx += 384) {
                    const int s = idx >> 4, j = idx & 15;
                    c.YRAW[((size_t)b * SEQ + (ck - 1) * SCH + s) * 512 + h * 64 + rq * 16 + j] = f2bf(yb[idx]);
                }
            }
        }
        asm volatile("s_waitcnt lgkmcnt(0)" ::: "memory"); __builtin_amdgcn_s_barrier(); asm volatile("" ::: "memory");
    }
    {
        const float* yb = (const float*)(lds + ((NCK - 1) & 1) * SB_BYTES + SB_Y);
        for (int idx = tid; idx < SCH * 16; idx += NTHREADS) {
            const int s = idx >> 4, j = idx & 15;
            c.YRAW[((size_t)b * SEQ + (NCK - 1) * SCH + s) * 512 + h * 64 + rq * 16 + j] = f2bf(yb[idx]);
        }
    }
    __syncthreads();
}
DI void phase_rwkv_post(const Ctx& c, unsigned char* lds) {
    const int tid = TID(), lane = tid & 63, wave = tid >> 6;
    const size_t PL = (size_t)NT * 512;
    for (int t = blockIdx.x * 8 + wave; t < NT; t += gridDim.x * 8) {
        bf16_t ry[8], rv[8], rg[8]; float bon[8], gw[8], gb[8];
#pragma unroll
        for (int h = 0; h < 8; ++h) { const size_t o = (size_t)t * 512 + h * 64 + lane; ry[h] = c.YRAW[o]; rv[h] = c.F[o + 2 * PL]; rg[h] = c.F[o + 5 * PL]; bon[h] = c.BON[((size_t)t * 8 + h) * 4 + 3];
            gw[h] = c.in(I_GNW)[c.l * 512 + h * 64 + lane]; gb[h] = c.in(I_GNB)[c.l * 512 + h * 64 + lane]; }
#pragma unroll
        for (int h = 0; h < 8; ++h) {
            const float y = bf2f(ry[h]);
            const float mean = wave_sum_dpp(y) * (1.0f / 64.0f);
            const float d = y - mean;
            const float var = wave_sum_dpp(d * d) * (1.0f / 64.0f);
            const float yn = d * rsqrtf(var + 64e-5f) * gw[h] + gb[h];
            c.F[(size_t)t * 512 + h * 64 + lane + 5 * PL] = f2bf((yn + bon[h] * bf2f(rv[h])) * bf2f(rg[h]));
        }
    }
    for (int it = blockIdx.x * 4; it < 768 + 128 + 128 + 256 + 256; it += gridDim.x * 4) {
        const float* WB = c.in(I_WBR) + (size_t)c.l * 2048 * DM; bf16_t* BR = (bf16_t*)(c.ws + WS_WT_BR);
        if (it < 768) convert_tile4(c.in(I_WMG) + (size_t)c.l * DM * 3 * DM, 3 * DM, 3 * DM, DM, (bf16_t*)(c.ws + WS_WT_MG), it, lds);
        else if (it < 896) convert_tile4(WB, DM, DM, 512, BR, it - 768, lds);
        else if (it < 1024) convert_tile4(WB + (size_t)512 * DM, DM, DM, 512, BR + (size_t)1024 * 512, it - 896, lds);
        else if (it < 1280) convert_tile4(WB + (size_t)1024 * DM, DM, DM, 1024, BR + (size_t)2048 * 512, it - 1024, lds);
        else convert_tile4(c.in(I_WOUT) + (size_t)c.l * DM * DM, DM, DM, DM, (bf16_t*)(c.ws + WS_WT_OUT), it - 1280, lds);
    }
}
constexpr int TS = 72;
constexpr int NSA_BIAS = 0;
constexpr int NSA_SELM = 2112;
constexpr int NSA_SCR = 2624;
constexpr int NSA_K0 = 4672;
constexpr int NSA_V0 = NSA_K0 + 2 * 64 * TS * 2;
constexpr int NSA_A = NSA_V0 + 2 * 64 * TS * 2;
constexpr int NSA_B = NSA_A + 16384;
constexpr int NSA_END = NSA_B + 16384;
static_assert(NSA_END <= LDS_BYTES - 16, "nsa lds");
static_assert(NSA_K0 % 16 == 0, "align");

struct NsaLane { int tq[2]; int h; float cbias; float m[2], l[2]; };

DI void nsa_prefetch(u32x4& rk, u32x4& rv, const bf16_t* kbase, int kstride, const bf16_t* vtbase, int vstride, int pos0, int tid) {
    const int r = tid >> 3, seg = (tid & 7) * 8;
    rk = *(const u32x4*)(kbase + (size_t)(pos0 + r) * kstride + seg);
    rv = *(const u32x4*)(vtbase + (size_t)r * vstride + pos0 + seg);
}
DI void nsa_store(unsigned char* lds, int buf, const u32x4& rk, const u32x4& rv, int tid) {
    const int r = tid >> 3, seg = (tid & 7) * 8;
    *(u32x4*)((bf16_t*)(lds + NSA_K0) + buf * 64 * TS + r * TS + seg) = rk;
    *(u32x4*)((bf16_t*)(lds + NSA_V0) + buf * 64 * TS + r * TS + seg) = rv;
}
template <int QM = 3>
DI void nsa_qk(f32x4 (&s)[2][4], const bf16_t* sK, const bf16x8 (&qf)[2][2], int lane) {
#pragma unroll
    for (int kt = 0; kt < 4; ++kt) {
#pragma unroll
        for (int ks = 0; ks < 2; ++ks) {
            const bf16x8 kf = *(const bf16x8*)(sK + (16 * kt + (lane & 15)) * TS + 32 * ks + (lane >> 4) * 8);
#pragma unroll
            for (int qi = 0; qi < 2; ++qi) if ((QM >> qi) & 1) s[qi][kt] = __builtin_amdgcn_mfma_f32_16x16x32_bf16(kf, qf[qi][ks], (ks == 0) ? (f32x4){0.f, 0.f, 0.f, 0.f} : s[qi][kt], 0, 0, 0);
        }
    }
}
template <int MODE>
DI void nsa_logits(float (&x)[4][4], const f32x4 (&s)[4], int tq, int h, float cbias, bool rowsel, int pos0, int qd, const float* biasT) {
#pragma unroll
    for (int kt = 0; kt < 4; ++kt)
#pragma unroll
        for (int i = 0; i < 4; ++i) {
            const int kk = pos0 + 16 * kt + 4 * qd + i;
            if (MODE == 1) { x[kt][i] = rowsel ? s[kt][i] + cbias : -INFINITY; }
            else {
                const int dist = (MODE == 0) ? (tq - 16 * kk - 31) : (tq - kk);
                bool ok = dist >= 0;
                if (MODE == 2) ok = ok && rowsel;
                if (MODE == 3) ok = ok && (dist < 512);
                const int di = dist < 0 ? 0 : (dist > 128 ? 128 : dist);
                float bias = biasT[di * 4 + h];
                asm volatile("" : "+v"(bias));
                x[kt][i] = ok ? s[kt][i] + bias : -INFINITY;
            }
        }
}
DI float quad16_max(float v) { v = fmaxf(v, __shfl_xor(v, 16)); v = fmaxf(v, __shfl_xor(v, 32)); return v; }
DI float quad16_sum(float v) { v += __shfl_xor(v, 16); v += __shfl_xor(v, 32); return v; }
DI void nsa_softmax(const float (&x)[4][4], float& m, float& l, f32x4 (&O)[4], bf16x8 (&pf)[2]) {
    float mx = -INFINITY;
#pragma unroll
    for (int kt = 0; kt < 4; ++kt)
#pragma unroll
        for (int i = 0; i < 4; ++i) mx = fmaxf(mx, x[kt][i]);
    mx = quad16_max(mx);
    const float mn = fmaxf(m, mx);
    const float mu = (mn == -INFINITY) ? 0.f : mn;
    const float mu2 = mu * 1.4426950408889634f;
    const float sc = __builtin_amdgcn_exp2f(__builtin_fmaf(m, 1.4426950408889634f, -mu2));
    float p[4][4]; float ps = 0.f;
#pragma unroll
    for (int kt = 0; kt < 4; ++kt)
#pragma unroll
        for (int i = 0; i < 4; ++i) { p[kt][i] = __builtin_amdgcn_exp2f(__builtin_fmaf(x[kt][i], 1.4426950408889634f, -mu2)); ps += p[kt][i]; }
    l = l * sc + ps; m = mn;
#pragma unroll
    for (int dt = 0; dt < 4; ++dt) O[dt] = O[dt] * sc;
#pragma unroll
    for (int ks = 0; ks < 2; ++ks) {
        u32x4 w; w.x = pack2(p[2 * ks][0], p[2 * ks][1]); w.y = pack2(p[2 * ks][2], p[2 * ks][3]); w.z = pack2(p[2 * ks + 1][0], p[2 * ks + 1][1]); w.w = pack2(p[2 * ks + 1][2], p[2 * ks + 1][3]);
        pf[ks] = __builtin_bit_cast(bf16x8, w);
    }
}
template <int QM = 3>
DI void nsa_pv(f32x4 (&O)[2][4], const bf16_t* sV, const bf16x8 (&pf)[2][2], int lane) {
    const int qd = lane >> 4;
#pragma unroll
    for (int dt = 0; dt < 4; ++dt)
#pragma unroll
        for (int ks = 0; ks < 2; ++ks) {
            const bf16_t* vp = sV + (16 * dt + (lane & 15)) * TS + 32 * ks + 4 * qd;
            const u32x2 a = *(const u32x2*)vp, b = *(const u32x2*)(vp + 16);
            u32x4 w; w.x = a.x; w.y = a.y; w.z = b.x; w.w = b.y;
            const bf16x8 vf = __builtin_bit_cast(bf16x8, w);
#pragma unroll
            for (int qi = 0; qi < 2; ++qi) if ((QM >> qi) & 1) O[qi][dt] = __builtin_amdgcn_mfma_f32_16x16x32_bf16(vf, pf[qi][ks], O[qi][dt], 0, 0, 0);
        }
}
template <int MODE, int QM = 3>
DI void nsa_tile(f32x4 (&O)[2][4], NsaLane& L, const bf16x8 (&qf)[2][2], const unsigned char* lds, int buf, int pos0, bool sel0, bool sel1, int lane) {
    const bf16_t* sK = (const bf16_t*)(lds + NSA_K0) + buf * 64 * TS;
    const bf16_t* sV = (const bf16_t*)(lds + NSA_V0) + buf * 64 * TS;
    const float* biasT = (const float*)(lds + NSA_BIAS);
    f32x4 s[2][4];
    nsa_qk<QM>(s, sK, qf, lane);
    bf16x8 pf[2][2];
#pragma unroll
    for (int qi = 0; qi < 2; ++qi) if ((QM >> qi) & 1) {
        float x[4][4];
        nsa_logits<MODE>(x, s[qi], L.tq[qi], L.h, L.cbias, qi ? sel1 : sel0, pos0, lane >> 4, biasT);
        nsa_softmax(x, L.m[qi], L.l[qi], O[qi], pf[qi]);
    }
    nsa_pv<QM>(O, sV, pf, lane);
}
template <int MODE>
DI void nsa_tile_sel(f32x4 (&O)[2][4], NsaLane& L, const bf16x8 (&qf)[2][2], const unsigned char* lds, int buf, int pos0, bool sel0, bool sel1, int lane) {
    const bool a0 = __ballot(sel0) != 0ull, a1 = __ballot(sel1) != 0ull;
    if (a0 && a1) nsa_tile<MODE, 3>(O, L, qf, lds, buf, pos0, sel0, sel1, lane);
    else if (a0) nsa_tile<MODE, 1>(O, L, qf, lds, buf, pos0, sel0, sel1, lane);
    else if (a1) nsa_tile<MODE, 2>(O, L, qf, lds, buf, pos0, sel0, sel1, lane);
}
DI void nsa_flush(f32x4 (&Y)[2][4], f32x4 (&O)[2][4], NsaLane& L, const float (&gate)[2]) {
#pragma unroll
    for (int qi = 0; qi < 2; ++qi) {
        const float lt = quad16_sum(L.l[qi]);
        const float f = (lt > 0.f) ? gate[qi] * __builtin_amdgcn_rcpf(lt) : 0.f;
#pragma unroll
        for (int dt = 0; dt < 4; ++dt) { Y[qi][dt] += O[qi][dt] * f; O[qi][dt] = (f32x4){0.f, 0.f, 0.f, 0.f}; }
    }
}
DI void nsa_item(const Ctx& c, int item, unsigned char* lds) {
    const int tid = TID(), lane = tid & 63, wave = tid >> 6, qd = lane >> 4;
    const int b = item >> 8, g = (item >> 6) & 3, qt = item & 63, t0 = qt * 64, cur = qt, bg = b * 4 + g;
    float* biasT = (float*)(lds + NSA_BIAS);
    unsigned long long* selm = (unsigned long long*)(lds + NSA_SELM);
    float* scr = (float*)(lds + NSA_SCR) + wave * 64;
    float* impA = (float*)(lds + NSA_A); float* impB = (float*)(lds + NSA_B);
    __syncthreads();
    for (int i = tid; i < 129 * 4; i += NTHREADS) { const int d = i >> 2, h = i & 3; biasT[i] = c.in(I_RELB)[t5_bucket(d) * 16 + g * 4 + h]; }
    for (int i = tid; i < 2 * 4096; i += NTHREADS) impA[i] = 0.f;
    NsaLane L; L.h = lane & 3;
    bf16x8 qf[2][2]; float gates[2][3];
    const bf16_t* pbat = c.PROJ + (size_t)b * SEQ * IN_COLS;
#pragma unroll
    for (int qi = 0; qi < 2; ++qi) {
        const int tl = 8 * wave + 4 * qi + ((lane & 15) >> 2);
        L.tq[qi] = t0 + tl;
        const bf16_t* prow = pbat + (size_t)L.tq[qi] * IN_COLS;
#pragma unroll
        for (int ks = 0; ks < 2; ++ks) {
            u32x4 w = *(const u32x4*)(prow + C_Q + (g * 4 + L.h) * 64 + 32 * ks + qd * 8);
            w.x = pack2(bflo(w.x) * 0.125f, bfhi(w.x) * 0.125f); w.y = pack2(bflo(w.y) * 0.125f, bfhi(w.y) * 0.125f);
            w.z = pack2(bflo(w.z) * 0.125f, bfhi(w.z) * 0.125f); w.w = pack2(bflo(w.w) * 0.125f, bfhi(w.w) * 0.125f);
            qf[qi][ks] = __builtin_bit_cast(bf16x8, w);
        }
#pragma unroll
        for (int br = 0; br < 3; ++br) gates[qi][br] = sigmoidf_(bf2f(prow[C_GATE + g * 12 + L.h * 3 + br]));
    }
    __syncthreads();
    L.cbias = biasT[128 * 4 + L.h];
    f32x4 O[2][4], Y[2][4];
#pragma unroll
    for (int qi = 0; qi < 2; ++qi)
#pragma unroll
        for (int dt = 0; dt < 4; ++dt) { O[qi][dt] = (f32x4){0.f, 0.f, 0.f, 0.f}; Y[qi][dt] = (f32x4){0.f, 0.f, 0.f, 0.f}; }
    u32x4 rk, rv;
    const int nvis_max = (t0 + 63 >= 31) ? ((t0 + 63 - 31) >> 4) + 1 : 0;
    const int ncb = (nvis_max + 63) >> 6;
    const bf16_t* kcb = c.KC + (size_t)bg * 256 * 64; const bf16_t* vcb = c.VCT + (size_t)bg * 64 * 256;
    L.m[0] = L.m[1] = -INFINITY; L.l[0] = L.l[1] = 0.f;
    if (ncb > 0) nsa_prefetch(rk, rv, kcb, 64, vcb, 256, 0, tid);
    for (int cb = 0; cb < ncb; ++cb) {
        nsa_store(lds, cb & 1, rk, rv, tid);
        __syncthreads();
        if (cb + 1 < ncb) nsa_prefetch(rk, rv, kcb, 64, vcb, 256, (cb + 1) * 64, tid);
        if (16 * (cb * 64 + 63) + 31 + 128 <= t0) nsa_tile<1>(O, L, qf, lds, cb & 1, cb * 64, true, true, lane);
        else nsa_tile<0>(O, L, qf, lds, cb & 1, cb * 64, true, true, lane);
    }
    float mfin[2], linv[2];
#pragma unroll
    for (int qi = 0; qi < 2; ++qi) { mfin[qi] = L.m[qi]; const float lt = quad16_sum(L.l[qi]); linv[qi] = (lt > 0.f) ? __builtin_amdgcn_rcpf(lt) : 0.f; }
    { const float gg[2] = {gates[0][0], gates[1][0]}; nsa_flush(Y, O, L, gg); }
    __syncthreads();
    if (ncb > 0) nsa_prefetch(rk, rv, kcb, 64, vcb, 256, 0, tid);
    for (int cb = 0; cb < ncb; ++cb) {
        nsa_store(lds, cb & 1, rk, rv, tid);
        __syncthreads();
        if (cb + 1 < ncb) nsa_prefetch(rk, rv, kcb, 64, vcb, 256, (cb + 1) * 64, tid);
        const bf16_t* sK = (const bf16_t*)(lds + NSA_K0) + (cb & 1) * 64 * TS;
        f32x4 s[2][4];
        nsa_qk(s, sK, qf, lane);
#pragma unroll
        for (int qi = 0; qi < 2; ++qi) {
            float x[4][4];
            nsa_logits<0>(x, s[qi], L.tq[qi], L.h, L.cbias, true, cb * 64, qd, biasT);
            const float mu = (mfin[qi] == -INFINITY) ? 0.f : mfin[qi];
#pragma unroll
            for (int kt = 0; kt < 4; ++kt) {
                float p3 = __expf(x[kt][3] - mu) * linv[qi];
                float pa = (__expf(x[kt][0] - mu) + __expf(x[kt][1] - mu) + __expf(x[kt][2] - mu)) * linv[qi] + p3;
                pa += __shfl_xor(pa, 1); p3 += __shfl_xor(p3, 1);
                pa += __shfl_xor(pa, 2); p3 += __shfl_xor(p3, 2);
                if (L.h == 0) { const int tl = 8 * wave + 4 * qi + ((lane & 15) >> 2), mi = 16 * cb + 4 * kt + qd; impA[tl * 64 + mi] = pa; impB[tl * 64 + mi] = p3; }
            }
        }
    }
    __syncthreads();
    for (int tl8 = 0; tl8 < 8; ++tl8) {
        const int tl = 8 * wave + tl8, n = lane;
        const bool cand = (n >= 1) && (n <= cur - 2);
        const float imp = cand ? impA[tl * 64 + n] + impB[tl * 64 + n - 1] : -1.0f;
        LDS_WAVE_SYNC();
        scr[n] = imp;
        LDS_WAVE_SYNC();
        int rank = 0;
#pragma unroll 4
        for (int q4 = 0; q4 < 16; ++q4) {
            const f32x4 o = *(const f32x4*)(scr + q4 * 4);
#pragma unroll
            for (int j = 0; j < 4; ++j) { const int n2 = q4 * 4 + j; rank += (o[j] > imp || (o[j] == imp && n2 < n)) ? 1 : 0; }
        }
        const bool forced = (n <= cur) && (n == 0 || n == cur || n == cur - 1);
        const unsigned long long msk = __ballot((cand && rank < 5) || forced);
        if (lane == 0) selm[tl] = msk;
    }
    __syncthreads();
    unsigned long long uni = selm[lane];
#pragma unroll
    for (int o = 32; o >= 1; o >>= 1) { const unsigned lo_ = __shfl_xor((unsigned)uni, o), hi_ = __shfl_xor((unsigned)(uni >> 32), o); uni |= ((unsigned long long)hi_ << 32) | lo_; }
    uni = ((unsigned long long)__builtin_amdgcn_readfirstlane((unsigned)(uni >> 32)) << 32) | (unsigned)__builtin_amdgcn_readfirstlane((unsigned)uni);
    unsigned long long sm[2];
#pragma unroll
    for (int qi = 0; qi < 2; ++qi) sm[qi] = selm[8 * wave + 4 * qi + ((lane & 15) >> 2)];
    const bf16_t* ksb = pbat + C_KS + g * 64; const bf16_t* vsb = c.VT + ((size_t)0 * 16 + bg) * 64 * SEQ;
    L.m[0] = L.m[1] = -INFINITY; L.l[0] = L.l[1] = 0.f;
    {
        unsigned long long rem = uni; int it = 0;
        int j = (int)__builtin_ctzll(rem); rem &= rem - 1;
        nsa_prefetch(rk, rv, ksb, IN_COLS, vsb, SEQ, j * 64, tid);
        for (;;) {
            nsa_store(lds, it & 1, rk, rv, tid);
            __syncthreads();
            const int jn = rem ? (int)__builtin_ctzll(rem) : -1;
            if (jn >= 0) { rem &= rem - 1; nsa_prefetch(rk, rv, ksb, IN_COLS, vsb, SEQ, jn * 64, tid); }
            const bool s0 = (sm[0] >> j) & 1ull, s1 = (sm[1] >> j) & 1ull;
            if (j <= cur - 3) nsa_tile_sel<1>(O, L, qf, lds, it & 1, j * 64, s0, s1, lane);
            else nsa_tile_sel<2>(O, L, qf, lds, it & 1, j * 64, s0, s1, lane);
            if (jn < 0) break;
            j = jn; ++it;
        }
    }
    { const float gg[2] = {gates[0][1], gates[1][1]}; nsa_flush(Y, O, L, gg); }
    const bf16_t* kwb = pbat + C_KW + g * 64; const bf16_t* vwb = c.VT + ((size_t)1 * 16 + bg) * 64 * SEQ;
    L.m[0] = L.m[1] = -INFINITY; L.l[0] = L.l[1] = 0.f;
    {
        const int j0 = (cur - 8 > 0) ? cur - 8 : 0;
        __syncthreads();
        nsa_prefetch(rk, rv, kwb, IN_COLS, vwb, SEQ, j0 * 64, tid);
        for (int j = j0; j <= cur; ++j) {
            nsa_store(lds, (j - j0) & 1, rk, rv, tid);
            __syncthreads();
            if (j + 1 <= cur) nsa_prefetch(rk, rv, kwb, IN_COLS, vwb, SEQ, (j + 1) * 64, tid);
            if (cur - j >= 3 && cur - j <= 7) nsa_tile<1>(O, L, qf, lds, (j - j0) & 1, j * 64, true, true, lane);
            else nsa_tile<3>(O, L, qf, lds, (j - j0) & 1, j * 64, true, true, lane);
        }
    }
    { const float gg[2] = {gates[0][2], gates[1][2]}; nsa_flush(Y, O, L, gg); }
#pragma unroll
    for (int qi = 0; qi < 2; ++qi) {
        bf16_t* yrow = c.PROJ + ((size_t)b * SEQ + L.tq[qi]) * IN_COLS + C_Q + (g * 4 + L.h) * 64;
#pragma unroll
        for (int dt = 0; dt < 4; ++dt) store_bf4(yrow + 16 * dt + 4 * qd, Y[qi][dt]);
    }
}
DI void phase_mix(const Ctx& c, unsigned char* lds) {
    const int G = gridDim.x, bid = blockIdx.x;
    const int n_nsa = NB * 4 * (SEQ / 64), n_scan = NB * 8 * 4;
    const bool split = G >= 2 * n_scan;
    if (split) { if (bid < n_scan) scan_item(c, bid, lds); }
    else for (int item = bid; item < n_scan; item += G) scan_item(c, item, lds);
    unsigned* ctr = c.ctl + CW_Q + c.l;
    volatile int* sitem = (volatile int*)(lds + LDS_BYTES - 32);
    for (;;) {
        __syncthreads();
        if (TID() == 0) *sitem = (int)atomicAdd(ctr, 1u);
        __syncthreads();
        const int k = *sitem;
        if (k >= n_nsa) break;
        const int qt = 63 - (k >> 4), bgi = k & 15;
        nsa_item(c, (bgi << 6) | qt, lds);
    }
}

DI void phase_merge(const Ctx& c, unsigned char* lds) {
    const int nM = NT / 256, nN = DM / 128;
    const bf16_t* WM = (const bf16_t*)(c.ws + WS_WT_MG);
    const bf16_t* BR = (const bf16_t*)(c.ws + WS_WT_BR);
    const float* BM_ = c.in(I_BMG) + (size_t)c.l * 3 * DM;
    bf16_t* TMP = c.YRAW + (size_t)blockIdx.x * 256 * 128;
    for (int it = 0;; ++it) {
        int tm, tn; if (!xcd_unit(it, nN, tm, tn)) break;
        const int m0 = tm * 256, n0 = tn * 128;
#pragma unroll 1
        for (int i = 0; i < 3; ++i) {
            {
                f32x4 ag[4][4]; acc_zero(ag);
                const ARows ar = plain_rows(c.H, DM, m0, TID());
                gemm_core<0>(ag, ar, WM + (size_t)(i * DM + n0) * DM, DM, DM, lds);
                ACC_FOREACH(ag, { const f32x4 bb = *(const f32x4*)(BM_ + i * DM + n0 + c_);
                    store_bf4(TMP + r_ * 128 + c_, (f32x4){sigmoidf_(v_[0] + bb[0]), sigmoidf_(v_[1] + bb[1]), sigmoidf_(v_[2] + bb[2]), sigmoidf_(v_[3] + bb[3])}); });
            }
            f32x4 ab[4][4]; acc_zero(ab);
            if (i == 0) { const ARows ar = plain_rows(c.POOLED, 512, m0, TID()); gemm_core<0>(ab, ar, BR + (size_t)n0 * 512, 512, 512, lds); }
            else if (i == 1) { const ARows ar = plain_rows(c.F + (size_t)5 * NT * 512, 512, m0, TID()); gemm_core<0>(ab, ar, BR + (size_t)1024 * 512 + (size_t)n0 * 512, 512, 512, lds); }
            else { const ARows ar = plain_rows(c.PROJ + C_Q, IN_COLS, m0, TID()); gemm_core<0>(ab, ar, BR + (size_t)2048 * 512 + (size_t)n0 * 1024, 1024, 1024, lds); }
            ACC_FOREACH(ab, {
                bf16_t* q = c.MERGED + (size_t)(m0 + r_) * DM + n0 + c_;
                const u32x2 gv = *(const u32x2*)(TMP + r_ * 128 + c_);
                f32x4 m4 = ((f32x4){0.f, 0.f, 0.f, 0.f});
                if (i > 0) { const u32x2 pv = *(const u32x2*)q; m4 = ((f32x4){bflo(pv.x), bfhi(pv.x), bflo(pv.y), bfhi(pv.y)}); }
                m4[0] += bflo(gv.x) * v_[0]; m4[1] += bfhi(gv.x) * v_[1]; m4[2] += bflo(gv.y) * v_[2]; m4[3] += bfhi(gv.y) * v_[3];
                store_bf4(q, m4); });
        }
    }
}

DI void phase_outp(const Ctx& c, unsigned char* lds) {
    const int nM = NT / 256, nN = DM / 128;
    const bf16_t* W = (const bf16_t*)(c.ws + WS_WT_OUT);
    const float* xin = (c.l == 0) ? c.in(I_X) : c.out;
    for (int it = 0;; ++it) {
        int tm, tn; if (!xcd_unit(it, nN, tm, tn)) break;
        const int m0 = tm * 256, n0 = tn * 128;
        f32x4 acc[4][4]; acc_zero(acc);
        const ARows ar = plain_rows(c.MERGED, DM, m0, TID());
        gemm_core<0>(acc, ar, W + (size_t)n0 * DM, DM, DM, lds);
        ACC_FOREACH(acc, { const size_t o = (size_t)(m0 + r_) * DM + n0 + c_; const f32x4 x = *(const f32x4*)(xin + o); *(f32x4*)(c.out + o) = x + v_; });
    }
    for (int it = blockIdx.x * 4; it < 3 * 32 * 64; it += gridDim.x * 4) {
        const int mat = it / 2048, e = (it >> 6) & 31, tl = it & 63;
        if (mat == 0) convert_tile4(c.in(I_EG) + ((size_t)c.l * 32 + e) * DM * 256, 256, 256, DM, (bf16_t*)(c.ws + WS_EG) + (size_t)e * 256 * DM, tl, lds);
        else if (mat == 1) convert_tile4(c.in(I_EU) + ((size_t)c.l * 32 + e) * DM * 256, 256, 256, DM, (bf16_t*)(c.ws + WS_EU) + (size_t)e * 256 * DM, tl, lds);
        else convert_tile4(c.in(I_ED) + ((size_t)c.l * 32 + e) * 256 * DM, DM, DM, 256, (bf16_t*)(c.ws + WS_ED) + (size_t)e * DM * 256, tl, lds);
    }
}

DI void phase_norm2(const Ctx& c) {
    const int tid = TID(), lane = tid & 63, wave = tid >> 6;
    const float* gain = c.in(I_NFFN) + c.l * DM;
    const float* wrg = c.in(I_WRG) + (size_t)c.l * DM * 4; const float* brg = c.in(I_BRG) + c.l * 4;
    const float* wre = c.in(I_WRE) + (size_t)c.l * DM * 32; const float* bre = c.in(I_BRE) + c.l * 32;
    unsigned* cnt = c.ctl + CW_CNT + c.l * 32;
    for (int row = blockIdx.x * 8 + wave; row < NT; row += gridDim.x * 8) {
        f32x4 v[4];
        float ss = 0.f;
#pragma unroll
        for (int i = 0; i < 4; ++i) { v[i] = *(const f32x4*)(c.out + (size_t)row * DM + i * 256 + lane * 4); ss += v[i][0] * v[i][0] + v[i][1] * v[i][1] + v[i][2] * v[i][2] + v[i][3] * v[i][3]; }
        ss = wave_sum_dpp(ss);
        const float rs = rsqrtf(ss * (1.0f / DM) + 1e-6f);
#pragma unroll
        for (int i = 0; i < 4; ++i) {
            const f32x4 g = *(const f32x4*)(gain + i * 256 + lane * 4);
            v[i] = (f32x4){v[i][0] * rs * g[0], v[i][1] * rs * g[1], v[i][2] * rs * g[2], v[i][3] * rs * g[3]};
            store_bf4(c.H + (size_t)row * DM + i * 256 + lane * 4, v[i]);
        }
        float lgp[4] = {0.f, 0.f, 0.f, 0.f};
#pragma unroll
        for (int i = 0; i < 4; ++i)
#pragma unroll
            for (int j = 0; j < 4; ++j) { const f32x4 w = *(const f32x4*)(wrg + (size_t)(i * 256 + lane * 4 + j) * 4); lgp[0] += v[i][j] * w[0]; lgp[1] += v[i][j] * w[1]; lgp[2] += v[i][j] * w[2]; lgp[3] += v[i][j] * w[3]; }
#pragma unroll
        for (int o = 0; o < 4; ++o) lgp[o] = wave_sum_dpp(lgp[o]) + brg[o];
        int grp = 0; float gm = lgp[0];
#pragma unroll
        for (int o = 1; o < 4; ++o) if (lgp[o] > gm) { gm = lgp[o]; grp = o; }
        float gs = 0.f;
#pragma unroll
        for (int o = 0; o < 4; ++o) gs += __expf(lgp[o] - gm);
        const float ptop = 1.0f / gs;
        float le[8] = {0.f, 0.f, 0.f, 0.f, 0.f, 0.f, 0.f, 0.f};
#pragma unroll
        for (int i = 0; i < 4; ++i)
#pragma unroll
            for (int j = 0; j < 4; ++j) {
                const float* wp = wre + (size_t)(i * 256 + lane * 4 + j) * 32 + grp * 8;
                const f32x4 w0 = *(const f32x4*)wp, w1 = *(const f32x4*)(wp + 4);
                le[0] += v[i][j] * w0[0]; le[1] += v[i][j] * w0[1]; le[2] += v[i][j] * w0[2]; le[3] += v[i][j] * w0[3];
                le[4] += v[i][j] * w1[0]; le[5] += v[i][j] * w1[1]; le[6] += v[i][j] * w1[2]; le[7] += v[i][j] * w1[3];
            }
#pragma unroll
        for (int o = 0; o < 8; ++o) le[o] = wave_sum_dpp(le[o]) + bre[grp * 8 + o];
        int i0 = 0; float v0 = le[0];
#pragma unroll
        for (int o = 1; o < 8; ++o) if (le[o] > v0) { v0 = le[o]; i0 = o; }
        int i1 = -1; float v1 = -INFINITY;
#pragma unroll
        for (int o = 0; o < 8; ++o) if (o != i0 && le[o] > v1) { v1 = le[o]; i1 = o; }
        const float e1 = __expf(v1 - v0), inv = 1.0f / (1.0f + e1);
        if (lane == 0) {
            int* rt = c.ROUTE + (size_t)row * 8;
            const int ex0 = grp * 8 + i0, ex1 = grp * 8 + i1;
            rt[0] = ex0; rt[1] = ex1; ((float*)rt)[2] = inv * ptop; ((float*)rt)[3] = e1 * inv * ptop;
            atomicAdd(cnt + ex0, 1u); atomicAdd(cnt + ex1, 1u);
        }
    }
}
DI void phase_route2(const Ctx& c, unsigned char* lds) {
    int* soff = (int*)lds;
    const unsigned* cnt = c.ctl + CW_CNT + c.l * 32;
    unsigned* cur = c.ctl + CW_CUR + c.l * 32;
    __syncthreads();
    if (TID() == 0) { int s = 0; for (int e = 0; e < 32; ++e) { soff[e] = s; s += (int)cnt[e]; } }
    __syncthreads();
    for (int t = blockIdx.x * NTHREADS + TID(); t < NT; t += gridDim.x * NTHREADS) {
        int* rt = c.ROUTE + (size_t)t * 8;
#pragma unroll
        for (int s = 0; s < 2; ++s) {
            const int e = rt[s];
            const int p = soff[e] + (int)atomicAdd(cur + e, 1u);
            rt[4 + s] = p;
            c.ENT[2 * p] = t; ((float*)c.ENT)[2 * p + 1] = ((const float*)rt)[2 + s];
        }
    }
}
DI void moe_tables(const Ctx& c, int* soff, int* stile, int ncol) {
    const unsigned* cnt = c.ctl + CW_CNT + c.l * 32;
    __syncthreads();
    if (TID() == 0) { int s = 0, tt = 0; for (int e = 0; e < 32; ++e) { soff[e] = s; stile[e] = tt; s += (int)cnt[e]; tt += (((int)cnt[e] + 255) >> 8) * ncol; } soff[32] = s; stile[32] = tt; }
    __syncthreads();
}
DI void phase_moe_up(const Ctx& c, unsigned char* lds) {
    int* soff = (int*)(lds + 2 * G_STAGE); int* stile = soff + 64;
    moe_tables(c, soff, stile, 2);
    const int total = stile[32];
    for (int item = blockIdx.x; item < total; item += gridDim.x) {
        int e = 0;
        for (int q = 1; q < 32; ++q) if (stile[q] <= item) e = q;
        const int loc = item - stile[e], tm = loc >> 1, tn = loc & 1, n0 = tn * 128;
        const int p0 = soff[e] + tm * 256, pend = soff[e + 1];
        ARows ar;
#pragma unroll
        for (int i = 0; i < 4; ++i) { const int pr = p0 + (TID() >> 3) + 64 * i; ar.p[i] = (pr < pend) ? c.H + (size_t)c.ENT[2 * pr] * DM : nullptr; }
        {
            f32x4 ag[4][4]; acc_zero(ag);
            gemm_core<0>(ag, ar, (const bf16_t*)(c.ws + WS_EG) + ((size_t)e * 256 + n0) * DM, DM, DM, lds);
            ACC_FOREACH(ag, { if (p0 + r_ < pend) store_bf4(c.HID + (size_t)(p0 + r_) * 256 + n0 + c_, (f32x4){v_[0] * sigmoidf_(v_[0]), v_[1] * sigmoidf_(v_[1]), v_[2] * sigmoidf_(v_[2]), v_[3] * sigmoidf_(v_[3])}); });
        }
        f32x4 au[4][4]; acc_zero(au);
        gemm_core<0>(au, ar, (const bf16_t*)(c.ws + WS_EU) + ((size_t)e * 256 + n0) * DM, DM, DM, lds);
        ACC_FOREACH(au, { if (p0 + r_ < pend) { bf16_t* q = c.HID + (size_t)(p0 + r_) * 256 + n0 + c_; const u32x2 sv = *(const u32x2*)q;
            store_bf4(q, (f32x4){bflo(sv.x) * v_[0], bfhi(sv.x) * v_[1], bflo(sv.y) * v_[2], bfhi(sv.y) * v_[3]}); } });
    }
}
DI void phase_moe_down(const Ctx& c, unsigned char* lds) {
    int* soff = (int*)(lds + 2 * G_STAGE); int* stile = soff + 64;
    moe_tables(c, soff, stile, 8);
    const int total = stile[32];
    for (int item = blockIdx.x; item < total; item += gridDim.x) {
        int e = 0;
        for (int q = 1; q < 32; ++q) if (stile[q] <= item) e = q;
        const int loc = item - stile[e], tm = loc >> 3, tn = loc & 7, n0 = tn * 128;
        const int p0 = soff[e] + tm * 256, pend = soff[e + 1];
        ARows ar;
#pragma unroll
        for (int i = 0; i < 4; ++i) { const int pr = p0 + (TID() >> 3) + 64 * i; ar.p[i] = (pr < pend) ? c.HID + (size_t)pr * 256 : nullptr; }
        f32x4 acc[4][4]; acc_zero(acc);
        gemm_core<0>(acc, ar, (const bf16_t*)(c.ws + WS_ED) + ((size_t)e * DM + n0) * 256, 256, 256, lds);
        ACC_FOREACH(acc, { if (p0 + r_ < pend) { const float w = ((const float*)c.ENT)[2 * (p0 + r_) + 1];
            store_bf4(c.Y + (size_t)(p0 + r_) * DM + n0 + c_, (f32x4){v_[0] * w, v_[1] * w, v_[2] * w, v_[3] * w}); } });
    }
}
DI void phase_final(const Ctx& c) {
    const int tid = TID(), lane = tid & 63, wave = tid >> 6;
    const float* gain = c.in(I_NFIN);
    for (int row = blockIdx.x * 8 + wave; row < NT; row += gridDim.x * 8) {
        f32x4 v[4];
#pragma unroll
        for (int i = 0; i < 4; ++i) v[i] = *(const f32x4*)(c.out + (size_t)row * DM + i * 256 + lane * 4);
        add_moe_rows(c, row, lane, v);
        float ss = 0.f;
#pragma unroll
        for (int i = 0; i < 4; ++i) ss += v[i][0] * v[i][0] + v[i][1] * v[i][1] + v[i][2] * v[i][2] + v[i][3] * v[i][3];
        ss = wave_sum_dpp(ss);
        const float rs = rsqrtf(ss * (1.0f / DM) + 1e-6f);
#pragma unroll
        for (int i = 0; i < 4; ++i) {
            const f32x4 g = *(const f32x4*)(gain + i * 256 + lane * 4);
            *(f32x4*)(c.out + (size_t)row * DM + i * 256 + lane * 4) = (f32x4){v[i][0] * rs * g[0], v[i][1] * rs * g[1], v[i][2] * rs * g[2], v[i][3] * rs * g[3]};
        }
    }
}

constexpr int PH_PER_LAYER = 12, N_PHASES = DEPTH * PH_PER_LAYER + 1;
__global__ void __launch_bounds__(NTHREADS, 2) fwd_kernel(Params P) {
    extern __shared__ __attribute__((aligned(16))) unsigned char lds[];
    const int lo = P.ph_lo, hi = P.ph_hi;
    LAS unsigned* xbw = (LAS unsigned*)(lds + LDS_BYTES - 16);
    if (threadIdx.x == 0) { xbw[0] = 0u; xbw[1] = 0u; xbw[2] = 0u; xbw[3] = 0u; }
    __syncthreads();
    Ctx c; c.P = &P; c.ws = P.ws; c.out = P.out; c.l = 0;
    c.ctl = (unsigned*)(P.ws + WS_CTL);
    c.H = (bf16_t*)(P.ws + WS_H); c.PROJ = (bf16_t*)(P.ws + WS_PROJ); c.F = (bf16_t*)(P.ws + WS_F); c.POOLED = (bf16_t*)(P.ws + WS_POOLED);
    c.MERGED = (bf16_t*)(P.ws + WS_F); c.CMPH = (bf16_t*)(P.ws + WS_CMPH); c.CMPO = (float*)(P.ws + WS_CMPO); c.POSB = (float*)(P.ws + WS_POSB);
    c.ROUTE = (int*)(P.ws + WS_ROUTE); c.ENT = (int*)(P.ws + WS_ENT); c.HID = (bf16_t*)(P.ws + WS_HID); c.Y = (bf16_t*)(P.ws + WS_Y);
    c.VT = (bf16_t*)(P.ws + WS_VT); c.KC = (bf16_t*)(P.ws + WS_KC); c.VCT = (bf16_t*)(P.ws + WS_VCT); c.YRAW = (bf16_t*)(P.ws + WS_YRAW); c.BON = (float*)(P.ws + WS_BON);
    XcdBarrier bar; bar.bar = c.ctl + CW_BAR; bar.x = 0; bar.st = (volatile LAS unsigned*)xbw;
    if (hi - lo > 1) bar = xcd_barrier_post(c.ctl + CW_BAR, (volatile LAS unsigned*)xbw);
#define IN(k) (lo <= (k) && (k) < hi)
#define SEAM(k) do { if (IN(k) && IN((k) + 1)) xcd_barrier(bar); } while (0)
#pragma unroll 1
    for (int l = 0; l < DEPTH; ++l) {
        c.l = l; const int pb = l * PH_PER_LAYER;
        if (IN(pb + 0)) phase_norm1(c, lds);
        SEAM(pb + 0);
        if (IN(pb + 1)) phase_gemm1(c, lds);
        SEAM(pb + 1);
        if (IN(pb + 2)) phase_prep(c, lds);
        SEAM(pb + 2);
        if (IN(pb + 3)) phase_poolgemm(c, lds);
        SEAM(pb + 3);
        if (IN(pb + 4)) phase_mix(c, lds);
        SEAM(pb + 4);
        if (IN(pb + 5)) phase_rwkv_post(c, lds);
        SEAM(pb + 5);
        if (IN(pb + 6)) phase_merge(c, lds);
        SEAM(pb + 6);
        if (IN(pb + 7)) phase_outp(c, lds);
        SEAM(pb + 7);
        if (IN(pb + 8)) phase_norm2(c);
        SEAM(pb + 8);
        if (IN(pb + 9)) phase_route2(c, lds);
        SEAM(pb + 9);
        if (IN(pb + 10)) phase_moe_up(c, lds);
        SEAM(pb + 10);
        if (IN(pb + 11)) phase_moe_down(c, lds);
        SEAM(pb + 11);
    }
    if (IN(N_PHASES - 1)) phase_final(c);
}

#ifndef MK_N_LAUNCHES
#define MK_N_LAUNCHES 1
#endif
extern "C" void kernel_launch(void* const* d_in, const int* in_sizes, int n_in, void* d_out, int out_size, void* d_ws, size_t ws_size, hipStream_t stream) {
    static int grid = 0;
    if (grid == 0) {
        if (n_in != N_IN || out_size != NT * DM || ws_size < WS_END) { fprintf(stderr, "kernel_launch: unexpected shapes n_in %d out %d ws %zu (need %zu)\n", n_in, out_size, ws_size, (size_t)WS_END); grid = -1; return; }
        int dev = 0, cus = 0, per_cu = 0;
        if (hipGetDevice(&dev) != hipSuccess || hipDeviceGetAttribute(&cus, hipDeviceAttributeMultiprocessorCount, dev) != hipSuccess) { grid = -1; return; }
        if (hipFuncSetAttribute((const void*)fwd_kernel, hipFuncAttributeMaxDynamicSharedMemorySize, LDS_BYTES) != hipSuccess) { fprintf(stderr, "kernel_launch: hipFuncSetAttribute failed\n"); grid = -1; return; }
        if (hipOccupancyMaxActiveBlocksPerMultiprocessor(&per_cu, (const void*)fwd_kernel, NTHREADS, LDS_BYTES) != hipSuccess || per_cu < 1) { fprintf(stderr, "kernel_launch: occupancy query says %d\n", per_cu); }
        (void)hipGetLastError();
        grid = cus;
    }
    if (grid < 0) return;
    if (hipMemsetAsync((char*)d_ws + WS_CTL, 0, CTL_BYTES, stream) != hipSuccess) return;
    Params p{};
    for (int i = 0; i < N_IN; ++i) p.in[i] = (const float*)d_in[i];
    p.out = (float*)d_out; p.ws = (unsigned char*)d_ws;
    if (MK_N_LAUNCHES == 1) {
        p.ph_lo = 0; p.ph_hi = N_PHASES;
        hipLaunchKernelGGL(fwd_kernel, dim3(grid), dim3(NTHREADS), LDS_BYTES, stream, p);
    } else {
        for (int k = 0; k < N_PHASES; ++k) { p.ph_lo = k; p.ph_hi = k + 1; hipLaunchKernelGGL(fwd_kernel, dim3(grid), dim3(NTHREADS), LDS_BYTES, stream, p); }
    }
}
```

```cpp
#include <hip/hip_runtime.h>
#include <cstdio>
#include <cstdint>

#define DI __device__ __forceinline__
typedef unsigned short bf16_t;
typedef short bf16x8 __attribute__((ext_vector_type(8)));
typedef float f32x4 __attribute__((ext_vector_type(4)));
typedef unsigned u32x4 __attribute__((ext_vector_type(4)));
typedef unsigned u32x2 __attribute__((ext_vector_type(2)));

constexpr int NB = 4, SEQ = 4096, DM = 1024, NT = NB * SEQ, DEPTH = 2;
constexpr int IN_COLS = 4816;
constexpr int C_POOL = 0, C_RW = 512, C_R = 512, C_K = 1024, C_V = 1536, C_WD = 2048, C_AD = 2080, C_GD = 2112;
constexpr int C_Q = 2208, C_KC = 3232, C_VC = 3488, C_KS = 3744, C_VS = 4000, C_KW = 4256, C_VW = 4512, C_GATE = 4768;
constexpr int RWC = 1696;
constexpr int NCMP = 255;
constexpr int NTHREADS = 512;
constexpr int LDS_BYTES = 114688;

enum { I_X = 0, I_RELB, I_NMIX, I_WIN, I_POOLW, I_POOLS, I_MU, I_W0, I_WUP, I_A0, I_AUP, I_GUP, I_KK, I_KA, I_RK, I_GNW, I_GNB,
       I_CPK, I_CW1K, I_CW2K, I_CPV, I_CW1V, I_CW2V, I_WBR, I_WMG, I_BMG, I_WOUT, I_NFFN, I_WRG, I_BRG, I_WRE, I_BRE, I_EG, I_EU, I_ED, I_NFIN, N_IN };

constexpr size_t WS_CTL = 0;
constexpr size_t CTL_BYTES = 65536;
constexpr size_t WS_H = CTL_BYTES;
constexpr size_t WS_PROJ = WS_H + (size_t)NT * DM * 2;
constexpr size_t WS_F = WS_PROJ + (size_t)NT * IN_COLS * 2;
constexpr size_t PLANE = (size_t)NT * 512 * 2;
constexpr size_t WS_POOLED = WS_F + 6 * PLANE;
constexpr size_t WS_CMPH = WS_POOLED + PLANE;
constexpr size_t WS_CMPO = WS_CMPH + (size_t)2 * 4096 * 256 * 2;
constexpr size_t WS_POSB = WS_CMPO + (size_t)2 * 4096 * 64 * 4;
constexpr size_t WS_ROUTE = WS_POSB + 4096;
constexpr size_t WS_ENT = WS_ROUTE + (size_t)NT * 32;
constexpr size_t WS_VT = WS_ENT + (size_t)2 * NT * 8;
constexpr size_t WS_KC = WS_VT + (size_t)2 * 16 * 64 * SEQ * 2;
constexpr size_t WS_VCT = WS_KC + (size_t)16 * 256 * 64 * 2;
constexpr size_t WS_YRAW = WS_VCT + (size_t)16 * 64 * 256 * 2;
constexpr size_t WS_BON = WS_YRAW + (size_t)NT * 512 * 2;
constexpr size_t WS_SMALLW = WS_BON + (size_t)NT * 8 * 16;
constexpr size_t WS_WT_LORA = WS_SMALLW + 262144;
constexpr size_t WS_END = WS_WT_LORA + (size_t)1536 * 128 * 2;
constexpr size_t WS_WT_IN = WS_F;
constexpr size_t WS_WT_C1 = WS_CMPO;
constexpr size_t WS_WT_C2 = WS_SMALLW;
constexpr size_t WS_WT_POOL = WS_SMALLW + 131072;
constexpr size_t WS_WT_MG = WS_VT;
constexpr size_t WS_WT_BR = WS_VT + (size_t)3072 * 1024 * 2;
constexpr size_t WS_WT_OUT = WS_CMPH;
constexpr size_t WS_EG = WS_F + 2 * PLANE;
constexpr size_t WS_EU = WS_EG + (size_t)32 * 256 * 1024 * 2;
constexpr size_t WS_ED = WS_EU + (size_t)32 * 256 * 1024 * 2;
static_assert(WS_ED + (size_t)32 * 1024 * 256 * 2 <= WS_F + 6 * PLANE, "expert alias");
static_assert(WS_WT_BR + (size_t)2048 * 1024 * 2 <= WS_VT + (size_t)2 * 16 * 64 * SEQ * 2, "merge alias");
static_assert((size_t)4864 * 1024 * 2 <= 6 * PLANE, "w_in alias");
constexpr size_t WS_HID = WS_PROJ;
constexpr size_t WS_Y = WS_PROJ + (size_t)2 * NT * 256 * 2;
static_assert(WS_Y + (size_t)2 * NT * 1024 * 2 <= WS_F, "alias");
constexpr int CW_BAR = 0;
constexpr int CW_CNT = 4096;
constexpr int CW_CUR = 4096 + 64;
constexpr int CW_Q = 4096 + 128;

#define XB_TMO      128
#define XB_XCNT(j)  (256  + 64 * (j))
#define XB_XSUB(j)  (1280 + 64 * (j))
#define XB_XGEN(j)  (2304 + 64 * (j))
#define XB_TOP      3328
#define XB_TOPGEN   3392
#define XCD_BAR_WORDS 3456
#define XB_SPIN_CAP (1u << 18)
#define LAS __attribute__((address_space(3)))

__device__ __forceinline__ unsigned xb_ld(unsigned* p)              { return __hip_atomic_load(p, __ATOMIC_RELAXED, __HIP_MEMORY_SCOPE_AGENT); }
__device__ __forceinline__ unsigned xb_add(unsigned* p, unsigned v) { return __hip_atomic_fetch_add(p, v, __ATOMIC_RELAXED, __HIP_MEMORY_SCOPE_AGENT); }
__device__ __forceinline__ unsigned xb_xcc_id() { return (unsigned)__builtin_amdgcn_s_getreg((3 << 11) | 20) & 0xFu; }
#define XB_SPIN(cond, bar) do { unsigned _sp = 0; while (cond) { __builtin_amdgcn_s_sleep(1); \
    if ((++_sp & 255u) == 0u) { if (xb_ld(&(bar)[XB_TMO])) break; if (_sp > XB_SPIN_CAP) { atomicAdd(&(bar)[XB_TMO], 1u); break; } } } } while (0)

struct XcdBarrier { unsigned* bar; unsigned x; volatile LAS unsigned* st; };

__device__ __forceinline__ XcdBarrier xcd_barrier_post(unsigned* bar, volatile LAS unsigned* st) {
    XcdBarrier b; b.bar = bar; b.x = xb_xcc_id(); b.st = st;
    if (threadIdx.x == 0) (void)xb_add(&bar[XB_XCNT(b.x)], 1u);
    return b;
}
__device__ __forceinline__ void xcd_barrier_complete(unsigned* bar, unsigned x, unsigned& nloc, unsigned& nx) {
    const unsigned G = gridDim.x * gridDim.y * gridDim.z;
    unsigned sum, cnt, mine, sp = 0u;
    for (;;) {
        sum = 0u; cnt = 0u; mine = 0u;
#pragma unroll
        for (unsigned j = 0; j < 16; ++j) { const unsigned c = xb_ld(&bar[XB_XCNT(j)]); sum += c; cnt += (c > 0u) ? 1u : 0u; mine = (j == x) ? c : mine; }
        if (sum == G) break;
        __builtin_amdgcn_s_sleep(1);
        if ((++sp & 255u) == 0u) { if (xb_ld(&bar[XB_TMO])) break; if (sp > XB_SPIN_CAP) { atomicAdd(&bar[XB_TMO], 1u); break; } }
    }
    nloc = mine > 0u ? mine : 1u; nx = cnt > 0u ? cnt : 1u;
}
__device__ __forceinline__ void xcd_barrier(const XcdBarrier& b) {
    asm volatile("s_waitcnt vmcnt(0)" ::: "memory");
    __syncthreads();
    if (threadIdx.x == 0) {
        unsigned* bar = b.bar;
        __builtin_amdgcn_s_waitcnt(0);
        unsigned nloc = b.st[0], nx = b.st[1];
        if (nloc == 0u) { xcd_barrier_complete(bar, b.x, nloc, nx); b.st[0] = nloc; b.st[1] = nx; }
        const unsigned old = xb_add(&bar[XB_XSUB(b.x)], 1u);
        const unsigned gen = old / nloc;
        if (old + 1u == (gen + 1u) * nloc) {
            __builtin_amdgcn_fence(__ATOMIC_RELEASE, "agent");
            asm volatile("s_waitcnt vmcnt(0)" ::: "memory");
            const unsigned og = xb_add(&bar[XB_TOP], 1u);
            const unsigned tg = og / nx;
            if (og + 1u == (tg + 1u) * nx) xb_add(&bar[XB_TOPGEN], 1u);
            else XB_SPIN(xb_ld(&bar[XB_TOPGEN]) == tg, bar);
            __builtin_amdgcn_fence(__ATOMIC_ACQUIRE, "agent");
            xb_add(&bar[XB_XGEN(b.x)], 1u);
            asm volatile("s_waitcnt vmcnt(0)" ::: "memory");
        } else {
            XB_SPIN(xb_ld(&bar[XB_XGEN(b.x)]) == gen, bar);
            __builtin_amdgcn_fence(__ATOMIC_ACQUIRE, "agent");
            asm volatile("s_waitcnt vmcnt(0)" ::: "memory");
        }
    }
    __syncthreads();
}

DI bf16_t f2bf(float x) { unsigned u = __float_as_uint(x); u += 0x7fffu + ((u >> 16) & 1u); return (bf16_t)(u >> 16); }
DI float bf2f(bf16_t b) { return __uint_as_float((unsigned)b << 16); }
typedef __bf16 bf16v2_t __attribute__((ext_vector_type(2)));
typedef float f32v2_t __attribute__((ext_vector_type(2)));
DI unsigned pack2(float lo, float hi) { const f32v2_t v = {lo, hi}; const bf16v2_t b = __builtin_convertvector(v, bf16v2_t); return __builtin_bit_cast(unsigned, b); }
DI float bflo(unsigned w) { return __uint_as_float(w << 16); }
DI float bfhi(unsigned w) { return __uint_as_float(w & 0xffff0000u); }
DI float wave_sum(float v) {
#pragma unroll
    for (int o = 32; o >= 1; o >>= 1) v += __shfl_xor(v, o);
    return v;
}
DI float wave_max(float v) {
#pragma unroll
    for (int o = 32; o >= 1; o >>= 1) v = fmaxf(v, __shfl_xor(v, o));
    return v;
}
DI float sigmoidf_(float x) { return __builtin_amdgcn_rcpf(1.0f + __expf(-x)); }
DI int TID() { int t = threadIdx.x; asm volatile("" : "+v"(t)); return t; }
#define LDS_WAVE_SYNC() asm volatile("s_waitcnt lgkmcnt(0)" ::: "memory")

#define DPP_MOV(v, ctrl) __builtin_bit_cast(float, __builtin_amdgcn_update_dpp(0, __builtin_bit_cast(int, (v)), (ctrl), 0xF, 0xF, true))
DI float wave_sum_dpp(float v) {
    v += DPP_MOV(v, 0xB1); v += DPP_MOV(v, 0x4E); v += DPP_MOV(v, 0x141); v += DPP_MOV(v, 0x140);
    return __builtin_bit_cast(float, __builtin_amdgcn_readlane(__builtin_bit_cast(int, v), 0)) + __builtin_bit_cast(float, __builtin_amdgcn_readlane(__builtin_bit_cast(int, v), 16)) +
        (__builtin_bit_cast(float, __builtin_amdgcn_readlane(__builtin_bit_cast(int, v), 32)) + __builtin_bit_cast(float, __builtin_amdgcn_readlane(__builtin_bit_cast(int, v), 48)));
}
struct Params { const float* in[N_IN]; float* out; unsigned char* ws; int ph_lo, ph_hi; };

DI int t5_bucket(int n) {
    if (n < 16) return n;
    if (n >= 128) return 31;
    int b = 16;
    b += (n >= 19) + (n >= 21) + (n >= 24) + (n >= 27) + (n >= 31) + (n >= 35) + (n >= 40) + (n >= 46) + (n >= 52) + (n >= 59) + (n >= 67) + (n >= 77) + (n >= 87) + (n >= 99) + (n >= 113);
    return b;
}

constexpr int G_A = 0, G_B = 256 * 64 * 2, G_STAGE = (256 + 128) * 64 * 2;
static_assert(2 * G_STAGE <= LDS_BYTES - 64, "gemm lds");
DI int g_off(int r, int c) { return ((r >> 4) * 2 + (c >> 5)) * 1024 + ((((r & 15) * 64) + (c & 31) * 2) ^ ((((r & 15) >> 3) & 1) << 5)); }
struct ARows { const bf16_t* p[4]; const float* mu; int ltype; int first; };
DI float tanhf_fast(float x) { const float e = __expf(2.0f * x); return 1.0f - 2.0f * __builtin_amdgcn_rcpf(e + 1.0f); }
DI u32x4 lora_chunk(const bf16_t* prow, bool first, const float* mu, int ltype, int k) {
    const int lim = (ltype == 2) ? 96 : 32;
    if (k >= lim) return (u32x4){0u, 0u, 0u, 0u};
    const int col = C_WD + ltype * 32 + k;
    const u32x4 cu = *(const u32x4*)(prow + col);
    u32x4 pu = (u32x4){0u, 0u, 0u, 0u};
    if (!first) pu = *(const u32x4*)(prow - IN_COLS + col);
    const f32x4 m0 = *(const f32x4*)(mu + col - C_RW), m1 = *(const f32x4*)(mu + col - C_RW + 4);
    float u[8] = {bflo(cu.x), bfhi(cu.x), bflo(cu.y), bfhi(cu.y), bflo(cu.z), bfhi(cu.z), bflo(cu.w), bfhi(cu.w)};
    const float p[8] = {bflo(pu.x), bfhi(pu.x), bflo(pu.y), bfhi(pu.y), bflo(pu.z), bfhi(pu.z), bflo(pu.w), bfhi(pu.w)};
    const float mm[8] = {m0[0], m0[1], m0[2], m0[3], m1[0], m1[1], m1[2], m1[3]};
#pragma unroll
    for (int j = 0; j < 8; ++j) { const float us = u[j] + (p[j] - u[j]) * mm[j]; u[j] = (ltype == 0) ? tanhf_fast(us) : ((ltype == 1) ? us : __builtin_amdgcn_rcpf(1.0f + __expf(-us))); }
    u32x4 w; w.x = pack2(u[0], u[1]); w.y = pack2(u[2], u[3]); w.z = pack2(u[4], u[5]); w.w = pack2(u[6], u[7]);
    return w;
}
template <int AMODE>
DI void g_load(u32x4 (&ra)[4], u32x4 (&rb)[2], const ARows& ar, const bf16_t* bt, int ldb, int k0, int tid) {
    const int kseg = (tid & 7) * 8;
#pragma unroll
    for (int i = 0; i < 4; ++i) {
        ra[i] = (u32x4){0u, 0u, 0u, 0u};
        if (AMODE == 2) ra[i] = lora_chunk(ar.p[i], (ar.first >> i) & 1, ar.mu, ar.ltype, k0 + kseg);
        else if (ar.p[i] != nullptr) ra[i] = *(const u32x4*)((AMODE == 0) ? (ar.p[i] + k0 + kseg) : (ar.p[i] + (size_t)(k0 >> 6) * IN_COLS + kseg));
    }
#pragma unroll
    for (int i = 0; i < 2; ++i) rb[i] = *(const u32x4*)(bt + (size_t)((tid >> 3) + 64 * i) * ldb + k0 + kseg);
}
DI void g_store(unsigned char* st, const u32x4 (&ra)[4], const u32x4 (&rb)[2], int tid) {
    const int off = g_off(tid >> 3, (tid & 7) * 8);
#pragma unroll
    for (int i = 0; i < 4; ++i) *(u32x4*)(st + G_A + off + i * 8192) = ra[i];
#pragma unroll
    for (int i = 0; i < 2; ++i) *(u32x4*)(st + G_B + off + i * 8192) = rb[i];
}
DI void g_compute(f32x4 (&acc)[4][4], const unsigned char* st, int lane, int wm, int wn) {
    const int lo = ((lane & 15) * 64 + (lane >> 4) * 16) ^ ((((lane & 15) >> 3) & 1) << 5);
    const unsigned char* sA = st + G_A + wm * 8192 + lo;
    const unsigned char* sB = st + G_B + wn * 8192 + lo;
    bf16x8 bcur[4], bnxt[4], a0, a1, a2;
#pragma unroll
    for (int i = 0; i < 4; ++i) bcur[i] = *(const bf16x8*)(sB + i * 2048);
    a0 = *(const bf16x8*)(sA);
    a1 = *(const bf16x8*)(sA + 2048);
#define G_AFRAG(s) (*(const bf16x8*)(sA + ((s) & 3) * 2048 + ((s) >> 2) * 1024))
#define G_GROUP(s, acur, anew) do { \
        if ((s) + 2 < 8) anew = G_AFRAG((s) + 2); \
        if ((s) < 4) bnxt[(s) & 3] = *(const bf16x8*)(sB + ((s) & 3) * 2048 + 1024); \
        __builtin_amdgcn_sched_barrier(0); \
        _Pragma("unroll") for (int ni = 0; ni < 4; ++ni) acc[(s) & 3][ni] = __builtin_amdgcn_mfma_f32_16x16x32_bf16(((s) < 4 ? bcur[ni] : bnxt[ni]), acur, acc[(s) & 3][ni], 0, 0, 0); \
        __builtin_amdgcn_sched_barrier(0); } while (0)
    G_GROUP(0, a0, a2); G_GROUP(1, a1, a0); G_GROUP(2, a2, a1); G_GROUP(3, a0, a2);
    G_GROUP(4, a1, a0); G_GROUP(5, a2, a1); G_GROUP(6, a0, a2); G_GROUP(7, a1, a0);
#undef G_GROUP
#undef G_AFRAG
}
#define LDS_BARRIER() do { asm volatile("s_waitcnt lgkmcnt(0)" ::: "memory"); __builtin_amdgcn_s_barrier(); asm volatile("" ::: "memory"); } while (0)
template <int AMODE>
DI void gemm_core(f32x4 (&acc)[4][4], const ARows& ar, const bf16_t* bt  , int ldb, int K, unsigned char* lds) {
    const int tid = TID(), lane = tid & 63, wave = tid >> 6, wm = wave >> 1, wn = wave & 1;
    const int nk = K >> 6;
    unsigned char* s0 = lds; unsigned char* s1 = lds + G_STAGE;
    u32x4 ra0[4], rb0[2], ra1[4], rb1[2];
    g_load<AMODE>(ra0, rb0, ar, bt, ldb, 0, tid);
    g_load<AMODE>(ra1, rb1, ar, bt, ldb, 64, tid);
    __syncthreads();
    g_store(s0, ra0, rb0, tid);
    g_load<AMODE>(ra0, rb0, ar, bt, ldb, (nk > 2 ? 2 : nk - 1) * 64, tid);
    LDS_BARRIER();
    for (int kt = 0; kt < nk; kt += 2) {
        g_store(s1, ra1, rb1, tid);
        { const int kn = (kt + 3 < nk) ? kt + 3 : nk - 1; g_load<AMODE>(ra1, rb1, ar, bt, ldb, kn * 64, tid); }
        g_compute(acc, s0, lane, wm, wn);
        LDS_BARRIER();
        g_store(s0, ra0, rb0, tid);
        { const int kn = (kt + 4 < nk) ? kt + 4 : nk - 1; g_load<AMODE>(ra0, rb0, ar, bt, ldb, kn * 64, tid); }
        g_compute(acc, s1, lane, wm, wn);
        LDS_BARRIER();
    }
}
DI void acc_zero(f32x4 (&acc)[4][4]) {
#pragma unroll
    for (int i = 0; i < 4; ++i)
#pragma unroll
        for (int j = 0; j < 4; ++j) acc[i][j] = (f32x4){0.f, 0.f, 0.f, 0.f};
}
#define ACC_FOREACH(acc, body) do { const int _l = TID() & 63, _w = TID() >> 6; \
    _Pragma("unroll") for (int _mi = 0; _mi < 4; ++_mi) _Pragma("unroll") for (int _ni = 0; _ni < 4; ++_ni) { \
        const int r_ = (_w >> 1) * 64 + _mi * 16 + (_l & 15), c_ = (_w & 1) * 64 + _ni * 16 + (_l >> 4) * 4; f32x4& v_ = acc[_mi][_ni]; body } } while (0)
DI ARows plain_rows(const bf16_t* base, size_t ld, int m0, int tid) { ARows a; a.mu = nullptr; a.ltype = 0; a.first = 0;
#pragma unroll
    for (int i = 0; i < 4; ++i) a.p[i] = base + (size_t)(m0 + (tid >> 3) + 64 * i) * ld;
    return a; }

DI void store_bf4(bf16_t* p, f32x4 v) { u32x2 w; w.x = pack2(v[0], v[1]); w.y = pack2(v[2], v[3]); *(u32x2*)p = w; }

DI void convert_tile4(const float* src, int ld, int N, int K, bf16_t* dst, int tile0, unsigned char* lds, int Kvalid = 1 << 30) {
    const int tid = TID();
    const int nkt = K >> 6;
    const int r = tid >> 3, seg = (tid & 7) * 8;
    f32x4 a[4], b[4];
#pragma unroll
    for (int u = 0; u < 4; ++u) {
        const int tile = tile0 + u, k0 = (tile % nkt) * 64, n0 = (tile / nkt) * 64;
        a[u] = (f32x4){0.f, 0.f, 0.f, 0.f}; b[u] = a[u];
        if (n0 + seg < N && k0 + r < Kvalid) { const float* q = src + (size_t)(k0 + r) * ld + n0 + seg; a[u] = *(const f32x4*)q; b[u] = *(const f32x4*)(q + 4); }
    }
    __syncthreads();
#pragma unroll
    for (int u = 0; u < 4; ++u) { bf16_t* T = (bf16_t*)lds + u * 64 * 72;
        u32x4 w; w.x = pack2(a[u][0], a[u][1]); w.y = pack2(a[u][2], a[u][3]); w.z = pack2(b[u][0], b[u][1]); w.w = pack2(b[u][2], b[u][3]); *(u32x4*)(T + r * 72 + seg) = w; }
    __syncthreads();
#pragma unroll
    for (int u = 0; u < 4; ++u) { const bf16_t* T = (const bf16_t*)lds + u * 64 * 72;
        const int tile = tile0 + u, k0 = (tile % nkt) * 64, n0 = (tile / nkt) * 64;
        u32x4 o;
        o.x = (unsigned)T[(seg + 0) * 72 + r] | ((unsigned)T[(seg + 1) * 72 + r] << 16); o.y = (unsigned)T[(seg + 2) * 72 + r] | ((unsigned)T[(seg + 3) * 72 + r] << 16);
        o.z = (unsigned)T[(seg + 4) * 72 + r] | ((unsigned)T[(seg + 5) * 72 + r] << 16); o.w = (unsigned)T[(seg + 6) * 72 + r] | ((unsigned)T[(seg + 7) * 72 + r] << 16);
        *(u32x4*)(dst + (size_t)(n0 + r) * K + k0 + seg) = o; }
}
struct Ctx {
    const Params* P; unsigned char* ws; float* out; int l;
    bf16_t* H; bf16_t* PROJ; bf16_t* F; bf16_t* POOLED; bf16_t* MERGED; bf16_t* CMPH; float* CMPO; float* POSB; int* ROUTE; int* ENT; bf16_t* HID; bf16_t* Y; bf16_t* VT; bf16_t* KC; bf16_t* VCT; bf16_t* YRAW; float* BON; unsigned* ctl;
    DI const float* in(int i) const { return P->in[i]; }
};

DI void add_moe_rows(const Ctx& c, int row, int lane, f32x4 (&v)[4]) {
    const int* rt = c.ROUTE + (size_t)row * 8;
    const int p0 = rt[4], p1 = rt[5];
    const bf16_t* y0 = c.Y + (size_t)p0 * DM; const bf16_t* y1 = c.Y + (size_t)p1 * DM;
#pragma unroll
    for (int i = 0; i < 4; ++i) {
        const u32x2 a = *(const u32x2*)(y0 + i * 256 + lane * 4), b = *(const u32x2*)(y1 + i * 256 + lane * 4);
        v[i][0] += bflo(a.x) + bflo(b.x); v[i][1] += bfhi(a.x) + bfhi(b.x); v[i][2] += bflo(a.y) + bflo(b.y); v[i][3] += bfhi(a.y) + bfhi(b.y);
    }
}
DI void phase_norm1(const Ctx& c, unsigned char* lds) {
    const int tid = TID(), lane = tid & 63, wave = tid >> 6;
    const float* gain = c.in(I_NMIX) + c.l * DM;
    const float* src = (c.l == 0) ? c.in(I_X) : c.out;
    for (int row = blockIdx.x * 8 + wave; row < NT; row += gridDim.x * 8) {
        f32x4 v[4];
#pragma unroll
        for (int i = 0; i < 4; ++i) v[i] = *(const f32x4*)(src + (size_t)row * DM + i * 256 + lane * 4);
        if (c.l > 0) {
            add_moe_rows(c, row, lane, v);
#pragma unroll
            for (int i = 0; i < 4; ++i) *(f32x4*)(c.out + (size_t)row * DM + i * 256 + lane * 4) = v[i];
        }
        float ss = 0.f;
#pragma unroll
        for (int i = 0; i < 4; ++i) ss += v[i][0] * v[i][0] + v[i][1] * v[i][1] + v[i][2] * v[i][2] + v[i][3] * v[i][3];
        ss = wave_sum_dpp(ss);
        const float rs = rsqrtf(ss * (1.0f / DM) + 1e-6f);
#pragma unroll
        for (int i = 0; i < 4; ++i) {
            const f32x4 g = *(const f32x4*)(gain + i * 256 + lane * 4);
            store_bf4(c.H + (size_t)row * DM + i * 256 + lane * 4, (f32x4){v[i][0] * rs * g[0], v[i][1] * rs * g[1], v[i][2] * rs * g[2], v[i][3] * rs * g[3]});
        }
    }
    for (int idx = blockIdx.x * 8 + wave; idx < 512; idx += gridDim.x * 8) {
        const int kv = idx >> 8, n = idx & 255;
        const float* pos = c.in(kv ? I_CPV : I_CPK) + (size_t)c.l * 2048;
        const float* w1 = c.in(kv ? I_CW1V : I_CW1K) + (size_t)c.l * 2048 * 256;
        float s = 0.f;
        for (int k = lane; k < 2048; k += 64) s += pos[k] * w1[(size_t)k * 256 + n];
        s = wave_sum_dpp(s);
        if (lane == 0) c.POSB[kv * 256 + n] = s;
    }
    for (int it = blockIdx.x * 4; it < 1216 + 256 + 16 + 16 + 48; it += gridDim.x * 4) {
        if (it < 1216) convert_tile4(c.in(I_WIN) + (size_t)c.l * DM * IN_COLS, IN_COLS, IN_COLS, DM, (bf16_t*)(c.ws + WS_WT_IN), it, lds);
        else if (it < 1216 + 256) { const int j = it - 1216, kv = j >> 7; convert_tile4(c.in(kv ? I_CW1V : I_CW1K) + (size_t)c.l * 2048 * 256, 256, 256, 2048, (bf16_t*)(c.ws + WS_WT_C1) + (size_t)kv * 256 * 2048, j & 127, lds); }
        else if (it < 1216 + 256 + 16) { const int j = it - 1472, kv = j >> 3; convert_tile4(c.in(kv ? I_CW2V : I_CW2K) + (size_t)c.l * 256 * 64, 64, 64, 256, (bf16_t*)(c.ws + WS_WT_C2) + (size_t)kv * 128 * 256, j & 7, lds); }
        else if (it < 1504) { const int j = it - 1488, gi = j >> 2; convert_tile4(c.in(I_POOLW) + ((size_t)c.l * 4 + gi) * 128 * 128, 128, 128, 128, (bf16_t*)(c.ws + WS_WT_POOL) + (size_t)gi * 128 * 128, 0, lds); }
        else { const int j = it - 1504, ty = j >> 4; bf16_t* dst = (bf16_t*)(c.ws + WS_WT_LORA) + (size_t)ty * 512 * 128;
            if (ty == 0) convert_tile4(c.in(I_WUP) + (size_t)c.l * 32 * 512, 512, 512, 128, dst, j & 15, lds, 32);
            else if (ty == 1) convert_tile4(c.in(I_AUP) + (size_t)c.l * 32 * 512, 512, 512, 128, dst, j & 15, lds, 32);
            else convert_tile4(c.in(I_GUP) + (size_t)c.l * 96 * 512, 512, 512, 128, dst, j & 15, lds, 96); }
    }
}

constexpr int EPS = 136;
DI void tile_store_bf16(f32x4 (&acc)[4][4], bf16_t* out, size_t ld, int nrows, int ncols, unsigned char* lds) {
    bf16_t* T = (bf16_t*)lds;
    const int tid = TID();
    __syncthreads();
    ACC_FOREACH(acc, { store_bf4(T + r_ * EPS + c_, v_); });
    __syncthreads();
#pragma unroll
    for (int i = 0; i < 8; ++i) {
        const int ch = tid + i * NTHREADS, r = ch >> 4, cc = (ch & 15) * 8;
        if (r < nrows && cc < ncols) *(u32x4*)(out + (size_t)r * ld + cc) = *(const u32x4*)(T + r * EPS + cc);
    }
}
DI bool xcd_unit(int it, int nN, int& tm, int& tn) {
    const int G = gridDim.x;
    if ((G & 7) != 0 || G < 8) { const int u = it * G + blockIdx.x; if (u >= 64 * nN) return false; tm = u % 64; tn = u / 64; return true; }
    const int x = blockIdx.x & 7, i = blockIdx.x >> 3, per = G >> 3;
    const int u = it * per + i;
    if (u >= 8 * nN) return false;
    tm = x * 8 + (u & 7); tn = u >> 3; return true;
}
DI void phase_gemm1(const Ctx& c, unsigned char* lds) {
    const int nM = NT / 256, nN = (IN_COLS + 127) / 128;
    const bf16_t* WT = (const bf16_t*)(c.ws + WS_WT_IN);
    for (int it = 0;; ++it) {
        int tm, tn; if (!xcd_unit(it, nN, tm, tn)) break;
        const int m0 = tm * 256, n0 = tn * 128;
        f32x4 acc[4][4]; acc_zero(acc);
        const ARows ar = plain_rows(c.H, DM, m0, TID());
        gemm_core<0>(acc, ar, WT + (size_t)n0 * DM, DM, DM, lds);
        tile_store_bf16(acc, c.PROJ + (size_t)m0 * IN_COLS + n0, IN_COLS, 256, (IN_COLS - n0 < 128) ? IN_COLS - n0 : 128, lds);
    }
}

DI float gelu_tanh(float x) { const float u = 0.7978845608028654f * (x + 0.044715f * x * x * x); const float e = __expf(2.0f * u); return x * (1.0f - __builtin_amdgcn_rcpf(e + 1.0f)); }
DI float softplusf_(float x) { return (x > 20.f) ? x : __logf(1.0f + __expf(x)); }
DI float tanhf_(float x) { const float e = __expf(2.0f * x); return 1.0f - 2.0f * __builtin_amdgcn_rcpf(e + 1.0f); }
constexpr int TKP = 8;
template <int WIN>
DI void pool_emit(const Ctx& c, const float (&pv)[31], int t0, int s0, int ch) {
#pragma unroll
    for (int k = 0; k < 16; ++k) {
        float sum = 0.f;
#pragma unroll
        for (int j = 0; j < WIN; ++j) sum += pv[15 + k - j];
        const int s = s0 + k, cnt = (s + 1 < WIN) ? s + 1 : WIN;
        c.POOLED[(size_t)(t0 + k) * 512 + ch] = f2bf(sum / (float)cnt - pv[15 + k]);
    }
}
DI void phase_prep(const Ctx& c, unsigned char* lds) {
    const int n_cmp_items = 2 * 16 * 2;
    for (int item = (int)gridDim.x - 1 - (int)blockIdx.x; item < n_cmp_items; item += gridDim.x) {
        const int tid = TID();
        const int kv = item >> 5, bgi = (item >> 1) & 15, tn = item & 1, m0 = bgi * 256, n0 = tn * 128;
        ARows ar; ar.mu = nullptr; ar.ltype = 0; ar.first = 0;
#pragma unroll
        for (int i = 0; i < 4; ++i) { const int cb = (tid >> 3) + 64 * i;
            ar.p[i] = (cb < NCMP) ? c.PROJ + ((size_t)(bgi >> 2) * SEQ + 16 * cb) * IN_COLS + (kv ? C_VC : C_KC) + (bgi & 3) * 64 : nullptr; }
        f32x4 acc[4][4]; acc_zero(acc);
        gemm_core<1>(acc, ar, (const bf16_t*)(c.ws + WS_WT_C1) + ((size_t)kv * 256 + n0) * 2048, 2048, 2048, lds);
        const float* pb = c.POSB + kv * 256;
        ACC_FOREACH(acc, {
            const f32x4 bb = *(const f32x4*)(pb + n0 + c_);
            store_bf4(c.CMPH + ((size_t)kv * 4096 + m0 + r_) * 256 + n0 + c_, (f32x4){gelu_tanh(v_[0] + bb[0]), gelu_tanh(v_[1] + bb[1]), gelu_tanh(v_[2] + bb[2]), gelu_tanh(v_[3] + bb[3])}); });
    }
    {
        const float* mu = c.in(I_MU) + (size_t)c.l * RWC;
        const bf16_t* WL = (const bf16_t*)(c.ws + WS_WT_LORA);
        for (int unit = blockIdx.x; unit < 64 * 12; unit += gridDim.x) {
            const int tid = TID();
            const int tm = unit & 63, tn = unit >> 6, m0 = tm * 256, n0 = tn * 128, ltype = tn >> 2, ch0 = n0 & 511;
            ARows ar; ar.mu = mu; ar.ltype = ltype; ar.first = 0;
#pragma unroll
            for (int i = 0; i < 4; ++i) { const int t = m0 + (tid >> 3) + 64 * i; ar.p[i] = c.PROJ + (size_t)t * IN_COLS; if ((t & (SEQ - 1)) == 0) ar.first |= 1 << i; }
            f32x4 acc[4][4]; acc_zero(acc);
            gemm_core<2>(acc, ar, WL + (size_t)n0 * 128, 128, 128, lds);
            if (ltype == 0) { const float* w0 = c.in(I_W0) + c.l * 512 + ch0;
                ACC_FOREACH(acc, { const f32x4 b4 = *(const f32x4*)(w0 + c_);
                    for (int j = 0; j < 4; ++j) v_[j] = __expf(-softplusf_(-(b4[j] + v_[j])) - 0.5f); }); }
            else if (ltype == 1) { const float* a0 = c.in(I_A0) + c.l * 512 + ch0;
                ACC_FOREACH(acc, { const f32x4 b4 = *(const f32x4*)(a0 + c_);
                    for (int j = 0; j < 4; ++j) v_[j] = sigmoidf_(b4[j] + v_[j]); }); }
            tile_store_bf16(acc, c.F + (size_t)(3 + ltype) * NT * 512 + (size_t)m0 * 512 + ch0, 512, 256, 128, lds);
        }
    }
    const int tid = TID();
    const int n_pool_items = NT / 16, n_items = n_pool_items + 2048;
    for (int item = blockIdx.x; item < n_items; item += gridDim.x) {
        if (item >= n_pool_items) {
            const int idx = item - n_pool_items, kind = idx >> 10, bgi = (idx >> 6) & 15, s0 = (idx & 63) * 64;
            bf16_t* T = (bf16_t*)lds;
            const int r = tid >> 3, seg = (tid & 7) * 8;
            const u32x4 w = *(const u32x4*)(c.PROJ + ((size_t)(bgi >> 2) * SEQ + s0 + r) * IN_COLS + (kind ? C_VW : C_VS) + (bgi & 3) * 64 + seg);
            __syncthreads();
            *(u32x4*)(T + r * 72 + seg) = w;
            __syncthreads();
            u32x4 o;
            o.x = (unsigned)T[(seg + 0) * 72 + r] | ((unsigned)T[(seg + 1) * 72 + r] << 16); o.y = (unsigned)T[(seg + 2) * 72 + r] | ((unsigned)T[(seg + 3) * 72 + r] << 16);
            o.z = (unsigned)T[(seg + 4) * 72 + r] | ((unsigned)T[(seg + 5) * 72 + r] << 16); o.w = (unsigned)T[(seg + 6) * 72 + r] | ((unsigned)T[(seg + 7) * 72 + r] << 16);
            *(u32x4*)(c.VT + (((size_t)kind * 16 + bgi) * 64 + r) * SEQ + s0 + seg) = o;
        } else {
            const int t0 = item * 16, ch = tid, gi = ch >> 7, s0 = t0 & (SEQ - 1);
            float pv[31];
#pragma unroll
            for (int i = 0; i < 31; ++i) pv[i] = (s0 - 15 + i >= 0) ? bf2f(c.PROJ[(size_t)(t0 - 15 + i) * IN_COLS + C_POOL + ch]) : 0.f;
            if (gi == 0) pool_emit<2>(c, pv, t0, s0, ch);
            else if (gi == 1) pool_emit<4>(c, pv, t0, s0, ch);
            else if (gi == 2) pool_emit<8>(c, pv, t0, s0, ch);
            else pool_emit<16>(c, pv, t0, s0, ch);
        }
    }
}

DI void rwkv_finalize_item(const Ctx& c, int item) {
    const int tid = TID(), ch = tid, t0 = item * 8;
    const float* mu = c.in(I_MU) + (size_t)c.l * RWC;
    const float kkw_ = c.in(I_KK)[c.l * 512 + ch], kaw_ = c.in(I_KA)[c.l * 512 + ch], rkw_ = c.in(I_RK)[c.l * 512 + ch];
    const float mur = mu[ch], muk = mu[512 + ch], muv = mu[1024 + ch];
    bf16_t ur[9], uk[9], uv[9], ua[8];
    const bool has_prev = (t0 & (SEQ - 1)) != 0;
#pragma unroll
    for (int k = 0; k < 9; ++k) {
        ur[k] = 0; uk[k] = 0; uv[k] = 0;
        if (k > 0 || has_prev) { const bf16_t* q = c.PROJ + (size_t)(t0 - 1 + k) * IN_COLS; ur[k] = q[C_R + ch]; uk[k] = q[C_K + ch]; uv[k] = q[C_V + ch]; }
    }
#pragma unroll
    for (int k = 0; k < 8; ++k) ua[k] = c.F[(size_t)4 * NT * 512 + (size_t)(t0 + k) * 512 + ch];
#pragma unroll
    for (int k = 0; k < 8; ++k) {
        const int t = t0 + k;
        const float cr = bf2f(ur[k + 1]), ck = bf2f(uk[k + 1]), cv = bf2f(uv[k + 1]);
        const float r = cr + (bf2f(ur[k]) - cr) * mur, kx = ck + (bf2f(uk[k]) - ck) * muk, vx = cv + (bf2f(uv[k]) - cv) * muv;
        const float a = bf2f(ua[k]);
        const float kxn = kx * kkw_, kp = kx * (1.0f + (a - 1.0f) * kaw_);
        const float ss = wave_sum_dpp(kxn * kxn);
        const float inv = __builtin_amdgcn_rsqf(fmaxf(ss, 1e-24f));
        const float br = wave_sum_dpp(kxn * inv * a * r), kr = wave_sum_dpp(kp * r), bon = wave_sum_dpp(r * kp * rkw_);
        if ((tid & 63) == 0) *(f32x4*)(c.BON + ((size_t)t * 8 + (tid >> 6)) * 4) = (f32x4){inv, br, kr, bon};
        const size_t o = (size_t)t * 512 + ch;
        c.F[o] = f2bf(r); c.F[o + (size_t)NT * 512] = f2bf(kx); c.F[o + (size_t)2 * NT * 512] = f2bf(vx);
    }
}

DI void phase_poolgemm(const Ctx& c, unsigned char* lds) {
    for (int item = blockIdx.x; item < NT / 8; item += gridDim.x) rwkv_finalize_item(c, item);
    const int n_pool = (NT / 256) * 4, n_items = n_pool + 32;
    for (int item = blockIdx.x; item < n_items; item += gridDim.x) {
        f32x4 acc[4][4]; acc_zero(acc);
        if (item < n_pool) {
            const int tm = item >> 2, gi = item & 3, m0 = tm * 256;
            const ARows ar = plain_rows(c.POOLED + gi * 128, 512, m0, TID());
            gemm_core<0>(acc, ar, (const bf16_t*)(c.ws + WS_WT_POOL) + (size_t)gi * 128 * 128, 128, 128, lds);
            const float* sc = c.in(I_POOLS) + c.l * 512 + gi * 128;
            ACC_FOREACH(acc, { const f32x4 s = *(const f32x4*)(sc + c_);
                store_bf4(c.POOLED + (size_t)(m0 + r_) * 512 + gi * 128 + c_, (f32x4){v_[0] * s[0], v_[1] * s[1], v_[2] * s[2], v_[3] * s[3]}); });
        } else {
            const int it = item - n_pool, kv = it >> 4, tm = it & 15, m0 = tm * 256;
            const ARows ar = plain_rows(c.CMPH + (size_t)kv * 4096 * 256, 256, m0, TID());
            gemm_core<0>(acc, ar, (const bf16_t*)(c.ws + WS_WT_C2) + (size_t)kv * 128 * 256, 256, 256, lds);
            ACC_FOREACH(acc, { if (c_ < 64) { const int R = m0 + r_;
                if (kv == 0) store_bf4(c.KC + (size_t)R * 64 + c_, v_);
                else { bf16_t* q = c.VCT + ((size_t)(R >> 8) * 64 + c_) * 256 + (R & 255); q[0] = f2bf(v_[0]); q[256] = f2bf(v_[1]); q[512] = f2bf(v_[2]); q[768] = f2bf(v_[3]); } } });
        }
    }
}

constexpr int SCH = 32;
constexpr int SB_AN = 0, SB_WR = SCH * 64 * 4, SB_W = 2 * SCH * 64 * 4, SB_BB = 3 * SCH * 64 * 4, SB_KP = 4 * SCH * 64 * 4;
constexpr int SB_V = 5 * SCH * 64 * 4;
constexpr int SB_SC = SB_V + SCH * 16 * 4;
constexpr int SB_Y = SB_SC + SCH * 2 * 4;
constexpr int SB_BYTES = SB_Y + SCH * 16 * 4;
static_assert(2 * SB_BYTES <= LDS_BYTES - 64, "scan lds");
typedef float f32x2 __attribute__((ext_vector_type(2)));
DI float row8_sum(float v) { v += DPP_MOV(v, 0xB1); v += DPP_MOV(v, 0x4E); v += DPP_MOV(v, 0x141); return v; }

constexpr int NPW = 6, NJ = (SCH + NPW - 1) / NPW;
struct PrepRegs { bf16_t r[NJ], k[NJ], v[NJ], e[NJ], a[NJ]; float s0[NJ], s1[NJ], s2[NJ]; };
DI void prep_load(PrepRegs& R, const Ctx& c, int b, int h, int ck, int pw, int lane) {
    const size_t PL = (size_t)NT * 512;
    const size_t tb = (size_t)b * SEQ + ck * SCH;
    const size_t o0 = tb * 512 + h * 64 + lane;
#pragma unroll
    for (int j = 0; j < NJ; ++j) {
        const int st = pw + NPW * j;
        if (st < SCH) { const size_t o = o0 + (size_t)st * 512; R.r[j] = c.F[o]; R.k[j] = c.F[o + PL]; R.v[j] = c.F[o + 2 * PL]; R.e[j] = c.F[o + 3 * PL]; R.a[j] = c.F[o + 4 * PL];
            const float* sp = c.BON + ((tb + st) * 8 + h) * 4; R.s0[j] = sp[0]; R.s1[j] = sp[1]; R.s2[j] = sp[2]; }
    }
}
DI void prep_store(const PrepRegs& R, unsigned char* sb, int rq, int pw, int lane, float kkw, float kaw) {
    float* an = (float*)(sb + SB_AN); float* wr = (float*)(sb + SB_WR); float* w_ = (float*)(sb + SB_W); float* bb_ = (float*)(sb + SB_BB); float* kp_ = (float*)(sb + SB_KP);
    float* vv = (float*)(sb + SB_V); float* sc = (float*)(sb + SB_SC);
#pragma unroll
    for (int j = 0; j < NJ; ++j) {
        const int st = pw + NPW * j;
        if (st < SCH) {
            const float r = bf2f(R.r[j]), k = bf2f(R.k[j]), v = bf2f(R.v[j]), e = bf2f(R.e[j]), a = bf2f(R.a[j]);
            const float w = __expf(-e);
            const float kk = k * kkw * R.s0[j];
            const float kp = k * (1.0f + (a - 1.0f) * kaw);
            an[st * 64 + lane] = -kk; wr[st * 64 + lane] = w * r; w_[st * 64 + lane] = w; bb_[st * 64 + lane] = kk * a; kp_[st * 64 + lane] = kp;
            if ((lane >> 4) == rq) vv[st * 16 + (lane & 15)] = v;
            if (lane == 0) { sc[st * 2] = R.s1[j]; sc[st * 2 + 1] = R.s2[j]; }
        }
    }
}
DI void scan_item(const Ctx& c, int item, unsigned char* lds) {
    const int tid = TID(), lane = tid & 63, wave = tid >> 6;
    const int b = item >> 5, h = (item >> 2) & 7, rq = item & 3;
    const int chn = h * 64 + lane;
    const float kkw = c.in(I_KK)[c.l * 512 + chn], kaw = c.in(I_KA)[c.l * 512 + chn];
    const int rowl = (tid & 127) >> 3, cg = tid & 7;
    f32x2 st[4];
#pragma unroll
    for (int i = 0; i < 4; ++i) st[i] = (f32x2){0.f, 0.f};
    constexpr int NCK = SEQ / SCH;
    PrepRegs R;
    __syncthreads();
    if (wave >= 2) { prep_load(R, c, b, h, 0, wave - 2, lane); prep_store(R, lds, rq, wave - 2, lane, kkw, kaw); prep_load(R, c, b, h, 1, wave - 2, lane); }
    __syncthreads();
    for (int ck = 0; ck < NCK; ++ck) {
        unsigned char* sb = lds + (ck & 1) * SB_BYTES;
        if (wave < 2) {
            const float* an = (const float*)(sb + SB_AN) + cg * 8; const float* wr = (const float*)(sb + SB_WR) + cg * 8; const float* w_ = (const float*)(sb + SB_W) + cg * 8;
            const float* bb_ = (const float*)(sb + SB_BB) + cg * 8; const float* kp_ = (const float*)(sb + SB_KP) + cg * 8;
            const float* vv = (const float*)(sb + SB_V) + rowl; const float* sc = (const float*)(sb + SB_SC); float* yb = (float*)(sb + SB_Y) + rowl;
            f32x4 a0 = *(const f32x4*)(an), a1 = *(const f32x4*)(an + 4), r0 = *(const f32x4*)(wr), r1 = *(const f32x4*)(wr + 4);
            f32x4 w0 = *(const f32x4*)(w_), w1 = *(const f32x4*)(w_ + 4), b0 = *(const f32x4*)(bb_), b1 = *(const f32x4*)(bb_ + 4);
            f32x4 k0 = *(const f32x4*)(kp_), k1 = *(const f32x4*)(kp_ + 4);
            float v = vv[0]; f32x2 bk = *(const f32x2*)(sc);
#pragma unroll 2
            for (int s = 0; s < SCH; ++s) {
                const int sn = (s + 1 < SCH) ? s + 1 : s;
                const f32x4 na0 = *(const f32x4*)(an + sn * 64), na1 = *(const f32x4*)(an + sn * 64 + 4), nr0 = *(const f32x4*)(wr + sn * 64), nr1 = *(const f32x4*)(wr + sn * 64 + 4);
                const f32x4 nw0 = *(const f32x4*)(w_ + sn * 64), nw1 = *(const f32x4*)(w_ + sn * 64 + 4), nb0 = *(const f32x4*)(bb_ + sn * 64), nb1 = *(const f32x4*)(bb_ + sn * 64 + 4);
                const f32x4 nk0 = *(const f32x4*)(kp_ + sn * 64), nk1 = *(const f32x4*)(kp_ + sn * 64 + 4);
                const float nv = vv[sn * 16]; const f32x2 nbk = *(const f32x2*)(sc + sn * 2);
                f32x2 da = st[0] * (f32x2){a0[0], a0[1]}; f32x2 dr = st[0] * (f32x2){r0[0], r0[1]};
                da += st[1] * (f32x2){a0[2], a0[3]}; dr += st[1] * (f32x2){r0[2], r0[3]};
                da += st[2] * (f32x2){a1[0], a1[1]}; dr += st[2] * (f32x2){r1[0], r1[1]};
                da += st[3] * (f32x2){a1[2], a1[3]}; dr += st[3] * (f32x2){r1[2], r1[3]};
                float sa = da[0] + da[1], sr = dr[0] + dr[1];
                sa += DPP_MOV(sa, 0xB1); sr += DPP_MOV(sr, 0xB1);
                sa += DPP_MOV(sa, 0x4E); sr += DPP_MOV(sr, 0x4E);
                sa += DPP_MOV(sa, 0x141); sr += DPP_MOV(sr, 0x141);
                const f32x2 sa2 = (f32x2){sa, sa}, v2 = (f32x2){v, v};
                st[0] = st[0] * (f32x2){w0[0], w0[1]} + sa2 * (f32x2){b0[0], b0[1]} + v2 * (f32x2){k0[0], k0[1]};
                st[1] = st[1] * (f32x2){w0[2], w0[3]} + sa2 * (f32x2){b0[2], b0[3]} + v2 * (f32x2){k0[2], k0[3]};
                st[2] = st[2] * (f32x2){w1[0], w1[1]} + sa2 * (f32x2){b1[0], b1[1]} + v2 * (f32x2){k1[0], k1[1]};
                st[3] = st[3] * (f32x2){w1[2], w1[3]} + sa2 * (f32x2){b1[2], b1[3]} + v2 * (f32x2){k1[2], k1[3]};
                yb[s * 16] = sr + sa * bk[0] + v * bk[1];
                a0 = na0; a1 = na1; r0 = nr0; r1 = nr1; w0 = nw0; w1 = nw1; b0 = nb0; b1 = nb1; k0 = nk0; k1 = nk1; v = nv; bk = nbk;
            }
        } else {
            const int pt = tid - 128;
            if (ck + 1 < NCK) prep_store(R, lds + ((ck + 1) & 1) * SB_BYTES, rq, wave - 2, lane, kkw, kaw);
            if (ck + 2 < NCK) prep_load(R, c, b, h, ck + 2, wave - 2, lane);
            if (ck > 0) {
                const float* yb = (const float*)(lds + ((ck - 1) & 1) * SB_BYTES + SB_Y);
                for (int idx = pt; idx < SCH * 16; idx += 384) {
                    const int s = idx >> 4, j = idx & 15;
                    c.YRAW[((size_t)b * SEQ + (ck - 1) * SCH + s) * 512 + h * 64 + rq * 16 + j] = f2bf(yb[idx]);
                }
            }
        }
        asm volatile("s_waitcnt lgkmcnt(0)" ::: "memory"); __builtin_amdgcn_s_barrier(); asm volatile("" ::: "memory");
    }
    {
        const float* yb = (const float*)(lds + ((NCK - 1) & 1) * SB_BYTES + SB_Y);
        for (int idx = tid; idx < SCH * 16; idx += NTHREADS) {
            const int s = idx >> 4, j = idx & 15;
            c.YRAW[((size_t)b * SEQ + (NCK - 1) * SCH + s) * 512 + h * 64 + rq * 16 + j] = f2bf(yb[idx]);
        }
    }
    __syncthreads();
}
DI void phase_rwkv_post(const Ctx& c, unsigned char* lds) {
    const int tid = TID(), lane = tid & 63, wave = tid >> 6;
    const size_t PL = (size_t)NT * 512;
    for (int t = blockIdx.x * 8 + wave; t < NT; t += gridDim.x * 8) {
        bf16_t ry[8], rv[8], rg[8]; float bon[8], gw[8], gb[8];
#pragma unroll
        for (int h = 0; h < 8; ++h) { const size_t o = (size_t)t * 512 + h * 64 + lane; ry[h] = c.YRAW[o]; rv[h] = c.F[o + 2 * PL]; rg[h] = c.F[o + 5 * PL]; bon[h] = c.BON[((size_t)t * 8 + h) * 4 + 3];
            gw[h] = c.in(I_GNW)[c.l * 512 + h * 64 + lane]; gb[h] = c.in(I_GNB)[c.l * 512 + h * 64 + lane]; }
#pragma unroll
        for (int h = 0; h < 8; ++h) {
            const float y = bf2f(ry[h]);
            const float mean = wave_sum_dpp(y) * (1.0f / 64.0f);
            const float d = y - mean;
            const float var = wave_sum_dpp(d * d) * (1.0f / 64.0f);
            const float yn = d * rsqrtf(var + 64e-5f) * gw[h] + gb[h];
            c.F[(size_t)t * 512 + h * 64 + lane + 5 * PL] = f2bf((yn + bon[h] * bf2f(rv[h])) * bf2f(rg[h]));
        }
    }
    for (int it = blockIdx.x * 4; it < 768 + 128 + 128 + 256 + 256; it += gridDim.x * 4) {
        const float* WB = c.in(I_WBR) + (size_t)c.l * 2048 * DM; bf16_t* BR = (bf16_t*)(c.ws + WS_WT_BR);
        if (it < 768) convert_tile4(c.in(I_WMG) + (size_t)c.l * DM * 3 * DM, 3 * DM, 3 * DM, DM, (bf16_t*)(c.ws + WS_WT_MG), it, lds);
        else if (it < 896) convert_tile4(WB, DM, DM, 512, BR, it - 768, lds);
        else if (it < 1024) convert_tile4(WB + (size_t)512 * DM, DM, DM, 512, BR + (size_t)1024 * 512, it - 896, lds);
        else if (it < 1280) convert_tile4(WB + (size_t)1024 * DM, DM, DM, 1024, BR + (size_t)2048 * 512, it - 1024, lds);
        else convert_tile4(c.in(I_WOUT) + (size_t)c.l * DM * DM, DM, DM, DM, (bf16_t*)(c.ws + WS_WT_OUT), it - 1280, lds);
    }
}
constexpr int TS = 72;
constexpr int NSA_BIAS = 0;
constexpr int NSA_SELM = 2112;
constexpr int NSA_SCR = 2624;
constexpr int NSA_K0 = 4672;
constexpr int NSA_V0 = NSA_K0 + 2 * 64 * TS * 2;
constexpr int NSA_A = NSA_V0 + 2 * 64 * TS * 2;
constexpr int NSA_B = NSA_A + 16384;
constexpr int NSA_END = NSA_B + 16384;
static_assert(NSA_END <= LDS_BYTES - 16, "nsa lds");
static_assert(NSA_K0 % 16 == 0, "align");

struct NsaLane { int tq[2]; int h; float cbias; float m[2], l[2]; };

DI void nsa_prefetch(u32x4& rk, u32x4& rv, const bf16_t* kbase, int kstride, const bf16_t* vtbase, int vstride, int pos0, int tid) {
    const int r = tid >> 3, seg = (tid & 7) * 8;
    rk = *(const u32x4*)(kbase + (size_t)(pos0 + r) * kstride + seg);
    rv = *(const u32x4*)(vtbase + (size_t)r * vstride + pos0 + seg);
}
DI void nsa_store(unsigned char* lds, int buf, const u32x4& rk, const u32x4& rv, int tid) {
    const int r = tid >> 3, seg = (tid & 7) * 8;
    *(u32x4*)((bf16_t*)(lds + NSA_K0) + buf * 64 * TS + r * TS + seg) = rk;
    *(u32x4*)((bf16_t*)(lds + NSA_V0) + buf * 64 * TS + r * TS + seg) = rv;
}
template <int QM = 3>
DI void nsa_qk(f32x4 (&s)[2][4], const bf16_t* sK, const bf16x8 (&qf)[2][2], int lane) {
#pragma unroll
    for (int kt = 0; kt < 4; ++kt) {
#pragma unroll
        for (int ks = 0; ks < 2; ++ks) {
            const bf16x8 kf = *(const bf16x8*)(sK + (16 * kt + (lane & 15)) * TS + 32 * ks + (lane >> 4) * 8);
#pragma unroll
            for (int qi = 0; qi < 2; ++qi) if ((QM >> qi) & 1) s[qi][kt] = __builtin_amdgcn_mfma_f32_16x16x32_bf16(kf, qf[qi][ks], (ks == 0) ? (f32x4){0.f, 0.f, 0.f, 0.f} : s[qi][kt], 0, 0, 0);
        }
    }
}
template <int MODE>
DI void nsa_logits(float (&x)[4][4], const f32x4 (&s)[4], int tq, int h, float cbias, bool rowsel, int pos0, int qd, const float* biasT) {
#pragma unroll
    for (int kt = 0; kt < 4; ++kt)
#pragma unroll
        for (int i = 0; i < 4; ++i) {
            const int kk = pos0 + 16 * kt + 4 * qd + i;
            if (MODE == 1) { x[kt][i] = rowsel ? s[kt][i] + cbias : -INFINITY; }
            else {
                const int dist = (MODE == 0) ? (tq - 16 * kk - 31) : (tq - kk);
                bool ok = dist >= 0;
                if (MODE == 2) ok = ok && rowsel;
                if (MODE == 3) ok = ok && (dist < 512);
                const int di = dist < 0 ? 0 : (dist > 128 ? 128 : dist);
                float bias = biasT[di * 4 + h];
                asm volatile("" : "+v"(bias));
                x[kt][i] = ok ? s[kt][i] + bias : -INFINITY;
            }
        }
}
DI float quad16_max(float v) { v = fmaxf(v, __shfl_xor(v, 16)); v = fmaxf(v, __shfl_xor(v, 32)); return v; }
DI float quad16_sum(float v) { v += __shfl_xor(v, 16); v += __shfl_xor(v, 32); return v; }
DI void nsa_softmax(const float (&x)[4][4], float& m, float& l, f32x4 (&O)[4], bf16x8 (&pf)[2]) {
    float mx = -INFINITY;
#pragma unroll
    for (int kt = 0; kt < 4; ++kt)
#pragma unroll
        for (int i = 0; i < 4; ++i) mx = fmaxf(mx, x[kt][i]);
    mx = quad16_max(mx);
    const float mn = fmaxf(m, mx);
    const float mu = (mn == -INFINITY) ? 0.f : mn;
    const float mu2 = mu * 1.4426950408889634f;
    const float sc = __builtin_amdgcn_exp2f(__builtin_fmaf(m, 1.4426950408889634f, -mu2));
    float p[4][4]; float ps = 0.f;
#pragma unroll
    for (int kt = 0; kt < 4; ++kt)
#pragma unroll
        for (int i = 0; i < 4; ++i) { p[kt][i] = __builtin_amdgcn_exp2f(__builtin_fmaf(x[kt][i], 1.4426950408889634f, -mu2)); ps += p[kt][i]; }
    l = l * sc + ps; m = mn;
#pragma unroll
    for (int dt = 0; dt < 4; ++dt) O[dt] = O[dt] * sc;
#pragma unroll
    for (int ks = 0; ks < 2; ++ks) {
        u32x4 w; w.x = pack2(p[2 * ks][0], p[2 * ks][1]); w.y = pack2(p[2 * ks][2], p[2 * ks][3]); w.z = pack2(p[2 * ks + 1][0], p[2 * ks + 1][1]); w.w = pack2(p[2 * ks + 1][2], p[2 * ks + 1][3]);
        pf[ks] = __builtin_bit_cast(bf16x8, w);
    }
}
template <int QM = 3>
DI void nsa_pv(f32x4 (&O)[2][4], const bf16_t* sV, const bf16x8 (&pf)[2][2], int lane) {
    const int qd = lane >> 4;
#pragma unroll
    for (int dt = 0; dt < 4; ++dt)
#pragma unroll
        for (int ks = 0; ks < 2; ++ks) {
            const bf16_t* vp = sV + (16 * dt + (lane & 15)) * TS + 32 * ks + 4 * qd;
            const u32x2 a = *(const u32x2*)vp, b = *(const u32x2*)(vp + 16);
            u32x4 w; w.x = a.x; w.y = a.y; w.z = b.x; w.w = b.y;
            const bf16x8 vf = __builtin_bit_cast(bf16x8, w);
#pragma unroll
            for (int qi = 0; qi < 2; ++qi) if ((QM >> qi) & 1) O[qi][dt] = __builtin_amdgcn_mfma_f32_16x16x32_bf16(vf, pf[qi][ks], O[qi][dt], 0, 0, 0);
        }
}
template <int MODE, int QM = 3>
DI void nsa_tile(f32x4 (&O)[2][4], NsaLane& L, const bf16x8 (&qf)[2][2], const unsigned char* lds, int buf, int pos0, bool sel0, bool sel1, int lane) {
    const bf16_t* sK = (const bf16_t*)(lds + NSA_K0) + buf * 64 * TS;
    const bf16_t* sV = (const bf16_t*)(lds + NSA_V0) + buf * 64 * TS;
    const float* biasT = (const float*)(lds + NSA_BIAS);
    f32x4 s[2][4];
    nsa_qk<QM>(s, sK, qf, lane);
    bf16x8 pf[2][2];
#pragma unroll
    for (int qi = 0; qi < 2; ++qi) if ((QM >> qi) & 1) {
        float x[4][4];
        nsa_logits<MODE>(x, s[qi], L.tq[qi], L.h, L.cbias, qi ? sel1 : sel0, pos0, lane >> 4, biasT);
        nsa_softmax(x, L.m[qi], L.l[qi], O[qi], pf[qi]);
    }
    nsa_pv<QM>(O, sV, pf, lane);
}
template <int MODE>
DI void nsa_tile_sel(f32x4 (&O)[2][4], NsaLane& L, const bf16x8 (&qf)[2][2], const unsigned char* lds, int buf, int pos0, bool sel0, bool sel1, int lane) {
    const bool a0 = __ballot(sel0) != 0ull, a1 = __ballot(sel1) != 0ull;
    if (a0 && a1) nsa_tile<MODE, 3>(O, L, qf, lds, buf, pos0, sel0, sel1, lane);
    else if (a0) nsa_tile<MODE, 1>(O, L, qf, lds, buf, pos0, sel0, sel1, lane);
    else if (a1) nsa_tile<MODE, 2>(O, L, qf, lds, buf, pos0, sel0, sel1, lane);
}
DI void nsa_flush(f32x4 (&Y)[2][4], f32x4 (&O)[2][4], NsaLane& L, const float (&gate)[2]) {
#pragma unroll
    for (int qi = 0; qi < 2; ++qi) {
        const float lt = quad16_sum(L.l[qi]);
        const float f = (lt > 0.f) ? gate[qi] * __builtin_amdgcn_rcpf(lt) : 0.f;
#pragma unroll
        for (int dt = 0; dt < 4; ++dt) { Y[qi][dt] += O[qi][dt] * f; O[qi][dt] = (f32x4){0.f, 0.f, 0.f, 0.f}; }
    }
}
DI void nsa_item(const Ctx& c, int item, unsigned char* lds) {
    const int tid = TID(), lane = tid & 63, wave = tid >> 6, qd = lane >> 4;
    const int b = item >> 8, g = (item >> 6) & 3, qt = item & 63, t0 = qt * 64, cur = qt, bg = b * 4 + g;
    float* biasT = (float*)(lds + NSA_BIAS);
    unsigned long long* selm = (unsigned long long*)(lds + NSA_SELM);
    float* scr = (float*)(lds + NSA_SCR) + wave * 64;
    float* impA = (float*)(lds + NSA_A); float* impB = (float*)(lds + NSA_B);
    __syncthreads();
    for (int i = tid; i < 129 * 4; i += NTHREADS) { const int d = i >> 2, h = i & 3; biasT[i] = c.in(I_RELB)[t5_bucket(d) * 16 + g * 4 + h]; }
    for (int i = tid; i < 2 * 4096; i += NTHREADS) impA[i] = 0.f;
    NsaLane L; L.h = lane & 3;
    bf16x8 qf[2][2]; float gates[2][3];
    const bf16_t* pbat = c.PROJ + (size_t)b * SEQ * IN_COLS;
#pragma unroll
    for (int qi = 0; qi < 2; ++qi) {
        const int tl = 8 * wave + 4 * qi + ((lane & 15) >> 2);
        L.tq[qi] = t0 + tl;
        const bf16_t* prow = pbat + (size_t)L.tq[qi] * IN_COLS;
#pragma unroll
        for (int ks = 0; ks < 2; ++ks) {
            u32x4 w = *(const u32x4*)(prow + C_Q + (g * 4 + L.h) * 64 + 32 * ks + qd * 8);
            w.x = pack2(bflo(w.x) * 0.125f, bfhi(w.x) * 0.125f); w.y = pack2(bflo(w.y) * 0.125f, bfhi(w.y) * 0.125f);
            w.z = pack2(bflo(w.z) * 0.125f, bfhi(w.z) * 0.125f); w.w = pack2(bflo(w.w) * 0.125f, bfhi(w.w) * 0.125f);
            qf[qi][ks] = __builtin_bit_cast(bf16x8, w);
        }
#pragma unroll
        for (int br = 0; br < 3; ++br) gates[qi][br] = sigmoidf_(bf2f(prow[C_GATE + g * 12 + L.h * 3 + br]));
    }
    __syncthreads();
    L.cbias = biasT[128 * 4 + L.h];
    f32x4 O[2][4], Y[2][4];
#pragma unroll
    for (int qi = 0; qi < 2; ++qi)
#pragma unroll
        for (int dt = 0; dt < 4; ++dt) { O[qi][dt] = (f32x4){0.f, 0.f, 0.f, 0.f}; Y[qi][dt] = (f32x4){0.f, 0.f, 0.f, 0.f}; }
    u32x4 rk, rv;
    const int nvis_max = (t0 + 63 >= 31) ? ((t0 + 63 - 31) >> 4) + 1 : 0;
    const int ncb = (nvis_max + 63) >> 6;
    const bf16_t* kcb = c.KC + (size_t)bg * 256 * 64; const bf16_t* vcb = c.VCT + (size_t)bg * 64 * 256;
    L.m[0] = L.m[1] = -INFINITY; L.l[0] = L.l[1] = 0.f;
    if (ncb > 0) nsa_prefetch(rk, rv, kcb, 64, vcb, 256, 0, tid);
    for (int cb = 0; cb < ncb; ++cb) {
        nsa_store(lds, cb & 1, rk, rv, tid);
        __syncthreads();
        if (cb + 1 < ncb) nsa_prefetch(rk, rv, kcb, 64, vcb, 256, (cb + 1) * 64, tid);
        if (16 * (cb * 64 + 63) + 31 + 128 <= t0) nsa_tile<1>(O, L, qf, lds, cb & 1, cb * 64, true, true, lane);
        else nsa_tile<0>(O, L, qf, lds, cb & 1, cb * 64, true, true, lane);
    }
    float mfin[2], linv[2];
#pragma unroll
    for (int qi = 0; qi < 2; ++qi) { mfin[qi] = L.m[qi]; const float lt = quad16_sum(L.l[qi]); linv[qi] = (lt > 0.f) ? __builtin_amdgcn_rcpf(lt) : 0.f; }
    { const float gg[2] = {gates[0][0], gates[1][0]}; nsa_flush(Y, O, L, gg); }
    __syncthreads();
    if (ncb > 0) nsa_prefetch(rk, rv, kcb, 64, vcb, 256, 0, tid);
    for (int cb = 0; cb < ncb; ++cb) {
        nsa_store(lds, cb & 1, rk, rv, tid);
        __syncthreads();
        if (cb + 1 < ncb) nsa_prefetch(rk, rv, kcb, 64, vcb, 256, (cb + 1) * 64, tid);
        const bf16_t* sK = (const bf16_t*)(lds + NSA_K0) + (cb & 1) * 64 * TS;
        f32x4 s[2][4];
        nsa_qk(s, sK, qf, lane);
#pragma unroll
        for (int qi = 0; qi < 2; ++qi) {
            float x[4][4];
            nsa_logits<0>(x, s[qi], L.tq[qi], L.h, L.cbias, true, cb * 64, qd, biasT);
            const float mu = (mfin[qi] == -INFINITY) ? 0.f : mfin[qi];
#pragma unroll
            for (int kt = 0; kt < 4; ++kt) {
                float p3 = __expf(x[kt][3] - mu) * linv[qi];
                float pa = (__expf(x[kt][0] - mu) + __expf(x[kt][1] - mu) + __expf(x[kt][2] - mu)) * linv[qi] + p3;
                pa += __shfl_xor(pa, 1); p3 += __shfl_xor(p3, 1);
                pa += __shfl_xor(pa, 2); p3 += __shfl_xor(p3, 2);
                if (L.h == 0) { const int tl = 8 * wave + 4 * qi + ((lane & 15) >> 2), mi = 16 * cb + 4 * kt + qd; impA[tl * 64 + mi] = pa; impB[tl * 64 + mi] = p3; }
            }
        }
    }
    __syncthreads();
    for (int tl8 = 0; tl8 < 8; ++tl8) {
        const int tl = 8 * wave + tl8, n = lane;
        const bool cand = (n >= 1) && (n <= cur - 2);
        const float imp = cand ? impA[tl * 64 + n] + impB[tl * 64 + n - 1] : -1.0f;
        LDS_WAVE_SYNC();
        scr[n] = imp;
        LDS_WAVE_SYNC();
        int rank = 0;
#pragma unroll 4
        for (int q4 = 0; q4 < 16; ++q4) {
            const f32x4 o = *(const f32x4*)(scr + q4 * 4);
#pragma unroll
            for (int j = 0; j < 4; ++j) { const int n2 = q4 * 4 + j; rank += (o[j] > imp || (o[j] == imp && n2 < n)) ? 1 : 0; }
        }
        const bool forced = (n <= cur) && (n == 0 || n == cur || n == cur - 1);
        const unsigned long long msk = __ballot((cand && rank < 5) || forced);
        if (lane == 0) selm[tl] = msk;
    }
    __syncthreads();
    unsigned long long uni = selm[lane];
#pragma unroll
    for (int o = 32; o >= 1; o >>= 1) { const unsigned lo_ = __shfl_xor((unsigned)uni, o), hi_ = __shfl_xor((unsigned)(uni >> 32), o); uni |= ((unsigned long long)hi_ << 32) | lo_; }
    uni = ((unsigned long long)__builtin_amdgcn_readfirstlane((unsigned)(uni >> 32)) << 32) | (unsigned)__builtin_amdgcn_readfirstlane((unsigned)uni);
    unsigned long long sm[2];
#pragma unroll
    for (int qi = 0; qi < 2; ++qi) sm[qi] = selm[8 * wave + 4 * qi + ((lane & 15) >> 2)];
    const bf16_t* ksb = pbat + C_KS + g * 64; const bf16_t* vsb = c.VT + ((size_t)0 * 16 + bg) * 64 * SEQ;
    L.m[0] = L.m[1] = -INFINITY; L.l[0] = L.l[1] = 0.f;
    {
        unsigned long long rem = uni; int it = 0;
        int j = (int)__builtin_ctzll(rem); rem &= rem - 1;
        nsa_prefetch(rk, rv, ksb, IN_COLS, vsb, SEQ, j * 64, tid);
        for (;;) {
            nsa_store(lds, it & 1, rk, rv, tid);
            __syncthreads();
            const int jn = rem ? (int)__builtin_ctzll(rem) : -1;
            if (jn >= 0) { rem &= rem - 1; nsa_prefetch(rk, rv, ksb, IN_COLS, vsb, SEQ, jn * 64, tid); }
            const bool s0 = (sm[0] >> j) & 1ull, s1 = (sm[1] >> j) & 1ull;
            if (j <= cur - 3) nsa_tile_sel<1>(O, L, qf, lds, it & 1, j * 64, s0, s1, lane);
            else nsa_tile_sel<2>(O, L, qf, lds, it & 1, j * 64, s0, s1, lane);
            if (jn < 0) break;
            j = jn; ++it;
        }
    }
    { const float gg[2] = {gates[0][1], gates[1][1]}; nsa_flush(Y, O, L, gg); }
    const bf16_t* kwb = pbat + C_KW + g * 64; const bf16_t* vwb = c.VT + ((size_t)1 * 16 + bg) * 64 * SEQ;
    L.m[0] = L.m[1] = -INFINITY; L.l[0] = L.l[1] = 0.f;
    {
        const int j0 = (cur - 8 > 0) ? cur - 8 : 0;
        __syncthreads();
        nsa_prefetch(rk, rv, kwb, IN_COLS, vwb, SEQ, j0 * 64, tid);
        for (int j = j0; j <= cur; ++j) {
            nsa_store(lds, (j - j0) & 1, rk, rv, tid);
            __syncthreads();
            if (j + 1 <= cur) nsa_prefetch(rk, rv, kwb, IN_COLS, vwb, SEQ, (j + 1) * 64, tid);
            if (cur - j >= 3 && cur - j <= 7) nsa_tile<1>(O, L, qf, lds, (j - j0) & 1, j * 64, true, true, lane);
            else nsa_tile<3>(O, L, qf, lds, (j - j0) & 1, j * 64, true, true, lane);
        }
    }
    { const float gg[2] = {gates[0][2], gates[1][2]}; nsa_flush(Y, O, L, gg); }
#pragma unroll
    for (int qi = 0; qi < 2; ++qi) {
        bf16_t* yrow = c.PROJ + ((size_t)b * SEQ + L.tq[qi]) * IN_COLS + C_Q + (g * 4 + L.h) * 64;
#pragma unroll
        for (int dt = 0; dt < 4; ++dt) store_bf4(yrow + 16 * dt + 4 * qd, Y[qi][dt]);
    }
}
DI void phase_mix(const Ctx& c, unsigned char* lds) {
    const int G = gridDim.x, bid = blockIdx.x;
    const int n_nsa = NB * 4 * (SEQ / 64), n_scan = NB * 8 * 4;
    const bool split = G >= 2 * n_scan;
    if (split) { if (bid < n_scan) scan_item(c, bid, lds); }
    else for (int item = bid; item < n_scan; item += G) scan_item(c, item, lds);
    unsigned* ctr = c.ctl + CW_Q + c.l;
    volatile int* sitem = (volatile int*)(lds + LDS_BYTES - 32);
    for (;;) {
        __syncthreads();
        if (TID() == 0) *sitem = (int)atomicAdd(ctr, 1u);
        __syncthreads();
        const int k = *sitem;
        if (k >= n_nsa) break;
        const int qt = 63 - (k >> 4), bgi = k & 15;
        nsa_item(c, (bgi << 6) | qt, lds);
    }
}

DI void phase_merge(const Ctx& c, unsigned char* lds) {
    const int nM = NT / 256, nN = DM / 128;
    const bf16_t* WM = (const bf16_t*)(c.ws + WS_WT_MG);
    const bf16_t* BR = (const bf16_t*)(c.ws + WS_WT_BR);
    const float* BM_ = c.in(I_BMG) + (size_t)c.l * 3 * DM;
    bf16_t* TMP = c.YRAW + (size_t)blockIdx.x * 256 * 128;
    for (int it = 0;; ++it) {
        int tm, tn; if (!xcd_unit(it, nN, tm, tn)) break;
        const int m0 = tm * 256, n0 = tn * 128;
#pragma unroll 1
        for (int i = 0; i < 3; ++i) {
            {
                f32x4 ag[4][4]; acc_zero(ag);
                const ARows ar = plain_rows(c.H, DM, m0, TID());
                gemm_core<0>(ag, ar, WM + (size_t)(i * DM + n0) * DM, DM, DM, lds);
                ACC_FOREACH(ag, { const f32x4 bb = *(const f32x4*)(BM_ + i * DM + n0 + c_);
                    store_bf4(TMP + r_ * 128 + c_, (f32x4){sigmoidf_(v_[0] + bb[0]), sigmoidf_(v_[1] + bb[1]), sigmoidf_(v_[2] + bb[2]), sigmoidf_(v_[3] + bb[3])}); });
            }
            f32x4 ab[4][4]; acc_zero(ab);
            if (i == 0) { const ARows ar = plain_rows(c.POOLED, 512, m0, TID()); gemm_core<0>(ab, ar, BR + (size_t)n0 * 512, 512, 512, lds); }
            else if (i == 1) { const ARows ar = plain_rows(c.F + (size_t)5 * NT * 512, 512, m0, TID()); gemm_core<0>(ab, ar, BR + (size_t)1024 * 512 + (size_t)n0 * 512, 512, 512, lds); }
            else { const ARows ar = plain_rows(c.PROJ + C_Q, IN_COLS, m0, TID()); gemm_core<0>(ab, ar, BR + (size_t)2048 * 512 + (size_t)n0 * 1024, 1024, 1024, lds); }
            ACC_FOREACH(ab, {
                bf16_t* q = c.MERGED + (size_t)(m0 + r_) * DM + n0 + c_;
                const u32x2 gv = *(const u32x2*)(TMP + r_ * 128 + c_);
                f32x4 m4 = ((f32x4){0.f, 0.f, 0.f, 0.f});
                if (i > 0) { const u32x2 pv = *(const u32x2*)q; m4 = ((f32x4){bflo(pv.x), bfhi(pv.x), bflo(pv.y), bfhi(pv.y)}); }
                m4[0] += bflo(gv.x) * v_[0]; m4[1] += bfhi(gv.x) * v_[1]; m4[2] += bflo(gv.y) * v_[2]; m4[3] += bfhi(gv.y) * v_[3];
                store_bf4(q, m4); });
        }
    }
}

DI void phase_outp(const Ctx& c, unsigned char* lds) {
    const int nM = NT / 256, nN = DM / 128;
    const bf16_t* W = (const bf16_t*)(c.ws + WS_WT_OUT);
    const float* xin = (c.l == 0) ? c.in(I_X) : c.out;
    for (int it = 0;; ++it) {
        int tm, tn; if (!xcd_unit(it, nN, tm, tn)) break;
        const int m0 = tm * 256, n0 = tn * 128;
        f32x4 acc[4][4]; acc_zero(acc);
        const ARows ar = plain_rows(c.MERGED, DM, m0, TID());
        gemm_core<0>(acc, ar, W + (size_t)n0 * DM, DM, DM, lds);
        ACC_FOREACH(acc, { const size_t o = (size_t)(m0 + r_) * DM + n0 + c_; const f32x4 x = *(const f32x4*)(xin + o); *(f32x4*)(c.out + o) = x + v_; });
    }
    for (int it = blockIdx.x * 4; it < 3 * 32 * 64; it += gridDim.x * 4) {
        const int mat = it / 2048, e = (it >> 6) & 31, tl = it & 63;
        if (mat == 0) convert_tile4(c.in(I_EG) + ((size_t)c.l * 32 + e) * DM * 256, 256, 256, DM, (bf16_t*)(c.ws + WS_EG) + (size_t)e * 256 * DM, tl, lds);
        else if (mat == 1) convert_tile4(c.in(I_EU) + ((size_t)c.l * 32 + e) * DM * 256, 256, 256, DM, (bf16_t*)(c.ws + WS_EU) + (size_t)e * 256 * DM, tl, lds);
        else convert_tile4(c.in(I_ED) + ((size_t)c.l * 32 + e) * 256 * DM, DM, DM, 256, (bf16_t*)(c.ws + WS_ED) + (size_t)e * DM * 256, tl, lds);
    }
}

DI void phase_norm2(const Ctx& c) {
    const int tid = TID(), lane = tid & 63, wave = tid >> 6;
    const float* gain = c.in(I_NFFN) + c.l * DM;
    const float* wrg = c.in(I_WRG) + (size_t)c.l * DM * 4; const float* brg = c.in(I_BRG) + c.l * 4;
    const float* wre = c.in(I_WRE) + (size_t)c.l * DM * 32; const float* bre = c.in(I_BRE) + c.l * 32;
    unsigned* cnt = c.ctl + CW_CNT + c.l * 32;
    for (int row = blockIdx.x * 8 + wave; row < NT; row += gridDim.x * 8) {
        f32x4 v[4];
        float ss = 0.f;
#pragma unroll
        for (int i = 0; i < 4; ++i) { v[i] = *(const f32x4*)(c.out + (size_t)row * DM + i * 256 + lane * 4); ss += v[i][0] * v[i][0] + v[i][1] * v[i][1] + v[i][2] * v[i][2] + v[i][3] * v[i][3]; }
        ss = wave_sum_dpp(ss);
        const float rs = rsqrtf(ss * (1.0f / DM) + 1e-6f);
#pragma unroll
        for (int i = 0; i < 4; ++i) {
            const f32x4 g = *(const f32x4*)(gain + i * 256 + lane * 4);
            v[i] = (f32x4){v[i][0] * rs * g[0], v[i][1] * rs * g[1], v[i][2] * rs * g[2], v[i][3] * rs * g[3]};
            store_bf4(c.H + (size_t)row * DM + i * 256 + lane * 4, v[i]);
        }
        float lgp[4] = {0.f, 0.f, 0.f, 0.f};
#pragma unroll
        for (int i = 0; i < 4; ++i)
#pragma unroll
            for (int j = 0; j < 4; ++j) { const f32x4 w = *(const f32x4*)(wrg + (size_t)(i * 256 + lane * 4 + j) * 4); lgp[0] += v[i][j] * w[0]; lgp[1] += v[i][j] * w[1]; lgp[2] += v[i][j] * w[2]; lgp[3] += v[i][j] * w[3]; }
#pragma unroll
        for (int o = 0; o < 4; ++o) lgp[o] = wave_sum_dpp(lgp[o]) + brg[o];
        int grp = 0; float gm = lgp[0];
#pragma unroll
        for (int o = 1; o < 4; ++o) if (lgp[o] > gm) { gm = lgp[o]; grp = o; }
        float gs = 0.f;
#pragma unroll
        for (int o = 0; o < 4; ++o) gs += __expf(lgp[o] - gm);
        const float ptop = 1.0f / gs;
        float le[8] = {0.f, 0.f, 0.f, 0.f, 0.f, 0.f, 0.f, 0.f};
#pragma unroll
        for (int i = 0; i < 4; ++i)
#pragma unroll
            for (int j = 0; j < 4; ++j) {
                const float* wp = wre + (size_t)(i * 256 + lane * 4 + j) * 32 + grp * 8;
                const f32x4 w0 = *(const f32x4*)wp, w1 = *(const f32x4*)(wp + 4);
                le[0] += v[i][j] * w0[0]; le[1] += v[i][j] * w0[1]; le[2] += v[i][j] * w0[2]; le[3] += v[i][j] * w0[3];
                le[4] += v[i][j] * w1[0]; le[5] += v[i][j] * w1[1]; le[6] += v[i][j] * w1[2]; le[7] += v[i][j] * w1[3];
            }
#pragma unroll
        for (int o = 0; o < 8; ++o) le[o] = wave_sum_dpp(le[o]) + bre[grp * 8 + o];
        int i0 = 0; float v0 = le[0];
#pragma unroll
        for (int o = 1; o < 8; ++o) if (le[o] > v0) { v0 = le[o]; i0 = o; }
        int i1 = -1; float v1 = -INFINITY;
#pragma unroll
        for (int o = 0; o < 8; ++o) if (o != i0 && le[o] > v1) { v1 = le[o]; i1 = o; }
        const float e1 = __expf(v1 - v0), inv = 1.0f / (1.0f + e1);
        if (lane == 0) {
            int* rt = c.ROUTE + (size_t)row * 8;
            const int ex0 = grp * 8 + i0, ex1 = grp * 8 + i1;
            rt[0] = ex0; rt[1] = ex1; ((float*)rt)[2] = inv * ptop; ((float*)rt)[3] = e1 * inv * ptop;
            atomicAdd(cnt + ex0, 1u); atomicAdd(cnt + ex1, 1u);
        }
    }
}
DI void phase_route2(const Ctx& c, unsigned char* lds) {
    int* soff = (int*)lds;
    const unsigned* cnt = c.ctl + CW_CNT + c.l * 32;
    unsigned* cur = c.ctl + CW_CUR + c.l * 32;
    __syncthreads();
    if (TID() == 0) { int s = 0; for (int e = 0; e < 32; ++e) { soff[e] = s; s += (int)cnt[e]; } }
    __syncthreads();
    for (int t = blockIdx.x * NTHREADS + TID(); t < NT; t += gridDim.x * NTHREADS) {
        int* rt = c.ROUTE + (size_t)t * 8;
#pragma unroll
        for (int s = 0; s < 2; ++s) {
            const int e = rt[s];
            const int p = soff[e] + (int)atomicAdd(cur + e, 1u);
            rt[4 + s] = p;
            c.ENT[2 * p] = t; ((float*)c.ENT)[2 * p + 1] = ((const float*)rt)[2 + s];
        }
    }
}
DI void moe_tables(const Ctx& c, int* soff, int* stile, int ncol) {
    const unsigned* cnt = c.ctl + CW_CNT + c.l * 32;
    __syncthreads();
    if (TID() == 0) { int s = 0, tt = 0; for (int e = 0; e < 32; ++e) { soff[e] = s; stile[e] = tt; s += (int)cnt[e]; tt += (((int)cnt[e] + 255) >> 8) * ncol; } soff[32] = s; stile[32] = tt; }
    __syncthreads();
}
DI void phase_moe_up(const Ctx& c, unsigned char* lds) {
    int* soff = (int*)(lds + 2 * G_STAGE); int* stile = soff + 64;
    moe_tables(c, soff, stile, 2);
    const int total = stile[32];
    for (int item = blockIdx.x; item < total; item += gridDim.x) {
        int e = 0;
        for (int q = 1; q < 32; ++q) if (stile[q] <= item) e = q;
        const int loc = item - stile[e], tm = loc >> 1, tn = loc & 1, n0 = tn * 128;
        const int p0 = soff[e] + tm * 256, pend = soff[e + 1];
        ARows ar; ar.mu = nullptr; ar.ltype = 0; ar.first = 0;
#pragma unroll
        for (int i = 0; i < 4; ++i) { const int pr = p0 + (TID() >> 3) + 64 * i; ar.p[i] = (pr < pend) ? c.H + (size_t)c.ENT[2 * pr] * DM : nullptr; }
        {
            f32x4 ag[4][4]; acc_zero(ag);
            gemm_core<0>(ag, ar, (const bf16_t*)(c.ws + WS_EG) + ((size_t)e * 256 + n0) * DM, DM, DM, lds);
            ACC_FOREACH(ag, { if (p0 + r_ < pend) store_bf4(c.HID + (size_t)(p0 + r_) * 256 + n0 + c_, (f32x4){v_[0] * sigmoidf_(v_[0]), v_[1] * sigmoidf_(v_[1]), v_[2] * sigmoidf_(v_[2]), v_[3] * sigmoidf_(v_[3])}); });
        }
        f32x4 au[4][4]; acc_zero(au);
        gemm_core<0>(au, ar, (const bf16_t*)(c.ws + WS_EU) + ((size_t)e * 256 + n0) * DM, DM, DM, lds);
        ACC_FOREACH(au, { if (p0 + r_ < pend) { bf16_t* q = c.HID + (size_t)(p0 + r_) * 256 + n0 + c_; const u32x2 sv = *(const u32x2*)q;
            store_bf4(q, (f32x4){bflo(sv.x) * v_[0], bfhi(sv.x) * v_[1], bflo(sv.y) * v_[2], bfhi(sv.y) * v_[3]}); } });
    }
}
DI void phase_moe_down(const Ctx& c, unsigned char* lds) {
    int* soff = (int*)(lds + 2 * G_STAGE); int* stile = soff + 64;
    moe_tables(c, soff, stile, 8);
    const int total = stile[32];
    for (int item = blockIdx.x; item < total; item += gridDim.x) {
        int e = 0;
        for (int q = 1; q < 32; ++q) if (stile[q] <= item) e = q;
        const int loc = item - stile[e], tm = loc >> 3, tn = loc & 7, n0 = tn * 128;
        const int p0 = soff[e] + tm * 256, pend = soff[e + 1];
        ARows ar; ar.mu = nullptr; ar.ltype = 0; ar.first = 0;
#pragma unroll
        for (int i = 0; i < 4; ++i) { const int pr = p0 + (TID() >> 3) + 64 * i; ar.p[i] = (pr < pend) ? c.HID + (size_t)pr * 256 : nullptr; }
        f32x4 acc[4][4]; acc_zero(acc);
        gemm_core<0>(acc, ar, (const bf16_t*)(c.ws + WS_ED) + ((size_t)e * DM + n0) * 256, 256, 256, lds);
        ACC_FOREACH(acc, { if (p0 + r_ < pend) { const float w = ((const float*)c.ENT)[2 * (p0 + r_) + 1];
            store_bf4(c.Y + (size_t)(p0 + r_) * DM + n0 + c_, (f32x4){v_[0] * w, v_[1] * w, v_[2] * w, v_[3] * w}); } });
    }
}
DI void phase_final(const Ctx& c) {
    const int tid = TID(), lane = tid & 63, wave = tid >> 6;
    const float* gain = c.in(I_NFIN);
    for (int row = blockIdx.x * 8 + wave; row < NT; row += gridDim.x * 8) {
        f32x4 v[4];
#pragma unroll
        for (int i = 0; i < 4; ++i) v[i] = *(const f32x4*)(c.out + (size_t)row * DM + i * 256 + lane * 4);
        add_moe_rows(c, row, lane, v);
        float ss = 0.f;
#pragma unroll
        for (int i = 0; i < 4; ++i) ss += v[i][0] * v[i][0] + v[i][1] * v[i][1] + v[i][2] * v[i][2] + v[i][3] * v[i][3];
        ss = wave_sum_dpp(ss);
        const float rs = rsqrtf(ss * (1.0f / DM) + 1e-6f);
#pragma unroll
        for (int i = 0; i < 4; ++i) {
            const f32x4 g = *(const f32x4*)(gain + i * 256 + lane * 4);
            *(f32x4*)(c.out + (size_t)row * DM + i * 256 + lane * 4) = (f32x4){v[i][0] * rs * g[0], v[i][1] * rs * g[1], v[i][2] * rs * g[2], v[i][3] * rs * g[3]};
        }
    }
}

constexpr int PH_PER_LAYER = 12, N_PHASES = DEPTH * PH_PER_LAYER + 1;
__global__ void __launch_bounds__(NTHREADS, 2) fwd_kernel(Params P) {
    extern __shared__ __attribute__((aligned(16))) unsigned char lds[];
    const int lo = P.ph_lo, hi = P.ph_hi;
    LAS unsigned* xbw = (LAS unsigned*)(lds + LDS_BYTES - 16);
    if (threadIdx.x == 0) { xbw[0] = 0u; xbw[1] = 0u; xbw[2] = 0u; xbw[3] = 0u; }
    __syncthreads();
    Ctx c; c.P = &P; c.ws = P.ws; c.out = P.out; c.l = 0;
    c.ctl = (unsigned*)(P.ws + WS_CTL);
    c.H = (bf16_t*)(P.ws + WS_H); c.PROJ = (bf16_t*)(P.ws + WS_PROJ); c.F = (bf16_t*)(P.ws + WS_F); c.POOLED = (bf16_t*)(P.ws + WS_POOLED);
    c.MERGED = (bf16_t*)(P.ws + WS_F); c.CMPH = (bf16_t*)(P.ws + WS_CMPH); c.CMPO = (float*)(P.ws + WS_CMPO); c.POSB = (float*)(P.ws + WS_POSB);
    c.ROUTE = (int*)(P.ws + WS_ROUTE); c.ENT = (int*)(P.ws + WS_ENT); c.HID = (bf16_t*)(P.ws + WS_HID); c.Y = (bf16_t*)(P.ws + WS_Y);
    c.VT = (bf16_t*)(P.ws + WS_VT); c.KC = (bf16_t*)(P.ws + WS_KC); c.VCT = (bf16_t*)(P.ws + WS_VCT); c.YRAW = (bf16_t*)(P.ws + WS_YRAW); c.BON = (float*)(P.ws + WS_BON);
    XcdBarrier bar; bar.bar = c.ctl + CW_BAR; bar.x = 0; bar.st = (volatile LAS unsigned*)xbw;
    if (hi - lo > 1) bar = xcd_barrier_post(c.ctl + CW_BAR, (volatile LAS unsigned*)xbw);
#define IN(k) (lo <= (k) && (k) < hi)
#define SEAM(k) do { if (IN(k) && IN((k) + 1)) xcd_barrier(bar); } while (0)
#pragma unroll 1
    for (int l = 0; l < DEPTH; ++l) {
        c.l = l; const int pb = l * PH_PER_LAYER;
        if (IN(pb + 0)) phase_norm1(c, lds);
        SEAM(pb + 0);
        if (IN(pb + 1)) phase_gemm1(c, lds);
        SEAM(pb + 1);
        if (IN(pb + 2)) phase_prep(c, lds);
        SEAM(pb + 2);
        if (IN(pb + 3)) phase_poolgemm(c, lds);
        SEAM(pb + 3);
        if (IN(pb + 4)) phase_mix(c, lds);
        SEAM(pb + 4);
        if (IN(pb + 5)) phase_rwkv_post(c, lds);
        SEAM(pb + 5);
        if (IN(pb + 6)) phase_merge(c, lds);
        SEAM(pb + 6);
        if (IN(pb + 7)) phase_outp(c, lds);
        SEAM(pb + 7);
        if (IN(pb + 8)) phase_norm2(c);
        SEAM(pb + 8);
        if (IN(pb + 9)) phase_route2(c, lds);
        SEAM(pb + 9);
        if (IN(pb + 10)) phase_moe_up(c, lds);
        SEAM(pb + 10);
        if (IN(pb + 11)) phase_moe_down(c, lds);
        SEAM(pb + 11);
    }
    if (IN(N_PHASES - 1)) phase_final(c);
}

#ifndef MK_N_LAUNCHES
#define MK_N_LAUNCHES 1
#endif
extern "C" void kernel_launch(void* const* d_in, const int* in_sizes, int n_in, void* d_out, int out_size, void* d_ws, size_t ws_size, hipStream_t stream) {
    static int grid = 0;
    if (grid == 0) {
        if (n_in != N_IN || out_size != NT * DM || ws_size < WS_END) { fprintf(stderr, "kernel_launch: unexpected shapes n_in %d out %d ws %zu (need %zu)\n", n_in, out_size, ws_size, (size_t)WS_END); grid = -1; return; }
        int dev = 0, cus = 0, per_cu = 0;
        if (hipGetDevice(&dev) != hipSuccess || hipDeviceGetAttribute(&cus, hipDeviceAttributeMultiprocessorCount, dev) != hipSuccess) { grid = -1; return; }
        if (hipFuncSetAttribute((const void*)fwd_kernel, hipFuncAttributeMaxDynamicSharedMemorySize, LDS_BYTES) != hipSuccess) { fprintf(stderr, "kernel_launch: hipFuncSetAttribute failed\n"); grid = -1; return; }
        if (hipOccupancyMaxActiveBlocksPerMultiprocessor(&per_cu, (const void*)fwd_kernel, NTHREADS, LDS_BYTES) != hipSuccess || per_cu < 1) { fprintf(stderr, "kernel_launch: occupancy query says %d\n", per_cu); }
        (void)hipGetLastError();
        grid = cus;
    }
    if (grid < 0) return;
    if (hipMemsetAsync((char*)d_ws + WS_CTL, 0, CTL_BYTES, stream) != hipSuccess) return;
    Params p{};
    for (int i = 0; i < N_IN; ++i) p.in[i] = (const float*)d_in[i];
    p.out = (float*)d_out; p.ws = (unsigned char*)d_ws;
    if (MK_N_LAUNCHES == 1) {
        p.ph_lo = 0; p.ph_hi = N_PHASES;
        hipLaunchKernelGGL(fwd_kernel, dim3(grid), dim3(NTHREADS), LDS_BYTES, stream, p);
    } else {
        for (int k = 0; k < N_PHASES; ++k) { p.ph_lo = k; p.ph_hi = k + 1; hipLaunchKernelGGL(fwd_kernel, dim3(grid), dim3(NTHREADS), LDS_BYTES, stream, p); }
    }
}
```

```cpp
#include <hip/hip_runtime.h>
#include <cstdio>
#include <cstdint>

#define DI __device__ __forceinline__
typedef unsigned short bf16_t;
typedef short bf16x8 __attribute__((ext_vector_type(8)));
typedef float f32x4 __attribute__((ext_vector_type(4)));
typedef unsigned u32x4 __attribute__((ext_vector_type(4)));
typedef unsigned u32x2 __attribute__((ext_vector_type(2)));

constexpr int NB = 4, SEQ = 4096, DM = 1024, NT = NB * SEQ, DEPTH = 2;
constexpr int IN_COLS = 4816;
constexpr int C_POOL = 0, C_RW = 512, C_R = 512, C_K = 1024, C_V = 1536, C_WD = 2048, C_AD = 2080, C_GD = 2112;
constexpr int C_Q = 2208, C_KC = 3232, C_VC = 3488, C_KS = 3744, C_VS = 4000, C_KW = 4256, C_VW = 4512, C_GATE = 4768;
constexpr int RWC = 1696;
constexpr int NCMP = 255;
constexpr int NTHREADS = 512;
constexpr int LDS_BYTES = 114688;

enum { I_X = 0, I_RELB, I_NMIX, I_WIN, I_POOLW, I_POOLS, I_MU, I_W0, I_WUP, I_A0, I_AUP, I_GUP, I_KK, I_KA, I_RK, I_GNW, I_GNB,
       I_CPK, I_CW1K, I_CW2K, I_CPV, I_CW1V, I_CW2V, I_WBR, I_WMG, I_BMG, I_WOUT, I_NFFN, I_WRG, I_BRG, I_WRE, I_BRE, I_EG, I_EU, I_ED, I_NFIN, N_IN };

constexpr size_t WS_CTL = 0;
constexpr size_t CTL_BYTES = 65536;
constexpr size_t WS_H = CTL_BYTES;
constexpr size_t WS_PROJ = WS_H + (size_t)NT * DM * 2;
constexpr size_t WS_F = WS_PROJ + (size_t)NT * IN_COLS * 2;
constexpr size_t PLANE = (size_t)NT * 512 * 2;
constexpr size_t WS_POOLED = WS_F + 6 * PLANE;
constexpr size_t WS_CMPH = WS_POOLED + PLANE;
constexpr size_t WS_CMPO = WS_CMPH + (size_t)2 * 4096 * 256 * 2;
constexpr size_t WS_POSB = WS_CMPO + (size_t)2 * 4096 * 64 * 4;
constexpr size_t WS_ROUTE = WS_POSB + 4096;
constexpr size_t WS_ENT = WS_ROUTE + (size_t)NT * 32;
constexpr size_t WS_VT = WS_ENT + (size_t)2 * NT * 8;
constexpr size_t WS_KC = WS_VT + (size_t)2 * 16 * 64 * SEQ * 2;
constexpr size_t WS_VCT = WS_KC + (size_t)16 * 256 * 64 * 2;
constexpr size_t WS_YRAW = WS_VCT + (size_t)16 * 64 * 256 * 2;
constexpr size_t WS_BON = WS_YRAW + (size_t)NT * 512 * 2;
constexpr size_t WS_SMALLW = WS_BON + (size_t)NT * 8 * 16;
constexpr size_t WS_WT_LORA = WS_SMALLW + 262144;
constexpr size_t WS_END = WS_WT_LORA + (size_t)1536 * 128 * 2;
constexpr size_t WS_WT_IN = WS_F;
constexpr size_t WS_WT_C1 = WS_CMPO;
constexpr size_t WS_WT_C2 = WS_SMALLW;
constexpr size_t WS_WT_POOL = WS_SMALLW + 131072;
constexpr size_t WS_WT_MG = WS_VT;
constexpr size_t WS_WT_BR = WS_VT + (size_t)3072 * 1024 * 2;
constexpr size_t WS_WT_OUT = WS_CMPH;
constexpr size_t WS_EG = WS_F + 2 * PLANE;
constexpr size_t WS_EU = WS_EG + (size_t)32 * 256 * 1024 * 2;
constexpr size_t WS_ED = WS_EU + (size_t)32 * 256 * 1024 * 2;
static_assert(WS_ED + (size_t)32 * 1024 * 256 * 2 <= WS_F + 6 * PLANE, "expert alias");
static_assert(WS_WT_BR + (size_t)2048 * 1024 * 2 <= WS_VT + (size_t)2 * 16 * 64 * SEQ * 2, "merge alias");
static_assert((size_t)4864 * 1024 * 2 <= 6 * PLANE, "w_in alias");
constexpr size_t WS_HID = WS_PROJ;
constexpr size_t WS_Y = WS_PROJ + (size_t)2 * NT * 256 * 2;
static_assert(WS_Y + (size_t)2 * NT * 1024 * 2 <= WS_F, "alias");
constexpr int CW_BAR = 0;
constexpr int CW_CNT = 4096;
constexpr int CW_CUR = 4096 + 64;
constexpr int CW_Q = 4096 + 128;

#define XB_TMO      128
#define XB_XCNT(j)  (256  + 64 * (j))
#define XB_XSUB(j)  (1280 + 64 * (j))
#define XB_XGEN(j)  (2304 + 64 * (j))
#define XB_TOP      3328
#define XB_TOPGEN   3392
#define XCD_BAR_WORDS 3456
#define XB_SPIN_CAP (1u << 18)
#define LAS __attribute__((address_space(3)))

__device__ __forceinline__ unsigned xb_ld(unsigned* p)              { return __hip_atomic_load(p, __ATOMIC_RELAXED, __HIP_MEMORY_SCOPE_AGENT); }
__device__ __forceinline__ unsigned xb_add(unsigned* p, unsigned v) { return __hip_atomic_fetch_add(p, v, __ATOMIC_RELAXED, __HIP_MEMORY_SCOPE_AGENT); }
__device__ __forceinline__ unsigned xb_xcc_id() { return (unsigned)__builtin_amdgcn_s_getreg((3 << 11) | 20) & 0xFu; }
#define XB_SPIN(cond, bar) do { unsigned _sp = 0; while (cond) { __builtin_amdgcn_s_sleep(1); \
    if ((++_sp & 255u) == 0u) { if (xb_ld(&(bar)[XB_TMO])) break; if (_sp > XB_SPIN_CAP) { atomicAdd(&(bar)[XB_TMO], 1u); break; } } } } while (0)

struct XcdBarrier { unsigned* bar; unsigned x; volatile LAS unsigned* st; };

__device__ __forceinline__ XcdBarrier xcd_barrier_post(unsigned* bar, volatile LAS unsigned* st) {
    XcdBarrier b; b.bar = bar; b.x = xb_xcc_id(); b.st = st;
    if (threadIdx.x == 0) (void)xb_add(&bar[XB_XCNT(b.x)], 1u);
    return b;
}
__device__ __forceinline__ void xcd_barrier_complete(unsigned* bar, unsigned x, unsigned& nloc, unsigned& nx) {
    const unsigned G = gridDim.x * gridDim.y * gridDim.z;
    unsigned sum, cnt, mine, sp = 0u;
    for (;;) {
        sum = 0u; cnt = 0u; mine = 0u;
#pragma unroll
        for (unsigned j = 0; j < 16; ++j) { const unsigned c = xb_ld(&bar[XB_XCNT(j)]); sum += c; cnt += (c > 0u) ? 1u : 0u; mine = (j == x) ? c : mine; }
        if (sum == G) break;
        __builtin_amdgcn_s_sleep(1);
        if ((++sp & 255u) == 0u) { if (xb_ld(&bar[XB_TMO])) break; if (sp > XB_SPIN_CAP) { atomicAdd(&bar[XB_TMO], 1u); break; } }
    }
    nloc = mine > 0u ? mine : 1u; nx = cnt > 0u ? cnt : 1u;
}
__device__ __forceinline__ void xcd_barrier(const XcdBarrier& b) {
    asm volatile("s_waitcnt vmcnt(0)" ::: "memory");
    __syncthreads();
    if (threadIdx.x == 0) {
        unsigned* bar = b.bar;
        __builtin_amdgcn_s_waitcnt(0);
        unsigned nloc = b.st[0], nx = b.st[1];
        if (nloc == 0u) { xcd_barrier_complete(bar, b.x, nloc, nx); b.st[0] = nloc; b.st[1] = nx; }
        const unsigned old = xb_add(&bar[XB_XSUB(b.x)], 1u);
        const unsigned gen = old / nloc;
        if (old + 1u == (gen + 1u) * nloc) {
            __builtin_amdgcn_fence(__ATOMIC_RELEASE, "agent");
            asm volatile("s_waitcnt vmcnt(0)" ::: "memory");
            const unsigned og = xb_add(&bar[XB_TOP], 1u);
            const unsigned tg = og / nx;
            if (og + 1u == (tg + 1u) * nx) xb_add(&bar[XB_TOPGEN], 1u);
            else XB_SPIN(xb_ld(&bar[XB_TOPGEN]) == tg, bar);
            __builtin_amdgcn_fence(__ATOMIC_ACQUIRE, "agent");
            xb_add(&bar[XB_XGEN(b.x)], 1u);
            asm volatile("s_waitcnt vmcnt(0)" ::: "memory");
        } else {
            XB_SPIN(xb_ld(&bar[XB_XGEN(b.x)]) == gen, bar);
            __builtin_amdgcn_fence(__ATOMIC_ACQUIRE, "agent");
            asm volatile("s_waitcnt vmcnt(0)" ::: "memory");
        }
    }
    __syncthreads();
}

DI bf16_t f2bf(float x) { unsigned u = __float_as_uint(x); u += 0x7fffu + ((u >> 16) & 1u); return (bf16_t)(u >> 16); }
DI float bf2f(bf16_t b) { return __uint_as_float((unsigned)b << 16); }
typedef __bf16 bf16v2_t __attribute__((ext_vector_type(2)));
typedef float f32v2_t __attribute__((ext_vector_type(2)));
DI unsigned pack2(float lo, float hi) { const f32v2_t v = {lo, hi}; const bf16v2_t b = __builtin_convertvector(v, bf16v2_t); return __builtin_bit_cast(unsigned, b); }
DI float bflo(unsigned w) { return __uint_as_float(w << 16); }
DI float bfhi(unsigned w) { return __uint_as_float(w & 0xffff0000u); }
DI float wave_sum(float v) {
#pragma unroll
    for (int o = 32; o >= 1; o >>= 1) v += __shfl_xor(v, o);
    return v;
}
DI float wave_max(float v) {
#pragma unroll
    for (int o = 32; o >= 1; o >>= 1) v = fmaxf(v, __shfl_xor(v, o));
    return v;
}
DI float sigmoidf_(float x) { return __builtin_amdgcn_rcpf(1.0f + __expf(-x)); }
DI int TID() { int t = threadIdx.x; asm volatile("" : "+v"(t)); return t; }
#define LDS_WAVE_SYNC() asm volatile("s_waitcnt lgkmcnt(0)" ::: "memory")

#define DPP_MOV(v, ctrl) __builtin_bit_cast(float, __builtin_amdgcn_update_dpp(0, __builtin_bit_cast(int, (v)), (ctrl), 0xF, 0xF, true))
DI float wave_sum_dpp(float v) {
    v += DPP_MOV(v, 0xB1); v += DPP_MOV(v, 0x4E); v += DPP_MOV(v, 0x141); v += DPP_MOV(v, 0x140);
    return __builtin_bit_cast(float, __builtin_amdgcn_readlane(__builtin_bit_cast(int, v), 0)) + __builtin_bit_cast(float, __builtin_amdgcn_readlane(__builtin_bit_cast(int, v), 16)) +
        (__builtin_bit_cast(float, __builtin_amdgcn_readlane(__builtin_bit_cast(int, v), 32)) + __builtin_bit_cast(float, __builtin_amdgcn_readlane(__builtin_bit_cast(int, v), 48)));
}
struct Params { const float* in[N_IN]; float* out; unsigned char* ws; int ph_lo, ph_hi; };

DI int t5_bucket(int n) {
    if (n < 16) return n;
    if (n >= 128) return 31;
    int b = 16;
    b += (n >= 19) + (n >= 21) + (n >= 24) + (n >= 27) + (n >= 31) + (n >= 35) + (n >= 40) + (n >= 46) + (n >= 52) + (n >= 59) + (n >= 67) + (n >= 77) + (n >= 87) + (n >= 99) + (n >= 113);
    return b;
}

constexpr int G_A = 0, G_B = 256 * 64 * 2, G_STAGE = (256 + 128) * 64 * 2;
static_assert(2 * G_STAGE <= LDS_BYTES - 64, "gemm lds");
DI int g_off(int r, int c) { return ((r >> 4) * 2 + (c >> 5)) * 1024 + ((((r & 15) * 64) + (c & 31) * 2) ^ ((((r & 15) >> 3) & 1) << 5)); }
struct ARows { const bf16_t* p[4]; const float* mu; int ltype; int first; };
DI float tanhf_fast(float x) { const float e = __expf(2.0f * x); return 1.0f - 2.0f * __builtin_amdgcn_rcpf(e + 1.0f); }
DI u32x4 lora_chunk(const bf16_t* prow, bool first, const float* mu, int ltype, int k) {
    const int lim = (ltype == 2) ? 96 : 32;
    if (k >= lim) return (u32x4){0u, 0u, 0u, 0u};
    const int col = C_WD + ltype * 32 + k;
    const u32x4 cu = *(const u32x4*)(prow + col);
    u32x4 pu = (u32x4){0u, 0u, 0u, 0u};
    if (!first) pu = *(const u32x4*)(prow - IN_COLS + col);
    const f32x4 m0 = *(const f32x4*)(mu + col - C_RW), m1 = *(const f32x4*)(mu + col - C_RW + 4);
    float u[8] = {bflo(cu.x), bfhi(cu.x), bflo(cu.y), bfhi(cu.y), bflo(cu.z), bfhi(cu.z), bflo(cu.w), bfhi(cu.w)};
    const float p[8] = {bflo(pu.x), bfhi(pu.x), bflo(pu.y), bfhi(pu.y), bflo(pu.z), bfhi(pu.z), bflo(pu.w), bfhi(pu.w)};
    const float mm[8] = {m0[0], m0[1], m0[2], m0[3], m1[0], m1[1], m1[2], m1[3]};
#pragma unroll
    for (int j = 0; j < 8; ++j) { const float us = u[j] + (p[j] - u[j]) * mm[j]; u[j] = (ltype == 0) ? tanhf_fast(us) : ((ltype == 1) ? us : __builtin_amdgcn_rcpf(1.0f + __expf(-us))); }
    u32x4 w; w.x = pack2(u[0], u[1]); w.y = pack2(u[2], u[3]); w.z = pack2(u[4], u[5]); w.w = pack2(u[6], u[7]);
    return w;
}
template <int AMODE>
DI void g_load(u32x4 (&ra)[4], u32x4 (&rb)[2], const ARows& ar, const bf16_t* bt, int ldb, int k0, int tid) {
    const int kseg = (tid & 7) * 8;
#pragma unroll
    for (int i = 0; i < 4; ++i) {
        ra[i] = (u32x4){0u, 0u, 0u, 0u};
        if (AMODE == 2) ra[i] = lora_chunk(ar.p[i], (ar.first >> i) & 1, ar.mu, ar.ltype, k0 + kseg);
        else if (ar.p[i] != nullptr) ra[i] = *(const u32x4*)((AMODE == 0) ? (ar.p[i] + k0 + kseg) : (ar.p[i] + (size_t)(k0 >> 6) * IN_COLS + kseg));
    }
#pragma unroll
    for (int i = 0; i < 2; ++i) rb[i] = *(const u32x4*)(bt + (size_t)((tid >> 3) + 64 * i) * ldb + k0 + kseg);
}
DI void g_store(unsigned char* st, const u32x4 (&ra)[4], const u32x4 (&rb)[2], int tid) {
    const int off = g_off(tid >> 3, (tid & 7) * 8);
#pragma unroll
    for (int i = 0; i < 4; ++i) *(u32x4*)(st + G_A + off + i * 8192) = ra[i];
#pragma unroll
    for (int i = 0; i < 2; ++i) *(u32x4*)(st + G_B + off + i * 8192) = rb[i];
}
DI void g_compute(f32x4 (&acc)[4][4], const unsigned char* st, int lane, int wm, int wn) {
    const int lo = ((lane & 15) * 64 + (lane >> 4) * 16) ^ ((((lane & 15) >> 3) & 1) << 5);
    const unsigned char* sA = st + G_A + wm * 8192 + lo;
    const unsigned char* sB = st + G_B + wn * 8192 + lo;
    bf16x8 bcur[4], bnxt[4], a0, a1, a2;
#pragma unroll
    for (int i = 0; i < 4; ++i) bcur[i] = *(const bf16x8*)(sB + i * 2048);
    a0 = *(const bf16x8*)(sA);
    a1 = *(const bf16x8*)(sA + 2048);
#define G_AFRAG(s) (*(const bf16x8*)(sA + ((s) & 3) * 2048 + ((s) >> 2) * 1024))
#define G_GROUP(s, acur, anew) do { \
        if ((s) + 2 < 8) anew = G_AFRAG((s) + 2); \
        if ((s) < 4) bnxt[(s) & 3] = *(const bf16x8*)(sB + ((s) & 3) * 2048 + 1024); \
        __builtin_amdgcn_sched_barrier(0); \
        _Pragma("unroll") for (int ni = 0; ni < 4; ++ni) acc[(s) & 3][ni] = __builtin_amdgcn_mfma_f32_16x16x32_bf16(((s) < 4 ? bcur[ni] : bnxt[ni]), acur, acc[(s) & 3][ni], 0, 0, 0); \
        __builtin_amdgcn_sched_barrier(0); } while (0)
    G_GROUP(0, a0, a2); G_GROUP(1, a1, a0); G_GROUP(2, a2, a1); G_GROUP(3, a0, a2);
    G_GROUP(4, a1, a0); G_GROUP(5, a2, a1); G_GROUP(6, a0, a2); G_GROUP(7, a1, a0);
#undef G_GROUP
#undef G_AFRAG
}
#define LDS_BARRIER() do { asm volatile("s_waitcnt lgkmcnt(0)" ::: "memory"); __builtin_amdgcn_s_barrier(); asm volatile("" ::: "memory"); } while (0)
template <int AMODE>
DI void gemm_core(f32x4 (&acc)[4][4], const ARows& ar, const bf16_t* bt  , int ldb, int K, unsigned char* lds) {
    const int tid = TID(), lane = tid & 63, wave = tid >> 6, wm = wave >> 1, wn = wave & 1;
    const int nk = K >> 6;
    unsigned char* s0 = lds; unsigned char* s1 = lds + G_STAGE;
    u32x4 ra0[4], rb0[2], ra1[4], rb1[2];
    g_load<AMODE>(ra0, rb0, ar, bt, ldb, 0, tid);
    g_load<AMODE>(ra1, rb1, ar, bt, ldb, 64, tid);
    __syncthreads();
    g_store(s0, ra0, rb0, tid);
    g_load<AMODE>(ra0, rb0, ar, bt, ldb, (nk > 2 ? 2 : nk - 1) * 64, tid);
    LDS_BARRIER();
    for (int kt = 0; kt < nk; kt += 2) {
        g_store(s1, ra1, rb1, tid);
        { const int kn = (kt + 3 < nk) ? kt + 3 : nk - 1; g_load<AMODE>(ra1, rb1, ar, bt, ldb, kn * 64, tid); }
        g_compute(acc, s0, lane, wm, wn);
        LDS_BARRIER();
        g_store(s0, ra0, rb0, tid);
        { const int kn = (kt + 4 < nk) ? kt + 4 : nk - 1; g_load<AMODE>(ra0, rb0, ar, bt, ldb, kn * 64, tid); }
        g_compute(acc, s1, lane, wm, wn);
        LDS_BARRIER();
    }
}
DI void acc_zero(f32x4 (&acc)[4][4]) {
#pragma unroll
    for (int i = 0; i < 4; ++i)
#pragma unroll
        for (int j = 0; j < 4; ++j) acc[i][j] = (f32x4){0.f, 0.f, 0.f, 0.f};
}
#define ACC_FOREACH(acc, body) do { const int _l = TID() & 63, _w = TID() >> 6; \
    _Pragma("unroll") for (int _mi = 0; _mi < 4; ++_mi) _Pragma("unroll") for (int _ni = 0; _ni < 4; ++_ni) { \
        const int r_ = (_w >> 1) * 64 + _mi * 16 + (_l & 15), c_ = (_w & 1) * 64 + _ni * 16 + (_l >> 4) * 4; f32x4& v_ = acc[_mi][_ni]; body } } while (0)
DI ARows plain_rows(const bf16_t* base, size_t ld, int m0, int tid) { ARows a; a.mu = nullptr; a.ltype = 0; a.first = 0;
#pragma unroll
    for (int i = 0; i < 4; ++i) a.p[i] = base + (size_t)(m0 + (tid >> 3) + 64 * i) * ld;
    return a; }

DI void store_bf4(bf16_t* p, f32x4 v) { u32x2 w; w.x = pack2(v[0], v[1]); w.y = pack2(v[2], v[3]); *(u32x2*)p = w; }

DI void convert_tile4(const float* src, int ld, int N, int K, bf16_t* dst, int tile0, unsigned char* lds, int Kvalid = 1 << 30) {
    const int tid = TID();
    const int nkt = K >> 6;
    const int r = tid >> 3, seg = (tid & 7) * 8;
    f32x4 a[4], b[4];
#pragma unroll
    for (int u = 0; u < 4; ++u) {
        const int tile = tile0 + u, k0 = (tile % nkt) * 64, n0 = (tile / nkt) * 64;
        a[u] = (f32x4){0.f, 0.f, 0.f, 0.f}; b[u] = a[u];
        if (n0 + seg < N && k0 + r < Kvalid) { const float* q = src + (size_t)(k0 + r) * ld + n0 + seg; a[u] = *(const f32x4*)q; b[u] = *(const f32x4*)(q + 4); }
    }
    __syncthreads();
#pragma unroll
    for (int u = 0; u < 4; ++u) { bf16_t* T = (bf16_t*)lds + u * 64 * 72;
        u32x4 w; w.x = pack2(a[u][0], a[u][1]); w.y = pack2(a[u][2], a[u][3]); w.z = pack2(b[u][0], b[u][1]); w.w = pack2(b[u][2], b[u][3]); *(u32x4*)(T + r * 72 + seg) = w; }
    __syncthreads();
#pragma unroll
    for (int u = 0; u < 4; ++u) { const bf16_t* T = (const bf16_t*)lds + u * 64 * 72;
        const int tile = tile0 + u, k0 = (tile % nkt) * 64, n0 = (tile / nkt) * 64;
        u32x4 o;
        o.x = (unsigned)T[(seg + 0) * 72 + r] | ((unsigned)T[(seg + 1) * 72 + r] << 16); o.y = (unsigned)T[(seg + 2) * 72 + r] | ((unsigned)T[(seg + 3) * 72 + r] << 16);
        o.z = (unsigned)T[(seg + 4) * 72 + r] | ((unsigned)T[(seg + 5) * 72 + r] << 16); o.w = (unsigned)T[(seg + 6) * 72 + r] | ((unsigned)T[(seg + 7) * 72 + r] << 16);
        *(u32x4*)(dst + (size_t)(n0 + r) * K + k0 + seg) = o; }
}
struct Ctx {
    const Params* P; unsigned char* ws; float* out; int l;
    bf16_t* H; bf16_t* PROJ; bf16_t* F; bf16_t* POOLED; bf16_t* MERGED; bf16_t* CMPH; float* CMPO; float* POSB; int* ROUTE; int* ENT; bf16_t* HID; bf16_t* Y; bf16_t* VT; bf16_t* KC; bf16_t* VCT; bf16_t* YRAW; float* BON; unsigned* ctl;
    DI const float* in(int i) const { return P->in[i]; }
};

DI void add_moe_rows(const Ctx& c, int row, int lane, f32x4 (&v)[4]) {
    const int* rt = c.ROUTE + (size_t)row * 8;
    const int p0 = rt[4], p1 = rt[5];
    const bf16_t* y0 = c.Y + (size_t)p0 * DM; const bf16_t* y1 = c.Y + (size_t)p1 * DM;
#pragma unroll
    for (int i = 0; i < 4; ++i) {
        const u32x2 a = *(const u32x2*)(y0 + i * 256 + lane * 4), b = *(const u32x2*)(y1 + i * 256 + lane * 4);
        v[i][0] += bflo(a.x) + bflo(b.x); v[i][1] += bfhi(a.x) + bfhi(b.x); v[i][2] += bflo(a.y) + bflo(b.y); v[i][3] += bfhi(a.y) + bfhi(b.y);
    }
}
DI void phase_norm1(const Ctx& c, unsigned char* lds) {
    const int tid = TID(), lane = tid & 63, wave = tid >> 6;
    const float* gain = c.in(I_NMIX) + c.l * DM;
    const float* src = (c.l == 0) ? c.in(I_X) : c.out;
    for (int row = blockIdx.x * 8 + wave; row < NT; row += gridDim.x * 8) {
        f32x4 v[4];
#pragma unroll
        for (int i = 0; i < 4; ++i) v[i] = *(const f32x4*)(src + (size_t)row * DM + i * 256 + lane * 4);
        if (c.l > 0) {
            add_moe_rows(c, row, lane, v);
#pragma unroll
            for (int i = 0; i < 4; ++i) *(f32x4*)(c.out + (size_t)row * DM + i * 256 + lane * 4) = v[i];
        }
        float ss = 0.f;
#pragma unroll
        for (int i = 0; i < 4; ++i) ss += v[i][0] * v[i][0] + v[i][1] * v[i][1] + v[i][2] * v[i][2] + v[i][3] * v[i][3];
        ss = wave_sum_dpp(ss);
        const float rs = rsqrtf(ss * (1.0f / DM) + 1e-6f);
#pragma unroll
        for (int i = 0; i < 4; ++i) {
            const f32x4 g = *(const f32x4*)(gain + i * 256 + lane * 4);
            store_bf4(c.H + (size_t)row * DM + i * 256 + lane * 4, (f32x4){v[i][0] * rs * g[0], v[i][1] * rs * g[1], v[i][2] * rs * g[2], v[i][3] * rs * g[3]});
        }
    }
    for (int idx = blockIdx.x * 8 + wave; idx < 512; idx += gridDim.x * 8) {
        const int kv = idx >> 8, n = idx & 255;
        const float* pos = c.in(kv ? I_CPV : I_CPK) + (size_t)c.l * 2048;
        const float* w1 = c.in(kv ? I_CW1V : I_CW1K) + (size_t)c.l * 2048 * 256;
        float s = 0.f;
        for (int k = lane; k < 2048; k += 64) s += pos[k] * w1[(size_t)k * 256 + n];
        s = wave_sum_dpp(s);
        if (lane == 0) c.POSB[kv * 256 + n] = s;
    }
    for (int it = blockIdx.x * 4; it < 1216 + 256 + 16 + 16 + 48; it += gridDim.x * 4) {
        if (it < 1216) convert_tile4(c.in(I_WIN) + (size_t)c.l * DM * IN_COLS, IN_COLS, IN_COLS, DM, (bf16_t*)(c.ws + WS_WT_IN), it, lds);
        else if (it < 1216 + 256) { const int j = it - 1216, kv = j >> 7; convert_tile4(c.in(kv ? I_CW1V : I_CW1K) + (size_t)c.l * 2048 * 256, 256, 256, 2048, (bf16_t*)(c.ws + WS_WT_C1) + (size_t)kv * 256 * 2048, j & 127, lds); }
        else if (it < 1216 + 256 + 16) { const int j = it - 1472, kv = j >> 3; convert_tile4(c.in(kv ? I_CW2V : I_CW2K) + (size_t)c.l * 256 * 64, 64, 64, 256, (bf16_t*)(c.ws + WS_WT_C2) + (size_t)kv * 128 * 256, j & 7, lds); }
        else if (it < 1504) { const int j = it - 1488, gi = j >> 2; convert_tile4(c.in(I_POOLW) + ((size_t)c.l * 4 + gi) * 128 * 128, 128, 128, 128, (bf16_t*)(c.ws + WS_WT_POOL) + (size_t)gi * 128 * 128, 0, lds); }
        else { const int j = it - 1504, ty = j >> 4; bf16_t* dst = (bf16_t*)(c.ws + WS_WT_LORA) + (size_t)ty * 512 * 128;
            if (ty == 0) convert_tile4(c.in(I_WUP) + (size_t)c.l * 32 * 512, 512, 512, 128, dst, j & 15, lds, 32);
            else if (ty == 1) convert_tile4(c.in(I_AUP) + (size_t)c.l * 32 * 512, 512, 512, 128, dst, j & 15, lds, 32);
            else convert_tile4(c.in(I_GUP) + (size_t)c.l * 96 * 512, 512, 512, 128, dst, j & 15, lds, 96); }
    }
}

constexpr int EPS = 136;
DI void tile_store_bf16(f32x4 (&acc)[4][4], bf16_t* out, size_t ld, int nrows, int ncols, unsigned char* lds) {
    bf16_t* T = (bf16_t*)lds;
    const int tid = TID();
    __syncthreads();
    ACC_FOREACH(acc, { store_bf4(T + r_ * EPS + c_, v_); });
    __syncthreads();
#pragma unroll
    for (int i = 0; i < 8; ++i) {
        const int ch = tid + i * NTHREADS, r = ch >> 4, cc = (ch & 15) * 8;
        if (r < nrows && cc < ncols) *(u32x4*)(out + (size_t)r * ld + cc) = *(const u32x4*)(T + r * EPS + cc);
    }
}
DI bool xcd_unit(int it, int nN, int& tm, int& tn) {
    const int G = gridDim.x;
    if ((G & 7) != 0 || G < 8) { const int u = it * G + blockIdx.x; if (u >= 64 * nN) return false; tm = u % 64; tn = u / 64; return true; }
    const int x = blockIdx.x & 7, i = blockIdx.x >> 3, per = G >> 3;
    const int u = it * per + i;
    if (u >= 8 * nN) return false;
    tm = x * 8 + (u & 7); tn = u >> 3; return true;
}
DI void phase_gemm1(const Ctx& c, unsigned char* lds) {
    const int nM = NT / 256, nN = (IN_COLS + 127) / 128;
    const bf16_t* WT = (const bf16_t*)(c.ws + WS_WT_IN);
    for (int it = 0;; ++it) {
        int tm, tn; if (!xcd_unit(it, nN, tm, tn)) break;
        const int m0 = tm * 256, n0 = tn * 128;
        f32x4 acc[4][4]; acc_zero(acc);
        const ARows ar = plain_rows(c.H, DM, m0, TID());
        gemm_core<0>(acc, ar, WT + (size_t)n0 * DM, DM, DM, lds);
        tile_store_bf16(acc, c.PROJ + (size_t)m0 * IN_COLS + n0, IN_COLS, 256, (IN_COLS - n0 < 128) ? IN_COLS - n0 : 128, lds);
    }
}

DI float gelu_tanh(float x) { const float u = 0.7978845608028654f * (x + 0.044715f * x * x * x); const float e = __expf(2.0f * u); return x * (1.0f - __builtin_amdgcn_rcpf(e + 1.0f)); }
DI float softplusf_(float x) { return (x > 20.f) ? x : __logf(1.0f + __expf(x)); }
DI float tanhf_(float x) { const float e = __expf(2.0f * x); return 1.0f - 2.0f * __builtin_amdgcn_rcpf(e + 1.0f); }
constexpr int TKP = 8;
template <int WIN>
DI void pool_emit(const Ctx& c, const float (&pv)[31], int t0, int s0, int ch) {
#pragma unroll
    for (int k = 0; k < 16; ++k) {
        float sum = 0.f;
#pragma unroll
        for (int j = 0; j < WIN; ++j) sum += pv[15 + k - j];
        const int s = s0 + k, cnt = (s + 1 < WIN) ? s + 1 : WIN;
        c.POOLED[(size_t)(t0 + k) * 512 + ch] = f2bf(sum / (float)cnt - pv[15 + k]);
    }
}
DI void phase_prep(const Ctx& c, unsigned char* lds) {
    const int n_cmp_items = 2 * 16 * 2;
    for (int item = (int)gridDim.x - 1 - (int)blockIdx.x; item < n_cmp_items; item += gridDim.x) {
        const int tid = TID();
        const int kv = item >> 5, bgi = (item >> 1) & 15, tn = item & 1, m0 = bgi * 256, n0 = tn * 128;
        ARows ar; ar.mu = nullptr; ar.ltype = 0; ar.first = 0;
#pragma unroll
        for (int i = 0; i < 4; ++i) { const int cb = (tid >> 3) + 64 * i;
            ar.p[i] = (cb < NCMP) ? c.PROJ + ((size_t)(bgi >> 2) * SEQ + 16 * cb) * IN_COLS + (kv ? C_VC : C_KC) + (bgi & 3) * 64 : nullptr; }
        f32x4 acc[4][4]; acc_zero(acc);
        gemm_core<1>(acc, ar, (const bf16_t*)(c.ws + WS_WT_C1) + ((size_t)kv * 256 + n0) * 2048, 2048, 2048, lds);
        const float* pb = c.POSB + kv * 256;
        ACC_FOREACH(acc, {
            const f32x4 bb = *(const f32x4*)(pb + n0 + c_);
            store_bf4(c.CMPH + ((size_t)kv * 4096 + m0 + r_) * 256 + n0 + c_, (f32x4){gelu_tanh(v_[0] + bb[0]), gelu_tanh(v_[1] + bb[1]), gelu_tanh(v_[2] + bb[2]), gelu_tanh(v_[3] + bb[3])}); });
    }
    {
        const float* mu = c.in(I_MU) + (size_t)c.l * RWC;
        const bf16_t* WL = (const bf16_t*)(c.ws + WS_WT_LORA);
        for (int unit = blockIdx.x; unit < 64 * 12; unit += gridDim.x) {
            const int tid = TID();
            const int tm = unit & 63, tn = unit >> 6, m0 = tm * 256, n0 = tn * 128, ltype = tn >> 2, ch0 = n0 & 511;
            ARows ar; ar.mu = mu; ar.ltype = ltype; ar.first = 0;
#pragma unroll
            for (int i = 0; i < 4; ++i) { const int t = m0 + (tid >> 3) + 64 * i; ar.p[i] = c.PROJ + (size_t)t * IN_COLS; if ((t & (SEQ - 1)) == 0) ar.first |= 1 << i; }
            f32x4 acc[4][4]; acc_zero(acc);
            gemm_core<2>(acc, ar, WL + (size_t)n0 * 128, 128, 128, lds);
            if (ltype == 0) { const float* w0 = c.in(I_W0) + c.l * 512 + ch0;
                ACC_FOREACH(acc, { const f32x4 b4 = *(const f32x4*)(w0 + c_);
                    for (int j = 0; j < 4; ++j) v_[j] = __expf(-softplusf_(-(b4[j] + v_[j])) - 0.5f); }); }
            else if (ltype == 1) { const float* a0 = c.in(I_A0) + c.l * 512 + ch0;
                ACC_FOREACH(acc, { const f32x4 b4 = *(const f32x4*)(a0 + c_);
                    for (int j = 0; j < 4; ++j) v_[j] = sigmoidf_(b4[j] + v_[j]); }); }
            tile_store_bf16(acc, c.F + (size_t)(3 + ltype) * NT * 512 + (size_t)m0 * 512 + ch0, 512, 256, 128, lds);
        }
    }
    const int tid = TID();
    const int n_pool_items = NT / 16, n_items = n_pool_items + 2048;
    for (int item = blockIdx.x; item < n_items; item += gridDim.x) {
        if (item >= n_pool_items) {
            const int idx = item - n_pool_items, kind = idx >> 10, bgi = (idx >> 6) & 15, s0 = (idx & 63) * 64;
            bf16_t* T = (bf16_t*)lds;
            const int r = tid >> 3, seg = (tid & 7) * 8;
            const u32x4 w = *(const u32x4*)(c.PROJ + ((size_t)(bgi >> 2) * SEQ + s0 + r) * IN_COLS + (kind ? C_VW : C_VS) + (bgi & 3) * 64 + seg);
            __syncthreads();
            *(u32x4*)(T + r * 72 + seg) = w;
            __syncthreads();
            u32x4 o;
            o.x = (unsigned)T[(seg + 0) * 72 + r] | ((unsigned)T[(seg + 1) * 72 + r] << 16); o.y = (unsigned)T[(seg + 2) * 72 + r] | ((unsigned)T[(seg + 3) * 72 + r] << 16);
            o.z = (unsigned)T[(seg + 4) * 72 + r] | ((unsigned)T[(seg + 5) * 72 + r] << 16); o.w = (unsigned)T[(seg + 6) * 72 + r] | ((unsigned)T[(seg + 7) * 72 + r] << 16);
            *(u32x4*)(c.VT + (((size_t)kind * 16 + bgi) * 64 + r) * SEQ + s0 + seg) = o;
        } else {
            const int t0 = item * 16, ch = tid, gi = ch >> 7, s0 = t0 & (SEQ - 1);
            float pv[31];
#pragma unroll
            for (int i = 0; i < 31; ++i) pv[i] = (s0 - 15 + i >= 0) ? bf2f(c.PROJ[(size_t)(t0 - 15 + i) * IN_COLS + C_POOL + ch]) : 0.f;
            if (gi == 0) pool_emit<2>(c, pv, t0, s0, ch);
            else if (gi == 1) pool_emit<4>(c, pv, t0, s0, ch);
            else if (gi == 2) pool_emit<8>(c, pv, t0, s0, ch);
            else pool_emit<16>(c, pv, t0, s0, ch);
        }
    }
}

DI void rwkv_finalize_item(const Ctx& c, int item) {
    const int tid = TID(), ch = tid, t0 = item * 8;
    const float* mu = c.in(I_MU) + (size_t)c.l * RWC;
    const float kkw_ = c.in(I_KK)[c.l * 512 + ch], kaw_ = c.in(I_KA)[c.l * 512 + ch], rkw_ = c.in(I_RK)[c.l * 512 + ch];
    const float mur = mu[ch], muk = mu[512 + ch], muv = mu[1024 + ch];
    bf16_t ur[9], uk[9], uv[9], ua[8];
    const bool has_prev = (t0 & (SEQ - 1)) != 0;
#pragma unroll
    for (int k = 0; k < 9; ++k) {
        ur[k] = 0; uk[k] = 0; uv[k] = 0;
        if (k > 0 || has_prev) { const bf16_t* q = c.PROJ + (size_t)(t0 - 1 + k) * IN_COLS; ur[k] = q[C_R + ch]; uk[k] = q[C_K + ch]; uv[k] = q[C_V + ch]; }
    }
#pragma unroll
    for (int k = 0; k < 8; ++k) ua[k] = c.F[(size_t)4 * NT * 512 + (size_t)(t0 + k) * 512 + ch];
#pragma unroll
    for (int k = 0; k < 8; ++k) {
        const int t = t0 + k;
        const float cr = bf2f(ur[k + 1]), ck = bf2f(uk[k + 1]), cv = bf2f(uv[k + 1]);
        const float r = cr + (bf2f(ur[k]) - cr) * mur, kx = ck + (bf2f(uk[k]) - ck) * muk, vx = cv + (bf2f(uv[k]) - cv) * muv;
        const float a = bf2f(ua[k]);
        const float kxn = kx * kkw_, kp = kx * (1.0f + (a - 1.0f) * kaw_);
        const float ss = wave_sum_dpp(kxn * kxn);
        const float inv = __builtin_amdgcn_rsqf(fmaxf(ss, 1e-24f));
        const float br = wave_sum_dpp(kxn * inv * a * r), kr = wave_sum_dpp(kp * r), bon = wave_sum_dpp(r * kp * rkw_);
        if ((tid & 63) == 0) *(f32x4*)(c.BON + ((size_t)t * 8 + (tid >> 6)) * 4) = (f32x4){inv, br, kr, bon};
        const size_t o = (size_t)t * 512 + ch;
        c.F[o] = f2bf(r); c.F[o + (size_t)NT * 512] = f2bf(kx); c.F[o + (size_t)2 * NT * 512] = f2bf(vx);
    }
}

DI void phase_poolgemm(const Ctx& c, unsigned char* lds) {
    for (int item = blockIdx.x; item < NT / 8; item += gridDim.x) rwkv_finalize_item(c, item);
    const int n_pool = (NT / 256) * 4, n_items = n_pool + 32;
    for (int item = blockIdx.x; item < n_items; item += gridDim.x) {
        f32x4 acc[4][4]; acc_zero(acc);
        if (item < n_pool) {
            const int tm = item >> 2, gi = item & 3, m0 = tm * 256;
            const ARows ar = plain_rows(c.POOLED + gi * 128, 512, m0, TID());
            gemm_core<0>(acc, ar, (const bf16_t*)(c.ws + WS_WT_POOL) + (size_t)gi * 128 * 128, 128, 128, lds);
            const float* sc = c.in(I_POOLS) + c.l * 512 + gi * 128;
            ACC_FOREACH(acc, { const f32x4 s = *(const f32x4*)(sc + c_);
                store_bf4(c.POOLED + (size_t)(m0 + r_) * 512 + gi * 128 + c_, (f32x4){v_[0] * s[0], v_[1] * s[1], v_[2] * s[2], v_[3] * s[3]}); });
        } else {
            const int it = item - n_pool, kv = it >> 4, tm = it & 15, m0 = tm * 256;
            const ARows ar = plain_rows(c.CMPH + (size_t)kv * 4096 * 256, 256, m0, TID());
            gemm_core<0>(acc, ar, (const bf16_t*)(c.ws + WS_WT_C2) + (size_t)kv * 128 * 256, 256, 256, lds);
            ACC_FOREACH(acc, { if (c_ < 64) { const int R = m0 + r_;
                if (kv == 0) store_bf4(c.KC + (size_t)R * 64 + c_, v_);
                else { bf16_t* q = c.VCT + ((size_t)(R >> 8) * 64 + c_) * 256 + (R & 255); q[0] = f2bf(v_[0]); q[256] = f2bf(v_[1]); q[512] = f2bf(v_[2]); q[768] = f2bf(v_[3]); } } });
        }
    }
}

constexpr int SCH = 32;
constexpr int SB_AN = 0, SB_WR = SCH * 64 * 4, SB_W = 2 * SCH * 64 * 4, SB_BB = 3 * SCH * 64 * 4, SB_KP = 4 * SCH * 64 * 4;
constexpr int SB_V = 5 * SCH * 64 * 4;
constexpr int SB_SC = SB_V + SCH * 16 * 4;
constexpr int SB_Y = SB_SC + SCH * 2 * 4;
constexpr int SB_BYTES = SB_Y + SCH * 16 * 4;
static_assert(2 * SB_BYTES <= LDS_BYTES - 64, "scan lds");
typedef float f32x2 __attribute__((ext_vector_type(2)));
DI float row8_sum(float v) { v += DPP_MOV(v, 0xB1); v += DPP_MOV(v, 0x4E); v += DPP_MOV(v, 0x141); return v; }

constexpr int NPW = 6, NJ = (SCH + NPW - 1) / NPW;
struct PrepRegs { bf16_t r[NJ], k[NJ], v[NJ], e[NJ], a[NJ]; float s0[NJ], s1[NJ], s2[NJ]; };
DI void prep_load(PrepRegs& R, const Ctx& c, int b, int h, int ck, int pw, int lane) {
    const size_t PL = (size_t)NT * 512;
    const size_t tb = (size_t)b * SEQ + ck * SCH;
    const size_t o0 = tb * 512 + h * 64 + lane;
#pragma unroll
    for (int j = 0; j < NJ; ++j) {
        const int st = pw + NPW * j;
        if (st < SCH) { const size_t o = o0 + (size_t)st * 512; R.r[j] = c.F[o]; R.k[j] = c.F[o + PL]; R.v[j] = c.F[o + 2 * PL]; R.e[j] = c.F[o + 3 * PL]; R.a[j] = c.F[o + 4 * PL];
            const float* sp = c.BON + ((tb + st) * 8 + h) * 4; R.s0[j] = sp[0]; R.s1[j] = sp[1]; R.s2[j] = sp[2]; }
    }
}
DI void prep_store(const PrepRegs& R, unsigned char* sb, int rq, int pw, int lane, float kkw, float kaw) {
    float* an = (float*)(sb + SB_AN); float* wr = (float*)(sb + SB_WR); float* w_ = (float*)(sb + SB_W); float* bb_ = (float*)(sb + SB_BB); float* kp_ = (float*)(sb + SB_KP);
    float* vv = (float*)(sb + SB_V); float* sc = (float*)(sb + SB_SC);
#pragma unroll
    for (int j = 0; j < NJ; ++j) {
        const int st = pw + NPW * j;
        if (st < SCH) {
            const float r = bf2f(R.r[j]), k = bf2f(R.k[j]), v = bf2f(R.v[j]), e = bf2f(R.e[j]), a = bf2f(R.a[j]);
            const float w = __expf(-e);
            const float kk = k * kkw * R.s0[j];
            const float kp = k * (1.0f + (a - 1.0f) * kaw);
            an[st * 64 + lane] = -kk; wr[st * 64 + lane] = w * r; w_[st * 64 + lane] = w; bb_[st * 64 + lane] = kk * a; kp_[st * 64 + lane] = kp;
            if ((lane >> 4) == rq) vv[st * 16 + (lane & 15)] = v;
            if (lane == 0) { sc[st * 2] = R.s1[j]; sc[st * 2 + 1] = R.s2[j]; }
        }
    }
}
DI void scan_item(const Ctx& c, int item, unsigned char* lds) {
    const int tid = TID(), lane = tid & 63, wave = tid >> 6;
    const int b = item >> 5, h = (item >> 2) & 7, rq = item & 3;
    const int chn = h * 64 + lane;
    const float kkw = c.in(I_KK)[c.l * 512 + chn], kaw = c.in(I_KA)[c.l * 512 + chn];
    const int rowl = (tid & 127) >> 3, cg = tid & 7;
    f32x2 st[4];
#pragma unroll
    for (int i = 0; i < 4; ++i) st[i] = (f32x2){0.f, 0.f};
    constexpr int NCK = SEQ / SCH;
    PrepRegs R;
    __syncthreads();
    if (wave >= 2) { prep_load(R, c, b, h, 0, wave - 2, lane); prep_store(R, lds, rq, wave - 2, lane, kkw, kaw); prep_load(R, c, b, h, 1, wave - 2, lane); }
    __syncthreads();
    for (int ck = 0; ck < NCK; ++ck) {
        unsigned char* sb = lds + (ck & 1) * SB_BYTES;
        if (wave < 2) {
            const float* an = (const float*)(sb + SB_AN) + cg * 8; const float* wr = (const float*)(sb + SB_WR) + cg * 8; const float* w_ = (const float*)(sb + SB_W) + cg * 8;
            const float* bb_ = (const float*)(sb + SB_BB) + cg * 8; const float* kp_ = (const float*)(sb + SB_KP) + cg * 8;
            const float* vv = (const float*)(sb + SB_V) + rowl; const float* sc = (const float*)(sb + SB_SC); float* yb = (float*)(sb + SB_Y) + rowl;
            f32x4 a0 = *(const f32x4*)(an), a1 = *(const f32x4*)(an + 4), r0 = *(const f32x4*)(wr), r1 = *(const f32x4*)(wr + 4);
            f32x4 w0 = *(const f32x4*)(w_), w1 = *(const f32x4*)(w_ + 4), b0 = *(const f32x4*)(bb_), b1 = *(const f32x4*)(bb_ + 4);
            f32x4 k0 = *(const f32x4*)(kp_), k1 = *(const f32x4*)(kp_ + 4);
            float v = vv[0]; f32x2 bk = *(const f32x2*)(sc);
#pragma unroll 2
            for (int s = 0; s < SCH; ++s) {
                const int sn = (s + 1 < SCH) ? s + 1 : s;
                const f32x4 na0 = *(const f32x4*)(an + sn * 64), na1 = *(const f32x4*)(an + sn * 64 + 4), nr0 = *(const f32x4*)(wr + sn * 64), nr1 = *(const f32x4*)(wr + sn * 64 + 4);
                const f32x4 nw0 = *(const f32x4*)(w_ + sn * 64), nw1 = *(const f32x4*)(w_ + sn * 64 + 4), nb0 = *(const f32x4*)(bb_ + sn * 64), nb1 = *(const f32x4*)(bb_ + sn * 64 + 4);
                const f32x4 nk0 = *(const f32x4*)(kp_ + sn * 64), nk1 = *(const f32x4*)(kp_ + sn * 64 + 4);
                const float nv = vv[sn * 16]; const f32x2 nbk = *(const f32x2*)(sc + sn * 2);
                f32x2 da = st[0] * (f32x2){a0[0], a0[1]}; f32x2 dr = st[0] * (f32x2){r0[0], r0[1]};
                da += st[1] * (f32x2){a0[2], a0[3]}; dr += st[1] * (f32x2){r0[2], r0[3]};
                da += st[2] * (f32x2){a1[0], a1[1]}; dr += st[2] * (f32x2){r1[0], r1[1]};
                da += st[3] * (f32x2){a1[2], a1[3]}; dr += st[3] * (f32x2){r1[2], r1[3]};
                float sa = da[0] + da[1], sr = dr[0] + dr[1];
                sa += DPP_MOV(sa, 0xB1); sr += DPP_MOV(sr, 0xB1);
                sa += DPP_MOV(sa, 0x4E); sr += DPP_MOV(sr, 0x4E);
                sa += DPP_MOV(sa, 0x141); sr += DPP_MOV(sr, 0x141);
                const f32x2 sa2 = (f32x2){sa, sa}, v2 = (f32x2){v, v};
                st[0] = st[0] * (f32x2){w0[0], w0[1]} + sa2 * (f32x2){b0[0], b0[1]} + v2 * (f32x2){k0[0], k0[1]};
                st[1] = st[1] * (f32x2){w0[2], w0[3]} + sa2 * (f32x2){b0[2], b0[3]} + v2 * (f32x2){k0[2], k0[3]};
                st[2] = st[2] * (f32x2){w1[0], w1[1]} + sa2 * (f32x2){b1[0], b1[1]} + v2 * (f32x2){k1[0], k1[1]};
                st[3] = st[3] * (f32x2){w1[2], w1[3]} + sa2 * (f32x2){b1[2], b1[3]} + v2 * (f32x2){k1[2], k1[3]};
                yb[s * 16] = sr + sa * bk[0] + v * bk[1];
                a0 = na0; a1 = na1; r0 = nr0; r1 = nr1; w0 = nw0; w1 = nw1; b0 = nb0; b1 = nb1; k0 = nk0; k1 = nk1; v = nv; bk = nbk;
            }
        } else {
            const int pt = tid - 128;
            if (ck + 1 < NCK) prep_store(R, lds + ((ck + 1) & 1) * SB_BYTES, rq, wave - 2, lane, kkw, kaw);
            if (ck + 2 < NCK) prep_load(R, c, b, h, ck + 2, wave - 2, lane);
            if (ck > 0) {
                const float* yb = (const float*)(lds + ((ck - 1) & 1) * SB_BYTES + SB_Y);
                for (int idx = pt; idx < SCH * 16; idx += 384) {
                    const int s = idx >> 4, j = idx & 15;
                    c.YRAW[((size_t)b * SEQ + (ck - 1) * SCH + s) * 512 + h * 64 + rq * 16 + j] = f2bf(yb[idx]);
                }
            }
        }
        asm volatile("s_waitcnt lgkmcnt(0)" ::: "memory"); __builtin_amdgcn_s_barrier(); asm volatile("" ::: "memory");
    }
    {
        const float* yb = (const float*)(lds + ((NCK - 1) & 1) * SB_BYTES + SB_Y);
        for (int idx = tid; idx < SCH * 16; idx += NTHREADS) {
            const int s = idx >> 4, j = idx & 15;
            c.YRAW[((size_t)b * SEQ + (NCK - 1) * SCH + s) * 512 + h * 64 + rq * 16 + j] = f2bf(yb[idx]);
        }
    }
    __syncthreads();
}
DI void phase_rwkv_post(const Ctx& c, unsigned char* lds) {
    const int tid = TID(), lane = tid & 63, wave = tid >> 6;
    const size_t PL = (size_t)NT * 512;
    for (int t = blockIdx.x * 8 + wave; t < NT; t += gridDim.x * 8) {
        bf16_t ry[8], rv[8], rg[8]; float bon[8], gw[8], gb[8];
#pragma unroll
        for (int h = 0; h < 8; ++h) { const size_t o = (size_t)t * 512 + h * 64 + lane; ry[h] = c.YRAW[o]; rv[h] = c.F[o + 2 * PL]; rg[h] = c.F[o + 5 * PL]; bon[h] = c.BON[((size_t)t * 8 + h) * 4 + 3];
            gw[h] = c.in(I_GNW)[c.l * 512 + h * 64 + lane]; gb[h] = c.in(I_GNB)[c.l * 512 + h * 64 + lane]; }
#pragma unroll
        for (int h = 0; h < 8; ++h) {
            const float y = bf2f(ry[h]);
            const float mean = wave_sum_dpp(y) * (1.0f / 64.0f);
            const float d = y - mean;
            const float var = wave_sum_dpp(d * d) * (1.0f / 64.0f);
            const float yn = d * rsqrtf(var + 64e-5f) * gw[h] + gb[h];
            c.F[(size_t)t * 512 + h * 64 + lane + 5 * PL] = f2bf((yn + bon[h] * bf2f(rv[h])) * bf2f(rg[h]));
        }
    }
    for (int it = blockIdx.x * 4; it < 768 + 128 + 128 + 256 + 256; it += gridDim.x * 4) {
        const float* WB = c.in(I_WBR) + (size_t)c.l * 2048 * DM; bf16_t* BR = (bf16_t*)(c.ws + WS_WT_BR);
        if (it < 768) convert_tile4(c.in(I_WMG) + (size_t)c.l * DM * 3 * DM, 3 * DM, 3 * DM, DM, (bf16_t*)(c.ws + WS_WT_MG), it, lds);
        else if (it < 896) convert_tile4(WB, DM, DM, 512, BR, it - 768, lds);
        else if (it < 1024) convert_tile4(WB + (size_t)512 * DM, DM, DM, 512, BR + (size_t)1024 * 512, it - 896, lds);
        else if (it < 1280) convert_tile4(WB + (size_t)1024 * DM, DM, DM, 1024, BR + (size_t)2048 * 512, it - 1024, lds);
        else convert_tile4(c.in(I_WOUT) + (size_t)c.l * DM * DM, DM, DM, DM, (bf16_t*)(c.ws + WS_WT_OUT), it - 1280, lds);
    }
}
constexpr int TS = 72;
constexpr int NSA_BIAS = 0;
constexpr int NSA_SELM = 2112;
constexpr int NSA_SCR = 2624;
constexpr int NSA_K0 = 4672;
constexpr int NSA_V0 = NSA_K0 + 2 * 64 * TS * 2;
constexpr int NSA_A = NSA_V0 + 2 * 64 * TS * 2;
constexpr int NSA_B = NSA_A + 16384;
constexpr int NSA_END = NSA_B + 16384;
static_assert(NSA_END <= LDS_BYTES - 16, "nsa lds");
static_assert(NSA_K0 % 16 == 0, "align");

struct NsaLane { int tq[2]; int h; float cbias; float m[2], l[2]; };

DI void nsa_prefetch(u32x4& rk, u32x4& rv, const bf16_t* kbase, int kstride, const bf16_t* vtbase, int vstride, int pos0, int tid) {
    const int r = tid >> 3, seg = (tid & 7) * 8;
    rk = *(const u32x4*)(kbase + (size_t)(pos0 + r) * kstride + seg);
    rv = *(const u32x4*)(vtbase + (size_t)r * vstride + pos0 + seg);
}
DI void nsa_store(unsigned char* lds, int buf, const u32x4& rk, const u32x4& rv, int tid) {
    const int r = tid >> 3, seg = (tid & 7) * 8;
    *(u32x4*)((bf16_t*)(lds + NSA_K0) + buf * 64 * TS + r * TS + seg) = rk;
    *(u32x4*)((bf16_t*)(lds + NSA_V0) + buf * 64 * TS + r * TS + seg) = rv;
}
template <int QM = 3>
DI void nsa_qk(f32x4 (&s)[2][4], const bf16_t* sK, const bf16x8 (&qf)[2][2], int lane) {
#pragma unroll
    for (int kt = 0; kt < 4; ++kt) {
#pragma unroll
        for (int ks = 0; ks < 2; ++ks) {
            const bf16x8 kf = *(const bf16x8*)(sK + (16 * kt + (lane & 15)) * TS + 32 * ks + (lane >> 4) * 8);
#pragma unroll
            for (int qi = 0; qi < 2; ++qi) if ((QM >> qi) & 1) s[qi][kt] = __builtin_amdgcn_mfma_f32_16x16x32_bf16(kf, qf[qi][ks], (ks == 0) ? (f32x4){0.f, 0.f, 0.f, 0.f} : s[qi][kt], 0, 0, 0);
        }
    }
}
template <int MODE>
DI void nsa_logits(float (&x)[4][4], const f32x4 (&s)[4], int tq, int h, float cbias, bool rowsel, int pos0, int qd, const float* biasT) {
#pragma unroll
    for (int kt = 0; kt < 4; ++kt)
#pragma unroll
        for (int i = 0; i < 4; ++i) {
            const int kk = pos0 + 16 * kt + 4 * qd + i;
            if (MODE == 1) { x[kt][i] = rowsel ? s[kt][i] + cbias : -INFINITY; }
            else {
                const int dist = (MODE == 0) ? (tq - 16 * kk - 31) : (tq - kk);
                bool ok = dist >= 0;
                if (MODE == 2) ok = ok && rowsel;
                if (MODE == 3) ok = ok && (dist < 512);
                const int di = dist < 0 ? 0 : (dist > 128 ? 128 : dist);
                float bias = biasT[di * 4 + h];
                asm volatile("" : "+v"(bias));
                x[kt][i] = ok ? s[kt][i] + bias : -INFINITY;
            }
        }
}
DI float quad16_max(float v) { v = fmaxf(v, __shfl_xor(v, 16)); v = fmaxf(v, __shfl_xor(v, 32)); return v; }
DI float quad16_sum(float v) { v += __shfl_xor(v, 16); v += __shfl_xor(v, 32); return v; }
DI void nsa_softmax(const float (&x)[4][4], float& m, float& l, f32x4 (&O)[4], bf16x8 (&pf)[2]) {
    float mx = -INFINITY;
#pragma unroll
    for (int kt = 0; kt < 4; ++kt)
#pragma unroll
        for (int i = 0; i < 4; ++i) mx = fmaxf(mx, x[kt][i]);
    mx = quad16_max(mx);
    const float mn = fmaxf(m, mx);
    const float mu = (mn == -INFINITY) ? 0.f : mn;
    const float mu2 = mu * 1.4426950408889634f;
    const float sc = __builtin_amdgcn_exp2f(__builtin_fmaf(m, 1.4426950408889634f, -mu2));
    float p[4][4]; float ps = 0.f;
#pragma unroll
    for (int kt = 0; kt < 4; ++kt)
#pragma unroll
        for (int i = 0; i < 4; ++i) { p[kt][i] = __builtin_amdgcn_exp2f(__builtin_fmaf(x[kt][i], 1.4426950408889634f, -mu2)); ps += p[kt][i]; }
    l = l * sc + ps; m = mn;
#pragma unroll
    for (int dt = 0; dt < 4; ++dt) O[dt] = O[dt] * sc;
#pragma unroll
    for (int ks = 0; ks < 2; ++ks) {
        u32x4 w; w.x = pack2(p[2 * ks][0], p[2 * ks][1]); w.y = pack2(p[2 * ks][2], p[2 * ks][3]); w.z = pack2(p[2 * ks + 1][0], p[2 * ks + 1][1]); w.w = pack2(p[2 * ks + 1][2], p[2 * ks + 1][3]);
        pf[ks] = __builtin_bit_cast(bf16x8, w);
    }
}
template <int QM = 3>
DI void nsa_pv(f32x4 (&O)[2][4], const bf16_t* sV, const bf16x8 (&pf)[2][2], int lane) {
    const int qd = lane >> 4;
#pragma unroll
    for (int dt = 0; dt < 4; ++dt)
#pragma unroll
        for (int ks = 0; ks < 2; ++ks) {
            const bf16_t* vp = sV + (16 * dt + (lane & 15)) * TS + 32 * ks + 4 * qd;
            const u32x2 a = *(const u32x2*)vp, b = *(const u32x2*)(vp + 16);
            u32x4 w; w.x = a.x; w.y = a.y; w.z = b.x; w.w = b.y;
            const bf16x8 vf = __builtin_bit_cast(bf16x8, w);
#pragma unroll
            for (int qi = 0; qi < 2; ++qi) if ((QM >> qi) & 1) O[qi][dt] = __builtin_amdgcn_mfma_f32_16x16x32_bf16(vf, pf[qi][ks], O[qi][dt], 0, 0, 0);
        }
}
template <int MODE, int QM = 3>
DI void nsa_tile(f32x4 (&O)[2][4], NsaLane& L, const bf16x8 (&qf)[2][2], const unsigned char* lds, int buf, int pos0, bool sel0, bool sel1, int lane) {
    const bf16_t* sK = (const bf16_t*)(lds + NSA_K0) + buf * 64 * TS;
    const bf16_t* sV = (const bf16_t*)(lds + NSA_V0) + buf * 64 * TS;
    const float* biasT = (const float*)(lds + NSA_BIAS);
    f32x4 s[2][4];
    nsa_qk<QM>(s, sK, qf, lane);
    bf16x8 pf[2][2];
#pragma unroll
    for (int qi = 0; qi < 2; ++qi) if ((QM >> qi) & 1) {
        float x[4][4];
        nsa_logits<MODE>(x, s[qi], L.tq[qi], L.h, L.cbias, qi ? sel1 : sel0, pos0, lane >> 4, biasT);
        nsa_softmax(x, L.m[qi], L.l[qi], O[qi], pf[qi]);
    }
    nsa_pv<QM>(O, sV, pf, lane);
}
template <int MODE>
DI void nsa_tile_sel(f32x4 (&O)[2][4], NsaLane& L, const bf16x8 (&qf)[2][2], const unsigned char* lds, int buf, int pos0, bool sel0, bool sel1, int lane) {
    const bool a0 = __ballot(sel0) != 0ull, a1 = __ballot(sel1) != 0ull;
    if (a0 && a1) nsa_tile<MODE, 3>(O, L, qf, lds, buf, pos0, sel0, sel1, lane);
    else if (a0) nsa_tile<MODE, 1>(O, L, qf, lds, buf, pos0, sel0, sel1, lane);
    else if (a1) nsa_tile<MODE, 2>(O, L, qf, lds, buf, pos0, sel0, sel1, lane);
}
DI void nsa_flush(f32x4 (&Y)[2][4], f32x4 (&O)[2][4], NsaLane& L, const float (&gate)[2]) {
#pragma unroll
    for (int qi = 0; qi < 2; ++qi) {
        const float lt = quad16_sum(L.l[qi]);
        const float f = (lt > 0.f) ? gate[qi] * __builtin_amdgcn_rcpf(lt) : 0.f;
#pragma unroll
        for (int dt = 0; dt < 4; ++dt) { Y[qi][dt] += O[qi][dt] * f; O[qi][dt] = (f32x4){0.f, 0.f, 0.f, 0.f}; }
    }
}
DI void nsa_item(const Ctx& c, int item, unsigned char* lds) {
    const int tid = TID(), lane = tid & 63, wave = tid >> 6, qd = lane >> 4;
    const int b = item >> 8, g = (item >> 6) & 3, qt = item & 63, t0 = qt * 64, cur = qt, bg = b * 4 + g;
    float* biasT = (float*)(lds + NSA_BIAS);
    unsigned long long* selm = (unsigned long long*)(lds + NSA_SELM);
    float* scr = (float*)(lds + NSA_SCR) + wave * 64;
    float* impA = (float*)(lds + NSA_A); float* impB = (float*)(lds + NSA_B);
    __syncthreads();
    for (int i = tid; i < 129 * 4; i += NTHREADS) { const int d = i >> 2, h = i & 3; biasT[i] = c.in(I_RELB)[t5_bucket(d) * 16 + g * 4 + h]; }
    for (int i = tid; i < 2 * 4096; i += NTHREADS) impA[i] = 0.f;
    NsaLane L; L.h = lane & 3;
    bf16x8 qf[2][2]; float gates[2][3];
    const bf16_t* pbat = c.PROJ + (size_t)b * SEQ * IN_COLS;
#pragma unroll
    for (int qi = 0; qi < 2; ++qi) {
        const int tl = 8 * wave + 4 * qi + ((lane & 15) >> 2);
        L.tq[qi] = t0 + tl;
        const bf16_t* prow = pbat + (size_t)L.tq[qi] * IN_COLS;
#pragma unroll
        for (int ks = 0; ks < 2; ++ks) {
            u32x4 w = *(const u32x4*)(prow + C_Q + (g * 4 + L.h) * 64 + 32 * ks + qd * 8);
            w.x = pack2(bflo(w.x) * 0.125f, bfhi(w.x) * 0.125f); w.y = pack2(bflo(w.y) * 0.125f, bfhi(w.y) * 0.125f);
            w.z = pack2(bflo(w.z) * 0.125f, bfhi(w.z) * 0.125f); w.w = pack2(bflo(w.w) * 0.125f, bfhi(w.w) * 0.125f);
            qf[qi][ks] = __builtin_bit_cast(bf16x8, w);
        }
#pragma unroll
        for (int br = 0; br < 3; ++br) gates[qi][br] = sigmoidf_(bf2f(prow[C_GATE + g * 12 + L.h * 3 + br]));
    }
    __syncthreads();
    L.cbias = biasT[128 * 4 + L.h];
    f32x4 O[2][4], Y[2][4];
#pragma unroll
    for (int qi = 0; qi < 2; ++qi)
#pragma unroll
        for (int dt = 0; dt < 4; ++dt) { O[qi][dt] = (f32x4){0.f, 0.f, 0.f, 0.f}; Y[qi][dt] = (f32x4){0.f, 0.f, 0.f, 0.f}; }
    u32x4 rk, rv;
    const int nvis_max = (t0 + 63 >= 31) ? ((t0 + 63 - 31) >> 4) + 1 : 0;
    const int ncb = (nvis_max + 63) >> 6;
    const bf16_t* kcb = c.KC + (size_t)bg * 256 * 64; const bf16_t* vcb = c.VCT + (size_t)bg * 64 * 256;
    L.m[0] = L.m[1] = -INFINITY; L.l[0] = L.l[1] = 0.f;
    if (ncb > 0) nsa_prefetch(rk, rv, kcb, 64, vcb, 256, 0, tid);
    for (int cb = 0; cb < ncb; ++cb) {
        nsa_store(lds, cb & 1, rk, rv, tid);
        __syncthreads();
        if (cb + 1 < ncb) nsa_prefetch(rk, rv, kcb, 64, vcb, 256, (cb + 1) * 64, tid);
        if (16 * (cb * 64 + 63) + 31 + 128 <= t0) nsa_tile<1>(O, L, qf, lds, cb & 1, cb * 64, true, true, lane);
        else nsa_tile<0>(O, L, qf, lds, cb & 1, cb * 64, true, true, lane);
    }
    float mfin[2], linv[2];
#pragma unroll
    for (int qi = 0; qi < 2; ++qi) { mfin[qi] = L.m[qi]; const float lt = quad16_sum(L.l[qi]); linv[qi] = (lt > 0.f) ? __builtin_amdgcn_rcpf(lt) : 0.f; }
    { const float gg[2] = {gates[0][0], gates[1][0]}; nsa_flush(Y, O, L, gg); }
    __syncthreads();
    if (ncb > 0) nsa_prefetch(rk, rv, kcb, 64, vcb, 256, 0, tid);
    for (int cb = 0; cb < ncb; ++cb) {
        nsa_store(lds, cb & 1, rk, rv, tid);
        __syncthreads();
        if (cb + 1 < ncb) nsa_prefetch(rk, rv, kcb, 64, vcb, 256, (cb + 1) * 64, tid);
        const bf16_t* sK = (const bf16_t*)(lds + NSA_K0) + (cb & 1) * 64 * TS;
        f32x4 s[2][4];
        nsa_qk(s, sK, qf, lane);
#pragma unroll
        for (int qi = 0; qi < 2; ++qi) {
            float x[4][4];
            nsa_logits<0>(x, s[qi], L.tq[qi], L.h, L.cbias, true, cb * 64, qd, biasT);
            const float mu = (mfin[qi] == -INFINITY) ? 0.f : mfin[qi];
#pragma unroll
            for (int kt = 0; kt < 4; ++kt) {
                float p3 = __expf(x[kt][3] - mu) * linv[qi];
                float pa = (__expf(x[kt][0] - mu) + __expf(x[kt][1] - mu) + __expf(x[kt][2] - mu)) * linv[qi] + p3;
                pa += __shfl_xor(pa, 1); p3 += __shfl_xor(p3, 1);
                pa += __shfl_xor(pa, 2); p3 += __shfl_xor(p3, 2);
                if (L.h == 0) { const int tl = 8 * wave + 4 * qi + ((lane & 15) >> 2), mi = 16 * cb + 4 * kt + qd; impA[tl * 64 + mi] = pa; impB[tl * 64 + mi] = p3; }
            }
        }
    }
    __syncthreads();
    for (int tl8 = 0; tl8 < 8; ++tl8) {
        const int tl = 8 * wave + tl8, n = lane;
        const bool cand = (n >= 1) && (n <= cur - 2);
        const float imp = cand ? impA[tl * 64 + n] + impB[tl * 64 + n - 1] : -1.0f;
        LDS_WAVE_SYNC();
        scr[n] = imp;
        LDS_WAVE_SYNC();
        int rank = 0;
#pragma unroll 4
        for (int q4 = 0; q4 < 16; ++q4) {
            const f32x4 o = *(const f32x4*)(scr + q4 * 4);
#pragma unroll
            for (int j = 0; j < 4; ++j) { const int n2 = q4 * 4 + j; rank += (o[j] > imp || (o[j] == imp && n2 < n)) ? 1 : 0; }
        }
        const bool forced = (n <= cur) && (n == 0 || n == cur || n == cur - 1);
        const unsigned long long msk = __ballot((cand && rank < 5) || forced);
        if (lane == 0) selm[tl] = msk;
    }
    __syncthreads();
    unsigned long long uni = selm[lane];
#pragma unroll
    for (int o = 32; o >= 1; o >>= 1) { const unsigned lo_ = __shfl_xor((unsigned)uni, o), hi_ = __shfl_xor((unsigned)(uni >> 32), o); uni |= ((unsigned long long)hi_ << 32) | lo_; }
    uni = ((unsigned long long)__builtin_amdgcn_readfirstlane((unsigned)(uni >> 32)) << 32) | (unsigned)__builtin_amdgcn_readfirstlane((unsigned)uni);
    unsigned long long sm[2];
#pragma unroll
    for (int qi = 0; qi < 2; ++qi) sm[qi] = selm[8 * wave + 4 * qi + ((lane & 15) >> 2)];
    const bf16_t* ksb = pbat + C_KS + g * 64; const bf16_t* vsb = c.VT + ((size_t)0 * 16 + bg) * 64 * SEQ;
    L.m[0] = L.m[1] = -INFINITY; L.l[0] = L.l[1] = 0.f;
    {
        unsigned long long rem = uni; int it = 0;
        int j = (int)__builtin_ctzll(rem); rem &= rem - 1;
        nsa_prefetch(rk, rv, ksb, IN_COLS, vsb, SEQ, j * 64, tid);
        for (;;) {
            nsa_store(lds, it & 1, rk, rv, tid);
            __syncthreads();
            const int jn = rem ? (int)__builtin_ctzll(rem) : -1;
            if (jn >= 0) { rem &= rem - 1; nsa_prefetch(rk, rv, ksb, IN_COLS, vsb, SEQ, jn * 64, tid); }
            const bool s0 = (sm[0] >> j) & 1ull, s1 = (sm[1] >> j) & 1ull;
            if (j <= cur - 3) nsa_tile_sel<1>(O, L, qf, lds, it & 1, j * 64, s0, s1, lane);
            else nsa_tile_sel<2>(O, L, qf, lds, it & 1, j * 64, s0, s1, lane);
            if (jn < 0) break;
            j = jn; ++it;
        }
    }
    { const float gg[2] = {gates[0][1], gates[1][1]}; nsa_flush(Y, O, L, gg); }
    const bf16_t* kwb = pbat + C_KW + g * 64; const bf16_t* vwb = c.VT + ((size_t)1 * 16 + bg) * 64 * SEQ;
    L.m[0] = L.m[1] = -INFINITY; L.l[0] = L.l[1] = 0.f;
    {
        const int j0 = (cur - 8 > 0) ? cur - 8 : 0;
        __syncthreads();
        nsa_prefetch(rk, rv, kwb, IN_COLS, vwb, SEQ, j0 * 64, tid);
        for (int j = j0; j <= cur; ++j) {
            nsa_store(lds, (j - j0) & 1, rk, rv, tid);
            __syncthreads();
            if (j + 1 <= cur) nsa_prefetch(rk, rv, kwb, IN_COLS, vwb, SEQ, (j + 1) * 64, tid);
            if (cur - j >= 3 && cur - j <= 7) nsa_tile<1>(O, L, qf, lds, (j - j0) & 1, j * 64, true, true, lane);
            else nsa_tile<3>(O, L, qf, lds, (j - j0) & 1, j * 64, true, true, lane);
        }
    }
    { const float gg[2] = {gates[0][2], gates[1][2]}; nsa_flush(Y, O, L, gg); }
#pragma unroll
    for (int qi = 0; qi < 2; ++qi) {
        bf16_t* yrow = c.PROJ + ((size_t)b * SEQ + L.tq[qi]) * IN_COLS + C_Q + (g * 4 + L.h) * 64;
#pragma unroll
        for (int dt = 0; dt < 4; ++dt) store_bf4(yrow + 16 * dt + 4 * qd, Y[qi][dt]);
    }
}
DI void phase_mix(const Ctx& c, unsigned char* lds) {
    const int G = gridDim.x, bid = blockIdx.x;
    const int n_nsa = NB * 4 * (SEQ / 64), n_scan = NB * 8 * 4;
    const bool split = G >= 2 * n_scan;
    if (split) { if (bid < n_scan) scan_item(c, bid, lds); }
    else for (int item = bid; item < n_scan; item += G) scan_item(c, item, lds);
    unsigned* ctr = c.ctl + CW_Q + c.l;
    volatile int* sitem = (volatile int*)(lds + LDS_BYTES - 32);
    for (;;) {
        __syncthreads();
        if (TID() == 0) *sitem = (int)atomicAdd(ctr, 1u);
        __syncthreads();
        const int k = *sitem;
        if (k >= n_nsa) break;
        const int qt = 63 - (k >> 4), bgi = k & 15;
        nsa_item(c, (bgi << 6) | qt, lds);
    }
}

DI void phase_merge(const Ctx& c, unsigned char* lds) {
    const int nM = NT / 256, nN = DM / 128;
    const bf16_t* WM = (const bf16_t*)(c.ws + WS_WT_MG);
    const bf16_t* BR = (const bf16_t*)(c.ws + WS_WT_BR);
    const float* BM_ = c.in(I_BMG) + (size_t)c.l * 3 * DM;
    bf16_t* TMP = c.YRAW + (size_t)blockIdx.x * 256 * 128;
    for (int it = 0;; ++it) {
        int tm, tn; if (!xcd_unit(it, nN, tm, tn)) break;
        const int m0 = tm * 256, n0 = tn * 128;
#pragma unroll 1
        for (int i = 0; i < 3; ++i) {
            {
                f32x4 ag[4][4]; acc_zero(ag);
                const ARows ar = plain_rows(c.H, DM, m0, TID());
                gemm_core<0>(ag, ar, WM + (size_t)(i * DM + n0) * DM, DM, DM, lds);
                ACC_FOREACH(ag, { const f32x4 bb = *(const f32x4*)(BM_ + i * DM + n0 + c_);
                    store_bf4(TMP + r_ * 128 + c_, (f32x4){sigmoidf_(v_[0] + bb[0]), sigmoidf_(v_[1] + bb[1]), sigmoidf_(v_[2] + bb[2]), sigmoidf_(v_[3] + bb[3])}); });
            }
            f32x4 ab[4][4]; acc_zero(ab);
            if (i == 0) { const ARows ar = plain_rows(c.POOLED, 512, m0, TID()); gemm_core<0>(ab, ar, BR + (size_t)n0 * 512, 512, 512, lds); }
            else if (i == 1) { const ARows ar = plain_rows(c.F + (size_t)5 * NT * 512, 512, m0, TID()); gemm_core<0>(ab, ar, BR + (size_t)1024 * 512 + (size_t)n0 * 512, 512, 512, lds); }
            else { const ARows ar = plain_rows(c.PROJ + C_Q, IN_COLS, m0, TID()); gemm_core<0>(ab, ar, BR + (size_t)2048 * 512 + (size_t)n0 * 1024, 1024, 1024, lds); }
            ACC_FOREACH(ab, {
                bf16_t* q = c.MERGED + (size_t)(m0 + r_) * DM + n0 + c_;
                const u32x2 gv = *(const u32x2*)(TMP + r_ * 128 + c_);
                f32x4 m4 = ((f32x4){0.f, 0.f, 0.f, 0.f});
                if (i > 0) { const u32x2 pv = *(const u32x2*)q; m4 = ((f32x4){bflo(pv.x), bfhi(pv.x), bflo(pv.y), bfhi(pv.y)}); }
                m4[0] += bflo(gv.x) * v_[0]; m4[1] += bfhi(gv.x) * v_[1]; m4[2] += bflo(gv.y) * v_[2]; m4[3] += bfhi(gv.y) * v_[3];
                store_bf4(q, m4); });
        }
    }
}

DI void phase_outp(const Ctx& c, unsigned char* lds) {
    const int nM = NT / 256, nN = DM / 128;
    const bf16_t* W = (const bf16_t*)(c.ws + WS_WT_OUT);
    const float* xin = (c.l == 0) ? c.in(I_X) : c.out;
    for (int it = 0;; ++it) {
        int tm, tn; if (!xcd_unit(it, nN, tm, tn)) break;
        const int m0 = tm * 256, n0 = tn * 128;
        f32x4 acc[4][4]; acc_zero(acc);
        const ARows ar = plain_rows(c.MERGED, DM, m0, TID());
        gemm_core<0>(acc, ar, W + (size_t)n0 * DM, DM, DM, lds);
        ACC_FOREACH(acc, { const size_t o = (size_t)(m0 + r_) * DM + n0 + c_; const f32x4 x = *(const f32x4*)(xin + o); *(f32x4*)(c.out + o) = x + v_; });
    }
    for (int it = blockIdx.x * 4; it < 3 * 32 * 64; it += gridDim.x * 4) {
        const int mat = it / 2048, e = (it >> 6) & 31, tl = it & 63;
        if (mat == 0) convert_tile4(c.in(I_EG) + ((size_t)c.l * 32 + e) * DM * 256, 256, 256, DM, (bf16_t*)(c.ws + WS_EG) + (size_t)e * 256 * DM, tl, lds);
        else if (mat == 1) convert_tile4(c.in(I_EU) + ((size_t)c.l * 32 + e) * DM * 256, 256, 256, DM, (bf16_t*)(c.ws + WS_EU) + (size_t)e * 256 * DM, tl, lds);
        else convert_tile4(c.in(I_ED) + ((size_t)c.l * 32 + e) * 256 * DM, DM, DM, 256, (bf16_t*)(c.ws + WS_ED) + (size_t)e * DM * 256, tl, lds);
    }
}

DI void phase_norm2(const Ctx& c, unsigned char* lds) {
    const int tid = TID(), lane = tid & 63, wave = tid >> 6;
    const float* gain = c.in(I_NFFN) + c.l * DM;
    const float* wrg = c.in(I_WRG) + (size_t)c.l * DM * 4; const float* brg = c.in(I_BRG) + c.l * 4;
    const float* wre = c.in(I_WRE) + (size_t)c.l * DM * 32; const float* bre = c.in(I_BRE) + c.l * 32;
    unsigned* cnt = c.ctl + CW_CNT + c.l * 32;
    float* lg = (float*)lds + wave * 16 * 48;
    if (wave < 4)
    for (int rt = blockIdx.x * 4 + wave; rt < NT / 16; rt += gridDim.x * 4) {
        const int r0 = rt * 16;
        float my_rs = 0.f;
#pragma unroll 2
        for (int rr = 0; rr < 16; ++rr) {
            const size_t ro = (size_t)(r0 + rr) * DM;
            f32x4 v[4]; float ss = 0.f;
#pragma unroll
            for (int i = 0; i < 4; ++i) { v[i] = *(const f32x4*)(c.out + ro + i * 256 + lane * 4); ss += v[i][0] * v[i][0] + v[i][1] * v[i][1] + v[i][2] * v[i][2] + v[i][3] * v[i][3]; }
            ss = wave_sum_dpp(ss);
            const float rs = rsqrtf(ss * (1.0f / DM) + 1e-6f);
            if ((lane & 15) == rr) my_rs = rs;
#pragma unroll
            for (int i = 0; i < 4; ++i) {
                const f32x4 g = *(const f32x4*)(gain + i * 256 + lane * 4);
                store_bf4(c.H + ro + i * 256 + lane * 4, (f32x4){v[i][0] * rs * g[0], v[i][1] * rs * g[1], v[i][2] * rs * g[2], v[i][3] * rs * g[3]});
            }
        }
        f32x4 acc0 = (f32x4){0.f, 0.f, 0.f, 0.f}, acc1 = acc0, acc2 = acc0;
        const float* xr = c.out + (size_t)(r0 + (lane & 15)) * DM + 4 * (lane >> 4);
        const int cl = lane & 15;
#pragma unroll 2
        for (int kb = 0; kb < 64; ++kb) {
            const f32x4 xa = *(const f32x4*)(xr + kb * 16);
            const f32x4 ga = *(const f32x4*)(gain + kb * 16 + 4 * (lane >> 4));
            const int k0 = kb * 16 + 4 * (lane >> 4);
            float b0[4], b1[4], b2[4];
#pragma unroll
            for (int m = 0; m < 4; ++m) { b0[m] = wre[(size_t)(k0 + m) * 32 + cl]; b1[m] = wre[(size_t)(k0 + m) * 32 + 16 + cl]; b2[m] = (cl < 4) ? wrg[(size_t)(k0 + m) * 4 + cl] : 0.f; }
#pragma unroll
            for (int m = 0; m < 4; ++m) {
                const float am = xa[m] * ga[m] * my_rs;
                acc0 = __builtin_amdgcn_mfma_f32_16x16x4f32(am, b0[m], acc0, 0, 0, 0);
                acc1 = __builtin_amdgcn_mfma_f32_16x16x4f32(am, b1[m], acc1, 0, 0, 0);
                acc2 = __builtin_amdgcn_mfma_f32_16x16x4f32(am, b2[m], acc2, 0, 0, 0);
            }
        }
        LDS_WAVE_SYNC();
#pragma unroll
        for (int i = 0; i < 4; ++i) { const int row = 4 * (lane >> 4) + i; lg[row * 48 + cl] = acc0[i]; lg[row * 48 + 16 + cl] = acc1[i]; lg[row * 48 + 32 + cl] = acc2[i]; }
        LDS_WAVE_SYNC();
        if (lane < 16) {
            const float* L = lg + lane * 48;
            float lgp[4];
#pragma unroll
            for (int o = 0; o < 4; ++o) lgp[o] = L[32 + o] + brg[o];
            int grp = 0; float gm = lgp[0];
#pragma unroll
            for (int o = 1; o < 4; ++o) if (lgp[o] > gm) { gm = lgp[o]; grp = o; }
            float gs = 0.f;
#pragma unroll
            for (int o = 0; o < 4; ++o) gs += __expf(lgp[o] - gm);
            const float ptop = 1.0f / gs;
            int i0 = 0; float v0 = -INFINITY; int i1 = 0; float v1 = -INFINITY;
            for (int o = 0; o < 8; ++o) { const float le = L[grp * 8 + o] + bre[grp * 8 + o]; if (le > v0) { v1 = v0; i1 = i0; v0 = le; i0 = o; } else if (le > v1) { v1 = le; i1 = o; } }
            const float e1 = __expf(v1 - v0), inv = 1.0f / (1.0f + e1);
            int* rt_ = c.ROUTE + (size_t)(r0 + lane) * 8;
            const int ex0 = grp * 8 + i0, ex1 = grp * 8 + i1;
            rt_[0] = ex0; rt_[1] = ex1; ((float*)rt_)[2] = inv * ptop; ((float*)rt_)[3] = e1 * inv * ptop;
            atomicAdd(cnt + ex0, 1u); atomicAdd(cnt + ex1, 1u);
        }
    }
}
DI void phase_route2(const Ctx& c, unsigned char* lds) {
    int* soff = (int*)lds;
    const unsigned* cnt = c.ctl + CW_CNT + c.l * 32;
    unsigned* cur = c.ctl + CW_CUR + c.l * 32;
    __syncthreads();
    if (TID() == 0) { int s = 0; for (int e = 0; e < 32; ++e) { soff[e] = s; s += (int)cnt[e]; } }
    __syncthreads();
    for (int t = blockIdx.x * NTHREADS + TID(); t < NT; t += gridDim.x * NTHREADS) {
        int* rt = c.ROUTE + (size_t)t * 8;
#pragma unroll
        for (int s = 0; s < 2; ++s) {
            const int e = rt[s];
            const int p = soff[e] + (int)atomicAdd(cur + e, 1u);
            rt[4 + s] = p;
            c.ENT[2 * p] = t; ((float*)c.ENT)[2 * p + 1] = ((const float*)rt)[2 + s];
        }
    }
}
DI void moe_tables(const Ctx& c, int* soff, int* stile, int ncol) {
    const unsigned* cnt = c.ctl + CW_CNT + c.l * 32;
    __syncthreads();
    if (TID() == 0) { int s = 0, tt = 0; for (int e = 0; e < 32; ++e) { soff[e] = s; stile[e] = tt; s += (int)cnt[e]; tt += (((int)cnt[e] + 255) >> 8) * ncol; } soff[32] = s; stile[32] = tt; }
    __syncthreads();
}
DI void phase_moe_up(const Ctx& c, unsigned char* lds) {
    int* soff = (int*)(lds + 2 * G_STAGE); int* stile = soff + 64;
    moe_tables(c, soff, stile, 2);
    const int total = stile[32];
    for (int item = blockIdx.x; item < total; item += gridDim.x) {
        int e = 0;
        for (int q = 1; q < 32; ++q) if (stile[q] <= item) e = q;
        const int loc = item - stile[e], tm = loc >> 1, tn = loc & 1, n0 = tn * 128;
        const int p0 = soff[e] + tm * 256, pend = soff[e + 1];
        ARows ar; ar.mu = nullptr; ar.ltype = 0; ar.first = 0;
#pragma unroll
        for (int i = 0; i < 4; ++i) { const int pr = p0 + (TID() >> 3) + 64 * i; ar.p[i] = (pr < pend) ? c.H + (size_t)c.ENT[2 * pr] * DM : nullptr; }
        {
            f32x4 ag[4][4]; acc_zero(ag);
            gemm_core<0>(ag, ar, (const bf16_t*)(c.ws + WS_EG) + ((size_t)e * 256 + n0) * DM, DM, DM, lds);
            ACC_FOREACH(ag, { if (p0 + r_ < pend) store_bf4(c.HID + (size_t)(p0 + r_) * 256 + n0 + c_, (f32x4){v_[0] * sigmoidf_(v_[0]), v_[1] * sigmoidf_(v_[1]), v_[2] * sigmoidf_(v_[2]), v_[3] * sigmoidf_(v_[3])}); });
        }
        f32x4 au[4][4]; acc_zero(au);
        gemm_core<0>(au, ar, (const bf16_t*)(c.ws + WS_EU) + ((size_t)e * 256 + n0) * DM, DM, DM, lds);
        ACC_FOREACH(au, { if (p0 + r_ < pend) { bf16_t* q = c.HID + (size_t)(p0 + r_) * 256 + n0 + c_; const u32x2 sv = *(const u32x2*)q;
            store_bf4(q, (f32x4){bflo(sv.x) * v_[0], bfhi(sv.x) * v_[1], bflo(sv.y) * v_[2], bfhi(sv.y) * v_[3]}); } });
    }
}
DI void phase_moe_down(const Ctx& c, unsigned char* lds) {
    int* soff = (int*)(lds + 2 * G_STAGE); int* stile = soff + 64;
    moe_tables(c, soff, stile, 8);
    const int total = stile[32];
    for (int item = blockIdx.x; item < total; item += gridDim.x) {
        int e = 0;
        for (int q = 1; q < 32; ++q) if (stile[q] <= item) e = q;
        const int loc = item - stile[e], tm = loc >> 3, tn = loc & 7, n0 = tn * 128;
        const int p0 = soff[e] + tm * 256, pend = soff[e + 1];
        ARows ar; ar.mu = nullptr; ar.ltype = 0; ar.first = 0;
#pragma unroll
        for (int i = 0; i < 4; ++i) { const int pr = p0 + (TID() >> 3) + 64 * i; ar.p[i] = (pr < pend) ? c.HID + (size_t)pr * 256 : nullptr; }
        f32x4 acc[4][4]; acc_zero(acc);
        gemm_core<0>(acc, ar, (const bf16_t*)(c.ws + WS_ED) + ((size_t)e * DM + n0) * 256, 256, 256, lds);
        ACC_FOREACH(acc, { if (p0 + r_ < pend) { const float w = ((const float*)c.ENT)[2 * (p0 + r_) + 1];
            store_bf4(c.Y + (size_t)(p0 + r_) * DM + n0 + c_, (f32x4){v_[0] * w, v_[1] * w, v_[2] * w, v_[3] * w}); } });
    }
}
DI void phase_final(const Ctx& c) {
    const int tid = TID(), lane = tid & 63, wave = tid >> 6;
    const float* gain = c.in(I_NFIN);
    for (int row = blockIdx.x * 8 + wave; row < NT; row += gridDim.x * 8) {
        f32x4 v[4];
#pragma unroll
        for (int i = 0; i < 4; ++i) v[i] = *(const f32x4*)(c.out + (size_t)row * DM + i * 256 + lane * 4);
        add_moe_rows(c, row, lane, v);
        float ss = 0.f;
#pragma unroll
        for (int i = 0; i < 4; ++i) ss += v[i][0] * v[i][0] + v[i][1] * v[i][1] + v[i][2] * v[i][2] + v[i][3] * v[i][3];
        ss = wave_sum_dpp(ss);
        const float rs = rsqrtf(ss * (1.0f / DM) + 1e-6f);
#pragma unroll
        for (int i = 0; i < 4; ++i) {
            const f32x4 g = *(const f32x4*)(gain + i * 256 + lane * 4);
            *(f32x4*)(c.out + (size_t)row * DM + i * 256 + lane * 4) = (f32x4){v[i][0] * rs * g[0], v[i][1] * rs * g[1], v[i][2] * rs * g[2], v[i][3] * rs * g[3]};
        }
    }
}

constexpr int PH_PER_LAYER = 12, N_PHASES = DEPTH * PH_PER_LAYER + 1;
__global__ void __launch_bounds__(NTHREADS, 2) fwd_kernel(Params P) {
    extern __shared__ __attribute__((aligned(16))) unsigned char lds[];
    const int lo = P.ph_lo, hi = P.ph_hi;
    LAS unsigned* xbw = (LAS unsigned*)(lds + LDS_BYTES - 16);
    if (threadIdx.x == 0) { xbw[0] = 0u; xbw[1] = 0u; xbw[2] = 0u; xbw[3] = 0u; }
    __syncthreads();
    Ctx c; c.P = &P; c.ws = P.ws; c.out = P.out; c.l = 0;
    c.ctl = (unsigned*)(P.ws + WS_CTL);
    c.H = (bf16_t*)(P.ws + WS_H); c.PROJ = (bf16_t*)(P.ws + WS_PROJ); c.F = (bf16_t*)(P.ws + WS_F); c.POOLED = (bf16_t*)(P.ws + WS_POOLED);
    c.MERGED = (bf16_t*)(P.ws + WS_F); c.CMPH = (bf16_t*)(P.ws + WS_CMPH); c.CMPO = (float*)(P.ws + WS_CMPO); c.POSB = (float*)(P.ws + WS_POSB);
    c.ROUTE = (int*)(P.ws + WS_ROUTE); c.ENT = (int*)(P.ws + WS_ENT); c.HID = (bf16_t*)(P.ws + WS_HID); c.Y = (bf16_t*)(P.ws + WS_Y);
    c.VT = (bf16_t*)(P.ws + WS_VT); c.KC = (bf16_t*)(P.ws + WS_KC); c.VCT = (bf16_t*)(P.ws + WS_VCT); c.YRAW = (bf16_t*)(P.ws + WS_YRAW); c.BON = (float*)(P.ws + WS_BON);
    XcdBarrier bar; bar.bar = c.ctl + CW_BAR; bar.x = 0; bar.st = (volatile LAS unsigned*)xbw;
    if (hi - lo > 1) bar = xcd_barrier_post(c.ctl + CW_BAR, (volatile LAS unsigned*)xbw);
#define IN(k) (lo <= (k) && (k) < hi)
#define SEAM(k) do { if (IN(k) && IN((k) + 1)) xcd_barrier(bar); } while (0)
#pragma unroll 1
    for (int l = 0; l < DEPTH; ++l) {
        c.l = l; const int pb = l * PH_PER_LAYER;
        if (IN(pb + 0)) phase_norm1(c, lds);
        SEAM(pb + 0);
        if (IN(pb + 1)) phase_gemm1(c, lds);
        SEAM(pb + 1);
        if (IN(pb + 2)) phase_prep(c, lds);
        SEAM(pb + 2);
        if (IN(pb + 3)) phase_poolgemm(c, lds);
        SEAM(pb + 3);
        if (IN(pb + 4)) phase_mix(c, lds);
        SEAM(pb + 4);
        if (IN(pb + 5)) phase_rwkv_post(c, lds);
        SEAM(pb + 5);
        if (IN(pb + 6)) phase_merge(c, lds);
        SEAM(pb + 6);
        if (IN(pb + 7)) phase_outp(c, lds);
        SEAM(pb + 7);
        if (IN(pb + 8)) phase_norm2(c, lds);
        SEAM(pb + 8);
        if (IN(pb + 9)) phase_route2(c, lds);
        SEAM(pb + 9);
        if (IN(pb + 10)) phase_moe_up(c, lds);
        SEAM(pb + 10);
        if (IN(pb + 11)) phase_moe_down(c, lds);
        SEAM(pb + 11);
    }
    if (IN(N_PHASES - 1)) phase_final(c);
}

#ifndef MK_N_LAUNCHES
#define MK_N_LAUNCHES 1
#endif
extern "C" void kernel_launch(void* const* d_in, const int* in_sizes, int n_in, void* d_out, int out_size, void* d_ws, size_t ws_size, hipStream_t stream) {
    static int grid = 0;
    if (grid == 0) {
        if (n_in != N_IN || out_size != NT * DM || ws_size < WS_END) { fprintf(stderr, "kernel_launch: unexpected shapes n_in %d out %d ws %zu (need %zu)\n", n_in, out_size, ws_size, (size_t)WS_END); grid = -1; return; }
        int dev = 0, cus = 0, per_cu = 0;
        if (hipGetDevice(&dev) != hipSuccess || hipDeviceGetAttribute(&cus, hipDeviceAttributeMultiprocessorCount, dev) != hipSuccess) { grid = -1; return; }
        if (hipFuncSetAttribute((const void*)fwd_kernel, hipFuncAttributeMaxDynamicSharedMemorySize, LDS_BYTES) != hipSuccess) { fprintf(stderr, "kernel_launch: hipFuncSetAttribute failed\n"); grid = -1; return; }
        if (hipOccupancyMaxActiveBlocksPerMultiprocessor(&per_cu, (const void*)fwd_kernel, NTHREADS, LDS_BYTES) != hipSuccess || per_cu < 1) { fprintf(stderr, "kernel_launch: occupancy query says %d\n", per_cu); }
        (void)hipGetLastError();
        grid = cus;
    }
    if (grid < 0) return;
    if (hipMemsetAsync((char*)d_ws + WS_CTL, 0, CTL_BYTES, stream) != hipSuccess) return;
    Params p{};
    for (int i = 0; i < N_IN; ++i) p.in[i] = (const float*)d_in[i];
    p.out = (float*)d_out; p.ws = (unsigned char*)d_ws;
    if (MK_N_LAUNCHES == 1) {
        p.ph_lo = 0; p.ph_hi = N_PHASES;
        hipLaunchKernelGGL(fwd_kernel, dim3(grid), dim3(NTHREADS), LDS_BYTES, stream, p);
    } else {
        for (int k = 0; k < N_PHASES; ++k) { p.ph_lo = k; p.ph_hi = k + 1; hipLaunchKernelGGL(fwd_kernel, dim3(grid), dim3(NTHREADS), LDS_BYTES, stream, p); }
    }
}
```

```cpp
#include <hip/hip_runtime.h>
#include <cstdio>
#include <cstdint>

#define DI __device__ __forceinline__
typedef unsigned short bf16_t;
typedef short bf16x8 __attribute__((ext_vector_type(8)));
typedef float f32x4 __attribute__((ext_vector_type(4)));
typedef unsigned u32x4 __attribute__((ext_vector_type(4)));
typedef unsigned u32x2 __attribute__((ext_vector_type(2)));

constexpr int NB = 4, SEQ = 4096, DM = 1024, NT = NB * SEQ, DEPTH = 2;
constexpr int IN_COLS = 4816;
constexpr int C_POOL = 0, C_RW = 512, C_R = 512, C_K = 1024, C_V = 1536, C_WD = 2048, C_AD = 2080, C_GD = 2112;
constexpr int C_Q = 2208, C_KC = 3232, C_VC = 3488, C_KS = 3744, C_VS = 4000, C_KW = 4256, C_VW = 4512, C_GATE = 4768;
constexpr int RWC = 1696;
constexpr int NCMP = 255;
constexpr int NTHREADS = 512;
constexpr int LDS_BYTES = 155648;

enum { I_X = 0, I_RELB, I_NMIX, I_WIN, I_POOLW, I_POOLS, I_MU, I_W0, I_WUP, I_A0, I_AUP, I_GUP, I_KK, I_KA, I_RK, I_GNW, I_GNB,
       I_CPK, I_CW1K, I_CW2K, I_CPV, I_CW1V, I_CW2V, I_WBR, I_WMG, I_BMG, I_WOUT, I_NFFN, I_WRG, I_BRG, I_WRE, I_BRE, I_EG, I_EU, I_ED, I_NFIN, N_IN };

constexpr size_t WS_CTL = 0;
constexpr size_t CTL_BYTES = 65536;
constexpr size_t WS_H = CTL_BYTES;
constexpr size_t WS_PROJ = WS_H + (size_t)NT * DM * 2;
constexpr size_t WS_F = WS_PROJ + (size_t)NT * IN_COLS * 2;
constexpr size_t PLANE = (size_t)NT * 512 * 2;
constexpr size_t WS_POOLED = WS_F + 6 * PLANE;
constexpr size_t WS_CMPH = WS_POOLED + PLANE;
constexpr size_t WS_CMPO = WS_CMPH + (size_t)2 * 4096 * 256 * 2;
constexpr size_t WS_POSB = WS_CMPO + (size_t)2 * 4096 * 64 * 4;
constexpr size_t WS_ROUTE = WS_POSB + 4096;
constexpr size_t WS_ENT = WS_ROUTE + (size_t)NT * 32;
constexpr size_t WS_VT = WS_ENT + (size_t)2 * NT * 8;
constexpr size_t WS_KC = WS_VT + (size_t)2 * 16 * 64 * SEQ * 2;
constexpr size_t WS_VCT = WS_KC + (size_t)16 * 256 * 64 * 2;
constexpr size_t WS_YRAW = WS_VCT + (size_t)16 * 64 * 256 * 2;
constexpr size_t WS_BON = WS_YRAW + (size_t)NT * 512 * 2;
constexpr size_t WS_SMALLW = WS_BON + (size_t)NT * 8 * 16;
constexpr size_t WS_WT_LORA = WS_SMALLW + 262144;
constexpr size_t WS_END = WS_WT_LORA + (size_t)1536 * 128 * 2;
constexpr size_t WS_WT_IN = WS_F;
constexpr size_t WS_WT_C1 = WS_CMPO;
constexpr size_t WS_WT_C2 = WS_SMALLW;
constexpr size_t WS_WT_POOL = WS_SMALLW + 131072;
constexpr size_t WS_WT_MG = WS_VT;
constexpr size_t WS_WT_BR = WS_VT + (size_t)3072 * 1024 * 2;
constexpr size_t WS_WT_OUT = WS_CMPH;
constexpr size_t WS_EG = WS_F + 2 * PLANE;
constexpr size_t WS_EU = WS_EG + (size_t)32 * 256 * 1024 * 2;
constexpr size_t WS_ED = WS_EU + (size_t)32 * 256 * 1024 * 2;
static_assert(WS_ED + (size_t)32 * 1024 * 256 * 2 <= WS_F + 6 * PLANE, "expert alias");
static_assert(WS_WT_BR + (size_t)2048 * 1024 * 2 <= WS_VT + (size_t)2 * 16 * 64 * SEQ * 2, "merge alias");
static_assert((size_t)4864 * 1024 * 2 <= 6 * PLANE, "w_in alias");
constexpr size_t WS_HID = WS_PROJ;
constexpr size_t WS_Y = WS_PROJ + (size_t)2 * NT * 256 * 2;
static_assert(WS_Y + (size_t)2 * NT * 1024 * 2 <= WS_F, "alias");
constexpr int CW_BAR = 0;
constexpr int CW_CNT = 4096;
constexpr int CW_CUR = 4096 + 64;
constexpr int CW_Q = 4096 + 128;

#define XB_TMO      128
#define XB_XCNT(j)  (256  + 64 * (j))
#define XB_XSUB(j)  (1280 + 64 * (j))
#define XB_XGEN(j)  (2304 + 64 * (j))
#define XB_TOP      3328
#define XB_TOPGEN   3392
#define XCD_BAR_WORDS 3456
#define XB_SPIN_CAP (1u << 18)
#define LAS __attribute__((address_space(3)))

__device__ __forceinline__ unsigned xb_ld(unsigned* p)              { return __hip_atomic_load(p, __ATOMIC_RELAXED, __HIP_MEMORY_SCOPE_AGENT); }
__device__ __forceinline__ unsigned xb_add(unsigned* p, unsigned v) { return __hip_atomic_fetch_add(p, v, __ATOMIC_RELAXED, __HIP_MEMORY_SCOPE_AGENT); }
__device__ __forceinline__ unsigned xb_xcc_id() { return (unsigned)__builtin_amdgcn_s_getreg((3 << 11) | 20) & 0xFu; }
#define XB_SPIN(cond, bar) do { unsigned _sp = 0; while (cond) { __builtin_amdgcn_s_sleep(1); \
    if ((++_sp & 255u) == 0u) { if (xb_ld(&(bar)[XB_TMO])) break; if (_sp > XB_SPIN_CAP) { atomicAdd(&(bar)[XB_TMO], 1u); break; } } } } while (0)

struct XcdBarrier { unsigned* bar; unsigned x; volatile LAS unsigned* st; };

__device__ __forceinline__ XcdBarrier xcd_barrier_post(unsigned* bar, volatile LAS unsigned* st) {
    XcdBarrier b; b.bar = bar; b.x = xb_xcc_id(); b.st = st;
    if (threadIdx.x == 0) (void)xb_add(&bar[XB_XCNT(b.x)], 1u);
    return b;
}
__device__ __forceinline__ void xcd_barrier_complete(unsigned* bar, unsigned x, unsigned& nloc, unsigned& nx) {
    const unsigned G = gridDim.x * gridDim.y * gridDim.z;
    unsigned sum, cnt, mine, sp = 0u;
    for (;;) {
        sum = 0u; cnt = 0u; mine = 0u;
#pragma unroll
        for (unsigned j = 0; j < 16; ++j) { const unsigned c = xb_ld(&bar[XB_XCNT(j)]); sum += c; cnt += (c > 0u) ? 1u : 0u; mine = (j == x) ? c : mine; }
        if (sum == G) break;
        __builtin_amdgcn_s_sleep(1);
        if ((++sp & 255u) == 0u) { if (xb_ld(&bar[XB_TMO])) break; if (sp > XB_SPIN_CAP) { atomicAdd(&bar[XB_TMO], 1u); break; } }
    }
    nloc = mine > 0u ? mine : 1u; nx = cnt > 0u ? cnt : 1u;
}
__device__ __forceinline__ void xcd_barrier(const XcdBarrier& b) {
    asm volatile("s_waitcnt vmcnt(0)" ::: "memory");
    __syncthreads();
    if (threadIdx.x == 0) {
        unsigned* bar = b.bar;
        __builtin_amdgcn_s_waitcnt(0);
        unsigned nloc = b.st[0], nx = b.st[1];
        if (nloc == 0u) { xcd_barrier_complete(bar, b.x, nloc, nx); b.st[0] = nloc; b.st[1] = nx; }
        const unsigned old = xb_add(&bar[XB_XSUB(b.x)], 1u);
        const unsigned gen = old / nloc;
        if (old + 1u == (gen + 1u) * nloc) {
            __builtin_amdgcn_fence(__ATOMIC_RELEASE, "agent");
            asm volatile("s_waitcnt vmcnt(0)" ::: "memory");
            const unsigned og = xb_add(&bar[XB_TOP], 1u);
            const unsigned tg = og / nx;
            if (og + 1u == (tg + 1u) * nx) xb_add(&bar[XB_TOPGEN], 1u);
            else XB_SPIN(xb_ld(&bar[XB_TOPGEN]) == tg, bar);
            __builtin_amdgcn_fence(__ATOMIC_ACQUIRE, "agent");
            xb_add(&bar[XB_XGEN(b.x)], 1u);
            asm volatile("s_waitcnt vmcnt(0)" ::: "memory");
        } else {
            XB_SPIN(xb_ld(&bar[XB_XGEN(b.x)]) == gen, bar);
            __builtin_amdgcn_fence(__ATOMIC_ACQUIRE, "agent");
            asm volatile("s_waitcnt vmcnt(0)" ::: "memory");
        }
    }
    __syncthreads();
}

DI bf16_t f2bf(float x) { unsigned u = __float_as_uint(x); u += 0x7fffu + ((u >> 16) & 1u); return (bf16_t)(u >> 16); }
DI float bf2f(bf16_t b) { return __uint_as_float((unsigned)b << 16); }
typedef __bf16 bf16v2_t __attribute__((ext_vector_type(2)));
typedef float f32v2_t __attribute__((ext_vector_type(2)));
DI unsigned pack2(float lo, float hi) { const f32v2_t v = {lo, hi}; const bf16v2_t b = __builtin_convertvector(v, bf16v2_t); return __builtin_bit_cast(unsigned, b); }
DI float bflo(unsigned w) { return __uint_as_float(w << 16); }
DI float bfhi(unsigned w) { return __uint_as_float(w & 0xffff0000u); }
DI float wave_sum(float v) {
#pragma unroll
    for (int o = 32; o >= 1; o >>= 1) v += __shfl_xor(v, o);
    return v;
}
DI float wave_max(float v) {
#pragma unroll
    for (int o = 32; o >= 1; o >>= 1) v = fmaxf(v, __shfl_xor(v, o));
    return v;
}
DI float sigmoidf_(float x) { return __builtin_amdgcn_rcpf(1.0f + __expf(-x)); }
DI int TID() { int t = threadIdx.x; asm volatile("" : "+v"(t)); return t; }
#define LDS_WAVE_SYNC() asm volatile("s_waitcnt lgkmcnt(0)" ::: "memory")

#define DPP_MOV(v, ctrl) __builtin_bit_cast(float, __builtin_amdgcn_update_dpp(0, __builtin_bit_cast(int, (v)), (ctrl), 0xF, 0xF, true))
DI float wave_sum_dpp(float v) {
    v += DPP_MOV(v, 0xB1); v += DPP_MOV(v, 0x4E); v += DPP_MOV(v, 0x141); v += DPP_MOV(v, 0x140);
    return __builtin_bit_cast(float, __builtin_amdgcn_readlane(__builtin_bit_cast(int, v), 0)) + __builtin_bit_cast(float, __builtin_amdgcn_readlane(__builtin_bit_cast(int, v), 16)) +
        (__builtin_bit_cast(float, __builtin_amdgcn_readlane(__builtin_bit_cast(int, v), 32)) + __builtin_bit_cast(float, __builtin_amdgcn_readlane(__builtin_bit_cast(int, v), 48)));
}
struct Params { const float* in[N_IN]; float* out; unsigned char* ws; int ph_lo, ph_hi; };

DI int t5_bucket(int n) {
    if (n < 16) return n;
    if (n >= 128) return 31;
    int b = 16;
    b += (n >= 19) + (n >= 21) + (n >= 24) + (n >= 27) + (n >= 31) + (n >= 35) + (n >= 40) + (n >= 46) + (n >= 52) + (n >= 59) + (n >= 67) + (n >= 77) + (n >= 87) + (n >= 99) + (n >= 113);
    return b;
}

constexpr int G_A = 0, G_B = 256 * 64 * 2, G_STAGE = (256 + 128) * 64 * 2;
static_assert(2 * G_STAGE <= LDS_BYTES - 64, "gemm lds");
DI int g_off(int r, int c) { return ((r >> 4) * 2 + (c >> 5)) * 1024 + ((((r & 15) * 64) + (c & 31) * 2) ^ ((((r & 15) >> 3) & 1) << 5)); }
struct ARows { const bf16_t* p[4]; const float* mu; int ltype; int first; };
DI float tanhf_fast(float x) { const float e = __expf(2.0f * x); return 1.0f - 2.0f * __builtin_amdgcn_rcpf(e + 1.0f); }
DI u32x4 lora_chunk(const bf16_t* prow, bool first, const float* mu, int ltype, int k) {
    const int lim = (ltype == 2) ? 96 : 32;
    if (k >= lim) return (u32x4){0u, 0u, 0u, 0u};
    const int col = C_WD + ltype * 32 + k;
    const u32x4 cu = *(const u32x4*)(prow + col);
    u32x4 pu = (u32x4){0u, 0u, 0u, 0u};
    if (!first) pu = *(const u32x4*)(prow - IN_COLS + col);
    const f32x4 m0 = *(const f32x4*)(mu + col - C_RW), m1 = *(const f32x4*)(mu + col - C_RW + 4);
    float u[8] = {bflo(cu.x), bfhi(cu.x), bflo(cu.y), bfhi(cu.y), bflo(cu.z), bfhi(cu.z), bflo(cu.w), bfhi(cu.w)};
    const float p[8] = {bflo(pu.x), bfhi(pu.x), bflo(pu.y), bfhi(pu.y), bflo(pu.z), bfhi(pu.z), bflo(pu.w), bfhi(pu.w)};
    const float mm[8] = {m0[0], m0[1], m0[2], m0[3], m1[0], m1[1], m1[2], m1[3]};
#pragma unroll
    for (int j = 0; j < 8; ++j) { const float us = u[j] + (p[j] - u[j]) * mm[j]; u[j] = (ltype == 0) ? tanhf_fast(us) : ((ltype == 1) ? us : __builtin_amdgcn_rcpf(1.0f + __expf(-us))); }
    u32x4 w; w.x = pack2(u[0], u[1]); w.y = pack2(u[2], u[3]); w.z = pack2(u[4], u[5]); w.w = pack2(u[6], u[7]);
    return w;
}
template <int AMODE>
DI void g_load(u32x4 (&ra)[4], u32x4 (&rb)[2], const ARows& ar, const bf16_t* bt, int ldb, int k0, int tid) {
    const int kseg = (tid & 7) * 8;
#pragma unroll
    for (int i = 0; i < 4; ++i) {
        ra[i] = (u32x4){0u, 0u, 0u, 0u};
        if (AMODE == 2) ra[i] = lora_chunk(ar.p[i], (ar.first >> i) & 1, ar.mu, ar.ltype, k0 + kseg);
        else if (ar.p[i] != nullptr) ra[i] = *(const u32x4*)((AMODE == 0) ? (ar.p[i] + k0 + kseg) : (ar.p[i] + (size_t)(k0 >> 6) * IN_COLS + kseg));
    }
#pragma unroll
    for (int i = 0; i < 2; ++i) rb[i] = *(const u32x4*)(bt + (size_t)((tid >> 3) + 64 * i) * ldb + k0 + kseg);
}
DI void g_store(unsigned char* st, const u32x4 (&ra)[4], const u32x4 (&rb)[2], int tid) {
    const int off = g_off(tid >> 3, (tid & 7) * 8);
#pragma unroll
    for (int i = 0; i < 4; ++i) *(u32x4*)(st + G_A + off + i * 8192) = ra[i];
#pragma unroll
    for (int i = 0; i < 2; ++i) *(u32x4*)(st + G_B + off + i * 8192) = rb[i];
}
DI void g_compute(f32x4 (&acc)[4][4], const unsigned char* st, int lane, int wm, int wn) {
    const int lo = ((lane & 15) * 64 + (lane >> 4) * 16) ^ ((((lane & 15) >> 3) & 1) << 5);
    const unsigned char* sA = st + G_A + wm * 8192 + lo;
    const unsigned char* sB = st + G_B + wn * 8192 + lo;
    bf16x8 bcur[4], bnxt[4], a0, a1, a2;
#pragma unroll
    for (int i = 0; i < 4; ++i) bcur[i] = *(const bf16x8*)(sB + i * 2048);
    a0 = *(const bf16x8*)(sA);
    a1 = *(const bf16x8*)(sA + 2048);
#define G_AFRAG(s) (*(const bf16x8*)(sA + ((s) & 3) * 2048 + ((s) >> 2) * 1024))
#define G_GROUP(s, acur, anew) do { \
        if ((s) + 2 < 8) anew = G_AFRAG((s) + 2); \
        if ((s) < 4) bnxt[(s) & 3] = *(const bf16x8*)(sB + ((s) & 3) * 2048 + 1024); \
        __builtin_amdgcn_sched_barrier(0); \
        _Pragma("unroll") for (int ni = 0; ni < 4; ++ni) acc[(s) & 3][ni] = __builtin_amdgcn_mfma_f32_16x16x32_bf16(((s) < 4 ? bcur[ni] : bnxt[ni]), acur, acc[(s) & 3][ni], 0, 0, 0); \
        __builtin_amdgcn_sched_barrier(0); } while (0)
    G_GROUP(0, a0, a2); G_GROUP(1, a1, a0); G_GROUP(2, a2, a1); G_GROUP(3, a0, a2);
    G_GROUP(4, a1, a0); G_GROUP(5, a2, a1); G_GROUP(6, a0, a2); G_GROUP(7, a1, a0);
#undef G_GROUP
#undef G_AFRAG
}
#define LDS_BARRIER() do { asm volatile("s_waitcnt lgkmcnt(0)" ::: "memory"); __builtin_amdgcn_s_barrier(); asm volatile("" ::: "memory"); } while (0)
template <int AMODE>
DI void gemm_core(f32x4 (&acc)[4][4], const ARows& ar, const bf16_t* bt  , int ldb, int K, unsigned char* lds) {
    const int tid = TID(), lane = tid & 63, wave = tid >> 6, wm = wave >> 1, wn = wave & 1;
    const int nk = K >> 6;
    unsigned char* s0 = lds; unsigned char* s1 = lds + G_STAGE;
    u32x4 ra0[4], rb0[2], ra1[4], rb1[2];
    g_load<AMODE>(ra0, rb0, ar, bt, ldb, 0, tid);
    g_load<AMODE>(ra1, rb1, ar, bt, ldb, 64, tid);
    __syncthreads();
    g_store(s0, ra0, rb0, tid);
    g_load<AMODE>(ra0, rb0, ar, bt, ldb, (nk > 2 ? 2 : nk - 1) * 64, tid);
    LDS_BARRIER();
    for (int kt = 0; kt < nk; kt += 2) {
        g_store(s1, ra1, rb1, tid);
        { const int kn = (kt + 3 < nk) ? kt + 3 : nk - 1; g_load<AMODE>(ra1, rb1, ar, bt, ldb, kn * 64, tid); }
        g_compute(acc, s0, lane, wm, wn);
        LDS_BARRIER();
        g_store(s0, ra0, rb0, tid);
        { const int kn = (kt + 4 < nk) ? kt + 4 : nk - 1; g_load<AMODE>(ra0, rb0, ar, bt, ldb, kn * 64, tid); }
        g_compute(acc, s1, lane, wm, wn);
        LDS_BARRIER();
    }
}
static_assert(3 * G_STAGE <= LDS_BYTES - 64, "dma ring");
DI void gemm_core_dma(f32x4 (&acc)[4][4], const bf16_t* A, size_t lda, const bf16_t* bt, size_t ldb, int K, unsigned char* lds) {
    const int tid = TID(), lane = tid & 63, wave = __builtin_amdgcn_readfirstlane(tid >> 6), wm = wave >> 1, wn = wave & 1;
    const int nk = K >> 6;
    const int srow = lane >> 2, skof = ((lane & 3) * 8) ^ ((lane >> 5) << 4);
    const char* gp[6]; int loff[6];
#pragma unroll
    for (int j = 0; j < 6; ++j) {
        const int sid = wave * 6 + j;
        if (sid < 32) { gp[j] = (const char*)(A + (size_t)((sid >> 1) * 16 + srow) * lda + (sid & 1) * 32 + skof); loff[j] = G_A + sid * 1024; }
        else { const int s2 = sid - 32; gp[j] = (const char*)(bt + (size_t)((s2 >> 1) * 16 + srow) * ldb + (s2 & 1) * 32 + skof); loff[j] = G_B + s2 * 1024; }
    }
#define DMA_ISSUE(kt_, st_) do { const int _k = ((kt_) < nk ? (kt_) : nk - 1) * 128; \
        _Pragma("unroll") for (int j = 0; j < 6; ++j) __builtin_amdgcn_global_load_lds((const unsigned*)(gp[j] + _k), (LAS unsigned*)(lds + (st_) * G_STAGE + loff[j]), 16, 0, 0); } while (0)
    asm volatile("s_waitcnt vmcnt(0)" ::: "memory");
    __syncthreads();
    DMA_ISSUE(0, 0); DMA_ISSUE(1, 1);
    int st = 0;
    for (int kt = 0; kt < nk; ++kt) {
        asm volatile("s_waitcnt vmcnt(6)" ::: "memory");
        __builtin_amdgcn_s_barrier();
        asm volatile("" ::: "memory");
        const int sn = (st == 0) ? 2 : st - 1;
        DMA_ISSUE(kt + 2, sn);
        g_compute(acc, lds + st * G_STAGE, lane, wm, wn);
        st = (st == 2) ? 0 : st + 1;
    }
    asm volatile("s_waitcnt vmcnt(0)" ::: "memory");
    __syncthreads();
#undef DMA_ISSUE
}
DI void acc_zero(f32x4 (&acc)[4][4]) {
#pragma unroll
    for (int i = 0; i < 4; ++i)
#pragma unroll
        for (int j = 0; j < 4; ++j) acc[i][j] = (f32x4){0.f, 0.f, 0.f, 0.f};
}
#define ACC_FOREACH(acc, body) do { const int _l = TID() & 63, _w = TID() >> 6; \
    _Pragma("unroll") for (int _mi = 0; _mi < 4; ++_mi) _Pragma("unroll") for (int _ni = 0; _ni < 4; ++_ni) { \
        const int r_ = (_w >> 1) * 64 + _mi * 16 + (_l & 15), c_ = (_w & 1) * 64 + _ni * 16 + (_l >> 4) * 4; f32x4& v_ = acc[_mi][_ni]; body } } while (0)
DI ARows plain_rows(const bf16_t* base, size_t ld, int m0, int tid) { ARows a; a.mu = nullptr; a.ltype = 0; a.first = 0;
#pragma unroll
    for (int i = 0; i < 4; ++i) a.p[i] = base + (size_t)(m0 + (tid >> 3) + 64 * i) * ld;
    return a; }

DI void store_bf4(bf16_t* p, f32x4 v) { u32x2 w; w.x = pack2(v[0], v[1]); w.y = pack2(v[2], v[3]); *(u32x2*)p = w; }

DI void convert_tile4(const float* src, int ld, int N, int K, bf16_t* dst, int tile0, unsigned char* lds, int Kvalid = 1 << 30) {
    const int tid = TID();
    const int nkt = K >> 6;
    const int r = tid >> 3, seg = (tid & 7) * 8;
    f32x4 a[4], b[4];
#pragma unroll
    for (int u = 0; u < 4; ++u) {
        const int tile = tile0 + u, k0 = (tile % nkt) * 64, n0 = (tile / nkt) * 64;
        a[u] = (f32x4){0.f, 0.f, 0.f, 0.f}; b[u] = a[u];
        if (n0 + seg < N && k0 + r < Kvalid) { const float* q = src + (size_t)(k0 + r) * ld + n0 + seg; a[u] = *(const f32x4*)q; b[u] = *(const f32x4*)(q + 4); }
    }
    __syncthreads();
#pragma unroll
    for (int u = 0; u < 4; ++u) { bf16_t* T = (bf16_t*)lds + u * 64 * 72;
        u32x4 w; w.x = pack2(a[u][0], a[u][1]); w.y = pack2(a[u][2], a[u][3]); w.z = pack2(b[u][0], b[u][1]); w.w = pack2(b[u][2], b[u][3]); *(u32x4*)(T + r * 72 + seg) = w; }
    __syncthreads();
#pragma unroll
    for (int u = 0; u < 4; ++u) { const bf16_t* T = (const bf16_t*)lds + u * 64 * 72;
        const int tile = tile0 + u, k0 = (tile % nkt) * 64, n0 = (tile / nkt) * 64;
        u32x4 o;
        o.x = (unsigned)T[(seg + 0) * 72 + r] | ((unsigned)T[(seg + 1) * 72 + r] << 16); o.y = (unsigned)T[(seg + 2) * 72 + r] | ((unsigned)T[(seg + 3) * 72 + r] << 16);
        o.z = (unsigned)T[(seg + 4) * 72 + r] | ((unsigned)T[(seg + 5) * 72 + r] << 16); o.w = (unsigned)T[(seg + 6) * 72 + r] | ((unsigned)T[(seg + 7) * 72 + r] << 16);
        *(u32x4*)(dst + (size_t)(n0 + r) * K + k0 + seg) = o; }
}
struct Ctx {
    const Params* P; unsigned char* ws; float* out; int l;
    bf16_t* H; bf16_t* PROJ; bf16_t* F; bf16_t* POOLED; bf16_t* MERGED; bf16_t* CMPH; float* CMPO; float* POSB; int* ROUTE; int* ENT; bf16_t* HID; bf16_t* Y; bf16_t* VT; bf16_t* KC; bf16_t* VCT; bf16_t* YRAW; float* BON; unsigned* ctl;
    DI const float* in(int i) const { return P->in[i]; }
};

DI void add_moe_rows(const Ctx& c, int row, int lane, f32x4 (&v)[4]) {
    const int* rt = c.ROUTE + (size_t)row * 8;
    const int p0 = rt[4], p1 = rt[5];
    const bf16_t* y0 = c.Y + (size_t)p0 * DM; const bf16_t* y1 = c.Y + (size_t)p1 * DM;
#pragma unroll
    for (int i = 0; i < 4; ++i) {
        const u32x2 a = *(const u32x2*)(y0 + i * 256 + lane * 4), b = *(const u32x2*)(y1 + i * 256 + lane * 4);
        v[i][0] += bflo(a.x) + bflo(b.x); v[i][1] += bfhi(a.x) + bfhi(b.x); v[i][2] += bflo(a.y) + bflo(b.y); v[i][3] += bfhi(a.y) + bfhi(b.y);
    }
}
DI void phase_norm1(const Ctx& c, unsigned char* lds) {
    const int tid = TID(), lane = tid & 63, wave = tid >> 6;
    const float* gain = c.in(I_NMIX) + c.l * DM;
    const float* src = (c.l == 0) ? c.in(I_X) : c.out;
    for (int row = blockIdx.x * 8 + wave; row < NT; row += gridDim.x * 8) {
        f32x4 v[4];
#pragma unroll
        for (int i = 0; i < 4; ++i) v[i] = *(const f32x4*)(src + (size_t)row * DM + i * 256 + lane * 4);
        if (c.l > 0) {
            add_moe_rows(c, row, lane, v);
#pragma unroll
            for (int i = 0; i < 4; ++i) *(f32x4*)(c.out + (size_t)row * DM + i * 256 + lane * 4) = v[i];
        }
        float ss = 0.f;
#pragma unroll
        for (int i = 0; i < 4; ++i) ss += v[i][0] * v[i][0] + v[i][1] * v[i][1] + v[i][2] * v[i][2] + v[i][3] * v[i][3];
        ss = wave_sum_dpp(ss);
        const float rs = rsqrtf(ss * (1.0f / DM) + 1e-6f);
#pragma unroll
        for (int i = 0; i < 4; ++i) {
            const f32x4 g = *(const f32x4*)(gain + i * 256 + lane * 4);
            store_bf4(c.H + (size_t)row * DM + i * 256 + lane * 4, (f32x4){v[i][0] * rs * g[0], v[i][1] * rs * g[1], v[i][2] * rs * g[2], v[i][3] * rs * g[3]});
        }
    }
    for (int idx = blockIdx.x * 8 + wave; idx < 512; idx += gridDim.x * 8) {
        const int kv = idx >> 8, n = idx & 255;
        const float* pos = c.in(kv ? I_CPV : I_CPK) + (size_t)c.l * 2048;
        const float* w1 = c.in(kv ? I_CW1V : I_CW1K) + (size_t)c.l * 2048 * 256;
        float s = 0.f;
        for (int k = lane; k < 2048; k += 64) s += pos[k] * w1[(size_t)k * 256 + n];
        s = wave_sum_dpp(s);
        if (lane == 0) c.POSB[kv * 256 + n] = s;
    }
    for (int it = blockIdx.x * 4; it < 1216 + 256 + 16 + 16 + 48; it += gridDim.x * 4) {
        if (it < 1216) convert_tile4(c.in(I_WIN) + (size_t)c.l * DM * IN_COLS, IN_COLS, IN_COLS, DM, (bf16_t*)(c.ws + WS_WT_IN), it, lds);
        else if (it < 1216 + 256) { const int j = it - 1216, kv = j >> 7; convert_tile4(c.in(kv ? I_CW1V : I_CW1K) + (size_t)c.l * 2048 * 256, 256, 256, 2048, (bf16_t*)(c.ws + WS_WT_C1) + (size_t)kv * 256 * 2048, j & 127, lds); }
        else if (it < 1216 + 256 + 16) { const int j = it - 1472, kv = j >> 3; convert_tile4(c.in(kv ? I_CW2V : I_CW2K) + (size_t)c.l * 256 * 64, 64, 64, 256, (bf16_t*)(c.ws + WS_WT_C2) + (size_t)kv * 128 * 256, j & 7, lds); }
        else if (it < 1504) { const int j = it - 1488, gi = j >> 2; convert_tile4(c.in(I_POOLW) + ((size_t)c.l * 4 + gi) * 128 * 128, 128, 128, 128, (bf16_t*)(c.ws + WS_WT_POOL) + (size_t)gi * 128 * 128, 0, lds); }
        else { const int j = it - 1504, ty = j >> 4; bf16_t* dst = (bf16_t*)(c.ws + WS_WT_LORA) + (size_t)ty * 512 * 128;
            if (ty == 0) convert_tile4(c.in(I_WUP) + (size_t)c.l * 32 * 512, 512, 512, 128, dst, j & 15, lds, 32);
            else if (ty == 1) convert_tile4(c.in(I_AUP) + (size_t)c.l * 32 * 512, 512, 512, 128, dst, j & 15, lds, 32);
            else convert_tile4(c.in(I_GUP) + (size_t)c.l * 96 * 512, 512, 512, 128, dst, j & 15, lds, 96); }
    }
}

constexpr int EPS = 136;
DI void tile_store_bf16(f32x4 (&acc)[4][4], bf16_t* out, size_t ld, int nrows, int ncols, unsigned char* lds) {
    bf16_t* T = (bf16_t*)lds;
    const int tid = TID();
    __syncthreads();
    ACC_FOREACH(acc, { store_bf4(T + r_ * EPS + c_, v_); });
    __syncthreads();
#pragma unroll
    for (int i = 0; i < 8; ++i) {
        const int ch = tid + i * NTHREADS, r = ch >> 4, cc = (ch & 15) * 8;
        if (r < nrows && cc < ncols) *(u32x4*)(out + (size_t)r * ld + cc) = *(const u32x4*)(T + r * EPS + cc);
    }
}
DI bool xcd_unit(int it, int nN, int& tm, int& tn) {
    const int G = gridDim.x;
    if ((G & 7) != 0 || G < 8) { const int u = it * G + blockIdx.x; if (u >= 64 * nN) return false; tm = u % 64; tn = u / 64; return true; }
    const int x = blockIdx.x & 7, i = blockIdx.x >> 3, per = G >> 3;
    const int u = it * per + i;
    if (u >= 8 * nN) return false;
    tm = x * 8 + (u & 7); tn = u >> 3; return true;
}
DI void phase_gemm1(const Ctx& c, unsigned char* lds) {
    const int nM = NT / 256, nN = (IN_COLS + 127) / 128;
    const bf16_t* WT = (const bf16_t*)(c.ws + WS_WT_IN);
    for (int it = 0;; ++it) {
        int tm, tn; if (!xcd_unit(it, nN, tm, tn)) break;
        const int m0 = tm * 256, n0 = tn * 128;
        f32x4 acc[4][4]; acc_zero(acc);
        gemm_core_dma(acc, c.H + (size_t)m0 * DM, DM, WT + (size_t)n0 * DM, DM, DM, lds);
        tile_store_bf16(acc, c.PROJ + (size_t)m0 * IN_COLS + n0, IN_COLS, 256, (IN_COLS - n0 < 128) ? IN_COLS - n0 : 128, lds);
    }
}

DI float gelu_tanh(float x) { const float u = 0.7978845608028654f * (x + 0.044715f * x * x * x); const float e = __expf(2.0f * u); return x * (1.0f - __builtin_amdgcn_rcpf(e + 1.0f)); }
DI float softplusf_(float x) { return (x > 20.f) ? x : __logf(1.0f + __expf(x)); }
DI float tanhf_(float x) { const float e = __expf(2.0f * x); return 1.0f - 2.0f * __builtin_amdgcn_rcpf(e + 1.0f); }
constexpr int TKP = 8;
template <int WIN>
DI void pool_emit(const Ctx& c, const float (&pv)[31], int t0, int s0, int ch) {
#pragma unroll
    for (int k = 0; k < 16; ++k) {
        float sum = 0.f;
#pragma unroll
        for (int j = 0; j < WIN; ++j) sum += pv[15 + k - j];
        const int s = s0 + k, cnt = (s + 1 < WIN) ? s + 1 : WIN;
        c.POOLED[(size_t)(t0 + k) * 512 + ch] = f2bf(sum / (float)cnt - pv[15 + k]);
    }
}
DI void phase_prep(const Ctx& c, unsigned char* lds) {
    const int n_cmp_items = 2 * 16 * 2;
    for (int item = (int)gridDim.x - 1 - (int)blockIdx.x; item < n_cmp_items; item += gridDim.x) {
        const int tid = TID();
        const int kv = item >> 5, bgi = (item >> 1) & 15, tn = item & 1, m0 = bgi * 256, n0 = tn * 128;
        ARows ar; ar.mu = nullptr; ar.ltype = 0; ar.first = 0;
#pragma unroll
        for (int i = 0; i < 4; ++i) { const int cb = (tid >> 3) + 64 * i;
            ar.p[i] = (cb < NCMP) ? c.PROJ + ((size_t)(bgi >> 2) * SEQ + 16 * cb) * IN_COLS + (kv ? C_VC : C_KC) + (bgi & 3) * 64 : nullptr; }
        f32x4 acc[4][4]; acc_zero(acc);
        gemm_core<1>(acc, ar, (const bf16_t*)(c.ws + WS_WT_C1) + ((size_t)kv * 256 + n0) * 2048, 2048, 2048, lds);
        const float* pb = c.POSB + kv * 256;
        ACC_FOREACH(acc, {
            const f32x4 bb = *(const f32x4*)(pb + n0 + c_);
            store_bf4(c.CMPH + ((size_t)kv * 4096 + m0 + r_) * 256 + n0 + c_, (f32x4){gelu_tanh(v_[0] + bb[0]), gelu_tanh(v_[1] + bb[1]), gelu_tanh(v_[2] + bb[2]), gelu_tanh(v_[3] + bb[3])}); });
    }
    {
        const float* mu = c.in(I_MU) + (size_t)c.l * RWC;
        const bf16_t* WL = (const bf16_t*)(c.ws + WS_WT_LORA);
        for (int unit = blockIdx.x; unit < 64 * 12; unit += gridDim.x) {
            const int tid = TID();
            const int tm = unit & 63, tn = unit >> 6, m0 = tm * 256, n0 = tn * 128, ltype = tn >> 2, ch0 = n0 & 511;
            ARows ar; ar.mu = mu; ar.ltype = ltype; ar.first = 0;
#pragma unroll
            for (int i = 0; i < 4; ++i) { const int t = m0 + (tid >> 3) + 64 * i; ar.p[i] = c.PROJ + (size_t)t * IN_COLS; if ((t & (SEQ - 1)) == 0) ar.first |= 1 << i; }
            f32x4 acc[4][4]; acc_zero(acc);
            gemm_core<2>(acc, ar, WL + (size_t)n0 * 128, 128, 128, lds);
            if (ltype == 0) { const float* w0 = c.in(I_W0) + c.l * 512 + ch0;
                ACC_FOREACH(acc, { const f32x4 b4 = *(const f32x4*)(w0 + c_);
                    for (int j = 0; j < 4; ++j) v_[j] = __expf(-softplusf_(-(b4[j] + v_[j])) - 0.5f); }); }
            else if (ltype == 1) { const float* a0 = c.in(I_A0) + c.l * 512 + ch0;
                ACC_FOREACH(acc, { const f32x4 b4 = *(const f32x4*)(a0 + c_);
                    for (int j = 0; j < 4; ++j) v_[j] = sigmoidf_(b4[j] + v_[j]); }); }
            tile_store_bf16(acc, c.F + (size_t)(3 + ltype) * NT * 512 + (size_t)m0 * 512 + ch0, 512, 256, 128, lds);
        }
    }
    const int tid = TID();
    const int n_pool_items = NT / 16, n_items = n_pool_items + 2048;
    for (int item = blockIdx.x; item < n_items; item += gridDim.x) {
        if (item >= n_pool_items) {
            const int idx = item - n_pool_items, kind = idx >> 10, bgi = (idx >> 6) & 15, s0 = (idx & 63) * 64;
            bf16_t* T = (bf16_t*)lds;
            const int r = tid >> 3, seg = (tid & 7) * 8;
            const u32x4 w = *(const u32x4*)(c.PROJ + ((size_t)(bgi >> 2) * SEQ + s0 + r) * IN_COLS + (kind ? C_VW : C_VS) + (bgi & 3) * 64 + seg);
            __syncthreads();
            *(u32x4*)(T + r * 72 + seg) = w;
            __syncthreads();
            u32x4 o;
            o.x = (unsigned)T[(seg + 0) * 72 + r] | ((unsigned)T[(seg + 1) * 72 + r] << 16); o.y = (unsigned)T[(seg + 2) * 72 + r] | ((unsigned)T[(seg + 3) * 72 + r] << 16);
            o.z = (unsigned)T[(seg + 4) * 72 + r] | ((unsigned)T[(seg + 5) * 72 + r] << 16); o.w = (unsigned)T[(seg + 6) * 72 + r] | ((unsigned)T[(seg + 7) * 72 + r] << 16);
            *(u32x4*)(c.VT + (((size_t)kind * 16 + bgi) * 64 + r) * SEQ + s0 + seg) = o;
        } else {
            const int t0 = item * 16, ch = tid, gi = ch >> 7, s0 = t0 & (SEQ - 1);
            float pv[31];
#pragma unroll
            for (int i = 0; i < 31; ++i) pv[i] = (s0 - 15 + i >= 0) ? bf2f(c.PROJ[(size_t)(t0 - 15 + i) * IN_COLS + C_POOL + ch]) : 0.f;
            if (gi == 0) pool_emit<2>(c, pv, t0, s0, ch);
            else if (gi == 1) pool_emit<4>(c, pv, t0, s0, ch);
            else if (gi == 2) pool_emit<8>(c, pv, t0, s0, ch);
            else pool_emit<16>(c, pv, t0, s0, ch);
        }
    }
}

DI void rwkv_finalize_item(const Ctx& c, int item) {
    const int tid = TID(), ch = tid, t0 = item * 8;
    const float* mu = c.in(I_MU) + (size_t)c.l * RWC;
    const float kkw_ = c.in(I_KK)[c.l * 512 + ch], kaw_ = c.in(I_KA)[c.l * 512 + ch], rkw_ = c.in(I_RK)[c.l * 512 + ch];
    const float mur = mu[ch], muk = mu[512 + ch], muv = mu[1024 + ch];
    bf16_t ur[9], uk[9], uv[9], ua[8];
    const bool has_prev = (t0 & (SEQ - 1)) != 0;
#pragma unroll
    for (int k = 0; k < 9; ++k) {
        ur[k] = 0; uk[k] = 0; uv[k] = 0;
        if (k > 0 || has_prev) { const bf16_t* q = c.PROJ + (size_t)(t0 - 1 + k) * IN_COLS; ur[k] = q[C_R + ch]; uk[k] = q[C_K + ch]; uv[k] = q[C_V + ch]; }
    }
#pragma unroll
    for (int k = 0; k < 8; ++k) ua[k] = c.F[(size_t)4 * NT * 512 + (size_t)(t0 + k) * 512 + ch];
#pragma unroll
    for (int k = 0; k < 8; ++k) {
        const int t = t0 + k;
        const float cr = bf2f(ur[k + 1]), ck = bf2f(uk[k + 1]), cv = bf2f(uv[k + 1]);
        const float r = cr + (bf2f(ur[k]) - cr) * mur, kx = ck + (bf2f(uk[k]) - ck) * muk, vx = cv + (bf2f(uv[k]) - cv) * muv;
        const float a = bf2f(ua[k]);
        const float kxn = kx * kkw_, kp = kx * (1.0f + (a - 1.0f) * kaw_);
        const float ss = wave_sum_dpp(kxn * kxn);
        const float inv = __builtin_amdgcn_rsqf(fmaxf(ss, 1e-24f));
        const float br = wave_sum_dpp(kxn * inv * a * r), kr = wave_sum_dpp(kp * r), bon = wave_sum_dpp(r * kp * rkw_);
        if ((tid & 63) == 0) *(f32x4*)(c.BON + ((size_t)t * 8 + (tid >> 6)) * 4) = (f32x4){inv, br, kr, bon};
        const size_t o = (size_t)t * 512 + ch;
        c.F[o] = f2bf(r); c.F[o + (size_t)NT * 512] = f2bf(kx); c.F[o + (size_t)2 * NT * 512] = f2bf(vx);
    }
}

DI void phase_poolgemm(const Ctx& c, unsigned char* lds) {
    for (int item = blockIdx.x; item < NT / 8; item += gridDim.x) rwkv_finalize_item(c, item);
    const int n_pool = (NT / 256) * 4, n_items = n_pool + 32;
    for (int item = blockIdx.x; item < n_items; item += gridDim.x) {
        f32x4 acc[4][4]; acc_zero(acc);
        if (item < n_pool) {
            const int tm = item >> 2, gi = item & 3, m0 = tm * 256;
            const ARows ar = plain_rows(c.POOLED + gi * 128, 512, m0, TID());
            gemm_core<0>(acc, ar, (const bf16_t*)(c.ws + WS_WT_POOL) + (size_t)gi * 128 * 128, 128, 128, lds);
            const float* sc = c.in(I_POOLS) + c.l * 512 + gi * 128;
            ACC_FOREACH(acc, { const f32x4 s = *(const f32x4*)(sc + c_);
                store_bf4(c.POOLED + (size_t)(m0 + r_) * 512 + gi * 128 + c_, (f32x4){v_[0] * s[0], v_[1] * s[1], v_[2] * s[2], v_[3] * s[3]}); });
        } else {
            const int it = item - n_pool, kv = it >> 4, tm = it & 15, m0 = tm * 256;
            const ARows ar = plain_rows(c.CMPH + (size_t)kv * 4096 * 256, 256, m0, TID());
            gemm_core<0>(acc, ar, (const bf16_t*)(c.ws + WS_WT_C2) + (size_t)kv * 128 * 256, 256, 256, lds);
            ACC_FOREACH(acc, { if (c_ < 64) { const int R = m0 + r_;
                if (kv == 0) store_bf4(c.KC + (size_t)R * 64 + c_, v_);
                else { bf16_t* q = c.VCT + ((size_t)(R >> 8) * 64 + c_) * 256 + (R & 255); q[0] = f2bf(v_[0]); q[256] = f2bf(v_[1]); q[512] = f2bf(v_[2]); q[768] = f2bf(v_[3]); } } });
        }
    }
}

constexpr int SCH = 32;
constexpr int SB_AN = 0, SB_WR = SCH * 64 * 4, SB_W = 2 * SCH * 64 * 4, SB_BB = 3 * SCH * 64 * 4, SB_KP = 4 * SCH * 64 * 4;
constexpr int SB_V = 5 * SCH * 64 * 4;
constexpr int SB_SC = SB_V + SCH * 16 * 4;
constexpr int SB_Y = SB_SC + SCH * 2 * 4;
constexpr int SB_BYTES = SB_Y + SCH * 16 * 4;
static_assert(2 * SB_BYTES <= LDS_BYTES - 64, "scan lds");
typedef float f32x2 __attribute__((ext_vector_type(2)));
DI float row8_sum(float v) { v += DPP_MOV(v, 0xB1); v += DPP_MOV(v, 0x4E); v += DPP_MOV(v, 0x141); return v; }

constexpr int NPW = 6, NJ = (SCH + NPW - 1) / NPW;
struct PrepRegs { bf16_t r[NJ], k[NJ], v[NJ], e[NJ], a[NJ]; float s0[NJ], s1[NJ], s2[NJ]; };
DI void prep_load(PrepRegs& R, const Ctx& c, int b, int h, int ck, int pw, int lane) {
    const size_t PL = (size_t)NT * 512;
    const size_t tb = (size_t)b * SEQ + ck * SCH;
    const size_t o0 = tb * 512 + h * 64 + lane;
#pragma unroll
    for (int j = 0; j < NJ; ++j) {
        const int st = pw + NPW * j;
        if (st < SCH) { const size_t o = o0 + (size_t)st * 512; R.r[j] = c.F[o]; R.k[j] = c.F[o + PL]; R.v[j] = c.F[o + 2 * PL]; R.e[j] = c.F[o + 3 * PL]; R.a[j] = c.F[o + 4 * PL];
            const float* sp = c.BON + ((tb + st) * 8 + h) * 4; R.s0[j] = sp[0]; R.s1[j] = sp[1]; R.s2[j] = sp[2]; }
    }
}
DI void prep_store(const PrepRegs& R, unsigned char* sb, int rq, int pw, int lane, float kkw, float kaw) {
    float* an = (float*)(sb + SB_AN); float* wr = (float*)(sb + SB_WR); float* w_ = (float*)(sb + SB_W); float* bb_ = (float*)(sb + SB_BB); float* kp_ = (float*)(sb + SB_KP);
    float* vv = (float*)(sb + SB_V); float* sc = (float*)(sb + SB_SC);
#pragma unroll
    for (int j = 0; j < NJ; ++j) {
        const int st = pw + NPW * j;
        if (st < SCH) {
            const float r = bf2f(R.r[j]), k = bf2f(R.k[j]), v = bf2f(R.v[j]), e = bf2f(R.e[j]), a = bf2f(R.a[j]);
            const float w = __expf(-e);
            const float kk = k * kkw * R.s0[j];
            const float kp = k * (1.0f + (a - 1.0f) * kaw);
            an[st * 64 + lane] = -kk; wr[st * 64 + lane] = w * r; w_[st * 64 + lane] = w; bb_[st * 64 + lane] = kk * a; kp_[st * 64 + lane] = kp;
            if ((lane >> 4) == rq) vv[st * 16 + (lane & 15)] = v;
            if (lane == 0) { sc[st * 2] = R.s1[j]; sc[st * 2 + 1] = R.s2[j]; }
        }
    }
}
DI void scan_item(const Ctx& c, int item, unsigned char* lds) {
    const int tid = TID(), lane = tid & 63, wave = tid >> 6;
    const int b = item >> 5, h = (item >> 2) & 7, rq = item & 3;
    const int chn = h * 64 + lane;
    const float kkw = c.in(I_KK)[c.l * 512 + chn], kaw = c.in(I_KA)[c.l * 512 + chn];
    const int rowl = (tid & 127) >> 3, cg = tid & 7;
    f32x2 st[4];
#pragma unroll
    for (int i = 0; i < 4; ++i) st[i] = (f32x2){0.f, 0.f};
    constexpr int NCK = SEQ / SCH;
    PrepRegs R;
    __syncthreads();
    if (wave >= 2) { prep_load(R, c, b, h, 0, wave - 2, lane); prep_store(R, lds, rq, wave - 2, lane, kkw, kaw); prep_load(R, c, b, h, 1, wave - 2, lane); }
    __syncthreads();
    for (int ck = 0; ck < NCK; ++ck) {
        unsigned char* sb = lds + (ck & 1) * SB_BYTES;
        if (wave < 2) {
            const float* an = (const float*)(sb + SB_AN) + cg * 8; const float* wr = (const float*)(sb + SB_WR) + cg * 8; const float* w_ = (const float*)(sb + SB_W) + cg * 8;
            const float* bb_ = (const float*)(sb + SB_BB) + cg * 8; const float* kp_ = (const float*)(sb + SB_KP) + cg * 8;
            const float* vv = (const float*)(sb + SB_V) + rowl; const float* sc = (const float*)(sb + SB_SC); float* yb = (float*)(sb + SB_Y) + rowl;
            f32x4 a0 = *(const f32x4*)(an), a1 = *(const f32x4*)(an + 4), r0 = *(const f32x4*)(wr), r1 = *(const f32x4*)(wr + 4);
            f32x4 w0 = *(const f32x4*)(w_), w1 = *(const f32x4*)(w_ + 4), b0 = *(const f32x4*)(bb_), b1 = *(const f32x4*)(bb_ + 4);
            f32x4 k0 = *(const f32x4*)(kp_), k1 = *(const f32x4*)(kp_ + 4);
            float v = vv[0]; f32x2 bk = *(const f32x2*)(sc);
#pragma unroll 2
            for (int s = 0; s < SCH; ++s) {
                const int sn = (s + 1 < SCH) ? s + 1 : s;
                const f32x4 na0 = *(const f32x4*)(an + sn * 64), na1 = *(const f32x4*)(an + sn * 64 + 4), nr0 = *(const f32x4*)(wr + sn * 64), nr1 = *(const f32x4*)(wr + sn * 64 + 4);
                const f32x4 nw0 = *(const f32x4*)(w_ + sn * 64), nw1 = *(const f32x4*)(w_ + sn * 64 + 4), nb0 = *(const f32x4*)(bb_ + sn * 64), nb1 = *(const f32x4*)(bb_ + sn * 64 + 4);
                const f32x4 nk0 = *(const f32x4*)(kp_ + sn * 64), nk1 = *(const f32x4*)(kp_ + sn * 64 + 4);
                const float nv = vv[sn * 16]; const f32x2 nbk = *(const f32x2*)(sc + sn * 2);
                f32x2 da = st[0] * (f32x2){a0[0], a0[1]}; f32x2 dr = st[0] * (f32x2){r0[0], r0[1]};
                da += st[1] * (f32x2){a0[2], a0[3]}; dr += st[1] * (f32x2){r0[2], r0[3]};
                da += st[2] * (f32x2){a1[0], a1[1]}; dr += st[2] * (f32x2){r1[0], r1[1]};
                da += st[3] * (f32x2){a1[2], a1[3]}; dr += st[3] * (f32x2){r1[2], r1[3]};
                float sa = da[0] + da[1], sr = dr[0] + dr[1];
                sa += DPP_MOV(sa, 0xB1); sr += DPP_MOV(sr, 0xB1);
                sa += DPP_MOV(sa, 0x4E); sr += DPP_MOV(sr, 0x4E);
                sa += DPP_MOV(sa, 0x141); sr += DPP_MOV(sr, 0x141);
                const f32x2 sa2 = (f32x2){sa, sa}, v2 = (f32x2){v, v};
                st[0] = st[0] * (f32x2){w0[0], w0[1]} + sa2 * (f32x2){b0[0], b0[1]} + v2 * (f32x2){k0[0], k0[1]};
                st[1] = st[1] * (f32x2){w0[2], w0[3]} + sa2 * (f32x2){b0[2], b0[3]} + v2 * (f32x2){k0[2], k0[3]};
                st[2] = st[2] * (f32x2){w1[0], w1[1]} + sa2 * (f32x2){b1[0], b1[1]} + v2 * (f32x2){k1[0], k1[1]};
                st[3] = st[3] * (f32x2){w1[2], w1[3]} + sa2 * (f32x2){b1[2], b1[3]} + v2 * (f32x2){k1[2], k1[3]};
                yb[s * 16] = sr + sa * bk[0] + v * bk[1];
                a0 = na0; a1 = na1; r0 = nr0; r1 = nr1; w0 = nw0; w1 = nw1; b0 = nb0; b1 = nb1; k0 = nk0; k1 = nk1; v = nv; bk = nbk;
            }
        } else {
            const int pt = tid - 128;
            if (ck + 1 < NCK) prep_store(R, lds + ((ck + 1) & 1) * SB_BYTES, rq, wave - 2, lane, kkw, kaw);
            if (ck + 2 < NCK) prep_load(R, c, b, h, ck + 2, wave - 2, lane);
            if (ck > 0) {
                const float* yb = (const float*)(lds + ((ck - 1) & 1) * SB_BYTES + SB_Y);
                for (int idx = pt; idx < SCH * 16; idx += 384) {
                    const int s = idx >> 4, j = idx & 15;
                    c.YRAW[((size_t)b * SEQ + (ck - 1) * SCH + s) * 512 + h * 64 + rq * 16 + j] = f2bf(yb[idx]);
                }
            }
        }
        asm volatile("s_waitcnt lgkmcnt(0)" ::: "memory"); __builtin_amdgcn_s_barrier(); asm volatile("" ::: "memory");
    }
    {
        const float* yb = (const float*)(lds + ((NCK - 1) & 1) * SB_BYTES + SB_Y);
        for (int idx = tid; idx < SCH * 16; idx += NTHREADS) {
            const int s = idx >> 4, j = idx & 15;
            c.YRAW[((size_t)b * SEQ + (NCK - 1) * SCH + s) * 512 + h * 64 + rq * 16 + j] = f2bf(yb[idx]);
        }
    }
    __syncthreads();
}
DI void phase_rwkv_post(const Ctx& c, unsigned char* lds) {
    const int tid = TID(), lane = tid & 63, wave = tid >> 6;
    const size_t PL = (size_t)NT * 512;
    for (int t = blockIdx.x * 8 + wave; t < NT; t += gridDim.x * 8) {
        bf16_t ry[8], rv[8], rg[8]; float bon[8], gw[8], gb[8];
#pragma unroll
        for (int h = 0; h < 8; ++h) { const size_t o = (size_t)t * 512 + h * 64 + lane; ry[h] = c.YRAW[o]; rv[h] = c.F[o + 2 * PL]; rg[h] = c.F[o + 5 * PL]; bon[h] = c.BON[((size_t)t * 8 + h) * 4 + 3];
            gw[h] = c.in(I_GNW)[c.l * 512 + h * 64 + lane]; gb[h] = c.in(I_GNB)[c.l * 512 + h * 64 + lane]; }
#pragma unroll
        for (int h = 0; h < 8; ++h) {
            const float y = bf2f(ry[h]);
            const float mean = wave_sum_dpp(y) * (1.0f / 64.0f);
            const float d = y - mean;
            const float var = wave_sum_dpp(d * d) * (1.0f / 64.0f);
            const float yn = d * rsqrtf(var + 64e-5f) * gw[h] + gb[h];
            c.F[(size_t)t * 512 + h * 64 + lane + 5 * PL] = f2bf((yn + bon[h] * bf2f(rv[h])) * bf2f(rg[h]));
        }
    }
    for (int it = blockIdx.x * 4; it < 768 + 128 + 128 + 256 + 256; it += gridDim.x * 4) {
        const float* WB = c.in(I_WBR) + (size_t)c.l * 2048 * DM; bf16_t* BR = (bf16_t*)(c.ws + WS_WT_BR);
        if (it < 768) convert_tile4(c.in(I_WMG) + (size_t)c.l * DM * 3 * DM, 3 * DM, 3 * DM, DM, (bf16_t*)(c.ws + WS_WT_MG), it, lds);
        else if (it < 896) convert_tile4(WB, DM, DM, 512, BR, it - 768, lds);
        else if (it < 1024) convert_tile4(WB + (size_t)512 * DM, DM, DM, 512, BR + (size_t)1024 * 512, it - 896, lds);
        else if (it < 1280) convert_tile4(WB + (size_t)1024 * DM, DM, DM, 1024, BR + (size_t)2048 * 512, it - 1024, lds);
        else convert_tile4(c.in(I_WOUT) + (size_t)c.l * DM * DM, DM, DM, DM, (bf16_t*)(c.ws + WS_WT_OUT), it - 1280, lds);
    }
}
constexpr int TS = 72;
constexpr int NSA_BIAS = 0;
constexpr int NSA_SELM = 2112;
constexpr int NSA_SCR = 2624;
constexpr int NSA_K0 = 4672;
constexpr int NSA_V0 = NSA_K0 + 2 * 64 * TS * 2;
constexpr int NSA_A = NSA_V0 + 2 * 64 * TS * 2;
constexpr int NSA_B = NSA_A + 16384;
constexpr int NSA_END = NSA_B + 16384;
static_assert(NSA_END <= LDS_BYTES - 16, "nsa lds");
static_assert(NSA_K0 % 16 == 0, "align");

struct NsaLane { int tq[2]; int h; float cbias; float m[2], l[2]; };

DI void nsa_prefetch(u32x4& rk, u32x4& rv, const bf16_t* kbase, int kstride, const bf16_t* vtbase, int vstride, int pos0, int tid) {
    const int r = tid >> 3, seg = (tid & 7) * 8;
    rk = *(const u32x4*)(kbase + (size_t)(pos0 + r) * kstride + seg);
    rv = *(const u32x4*)(vtbase + (size_t)r * vstride + pos0 + seg);
}
DI void nsa_store(unsigned char* lds, int buf, const u32x4& rk, const u32x4& rv, int tid) {
    const int r = tid >> 3, seg = (tid & 7) * 8;
    *(u32x4*)((bf16_t*)(lds + NSA_K0) + buf * 64 * TS + r * TS + seg) = rk;
    *(u32x4*)((bf16_t*)(lds + NSA_V0) + buf * 64 * TS + r * TS + seg) = rv;
}
template <int QM = 3>
DI void nsa_qk(f32x4 (&s)[2][4], const bf16_t* sK, const bf16x8 (&qf)[2][2], int lane) {
#pragma unroll
    for (int kt = 0; kt < 4; ++kt) {
#pragma unroll
        for (int ks = 0; ks < 2; ++ks) {
            const bf16x8 kf = *(const bf16x8*)(sK + (16 * kt + (lane & 15)) * TS + 32 * ks + (lane >> 4) * 8);
#pragma unroll
            for (int qi = 0; qi < 2; ++qi) if ((QM >> qi) & 1) s[qi][kt] = __builtin_amdgcn_mfma_f32_16x16x32_bf16(kf, qf[qi][ks], (ks == 0) ? (f32x4){0.f, 0.f, 0.f, 0.f} : s[qi][kt], 0, 0, 0);
        }
    }
}
template <int MODE>
DI void nsa_logits(float (&x)[4][4], const f32x4 (&s)[4], int tq, int h, float cbias, bool rowsel, int pos0, int qd, const float* biasT) {
#pragma unroll
    for (int kt = 0; kt < 4; ++kt)
#pragma unroll
        for (int i = 0; i < 4; ++i) {
            const int kk = pos0 + 16 * kt + 4 * qd + i;
            if (MODE == 1) { x[kt][i] = rowsel ? s[kt][i] + cbias : -INFINITY; }
            else {
                const int dist = (MODE == 0) ? (tq - 16 * kk - 31) : (tq - kk);
                bool ok = dist >= 0;
                if (MODE == 2) ok = ok && rowsel;
                if (MODE == 3) ok = ok && (dist < 512);
                const int di = dist < 0 ? 0 : (dist > 128 ? 128 : dist);
                float bias = biasT[di * 4 + h];
                asm volatile("" : "+v"(bias));
                x[kt][i] = ok ? s[kt][i] + bias : -INFINITY;
            }
        }
}
DI float quad16_max(float v) { v = fmaxf(v, __shfl_xor(v, 16)); v = fmaxf(v, __shfl_xor(v, 32)); return v; }
DI float quad16_sum(float v) { v += __shfl_xor(v, 16); v += __shfl_xor(v, 32); return v; }
DI void nsa_softmax(const float (&x)[4][4], float& m, float& l, f32x4 (&O)[4], bf16x8 (&pf)[2]) {
    float mx = -INFINITY;
#pragma unroll
    for (int kt = 0; kt < 4; ++kt)
#pragma unroll
        for (int i = 0; i < 4; ++i) mx = fmaxf(mx, x[kt][i]);
    mx = quad16_max(mx);
    const float mn = fmaxf(m, mx);
    const float mu = (mn == -INFINITY) ? 0.f : mn;
    const float mu2 = mu * 1.4426950408889634f;
    const float sc = __builtin_amdgcn_exp2f(__builtin_fmaf(m, 1.4426950408889634f, -mu2));
    float p[4][4]; float ps = 0.f;
#pragma unroll
    for (int kt = 0; kt < 4; ++kt)
#pragma unroll
        for (int i = 0; i < 4; ++i) { p[kt][i] = __builtin_amdgcn_exp2f(__builtin_fmaf(x[kt][i], 1.4426950408889634f, -mu2)); ps += p[kt][i]; }
    l = l * sc + ps; m = mn;
#pragma unroll
    for (int dt = 0; dt < 4; ++dt) O[dt] = O[dt] * sc;
#pragma unroll
    for (int ks = 0; ks < 2; ++ks) {
        u32x4 w; w.x = pack2(p[2 * ks][0], p[2 * ks][1]); w.y = pack2(p[2 * ks][2], p[2 * ks][3]); w.z = pack2(p[2 * ks + 1][0], p[2 * ks + 1][1]); w.w = pack2(p[2 * ks + 1][2], p[2 * ks + 1][3]);
        pf[ks] = __builtin_bit_cast(bf16x8, w);
    }
}
template <int QM = 3>
DI void nsa_pv(f32x4 (&O)[2][4], const bf16_t* sV, const bf16x8 (&pf)[2][2], int lane) {
    const int qd = lane >> 4;
#pragma unroll
    for (int dt = 0; dt < 4; ++dt)
#pragma unroll
        for (int ks = 0; ks < 2; ++ks) {
            const bf16_t* vp = sV + (16 * dt + (lane & 15)) * TS + 32 * ks + 4 * qd;
            const u32x2 a = *(const u32x2*)vp, b = *(const u32x2*)(vp + 16);
            u32x4 w; w.x = a.x; w.y = a.y; w.z = b.x; w.w = b.y;
            const bf16x8 vf = __builtin_bit_cast(bf16x8, w);
#pragma unroll
            for (int qi = 0; qi < 2; ++qi) if ((QM >> qi) & 1) O[qi][dt] = __builtin_amdgcn_mfma_f32_16x16x32_bf16(vf, pf[qi][ks], O[qi][dt], 0, 0, 0);
        }
}
template <int MODE, int QM = 3>
DI void nsa_tile(f32x4 (&O)[2][4], NsaLane& L, const bf16x8 (&qf)[2][2], const unsigned char* lds, int buf, int pos0, bool sel0, bool sel1, int lane) {
    const bf16_t* sK = (const bf16_t*)(lds + NSA_K0) + buf * 64 * TS;
    const bf16_t* sV = (const bf16_t*)(lds + NSA_V0) + buf * 64 * TS;
    const float* biasT = (const float*)(lds + NSA_BIAS);
    f32x4 s[2][4];
    nsa_qk<QM>(s, sK, qf, lane);
    bf16x8 pf[2][2];
#pragma unroll
    for (int qi = 0; qi < 2; ++qi) if ((QM >> qi) & 1) {
        float x[4][4];
        nsa_logits<MODE>(x, s[qi], L.tq[qi], L.h, L.cbias, qi ? sel1 : sel0, pos0, lane >> 4, biasT);
        nsa_softmax(x, L.m[qi], L.l[qi], O[qi], pf[qi]);
    }
    nsa_pv<QM>(O, sV, pf, lane);
}
template <int MODE>
DI void nsa_tile_sel(f32x4 (&O)[2][4], NsaLane& L, const bf16x8 (&qf)[2][2], const unsigned char* lds, int buf, int pos0, bool sel0, bool sel1, int lane) {
    const bool a0 = __ballot(sel0) != 0ull, a1 = __ballot(sel1) != 0ull;
    if (a0 && a1) nsa_tile<MODE, 3>(O, L, qf, lds, buf, pos0, sel0, sel1, lane);
    else if (a0) nsa_tile<MODE, 1>(O, L, qf, lds, buf, pos0, sel0, sel1, lane);
    else if (a1) nsa_tile<MODE, 2>(O, L, qf, lds, buf, pos0, sel0, sel1, lane);
}
DI void nsa_flush(f32x4 (&Y)[2][4], f32x4 (&O)[2][4], NsaLane& L, const float (&gate)[2]) {
#pragma unroll
    for (int qi = 0; qi < 2; ++qi) {
        const float lt = quad16_sum(L.l[qi]);
        const float f = (lt > 0.f) ? gate[qi] * __builtin_amdgcn_rcpf(lt) : 0.f;
#pragma unroll
        for (int dt = 0; dt < 4; ++dt) { Y[qi][dt] += O[qi][dt] * f; O[qi][dt] = (f32x4){0.f, 0.f, 0.f, 0.f}; }
    }
}
DI void nsa_item(const Ctx& c, int item, unsigned char* lds) {
    const int tid = TID(), lane = tid & 63, wave = tid >> 6, qd = lane >> 4;
    const int b = item >> 8, g = (item >> 6) & 3, qt = item & 63, t0 = qt * 64, cur = qt, bg = b * 4 + g;
    float* biasT = (float*)(lds + NSA_BIAS);
    unsigned long long* selm = (unsigned long long*)(lds + NSA_SELM);
    float* scr = (float*)(lds + NSA_SCR) + wave * 64;
    float* impA = (float*)(lds + NSA_A); float* impB = (float*)(lds + NSA_B);
    __syncthreads();
    for (int i = tid; i < 129 * 4; i += NTHREADS) { const int d = i >> 2, h = i & 3; biasT[i] = c.in(I_RELB)[t5_bucket(d) * 16 + g * 4 + h]; }
    for (int i = tid; i < 2 * 4096; i += NTHREADS) impA[i] = 0.f;
    NsaLane L; L.h = lane & 3;
    bf16x8 qf[2][2]; float gates[2][3];
    const bf16_t* pbat = c.PROJ + (size_t)b * SEQ * IN_COLS;
#pragma unroll
    for (int qi = 0; qi < 2; ++qi) {
        const int tl = 8 * wave + 4 * qi + ((lane & 15) >> 2);
        L.tq[qi] = t0 + tl;
        const bf16_t* prow = pbat + (size_t)L.tq[qi] * IN_COLS;
#pragma unroll
        for (int ks = 0; ks < 2; ++ks) {
            u32x4 w = *(const u32x4*)(prow + C_Q + (g * 4 + L.h) * 64 + 32 * ks + qd * 8);
            w.x = pack2(bflo(w.x) * 0.125f, bfhi(w.x) * 0.125f); w.y = pack2(bflo(w.y) * 0.125f, bfhi(w.y) * 0.125f);
            w.z = pack2(bflo(w.z) * 0.125f, bfhi(w.z) * 0.125f); w.w = pack2(bflo(w.w) * 0.125f, bfhi(w.w) * 0.125f);
            qf[qi][ks] = __builtin_bit_cast(bf16x8, w);
        }
#pragma unroll
        for (int br = 0; br < 3; ++br) gates[qi][br] = sigmoidf_(bf2f(prow[C_GATE + g * 12 + L.h * 3 + br]));
    }
    __syncthreads();
    L.cbias = biasT[128 * 4 + L.h];
    f32x4 O[2][4], Y[2][4];
#pragma unroll
    for (int qi = 0; qi < 2; ++qi)
#pragma unroll
        for (int dt = 0; dt < 4; ++dt) { O[qi][dt] = (f32x4){0.f, 0.f, 0.f, 0.f}; Y[qi][dt] = (f32x4){0.f, 0.f, 0.f, 0.f}; }
    u32x4 rk, rv;
    const int nvis_max = (t0 + 63 >= 31) ? ((t0 + 63 - 31) >> 4) + 1 : 0;
    const int ncb = (nvis_max + 63) >> 6;
    const bf16_t* kcb = c.KC + (size_t)bg * 256 * 64; const bf16_t* vcb = c.VCT + (size_t)bg * 64 * 256;
    L.m[0] = L.m[1] = -INFINITY; L.l[0] = L.l[1] = 0.f;
    if (ncb > 0) nsa_prefetch(rk, rv, kcb, 64, vcb, 256, 0, tid);
    for (int cb = 0; cb < ncb; ++cb) {
        nsa_store(lds, cb & 1, rk, rv, tid);
        __syncthreads();
        if (cb + 1 < ncb) nsa_prefetch(rk, rv, kcb, 64, vcb, 256, (cb + 1) * 64, tid);
        if (16 * (cb * 64 + 63) + 31 + 128 <= t0) nsa_tile<1>(O, L, qf, lds, cb & 1, cb * 64, true, true, lane);
        else nsa_tile<0>(O, L, qf, lds, cb & 1, cb * 64, true, true, lane);
    }
    float mfin[2], linv[2];
#pragma unroll
    for (int qi = 0; qi < 2; ++qi) { mfin[qi] = L.m[qi]; const float lt = quad16_sum(L.l[qi]); linv[qi] = (lt > 0.f) ? __builtin_amdgcn_rcpf(lt) : 0.f; }
    { const float gg[2] = {gates[0][0], gates[1][0]}; nsa_flush(Y, O, L, gg); }
    __syncthreads();
    if (ncb > 0) nsa_prefetch(rk, rv, kcb, 64, vcb, 256, 0, tid);
    for (int cb = 0; cb < ncb; ++cb) {
        nsa_store(lds, cb & 1, rk, rv, tid);
        __syncthreads();
        if (cb + 1 < ncb) nsa_prefetch(rk, rv, kcb, 64, vcb, 256, (cb + 1) * 64, tid);
        const bf16_t* sK = (const bf16_t*)(lds + NSA_K0) + (cb & 1) * 64 * TS;
        f32x4 s[2][4];
        nsa_qk(s, sK, qf, lane);
#pragma unroll
        for (int qi = 0; qi < 2; ++qi) {
            float x[4][4];
            nsa_logits<0>(x, s[qi], L.tq[qi], L.h, L.cbias, true, cb * 64, qd, biasT);
            const float mu = (mfin[qi] == -INFINITY) ? 0.f : mfin[qi];
#pragma unroll
            for (int kt = 0; kt < 4; ++kt) {
                float p3 = __expf(x[kt][3] - mu) * linv[qi];
                float pa = (__expf(x[kt][0] - mu) + __expf(x[kt][1] - mu) + __expf(x[kt][2] - mu)) * linv[qi] + p3;
                pa += __shfl_xor(pa, 1); p3 += __shfl_xor(p3, 1);
                pa += __shfl_xor(pa, 2); p3 += __shfl_xor(p3, 2);
                if (L.h == 0) { const int tl = 8 * wave + 4 * qi + ((lane & 15) >> 2), mi = 16 * cb + 4 * kt + qd; impA[tl * 64 + mi] = pa; impB[tl * 64 + mi] = p3; }
            }
        }
    }
    __syncthreads();
    for (int tl8 = 0; tl8 < 8; ++tl8) {
        const int tl = 8 * wave + tl8, n = lane;
        const bool cand = (n >= 1) && (n <= cur - 2);
        const float imp = cand ? impA[tl * 64 + n] + impB[tl * 64 + n - 1] : -1.0f;
        LDS_WAVE_SYNC();
        scr[n] = imp;
        LDS_WAVE_SYNC();
        int rank = 0;
#pragma unroll 4
        for (int q4 = 0; q4 < 16; ++q4) {
            const f32x4 o = *(const f32x4*)(scr + q4 * 4);
#pragma unroll
            for (int j = 0; j < 4; ++j) { const int n2 = q4 * 4 + j; rank += (o[j] > imp || (o[j] == imp && n2 < n)) ? 1 : 0; }
        }
        const bool forced = (n <= cur) && (n == 0 || n == cur || n == cur - 1);
        const unsigned long long msk = __ballot((cand && rank < 5) || forced);
        if (lane == 0) selm[tl] = msk;
    }
    __syncthreads();
    unsigned long long uni = selm[lane];
#pragma unroll
    for (int o = 32; o >= 1; o >>= 1) { const unsigned lo_ = __shfl_xor((unsigned)uni, o), hi_ = __shfl_xor((unsigned)(uni >> 32), o); uni |= ((unsigned long long)hi_ << 32) | lo_; }
    uni = ((unsigned long long)__builtin_amdgcn_readfirstlane((unsigned)(uni >> 32)) << 32) | (unsigned)__builtin_amdgcn_readfirstlane((unsigned)uni);
    unsigned long long sm[2];
#pragma unroll
    for (int qi = 0; qi < 2; ++qi) sm[qi] = selm[8 * wave + 4 * qi + ((lane & 15) >> 2)];
    const bf16_t* ksb = pbat + C_KS + g * 64; const bf16_t* vsb = c.VT + ((size_t)0 * 16 + bg) * 64 * SEQ;
    L.m[0] = L.m[1] = -INFINITY; L.l[0] = L.l[1] = 0.f;
    {
        unsigned long long rem = uni; int it = 0;
        int j = (int)__builtin_ctzll(rem); rem &= rem - 1;
        nsa_prefetch(rk, rv, ksb, IN_COLS, vsb, SEQ, j * 64, tid);
        for (;;) {
            nsa_store(lds, it & 1, rk, rv, tid);
            __syncthreads();
            const int jn = rem ? (int)__builtin_ctzll(rem) : -1;
            if (jn >= 0) { rem &= rem - 1; nsa_prefetch(rk, rv, ksb, IN_COLS, vsb, SEQ, jn * 64, tid); }
            const bool s0 = (sm[0] >> j) & 1ull, s1 = (sm[1] >> j) & 1ull;
            if (j <= cur - 3) nsa_tile_sel<1>(O, L, qf, lds, it & 1, j * 64, s0, s1, lane);
            else nsa_tile_sel<2>(O, L, qf, lds, it & 1, j * 64, s0, s1, lane);
            if (jn < 0) break;
            j = jn; ++it;
        }
    }
    { const float gg[2] = {gates[0][1], gates[1][1]}; nsa_flush(Y, O, L, gg); }
    const bf16_t* kwb = pbat + C_KW + g * 64; const bf16_t* vwb = c.VT + ((size_t)1 * 16 + bg) * 64 * SEQ;
    L.m[0] = L.m[1] = -INFINITY; L.l[0] = L.l[1] = 0.f;
    {
        const int j0 = (cur - 8 > 0) ? cur - 8 : 0;
        __syncthreads();
        nsa_prefetch(rk, rv, kwb, IN_COLS, vwb, SEQ, j0 * 64, tid);
        for (int j = j0; j <= cur; ++j) {
            nsa_store(lds, (j - j0) & 1, rk, rv, tid);
            __syncthreads();
            if (j + 1 <= cur) nsa_prefetch(rk, rv, kwb, IN_COLS, vwb, SEQ, (j + 1) * 64, tid);
            if (cur - j >= 3 && cur - j <= 7) nsa_tile<1>(O, L, qf, lds, (j - j0) & 1, j * 64, true, true, lane);
            else nsa_tile<3>(O, L, qf, lds, (j - j0) & 1, j * 64, true, true, lane);
        }
    }
    { const float gg[2] = {gates[0][2], gates[1][2]}; nsa_flush(Y, O, L, gg); }
#pragma unroll
    for (int qi = 0; qi < 2; ++qi) {
        bf16_t* yrow = c.PROJ + ((size_t)b * SEQ + L.tq[qi]) * IN_COLS + C_Q + (g * 4 + L.h) * 64;
#pragma unroll
        for (int dt = 0; dt < 4; ++dt) store_bf4(yrow + 16 * dt + 4 * qd, Y[qi][dt]);
    }
}
DI void phase_mix(const Ctx& c, unsigned char* lds) {
    const int G = gridDim.x, bid = blockIdx.x;
    const int n_nsa = NB * 4 * (SEQ / 64), n_scan = NB * 8 * 4;
    const bool split = G >= 2 * n_scan;
    if (split) { if (bid < n_scan) scan_item(c, bid, lds); }
    else for (int item = bid; item < n_scan; item += G) scan_item(c, item, lds);
    unsigned* ctr = c.ctl + CW_Q + c.l;
    volatile int* sitem = (volatile int*)(lds + LDS_BYTES - 32);
    for (;;) {
        __syncthreads();
        if (TID() == 0) *sitem = (int)atomicAdd(ctr, 1u);
        __syncthreads();
        const int k = *sitem;
        if (k >= n_nsa) break;
        const int qt = 63 - (k >> 4), bgi = k & 15;
        nsa_item(c, (bgi << 6) | qt, lds);
    }
}

DI void phase_merge(const Ctx& c, unsigned char* lds) {
    const int nM = NT / 256, nN = DM / 128;
    const bf16_t* WM = (const bf16_t*)(c.ws + WS_WT_MG);
    const bf16_t* BR = (const bf16_t*)(c.ws + WS_WT_BR);
    const float* BM_ = c.in(I_BMG) + (size_t)c.l * 3 * DM;
    bf16_t* TMP = c.YRAW + (size_t)blockIdx.x * 256 * 128;
    for (int it = 0;; ++it) {
        int tm, tn; if (!xcd_unit(it, nN, tm, tn)) break;
        const int m0 = tm * 256, n0 = tn * 128;
#pragma unroll 1
        for (int i = 0; i < 3; ++i) {
            {
                f32x4 ag[4][4]; acc_zero(ag);
                gemm_core_dma(ag, c.H + (size_t)m0 * DM, DM, WM + (size_t)(i * DM + n0) * DM, DM, DM, lds);
                ACC_FOREACH(ag, { const f32x4 bb = *(const f32x4*)(BM_ + i * DM + n0 + c_);
                    store_bf4(TMP + r_ * 128 + c_, (f32x4){sigmoidf_(v_[0] + bb[0]), sigmoidf_(v_[1] + bb[1]), sigmoidf_(v_[2] + bb[2]), sigmoidf_(v_[3] + bb[3])}); });
            }
            f32x4 ab[4][4]; acc_zero(ab);
            if (i == 0) gemm_core_dma(ab, c.POOLED + (size_t)m0 * 512, 512, BR + (size_t)n0 * 512, 512, 512, lds);
            else if (i == 1) gemm_core_dma(ab, c.F + (size_t)5 * NT * 512 + (size_t)m0 * 512, 512, BR + (size_t)1024 * 512 + (size_t)n0 * 512, 512, 512, lds);
            else gemm_core_dma(ab, c.PROJ + C_Q + (size_t)m0 * IN_COLS, IN_COLS, BR + (size_t)2048 * 512 + (size_t)n0 * 1024, 1024, 1024, lds);
            ACC_FOREACH(ab, {
                bf16_t* q = c.MERGED + (size_t)(m0 + r_) * DM + n0 + c_;
                const u32x2 gv = *(const u32x2*)(TMP + r_ * 128 + c_);
                f32x4 m4 = ((f32x4){0.f, 0.f, 0.f, 0.f});
                if (i > 0) { const u32x2 pv = *(const u32x2*)q; m4 = ((f32x4){bflo(pv.x), bfhi(pv.x), bflo(pv.y), bfhi(pv.y)}); }
                m4[0] += bflo(gv.x) * v_[0]; m4[1] += bfhi(gv.x) * v_[1]; m4[2] += bflo(gv.y) * v_[2]; m4[3] += bfhi(gv.y) * v_[3];
                store_bf4(q, m4); });
        }
    }
}

DI void phase_outp(const Ctx& c, unsigned char* lds) {
    const int nM = NT / 256, nN = DM / 128;
    const bf16_t* W = (const bf16_t*)(c.ws + WS_WT_OUT);
    const float* xin = (c.l == 0) ? c.in(I_X) : c.out;
    for (int it = 0;; ++it) {
        int tm, tn; if (!xcd_unit(it, nN, tm, tn)) break;
        const int m0 = tm * 256, n0 = tn * 128;
        f32x4 acc[4][4]; acc_zero(acc);
        gemm_core_dma(acc, c.MERGED + (size_t)m0 * DM, DM, W + (size_t)n0 * DM, DM, DM, lds);
        ACC_FOREACH(acc, { const size_t o = (size_t)(m0 + r_) * DM + n0 + c_; const f32x4 x = *(const f32x4*)(xin + o); *(f32x4*)(c.out + o) = x + v_; });
    }
    for (int it = blockIdx.x * 4; it < 3 * 32 * 64; it += gridDim.x * 4) {
        const int mat = it / 2048, e = (it >> 6) & 31, tl = it & 63;
        if (mat == 0) convert_tile4(c.in(I_EG) + ((size_t)c.l * 32 + e) * DM * 256, 256, 256, DM, (bf16_t*)(c.ws + WS_EG) + (size_t)e * 256 * DM, tl, lds);
        else if (mat == 1) convert_tile4(c.in(I_EU) + ((size_t)c.l * 32 + e) * DM * 256, 256, 256, DM, (bf16_t*)(c.ws + WS_EU) + (size_t)e * 256 * DM, tl, lds);
        else convert_tile4(c.in(I_ED) + ((size_t)c.l * 32 + e) * 256 * DM, DM, DM, 256, (bf16_t*)(c.ws + WS_ED) + (size_t)e * DM * 256, tl, lds);
    }
}

DI void phase_norm2(const Ctx& c, unsigned char* lds) {
    const int tid = TID(), lane = tid & 63, wave = tid >> 6;
    const float* gain = c.in(I_NFFN) + c.l * DM;
    const float* wrg = c.in(I_WRG) + (size_t)c.l * DM * 4; const float* brg = c.in(I_BRG) + c.l * 4;
    const float* wre = c.in(I_WRE) + (size_t)c.l * DM * 32; const float* bre = c.in(I_BRE) + c.l * 32;
    unsigned* cnt = c.ctl + CW_CNT + c.l * 32;
    float* lg = (float*)lds + wave * 16 * 48;
    if (wave < 4)
    for (int rt = blockIdx.x * 4 + wave; rt < NT / 16; rt += gridDim.x * 4) {
        const int r0 = rt * 16;
        float my_rs = 0.f;
#pragma unroll 2
        for (int rr = 0; rr < 16; ++rr) {
            const size_t ro = (size_t)(r0 + rr) * DM;
            f32x4 v[4]; float ss = 0.f;
#pragma unroll
            for (int i = 0; i < 4; ++i) { v[i] = *(const f32x4*)(c.out + ro + i * 256 + lane * 4); ss += v[i][0] * v[i][0] + v[i][1] * v[i][1] + v[i][2] * v[i][2] + v[i][3] * v[i][3]; }
            ss = wave_sum_dpp(ss);
            const float rs = rsqrtf(ss * (1.0f / DM) + 1e-6f);
            if ((lane & 15) == rr) my_rs = rs;
#pragma unroll
            for (int i = 0; i < 4; ++i) {
                const f32x4 g = *(const f32x4*)(gain + i * 256 + lane * 4);
                store_bf4(c.H + ro + i * 256 + lane * 4, (f32x4){v[i][0] * rs * g[0], v[i][1] * rs * g[1], v[i][2] * rs * g[2], v[i][3] * rs * g[3]});
            }
        }
        f32x4 acc0 = (f32x4){0.f, 0.f, 0.f, 0.f}, acc1 = acc0, acc2 = acc0;
        const float* xr = c.out + (size_t)(r0 + (lane & 15)) * DM + 4 * (lane >> 4);
        const int cl = lane & 15;
#pragma unroll 2
        for (int kb = 0; kb < 64; ++kb) {
            const f32x4 xa = *(const f32x4*)(xr + kb * 16);
            const f32x4 ga = *(const f32x4*)(gain + kb * 16 + 4 * (lane >> 4));
            const int k0 = kb * 16 + 4 * (lane >> 4);
            float b0[4], b1[4], b2[4];
#pragma unroll
            for (int m = 0; m < 4; ++m) { b0[m] = wre[(size_t)(k0 + m) * 32 + cl]; b1[m] = wre[(size_t)(k0 + m) * 32 + 16 + cl]; b2[m] = (cl < 4) ? wrg[(size_t)(k0 + m) * 4 + cl] : 0.f; }
#pragma unroll
            for (int m = 0; m < 4; ++m) {
                const float am = xa[m] * ga[m] * my_rs;
                acc0 = __builtin_amdgcn_mfma_f32_16x16x4f32(am, b0[m], acc0, 0, 0, 0);
                acc1 = __builtin_amdgcn_mfma_f32_16x16x4f32(am, b1[m], acc1, 0, 0, 0);
                acc2 = __builtin_amdgcn_mfma_f32_16x16x4f32(am, b2[m], acc2, 0, 0, 0);
            }
        }
        LDS_WAVE_SYNC();
#pragma unroll
        for (int i = 0; i < 4; ++i) { const int row = 4 * (lane >> 4) + i; lg[row * 48 + cl] = acc0[i]; lg[row * 48 + 16 + cl] = acc1[i]; lg[row * 48 + 32 + cl] = acc2[i]; }
        LDS_WAVE_SYNC();
        if (lane < 16) {
            const float* L = lg + lane * 48;
            float lgp[4];
#pragma unroll
            for (int o = 0; o < 4; ++o) lgp[o] = L[32 + o] + brg[o];
            int grp = 0; float gm = lgp[0];
#pragma unroll
            for (int o = 1; o < 4; ++o) if (lgp[o] > gm) { gm = lgp[o]; grp = o; }
            float gs = 0.f;
#pragma unroll
            for (int o = 0; o < 4; ++o) gs += __expf(lgp[o] - gm);
            const float ptop = 1.0f / gs;
            int i0 = 0; float v0 = -INFINITY; int i1 = 0; float v1 = -INFINITY;
            for (int o = 0; o < 8; ++o) { const float le = L[grp * 8 + o] + bre[grp * 8 + o]; if (le > v0) { v1 = v0; i1 = i0; v0 = le; i0 = o; } else if (le > v1) { v1 = le; i1 = o; } }
            const float e1 = __expf(v1 - v0), inv = 1.0f / (1.0f + e1);
            int* rt_ = c.ROUTE + (size_t)(r0 + lane) * 8;
            const int ex0 = grp * 8 + i0, ex1 = grp * 8 + i1;
            rt_[0] = ex0; rt_[1] = ex1; ((float*)rt_)[2] = inv * ptop; ((float*)rt_)[3] = e1 * inv * ptop;
            atomicAdd(cnt + ex0, 1u); atomicAdd(cnt + ex1, 1u);
        }
    }
}
DI void phase_route2(const Ctx& c, unsigned char* lds) {
    int* soff = (int*)lds;
    const unsigned* cnt = c.ctl + CW_CNT + c.l * 32;
    unsigned* cur = c.ctl + CW_CUR + c.l * 32;
    __syncthreads();
    if (TID() == 0) { int s = 0; for (int e = 0; e < 32; ++e) { soff[e] = s; s += (int)cnt[e]; } }
    __syncthreads();
    for (int t = blockIdx.x * NTHREADS + TID(); t < NT; t += gridDim.x * NTHREADS) {
        int* rt = c.ROUTE + (size_t)t * 8;
#pragma unroll
        for (int s = 0; s < 2; ++s) {
            const int e = rt[s];
            const int p = soff[e] + (int)atomicAdd(cur + e, 1u);
            rt[4 + s] = p;
            c.ENT[2 * p] = t; ((float*)c.ENT)[2 * p + 1] = ((const float*)rt)[2 + s];
        }
    }
}
DI void moe_tables(const Ctx& c, int* soff, int* stile, int ncol) {
    const unsigned* cnt = c.ctl + CW_CNT + c.l * 32;
    __syncthreads();
    if (TID() == 0) { int s = 0, tt = 0; for (int e = 0; e < 32; ++e) { soff[e] = s; stile[e] = tt; s += (int)cnt[e]; tt += (((int)cnt[e] + 255) >> 8) * ncol; } soff[32] = s; stile[32] = tt; }
    __syncthreads();
}
DI void phase_moe_up(const Ctx& c, unsigned char* lds) {
    int* soff = (int*)(lds + 2 * G_STAGE); int* stile = soff + 64;
    moe_tables(c, soff, stile, 2);
    const int total = stile[32];
    for (int item = blockIdx.x; item < total; item += gridDim.x) {
        int e = 0;
        for (int q = 1; q < 32; ++q) if (stile[q] <= item) e = q;
        const int loc = item - stile[e], tm = loc >> 1, tn = loc & 1, n0 = tn * 128;
        const int p0 = soff[e] + tm * 256, pend = soff[e + 1];
        ARows ar; ar.mu = nullptr; ar.ltype = 0; ar.first = 0;
#pragma unroll
        for (int i = 0; i < 4; ++i) { const int pr = p0 + (TID() >> 3) + 64 * i; ar.p[i] = (pr < pend) ? c.H + (size_t)c.ENT[2 * pr] * DM : nullptr; }
        {
            f32x4 ag[4][4]; acc_zero(ag);
            gemm_core<0>(ag, ar, (const bf16_t*)(c.ws + WS_EG) + ((size_t)e * 256 + n0) * DM, DM, DM, lds);
            ACC_FOREACH(ag, { if (p0 + r_ < pend) store_bf4(c.HID + (size_t)(p0 + r_) * 256 + n0 + c_, (f32x4){v_[0] * sigmoidf_(v_[0]), v_[1] * sigmoidf_(v_[1]), v_[2] * sigmoidf_(v_[2]), v_[3] * sigmoidf_(v_[3])}); });
        }
        f32x4 au[4][4]; acc_zero(au);
        gemm_core<0>(au, ar, (const bf16_t*)(c.ws + WS_EU) + ((size_t)e * 256 + n0) * DM, DM, DM, lds);
        ACC_FOREACH(au, { if (p0 + r_ < pend) { bf16_t* q = c.HID + (size_t)(p0 + r_) * 256 + n0 + c_; const u32x2 sv = *(const u32x2*)q;
            store_bf4(q, (f32x4){bflo(sv.x) * v_[0], bfhi(sv.x) * v_[1], bflo(sv.y) * v_[2], bfhi(sv.y) * v_[3]}); } });
    }
}
DI void phase_moe_down(const Ctx& c, unsigned char* lds) {
    int* soff = (int*)(lds + 2 * G_STAGE); int* stile = soff + 64;
    moe_tables(c, soff, stile, 8);
    const int total = stile[32];
    for (int item = blockIdx.x; item < total; item += gridDim.x) {
        int e = 0;
        for (int q = 1; q < 32; ++q) if (stile[q] <= item) e = q;
        const int loc = item - stile[e], tm = loc >> 3, tn = loc & 7, n0 = tn * 128;
        const int p0 = soff[e] + tm * 256, pend = soff[e + 1];
        ARows ar; ar.mu = nullptr; ar.ltype = 0; ar.first = 0;
#pragma unroll
        for (int i = 0; i < 4; ++i) { const int pr = p0 + (TID() >> 3) + 64 * i; ar.p[i] = (pr < pend) ? c.HID + (size_t)pr * 256 : nullptr; }
        f32x4 acc[4][4]; acc_zero(acc);
        gemm_core<0>(acc, ar, (const bf16_t*)(c.ws + WS_ED) + ((size_t)e * DM + n0) * 256, 256, 256, lds);
        ACC_FOREACH(acc, { if (p0 + r_ < pend) { const float w = ((const float*)c.ENT)[2 * (p0 + r_) + 1];
            store_bf4(c.Y + (size_t)(p0 + r_) * DM + n0 + c_, (f32x4){v_[0] * w, v_[1] * w, v_[2] * w, v_[3] * w}); } });
    }
}
DI void phase_final(const Ctx& c) {
    const int tid = TID(), lane = tid & 63, wave = tid >> 6;
    const float* gain = c.in(I_NFIN);
    for (int row = blockIdx.x * 8 + wave; row < NT; row += gridDim.x * 8) {
        f32x4 v[4];
#pragma unroll
        for (int i = 0; i < 4; ++i) v[i] = *(const f32x4*)(c.out + (size_t)row * DM + i * 256 + lane * 4);
        add_moe_rows(c, row, lane, v);
        float ss = 0.f;
#pragma unroll
        for (int i = 0; i < 4; ++i) ss += v[i][0] * v[i][0] + v[i][1] * v[i][1] + v[i][2] * v[i][2] + v[i][3] * v[i][3];
        ss = wave_sum_dpp(ss);
        const float rs = rsqrtf(ss * (1.0f / DM) + 1e-6f);
#pragma unroll
        for (int i = 0; i < 4; ++i) {
            const f32x4 g = *(const f32x4*)(gain + i * 256 + lane * 4);
            *(f32x4*)(c.out + (size_t)row * DM + i * 256 + lane * 4) = (f32x4){v[i][0] * rs * g[0], v[i][1] * rs * g[1], v[i][2] * rs * g[2], v[i][3] * rs * g[3]};
        }
    }
}

constexpr int PH_PER_LAYER = 12, N_PHASES = DEPTH * PH_PER_LAYER + 1;
__global__ void __launch_bounds__(NTHREADS, 2) fwd_kernel(Params P) {
    extern __shared__ __attribute__((aligned(16))) unsigned char lds[];
    const int lo = P.ph_lo, hi = P.ph_hi;
    LAS unsigned* xbw = (LAS unsigned*)(lds + LDS_BYTES - 16);
    if (threadIdx.x == 0) { xbw[0] = 0u; xbw[1] = 0u; xbw[2] = 0u; xbw[3] = 0u; }
    __syncthreads();
    Ctx c; c.P = &P; c.ws = P.ws; c.out = P.out; c.l = 0;
    c.ctl = (unsigned*)(P.ws + WS_CTL);
    c.H = (bf16_t*)(P.ws + WS_H); c.PROJ = (bf16_t*)(P.ws + WS_PROJ); c.F = (bf16_t*)(P.ws + WS_F); c.POOLED = (bf16_t*)(P.ws + WS_POOLED);
    c.MERGED = (bf16_t*)(P.ws + WS_F); c.CMPH = (bf16_t*)(P.ws + WS_CMPH); c.CMPO = (float*)(P.ws + WS_CMPO); c.POSB = (float*)(P.ws + WS_POSB);
    c.ROUTE = (int*)(P.ws + WS_ROUTE); c.ENT = (int*)(P.ws + WS_ENT); c.HID = (bf16_t*)(P.ws + WS_HID); c.Y = (bf16_t*)(P.ws + WS_Y);
    c.VT = (bf16_t*)(P.ws + WS_VT); c.KC = (bf16_t*)(P.ws + WS_KC); c.VCT = (bf16_t*)(P.ws + WS_VCT); c.YRAW = (bf16_t*)(P.ws + WS_YRAW); c.BON = (float*)(P.ws + WS_BON);
    XcdBarrier bar; bar.bar = c.ctl + CW_BAR; bar.x = 0; bar.st = (volatile LAS unsigned*)xbw;
    if (hi - lo > 1) bar = xcd_barrier_post(c.ctl + CW_BAR, (volatile LAS unsigned*)xbw);
#define IN(k) (lo <= (k) && (k) < hi)
#define SEAM(k) do { if (IN(k) && IN((k) + 1)) xcd_barrier(bar); } while (0)
#pragma unroll 1
    for (int l = 0; l < DEPTH; ++l) {
        c.l = l; const int pb = l * PH_PER_LAYER;
        if (IN(pb + 0)) phase_norm1(c, lds);
        SEAM(pb + 0);
        if (IN(pb + 1)) phase_gemm1(c, lds);
        SEAM(pb + 1);
        if (IN(pb + 2)) phase_prep(c, lds);
        SEAM(pb + 2);
        if (IN(pb + 3)) phase_poolgemm(c, lds);
        SEAM(pb + 3);
        if (IN(pb + 4)) phase_mix(c, lds);
        SEAM(pb + 4);
        if (IN(pb + 5)) phase_rwkv_post(c, lds);
        SEAM(pb + 5);
        if (IN(pb + 6)) phase_merge(c, lds);
        SEAM(pb + 6);
        if (IN(pb + 7)) phase_outp(c, lds);
        SEAM(pb + 7);
        if (IN(pb + 8)) phase_norm2(c, lds);
        SEAM(pb + 8);
        if (IN(pb + 9)) phase_route2(c, lds);
        SEAM(pb + 9);
        if (IN(pb + 10)) phase_moe_up(c, lds);
        SEAM(pb + 10);
        if (IN(pb + 11)) phase_moe_down(c, lds);
        SEAM(pb + 11);
    }
    if (IN(N_PHASES - 1)) phase_final(c);
}

#ifndef MK_N_LAUNCHES
#define MK_N_LAUNCHES 1
#endif
extern "C" void kernel_launch(void* const* d_in, const int* in_sizes, int n_in, void* d_out, int out_size, void* d_ws, size_t ws_size, hipStream_t stream) {
    static int grid = 0;
    if (grid == 0) {
        if (n_in != N_IN || out_size != NT * DM || ws_size < WS_END) { fprintf(stderr, "kernel_launch: unexpected shapes n_in %d out %d ws %zu (need %zu)\n", n_in, out_size, ws_size, (size_t)WS_END); grid = -1; return; }
        int dev = 0, cus = 0, per_cu = 0;
        if (hipGetDevice(&dev) != hipSuccess || hipDeviceGetAttribute(&cus, hipDeviceAttributeMultiprocessorCount, dev) != hipSuccess) { grid = -1; return; }
        if (hipFuncSetAttribute((const void*)fwd_kernel, hipFuncAttributeMaxDynamicSharedMemorySize, LDS_BYTES) != hipSuccess) { fprintf(stderr, "kernel_launch: hipFuncSetAttribute failed\n"); grid = -1; return; }
        if (hipOccupancyMaxActiveBlocksPerMultiprocessor(&per_cu, (const void*)fwd_kernel, NTHREADS, LDS_BYTES) != hipSuccess || per_cu < 1) { fprintf(stderr, "kernel_launch: occupancy query says %d\n", per_cu); }
        (void)hipGetLastError();
        grid = cus;
    }
    if (grid < 0) return;
    if (hipMemsetAsync((char*)d_ws + WS_CTL, 0, CTL_BYTES, stream) != hipSuccess) return;
    Params p{};
    for (int i = 0; i < N_IN; ++i) p.in[i] = (const float*)d_in[i];
    p.out = (float*)d_out; p.ws = (unsigned char*)d_ws;
    if (MK_N_LAUNCHES == 1) {
        p.ph_lo = 0; p.ph_hi = N_PHASES;
        hipLaunchKernelGGL(fwd_kernel, dim3(grid), dim3(NTHREADS), LDS_BYTES, stream, p);
    } else {
        for (int k = 0; k < N_PHASES; ++k) { p.ph_lo = k; p.ph_hi = k + 1; hipLaunchKernelGGL(fwd_kernel, dim3(grid), dim3(NTHREADS), LDS_BYTES, stream, p); }
    }
}
```

```cpp
#include <hip/hip_runtime.h>
#include <cstdio>
#include <cstdint>

#define DI __device__ __forceinline__
typedef unsigned short bf16_t;
typedef short bf16x8 __attribute__((ext_vector_type(8)));
typedef float f32x4 __attribute__((ext_vector_type(4)));
typedef unsigned u32x4 __attribute__((ext_vector_type(4)));
typedef unsigned u32x2 __attribute__((ext_vector_type(2)));

constexpr int NB = 4, SEQ = 4096, DM = 1024, NT = NB * SEQ, DEPTH = 2;
constexpr int IN_COLS = 4816;
constexpr int C_POOL = 0, C_RW = 512, C_R = 512, C_K = 1024, C_V = 1536, C_WD = 2048, C_AD = 2080, C_GD = 2112;
constexpr int C_Q = 2208, C_KC = 3232, C_VC = 3488, C_KS = 3744, C_VS = 4000, C_KW = 4256, C_VW = 4512, C_GATE = 4768;
constexpr int RWC = 1696;
constexpr int NCMP = 255;
constexpr int NTHREADS = 512;
constexpr int LDS_BYTES = 155648;

enum { I_X = 0, I_RELB, I_NMIX, I_WIN, I_POOLW, I_POOLS, I_MU, I_W0, I_WUP, I_A0, I_AUP, I_GUP, I_KK, I_KA, I_RK, I_GNW, I_GNB,
       I_CPK, I_CW1K, I_CW2K, I_CPV, I_CW1V, I_CW2V, I_WBR, I_WMG, I_BMG, I_WOUT, I_NFFN, I_WRG, I_BRG, I_WRE, I_BRE, I_EG, I_EU, I_ED, I_NFIN, N_IN };

constexpr size_t WS_CTL = 0;
constexpr size_t CTL_BYTES = 65536;
constexpr size_t WS_H = CTL_BYTES;
constexpr size_t WS_PROJ = WS_H + (size_t)NT * DM * 2;
constexpr size_t WS_F = WS_PROJ + (size_t)NT * IN_COLS * 2;
constexpr size_t PLANE = (size_t)NT * 512 * 2;
constexpr size_t WS_POOLED = WS_F + 6 * PLANE;
constexpr size_t WS_CMPH = WS_POOLED + PLANE;
constexpr size_t WS_CMPO = WS_CMPH + (size_t)2 * 4096 * 256 * 2;
constexpr size_t WS_POSB = WS_CMPO + (size_t)2 * 4096 * 64 * 4;
constexpr size_t WS_ROUTE = WS_POSB + 4096;
constexpr size_t WS_ENT = WS_ROUTE + (size_t)NT * 32;
constexpr size_t WS_VT = WS_ENT + (size_t)2 * NT * 8;
constexpr size_t WS_KC = WS_VT + (size_t)2 * 16 * 64 * SEQ * 2;
constexpr size_t WS_VCT = WS_KC + (size_t)16 * 256 * 64 * 2;
constexpr size_t WS_YRAW = WS_VCT + (size_t)16 * 64 * 256 * 2;
constexpr size_t WS_BON = WS_YRAW + (size_t)NT * 512 * 2;
constexpr size_t WS_SMALLW = WS_BON + (size_t)NT * 8 * 16;
constexpr size_t WS_WT_LORA = WS_SMALLW + 262144;
constexpr size_t WS_END = WS_WT_LORA + (size_t)1536 * 128 * 2;
constexpr size_t WS_WT_IN = WS_F;
constexpr size_t WS_WT_C1 = WS_CMPO;
constexpr size_t WS_WT_C2 = WS_SMALLW;
constexpr size_t WS_WT_POOL = WS_SMALLW + 131072;
constexpr size_t WS_WT_MG = WS_VT;
constexpr size_t WS_WT_BR = WS_VT + (size_t)3072 * 1024 * 2;
constexpr size_t WS_WT_OUT = WS_CMPH;
constexpr size_t WS_EG = WS_F + 2 * PLANE;
constexpr size_t WS_EU = WS_EG + (size_t)32 * 256 * 1024 * 2;
constexpr size_t WS_ED = WS_EU + (size_t)32 * 256 * 1024 * 2;
static_assert(WS_ED + (size_t)32 * 1024 * 256 * 2 <= WS_F + 6 * PLANE, "expert alias");
static_assert(WS_WT_BR + (size_t)2048 * 1024 * 2 <= WS_VT + (size_t)2 * 16 * 64 * SEQ * 2, "merge alias");
static_assert((size_t)4864 * 1024 * 2 <= 6 * PLANE, "w_in alias");
constexpr size_t WS_HID = WS_PROJ;
constexpr size_t WS_Y = WS_PROJ + (size_t)2 * NT * 256 * 2;
static_assert(WS_Y + (size_t)2 * NT * 1024 * 2 <= WS_F, "alias");
constexpr int CW_BAR = 0;
constexpr int CW_CNT = 4096;
constexpr int CW_CUR = 4096 + 64;
constexpr int CW_Q = 4096 + 128;

#define XB_TMO      128
#define XB_XCNT(j)  (256  + 64 * (j))
#define XB_XSUB(j)  (1280 + 64 * (j))
#define XB_XGEN(j)  (2304 + 64 * (j))
#define XB_TOP      3328
#define XB_TOPGEN   3392
#define XCD_BAR_WORDS 3456
#define XB_SPIN_CAP (1u << 18)
#define LAS __attribute__((address_space(3)))

__device__ __forceinline__ unsigned xb_ld(unsigned* p)              { return __hip_atomic_load(p, __ATOMIC_RELAXED, __HIP_MEMORY_SCOPE_AGENT); }
__device__ __forceinline__ unsigned xb_add(unsigned* p, unsigned v) { return __hip_atomic_fetch_add(p, v, __ATOMIC_RELAXED, __HIP_MEMORY_SCOPE_AGENT); }
__device__ __forceinline__ unsigned xb_xcc_id() { return (unsigned)__builtin_amdgcn_s_getreg((3 << 11) | 20) & 0xFu; }
#define XB_SPIN(cond, bar) do { unsigned _sp = 0; while (cond) { __builtin_amdgcn_s_sleep(1); \
    if ((++_sp & 255u) == 0u) { if (xb_ld(&(bar)[XB_TMO])) break; if (_sp > XB_SPIN_CAP) { atomicAdd(&(bar)[XB_TMO], 1u); break; } } } } while (0)

struct XcdBarrier { unsigned* bar; unsigned x; volatile LAS unsigned* st; };

__device__ __forceinline__ XcdBarrier xcd_barrier_post(unsigned* bar, volatile LAS unsigned* st) {
    XcdBarrier b; b.bar = bar; b.x = xb_xcc_id(); b.st = st;
    if (threadIdx.x == 0) (void)xb_add(&bar[XB_XCNT(b.x)], 1u);
    return b;
}
__device__ __forceinline__ void xcd_barrier_complete(unsigned* bar, unsigned x, unsigned& nloc, unsigned& nx) {
    const unsigned G = gridDim.x * gridDim.y * gridDim.z;
    unsigned sum, cnt, mine, sp = 0u;
    for (;;) {
        sum = 0u; cnt = 0u; mine = 0u;
#pragma unroll
        for (unsigned j = 0; j < 16; ++j) { const unsigned c = xb_ld(&bar[XB_XCNT(j)]); sum += c; cnt += (c > 0u) ? 1u : 0u; mine = (j == x) ? c : mine; }
        if (sum == G) break;
        __builtin_amdgcn_s_sleep(1);
        if ((++sp & 255u) == 0u) { if (xb_ld(&bar[XB_TMO])) break; if (sp > XB_SPIN_CAP) { atomicAdd(&bar[XB_TMO], 1u); break; } }
    }
    nloc = mine > 0u ? mine : 1u; nx = cnt > 0u ? cnt : 1u;
}
__device__ __forceinline__ void xcd_barrier(const XcdBarrier& b) {
    asm volatile("s_waitcnt vmcnt(0)" ::: "memory");
    __syncthreads();
    if (threadIdx.x == 0) {
        unsigned* bar = b.bar;
        __builtin_amdgcn_s_waitcnt(0);
        unsigned nloc = b.st[0], nx = b.st[1];
        if (nloc == 0u) { xcd_barrier_complete(bar, b.x, nloc, nx); b.st[0] = nloc; b.st[1] = nx; }
        const unsigned old = xb_add(&bar[XB_XSUB(b.x)], 1u);
        const unsigned gen = old / nloc;
        if (old + 1u == (gen + 1u) * nloc) {
            __builtin_amdgcn_fence(__ATOMIC_RELEASE, "agent");
            asm volatile("s_waitcnt vmcnt(0)" ::: "memory");
            const unsigned og = xb_add(&bar[XB_TOP], 1u);
            const unsigned tg = og / nx;
            if (og + 1u == (tg + 1u) * nx) xb_add(&bar[XB_TOPGEN], 1u);
            else XB_SPIN(xb_ld(&bar[XB_TOPGEN]) == tg, bar);
            __builtin_amdgcn_fence(__ATOMIC_ACQUIRE, "agent");
            xb_add(&bar[XB_XGEN(b.x)], 1u);
            asm volatile("s_waitcnt vmcnt(0)" ::: "memory");
        } else {
            XB_SPIN(xb_ld(&bar[XB_XGEN(b.x)]) == gen, bar);
            __builtin_amdgcn_fence(__ATOMIC_ACQUIRE, "agent");
            asm volatile("s_waitcnt vmcnt(0)" ::: "memory");
        }
    }
    __syncthreads();
}

DI bf16_t f2bf(float x) { unsigned u = __float_as_uint(x); u += 0x7fffu + ((u >> 16) & 1u); return (bf16_t)(u >> 16); }
DI float bf2f(bf16_t b) { return __uint_as_float((unsigned)b << 16); }
typedef __bf16 bf16v2_t __attribute__((ext_vector_type(2)));
typedef float f32v2_t __attribute__((ext_vector_type(2)));
DI unsigned pack2(float lo, float hi) { const f32v2_t v = {lo, hi}; const bf16v2_t b = __builtin_convertvector(v, bf16v2_t); return __builtin_bit_cast(unsigned, b); }
DI float bflo(unsigned w) { return __uint_as_float(w << 16); }
DI float bfhi(unsigned w) { return __uint_as_float(w & 0xffff0000u); }
DI float wave_sum(float v) {
#pragma unroll
    for (int o = 32; o >= 1; o >>= 1) v += __shfl_xor(v, o);
    return v;
}
DI float wave_max(float v) {
#pragma unroll
    for (int o = 32; o >= 1; o >>= 1) v = fmaxf(v, __shfl_xor(v, o));
    return v;
}
DI float sigmoidf_(float x) { return __builtin_amdgcn_rcpf(1.0f + __expf(-x)); }
DI int TID() { int t = threadIdx.x; asm volatile("" : "+v"(t)); return t; }
#define LDS_WAVE_SYNC() asm volatile("s_waitcnt lgkmcnt(0)" ::: "memory")

#define DPP_MOV(v, ctrl) __builtin_bit_cast(float, __builtin_amdgcn_update_dpp(0, __builtin_bit_cast(int, (v)), (ctrl), 0xF, 0xF, true))
DI float wave_sum_dpp(float v) {
    v += DPP_MOV(v, 0xB1); v += DPP_MOV(v, 0x4E); v += DPP_MOV(v, 0x141); v += DPP_MOV(v, 0x140);
    return __builtin_bit_cast(float, __builtin_amdgcn_readlane(__builtin_bit_cast(int, v), 0)) + __builtin_bit_cast(float, __builtin_amdgcn_readlane(__builtin_bit_cast(int, v), 16)) +
        (__builtin_bit_cast(float, __builtin_amdgcn_readlane(__builtin_bit_cast(int, v), 32)) + __builtin_bit_cast(float, __builtin_amdgcn_readlane(__builtin_bit_cast(int, v), 48)));
}
struct Params { const float* in[N_IN]; float* out; unsigned char* ws; int ph_lo, ph_hi; };

DI int t5_bucket(int n) {
    if (n < 16) return n;
    if (n >= 128) return 31;
    int b = 16;
    b += (n >= 19) + (n >= 21) + (n >= 24) + (n >= 27) + (n >= 31) + (n >= 35) + (n >= 40) + (n >= 46) + (n >= 52) + (n >= 59) + (n >= 67) + (n >= 77) + (n >= 87) + (n >= 99) + (n >= 113);
    return b;
}

constexpr int G_A = 0, G_B = 256 * 64 * 2, G_STAGE = (256 + 128) * 64 * 2;
static_assert(2 * G_STAGE <= LDS_BYTES - 64, "gemm lds");
DI int g_off(int r, int c) { return ((r >> 4) * 2 + (c >> 5)) * 1024 + ((((r & 15) * 64) + (c & 31) * 2) ^ ((((r & 15) >> 3) & 1) << 5)); }
struct ARows { const bf16_t* p[4]; const float* mu; int ltype; int first; };
DI float tanhf_fast(float x) { const float e = __expf(2.0f * x); return 1.0f - 2.0f * __builtin_amdgcn_rcpf(e + 1.0f); }
DI u32x4 lora_chunk(const bf16_t* prow, bool first, const float* mu, int ltype, int k) {
    const int lim = (ltype == 2) ? 96 : 32;
    if (k >= lim) return (u32x4){0u, 0u, 0u, 0u};
    const int col = C_WD + ltype * 32 + k;
    const u32x4 cu = *(const u32x4*)(prow + col);
    u32x4 pu = (u32x4){0u, 0u, 0u, 0u};
    if (!first) pu = *(const u32x4*)(prow - IN_COLS + col);
    const f32x4 m0 = *(const f32x4*)(mu + col - C_RW), m1 = *(const f32x4*)(mu + col - C_RW + 4);
    float u[8] = {bflo(cu.x), bfhi(cu.x), bflo(cu.y), bfhi(cu.y), bflo(cu.z), bfhi(cu.z), bflo(cu.w), bfhi(cu.w)};
    const float p[8] = {bflo(pu.x), bfhi(pu.x), bflo(pu.y), bfhi(pu.y), bflo(pu.z), bfhi(pu.z), bflo(pu.w), bfhi(pu.w)};
    const float mm[8] = {m0[0], m0[1], m0[2], m0[3], m1[0], m1[1], m1[2], m1[3]};
#pragma unroll
    for (int j = 0; j < 8; ++j) { const float us = u[j] + (p[j] - u[j]) * mm[j]; u[j] = (ltype == 0) ? tanhf_fast(us) : ((ltype == 1) ? us : __builtin_amdgcn_rcpf(1.0f + __expf(-us))); }
    u32x4 w; w.x = pack2(u[0], u[1]); w.y = pack2(u[2], u[3]); w.z = pack2(u[4], u[5]); w.w = pack2(u[6], u[7]);
    return w;
}
template <int AMODE>
DI void g_load(u32x4 (&ra)[4], u32x4 (&rb)[2], const ARows& ar, const bf16_t* bt, int ldb, int k0, int tid) {
    const int kseg = (tid & 7) * 8;
#pragma unroll
    for (int i = 0; i < 4; ++i) {
        ra[i] = (u32x4){0u, 0u, 0u, 0u};
        if (AMODE == 2) ra[i] = lora_chunk(ar.p[i], (ar.first >> i) & 1, ar.mu, ar.ltype, k0 + kseg);
        else if (ar.p[i] != nullptr) ra[i] = *(const u32x4*)((AMODE == 0) ? (ar.p[i] + k0 + kseg) : (ar.p[i] + (size_t)(k0 >> 6) * IN_COLS + kseg));
    }
#pragma unroll
    for (int i = 0; i < 2; ++i) rb[i] = *(const u32x4*)(bt + (size_t)((tid >> 3) + 64 * i) * ldb + k0 + kseg);
}
DI void g_store(unsigned char* st, const u32x4 (&ra)[4], const u32x4 (&rb)[2], int tid) {
    const int off = g_off(tid >> 3, (tid & 7) * 8);
#pragma unroll
    for (int i = 0; i < 4; ++i) *(u32x4*)(st + G_A + off + i * 8192) = ra[i];
#pragma unroll
    for (int i = 0; i < 2; ++i) *(u32x4*)(st + G_B + off + i * 8192) = rb[i];
}
DI void g_compute(f32x4 (&acc)[4][4], const unsigned char* st, int lane, int wm, int wn) {
    const int lo = ((lane & 15) * 64 + (lane >> 4) * 16) ^ ((((lane & 15) >> 3) & 1) << 5);
    const unsigned char* sA = st + G_A + wm * 8192 + lo;
    const unsigned char* sB = st + G_B + wn * 8192 + lo;
    bf16x8 bcur[4], bnxt[4], a0, a1, a2;
#pragma unroll
    for (int i = 0; i < 4; ++i) bcur[i] = *(const bf16x8*)(sB + i * 2048);
    a0 = *(const bf16x8*)(sA);
    a1 = *(const bf16x8*)(sA + 2048);
#define G_AFRAG(s) (*(const bf16x8*)(sA + ((s) & 3) * 2048 + ((s) >> 2) * 1024))
#define G_GROUP(s, acur, anew) do { \
        if ((s) + 2 < 8) anew = G_AFRAG((s) + 2); \
        if ((s) < 4) bnxt[(s) & 3] = *(const bf16x8*)(sB + ((s) & 3) * 2048 + 1024); \
        __builtin_amdgcn_sched_barrier(0); \
        _Pragma("unroll") for (int ni = 0; ni < 4; ++ni) acc[(s) & 3][ni] = __builtin_amdgcn_mfma_f32_16x16x32_bf16(((s) < 4 ? bcur[ni] : bnxt[ni]), acur, acc[(s) & 3][ni], 0, 0, 0); \
        __builtin_amdgcn_sched_barrier(0); } while (0)
    G_GROUP(0, a0, a2); G_GROUP(1, a1, a0); G_GROUP(2, a2, a1); G_GROUP(3, a0, a2);
    G_GROUP(4, a1, a0); G_GROUP(5, a2, a1); G_GROUP(6, a0, a2); G_GROUP(7, a1, a0);
#undef G_GROUP
#undef G_AFRAG
}
#define LDS_BARRIER() do { asm volatile("s_waitcnt lgkmcnt(0)" ::: "memory"); __builtin_amdgcn_s_barrier(); asm volatile("" ::: "memory"); } while (0)
template <int AMODE>
DI void gemm_core(f32x4 (&acc)[4][4], const ARows& ar, const bf16_t* bt  , int ldb, int K, unsigned char* lds) {
    const int tid = TID(), lane = tid & 63, wave = tid >> 6, wm = wave >> 1, wn = wave & 1;
    const int nk = K >> 6;
    unsigned char* s0 = lds; unsigned char* s1 = lds + G_STAGE;
    u32x4 ra0[4], rb0[2], ra1[4], rb1[2];
    g_load<AMODE>(ra0, rb0, ar, bt, ldb, 0, tid);
    g_load<AMODE>(ra1, rb1, ar, bt, ldb, 64, tid);
    __syncthreads();
    g_store(s0, ra0, rb0, tid);
    g_load<AMODE>(ra0, rb0, ar, bt, ldb, (nk > 2 ? 2 : nk - 1) * 64, tid);
    LDS_BARRIER();
    for (int kt = 0; kt < nk; kt += 2) {
        g_store(s1, ra1, rb1, tid);
        { const int kn = (kt + 3 < nk) ? kt + 3 : nk - 1; g_load<AMODE>(ra1, rb1, ar, bt, ldb, kn * 64, tid); }
        g_compute(acc, s0, lane, wm, wn);
        LDS_BARRIER();
        g_store(s0, ra0, rb0, tid);
        { const int kn = (kt + 4 < nk) ? kt + 4 : nk - 1; g_load<AMODE>(ra0, rb0, ar, bt, ldb, kn * 64, tid); }
        g_compute(acc, s1, lane, wm, wn);
        LDS_BARRIER();
    }
}
static_assert(3 * G_STAGE <= LDS_BYTES - 64, "dma ring");
DI void gemm_core_dma(f32x4 (&acc)[4][4], const bf16_t* A, size_t lda, const bf16_t* bt, size_t ldb, int K, unsigned char* lds) {
    const int tid = TID(), lane = tid & 63, wave = __builtin_amdgcn_readfirstlane(tid >> 6), wm = wave >> 1, wn = wave & 1;
    const int nk = K >> 6;
    const int srow = lane >> 2, skof = ((lane & 3) * 8) ^ ((lane >> 5) << 4);
    const char* gp[6]; int loff[6];
#pragma unroll
    for (int j = 0; j < 6; ++j) {
        const int sid = wave * 6 + j;
        if (sid < 32) { gp[j] = (const char*)(A + (size_t)((sid >> 1) * 16 + srow) * lda + (sid & 1) * 32 + skof); loff[j] = G_A + sid * 1024; }
        else { const int s2 = sid - 32; gp[j] = (const char*)(bt + (size_t)((s2 >> 1) * 16 + srow) * ldb + (s2 & 1) * 32 + skof); loff[j] = G_B + s2 * 1024; }
    }
#define DMA_ISSUE(kt_, st_) do { const int _k = ((kt_) < nk ? (kt_) : nk - 1) * 128; \
        _Pragma("unroll") for (int j = 0; j < 6; ++j) __builtin_amdgcn_global_load_lds((const unsigned*)(gp[j] + _k), (LAS unsigned*)(lds + (st_) * G_STAGE + loff[j]), 16, 0, 0); } while (0)
    asm volatile("s_waitcnt vmcnt(0)" ::: "memory");
    __syncthreads();
    DMA_ISSUE(0, 0); DMA_ISSUE(1, 1);
    int st = 0;
    for (int kt = 0; kt < nk; ++kt) {
        asm volatile("s_waitcnt vmcnt(6)" ::: "memory");
        __builtin_amdgcn_s_barrier();
        asm volatile("" ::: "memory");
        const int sn = (st == 0) ? 2 : st - 1;
        DMA_ISSUE(kt + 2, sn);
        g_compute(acc, lds + st * G_STAGE, lane, wm, wn);
        st = (st == 2) ? 0 : st + 1;
    }
    asm volatile("s_waitcnt vmcnt(0)" ::: "memory");
    __syncthreads();
#undef DMA_ISSUE
}
DI void store_bf4(bf16_t* p, f32x4 v) { u32x2 w; w.x = pack2(v[0], v[1]); w.y = pack2(v[2], v[3]); *(u32x2*)p = w; }
constexpr int H_A = 0, H_B = 256 * 64 * 2, H_STAGE = 2 * 256 * 64 * 2;
static_assert(2 * H_STAGE <= LDS_BYTES - 64, "gemm256 lds");
DI void h_compute(f32x4 (&acc)[8][4], const unsigned char* st, int lane, int wm, int wn) {
    const int lo = ((lane & 15) * 64 + (lane >> 4) * 16) ^ ((((lane & 15) >> 3) & 1) << 5);
    const unsigned char* sA = st + H_A + wm * 16384 + lo;
    const unsigned char* sB = st + H_B + wn * 8192 + lo;
#pragma unroll
    for (int ks = 0; ks < 2; ++ks) {
        bf16x8 bf[4], a0, a1, a2;
#pragma unroll
        for (int i = 0; i < 4; ++i) bf[i] = *(const bf16x8*)(sB + i * 2048 + ks * 1024);
        a0 = *(const bf16x8*)(sA + ks * 1024);
        a1 = *(const bf16x8*)(sA + 2048 + ks * 1024);
#define H_GROUP(s, acur, anew) do { \
        if ((s) + 2 < 8) anew = *(const bf16x8*)(sA + ((s) + 2) * 2048 + ks * 1024); \
        __builtin_amdgcn_sched_barrier(0); \
        _Pragma("unroll") for (int ni = 0; ni < 4; ++ni) acc[(s)][ni] = __builtin_amdgcn_mfma_f32_16x16x32_bf16(bf[ni], acur, acc[(s)][ni], 0, 0, 0); \
        __builtin_amdgcn_sched_barrier(0); } while (0)
        H_GROUP(0, a0, a2); H_GROUP(1, a1, a0); H_GROUP(2, a2, a1); H_GROUP(3, a0, a2);
        H_GROUP(4, a1, a0); H_GROUP(5, a2, a1); H_GROUP(6, a0, a2); H_GROUP(7, a1, a0);
#undef H_GROUP
    }
}
DI void gemm256_dma(f32x4 (&acc)[8][4], const bf16_t* A, size_t lda, const bf16_t* bt, size_t ldb, int K, unsigned char* lds) {
    const int tid = TID(), lane = tid & 63, wave = __builtin_amdgcn_readfirstlane(tid >> 6), wm = wave >> 2, wn = wave & 3;
    const int nk = K >> 6;
    const int srow = lane >> 2, skof = ((lane & 3) * 8) ^ ((lane >> 5) << 4);
    const char* gp[8]; int loff[8];
#pragma unroll
    for (int j = 0; j < 8; ++j) {
        const int sid = wave * 8 + j;
        if (sid < 32) { gp[j] = (const char*)(A + (size_t)((sid >> 1) * 16 + srow) * lda + (sid & 1) * 32 + skof); loff[j] = H_A + sid * 1024; }
        else { const int s2 = sid - 32; gp[j] = (const char*)(bt + (size_t)((s2 >> 1) * 16 + srow) * ldb + (s2 & 1) * 32 + skof); loff[j] = H_B + s2 * 1024; }
    }
#define H_ISSUE(kt_, st_) do { const int _k = ((kt_) < nk ? (kt_) : nk - 1) * 128; \
        _Pragma("unroll") for (int j = 0; j < 8; ++j) __builtin_amdgcn_global_load_lds((const unsigned*)(gp[j] + _k), (LAS unsigned*)(lds + (st_) * H_STAGE + loff[j]), 16, 0, 0); } while (0)
    asm volatile("s_waitcnt vmcnt(0)" ::: "memory");
    __syncthreads();
    H_ISSUE(0, 0);
    for (int kt = 0; kt < nk; ++kt) {
        asm volatile("s_waitcnt vmcnt(0)" ::: "memory");
        __builtin_amdgcn_s_barrier();
        asm volatile("" ::: "memory");
        H_ISSUE(kt + 1, (kt + 1) & 1);
        h_compute(acc, lds + (kt & 1) * H_STAGE, lane, wm, wn);
    }
    asm volatile("s_waitcnt vmcnt(0)" ::: "memory");
    __syncthreads();
#undef H_ISSUE
}
DI void tile256_store_bf16(f32x4 (&acc)[8][4], bf16_t* out, size_t ld, int ncols, unsigned char* lds) {
    bf16_t* T = (bf16_t*)lds;
    const int tid = TID(), lane = tid & 63, wave = tid >> 6, wm = wave >> 2, wn = wave & 3;
    __syncthreads();
#pragma unroll
    for (int mi = 0; mi < 8; ++mi)
#pragma unroll
        for (int ni = 0; ni < 4; ++ni) store_bf4(T + (wm * 128 + mi * 16 + (lane & 15)) * 264 + wn * 64 + ni * 16 + (lane >> 4) * 4, acc[mi][ni]);
    __syncthreads();
#pragma unroll
    for (int i = 0; i < 16; ++i) {
        const int ch = tid + i * NTHREADS, r = ch >> 5, cc = (ch & 31) * 8;
        if (cc < ncols) *(u32x4*)(out + (size_t)r * ld + cc) = *(const u32x4*)(T + r * 264 + cc);
    }
}
DI void acc_zero(f32x4 (&acc)[4][4]) {
#pragma unroll
    for (int i = 0; i < 4; ++i)
#pragma unroll
        for (int j = 0; j < 4; ++j) acc[i][j] = (f32x4){0.f, 0.f, 0.f, 0.f};
}
#define ACC_FOREACH(acc, body) do { const int _l = TID() & 63, _w = TID() >> 6; \
    _Pragma("unroll") for (int _mi = 0; _mi < 4; ++_mi) _Pragma("unroll") for (int _ni = 0; _ni < 4; ++_ni) { \
        const int r_ = (_w >> 1) * 64 + _mi * 16 + (_l & 15), c_ = (_w & 1) * 64 + _ni * 16 + (_l >> 4) * 4; f32x4& v_ = acc[_mi][_ni]; body } } while (0)
DI ARows plain_rows(const bf16_t* base, size_t ld, int m0, int tid) { ARows a; a.mu = nullptr; a.ltype = 0; a.first = 0;
#pragma unroll
    for (int i = 0; i < 4; ++i) a.p[i] = base + (size_t)(m0 + (tid >> 3) + 64 * i) * ld;
    return a; }


DI void convert_tile4(const float* src, int ld, int N, int K, bf16_t* dst, int tile0, unsigned char* lds, int Kvalid = 1 << 30) {
    const int tid = TID();
    const int nkt = K >> 6;
    const int r = tid >> 3, seg = (tid & 7) * 8;
    f32x4 a[4], b[4];
#pragma unroll
    for (int u = 0; u < 4; ++u) {
        const int tile = tile0 + u, k0 = (tile % nkt) * 64, n0 = (tile / nkt) * 64;
        a[u] = (f32x4){0.f, 0.f, 0.f, 0.f}; b[u] = a[u];
        if (n0 + seg < N && k0 + r < Kvalid) { const float* q = src + (size_t)(k0 + r) * ld + n0 + seg; a[u] = *(const f32x4*)q; b[u] = *(const f32x4*)(q + 4); }
    }
    __syncthreads();
#pragma unroll
    for (int u = 0; u < 4; ++u) { bf16_t* T = (bf16_t*)lds + u * 64 * 72;
        u32x4 w; w.x = pack2(a[u][0], a[u][1]); w.y = pack2(a[u][2], a[u][3]); w.z = pack2(b[u][0], b[u][1]); w.w = pack2(b[u][2], b[u][3]); *(u32x4*)(T + r * 72 + seg) = w; }
    __syncthreads();
#pragma unroll
    for (int u = 0; u < 4; ++u) { const bf16_t* T = (const bf16_t*)lds + u * 64 * 72;
        const int tile = tile0 + u, k0 = (tile % nkt) * 64, n0 = (tile / nkt) * 64;
        u32x4 o;
        o.x = (unsigned)T[(seg + 0) * 72 + r] | ((unsigned)T[(seg + 1) * 72 + r] << 16); o.y = (unsigned)T[(seg + 2) * 72 + r] | ((unsigned)T[(seg + 3) * 72 + r] << 16);
        o.z = (unsigned)T[(seg + 4) * 72 + r] | ((unsigned)T[(seg + 5) * 72 + r] << 16); o.w = (unsigned)T[(seg + 6) * 72 + r] | ((unsigned)T[(seg + 7) * 72 + r] << 16);
        *(u32x4*)(dst + (size_t)(n0 + r) * K + k0 + seg) = o; }
}
struct Ctx {
    const Params* P; unsigned char* ws; float* out; int l;
    bf16_t* H; bf16_t* PROJ; bf16_t* F; bf16_t* POOLED; bf16_t* MERGED; bf16_t* CMPH; float* CMPO; float* POSB; int* ROUTE; int* ENT; bf16_t* HID; bf16_t* Y; bf16_t* VT; bf16_t* KC; bf16_t* VCT; bf16_t* YRAW; float* BON; unsigned* ctl;
    DI const float* in(int i) const { return P->in[i]; }
};

DI void add_moe_rows(const Ctx& c, int row, int lane, f32x4 (&v)[4]) {
    const int* rt = c.ROUTE + (size_t)row * 8;
    const int p0 = rt[4], p1 = rt[5];
    const bf16_t* y0 = c.Y + (size_t)p0 * DM; const bf16_t* y1 = c.Y + (size_t)p1 * DM;
#pragma unroll
    for (int i = 0; i < 4; ++i) {
        const u32x2 a = *(const u32x2*)(y0 + i * 256 + lane * 4), b = *(const u32x2*)(y1 + i * 256 + lane * 4);
        v[i][0] += bflo(a.x) + bflo(b.x); v[i][1] += bfhi(a.x) + bfhi(b.x); v[i][2] += bflo(a.y) + bflo(b.y); v[i][3] += bfhi(a.y) + bfhi(b.y);
    }
}
DI void phase_norm1(const Ctx& c, unsigned char* lds) {
    const int tid = TID(), lane = tid & 63, wave = tid >> 6;
    const float* gain = c.in(I_NMIX) + c.l * DM;
    const float* src = (c.l == 0) ? c.in(I_X) : c.out;
    for (int row = blockIdx.x * 8 + wave; row < NT; row += gridDim.x * 8) {
        f32x4 v[4];
#pragma unroll
        for (int i = 0; i < 4; ++i) v[i] = *(const f32x4*)(src + (size_t)row * DM + i * 256 + lane * 4);
        if (c.l > 0) {
            add_moe_rows(c, row, lane, v);
#pragma unroll
            for (int i = 0; i < 4; ++i) *(f32x4*)(c.out + (size_t)row * DM + i * 256 + lane * 4) = v[i];
        }
        float ss = 0.f;
#pragma unroll
        for (int i = 0; i < 4; ++i) ss += v[i][0] * v[i][0] + v[i][1] * v[i][1] + v[i][2] * v[i][2] + v[i][3] * v[i][3];
        ss = wave_sum_dpp(ss);
        const float rs = rsqrtf(ss * (1.0f / DM) + 1e-6f);
#pragma unroll
        for (int i = 0; i < 4; ++i) {
            const f32x4 g = *(const f32x4*)(gain + i * 256 + lane * 4);
            store_bf4(c.H + (size_t)row * DM + i * 256 + lane * 4, (f32x4){v[i][0] * rs * g[0], v[i][1] * rs * g[1], v[i][2] * rs * g[2], v[i][3] * rs * g[3]});
        }
    }
    for (int idx = blockIdx.x * 8 + wave; idx < 512; idx += gridDim.x * 8) {
        const int kv = idx >> 8, n = idx & 255;
        const float* pos = c.in(kv ? I_CPV : I_CPK) + (size_t)c.l * 2048;
        const float* w1 = c.in(kv ? I_CW1V : I_CW1K) + (size_t)c.l * 2048 * 256;
        float s = 0.f;
        for (int k = lane; k < 2048; k += 64) s += pos[k] * w1[(size_t)k * 256 + n];
        s = wave_sum_dpp(s);
        if (lane == 0) c.POSB[kv * 256 + n] = s;
    }
    for (int it = blockIdx.x * 4; it < 1216 + 256 + 16 + 16 + 48; it += gridDim.x * 4) {
        if (it < 1216) convert_tile4(c.in(I_WIN) + (size_t)c.l * DM * IN_COLS, IN_COLS, IN_COLS, DM, (bf16_t*)(c.ws + WS_WT_IN), it, lds);
        else if (it < 1216 + 256) { const int j = it - 1216, kv = j >> 7; convert_tile4(c.in(kv ? I_CW1V : I_CW1K) + (size_t)c.l * 2048 * 256, 256, 256, 2048, (bf16_t*)(c.ws + WS_WT_C1) + (size_t)kv * 256 * 2048, j & 127, lds); }
        else if (it < 1216 + 256 + 16) { const int j = it - 1472, kv = j >> 3; convert_tile4(c.in(kv ? I_CW2V : I_CW2K) + (size_t)c.l * 256 * 64, 64, 64, 256, (bf16_t*)(c.ws + WS_WT_C2) + (size_t)kv * 128 * 256, j & 7, lds); }
        else if (it < 1504) { const int j = it - 1488, gi = j >> 2; convert_tile4(c.in(I_POOLW) + ((size_t)c.l * 4 + gi) * 128 * 128, 128, 128, 128, (bf16_t*)(c.ws + WS_WT_POOL) + (size_t)gi * 128 * 128, 0, lds); }
        else { const int j = it - 1504, ty = j >> 4; bf16_t* dst = (bf16_t*)(c.ws + WS_WT_LORA) + (size_t)ty * 512 * 128;
            if (ty == 0) convert_tile4(c.in(I_WUP) + (size_t)c.l * 32 * 512, 512, 512, 128, dst, j & 15, lds, 32);
            else if (ty == 1) convert_tile4(c.in(I_AUP) + (size_t)c.l * 32 * 512, 512, 512, 128, dst, j & 15, lds, 32);
            else convert_tile4(c.in(I_GUP) + (size_t)c.l * 96 * 512, 512, 512, 128, dst, j & 15, lds, 96); }
    }
}

constexpr int EPS = 136;
DI void tile_store_bf16(f32x4 (&acc)[4][4], bf16_t* out, size_t ld, int nrows, int ncols, unsigned char* lds) {
    bf16_t* T = (bf16_t*)lds;
    const int tid = TID();
    __syncthreads();
    ACC_FOREACH(acc, { store_bf4(T + r_ * EPS + c_, v_); });
    __syncthreads();
#pragma unroll
    for (int i = 0; i < 8; ++i) {
        const int ch = tid + i * NTHREADS, r = ch >> 4, cc = (ch & 15) * 8;
        if (r < nrows && cc < ncols) *(u32x4*)(out + (size_t)r * ld + cc) = *(const u32x4*)(T + r * EPS + cc);
    }
}
DI bool xcd_unit(int it, int nN, int& tm, int& tn) {
    const int G = gridDim.x;
    if ((G & 7) != 0 || G < 8) { const int u = it * G + blockIdx.x; if (u >= 64 * nN) return false; tm = u % 64; tn = u / 64; return true; }
    const int x = blockIdx.x & 7, i = blockIdx.x >> 3, per = G >> 3;
    const int u = it * per + i;
    if (u >= 8 * nN) return false;
    tm = x * 8 + (u & 7); tn = u >> 3; return true;
}
DI void phase_gemm1(const Ctx& c, unsigned char* lds) {
    const int nN = (IN_COLS + 255) / 256;
    const bf16_t* WT = (const bf16_t*)(c.ws + WS_WT_IN);
    for (int it = 0;; ++it) {
        int tm, tn; if (!xcd_unit(it, nN, tm, tn)) break;
        const int m0 = tm * 256, n0 = tn * 256;
        f32x4 acc[8][4];
#pragma unroll
        for (int i = 0; i < 8; ++i)
#pragma unroll
            for (int j = 0; j < 4; ++j) acc[i][j] = (f32x4){0.f, 0.f, 0.f, 0.f};
        gemm256_dma(acc, c.H + (size_t)m0 * DM, DM, WT + (size_t)n0 * DM, DM, DM, lds);
        tile256_store_bf16(acc, c.PROJ + (size_t)m0 * IN_COLS + n0, IN_COLS, (IN_COLS - n0 < 256) ? IN_COLS - n0 : 256, lds);
    }
}

DI float gelu_tanh(float x) { const float u = 0.7978845608028654f * (x + 0.044715f * x * x * x); const float e = __expf(2.0f * u); return x * (1.0f - __builtin_amdgcn_rcpf(e + 1.0f)); }
DI float softplusf_(float x) { return (x > 20.f) ? x : __logf(1.0f + __expf(x)); }
DI float tanhf_(float x) { const float e = __expf(2.0f * x); return 1.0f - 2.0f * __builtin_amdgcn_rcpf(e + 1.0f); }
constexpr int TKP = 8;
template <int WIN>
DI void pool_emit(const Ctx& c, const float (&pv)[31], int t0, int s0, int ch) {
#pragma unroll
    for (int k = 0; k < 16; ++k) {
        float sum = 0.f;
#pragma unroll
        for (int j = 0; j < WIN; ++j) sum += pv[15 + k - j];
        const int s = s0 + k, cnt = (s + 1 < WIN) ? s + 1 : WIN;
        c.POOLED[(size_t)(t0 + k) * 512 + ch] = f2bf(sum / (float)cnt - pv[15 + k]);
    }
}
DI void phase_prep(const Ctx& c, unsigned char* lds) {
    const int n_cmp_items = 2 * 16 * 2;
    for (int item = (int)gridDim.x - 1 - (int)blockIdx.x; item < n_cmp_items; item += gridDim.x) {
        const int tid = TID();
        const int kv = item >> 5, bgi = (item >> 1) & 15, tn = item & 1, m0 = bgi * 256, n0 = tn * 128;
        ARows ar; ar.mu = nullptr; ar.ltype = 0; ar.first = 0;
#pragma unroll
        for (int i = 0; i < 4; ++i) { const int cb = (tid >> 3) + 64 * i;
            ar.p[i] = (cb < NCMP) ? c.PROJ + ((size_t)(bgi >> 2) * SEQ + 16 * cb) * IN_COLS + (kv ? C_VC : C_KC) + (bgi & 3) * 64 : nullptr; }
        f32x4 acc[4][4]; acc_zero(acc);
        gemm_core<1>(acc, ar, (const bf16_t*)(c.ws + WS_WT_C1) + ((size_t)kv * 256 + n0) * 2048, 2048, 2048, lds);
        const float* pb = c.POSB + kv * 256;
        ACC_FOREACH(acc, {
            const f32x4 bb = *(const f32x4*)(pb + n0 + c_);
            store_bf4(c.CMPH + ((size_t)kv * 4096 + m0 + r_) * 256 + n0 + c_, (f32x4){gelu_tanh(v_[0] + bb[0]), gelu_tanh(v_[1] + bb[1]), gelu_tanh(v_[2] + bb[2]), gelu_tanh(v_[3] + bb[3])}); });
    }
    {
        const float* mu = c.in(I_MU) + (size_t)c.l * RWC;
        const bf16_t* WL = (const bf16_t*)(c.ws + WS_WT_LORA);
        for (int unit = blockIdx.x; unit < 64 * 12; unit += gridDim.x) {
            const int tid = TID();
            const int tm = unit & 63, tn = unit >> 6, m0 = tm * 256, n0 = tn * 128, ltype = tn >> 2, ch0 = n0 & 511;
            ARows ar; ar.mu = mu; ar.ltype = ltype; ar.first = 0;
#pragma unroll
            for (int i = 0; i < 4; ++i) { const int t = m0 + (tid >> 3) + 64 * i; ar.p[i] = c.PROJ + (size_t)t * IN_COLS; if ((t & (SEQ - 1)) == 0) ar.first |= 1 << i; }
            f32x4 acc[4][4]; acc_zero(acc);
            gemm_core<2>(acc, ar, WL + (size_t)n0 * 128, 128, 128, lds);
            if (ltype == 0) { const float* w0 = c.in(I_W0) + c.l * 512 + ch0;
                ACC_FOREACH(acc, { const f32x4 b4 = *(const f32x4*)(w0 + c_);
                    for (int j = 0; j < 4; ++j) v_[j] = __expf(-softplusf_(-(b4[j] + v_[j])) - 0.5f); }); }
            else if (ltype == 1) { const float* a0 = c.in(I_A0) + c.l * 512 + ch0;
                ACC_FOREACH(acc, { const f32x4 b4 = *(const f32x4*)(a0 + c_);
                    for (int j = 0; j < 4; ++j) v_[j] = sigmoidf_(b4[j] + v_[j]); }); }
            tile_store_bf16(acc, c.F + (size_t)(3 + ltype) * NT * 512 + (size_t)m0 * 512 + ch0, 512, 256, 128, lds);
        }
    }
    const int tid = TID();
    const int n_pool_items = NT / 16, n_items = n_pool_items + 2048;
    for (int item = blockIdx.x; item < n_items; item += gridDim.x) {
        if (item >= n_pool_items) {
            const int idx = item - n_pool_items, kind = idx >> 10, bgi = (idx >> 6) & 15, s0 = (idx & 63) * 64;
            bf16_t* T = (bf16_t*)lds;
            const int r = tid >> 3, seg = (tid & 7) * 8;
            const u32x4 w = *(const u32x4*)(c.PROJ + ((size_t)(bgi >> 2) * SEQ + s0 + r) * IN_COLS + (kind ? C_VW : C_VS) + (bgi & 3) * 64 + seg);
            __syncthreads();
            *(u32x4*)(T + r * 72 + seg) = w;
            __syncthreads();
            u32x4 o;
            o.x = (unsigned)T[(seg + 0) * 72 + r] | ((unsigned)T[(seg + 1) * 72 + r] << 16); o.y = (unsigned)T[(seg + 2) * 72 + r] | ((unsigned)T[(seg + 3) * 72 + r] << 16);
            o.z = (unsigned)T[(seg + 4) * 72 + r] | ((unsigned)T[(seg + 5) * 72 + r] << 16); o.w = (unsigned)T[(seg + 6) * 72 + r] | ((unsigned)T[(seg + 7) * 72 + r] << 16);
            *(u32x4*)(c.VT + (((size_t)kind * 16 + bgi) * 64 + r) * SEQ + s0 + seg) = o;
        } else {
            const int t0 = item * 16, ch = tid, gi = ch >> 7, s0 = t0 & (SEQ - 1);
            float pv[31];
#pragma unroll
            for (int i = 0; i < 31; ++i) pv[i] = (s0 - 15 + i >= 0) ? bf2f(c.PROJ[(size_t)(t0 - 15 + i) * IN_COLS + C_POOL + ch]) : 0.f;
            if (gi == 0) pool_emit<2>(c, pv, t0, s0, ch);
            else if (gi == 1) pool_emit<4>(c, pv, t0, s0, ch);
            else if (gi == 2) pool_emit<8>(c, pv, t0, s0, ch);
            else pool_emit<16>(c, pv, t0, s0, ch);
        }
    }
}

DI void rwkv_finalize_item(const Ctx& c, int item) {
    const int tid = TID(), ch = tid, t0 = item * 8;
    const float* mu = c.in(I_MU) + (size_t)c.l * RWC;
    const float kkw_ = c.in(I_KK)[c.l * 512 + ch], kaw_ = c.in(I_KA)[c.l * 512 + ch], rkw_ = c.in(I_RK)[c.l * 512 + ch];
    const float mur = mu[ch], muk = mu[512 + ch], muv = mu[1024 + ch];
    bf16_t ur[9], uk[9], uv[9], ua[8];
    const bool has_prev = (t0 & (SEQ - 1)) != 0;
#pragma unroll
    for (int k = 0; k < 9; ++k) {
        ur[k] = 0; uk[k] = 0; uv[k] = 0;
        if (k > 0 || has_prev) { const bf16_t* q = c.PROJ + (size_t)(t0 - 1 + k) * IN_COLS; ur[k] = q[C_R + ch]; uk[k] = q[C_K + ch]; uv[k] = q[C_V + ch]; }
    }
#pragma unroll
    for (int k = 0; k < 8; ++k) ua[k] = c.F[(size_t)4 * NT * 512 + (size_t)(t0 + k) * 512 + ch];
#pragma unroll
    for (int k = 0; k < 8; ++k) {
        const int t = t0 + k;
        const float cr = bf2f(ur[k + 1]), ck = bf2f(uk[k + 1]), cv = bf2f(uv[k + 1]);
        const float r = cr + (bf2f(ur[k]) - cr) * mur, kx = ck + (bf2f(uk[k]) - ck) * muk, vx = cv + (bf2f(uv[k]) - cv) * muv;
        const float a = bf2f(ua[k]);
        const float kxn = kx * kkw_, kp = kx * (1.0f + (a - 1.0f) * kaw_);
        const float ss = wave_sum_dpp(kxn * kxn);
        const float inv = __builtin_amdgcn_rsqf(fmaxf(ss, 1e-24f));
        const float br = wave_sum_dpp(kxn * inv * a * r), kr = wave_sum_dpp(kp * r), bon = wave_sum_dpp(r * kp * rkw_);
        if ((tid & 63) == 0) *(f32x4*)(c.BON + ((size_t)t * 8 + (tid >> 6)) * 4) = (f32x4){inv, br, kr, bon};
        const size_t o = (size_t)t * 512 + ch;
        c.F[o] = f2bf(r); c.F[o + (size_t)NT * 512] = f2bf(kx); c.F[o + (size_t)2 * NT * 512] = f2bf(vx);
    }
}

DI void phase_poolgemm(const Ctx& c, unsigned char* lds) {
    for (int item = blockIdx.x; item < NT / 8; item += gridDim.x) rwkv_finalize_item(c, item);
    const int n_pool = (NT / 256) * 4, n_items = n_pool + 32;
    for (int item = blockIdx.x; item < n_items; item += gridDim.x) {
        f32x4 acc[4][4]; acc_zero(acc);
        if (item < n_pool) {
            const int tm = item >> 2, gi = item & 3, m0 = tm * 256;
            const ARows ar = plain_rows(c.POOLED + gi * 128, 512, m0, TID());
            gemm_core<0>(acc, ar, (const bf16_t*)(c.ws + WS_WT_POOL) + (size_t)gi * 128 * 128, 128, 128, lds);
            const float* sc = c.in(I_POOLS) + c.l * 512 + gi * 128;
            ACC_FOREACH(acc, { const f32x4 s = *(const f32x4*)(sc + c_);
                store_bf4(c.POOLED + (size_t)(m0 + r_) * 512 + gi * 128 + c_, (f32x4){v_[0] * s[0], v_[1] * s[1], v_[2] * s[2], v_[3] * s[3]}); });
        } else {
            const int it = item - n_pool, kv = it >> 4, tm = it & 15, m0 = tm * 256;
            const ARows ar = plain_rows(c.CMPH + (size_t)kv * 4096 * 256, 256, m0, TID());
            gemm_core<0>(acc, ar, (const bf16_t*)(c.ws + WS_WT_C2) + (size_t)kv * 128 * 256, 256, 256, lds);
            ACC_FOREACH(acc, { if (c_ < 64) { const int R = m0 + r_;
                if (kv == 0) store_bf4(c.KC + (size_t)R * 64 + c_, v_);
                else { bf16_t* q = c.VCT + ((size_t)(R >> 8) * 64 + c_) * 256 + (R & 255); q[0] = f2bf(v_[0]); q[256] = f2bf(v_[1]); q[512] = f2bf(v_[2]); q[768] = f2bf(v_[3]); } } });
        }
    }
}

constexpr int SCH = 32;
constexpr int SB_AN = 0, SB_WR = SCH * 64 * 4, SB_W = 2 * SCH * 64 * 4, SB_BB = 3 * SCH * 64 * 4, SB_KP = 4 * SCH * 64 * 4;
constexpr int SB_V = 5 * SCH * 64 * 4;
constexpr int SB_SC = SB_V + SCH * 16 * 4;
constexpr int SB_Y = SB_SC + SCH * 2 * 4;
constexpr int SB_BYTES = SB_Y + SCH * 16 * 4;
static_assert(2 * SB_BYTES <= LDS_BYTES - 64, "scan lds");
typedef float f32x2 __attribute__((ext_vector_type(2)));
DI float row8_sum(float v) { v += DPP_MOV(v, 0xB1); v += DPP_MOV(v, 0x4E); v += DPP_MOV(v, 0x141); return v; }

constexpr int NPW = 6, NJ = (SCH + NPW - 1) / NPW;
struct PrepRegs { bf16_t r[NJ], k[NJ], v[NJ], e[NJ], a[NJ]; float s0[NJ], s1[NJ], s2[NJ]; };
DI void prep_load(PrepRegs& R, const Ctx& c, int b, int h, int ck, int pw, int lane) {
    const size_t PL = (size_t)NT * 512;
    const size_t tb = (size_t)b * SEQ + ck * SCH;
    const size_t o0 = tb * 512 + h * 64 + lane;
#pragma unroll
    for (int j = 0; j < NJ; ++j) {
        const int st = pw + NPW * j;
        if (st < SCH) { const size_t o = o0 + (size_t)st * 512; R.r[j] = c.F[o]; R.k[j] = c.F[o + PL]; R.v[j] = c.F[o + 2 * PL]; R.e[j] = c.F[o + 3 * PL]; R.a[j] = c.F[o + 4 * PL];
            const float* sp = c.BON + ((tb + st) * 8 + h) * 4; R.s0[j] = sp[0]; R.s1[j] = sp[1]; R.s2[j] = sp[2]; }
    }
}
DI void prep_store(const PrepRegs& R, unsigned char* sb, int rq, int pw, int lane, float kkw, float kaw) {
    float* an = (float*)(sb + SB_AN); float* wr = (float*)(sb + SB_WR); float* w_ = (float*)(sb + SB_W); float* bb_ = (float*)(sb + SB_BB); float* kp_ = (float*)(sb + SB_KP);
    float* vv = (float*)(sb + SB_V); float* sc = (float*)(sb + SB_SC);
#pragma unroll
    for (int j = 0; j < NJ; ++j) {
        const int st = pw + NPW * j;
        if (st < SCH) {
            const float r = bf2f(R.r[j]), k = bf2f(R.k[j]), v = bf2f(R.v[j]), e = bf2f(R.e[j]), a = bf2f(R.a[j]);
            const float w = __expf(-e);
            const float kk = k * kkw * R.s0[j];
            const float kp = k * (1.0f + (a - 1.0f) * kaw);
            an[st * 64 + lane] = -kk; wr[st * 64 + lane] = w * r; w_[st * 64 + lane] = w; bb_[st * 64 + lane] = kk * a; kp_[st * 64 + lane] = kp;
            if ((lane >> 4) == rq) vv[st * 16 + (lane & 15)] = v;
            if (lane == 0) { sc[st * 2] = R.s1[j]; sc[st * 2 + 1] = R.s2[j]; }
        }
    }
}
DI void scan_item(const Ctx& c, int item, unsigned char* lds) {
    const int tid = TID(), lane = tid & 63, wave = tid >> 6;
    const int b = item >> 5, h = (item >> 2) & 7, rq = item & 3;
    const int chn = h * 64 + lane;
    const float kkw = c.in(I_KK)[c.l * 512 + chn], kaw = c.in(I_KA)[c.l * 512 + chn];
    const int rowl = (tid & 127) >> 3, cg = tid & 7;
    f32x2 st[4];
#pragma unroll
    for (int i = 0; i < 4; ++i) st[i] = (f32x2){0.f, 0.f};
    constexpr int NCK = SEQ / SCH;
    PrepRegs R;
    __syncthreads();
    if (wave >= 2) { prep_load(R, c, b, h, 0, wave - 2, lane); prep_store(R, lds, rq, wave - 2, lane, kkw, kaw); prep_load(R, c, b, h, 1, wave - 2, lane); }
    __syncthreads();
    for (int ck = 0; ck < NCK; ++ck) {
        unsigned char* sb = lds + (ck & 1) * SB_BYTES;
        if (wave < 2) {
            const float* an = (const float*)(sb + SB_AN) + cg * 8; const float* wr = (const float*)(sb + SB_WR) + cg * 8; const float* w_ = (const float*)(sb + SB_W) + cg * 8;
            const float* bb_ = (const float*)(sb + SB_BB) + cg * 8; const float* kp_ = (const float*)(sb + SB_KP) + cg * 8;
            const float* vv = (const float*)(sb + SB_V) + rowl; const float* sc = (const float*)(sb + SB_SC); float* yb = (float*)(sb + SB_Y) + rowl;
            f32x4 a0 = *(const f32x4*)(an), a1 = *(const f32x4*)(an + 4), r0 = *(const f32x4*)(wr), r1 = *(const f32x4*)(wr + 4);
            f32x4 w0 = *(const f32x4*)(w_), w1 = *(const f32x4*)(w_ + 4), b0 = *(const f32x4*)(bb_), b1 = *(const f32x4*)(bb_ + 4);
            f32x4 k0 = *(const f32x4*)(kp_), k1 = *(const f32x4*)(kp_ + 4);
            float v = vv[0]; f32x2 bk = *(const f32x2*)(sc);
#pragma unroll 2
            for (int s = 0; s < SCH; ++s) {
                const int sn = (s + 1 < SCH) ? s + 1 : s;
                const f32x4 na0 = *(const f32x4*)(an + sn * 64), na1 = *(const f32x4*)(an + sn * 64 + 4), nr0 = *(const f32x4*)(wr + sn * 64), nr1 = *(const f32x4*)(wr + sn * 64 + 4);
                const f32x4 nw0 = *(const f32x4*)(w_ + sn * 64), nw1 = *(const f32x4*)(w_ + sn * 64 + 4), nb0 = *(const f32x4*)(bb_ + sn * 64), nb1 = *(const f32x4*)(bb_ + sn * 64 + 4);
                const f32x4 nk0 = *(const f32x4*)(kp_ + sn * 64), nk1 = *(const f32x4*)(kp_ + sn * 64 + 4);
                const float nv = vv[sn * 16]; const f32x2 nbk = *(const f32x2*)(sc + sn * 2);
                f32x2 da = st[0] * (f32x2){a0[0], a0[1]}; f32x2 dr = st[0] * (f32x2){r0[0], r0[1]};
                da += st[1] * (f32x2){a0[2], a0[3]}; dr += st[1] * (f32x2){r0[2], r0[3]};
                da += st[2] * (f32x2){a1[0], a1[1]}; dr += st[2] * (f32x2){r1[0], r1[1]};
                da += st[3] * (f32x2){a1[2], a1[3]}; dr += st[3] * (f32x2){r1[2], r1[3]};
                float sa = da[0] + da[1], sr = dr[0] + dr[1];
                sa += DPP_MOV(sa, 0xB1); sr += DPP_MOV(sr, 0xB1);
                sa += DPP_MOV(sa, 0x4E); sr += DPP_MOV(sr, 0x4E);
                sa += DPP_MOV(sa, 0x141); sr += DPP_MOV(sr, 0x141);
                const f32x2 sa2 = (f32x2){sa, sa}, v2 = (f32x2){v, v};
                st[0] = st[0] * (f32x2){w0[0], w0[1]} + sa2 * (f32x2){b0[0], b0[1]} + v2 * (f32x2){k0[0], k0[1]};
                st[1] = st[1] * (f32x2){w0[2], w0[3]} + sa2 * (f32x2){b0[2], b0[3]} + v2 * (f32x2){k0[2], k0[3]};
                st[2] = st[2] * (f32x2){w1[0], w1[1]} + sa2 * (f32x2){b1[0], b1[1]} + v2 * (f32x2){k1[0], k1[1]};
                st[3] = st[3] * (f32x2){w1[2], w1[3]} + sa2 * (f32x2){b1[2], b1[3]} + v2 * (f32x2){k1[2], k1[3]};
                yb[s * 16] = sr + sa * bk[0] + v * bk[1];
                a0 = na0; a1 = na1; r0 = nr0; r1 = nr1; w0 = nw0; w1 = nw1; b0 = nb0; b1 = nb1; k0 = nk0; k1 = nk1; v = nv; bk = nbk;
            }
        } else {
            const int pt = tid - 128;
            if (ck + 1 < NCK) prep_store(R, lds + ((ck + 1) & 1) * SB_BYTES, rq, wave - 2, lane, kkw, kaw);
            if (ck + 2 < NCK) prep_load(R, c, b, h, ck + 2, wave - 2, lane);
            if (ck > 0) {
                const float* yb = (const float*)(lds + ((ck - 1) & 1) * SB_BYTES + SB_Y);
                for (int idx = pt; idx < SCH * 16; idx += 384) {
                    const int s = idx >> 4, j = idx & 15;
                    c.YRAW[((size_t)b * SEQ + (ck - 1) * SCH + s) * 512 + h * 64 + rq * 16 + j] = f2bf(yb[idx]);
                }
            }
        }
        asm volatile("s_waitcnt lgkmcnt(0)" ::: "memory"); __builtin_amdgcn_s_barrier(); asm volatile("" ::: "memory");
    }
    {
        const float* yb = (const float*)(lds + ((NCK - 1) & 1) * SB_BYTES + SB_Y);
        for (int idx = tid; idx < SCH * 16; idx += NTHREADS) {
            const int s = idx >> 4, j = idx & 15;
            c.YRAW[((size_t)b * SEQ + (NCK - 1) * SCH + s) * 512 + h * 64 + rq * 16 + j] = f2bf(yb[idx]);
        }
    }
    __syncthreads();
}
DI void phase_rwkv_post(const Ctx& c, unsigned char* lds) {
    const int tid = TID(), lane = tid & 63, wave = tid >> 6;
    const size_t PL = (size_t)NT * 512;
    for (int t = blockIdx.x * 8 + wave; t < NT; t += gridDim.x * 8) {
        bf16_t ry[8], rv[8], rg[8]; float bon[8], gw[8], gb[8];
#pragma unroll
        for (int h = 0; h < 8; ++h) { const size_t o = (size_t)t * 512 + h * 64 + lane; ry[h] = c.YRAW[o]; rv[h] = c.F[o + 2 * PL]; rg[h] = c.F[o + 5 * PL]; bon[h] = c.BON[((size_t)t * 8 + h) * 4 + 3];
            gw[h] = c.in(I_GNW)[c.l * 512 + h * 64 + lane]; gb[h] = c.in(I_GNB)[c.l * 512 + h * 64 + lane]; }
#pragma unroll
        for (int h = 0; h < 8; ++h) {
            const float y = bf2f(ry[h]);
            const float mean = wave_sum_dpp(y) * (1.0f / 64.0f);
            const float d = y - mean;
            const float var = wave_sum_dpp(d * d) * (1.0f / 64.0f);
            const float yn = d * rsqrtf(var + 64e-5f) * gw[h] + gb[h];
            c.F[(size_t)t * 512 + h * 64 + lane + 5 * PL] = f2bf((yn + bon[h] * bf2f(rv[h])) * bf2f(rg[h]));
        }
    }
    for (int it = blockIdx.x * 4; it < 768 + 128 + 128 + 256 + 256; it += gridDim.x * 4) {
        const float* WB = c.in(I_WBR) + (size_t)c.l * 2048 * DM; bf16_t* BR = (bf16_t*)(c.ws + WS_WT_BR);
        if (it < 768) convert_tile4(c.in(I_WMG) + (size_t)c.l * DM * 3 * DM, 3 * DM, 3 * DM, DM, (bf16_t*)(c.ws + WS_WT_MG), it, lds);
        else if (it < 896) convert_tile4(WB, DM, DM, 512, BR, it - 768, lds);
        else if (it < 1024) convert_tile4(WB + (size_t)512 * DM, DM, DM, 512, BR + (size_t)1024 * 512, it - 896, lds);
        else if (it < 1280) convert_tile4(WB + (size_t)1024 * DM, DM, DM, 1024, BR + (size_t)2048 * 512, it - 1024, lds);
        else convert_tile4(c.in(I_WOUT) + (size_t)c.l * DM * DM, DM, DM, DM, (bf16_t*)(c.ws + WS_WT_OUT), it - 1280, lds);
    }
}
constexpr int TS = 72;
constexpr int NSA_BIAS = 0;
constexpr int NSA_SELM = 2112;
constexpr int NSA_SCR = 2624;
constexpr int NSA_K0 = 4672;
constexpr int NSA_V0 = NSA_K0 + 2 * 64 * TS * 2;
constexpr int NSA_A = NSA_V0 + 2 * 64 * TS * 2;
constexpr int NSA_B = NSA_A + 16384;
constexpr int NSA_END = NSA_B + 16384;
static_assert(NSA_END <= LDS_BYTES - 16, "nsa lds");
static_assert(NSA_K0 % 16 == 0, "align");

struct NsaLane { int tq[2]; int h; float cbias; float m[2], l[2]; };

DI void nsa_prefetch(u32x4& rk, u32x4& rv, const bf16_t* kbase, int kstride, const bf16_t* vtbase, int vstride, int pos0, int tid) {
    const int r = tid >> 3, seg = (tid & 7) * 8;
    rk = *(const u32x4*)(kbase + (size_t)(pos0 + r) * kstride + seg);
    rv = *(const u32x4*)(vtbase + (size_t)r * vstride + pos0 + seg);
}
DI void nsa_store(unsigned char* lds, int buf, const u32x4& rk, const u32x4& rv, int tid) {
    const int r = tid >> 3, seg = (tid & 7) * 8;
    *(u32x4*)((bf16_t*)(lds + NSA_K0) + buf * 64 * TS + r * TS + seg) = rk;
    *(u32x4*)((bf16_t*)(lds + NSA_V0) + buf * 64 * TS + r * TS + seg) = rv;
}
template <int QM = 3>
DI void nsa_qk(f32x4 (&s)[2][4], const bf16_t* sK, const bf16x8 (&qf)[2][2], int lane) {
#pragma unroll
    for (int kt = 0; kt < 4; ++kt) {
#pragma unroll
        for (int ks = 0; ks < 2; ++ks) {
            const bf16x8 kf = *(const bf16x8*)(sK + (16 * kt + (lane & 15)) * TS + 32 * ks + (lane >> 4) * 8);
#pragma unroll
            for (int qi = 0; qi < 2; ++qi) if ((QM >> qi) & 1) s[qi][kt] = __builtin_amdgcn_mfma_f32_16x16x32_bf16(kf, qf[qi][ks], (ks == 0) ? (f32x4){0.f, 0.f, 0.f, 0.f} : s[qi][kt], 0, 0, 0);
        }
    }
}
template <int MODE>
DI void nsa_logits(float (&x)[4][4], const f32x4 (&s)[4], int tq, int h, float cbias, bool rowsel, int pos0, int qd, const float* biasT) {
#pragma unroll
    for (int kt = 0; kt < 4; ++kt)
#pragma unroll
        for (int i = 0; i < 4; ++i) {
            const int kk = pos0 + 16 * kt + 4 * qd + i;
            if (MODE == 1) { x[kt][i] = rowsel ? s[kt][i] + cbias : -INFINITY; }
            else {
                const int dist = (MODE == 0) ? (tq - 16 * kk - 31) : (tq - kk);
                bool ok = dist >= 0;
                if (MODE == 2) ok = ok && rowsel;
                if (MODE == 3) ok = ok && (dist < 512);
                const int di = dist < 0 ? 0 : (dist > 128 ? 128 : dist);
                float bias = biasT[di * 4 + h];
                asm volatile("" : "+v"(bias));
                x[kt][i] = ok ? s[kt][i] + bias : -INFINITY;
            }
        }
}
DI float quad16_max(float v) { v = fmaxf(v, __shfl_xor(v, 16)); v = fmaxf(v, __shfl_xor(v, 32)); return v; }
DI float quad16_sum(float v) { v += __shfl_xor(v, 16); v += __shfl_xor(v, 32); return v; }
DI void nsa_softmax(const float (&x)[4][4], float& m, float& l, f32x4 (&O)[4], bf16x8 (&pf)[2]) {
    float mx = -INFINITY;
#pragma unroll
    for (int kt = 0; kt < 4; ++kt)
#pragma unroll
        for (int i = 0; i < 4; ++i) mx = fmaxf(mx, x[kt][i]);
    mx = quad16_max(mx);
    const float mn = fmaxf(m, mx);
    const float mu = (mn == -INFINITY) ? 0.f : mn;
    const float mu2 = mu * 1.4426950408889634f;
    const float sc = __builtin_amdgcn_exp2f(__builtin_fmaf(m, 1.4426950408889634f, -mu2));
    float p[4][4]; float ps = 0.f;
#pragma unroll
    for (int kt = 0; kt < 4; ++kt)
#pragma unroll
        for (int i = 0; i < 4; ++i) { p[kt][i] = __builtin_amdgcn_exp2f(__builtin_fmaf(x[kt][i], 1.4426950408889634f, -mu2)); ps += p[kt][i]; }
    l = l * sc + ps; m = mn;
#pragma unroll
    for (int dt = 0; dt < 4; ++dt) O[dt] = O[dt] * sc;
#pragma unroll
    for (int ks = 0; ks < 2; ++ks) {
        u32x4 w; w.x = pack2(p[2 * ks][0], p[2 * ks][1]); w.y = pack2(p[2 * ks][2], p[2 * ks][3]); w.z = pack2(p[2 * ks + 1][0], p[2 * ks + 1][1]); w.w = pack2(p[2 * ks + 1][2], p[2 * ks + 1][3]);
        pf[ks] = __builtin_bit_cast(bf16x8, w);
    }
}
template <int QM = 3>
DI void nsa_pv(f32x4 (&O)[2][4], const bf16_t* sV, const bf16x8 (&pf)[2][2], int lane) {
    const int qd = lane >> 4;
#pragma unroll
    for (int dt = 0; dt < 4; ++dt)
#pragma unroll
        for (int ks = 0; ks < 2; ++ks) {
            const bf16_t* vp = sV + (16 * dt + (lane & 15)) * TS + 32 * ks + 4 * qd;
            const u32x2 a = *(const u32x2*)vp, b = *(const u32x2*)(vp + 16);
            u32x4 w; w.x = a.x; w.y = a.y; w.z = b.x; w.w = b.y;
            const bf16x8 vf = __builtin_bit_cast(bf16x8, w);
#pragma unroll
            for (int qi = 0; qi < 2; ++qi) if ((QM >> qi) & 1) O[qi][dt] = __builtin_amdgcn_mfma_f32_16x16x32_bf16(vf, pf[qi][ks], O[qi][dt], 0, 0, 0);
        }
}
template <int MODE, int QM = 3>
DI void nsa_tile(f32x4 (&O)[2][4], NsaLane& L, const bf16x8 (&qf)[2][2], const unsigned char* lds, int buf, int pos0, bool sel0, bool sel1, int lane) {
    const bf16_t* sK = (const bf16_t*)(lds + NSA_K0) + buf * 64 * TS;
    const bf16_t* sV = (const bf16_t*)(lds + NSA_V0) + buf * 64 * TS;
    const float* biasT = (const float*)(lds + NSA_BIAS);
    f32x4 s[2][4];
    nsa_qk<QM>(s, sK, qf, lane);
    bf16x8 pf[2][2];
#pragma unroll
    for (int qi = 0; qi < 2; ++qi) if ((QM >> qi) & 1) {
        float x[4][4];
        nsa_logits<MODE>(x, s[qi], L.tq[qi], L.h, L.cbias, qi ? sel1 : sel0, pos0, lane >> 4, biasT);
        nsa_softmax(x, L.m[qi], L.l[qi], O[qi], pf[qi]);
    }
    nsa_pv<QM>(O, sV, pf, lane);
}
template <int MODE>
DI void nsa_tile_sel(f32x4 (&O)[2][4], NsaLane& L, const bf16x8 (&qf)[2][2], const unsigned char* lds, int buf, int pos0, bool sel0, bool sel1, int lane) {
    const bool a0 = __ballot(sel0) != 0ull, a1 = __ballot(sel1) != 0ull;
    if (a0 && a1) nsa_tile<MODE, 3>(O, L, qf, lds, buf, pos0, sel0, sel1, lane);
    else if (a0) nsa_tile<MODE, 1>(O, L, qf, lds, buf, pos0, sel0, sel1, lane);
    else if (a1) nsa_tile<MODE, 2>(O, L, qf, lds, buf, pos0, sel0, sel1, lane);
}
DI void nsa_flush(f32x4 (&Y)[2][4], f32x4 (&O)[2][4], NsaLane& L, const float (&gate)[2]) {
#pragma unroll
    for (int qi = 0; qi < 2; ++qi) {
        const float lt = quad16_sum(L.l[qi]);
        const float f = (lt > 0.f) ? gate[qi] * __builtin_amdgcn_rcpf(lt) : 0.f;
#pragma unroll
        for (int dt = 0; dt < 4; ++dt) { Y[qi][dt] += O[qi][dt] * f; O[qi][dt] = (f32x4){0.f, 0.f, 0.f, 0.f}; }
    }
}
DI void nsa_item(const Ctx& c, int item, unsigned char* lds) {
    const int tid = TID(), lane = tid & 63, wave = tid >> 6, qd = lane >> 4;
    const int b = item >> 8, g = (item >> 6) & 3, qt = item & 63, t0 = qt * 64, cur = qt, bg = b * 4 + g;
    float* biasT = (float*)(lds + NSA_BIAS);
    unsigned long long* selm = (unsigned long long*)(lds + NSA_SELM);
    float* scr = (float*)(lds + NSA_SCR) + wave * 64;
    float* impA = (float*)(lds + NSA_A); float* impB = (float*)(lds + NSA_B);
    __syncthreads();
    for (int i = tid; i < 129 * 4; i += NTHREADS) { const int d = i >> 2, h = i & 3; biasT[i] = c.in(I_RELB)[t5_bucket(d) * 16 + g * 4 + h]; }
    for (int i = tid; i < 2 * 4096; i += NTHREADS) impA[i] = 0.f;
    NsaLane L; L.h = lane & 3;
    bf16x8 qf[2][2]; float gates[2][3];
    const bf16_t* pbat = c.PROJ + (size_t)b * SEQ * IN_COLS;
#pragma unroll
    for (int qi = 0; qi < 2; ++qi) {
        const int tl = 8 * wave + 4 * qi + ((lane & 15) >> 2);
        L.tq[qi] = t0 + tl;
        const bf16_t* prow = pbat + (size_t)L.tq[qi] * IN_COLS;
#pragma unroll
        for (int ks = 0; ks < 2; ++ks) {
            u32x4 w = *(const u32x4*)(prow + C_Q + (g * 4 + L.h) * 64 + 32 * ks + qd * 8);
            w.x = pack2(bflo(w.x) * 0.125f, bfhi(w.x) * 0.125f); w.y = pack2(bflo(w.y) * 0.125f, bfhi(w.y) * 0.125f);
            w.z = pack2(bflo(w.z) * 0.125f, bfhi(w.z) * 0.125f); w.w = pack2(bflo(w.w) * 0.125f, bfhi(w.w) * 0.125f);
            qf[qi][ks] = __builtin_bit_cast(bf16x8, w);
        }
#pragma unroll
        for (int br = 0; br < 3; ++br) gates[qi][br] = sigmoidf_(bf2f(prow[C_GATE + g * 12 + L.h * 3 + br]));
    }
    __syncthreads();
    L.cbias = biasT[128 * 4 + L.h];
    f32x4 O[2][4], Y[2][4];
#pragma unroll
    for (int qi = 0; qi < 2; ++qi)
#pragma unroll
        for (int dt = 0; dt < 4; ++dt) { O[qi][dt] = (f32x4){0.f, 0.f, 0.f, 0.f}; Y[qi][dt] = (f32x4){0.f, 0.f, 0.f, 0.f}; }
    u32x4 rk, rv;
    const int nvis_max = (t0 + 63 >= 31) ? ((t0 + 63 - 31) >> 4) + 1 : 0;
    const int ncb = (nvis_max + 63) >> 6;
    const bf16_t* kcb = c.KC + (size_t)bg * 256 * 64; const bf16_t* vcb = c.VCT + (size_t)bg * 64 * 256;
    L.m[0] = L.m[1] = -INFINITY; L.l[0] = L.l[1] = 0.f;
    if (ncb > 0) nsa_prefetch(rk, rv, kcb, 64, vcb, 256, 0, tid);
    for (int cb = 0; cb < ncb; ++cb) {
        nsa_store(lds, cb & 1, rk, rv, tid);
        __syncthreads();
        if (cb + 1 < ncb) nsa_prefetch(rk, rv, kcb, 64, vcb, 256, (cb + 1) * 64, tid);
        if (16 * (cb * 64 + 63) + 31 + 128 <= t0) nsa_tile<1>(O, L, qf, lds, cb & 1, cb * 64, true, true, lane);
        else nsa_tile<0>(O, L, qf, lds, cb & 1, cb * 64, true, true, lane);
    }
    float mfin[2], linv[2];
#pragma unroll
    for (int qi = 0; qi < 2; ++qi) { mfin[qi] = L.m[qi]; const float lt = quad16_sum(L.l[qi]); linv[qi] = (lt > 0.f) ? __builtin_amdgcn_rcpf(lt) : 0.f; }
    { const float gg[2] = {gates[0][0], gates[1][0]}; nsa_flush(Y, O, L, gg); }
    __syncthreads();
    if (ncb > 0) nsa_prefetch(rk, rv, kcb, 64, vcb, 256, 0, tid);
    for (int cb = 0; cb < ncb; ++cb) {
        nsa_store(lds, cb & 1, rk, rv, tid);
        __syncthreads();
        if (cb + 1 < ncb) nsa_prefetch(rk, rv, kcb, 64, vcb, 256, (cb + 1) * 64, tid);
        const bf16_t* sK = (const bf16_t*)(lds + NSA_K0) + (cb & 1) * 64 * TS;
        f32x4 s[2][4];
        nsa_qk(s, sK, qf, lane);
#pragma unroll
        for (int qi = 0; qi < 2; ++qi) {
            float x[4][4];
            nsa_logits<0>(x, s[qi], L.tq[qi], L.h, L.cbias, true, cb * 64, qd, biasT);
            const float mu = (mfin[qi] == -INFINITY) ? 0.f : mfin[qi];
#pragma unroll
            for (int kt = 0; kt < 4; ++kt) {
                float p3 = __expf(x[kt][3] - mu) * linv[qi];
                float pa = (__expf(x[kt][0] - mu) + __expf(x[kt][1] - mu) + __expf(x[kt][2] - mu)) * linv[qi] + p3;
                pa += __shfl_xor(pa, 1); p3 += __shfl_xor(p3, 1);
                pa += __shfl_xor(pa, 2); p3 += __shfl_xor(p3, 2);
                if (L.h == 0) { const int tl = 8 * wave + 4 * qi + ((lane & 15) >> 2), mi = 16 * cb + 4 * kt + qd; impA[tl * 64 + mi] = pa; impB[tl * 64 + mi] = p3; }
            }
        }
    }
    __syncthreads();
    for (int tl8 = 0; tl8 < 8; ++tl8) {
        const int tl = 8 * wave + tl8, n = lane;
        const bool cand = (n >= 1) && (n <= cur - 2);
        const float imp = cand ? impA[tl * 64 + n] + impB[tl * 64 + n - 1] : -1.0f;
        LDS_WAVE_SYNC();
        scr[n] = imp;
        LDS_WAVE_SYNC();
        int rank = 0;
#pragma unroll 4
        for (int q4 = 0; q4 < 16; ++q4) {
            const f32x4 o = *(const f32x4*)(scr + q4 * 4);
#pragma unroll
            for (int j = 0; j < 4; ++j) { const int n2 = q4 * 4 + j; rank += (o[j] > imp || (o[j] == imp && n2 < n)) ? 1 : 0; }
        }
        const bool forced = (n <= cur) && (n == 0 || n == cur || n == cur - 1);
        const unsigned long long msk = __ballot((cand && rank < 5) || forced);
        if (lane == 0) selm[tl] = msk;
    }
    __syncthreads();
    unsigned long long uni = selm[lane];
#pragma unroll
    for (int o = 32; o >= 1; o >>= 1) { const unsigned lo_ = __shfl_xor((unsigned)uni, o), hi_ = __shfl_xor((unsigned)(uni >> 32), o); uni |= ((unsigned long long)hi_ << 32) | lo_; }
    uni = ((unsigned long long)__builtin_amdgcn_readfirstlane((unsigned)(uni >> 32)) << 32) | (unsigned)__builtin_amdgcn_readfirstlane((unsigned)uni);
    unsigned long long sm[2];
#pragma unroll
    for (int qi = 0; qi < 2; ++qi) sm[qi] = selm[8 * wave + 4 * qi + ((lane & 15) >> 2)];
    const bf16_t* ksb = pbat + C_KS + g * 64; const bf16_t* vsb = c.VT + ((size_t)0 * 16 + bg) * 64 * SEQ;
    L.m[0] = L.m[1] = -INFINITY; L.l[0] = L.l[1] = 0.f;
    {
        unsigned long long rem = uni; int it = 0;
        int j = (int)__builtin_ctzll(rem); rem &= rem - 1;
        nsa_prefetch(rk, rv, ksb, IN_COLS, vsb, SEQ, j * 64, tid);
        for (;;) {
            nsa_store(lds, it & 1, rk, rv, tid);
            __syncthreads();
            const int jn = rem ? (int)__builtin_ctzll(rem) : -1;
            if (jn >= 0) { rem &= rem - 1; nsa_prefetch(rk, rv, ksb, IN_COLS, vsb, SEQ, jn * 64, tid); }
            const bool s0 = (sm[0] >> j) & 1ull, s1 = (sm[1] >> j) & 1ull;
            if (j <= cur - 3) nsa_tile_sel<1>(O, L, qf, lds, it & 1, j * 64, s0, s1, lane);
            else nsa_tile_sel<2>(O, L, qf, lds, it & 1, j * 64, s0, s1, lane);
            if (jn < 0) break;
            j = jn; ++it;
        }
    }
    { const float gg[2] = {gates[0][1], gates[1][1]}; nsa_flush(Y, O, L, gg); }
    const bf16_t* kwb = pbat + C_KW + g * 64; const bf16_t* vwb = c.VT + ((size_t)1 * 16 + bg) * 64 * SEQ;
    L.m[0] = L.m[1] = -INFINITY; L.l[0] = L.l[1] = 0.f;
    {
        const int j0 = (cur - 8 > 0) ? cur - 8 : 0;
        __syncthreads();
        nsa_prefetch(rk, rv, kwb, IN_COLS, vwb, SEQ, j0 * 64, tid);
        for (int j = j0; j <= cur; ++j) {
            nsa_store(lds, (j - j0) & 1, rk, rv, tid);
            __syncthreads();
            if (j + 1 <= cur) nsa_prefetch(rk, rv, kwb, IN_COLS, vwb, SEQ, (j + 1) * 64, tid);
            if (cur - j >= 3 && cur - j <= 7) nsa_tile<1>(O, L, qf, lds, (j - j0) & 1, j * 64, true, true, lane);
            else nsa_tile<3>(O, L, qf, lds, (j - j0) & 1, j * 64, true, true, lane);
        }
    }
    { const float gg[2] = {gates[0][2], gates[1][2]}; nsa_flush(Y, O, L, gg); }
#pragma unroll
    for (int qi = 0; qi < 2; ++qi) {
        bf16_t* yrow = c.PROJ + ((size_t)b * SEQ + L.tq[qi]) * IN_COLS + C_Q + (g * 4 + L.h) * 64;
#pragma unroll
        for (int dt = 0; dt < 4; ++dt) store_bf4(yrow + 16 * dt + 4 * qd, Y[qi][dt]);
    }
}
DI void phase_mix(const Ctx& c, unsigned char* lds) {
    const int G = gridDim.x, bid = blockIdx.x;
    const int n_nsa = NB * 4 * (SEQ / 64), n_scan = NB * 8 * 4;
    const bool split = G >= 2 * n_scan;
    if (split) { if (bid < n_scan) scan_item(c, bid, lds); }
    else for (int item = bid; item < n_scan; item += G) scan_item(c, item, lds);
    unsigned* ctr = c.ctl + CW_Q + c.l;
    volatile int* sitem = (volatile int*)(lds + LDS_BYTES - 32);
    for (;;) {
        __syncthreads();
        if (TID() == 0) *sitem = (int)atomicAdd(ctr, 1u);
        __syncthreads();
        const int k = *sitem;
        if (k >= n_nsa) break;
        const int qt = 63 - (k >> 4), bgi = k & 15;
        nsa_item(c, (bgi << 6) | qt, lds);
    }
}

DI void phase_merge(const Ctx& c, unsigned char* lds) {
    const int nM = NT / 256, nN = DM / 128;
    const bf16_t* WM = (const bf16_t*)(c.ws + WS_WT_MG);
    const bf16_t* BR = (const bf16_t*)(c.ws + WS_WT_BR);
    const float* BM_ = c.in(I_BMG) + (size_t)c.l * 3 * DM;
    bf16_t* TMP = c.YRAW + (size_t)blockIdx.x * 256 * 128;
    for (int it = 0;; ++it) {
        int tm, tn; if (!xcd_unit(it, nN, tm, tn)) break;
        const int m0 = tm * 256, n0 = tn * 128;
#pragma unroll 1
        for (int i = 0; i < 3; ++i) {
            {
                f32x4 ag[4][4]; acc_zero(ag);
                gemm_core_dma(ag, c.H + (size_t)m0 * DM, DM, WM + (size_t)(i * DM + n0) * DM, DM, DM, lds);
                ACC_FOREACH(ag, { const f32x4 bb = *(const f32x4*)(BM_ + i * DM + n0 + c_);
                    store_bf4(TMP + r_ * 128 + c_, (f32x4){sigmoidf_(v_[0] + bb[0]), sigmoidf_(v_[1] + bb[1]), sigmoidf_(v_[2] + bb[2]), sigmoidf_(v_[3] + bb[3])}); });
            }
            f32x4 ab[4][4]; acc_zero(ab);
            if (i == 0) gemm_core_dma(ab, c.POOLED + (size_t)m0 * 512, 512, BR + (size_t)n0 * 512, 512, 512, lds);
            else if (i == 1) gemm_core_dma(ab, c.F + (size_t)5 * NT * 512 + (size_t)m0 * 512, 512, BR + (size_t)1024 * 512 + (size_t)n0 * 512, 512, 512, lds);
            else gemm_core_dma(ab, c.PROJ + C_Q + (size_t)m0 * IN_COLS, IN_COLS, BR + (size_t)2048 * 512 + (size_t)n0 * 1024, 1024, 1024, lds);
            ACC_FOREACH(ab, {
                bf16_t* q = c.MERGED + (size_t)(m0 + r_) * DM + n0 + c_;
                const u32x2 gv = *(const u32x2*)(TMP + r_ * 128 + c_);
                f32x4 m4 = ((f32x4){0.f, 0.f, 0.f, 0.f});
                if (i > 0) { const u32x2 pv = *(const u32x2*)q; m4 = ((f32x4){bflo(pv.x), bfhi(pv.x), bflo(pv.y), bfhi(pv.y)}); }
                m4[0] += bflo(gv.x) * v_[0]; m4[1] += bfhi(gv.x) * v_[1]; m4[2] += bflo(gv.y) * v_[2]; m4[3] += bfhi(gv.y) * v_[3];
                store_bf4(q, m4); });
        }
    }
}

DI void phase_outp(const Ctx& c, unsigned char* lds) {
    const int nN = DM / 256;
    const bf16_t* W = (const bf16_t*)(c.ws + WS_WT_OUT);
    const float* xin = (c.l == 0) ? c.in(I_X) : c.out;
    for (int it = 0;; ++it) {
        int tm, tn; if (!xcd_unit(it, nN, tm, tn)) break;
        const int m0 = tm * 256, n0 = tn * 256;
        f32x4 acc[8][4];
#pragma unroll
        for (int i = 0; i < 8; ++i)
#pragma unroll
            for (int j = 0; j < 4; ++j) acc[i][j] = (f32x4){0.f, 0.f, 0.f, 0.f};
        gemm256_dma(acc, c.MERGED + (size_t)m0 * DM, DM, W + (size_t)n0 * DM, DM, DM, lds);
        const int lane = TID() & 63, wave = TID() >> 6, wm = wave >> 2, wn = wave & 3;
#pragma unroll
        for (int mi = 0; mi < 8; ++mi)
#pragma unroll
            for (int ni = 0; ni < 4; ++ni) {
                const size_t o = (size_t)(m0 + wm * 128 + mi * 16 + (lane & 15)) * DM + n0 + wn * 64 + ni * 16 + (lane >> 4) * 4;
                const f32x4 x = *(const f32x4*)(xin + o); *(f32x4*)(c.out + o) = x + acc[mi][ni];
            }
    }
    for (int it = blockIdx.x * 4; it < 3 * 32 * 64; it += gridDim.x * 4) {
        const int mat = it / 2048, e = (it >> 6) & 31, tl = it & 63;
        if (mat == 0) convert_tile4(c.in(I_EG) + ((size_t)c.l * 32 + e) * DM * 256, 256, 256, DM, (bf16_t*)(c.ws + WS_EG) + (size_t)e * 256 * DM, tl, lds);
        else if (mat == 1) convert_tile4(c.in(I_EU) + ((size_t)c.l * 32 + e) * DM * 256, 256, 256, DM, (bf16_t*)(c.ws + WS_EU) + (size_t)e * 256 * DM, tl, lds);
        else convert_tile4(c.in(I_ED) + ((size_t)c.l * 32 + e) * 256 * DM, DM, DM, 256, (bf16_t*)(c.ws + WS_ED) + (size_t)e * DM * 256, tl, lds);
    }
}

DI void phase_norm2(const Ctx& c, unsigned char* lds) {
    const int tid = TID(), lane = tid & 63, wave = tid >> 6;
    const float* gain = c.in(I_NFFN) + c.l * DM;
    const float* wrg = c.in(I_WRG) + (size_t)c.l * DM * 4; const float* brg = c.in(I_BRG) + c.l * 4;
    const float* wre = c.in(I_WRE) + (size_t)c.l * DM * 32; const float* bre = c.in(I_BRE) + c.l * 32;
    unsigned* cnt = c.ctl + CW_CNT + c.l * 32;
    float* lg = (float*)lds + wave * 16 * 48;
    if (wave < 4)
    for (int rt = blockIdx.x * 4 + wave; rt < NT / 16; rt += gridDim.x * 4) {
        const int r0 = rt * 16;
        float my_rs = 0.f;
#pragma unroll 2
        for (int rr = 0; rr < 16; ++rr) {
            const size_t ro = (size_t)(r0 + rr) * DM;
            f32x4 v[4]; float ss = 0.f;
#pragma unroll
            for (int i = 0; i < 4; ++i) { v[i] = *(const f32x4*)(c.out + ro + i * 256 + lane * 4); ss += v[i][0] * v[i][0] + v[i][1] * v[i][1] + v[i][2] * v[i][2] + v[i][3] * v[i][3]; }
            ss = wave_sum_dpp(ss);
            const float rs = rsqrtf(ss * (1.0f / DM) + 1e-6f);
            if ((lane & 15) == rr) my_rs = rs;
#pragma unroll
            for (int i = 0; i < 4; ++i) {
                const f32x4 g = *(const f32x4*)(gain + i * 256 + lane * 4);
                store_bf4(c.H + ro + i * 256 + lane * 4, (f32x4){v[i][0] * rs * g[0], v[i][1] * rs * g[1], v[i][2] * rs * g[2], v[i][3] * rs * g[3]});
            }
        }
        f32x4 acc0 = (f32x4){0.f, 0.f, 0.f, 0.f}, acc1 = acc0, acc2 = acc0;
        const float* xr = c.out + (size_t)(r0 + (lane & 15)) * DM + 4 * (lane >> 4);
        const int cl = lane & 15;
#pragma unroll 2
        for (int kb = 0; kb < 64; ++kb) {
            const f32x4 xa = *(const f32x4*)(xr + kb * 16);
            const f32x4 ga = *(const f32x4*)(gain + kb * 16 + 4 * (lane >> 4));
            const int k0 = kb * 16 + 4 * (lane >> 4);
            float b0[4], b1[4], b2[4];
#pragma unroll
            for (int m = 0; m < 4; ++m) { b0[m] = wre[(size_t)(k0 + m) * 32 + cl]; b1[m] = wre[(size_t)(k0 + m) * 32 + 16 + cl]; b2[m] = (cl < 4) ? wrg[(size_t)(k0 + m) * 4 + cl] : 0.f; }
#pragma unroll
            for (int m = 0; m < 4; ++m) {
                const float am = xa[m] * ga[m] * my_rs;
                acc0 = __builtin_amdgcn_mfma_f32_16x16x4f32(am, b0[m], acc0, 0, 0, 0);
                acc1 = __builtin_amdgcn_mfma_f32_16x16x4f32(am, b1[m], acc1, 0, 0, 0);
                acc2 = __builtin_amdgcn_mfma_f32_16x16x4f32(am, b2[m], acc2, 0, 0, 0);
            }
        }
        LDS_WAVE_SYNC();
#pragma unroll
        for (int i = 0; i < 4; ++i) { const int row = 4 * (lane >> 4) + i; lg[row * 48 + cl] = acc0[i]; lg[row * 48 + 16 + cl] = acc1[i]; lg[row * 48 + 32 + cl] = acc2[i]; }
        LDS_WAVE_SYNC();
        if (lane < 16) {
            const float* L = lg + lane * 48;
            float lgp[4];
#pragma unroll
            for (int o = 0; o < 4; ++o) lgp[o] = L[32 + o] + brg[o];
            int grp = 0; float gm = lgp[0];
#pragma unroll
            for (int o = 1; o < 4; ++o) if (lgp[o] > gm) { gm = lgp[o]; grp = o; }
            float gs = 0.f;
#pragma unroll
            for (int o = 0; o < 4; ++o) gs += __expf(lgp[o] - gm);
            const float ptop = 1.0f / gs;
            int i0 = 0; float v0 = -INFINITY; int i1 = 0; float v1 = -INFINITY;
            for (int o = 0; o < 8; ++o) { const float le = L[grp * 8 + o] + bre[grp * 8 + o]; if (le > v0) { v1 = v0; i1 = i0; v0 = le; i0 = o; } else if (le > v1) { v1 = le; i1 = o; } }
            const float e1 = __expf(v1 - v0), inv = 1.0f / (1.0f + e1);
            int* rt_ = c.ROUTE + (size_t)(r0 + lane) * 8;
            const int ex0 = grp * 8 + i0, ex1 = grp * 8 + i1;
            rt_[0] = ex0; rt_[1] = ex1; ((float*)rt_)[2] = inv * ptop; ((float*)rt_)[3] = e1 * inv * ptop;
            atomicAdd(cnt + ex0, 1u); atomicAdd(cnt + ex1, 1u);
        }
    }
}
DI void phase_route2(const Ctx& c, unsigned char* lds) {
    int* soff = (int*)lds;
    const unsigned* cnt = c.ctl + CW_CNT + c.l * 32;
    unsigned* cur = c.ctl + CW_CUR + c.l * 32;
    __syncthreads();
    if (TID() == 0) { int s = 0; for (int e = 0; e < 32; ++e) { soff[e] = s; s += (int)cnt[e]; } }
    __syncthreads();
    for (int t = blockIdx.x * NTHREADS + TID(); t < NT; t += gridDim.x * NTHREADS) {
        int* rt = c.ROUTE + (size_t)t * 8;
#pragma unroll
        for (int s = 0; s < 2; ++s) {
            const int e = rt[s];
            const int p = soff[e] + (int)atomicAdd(cur + e, 1u);
            rt[4 + s] = p;
            c.ENT[2 * p] = t; ((float*)c.ENT)[2 * p + 1] = ((const float*)rt)[2 + s];
        }
    }
}
DI void moe_tables(const Ctx& c, int* soff, int* stile, int ncol) {
    const unsigned* cnt = c.ctl + CW_CNT + c.l * 32;
    __syncthreads();
    if (TID() == 0) { int s = 0, tt = 0; for (int e = 0; e < 32; ++e) { soff[e] = s; stile[e] = tt; s += (int)cnt[e]; tt += (((int)cnt[e] + 255) >> 8) * ncol; } soff[32] = s; stile[32] = tt; }
    __syncthreads();
}
DI void phase_moe_up(const Ctx& c, unsigned char* lds) {
    int* soff = (int*)(lds + 2 * G_STAGE); int* stile = soff + 64;
    moe_tables(c, soff, stile, 2);
    const int total = stile[32];
    for (int item = blockIdx.x; item < total; item += gridDim.x) {
        int e = 0;
        for (int q = 1; q < 32; ++q) if (stile[q] <= item) e = q;
        const int loc = item - stile[e], tm = loc >> 1, tn = loc & 1, n0 = tn * 128;
        const int p0 = soff[e] + tm * 256, pend = soff[e + 1];
        ARows ar; ar.mu = nullptr; ar.ltype = 0; ar.first = 0;
#pragma unroll
        for (int i = 0; i < 4; ++i) { const int pr = p0 + (TID() >> 3) + 64 * i; ar.p[i] = (pr < pend) ? c.H + (size_t)c.ENT[2 * pr] * DM : nullptr; }
        {
            f32x4 ag[4][4]; acc_zero(ag);
            gemm_core<0>(ag, ar, (const bf16_t*)(c.ws + WS_EG) + ((size_t)e * 256 + n0) * DM, DM, DM, lds);
            ACC_FOREACH(ag, { if (p0 + r_ < pend) store_bf4(c.HID + (size_t)(p0 + r_) * 256 + n0 + c_, (f32x4){v_[0] * sigmoidf_(v_[0]), v_[1] * sigmoidf_(v_[1]), v_[2] * sigmoidf_(v_[2]), v_[3] * sigmoidf_(v_[3])}); });
        }
        f32x4 au[4][4]; acc_zero(au);
        gemm_core<0>(au, ar, (const bf16_t*)(c.ws + WS_EU) + ((size_t)e * 256 + n0) * DM, DM, DM, lds);
        ACC_FOREACH(au, { if (p0 + r_ < pend) { bf16_t* q = c.HID + (size_t)(p0 + r_) * 256 + n0 + c_; const u32x2 sv = *(const u32x2*)q;
            store_bf4(q, (f32x4){bflo(sv.x) * v_[0], bfhi(sv.x) * v_[1], bflo(sv.y) * v_[2], bfhi(sv.y) * v_[3]}); } });
    }
}
DI void phase_moe_down(const Ctx& c, unsigned char* lds) {
    int* soff = (int*)(lds + 2 * G_STAGE); int* stile = soff + 64;
    moe_tables(c, soff, stile, 8);
    const int total = stile[32];
    for (int item = blockIdx.x; item < total; item += gridDim.x) {
        int e = 0;
        for (int q = 1; q < 32; ++q) if (stile[q] <= item) e = q;
        const int loc = item - stile[e], tm = loc >> 3, tn = loc & 7, n0 = tn * 128;
        const int p0 = soff[e] + tm * 256, pend = soff[e + 1];
        ARows ar; ar.mu = nullptr; ar.ltype = 0; ar.first = 0;
#pragma unroll
        for (int i = 0; i < 4; ++i) { const int pr = p0 + (TID() >> 3) + 64 * i; ar.p[i] = (pr < pend) ? c.HID + (size_t)pr * 256 : nullptr; }
        f32x4 acc[4][4]; acc_zero(acc);
        gemm_core<0>(acc, ar, (const bf16_t*)(c.ws + WS_ED) + ((size_t)e * DM + n0) * 256, 256, 256, lds);
        ACC_FOREACH(acc, { if (p0 + r_ < pend) { const float w = ((const float*)c.ENT)[2 * (p0 + r_) + 1];
            store_bf4(c.Y + (size_t)(p0 + r_) * DM + n0 + c_, (f32x4){v_[0] * w, v_[1] * w, v_[2] * w, v_[3] * w}); } });
    }
}
DI void phase_final(const Ctx& c) {
    const int tid = TID(), lane = tid & 63, wave = tid >> 6;
    const float* gain = c.in(I_NFIN);
    for (int row = blockIdx.x * 8 + wave; row < NT; row += gridDim.x * 8) {
        f32x4 v[4];
#pragma unroll
        for (int i = 0; i < 4; ++i) v[i] = *(const f32x4*)(c.out + (size_t)row * DM + i * 256 + lane * 4);
        add_moe_rows(c, row, lane, v);
        float ss = 0.f;
#pragma unroll
        for (int i = 0; i < 4; ++i) ss += v[i][0] * v[i][0] + v[i][1] * v[i][1] + v[i][2] * v[i][2] + v[i][3] * v[i][3];
        ss = wave_sum_dpp(ss);
        const float rs = rsqrtf(ss * (1.0f / DM) + 1e-6f);
#pragma unroll
        for (int i = 0; i < 4; ++i) {
            const f32x4 g = *(const f32x4*)(gain + i * 256 + lane * 4);
            *(f32x4*)(c.out + (size_t)row * DM + i * 256 + lane * 4) = (f32x4){v[i][0] * rs * g[0], v[i][1] * rs * g[1], v[i][2] * rs * g[2], v[i][3] * rs * g[3]};
        }
    }
}

constexpr int PH_PER_LAYER = 12, N_PHASES = DEPTH * PH_PER_LAYER + 1;
__global__ void __launch_bounds__(NTHREADS, 2) fwd_kernel(Params P) {
    extern __shared__ __attribute__((aligned(16))) unsigned char lds[];
    const int lo = P.ph_lo, hi = P.ph_hi;
    LAS unsigned* xbw = (LAS unsigned*)(lds + LDS_BYTES - 16);
    if (threadIdx.x == 0) { xbw[0] = 0u; xbw[1] = 0u; xbw[2] = 0u; xbw[3] = 0u; }
    __syncthreads();
    Ctx c; c.P = &P; c.ws = P.ws; c.out = P.out; c.l = 0;
    c.ctl = (unsigned*)(P.ws + WS_CTL);
    c.H = (bf16_t*)(P.ws + WS_H); c.PROJ = (bf16_t*)(P.ws + WS_PROJ); c.F = (bf16_t*)(P.ws + WS_F); c.POOLED = (bf16_t*)(P.ws + WS_POOLED);
    c.MERGED = (bf16_t*)(P.ws + WS_F); c.CMPH = (bf16_t*)(P.ws + WS_CMPH); c.CMPO = (float*)(P.ws + WS_CMPO); c.POSB = (float*)(P.ws + WS_POSB);
    c.ROUTE = (int*)(P.ws + WS_ROUTE); c.ENT = (int*)(P.ws + WS_ENT); c.HID = (bf16_t*)(P.ws + WS_HID); c.Y = (bf16_t*)(P.ws + WS_Y);
    c.VT = (bf16_t*)(P.ws + WS_VT); c.KC = (bf16_t*)(P.ws + WS_KC); c.VCT = (bf16_t*)(P.ws + WS_VCT); c.YRAW = (bf16_t*)(P.ws + WS_YRAW); c.BON = (float*)(P.ws + WS_BON);
    XcdBarrier bar; bar.bar = c.ctl + CW_BAR; bar.x = 0; bar.st = (volatile LAS unsigned*)xbw;
    if (hi - lo > 1) bar = xcd_barrier_post(c.ctl + CW_BAR, (volatile LAS unsigned*)xbw);
#define IN(k) (lo <= (k) && (k) < hi)
#define SEAM(k) do { if (IN(k) && IN((k) + 1)) xcd_barrier(bar); } while (0)
#pragma unroll 1
    for (int l = 0; l < DEPTH; ++l) {
        c.l = l; const int pb = l * PH_PER_LAYER;
        if (IN(pb + 0)) phase_norm1(c, lds);
        SEAM(pb + 0);
        if (IN(pb + 1)) phase_gemm1(c, lds);
        SEAM(pb + 1);
        if (IN(pb + 2)) phase_prep(c, lds);
        SEAM(pb + 2);
        if (IN(pb + 3)) phase_poolgemm(c, lds);
        SEAM(pb + 3);
        if (IN(pb + 4)) phase_mix(c, lds);
        SEAM(pb + 4);
        if (IN(pb + 5)) phase_rwkv_post(c, lds);
        SEAM(pb + 5);
        if (IN(pb + 6)) phase_merge(c, lds);
        SEAM(pb + 6);
        if (IN(pb + 7)) phase_outp(c, lds);
        SEAM(pb + 7);
        if (IN(pb + 8)) phase_norm2(c, lds);
        SEAM(pb + 8);
        if (IN(pb + 9)) phase_route2(c, lds);
        SEAM(pb + 9);
        if (IN(pb + 10)) phase_moe_up(c, lds);
        SEAM(pb + 10);
        if (IN(pb + 11)) phase_moe_down(c, lds);
        SEAM(pb + 11);
    }
    if (IN(N_PHASES - 1)) phase_final(c);
}

#ifndef MK_N_LAUNCHES
#define MK_N_LAUNCHES 1
#endif
extern "C" void kernel_launch(void* const* d_in, const int* in_sizes, int n_in, void* d_out, int out_size, void* d_ws, size_t ws_size, hipStream_t stream) {
    static int grid = 0;
    if (grid == 0) {
        if (n_in != N_IN || out_size != NT * DM || ws_size < WS_END) { fprintf(stderr, "kernel_launch: unexpected shapes n_in %d out %d ws %zu (need %zu)\n", n_in, out_size, ws_size, (size_t)WS_END); grid = -1; return; }
        int dev = 0, cus = 0, per_cu = 0;
        if (hipGetDevice(&dev) != hipSuccess || hipDeviceGetAttribute(&cus, hipDeviceAttributeMultiprocessorCount, dev) != hipSuccess) { grid = -1; return; }
        if (hipFuncSetAttribute((const void*)fwd_kernel, hipFuncAttributeMaxDynamicSharedMemorySize, LDS_BYTES) != hipSuccess) { fprintf(stderr, "kernel_launch: hipFuncSetAttribute failed\n"); grid = -1; return; }
        if (hipOccupancyMaxActiveBlocksPerMultiprocessor(&per_cu, (const void*)fwd_kernel, NTHREADS, LDS_BYTES) != hipSuccess || per_cu < 1) { fprintf(stderr, "kernel_launch: occupancy query says %d\n", per_cu); }
        (void)hipGetLastError();
        grid = cus;
    }
    if (grid < 0) return;
    if (hipMemsetAsync((char*)d_ws + WS_CTL, 0, CTL_BYTES, stream) != hipSuccess) return;
    Params p{};
    for (int i = 0; i < N_IN; ++i) p.in[i] = (const float*)d_in[i];
    p.out = (float*)d_out; p.ws = (unsigned char*)d_ws;
    if (MK_N_LAUNCHES == 1) {
        p.ph_lo = 0; p.ph_hi = N_PHASES;
        hipLaunchKernelGGL(fwd_kernel, dim3(grid), dim3(NTHREADS), LDS_BYTES, stream, p);
    } else {
        for (int k = 0; k < N_PHASES; ++k) { p.ph_lo = k; p.ph_hi = k + 1; hipLaunchKernelGGL(fwd_kernel, dim3(grid), dim3(NTHREADS), LDS_BYTES, stream, p); }
    }
}
```

```cpp
#include <hip/hip_runtime.h>
#include <cstdio>
#include <cstdint>

#define DI __device__ __forceinline__
typedef unsigned short bf16_t;
typedef short bf16x8 __attribute__((ext_vector_type(8)));
typedef float f32x4 __attribute__((ext_vector_type(4)));
typedef unsigned u32x4 __attribute__((ext_vector_type(4)));
typedef unsigned u32x2 __attribute__((ext_vector_type(2)));

constexpr int NB = 4, SEQ = 4096, DM = 1024, NT = NB * SEQ, DEPTH = 2;
constexpr int IN_COLS = 4816;
constexpr int C_POOL = 0, C_RW = 512, C_R = 512, C_K = 1024, C_V = 1536, C_WD = 2048, C_AD = 2080, C_GD = 2112;
constexpr int C_Q = 2208, C_KC = 3232, C_VC = 3488, C_KS = 3744, C_VS = 4000, C_KW = 4256, C_VW = 4512, C_GATE = 4768;
constexpr int RWC = 1696;
constexpr int NCMP = 255;
constexpr int NTHREADS = 512;
constexpr int LDS_BYTES = 155648;

enum { I_X = 0, I_RELB, I_NMIX, I_WIN, I_POOLW, I_POOLS, I_MU, I_W0, I_WUP, I_A0, I_AUP, I_GUP, I_KK, I_KA, I_RK, I_GNW, I_GNB,
       I_CPK, I_CW1K, I_CW2K, I_CPV, I_CW1V, I_CW2V, I_WBR, I_WMG, I_BMG, I_WOUT, I_NFFN, I_WRG, I_BRG, I_WRE, I_BRE, I_EG, I_EU, I_ED, I_NFIN, N_IN };

constexpr size_t WS_CTL = 0;
constexpr size_t CTL_BYTES = 65536;
constexpr size_t WS_H = CTL_BYTES;
constexpr size_t WS_PROJ = WS_H + (size_t)NT * DM * 2;
constexpr size_t WS_F = WS_PROJ + (size_t)NT * IN_COLS * 2;
constexpr size_t PLANE = (size_t)NT * 512 * 2;
constexpr size_t WS_POOLED = WS_F + 6 * PLANE;
constexpr size_t WS_CMPH = WS_POOLED + PLANE;
constexpr size_t WS_CMPO = WS_CMPH + (size_t)2 * 4096 * 256 * 2;
constexpr size_t WS_POSB = WS_CMPO + (size_t)2 * 4096 * 64 * 4;
constexpr size_t WS_ROUTE = WS_POSB + 4096;
constexpr size_t WS_ENT = WS_ROUTE + (size_t)NT * 32;
constexpr size_t WS_VT = WS_ENT + (size_t)32 * NT * 8;
constexpr size_t WS_KC = WS_VT + (size_t)2 * 16 * 64 * SEQ * 2;
constexpr size_t WS_VCT = WS_KC + (size_t)16 * 256 * 64 * 2;
constexpr size_t WS_YRAW = WS_VCT + (size_t)16 * 64 * 256 * 2;
constexpr size_t WS_BON = WS_YRAW + (size_t)NT * 512 * 2;
constexpr size_t WS_SMALLW = WS_BON + (size_t)NT * 8 * 16;
constexpr size_t WS_WT_LORA = WS_SMALLW + 262144;
constexpr size_t WS_END = WS_WT_LORA + (size_t)1536 * 128 * 2;
constexpr size_t WS_WT_IN = WS_F;
constexpr size_t WS_WT_C1 = WS_CMPO;
constexpr size_t WS_WT_C2 = WS_SMALLW;
constexpr size_t WS_WT_POOL = WS_SMALLW + 131072;
constexpr size_t WS_WT_MG = WS_VT;
constexpr size_t WS_WT_BR = WS_VT + (size_t)3072 * 1024 * 2;
constexpr size_t WS_WT_OUT = WS_CMPH;
constexpr size_t WS_EG = WS_F + 2 * PLANE;
constexpr size_t WS_EU = WS_EG + (size_t)32 * 256 * 1024 * 2;
constexpr size_t WS_ED = WS_EU + (size_t)32 * 256 * 1024 * 2;
static_assert(WS_ED + (size_t)32 * 1024 * 256 * 2 <= WS_F + 6 * PLANE, "expert alias");
static_assert(WS_WT_BR + (size_t)2048 * 1024 * 2 <= WS_VT + (size_t)2 * 16 * 64 * SEQ * 2, "merge alias");
static_assert((size_t)4864 * 1024 * 2 <= 6 * PLANE, "w_in alias");
constexpr size_t WS_HID = WS_PROJ;
constexpr size_t WS_Y = WS_PROJ + (size_t)2 * NT * 256 * 2;
static_assert(WS_Y + (size_t)2 * NT * 1024 * 2 <= WS_F, "alias");
constexpr int CW_BAR = 0;
constexpr int CW_CNT = 4096;
constexpr int CW_CUR = 4096 + 64;
constexpr int CW_Q = 4096 + 128;

#define XB_TMO      128
#define XB_XCNT(j)  (256  + 64 * (j))
#define XB_XSUB(j)  (1280 + 64 * (j))
#define XB_XGEN(j)  (2304 + 64 * (j))
#define XB_TOP      3328
#define XB_TOPGEN   3392
#define XCD_BAR_WORDS 3456
#define XB_SPIN_CAP (1u << 18)
#define LAS __attribute__((address_space(3)))

__device__ __forceinline__ unsigned xb_ld(unsigned* p)              { return __hip_atomic_load(p, __ATOMIC_RELAXED, __HIP_MEMORY_SCOPE_AGENT); }
__device__ __forceinline__ unsigned xb_add(unsigned* p, unsigned v) { return __hip_atomic_fetch_add(p, v, __ATOMIC_RELAXED, __HIP_MEMORY_SCOPE_AGENT); }
__device__ __forceinline__ unsigned xb_xcc_id() { return (unsigned)__builtin_amdgcn_s_getreg((3 << 11) | 20) & 0xFu; }
#define XB_SPIN(cond, bar) do { unsigned _sp = 0; while (cond) { __builtin_amdgcn_s_sleep(1); \
    if ((++_sp & 255u) == 0u) { if (xb_ld(&(bar)[XB_TMO])) break; if (_sp > XB_SPIN_CAP) { atomicAdd(&(bar)[XB_TMO], 1u); break; } } } } while (0)

struct XcdBarrier { unsigned* bar; unsigned x; volatile LAS unsigned* st; };

__device__ __forceinline__ XcdBarrier xcd_barrier_post(unsigned* bar, volatile LAS unsigned* st) {
    XcdBarrier b; b.bar = bar; b.x = xb_xcc_id(); b.st = st;
    if (threadIdx.x == 0) (void)xb_add(&bar[XB_XCNT(b.x)], 1u);
    return b;
}
__device__ __forceinline__ void xcd_barrier_complete(unsigned* bar, unsigned x, unsigned& nloc, unsigned& nx) {
    const unsigned G = gridDim.x * gridDim.y * gridDim.z;
    unsigned sum, cnt, mine, sp = 0u;
    for (;;) {
        sum = 0u; cnt = 0u; mine = 0u;
#pragma unroll
        for (unsigned j = 0; j < 16; ++j) { const unsigned c = xb_ld(&bar[XB_XCNT(j)]); sum += c; cnt += (c > 0u) ? 1u : 0u; mine = (j == x) ? c : mine; }
        if (sum == G) break;
        __builtin_amdgcn_s_sleep(1);
        if ((++sp & 255u) == 0u) { if (xb_ld(&bar[XB_TMO])) break; if (sp > XB_SPIN_CAP) { atomicAdd(&bar[XB_TMO], 1u); break; } }
    }
    nloc = mine > 0u ? mine : 1u; nx = cnt > 0u ? cnt : 1u;
}
__device__ __forceinline__ void xcd_barrier(const XcdBarrier& b) {
    asm volatile("s_waitcnt vmcnt(0)" ::: "memory");
    __syncthreads();
    if (threadIdx.x == 0) {
        unsigned* bar = b.bar;
        __builtin_amdgcn_s_waitcnt(0);
        unsigned nloc = b.st[0], nx = b.st[1];
        if (nloc == 0u) { xcd_barrier_complete(bar, b.x, nloc, nx); b.st[0] = nloc; b.st[1] = nx; }
        const unsigned old = xb_add(&bar[XB_XSUB(b.x)], 1u);
        const unsigned gen = old / nloc;
        if (old + 1u == (gen + 1u) * nloc) {
            __builtin_amdgcn_fence(__ATOMIC_RELEASE, "agent");
            asm volatile("s_waitcnt vmcnt(0)" ::: "memory");
            const unsigned og = xb_add(&bar[XB_TOP], 1u);
            const unsigned tg = og / nx;
            if (og + 1u == (tg + 1u) * nx) xb_add(&bar[XB_TOPGEN], 1u);
            else XB_SPIN(xb_ld(&bar[XB_TOPGEN]) == tg, bar);
            __builtin_amdgcn_fence(__ATOMIC_ACQUIRE, "agent");
            xb_add(&bar[XB_XGEN(b.x)], 1u);
            asm volatile("s_waitcnt vmcnt(0)" ::: "memory");
        } else {
            XB_SPIN(xb_ld(&bar[XB_XGEN(b.x)]) == gen, bar);
            __builtin_amdgcn_fence(__ATOMIC_ACQUIRE, "agent");
            asm volatile("s_waitcnt vmcnt(0)" ::: "memory");
        }
    }
    __syncthreads();
}

DI bf16_t f2bf(float x) { unsigned u = __float_as_uint(x); u += 0x7fffu + ((u >> 16) & 1u); return (bf16_t)(u >> 16); }
DI float bf2f(bf16_t b) { return __uint_as_float((unsigned)b << 16); }
typedef __bf16 bf16v2_t __attribute__((ext_vector_type(2)));
typedef float f32v2_t __attribute__((ext_vector_type(2)));
DI unsigned pack2(float lo, float hi) { const f32v2_t v = {lo, hi}; const bf16v2_t b = __builtin_convertvector(v, bf16v2_t); return __builtin_bit_cast(unsigned, b); }
DI float bflo(unsigned w) { return __uint_as_float(w << 16); }
DI float bfhi(unsigned w) { return __uint_as_float(w & 0xffff0000u); }
DI float wave_sum(float v) {
#pragma unroll
    for (int o = 32; o >= 1; o >>= 1) v += __shfl_xor(v, o);
    return v;
}
DI float wave_max(float v) {
#pragma unroll
    for (int o = 32; o >= 1; o >>= 1) v = fmaxf(v, __shfl_xor(v, o));
    return v;
}
DI float sigmoidf_(float x) { return __builtin_amdgcn_rcpf(1.0f + __expf(-x)); }
DI int TID() { int t = threadIdx.x; asm volatile("" : "+v"(t)); return t; }
#define LDS_WAVE_SYNC() asm volatile("s_waitcnt lgkmcnt(0)" ::: "memory")

#define DPP_MOV(v, ctrl) __builtin_bit_cast(float, __builtin_amdgcn_update_dpp(0, __builtin_bit_cast(int, (v)), (ctrl), 0xF, 0xF, true))
DI float wave_sum_dpp(float v) {
    v += DPP_MOV(v, 0xB1); v += DPP_MOV(v, 0x4E); v += DPP_MOV(v, 0x141); v += DPP_MOV(v, 0x140);
    return __builtin_bit_cast(float, __builtin_amdgcn_readlane(__builtin_bit_cast(int, v), 0)) + __builtin_bit_cast(float, __builtin_amdgcn_readlane(__builtin_bit_cast(int, v), 16)) +
        (__builtin_bit_cast(float, __builtin_amdgcn_readlane(__builtin_bit_cast(int, v), 32)) + __builtin_bit_cast(float, __builtin_amdgcn_readlane(__builtin_bit_cast(int, v), 48)));
}
struct Params { const float* in[N_IN]; float* out; unsigned char* ws; int ph_lo, ph_hi; };

DI int t5_bucket(int n) {
    if (n < 16) return n;
    if (n >= 128) return 31;
    int b = 16;
    b += (n >= 19) + (n >= 21) + (n >= 24) + (n >= 27) + (n >= 31) + (n >= 35) + (n >= 40) + (n >= 46) + (n >= 52) + (n >= 59) + (n >= 67) + (n >= 77) + (n >= 87) + (n >= 99) + (n >= 113);
    return b;
}

constexpr int G_A = 0, G_B = 256 * 64 * 2, G_STAGE = (256 + 128) * 64 * 2;
static_assert(2 * G_STAGE <= LDS_BYTES - 64, "gemm lds");
DI int g_off(int r, int c) { return ((r >> 4) * 2 + (c >> 5)) * 1024 + ((((r & 15) * 64) + (c & 31) * 2) ^ ((((r & 15) >> 3) & 1) << 5)); }
struct ARows { const bf16_t* p[4]; const float* mu; int ltype; int first; };
DI float tanhf_fast(float x) { const float e = __expf(2.0f * x); return 1.0f - 2.0f * __builtin_amdgcn_rcpf(e + 1.0f); }
DI u32x4 lora_chunk(const bf16_t* prow, bool first, const float* mu, int ltype, int k) {
    const int lim = (ltype == 2) ? 96 : 32;
    if (k >= lim) return (u32x4){0u, 0u, 0u, 0u};
    const int col = C_WD + ltype * 32 + k;
    const u32x4 cu = *(const u32x4*)(prow + col);
    u32x4 pu = (u32x4){0u, 0u, 0u, 0u};
    if (!first) pu = *(const u32x4*)(prow - IN_COLS + col);
    const f32x4 m0 = *(const f32x4*)(mu + col - C_RW), m1 = *(const f32x4*)(mu + col - C_RW + 4);
    float u[8] = {bflo(cu.x), bfhi(cu.x), bflo(cu.y), bfhi(cu.y), bflo(cu.z), bfhi(cu.z), bflo(cu.w), bfhi(cu.w)};
    const float p[8] = {bflo(pu.x), bfhi(pu.x), bflo(pu.y), bfhi(pu.y), bflo(pu.z), bfhi(pu.z), bflo(pu.w), bfhi(pu.w)};
    const float mm[8] = {m0[0], m0[1], m0[2], m0[3], m1[0], m1[1], m1[2], m1[3]};
#pragma unroll
    for (int j = 0; j < 8; ++j) { const float us = u[j] + (p[j] - u[j]) * mm[j]; u[j] = (ltype == 0) ? tanhf_fast(us) : ((ltype == 1) ? us : __builtin_amdgcn_rcpf(1.0f + __expf(-us))); }
    u32x4 w; w.x = pack2(u[0], u[1]); w.y = pack2(u[2], u[3]); w.z = pack2(u[4], u[5]); w.w = pack2(u[6], u[7]);
    return w;
}
template <int AMODE>
DI void g_load(u32x4 (&ra)[4], u32x4 (&rb)[2], const ARows& ar, const bf16_t* bt, int ldb, int k0, int tid) {
    const int kseg = (tid & 7) * 8;
#pragma unroll
    for (int i = 0; i < 4; ++i) {
        ra[i] = (u32x4){0u, 0u, 0u, 0u};
        if (AMODE == 2) ra[i] = lora_chunk(ar.p[i], (ar.first >> i) & 1, ar.mu, ar.ltype, k0 + kseg);
        else if (ar.p[i] != nullptr) ra[i] = *(const u32x4*)((AMODE == 0) ? (ar.p[i] + k0 + kseg) : (ar.p[i] + (size_t)(k0 >> 6) * IN_COLS + kseg));
    }
#pragma unroll
    for (int i = 0; i < 2; ++i) rb[i] = *(const u32x4*)(bt + (size_t)((tid >> 3) + 64 * i) * ldb + k0 + kseg);
}
DI void g_store(unsigned char* st, const u32x4 (&ra)[4], const u32x4 (&rb)[2], int tid) {
    const int off = g_off(tid >> 3, (tid & 7) * 8);
#pragma unroll
    for (int i = 0; i < 4; ++i) *(u32x4*)(st + G_A + off + i * 8192) = ra[i];
#pragma unroll
    for (int i = 0; i < 2; ++i) *(u32x4*)(st + G_B + off + i * 8192) = rb[i];
}
DI void g_compute(f32x4 (&acc)[4][4], const unsigned char* st, int lane, int wm, int wn) {
    const int lo = ((lane & 15) * 64 + (lane >> 4) * 16) ^ ((((lane & 15) >> 3) & 1) << 5);
    const unsigned char* sA = st + G_A + wm * 8192 + lo;
    const unsigned char* sB = st + G_B + wn * 8192 + lo;
    bf16x8 bcur[4], bnxt[4], a0, a1, a2;
#pragma unroll
    for (int i = 0; i < 4; ++i) bcur[i] = *(const bf16x8*)(sB + i * 2048);
    a0 = *(const bf16x8*)(sA);
    a1 = *(const bf16x8*)(sA + 2048);
#define G_AFRAG(s) (*(const bf16x8*)(sA + ((s) & 3) * 2048 + ((s) >> 2) * 1024))
#define G_GROUP(s, acur, anew) do { \
        if ((s) + 2 < 8) anew = G_AFRAG((s) + 2); \
        if ((s) < 4) bnxt[(s) & 3] = *(const bf16x8*)(sB + ((s) & 3) * 2048 + 1024); \
        __builtin_amdgcn_sched_barrier(0); \
        _Pragma("unroll") for (int ni = 0; ni < 4; ++ni) acc[(s) & 3][ni] = __builtin_amdgcn_mfma_f32_16x16x32_bf16(((s) < 4 ? bcur[ni] : bnxt[ni]), acur, acc[(s) & 3][ni], 0, 0, 0); \
        __builtin_amdgcn_sched_barrier(0); } while (0)
    G_GROUP(0, a0, a2); G_GROUP(1, a1, a0); G_GROUP(2, a2, a1); G_GROUP(3, a0, a2);
    G_GROUP(4, a1, a0); G_GROUP(5, a2, a1); G_GROUP(6, a0, a2); G_GROUP(7, a1, a0);
#undef G_GROUP
#undef G_AFRAG
}
#define LDS_BARRIER() do { asm volatile("s_waitcnt lgkmcnt(0)" ::: "memory"); __builtin_amdgcn_s_barrier(); asm volatile("" ::: "memory"); } while (0)
template <int AMODE>
DI void gemm_core(f32x4 (&acc)[4][4], const ARows& ar, const bf16_t* bt  , int ldb, int K, unsigned char* lds) {
    const int tid = TID(), lane = tid & 63, wave = tid >> 6, wm = wave >> 1, wn = wave & 1;
    const int nk = K >> 6;
    unsigned char* s0 = lds; unsigned char* s1 = lds + G_STAGE;
    u32x4 ra0[4], rb0[2], ra1[4], rb1[2];
    g_load<AMODE>(ra0, rb0, ar, bt, ldb, 0, tid);
    g_load<AMODE>(ra1, rb1, ar, bt, ldb, 64, tid);
    __syncthreads();
    g_store(s0, ra0, rb0, tid);
    g_load<AMODE>(ra0, rb0, ar, bt, ldb, (nk > 2 ? 2 : nk - 1) * 64, tid);
    LDS_BARRIER();
    for (int kt = 0; kt < nk; kt += 2) {
        g_store(s1, ra1, rb1, tid);
        { const int kn = (kt + 3 < nk) ? kt + 3 : nk - 1; g_load<AMODE>(ra1, rb1, ar, bt, ldb, kn * 64, tid); }
        g_compute(acc, s0, lane, wm, wn);
        LDS_BARRIER();
        g_store(s0, ra0, rb0, tid);
        { const int kn = (kt + 4 < nk) ? kt + 4 : nk - 1; g_load<AMODE>(ra0, rb0, ar, bt, ldb, kn * 64, tid); }
        g_compute(acc, s1, lane, wm, wn);
        LDS_BARRIER();
    }
}
static_assert(3 * G_STAGE <= LDS_BYTES - 64, "dma ring");
DI void gemm_core_dma(f32x4 (&acc)[4][4], const bf16_t* A, size_t lda, const bf16_t* bt, size_t ldb, int K, unsigned char* lds) {
    const int tid = TID(), lane = tid & 63, wave = __builtin_amdgcn_readfirstlane(tid >> 6), wm = wave >> 1, wn = wave & 1;
    const int nk = K >> 6;
    const int srow = lane >> 2, skof = ((lane & 3) * 8) ^ ((lane >> 5) << 4);
    const char* gp[6]; int loff[6];
#pragma unroll
    for (int j = 0; j < 6; ++j) {
        const int sid = wave * 6 + j;
        if (sid < 32) { gp[j] = (const char*)(A + (size_t)((sid >> 1) * 16 + srow) * lda + (sid & 1) * 32 + skof); loff[j] = G_A + sid * 1024; }
        else { const int s2 = sid - 32; gp[j] = (const char*)(bt + (size_t)((s2 >> 1) * 16 + srow) * ldb + (s2 & 1) * 32 + skof); loff[j] = G_B + s2 * 1024; }
    }
#define DMA_ISSUE(kt_, st_) do { const int _k = ((kt_) < nk ? (kt_) : nk - 1) * 128; \
        _Pragma("unroll") for (int j = 0; j < 6; ++j) __builtin_amdgcn_global_load_lds((const unsigned*)(gp[j] + _k), (LAS unsigned*)(lds + (st_) * G_STAGE + loff[j]), 16, 0, 0); } while (0)
    asm volatile("s_waitcnt vmcnt(0)" ::: "memory");
    __syncthreads();
    DMA_ISSUE(0, 0); DMA_ISSUE(1, 1);
    int st = 0;
    for (int kt = 0; kt < nk; ++kt) {
        asm volatile("s_waitcnt vmcnt(6)" ::: "memory");
        __builtin_amdgcn_s_barrier();
        asm volatile("" ::: "memory");
        const int sn = (st == 0) ? 2 : st - 1;
        DMA_ISSUE(kt + 2, sn);
        g_compute(acc, lds + st * G_STAGE, lane, wm, wn);
        st = (st == 2) ? 0 : st + 1;
    }
    asm volatile("s_waitcnt vmcnt(0)" ::: "memory");
    __syncthreads();
#undef DMA_ISSUE
}
DI void store_bf4(bf16_t* p, f32x4 v) { u32x2 w; w.x = pack2(v[0], v[1]); w.y = pack2(v[2], v[3]); *(u32x2*)p = w; }
constexpr int H_A = 0, H_B = 256 * 64 * 2, H_STAGE = 2 * 256 * 64 * 2;
static_assert(2 * H_STAGE <= LDS_BYTES - 64, "gemm256 lds");
DI void h_compute(f32x4 (&acc)[8][4], const unsigned char* st, int lane, int wm, int wn) {
    const int lo = ((lane & 15) * 64 + (lane >> 4) * 16) ^ ((((lane & 15) >> 3) & 1) << 5);
    const unsigned char* sA = st + H_A + wm * 16384 + lo;
    const unsigned char* sB = st + H_B + wn * 8192 + lo;
#pragma unroll
    for (int ks = 0; ks < 2; ++ks) {
        bf16x8 bf[4], a0, a1, a2;
#pragma unroll
        for (int i = 0; i < 4; ++i) bf[i] = *(const bf16x8*)(sB + i * 2048 + ks * 1024);
        a0 = *(const bf16x8*)(sA + ks * 1024);
        a1 = *(const bf16x8*)(sA + 2048 + ks * 1024);
#define H_GROUP(s, acur, anew) do { \
        if ((s) + 2 < 8) anew = *(const bf16x8*)(sA + ((s) + 2) * 2048 + ks * 1024); \
        __builtin_amdgcn_sched_barrier(0); \
        _Pragma("unroll") for (int ni = 0; ni < 4; ++ni) acc[(s)][ni] = __builtin_amdgcn_mfma_f32_16x16x32_bf16(bf[ni], acur, acc[(s)][ni], 0, 0, 0); \
        __builtin_amdgcn_sched_barrier(0); } while (0)
        H_GROUP(0, a0, a2); H_GROUP(1, a1, a0); H_GROUP(2, a2, a1); H_GROUP(3, a0, a2);
        H_GROUP(4, a1, a0); H_GROUP(5, a2, a1); H_GROUP(6, a0, a2); H_GROUP(7, a1, a0);
#undef H_GROUP
    }
}
DI void gemm256_dma(f32x4 (&acc)[8][4], const bf16_t* A, size_t lda, const bf16_t* bt, size_t ldb, int K, unsigned char* lds) {
    const int tid = TID(), lane = tid & 63, wave = __builtin_amdgcn_readfirstlane(tid >> 6), wm = wave >> 2, wn = wave & 3;
    const int nk = K >> 6;
    const int srow = lane >> 2, skof = ((lane & 3) * 8) ^ ((lane >> 5) << 4);
    const char* gp[8]; int loff[8];
#pragma unroll
    for (int j = 0; j < 8; ++j) {
        const int sid = wave * 8 + j;
        if (sid < 32) { gp[j] = (const char*)(A + (size_t)((sid >> 1) * 16 + srow) * lda + (sid & 1) * 32 + skof); loff[j] = H_A + sid * 1024; }
        else { const int s2 = sid - 32; gp[j] = (const char*)(bt + (size_t)((s2 >> 1) * 16 + srow) * ldb + (s2 & 1) * 32 + skof); loff[j] = H_B + s2 * 1024; }
    }
#define H_ISSUE(kt_, st_) do { const int _k = ((kt_) < nk ? (kt_) : nk - 1) * 128; \
        _Pragma("unroll") for (int j = 0; j < 8; ++j) __builtin_amdgcn_global_load_lds((const unsigned*)(gp[j] + _k), (LAS unsigned*)(lds + (st_) * H_STAGE + loff[j]), 16, 0, 0); } while (0)
    asm volatile("s_waitcnt vmcnt(0)" ::: "memory");
    __syncthreads();
    H_ISSUE(0, 0);
    for (int kt = 0; kt < nk; ++kt) {
        asm volatile("s_waitcnt vmcnt(0)" ::: "memory");
        __builtin_amdgcn_s_barrier();
        asm volatile("" ::: "memory");
        H_ISSUE(kt + 1, (kt + 1) & 1);
        h_compute(acc, lds + (kt & 1) * H_STAGE, lane, wm, wn);
    }
    asm volatile("s_waitcnt vmcnt(0)" ::: "memory");
    __syncthreads();
#undef H_ISSUE
}
DI void tile256_store_bf16(f32x4 (&acc)[8][4], bf16_t* out, size_t ld, int ncols, unsigned char* lds) {
    bf16_t* T = (bf16_t*)lds;
    const int tid = TID(), lane = tid & 63, wave = tid >> 6, wm = wave >> 2, wn = wave & 3;
    __syncthreads();
#pragma unroll
    for (int mi = 0; mi < 8; ++mi)
#pragma unroll
        for (int ni = 0; ni < 4; ++ni) store_bf4(T + (wm * 128 + mi * 16 + (lane & 15)) * 264 + wn * 64 + ni * 16 + (lane >> 4) * 4, acc[mi][ni]);
    __syncthreads();
#pragma unroll
    for (int i = 0; i < 16; ++i) {
        const int ch = tid + i * NTHREADS, r = ch >> 5, cc = (ch & 31) * 8;
        if (cc < ncols) *(u32x4*)(out + (size_t)r * ld + cc) = *(const u32x4*)(T + r * 264 + cc);
    }
}
DI void acc_zero(f32x4 (&acc)[4][4]) {
#pragma unroll
    for (int i = 0; i < 4; ++i)
#pragma unroll
        for (int j = 0; j < 4; ++j) acc[i][j] = (f32x4){0.f, 0.f, 0.f, 0.f};
}
#define ACC_FOREACH(acc, body) do { const int _l = TID() & 63, _w = TID() >> 6; \
    _Pragma("unroll") for (int _mi = 0; _mi < 4; ++_mi) _Pragma("unroll") for (int _ni = 0; _ni < 4; ++_ni) { \
        const int r_ = (_w >> 1) * 64 + _mi * 16 + (_l & 15), c_ = (_w & 1) * 64 + _ni * 16 + (_l >> 4) * 4; f32x4& v_ = acc[_mi][_ni]; body } } while (0)
DI ARows plain_rows(const bf16_t* base, size_t ld, int m0, int tid) { ARows a; a.mu = nullptr; a.ltype = 0; a.first = 0;
#pragma unroll
    for (int i = 0; i < 4; ++i) a.p[i] = base + (size_t)(m0 + (tid >> 3) + 64 * i) * ld;
    return a; }


DI void convert_tile4(const float* src, int ld, int N, int K, bf16_t* dst, int tile0, unsigned char* lds, int Kvalid = 1 << 30) {
    const int tid = TID();
    const int nkt = K >> 6;
    const int r = tid >> 3, seg = (tid & 7) * 8;
    f32x4 a[4], b[4];
#pragma unroll
    for (int u = 0; u < 4; ++u) {
        const int tile = tile0 + u, k0 = (tile % nkt) * 64, n0 = (tile / nkt) * 64;
        a[u] = (f32x4){0.f, 0.f, 0.f, 0.f}; b[u] = a[u];
        if (n0 + seg < N && k0 + r < Kvalid) { const float* q = src + (size_t)(k0 + r) * ld + n0 + seg; a[u] = *(const f32x4*)q; b[u] = *(const f32x4*)(q + 4); }
    }
    __syncthreads();
#pragma unroll
    for (int u = 0; u < 4; ++u) { bf16_t* T = (bf16_t*)lds + u * 64 * 72;
        u32x4 w; w.x = pack2(a[u][0], a[u][1]); w.y = pack2(a[u][2], a[u][3]); w.z = pack2(b[u][0], b[u][1]); w.w = pack2(b[u][2], b[u][3]); *(u32x4*)(T + r * 72 + seg) = w; }
    __syncthreads();
#pragma unroll
    for (int u = 0; u < 4; ++u) { const bf16_t* T = (const bf16_t*)lds + u * 64 * 72;
        const int tile = tile0 + u, k0 = (tile % nkt) * 64, n0 = (tile / nkt) * 64;
        u32x4 o;
        o.x = (unsigned)T[(seg + 0) * 72 + r] | ((unsigned)T[(seg + 1) * 72 + r] << 16); o.y = (unsigned)T[(seg + 2) * 72 + r] | ((unsigned)T[(seg + 3) * 72 + r] << 16);
        o.z = (unsigned)T[(seg + 4) * 72 + r] | ((unsigned)T[(seg + 5) * 72 + r] << 16); o.w = (unsigned)T[(seg + 6) * 72 + r] | ((unsigned)T[(seg + 7) * 72 + r] << 16);
        *(u32x4*)(dst + (size_t)(n0 + r) * K + k0 + seg) = o; }
}
struct Ctx {
    const Params* P; unsigned char* ws; float* out; int l;
    bf16_t* H; bf16_t* PROJ; bf16_t* F; bf16_t* POOLED; bf16_t* MERGED; bf16_t* CMPH; float* CMPO; float* POSB; int* ROUTE; int* ENT; bf16_t* HID; bf16_t* Y; bf16_t* VT; bf16_t* KC; bf16_t* VCT; bf16_t* YRAW; float* BON; unsigned* ctl;
    DI const float* in(int i) const { return P->in[i]; }
};

DI void moe_offsets(const Ctx& c, int layer, int* soff) {
    const unsigned* cnt = c.ctl + CW_CNT + layer * 32;
    __syncthreads();
    if (TID() == 0) { int s = 0; for (int e = 0; e < 32; ++e) { soff[e] = s; s += (int)cnt[e]; } soff[32] = s; }
    __syncthreads();
}
DI void add_moe_rows(const Ctx& c, int row, int lane, f32x4 (&v)[4], const int* soff) {
    const int* rt = c.ROUTE + (size_t)row * 8;
    const int p0 = soff[rt[0]] + rt[4], p1 = soff[rt[1]] + rt[5];
    const bf16_t* y0 = c.Y + (size_t)p0 * DM; const bf16_t* y1 = c.Y + (size_t)p1 * DM;
#pragma unroll
    for (int i = 0; i < 4; ++i) {
        const u32x2 a = *(const u32x2*)(y0 + i * 256 + lane * 4), b = *(const u32x2*)(y1 + i * 256 + lane * 4);
        v[i][0] += bflo(a.x) + bflo(b.x); v[i][1] += bfhi(a.x) + bfhi(b.x); v[i][2] += bflo(a.y) + bflo(b.y); v[i][3] += bfhi(a.y) + bfhi(b.y);
    }
}
DI void phase_norm1(const Ctx& c, unsigned char* lds) {
    const int tid = TID(), lane = tid & 63, wave = tid >> 6;
    const float* gain = c.in(I_NMIX) + c.l * DM;
    const float* src = (c.l == 0) ? c.in(I_X) : c.out;
    int* soff = (int*)(lds + 65536);
    if (c.l > 0) moe_offsets(c, c.l - 1, soff);
    for (int row = blockIdx.x * 8 + wave; row < NT; row += gridDim.x * 8) {
        f32x4 v[4];
#pragma unroll
        for (int i = 0; i < 4; ++i) v[i] = *(const f32x4*)(src + (size_t)row * DM + i * 256 + lane * 4);
        if (c.l > 0) {
            add_moe_rows(c, row, lane, v, soff);
#pragma unroll
            for (int i = 0; i < 4; ++i) *(f32x4*)(c.out + (size_t)row * DM + i * 256 + lane * 4) = v[i];
        }
        float ss = 0.f;
#pragma unroll
        for (int i = 0; i < 4; ++i) ss += v[i][0] * v[i][0] + v[i][1] * v[i][1] + v[i][2] * v[i][2] + v[i][3] * v[i][3];
        ss = wave_sum_dpp(ss);
        const float rs = rsqrtf(ss * (1.0f / DM) + 1e-6f);
#pragma unroll
        for (int i = 0; i < 4; ++i) {
            const f32x4 g = *(const f32x4*)(gain + i * 256 + lane * 4);
            store_bf4(c.H + (size_t)row * DM + i * 256 + lane * 4, (f32x4){v[i][0] * rs * g[0], v[i][1] * rs * g[1], v[i][2] * rs * g[2], v[i][3] * rs * g[3]});
        }
    }
    for (int idx = blockIdx.x * 8 + wave; idx < 512; idx += gridDim.x * 8) {
        const int kv = idx >> 8, n = idx & 255;
        const float* pos = c.in(kv ? I_CPV : I_CPK) + (size_t)c.l * 2048;
        const float* w1 = c.in(kv ? I_CW1V : I_CW1K) + (size_t)c.l * 2048 * 256;
        float s = 0.f;
        for (int k = lane; k < 2048; k += 64) s += pos[k] * w1[(size_t)k * 256 + n];
        s = wave_sum_dpp(s);
        if (lane == 0) c.POSB[kv * 256 + n] = s;
    }
    for (int it = blockIdx.x * 4; it < 1216 + 256 + 16 + 16 + 48; it += gridDim.x * 4) {
        if (it < 1216) convert_tile4(c.in(I_WIN) + (size_t)c.l * DM * IN_COLS, IN_COLS, IN_COLS, DM, (bf16_t*)(c.ws + WS_WT_IN), it, lds);
        else if (it < 1216 + 256) { const int j = it - 1216, kv = j >> 7; convert_tile4(c.in(kv ? I_CW1V : I_CW1K) + (size_t)c.l * 2048 * 256, 256, 256, 2048, (bf16_t*)(c.ws + WS_WT_C1) + (size_t)kv * 256 * 2048, j & 127, lds); }
        else if (it < 1216 + 256 + 16) { const int j = it - 1472, kv = j >> 3; convert_tile4(c.in(kv ? I_CW2V : I_CW2K) + (size_t)c.l * 256 * 64, 64, 64, 256, (bf16_t*)(c.ws + WS_WT_C2) + (size_t)kv * 128 * 256, j & 7, lds); }
        else if (it < 1504) { const int j = it - 1488, gi = j >> 2; convert_tile4(c.in(I_POOLW) + ((size_t)c.l * 4 + gi) * 128 * 128, 128, 128, 128, (bf16_t*)(c.ws + WS_WT_POOL) + (size_t)gi * 128 * 128, 0, lds); }
        else { const int j = it - 1504, ty = j >> 4; bf16_t* dst = (bf16_t*)(c.ws + WS_WT_LORA) + (size_t)ty * 512 * 128;
            if (ty == 0) convert_tile4(c.in(I_WUP) + (size_t)c.l * 32 * 512, 512, 512, 128, dst, j & 15, lds, 32);
            else if (ty == 1) convert_tile4(c.in(I_AUP) + (size_t)c.l * 32 * 512, 512, 512, 128, dst, j & 15, lds, 32);
            else convert_tile4(c.in(I_GUP) + (size_t)c.l * 96 * 512, 512, 512, 128, dst, j & 15, lds, 96); }
    }
}

constexpr int EPS = 136;
DI void tile_store_bf16(f32x4 (&acc)[4][4], bf16_t* out, size_t ld, int nrows, int ncols, unsigned char* lds) {
    bf16_t* T = (bf16_t*)lds;
    const int tid = TID();
    __syncthreads();
    ACC_FOREACH(acc, { store_bf4(T + r_ * EPS + c_, v_); });
    __syncthreads();
#pragma unroll
    for (int i = 0; i < 8; ++i) {
        const int ch = tid + i * NTHREADS, r = ch >> 4, cc = (ch & 15) * 8;
        if (r < nrows && cc < ncols) *(u32x4*)(out + (size_t)r * ld + cc) = *(const u32x4*)(T + r * EPS + cc);
    }
}
DI bool xcd_unit(int it, int nN, int& tm, int& tn) {
    const int G = gridDim.x;
    if ((G & 7) != 0 || G < 8) { const int u = it * G + blockIdx.x; if (u >= 64 * nN) return false; tm = u % 64; tn = u / 64; return true; }
    const int x = blockIdx.x & 7, i = blockIdx.x >> 3, per = G >> 3;
    const int u = it * per + i;
    if (u >= 8 * nN) return false;
    tm = x * 8 + (u & 7); tn = u >> 3; return true;
}
DI void phase_gemm1(const Ctx& c, unsigned char* lds) {
    const int nN = (IN_COLS + 255) / 256;
    const bf16_t* WT = (const bf16_t*)(c.ws + WS_WT_IN);
    for (int it = 0;; ++it) {
        int tm, tn; if (!xcd_unit(it, nN, tm, tn)) break;
        const int m0 = tm * 256, n0 = tn * 256;
        f32x4 acc[8][4];
#pragma unroll
        for (int i = 0; i < 8; ++i)
#pragma unroll
            for (int j = 0; j < 4; ++j) acc[i][j] = (f32x4){0.f, 0.f, 0.f, 0.f};
        gemm256_dma(acc, c.H + (size_t)m0 * DM, DM, WT + (size_t)n0 * DM, DM, DM, lds);
        tile256_store_bf16(acc, c.PROJ + (size_t)m0 * IN_COLS + n0, IN_COLS, (IN_COLS - n0 < 256) ? IN_COLS - n0 : 256, lds);
    }
}

DI float gelu_tanh(float x) { const float u = 0.7978845608028654f * (x + 0.044715f * x * x * x); const float e = __expf(2.0f * u); return x * (1.0f - __builtin_amdgcn_rcpf(e + 1.0f)); }
DI float softplusf_(float x) { return (x > 20.f) ? x : __logf(1.0f + __expf(x)); }
DI float tanhf_(float x) { const float e = __expf(2.0f * x); return 1.0f - 2.0f * __builtin_amdgcn_rcpf(e + 1.0f); }
constexpr int TKP = 8;
template <int WIN>
DI void pool_emit(const Ctx& c, const float (&pv)[31], int t0, int s0, int ch) {
#pragma unroll
    for (int k = 0; k < 16; ++k) {
        float sum = 0.f;
#pragma unroll
        for (int j = 0; j < WIN; ++j) sum += pv[15 + k - j];
        const int s = s0 + k, cnt = (s + 1 < WIN) ? s + 1 : WIN;
        c.POOLED[(size_t)(t0 + k) * 512 + ch] = f2bf(sum / (float)cnt - pv[15 + k]);
    }
}
DI void phase_prep(const Ctx& c, unsigned char* lds) {
    const int n_cmp_items = 2 * 16 * 2;
    for (int item = (int)gridDim.x - 1 - (int)blockIdx.x; item < n_cmp_items; item += gridDim.x) {
        const int tid = TID();
        const int kv = item >> 5, bgi = (item >> 1) & 15, tn = item & 1, m0 = bgi * 256, n0 = tn * 128;
        ARows ar; ar.mu = nullptr; ar.ltype = 0; ar.first = 0;
#pragma unroll
        for (int i = 0; i < 4; ++i) { const int cb = (tid >> 3) + 64 * i;
            ar.p[i] = (cb < NCMP) ? c.PROJ + ((size_t)(bgi >> 2) * SEQ + 16 * cb) * IN_COLS + (kv ? C_VC : C_KC) + (bgi & 3) * 64 : nullptr; }
        f32x4 acc[4][4]; acc_zero(acc);
        gemm_core<1>(acc, ar, (const bf16_t*)(c.ws + WS_WT_C1) + ((size_t)kv * 256 + n0) * 2048, 2048, 2048, lds);
        const float* pb = c.POSB + kv * 256;
        ACC_FOREACH(acc, {
            const f32x4 bb = *(const f32x4*)(pb + n0 + c_);
            store_bf4(c.CMPH + ((size_t)kv * 4096 + m0 + r_) * 256 + n0 + c_, (f32x4){gelu_tanh(v_[0] + bb[0]), gelu_tanh(v_[1] + bb[1]), gelu_tanh(v_[2] + bb[2]), gelu_tanh(v_[3] + bb[3])}); });
    }
    {
        const float* mu = c.in(I_MU) + (size_t)c.l * RWC;
        const bf16_t* WL = (const bf16_t*)(c.ws + WS_WT_LORA);
        for (int unit = blockIdx.x; unit < 64 * 12; unit += gridDim.x) {
            const int tid = TID();
            const int tm = unit & 63, tn = unit >> 6, m0 = tm * 256, n0 = tn * 128, ltype = tn >> 2, ch0 = n0 & 511;
            ARows ar; ar.mu = mu; ar.ltype = ltype; ar.first = 0;
#pragma unroll
            for (int i = 0; i < 4; ++i) { const int t = m0 + (tid >> 3) + 64 * i; ar.p[i] = c.PROJ + (size_t)t * IN_COLS; if ((t & (SEQ - 1)) == 0) ar.first |= 1 << i; }
            f32x4 acc[4][4]; acc_zero(acc);
            gemm_core<2>(acc, ar, WL + (size_t)n0 * 128, 128, 128, lds);
            if (ltype == 0) { const float* w0 = c.in(I_W0) + c.l * 512 + ch0;
                ACC_FOREACH(acc, { const f32x4 b4 = *(const f32x4*)(w0 + c_);
                    for (int j = 0; j < 4; ++j) v_[j] = __expf(-softplusf_(-(b4[j] + v_[j])) - 0.5f); }); }
            else if (ltype == 1) { const float* a0 = c.in(I_A0) + c.l * 512 + ch0;
                ACC_FOREACH(acc, { const f32x4 b4 = *(const f32x4*)(a0 + c_);
                    for (int j = 0; j < 4; ++j) v_[j] = sigmoidf_(b4[j] + v_[j]); }); }
            tile_store_bf16(acc, c.F + (size_t)(3 + ltype) * NT * 512 + (size_t)m0 * 512 + ch0, 512, 256, 128, lds);
        }
    }
    const int tid = TID();
    const int n_pool_items = NT / 16, n_items = n_pool_items + 2048;
    for (int item = blockIdx.x; item < n_items; item += gridDim.x) {
        if (item >= n_pool_items) {
            const int idx = item - n_pool_items, kind = idx >> 10, bgi = (idx >> 6) & 15, s0 = (idx & 63) * 64;
            bf16_t* T = (bf16_t*)lds;
            const int r = tid >> 3, seg = (tid & 7) * 8;
            const u32x4 w = *(const u32x4*)(c.PROJ + ((size_t)(bgi >> 2) * SEQ + s0 + r) * IN_COLS + (kind ? C_VW : C_VS) + (bgi & 3) * 64 + seg);
            __syncthreads();
            *(u32x4*)(T + r * 72 + seg) = w;
            __syncthreads();
            u32x4 o;
            o.x = (unsigned)T[(seg + 0) * 72 + r] | ((unsigned)T[(seg + 1) * 72 + r] << 16); o.y = (unsigned)T[(seg + 2) * 72 + r] | ((unsigned)T[(seg + 3) * 72 + r] << 16);
            o.z = (unsigned)T[(seg + 4) * 72 + r] | ((unsigned)T[(seg + 5) * 72 + r] << 16); o.w = (unsigned)T[(seg + 6) * 72 + r] | ((unsigned)T[(seg + 7) * 72 + r] << 16);
            *(u32x4*)(c.VT + (((size_t)kind * 16 + bgi) * 64 + r) * SEQ + s0 + seg) = o;
        } else {
            const int t0 = item * 16, ch = tid, gi = ch >> 7, s0 = t0 & (SEQ - 1);
            float pv[31];
#pragma unroll
            for (int i = 0; i < 31; ++i) pv[i] = (s0 - 15 + i >= 0) ? bf2f(c.PROJ[(size_t)(t0 - 15 + i) * IN_COLS + C_POOL + ch]) : 0.f;
            if (gi == 0) pool_emit<2>(c, pv, t0, s0, ch);
            else if (gi == 1) pool_emit<4>(c, pv, t0, s0, ch);
            else if (gi == 2) pool_emit<8>(c, pv, t0, s0, ch);
            else pool_emit<16>(c, pv, t0, s0, ch);
        }
    }
}

DI void rwkv_finalize_item(const Ctx& c, int item) {
    const int tid = TID(), ch = tid, t0 = item * 8;
    const float* mu = c.in(I_MU) + (size_t)c.l * RWC;
    const float kkw_ = c.in(I_KK)[c.l * 512 + ch], kaw_ = c.in(I_KA)[c.l * 512 + ch], rkw_ = c.in(I_RK)[c.l * 512 + ch];
    const float mur = mu[ch], muk = mu[512 + ch], muv = mu[1024 + ch];
    bf16_t ur[9], uk[9], uv[9], ua[8];
    const bool has_prev = (t0 & (SEQ - 1)) != 0;
#pragma unroll
    for (int k = 0; k < 9; ++k) {
        ur[k] = 0; uk[k] = 0; uv[k] = 0;
        if (k > 0 || has_prev) { const bf16_t* q = c.PROJ + (size_t)(t0 - 1 + k) * IN_COLS; ur[k] = q[C_R + ch]; uk[k] = q[C_K + ch]; uv[k] = q[C_V + ch]; }
    }
#pragma unroll
    for (int k = 0; k < 8; ++k) ua[k] = c.F[(size_t)4 * NT * 512 + (size_t)(t0 + k) * 512 + ch];
#pragma unroll
    for (int k = 0; k < 8; ++k) {
        const int t = t0 + k;
        const float cr = bf2f(ur[k + 1]), ck = bf2f(uk[k + 1]), cv = bf2f(uv[k + 1]);
        const float r = cr + (bf2f(ur[k]) - cr) * mur, kx = ck + (bf2f(uk[k]) - ck) * muk, vx = cv + (bf2f(uv[k]) - cv) * muv;
        const float a = bf2f(ua[k]);
        const float kxn = kx * kkw_, kp = kx * (1.0f + (a - 1.0f) * kaw_);
        const float ss = wave_sum_dpp(kxn * kxn);
        const float inv = __builtin_amdgcn_rsqf(fmaxf(ss, 1e-24f));
        const float br = wave_sum_dpp(kxn * inv * a * r), kr = wave_sum_dpp(kp * r), bon = wave_sum_dpp(r * kp * rkw_);
        if ((tid & 63) == 0) *(f32x4*)(c.BON + ((size_t)t * 8 + (tid >> 6)) * 4) = (f32x4){inv, br, kr, bon};
        const size_t o = (size_t)t * 512 + ch;
        c.F[o] = f2bf(r); c.F[o + (size_t)NT * 512] = f2bf(kx); c.F[o + (size_t)2 * NT * 512] = f2bf(vx);
    }
}

DI void phase_poolgemm(const Ctx& c, unsigned char* lds) {
    for (int item = blockIdx.x; item < NT / 8; item += gridDim.x) rwkv_finalize_item(c, item);
    const int n_pool = (NT / 256) * 4, n_items = n_pool + 32;
    for (int item = blockIdx.x; item < n_items; item += gridDim.x) {
        f32x4 acc[4][4]; acc_zero(acc);
        if (item < n_pool) {
            const int tm = item >> 2, gi = item & 3, m0 = tm * 256;
            const ARows ar = plain_rows(c.POOLED + gi * 128, 512, m0, TID());
            gemm_core<0>(acc, ar, (const bf16_t*)(c.ws + WS_WT_POOL) + (size_t)gi * 128 * 128, 128, 128, lds);
            const float* sc = c.in(I_POOLS) + c.l * 512 + gi * 128;
            ACC_FOREACH(acc, { const f32x4 s = *(const f32x4*)(sc + c_);
                store_bf4(c.POOLED + (size_t)(m0 + r_) * 512 + gi * 128 + c_, (f32x4){v_[0] * s[0], v_[1] * s[1], v_[2] * s[2], v_[3] * s[3]}); });
        } else {
            const int it = item - n_pool, kv = it >> 4, tm = it & 15, m0 = tm * 256;
            const ARows ar = plain_rows(c.CMPH + (size_t)kv * 4096 * 256, 256, m0, TID());
            gemm_core<0>(acc, ar, (const bf16_t*)(c.ws + WS_WT_C2) + (size_t)kv * 128 * 256, 256, 256, lds);
            ACC_FOREACH(acc, { if (c_ < 64) { const int R = m0 + r_;
                if (kv == 0) store_bf4(c.KC + (size_t)R * 64 + c_, v_);
                else { bf16_t* q = c.VCT + ((size_t)(R >> 8) * 64 + c_) * 256 + (R & 255); q[0] = f2bf(v_[0]); q[256] = f2bf(v_[1]); q[512] = f2bf(v_[2]); q[768] = f2bf(v_[3]); } } });
        }
    }
}

constexpr int SCH = 32;
constexpr int SB_AN = 0, SB_WR = SCH * 64 * 4, SB_W = 2 * SCH * 64 * 4, SB_BB = 3 * SCH * 64 * 4, SB_KP = 4 * SCH * 64 * 4;
constexpr int SB_V = 5 * SCH * 64 * 4;
constexpr int SB_SC = SB_V + SCH * 16 * 4;
constexpr int SB_Y = SB_SC + SCH * 2 * 4;
constexpr int SB_BYTES = SB_Y + SCH * 16 * 4;
static_assert(2 * SB_BYTES <= LDS_BYTES - 64, "scan lds");
typedef float f32x2 __attribute__((ext_vector_type(2)));
DI float row8_sum(float v) { v += DPP_MOV(v, 0xB1); v += DPP_MOV(v, 0x4E); v += DPP_MOV(v, 0x141); return v; }

constexpr int NPW = 6, NJ = (SCH + NPW - 1) / NPW;
struct PrepRegs { bf16_t r[NJ], k[NJ], v[NJ], e[NJ], a[NJ]; float s0[NJ], s1[NJ], s2[NJ]; };
DI void prep_load(PrepRegs& R, const Ctx& c, int b, int h, int ck, int pw, int lane) {
    const size_t PL = (size_t)NT * 512;
    const size_t tb = (size_t)b * SEQ + ck * SCH;
    const size_t o0 = tb * 512 + h * 64 + lane;
#pragma unroll
    for (int j = 0; j < NJ; ++j) {
        const int st = pw + NPW * j;
        if (st < SCH) { const size_t o = o0 + (size_t)st * 512; R.r[j] = c.F[o]; R.k[j] = c.F[o + PL]; R.v[j] = c.F[o + 2 * PL]; R.e[j] = c.F[o + 3 * PL]; R.a[j] = c.F[o + 4 * PL];
            const float* sp = c.BON + ((tb + st) * 8 + h) * 4; R.s0[j] = sp[0]; R.s1[j] = sp[1]; R.s2[j] = sp[2]; }
    }
}
DI void prep_store(const PrepRegs& R, unsigned char* sb, int rq, int pw, int lane, float kkw, float kaw) {
    float* an = (float*)(sb + SB_AN); float* wr = (float*)(sb + SB_WR); float* w_ = (float*)(sb + SB_W); float* bb_ = (float*)(sb + SB_BB); float* kp_ = (float*)(sb + SB_KP);
    float* vv = (float*)(sb + SB_V); float* sc = (float*)(sb + SB_SC);
#pragma unroll
    for (int j = 0; j < NJ; ++j) {
        const int st = pw + NPW * j;
        if (st < SCH) {
            const float r = bf2f(R.r[j]), k = bf2f(R.k[j]), v = bf2f(R.v[j]), e = bf2f(R.e[j]), a = bf2f(R.a[j]);
            const float w = __expf(-e);
            const float kk = k * kkw * R.s0[j];
            const float kp = k * (1.0f + (a - 1.0f) * kaw);
            an[st * 64 + lane] = -kk; wr[st * 64 + lane] = w * r; w_[st * 64 + lane] = w; bb_[st * 64 + lane] = kk * a; kp_[st * 64 + lane] = kp;
            if ((lane >> 4) == rq) vv[st * 16 + (lane & 15)] = v;
            if (lane == 0) { sc[st * 2] = R.s1[j]; sc[st * 2 + 1] = R.s2[j]; }
        }
    }
}
DI void scan_item(const Ctx& c, int item, unsigned char* lds) {
    const int tid = TID(), lane = tid & 63, wave = tid >> 6;
    const int b = item >> 5, h = (item >> 2) & 7, rq = item & 3;
    const int chn = h * 64 + lane;
    const float kkw = c.in(I_KK)[c.l * 512 + chn], kaw = c.in(I_KA)[c.l * 512 + chn];
    const int rowl = (tid & 127) >> 3, cg = tid & 7;
    f32x2 st[4];
#pragma unroll
    for (int i = 0; i < 4; ++i) st[i] = (f32x2){0.f, 0.f};
    constexpr int NCK = SEQ / SCH;
    PrepRegs R;
    __syncthreads();
    if (wave >= 2) { prep_load(R, c, b, h, 0, wave - 2, lane); prep_store(R, lds, rq, wave - 2, lane, kkw, kaw); prep_load(R, c, b, h, 1, wave - 2, lane); }
    __syncthreads();
    for (int ck = 0; ck < NCK; ++ck) {
        unsigned char* sb = lds + (ck & 1) * SB_BYTES;
        if (wave < 2) {
            const float* an = (const float*)(sb + SB_AN) + cg * 8; const float* wr = (const float*)(sb + SB_WR) + cg * 8; const float* w_ = (const float*)(sb + SB_W) + cg * 8;
            const float* bb_ = (const float*)(sb + SB_BB) + cg * 8; const float* kp_ = (const float*)(sb + SB_KP) + cg * 8;
            const float* vv = (const float*)(sb + SB_V) + rowl; const float* sc = (const float*)(sb + SB_SC); float* yb = (float*)(sb + SB_Y) + rowl;
            f32x4 a0 = *(const f32x4*)(an), a1 = *(const f32x4*)(an + 4), r0 = *(const f32x4*)(wr), r1 = *(const f32x4*)(wr + 4);
            f32x4 w0 = *(const f32x4*)(w_), w1 = *(const f32x4*)(w_ + 4), b0 = *(const f32x4*)(bb_), b1 = *(const f32x4*)(bb_ + 4);
            f32x4 k0 = *(const f32x4*)(kp_), k1 = *(const f32x4*)(kp_ + 4);
            float v = vv[0]; f32x2 bk = *(const f32x2*)(sc);
#pragma unroll 2
            for (int s = 0; s < SCH; ++s) {
                const int sn = (s + 1 < SCH) ? s + 1 : s;
                const f32x4 na0 = *(const f32x4*)(an + sn * 64), na1 = *(const f32x4*)(an + sn * 64 + 4), nr0 = *(const f32x4*)(wr + sn * 64), nr1 = *(const f32x4*)(wr + sn * 64 + 4);
                const f32x4 nw0 = *(const f32x4*)(w_ + sn * 64), nw1 = *(const f32x4*)(w_ + sn * 64 + 4), nb0 = *(const f32x4*)(bb_ + sn * 64), nb1 = *(const f32x4*)(bb_ + sn * 64 + 4);
                const f32x4 nk0 = *(const f32x4*)(kp_ + sn * 64), nk1 = *(const f32x4*)(kp_ + sn * 64 + 4);
                const float nv = vv[sn * 16]; const f32x2 nbk = *(const f32x2*)(sc + sn * 2);
                f32x2 da = st[0] * (f32x2){a0[0], a0[1]}; f32x2 dr = st[0] * (f32x2){r0[0], r0[1]};
                da += st[1] * (f32x2){a0[2], a0[3]}; dr += st[1] * (f32x2){r0[2], r0[3]};
                da += st[2] * (f32x2){a1[0], a1[1]}; dr += st[2] * (f32x2){r1[0], r1[1]};
                da += st[3] * (f32x2){a1[2], a1[3]}; dr += st[3] * (f32x2){r1[2], r1[3]};
                float sa = da[0] + da[1], sr = dr[0] + dr[1];
                sa += DPP_MOV(sa, 0xB1); sr += DPP_MOV(sr, 0xB1);
                sa += DPP_MOV(sa, 0x4E); sr += DPP_MOV(sr, 0x4E);
                sa += DPP_MOV(sa, 0x141); sr += DPP_MOV(sr, 0x141);
                const f32x2 sa2 = (f32x2){sa, sa}, v2 = (f32x2){v, v};
                st[0] = st[0] * (f32x2){w0[0], w0[1]} + sa2 * (f32x2){b0[0], b0[1]} + v2 * (f32x2){k0[0], k0[1]};
                st[1] = st[1] * (f32x2){w0[2], w0[3]} + sa2 * (f32x2){b0[2], b0[3]} + v2 * (f32x2){k0[2], k0[3]};
                st[2] = st[2] * (f32x2){w1[0], w1[1]} + sa2 * (f32x2){b1[0], b1[1]} + v2 * (f32x2){k1[0], k1[1]};
                st[3] = st[3] * (f32x2){w1[2], w1[3]} + sa2 * (f32x2){b1[2], b1[3]} + v2 * (f32x2){k1[2], k1[3]};
                yb[s * 16] = sr + sa * bk[0] + v * bk[1];
                a0 = na0; a1 = na1; r0 = nr0; r1 = nr1; w0 = nw0; w1 = nw1; b0 = nb0; b1 = nb1; k0 = nk0; k1 = nk1; v = nv; bk = nbk;
            }
        } else {
            const int pt = tid - 128;
            if (ck + 1 < NCK) prep_store(R, lds + ((ck + 1) & 1) * SB_BYTES, rq, wave - 2, lane, kkw, kaw);
            if (ck + 2 < NCK) prep_load(R, c, b, h, ck + 2, wave - 2, lane);
            if (ck > 0) {
                const float* yb = (const float*)(lds + ((ck - 1) & 1) * SB_BYTES + SB_Y);
                for (int idx = pt; idx < SCH * 16; idx += 384) {
                    const int s = idx >> 4, j = idx & 15;
                    c.YRAW[((size_t)b * SEQ + (ck - 1) * SCH + s) * 512 + h * 64 + rq * 16 + j] = f2bf(yb[idx]);
                }
            }
        }
        asm volatile("s_waitcnt lgkmcnt(0)" ::: "memory"); __builtin_amdgcn_s_barrier(); asm volatile("" ::: "memory");
    }
    {
        const float* yb = (const float*)(lds + ((NCK - 1) & 1) * SB_BYTES + SB_Y);
        for (int idx = tid; idx < SCH * 16; idx += NTHREADS) {
            const int s = idx >> 4, j = idx & 15;
            c.YRAW[((size_t)b * SEQ + (NCK - 1) * SCH + s) * 512 + h * 64 + rq * 16 + j] = f2bf(yb[idx]);
        }
    }
    __syncthreads();
}
DI void phase_rwkv_post(const Ctx& c, unsigned char* lds) {
    const int tid = TID(), lane = tid & 63, wave = tid >> 6;
    const size_t PL = (size_t)NT * 512;
    for (int t = blockIdx.x * 8 + wave; t < NT; t += gridDim.x * 8) {
        bf16_t ry[8], rv[8], rg[8]; float bon[8], gw[8], gb[8];
#pragma unroll
        for (int h = 0; h < 8; ++h) { const size_t o = (size_t)t * 512 + h * 64 + lane; ry[h] = c.YRAW[o]; rv[h] = c.F[o + 2 * PL]; rg[h] = c.F[o + 5 * PL]; bon[h] = c.BON[((size_t)t * 8 + h) * 4 + 3];
            gw[h] = c.in(I_GNW)[c.l * 512 + h * 64 + lane]; gb[h] = c.in(I_GNB)[c.l * 512 + h * 64 + lane]; }
#pragma unroll
        for (int h = 0; h < 8; ++h) {
            const float y = bf2f(ry[h]);
            const float mean = wave_sum_dpp(y) * (1.0f / 64.0f);
            const float d = y - mean;
            const float var = wave_sum_dpp(d * d) * (1.0f / 64.0f);
            const float yn = d * rsqrtf(var + 64e-5f) * gw[h] + gb[h];
            c.F[(size_t)t * 512 + h * 64 + lane + 5 * PL] = f2bf((yn + bon[h] * bf2f(rv[h])) * bf2f(rg[h]));
        }
    }
    for (int it = blockIdx.x * 4; it < 768 + 128 + 128 + 256 + 256; it += gridDim.x * 4) {
        const float* WB = c.in(I_WBR) + (size_t)c.l * 2048 * DM; bf16_t* BR = (bf16_t*)(c.ws + WS_WT_BR);
        if (it < 768) convert_tile4(c.in(I_WMG) + (size_t)c.l * DM * 3 * DM, 3 * DM, 3 * DM, DM, (bf16_t*)(c.ws + WS_WT_MG), it, lds);
        else if (it < 896) convert_tile4(WB, DM, DM, 512, BR, it - 768, lds);
        else if (it < 1024) convert_tile4(WB + (size_t)512 * DM, DM, DM, 512, BR + (size_t)1024 * 512, it - 896, lds);
        else if (it < 1280) convert_tile4(WB + (size_t)1024 * DM, DM, DM, 1024, BR + (size_t)2048 * 512, it - 1024, lds);
        else convert_tile4(c.in(I_WOUT) + (size_t)c.l * DM * DM, DM, DM, DM, (bf16_t*)(c.ws + WS_WT_OUT), it - 1280, lds);
    }
}
constexpr int TS = 72;
constexpr int NSA_BIAS = 0;
constexpr int NSA_SELM = 2112;
constexpr int NSA_SCR = 2624;
constexpr int NSA_K0 = 4672;
constexpr int NSA_V0 = NSA_K0 + 2 * 64 * TS * 2;
constexpr int NSA_A = NSA_V0 + 2 * 64 * TS * 2;
constexpr int NSA_B = NSA_A + 16384;
constexpr int NSA_END = NSA_B + 16384;
static_assert(NSA_END <= LDS_BYTES - 16, "nsa lds");
static_assert(NSA_K0 % 16 == 0, "align");

struct NsaLane { int tq[2]; int h; float cbias; float m[2], l[2]; };

DI void nsa_prefetch(u32x4& rk, u32x4& rv, const bf16_t* kbase, int kstride, const bf16_t* vtbase, int vstride, int pos0, int tid) {
    const int r = tid >> 3, seg = (tid & 7) * 8;
    rk = *(const u32x4*)(kbase + (size_t)(pos0 + r) * kstride + seg);
    rv = *(const u32x4*)(vtbase + (size_t)r * vstride + pos0 + seg);
}
DI void nsa_store(unsigned char* lds, int buf, const u32x4& rk, const u32x4& rv, int tid) {
    const int r = tid >> 3, seg = (tid & 7) * 8;
    *(u32x4*)((bf16_t*)(lds + NSA_K0) + buf * 64 * TS + r * TS + seg) = rk;
    *(u32x4*)((bf16_t*)(lds + NSA_V0) + buf * 64 * TS + r * TS + seg) = rv;
}
template <int QM = 3>
DI void nsa_qk(f32x4 (&s)[2][4], const bf16_t* sK, const bf16x8 (&qf)[2][2], int lane) {
#pragma unroll
    for (int kt = 0; kt < 4; ++kt) {
#pragma unroll
        for (int ks = 0; ks < 2; ++ks) {
            const bf16x8 kf = *(const bf16x8*)(sK + (16 * kt + (lane & 15)) * TS + 32 * ks + (lane >> 4) * 8);
#pragma unroll
            for (int qi = 0; qi < 2; ++qi) if ((QM >> qi) & 1) s[qi][kt] = __builtin_amdgcn_mfma_f32_16x16x32_bf16(kf, qf[qi][ks], (ks == 0) ? (f32x4){0.f, 0.f, 0.f, 0.f} : s[qi][kt], 0, 0, 0);
        }
    }
}
template <int MODE>
DI void nsa_logits(float (&x)[4][4], const f32x4 (&s)[4], int tq, int h, float cbias, bool rowsel, int pos0, int qd, const float* biasT) {
#pragma unroll
    for (int kt = 0; kt < 4; ++kt)
#pragma unroll
        for (int i = 0; i < 4; ++i) {
            const int kk = pos0 + 16 * kt + 4 * qd + i;
            if (MODE == 1) { x[kt][i] = rowsel ? s[kt][i] + cbias : -INFINITY; }
            else {
                const int dist = (MODE == 0) ? (tq - 16 * kk - 31) : (tq - kk);
                bool ok = dist >= 0;
                if (MODE == 2) ok = ok && rowsel;
                if (MODE == 3) ok = ok && (dist < 512);
                const int di = dist < 0 ? 0 : (dist > 128 ? 128 : dist);
                float bias = biasT[di * 4 + h];
                asm volatile("" : "+v"(bias));
                x[kt][i] = ok ? s[kt][i] + bias : -INFINITY;
            }
        }
}
DI float quad16_max(float v) { v = fmaxf(v, __shfl_xor(v, 16)); v = fmaxf(v, __shfl_xor(v, 32)); return v; }
DI float quad16_sum(float v) { v += __shfl_xor(v, 16); v += __shfl_xor(v, 32); return v; }
DI void nsa_softmax(const float (&x)[4][4], float& m, float& l, f32x4 (&O)[4], bf16x8 (&pf)[2]) {
    float mx = -INFINITY;
#pragma unroll
    for (int kt = 0; kt < 4; ++kt)
#pragma unroll
        for (int i = 0; i < 4; ++i) mx = fmaxf(mx, x[kt][i]);
    mx = quad16_max(mx);
    const float mn = fmaxf(m, mx);
    const float mu = (mn == -INFINITY) ? 0.f : mn;
    const float mu2 = mu * 1.4426950408889634f;
    const float sc = __builtin_amdgcn_exp2f(__builtin_fmaf(m, 1.4426950408889634f, -mu2));
    float p[4][4]; float ps = 0.f;
#pragma unroll
    for (int kt = 0; kt < 4; ++kt)
#pragma unroll
        for (int i = 0; i < 4; ++i) { p[kt][i] = __builtin_amdgcn_exp2f(__builtin_fmaf(x[kt][i], 1.4426950408889634f, -mu2)); ps += p[kt][i]; }
    l = l * sc + ps; m = mn;
#pragma unroll
    for (int dt = 0; dt < 4; ++dt) O[dt] = O[dt] * sc;
#pragma unroll
    for (int ks = 0; ks < 2; ++ks) {
        u32x4 w; w.x = pack2(p[2 * ks][0], p[2 * ks][1]); w.y = pack2(p[2 * ks][2], p[2 * ks][3]); w.z = pack2(p[2 * ks + 1][0], p[2 * ks + 1][1]); w.w = pack2(p[2 * ks + 1][2], p[2 * ks + 1][3]);
        pf[ks] = __builtin_bit_cast(bf16x8, w);
    }
}
template <int QM = 3>
DI void nsa_pv(f32x4 (&O)[2][4], const bf16_t* sV, const bf16x8 (&pf)[2][2], int lane) {
    const int qd = lane >> 4;
#pragma unroll
    for (int dt = 0; dt < 4; ++dt)
#pragma unroll
        for (int ks = 0; ks < 2; ++ks) {
            const bf16_t* vp = sV + (16 * dt + (lane & 15)) * TS + 32 * ks + 4 * qd;
            const u32x2 a = *(const u32x2*)vp, b = *(const u32x2*)(vp + 16);
            u32x4 w; w.x = a.x; w.y = a.y; w.z = b.x; w.w = b.y;
            const bf16x8 vf = __builtin_bit_cast(bf16x8, w);
#pragma unroll
            for (int qi = 0; qi < 2; ++qi) if ((QM >> qi) & 1) O[qi][dt] = __builtin_amdgcn_mfma_f32_16x16x32_bf16(vf, pf[qi][ks], O[qi][dt], 0, 0, 0);
        }
}
template <int MODE, int QM = 3>
DI void nsa_tile(f32x4 (&O)[2][4], NsaLane& L, const bf16x8 (&qf)[2][2], const unsigned char* lds, int buf, int pos0, bool sel0, bool sel1, int lane) {
    const bf16_t* sK = (const bf16_t*)(lds + NSA_K0) + buf * 64 * TS;
    const bf16_t* sV = (const bf16_t*)(lds + NSA_V0) + buf * 64 * TS;
    const float* biasT = (const float*)(lds + NSA_BIAS);
    f32x4 s[2][4];
    nsa_qk<QM>(s, sK, qf, lane);
    bf16x8 pf[2][2];
#pragma unroll
    for (int qi = 0; qi < 2; ++qi) if ((QM >> qi) & 1) {
        float x[4][4];
        nsa_logits<MODE>(x, s[qi], L.tq[qi], L.h, L.cbias, qi ? sel1 : sel0, pos0, lane >> 4, biasT);
        nsa_softmax(x, L.m[qi], L.l[qi], O[qi], pf[qi]);
    }
    nsa_pv<QM>(O, sV, pf, lane);
}
template <int MODE>
DI void nsa_tile_sel(f32x4 (&O)[2][4], NsaLane& L, const bf16x8 (&qf)[2][2], const unsigned char* lds, int buf, int pos0, bool sel0, bool sel1, int lane) {
    const bool a0 = __ballot(sel0) != 0ull, a1 = __ballot(sel1) != 0ull;
    if (a0 && a1) nsa_tile<MODE, 3>(O, L, qf, lds, buf, pos0, sel0, sel1, lane);
    else if (a0) nsa_tile<MODE, 1>(O, L, qf, lds, buf, pos0, sel0, sel1, lane);
    else if (a1) nsa_tile<MODE, 2>(O, L, qf, lds, buf, pos0, sel0, sel1, lane);
}
DI void nsa_flush(f32x4 (&Y)[2][4], f32x4 (&O)[2][4], NsaLane& L, const float (&gate)[2]) {
#pragma unroll
    for (int qi = 0; qi < 2; ++qi) {
        const float lt = quad16_sum(L.l[qi]);
        const float f = (lt > 0.f) ? gate[qi] * __builtin_amdgcn_rcpf(lt) : 0.f;
#pragma unroll
        for (int dt = 0; dt < 4; ++dt) { Y[qi][dt] += O[qi][dt] * f; O[qi][dt] = (f32x4){0.f, 0.f, 0.f, 0.f}; }
    }
}
DI void nsa_item(const Ctx& c, int item, unsigned char* lds) {
    const int tid = TID(), lane = tid & 63, wave = tid >> 6, qd = lane >> 4;
    const int b = item >> 8, g = (item >> 6) & 3, qt = item & 63, t0 = qt * 64, cur = qt, bg = b * 4 + g;
    float* biasT = (float*)(lds + NSA_BIAS);
    unsigned long long* selm = (unsigned long long*)(lds + NSA_SELM);
    float* scr = (float*)(lds + NSA_SCR) + wave * 64;
    float* impA = (float*)(lds + NSA_A); float* impB = (float*)(lds + NSA_B);
    __syncthreads();
    for (int i = tid; i < 129 * 4; i += NTHREADS) { const int d = i >> 2, h = i & 3; biasT[i] = c.in(I_RELB)[t5_bucket(d) * 16 + g * 4 + h]; }
    for (int i = tid; i < 2 * 4096; i += NTHREADS) impA[i] = 0.f;
    NsaLane L; L.h = lane & 3;
    bf16x8 qf[2][2]; float gates[2][3];
    const bf16_t* pbat = c.PROJ + (size_t)b * SEQ * IN_COLS;
#pragma unroll
    for (int qi = 0; qi < 2; ++qi) {
        const int tl = 8 * wave + 4 * qi + ((lane & 15) >> 2);
        L.tq[qi] = t0 + tl;
        const bf16_t* prow = pbat + (size_t)L.tq[qi] * IN_COLS;
#pragma unroll
        for (int ks = 0; ks < 2; ++ks) {
            u32x4 w = *(const u32x4*)(prow + C_Q + (g * 4 + L.h) * 64 + 32 * ks + qd * 8);
            w.x = pack2(bflo(w.x) * 0.125f, bfhi(w.x) * 0.125f); w.y = pack2(bflo(w.y) * 0.125f, bfhi(w.y) * 0.125f);
            w.z = pack2(bflo(w.z) * 0.125f, bfhi(w.z) * 0.125f); w.w = pack2(bflo(w.w) * 0.125f, bfhi(w.w) * 0.125f);
            qf[qi][ks] = __builtin_bit_cast(bf16x8, w);
        }
#pragma unroll
        for (int br = 0; br < 3; ++br) gates[qi][br] = sigmoidf_(bf2f(prow[C_GATE + g * 12 + L.h * 3 + br]));
    }
    __syncthreads();
    L.cbias = biasT[128 * 4 + L.h];
    f32x4 O[2][4], Y[2][4];
#pragma unroll
    for (int qi = 0; qi < 2; ++qi)
#pragma unroll
        for (int dt = 0; dt < 4; ++dt) { O[qi][dt] = (f32x4){0.f, 0.f, 0.f, 0.f}; Y[qi][dt] = (f32x4){0.f, 0.f, 0.f, 0.f}; }
    u32x4 rk, rv;
    const int nvis_max = (t0 + 63 >= 31) ? ((t0 + 63 - 31) >> 4) + 1 : 0;
    const int ncb = (nvis_max + 63) >> 6;
    const bf16_t* kcb = c.KC + (size_t)bg * 256 * 64; const bf16_t* vcb = c.VCT + (size_t)bg * 64 * 256;
    L.m[0] = L.m[1] = -INFINITY; L.l[0] = L.l[1] = 0.f;
    if (ncb > 0) nsa_prefetch(rk, rv, kcb, 64, vcb, 256, 0, tid);
    for (int cb = 0; cb < ncb; ++cb) {
        nsa_store(lds, cb & 1, rk, rv, tid);
        __syncthreads();
        if (cb + 1 < ncb) nsa_prefetch(rk, rv, kcb, 64, vcb, 256, (cb + 1) * 64, tid);
        if (16 * (cb * 64 + 63) + 31 + 128 <= t0) nsa_tile<1>(O, L, qf, lds, cb & 1, cb * 64, true, true, lane);
        else nsa_tile<0>(O, L, qf, lds, cb & 1, cb * 64, true, true, lane);
    }
    float mfin[2], linv[2];
#pragma unroll
    for (int qi = 0; qi < 2; ++qi) { mfin[qi] = L.m[qi]; const float lt = quad16_sum(L.l[qi]); linv[qi] = (lt > 0.f) ? __builtin_amdgcn_rcpf(lt) : 0.f; }
    { const float gg[2] = {gates[0][0], gates[1][0]}; nsa_flush(Y, O, L, gg); }
    __syncthreads();
    if (ncb > 0) nsa_prefetch(rk, rv, kcb, 64, vcb, 256, 0, tid);
    for (int cb = 0; cb < ncb; ++cb) {
        nsa_store(lds, cb & 1, rk, rv, tid);
        __syncthreads();
        if (cb + 1 < ncb) nsa_prefetch(rk, rv, kcb, 64, vcb, 256, (cb + 1) * 64, tid);
        const bf16_t* sK = (const bf16_t*)(lds + NSA_K0) + (cb & 1) * 64 * TS;
        f32x4 s[2][4];
        nsa_qk(s, sK, qf, lane);
#pragma unroll
        for (int qi = 0; qi < 2; ++qi) {
            float x[4][4];
            nsa_logits<0>(x, s[qi], L.tq[qi], L.h, L.cbias, true, cb * 64, qd, biasT);
            const float mu = (mfin[qi] == -INFINITY) ? 0.f : mfin[qi];
#pragma unroll
            for (int kt = 0; kt < 4; ++kt) {
                float p3 = __expf(x[kt][3] - mu) * linv[qi];
                float pa = (__expf(x[kt][0] - mu) + __expf(x[kt][1] - mu) + __expf(x[kt][2] - mu)) * linv[qi] + p3;
                pa += __shfl_xor(pa, 1); p3 += __shfl_xor(p3, 1);
                pa += __shfl_xor(pa, 2); p3 += __shfl_xor(p3, 2);
                if (L.h == 0) { const int tl = 8 * wave + 4 * qi + ((lane & 15) >> 2), mi = 16 * cb + 4 * kt + qd; impA[tl * 64 + mi] = pa; impB[tl * 64 + mi] = p3; }
            }
        }
    }
    __syncthreads();
    for (int tl8 = 0; tl8 < 8; ++tl8) {
        const int tl = 8 * wave + tl8, n = lane;
        const bool cand = (n >= 1) && (n <= cur - 2);
        const float imp = cand ? impA[tl * 64 + n] + impB[tl * 64 + n - 1] : -1.0f;
        LDS_WAVE_SYNC();
        scr[n] = imp;
        LDS_WAVE_SYNC();
        int rank = 0;
#pragma unroll 4
        for (int q4 = 0; q4 < 16; ++q4) {
            const f32x4 o = *(const f32x4*)(scr + q4 * 4);
#pragma unroll
            for (int j = 0; j < 4; ++j) { const int n2 = q4 * 4 + j; rank += (o[j] > imp || (o[j] == imp && n2 < n)) ? 1 : 0; }
        }
        const bool forced = (n <= cur) && (n == 0 || n == cur || n == cur - 1);
        const unsigned long long msk = __ballot((cand && rank < 5) || forced);
        if (lane == 0) selm[tl] = msk;
    }
    __syncthreads();
    unsigned long long uni = selm[lane];
#pragma unroll
    for (int o = 32; o >= 1; o >>= 1) { const unsigned lo_ = __shfl_xor((unsigned)uni, o), hi_ = __shfl_xor((unsigned)(uni >> 32), o); uni |= ((unsigned long long)hi_ << 32) | lo_; }
    uni = ((unsigned long long)__builtin_amdgcn_readfirstlane((unsigned)(uni >> 32)) << 32) | (unsigned)__builtin_amdgcn_readfirstlane((unsigned)uni);
    unsigned long long sm[2];
#pragma unroll
    for (int qi = 0; qi < 2; ++qi) sm[qi] = selm[8 * wave + 4 * qi + ((lane & 15) >> 2)];
    const bf16_t* ksb = pbat + C_KS + g * 64; const bf16_t* vsb = c.VT + ((size_t)0 * 16 + bg) * 64 * SEQ;
    L.m[0] = L.m[1] = -INFINITY; L.l[0] = L.l[1] = 0.f;
    {
        unsigned long long rem = uni; int it = 0;
        int j = (int)__builtin_ctzll(rem); rem &= rem - 1;
        nsa_prefetch(rk, rv, ksb, IN_COLS, vsb, SEQ, j * 64, tid);
        for (;;) {
            nsa_store(lds, it & 1, rk, rv, tid);
            __syncthreads();
            const int jn = rem ? (int)__builtin_ctzll(rem) : -1;
            if (jn >= 0) { rem &= rem - 1; nsa_prefetch(rk, rv, ksb, IN_COLS, vsb, SEQ, jn * 64, tid); }
            const bool s0 = (sm[0] >> j) & 1ull, s1 = (sm[1] >> j) & 1ull;
            if (j <= cur - 3) nsa_tile_sel<1>(O, L, qf, lds, it & 1, j * 64, s0, s1, lane);
            else nsa_tile_sel<2>(O, L, qf, lds, it & 1, j * 64, s0, s1, lane);
            if (jn < 0) break;
            j = jn; ++it;
        }
    }
    { const float gg[2] = {gates[0][1], gates[1][1]}; nsa_flush(Y, O, L, gg); }
    const bf16_t* kwb = pbat + C_KW + g * 64; const bf16_t* vwb = c.VT + ((size_t)1 * 16 + bg) * 64 * SEQ;
    L.m[0] = L.m[1] = -INFINITY; L.l[0] = L.l[1] = 0.f;
    {
        const int j0 = (cur - 8 > 0) ? cur - 8 : 0;
        __syncthreads();
        nsa_prefetch(rk, rv, kwb, IN_COLS, vwb, SEQ, j0 * 64, tid);
        for (int j = j0; j <= cur; ++j) {
            nsa_store(lds, (j - j0) & 1, rk, rv, tid);
            __syncthreads();
            if (j + 1 <= cur) nsa_prefetch(rk, rv, kwb, IN_COLS, vwb, SEQ, (j + 1) * 64, tid);
            if (cur - j >= 3 && cur - j <= 7) nsa_tile<1>(O, L, qf, lds, (j - j0) & 1, j * 64, true, true, lane);
            else nsa_tile<3>(O, L, qf, lds, (j - j0) & 1, j * 64, true, true, lane);
        }
    }
    { const float gg[2] = {gates[0][2], gates[1][2]}; nsa_flush(Y, O, L, gg); }
#pragma unroll
    for (int qi = 0; qi < 2; ++qi) {
        bf16_t* yrow = c.PROJ + ((size_t)b * SEQ + L.tq[qi]) * IN_COLS + C_Q + (g * 4 + L.h) * 64;
#pragma unroll
        for (int dt = 0; dt < 4; ++dt) store_bf4(yrow + 16 * dt + 4 * qd, Y[qi][dt]);
    }
}
DI void phase_mix(const Ctx& c, unsigned char* lds) {
    const int G = gridDim.x, bid = blockIdx.x;
    const int n_nsa = NB * 4 * (SEQ / 64), n_scan = NB * 8 * 4;
    const bool split = G >= 2 * n_scan;
    if (split) { if (bid < n_scan) scan_item(c, bid, lds); }
    else for (int item = bid; item < n_scan; item += G) scan_item(c, item, lds);
    unsigned* ctr = c.ctl + CW_Q + c.l;
    volatile int* sitem = (volatile int*)(lds + LDS_BYTES - 32);
    for (;;) {
        __syncthreads();
        if (TID() == 0) *sitem = (int)atomicAdd(ctr, 1u);
        __syncthreads();
        const int k = *sitem;
        if (k >= n_nsa) break;
        const int qt = 63 - (k >> 4), bgi = k & 15;
        nsa_item(c, (bgi << 6) | qt, lds);
    }
}

DI void phase_merge(const Ctx& c, unsigned char* lds) {
    const int nM = NT / 256, nN = DM / 128;
    const bf16_t* WM = (const bf16_t*)(c.ws + WS_WT_MG);
    const bf16_t* BR = (const bf16_t*)(c.ws + WS_WT_BR);
    const float* BM_ = c.in(I_BMG) + (size_t)c.l * 3 * DM;
    bf16_t* TMP = c.YRAW + (size_t)blockIdx.x * 256 * 128;
    for (int it = 0;; ++it) {
        int tm, tn; if (!xcd_unit(it, nN, tm, tn)) break;
        const int m0 = tm * 256, n0 = tn * 128;
#pragma unroll 1
        for (int i = 0; i < 3; ++i) {
            {
                f32x4 ag[4][4]; acc_zero(ag);
                gemm_core_dma(ag, c.H + (size_t)m0 * DM, DM, WM + (size_t)(i * DM + n0) * DM, DM, DM, lds);
                ACC_FOREACH(ag, { const f32x4 bb = *(const f32x4*)(BM_ + i * DM + n0 + c_);
                    store_bf4(TMP + r_ * 128 + c_, (f32x4){sigmoidf_(v_[0] + bb[0]), sigmoidf_(v_[1] + bb[1]), sigmoidf_(v_[2] + bb[2]), sigmoidf_(v_[3] + bb[3])}); });
            }
            f32x4 ab[4][4]; acc_zero(ab);
            if (i == 0) gemm_core_dma(ab, c.POOLED + (size_t)m0 * 512, 512, BR + (size_t)n0 * 512, 512, 512, lds);
            else if (i == 1) gemm_core_dma(ab, c.F + (size_t)5 * NT * 512 + (size_t)m0 * 512, 512, BR + (size_t)1024 * 512 + (size_t)n0 * 512, 512, 512, lds);
            else gemm_core_dma(ab, c.PROJ + C_Q + (size_t)m0 * IN_COLS, IN_COLS, BR + (size_t)2048 * 512 + (size_t)n0 * 1024, 1024, 1024, lds);
            ACC_FOREACH(ab, {
                bf16_t* q = c.MERGED + (size_t)(m0 + r_) * DM + n0 + c_;
                const u32x2 gv = *(const u32x2*)(TMP + r_ * 128 + c_);
                f32x4 m4 = ((f32x4){0.f, 0.f, 0.f, 0.f});
                if (i > 0) { const u32x2 pv = *(const u32x2*)q; m4 = ((f32x4){bflo(pv.x), bfhi(pv.x), bflo(pv.y), bfhi(pv.y)}); }
                m4[0] += bflo(gv.x) * v_[0]; m4[1] += bfhi(gv.x) * v_[1]; m4[2] += bflo(gv.y) * v_[2]; m4[3] += bfhi(gv.y) * v_[3];
                store_bf4(q, m4); });
        }
    }
}

DI void phase_outp(const Ctx& c, unsigned char* lds) {
    const int nN = DM / 256;
    const bf16_t* W = (const bf16_t*)(c.ws + WS_WT_OUT);
    const float* xin = (c.l == 0) ? c.in(I_X) : c.out;
    for (int it = 0;; ++it) {
        int tm, tn; if (!xcd_unit(it, nN, tm, tn)) break;
        const int m0 = tm * 256, n0 = tn * 256;
        f32x4 acc[8][4];
#pragma unroll
        for (int i = 0; i < 8; ++i)
#pragma unroll
            for (int j = 0; j < 4; ++j) acc[i][j] = (f32x4){0.f, 0.f, 0.f, 0.f};
        gemm256_dma(acc, c.MERGED + (size_t)m0 * DM, DM, W + (size_t)n0 * DM, DM, DM, lds);
        const int lane = TID() & 63, wave = TID() >> 6, wm = wave >> 2, wn = wave & 3;
#pragma unroll
        for (int mi = 0; mi < 8; ++mi)
#pragma unroll
            for (int ni = 0; ni < 4; ++ni) {
                const size_t o = (size_t)(m0 + wm * 128 + mi * 16 + (lane & 15)) * DM + n0 + wn * 64 + ni * 16 + (lane >> 4) * 4;
                const f32x4 x = *(const f32x4*)(xin + o); *(f32x4*)(c.out + o) = x + acc[mi][ni];
            }
    }
    for (int it = blockIdx.x * 4; it < 3 * 32 * 64; it += gridDim.x * 4) {
        const int mat = it / 2048, e = (it >> 6) & 31, tl = it & 63;
        if (mat == 0) convert_tile4(c.in(I_EG) + ((size_t)c.l * 32 + e) * DM * 256, 256, 256, DM, (bf16_t*)(c.ws + WS_EG) + (size_t)e * 256 * DM, tl, lds);
        else if (mat == 1) convert_tile4(c.in(I_EU) + ((size_t)c.l * 32 + e) * DM * 256, 256, 256, DM, (bf16_t*)(c.ws + WS_EU) + (size_t)e * 256 * DM, tl, lds);
        else convert_tile4(c.in(I_ED) + ((size_t)c.l * 32 + e) * 256 * DM, DM, DM, 256, (bf16_t*)(c.ws + WS_ED) + (size_t)e * DM * 256, tl, lds);
    }
}

DI void phase_norm2(const Ctx& c, unsigned char* lds) {
    const int tid = TID(), lane = tid & 63, wave = tid >> 6;
    const float* gain = c.in(I_NFFN) + c.l * DM;
    const float* wrg = c.in(I_WRG) + (size_t)c.l * DM * 4; const float* brg = c.in(I_BRG) + c.l * 4;
    const float* wre = c.in(I_WRE) + (size_t)c.l * DM * 32; const float* bre = c.in(I_BRE) + c.l * 32;
    unsigned* cnt = c.ctl + CW_CNT + c.l * 32;
    float* lg = (float*)lds + wave * 16 * 48;
    if (wave < 4)
    for (int rt = blockIdx.x * 4 + wave; rt < NT / 16; rt += gridDim.x * 4) {
        const int r0 = rt * 16;
        float my_rs = 0.f;
#pragma unroll 2
        for (int rr = 0; rr < 16; ++rr) {
            const size_t ro = (size_t)(r0 + rr) * DM;
            f32x4 v[4]; float ss = 0.f;
#pragma unroll
            for (int i = 0; i < 4; ++i) { v[i] = *(const f32x4*)(c.out + ro + i * 256 + lane * 4); ss += v[i][0] * v[i][0] + v[i][1] * v[i][1] + v[i][2] * v[i][2] + v[i][3] * v[i][3]; }
            ss = wave_sum_dpp(ss);
            const float rs = rsqrtf(ss * (1.0f / DM) + 1e-6f);
            if ((lane & 15) == rr) my_rs = rs;
#pragma unroll
            for (int i = 0; i < 4; ++i) {
                const f32x4 g = *(const f32x4*)(gain + i * 256 + lane * 4);
                store_bf4(c.H + ro + i * 256 + lane * 4, (f32x4){v[i][0] * rs * g[0], v[i][1] * rs * g[1], v[i][2] * rs * g[2], v[i][3] * rs * g[3]});
            }
        }
        f32x4 acc0 = (f32x4){0.f, 0.f, 0.f, 0.f}, acc1 = acc0, acc2 = acc0;
        const float* xr = c.out + (size_t)(r0 + (lane & 15)) * DM + 4 * (lane >> 4);
        const int cl = lane & 15;
#pragma unroll 2
        for (int kb = 0; kb < 64; ++kb) {
            const f32x4 xa = *(const f32x4*)(xr + kb * 16);
            const f32x4 ga = *(const f32x4*)(gain + kb * 16 + 4 * (lane >> 4));
            const int k0 = kb * 16 + 4 * (lane >> 4);
            float b0[4], b1[4], b2[4];
#pragma unroll
            for (int m = 0; m < 4; ++m) { b0[m] = wre[(size_t)(k0 + m) * 32 + cl]; b1[m] = wre[(size_t)(k0 + m) * 32 + 16 + cl]; b2[m] = (cl < 4) ? wrg[(size_t)(k0 + m) * 4 + cl] : 0.f; }
#pragma unroll
            for (int m = 0; m < 4; ++m) {
                const float am = xa[m] * ga[m] * my_rs;
                acc0 = __builtin_amdgcn_mfma_f32_16x16x4f32(am, b0[m], acc0, 0, 0, 0);
                acc1 = __builtin_amdgcn_mfma_f32_16x16x4f32(am, b1[m], acc1, 0, 0, 0);
                acc2 = __builtin_amdgcn_mfma_f32_16x16x4f32(am, b2[m], acc2, 0, 0, 0);
            }
        }
        LDS_WAVE_SYNC();
#pragma unroll
        for (int i = 0; i < 4; ++i) { const int row = 4 * (lane >> 4) + i; lg[row * 48 + cl] = acc0[i]; lg[row * 48 + 16 + cl] = acc1[i]; lg[row * 48 + 32 + cl] = acc2[i]; }
        LDS_WAVE_SYNC();
        if (lane < 16) {
            const float* L = lg + lane * 48;
            float lgp[4];
#pragma unroll
            for (int o = 0; o < 4; ++o) lgp[o] = L[32 + o] + brg[o];
            int grp = 0; float gm = lgp[0];
#pragma unroll
            for (int o = 1; o < 4; ++o) if (lgp[o] > gm) { gm = lgp[o]; grp = o; }
            float gs = 0.f;
#pragma unroll
            for (int o = 0; o < 4; ++o) gs += __expf(lgp[o] - gm);
            const float ptop = 1.0f / gs;
            int i0 = 0; float v0 = -INFINITY; int i1 = 0; float v1 = -INFINITY;
            for (int o = 0; o < 8; ++o) { const float le = L[grp * 8 + o] + bre[grp * 8 + o]; if (le > v0) { v1 = v0; i1 = i0; v0 = le; i0 = o; } else if (le > v1) { v1 = le; i1 = o; } }
            const float e1 = __expf(v1 - v0), inv = 1.0f / (1.0f + e1);
            int* rt_ = c.ROUTE + (size_t)(r0 + lane) * 8;
            const int ex0 = grp * 8 + i0, ex1 = grp * 8 + i1;
            const float w0_ = inv * ptop, w1_ = e1 * inv * ptop;
            const int q0 = (int)atomicAdd(cnt + ex0, 1u), q1 = (int)atomicAdd(cnt + ex1, 1u);
            rt_[0] = ex0; rt_[1] = ex1; ((float*)rt_)[2] = w0_; ((float*)rt_)[3] = w1_; rt_[4] = q0; rt_[5] = q1;
            int* e0p = c.ENT + ((size_t)ex0 * NT + q0) * 2; e0p[0] = r0 + lane; ((float*)e0p)[1] = w0_;
            int* e1p = c.ENT + ((size_t)ex1 * NT + q1) * 2; e1p[0] = r0 + lane; ((float*)e1p)[1] = w1_;
        }
    }
}
DI void moe_tables(const Ctx& c, int* soff, int* stile, int ncol) {
    const unsigned* cnt = c.ctl + CW_CNT + c.l * 32;
    __syncthreads();
    if (TID() == 0) { int s = 0, tt = 0; for (int e = 0; e < 32; ++e) { soff[e] = s; stile[e] = tt; s += (int)cnt[e]; tt += (((int)cnt[e] + 255) >> 8) * ncol; } soff[32] = s; stile[32] = tt; }
    __syncthreads();
}
DI void phase_moe_up(const Ctx& c, unsigned char* lds) {
    int* soff = (int*)(lds + 2 * G_STAGE); int* stile = soff + 64;
    moe_tables(c, soff, stile, 2);
    const int total = stile[32];
    for (int item = blockIdx.x; item < total; item += gridDim.x) {
        int e = 0;
        for (int q = 1; q < 32; ++q) if (stile[q] <= item) e = q;
        const int loc = item - stile[e], tm = loc >> 1, tn = loc & 1, n0 = tn * 128;
        const int p0 = soff[e] + tm * 256, pend = soff[e + 1];
        ARows ar; ar.mu = nullptr; ar.ltype = 0; ar.first = 0;
#pragma unroll
        for (int i = 0; i < 4; ++i) { const int pr = p0 + (TID() >> 3) + 64 * i; ar.p[i] = (pr < pend) ? c.H + (size_t)c.ENT[((size_t)e * NT + (pr - soff[e])) * 2] * DM : nullptr; }
        {
            f32x4 ag[4][4]; acc_zero(ag);
            gemm_core<0>(ag, ar, (const bf16_t*)(c.ws + WS_EG) + ((size_t)e * 256 + n0) * DM, DM, DM, lds);
            ACC_FOREACH(ag, { if (p0 + r_ < pend) store_bf4(c.HID + (size_t)(p0 + r_) * 256 + n0 + c_, (f32x4){v_[0] * sigmoidf_(v_[0]), v_[1] * sigmoidf_(v_[1]), v_[2] * sigmoidf_(v_[2]), v_[3] * sigmoidf_(v_[3])}); });
        }
        f32x4 au[4][4]; acc_zero(au);
        gemm_core<0>(au, ar, (const bf16_t*)(c.ws + WS_EU) + ((size_t)e * 256 + n0) * DM, DM, DM, lds);
        ACC_FOREACH(au, { if (p0 + r_ < pend) { bf16_t* q = c.HID + (size_t)(p0 + r_) * 256 + n0 + c_; const u32x2 sv = *(const u32x2*)q;
            store_bf4(q, (f32x4){bflo(sv.x) * v_[0], bfhi(sv.x) * v_[1], bflo(sv.y) * v_[2], bfhi(sv.y) * v_[3]}); } });
    }
}
DI void phase_moe_down(const Ctx& c, unsigned char* lds) {
    int* soff = (int*)(lds + 2 * G_STAGE); int* stile = soff + 64;
    moe_tables(c, soff, stile, 8);
    const int total = stile[32];
    for (int item = blockIdx.x; item < total; item += gridDim.x) {
        int e = 0;
        for (int q = 1; q < 32; ++q) if (stile[q] <= item) e = q;
        const int loc = item - stile[e], tm = loc >> 3, tn = loc & 7, n0 = tn * 128;
        const int p0 = soff[e] + tm * 256, pend = soff[e + 1];
        ARows ar; ar.mu = nullptr; ar.ltype = 0; ar.first = 0;
#pragma unroll
        for (int i = 0; i < 4; ++i) { const int pr = p0 + (TID() >> 3) + 64 * i; ar.p[i] = (pr < pend) ? c.HID + (size_t)pr * 256 : nullptr; }
        f32x4 acc[4][4]; acc_zero(acc);
        gemm_core<0>(acc, ar, (const bf16_t*)(c.ws + WS_ED) + ((size_t)e * DM + n0) * 256, 256, 256, lds);
        ACC_FOREACH(acc, { if (p0 + r_ < pend) { const float w = ((const float*)c.ENT)[((size_t)e * NT + (p0 + r_ - soff[e])) * 2 + 1];
            store_bf4(c.Y + (size_t)(p0 + r_) * DM + n0 + c_, (f32x4){v_[0] * w, v_[1] * w, v_[2] * w, v_[3] * w}); } });
    }
}
DI void phase_final(const Ctx& c, unsigned char* lds) {
    const int tid = TID(), lane = tid & 63, wave = tid >> 6;
    const float* gain = c.in(I_NFIN);
    int* soff = (int*)(lds + 65536);
    moe_offsets(c, DEPTH - 1, soff);
    for (int row = blockIdx.x * 8 + wave; row < NT; row += gridDim.x * 8) {
        f32x4 v[4];
#pragma unroll
        for (int i = 0; i < 4; ++i) v[i] = *(const f32x4*)(c.out + (size_t)row * DM + i * 256 + lane * 4);
        add_moe_rows(c, row, lane, v, soff);
        float ss = 0.f;
#pragma unroll
        for (int i = 0; i < 4; ++i) ss += v[i][0] * v[i][0] + v[i][1] * v[i][1] + v[i][2] * v[i][2] + v[i][3] * v[i][3];
        ss = wave_sum_dpp(ss);
        const float rs = rsqrtf(ss * (1.0f / DM) + 1e-6f);
#pragma unroll
        for (int i = 0; i < 4; ++i) {
            const f32x4 g = *(const f32x4*)(gain + i * 256 + lane * 4);
            *(f32x4*)(c.out + (size_t)row * DM + i * 256 + lane * 4) = (f32x4){v[i][0] * rs * g[0], v[i][1] * rs * g[1], v[i][2] * rs * g[2], v[i][3] * rs * g[3]};
        }
    }
}

constexpr int PH_PER_LAYER = 11, N_PHASES = DEPTH * PH_PER_LAYER + 1;
__global__ void __launch_bounds__(NTHREADS, 2) fwd_kernel(Params P) {
    extern __shared__ __attribute__((aligned(16))) unsigned char lds[];
    const int lo = P.ph_lo, hi = P.ph_hi;
    LAS unsigned* xbw = (LAS unsigned*)(lds + LDS_BYTES - 16);
    if (threadIdx.x == 0) { xbw[0] = 0u; xbw[1] = 0u; xbw[2] = 0u; xbw[3] = 0u; }
    __syncthreads();
    Ctx c; c.P = &P; c.ws = P.ws; c.out = P.out; c.l = 0;
    c.ctl = (unsigned*)(P.ws + WS_CTL);
    c.H = (bf16_t*)(P.ws + WS_H); c.PROJ = (bf16_t*)(P.ws + WS_PROJ); c.F = (bf16_t*)(P.ws + WS_F); c.POOLED = (bf16_t*)(P.ws + WS_POOLED);
    c.MERGED = (bf16_t*)(P.ws + WS_F); c.CMPH = (bf16_t*)(P.ws + WS_CMPH); c.CMPO = (float*)(P.ws + WS_CMPO); c.POSB = (float*)(P.ws + WS_POSB);
    c.ROUTE = (int*)(P.ws + WS_ROUTE); c.ENT = (int*)(P.ws + WS_ENT); c.HID = (bf16_t*)(P.ws + WS_HID); c.Y = (bf16_t*)(P.ws + WS_Y);
    c.VT = (bf16_t*)(P.ws + WS_VT); c.KC = (bf16_t*)(P.ws + WS_KC); c.VCT = (bf16_t*)(P.ws + WS_VCT); c.YRAW = (bf16_t*)(P.ws + WS_YRAW); c.BON = (float*)(P.ws + WS_BON);
    XcdBarrier bar; bar.bar = c.ctl + CW_BAR; bar.x = 0; bar.st = (volatile LAS unsigned*)xbw;
    if (hi - lo > 1) bar = xcd_barrier_post(c.ctl + CW_BAR, (volatile LAS unsigned*)xbw);
#define IN(k) (lo <= (k) && (k) < hi)
#define SEAM(k) do { if (IN(k) && IN((k) + 1)) xcd_barrier(bar); } while (0)
#pragma unroll 1
    for (int l = 0; l < DEPTH; ++l) {
        c.l = l; const int pb = l * PH_PER_LAYER;
        if (IN(pb + 0)) phase_norm1(c, lds);
        SEAM(pb + 0);
        if (IN(pb + 1)) phase_gemm1(c, lds);
        SEAM(pb + 1);
        if (IN(pb + 2)) phase_prep(c, lds);
        SEAM(pb + 2);
        if (IN(pb + 3)) phase_poolgemm(c, lds);
        SEAM(pb + 3);
        if (IN(pb + 4)) phase_mix(c, lds);
        SEAM(pb + 4);
        if (IN(pb + 5)) phase_rwkv_post(c, lds);
        SEAM(pb + 5);
        if (IN(pb + 6)) phase_merge(c, lds);
        SEAM(pb + 6);
        if (IN(pb + 7)) phase_outp(c, lds);
        SEAM(pb + 7);
        if (IN(pb + 8)) phase_norm2(c, lds);
        SEAM(pb + 8);
        if (IN(pb + 9)) phase_moe_up(c, lds);
        SEAM(pb + 9);
        if (IN(pb + 10)) phase_moe_down(c, lds);
        SEAM(pb + 10);
    }
    if (IN(N_PHASES - 1)) phase_final(c, lds);
}

#ifndef MK_N_LAUNCHES
#define MK_N_LAUNCHES 1
#endif
extern "C" void kernel_launch(void* const* d_in, const int* in_sizes, int n_in, void* d_out, int out_size, void* d_ws, size_t ws_size, hipStream_t stream) {
    static int grid = 0;
    if (grid == 0) {
        if (n_in != N_IN || out_size != NT * DM || ws_size < WS_END) { fprintf(stderr, "kernel_launch: unexpected shapes n_in %d out %d ws %zu (need %zu)\n", n_in, out_size, ws_size, (size_t)WS_END); grid = -1; return; }
        int dev = 0, cus = 0, per_cu = 0;
        if (hipGetDevice(&dev) != hipSuccess || hipDeviceGetAttribute(&cus, hipDeviceAttributeMultiprocessorCount, dev) != hipSuccess) { grid = -1; return; }
        if (hipFuncSetAttribute((const void*)fwd_kernel, hipFuncAttributeMaxDynamicSharedMemorySize, LDS_BYTES) != hipSuccess) { fprintf(stderr, "kernel_launch: hipFuncSetAttribute failed\n"); grid = -1; return; }
        if (hipOccupancyMaxActiveBlocksPerMultiprocessor(&per_cu, (const void*)fwd_kernel, NTHREADS, LDS_BYTES) != hipSuccess || per_cu < 1) { fprintf(stderr, "kernel_launch: occupancy query says %d\n", per_cu); }
        (void)hipGetLastError();
        grid = cus;
    }
    if (grid < 0) return;
    if (hipMemsetAsync((char*)d_ws + WS_CTL, 0, CTL_BYTES, stream) != hipSuccess) return;
    Params p{};
    for (int i = 0; i < N_IN; ++i) p.in[i] = (const float*)d_in[i];
    p.out = (float*)d_out; p.ws = (unsigned char*)d_ws;
    if (MK_N_LAUNCHES == 1) {
        p.ph_lo = 0; p.ph_hi = N_PHASES;
        hipLaunchKernelGGL(fwd_kernel, dim3(grid), dim3(NTHREADS), LDS_BYTES, stream, p);
    } else {
        for (int k = 0; k < N_PHASES; ++k) { p.ph_lo = k; p.ph_hi = k + 1; hipLaunchKernelGGL(fwd_kernel, dim3(grid), dim3(NTHREADS), LDS_BYTES, stream, p); }
    }
}
```

```cpp
#include <hip/hip_runtime.h>
#include <cstdio>
#include <cstdint>

#define DI __device__ __forceinline__
typedef unsigned short bf16_t;
typedef short bf16x8 __attribute__((ext_vector_type(8)));
typedef float f32x4 __attribute__((ext_vector_type(4)));
typedef unsigned u32x4 __attribute__((ext_vector_type(4)));
typedef unsigned u32x2 __attribute__((ext_vector_type(2)));

constexpr int NB = 4, SEQ = 4096, DM = 1024, NT = NB * SEQ, DEPTH = 2;
constexpr int IN_COLS = 4816;
constexpr int C_POOL = 0, C_RW = 512, C_R = 512, C_K = 1024, C_V = 1536, C_WD = 2048, C_AD = 2080, C_GD = 2112;
constexpr int C_Q = 2208, C_KC = 3232, C_VC = 3488, C_KS = 3744, C_VS = 4000, C_KW = 4256, C_VW = 4512, C_GATE = 4768;
constexpr int RWC = 1696;
constexpr int NCMP = 255;
constexpr int NTHREADS = 512;
constexpr int LDS_BYTES = 155648;

enum { I_X = 0, I_RELB, I_NMIX, I_WIN, I_POOLW, I_POOLS, I_MU, I_W0, I_WUP, I_A0, I_AUP, I_GUP, I_KK, I_KA, I_RK, I_GNW, I_GNB,
       I_CPK, I_CW1K, I_CW2K, I_CPV, I_CW1V, I_CW2V, I_WBR, I_WMG, I_BMG, I_WOUT, I_NFFN, I_WRG, I_BRG, I_WRE, I_BRE, I_EG, I_EU, I_ED, I_NFIN, N_IN };

constexpr size_t WS_CTL = 0;
constexpr size_t CTL_BYTES = 65536;
constexpr size_t WS_H = CTL_BYTES;
constexpr size_t WS_PROJ = WS_H + (size_t)NT * DM * 2;
constexpr size_t WS_F = WS_PROJ + (size_t)NT * IN_COLS * 2;
constexpr size_t PLANE = (size_t)NT * 512 * 2;
constexpr size_t WS_POOLED = WS_F + 6 * PLANE;
constexpr size_t WS_CMPH = WS_POOLED + PLANE;
constexpr size_t WS_CMPO = WS_CMPH + (size_t)2 * 4096 * 256 * 2;
constexpr size_t WS_POSB = WS_CMPO + (size_t)2 * 4096 * 64 * 4;
constexpr size_t WS_ROUTE = WS_POSB + 4096;
constexpr size_t WS_ENT = WS_ROUTE + (size_t)NT * 32;
constexpr size_t WS_VT = WS_ENT + (size_t)32 * NT * 8;
constexpr size_t WS_KC = WS_VT + (size_t)2 * 16 * 64 * SEQ * 2;
constexpr size_t WS_VCT = WS_KC + (size_t)16 * 256 * 64 * 2;
constexpr size_t WS_YRAW = WS_VCT + (size_t)16 * 64 * 256 * 2;
constexpr size_t WS_BON = WS_YRAW + (size_t)NT * 512 * 2;
constexpr size_t WS_SMALLW = WS_BON + (size_t)NT * 8 * 16;
constexpr size_t WS_WT_LORA = WS_SMALLW + 262144;
constexpr size_t WS_END = WS_WT_LORA + (size_t)1536 * 128 * 2;
constexpr size_t WS_WT_IN = WS_F;
constexpr size_t WS_WT_C1 = WS_CMPO;
constexpr size_t WS_WT_C2 = WS_SMALLW;
constexpr size_t WS_WT_POOL = WS_SMALLW + 131072;
constexpr size_t WS_WT_MG = WS_VT;
constexpr size_t WS_WT_BR = WS_VT + (size_t)3072 * 1024 * 2;
constexpr size_t WS_WT_OUT = WS_CMPH;
constexpr size_t WS_EG = WS_F + 2 * PLANE;
constexpr size_t WS_EU = WS_EG + (size_t)32 * 256 * 1024 * 2;
constexpr size_t WS_ED = WS_EU + (size_t)32 * 256 * 1024 * 2;
static_assert(WS_ED + (size_t)32 * 1024 * 256 * 2 <= WS_F + 6 * PLANE, "expert alias");
static_assert(WS_WT_BR + (size_t)2048 * 1024 * 2 <= WS_VT + (size_t)2 * 16 * 64 * SEQ * 2, "merge alias");
static_assert((size_t)4864 * 1024 * 2 <= 6 * PLANE, "w_in alias");
constexpr size_t WS_HID = WS_PROJ;
constexpr size_t WS_Y = WS_PROJ + (size_t)2 * NT * 256 * 2;
static_assert(WS_Y + (size_t)2 * NT * 1024 * 2 <= WS_F, "alias");
constexpr int CW_BAR = 0;
constexpr int CW_CNT = 4096;
constexpr int CW_CUR = 4096 + 64;
constexpr int CW_Q = 4096 + 128;

#define XB_TMO      128
#define XB_XCNT(j)  (256  + 64 * (j))
#define XB_XSUB(j)  (1280 + 64 * (j))
#define XB_XGEN(j)  (2304 + 64 * (j))
#define XB_TOP      3328
#define XB_TOPGEN   3392
#define XCD_BAR_WORDS 3456
#define XB_SPIN_CAP (1u << 18)
#define LAS __attribute__((address_space(3)))

__device__ __forceinline__ unsigned xb_ld(unsigned* p)              { return __hip_atomic_load(p, __ATOMIC_RELAXED, __HIP_MEMORY_SCOPE_AGENT); }
__device__ __forceinline__ unsigned xb_add(unsigned* p, unsigned v) { return __hip_atomic_fetch_add(p, v, __ATOMIC_RELAXED, __HIP_MEMORY_SCOPE_AGENT); }
__device__ __forceinline__ unsigned xb_xcc_id() { return (unsigned)__builtin_amdgcn_s_getreg((3 << 11) | 20) & 0xFu; }
#define XB_SPIN(cond, bar) do { unsigned _sp = 0; while (cond) { __builtin_amdgcn_s_sleep(1); \
    if ((++_sp & 255u) == 0u) { if (xb_ld(&(bar)[XB_TMO])) break; if (_sp > XB_SPIN_CAP) { atomicAdd(&(bar)[XB_TMO], 1u); break; } } } } while (0)

struct XcdBarrier { unsigned* bar; unsigned x; volatile LAS unsigned* st; };

__device__ __forceinline__ XcdBarrier xcd_barrier_post(unsigned* bar, volatile LAS unsigned* st) {
    XcdBarrier b; b.bar = bar; b.x = xb_xcc_id(); b.st = st;
    if (threadIdx.x == 0) (void)xb_add(&bar[XB_XCNT(b.x)], 1u);
    return b;
}
__device__ __forceinline__ void xcd_barrier_complete(unsigned* bar, unsigned x, unsigned& nloc, unsigned& nx) {
    const unsigned G = gridDim.x * gridDim.y * gridDim.z;
    unsigned sum, cnt, mine, sp = 0u;
    for (;;) {
        sum = 0u; cnt = 0u; mine = 0u;
#pragma unroll
        for (unsigned j = 0; j < 16; ++j) { const unsigned c = xb_ld(&bar[XB_XCNT(j)]); sum += c; cnt += (c > 0u) ? 1u : 0u; mine = (j == x) ? c : mine; }
        if (sum == G) break;
        __builtin_amdgcn_s_sleep(1);
        if ((++sp & 255u) == 0u) { if (xb_ld(&bar[XB_TMO])) break; if (sp > XB_SPIN_CAP) { atomicAdd(&bar[XB_TMO], 1u); break; } }
    }
    nloc = mine > 0u ? mine : 1u; nx = cnt > 0u ? cnt : 1u;
}
__device__ __forceinline__ void xcd_barrier(const XcdBarrier& b) {
    asm volatile("s_waitcnt vmcnt(0)" ::: "memory");
    __syncthreads();
    if (threadIdx.x == 0) {
        unsigned* bar = b.bar;
        __builtin_amdgcn_s_waitcnt(0);
        unsigned nloc = b.st[0], nx = b.st[1];
        if (nloc == 0u) { xcd_barrier_complete(bar, b.x, nloc, nx); b.st[0] = nloc; b.st[1] = nx; }
        const unsigned old = xb_add(&bar[XB_XSUB(b.x)], 1u);
        const unsigned gen = old / nloc;
        if (old + 1u == (gen + 1u) * nloc) {
            __builtin_amdgcn_fence(__ATOMIC_RELEASE, "agent");
            asm volatile("s_waitcnt vmcnt(0)" ::: "memory");
            const unsigned og = xb_add(&bar[XB_TOP], 1u);
            const unsigned tg = og / nx;
            if (og + 1u == (tg + 1u) * nx) xb_add(&bar[XB_TOPGEN], 1u);
            else XB_SPIN(xb_ld(&bar[XB_TOPGEN]) == tg, bar);
            __builtin_amdgcn_fence(__ATOMIC_ACQUIRE, "agent");
            xb_add(&bar[XB_XGEN(b.x)], 1u);
            asm volatile("s_waitcnt vmcnt(0)" ::: "memory");
        } else {
            XB_SPIN(xb_ld(&bar[XB_XGEN(b.x)]) == gen, bar);
            __builtin_amdgcn_fence(__ATOMIC_ACQUIRE, "agent");
            asm volatile("s_waitcnt vmcnt(0)" ::: "memory");
        }
    }
    __syncthreads();
}

DI bf16_t f2bf(float x) { unsigned u = __float_as_uint(x); u += 0x7fffu + ((u >> 16) & 1u); return (bf16_t)(u >> 16); }
DI float bf2f(bf16_t b) { return __uint_as_float((unsigned)b << 16); }
typedef __bf16 bf16v2_t __attribute__((ext_vector_type(2)));
typedef float f32v2_t __attribute__((ext_vector_type(2)));
DI unsigned pack2(float lo, float hi) { const f32v2_t v = {lo, hi}; const bf16v2_t b = __builtin_convertvector(v, bf16v2_t); return __builtin_bit_cast(unsigned, b); }
DI float bflo(unsigned w) { return __uint_as_float(w << 16); }
DI float bfhi(unsigned w) { return __uint_as_float(w & 0xffff0000u); }
DI float wave_sum(float v) {
#pragma unroll
    for (int o = 32; o >= 1; o >>= 1) v += __shfl_xor(v, o);
    return v;
}
DI float wave_max(float v) {
#pragma unroll
    for (int o = 32; o >= 1; o >>= 1) v = fmaxf(v, __shfl_xor(v, o));
    return v;
}
DI float sigmoidf_(float x) { return __builtin_amdgcn_rcpf(1.0f + __expf(-x)); }
DI int TID() { int t = threadIdx.x; asm volatile("" : "+v"(t)); return t; }
#define LDS_WAVE_SYNC() asm volatile("s_waitcnt lgkmcnt(0)" ::: "memory")

#define DPP_MOV(v, ctrl) __builtin_bit_cast(float, __builtin_amdgcn_update_dpp(0, __builtin_bit_cast(int, (v)), (ctrl), 0xF, 0xF, true))
DI float wave_sum_dpp(float v) {
    v += DPP_MOV(v, 0xB1); v += DPP_MOV(v, 0x4E); v += DPP_MOV(v, 0x141); v += DPP_MOV(v, 0x140);
    return __builtin_bit_cast(float, __builtin_amdgcn_readlane(__builtin_bit_cast(int, v), 0)) + __builtin_bit_cast(float, __builtin_amdgcn_readlane(__builtin_bit_cast(int, v), 16)) +
        (__builtin_bit_cast(float, __builtin_amdgcn_readlane(__builtin_bit_cast(int, v), 32)) + __builtin_bit_cast(float, __builtin_amdgcn_readlane(__builtin_bit_cast(int, v), 48)));
}
struct Params { const float* in[N_IN]; float* out; unsigned char* ws; int ph_lo, ph_hi; };

DI int t5_bucket(int n) {
    if (n < 16) return n;
    if (n >= 128) return 31;
    int b = 16;
    b += (n >= 19) + (n >= 21) + (n >= 24) + (n >= 27) + (n >= 31) + (n >= 35) + (n >= 40) + (n >= 46) + (n >= 52) + (n >= 59) + (n >= 67) + (n >= 77) + (n >= 87) + (n >= 99) + (n >= 113);
    return b;
}

constexpr int G_A = 0, G_B = 256 * 64 * 2, G_STAGE = (256 + 128) * 64 * 2;
static_assert(2 * G_STAGE <= LDS_BYTES - 64, "gemm lds");
DI int g_off(int r, int c) { return ((r >> 4) * 2 + (c >> 5)) * 1024 + ((((r & 15) * 64) + (c & 31) * 2) ^ ((((r & 15) >> 3) & 1) << 5)); }
struct ARows { const bf16_t* p[4]; const float* mu; int ltype; int first; };
DI float tanhf_fast(float x) { const float e = __expf(2.0f * x); return 1.0f - 2.0f * __builtin_amdgcn_rcpf(e + 1.0f); }
DI u32x4 lora_chunk(const bf16_t* prow, bool first, const float* mu, int ltype, int k) {
    const int lim = (ltype == 2) ? 96 : 32;
    if (k >= lim) return (u32x4){0u, 0u, 0u, 0u};
    const int col = C_WD + ltype * 32 + k;
    const u32x4 cu = *(const u32x4*)(prow + col);
    u32x4 pu = (u32x4){0u, 0u, 0u, 0u};
    if (!first) pu = *(const u32x4*)(prow - IN_COLS + col);
    const f32x4 m0 = *(const f32x4*)(mu + col - C_RW), m1 = *(const f32x4*)(mu + col - C_RW + 4);
    float u[8] = {bflo(cu.x), bfhi(cu.x), bflo(cu.y), bfhi(cu.y), bflo(cu.z), bfhi(cu.z), bflo(cu.w), bfhi(cu.w)};
    const float p[8] = {bflo(pu.x), bfhi(pu.x), bflo(pu.y), bfhi(pu.y), bflo(pu.z), bfhi(pu.z), bflo(pu.w), bfhi(pu.w)};
    const float mm[8] = {m0[0], m0[1], m0[2], m0[3], m1[0], m1[1], m1[2], m1[3]};
#pragma unroll
    for (int j = 0; j < 8; ++j) { const float us = u[j] + (p[j] - u[j]) * mm[j]; u[j] = (ltype == 0) ? tanhf_fast(us) : ((ltype == 1) ? us : __builtin_amdgcn_rcpf(1.0f + __expf(-us))); }
    u32x4 w; w.x = pack2(u[0], u[1]); w.y = pack2(u[2], u[3]); w.z = pack2(u[4], u[5]); w.w = pack2(u[6], u[7]);
    return w;
}
template <int AMODE>
DI void g_load(u32x4 (&ra)[4], u32x4 (&rb)[2], const ARows& ar, const bf16_t* bt, int ldb, int k0, int tid) {
    const int kseg = (tid & 7) * 8;
#pragma unroll
    for (int i = 0; i < 4; ++i) {
        ra[i] = (u32x4){0u, 0u, 0u, 0u};
        if (AMODE == 2) ra[i] = lora_chunk(ar.p[i], (ar.first >> i) & 1, ar.mu, ar.ltype, k0 + kseg);
        else if (ar.p[i] != nullptr) ra[i] = *(const u32x4*)((AMODE == 0) ? (ar.p[i] + k0 + kseg) : (ar.p[i] + (size_t)(k0 >> 6) * IN_COLS + kseg));
    }
#pragma unroll
    for (int i = 0; i < 2; ++i) rb[i] = *(const u32x4*)(bt + (size_t)((tid >> 3) + 64 * i) * ldb + k0 + kseg);
}
DI void g_store(unsigned char* st, const u32x4 (&ra)[4], const u32x4 (&rb)[2], int tid) {
    const int off = g_off(tid >> 3, (tid & 7) * 8);
#pragma unroll
    for (int i = 0; i < 4; ++i) *(u32x4*)(st + G_A + off + i * 8192) = ra[i];
#pragma unroll
    for (int i = 0; i < 2; ++i) *(u32x4*)(st + G_B + off + i * 8192) = rb[i];
}
DI void g_compute(f32x4 (&acc)[4][4], const unsigned char* st, int lane, int wm, int wn) {
    const int lo = ((lane & 15) * 64 + (lane >> 4) * 16) ^ ((((lane & 15) >> 3) & 1) << 5);
    const unsigned char* sA = st + G_A + wm * 8192 + lo;
    const unsigned char* sB = st + G_B + wn * 8192 + lo;
    bf16x8 bcur[4], bnxt[4], a0, a1, a2;
#pragma unroll
    for (int i = 0; i < 4; ++i) bcur[i] = *(const bf16x8*)(sB + i * 2048);
    a0 = *(const bf16x8*)(sA);
    a1 = *(const bf16x8*)(sA + 2048);
#define G_AFRAG(s) (*(const bf16x8*)(sA + ((s) & 3) * 2048 + ((s) >> 2) * 1024))
#define G_GROUP(s, acur, anew) do { \
        if ((s) + 2 < 8) anew = G_AFRAG((s) + 2); \
        if ((s) < 4) bnxt[(s) & 3] = *(const bf16x8*)(sB + ((s) & 3) * 2048 + 1024); \
        __builtin_amdgcn_sched_barrier(0); \
        _Pragma("unroll") for (int ni = 0; ni < 4; ++ni) acc[(s) & 3][ni] = __builtin_amdgcn_mfma_f32_16x16x32_bf16(((s) < 4 ? bcur[ni] : bnxt[ni]), acur, acc[(s) & 3][ni], 0, 0, 0); \
        __builtin_amdgcn_sched_barrier(0); } while (0)
    G_GROUP(0, a0, a2); G_GROUP(1, a1, a0); G_GROUP(2, a2, a1); G_GROUP(3, a0, a2);
    G_GROUP(4, a1, a0); G_GROUP(5, a2, a1); G_GROUP(6, a0, a2); G_GROUP(7, a1, a0);
#undef G_GROUP
#undef G_AFRAG
}
#define LDS_BARRIER() do { asm volatile("s_waitcnt lgkmcnt(0)" ::: "memory"); __builtin_amdgcn_s_barrier(); asm volatile("" ::: "memory"); } while (0)
template <int AMODE>
DI void gemm_core(f32x4 (&acc)[4][4], const ARows& ar, const bf16_t* bt  , int ldb, int K, unsigned char* lds) {
    const int tid = TID(), lane = tid & 63, wave = tid >> 6, wm = wave >> 1, wn = wave & 1;
    const int nk = K >> 6;
    unsigned char* s0 = lds; unsigned char* s1 = lds + G_STAGE;
    u32x4 ra0[4], rb0[2], ra1[4], rb1[2];
    g_load<AMODE>(ra0, rb0, ar, bt, ldb, 0, tid);
    g_load<AMODE>(ra1, rb1, ar, bt, ldb, 64, tid);
    __syncthreads();
    g_store(s0, ra0, rb0, tid);
    g_load<AMODE>(ra0, rb0, ar, bt, ldb, (nk > 2 ? 2 : nk - 1) * 64, tid);
    LDS_BARRIER();
    for (int kt = 0; kt < nk; kt += 2) {
        g_store(s1, ra1, rb1, tid);
        { const int kn = (kt + 3 < nk) ? kt + 3 : nk - 1; g_load<AMODE>(ra1, rb1, ar, bt, ldb, kn * 64, tid); }
        g_compute(acc, s0, lane, wm, wn);
        LDS_BARRIER();
        g_store(s0, ra0, rb0, tid);
        { const int kn = (kt + 4 < nk) ? kt + 4 : nk - 1; g_load<AMODE>(ra0, rb0, ar, bt, ldb, kn * 64, tid); }
        g_compute(acc, s1, lane, wm, wn);
        LDS_BARRIER();
    }
}
static_assert(3 * G_STAGE <= LDS_BYTES - 64, "dma ring");
DI void gemm_core_dma(f32x4 (&acc)[4][4], const bf16_t* A, size_t lda, const bf16_t* bt, size_t ldb, int K, unsigned char* lds) {
    const int tid = TID(), lane = tid & 63, wave = __builtin_amdgcn_readfirstlane(tid >> 6), wm = wave >> 1, wn = wave & 1;
    const int nk = K >> 6;
    const int srow = lane >> 2, skof = ((lane & 3) * 8) ^ ((lane >> 5) << 4);
    const char* gp[6]; int loff[6];
#pragma unroll
    for (int j = 0; j < 6; ++j) {
        const int sid = wave * 6 + j;
        if (sid < 32) { gp[j] = (const char*)(A + (size_t)((sid >> 1) * 16 + srow) * lda + (sid & 1) * 32 + skof); loff[j] = G_A + sid * 1024; }
        else { const int s2 = sid - 32; gp[j] = (const char*)(bt + (size_t)((s2 >> 1) * 16 + srow) * ldb + (s2 & 1) * 32 + skof); loff[j] = G_B + s2 * 1024; }
    }
#define DMA_ISSUE(kt_, st_) do { const int _k = ((kt_) < nk ? (kt_) : nk - 1) * 128; \
        _Pragma("unroll") for (int j = 0; j < 6; ++j) __builtin_amdgcn_global_load_lds((const unsigned*)(gp[j] + _k), (LAS unsigned*)(lds + (st_) * G_STAGE + loff[j]), 16, 0, 0); } while (0)
    asm volatile("s_waitcnt vmcnt(0)" ::: "memory");
    __syncthreads();
    DMA_ISSUE(0, 0); DMA_ISSUE(1, 1);
    int st = 0;
    for (int kt = 0; kt < nk; ++kt) {
        asm volatile("s_waitcnt vmcnt(6)" ::: "memory");
        __builtin_amdgcn_s_barrier();
        asm volatile("" ::: "memory");
        const int sn = (st == 0) ? 2 : st - 1;
        DMA_ISSUE(kt + 2, sn);
        g_compute(acc, lds + st * G_STAGE, lane, wm, wn);
        st = (st == 2) ? 0 : st + 1;
    }
    asm volatile("s_waitcnt vmcnt(0)" ::: "memory");
    __syncthreads();
#undef DMA_ISSUE
}
DI void store_bf4(bf16_t* p, f32x4 v) { u32x2 w; w.x = pack2(v[0], v[1]); w.y = pack2(v[2], v[3]); *(u32x2*)p = w; }
constexpr int H_A = 0, H_B = 256 * 64 * 2, H_STAGE = 2 * 256 * 64 * 2;
static_assert(2 * H_STAGE <= LDS_BYTES - 64, "gemm256 lds");
DI void h_compute(f32x4 (&acc)[8][4], const unsigned char* st, int lane, int wm, int wn) {
    const int lo = ((lane & 15) * 64 + (lane >> 4) * 16) ^ ((((lane & 15) >> 3) & 1) << 5);
    const unsigned char* sA = st + H_A + wm * 16384 + lo;
    const unsigned char* sB = st + H_B + wn * 8192 + lo;
#pragma unroll
    for (int ks = 0; ks < 2; ++ks) {
        bf16x8 bf[4], a0, a1, a2;
#pragma unroll
        for (int i = 0; i < 4; ++i) bf[i] = *(const bf16x8*)(sB + i * 2048 + ks * 1024);
        a0 = *(const bf16x8*)(sA + ks * 1024);
        a1 = *(const bf16x8*)(sA + 2048 + ks * 1024);
#define H_GROUP(s, acur, anew) do { \
        if ((s) + 2 < 8) anew = *(const bf16x8*)(sA + ((s) + 2) * 2048 + ks * 1024); \
        __builtin_amdgcn_sched_barrier(0); \
        _Pragma("unroll") for (int ni = 0; ni < 4; ++ni) acc[(s)][ni] = __builtin_amdgcn_mfma_f32_16x16x32_bf16(bf[ni], acur, acc[(s)][ni], 0, 0, 0); \
        __builtin_amdgcn_sched_barrier(0); } while (0)
        H_GROUP(0, a0, a2); H_GROUP(1, a1, a0); H_GROUP(2, a2, a1); H_GROUP(3, a0, a2);
        H_GROUP(4, a1, a0); H_GROUP(5, a2, a1); H_GROUP(6, a0, a2); H_GROUP(7, a1, a0);
#undef H_GROUP
    }
}
DI void gemm256_dma(f32x4 (&acc)[8][4], const bf16_t* A, size_t lda, const bf16_t* bt, size_t ldb, int K, unsigned char* lds) {
    const int tid = TID(), lane = tid & 63, wave = __builtin_amdgcn_readfirstlane(tid >> 6), wm = wave >> 2, wn = wave & 3;
    const int nk = K >> 6;
    const int srow = lane >> 2, skof = ((lane & 3) * 8) ^ ((lane >> 5) << 4);
    const char* gp[8]; int loff[8];
#pragma unroll
    for (int j = 0; j < 8; ++j) {
        const int sid = wave * 8 + j;
        if (sid < 32) { gp[j] = (const char*)(A + (size_t)((sid >> 1) * 16 + srow) * lda + (sid & 1) * 32 + skof); loff[j] = H_A + sid * 1024; }
        else { const int s2 = sid - 32; gp[j] = (const char*)(bt + (size_t)((s2 >> 1) * 16 + srow) * ldb + (s2 & 1) * 32 + skof); loff[j] = H_B + s2 * 1024; }
    }
#define H_ISSUE(kt_, st_) do { const int _k = ((kt_) < nk ? (kt_) : nk - 1) * 128; \
        _Pragma("unroll") for (int j = 0; j < 8; ++j) __builtin_amdgcn_global_load_lds((const unsigned*)(gp[j] + _k), (LAS unsigned*)(lds + (st_) * H_STAGE + loff[j]), 16, 0, 0); } while (0)
    asm volatile("s_waitcnt vmcnt(0)" ::: "memory");
    __syncthreads();
    H_ISSUE(0, 0);
    for (int kt = 0; kt < nk; ++kt) {
        asm volatile("s_waitcnt vmcnt(0)" ::: "memory");
        __builtin_amdgcn_s_barrier();
        asm volatile("" ::: "memory");
        H_ISSUE(kt + 1, (kt + 1) & 1);
        h_compute(acc, lds + (kt & 1) * H_STAGE, lane, wm, wn);
    }
    asm volatile("s_waitcnt vmcnt(0)" ::: "memory");
    __syncthreads();
#undef H_ISSUE
}
DI void tile256_store_bf16(f32x4 (&acc)[8][4], bf16_t* out, size_t ld, int ncols, unsigned char* lds) {
    bf16_t* T = (bf16_t*)lds;
    const int tid = TID(), lane = tid & 63, wave = tid >> 6, wm = wave >> 2, wn = wave & 3;
    __syncthreads();
#pragma unroll
    for (int mi = 0; mi < 8; ++mi)
#pragma unroll
        for (int ni = 0; ni < 4; ++ni) store_bf4(T + (wm * 128 + mi * 16 + (lane & 15)) * 264 + wn * 64 + ni * 16 + (lane >> 4) * 4, acc[mi][ni]);
    __syncthreads();
#pragma unroll
    for (int i = 0; i < 16; ++i) {
        const int ch = tid + i * NTHREADS, r = ch >> 5, cc = (ch & 31) * 8;
        if (cc < ncols) *(u32x4*)(out + (size_t)r * ld + cc) = *(const u32x4*)(T + r * 264 + cc);
    }
}
DI void acc_zero(f32x4 (&acc)[4][4]) {
#pragma unroll
    for (int i = 0; i < 4; ++i)
#pragma unroll
        for (int j = 0; j < 4; ++j) acc[i][j] = (f32x4){0.f, 0.f, 0.f, 0.f};
}
#define ACC_FOREACH(acc, body) do { const int _l = TID() & 63, _w = TID() >> 6; \
    _Pragma("unroll") for (int _mi = 0; _mi < 4; ++_mi) _Pragma("unroll") for (int _ni = 0; _ni < 4; ++_ni) { \
        const int r_ = (_w >> 1) * 64 + _mi * 16 + (_l & 15), c_ = (_w & 1) * 64 + _ni * 16 + (_l >> 4) * 4; f32x4& v_ = acc[_mi][_ni]; body } } while (0)
DI ARows plain_rows(const bf16_t* base, size_t ld, int m0, int tid) { ARows a; a.mu = nullptr; a.ltype = 0; a.first = 0;
#pragma unroll
    for (int i = 0; i < 4; ++i) a.p[i] = base + (size_t)(m0 + (tid >> 3) + 64 * i) * ld;
    return a; }


DI void convert_tile4(const float* src, int ld, int N, int K, bf16_t* dst, int tile0, unsigned char* lds, int Kvalid = 1 << 30) {
    const int tid = TID();
    const int nkt = K >> 6;
    const int r = tid >> 3, seg = (tid & 7) * 8;
    f32x4 a[4], b[4];
#pragma unroll
    for (int u = 0; u < 4; ++u) {
        const int tile = tile0 + u, k0 = (tile % nkt) * 64, n0 = (tile / nkt) * 64;
        a[u] = (f32x4){0.f, 0.f, 0.f, 0.f}; b[u] = a[u];
        if (n0 + seg < N && k0 + r < Kvalid) { const float* q = src + (size_t)(k0 + r) * ld + n0 + seg; a[u] = *(const f32x4*)q; b[u] = *(const f32x4*)(q + 4); }
    }
    __syncthreads();
#pragma unroll
    for (int u = 0; u < 4; ++u) { bf16_t* T = (bf16_t*)lds + u * 64 * 72;
        u32x4 w; w.x = pack2(a[u][0], a[u][1]); w.y = pack2(a[u][2], a[u][3]); w.z = pack2(b[u][0], b[u][1]); w.w = pack2(b[u][2], b[u][3]); *(u32x4*)(T + r * 72 + seg) = w; }
    __syncthreads();
#pragma unroll
    for (int u = 0; u < 4; ++u) { const bf16_t* T = (const bf16_t*)lds + u * 64 * 72;
        const int tile = tile0 + u, k0 = (tile % nkt) * 64, n0 = (tile / nkt) * 64;
        u32x4 o;
        o.x = (unsigned)T[(seg + 0) * 72 + r] | ((unsigned)T[(seg + 1) * 72 + r] << 16); o.y = (unsigned)T[(seg + 2) * 72 + r] | ((unsigned)T[(seg + 3) * 72 + r] << 16);
        o.z = (unsigned)T[(seg + 4) * 72 + r] | ((unsigned)T[(seg + 5) * 72 + r] << 16); o.w = (unsigned)T[(seg + 6) * 72 + r] | ((unsigned)T[(seg + 7) * 72 + r] << 16);
        *(u32x4*)(dst + (size_t)(n0 + r) * K + k0 + seg) = o; }
}
struct Ctx {
    const Params* P; unsigned char* ws; float* out; int l;
    bf16_t* H; bf16_t* PROJ; bf16_t* F; bf16_t* POOLED; bf16_t* MERGED; bf16_t* CMPH; float* CMPO; float* POSB; int* ROUTE; int* ENT; bf16_t* HID; bf16_t* Y; bf16_t* VT; bf16_t* KC; bf16_t* VCT; bf16_t* YRAW; float* BON; unsigned* ctl;
    DI const float* in(int i) const { return P->in[i]; }
};

DI void moe_offsets(const Ctx& c, int layer, int* soff) {
    const unsigned* cnt = c.ctl + CW_CNT + layer * 32;
    __syncthreads();
    if (TID() == 0) { int s = 0; for (int e = 0; e < 32; ++e) { soff[e] = s; s += (int)cnt[e]; } soff[32] = s; }
    __syncthreads();
}
DI void add_moe_rows(const Ctx& c, int row, int lane, f32x4 (&v)[4], const int* soff) {
    const int* rt = c.ROUTE + (size_t)row * 8;
    const int p0 = soff[rt[0]] + rt[4], p1 = soff[rt[1]] + rt[5];
    const bf16_t* y0 = c.Y + (size_t)p0 * DM; const bf16_t* y1 = c.Y + (size_t)p1 * DM;
#pragma unroll
    for (int i = 0; i < 4; ++i) {
        const u32x2 a = *(const u32x2*)(y0 + i * 256 + lane * 4), b = *(const u32x2*)(y1 + i * 256 + lane * 4);
        v[i][0] += bflo(a.x) + bflo(b.x); v[i][1] += bfhi(a.x) + bfhi(b.x); v[i][2] += bflo(a.y) + bflo(b.y); v[i][3] += bfhi(a.y) + bfhi(b.y);
    }
}
DI void phase_norm1(const Ctx& c, unsigned char* lds) {
    const int tid = TID(), lane = tid & 63, wave = tid >> 6;
    const float* gain = c.in(I_NMIX) + c.l * DM;
    const float* src = (c.l == 0) ? c.in(I_X) : c.out;
    int* soff = (int*)(lds + 65536);
    if (c.l > 0) moe_offsets(c, c.l - 1, soff);
    for (int row = blockIdx.x * 8 + wave; row < NT; row += gridDim.x * 8) {
        f32x4 v[4];
#pragma unroll
        for (int i = 0; i < 4; ++i) v[i] = *(const f32x4*)(src + (size_t)row * DM + i * 256 + lane * 4);
        if (c.l > 0) {
            add_moe_rows(c, row, lane, v, soff);
#pragma unroll
            for (int i = 0; i < 4; ++i) *(f32x4*)(c.out + (size_t)row * DM + i * 256 + lane * 4) = v[i];
        }
        float ss = 0.f;
#pragma unroll
        for (int i = 0; i < 4; ++i) ss += v[i][0] * v[i][0] + v[i][1] * v[i][1] + v[i][2] * v[i][2] + v[i][3] * v[i][3];
        ss = wave_sum_dpp(ss);
        const float rs = rsqrtf(ss * (1.0f / DM) + 1e-6f);
#pragma unroll
        for (int i = 0; i < 4; ++i) {
            const f32x4 g = *(const f32x4*)(gain + i * 256 + lane * 4);
            store_bf4(c.H + (size_t)row * DM + i * 256 + lane * 4, (f32x4){v[i][0] * rs * g[0], v[i][1] * rs * g[1], v[i][2] * rs * g[2], v[i][3] * rs * g[3]});
        }
    }
    for (int idx = blockIdx.x * 8 + wave; idx < 512; idx += gridDim.x * 8) {
        const int kv = idx >> 8, n = idx & 255;
        const float* pos = c.in(kv ? I_CPV : I_CPK) + (size_t)c.l * 2048;
        const float* w1 = c.in(kv ? I_CW1V : I_CW1K) + (size_t)c.l * 2048 * 256;
        float s = 0.f;
        for (int k = lane; k < 2048; k += 64) s += pos[k] * w1[(size_t)k * 256 + n];
        s = wave_sum_dpp(s);
        if (lane == 0) c.POSB[kv * 256 + n] = s;
    }
    for (int it = blockIdx.x * 4; it < 1216 + 256 + 16 + 16 + 48; it += gridDim.x * 4) {
        if (it < 1216) convert_tile4(c.in(I_WIN) + (size_t)c.l * DM * IN_COLS, IN_COLS, IN_COLS, DM, (bf16_t*)(c.ws + WS_WT_IN), it, lds);
        else if (it < 1216 + 256) { const int j = it - 1216, kv = j >> 7; convert_tile4(c.in(kv ? I_CW1V : I_CW1K) + (size_t)c.l * 2048 * 256, 256, 256, 2048, (bf16_t*)(c.ws + WS_WT_C1) + (size_t)kv * 256 * 2048, j & 127, lds); }
        else if (it < 1216 + 256 + 16) { const int j = it - 1472, kv = j >> 3; convert_tile4(c.in(kv ? I_CW2V : I_CW2K) + (size_t)c.l * 256 * 64, 64, 64, 256, (bf16_t*)(c.ws + WS_WT_C2) + (size_t)kv * 128 * 256, j & 7, lds); }
        else if (it < 1504) { const int j = it - 1488, gi = j >> 2; convert_tile4(c.in(I_POOLW) + ((size_t)c.l * 4 + gi) * 128 * 128, 128, 128, 128, (bf16_t*)(c.ws + WS_WT_POOL) + (size_t)gi * 128 * 128, 0, lds); }
        else { const int j = it - 1504, ty = j >> 4; bf16_t* dst = (bf16_t*)(c.ws + WS_WT_LORA) + (size_t)ty * 512 * 128;
            if (ty == 0) convert_tile4(c.in(I_WUP) + (size_t)c.l * 32 * 512, 512, 512, 128, dst, j & 15, lds, 32);
            else if (ty == 1) convert_tile4(c.in(I_AUP) + (size_t)c.l * 32 * 512, 512, 512, 128, dst, j & 15, lds, 32);
            else convert_tile4(c.in(I_GUP) + (size_t)c.l * 96 * 512, 512, 512, 128, dst, j & 15, lds, 96); }
    }
}

constexpr int EPS = 136;
DI void tile_store_bf16(f32x4 (&acc)[4][4], bf16_t* out, size_t ld, int nrows, int ncols, unsigned char* lds) {
    bf16_t* T = (bf16_t*)lds;
    const int tid = TID();
    __syncthreads();
    ACC_FOREACH(acc, { store_bf4(T + r_ * EPS + c_, v_); });
    __syncthreads();
#pragma unroll
    for (int i = 0; i < 8; ++i) {
        const int ch = tid + i * NTHREADS, r = ch >> 4, cc = (ch & 15) * 8;
        if (r < nrows && cc < ncols) *(u32x4*)(out + (size_t)r * ld + cc) = *(const u32x4*)(T + r * EPS + cc);
    }
}
DI bool xcd_unit(int it, int nN, int& tm, int& tn) {
    const int G = gridDim.x;
    if ((G & 7) != 0 || G < 8) { const int u = it * G + blockIdx.x; if (u >= 64 * nN) return false; tm = u % 64; tn = u / 64; return true; }
    const int x = blockIdx.x & 7, i = blockIdx.x >> 3, per = G >> 3;
    const int u = it * per + i;
    if (u >= 8 * nN) return false;
    tm = x * 8 + (u & 7); tn = u >> 3; return true;
}
DI void phase_gemm1(const Ctx& c, unsigned char* lds) {
    const int nN = (IN_COLS + 255) / 256;
    const bf16_t* WT = (const bf16_t*)(c.ws + WS_WT_IN);
    for (int it = 0;; ++it) {
        int tm, tn; if (!xcd_unit(it, nN, tm, tn)) break;
        const int m0 = tm * 256, n0 = tn * 256;
        f32x4 acc[8][4];
#pragma unroll
        for (int i = 0; i < 8; ++i)
#pragma unroll
            for (int j = 0; j < 4; ++j) acc[i][j] = (f32x4){0.f, 0.f, 0.f, 0.f};
        gemm256_dma(acc, c.H + (size_t)m0 * DM, DM, WT + (size_t)n0 * DM, DM, DM, lds);
        tile256_store_bf16(acc, c.PROJ + (size_t)m0 * IN_COLS + n0, IN_COLS, (IN_COLS - n0 < 256) ? IN_COLS - n0 : 256, lds);
    }
}

DI float gelu_tanh(float x) { const float u = 0.7978845608028654f * (x + 0.044715f * x * x * x); const float e = __expf(2.0f * u); return x * (1.0f - __builtin_amdgcn_rcpf(e + 1.0f)); }
DI float softplusf_(float x) { return (x > 20.f) ? x : __logf(1.0f + __expf(x)); }
DI float tanhf_(float x) { const float e = __expf(2.0f * x); return 1.0f - 2.0f * __builtin_amdgcn_rcpf(e + 1.0f); }
constexpr int TKP = 8;
template <int WIN>
DI void pool_emit(const Ctx& c, const float (&pv)[31], int t0, int s0, int ch) {
#pragma unroll
    for (int k = 0; k < 16; ++k) {
        float sum = 0.f;
#pragma unroll
        for (int j = 0; j < WIN; ++j) sum += pv[15 + k - j];
        const int s = s0 + k, cnt = (s + 1 < WIN) ? s + 1 : WIN;
        c.POOLED[(size_t)(t0 + k) * 512 + ch] = f2bf(sum / (float)cnt - pv[15 + k]);
    }
}
DI void phase_prep(const Ctx& c, unsigned char* lds) {
    const int n_cmp_items = 2 * 16 * 2;
    for (int item = (int)gridDim.x - 1 - (int)blockIdx.x; item < n_cmp_items; item += gridDim.x) {
        const int tid = TID();
        const int kv = item >> 5, bgi = (item >> 1) & 15, tn = item & 1, m0 = bgi * 256, n0 = tn * 128;
        ARows ar; ar.mu = nullptr; ar.ltype = 0; ar.first = 0;
#pragma unroll
        for (int i = 0; i < 4; ++i) { const int cb = (tid >> 3) + 64 * i;
            ar.p[i] = (cb < NCMP) ? c.PROJ + ((size_t)(bgi >> 2) * SEQ + 16 * cb) * IN_COLS + (kv ? C_VC : C_KC) + (bgi & 3) * 64 : nullptr; }
        f32x4 acc[4][4]; acc_zero(acc);
        gemm_core<1>(acc, ar, (const bf16_t*)(c.ws + WS_WT_C1) + ((size_t)kv * 256 + n0) * 2048, 2048, 2048, lds);
        const float* pb = c.POSB + kv * 256;
        ACC_FOREACH(acc, {
            const f32x4 bb = *(const f32x4*)(pb + n0 + c_);
            store_bf4(c.CMPH + ((size_t)kv * 4096 + m0 + r_) * 256 + n0 + c_, (f32x4){gelu_tanh(v_[0] + bb[0]), gelu_tanh(v_[1] + bb[1]), gelu_tanh(v_[2] + bb[2]), gelu_tanh(v_[3] + bb[3])}); });
    }
    {
        const float* mu = c.in(I_MU) + (size_t)c.l * RWC;
        const bf16_t* WL = (const bf16_t*)(c.ws + WS_WT_LORA);
        for (int unit = blockIdx.x; unit < 64 * 12; unit += gridDim.x) {
            const int tid = TID();
            const int tm = unit & 63, tn = unit >> 6, m0 = tm * 256, n0 = tn * 128, ltype = tn >> 2, ch0 = n0 & 511;
            ARows ar; ar.mu = mu; ar.ltype = ltype; ar.first = 0;
#pragma unroll
            for (int i = 0; i < 4; ++i) { const int t = m0 + (tid >> 3) + 64 * i; ar.p[i] = c.PROJ + (size_t)t * IN_COLS; if ((t & (SEQ - 1)) == 0) ar.first |= 1 << i; }
            f32x4 acc[4][4]; acc_zero(acc);
            gemm_core<2>(acc, ar, WL + (size_t)n0 * 128, 128, 128, lds);
            if (ltype == 0) { const float* w0 = c.in(I_W0) + c.l * 512 + ch0;
                ACC_FOREACH(acc, { const f32x4 b4 = *(const f32x4*)(w0 + c_);
                    for (int j = 0; j < 4; ++j) v_[j] = __expf(-softplusf_(-(b4[j] + v_[j])) - 0.5f); }); }
            else if (ltype == 1) { const float* a0 = c.in(I_A0) + c.l * 512 + ch0;
                ACC_FOREACH(acc, { const f32x4 b4 = *(const f32x4*)(a0 + c_);
                    for (int j = 0; j < 4; ++j) v_[j] = sigmoidf_(b4[j] + v_[j]); }); }
            tile_store_bf16(acc, c.F + (size_t)(3 + ltype) * NT * 512 + (size_t)m0 * 512 + ch0, 512, 256, 128, lds);
        }
    }
    const int tid = TID();
    const int n_pool_items = NT / 16, n_items = n_pool_items + 2048;
    for (int item = blockIdx.x; item < n_items; item += gridDim.x) {
        if (item >= n_pool_items) {
            const int idx = item - n_pool_items, kind = idx >> 10, bgi = (idx >> 6) & 15, s0 = (idx & 63) * 64;
            bf16_t* T = (bf16_t*)lds;
            const int r = tid >> 3, seg = (tid & 7) * 8;
            const u32x4 w = *(const u32x4*)(c.PROJ + ((size_t)(bgi >> 2) * SEQ + s0 + r) * IN_COLS + (kind ? C_VW : C_VS) + (bgi & 3) * 64 + seg);
            __syncthreads();
            *(u32x4*)(T + r * 72 + seg) = w;
            __syncthreads();
            u32x4 o;
            o.x = (unsigned)T[(seg + 0) * 72 + r] | ((unsigned)T[(seg + 1) * 72 + r] << 16); o.y = (unsigned)T[(seg + 2) * 72 + r] | ((unsigned)T[(seg + 3) * 72 + r] << 16);
            o.z = (unsigned)T[(seg + 4) * 72 + r] | ((unsigned)T[(seg + 5) * 72 + r] << 16); o.w = (unsigned)T[(seg + 6) * 72 + r] | ((unsigned)T[(seg + 7) * 72 + r] << 16);
            *(u32x4*)(c.VT + (((size_t)kind * 16 + bgi) * 64 + r) * SEQ + s0 + seg) = o;
        } else {
            const int t0 = item * 16, ch = tid, gi = ch >> 7, s0 = t0 & (SEQ - 1);
            float pv[31];
#pragma unroll
            for (int i = 0; i < 31; ++i) pv[i] = (s0 - 15 + i >= 0) ? bf2f(c.PROJ[(size_t)(t0 - 15 + i) * IN_COLS + C_POOL + ch]) : 0.f;
            if (gi == 0) pool_emit<2>(c, pv, t0, s0, ch);
            else if (gi == 1) pool_emit<4>(c, pv, t0, s0, ch);
            else if (gi == 2) pool_emit<8>(c, pv, t0, s0, ch);
            else pool_emit<16>(c, pv, t0, s0, ch);
        }
    }
}

DI void rwkv_finalize_item(const Ctx& c, int item) {
    const int tid = TID(), ch = tid, t0 = item * 8;
    const float* mu = c.in(I_MU) + (size_t)c.l * RWC;
    const float kkw_ = c.in(I_KK)[c.l * 512 + ch], kaw_ = c.in(I_KA)[c.l * 512 + ch], rkw_ = c.in(I_RK)[c.l * 512 + ch];
    const float mur = mu[ch], muk = mu[512 + ch], muv = mu[1024 + ch];
    bf16_t ur[9], uk[9], uv[9], ua[8];
    const bool has_prev = (t0 & (SEQ - 1)) != 0;
#pragma unroll
    for (int k = 0; k < 9; ++k) {
        ur[k] = 0; uk[k] = 0; uv[k] = 0;
        if (k > 0 || has_prev) { const bf16_t* q = c.PROJ + (size_t)(t0 - 1 + k) * IN_COLS; ur[k] = q[C_R + ch]; uk[k] = q[C_K + ch]; uv[k] = q[C_V + ch]; }
    }
#pragma unroll
    for (int k = 0; k < 8; ++k) ua[k] = c.F[(size_t)4 * NT * 512 + (size_t)(t0 + k) * 512 + ch];
#pragma unroll
    for (int k = 0; k < 8; ++k) {
        const int t = t0 + k;
        const float cr = bf2f(ur[k + 1]), ck = bf2f(uk[k + 1]), cv = bf2f(uv[k + 1]);
        const float r = cr + (bf2f(ur[k]) - cr) * mur, kx = ck + (bf2f(uk[k]) - ck) * muk, vx = cv + (bf2f(uv[k]) - cv) * muv;
        const float a = bf2f(ua[k]);
        const float kxn = kx * kkw_, kp = kx * (1.0f + (a - 1.0f) * kaw_);
        const float ss = wave_sum_dpp(kxn * kxn);
        const float inv = __builtin_amdgcn_rsqf(fmaxf(ss, 1e-24f));
        const float br = wave_sum_dpp(kxn * inv * a * r), kr = wave_sum_dpp(kp * r), bon = wave_sum_dpp(r * kp * rkw_);
        if ((tid & 63) == 0) *(f32x4*)(c.BON + ((size_t)t * 8 + (tid >> 6)) * 4) = (f32x4){inv, br, kr, bon};
        const size_t o = (size_t)t * 512 + ch;
        c.F[o] = f2bf(r); c.F[o + (size_t)NT * 512] = f2bf(kx); c.F[o + (size_t)2 * NT * 512] = f2bf(vx);
    }
}

DI void phase_poolgemm(const Ctx& c, unsigned char* lds) {
    for (int item = blockIdx.x; item < NT / 8; item += gridDim.x) rwkv_finalize_item(c, item);
    const int n_pool = (NT / 256) * 4, n_items = n_pool + 32;
    for (int item = blockIdx.x; item < n_items; item += gridDim.x) {
        f32x4 acc[4][4]; acc_zero(acc);
        if (item < n_pool) {
            const int tm = item >> 2, gi = item & 3, m0 = tm * 256;
            const ARows ar = plain_rows(c.POOLED + gi * 128, 512, m0, TID());
            gemm_core<0>(acc, ar, (const bf16_t*)(c.ws + WS_WT_POOL) + (size_t)gi * 128 * 128, 128, 128, lds);
            const float* sc = c.in(I_POOLS) + c.l * 512 + gi * 128;
            ACC_FOREACH(acc, { const f32x4 s = *(const f32x4*)(sc + c_);
                store_bf4(c.POOLED + (size_t)(m0 + r_) * 512 + gi * 128 + c_, (f32x4){v_[0] * s[0], v_[1] * s[1], v_[2] * s[2], v_[3] * s[3]}); });
        } else {
            const int it = item - n_pool, kv = it >> 4, tm = it & 15, m0 = tm * 256;
            const ARows ar = plain_rows(c.CMPH + (size_t)kv * 4096 * 256, 256, m0, TID());
            gemm_core<0>(acc, ar, (const bf16_t*)(c.ws + WS_WT_C2) + (size_t)kv * 128 * 256, 256, 256, lds);
            ACC_FOREACH(acc, { if (c_ < 64) { const int R = m0 + r_;
                if (kv == 0) store_bf4(c.KC + (size_t)R * 64 + c_, v_);
                else { bf16_t* q = c.VCT + ((size_t)(R >> 8) * 64 + c_) * 256 + (R & 255); q[0] = f2bf(v_[0]); q[256] = f2bf(v_[1]); q[512] = f2bf(v_[2]); q[768] = f2bf(v_[3]); } } });
        }
    }
}

constexpr int SCH = 32;
constexpr int SB_AN = 0, SB_WR = SCH * 64 * 4, SB_W = 2 * SCH * 64 * 4, SB_BB = 3 * SCH * 64 * 4, SB_KP = 4 * SCH * 64 * 4;
constexpr int SB_V = 5 * SCH * 64 * 4;
constexpr int SB_SC = SB_V + SCH * 16 * 4;
constexpr int SB_Y = SB_SC + SCH * 2 * 4;
constexpr int SB_BYTES = SB_Y + SCH * 16 * 4;
static_assert(2 * SB_BYTES <= LDS_BYTES - 64, "scan lds");
typedef float f32x2 __attribute__((ext_vector_type(2)));
DI float row8_sum(float v) { v += DPP_MOV(v, 0xB1); v += DPP_MOV(v, 0x4E); v += DPP_MOV(v, 0x141); return v; }

constexpr int NPW = 6, NJ = (SCH + NPW - 1) / NPW;
struct PrepRegs { bf16_t r[NJ], k[NJ], v[NJ], e[NJ], a[NJ]; float s0[NJ], s1[NJ], s2[NJ]; };
DI void prep_load(PrepRegs& R, const Ctx& c, int b, int h, int ck, int pw, int lane) {
    const size_t PL = (size_t)NT * 512;
    const size_t tb = (size_t)b * SEQ + ck * SCH;
    const size_t o0 = tb * 512 + h * 64 + lane;
#pragma unroll
    for (int j = 0; j < NJ; ++j) {
        const int st = pw + NPW * j;
        if (st < SCH) { const size_t o = o0 + (size_t)st * 512; R.r[j] = c.F[o]; R.k[j] = c.F[o + PL]; R.v[j] = c.F[o + 2 * PL]; R.e[j] = c.F[o + 3 * PL]; R.a[j] = c.F[o + 4 * PL];
            const float* sp = c.BON + ((tb + st) * 8 + h) * 4; R.s0[j] = sp[0]; R.s1[j] = sp[1]; R.s2[j] = sp[2]; }
    }
}
DI void prep_store(const PrepRegs& R, unsigned char* sb, int rq, int pw, int lane, float kkw, float kaw) {
    float* an = (float*)(sb + SB_AN); float* wr = (float*)(sb + SB_WR); float* w_ = (float*)(sb + SB_W); float* bb_ = (float*)(sb + SB_BB); float* kp_ = (float*)(sb + SB_KP);
    float* vv = (float*)(sb + SB_V); float* sc = (float*)(sb + SB_SC);
#pragma unroll
    for (int j = 0; j < NJ; ++j) {
        const int st = pw + NPW * j;
        if (st < SCH) {
            const float r = bf2f(R.r[j]), k = bf2f(R.k[j]), v = bf2f(R.v[j]), e = bf2f(R.e[j]), a = bf2f(R.a[j]);
            const float w = __expf(-e);
            const float kk = k * kkw * R.s0[j];
            const float kp = k * (1.0f + (a - 1.0f) * kaw);
            an[st * 64 + lane] = -kk; wr[st * 64 + lane] = w * r; w_[st * 64 + lane] = w; bb_[st * 64 + lane] = kk * a; kp_[st * 64 + lane] = kp;
            if ((lane >> 4) == rq) vv[st * 16 + (lane & 15)] = v;
            if (lane == 0) { sc[st * 2] = R.s1[j]; sc[st * 2 + 1] = R.s2[j]; }
        }
    }
}
DI void scan_item(const Ctx& c, int item, unsigned char* lds) {
    const int tid = TID(), lane = tid & 63, wave = tid >> 6;
    const int b = item >> 5, h = (item >> 2) & 7, rq = item & 3;
    const int chn = h * 64 + lane;
    const float kkw = c.in(I_KK)[c.l * 512 + chn], kaw = c.in(I_KA)[c.l * 512 + chn];
    const int rowl = (tid & 127) >> 3, cg = tid & 7;
    f32x2 st[4];
#pragma unroll
    for (int i = 0; i < 4; ++i) st[i] = (f32x2){0.f, 0.f};
    constexpr int NCK = SEQ / SCH;
    PrepRegs R;
    __syncthreads();
    if (wave >= 2) { prep_load(R, c, b, h, 0, wave - 2, lane); prep_store(R, lds, rq, wave - 2, lane, kkw, kaw); prep_load(R, c, b, h, 1, wave - 2, lane); }
    __syncthreads();
    for (int ck = 0; ck < NCK; ++ck) {
        unsigned char* sb = lds + (ck & 1) * SB_BYTES;
        if (wave < 2) {
            const float* an = (const float*)(sb + SB_AN) + cg * 8; const float* wr = (const float*)(sb + SB_WR) + cg * 8; const float* w_ = (const float*)(sb + SB_W) + cg * 8;
            const float* bb_ = (const float*)(sb + SB_BB) + cg * 8; const float* kp_ = (const float*)(sb + SB_KP) + cg * 8;
            const float* vv = (const float*)(sb + SB_V) + rowl; const float* sc = (const float*)(sb + SB_SC); float* yb = (float*)(sb + SB_Y) + rowl;
            f32x4 a0 = *(const f32x4*)(an), a1 = *(const f32x4*)(an + 4), r0 = *(const f32x4*)(wr), r1 = *(const f32x4*)(wr + 4);
            f32x4 w0 = *(const f32x4*)(w_), w1 = *(const f32x4*)(w_ + 4), b0 = *(const f32x4*)(bb_), b1 = *(const f32x4*)(bb_ + 4);
            f32x4 k0 = *(const f32x4*)(kp_), k1 = *(const f32x4*)(kp_ + 4);
            float v = vv[0]; f32x2 bk = *(const f32x2*)(sc);
#pragma unroll 2
            for (int s = 0; s < SCH; ++s) {
                const int sn = (s + 1 < SCH) ? s + 1 : s;
                const f32x4 na0 = *(const f32x4*)(an + sn * 64), na1 = *(const f32x4*)(an + sn * 64 + 4), nr0 = *(const f32x4*)(wr + sn * 64), nr1 = *(const f32x4*)(wr + sn * 64 + 4);
                const f32x4 nw0 = *(const f32x4*)(w_ + sn * 64), nw1 = *(const f32x4*)(w_ + sn * 64 + 4), nb0 = *(const f32x4*)(bb_ + sn * 64), nb1 = *(const f32x4*)(bb_ + sn * 64 + 4);
                const f32x4 nk0 = *(const f32x4*)(kp_ + sn * 64), nk1 = *(const f32x4*)(kp_ + sn * 64 + 4);
                const float nv = vv[sn * 16]; const f32x2 nbk = *(const f32x2*)(sc + sn * 2);
                f32x2 da = st[0] * (f32x2){a0[0], a0[1]}; f32x2 dr = st[0] * (f32x2){r0[0], r0[1]};
                da += st[1] * (f32x2){a0[2], a0[3]}; dr += st[1] * (f32x2){r0[2], r0[3]};
                da += st[2] * (f32x2){a1[0], a1[1]}; dr += st[2] * (f32x2){r1[0], r1[1]};
                da += st[3] * (f32x2){a1[2], a1[3]}; dr += st[3] * (f32x2){r1[2], r1[3]};
                float sa = da[0] + da[1], sr = dr[0] + dr[1];
                sa += DPP_MOV(sa, 0xB1); sr += DPP_MOV(sr, 0xB1);
                sa += DPP_MOV(sa, 0x4E); sr += DPP_MOV(sr, 0x4E);
                sa += DPP_MOV(sa, 0x141); sr += DPP_MOV(sr, 0x141);
                const f32x2 sa2 = (f32x2){sa, sa}, v2 = (f32x2){v, v};
                st[0] = st[0] * (f32x2){w0[0], w0[1]} + sa2 * (f32x2){b0[0], b0[1]} + v2 * (f32x2){k0[0], k0[1]};
                st[1] = st[1] * (f32x2){w0[2], w0[3]} + sa2 * (f32x2){b0[2], b0[3]} + v2 * (f32x2){k0[2], k0[3]};
                st[2] = st[2] * (f32x2){w1[0], w1[1]} + sa2 * (f32x2){b1[0], b1[1]} + v2 * (f32x2){k1[0], k1[1]};
                st[3] = st[3] * (f32x2){w1[2], w1[3]} + sa2 * (f32x2){b1[2], b1[3]} + v2 * (f32x2){k1[2], k1[3]};
                yb[s * 16] = sr + sa * bk[0] + v * bk[1];
                a0 = na0; a1 = na1; r0 = nr0; r1 = nr1; w0 = nw0; w1 = nw1; b0 = nb0; b1 = nb1; k0 = nk0; k1 = nk1; v = nv; bk = nbk;
            }
        } else {
            const int pt = tid - 128;
            if (ck + 1 < NCK) prep_store(R, lds + ((ck + 1) & 1) * SB_BYTES, rq, wave - 2, lane, kkw, kaw);
            if (ck + 2 < NCK) prep_load(R, c, b, h, ck + 2, wave - 2, lane);
            if (ck > 0) {
                const float* yb = (const float*)(lds + ((ck - 1) & 1) * SB_BYTES + SB_Y);
                for (int idx = pt; idx < SCH * 16; idx += 384) {
                    const int s = idx >> 4, j = idx & 15;
                    c.YRAW[((size_t)b * SEQ + (ck - 1) * SCH + s) * 512 + h * 64 + rq * 16 + j] = f2bf(yb[idx]);
                }
            }
        }
        asm volatile("s_waitcnt lgkmcnt(0)" ::: "memory"); __builtin_amdgcn_s_barrier(); asm volatile("" ::: "memory");
    }
    {
        const float* yb = (const float*)(lds + ((NCK - 1) & 1) * SB_BYTES + SB_Y);
        for (int idx = tid; idx < SCH * 16; idx += NTHREADS) {
            const int s = idx >> 4, j = idx & 15;
            c.YRAW[((size_t)b * SEQ + (NCK - 1) * SCH + s) * 512 + h * 64 + rq * 16 + j] = f2bf(yb[idx]);
        }
    }
    __syncthreads();
}
DI void phase_rwkv_post(const Ctx& c, unsigned char* lds) {
    const int tid = TID(), lane = tid & 63, wave = tid >> 6;
    const size_t PL = (size_t)NT * 512;
    for (int t = blockIdx.x * 8 + wave; t < NT; t += gridDim.x * 8) {
        bf16_t ry[8], rv[8], rg[8]; float bon[8], gw[8], gb[8];
#pragma unroll
        for (int h = 0; h < 8; ++h) { const size_t o = (size_t)t * 512 + h * 64 + lane; ry[h] = c.YRAW[o]; rv[h] = c.F[o + 2 * PL]; rg[h] = c.F[o + 5 * PL]; bon[h] = c.BON[((size_t)t * 8 + h) * 4 + 3];
            gw[h] = c.in(I_GNW)[c.l * 512 + h * 64 + lane]; gb[h] = c.in(I_GNB)[c.l * 512 + h * 64 + lane]; }
#pragma unroll
        for (int h = 0; h < 8; ++h) {
            const float y = bf2f(ry[h]);
            const float mean = wave_sum_dpp(y) * (1.0f / 64.0f);
            const float d = y - mean;
            const float var = wave_sum_dpp(d * d) * (1.0f / 64.0f);
            const float yn = d * rsqrtf(var + 64e-5f) * gw[h] + gb[h];
            c.F[(size_t)t * 512 + h * 64 + lane + 5 * PL] = f2bf((yn + bon[h] * bf2f(rv[h])) * bf2f(rg[h]));
        }
    }
    for (int it = blockIdx.x * 4; it < 768 + 128 + 128 + 256 + 256; it += gridDim.x * 4) {
        const float* WB = c.in(I_WBR) + (size_t)c.l * 2048 * DM; bf16_t* BR = (bf16_t*)(c.ws + WS_WT_BR);
        if (it < 768) convert_tile4(c.in(I_WMG) + (size_t)c.l * DM * 3 * DM, 3 * DM, 3 * DM, DM, (bf16_t*)(c.ws + WS_WT_MG), it, lds);
        else if (it < 896) convert_tile4(WB, DM, DM, 512, BR, it - 768, lds);
        else if (it < 1024) convert_tile4(WB + (size_t)512 * DM, DM, DM, 512, BR + (size_t)1024 * 512, it - 896, lds);
        else if (it < 1280) convert_tile4(WB + (size_t)1024 * DM, DM, DM, 1024, BR + (size_t)2048 * 512, it - 1024, lds);
        else convert_tile4(c.in(I_WOUT) + (size_t)c.l * DM * DM, DM, DM, DM, (bf16_t*)(c.ws + WS_WT_OUT), it - 1280, lds);
    }
}
constexpr int TS = 72;
constexpr int NSA_BIAS = 0;
constexpr int NSA_SELM = 2112;
constexpr int NSA_SCR = 2624;
constexpr int NSA_K0 = 4672;
constexpr int NSA_V0 = NSA_K0 + 2 * 64 * TS * 2;
constexpr int NSA_A = NSA_V0 + 2 * 64 * TS * 2;
constexpr int NSA_B = NSA_A + 16384;
constexpr int NSA_END = NSA_B + 16384;
static_assert(NSA_END <= LDS_BYTES - 16, "nsa lds");
static_assert(NSA_K0 % 16 == 0, "align");

struct NsaLane { int tq[2]; int h; float cbias; float m[2], l[2]; };

DI void nsa_prefetch(u32x4& rk, u32x4& rv, const bf16_t* kbase, int kstride, const bf16_t* vtbase, int vstride, int pos0, int tid) {
    const int r = tid >> 3, seg = (tid & 7) * 8;
    rk = *(const u32x4*)(kbase + (size_t)(pos0 + r) * kstride + seg);
    rv = *(const u32x4*)(vtbase + (size_t)r * vstride + pos0 + seg);
}
DI void nsa_store(unsigned char* lds, int buf, const u32x4& rk, const u32x4& rv, int tid) {
    const int r = tid >> 3, seg = (tid & 7) * 8;
    *(u32x4*)((bf16_t*)(lds + NSA_K0) + buf * 64 * TS + r * TS + seg) = rk;
    *(u32x4*)((bf16_t*)(lds + NSA_V0) + buf * 64 * TS + r * TS + seg) = rv;
}
template <int QM = 3>
DI void nsa_qk(f32x4 (&s)[2][4], const bf16_t* sK, const bf16x8 (&qf)[2][2], int lane) {
#pragma unroll
    for (int kt = 0; kt < 4; ++kt) {
#pragma unroll
        for (int ks = 0; ks < 2; ++ks) {
            const bf16x8 kf = *(const bf16x8*)(sK + (16 * kt + (lane & 15)) * TS + 32 * ks + (lane >> 4) * 8);
#pragma unroll
            for (int qi = 0; qi < 2; ++qi) if ((QM >> qi) & 1) s[qi][kt] = __builtin_amdgcn_mfma_f32_16x16x32_bf16(kf, qf[qi][ks], (ks == 0) ? (f32x4){0.f, 0.f, 0.f, 0.f} : s[qi][kt], 0, 0, 0);
        }
    }
}
template <int MODE>
DI void nsa_logits(float (&x)[4][4], const f32x4 (&s)[4], int tq, int h, float cbias, bool rowsel, int pos0, int qd, const float* biasT) {
#pragma unroll
    for (int kt = 0; kt < 4; ++kt)
#pragma unroll
        for (int i = 0; i < 4; ++i) {
            const int kk = pos0 + 16 * kt + 4 * qd + i;
            if (MODE == 1) { x[kt][i] = rowsel ? s[kt][i] + cbias : -INFINITY; }
            else {
                const int dist = (MODE == 0) ? (tq - 16 * kk - 31) : (tq - kk);
                bool ok = dist >= 0;
                if (MODE == 2) ok = ok && rowsel;
                if (MODE == 3) ok = ok && (dist < 512);
                const int di = dist < 0 ? 0 : (dist > 128 ? 128 : dist);
                float bias = biasT[di * 4 + h];
                asm volatile("" : "+v"(bias));
                x[kt][i] = ok ? s[kt][i] + bias : -INFINITY;
            }
        }
}
DI float quad16_max(float v) { v = fmaxf(v, __shfl_xor(v, 16)); v = fmaxf(v, __shfl_xor(v, 32)); return v; }
DI float quad16_sum(float v) { v += __shfl_xor(v, 16); v += __shfl_xor(v, 32); return v; }
DI void nsa_softmax(const float (&x)[4][4], float& m, float& l, f32x4 (&O)[4], bf16x8 (&pf)[2]) {
    float mx = -INFINITY;
#pragma unroll
    for (int kt = 0; kt < 4; ++kt)
#pragma unroll
        for (int i = 0; i < 4; ++i) mx = fmaxf(mx, x[kt][i]);
    mx = quad16_max(mx);
    const float mn = fmaxf(m, mx);
    const float mu = (mn == -INFINITY) ? 0.f : mn;
    const float mu2 = mu * 1.4426950408889634f;
    const float sc = __builtin_amdgcn_exp2f(__builtin_fmaf(m, 1.4426950408889634f, -mu2));
    float p[4][4]; float ps = 0.f;
#pragma unroll
    for (int kt = 0; kt < 4; ++kt)
#pragma unroll
        for (int i = 0; i < 4; ++i) { p[kt][i] = __builtin_amdgcn_exp2f(__builtin_fmaf(x[kt][i], 1.4426950408889634f, -mu2)); ps += p[kt][i]; }
    l = l * sc + ps; m = mn;
#pragma unroll
    for (int dt = 0; dt < 4; ++dt) O[dt] = O[dt] * sc;
#pragma unroll
    for (int ks = 0; ks < 2; ++ks) {
        u32x4 w; w.x = pack2(p[2 * ks][0], p[2 * ks][1]); w.y = pack2(p[2 * ks][2], p[2 * ks][3]); w.z = pack2(p[2 * ks + 1][0], p[2 * ks + 1][1]); w.w = pack2(p[2 * ks + 1][2], p[2 * ks + 1][3]);
        pf[ks] = __builtin_bit_cast(bf16x8, w);
    }
}
template <int QM = 3>
DI void nsa_pv(f32x4 (&O)[2][4], const bf16_t* sV, const bf16x8 (&pf)[2][2], int lane) {
    const int qd = lane >> 4;
#pragma unroll
    for (int dt = 0; dt < 4; ++dt)
#pragma unroll
        for (int ks = 0; ks < 2; ++ks) {
            const bf16_t* vp = sV + (16 * dt + (lane & 15)) * TS + 32 * ks + 4 * qd;
            const u32x2 a = *(const u32x2*)vp, b = *(const u32x2*)(vp + 16);
            u32x4 w; w.x = a.x; w.y = a.y; w.z = b.x; w.w = b.y;
            const bf16x8 vf = __builtin_bit_cast(bf16x8, w);
#pragma unroll
            for (int qi = 0; qi < 2; ++qi) if ((QM >> qi) & 1) O[qi][dt] = __builtin_amdgcn_mfma_f32_16x16x32_bf16(vf, pf[qi][ks], O[qi][dt], 0, 0, 0);
        }
}
template <int MODE, int QM = 3>
DI void nsa_tile(f32x4 (&O)[2][4], NsaLane& L, const bf16x8 (&qf)[2][2], const unsigned char* lds, int buf, int pos0, bool sel0, bool sel1, int lane) {
    const bf16_t* sK = (const bf16_t*)(lds + NSA_K0) + buf * 64 * TS;
    const bf16_t* sV = (const bf16_t*)(lds + NSA_V0) + buf * 64 * TS;
    const float* biasT = (const float*)(lds + NSA_BIAS);
    f32x4 s[2][4];
    nsa_qk<QM>(s, sK, qf, lane);
    bf16x8 pf[2][2];
#pragma unroll
    for (int qi = 0; qi < 2; ++qi) if ((QM >> qi) & 1) {
        float x[4][4];
        nsa_logits<MODE>(x, s[qi], L.tq[qi], L.h, L.cbias, qi ? sel1 : sel0, pos0, lane >> 4, biasT);
        nsa_softmax(x, L.m[qi], L.l[qi], O[qi], pf[qi]);
    }
    nsa_pv<QM>(O, sV, pf, lane);
}
template <int MODE>
DI void nsa_tile_sel(f32x4 (&O)[2][4], NsaLane& L, const bf16x8 (&qf)[2][2], const unsigned char* lds, int buf, int pos0, bool sel0, bool sel1, int lane) {
    const bool a0 = __ballot(sel0) != 0ull, a1 = __ballot(sel1) != 0ull;
    if (a0 && a1) nsa_tile<MODE, 3>(O, L, qf, lds, buf, pos0, sel0, sel1, lane);
    else if (a0) nsa_tile<MODE, 1>(O, L, qf, lds, buf, pos0, sel0, sel1, lane);
    else if (a1) nsa_tile<MODE, 2>(O, L, qf, lds, buf, pos0, sel0, sel1, lane);
}
DI void nsa_flush(f32x4 (&Y)[2][4], f32x4 (&O)[2][4], NsaLane& L, const float (&gate)[2]) {
#pragma unroll
    for (int qi = 0; qi < 2; ++qi) {
        const float lt = quad16_sum(L.l[qi]);
        const float f = (lt > 0.f) ? gate[qi] * __builtin_amdgcn_rcpf(lt) : 0.f;
#pragma unroll
        for (int dt = 0; dt < 4; ++dt) { Y[qi][dt] += O[qi][dt] * f; O[qi][dt] = (f32x4){0.f, 0.f, 0.f, 0.f}; }
    }
}
DI void nsa_item(const Ctx& c, int item, unsigned char* lds) {
    const int tid = TID(), lane = tid & 63, wave = tid >> 6, qd = lane >> 4;
    const int b = item >> 8, g = (item >> 6) & 3, qt = item & 63, t0 = qt * 64, cur = qt, bg = b * 4 + g;
    float* biasT = (float*)(lds + NSA_BIAS);
    unsigned long long* selm = (unsigned long long*)(lds + NSA_SELM);
    float* scr = (float*)(lds + NSA_SCR) + wave * 64;
    float* impA = (float*)(lds + NSA_A); float* impB = (float*)(lds + NSA_B);
    __syncthreads();
    for (int i = tid; i < 129 * 4; i += NTHREADS) { const int d = i >> 2, h = i & 3; biasT[i] = c.in(I_RELB)[t5_bucket(d) * 16 + g * 4 + h]; }
    for (int i = tid; i < 2 * 4096; i += NTHREADS) impA[i] = 0.f;
    NsaLane L; L.h = lane & 3;
    bf16x8 qf[2][2]; float gates[2][3];
    const bf16_t* pbat = c.PROJ + (size_t)b * SEQ * IN_COLS;
#pragma unroll
    for (int qi = 0; qi < 2; ++qi) {
        const int tl = 8 * wave + 4 * qi + ((lane & 15) >> 2);
        L.tq[qi] = t0 + tl;
        const bf16_t* prow = pbat + (size_t)L.tq[qi] * IN_COLS;
#pragma unroll
        for (int ks = 0; ks < 2; ++ks) {
            u32x4 w = *(const u32x4*)(prow + C_Q + (g * 4 + L.h) * 64 + 32 * ks + qd * 8);
            w.x = pack2(bflo(w.x) * 0.125f, bfhi(w.x) * 0.125f); w.y = pack2(bflo(w.y) * 0.125f, bfhi(w.y) * 0.125f);
            w.z = pack2(bflo(w.z) * 0.125f, bfhi(w.z) * 0.125f); w.w = pack2(bflo(w.w) * 0.125f, bfhi(w.w) * 0.125f);
            qf[qi][ks] = __builtin_bit_cast(bf16x8, w);
        }
#pragma unroll
        for (int br = 0; br < 3; ++br) gates[qi][br] = sigmoidf_(bf2f(prow[C_GATE + g * 12 + L.h * 3 + br]));
    }
    __syncthreads();
    L.cbias = biasT[128 * 4 + L.h];
    f32x4 O[2][4], Y[2][4];
#pragma unroll
    for (int qi = 0; qi < 2; ++qi)
#pragma unroll
        for (int dt = 0; dt < 4; ++dt) { O[qi][dt] = (f32x4){0.f, 0.f, 0.f, 0.f}; Y[qi][dt] = (f32x4){0.f, 0.f, 0.f, 0.f}; }
    u32x4 rk, rv;
    const int nvis_max = (t0 + 63 >= 31) ? ((t0 + 63 - 31) >> 4) + 1 : 0;
    const int ncb = (nvis_max + 63) >> 6;
    const bf16_t* kcb = c.KC + (size_t)bg * 256 * 64; const bf16_t* vcb = c.VCT + (size_t)bg * 64 * 256;
    L.m[0] = L.m[1] = -INFINITY; L.l[0] = L.l[1] = 0.f;
    if (ncb > 0) nsa_prefetch(rk, rv, kcb, 64, vcb, 256, 0, tid);
    for (int cb = 0; cb < ncb; ++cb) {
        nsa_store(lds, cb & 1, rk, rv, tid);
        __syncthreads();
        if (cb + 1 < ncb) nsa_prefetch(rk, rv, kcb, 64, vcb, 256, (cb + 1) * 64, tid);
        if (16 * (cb * 64 + 63) + 31 + 128 <= t0) nsa_tile<1>(O, L, qf, lds, cb & 1, cb * 64, true, true, lane);
        else nsa_tile<0>(O, L, qf, lds, cb & 1, cb * 64, true, true, lane);
    }
    if (ncb > 0) nsa_prefetch(rk, rv, kcb, 64, vcb, 256, 0, tid);
    float mfin[2], linv[2];
#pragma unroll
    for (int qi = 0; qi < 2; ++qi) { mfin[qi] = L.m[qi]; const float lt = quad16_sum(L.l[qi]); linv[qi] = (lt > 0.f) ? __builtin_amdgcn_rcpf(lt) : 0.f; }
    { const float gg[2] = {gates[0][0], gates[1][0]}; nsa_flush(Y, O, L, gg); }
    __syncthreads();
    for (int cb = 0; cb < ncb; ++cb) {
        nsa_store(lds, cb & 1, rk, rv, tid);
        __syncthreads();
        if (cb + 1 < ncb) nsa_prefetch(rk, rv, kcb, 64, vcb, 256, (cb + 1) * 64, tid);
        const bf16_t* sK = (const bf16_t*)(lds + NSA_K0) + (cb & 1) * 64 * TS;
        f32x4 s[2][4];
        nsa_qk(s, sK, qf, lane);
#pragma unroll
        for (int qi = 0; qi < 2; ++qi) {
            float x[4][4];
            nsa_logits<0>(x, s[qi], L.tq[qi], L.h, L.cbias, true, cb * 64, qd, biasT);
            const float mu = (mfin[qi] == -INFINITY) ? 0.f : mfin[qi];
#pragma unroll
            for (int kt = 0; kt < 4; ++kt) {
                float p3 = __expf(x[kt][3] - mu) * linv[qi];
                float pa = (__expf(x[kt][0] - mu) + __expf(x[kt][1] - mu) + __expf(x[kt][2] - mu)) * linv[qi] + p3;
                pa += __shfl_xor(pa, 1); p3 += __shfl_xor(p3, 1);
                pa += __shfl_xor(pa, 2); p3 += __shfl_xor(p3, 2);
                if (L.h == 0) { const int tl = 8 * wave + 4 * qi + ((lane & 15) >> 2), mi = 16 * cb + 4 * kt + qd; impA[tl * 64 + mi] = pa; impB[tl * 64 + mi] = p3; }
            }
        }
    }
    const bf16_t* ksb = pbat + C_KS + g * 64; const bf16_t* vsb = c.VT + ((size_t)0 * 16 + bg) * 64 * SEQ;
    nsa_prefetch(rk, rv, ksb, IN_COLS, vsb, SEQ, 0, tid);
    __syncthreads();
    for (int tl8 = 0; tl8 < 8; ++tl8) {
        const int tl = 8 * wave + tl8, n = lane;
        const bool cand = (n >= 1) && (n <= cur - 2);
        const float imp = cand ? impA[tl * 64 + n] + impB[tl * 64 + n - 1] : -1.0f;
        LDS_WAVE_SYNC();
        scr[n] = imp;
        LDS_WAVE_SYNC();
        int rank = 0;
#pragma unroll 4
        for (int q4 = 0; q4 < 16; ++q4) {
            const f32x4 o = *(const f32x4*)(scr + q4 * 4);
#pragma unroll
            for (int j = 0; j < 4; ++j) { const int n2 = q4 * 4 + j; rank += (o[j] > imp || (o[j] == imp && n2 < n)) ? 1 : 0; }
        }
        const bool forced = (n <= cur) && (n == 0 || n == cur || n == cur - 1);
        const unsigned long long msk = __ballot((cand && rank < 5) || forced);
        if (lane == 0) selm[tl] = msk;
    }
    __syncthreads();
    unsigned long long uni = selm[lane];
#pragma unroll
    for (int o = 32; o >= 1; o >>= 1) { const unsigned lo_ = __shfl_xor((unsigned)uni, o), hi_ = __shfl_xor((unsigned)(uni >> 32), o); uni |= ((unsigned long long)hi_ << 32) | lo_; }
    uni = ((unsigned long long)__builtin_amdgcn_readfirstlane((unsigned)(uni >> 32)) << 32) | (unsigned)__builtin_amdgcn_readfirstlane((unsigned)uni);
    unsigned long long sm[2];
#pragma unroll
    for (int qi = 0; qi < 2; ++qi) sm[qi] = selm[8 * wave + 4 * qi + ((lane & 15) >> 2)];
    L.m[0] = L.m[1] = -INFINITY; L.l[0] = L.l[1] = 0.f;
    {
        unsigned long long rem = uni; int it = 0;
        int j = (int)__builtin_ctzll(rem); rem &= rem - 1;
        for (;;) {
            nsa_store(lds, it & 1, rk, rv, tid);
            __syncthreads();
            const int jn = rem ? (int)__builtin_ctzll(rem) : -1;
            if (jn >= 0) { rem &= rem - 1; nsa_prefetch(rk, rv, ksb, IN_COLS, vsb, SEQ, jn * 64, tid); }
            const bool s0 = (sm[0] >> j) & 1ull, s1 = (sm[1] >> j) & 1ull;
            if (j <= cur - 3) nsa_tile_sel<1>(O, L, qf, lds, it & 1, j * 64, s0, s1, lane);
            else nsa_tile_sel<2>(O, L, qf, lds, it & 1, j * 64, s0, s1, lane);
            if (jn < 0) break;
            j = jn; ++it;
        }
    }
    const bf16_t* kwb = pbat + C_KW + g * 64; const bf16_t* vwb = c.VT + ((size_t)1 * 16 + bg) * 64 * SEQ;
    const int j0 = (cur - 8 > 0) ? cur - 8 : 0;
    nsa_prefetch(rk, rv, kwb, IN_COLS, vwb, SEQ, j0 * 64, tid);
    { const float gg[2] = {gates[0][1], gates[1][1]}; nsa_flush(Y, O, L, gg); }
    L.m[0] = L.m[1] = -INFINITY; L.l[0] = L.l[1] = 0.f;
    {
        __syncthreads();
        for (int j = j0; j <= cur; ++j) {
            nsa_store(lds, (j - j0) & 1, rk, rv, tid);
            __syncthreads();
            if (j + 1 <= cur) nsa_prefetch(rk, rv, kwb, IN_COLS, vwb, SEQ, (j + 1) * 64, tid);
            if (cur - j >= 3 && cur - j <= 7) nsa_tile<1>(O, L, qf, lds, (j - j0) & 1, j * 64, true, true, lane);
            else nsa_tile<3>(O, L, qf, lds, (j - j0) & 1, j * 64, true, true, lane);
        }
    }
    { const float gg[2] = {gates[0][2], gates[1][2]}; nsa_flush(Y, O, L, gg); }
#pragma unroll
    for (int qi = 0; qi < 2; ++qi) {
        bf16_t* yrow = c.PROJ + ((size_t)b * SEQ + L.tq[qi]) * IN_COLS + C_Q + (g * 4 + L.h) * 64;
#pragma unroll
        for (int dt = 0; dt < 4; ++dt) store_bf4(yrow + 16 * dt + 4 * qd, Y[qi][dt]);
    }
}
DI void phase_mix(const Ctx& c, unsigned char* lds) {
    const int G = gridDim.x, bid = blockIdx.x;
    const int n_nsa = NB * 4 * (SEQ / 64), n_scan = NB * 8 * 4;
    const bool split = G >= 2 * n_scan;
    if (split) { if (bid < n_scan) scan_item(c, bid, lds); }
    else for (int item = bid; item < n_scan; item += G) scan_item(c, item, lds);
    unsigned* ctr = c.ctl + CW_Q + c.l;
    volatile int* sitem = (volatile int*)(lds + LDS_BYTES - 32);
    for (;;) {
        __syncthreads();
        if (TID() == 0) *sitem = (int)atomicAdd(ctr, 1u);
        __syncthreads();
        const int k = *sitem;
        if (k >= n_nsa) break;
        const int qt = 63 - (k >> 4), bgi = k & 15;
        nsa_item(c, (bgi << 6) | qt, lds);
    }
}

DI void phase_merge(const Ctx& c, unsigned char* lds) {
    const int nM = NT / 256, nN = DM / 128;
    const bf16_t* WM = (const bf16_t*)(c.ws + WS_WT_MG);
    const bf16_t* BR = (const bf16_t*)(c.ws + WS_WT_BR);
    const float* BM_ = c.in(I_BMG) + (size_t)c.l * 3 * DM;
    bf16_t* TMP = c.YRAW + (size_t)blockIdx.x * 256 * 128;
    for (int it = 0;; ++it) {
        int tm, tn; if (!xcd_unit(it, nN, tm, tn)) break;
        const int m0 = tm * 256, n0 = tn * 128;
#pragma unroll 1
        for (int i = 0; i < 3; ++i) {
            {
                f32x4 ag[4][4]; acc_zero(ag);
                gemm_core_dma(ag, c.H + (size_t)m0 * DM, DM, WM + (size_t)(i * DM + n0) * DM, DM, DM, lds);
                ACC_FOREACH(ag, { const f32x4 bb = *(const f32x4*)(BM_ + i * DM + n0 + c_);
                    store_bf4(TMP + r_ * 128 + c_, (f32x4){sigmoidf_(v_[0] + bb[0]), sigmoidf_(v_[1] + bb[1]), sigmoidf_(v_[2] + bb[2]), sigmoidf_(v_[3] + bb[3])}); });
            }
            f32x4 ab[4][4]; acc_zero(ab);
            if (i == 0) gemm_core_dma(ab, c.POOLED + (size_t)m0 * 512, 512, BR + (size_t)n0 * 512, 512, 512, lds);
            else if (i == 1) gemm_core_dma(ab, c.F + (size_t)5 * NT * 512 + (size_t)m0 * 512, 512, BR + (size_t)1024 * 512 + (size_t)n0 * 512, 512, 512, lds);
            else gemm_core_dma(ab, c.PROJ + C_Q + (size_t)m0 * IN_COLS, IN_COLS, BR + (size_t)2048 * 512 + (size_t)n0 * 1024, 1024, 1024, lds);
            ACC_FOREACH(ab, {
                bf16_t* q = c.MERGED + (size_t)(m0 + r_) * DM + n0 + c_;
                const u32x2 gv = *(const u32x2*)(TMP + r_ * 128 + c_);
                f32x4 m4 = ((f32x4){0.f, 0.f, 0.f, 0.f});
                if (i > 0) { const u32x2 pv = *(const u32x2*)q; m4 = ((f32x4){bflo(pv.x), bfhi(pv.x), bflo(pv.y), bfhi(pv.y)}); }
                m4[0] += bflo(gv.x) * v_[0]; m4[1] += bfhi(gv.x) * v_[1]; m4[2] += bflo(gv.y) * v_[2]; m4[3] += bfhi(gv.y) * v_[3];
                store_bf4(q, m4); });
        }
    }
}

DI void phase_outp(const Ctx& c, unsigned char* lds) {
    const int nN = DM / 256;
    const bf16_t* W = (const bf16_t*)(c.ws + WS_WT_OUT);
    const float* xin = (c.l == 0) ? c.in(I_X) : c.out;
    for (int it = 0;; ++it) {
        int tm, tn; if (!xcd_unit(it, nN, tm, tn)) break;
        const int m0 = tm * 256, n0 = tn * 256;
        f32x4 acc[8][4];
#pragma unroll
        for (int i = 0; i < 8; ++i)
#pragma unroll
            for (int j = 0; j < 4; ++j) acc[i][j] = (f32x4){0.f, 0.f, 0.f, 0.f};
        gemm256_dma(acc, c.MERGED + (size_t)m0 * DM, DM, W + (size_t)n0 * DM, DM, DM, lds);
        const int lane = TID() & 63, wave = TID() >> 6, wm = wave >> 2, wn = wave & 3;
#pragma unroll
        for (int mi = 0; mi < 8; ++mi)
#pragma unroll
            for (int ni = 0; ni < 4; ++ni) {
                const size_t o = (size_t)(m0 + wm * 128 + mi * 16 + (lane & 15)) * DM + n0 + wn * 64 + ni * 16 + (lane >> 4) * 4;
                const f32x4 x = *(const f32x4*)(xin + o); *(f32x4*)(c.out + o) = x + acc[mi][ni];
            }
    }
    for (int it = blockIdx.x * 4; it < 3 * 32 * 64; it += gridDim.x * 4) {
        const int mat = it / 2048, e = (it >> 6) & 31, tl = it & 63;
        if (mat == 0) convert_tile4(c.in(I_EG) + ((size_t)c.l * 32 + e) * DM * 256, 256, 256, DM, (bf16_t*)(c.ws + WS_EG) + (size_t)e * 256 * DM, tl, lds);
        else if (mat == 1) convert_tile4(c.in(I_EU) + ((size_t)c.l * 32 + e) * DM * 256, 256, 256, DM, (bf16_t*)(c.ws + WS_EU) + (size_t)e * 256 * DM, tl, lds);
        else convert_tile4(c.in(I_ED) + ((size_t)c.l * 32 + e) * 256 * DM, DM, DM, 256, (bf16_t*)(c.ws + WS_ED) + (size_t)e * DM * 256, tl, lds);
    }
}

DI void phase_norm2(const Ctx& c, unsigned char* lds) {
    const int tid = TID(), lane = tid & 63, wave = tid >> 6;
    const float* gain = c.in(I_NFFN) + c.l * DM;
    const float* wrg = c.in(I_WRG) + (size_t)c.l * DM * 4; const float* brg = c.in(I_BRG) + c.l * 4;
    const float* wre = c.in(I_WRE) + (size_t)c.l * DM * 32; const float* bre = c.in(I_BRE) + c.l * 32;
    unsigned* cnt = c.ctl + CW_CNT + c.l * 32;
    float* lg = (float*)lds + wave * 16 * 48;
    if (wave < 4)
    for (int rt = blockIdx.x * 4 + wave; rt < NT / 16; rt += gridDim.x * 4) {
        const int r0 = rt * 16;
        float my_rs = 0.f;
#pragma unroll 2
        for (int rr = 0; rr < 16; ++rr) {
            const size_t ro = (size_t)(r0 + rr) * DM;
            f32x4 v[4]; float ss = 0.f;
#pragma unroll
            for (int i = 0; i < 4; ++i) { v[i] = *(const f32x4*)(c.out + ro + i * 256 + lane * 4); ss += v[i][0] * v[i][0] + v[i][1] * v[i][1] + v[i][2] * v[i][2] + v[i][3] * v[i][3]; }
            ss = wave_sum_dpp(ss);
            const float rs = rsqrtf(ss * (1.0f / DM) + 1e-6f);
            if ((lane & 15) == rr) my_rs = rs;
#pragma unroll
            for (int i = 0; i < 4; ++i) {
                const f32x4 g = *(const f32x4*)(gain + i * 256 + lane * 4);
                store_bf4(c.H + ro + i * 256 + lane * 4, (f32x4){v[i][0] * rs * g[0], v[i][1] * rs * g[1], v[i][2] * rs * g[2], v[i][3] * rs * g[3]});
            }
        }
        f32x4 acc0 = (f32x4){0.f, 0.f, 0.f, 0.f}, acc1 = acc0, acc2 = acc0;
        const float* xr = c.out + (size_t)(r0 + (lane & 15)) * DM + 4 * (lane >> 4);
        const int cl = lane & 15;
#pragma unroll 2
        for (int kb = 0; kb < 64; ++kb) {
            const f32x4 xa = *(const f32x4*)(xr + kb * 16);
            const f32x4 ga = *(const f32x4*)(gain + kb * 16 + 4 * (lane >> 4));
            const int k0 = kb * 16 + 4 * (lane >> 4);
            float b0[4], b1[4], b2[4];
#pragma unroll
            for (int m = 0; m < 4; ++m) { b0[m] = wre[(size_t)(k0 + m) * 32 + cl]; b1[m] = wre[(size_t)(k0 + m) * 32 + 16 + cl]; b2[m] = (cl < 4) ? wrg[(size_t)(k0 + m) * 4 + cl] : 0.f; }
#pragma unroll
            for (int m = 0; m < 4; ++m) {
                const float am = xa[m] * ga[m] * my_rs;
                acc0 = __builtin_amdgcn_mfma_f32_16x16x4f32(am, b0[m], acc0, 0, 0, 0);
                acc1 = __builtin_amdgcn_mfma_f32_16x16x4f32(am, b1[m], acc1, 0, 0, 0);
                acc2 = __builtin_amdgcn_mfma_f32_16x16x4f32(am, b2[m], acc2, 0, 0, 0);
            }
        }
        LDS_WAVE_SYNC();
#pragma unroll
        for (int i = 0; i < 4; ++i) { const int row = 4 * (lane >> 4) + i; lg[row * 48 + cl] = acc0[i]; lg[row * 48 + 16 + cl] = acc1[i]; lg[row * 48 + 32 + cl] = acc2[i]; }
        LDS_WAVE_SYNC();
        if (lane < 16) {
            const float* L = lg + lane * 48;
            float lgp[4];
#pragma unroll
            for (int o = 0; o < 4; ++o) lgp[o] = L[32 + o] + brg[o];
            int grp = 0; float gm = lgp[0];
#pragma unroll
            for (int o = 1; o < 4; ++o) if (lgp[o] > gm) { gm = lgp[o]; grp = o; }
            float gs = 0.f;
#pragma unroll
            for (int o = 0; o < 4; ++o) gs += __expf(lgp[o] - gm);
            const float ptop = 1.0f / gs;
            int i0 = 0; float v0 = -INFINITY; int i1 = 0; float v1 = -INFINITY;
            for (int o = 0; o < 8; ++o) { const float le = L[grp * 8 + o] + bre[grp * 8 + o]; if (le > v0) { v1 = v0; i1 = i0; v0 = le; i0 = o; } else if (le > v1) { v1 = le; i1 = o; } }
            const float e1 = __expf(v1 - v0), inv = 1.0f / (1.0f + e1);
            int* rt_ = c.ROUTE + (size_t)(r0 + lane) * 8;
            const int ex0 = grp * 8 + i0, ex1 = grp * 8 + i1;
            const float w0_ = inv * ptop, w1_ = e1 * inv * ptop;
            const int q0 = (int)atomicAdd(cnt + ex0, 1u), q1 = (int)atomicAdd(cnt + ex1, 1u);
            rt_[0] = ex0; rt_[1] = ex1; ((float*)rt_)[2] = w0_; ((float*)rt_)[3] = w1_; rt_[4] = q0; rt_[5] = q1;
            int* e0p = c.ENT + ((size_t)ex0 * NT + q0) * 2; e0p[0] = r0 + lane; ((float*)e0p)[1] = w0_;
            int* e1p = c.ENT + ((size_t)ex1 * NT + q1) * 2; e1p[0] = r0 + lane; ((float*)e1p)[1] = w1_;
        }
    }
}
DI void moe_tables(const Ctx& c, int* soff, int* stile, int ncol) {
    const unsigned* cnt = c.ctl + CW_CNT + c.l * 32;
    __syncthreads();
    if (TID() == 0) { int s = 0, tt = 0; for (int e = 0; e < 32; ++e) { soff[e] = s; stile[e] = tt; s += (int)cnt[e]; tt += (((int)cnt[e] + 255) >> 8) * ncol; } soff[32] = s; stile[32] = tt; }
    __syncthreads();
}
DI void phase_moe_up(const Ctx& c, unsigned char* lds) {
    int* soff = (int*)(lds + 2 * G_STAGE); int* stile = soff + 64;
    moe_tables(c, soff, stile, 2);
    const int total = stile[32];
    for (int item = blockIdx.x; item < total; item += gridDim.x) {
        int e = 0;
        for (int q = 1; q < 32; ++q) if (stile[q] <= item) e = q;
        const int loc = item - stile[e], tm = loc >> 1, tn = loc & 1, n0 = tn * 128;
        const int p0 = soff[e] + tm * 256, pend = soff[e + 1];
        ARows ar; ar.mu = nullptr; ar.ltype = 0; ar.first = 0;
#pragma unroll
        for (int i = 0; i < 4; ++i) { const int pr = p0 + (TID() >> 3) + 64 * i; ar.p[i] = (pr < pend) ? c.H + (size_t)c.ENT[((size_t)e * NT + (pr - soff[e])) * 2] * DM : nullptr; }
        {
            f32x4 ag[4][4]; acc_zero(ag);
            gemm_core<0>(ag, ar, (const bf16_t*)(c.ws + WS_EG) + ((size_t)e * 256 + n0) * DM, DM, DM, lds);
            ACC_FOREACH(ag, { if (p0 + r_ < pend) store_bf4(c.HID + (size_t)(p0 + r_) * 256 + n0 + c_, (f32x4){v_[0] * sigmoidf_(v_[0]), v_[1] * sigmoidf_(v_[1]), v_[2] * sigmoidf_(v_[2]), v_[3] * sigmoidf_(v_[3])}); });
        }
        f32x4 au[4][4]; acc_zero(au);
        gemm_core<0>(au, ar, (const bf16_t*)(c.ws + WS_EU) + ((size_t)e * 256 + n0) * DM, DM, DM, lds);
        ACC_FOREACH(au, { if (p0 + r_ < pend) { bf16_t* q = c.HID + (size_t)(p0 + r_) * 256 + n0 + c_; const u32x2 sv = *(const u32x2*)q;
            store_bf4(q, (f32x4){bflo(sv.x) * v_[0], bfhi(sv.x) * v_[1], bflo(sv.y) * v_[2], bfhi(sv.y) * v_[3]}); } });
    }
}
DI void phase_moe_down(const Ctx& c, unsigned char* lds) {
    int* soff = (int*)(lds + 2 * G_STAGE); int* stile = soff + 64;
    moe_tables(c, soff, stile, 8);
    const int total = stile[32];
    for (int item = blockIdx.x; item < total; item += gridDim.x) {
        int e = 0;
        for (int q = 1; q < 32; ++q) if (stile[q] <= item) e = q;
        const int loc = item - stile[e], tm = loc >> 3, tn = loc & 7, n0 = tn * 128;
        const int p0 = soff[e] + tm * 256, pend = soff[e + 1];
        ARows ar; ar.mu = nullptr; ar.ltype = 0; ar.first = 0;
#pragma unroll
        for (int i = 0; i < 4; ++i) { const int pr = p0 + (TID() >> 3) + 64 * i; ar.p[i] = (pr < pend) ? c.HID + (size_t)pr * 256 : nullptr; }
        f32x4 acc[4][4]; acc_zero(acc);
        gemm_core<0>(acc, ar, (const bf16_t*)(c.ws + WS_ED) + ((size_t)e * DM + n0) * 256, 256, 256, lds);
        ACC_FOREACH(acc, { if (p0 + r_ < pend) { const float w = ((const float*)c.ENT)[((size_t)e * NT + (p0 + r_ - soff[e])) * 2 + 1];
            store_bf4(c.Y + (size_t)(p0 + r_) * DM + n0 + c_, (f32x4){v_[0] * w, v_[1] * w, v_[2] * w, v_[3] * w}); } });
    }
}
DI void phase_final(const Ctx& c, unsigned char* lds) {
    const int tid = TID(), lane = tid & 63, wave = tid >> 6;
    const float* gain = c.in(I_NFIN);
    int* soff = (int*)(lds + 65536);
    moe_offsets(c, DEPTH - 1, soff);
    for (int row = blockIdx.x * 8 + wave; row < NT; row += gridDim.x * 8) {
        f32x4 v[4];
#pragma unroll
        for (int i = 0; i < 4; ++i) v[i] = *(const f32x4*)(c.out + (size_t)row * DM + i * 256 + lane * 4);
        add_moe_rows(c, row, lane, v, soff);
        float ss = 0.f;
#pragma unroll
        for (int i = 0; i < 4; ++i) ss += v[i][0] * v[i][0] + v[i][1] * v[i][1] + v[i][2] * v[i][2] + v[i][3] * v[i][3];
        ss = wave_sum_dpp(ss);
        const float rs = rsqrtf(ss * (1.0f / DM) + 1e-6f);
#pragma unroll
        for (int i = 0; i < 4; ++i) {
            const f32x4 g = *(const f32x4*)(gain + i * 256 + lane * 4);
            *(f32x4*)(c.out + (size_t)row * DM + i * 256 + lane * 4) = (f32x4){v[i][0] * rs * g[0], v[i][1] * rs * g[1], v[i][2] * rs * g[2], v[i][3] * rs * g[3]};
        }
    }
}

constexpr int PH_PER_LAYER = 11, N_PHASES = DEPTH * PH_PER_LAYER + 1;
__global__ void __launch_bounds__(NTHREADS, 2) fwd_kernel(Params P) {
    extern __shared__ __attribute__((aligned(16))) unsigned char lds[];
    const int lo = P.ph_lo, hi = P.ph_hi;
    LAS unsigned* xbw = (LAS unsigned*)(lds + LDS_BYTES - 16);
    if (threadIdx.x == 0) { xbw[0] = 0u; xbw[1] = 0u; xbw[2] = 0u; xbw[3] = 0u; }
    __syncthreads();
    Ctx c; c.P = &P; c.ws = P.ws; c.out = P.out; c.l = 0;
    c.ctl = (unsigned*)(P.ws + WS_CTL);
    c.H = (bf16_t*)(P.ws + WS_H); c.PROJ = (bf16_t*)(P.ws + WS_PROJ); c.F = (bf16_t*)(P.ws + WS_F); c.POOLED = (bf16_t*)(P.ws + WS_POOLED);
    c.MERGED = (bf16_t*)(P.ws + WS_F); c.CMPH = (bf16_t*)(P.ws + WS_CMPH); c.CMPO = (float*)(P.ws + WS_CMPO); c.POSB = (float*)(P.ws + WS_POSB);
    c.ROUTE = (int*)(P.ws + WS_ROUTE); c.ENT = (int*)(P.ws + WS_ENT); c.HID = (bf16_t*)(P.ws + WS_HID); c.Y = (bf16_t*)(P.ws + WS_Y);
    c.VT = (bf16_t*)(P.ws + WS_VT); c.KC = (bf16_t*)(P.ws + WS_KC); c.VCT = (bf16_t*)(P.ws + WS_VCT); c.YRAW = (bf16_t*)(P.ws + WS_YRAW); c.BON = (float*)(P.ws + WS_BON);
    XcdBarrier bar; bar.bar = c.ctl + CW_BAR; bar.x = 0; bar.st = (volatile LAS unsigned*)xbw;
    if (hi - lo > 1) bar = xcd_barrier_post(c.ctl + CW_BAR, (volatile LAS unsigned*)xbw);
#define IN(k) (lo <= (k) && (k) < hi)
#define SEAM(k) do { if (IN(k) && IN((k) + 1)) xcd_barrier(bar); } while (0)
#pragma unroll 1
    for (int l = 0; l < DEPTH; ++l) {
        c.l = l; const int pb = l * PH_PER_LAYER;
        if (IN(pb + 0)) phase_norm1(c, lds);
        SEAM(pb + 0);
        if (IN(pb + 1)) phase_gemm1(c, lds);
        SEAM(pb + 1);
        if (IN(pb + 2)) phase_prep(c, lds);
        SEAM(pb + 2);
        if (IN(pb + 3)) phase_poolgemm(c, lds);
        SEAM(pb + 3);
        if (IN(pb + 4)) phase_mix(c, lds);
        SEAM(pb + 4);
        if (IN(pb + 5)) phase_rwkv_post(c, lds);
        SEAM(pb + 5);
        if (IN(pb + 6)) phase_merge(c, lds);
        SEAM(pb + 6);
        if (IN(pb + 7)) phase_outp(c, lds);
        SEAM(pb + 7);
        if (IN(pb + 8)) phase_norm2(c, lds);
        SEAM(pb + 8);
        if (IN(pb + 9)) phase_moe_up(c, lds);
        SEAM(pb + 9);
        if (IN(pb + 10)) phase_moe_down(c, lds);
        SEAM(pb + 10);
    }
    if (IN(N_PHASES - 1)) phase_final(c, lds);
}

#ifndef MK_N_LAUNCHES
#define MK_N_LAUNCHES 1
#endif
extern "C" void kernel_launch(void* const* d_in, const int* in_sizes, int n_in, void* d_out, int out_size, void* d_ws, size_t ws_size, hipStream_t stream) {
    static int grid = 0;
    if (grid == 0) {
        if (n_in != N_IN || out_size != NT * DM || ws_size < WS_END) { fprintf(stderr, "kernel_launch: unexpected shapes n_in %d out %d ws %zu (need %zu)\n", n_in, out_size, ws_size, (size_t)WS_END); grid = -1; return; }
        int dev = 0, cus = 0, per_cu = 0;
        if (hipGetDevice(&dev) != hipSuccess || hipDeviceGetAttribute(&cus, hipDeviceAttributeMultiprocessorCount, dev) != hipSuccess) { grid = -1; return; }
        if (hipFuncSetAttribute((const void*)fwd_kernel, hipFuncAttributeMaxDynamicSharedMemorySize, LDS_BYTES) != hipSuccess) { fprintf(stderr, "kernel_launch: hipFuncSetAttribute failed\n"); grid = -1; return; }
        if (hipOccupancyMaxActiveBlocksPerMultiprocessor(&per_cu, (const void*)fwd_kernel, NTHREADS, LDS_BYTES) != hipSuccess || per_cu < 1) { fprintf(stderr, "kernel_launch: occupancy query says %d\n", per_cu); }
        (void)hipGetLastError();
        grid = cus;
    }
    if (grid < 0) return;
    if (hipMemsetAsync((char*)d_ws + WS_CTL, 0, CTL_BYTES, stream) != hipSuccess) return;
    Params p{};
    for (int i = 0; i < N_IN; ++i) p.in[i] = (const float*)d_in[i];
    p.out = (float*)d_out; p.ws = (unsigned char*)d_ws;
    if (MK_N_LAUNCHES == 1) {
        p.ph_lo = 0; p.ph_hi = N_PHASES;
        hipLaunchKernelGGL(fwd_kernel, dim3(grid), dim3(NTHREADS), LDS_BYTES, stream, p);
    } else {
        for (int k = 0; k < N_PHASES; ++k) { p.ph_lo = k; p.ph_hi = k + 1; hipLaunchKernelGGL(fwd_kernel, dim3(grid), dim3(NTHREADS), LDS_BYTES, stream, p); }
    }
}
```

```cpp
#include <hip/hip_runtime.h>
#include <cstdio>
#include <cstdint>

#define DI __device__ __forceinline__
typedef unsigned short bf16_t;
typedef short bf16x8 __attribute__((ext_vector_type(8)));
typedef float f32x4 __attribute__((ext_vector_type(4)));
typedef unsigned u32x4 __attribute__((ext_vector_type(4)));
typedef unsigned u32x2 __attribute__((ext_vector_type(2)));

constexpr int NB = 4, SEQ = 4096, DM = 1024, NT = NB * SEQ, DEPTH = 2;
constexpr int IN_COLS = 4816;
constexpr int C_POOL = 0, C_RW = 512, C_R = 512, C_K = 1024, C_V = 1536, C_WD = 2048, C_AD = 2080, C_GD = 2112;
constexpr int C_Q = 2208, C_KC = 3232, C_VC = 3488, C_KS = 3744, C_VS = 4000, C_KW = 4256, C_VW = 4512, C_GATE = 4768;
constexpr int RWC = 1696;
constexpr int NCMP = 255;
constexpr int NTHREADS = 512;
constexpr int LDS_BYTES = 155648;

enum { I_X = 0, I_RELB, I_NMIX, I_WIN, I_POOLW, I_POOLS, I_MU, I_W0, I_WUP, I_A0, I_AUP, I_GUP, I_KK, I_KA, I_RK, I_GNW, I_GNB,
       I_CPK, I_CW1K, I_CW2K, I_CPV, I_CW1V, I_CW2V, I_WBR, I_WMG, I_BMG, I_WOUT, I_NFFN, I_WRG, I_BRG, I_WRE, I_BRE, I_EG, I_EU, I_ED, I_NFIN, N_IN };

constexpr size_t WS_CTL = 0;
constexpr size_t CTL_BYTES = 65536;
constexpr size_t WS_H = CTL_BYTES;
constexpr size_t WS_PROJ = WS_H + (size_t)NT * DM * 2;
constexpr size_t WS_F = WS_PROJ + (size_t)NT * IN_COLS * 2;
constexpr size_t PLANE = (size_t)NT * 512 * 2;
constexpr size_t WS_POOLED = WS_F + 6 * PLANE;
constexpr size_t WS_CMPH = WS_POOLED + PLANE;
constexpr size_t WS_CMPO = WS_CMPH + (size_t)2 * 4096 * 256 * 2;
constexpr size_t WS_POSB = WS_CMPO + (size_t)2 * 4096 * 64 * 4;
constexpr size_t WS_ROUTE = WS_POSB + 4096;
constexpr size_t WS_ENT = WS_ROUTE + (size_t)NT * 32;
constexpr size_t WS_VT = WS_ENT + (size_t)32 * NT * 8;
constexpr size_t WS_KC = WS_VT + (size_t)2 * 16 * 64 * SEQ * 2;
constexpr size_t WS_VCT = WS_KC + (size_t)16 * 256 * 64 * 2;
constexpr size_t WS_YRAW = WS_VCT + (size_t)16 * 64 * 256 * 2;
constexpr size_t WS_BON = WS_YRAW + (size_t)NT * 512 * 2;
constexpr size_t WS_SMALLW = WS_BON + (size_t)NT * 8 * 16;
constexpr size_t WS_WT_LORA = WS_SMALLW + 262144;
constexpr size_t WS_END = WS_WT_LORA + (size_t)1536 * 128 * 2;
constexpr size_t WS_WT_IN = WS_F;
constexpr size_t WS_WT_C1 = WS_CMPO;
constexpr size_t WS_WT_C2 = WS_SMALLW;
constexpr size_t WS_WT_POOL = WS_SMALLW + 131072;
constexpr size_t WS_WT_MG = WS_VT;
constexpr size_t WS_WT_BR = WS_VT + (size_t)3072 * 1024 * 2;
constexpr size_t WS_WT_OUT = WS_CMPH;
constexpr size_t WS_EG = WS_F + 2 * PLANE;
constexpr size_t WS_EU = WS_EG + (size_t)32 * 256 * 1024 * 2;
constexpr size_t WS_ED = WS_EU + (size_t)32 * 256 * 1024 * 2;
static_assert(WS_ED + (size_t)32 * 1024 * 256 * 2 <= WS_F + 6 * PLANE, "expert alias");
static_assert(WS_WT_BR + (size_t)2048 * 1024 * 2 <= WS_VT + (size_t)2 * 16 * 64 * SEQ * 2, "merge alias");
static_assert((size_t)4864 * 1024 * 2 <= 6 * PLANE, "w_in alias");
constexpr size_t WS_HID = WS_PROJ;
constexpr size_t WS_Y = WS_PROJ + (size_t)2 * NT * 256 * 2;
static_assert(WS_Y + (size_t)2 * NT * 1024 * 2 <= WS_F, "alias");
constexpr int CW_BAR = 0;
constexpr int CW_CNT = 4096;
constexpr int CW_CUR = 4096 + 64;
constexpr int CW_Q = 4096 + 128;

#define XB_TMO      128
#define XB_XCNT(j)  (256  + 64 * (j))
#define XB_XSUB(j)  (1280 + 64 * (j))
#define XB_XGEN(j)  (2304 + 64 * (j))
#define XB_TOP      3328
#define XB_TOPGEN   3392
#define XCD_BAR_WORDS 3456
#define XB_SPIN_CAP (1u << 18)
#define LAS __attribute__((address_space(3)))

__device__ __forceinline__ unsigned xb_ld(unsigned* p)              { return __hip_atomic_load(p, __ATOMIC_RELAXED, __HIP_MEMORY_SCOPE_AGENT); }
__device__ __forceinline__ unsigned xb_add(unsigned* p, unsigned v) { return __hip_atomic_fetch_add(p, v, __ATOMIC_RELAXED, __HIP_MEMORY_SCOPE_AGENT); }
__device__ __forceinline__ unsigned xb_xcc_id() { return (unsigned)__builtin_amdgcn_s_getreg((3 << 11) | 20) & 0xFu; }
#define XB_SPIN(cond, bar) do { unsigned _sp = 0; while (cond) { __builtin_amdgcn_s_sleep(1); \
    if ((++_sp & 255u) == 0u) { if (xb_ld(&(bar)[XB_TMO])) break; if (_sp > XB_SPIN_CAP) { atomicAdd(&(bar)[XB_TMO], 1u); break; } } } } while (0)

struct XcdBarrier { unsigned* bar; unsigned x; volatile LAS unsigned* st; };

__device__ __forceinline__ XcdBarrier xcd_barrier_post(unsigned* bar, volatile LAS unsigned* st) {
    XcdBarrier b; b.bar = bar; b.x = xb_xcc_id(); b.st = st;
    if (threadIdx.x == 0) (void)xb_add(&bar[XB_XCNT(b.x)], 1u);
    return b;
}
__device__ __forceinline__ void xcd_barrier_complete(unsigned* bar, unsigned x, unsigned& nloc, unsigned& nx) {
    const unsigned G = gridDim.x * gridDim.y * gridDim.z;
    unsigned sum, cnt, mine, sp = 0u;
    for (;;) {
        sum = 0u; cnt = 0u; mine = 0u;
#pragma unroll
        for (unsigned j = 0; j < 16; ++j) { const unsigned c = xb_ld(&bar[XB_XCNT(j)]); sum += c; cnt += (c > 0u) ? 1u : 0u; mine = (j == x) ? c : mine; }
        if (sum == G) break;
        __builtin_amdgcn_s_sleep(1);
        if ((++sp & 255u) == 0u) { if (xb_ld(&bar[XB_TMO])) break; if (sp > XB_SPIN_CAP) { atomicAdd(&bar[XB_TMO], 1u); break; } }
    }
    nloc = mine > 0u ? mine : 1u; nx = cnt > 0u ? cnt : 1u;
}
__device__ __forceinline__ void xcd_barrier(const XcdBarrier& b) {
    asm volatile("s_waitcnt vmcnt(0)" ::: "memory");
    __syncthreads();
    if (threadIdx.x == 0) {
        unsigned* bar = b.bar;
        __builtin_amdgcn_s_waitcnt(0);
        unsigned nloc = b.st[0], nx = b.st[1];
        if (nloc == 0u) { xcd_barrier_complete(bar, b.x, nloc, nx); b.st[0] = nloc; b.st[1] = nx; }
        const unsigned old = xb_add(&bar[XB_XSUB(b.x)], 1u);
        const unsigned gen = old / nloc;
        if (old + 1u == (gen + 1u) * nloc) {
            __builtin_amdgcn_fence(__ATOMIC_RELEASE, "agent");
            asm volatile("s_waitcnt vmcnt(0)" ::: "memory");
            const unsigned og = xb_add(&bar[XB_TOP], 1u);
            const unsigned tg = og / nx;
            if (og + 1u == (tg + 1u) * nx) xb_add(&bar[XB_TOPGEN], 1u);
            else XB_SPIN(xb_ld(&bar[XB_TOPGEN]) == tg, bar);
            __builtin_amdgcn_fence(__ATOMIC_ACQUIRE, "agent");
            xb_add(&bar[XB_XGEN(b.x)], 1u);
            asm volatile("s_waitcnt vmcnt(0)" ::: "memory");
        } else {
            XB_SPIN(xb_ld(&bar[XB_XGEN(b.x)]) == gen, bar);
            __builtin_amdgcn_fence(__ATOMIC_ACQUIRE, "agent");
            asm volatile("s_waitcnt vmcnt(0)" ::: "memory");
        }
    }
    __syncthreads();
}

DI bf16_t f2bf(float x) { unsigned u = __float_as_uint(x); u += 0x7fffu + ((u >> 16) & 1u); return (bf16_t)(u >> 16); }
DI float bf2f(bf16_t b) { return __uint_as_float((unsigned)b << 16); }
typedef __bf16 bf16v2_t __attribute__((ext_vector_type(2)));
typedef float f32v2_t __attribute__((ext_vector_type(2)));
DI unsigned pack2(float lo, float hi) { const f32v2_t v = {lo, hi}; const bf16v2_t b = __builtin_convertvector(v, bf16v2_t); return __builtin_bit_cast(unsigned, b); }
DI float bflo(unsigned w) { return __uint_as_float(w << 16); }
DI float bfhi(unsigned w) { return __uint_as_float(w & 0xffff0000u); }
DI float wave_sum(float v) {
#pragma unroll
    for (int o = 32; o >= 1; o >>= 1) v += __shfl_xor(v, o);
    return v;
}
DI float wave_max(float v) {
#pragma unroll
    for (int o = 32; o >= 1; o >>= 1) v = fmaxf(v, __shfl_xor(v, o));
    return v;
}
DI float sigmoidf_(float x) { return __builtin_amdgcn_rcpf(1.0f + __expf(-x)); }
DI int TID() { int t = threadIdx.x; asm volatile("" : "+v"(t)); return t; }
#define LDS_WAVE_SYNC() asm volatile("s_waitcnt lgkmcnt(0)" ::: "memory")

#define DPP_MOV(v, ctrl) __builtin_bit_cast(float, __builtin_amdgcn_update_dpp(0, __builtin_bit_cast(int, (v)), (ctrl), 0xF, 0xF, true))
DI float wave_sum_dpp(float v) {
    v += DPP_MOV(v, 0xB1); v += DPP_MOV(v, 0x4E); v += DPP_MOV(v, 0x141); v += DPP_MOV(v, 0x140);
    return __builtin_bit_cast(float, __builtin_amdgcn_readlane(__builtin_bit_cast(int, v), 0)) + __builtin_bit_cast(float, __builtin_amdgcn_readlane(__builtin_bit_cast(int, v), 16)) +
        (__builtin_bit_cast(float, __builtin_amdgcn_readlane(__builtin_bit_cast(int, v), 32)) + __builtin_bit_cast(float, __builtin_amdgcn_readlane(__builtin_bit_cast(int, v), 48)));
}
struct Params { const float* in[N_IN]; float* out; unsigned char* ws; int ph_lo, ph_hi; };

DI int t5_bucket(int n) {
    if (n < 16) return n;
    if (n >= 128) return 31;
    int b = 16;
    b += (n >= 19) + (n >= 21) + (n >= 24) + (n >= 27) + (n >= 31) + (n >= 35) + (n >= 40) + (n >= 46) + (n >= 52) + (n >= 59) + (n >= 67) + (n >= 77) + (n >= 87) + (n >= 99) + (n >= 113);
    return b;
}

constexpr int G_A = 0, G_B = 256 * 64 * 2, G_STAGE = (256 + 128) * 64 * 2;
static_assert(2 * G_STAGE <= LDS_BYTES - 64, "gemm lds");
DI int g_off(int r, int c) { return ((r >> 4) * 2 + (c >> 5)) * 1024 + ((((r & 15) * 64) + (c & 31) * 2) ^ ((((r & 15) >> 3) & 1) << 5)); }
struct ARows { const bf16_t* p[4]; const float* mu; int ltype; int first; };
DI float tanhf_fast(float x) { const float e = __expf(2.0f * x); return 1.0f - 2.0f * __builtin_amdgcn_rcpf(e + 1.0f); }
DI u32x4 lora_chunk(const bf16_t* prow, bool first, const float* mu, int ltype, int k) {
    const int lim = (ltype == 2) ? 96 : 32;
    if (k >= lim) return (u32x4){0u, 0u, 0u, 0u};
    const int col = C_WD + ltype * 32 + k;
    const u32x4 cu = *(const u32x4*)(prow + col);
    u32x4 pu = (u32x4){0u, 0u, 0u, 0u};
    if (!first) pu = *(const u32x4*)(prow - IN_COLS + col);
    const f32x4 m0 = *(const f32x4*)(mu + col - C_RW), m1 = *(const f32x4*)(mu + col - C_RW + 4);
    float u[8] = {bflo(cu.x), bfhi(cu.x), bflo(cu.y), bfhi(cu.y), bflo(cu.z), bfhi(cu.z), bflo(cu.w), bfhi(cu.w)};
    const float p[8] = {bflo(pu.x), bfhi(pu.x), bflo(pu.y), bfhi(pu.y), bflo(pu.z), bfhi(pu.z), bflo(pu.w), bfhi(pu.w)};
    const float mm[8] = {m0[0], m0[1], m0[2], m0[3], m1[0], m1[1], m1[2], m1[3]};
#pragma unroll
    for (int j = 0; j < 8; ++j) { const float us = u[j] + (p[j] - u[j]) * mm[j]; u[j] = (ltype == 0) ? tanhf_fast(us) : ((ltype == 1) ? us : __builtin_amdgcn_rcpf(1.0f + __expf(-us))); }
    u32x4 w; w.x = pack2(u[0], u[1]); w.y = pack2(u[2], u[3]); w.z = pack2(u[4], u[5]); w.w = pack2(u[6], u[7]);
    return w;
}
template <int AMODE>
DI void g_load(u32x4 (&ra)[4], u32x4 (&rb)[2], const ARows& ar, const bf16_t* bt, int ldb, int k0, int tid) {
    const int kseg = (tid & 7) * 8;
#pragma unroll
    for (int i = 0; i < 4; ++i) {
        ra[i] = (u32x4){0u, 0u, 0u, 0u};
        if (AMODE == 2) ra[i] = lora_chunk(ar.p[i], (ar.first >> i) & 1, ar.mu, ar.ltype, k0 + kseg);
        else if (ar.p[i] != nullptr) ra[i] = *(const u32x4*)((AMODE == 0) ? (ar.p[i] + k0 + kseg) : (ar.p[i] + (size_t)(k0 >> 6) * IN_COLS + kseg));
    }
#pragma unroll
    for (int i = 0; i < 2; ++i) rb[i] = *(const u32x4*)(bt + (size_t)((tid >> 3) + 64 * i) * ldb + k0 + kseg);
}
DI void g_store(unsigned char* st, const u32x4 (&ra)[4], const u32x4 (&rb)[2], int tid) {
    const int off = g_off(tid >> 3, (tid & 7) * 8);
#pragma unroll
    for (int i = 0; i < 4; ++i) *(u32x4*)(st + G_A + off + i * 8192) = ra[i];
#pragma unroll
    for (int i = 0; i < 2; ++i) *(u32x4*)(st + G_B + off + i * 8192) = rb[i];
}
DI void g_compute(f32x4 (&acc)[4][4], const unsigned char* st, int lane, int wm, int wn) {
    const int lo = ((lane & 15) * 64 + (lane >> 4) * 16) ^ ((((lane & 15) >> 3) & 1) << 5);
    const unsigned char* sA = st + G_A + wm * 8192 + lo;
    const unsigned char* sB = st + G_B + wn * 8192 + lo;
    bf16x8 bcur[4], bnxt[4], a0, a1, a2;
#pragma unroll
    for (int i = 0; i < 4; ++i) bcur[i] = *(const bf16x8*)(sB + i * 2048);
    a0 = *(const bf16x8*)(sA);
    a1 = *(const bf16x8*)(sA + 2048);
#define G_AFRAG(s) (*(const bf16x8*)(sA + ((s) & 3) * 2048 + ((s) >> 2) * 1024))
#define G_GROUP(s, acur, anew) do { \
        if ((s) + 2 < 8) anew = G_AFRAG((s) + 2); \
        if ((s) < 4) bnxt[(s) & 3] = *(const bf16x8*)(sB + ((s) & 3) * 2048 + 1024); \
        __builtin_amdgcn_sched_barrier(0); \
        _Pragma("unroll") for (int ni = 0; ni < 4; ++ni) acc[(s) & 3][ni] = __builtin_amdgcn_mfma_f32_16x16x32_bf16(((s) < 4 ? bcur[ni] : bnxt[ni]), acur, acc[(s) & 3][ni], 0, 0, 0); \
        __builtin_amdgcn_sched_barrier(0); } while (0)
    G_GROUP(0, a0, a2); G_GROUP(1, a1, a0); G_GROUP(2, a2, a1); G_GROUP(3, a0, a2);
    G_GROUP(4, a1, a0); G_GROUP(5, a2, a1); G_GROUP(6, a0, a2); G_GROUP(7, a1, a0);
#undef G_GROUP
#undef G_AFRAG
}
#define LDS_BARRIER() do { asm volatile("s_waitcnt lgkmcnt(0)" ::: "memory"); __builtin_amdgcn_s_barrier(); asm volatile("" ::: "memory"); } while (0)
template <int AMODE>
DI void gemm_core(f32x4 (&acc)[4][4], const ARows& ar, const bf16_t* bt  , int ldb, int K, unsigned char* lds) {
    const int tid = TID(), lane = tid & 63, wave = tid >> 6, wm = wave >> 1, wn = wave & 1;
    const int nk = K >> 6;
    unsigned char* s0 = lds; unsigned char* s1 = lds + G_STAGE;
    u32x4 ra0[4], rb0[2], ra1[4], rb1[2];
    g_load<AMODE>(ra0, rb0, ar, bt, ldb, 0, tid);
    g_load<AMODE>(ra1, rb1, ar, bt, ldb, 64, tid);
    __syncthreads();
    g_store(s0, ra0, rb0, tid);
    g_load<AMODE>(ra0, rb0, ar, bt, ldb, (nk > 2 ? 2 : nk - 1) * 64, tid);
    LDS_BARRIER();
    for (int kt = 0; kt < nk; kt += 2) {
        g_store(s1, ra1, rb1, tid);
        { const int kn = (kt + 3 < nk) ? kt + 3 : nk - 1; g_load<AMODE>(ra1, rb1, ar, bt, ldb, kn * 64, tid); }
        g_compute(acc, s0, lane, wm, wn);
        LDS_BARRIER();
        g_store(s0, ra0, rb0, tid);
        { const int kn = (kt + 4 < nk) ? kt + 4 : nk - 1; g_load<AMODE>(ra0, rb0, ar, bt, ldb, kn * 64, tid); }
        g_compute(acc, s1, lane, wm, wn);
        LDS_BARRIER();
    }
}
static_assert(3 * G_STAGE <= LDS_BYTES - 64, "dma ring");
DI void gemm_core_dma(f32x4 (&acc)[4][4], const bf16_t* A, size_t lda, const bf16_t* bt, size_t ldb, int K, unsigned char* lds) {
    const int tid = TID(), lane = tid & 63, wave = __builtin_amdgcn_readfirstlane(tid >> 6), wm = wave >> 1, wn = wave & 1;
    const int nk = K >> 6;
    const int srow = lane >> 2, skof = ((lane & 3) * 8) ^ ((lane >> 5) << 4);
    const char* gp[6]; int loff[6];
#pragma unroll
    for (int j = 0; j < 6; ++j) {
        const int sid = wave * 6 + j;
        if (sid < 32) { gp[j] = (const char*)(A + (size_t)((sid >> 1) * 16 + srow) * lda + (sid & 1) * 32 + skof); loff[j] = G_A + sid * 1024; }
        else { const int s2 = sid - 32; gp[j] = (const char*)(bt + (size_t)((s2 >> 1) * 16 + srow) * ldb + (s2 & 1) * 32 + skof); loff[j] = G_B + s2 * 1024; }
    }
#define DMA_ISSUE(kt_, st_) do { const int _k = ((kt_) < nk ? (kt_) : nk - 1) * 128; \
        _Pragma("unroll") for (int j = 0; j < 6; ++j) __builtin_amdgcn_global_load_lds((const unsigned*)(gp[j] + _k), (LAS unsigned*)(lds + (st_) * G_STAGE + loff[j]), 16, 0, 0); } while (0)
    asm volatile("s_waitcnt vmcnt(0)" ::: "memory");
    __syncthreads();
    DMA_ISSUE(0, 0); DMA_ISSUE(1, 1);
    int st = 0;
    for (int kt = 0; kt < nk; ++kt) {
        asm volatile("s_waitcnt vmcnt(6)" ::: "memory");
        __builtin_amdgcn_s_barrier();
        asm volatile("" ::: "memory");
        const int sn = (st == 0) ? 2 : st - 1;
        DMA_ISSUE(kt + 2, sn);
        g_compute(acc, lds + st * G_STAGE, lane, wm, wn);
        st = (st == 2) ? 0 : st + 1;
    }
    asm volatile("s_waitcnt vmcnt(0)" ::: "memory");
    __syncthreads();
#undef DMA_ISSUE
}
DI void store_bf4(bf16_t* p, f32x4 v) { u32x2 w; w.x = pack2(v[0], v[1]); w.y = pack2(v[2], v[3]); *(u32x2*)p = w; }
constexpr int H_A = 0, H_B = 256 * 64 * 2, H_STAGE = 2 * 256 * 64 * 2;
static_assert(2 * H_STAGE <= LDS_BYTES - 64, "gemm256 lds");
DI void h_compute(f32x4 (&acc)[8][4], const unsigned char* st, int lane, int wm, int wn) {
    const int lo = ((lane & 15) * 64 + (lane >> 4) * 16) ^ ((((lane & 15) >> 3) & 1) << 5);
    const unsigned char* sA = st + H_A + wm * 16384 + lo;
    const unsigned char* sB = st + H_B + wn * 8192 + lo;
#pragma unroll
    for (int ks = 0; ks < 2; ++ks) {
        bf16x8 bf[4], a0, a1, a2;
#pragma unroll
        for (int i = 0; i < 4; ++i) bf[i] = *(const bf16x8*)(sB + i * 2048 + ks * 1024);
        a0 = *(const bf16x8*)(sA + ks * 1024);
        a1 = *(const bf16x8*)(sA + 2048 + ks * 1024);
#define H_GROUP(s, acur, anew) do { \
        if ((s) + 2 < 8) anew = *(const bf16x8*)(sA + ((s) + 2) * 2048 + ks * 1024); \
        __builtin_amdgcn_sched_barrier(0); \
        _Pragma("unroll") for (int ni = 0; ni < 4; ++ni) acc[(s)][ni] = __builtin_amdgcn_mfma_f32_16x16x32_bf16(bf[ni], acur, acc[(s)][ni], 0, 0, 0); \
        __builtin_amdgcn_sched_barrier(0); } while (0)
        H_GROUP(0, a0, a2); H_GROUP(1, a1, a0); H_GROUP(2, a2, a1); H_GROUP(3, a0, a2);
        H_GROUP(4, a1, a0); H_GROUP(5, a2, a1); H_GROUP(6, a0, a2); H_GROUP(7, a1, a0);
#undef H_GROUP
    }
}
DI void gemm256_dma(f32x4 (&acc)[8][4], const bf16_t* A, size_t lda, const bf16_t* bt, size_t ldb, int K, unsigned char* lds) {
    const int tid = TID(), lane = tid & 63, wave = __builtin_amdgcn_readfirstlane(tid >> 6), wm = wave >> 2, wn = wave & 3;
    const int nk = K >> 6;
    const int srow = lane >> 2, skof = ((lane & 3) * 8) ^ ((lane >> 5) << 4);
    const char* gp[8]; int loff[8];
#pragma unroll
    for (int j = 0; j < 8; ++j) {
        const int sid = wave * 8 + j;
        if (sid < 32) { gp[j] = (const char*)(A + (size_t)((sid >> 1) * 16 + srow) * lda + (sid & 1) * 32 + skof); loff[j] = H_A + sid * 1024; }
        else { const int s2 = sid - 32; gp[j] = (const char*)(bt + (size_t)((s2 >> 1) * 16 + srow) * ldb + (s2 & 1) * 32 + skof); loff[j] = H_B + s2 * 1024; }
    }
#define H_ISSUE(kt_, st_) do { const int _k = ((kt_) < nk ? (kt_) : nk - 1) * 128; \
        _Pragma("unroll") for (int j = 0; j < 8; ++j) __builtin_amdgcn_global_load_lds((const unsigned*)(gp[j] + _k), (LAS unsigned*)(lds + (st_) * H_STAGE + loff[j]), 16, 0, 0); } while (0)
    asm volatile("s_waitcnt vmcnt(0)" ::: "memory");
    __syncthreads();
    H_ISSUE(0, 0);
    for (int kt = 0; kt < nk; ++kt) {
        asm volatile("s_waitcnt vmcnt(0)" ::: "memory");
        __builtin_amdgcn_s_barrier();
        asm volatile("" ::: "memory");
        H_ISSUE(kt + 1, (kt + 1) & 1);
        h_compute(acc, lds + (kt & 1) * H_STAGE, lane, wm, wn);
    }
    asm volatile("s_waitcnt vmcnt(0)" ::: "memory");
    __syncthreads();
#undef H_ISSUE
}
DI void tile256_store_bf16(f32x4 (&acc)[8][4], bf16_t* out, size_t ld, int ncols, unsigned char* lds) {
    bf16_t* T = (bf16_t*)lds;
    const int tid = TID(), lane = tid & 63, wave = tid >> 6, wm = wave >> 2, wn = wave & 3;
    __syncthreads();
#pragma unroll
    for (int mi = 0; mi < 8; ++mi)
#pragma unroll
        for (int ni = 0; ni < 4; ++ni) store_bf4(T + (wm * 128 + mi * 16 + (lane & 15)) * 264 + wn * 64 + ni * 16 + (lane >> 4) * 4, acc[mi][ni]);
    __syncthreads();
#pragma unroll
    for (int i = 0; i < 16; ++i) {
        const int ch = tid + i * NTHREADS, r = ch >> 5, cc = (ch & 31) * 8;
        if (cc < ncols) *(u32x4*)(out + (size_t)r * ld + cc) = *(const u32x4*)(T + r * 264 + cc);
    }
}
DI void acc_zero(f32x4 (&acc)[4][4]) {
#pragma unroll
    for (int i = 0; i < 4; ++i)
#pragma unroll
        for (int j = 0; j < 4; ++j) acc[i][j] = (f32x4){0.f, 0.f, 0.f, 0.f};
}
#define ACC_FOREACH(acc, body) do { const int _l = TID() & 63, _w = TID() >> 6; \
    _Pragma("unroll") for (int _mi = 0; _mi < 4; ++_mi) _Pragma("unroll") for (int _ni = 0; _ni < 4; ++_ni) { \
        const int r_ = (_w >> 1) * 64 + _mi * 16 + (_l & 15), c_ = (_w & 1) * 64 + _ni * 16 + (_l >> 4) * 4; f32x4& v_ = acc[_mi][_ni]; body } } while (0)
DI ARows plain_rows(const bf16_t* base, size_t ld, int m0, int tid) { ARows a; a.mu = nullptr; a.ltype = 0; a.first = 0;
#pragma unroll
    for (int i = 0; i < 4; ++i) a.p[i] = base + (size_t)(m0 + (tid >> 3) + 64 * i) * ld;
    return a; }


DI void convert_tile4(const float* src, int ld, int N, int K, bf16_t* dst, int tile0, unsigned char* lds, int Kvalid = 1 << 30) {
    const int tid = TID();
    const int nkt = K >> 6;
    const int r = tid >> 3, seg = (tid & 7) * 8;
    f32x4 a[4], b[4];
#pragma unroll
    for (int u = 0; u < 4; ++u) {
        const int tile = tile0 + u, k0 = (tile % nkt) * 64, n0 = (tile / nkt) * 64;
        a[u] = (f32x4){0.f, 0.f, 0.f, 0.f}; b[u] = a[u];
        if (n0 + seg < N && k0 + r < Kvalid) { const float* q = src + (size_t)(k0 + r) * ld + n0 + seg; a[u] = *(const f32x4*)q; b[u] = *(const f32x4*)(q + 4); }
    }
    __syncthreads();
#pragma unroll
    for (int u = 0; u < 4; ++u) { bf16_t* T = (bf16_t*)lds + u * 64 * 72;
        u32x4 w; w.x = pack2(a[u][0], a[u][1]); w.y = pack2(a[u][2], a[u][3]); w.z = pack2(b[u][0], b[u][1]); w.w = pack2(b[u][2], b[u][3]); *(u32x4*)(T + r * 72 + seg) = w; }
    __syncthreads();
#pragma unroll
    for (int u = 0; u < 4; ++u) { const bf16_t* T = (const bf16_t*)lds + u * 64 * 72;
        const int tile = tile0 + u, k0 = (tile % nkt) * 64, n0 = (tile / nkt) * 64;
        u32x4 o;
        o.x = (unsigned)T[(seg + 0) * 72 + r] | ((unsigned)T[(seg + 1) * 72 + r] << 16); o.y = (unsigned)T[(seg + 2) * 72 + r] | ((unsigned)T[(seg + 3) * 72 + r] << 16);
        o.z = (unsigned)T[(seg + 4) * 72 + r] | ((unsigned)T[(seg + 5) * 72 + r] << 16); o.w = (unsigned)T[(seg + 6) * 72 + r] | ((unsigned)T[(seg + 7) * 72 + r] << 16);
        *(u32x4*)(dst + (size_t)(n0 + r) * K + k0 + seg) = o; }
}
struct Ctx {
    const Params* P; unsigned char* ws; float* out; int l;
    bf16_t* H; bf16_t* PROJ; bf16_t* F; bf16_t* POOLED; bf16_t* MERGED; bf16_t* CMPH; float* CMPO; float* POSB; int* ROUTE; int* ENT; bf16_t* HID; bf16_t* Y; bf16_t* VT; bf16_t* KC; bf16_t* VCT; bf16_t* YRAW; float* BON; unsigned* ctl;
    DI const float* in(int i) const { return P->in[i]; }
};

DI void moe_offsets(const Ctx& c, int layer, int* soff) {
    const unsigned* cnt = c.ctl + CW_CNT + layer * 32;
    __syncthreads();
    if (TID() == 0) { int s = 0; for (int e = 0; e < 32; ++e) { soff[e] = s; s += (int)cnt[e]; } soff[32] = s; }
    __syncthreads();
}
DI void add_moe_rows(const Ctx& c, int row, int lane, f32x4 (&v)[4], const int* soff) {
    const int* rt = c.ROUTE + (size_t)row * 8;
    const int p0 = soff[rt[0]] + rt[4], p1 = soff[rt[1]] + rt[5];
    const bf16_t* y0 = c.Y + (size_t)p0 * DM; const bf16_t* y1 = c.Y + (size_t)p1 * DM;
#pragma unroll
    for (int i = 0; i < 4; ++i) {
        const u32x2 a = *(const u32x2*)(y0 + i * 256 + lane * 4), b = *(const u32x2*)(y1 + i * 256 + lane * 4);
        v[i][0] += bflo(a.x) + bflo(b.x); v[i][1] += bfhi(a.x) + bfhi(b.x); v[i][2] += bflo(a.y) + bflo(b.y); v[i][3] += bfhi(a.y) + bfhi(b.y);
    }
}
DI void phase_norm1(const Ctx& c, unsigned char* lds) {
    const int tid = TID(), lane = tid & 63, wave = tid >> 6;
    const float* gain = c.in(I_NMIX) + c.l * DM;
    const float* src = (c.l == 0) ? c.in(I_X) : c.out;
    int* soff = (int*)(lds + 65536);
    if (c.l > 0) moe_offsets(c, c.l - 1, soff);
    for (int row = blockIdx.x * 8 + wave; row < NT; row += gridDim.x * 8) {
        f32x4 v[4];
#pragma unroll
        for (int i = 0; i < 4; ++i) v[i] = *(const f32x4*)(src + (size_t)row * DM + i * 256 + lane * 4);
        if (c.l > 0) {
            add_moe_rows(c, row, lane, v, soff);
#pragma unroll
            for (int i = 0; i < 4; ++i) *(f32x4*)(c.out + (size_t)row * DM + i * 256 + lane * 4) = v[i];
        }
        float ss = 0.f;
#pragma unroll
        for (int i = 0; i < 4; ++i) ss += v[i][0] * v[i][0] + v[i][1] * v[i][1] + v[i][2] * v[i][2] + v[i][3] * v[i][3];
        ss = wave_sum_dpp(ss);
        const float rs = rsqrtf(ss * (1.0f / DM) + 1e-6f);
#pragma unroll
        for (int i = 0; i < 4; ++i) {
            const f32x4 g = *(const f32x4*)(gain + i * 256 + lane * 4);
            store_bf4(c.H + (size_t)row * DM + i * 256 + lane * 4, (f32x4){v[i][0] * rs * g[0], v[i][1] * rs * g[1], v[i][2] * rs * g[2], v[i][3] * rs * g[3]});
        }
    }
    for (int idx = blockIdx.x * 8 + wave; idx < 512; idx += gridDim.x * 8) {
        const int kv = idx >> 8, n = idx & 255;
        const float* pos = c.in(kv ? I_CPV : I_CPK) + (size_t)c.l * 2048;
        const float* w1 = c.in(kv ? I_CW1V : I_CW1K) + (size_t)c.l * 2048 * 256;
        float s = 0.f;
        for (int k = lane; k < 2048; k += 64) s += pos[k] * w1[(size_t)k * 256 + n];
        s = wave_sum_dpp(s);
        if (lane == 0) c.POSB[kv * 256 + n] = s;
    }
    for (int it = blockIdx.x * 4; it < 1216 + 256 + 16 + 16 + 48; it += gridDim.x * 4) {
        if (it < 1216) convert_tile4(c.in(I_WIN) + (size_t)c.l * DM * IN_COLS, IN_COLS, IN_COLS, DM, (bf16_t*)(c.ws + WS_WT_IN), it, lds);
        else if (it < 1216 + 256) { const int j = it - 1216, kv = j >> 7; convert_tile4(c.in(kv ? I_CW1V : I_CW1K) + (size_t)c.l * 2048 * 256, 256, 256, 2048, (bf16_t*)(c.ws + WS_WT_C1) + (size_t)kv * 256 * 2048, j & 127, lds); }
        else if (it < 1216 + 256 + 16) { const int j = it - 1472, kv = j >> 3; convert_tile4(c.in(kv ? I_CW2V : I_CW2K) + (size_t)c.l * 256 * 64, 64, 64, 256, (bf16_t*)(c.ws + WS_WT_C2) + (size_t)kv * 128 * 256, j & 7, lds); }
        else if (it < 1504) { const int j = it - 1488, gi = j >> 2; convert_tile4(c.in(I_POOLW) + ((size_t)c.l * 4 + gi) * 128 * 128, 128, 128, 128, (bf16_t*)(c.ws + WS_WT_POOL) + (size_t)gi * 128 * 128, 0, lds); }
        else { const int j = it - 1504, ty = j >> 4; bf16_t* dst = (bf16_t*)(c.ws + WS_WT_LORA) + (size_t)ty * 512 * 128;
            if (ty == 0) convert_tile4(c.in(I_WUP) + (size_t)c.l * 32 * 512, 512, 512, 128, dst, j & 15, lds, 32);
            else if (ty == 1) convert_tile4(c.in(I_AUP) + (size_t)c.l * 32 * 512, 512, 512, 128, dst, j & 15, lds, 32);
            else convert_tile4(c.in(I_GUP) + (size_t)c.l * 96 * 512, 512, 512, 128, dst, j & 15, lds, 96); }
    }
}

constexpr int EPS = 136;
DI void tile_store_bf16(f32x4 (&acc)[4][4], bf16_t* out, size_t ld, int nrows, int ncols, unsigned char* lds) {
    bf16_t* T = (bf16_t*)lds;
    const int tid = TID();
    __syncthreads();
    ACC_FOREACH(acc, { store_bf4(T + r_ * EPS + c_, v_); });
    __syncthreads();
#pragma unroll
    for (int i = 0; i < 8; ++i) {
        const int ch = tid + i * NTHREADS, r = ch >> 4, cc = (ch & 15) * 8;
        if (r < nrows && cc < ncols) *(u32x4*)(out + (size_t)r * ld + cc) = *(const u32x4*)(T + r * EPS + cc);
    }
}
DI bool xcd_unit(int it, int nN, int& tm, int& tn) {
    const int G = gridDim.x;
    if ((G & 7) != 0 || G < 8) { const int u = it * G + blockIdx.x; if (u >= 64 * nN) return false; tm = u % 64; tn = u / 64; return true; }
    const int x = blockIdx.x & 7, i = blockIdx.x >> 3, per = G >> 3;
    const int u = it * per + i;
    if (u >= 8 * nN) return false;
    tm = x * 8 + (u & 7); tn = u >> 3; return true;
}
DI void phase_gemm1(const Ctx& c, unsigned char* lds) {
    const int nN = (IN_COLS + 255) / 256;
    const bf16_t* WT = (const bf16_t*)(c.ws + WS_WT_IN);
    for (int it = 0;; ++it) {
        int tm, tn; if (!xcd_unit(it, nN, tm, tn)) break;
        const int m0 = tm * 256, n0 = tn * 256;
        f32x4 acc[8][4];
#pragma unroll
        for (int i = 0; i < 8; ++i)
#pragma unroll
            for (int j = 0; j < 4; ++j) acc[i][j] = (f32x4){0.f, 0.f, 0.f, 0.f};
        gemm256_dma(acc, c.H + (size_t)m0 * DM, DM, WT + (size_t)n0 * DM, DM, DM, lds);
        tile256_store_bf16(acc, c.PROJ + (size_t)m0 * IN_COLS + n0, IN_COLS, (IN_COLS - n0 < 256) ? IN_COLS - n0 : 256, lds);
    }
}

DI float gelu_tanh(float x) { const float u = 0.7978845608028654f * (x + 0.044715f * x * x * x); const float e = __expf(2.0f * u); return x * (1.0f - __builtin_amdgcn_rcpf(e + 1.0f)); }
DI float softplusf_(float x) { return (x > 20.f) ? x : __logf(1.0f + __expf(x)); }
DI float tanhf_(float x) { const float e = __expf(2.0f * x); return 1.0f - 2.0f * __builtin_amdgcn_rcpf(e + 1.0f); }
constexpr int TKP = 8;
template <int WIN>
DI void pool_emit(const Ctx& c, const float (&pv)[31], int t0, int s0, int ch) {
#pragma unroll
    for (int k = 0; k < 16; ++k) {
        float sum = 0.f;
#pragma unroll
        for (int j = 0; j < WIN; ++j) sum += pv[15 + k - j];
        const int s = s0 + k, cnt = (s + 1 < WIN) ? s + 1 : WIN;
        c.POOLED[(size_t)(t0 + k) * 512 + ch] = f2bf(sum / (float)cnt - pv[15 + k]);
    }
}
DI void phase_prep(const Ctx& c, unsigned char* lds) {
    const int n_cmp_items = 2 * 16 * 2;
    for (int item = (int)gridDim.x - 1 - (int)blockIdx.x; item < n_cmp_items; item += gridDim.x) {
        const int tid = TID();
        const int kv = item >> 5, bgi = (item >> 1) & 15, tn = item & 1, m0 = bgi * 256, n0 = tn * 128;
        ARows ar; ar.mu = nullptr; ar.ltype = 0; ar.first = 0;
#pragma unroll
        for (int i = 0; i < 4; ++i) { const int cb = (tid >> 3) + 64 * i;
            ar.p[i] = (cb < NCMP) ? c.PROJ + ((size_t)(bgi >> 2) * SEQ + 16 * cb) * IN_COLS + (kv ? C_VC : C_KC) + (bgi & 3) * 64 : nullptr; }
        f32x4 acc[4][4]; acc_zero(acc);
        gemm_core<1>(acc, ar, (const bf16_t*)(c.ws + WS_WT_C1) + ((size_t)kv * 256 + n0) * 2048, 2048, 2048, lds);
        const float* pb = c.POSB + kv * 256;
        ACC_FOREACH(acc, {
            const f32x4 bb = *(const f32x4*)(pb + n0 + c_);
            store_bf4(c.CMPH + ((size_t)kv * 4096 + m0 + r_) * 256 + n0 + c_, (f32x4){gelu_tanh(v_[0] + bb[0]), gelu_tanh(v_[1] + bb[1]), gelu_tanh(v_[2] + bb[2]), gelu_tanh(v_[3] + bb[3])}); });
    }
    {
        const float* mu = c.in(I_MU) + (size_t)c.l * RWC;
        const bf16_t* WL = (const bf16_t*)(c.ws + WS_WT_LORA);
        for (int unit = blockIdx.x; unit < 64 * 12; unit += gridDim.x) {
            const int tid = TID();
            const int tm = unit & 63, tn = unit >> 6, m0 = tm * 256, n0 = tn * 128, ltype = tn >> 2, ch0 = n0 & 511;
            ARows ar; ar.mu = mu; ar.ltype = ltype; ar.first = 0;
#pragma unroll
            for (int i = 0; i < 4; ++i) { const int t = m0 + (tid >> 3) + 64 * i; ar.p[i] = c.PROJ + (size_t)t * IN_COLS; if ((t & (SEQ - 1)) == 0) ar.first |= 1 << i; }
            f32x4 acc[4][4]; acc_zero(acc);
            gemm_core<2>(acc, ar, WL + (size_t)n0 * 128, 128, 128, lds);
            if (ltype == 0) { const float* w0 = c.in(I_W0) + c.l * 512 + ch0;
                ACC_FOREACH(acc, { const f32x4 b4 = *(const f32x4*)(w0 + c_);
                    for (int j = 0; j < 4; ++j) v_[j] = __expf(-softplusf_(-(b4[j] + v_[j])) - 0.5f); }); }
            else if (ltype == 1) { const float* a0 = c.in(I_A0) + c.l * 512 + ch0;
                ACC_FOREACH(acc, { const f32x4 b4 = *(const f32x4*)(a0 + c_);
                    for (int j = 0; j < 4; ++j) v_[j] = sigmoidf_(b4[j] + v_[j]); }); }
            tile_store_bf16(acc, c.F + (size_t)(3 + ltype) * NT * 512 + (size_t)m0 * 512 + ch0, 512, 256, 128, lds);
        }
    }
    const int tid = TID();
    const int n_pool_items = NT / 16, n_items = n_pool_items + 512;
    for (int item = blockIdx.x; item < n_items; item += gridDim.x) {
        if (item >= n_pool_items) {
            const int idx0 = (item - n_pool_items) * 4;
            const int r = tid >> 3, seg = (tid & 7) * 8;
            u32x4 w[4];
#pragma unroll
            for (int u = 0; u < 4; ++u) { const int idx = idx0 + u, kind = idx >> 10, bgi = (idx >> 6) & 15, s0 = (idx & 63) * 64;
                w[u] = *(const u32x4*)(c.PROJ + ((size_t)(bgi >> 2) * SEQ + s0 + r) * IN_COLS + (kind ? C_VW : C_VS) + (bgi & 3) * 64 + seg); }
            __syncthreads();
#pragma unroll
            for (int u = 0; u < 4; ++u) *(u32x4*)((bf16_t*)lds + u * 64 * 72 + r * 72 + seg) = w[u];
            __syncthreads();
#pragma unroll
            for (int u = 0; u < 4; ++u) { const int idx = idx0 + u, kind = idx >> 10, bgi = (idx >> 6) & 15, s0 = (idx & 63) * 64;
                const bf16_t* T = (const bf16_t*)lds + u * 64 * 72;
                u32x4 o;
                o.x = (unsigned)T[(seg + 0) * 72 + r] | ((unsigned)T[(seg + 1) * 72 + r] << 16); o.y = (unsigned)T[(seg + 2) * 72 + r] | ((unsigned)T[(seg + 3) * 72 + r] << 16);
                o.z = (unsigned)T[(seg + 4) * 72 + r] | ((unsigned)T[(seg + 5) * 72 + r] << 16); o.w = (unsigned)T[(seg + 6) * 72 + r] | ((unsigned)T[(seg + 7) * 72 + r] << 16);
                *(u32x4*)(c.VT + (((size_t)kind * 16 + bgi) * 64 + r) * SEQ + s0 + seg) = o; }
        } else {
            const int t0 = item * 16, ch = tid, gi = ch >> 7, s0 = t0 & (SEQ - 1);
            float pv[31];
#pragma unroll
            for (int i = 0; i < 31; ++i) pv[i] = (s0 - 15 + i >= 0) ? bf2f(c.PROJ[(size_t)(t0 - 15 + i) * IN_COLS + C_POOL + ch]) : 0.f;
            if (gi == 0) pool_emit<2>(c, pv, t0, s0, ch);
            else if (gi == 1) pool_emit<4>(c, pv, t0, s0, ch);
            else if (gi == 2) pool_emit<8>(c, pv, t0, s0, ch);
            else pool_emit<16>(c, pv, t0, s0, ch);
        }
    }
}

DI void rwkv_finalize_item(const Ctx& c, int item) {
    const int tid = TID(), ch = tid, t0 = item * 8;
    const float* mu = c.in(I_MU) + (size_t)c.l * RWC;
    const float kkw_ = c.in(I_KK)[c.l * 512 + ch], kaw_ = c.in(I_KA)[c.l * 512 + ch], rkw_ = c.in(I_RK)[c.l * 512 + ch];
    const float mur = mu[ch], muk = mu[512 + ch], muv = mu[1024 + ch];
    bf16_t ur[9], uk[9], uv[9], ua[8];
    const bool has_prev = (t0 & (SEQ - 1)) != 0;
#pragma unroll
    for (int k = 0; k < 9; ++k) {
        ur[k] = 0; uk[k] = 0; uv[k] = 0;
        if (k > 0 || has_prev) { const bf16_t* q = c.PROJ + (size_t)(t0 - 1 + k) * IN_COLS; ur[k] = q[C_R + ch]; uk[k] = q[C_K + ch]; uv[k] = q[C_V + ch]; }
    }
#pragma unroll
    for (int k = 0; k < 8; ++k) ua[k] = c.F[(size_t)4 * NT * 512 + (size_t)(t0 + k) * 512 + ch];
#pragma unroll
    for (int k = 0; k < 8; ++k) {
        const int t = t0 + k;
        const float cr = bf2f(ur[k + 1]), ck = bf2f(uk[k + 1]), cv = bf2f(uv[k + 1]);
        const float r = cr + (bf2f(ur[k]) - cr) * mur, kx = ck + (bf2f(uk[k]) - ck) * muk, vx = cv + (bf2f(uv[k]) - cv) * muv;
        const float a = bf2f(ua[k]);
        const float kxn = kx * kkw_, kp = kx * (1.0f + (a - 1.0f) * kaw_);
        const float ss = wave_sum_dpp(kxn * kxn);
        const float inv = __builtin_amdgcn_rsqf(fmaxf(ss, 1e-24f));
        const float br = wave_sum_dpp(kxn * inv * a * r), kr = wave_sum_dpp(kp * r), bon = wave_sum_dpp(r * kp * rkw_);
        if ((tid & 63) == 0) *(f32x4*)(c.BON + ((size_t)t * 8 + (tid >> 6)) * 4) = (f32x4){inv, br, kr, bon};
        const size_t o = (size_t)t * 512 + ch;
        c.F[o] = f2bf(r); c.F[o + (size_t)NT * 512] = f2bf(kx); c.F[o + (size_t)2 * NT * 512] = f2bf(vx);
    }
}

DI void phase_poolgemm(const Ctx& c, unsigned char* lds) {
    for (int item = blockIdx.x; item < NT / 8; item += gridDim.x) rwkv_finalize_item(c, item);
    const int n_pool = (NT / 256) * 4, n_items = n_pool + 32;
    for (int item = blockIdx.x; item < n_items; item += gridDim.x) {
        f32x4 acc[4][4]; acc_zero(acc);
        if (item < n_pool) {
            const int tm = item >> 2, gi = item & 3, m0 = tm * 256;
            const ARows ar = plain_rows(c.POOLED + gi * 128, 512, m0, TID());
            gemm_core<0>(acc, ar, (const bf16_t*)(c.ws + WS_WT_POOL) + (size_t)gi * 128 * 128, 128, 128, lds);
            const float* sc = c.in(I_POOLS) + c.l * 512 + gi * 128;
            ACC_FOREACH(acc, { const f32x4 s = *(const f32x4*)(sc + c_);
                store_bf4(c.POOLED + (size_t)(m0 + r_) * 512 + gi * 128 + c_, (f32x4){v_[0] * s[0], v_[1] * s[1], v_[2] * s[2], v_[3] * s[3]}); });
        } else {
            const int it = item - n_pool, kv = it >> 4, tm = it & 15, m0 = tm * 256;
            const ARows ar = plain_rows(c.CMPH + (size_t)kv * 4096 * 256, 256, m0, TID());
            gemm_core<0>(acc, ar, (const bf16_t*)(c.ws + WS_WT_C2) + (size_t)kv * 128 * 256, 256, 256, lds);
            ACC_FOREACH(acc, { if (c_ < 64) { const int R = m0 + r_;
                if (kv == 0) store_bf4(c.KC + (size_t)R * 64 + c_, v_);
                else { bf16_t* q = c.VCT + ((size_t)(R >> 8) * 64 + c_) * 256 + (R & 255); q[0] = f2bf(v_[0]); q[256] = f2bf(v_[1]); q[512] = f2bf(v_[2]); q[768] = f2bf(v_[3]); } } });
        }
    }
}

constexpr int SCH = 32;
constexpr int SB_AN = 0, SB_WR = SCH * 64 * 4, SB_W = 2 * SCH * 64 * 4, SB_BB = 3 * SCH * 64 * 4, SB_KP = 4 * SCH * 64 * 4;
constexpr int SB_V = 5 * SCH * 64 * 4;
constexpr int SB_SC = SB_V + SCH * 16 * 4;
constexpr int SB_Y = SB_SC + SCH * 2 * 4;
constexpr int SB_BYTES = SB_Y + SCH * 16 * 4;
static_assert(2 * SB_BYTES <= LDS_BYTES - 64, "scan lds");
typedef float f32x2 __attribute__((ext_vector_type(2)));
DI float row8_sum(float v) { v += DPP_MOV(v, 0xB1); v += DPP_MOV(v, 0x4E); v += DPP_MOV(v, 0x141); return v; }

constexpr int NPW = 6, NJ = (SCH + NPW - 1) / NPW;
struct PrepRegs { bf16_t r[NJ], k[NJ], v[NJ], e[NJ], a[NJ]; float s0[NJ], s1[NJ], s2[NJ]; };
DI void prep_load(PrepRegs& R, const Ctx& c, int b, int h, int ck, int pw, int lane) {
    const size_t PL = (size_t)NT * 512;
    const size_t tb = (size_t)b * SEQ + ck * SCH;
    const size_t o0 = tb * 512 + h * 64 + lane;
#pragma unroll
    for (int j = 0; j < NJ; ++j) {
        const int st = pw + NPW * j;
        if (st < SCH) { const size_t o = o0 + (size_t)st * 512; R.r[j] = c.F[o]; R.k[j] = c.F[o + PL]; R.v[j] = c.F[o + 2 * PL]; R.e[j] = c.F[o + 3 * PL]; R.a[j] = c.F[o + 4 * PL];
            const float* sp = c.BON + ((tb + st) * 8 + h) * 4; R.s0[j] = sp[0]; R.s1[j] = sp[1]; R.s2[j] = sp[2]; }
    }
}
DI void prep_store(const PrepRegs& R, unsigned char* sb, int rq, int pw, int lane, float kkw, float kaw) {
    float* an = (float*)(sb + SB_AN); float* wr = (float*)(sb + SB_WR); float* w_ = (float*)(sb + SB_W); float* bb_ = (float*)(sb + SB_BB); float* kp_ = (float*)(sb + SB_KP);
    float* vv = (float*)(sb + SB_V); float* sc = (float*)(sb + SB_SC);
#pragma unroll
    for (int j = 0; j < NJ; ++j) {
        const int st = pw + NPW * j;
        if (st < SCH) {
            const float r = bf2f(R.r[j]), k = bf2f(R.k[j]), v = bf2f(R.v[j]), e = bf2f(R.e[j]), a = bf2f(R.a[j]);
            const float w = __expf(-e);
            const float kk = k * kkw * R.s0[j];
            const float kp = k * (1.0f + (a - 1.0f) * kaw);
            an[st * 64 + lane] = -kk; wr[st * 64 + lane] = w * r; w_[st * 64 + lane] = w; bb_[st * 64 + lane] = kk * a; kp_[st * 64 + lane] = kp;
            if ((lane >> 4) == rq) vv[st * 16 + (lane & 15)] = v;
            if (lane == 0) { sc[st * 2] = R.s1[j]; sc[st * 2 + 1] = R.s2[j]; }
        }
    }
}
DI void scan_item(const Ctx& c, int item, unsigned char* lds) {
    const int tid = TID(), lane = tid & 63, wave = tid >> 6;
    const int b = item >> 5, h = (item >> 2) & 7, rq = item & 3;
    const int chn = h * 64 + lane;
    const float kkw = c.in(I_KK)[c.l * 512 + chn], kaw = c.in(I_KA)[c.l * 512 + chn];
    const int rowl = (tid & 127) >> 3, cg = tid & 7;
    f32x2 st[4];
#pragma unroll
    for (int i = 0; i < 4; ++i) st[i] = (f32x2){0.f, 0.f};
    constexpr int NCK = SEQ / SCH;
    PrepRegs R;
    __syncthreads();
    if (wave >= 2) { prep_load(R, c, b, h, 0, wave - 2, lane); prep_store(R, lds, rq, wave - 2, lane, kkw, kaw); prep_load(R, c, b, h, 1, wave - 2, lane); }
    __syncthreads();
    for (int ck = 0; ck < NCK; ++ck) {
        unsigned char* sb = lds + (ck & 1) * SB_BYTES;
        if (wave < 2) {
            const float* an = (const float*)(sb + SB_AN) + cg * 8; const float* wr = (const float*)(sb + SB_WR) + cg * 8; const float* w_ = (const float*)(sb + SB_W) + cg * 8;
            const float* bb_ = (const float*)(sb + SB_BB) + cg * 8; const float* kp_ = (const float*)(sb + SB_KP) + cg * 8;
            const float* vv = (const float*)(sb + SB_V) + rowl; const float* sc = (const float*)(sb + SB_SC); float* yb = (float*)(sb + SB_Y) + rowl;
            f32x4 a0 = *(const f32x4*)(an), a1 = *(const f32x4*)(an + 4), r0 = *(const f32x4*)(wr), r1 = *(const f32x4*)(wr + 4);
            f32x4 w0 = *(const f32x4*)(w_), w1 = *(const f32x4*)(w_ + 4), b0 = *(const f32x4*)(bb_), b1 = *(const f32x4*)(bb_ + 4);
            f32x4 k0 = *(const f32x4*)(kp_), k1 = *(const f32x4*)(kp_ + 4);
            float v = vv[0]; f32x2 bk = *(const f32x2*)(sc);
#pragma unroll 2
            for (int s = 0; s < SCH; ++s) {
                const int sn = (s + 1 < SCH) ? s + 1 : s;
                const f32x4 na0 = *(const f32x4*)(an + sn * 64), na1 = *(const f32x4*)(an + sn * 64 + 4), nr0 = *(const f32x4*)(wr + sn * 64), nr1 = *(const f32x4*)(wr + sn * 64 + 4);
                const f32x4 nw0 = *(const f32x4*)(w_ + sn * 64), nw1 = *(const f32x4*)(w_ + sn * 64 + 4), nb0 = *(const f32x4*)(bb_ + sn * 64), nb1 = *(const f32x4*)(bb_ + sn * 64 + 4);
                const f32x4 nk0 = *(const f32x4*)(kp_ + sn * 64), nk1 = *(const f32x4*)(kp_ + sn * 64 + 4);
                const float nv = vv[sn * 16]; const f32x2 nbk = *(const f32x2*)(sc + sn * 2);
                f32x2 da = st[0] * (f32x2){a0[0], a0[1]}; f32x2 dr = st[0] * (f32x2){r0[0], r0[1]};
                da += st[1] * (f32x2){a0[2], a0[3]}; dr += st[1] * (f32x2){r0[2], r0[3]};
                da += st[2] * (f32x2){a1[0], a1[1]}; dr += st[2] * (f32x2){r1[0], r1[1]};
                da += st[3] * (f32x2){a1[2], a1[3]}; dr += st[3] * (f32x2){r1[2], r1[3]};
                float sa = da[0] + da[1], sr = dr[0] + dr[1];
                sa += DPP_MOV(sa, 0xB1); sr += DPP_MOV(sr, 0xB1);
                sa += DPP_MOV(sa, 0x4E); sr += DPP_MOV(sr, 0x4E);
                sa += DPP_MOV(sa, 0x141); sr += DPP_MOV(sr, 0x141);
                const f32x2 sa2 = (f32x2){sa, sa}, v2 = (f32x2){v, v};
                st[0] = st[0] * (f32x2){w0[0], w0[1]} + sa2 * (f32x2){b0[0], b0[1]} + v2 * (f32x2){k0[0], k0[1]};
                st[1] = st[1] * (f32x2){w0[2], w0[3]} + sa2 * (f32x2){b0[2], b0[3]} + v2 * (f32x2){k0[2], k0[3]};
                st[2] = st[2] * (f32x2){w1[0], w1[1]} + sa2 * (f32x2){b1[0], b1[1]} + v2 * (f32x2){k1[0], k1[1]};
                st[3] = st[3] * (f32x2){w1[2], w1[3]} + sa2 * (f32x2){b1[2], b1[3]} + v2 * (f32x2){k1[2], k1[3]};
                yb[s * 16] = sr + sa * bk[0] + v * bk[1];
                a0 = na0; a1 = na1; r0 = nr0; r1 = nr1; w0 = nw0; w1 = nw1; b0 = nb0; b1 = nb1; k0 = nk0; k1 = nk1; v = nv; bk = nbk;
            }
        } else {
            const int pt = tid - 128;
            if (ck + 1 < NCK) prep_store(R, lds + ((ck + 1) & 1) * SB_BYTES, rq, wave - 2, lane, kkw, kaw);
            if (ck + 2 < NCK) prep_load(R, c, b, h, ck + 2, wave - 2, lane);
            if (ck > 0) {
                const float* yb = (const float*)(lds + ((ck - 1) & 1) * SB_BYTES + SB_Y);
                for (int idx = pt; idx < SCH * 16; idx += 384) {
                    const int s = idx >> 4, j = idx & 15;
                    c.YRAW[((size_t)b * SEQ + (ck - 1) * SCH + s) * 512 + h * 64 + rq * 16 + j] = f2bf(yb[idx]);
                }
            }
        }
        asm volatile("s_waitcnt lgkmcnt(0)" ::: "memory"); __builtin_amdgcn_s_barrier(); asm volatile("" ::: "memory");
    }
    {
        const float* yb = (const float*)(lds + ((NCK - 1) & 1) * SB_BYTES + SB_Y);
        for (int idx = tid; idx < SCH * 16; idx += NTHREADS) {
            const int s = idx >> 4, j = idx & 15;
            c.YRAW[((size_t)b * SEQ + (NCK - 1) * SCH + s) * 512 + h * 64 + rq * 16 + j] = f2bf(yb[idx]);
        }
    }
    __syncthreads();
}
DI void phase_rwkv_post(const Ctx& c, unsigned char* lds) {
    const int tid = TID(), lane = tid & 63, wave = tid >> 6;
    const size_t PL = (size_t)NT * 512;
    for (int t = blockIdx.x * 8 + wave; t < NT; t += gridDim.x * 8) {
        bf16_t ry[8], rv[8], rg[8]; float bon[8], gw[8], gb[8];
#pragma unroll
        for (int h = 0; h < 8; ++h) { const size_t o = (size_t)t * 512 + h * 64 + lane; ry[h] = c.YRAW[o]; rv[h] = c.F[o + 2 * PL]; rg[h] = c.F[o + 5 * PL]; bon[h] = c.BON[((size_t)t * 8 + h) * 4 + 3];
            gw[h] = c.in(I_GNW)[c.l * 512 + h * 64 + lane]; gb[h] = c.in(I_GNB)[c.l * 512 + h * 64 + lane]; }
#pragma unroll
        for (int h = 0; h < 8; ++h) {
            const float y = bf2f(ry[h]);
            const float mean = wave_sum_dpp(y) * (1.0f / 64.0f);
            const float d = y - mean;
            const float var = wave_sum_dpp(d * d) * (1.0f / 64.0f);
            const float yn = d * rsqrtf(var + 64e-5f) * gw[h] + gb[h];
            c.F[(size_t)t * 512 + h * 64 + lane + 5 * PL] = f2bf((yn + bon[h] * bf2f(rv[h])) * bf2f(rg[h]));
        }
    }
    for (int it = blockIdx.x * 4; it < 768 + 128 + 128 + 256 + 256; it += gridDim.x * 4) {
        const float* WB = c.in(I_WBR) + (size_t)c.l * 2048 * DM; bf16_t* BR = (bf16_t*)(c.ws + WS_WT_BR);
        if (it < 768) convert_tile4(c.in(I_WMG) + (size_t)c.l * DM * 3 * DM, 3 * DM, 3 * DM, DM, (bf16_t*)(c.ws + WS_WT_MG), it, lds);
        else if (it < 896) convert_tile4(WB, DM, DM, 512, BR, it - 768, lds);
        else if (it < 1024) convert_tile4(WB + (size_t)512 * DM, DM, DM, 512, BR + (size_t)1024 * 512, it - 896, lds);
        else if (it < 1280) convert_tile4(WB + (size_t)1024 * DM, DM, DM, 1024, BR + (size_t)2048 * 512, it - 1024, lds);
        else convert_tile4(c.in(I_WOUT) + (size_t)c.l * DM * DM, DM, DM, DM, (bf16_t*)(c.ws + WS_WT_OUT), it - 1280, lds);
    }
}
constexpr int TS = 72;
constexpr int NSA_BIAS = 0;
constexpr int NSA_SELM = 2112;
constexpr int NSA_SCR = 2624;
constexpr int NSA_K0 = 4672;
constexpr int NSA_V0 = NSA_K0 + 2 * 64 * TS * 2;
constexpr int NSA_A = NSA_V0 + 2 * 64 * TS * 2;
constexpr int NSA_B = NSA_A + 16384;
constexpr int NSA_END = NSA_B + 16384;
static_assert(NSA_END <= LDS_BYTES - 16, "nsa lds");
static_assert(NSA_K0 % 16 == 0, "align");

struct NsaLane { int tq[2]; int h; float cbias; float m[2], l[2]; };

DI void nsa_prefetch(u32x4& rk, u32x4& rv, const bf16_t* kbase, int kstride, const bf16_t* vtbase, int vstride, int pos0, int tid) {
    const int r = tid >> 3, seg = (tid & 7) * 8;
    rk = *(const u32x4*)(kbase + (size_t)(pos0 + r) * kstride + seg);
    rv = *(const u32x4*)(vtbase + (size_t)r * vstride + pos0 + seg);
}
DI void nsa_store(unsigned char* lds, int buf, const u32x4& rk, const u32x4& rv, int tid) {
    const int r = tid >> 3, seg = (tid & 7) * 8;
    *(u32x4*)((bf16_t*)(lds + NSA_K0) + buf * 64 * TS + r * TS + seg) = rk;
    *(u32x4*)((bf16_t*)(lds + NSA_V0) + buf * 64 * TS + r * TS + seg) = rv;
}
template <int QM = 3>
DI void nsa_qk(f32x4 (&s)[2][4], const bf16_t* sK, const bf16x8 (&qf)[2][2], int lane) {
#pragma unroll
    for (int kt = 0; kt < 4; ++kt) {
#pragma unroll
        for (int ks = 0; ks < 2; ++ks) {
            const bf16x8 kf = *(const bf16x8*)(sK + (16 * kt + (lane & 15)) * TS + 32 * ks + (lane >> 4) * 8);
#pragma unroll
            for (int qi = 0; qi < 2; ++qi) if ((QM >> qi) & 1) s[qi][kt] = __builtin_amdgcn_mfma_f32_16x16x32_bf16(kf, qf[qi][ks], (ks == 0) ? (f32x4){0.f, 0.f, 0.f, 0.f} : s[qi][kt], 0, 0, 0);
        }
    }
}
template <int MODE>
DI void nsa_logits(float (&x)[4][4], const f32x4 (&s)[4], int tq, int h, float cbias, bool rowsel, int pos0, int qd, const float* biasT) {
#pragma unroll
    for (int kt = 0; kt < 4; ++kt)
#pragma unroll
        for (int i = 0; i < 4; ++i) {
            const int kk = pos0 + 16 * kt + 4 * qd + i;
            if (MODE == 1) { x[kt][i] = rowsel ? s[kt][i] + cbias : -INFINITY; }
            else {
                const int dist = (MODE == 0) ? (tq - 16 * kk - 31) : (tq - kk);
                bool ok = dist >= 0;
                if (MODE == 2) ok = ok && rowsel;
                if (MODE == 3) ok = ok && (dist < 512);
                const int di = dist < 0 ? 0 : (dist > 128 ? 128 : dist);
                float bias = biasT[di * 4 + h];
                asm volatile("" : "+v"(bias));
                x[kt][i] = ok ? s[kt][i] + bias : -INFINITY;
            }
        }
}
DI float quad16_max(float v) { v = fmaxf(v, __shfl_xor(v, 16)); v = fmaxf(v, __shfl_xor(v, 32)); return v; }
DI float quad16_sum(float v) { v += __shfl_xor(v, 16); v += __shfl_xor(v, 32); return v; }
DI void nsa_softmax(const float (&x)[4][4], float& m, float& l, f32x4 (&O)[4], bf16x8 (&pf)[2]) {
    float mx = -INFINITY;
#pragma unroll
    for (int kt = 0; kt < 4; ++kt)
#pragma unroll
        for (int i = 0; i < 4; ++i) mx = fmaxf(mx, x[kt][i]);
    mx = quad16_max(mx);
    const float mn = fmaxf(m, mx);
    const float mu = (mn == -INFINITY) ? 0.f : mn;
    const float mu2 = mu * 1.4426950408889634f;
    const float sc = __builtin_amdgcn_exp2f(__builtin_fmaf(m, 1.4426950408889634f, -mu2));
    float p[4][4]; float ps = 0.f;
#pragma unroll
    for (int kt = 0; kt < 4; ++kt)
#pragma unroll
        for (int i = 0; i < 4; ++i) { p[kt][i] = __builtin_amdgcn_exp2f(__builtin_fmaf(x[kt][i], 1.4426950408889634f, -mu2)); ps += p[kt][i]; }
    l = l * sc + ps; m = mn;
#pragma unroll
    for (int dt = 0; dt < 4; ++dt) O[dt] = O[dt] * sc;
#pragma unroll
    for (int ks = 0; ks < 2; ++ks) {
        u32x4 w; w.x = pack2(p[2 * ks][0], p[2 * ks][1]); w.y = pack2(p[2 * ks][2], p[2 * ks][3]); w.z = pack2(p[2 * ks + 1][0], p[2 * ks + 1][1]); w.w = pack2(p[2 * ks + 1][2], p[2 * ks + 1][3]);
        pf[ks] = __builtin_bit_cast(bf16x8, w);
    }
}
template <int QM = 3>
DI void nsa_pv(f32x4 (&O)[2][4], const bf16_t* sV, const bf16x8 (&pf)[2][2], int lane) {
    const int qd = lane >> 4;
#pragma unroll
    for (int dt = 0; dt < 4; ++dt)
#pragma unroll
        for (int ks = 0; ks < 2; ++ks) {
            const bf16_t* vp = sV + (16 * dt + (lane & 15)) * TS + 32 * ks + 4 * qd;
            const u32x2 a = *(const u32x2*)vp, b = *(const u32x2*)(vp + 16);
            u32x4 w; w.x = a.x; w.y = a.y; w.z = b.x; w.w = b.y;
            const bf16x8 vf = __builtin_bit_cast(bf16x8, w);
#pragma unroll
            for (int qi = 0; qi < 2; ++qi) if ((QM >> qi) & 1) O[qi][dt] = __builtin_amdgcn_mfma_f32_16x16x32_bf16(vf, pf[qi][ks], O[qi][dt], 0, 0, 0);
        }
}
template <int MODE, int QM = 3>
DI void nsa_tile(f32x4 (&O)[2][4], NsaLane& L, const bf16x8 (&qf)[2][2], const unsigned char* lds, int buf, int pos0, bool sel0, bool sel1, int lane) {
    const bf16_t* sK = (const bf16_t*)(lds + NSA_K0) + buf * 64 * TS;
    const bf16_t* sV = (const bf16_t*)(lds + NSA_V0) + buf * 64 * TS;
    const float* biasT = (const float*)(lds + NSA_BIAS);
    f32x4 s[2][4];
    nsa_qk<QM>(s, sK, qf, lane);
    bf16x8 pf[2][2];
#pragma unroll
    for (int qi = 0; qi < 2; ++qi) if ((QM >> qi) & 1) {
        float x[4][4];
        nsa_logits<MODE>(x, s[qi], L.tq[qi], L.h, L.cbias, qi ? sel1 : sel0, pos0, lane >> 4, biasT);
        nsa_softmax(x, L.m[qi], L.l[qi], O[qi], pf[qi]);
    }
    nsa_pv<QM>(O, sV, pf, lane);
}
template <int MODE>
DI void nsa_tile_sel(f32x4 (&O)[2][4], NsaLane& L, const bf16x8 (&qf)[2][2], const unsigned char* lds, int buf, int pos0, bool sel0, bool sel1, int lane) {
    const bool a0 = __ballot(sel0) != 0ull, a1 = __ballot(sel1) != 0ull;
    if (a0 && a1) nsa_tile<MODE, 3>(O, L, qf, lds, buf, pos0, sel0, sel1, lane);
    else if (a0) nsa_tile<MODE, 1>(O, L, qf, lds, buf, pos0, sel0, sel1, lane);
    else if (a1) nsa_tile<MODE, 2>(O, L, qf, lds, buf, pos0, sel0, sel1, lane);
}
DI void nsa_flush(f32x4 (&Y)[2][4], f32x4 (&O)[2][4], NsaLane& L, const float (&gate)[2]) {
#pragma unroll
    for (int qi = 0; qi < 2; ++qi) {
        const float lt = quad16_sum(L.l[qi]);
        const float f = (lt > 0.f) ? gate[qi] * __builtin_amdgcn_rcpf(lt) : 0.f;
#pragma unroll
        for (int dt = 0; dt < 4; ++dt) { Y[qi][dt] += O[qi][dt] * f; O[qi][dt] = (f32x4){0.f, 0.f, 0.f, 0.f}; }
    }
}
DI void nsa_item(const Ctx& c, int item, unsigned char* lds) {
    const int tid = TID(), lane = tid & 63, wave = tid >> 6, qd = lane >> 4;
    const int b = item >> 8, g = (item >> 6) & 3, qt = item & 63, t0 = qt * 64, cur = qt, bg = b * 4 + g;
    float* biasT = (float*)(lds + NSA_BIAS);
    unsigned long long* selm = (unsigned long long*)(lds + NSA_SELM);
    float* scr = (float*)(lds + NSA_SCR) + wave * 64;
    float* impA = (float*)(lds + NSA_A); float* impB = (float*)(lds + NSA_B);
    __syncthreads();
    for (int i = tid; i < 129 * 4; i += NTHREADS) { const int d = i >> 2, h = i & 3; biasT[i] = c.in(I_RELB)[t5_bucket(d) * 16 + g * 4 + h]; }
    for (int i = tid; i < 2 * 4096; i += NTHREADS) impA[i] = 0.f;
    NsaLane L; L.h = lane & 3;
    bf16x8 qf[2][2]; float gates[2][3];
    const bf16_t* pbat = c.PROJ + (size_t)b * SEQ * IN_COLS;
#pragma unroll
    for (int qi = 0; qi < 2; ++qi) {
        const int tl = 8 * wave + 4 * qi + ((lane & 15) >> 2);
        L.tq[qi] = t0 + tl;
        const bf16_t* prow = pbat + (size_t)L.tq[qi] * IN_COLS;
#pragma unroll
        for (int ks = 0; ks < 2; ++ks) {
            u32x4 w = *(const u32x4*)(prow + C_Q + (g * 4 + L.h) * 64 + 32 * ks + qd * 8);
            w.x = pack2(bflo(w.x) * 0.125f, bfhi(w.x) * 0.125f); w.y = pack2(bflo(w.y) * 0.125f, bfhi(w.y) * 0.125f);
            w.z = pack2(bflo(w.z) * 0.125f, bfhi(w.z) * 0.125f); w.w = pack2(bflo(w.w) * 0.125f, bfhi(w.w) * 0.125f);
            qf[qi][ks] = __builtin_bit_cast(bf16x8, w);
        }
#pragma unroll
        for (int br = 0; br < 3; ++br) gates[qi][br] = sigmoidf_(bf2f(prow[C_GATE + g * 12 + L.h * 3 + br]));
    }
    __syncthreads();
    L.cbias = biasT[128 * 4 + L.h];
    f32x4 O[2][4], Y[2][4];
#pragma unroll
    for (int qi = 0; qi < 2; ++qi)
#pragma unroll
        for (int dt = 0; dt < 4; ++dt) { O[qi][dt] = (f32x4){0.f, 0.f, 0.f, 0.f}; Y[qi][dt] = (f32x4){0.f, 0.f, 0.f, 0.f}; }
    u32x4 rk, rv;
    const int nvis_max = (t0 + 63 >= 31) ? ((t0 + 63 - 31) >> 4) + 1 : 0;
    const int ncb = (nvis_max + 63) >> 6;
    const bf16_t* kcb = c.KC + (size_t)bg * 256 * 64; const bf16_t* vcb = c.VCT + (size_t)bg * 64 * 256;
    L.m[0] = L.m[1] = -INFINITY; L.l[0] = L.l[1] = 0.f;
    if (ncb > 0) nsa_prefetch(rk, rv, kcb, 64, vcb, 256, 0, tid);
    for (int cb = 0; cb < ncb; ++cb) {
        nsa_store(lds, cb & 1, rk, rv, tid);
        __syncthreads();
        if (cb + 1 < ncb) nsa_prefetch(rk, rv, kcb, 64, vcb, 256, (cb + 1) * 64, tid);
        if (16 * (cb * 64 + 63) + 31 + 128 <= t0) nsa_tile<1>(O, L, qf, lds, cb & 1, cb * 64, true, true, lane);
        else nsa_tile<0>(O, L, qf, lds, cb & 1, cb * 64, true, true, lane);
    }
    if (ncb > 0) nsa_prefetch(rk, rv, kcb, 64, vcb, 256, 0, tid);
    float mfin[2], linv[2];
#pragma unroll
    for (int qi = 0; qi < 2; ++qi) { mfin[qi] = L.m[qi]; const float lt = quad16_sum(L.l[qi]); linv[qi] = (lt > 0.f) ? __builtin_amdgcn_rcpf(lt) : 0.f; }
    { const float gg[2] = {gates[0][0], gates[1][0]}; nsa_flush(Y, O, L, gg); }
    __syncthreads();
    for (int cb = 0; cb < ncb; ++cb) {
        nsa_store(lds, cb & 1, rk, rv, tid);
        __syncthreads();
        if (cb + 1 < ncb) nsa_prefetch(rk, rv, kcb, 64, vcb, 256, (cb + 1) * 64, tid);
        const bf16_t* sK = (const bf16_t*)(lds + NSA_K0) + (cb & 1) * 64 * TS;
        f32x4 s[2][4];
        nsa_qk(s, sK, qf, lane);
#pragma unroll
        for (int qi = 0; qi < 2; ++qi) {
            float x[4][4];
            nsa_logits<0>(x, s[qi], L.tq[qi], L.h, L.cbias, true, cb * 64, qd, biasT);
            const float mu = (mfin[qi] == -INFINITY) ? 0.f : mfin[qi];
#pragma unroll
            for (int kt = 0; kt < 4; ++kt) {
                float p3 = __expf(x[kt][3] - mu) * linv[qi];
                float pa = (__expf(x[kt][0] - mu) + __expf(x[kt][1] - mu) + __expf(x[kt][2] - mu)) * linv[qi] + p3;
                pa += __shfl_xor(pa, 1); p3 += __shfl_xor(p3, 1);
                pa += __shfl_xor(pa, 2); p3 += __shfl_xor(p3, 2);
                if (L.h == 0) { const int tl = 8 * wave + 4 * qi + ((lane & 15) >> 2), mi = 16 * cb + 4 * kt + qd; impA[tl * 64 + mi] = pa; impB[tl * 64 + mi] = p3; }
            }
        }
    }
    const bf16_t* ksb = pbat + C_KS + g * 64; const bf16_t* vsb = c.VT + ((size_t)0 * 16 + bg) * 64 * SEQ;
    nsa_prefetch(rk, rv, ksb, IN_COLS, vsb, SEQ, 0, tid);
    __syncthreads();
    for (int tl8 = 0; tl8 < 8; ++tl8) {
        const int tl = 8 * wave + tl8, n = lane;
        const bool cand = (n >= 1) && (n <= cur - 2);
        const float imp = cand ? impA[tl * 64 + n] + impB[tl * 64 + n - 1] : -1.0f;
        LDS_WAVE_SYNC();
        scr[n] = imp;
        LDS_WAVE_SYNC();
        int rank = 0;
#pragma unroll 4
        for (int q4 = 0; q4 < 16; ++q4) {
            const f32x4 o = *(const f32x4*)(scr + q4 * 4);
#pragma unroll
            for (int j = 0; j < 4; ++j) { const int n2 = q4 * 4 + j; rank += (o[j] > imp || (o[j] == imp && n2 < n)) ? 1 : 0; }
        }
        const bool forced = (n <= cur) && (n == 0 || n == cur || n == cur - 1);
        const unsigned long long msk = __ballot((cand && rank < 5) || forced);
        if (lane == 0) selm[tl] = msk;
    }
    __syncthreads();
    unsigned long long uni = selm[lane];
#pragma unroll
    for (int o = 32; o >= 1; o >>= 1) { const unsigned lo_ = __shfl_xor((unsigned)uni, o), hi_ = __shfl_xor((unsigned)(uni >> 32), o); uni |= ((unsigned long long)hi_ << 32) | lo_; }
    uni = ((unsigned long long)__builtin_amdgcn_readfirstlane((unsigned)(uni >> 32)) << 32) | (unsigned)__builtin_amdgcn_readfirstlane((unsigned)uni);
    unsigned long long sm[2];
#pragma unroll
    for (int qi = 0; qi < 2; ++qi) sm[qi] = selm[8 * wave + 4 * qi + ((lane & 15) >> 2)];
    L.m[0] = L.m[1] = -INFINITY; L.l[0] = L.l[1] = 0.f;
    {
        unsigned long long rem = uni; int it = 0;
        int j = (int)__builtin_ctzll(rem); rem &= rem - 1;
        for (;;) {
            nsa_store(lds, it & 1, rk, rv, tid);
            __syncthreads();
            const int jn = rem ? (int)__builtin_ctzll(rem) : -1;
            if (jn >= 0) { rem &= rem - 1; nsa_prefetch(rk, rv, ksb, IN_COLS, vsb, SEQ, jn * 64, tid); }
            const bool s0 = (sm[0] >> j) & 1ull, s1 = (sm[1] >> j) & 1ull;
            if (j <= cur - 3) nsa_tile_sel<1>(O, L, qf, lds, it & 1, j * 64, s0, s1, lane);
            else nsa_tile_sel<2>(O, L, qf, lds, it & 1, j * 64, s0, s1, lane);
            if (jn < 0) break;
            j = jn; ++it;
        }
    }
    const bf16_t* kwb = pbat + C_KW + g * 64; const bf16_t* vwb = c.VT + ((size_t)1 * 16 + bg) * 64 * SEQ;
    const int j0 = (cur - 8 > 0) ? cur - 8 : 0;
    nsa_prefetch(rk, rv, kwb, IN_COLS, vwb, SEQ, j0 * 64, tid);
    { const float gg[2] = {gates[0][1], gates[1][1]}; nsa_flush(Y, O, L, gg); }
    L.m[0] = L.m[1] = -INFINITY; L.l[0] = L.l[1] = 0.f;
    {
        __syncthreads();
        for (int j = j0; j <= cur; ++j) {
            nsa_store(lds, (j - j0) & 1, rk, rv, tid);
            __syncthreads();
            if (j + 1 <= cur) nsa_prefetch(rk, rv, kwb, IN_COLS, vwb, SEQ, (j + 1) * 64, tid);
            if (cur - j >= 3 && cur - j <= 7) nsa_tile<1>(O, L, qf, lds, (j - j0) & 1, j * 64, true, true, lane);
            else nsa_tile<3>(O, L, qf, lds, (j - j0) & 1, j * 64, true, true, lane);
        }
    }
    { const float gg[2] = {gates[0][2], gates[1][2]}; nsa_flush(Y, O, L, gg); }
#pragma unroll
    for (int qi = 0; qi < 2; ++qi) {
        bf16_t* yrow = c.PROJ + ((size_t)b * SEQ + L.tq[qi]) * IN_COLS + C_Q + (g * 4 + L.h) * 64;
#pragma unroll
        for (int dt = 0; dt < 4; ++dt) store_bf4(yrow + 16 * dt + 4 * qd, Y[qi][dt]);
    }
}
DI void phase_mix(const Ctx& c, unsigned char* lds) {
    const int G = gridDim.x, bid = blockIdx.x;
    const int n_nsa = NB * 4 * (SEQ / 64), n_scan = NB * 8 * 4;
    const bool split = G >= 2 * n_scan;
    if (split) { if (bid < n_scan) scan_item(c, bid, lds); }
    else for (int item = bid; item < n_scan; item += G) scan_item(c, item, lds);
    unsigned* ctr = c.ctl + CW_Q + c.l;
    volatile int* sitem = (volatile int*)(lds + LDS_BYTES - 32);
    for (;;) {
        __syncthreads();
        if (TID() == 0) *sitem = (int)atomicAdd(ctr, 1u);
        __syncthreads();
        const int k = *sitem;
        if (k >= n_nsa) break;
        const int qt = 63 - (k >> 4), bgi = k & 15;
        nsa_item(c, (bgi << 6) | qt, lds);
    }
}

DI void phase_merge(const Ctx& c, unsigned char* lds) {
    const int nM = NT / 256, nN = DM / 128;
    const bf16_t* WM = (const bf16_t*)(c.ws + WS_WT_MG);
    const bf16_t* BR = (const bf16_t*)(c.ws + WS_WT_BR);
    const float* BM_ = c.in(I_BMG) + (size_t)c.l * 3 * DM;
    bf16_t* TMP = c.YRAW + (size_t)blockIdx.x * 256 * 128;
    for (int it = 0;; ++it) {
        int tm, tn; if (!xcd_unit(it, nN, tm, tn)) break;
        const int m0 = tm * 256, n0 = tn * 128;
#pragma unroll 1
        for (int i = 0; i < 3; ++i) {
            {
                f32x4 ag[4][4]; acc_zero(ag);
                gemm_core_dma(ag, c.H + (size_t)m0 * DM, DM, WM + (size_t)(i * DM + n0) * DM, DM, DM, lds);
                ACC_FOREACH(ag, { const f32x4 bb = *(const f32x4*)(BM_ + i * DM + n0 + c_);
                    store_bf4(TMP + r_ * 128 + c_, (f32x4){sigmoidf_(v_[0] + bb[0]), sigmoidf_(v_[1] + bb[1]), sigmoidf_(v_[2] + bb[2]), sigmoidf_(v_[3] + bb[3])}); });
            }
            f32x4 ab[4][4]; acc_zero(ab);
            if (i == 0) gemm_core_dma(ab, c.POOLED + (size_t)m0 * 512, 512, BR + (size_t)n0 * 512, 512, 512, lds);
            else if (i == 1) gemm_core_dma(ab, c.F + (size_t)5 * NT * 512 + (size_t)m0 * 512, 512, BR + (size_t)1024 * 512 + (size_t)n0 * 512, 512, 512, lds);
            else gemm_core_dma(ab, c.PROJ + C_Q + (size_t)m0 * IN_COLS, IN_COLS, BR + (size_t)2048 * 512 + (size_t)n0 * 1024, 1024, 1024, lds);
            ACC_FOREACH(ab, {
                bf16_t* q = c.MERGED + (size_t)(m0 + r_) * DM + n0 + c_;
                const u32x2 gv = *(const u32x2*)(TMP + r_ * 128 + c_);
                f32x4 m4 = ((f32x4){0.f, 0.f, 0.f, 0.f});
                if (i > 0) { const u32x2 pv = *(const u32x2*)q; m4 = ((f32x4){bflo(pv.x), bfhi(pv.x), bflo(pv.y), bfhi(pv.y)}); }
                m4[0] += bflo(gv.x) * v_[0]; m4[1] += bfhi(gv.x) * v_[1]; m4[2] += bflo(gv.y) * v_[2]; m4[3] += bfhi(gv.y) * v_[3];
                store_bf4(q, m4); });
        }
    }
}

DI void phase_outp(const Ctx& c, unsigned char* lds) {
    const int nN = DM / 256;
    const bf16_t* W = (const bf16_t*)(c.ws + WS_WT_OUT);
    const float* xin = (c.l == 0) ? c.in(I_X) : c.out;
    for (int it = 0;; ++it) {
        int tm, tn; if (!xcd_unit(it, nN, tm, tn)) break;
        const int m0 = tm * 256, n0 = tn * 256;
        f32x4 acc[8][4];
#pragma unroll
        for (int i = 0; i < 8; ++i)
#pragma unroll
            for (int j = 0; j < 4; ++j) acc[i][j] = (f32x4){0.f, 0.f, 0.f, 0.f};
        gemm256_dma(acc, c.MERGED + (size_t)m0 * DM, DM, W + (size_t)n0 * DM, DM, DM, lds);
        const int lane = TID() & 63, wave = TID() >> 6, wm = wave >> 2, wn = wave & 3;
#pragma unroll
        for (int mi = 0; mi < 8; ++mi)
#pragma unroll
            for (int ni = 0; ni < 4; ++ni) {
                const size_t o = (size_t)(m0 + wm * 128 + mi * 16 + (lane & 15)) * DM + n0 + wn * 64 + ni * 16 + (lane >> 4) * 4;
                const f32x4 x = *(const f32x4*)(xin + o); *(f32x4*)(c.out + o) = x + acc[mi][ni];
            }
    }
    for (int it = blockIdx.x * 4; it < 3 * 32 * 64; it += gridDim.x * 4) {
        const int mat = it / 2048, e = (it >> 6) & 31, tl = it & 63;
        if (mat == 0) convert_tile4(c.in(I_EG) + ((size_t)c.l * 32 + e) * DM * 256, 256, 256, DM, (bf16_t*)(c.ws + WS_EG) + (size_t)e * 256 * DM, tl, lds);
        else if (mat == 1) convert_tile4(c.in(I_EU) + ((size_t)c.l * 32 + e) * DM * 256, 256, 256, DM, (bf16_t*)(c.ws + WS_EU) + (size_t)e * 256 * DM, tl, lds);
        else convert_tile4(c.in(I_ED) + ((size_t)c.l * 32 + e) * 256 * DM, DM, DM, 256, (bf16_t*)(c.ws + WS_ED) + (size_t)e * DM * 256, tl, lds);
    }
}

DI void phase_norm2(const Ctx& c, unsigned char* lds) {
    const int tid = TID(), lane = tid & 63, wave = tid >> 6;
    const float* gain = c.in(I_NFFN) + c.l * DM;
    const float* wrg = c.in(I_WRG) + (size_t)c.l * DM * 4; const float* brg = c.in(I_BRG) + c.l * 4;
    const float* wre = c.in(I_WRE) + (size_t)c.l * DM * 32; const float* bre = c.in(I_BRE) + c.l * 32;
    unsigned* cnt = c.ctl + CW_CNT + c.l * 32;
    float* lg = (float*)lds + wave * 16 * 48;
    if (wave < 4)
    for (int rt = blockIdx.x * 4 + wave; rt < NT / 16; rt += gridDim.x * 4) {
        const int r0 = rt * 16;
        float my_rs = 0.f;
#pragma unroll 2
        for (int rr = 0; rr < 16; ++rr) {
            const size_t ro = (size_t)(r0 + rr) * DM;
            f32x4 v[4]; float ss = 0.f;
#pragma unroll
            for (int i = 0; i < 4; ++i) { v[i] = *(const f32x4*)(c.out + ro + i * 256 + lane * 4); ss += v[i][0] * v[i][0] + v[i][1] * v[i][1] + v[i][2] * v[i][2] + v[i][3] * v[i][3]; }
            ss = wave_sum_dpp(ss);
            const float rs = rsqrtf(ss * (1.0f / DM) + 1e-6f);
            if ((lane & 15) == rr) my_rs = rs;
#pragma unroll
            for (int i = 0; i < 4; ++i) {
                const f32x4 g = *(const f32x4*)(gain + i * 256 + lane * 4);
                store_bf4(c.H + ro + i * 256 + lane * 4, (f32x4){v[i][0] * rs * g[0], v[i][1] * rs * g[1], v[i][2] * rs * g[2], v[i][3] * rs * g[3]});
            }
        }
        f32x4 acc0 = (f32x4){0.f, 0.f, 0.f, 0.f}, acc1 = acc0, acc2 = acc0;
        const float* xr = c.out + (size_t)(r0 + (lane & 15)) * DM + 4 * (lane >> 4);
        const int cl = lane & 15;
#pragma unroll 2
        for (int kb = 0; kb < 64; ++kb) {
            const f32x4 xa = *(const f32x4*)(xr + kb * 16);
            const f32x4 ga = *(const f32x4*)(gain + kb * 16 + 4 * (lane >> 4));
            const int k0 = kb * 16 + 4 * (lane >> 4);
            float b0[4], b1[4], b2[4];
#pragma unroll
            for (int m = 0; m < 4; ++m) { b0[m] = wre[(size_t)(k0 + m) * 32 + cl]; b1[m] = wre[(size_t)(k0 + m) * 32 + 16 + cl]; b2[m] = (cl < 4) ? wrg[(size_t)(k0 + m) * 4 + cl] : 0.f; }
#pragma unroll
            for (int m = 0; m < 4; ++m) {
                const float am = xa[m] * ga[m] * my_rs;
                acc0 = __builtin_amdgcn_mfma_f32_16x16x4f32(am, b0[m], acc0, 0, 0, 0);
                acc1 = __builtin_amdgcn_mfma_f32_16x16x4f32(am, b1[m], acc1, 0, 0, 0);
                acc2 = __builtin_amdgcn_mfma_f32_16x16x4f32(am, b2[m], acc2, 0, 0, 0);
            }
        }
        LDS_WAVE_SYNC();
#pragma unroll
        for (int i = 0; i < 4; ++i) { const int row = 4 * (lane >> 4) + i; lg[row * 48 + cl] = acc0[i]; lg[row * 48 + 16 + cl] = acc1[i]; lg[row * 48 + 32 + cl] = acc2[i]; }
        LDS_WAVE_SYNC();
        if (lane < 16) {
            const float* L = lg + lane * 48;
            float lgp[4];
#pragma unroll
            for (int o = 0; o < 4; ++o) lgp[o] = L[32 + o] + brg[o];
            int grp = 0; float gm = lgp[0];
#pragma unroll
            for (int o = 1; o < 4; ++o) if (lgp[o] > gm) { gm = lgp[o]; grp = o; }
            float gs = 0.f;
#pragma unroll
            for (int o = 0; o < 4; ++o) gs += __expf(lgp[o] - gm);
            const float ptop = 1.0f / gs;
            int i0 = 0; float v0 = -INFINITY; int i1 = 0; float v1 = -INFINITY;
            for (int o = 0; o < 8; ++o) { const float le = L[grp * 8 + o] + bre[grp * 8 + o]; if (le > v0) { v1 = v0; i1 = i0; v0 = le; i0 = o; } else if (le > v1) { v1 = le; i1 = o; } }
            const float e1 = __expf(v1 - v0), inv = 1.0f / (1.0f + e1);
            int* rt_ = c.ROUTE + (size_t)(r0 + lane) * 8;
            const int ex0 = grp * 8 + i0, ex1 = grp * 8 + i1;
            const float w0_ = inv * ptop, w1_ = e1 * inv * ptop;
            const int q0 = (int)atomicAdd(cnt + ex0, 1u), q1 = (int)atomicAdd(cnt + ex1, 1u);
            rt_[0] = ex0; rt_[1] = ex1; ((float*)rt_)[2] = w0_; ((float*)rt_)[3] = w1_; rt_[4] = q0; rt_[5] = q1;
            int* e0p = c.ENT + ((size_t)ex0 * NT + q0) * 2; e0p[0] = r0 + lane; ((float*)e0p)[1] = w0_;
            int* e1p = c.ENT + ((size_t)ex1 * NT + q1) * 2; e1p[0] = r0 + lane; ((float*)e1p)[1] = w1_;
        }
    }
}
DI void moe_tables(const Ctx& c, int* soff, int* stile, int ncol) {
    const unsigned* cnt = c.ctl + CW_CNT + c.l * 32;
    __syncthreads();
    if (TID() == 0) { int s = 0, tt = 0; for (int e = 0; e < 32; ++e) { soff[e] = s; stile[e] = tt; s += (int)cnt[e]; tt += (((int)cnt[e] + 255) >> 8) * ncol; } soff[32] = s; stile[32] = tt; }
    __syncthreads();
}
DI void phase_moe_up(const Ctx& c, unsigned char* lds) {
    int* soff = (int*)(lds + 2 * G_STAGE); int* stile = soff + 64;
    moe_tables(c, soff, stile, 2);
    const int total = stile[32];
    for (int item = blockIdx.x; item < total; item += gridDim.x) {
        int e = 0;
        for (int q = 1; q < 32; ++q) if (stile[q] <= item) e = q;
        const int loc = item - stile[e], tm = loc >> 1, tn = loc & 1, n0 = tn * 128;
        const int p0 = soff[e] + tm * 256, pend = soff[e + 1];
        ARows ar; ar.mu = nullptr; ar.ltype = 0; ar.first = 0;
#pragma unroll
        for (int i = 0; i < 4; ++i) { const int pr = p0 + (TID() >> 3) + 64 * i; ar.p[i] = (pr < pend) ? c.H + (size_t)c.ENT[((size_t)e * NT + (pr - soff[e])) * 2] * DM : nullptr; }
        {
            f32x4 ag[4][4]; acc_zero(ag);
            gemm_core<0>(ag, ar, (const bf16_t*)(c.ws + WS_EG) + ((size_t)e * 256 + n0) * DM, DM, DM, lds);
            ACC_FOREACH(ag, { if (p0 + r_ < pend) store_bf4(c.HID + (size_t)(p0 + r_) * 256 + n0 + c_, (f32x4){v_[0] * sigmoidf_(v_[0]), v_[1] * sigmoidf_(v_[1]), v_[2] * sigmoidf_(v_[2]), v_[3] * sigmoidf_(v_[3])}); });
        }
        f32x4 au[4][4]; acc_zero(au);
        gemm_core<0>(au, ar, (const bf16_t*)(c.ws + WS_EU) + ((size_t)e * 256 + n0) * DM, DM, DM, lds);
        ACC_FOREACH(au, { if (p0 + r_ < pend) { bf16_t* q = c.HID + (size_t)(p0 + r_) * 256 + n0 + c_; const u32x2 sv = *(const u32x2*)q;
            store_bf4(q, (f32x4){bflo(sv.x) * v_[0], bfhi(sv.x) * v_[1], bflo(sv.y) * v_[2], bfhi(sv.y) * v_[3]}); } });
    }
}
DI void phase_moe_down(const Ctx& c, unsigned char* lds) {
    int* soff = (int*)(lds + 2 * G_STAGE); int* stile = soff + 64;
    moe_tables(c, soff, stile, 8);
    const int total = stile[32];
    for (int item = blockIdx.x; item < total; item += gridDim.x) {
        int e = 0;
        for (int q = 1; q < 32; ++q) if (stile[q] <= item) e = q;
        const int loc = item - stile[e], tm = loc >> 3, tn = loc & 7, n0 = tn * 128;
        const int p0 = soff[e] + tm * 256, pend = soff[e + 1];
        ARows ar; ar.mu = nullptr; ar.ltype = 0; ar.first = 0;
#pragma unroll
        for (int i = 0; i < 4; ++i) { const int pr = p0 + (TID() >> 3) + 64 * i; ar.p[i] = (pr < pend) ? c.HID + (size_t)pr * 256 : nullptr; }
        f32x4 acc[4][4]; acc_zero(acc);
        gemm_core<0>(acc, ar, (const bf16_t*)(c.ws + WS_ED) + ((size_t)e * DM + n0) * 256, 256, 256, lds);
        ACC_FOREACH(acc, { if (p0 + r_ < pend) { const float w = ((const float*)c.ENT)[((size_t)e * NT + (p0 + r_ - soff[e])) * 2 + 1];
            store_bf4(c.Y + (size_t)(p0 + r_) * DM + n0 + c_, (f32x4){v_[0] * w, v_[1] * w, v_[2] * w, v_[3] * w}); } });
    }
}
DI void phase_final(const Ctx& c, unsigned char* lds) {
    const int tid = TID(), lane = tid & 63, wave = tid >> 6;
    const float* gain = c.in(I_NFIN);
    int* soff = (int*)(lds + 65536);
    moe_offsets(c, DEPTH - 1, soff);
    for (int row = blockIdx.x * 8 + wave; row < NT; row += gridDim.x * 8) {
        f32x4 v[4];
#pragma unroll
        for (int i = 0; i < 4; ++i) v[i] = *(const f32x4*)(c.out + (size_t)row * DM + i * 256 + lane * 4);
        add_moe_rows(c, row, lane, v, soff);
        float ss = 0.f;
#pragma unroll
        for (int i = 0; i < 4; ++i) ss += v[i][0] * v[i][0] + v[i][1] * v[i][1] + v[i][2] * v[i][2] + v[i][3] * v[i][3];
        ss = wave_sum_dpp(ss);
        const float rs = rsqrtf(ss * (1.0f / DM) + 1e-6f);
#pragma unroll
        for (int i = 0; i < 4; ++i) {
            const f32x4 g = *(const f32x4*)(gain + i * 256 + lane * 4);
            *(f32x4*)(c.out + (size_t)row * DM + i * 256 + lane * 4) = (f32x4){v[i][0] * rs * g[0], v[i][1] * rs * g[1], v[i][2] * rs * g[2], v[i][3] * rs * g[3]};
        }
    }
}

constexpr int PH_PER_LAYER = 11, N_PHASES = DEPTH * PH_PER_LAYER + 1;
__global__ void __launch_bounds__(NTHREADS, 2) fwd_kernel(Params P) {
    extern __shared__ __attribute__((aligned(16))) unsigned char lds[];
    const int lo = P.ph_lo, hi = P.ph_hi;
    LAS unsigned* xbw = (LAS unsigned*)(lds + LDS_BYTES - 16);
    if (threadIdx.x == 0) { xbw[0] = 0u; xbw[1] = 0u; xbw[2] = 0u; xbw[3] = 0u; }
    __syncthreads();
    Ctx c; c.P = &P; c.ws = P.ws; c.out = P.out; c.l = 0;
    c.ctl = (unsigned*)(P.ws + WS_CTL);
    c.H = (bf16_t*)(P.ws + WS_H); c.PROJ = (bf16_t*)(P.ws + WS_PROJ); c.F = (bf16_t*)(P.ws + WS_F); c.POOLED = (bf16_t*)(P.ws + WS_POOLED);
    c.MERGED = (bf16_t*)(P.ws + WS_F); c.CMPH = (bf16_t*)(P.ws + WS_CMPH); c.CMPO = (float*)(P.ws + WS_CMPO); c.POSB = (float*)(P.ws + WS_POSB);
    c.ROUTE = (int*)(P.ws + WS_ROUTE); c.ENT = (int*)(P.ws + WS_ENT); c.HID = (bf16_t*)(P.ws + WS_HID); c.Y = (bf16_t*)(P.ws + WS_Y);
    c.VT = (bf16_t*)(P.ws + WS_VT); c.KC = (bf16_t*)(P.ws + WS_KC); c.VCT = (bf16_t*)(P.ws + WS_VCT); c.YRAW = (bf16_t*)(P.ws + WS_YRAW); c.BON = (float*)(P.ws + WS_BON);
    XcdBarrier bar; bar.bar = c.ctl + CW_BAR; bar.x = 0; bar.st = (volatile LAS unsigned*)xbw;
    if (hi - lo > 1) bar = xcd_barrier_post(c.ctl + CW_BAR, (volatile LAS unsigned*)xbw);
#define IN(k) (lo <= (k) && (k) < hi)
#define SEAM(k) do { if (IN(k) && IN((k) + 1)) xcd_barrier(bar); } while (0)
#pragma unroll 1
    for (int l = 0; l < DEPTH; ++l) {
        c.l = l; const int pb = l * PH_PER_LAYER;
        if (IN(pb + 0)) phase_norm1(c, lds);
        SEAM(pb + 0);
        if (IN(pb + 1)) phase_gemm1(c, lds);
        SEAM(pb + 1);
        if (IN(pb + 2)) phase_prep(c, lds);
        SEAM(pb + 2);
        if (IN(pb + 3)) phase_poolgemm(c, lds);
        SEAM(pb + 3);
        if (IN(pb + 4)) phase_mix(c, lds);
        SEAM(pb + 4);
        if (IN(pb + 5)) phase_rwkv_post(c, lds);
        SEAM(pb + 5);
        if (IN(pb + 6)) phase_merge(c, lds);
        SEAM(pb + 6);
        if (IN(pb + 7)) phase_outp(c, lds);
        SEAM(pb + 7);
        if (IN(pb + 8)) phase_norm2(c, lds);
        SEAM(pb + 8);
        if (IN(pb + 9)) phase_moe_up(c, lds);
        SEAM(pb + 9);
        if (IN(pb + 10)) phase_moe_down(c, lds);
        SEAM(pb + 10);
    }
    if (IN(N_PHASES - 1)) phase_final(c, lds);
}

#ifndef MK_N_LAUNCHES
#define MK_N_LAUNCHES 1
#endif
extern "C" void kernel_launch(void* const* d_in, const int* in_sizes, int n_in, void* d_out, int out_size, void* d_ws, size_t ws_size, hipStream_t stream) {
    static int grid = 0;
    if (grid == 0) {
        if (n_in != N_IN || out_size != NT * DM || ws_size < WS_END) { fprintf(stderr, "kernel_launch: unexpected shapes n_in %d out %d ws %zu (need %zu)\n", n_in, out_size, ws_size, (size_t)WS_END); grid = -1; return; }
        int dev = 0, cus = 0, per_cu = 0;
        if (hipGetDevice(&dev) != hipSuccess || hipDeviceGetAttribute(&cus, hipDeviceAttributeMultiprocessorCount, dev) != hipSuccess) { grid = -1; return; }
        if (hipFuncSetAttribute((const void*)fwd_kernel, hipFuncAttributeMaxDynamicSharedMemorySize, LDS_BYTES) != hipSuccess) { fprintf(stderr, "kernel_launch: hipFuncSetAttribute failed\n"); grid = -1; return; }
        if (hipOccupancyMaxActiveBlocksPerMultiprocessor(&per_cu, (const void*)fwd_kernel, NTHREADS, LDS_BYTES) != hipSuccess || per_cu < 1) { fprintf(stderr, "kernel_launch: occupancy query says %d\n", per_cu); }
        (void)hipGetLastError();
        grid = cus;
    }
    if (grid < 0) return;
    if (hipMemsetAsync((char*)d_ws + WS_CTL, 0, CTL_BYTES, stream) != hipSuccess) return;
    Params p{};
    for (int i = 0; i < N_IN; ++i) p.in[i] = (const float*)d_in[i];
    p.out = (float*)d_out; p.ws = (unsigned char*)d_ws;
    if (MK_N_LAUNCHES == 1) {
        p.ph_lo = 0; p.ph_hi = N_PHASES;
        hipLaunchKernelGGL(fwd_kernel, dim3(grid), dim3(NTHREADS), LDS_BYTES, stream, p);
    } else {
        for (int k = 0; k < N_PHASES; ++k) { p.ph_lo = k; p.ph_hi = k + 1; hipLaunchKernelGGL(fwd_kernel, dim3(grid), dim3(NTHREADS), LDS_BYTES, stream, p); }
    }
}
```

```cpp
#include <hip/hip_runtime.h>
#include <cstdio>
#include <cstdint>

#define DI __device__ __forceinline__
typedef unsigned short bf16_t;
typedef short bf16x8 __attribute__((ext_vector_type(8)));
typedef float f32x4 __attribute__((ext_vector_type(4)));
typedef unsigned u32x4 __attribute__((ext_vector_type(4)));
typedef unsigned u32x2 __attribute__((ext_vector_type(2)));

constexpr int NB = 4, SEQ = 4096, DM = 1024, NT = NB * SEQ, DEPTH = 2;
constexpr int IN_COLS = 4816;
constexpr int C_POOL = 0, C_RW = 512, C_R = 512, C_K = 1024, C_V = 1536, C_WD = 2048, C_AD = 2080, C_GD = 2112;
constexpr int C_Q = 2208, C_KC = 3232, C_VC = 3488, C_KS = 3744, C_VS = 4000, C_KW = 4256, C_VW = 4512, C_GATE = 4768;
constexpr int RWC = 1696;
constexpr int NCMP = 255;
constexpr int NTHREADS = 512;
constexpr int LDS_BYTES = 155648;

enum { I_X = 0, I_RELB, I_NMIX, I_WIN, I_POOLW, I_POOLS, I_MU, I_W0, I_WUP, I_A0, I_AUP, I_GUP, I_KK, I_KA, I_RK, I_GNW, I_GNB,
       I_CPK, I_CW1K, I_CW2K, I_CPV, I_CW1V, I_CW2V, I_WBR, I_WMG, I_BMG, I_WOUT, I_NFFN, I_WRG, I_BRG, I_WRE, I_BRE, I_EG, I_EU, I_ED, I_NFIN, N_IN };

constexpr size_t WS_CTL = 0;
constexpr size_t CTL_BYTES = 65536;
constexpr size_t WS_H = CTL_BYTES;
constexpr size_t WS_PROJ = WS_H + (size_t)NT * DM * 2;
constexpr size_t WS_F = WS_PROJ + (size_t)NT * IN_COLS * 2;
constexpr size_t PLANE = (size_t)NT * 512 * 2;
constexpr size_t WS_POOLED = WS_F + 6 * PLANE;
constexpr size_t WS_CMPH = WS_POOLED + PLANE;
constexpr size_t WS_CMPO = WS_CMPH + (size_t)2 * 4096 * 256 * 2;
constexpr size_t WS_POSB = WS_CMPO + (size_t)2 * 4096 * 64 * 4;
constexpr size_t WS_ROUTE = WS_POSB + 4096;
constexpr size_t WS_ENT = WS_ROUTE + (size_t)NT * 32;
constexpr size_t WS_VT = WS_ENT + (size_t)32 * NT * 8;
constexpr size_t WS_KC = WS_VT + (size_t)2 * 16 * 64 * SEQ * 2;
constexpr size_t WS_VCT = WS_KC + (size_t)16 * 256 * 64 * 2;
constexpr size_t WS_YRAW = WS_VCT + (size_t)16 * 64 * 256 * 2;
constexpr size_t WS_BON = WS_YRAW + (size_t)NT * 512 * 2;
constexpr size_t WS_SMALLW = WS_BON + (size_t)NT * 8 * 16;
constexpr size_t WS_WT_LORA = WS_SMALLW + 262144;
constexpr size_t WS_END = WS_WT_LORA + (size_t)1536 * 128 * 2;
constexpr size_t WS_WT_IN = WS_F;
constexpr size_t WS_WT_C1 = WS_CMPO;
constexpr size_t WS_WT_C2 = WS_SMALLW;
constexpr size_t WS_WT_POOL = WS_SMALLW + 131072;
constexpr size_t WS_WT_MG = WS_VT;
constexpr size_t WS_WT_BR = WS_VT + (size_t)3072 * 1024 * 2;
constexpr size_t WS_WT_OUT = WS_CMPH;
constexpr size_t WS_EG = WS_F + 2 * PLANE;
constexpr size_t WS_EU = WS_EG + (size_t)32 * 256 * 1024 * 2;
constexpr size_t WS_ED = WS_EU + (size_t)32 * 256 * 1024 * 2;
static_assert(WS_ED + (size_t)32 * 1024 * 256 * 2 <= WS_F + 6 * PLANE, "expert alias");
static_assert(WS_WT_BR + (size_t)2048 * 1024 * 2 <= WS_VT + (size_t)2 * 16 * 64 * SEQ * 2, "merge alias");
static_assert((size_t)4864 * 1024 * 2 <= 6 * PLANE, "w_in alias");
constexpr size_t WS_HID = WS_PROJ;
constexpr size_t WS_Y = WS_PROJ + (size_t)2 * NT * 256 * 2;
static_assert(WS_Y + (size_t)2 * NT * 1024 * 2 <= WS_F, "alias");
constexpr int CW_BAR = 0;
constexpr int CW_CNT = 4096;
constexpr int CW_CUR = 4096 + 64;
constexpr int CW_Q = 4096 + 128;

#define XB_TMO      128
#define XB_XCNT(j)  (256  + 64 * (j))
#define XB_XSUB(j)  (1280 + 64 * (j))
#define XB_XGEN(j)  (2304 + 64 * (j))
#define XB_TOP      3328
#define XB_TOPGEN   3392
#define XCD_BAR_WORDS 3456
#define XB_SPIN_CAP (1u << 18)
#define LAS __attribute__((address_space(3)))

__device__ __forceinline__ unsigned xb_ld(unsigned* p)              { return __hip_atomic_load(p, __ATOMIC_RELAXED, __HIP_MEMORY_SCOPE_AGENT); }
__device__ __forceinline__ unsigned xb_add(unsigned* p, unsigned v) { return __hip_atomic_fetch_add(p, v, __ATOMIC_RELAXED, __HIP_MEMORY_SCOPE_AGENT); }
__device__ __forceinline__ unsigned xb_xcc_id() { return (unsigned)__builtin_amdgcn_s_getreg((3 << 11) | 20) & 0xFu; }
#define XB_SPIN(cond, bar) do { unsigned _sp = 0; while (cond) { __builtin_amdgcn_s_sleep(1); \
    if ((++_sp & 255u) == 0u) { if (xb_ld(&(bar)[XB_TMO])) break; if (_sp > XB_SPIN_CAP) { atomicAdd(&(bar)[XB_TMO], 1u); break; } } } } while (0)

struct XcdBarrier { unsigned* bar; unsigned x; volatile LAS unsigned* st; };

__device__ __forceinline__ XcdBarrier xcd_barrier_post(unsigned* bar, volatile LAS unsigned* st) {
    XcdBarrier b; b.bar = bar; b.x = xb_xcc_id(); b.st = st;
    if (threadIdx.x == 0) (void)xb_add(&bar[XB_XCNT(b.x)], 1u);
    return b;
}
__device__ __forceinline__ void xcd_barrier_complete(unsigned* bar, unsigned x, unsigned& nloc, unsigned& nx) {
    const unsigned G = gridDim.x * gridDim.y * gridDim.z;
    unsigned sum, cnt, mine, sp = 0u;
    for (;;) {
        sum = 0u; cnt = 0u; mine = 0u;
#pragma unroll
        for (unsigned j = 0; j < 16; ++j) { const unsigned c = xb_ld(&bar[XB_XCNT(j)]); sum += c; cnt += (c > 0u) ? 1u : 0u; mine = (j == x) ? c : mine; }
        if (sum == G) break;
        __builtin_amdgcn_s_sleep(1);
        if ((++sp & 255u) == 0u) { if (xb_ld(&bar[XB_TMO])) break; if (sp > XB_SPIN_CAP) { atomicAdd(&bar[XB_TMO], 1u); break; } }
    }
    nloc = mine > 0u ? mine : 1u; nx = cnt > 0u ? cnt : 1u;
}
__device__ __forceinline__ void xcd_barrier(const XcdBarrier& b) {
    asm volatile("s_waitcnt vmcnt(0)" ::: "memory");
    __syncthreads();
    if (threadIdx.x == 0) {
        unsigned* bar = b.bar;
        __builtin_amdgcn_s_waitcnt(0);
        unsigned nloc = b.st[0], nx = b.st[1];
        if (nloc == 0u) { xcd_barrier_complete(bar, b.x, nloc, nx); b.st[0] = nloc; b.st[1] = nx; }
        const unsigned old = xb_add(&bar[XB_XSUB(b.x)], 1u);
        const unsigned gen = old / nloc;
        if (old + 1u == (gen + 1u) * nloc) {
            __builtin_amdgcn_fence(__ATOMIC_RELEASE, "agent");
            asm volatile("s_waitcnt vmcnt(0)" ::: "memory");
            const unsigned og = xb_add(&bar[XB_TOP], 1u);
            const unsigned tg = og / nx;
            if (og + 1u == (tg + 1u) * nx) xb_add(&bar[XB_TOPGEN], 1u);
            else XB_SPIN(xb_ld(&bar[XB_TOPGEN]) == tg, bar);
            __builtin_amdgcn_fence(__ATOMIC_ACQUIRE, "agent");
            xb_add(&bar[XB_XGEN(b.x)], 1u);
            asm volatile("s_waitcnt vmcnt(0)" ::: "memory");
        } else {
            XB_SPIN(xb_ld(&bar[XB_XGEN(b.x)]) == gen, bar);
            __builtin_amdgcn_fence(__ATOMIC_ACQUIRE, "agent");
            asm volatile("s_waitcnt vmcnt(0)" ::: "memory");
        }
    }
    __syncthreads();
}

DI bf16_t f2bf(float x) { unsigned u = __float_as_uint(x); u += 0x7fffu + ((u >> 16) & 1u); return (bf16_t)(u >> 16); }
DI float bf2f(bf16_t b) { return __uint_as_float((unsigned)b << 16); }
typedef __bf16 bf16v2_t __attribute__((ext_vector_type(2)));
typedef float f32v2_t __attribute__((ext_vector_type(2)));
DI unsigned pack2(float lo, float hi) { const f32v2_t v = {lo, hi}; const bf16v2_t b = __builtin_convertvector(v, bf16v2_t); return __builtin_bit_cast(unsigned, b); }
DI float bflo(unsigned w) { return __uint_as_float(w << 16); }
DI float bfhi(unsigned w) { return __uint_as_float(w & 0xffff0000u); }
DI float wave_sum(float v) {
#pragma unroll
    for (int o = 32; o >= 1; o >>= 1) v += __shfl_xor(v, o);
    return v;
}
DI float wave_max(float v) {
#pragma unroll
    for (int o = 32; o >= 1; o >>= 1) v = fmaxf(v, __shfl_xor(v, o));
    return v;
}
DI float sigmoidf_(float x) { return __builtin_amdgcn_rcpf(1.0f + __expf(-x)); }
DI int TID() { int t = threadIdx.x; asm volatile("" : "+v"(t)); return t; }
#define LDS_WAVE_SYNC() asm volatile("s_waitcnt lgkmcnt(0)" ::: "memory")

#define DPP_MOV(v, ctrl) __builtin_bit_cast(float, __builtin_amdgcn_update_dpp(0, __builtin_bit_cast(int, (v)), (ctrl), 0xF, 0xF, true))
DI float wave_sum_dpp(float v) {
    v += DPP_MOV(v, 0xB1); v += DPP_MOV(v, 0x4E); v += DPP_MOV(v, 0x141); v += DPP_MOV(v, 0x140);
    return __builtin_bit_cast(float, __builtin_amdgcn_readlane(__builtin_bit_cast(int, v), 0)) + __builtin_bit_cast(float, __builtin_amdgcn_readlane(__builtin_bit_cast(int, v), 16)) +
        (__builtin_bit_cast(float, __builtin_amdgcn_readlane(__builtin_bit_cast(int, v), 32)) + __builtin_bit_cast(float, __builtin_amdgcn_readlane(__builtin_bit_cast(int, v), 48)));
}
struct Params { const float* in[N_IN]; float* out; unsigned char* ws; int ph_lo, ph_hi; };

DI int t5_bucket(int n) {
    if (n < 16) return n;
    if (n >= 128) return 31;
    int b = 16;
    b += (n >= 19) + (n >= 21) + (n >= 24) + (n >= 27) + (n >= 31) + (n >= 35) + (n >= 40) + (n >= 46) + (n >= 52) + (n >= 59) + (n >= 67) + (n >= 77) + (n >= 87) + (n >= 99) + (n >= 113);
    return b;
}

constexpr int G_A = 0, G_B = 256 * 64 * 2, G_STAGE = (256 + 128) * 64 * 2;
static_assert(2 * G_STAGE <= LDS_BYTES - 64, "gemm lds");
DI int g_off(int r, int c) { return ((r >> 4) * 2 + (c >> 5)) * 1024 + ((((r & 15) * 64) + (c & 31) * 2) ^ ((((r & 15) >> 3) & 1) << 5)); }
struct ARows { const bf16_t* p[4]; const float* mu; int ltype; int first; };
DI float tanhf_fast(float x) { const float e = __expf(2.0f * x); return 1.0f - 2.0f * __builtin_amdgcn_rcpf(e + 1.0f); }
DI u32x4 lora_chunk(const bf16_t* prow, bool first, const float* mu, int ltype, int k) {
    const int lim = (ltype == 2) ? 96 : 32;
    if (k >= lim) return (u32x4){0u, 0u, 0u, 0u};
    const int col = C_WD + ltype * 32 + k;
    const u32x4 cu = *(const u32x4*)(prow + col);
    u32x4 pu = (u32x4){0u, 0u, 0u, 0u};
    if (!first) pu = *(const u32x4*)(prow - IN_COLS + col);
    const f32x4 m0 = *(const f32x4*)(mu + col - C_RW), m1 = *(const f32x4*)(mu + col - C_RW + 4);
    float u[8] = {bflo(cu.x), bfhi(cu.x), bflo(cu.y), bfhi(cu.y), bflo(cu.z), bfhi(cu.z), bflo(cu.w), bfhi(cu.w)};
    const float p[8] = {bflo(pu.x), bfhi(pu.x), bflo(pu.y), bfhi(pu.y), bflo(pu.z), bfhi(pu.z), bflo(pu.w), bfhi(pu.w)};
    const float mm[8] = {m0[0], m0[1], m0[2], m0[3], m1[0], m1[1], m1[2], m1[3]};
#pragma unroll
    for (int j = 0; j < 8; ++j) { const float us = u[j] + (p[j] - u[j]) * mm[j]; u[j] = (ltype == 0) ? tanhf_fast(us) : ((ltype == 1) ? us : __builtin_amdgcn_rcpf(1.0f + __expf(-us))); }
    u32x4 w; w.x = pack2(u[0], u[1]); w.y = pack2(u[2], u[3]); w.z = pack2(u[4], u[5]); w.w = pack2(u[6], u[7]);
    return w;
}
template <int AMODE>
DI void g_load(u32x4 (&ra)[4], u32x4 (&rb)[2], const ARows& ar, const bf16_t* bt, int ldb, int k0, int tid) {
    const int kseg = (tid & 7) * 8;
#pragma unroll
    for (int i = 0; i < 4; ++i) {
        ra[i] = (u32x4){0u, 0u, 0u, 0u};
        if (AMODE == 2) ra[i] = lora_chunk(ar.p[i], (ar.first >> i) & 1, ar.mu, ar.ltype, k0 + kseg);
        else if (ar.p[i] != nullptr) ra[i] = *(const u32x4*)((AMODE == 0) ? (ar.p[i] + k0 + kseg) : (ar.p[i] + (size_t)(k0 >> 6) * IN_COLS + kseg));
    }
#pragma unroll
    for (int i = 0; i < 2; ++i) rb[i] = *(const u32x4*)(bt + (size_t)((tid >> 3) + 64 * i) * ldb + k0 + kseg);
}
DI void g_store(unsigned char* st, const u32x4 (&ra)[4], const u32x4 (&rb)[2], int tid) {
    const int off = g_off(tid >> 3, (tid & 7) * 8);
#pragma unroll
    for (int i = 0; i < 4; ++i) *(u32x4*)(st + G_A + off + i * 8192) = ra[i];
#pragma unroll
    for (int i = 0; i < 2; ++i) *(u32x4*)(st + G_B + off + i * 8192) = rb[i];
}
DI void g_compute(f32x4 (&acc)[4][4], const unsigned char* st, int lane, int wm, int wn) {
    const int lo = ((lane & 15) * 64 + (lane >> 4) * 16) ^ ((((lane & 15) >> 3) & 1) << 5);
    const unsigned char* sA = st + G_A + wm * 8192 + lo;
    const unsigned char* sB = st + G_B + wn * 8192 + lo;
    bf16x8 bcur[4], bnxt[4], a0, a1, a2;
#pragma unroll
    for (int i = 0; i < 4; ++i) bcur[i] = *(const bf16x8*)(sB + i * 2048);
    a0 = *(const bf16x8*)(sA);
    a1 = *(const bf16x8*)(sA + 2048);
#define G_AFRAG(s) (*(const bf16x8*)(sA + ((s) & 3) * 2048 + ((s) >> 2) * 1024))
#define G_GROUP(s, acur, anew) do { \
        if ((s) + 2 < 8) anew = G_AFRAG((s) + 2); \
        if ((s) < 4) bnxt[(s) & 3] = *(const bf16x8*)(sB + ((s) & 3) * 2048 + 1024); \
        __builtin_amdgcn_sched_barrier(0); \
        _Pragma("unroll") for (int ni = 0; ni < 4; ++ni) acc[(s) & 3][ni] = __builtin_amdgcn_mfma_f32_16x16x32_bf16(((s) < 4 ? bcur[ni] : bnxt[ni]), acur, acc[(s) & 3][ni], 0, 0, 0); \
        __builtin_amdgcn_sched_barrier(0); } while (0)
    G_GROUP(0, a0, a2); G_GROUP(1, a1, a0); G_GROUP(2, a2, a1); G_GROUP(3, a0, a2);
    G_GROUP(4, a1, a0); G_GROUP(5, a2, a1); G_GROUP(6, a0, a2); G_GROUP(7, a1, a0);
#undef G_GROUP
#undef G_AFRAG
}
#define LDS_BARRIER() do { asm volatile("s_waitcnt lgkmcnt(0)" ::: "memory"); __builtin_amdgcn_s_barrier(); asm volatile("" ::: "memory"); } while (0)
template <int AMODE>
DI void gemm_core(f32x4 (&acc)[4][4], const ARows& ar, const bf16_t* bt  , int ldb, int K, unsigned char* lds) {
    const int tid = TID(), lane = tid & 63, wave = tid >> 6, wm = wave >> 1, wn = wave & 1;
    const int nk = K >> 6;
    unsigned char* s0 = lds; unsigned char* s1 = lds + G_STAGE;
    u32x4 ra0[4], rb0[2], ra1[4], rb1[2];
    g_load<AMODE>(ra0, rb0, ar, bt, ldb, 0, tid);
    g_load<AMODE>(ra1, rb1, ar, bt, ldb, 64, tid);
    __syncthreads();
    g_store(s0, ra0, rb0, tid);
    g_load<AMODE>(ra0, rb0, ar, bt, ldb, (nk > 2 ? 2 : nk - 1) * 64, tid);
    LDS_BARRIER();
    for (int kt = 0; kt < nk; kt += 2) {
        g_store(s1, ra1, rb1, tid);
        { const int kn = (kt + 3 < nk) ? kt + 3 : nk - 1; g_load<AMODE>(ra1, rb1, ar, bt, ldb, kn * 64, tid); }
        g_compute(acc, s0, lane, wm, wn);
        LDS_BARRIER();
        g_store(s0, ra0, rb0, tid);
        { const int kn = (kt + 4 < nk) ? kt + 4 : nk - 1; g_load<AMODE>(ra0, rb0, ar, bt, ldb, kn * 64, tid); }
        g_compute(acc, s1, lane, wm, wn);
        LDS_BARRIER();
    }
}
static_assert(3 * G_STAGE <= LDS_BYTES - 64, "dma ring");
DI void gemm_core_dma(f32x4 (&acc)[4][4], const bf16_t* A, size_t lda, const bf16_t* bt, size_t ldb, int K, unsigned char* lds) {
    const int tid = TID(), lane = tid & 63, wave = __builtin_amdgcn_readfirstlane(tid >> 6), wm = wave >> 1, wn = wave & 1;
    const int nk = K >> 6;
    const int srow = lane >> 2, skof = ((lane & 3) * 8) ^ ((lane >> 5) << 4);
    const char* gp[6]; int loff[6];
#pragma unroll
    for (int j = 0; j < 6; ++j) {
        const int sid = wave * 6 + j;
        if (sid < 32) { gp[j] = (const char*)(A + (size_t)((sid >> 1) * 16 + srow) * lda + (sid & 1) * 32 + skof); loff[j] = G_A + sid * 1024; }
        else { const int s2 = sid - 32; gp[j] = (const char*)(bt + (size_t)((s2 >> 1) * 16 + srow) * ldb + (s2 & 1) * 32 + skof); loff[j] = G_B + s2 * 1024; }
    }
#define DMA_ISSUE(kt_, st_) do { const int _k = ((kt_) < nk ? (kt_) : nk - 1) * 128; \
        _Pragma("unroll") for (int j = 0; j < 6; ++j) __builtin_amdgcn_global_load_lds((const unsigned*)(gp[j] + _k), (LAS unsigned*)(lds + (st_) * G_STAGE + loff[j]), 16, 0, 0); } while (0)
    asm volatile("s_waitcnt vmcnt(0)" ::: "memory");
    __syncthreads();
    DMA_ISSUE(0, 0); DMA_ISSUE(1, 1);
    int st = 0;
    for (int kt = 0; kt < nk; ++kt) {
        asm volatile("s_waitcnt vmcnt(6)" ::: "memory");
        __builtin_amdgcn_s_barrier();
        asm volatile("" ::: "memory");
        const int sn = (st == 0) ? 2 : st - 1;
        DMA_ISSUE(kt + 2, sn);
        g_compute(acc, lds + st * G_STAGE, lane, wm, wn);
        st = (st == 2) ? 0 : st + 1;
    }
    asm volatile("s_waitcnt vmcnt(0)" ::: "memory");
    __syncthreads();
#undef DMA_ISSUE
}
DI void store_bf4(bf16_t* p, f32x4 v) { u32x2 w; w.x = pack2(v[0], v[1]); w.y = pack2(v[2], v[3]); *(u32x2*)p = w; }
constexpr int H_A = 0, H_B = 256 * 64 * 2, H_STAGE = 2 * 256 * 64 * 2;
static_assert(2 * H_STAGE <= LDS_BYTES - 64, "gemm256 lds");
DI void h_compute(f32x4 (&acc)[8][4], const unsigned char* st, int lane, int wm, int wn) {
    const int lo = ((lane & 15) * 64 + (lane >> 4) * 16) ^ ((((lane & 15) >> 3) & 1) << 5);
    const unsigned char* sA = st + H_A + wm * 16384 + lo;
    const unsigned char* sB = st + H_B + wn * 8192 + lo;
#pragma unroll
    for (int ks = 0; ks < 2; ++ks) {
        bf16x8 bf[4], a0, a1, a2;
#pragma unroll
        for (int i = 0; i < 4; ++i) bf[i] = *(const bf16x8*)(sB + i * 2048 + ks * 1024);
        a0 = *(const bf16x8*)(sA + ks * 1024);
        a1 = *(const bf16x8*)(sA + 2048 + ks * 1024);
#define H_GROUP(s, acur, anew) do { \
        if ((s) + 2 < 8) anew = *(const bf16x8*)(sA + ((s) + 2) * 2048 + ks * 1024); \
        __builtin_amdgcn_sched_barrier(0); \
        _Pragma("unroll") for (int ni = 0; ni < 4; ++ni) acc[(s)][ni] = __builtin_amdgcn_mfma_f32_16x16x32_bf16(bf[ni], acur, acc[(s)][ni], 0, 0, 0); \
        __builtin_amdgcn_sched_barrier(0); } while (0)
        H_GROUP(0, a0, a2); H_GROUP(1, a1, a0); H_GROUP(2, a2, a1); H_GROUP(3, a0, a2);
        H_GROUP(4, a1, a0); H_GROUP(5, a2, a1); H_GROUP(6, a0, a2); H_GROUP(7, a1, a0);
#undef H_GROUP
    }
}
DI void gemm256_dma(f32x4 (&acc)[8][4], const bf16_t* A, size_t lda, const bf16_t* bt, size_t ldb, int K, unsigned char* lds) {
    const int tid = TID(), lane = tid & 63, wave = __builtin_amdgcn_readfirstlane(tid >> 6), wm = wave >> 2, wn = wave & 3;
    const int nk = K >> 6;
    const int srow = lane >> 2, skof = ((lane & 3) * 8) ^ ((lane >> 5) << 4);
    const char* gp[8]; int loff[8];
#pragma unroll
    for (int j = 0; j < 8; ++j) {
        const int sid = wave * 8 + j;
        if (sid < 32) { gp[j] = (const char*)(A + (size_t)((sid >> 1) * 16 + srow) * lda + (sid & 1) * 32 + skof); loff[j] = H_A + sid * 1024; }
        else { const int s2 = sid - 32; gp[j] = (const char*)(bt + (size_t)((s2 >> 1) * 16 + srow) * ldb + (s2 & 1) * 32 + skof); loff[j] = H_B + s2 * 1024; }
    }
#define H_ISSUE(kt_, st_) do { const int _k = ((kt_) < nk ? (kt_) : nk - 1) * 128; \
        _Pragma("unroll") for (int j = 0; j < 8; ++j) __builtin_amdgcn_global_load_lds((const unsigned*)(gp[j] + _k), (LAS unsigned*)(lds + (st_) * H_STAGE + loff[j]), 16, 0, 0); } while (0)
    asm volatile("s_waitcnt vmcnt(0)" ::: "memory");
    __syncthreads();
    H_ISSUE(0, 0);
    for (int kt = 0; kt < nk; ++kt) {
        asm volatile("s_waitcnt vmcnt(0)" ::: "memory");
        __builtin_amdgcn_s_barrier();
        asm volatile("" ::: "memory");
        H_ISSUE(kt + 1, (kt + 1) & 1);
        h_compute(acc, lds + (kt & 1) * H_STAGE, lane, wm, wn);
    }
    asm volatile("s_waitcnt vmcnt(0)" ::: "memory");
    __syncthreads();
#undef H_ISSUE
}
DI void tile256_store_bf16(f32x4 (&acc)[8][4], bf16_t* out, size_t ld, int ncols, unsigned char* lds) {
    bf16_t* T = (bf16_t*)lds;
    const int tid = TID(), lane = tid & 63, wave = tid >> 6, wm = wave >> 2, wn = wave & 3;
    __syncthreads();
#pragma unroll
    for (int mi = 0; mi < 8; ++mi)
#pragma unroll
        for (int ni = 0; ni < 4; ++ni) store_bf4(T + (wm * 128 + mi * 16 + (lane & 15)) * 264 + wn * 64 + ni * 16 + (lane >> 4) * 4, acc[mi][ni]);
    __syncthreads();
#pragma unroll
    for (int i = 0; i < 16; ++i) {
        const int ch = tid + i * NTHREADS, r = ch >> 5, cc = (ch & 31) * 8;
        if (cc < ncols) *(u32x4*)(out + (size_t)r * ld + cc) = *(const u32x4*)(T + r * 264 + cc);
    }
}
DI void acc_zero(f32x4 (&acc)[4][4]) {
#pragma unroll
    for (int i = 0; i < 4; ++i)
#pragma unroll
        for (int j = 0; j < 4; ++j) acc[i][j] = (f32x4){0.f, 0.f, 0.f, 0.f};
}
#define ACC_FOREACH(acc, body) do { const int _l = TID() & 63, _w = TID() >> 6; \
    _Pragma("unroll") for (int _mi = 0; _mi < 4; ++_mi) _Pragma("unroll") for (int _ni = 0; _ni < 4; ++_ni) { \
        const int r_ = (_w >> 1) * 64 + _mi * 16 + (_l & 15), c_ = (_w & 1) * 64 + _ni * 16 + (_l >> 4) * 4; f32x4& v_ = acc[_mi][_ni]; body } } while (0)
DI ARows plain_rows(const bf16_t* base, size_t ld, int m0, int tid) { ARows a; a.mu = nullptr; a.ltype = 0; a.first = 0;
#pragma unroll
    for (int i = 0; i < 4; ++i) a.p[i] = base + (size_t)(m0 + (tid >> 3) + 64 * i) * ld;
    return a; }


DI void convert_tile4(const float* src, int ld, int N, int K, bf16_t* dst, int tile0, unsigned char* lds, int Kvalid = 1 << 30) {
    const int tid = TID();
    const int nkt = K >> 6;
    const int r = tid >> 3, seg = (tid & 7) * 8;
    f32x4 a[4], b[4];
#pragma unroll
    for (int u = 0; u < 4; ++u) {
        const int tile = tile0 + u, k0 = (tile % nkt) * 64, n0 = (tile / nkt) * 64;
        a[u] = (f32x4){0.f, 0.f, 0.f, 0.f}; b[u] = a[u];
        if (n0 + seg < N && k0 + r < Kvalid) { const float* q = src + (size_t)(k0 + r) * ld + n0 + seg; a[u] = *(const f32x4*)q; b[u] = *(const f32x4*)(q + 4); }
    }
    __syncthreads();
#pragma unroll
    for (int u = 0; u < 4; ++u) { bf16_t* T = (bf16_t*)lds + u * 64 * 72;
        u32x4 w; w.x = pack2(a[u][0], a[u][1]); w.y = pack2(a[u][2], a[u][3]); w.z = pack2(b[u][0], b[u][1]); w.w = pack2(b[u][2], b[u][3]); *(u32x4*)(T + r * 72 + seg) = w; }
    __syncthreads();
#pragma unroll
    for (int u = 0; u < 4; ++u) { const bf16_t* T = (const bf16_t*)lds + u * 64 * 72;
        const int tile = tile0 + u, k0 = (tile % nkt) * 64, n0 = (tile / nkt) * 64;
        u32x4 o;
        o.x = (unsigned)T[(seg + 0) * 72 + r] | ((unsigned)T[(seg + 1) * 72 + r] << 16); o.y = (unsigned)T[(seg + 2) * 72 + r] | ((unsigned)T[(seg + 3) * 72 + r] << 16);
        o.z = (unsigned)T[(seg + 4) * 72 + r] | ((unsigned)T[(seg + 5) * 72 + r] << 16); o.w = (unsigned)T[(seg + 6) * 72 + r] | ((unsigned)T[(seg + 7) * 72 + r] << 16);
        *(u32x4*)(dst + (size_t)(n0 + r) * K + k0 + seg) = o; }
}
struct Ctx {
    const Params* P; unsigned char* ws; float* out; int l;
    bf16_t* H; bf16_t* PROJ; bf16_t* F; bf16_t* POOLED; bf16_t* MERGED; bf16_t* CMPH; float* CMPO; float* POSB; int* ROUTE; int* ENT; bf16_t* HID; bf16_t* Y; bf16_t* VT; bf16_t* KC; bf16_t* VCT; bf16_t* YRAW; float* BON; unsigned* ctl;
    DI const float* in(int i) const { return P->in[i]; }
};

DI void moe_offsets(const Ctx& c, int layer, int* soff) {
    const unsigned* cnt = c.ctl + CW_CNT + layer * 32;
    __syncthreads();
    if (TID() == 0) { int s = 0; for (int e = 0; e < 32; ++e) { soff[e] = s; s += (int)cnt[e]; } soff[32] = s; }
    __syncthreads();
}
DI void add_moe_rows(const Ctx& c, int row, int lane, f32x4 (&v)[4], const int* soff) {
    const int* rt = c.ROUTE + (size_t)row * 8;
    const int p0 = soff[rt[0]] + rt[4], p1 = soff[rt[1]] + rt[5];
    const bf16_t* y0 = c.Y + (size_t)p0 * DM; const bf16_t* y1 = c.Y + (size_t)p1 * DM;
#pragma unroll
    for (int i = 0; i < 4; ++i) {
        const u32x2 a = *(const u32x2*)(y0 + i * 256 + lane * 4), b = *(const u32x2*)(y1 + i * 256 + lane * 4);
        v[i][0] += bflo(a.x) + bflo(b.x); v[i][1] += bfhi(a.x) + bfhi(b.x); v[i][2] += bflo(a.y) + bflo(b.y); v[i][3] += bfhi(a.y) + bfhi(b.y);
    }
}
DI void phase_norm1(const Ctx& c, unsigned char* lds) {
    const int tid = TID(), lane = tid & 63, wave = tid >> 6;
    const float* gain = c.in(I_NMIX) + c.l * DM;
    const float* src = (c.l == 0) ? c.in(I_X) : c.out;
    int* soff = (int*)(lds + 65536);
    if (c.l > 0) moe_offsets(c, c.l - 1, soff);
    for (int row = blockIdx.x * 8 + wave; row < NT; row += gridDim.x * 8) {
        f32x4 v[4];
#pragma unroll
        for (int i = 0; i < 4; ++i) v[i] = *(const f32x4*)(src + (size_t)row * DM + i * 256 + lane * 4);
        if (c.l > 0) {
            add_moe_rows(c, row, lane, v, soff);
#pragma unroll
            for (int i = 0; i < 4; ++i) *(f32x4*)(c.out + (size_t)row * DM + i * 256 + lane * 4) = v[i];
        }
        float ss = 0.f;
#pragma unroll
        for (int i = 0; i < 4; ++i) ss += v[i][0] * v[i][0] + v[i][1] * v[i][1] + v[i][2] * v[i][2] + v[i][3] * v[i][3];
        ss = wave_sum_dpp(ss);
        const float rs = rsqrtf(ss * (1.0f / DM) + 1e-6f);
#pragma unroll
        for (int i = 0; i < 4; ++i) {
            const f32x4 g = *(const f32x4*)(gain + i * 256 + lane * 4);
            store_bf4(c.H + (size_t)row * DM + i * 256 + lane * 4, (f32x4){v[i][0] * rs * g[0], v[i][1] * rs * g[1], v[i][2] * rs * g[2], v[i][3] * rs * g[3]});
        }
    }
    for (int idx = blockIdx.x * 8 + wave; idx < 512; idx += gridDim.x * 8) {
        const int kv = idx >> 8, n = idx & 255;
        const float* pos = c.in(kv ? I_CPV : I_CPK) + (size_t)c.l * 2048;
        const float* w1 = c.in(kv ? I_CW1V : I_CW1K) + (size_t)c.l * 2048 * 256;
        float s = 0.f;
        for (int k = lane; k < 2048; k += 64) s += pos[k] * w1[(size_t)k * 256 + n];
        s = wave_sum_dpp(s);
        if (lane == 0) c.POSB[kv * 256 + n] = s;
    }
    for (int it = blockIdx.x * 4; it < 1216 + 256 + 16 + 16 + 48; it += gridDim.x * 4) {
        if (it < 1216) convert_tile4(c.in(I_WIN) + (size_t)c.l * DM * IN_COLS, IN_COLS, IN_COLS, DM, (bf16_t*)(c.ws + WS_WT_IN), it, lds);
        else if (it < 1216 + 256) { const int j = it - 1216, kv = j >> 7; convert_tile4(c.in(kv ? I_CW1V : I_CW1K) + (size_t)c.l * 2048 * 256, 256, 256, 2048, (bf16_t*)(c.ws + WS_WT_C1) + (size_t)kv * 256 * 2048, j & 127, lds); }
        else if (it < 1216 + 256 + 16) { const int j = it - 1472, kv = j >> 3; convert_tile4(c.in(kv ? I_CW2V : I_CW2K) + (size_t)c.l * 256 * 64, 64, 64, 256, (bf16_t*)(c.ws + WS_WT_C2) + (size_t)kv * 128 * 256, j & 7, lds); }
        else if (it < 1504) { const int j = it - 1488, gi = j >> 2; convert_tile4(c.in(I_POOLW) + ((size_t)c.l * 4 + gi) * 128 * 128, 128, 128, 128, (bf16_t*)(c.ws + WS_WT_POOL) + (size_t)gi * 128 * 128, 0, lds); }
        else { const int j = it - 1504, ty = j >> 4; bf16_t* dst = (bf16_t*)(c.ws + WS_WT_LORA) + (size_t)ty * 512 * 128;
            if (ty == 0) convert_tile4(c.in(I_WUP) + (size_t)c.l * 32 * 512, 512, 512, 128, dst, j & 15, lds, 32);
            else if (ty == 1) convert_tile4(c.in(I_AUP) + (size_t)c.l * 32 * 512, 512, 512, 128, dst, j & 15, lds, 32);
            else convert_tile4(c.in(I_GUP) + (size_t)c.l * 96 * 512, 512, 512, 128, dst, j & 15, lds, 96); }
    }
}

constexpr int EPS = 136;
DI void tile_store_bf16(f32x4 (&acc)[4][4], bf16_t* out, size_t ld, int nrows, int ncols, unsigned char* lds) {
    bf16_t* T = (bf16_t*)lds;
    const int tid = TID();
    __syncthreads();
    ACC_FOREACH(acc, { store_bf4(T + r_ * EPS + c_, v_); });
    __syncthreads();
#pragma unroll
    for (int i = 0; i < 8; ++i) {
        const int ch = tid + i * NTHREADS, r = ch >> 4, cc = (ch & 15) * 8;
        if (r < nrows && cc < ncols) *(u32x4*)(out + (size_t)r * ld + cc) = *(const u32x4*)(T + r * EPS + cc);
    }
}
DI bool xcd_unit(int it, int nN, int& tm, int& tn) {
    const int G = gridDim.x;
    if ((G & 7) != 0 || G < 8) { const int u = it * G + blockIdx.x; if (u >= 64 * nN) return false; tm = u % 64; tn = u / 64; return true; }
    const int x = blockIdx.x & 7, i = blockIdx.x >> 3, per = G >> 3;
    const int u = it * per + i;
    if (u >= 8 * nN) return false;
    tm = x * 8 + (u & 7); tn = u >> 3; return true;
}
DI void phase_gemm1(const Ctx& c, unsigned char* lds) {
    const int nN = (IN_COLS + 255) / 256;
    const bf16_t* WT = (const bf16_t*)(c.ws + WS_WT_IN);
    for (int it = 0;; ++it) {
        int tm, tn; if (!xcd_unit(it, nN, tm, tn)) break;
        const int m0 = tm * 256, n0 = tn * 256;
        f32x4 acc[8][4];
#pragma unroll
        for (int i = 0; i < 8; ++i)
#pragma unroll
            for (int j = 0; j < 4; ++j) acc[i][j] = (f32x4){0.f, 0.f, 0.f, 0.f};
        gemm256_dma(acc, c.H + (size_t)m0 * DM, DM, WT + (size_t)n0 * DM, DM, DM, lds);
        tile256_store_bf16(acc, c.PROJ + (size_t)m0 * IN_COLS + n0, IN_COLS, (IN_COLS - n0 < 256) ? IN_COLS - n0 : 256, lds);
    }
}

DI float gelu_tanh(float x) { const float u = 0.7978845608028654f * (x + 0.044715f * x * x * x); const float e = __expf(2.0f * u); return x * (1.0f - __builtin_amdgcn_rcpf(e + 1.0f)); }
DI float softplusf_(float x) { return (x > 20.f) ? x : __logf(1.0f + __expf(x)); }
DI float tanhf_(float x) { const float e = __expf(2.0f * x); return 1.0f - 2.0f * __builtin_amdgcn_rcpf(e + 1.0f); }
constexpr int TKP = 8;
template <int WIN>
DI void pool_emit(const Ctx& c, const float (&pv)[31], int t0, int s0, int ch) {
#pragma unroll
    for (int k = 0; k < 16; ++k) {
        float sum = 0.f;
#pragma unroll
        for (int j = 0; j < WIN; ++j) sum += pv[15 + k - j];
        const int s = s0 + k, cnt = (s + 1 < WIN) ? s + 1 : WIN;
        c.POOLED[(size_t)(t0 + k) * 512 + ch] = f2bf(sum / (float)cnt - pv[15 + k]);
    }
}
DI void phase_prep(const Ctx& c, unsigned char* lds) {
    const int n_cmp_items = 2 * 16 * 2;
    for (int item = (int)gridDim.x - 1 - (int)blockIdx.x; item < n_cmp_items; item += gridDim.x) {
        const int tid = TID();
        const int kv = item >> 5, bgi = (item >> 1) & 15, tn = item & 1, m0 = bgi * 256, n0 = tn * 128;
        ARows ar; ar.mu = nullptr; ar.ltype = 0; ar.first = 0;
#pragma unroll
        for (int i = 0; i < 4; ++i) { const int cb = (tid >> 3) + 64 * i;
            ar.p[i] = (cb < NCMP) ? c.PROJ + ((size_t)(bgi >> 2) * SEQ + 16 * cb) * IN_COLS + (kv ? C_VC : C_KC) + (bgi & 3) * 64 : nullptr; }
        f32x4 acc[4][4]; acc_zero(acc);
        gemm_core<1>(acc, ar, (const bf16_t*)(c.ws + WS_WT_C1) + ((size_t)kv * 256 + n0) * 2048, 2048, 2048, lds);
        const float* pb = c.POSB + kv * 256;
        ACC_FOREACH(acc, {
            const f32x4 bb = *(const f32x4*)(pb + n0 + c_);
            store_bf4(c.CMPH + ((size_t)kv * 4096 + m0 + r_) * 256 + n0 + c_, (f32x4){gelu_tanh(v_[0] + bb[0]), gelu_tanh(v_[1] + bb[1]), gelu_tanh(v_[2] + bb[2]), gelu_tanh(v_[3] + bb[3])}); });
    }
    {
        const float* mu = c.in(I_MU) + (size_t)c.l * RWC;
        const bf16_t* WL = (const bf16_t*)(c.ws + WS_WT_LORA);
        for (int unit = blockIdx.x; unit < 64 * 12; unit += gridDim.x) {
            const int tid = TID();
            const int tm = unit & 63, tn = unit >> 6, m0 = tm * 256, n0 = tn * 128, ltype = tn >> 2, ch0 = n0 & 511;
            ARows ar; ar.mu = mu; ar.ltype = ltype; ar.first = 0;
#pragma unroll
            for (int i = 0; i < 4; ++i) { const int t = m0 + (tid >> 3) + 64 * i; ar.p[i] = c.PROJ + (size_t)t * IN_COLS; if ((t & (SEQ - 1)) == 0) ar.first |= 1 << i; }
            f32x4 acc[4][4]; acc_zero(acc);
            gemm_core<2>(acc, ar, WL + (size_t)n0 * 128, 128, 128, lds);
            if (ltype == 0) { const float* w0 = c.in(I_W0) + c.l * 512 + ch0;
                ACC_FOREACH(acc, { const f32x4 b4 = *(const f32x4*)(w0 + c_);
                    for (int j = 0; j < 4; ++j) v_[j] = __expf(-softplusf_(-(b4[j] + v_[j])) - 0.5f); }); }
            else if (ltype == 1) { const float* a0 = c.in(I_A0) + c.l * 512 + ch0;
                ACC_FOREACH(acc, { const f32x4 b4 = *(const f32x4*)(a0 + c_);
                    for (int j = 0; j < 4; ++j) v_[j] = sigmoidf_(b4[j] + v_[j]); }); }
            tile_store_bf16(acc, c.F + (size_t)(3 + ltype) * NT * 512 + (size_t)m0 * 512 + ch0, 512, 256, 128, lds);
        }
    }
    const int tid = TID();
    const int n_pool_items = NT / 16, n_items = n_pool_items + 512;
    for (int item = blockIdx.x; item < n_items; item += gridDim.x) {
        if (item >= n_pool_items) {
            const int idx0 = (item - n_pool_items) * 4;
            const int r = tid >> 3, seg = (tid & 7) * 8;
            u32x4 w[4];
#pragma unroll
            for (int u = 0; u < 4; ++u) { const int idx = idx0 + u, kind = idx >> 10, bgi = (idx >> 6) & 15, s0 = (idx & 63) * 64;
                w[u] = *(const u32x4*)(c.PROJ + ((size_t)(bgi >> 2) * SEQ + s0 + r) * IN_COLS + (kind ? C_VW : C_VS) + (bgi & 3) * 64 + seg); }
            __syncthreads();
#pragma unroll
            for (int u = 0; u < 4; ++u) *(u32x4*)((bf16_t*)lds + u * 64 * 72 + r * 72 + seg) = w[u];
            __syncthreads();
#pragma unroll
            for (int u = 0; u < 4; ++u) { const int idx = idx0 + u, kind = idx >> 10, bgi = (idx >> 6) & 15, s0 = (idx & 63) * 64;
                const bf16_t* T = (const bf16_t*)lds + u * 64 * 72;
                u32x4 o;
                o.x = (unsigned)T[(seg + 0) * 72 + r] | ((unsigned)T[(seg + 1) * 72 + r] << 16); o.y = (unsigned)T[(seg + 2) * 72 + r] | ((unsigned)T[(seg + 3) * 72 + r] << 16);
                o.z = (unsigned)T[(seg + 4) * 72 + r] | ((unsigned)T[(seg + 5) * 72 + r] << 16); o.w = (unsigned)T[(seg + 6) * 72 + r] | ((unsigned)T[(seg + 7) * 72 + r] << 16);
                *(u32x4*)(c.VT + (((size_t)kind * 16 + bgi) * 64 + r) * SEQ + s0 + seg) = o; }
        } else {
            const int t0 = item * 16, ch = tid, gi = ch >> 7, s0 = t0 & (SEQ - 1);
            float pv[31];
#pragma unroll
            for (int i = 0; i < 31; ++i) pv[i] = (s0 - 15 + i >= 0) ? bf2f(c.PROJ[(size_t)(t0 - 15 + i) * IN_COLS + C_POOL + ch]) : 0.f;
            if (gi == 0) pool_emit<2>(c, pv, t0, s0, ch);
            else if (gi == 1) pool_emit<4>(c, pv, t0, s0, ch);
            else if (gi == 2) pool_emit<8>(c, pv, t0, s0, ch);
            else pool_emit<16>(c, pv, t0, s0, ch);
        }
    }
}

DI void rwkv_finalize_item(const Ctx& c, int item) {
    const int tid = TID(), ch = tid, t0 = item * 8;
    const float* mu = c.in(I_MU) + (size_t)c.l * RWC;
    const float kkw_ = c.in(I_KK)[c.l * 512 + ch], kaw_ = c.in(I_KA)[c.l * 512 + ch], rkw_ = c.in(I_RK)[c.l * 512 + ch];
    const float mur = mu[ch], muk = mu[512 + ch], muv = mu[1024 + ch];
    bf16_t ur[9], uk[9], uv[9], ua[8];
    const bool has_prev = (t0 & (SEQ - 1)) != 0;
#pragma unroll
    for (int k = 0; k < 9; ++k) {
        ur[k] = 0; uk[k] = 0; uv[k] = 0;
        if (k > 0 || has_prev) { const bf16_t* q = c.PROJ + (size_t)(t0 - 1 + k) * IN_COLS; ur[k] = q[C_R + ch]; uk[k] = q[C_K + ch]; uv[k] = q[C_V + ch]; }
    }
#pragma unroll
    for (int k = 0; k < 8; ++k) ua[k] = c.F[(size_t)4 * NT * 512 + (size_t)(t0 + k) * 512 + ch];
#pragma unroll
    for (int k = 0; k < 8; ++k) {
        const int t = t0 + k;
        const float cr = bf2f(ur[k + 1]), ck = bf2f(uk[k + 1]), cv = bf2f(uv[k + 1]);
        const float r = cr + (bf2f(ur[k]) - cr) * mur, kx = ck + (bf2f(uk[k]) - ck) * muk, vx = cv + (bf2f(uv[k]) - cv) * muv;
        const float a = bf2f(ua[k]);
        const float kxn = kx * kkw_, kp = kx * (1.0f + (a - 1.0f) * kaw_);
        const float ss = wave_sum_dpp(kxn * kxn);
        const float inv = __builtin_amdgcn_rsqf(fmaxf(ss, 1e-24f));
        const float br = wave_sum_dpp(kxn * inv * a * r), kr = wave_sum_dpp(kp * r), bon = wave_sum_dpp(r * kp * rkw_);
        if ((tid & 63) == 0) *(f32x4*)(c.BON + ((size_t)t * 8 + (tid >> 6)) * 4) = (f32x4){inv, br, kr, bon};
        const size_t o = (size_t)t * 512 + ch;
        c.F[o] = f2bf(r); c.F[o + (size_t)NT * 512] = f2bf(kx); c.F[o + (size_t)2 * NT * 512] = f2bf(vx);
    }
}

DI void phase_poolgemm(const Ctx& c, unsigned char* lds) {
    for (int item = blockIdx.x; item < NT / 8; item += gridDim.x) rwkv_finalize_item(c, item);
    const int n_pool = (NT / 256) * 4, n_items = n_pool + 32;
    for (int item = blockIdx.x; item < n_items; item += gridDim.x) {
        f32x4 acc[4][4]; acc_zero(acc);
        if (item < n_pool) {
            const int tm = item >> 2, gi = item & 3, m0 = tm * 256;
            const ARows ar = plain_rows(c.POOLED + gi * 128, 512, m0, TID());
            gemm_core<0>(acc, ar, (const bf16_t*)(c.ws + WS_WT_POOL) + (size_t)gi * 128 * 128, 128, 128, lds);
            const float* sc = c.in(I_POOLS) + c.l * 512 + gi * 128;
            ACC_FOREACH(acc, { const f32x4 s = *(const f32x4*)(sc + c_);
                store_bf4(c.POOLED + (size_t)(m0 + r_) * 512 + gi * 128 + c_, (f32x4){v_[0] * s[0], v_[1] * s[1], v_[2] * s[2], v_[3] * s[3]}); });
        } else {
            const int it = item - n_pool, kv = it >> 4, tm = it & 15, m0 = tm * 256;
            const ARows ar = plain_rows(c.CMPH + (size_t)kv * 4096 * 256, 256, m0, TID());
            gemm_core<0>(acc, ar, (const bf16_t*)(c.ws + WS_WT_C2) + (size_t)kv * 128 * 256, 256, 256, lds);
            ACC_FOREACH(acc, { if (c_ < 64) { const int R = m0 + r_;
                if (kv == 0) store_bf4(c.KC + (size_t)R * 64 + c_, v_);
                else { bf16_t* q = c.VCT + ((size_t)(R >> 8) * 64 + c_) * 256 + (R & 255); q[0] = f2bf(v_[0]); q[256] = f2bf(v_[1]); q[512] = f2bf(v_[2]); q[768] = f2bf(v_[3]); } } });
        }
    }
}

constexpr int SCH = 32;
constexpr int SB_AN = 0, SB_WR = SCH * 64 * 4, SB_W = 2 * SCH * 64 * 4, SB_BB = 3 * SCH * 64 * 4, SB_KP = 4 * SCH * 64 * 4;
constexpr int SB_V = 5 * SCH * 64 * 4;
constexpr int SB_SC = SB_V + SCH * 16 * 4;
constexpr int SB_Y = SB_SC + SCH * 2 * 4;
constexpr int SB_BYTES = SB_Y + SCH * 16 * 4;
static_assert(2 * SB_BYTES <= LDS_BYTES - 64, "scan lds");
typedef float f32x2 __attribute__((ext_vector_type(2)));
DI float row8_sum(float v) { v += DPP_MOV(v, 0xB1); v += DPP_MOV(v, 0x4E); v += DPP_MOV(v, 0x141); return v; }

constexpr int NPW = 6, NJ = (SCH + NPW - 1) / NPW;
struct PrepRegs { bf16_t r[NJ], k[NJ], v[NJ], e[NJ], a[NJ]; float s0[NJ], s1[NJ], s2[NJ]; };
DI void prep_load(PrepRegs& R, const Ctx& c, int b, int h, int ck, int pw, int lane) {
    const size_t PL = (size_t)NT * 512;
    const size_t tb = (size_t)b * SEQ + ck * SCH;
    const size_t o0 = tb * 512 + h * 64 + lane;
#pragma unroll
    for (int j = 0; j < NJ; ++j) {
        const int st = pw + NPW * j;
        if (st < SCH) { const size_t o = o0 + (size_t)st * 512; R.r[j] = c.F[o]; R.k[j] = c.F[o + PL]; R.v[j] = c.F[o + 2 * PL]; R.e[j] = c.F[o + 3 * PL]; R.a[j] = c.F[o + 4 * PL];
            const float* sp = c.BON + ((tb + st) * 8 + h) * 4; R.s0[j] = sp[0]; R.s1[j] = sp[1]; R.s2[j] = sp[2]; }
    }
}
DI void prep_store(const PrepRegs& R, unsigned char* sb, int rq, int pw, int lane, float kkw, float kaw) {
    float* an = (float*)(sb + SB_AN); float* wr = (float*)(sb + SB_WR); float* w_ = (float*)(sb + SB_W); float* bb_ = (float*)(sb + SB_BB); float* kp_ = (float*)(sb + SB_KP);
    float* vv = (float*)(sb + SB_V); float* sc = (float*)(sb + SB_SC);
#pragma unroll
    for (int j = 0; j < NJ; ++j) {
        const int st = pw + NPW * j;
        if (st < SCH) {
            const float r = bf2f(R.r[j]), k = bf2f(R.k[j]), v = bf2f(R.v[j]), e = bf2f(R.e[j]), a = bf2f(R.a[j]);
            const float w = __expf(-e);
            const float kk = k * kkw * R.s0[j];
            const float kp = k * (1.0f + (a - 1.0f) * kaw);
            an[st * 64 + lane] = -kk; wr[st * 64 + lane] = w * r; w_[st * 64 + lane] = w; bb_[st * 64 + lane] = kk * a; kp_[st * 64 + lane] = kp;
            if ((lane >> 4) == rq) vv[st * 16 + (lane & 15)] = v;
            if (lane == 0) { sc[st * 2] = R.s1[j]; sc[st * 2 + 1] = R.s2[j]; }
        }
    }
}
DI void scan_item(const Ctx& c, int item, unsigned char* lds) {
    const int tid = TID(), lane = tid & 63, wave = tid >> 6;
    const int b = item >> 5, h = (item >> 2) & 7, rq = item & 3;
    const int chn = h * 64 + lane;
    const float kkw = c.in(I_KK)[c.l * 512 + chn], kaw = c.in(I_KA)[c.l * 512 + chn];
    const int rowl = (tid & 127) >> 3, cg = tid & 7;
    f32x2 st[4];
#pragma unroll
    for (int i = 0; i < 4; ++i) st[i] = (f32x2){0.f, 0.f};
    constexpr int NCK = SEQ / SCH;
    PrepRegs R;
    __syncthreads();
    if (wave >= 2) { prep_load(R, c, b, h, 0, wave - 2, lane); prep_store(R, lds, rq, wave - 2, lane, kkw, kaw); prep_load(R, c, b, h, 1, wave - 2, lane); }
    __syncthreads();
    for (int ck = 0; ck < NCK; ++ck) {
        unsigned char* sb = lds + (ck & 1) * SB_BYTES;
        if (wave < 2) {
            const float* an = (const float*)(sb + SB_AN) + cg * 8; const float* wr = (const float*)(sb + SB_WR) + cg * 8; const float* w_ = (const float*)(sb + SB_W) + cg * 8;
            const float* bb_ = (const float*)(sb + SB_BB) + cg * 8; const float* kp_ = (const float*)(sb + SB_KP) + cg * 8;
            const float* vv = (const float*)(sb + SB_V) + rowl; const float* sc = (const float*)(sb + SB_SC); float* yb = (float*)(sb + SB_Y) + rowl;
            f32x4 a0 = *(const f32x4*)(an), a1 = *(const f32x4*)(an + 4), r0 = *(const f32x4*)(wr), r1 = *(const f32x4*)(wr + 4);
            f32x4 w0 = *(const f32x4*)(w_), w1 = *(const f32x4*)(w_ + 4), b0 = *(const f32x4*)(bb_), b1 = *(const f32x4*)(bb_ + 4);
            f32x4 k0 = *(const f32x4*)(kp_), k1 = *(const f32x4*)(kp_ + 4);
            float v = vv[0]; f32x2 bk = *(const f32x2*)(sc);
#pragma unroll 2
            for (int s = 0; s < SCH; ++s) {
                const int sn = (s + 1 < SCH) ? s + 1 : s;
                const f32x4 na0 = *(const f32x4*)(an + sn * 64), na1 = *(const f32x4*)(an + sn * 64 + 4), nr0 = *(const f32x4*)(wr + sn * 64), nr1 = *(const f32x4*)(wr + sn * 64 + 4);
                const f32x4 nw0 = *(const f32x4*)(w_ + sn * 64), nw1 = *(const f32x4*)(w_ + sn * 64 + 4), nb0 = *(const f32x4*)(bb_ + sn * 64), nb1 = *(const f32x4*)(bb_ + sn * 64 + 4);
                const f32x4 nk0 = *(const f32x4*)(kp_ + sn * 64), nk1 = *(const f32x4*)(kp_ + sn * 64 + 4);
                const float nv = vv[sn * 16]; const f32x2 nbk = *(const f32x2*)(sc + sn * 2);
                f32x2 da = st[0] * (f32x2){a0[0], a0[1]}; f32x2 dr = st[0] * (f32x2){r0[0], r0[1]};
                da += st[1] * (f32x2){a0[2], a0[3]}; dr += st[1] * (f32x2){r0[2], r0[3]};
                da += st[2] * (f32x2){a1[0], a1[1]}; dr += st[2] * (f32x2){r1[0], r1[1]};
                da += st[3] * (f32x2){a1[2], a1[3]}; dr += st[3] * (f32x2){r1[2], r1[3]};
                float sa = da[0] + da[1], sr = dr[0] + dr[1];
                sa += DPP_MOV(sa, 0xB1); sr += DPP_MOV(sr, 0xB1);
                sa += DPP_MOV(sa, 0x4E); sr += DPP_MOV(sr, 0x4E);
                sa += DPP_MOV(sa, 0x141); sr += DPP_MOV(sr, 0x141);
                const f32x2 sa2 = (f32x2){sa, sa}, v2 = (f32x2){v, v};
                st[0] = st[0] * (f32x2){w0[0], w0[1]} + sa2 * (f32x2){b0[0], b0[1]} + v2 * (f32x2){k0[0], k0[1]};
                st[1] = st[1] * (f32x2){w0[2], w0[3]} + sa2 * (f32x2){b0[2], b0[3]} + v2 * (f32x2){k0[2], k0[3]};
                st[2] = st[2] * (f32x2){w1[0], w1[1]} + sa2 * (f32x2){b1[0], b1[1]} + v2 * (f32x2){k1[0], k1[1]};
                st[3] = st[3] * (f32x2){w1[2], w1[3]} + sa2 * (f32x2){b1[2], b1[3]} + v2 * (f32x2){k1[2], k1[3]};
                yb[s * 16] = sr + sa * bk[0] + v * bk[1];
                a0 = na0; a1 = na1; r0 = nr0; r1 = nr1; w0 = nw0; w1 = nw1; b0 = nb0; b1 = nb1; k0 = nk0; k1 = nk1; v = nv; bk = nbk;
            }
        } else {
            const int pt = tid - 128;
            if (ck + 1 < NCK) prep_store(R, lds + ((ck + 1) & 1) * SB_BYTES, rq, wave - 2, lane, kkw, kaw);
            if (ck + 2 < NCK) prep_load(R, c, b, h, ck + 2, wave - 2, lane);
            if (ck > 0) {
                const float* yb = (const float*)(lds + ((ck - 1) & 1) * SB_BYTES + SB_Y);
                for (int idx = pt; idx < SCH * 16; idx += 384) {
                    const int s = idx >> 4, j = idx & 15;
                    c.YRAW[((size_t)b * SEQ + (ck - 1) * SCH + s) * 512 + h * 64 + rq * 16 + j] = f2bf(yb[idx]);
                }
            }
        }
        asm volatile("s_waitcnt lgkmcnt(0)" ::: "memory"); __builtin_amdgcn_s_barrier(); asm volatile("" ::: "memory");
    }
    {
        const float* yb = (const float*)(lds + ((NCK - 1) & 1) * SB_BYTES + SB_Y);
        for (int idx = tid; idx < SCH * 16; idx += NTHREADS) {
            const int s = idx >> 4, j = idx & 15;
            c.YRAW[((size_t)b * SEQ + (NCK - 1) * SCH + s) * 512 + h * 64 + rq * 16 + j] = f2bf(yb[idx]);
        }
    }
    __syncthreads();
}
DI void phase_rwkv_post(const Ctx& c, unsigned char* lds) {
    const int tid = TID(), lane = tid & 63, wave = tid >> 6;
    const size_t PL = (size_t)NT * 512;
    for (int t = blockIdx.x * 8 + wave; t < NT; t += gridDim.x * 8) {
        bf16_t ry[8], rv[8], rg[8]; float bon[8], gw[8], gb[8];
#pragma unroll
        for (int h = 0; h < 8; ++h) { const size_t o = (size_t)t * 512 + h * 64 + lane; ry[h] = c.YRAW[o]; rv[h] = c.F[o + 2 * PL]; rg[h] = c.F[o + 5 * PL]; bon[h] = c.BON[((size_t)t * 8 + h) * 4 + 3];
            gw[h] = c.in(I_GNW)[c.l * 512 + h * 64 + lane]; gb[h] = c.in(I_GNB)[c.l * 512 + h * 64 + lane]; }
#pragma unroll
        for (int h = 0; h < 8; ++h) {
            const float y = bf2f(ry[h]);
            const float mean = wave_sum_dpp(y) * (1.0f / 64.0f);
            const float d = y - mean;
            const float var = wave_sum_dpp(d * d) * (1.0f / 64.0f);
            const float yn = d * rsqrtf(var + 64e-5f) * gw[h] + gb[h];
            c.F[(size_t)t * 512 + h * 64 + lane + 5 * PL] = f2bf((yn + bon[h] * bf2f(rv[h])) * bf2f(rg[h]));
        }
    }
    for (int it = blockIdx.x * 4; it < 768 + 128 + 128 + 256 + 256; it += gridDim.x * 4) {
        const float* WB = c.in(I_WBR) + (size_t)c.l * 2048 * DM; bf16_t* BR = (bf16_t*)(c.ws + WS_WT_BR);
        if (it < 768) convert_tile4(c.in(I_WMG) + (size_t)c.l * DM * 3 * DM, 3 * DM, 3 * DM, DM, (bf16_t*)(c.ws + WS_WT_MG), it, lds);
        else if (it < 896) convert_tile4(WB, DM, DM, 512, BR, it - 768, lds);
        else if (it < 1024) convert_tile4(WB + (size_t)512 * DM, DM, DM, 512, BR + (size_t)1024 * 512, it - 896, lds);
        else if (it < 1280) convert_tile4(WB + (size_t)1024 * DM, DM, DM, 1024, BR + (size_t)2048 * 512, it - 1024, lds);
        else convert_tile4(c.in(I_WOUT) + (size_t)c.l * DM * DM, DM, DM, DM, (bf16_t*)(c.ws + WS_WT_OUT), it - 1280, lds);
    }
}
constexpr int TS = 72;
constexpr int NSA_BIAS = 0;
constexpr int NSA_SELM = 2112;
constexpr int NSA_SCR = 2624;
constexpr int NSA_K0 = 4672;
constexpr int NSA_V0 = NSA_K0 + 2 * 64 * TS * 2;
constexpr int NSA_A = NSA_V0 + 2 * 64 * TS * 2;
constexpr int NSA_B = NSA_A + 16384;
constexpr int NSA_END = NSA_B + 16384;
static_assert(NSA_END <= LDS_BYTES - 16, "nsa lds");
static_assert(NSA_K0 % 16 == 0, "align");

struct NsaLane { int tq[2]; int h; float cbias; float m[2], l[2]; };

DI void nsa_prefetch(u32x4& rk, u32x4& rv, const bf16_t* kbase, int kstride, const bf16_t* vtbase, int vstride, int pos0, int tid) {
    const int r = tid >> 3, seg = (tid & 7) * 8;
    rk = *(const u32x4*)(kbase + (size_t)(pos0 + r) * kstride + seg);
    rv = *(const u32x4*)(vtbase + (size_t)r * vstride + pos0 + seg);
}
DI void nsa_store(unsigned char* lds, int buf, const u32x4& rk, const u32x4& rv, int tid) {
    const int r = tid >> 3, seg = (tid & 7) * 8;
    *(u32x4*)((bf16_t*)(lds + NSA_K0) + buf * 64 * TS + r * TS + seg) = rk;
    *(u32x4*)((bf16_t*)(lds + NSA_V0) + buf * 64 * TS + r * TS + seg) = rv;
}
template <int QM = 3>
DI void nsa_qk(f32x4 (&s)[2][4], const bf16_t* sK, const bf16x8 (&qf)[2][2], int lane) {
#pragma unroll
    for (int kt = 0; kt < 4; ++kt) {
#pragma unroll
        for (int ks = 0; ks < 2; ++ks) {
            const bf16x8 kf = *(const bf16x8*)(sK + (16 * kt + (lane & 15)) * TS + 32 * ks + (lane >> 4) * 8);
#pragma unroll
            for (int qi = 0; qi < 2; ++qi) if ((QM >> qi) & 1) s[qi][kt] = __builtin_amdgcn_mfma_f32_16x16x32_bf16(kf, qf[qi][ks], (ks == 0) ? (f32x4){0.f, 0.f, 0.f, 0.f} : s[qi][kt], 0, 0, 0);
        }
    }
}
template <int MODE>
DI void nsa_logits(float (&x)[4][4], const f32x4 (&s)[4], int tq, int h, float cbias, bool rowsel, int pos0, int qd, const float* biasT) {
#pragma unroll
    for (int kt = 0; kt < 4; ++kt)
#pragma unroll
        for (int i = 0; i < 4; ++i) {
            const int kk = pos0 + 16 * kt + 4 * qd + i;
            if (MODE == 1) { x[kt][i] = rowsel ? s[kt][i] + cbias : -INFINITY; }
            else {
                const int dist = (MODE == 0) ? (tq - 16 * kk - 31) : (tq - kk);
                bool ok = dist >= 0;
                if (MODE == 2) ok = ok && rowsel;
                if (MODE == 3) ok = ok && (dist < 512);
                const int di = dist < 0 ? 0 : (dist > 128 ? 128 : dist);
                float bias = biasT[di * 4 + h];
                asm volatile("" : "+v"(bias));
                x[kt][i] = ok ? s[kt][i] + bias : -INFINITY;
            }
        }
}
DI float quad16_max(float v) { v = fmaxf(v, __shfl_xor(v, 16)); v = fmaxf(v, __shfl_xor(v, 32)); return v; }
DI float quad16_sum(float v) { v += __shfl_xor(v, 16); v += __shfl_xor(v, 32); return v; }
DI void nsa_softmax(const float (&x)[4][4], float& m, float& l, f32x4 (&O)[4], bf16x8 (&pf)[2]) {
    float mx = -INFINITY;
#pragma unroll
    for (int kt = 0; kt < 4; ++kt)
#pragma unroll
        for (int i = 0; i < 4; ++i) mx = fmaxf(mx, x[kt][i]);
    mx = quad16_max(mx);
    const float mn = fmaxf(m, mx);
    const float mu = (mn == -INFINITY) ? 0.f : mn;
    const float mu2 = mu * 1.4426950408889634f;
    const float sc = __builtin_amdgcn_exp2f(__builtin_fmaf(m, 1.4426950408889634f, -mu2));
    float p[4][4]; float ps = 0.f;
#pragma unroll
    for (int kt = 0; kt < 4; ++kt)
#pragma unroll
        for (int i = 0; i < 4; ++i) { p[kt][i] = __builtin_amdgcn_exp2f(__builtin_fmaf(x[kt][i], 1.4426950408889634f, -mu2)); ps += p[kt][i]; }
    l = l * sc + ps; m = mn;
#pragma unroll
    for (int dt = 0; dt < 4; ++dt) O[dt] = O[dt] * sc;
#pragma unroll
    for (int ks = 0; ks < 2; ++ks) {
        u32x4 w; w.x = pack2(p[2 * ks][0], p[2 * ks][1]); w.y = pack2(p[2 * ks][2], p[2 * ks][3]); w.z = pack2(p[2 * ks + 1][0], p[2 * ks + 1][1]); w.w = pack2(p[2 * ks + 1][2], p[2 * ks + 1][3]);
        pf[ks] = __builtin_bit_cast(bf16x8, w);
    }
}
template <int QM = 3>
DI void nsa_pv(f32x4 (&O)[2][4], const bf16_t* sV, const bf16x8 (&pf)[2][2], int lane) {
    const int qd = lane >> 4;
#pragma unroll
    for (int dt = 0; dt < 4; ++dt)
#pragma unroll
        for (int ks = 0; ks < 2; ++ks) {
            const bf16_t* vp = sV + (16 * dt + (lane & 15)) * TS + 32 * ks + 4 * qd;
            const u32x2 a = *(const u32x2*)vp, b = *(const u32x2*)(vp + 16);
            u32x4 w; w.x = a.x; w.y = a.y; w.z = b.x; w.w = b.y;
            const bf16x8 vf = __builtin_bit_cast(bf16x8, w);
#pragma unroll
            for (int qi = 0; qi < 2; ++qi) if ((QM >> qi) & 1) O[qi][dt] = __builtin_amdgcn_mfma_f32_16x16x32_bf16(vf, pf[qi][ks], O[qi][dt], 0, 0, 0);
        }
}
template <int MODE, int QM = 3>
DI void nsa_tile(f32x4 (&O)[2][4], NsaLane& L, const bf16x8 (&qf)[2][2], const unsigned char* lds, int buf, int pos0, bool sel0, bool sel1, int lane) {
    const bf16_t* sK = (const bf16_t*)(lds + NSA_K0) + buf * 64 * TS;
    const bf16_t* sV = (const bf16_t*)(lds + NSA_V0) + buf * 64 * TS;
    const float* biasT = (const float*)(lds + NSA_BIAS);
    f32x4 s[2][4];
    nsa_qk<QM>(s, sK, qf, lane);
    bf16x8 pf[2][2];
#pragma unroll
    for (int qi = 0; qi < 2; ++qi) if ((QM >> qi) & 1) {
        float x[4][4];
        nsa_logits<MODE>(x, s[qi], L.tq[qi], L.h, L.cbias, qi ? sel1 : sel0, pos0, lane >> 4, biasT);
        nsa_softmax(x, L.m[qi], L.l[qi], O[qi], pf[qi]);
    }
    nsa_pv<QM>(O, sV, pf, lane);
}
template <int MODE>
DI void nsa_tile_sel(f32x4 (&O)[2][4], NsaLane& L, const bf16x8 (&qf)[2][2], const unsigned char* lds, int buf, int pos0, bool sel0, bool sel1, int lane) {
    const bool a0 = __ballot(sel0) != 0ull, a1 = __ballot(sel1) != 0ull;
    if (a0 && a1) nsa_tile<MODE, 3>(O, L, qf, lds, buf, pos0, sel0, sel1, lane);
    else if (a0) nsa_tile<MODE, 1>(O, L, qf, lds, buf, pos0, sel0, sel1, lane);
    else if (a1) nsa_tile<MODE, 2>(O, L, qf, lds, buf, pos0, sel0, sel1, lane);
}
DI void nsa_flush(f32x4 (&Y)[2][4], f32x4 (&O)[2][4], NsaLane& L, const float (&gate)[2]) {
#pragma unroll
    for (int qi = 0; qi < 2; ++qi) {
        const float lt = quad16_sum(L.l[qi]);
        const float f = (lt > 0.f) ? gate[qi] * __builtin_amdgcn_rcpf(lt) : 0.f;
#pragma unroll
        for (int dt = 0; dt < 4; ++dt) { Y[qi][dt] += O[qi][dt] * f; O[qi][dt] = (f32x4){0.f, 0.f, 0.f, 0.f}; }
    }
}
DI void nsa_item(const Ctx& c, int item, unsigned char* lds) {
    const int tid = TID(), lane = tid & 63, wave = tid >> 6, qd = lane >> 4;
    const int b = item >> 8, g = (item >> 6) & 3, qt = item & 63, t0 = qt * 64, cur = qt, bg = b * 4 + g;
    float* biasT = (float*)(lds + NSA_BIAS);
    unsigned long long* selm = (unsigned long long*)(lds + NSA_SELM);
    float* scr = (float*)(lds + NSA_SCR) + wave * 64;
    float* impA = (float*)(lds + NSA_A); float* impB = (float*)(lds + NSA_B);
    __syncthreads();
    for (int i = tid; i < 129 * 4; i += NTHREADS) { const int d = i >> 2, h = i & 3; biasT[i] = c.in(I_RELB)[t5_bucket(d) * 16 + g * 4 + h]; }
    for (int i = tid; i < 2 * 4096; i += NTHREADS) impA[i] = 0.f;
    NsaLane L; L.h = lane & 3;
    bf16x8 qf[2][2]; float gates[2][3];
    const bf16_t* pbat = c.PROJ + (size_t)b * SEQ * IN_COLS;
#pragma unroll
    for (int qi = 0; qi < 2; ++qi) {
        const int tl = 8 * wave + 4 * qi + ((lane & 15) >> 2);
        L.tq[qi] = t0 + tl;
        const bf16_t* prow = pbat + (size_t)L.tq[qi] * IN_COLS;
#pragma unroll
        for (int ks = 0; ks < 2; ++ks) {
            u32x4 w = *(const u32x4*)(prow + C_Q + (g * 4 + L.h) * 64 + 32 * ks + qd * 8);
            w.x = pack2(bflo(w.x) * 0.125f, bfhi(w.x) * 0.125f); w.y = pack2(bflo(w.y) * 0.125f, bfhi(w.y) * 0.125f);
            w.z = pack2(bflo(w.z) * 0.125f, bfhi(w.z) * 0.125f); w.w = pack2(bflo(w.w) * 0.125f, bfhi(w.w) * 0.125f);
            qf[qi][ks] = __builtin_bit_cast(bf16x8, w);
        }
#pragma unroll
        for (int br = 0; br < 3; ++br) gates[qi][br] = sigmoidf_(bf2f(prow[C_GATE + g * 12 + L.h * 3 + br]));
    }
    __syncthreads();
    L.cbias = biasT[128 * 4 + L.h];
    f32x4 O[2][4], Y[2][4];
#pragma unroll
    for (int qi = 0; qi < 2; ++qi)
#pragma unroll
        for (int dt = 0; dt < 4; ++dt) { O[qi][dt] = (f32x4){0.f, 0.f, 0.f, 0.f}; Y[qi][dt] = (f32x4){0.f, 0.f, 0.f, 0.f}; }
    u32x4 rk, rv;
    const int nvis_max = (t0 + 63 >= 31) ? ((t0 + 63 - 31) >> 4) + 1 : 0;
    const int ncb = (nvis_max + 63) >> 6;
    const bf16_t* kcb = c.KC + (size_t)bg * 256 * 64; const bf16_t* vcb = c.VCT + (size_t)bg * 64 * 256;
    L.m[0] = L.m[1] = -INFINITY; L.l[0] = L.l[1] = 0.f;
    if (ncb > 0) nsa_prefetch(rk, rv, kcb, 64, vcb, 256, 0, tid);
    for (int cb = 0; cb < ncb; ++cb) {
        nsa_store(lds, cb & 1, rk, rv, tid);
        __syncthreads();
        if (cb + 1 < ncb) nsa_prefetch(rk, rv, kcb, 64, vcb, 256, (cb + 1) * 64, tid);
        if (16 * (cb * 64 + 63) + 31 + 128 <= t0) nsa_tile<1>(O, L, qf, lds, cb & 1, cb * 64, true, true, lane);
        else nsa_tile<0>(O, L, qf, lds, cb & 1, cb * 64, true, true, lane);
    }
    if (ncb > 0) nsa_prefetch(rk, rv, kcb, 64, vcb, 256, 0, tid);
    float mfin[2], linv[2];
#pragma unroll
    for (int qi = 0; qi < 2; ++qi) { mfin[qi] = L.m[qi]; const float lt = quad16_sum(L.l[qi]); linv[qi] = (lt > 0.f) ? __builtin_amdgcn_rcpf(lt) : 0.f; }
    { const float gg[2] = {gates[0][0], gates[1][0]}; nsa_flush(Y, O, L, gg); }
    __syncthreads();
    for (int cb = 0; cb < ncb; ++cb) {
        nsa_store(lds, cb & 1, rk, rv, tid);
        __syncthreads();
        if (cb + 1 < ncb) nsa_prefetch(rk, rv, kcb, 64, vcb, 256, (cb + 1) * 64, tid);
        const bf16_t* sK = (const bf16_t*)(lds + NSA_K0) + (cb & 1) * 64 * TS;
        f32x4 s[2][4];
        nsa_qk(s, sK, qf, lane);
#pragma unroll
        for (int qi = 0; qi < 2; ++qi) {
            float x[4][4];
            nsa_logits<0>(x, s[qi], L.tq[qi], L.h, L.cbias, true, cb * 64, qd, biasT);
            const float mu = (mfin[qi] == -INFINITY) ? 0.f : mfin[qi];
#pragma unroll
            for (int kt = 0; kt < 4; ++kt) {
                float p3 = __expf(x[kt][3] - mu) * linv[qi];
                float pa = (__expf(x[kt][0] - mu) + __expf(x[kt][1] - mu) + __expf(x[kt][2] - mu)) * linv[qi] + p3;
                pa += __shfl_xor(pa, 1); p3 += __shfl_xor(p3, 1);
                pa += __shfl_xor(pa, 2); p3 += __shfl_xor(p3, 2);
                if (L.h == 0) { const int tl = 8 * wave + 4 * qi + ((lane & 15) >> 2), mi = 16 * cb + 4 * kt + qd; impA[tl * 64 + mi] = pa; impB[tl * 64 + mi] = p3; }
            }
        }
    }
    const bf16_t* ksb = pbat + C_KS + g * 64; const bf16_t* vsb = c.VT + ((size_t)0 * 16 + bg) * 64 * SEQ;
    nsa_prefetch(rk, rv, ksb, IN_COLS, vsb, SEQ, 0, tid);
    __syncthreads();
    for (int tl8 = 0; tl8 < 8; ++tl8) {
        const int tl = 8 * wave + tl8, n = lane;
        const bool cand = (n >= 1) && (n <= cur - 2);
        const float imp = cand ? impA[tl * 64 + n] + impB[tl * 64 + n - 1] : -1.0f;
        LDS_WAVE_SYNC();
        scr[n] = imp;
        LDS_WAVE_SYNC();
        int rank = 0;
#pragma unroll 4
        for (int q4 = 0; q4 < 16; ++q4) {
            const f32x4 o = *(const f32x4*)(scr + q4 * 4);
#pragma unroll
            for (int j = 0; j < 4; ++j) { const int n2 = q4 * 4 + j; rank += (o[j] > imp || (o[j] == imp && n2 < n)) ? 1 : 0; }
        }
        const bool forced = (n <= cur) && (n == 0 || n == cur || n == cur - 1);
        const unsigned long long msk = __ballot((cand && rank < 5) || forced);
        if (lane == 0) selm[tl] = msk;
    }
    __syncthreads();
    unsigned long long uni = selm[lane];
#pragma unroll
    for (int o = 32; o >= 1; o >>= 1) { const unsigned lo_ = __shfl_xor((unsigned)uni, o), hi_ = __shfl_xor((unsigned)(uni >> 32), o); uni |= ((unsigned long long)hi_ << 32) | lo_; }
    uni = ((unsigned long long)__builtin_amdgcn_readfirstlane((unsigned)(uni >> 32)) << 32) | (unsigned)__builtin_amdgcn_readfirstlane((unsigned)uni);
    unsigned long long sm[2];
#pragma unroll
    for (int qi = 0; qi < 2; ++qi) sm[qi] = selm[8 * wave + 4 * qi + ((lane & 15) >> 2)];
    L.m[0] = L.m[1] = -INFINITY; L.l[0] = L.l[1] = 0.f;
    {
        unsigned long long rem = uni; int it = 0;
        int j = (int)__builtin_ctzll(rem); rem &= rem - 1;
        for (;;) {
            nsa_store(lds, it & 1, rk, rv, tid);
            __syncthreads();
            const int jn = rem ? (int)__builtin_ctzll(rem) : -1;
            if (jn >= 0) { rem &= rem - 1; nsa_prefetch(rk, rv, ksb, IN_COLS, vsb, SEQ, jn * 64, tid); }
            const bool s0 = (sm[0] >> j) & 1ull, s1 = (sm[1] >> j) & 1ull;
            if (j <= cur - 3) nsa_tile_sel<1>(O, L, qf, lds, it & 1, j * 64, s0, s1, lane);
            else nsa_tile_sel<2>(O, L, qf, lds, it & 1, j * 64, s0, s1, lane);
            if (jn < 0) break;
            j = jn; ++it;
        }
    }
    const bf16_t* kwb = pbat + C_KW + g * 64; const bf16_t* vwb = c.VT + ((size_t)1 * 16 + bg) * 64 * SEQ;
    const int j0 = (cur - 8 > 0) ? cur - 8 : 0;
    nsa_prefetch(rk, rv, kwb, IN_COLS, vwb, SEQ, j0 * 64, tid);
    { const float gg[2] = {gates[0][1], gates[1][1]}; nsa_flush(Y, O, L, gg); }
    L.m[0] = L.m[1] = -INFINITY; L.l[0] = L.l[1] = 0.f;
    {
        __syncthreads();
        for (int j = j0; j <= cur; ++j) {
            nsa_store(lds, (j - j0) & 1, rk, rv, tid);
            __syncthreads();
            if (j + 1 <= cur) nsa_prefetch(rk, rv, kwb, IN_COLS, vwb, SEQ, (j + 1) * 64, tid);
            if (cur - j >= 3 && cur - j <= 7) nsa_tile<1>(O, L, qf, lds, (j - j0) & 1, j * 64, true, true, lane);
            else nsa_tile<3>(O, L, qf, lds, (j - j0) & 1, j * 64, true, true, lane);
        }
    }
    { const float gg[2] = {gates[0][2], gates[1][2]}; nsa_flush(Y, O, L, gg); }
#pragma unroll
    for (int qi = 0; qi < 2; ++qi) {
        bf16_t* yrow = c.PROJ + ((size_t)b * SEQ + L.tq[qi]) * IN_COLS + C_Q + (g * 4 + L.h) * 64;
#pragma unroll
        for (int dt = 0; dt < 4; ++dt) store_bf4(yrow + 16 * dt + 4 * qd, Y[qi][dt]);
    }
}
DI void phase_mix(const Ctx& c, unsigned char* lds) {
    const int G = gridDim.x, bid = blockIdx.x;
    const int n_nsa = NB * 4 * (SEQ / 64), n_scan = NB * 8 * 4;
    const bool split = G >= 2 * n_scan;
    if (split) { if (bid < n_scan) scan_item(c, bid, lds); }
    else for (int item = bid; item < n_scan; item += G) scan_item(c, item, lds);
    unsigned* ctr = c.ctl + CW_Q + c.l;
    volatile int* sitem = (volatile int*)(lds + LDS_BYTES - 32);
    for (;;) {
        __syncthreads();
        if (TID() == 0) *sitem = (int)atomicAdd(ctr, 1u);
        __syncthreads();
        const int k = *sitem;
        if (k >= n_nsa) break;
        const int qt = 63 - (k >> 4), bgi = k & 15;
        nsa_item(c, (bgi << 6) | qt, lds);
    }
}

DI void phase_merge(const Ctx& c, unsigned char* lds) {
    const int nN = DM / 256;
    const bf16_t* WM = (const bf16_t*)(c.ws + WS_WT_MG);
    const bf16_t* BR = (const bf16_t*)(c.ws + WS_WT_BR);
    const float* BM_ = c.in(I_BMG) + (size_t)c.l * 3 * DM;
    bf16_t* TMP = c.F + (size_t)2 * NT * 512 + (size_t)blockIdx.x * 256 * 256;
    for (int it = 0;; ++it) {
        int tm, tn; if (!xcd_unit(it, nN, tm, tn)) break;
        const int m0 = tm * 256, n0 = tn * 256;
#pragma unroll 1
        for (int i = 0; i < 3; ++i) {
            f32x4 acc[8][4];
#pragma unroll
            for (int a_ = 0; a_ < 8; ++a_)
#pragma unroll
                for (int b_ = 0; b_ < 4; ++b_) acc[a_][b_] = (f32x4){0.f, 0.f, 0.f, 0.f};
            gemm256_dma(acc, c.H + (size_t)m0 * DM, DM, WM + (size_t)(i * DM + n0) * DM, DM, DM, lds);
            tile256_store_bf16(acc, TMP, 256, 256, lds);
#pragma unroll
            for (int a_ = 0; a_ < 8; ++a_)
#pragma unroll
                for (int b_ = 0; b_ < 4; ++b_) acc[a_][b_] = (f32x4){0.f, 0.f, 0.f, 0.f};
            {
                const bf16_t* Ab = (i == 0) ? c.POOLED + (size_t)m0 * 512 : ((i == 1) ? c.F + (size_t)5 * NT * 512 + (size_t)m0 * 512 : c.PROJ + C_Q + (size_t)m0 * IN_COLS);
                const size_t la = (i == 2) ? (size_t)IN_COLS : (size_t)512;
                const int Kb = (i == 2) ? 1024 : 512;
                gemm256_dma(acc, Ab, la, BR + (size_t)i * 1024 * 512 + (size_t)n0 * Kb, (size_t)Kb, Kb, lds);
            }
            const int lane = TID() & 63, wave = TID() >> 6, wm = wave >> 2, wn = wave & 3;
            const float* bias = BM_ + i * DM + n0 + wn * 64 + (lane >> 4) * 4;
#pragma unroll
            for (int mi = 0; mi < 8; ++mi) {
#pragma unroll
                for (int ni = 0; ni < 4; ++ni) {
                    const int r = wm * 128 + mi * 16 + (lane & 15), cc = wn * 64 + ni * 16 + (lane >> 4) * 4;
                    bf16_t* q = c.MERGED + (size_t)(m0 + r) * DM + n0 + cc;
                    const u32x2 gv = *(const u32x2*)(TMP + r * 256 + cc);
                    const f32x4 bb = *(const f32x4*)(bias + ni * 16);
                    f32x4 m4 = (f32x4){0.f, 0.f, 0.f, 0.f};
                    if (i > 0) { const u32x2 pv = *(const u32x2*)q; m4 = (f32x4){bflo(pv.x), bfhi(pv.x), bflo(pv.y), bfhi(pv.y)}; }
                    m4[0] += sigmoidf_(bflo(gv.x) + bb[0]) * acc[mi][ni][0]; m4[1] += sigmoidf_(bfhi(gv.x) + bb[1]) * acc[mi][ni][1];
                    m4[2] += sigmoidf_(bflo(gv.y) + bb[2]) * acc[mi][ni][2]; m4[3] += sigmoidf_(bfhi(gv.y) + bb[3]) * acc[mi][ni][3];
                    store_bf4(q, m4);
                }
                asm volatile("" ::: "memory"); __builtin_amdgcn_sched_barrier(0);
            }
        }
    }
}

DI void phase_outp(const Ctx& c, unsigned char* lds) {
    const int nN = DM / 256;
    const bf16_t* W = (const bf16_t*)(c.ws + WS_WT_OUT);
    const float* xin = (c.l == 0) ? c.in(I_X) : c.out;
    for (int it = 0;; ++it) {
        int tm, tn; if (!xcd_unit(it, nN, tm, tn)) break;
        const int m0 = tm * 256, n0 = tn * 256;
        f32x4 acc[8][4];
#pragma unroll
        for (int i = 0; i < 8; ++i)
#pragma unroll
            for (int j = 0; j < 4; ++j) acc[i][j] = (f32x4){0.f, 0.f, 0.f, 0.f};
        gemm256_dma(acc, c.MERGED + (size_t)m0 * DM, DM, W + (size_t)n0 * DM, DM, DM, lds);
        const int lane = TID() & 63, wave = TID() >> 6, wm = wave >> 2, wn = wave & 3;
#pragma unroll
        for (int mi = 0; mi < 8; ++mi)
#pragma unroll
            for (int ni = 0; ni < 4; ++ni) {
                const size_t o = (size_t)(m0 + wm * 128 + mi * 16 + (lane & 15)) * DM + n0 + wn * 64 + ni * 16 + (lane >> 4) * 4;
                const f32x4 x = *(const f32x4*)(xin + o); *(f32x4*)(c.out + o) = x + acc[mi][ni];
            }
    }
    for (int it = blockIdx.x * 4; it < 3 * 32 * 64; it += gridDim.x * 4) {
        const int mat = it / 2048, e = (it >> 6) & 31, tl = it & 63;
        if (mat == 0) convert_tile4(c.in(I_EG) + ((size_t)c.l * 32 + e) * DM * 256, 256, 256, DM, (bf16_t*)(c.ws + WS_EG) + (size_t)e * 256 * DM, tl, lds);
        else if (mat == 1) convert_tile4(c.in(I_EU) + ((size_t)c.l * 32 + e) * DM * 256, 256, 256, DM, (bf16_t*)(c.ws + WS_EU) + (size_t)e * 256 * DM, tl, lds);
        else convert_tile4(c.in(I_ED) + ((size_t)c.l * 32 + e) * 256 * DM, DM, DM, 256, (bf16_t*)(c.ws + WS_ED) + (size_t)e * DM * 256, tl, lds);
    }
}

DI void phase_norm2(const Ctx& c, unsigned char* lds) {
    const int tid = TID(), lane = tid & 63, wave = tid >> 6;
    const float* gain = c.in(I_NFFN) + c.l * DM;
    const float* wrg = c.in(I_WRG) + (size_t)c.l * DM * 4; const float* brg = c.in(I_BRG) + c.l * 4;
    const float* wre = c.in(I_WRE) + (size_t)c.l * DM * 32; const float* bre = c.in(I_BRE) + c.l * 32;
    unsigned* cnt = c.ctl + CW_CNT + c.l * 32;
    float* lg = (float*)lds + wave * 16 * 48;
    if (wave < 4)
    for (int rt = blockIdx.x * 4 + wave; rt < NT / 16; rt += gridDim.x * 4) {
        const int r0 = rt * 16;
        float my_rs = 0.f;
#pragma unroll 2
        for (int rr = 0; rr < 16; ++rr) {
            const size_t ro = (size_t)(r0 + rr) * DM;
            f32x4 v[4]; float ss = 0.f;
#pragma unroll
            for (int i = 0; i < 4; ++i) { v[i] = *(const f32x4*)(c.out + ro + i * 256 + lane * 4); ss += v[i][0] * v[i][0] + v[i][1] * v[i][1] + v[i][2] * v[i][2] + v[i][3] * v[i][3]; }
            ss = wave_sum_dpp(ss);
            const float rs = rsqrtf(ss * (1.0f / DM) + 1e-6f);
            if ((lane & 15) == rr) my_rs = rs;
#pragma unroll
            for (int i = 0; i < 4; ++i) {
                const f32x4 g = *(const f32x4*)(gain + i * 256 + lane * 4);
                store_bf4(c.H + ro + i * 256 + lane * 4, (f32x4){v[i][0] * rs * g[0], v[i][1] * rs * g[1], v[i][2] * rs * g[2], v[i][3] * rs * g[3]});
            }
        }
        f32x4 acc0 = (f32x4){0.f, 0.f, 0.f, 0.f}, acc1 = acc0, acc2 = acc0;
        const float* xr = c.out + (size_t)(r0 + (lane & 15)) * DM + 4 * (lane >> 4);
        const int cl = lane & 15;
#pragma unroll 2
        for (int kb = 0; kb < 64; ++kb) {
            const f32x4 xa = *(const f32x4*)(xr + kb * 16);
            const f32x4 ga = *(const f32x4*)(gain + kb * 16 + 4 * (lane >> 4));
            const int k0 = kb * 16 + 4 * (lane >> 4);
            float b0[4], b1[4], b2[4];
#pragma unroll
            for (int m = 0; m < 4; ++m) { b0[m] = wre[(size_t)(k0 + m) * 32 + cl]; b1[m] = wre[(size_t)(k0 + m) * 32 + 16 + cl]; b2[m] = (cl < 4) ? wrg[(size_t)(k0 + m) * 4 + cl] : 0.f; }
#pragma unroll
            for (int m = 0; m < 4; ++m) {
                const float am = xa[m] * ga[m] * my_rs;
                acc0 = __builtin_amdgcn_mfma_f32_16x16x4f32(am, b0[m], acc0, 0, 0, 0);
                acc1 = __builtin_amdgcn_mfma_f32_16x16x4f32(am, b1[m], acc1, 0, 0, 0);
                acc2 = __builtin_amdgcn_mfma_f32_16x16x4f32(am, b2[m], acc2, 0, 0, 0);
            }
        }
        LDS_WAVE_SYNC();
#pragma unroll
        for (int i = 0; i < 4; ++i) { const int row = 4 * (lane >> 4) + i; lg[row * 48 + cl] = acc0[i]; lg[row * 48 + 16 + cl] = acc1[i]; lg[row * 48 + 32 + cl] = acc2[i]; }
        LDS_WAVE_SYNC();
        if (lane < 16) {
            const float* L = lg + lane * 48;
            float lgp[4];
#pragma unroll
            for (int o = 0; o < 4; ++o) lgp[o] = L[32 + o] + brg[o];
            int grp = 0; float gm = lgp[0];
#pragma unroll
            for (int o = 1; o < 4; ++o) if (lgp[o] > gm) { gm = lgp[o]; grp = o; }
            float gs = 0.f;
#pragma unroll
            for (int o = 0; o < 4; ++o) gs += __expf(lgp[o] - gm);
            const float ptop = 1.0f / gs;
            int i0 = 0; float v0 = -INFINITY; int i1 = 0; float v1 = -INFINITY;
            for (int o = 0; o < 8; ++o) { const float le = L[grp * 8 + o] + bre[grp * 8 + o]; if (le > v0) { v1 = v0; i1 = i0; v0 = le; i0 = o; } else if (le > v1) { v1 = le; i1 = o; } }
            const float e1 = __expf(v1 - v0), inv = 1.0f / (1.0f + e1);
            int* rt_ = c.ROUTE + (size_t)(r0 + lane) * 8;
            const int ex0 = grp * 8 + i0, ex1 = grp * 8 + i1;
            const float w0_ = inv * ptop, w1_ = e1 * inv * ptop;
            const int q0 = (int)atomicAdd(cnt + ex0, 1u), q1 = (int)atomicAdd(cnt + ex1, 1u);
            rt_[0] = ex0; rt_[1] = ex1; ((float*)rt_)[2] = w0_; ((float*)rt_)[3] = w1_; rt_[4] = q0; rt_[5] = q1;
            int* e0p = c.ENT + ((size_t)ex0 * NT + q0) * 2; e0p[0] = r0 + lane; ((float*)e0p)[1] = w0_;
            int* e1p = c.ENT + ((size_t)ex1 * NT + q1) * 2; e1p[0] = r0 + lane; ((float*)e1p)[1] = w1_;
        }
    }
}
DI void moe_tables(const Ctx& c, int* soff, int* stile, int ncol) {
    const unsigned* cnt = c.ctl + CW_CNT + c.l * 32;
    __syncthreads();
    if (TID() == 0) { int s = 0, tt = 0; for (int e = 0; e < 32; ++e) { soff[e] = s; stile[e] = tt; s += (int)cnt[e]; tt += (((int)cnt[e] + 255) >> 8) * ncol; } soff[32] = s; stile[32] = tt; }
    __syncthreads();
}
DI void phase_moe_up(const Ctx& c, unsigned char* lds) {
    int* soff = (int*)(lds + 2 * G_STAGE); int* stile = soff + 64;
    moe_tables(c, soff, stile, 2);
    const int total = stile[32];
    for (int item = blockIdx.x; item < total; item += gridDim.x) {
        int e = 0;
        for (int q = 1; q < 32; ++q) if (stile[q] <= item) e = q;
        const int loc = item - stile[e], tm = loc >> 1, tn = loc & 1, n0 = tn * 128;
        const int p0 = soff[e] + tm * 256, pend = soff[e + 1];
        ARows ar; ar.mu = nullptr; ar.ltype = 0; ar.first = 0;
#pragma unroll
        for (int i = 0; i < 4; ++i) { const int pr = p0 + (TID() >> 3) + 64 * i; ar.p[i] = (pr < pend) ? c.H + (size_t)c.ENT[((size_t)e * NT + (pr - soff[e])) * 2] * DM : nullptr; }
        {
            f32x4 ag[4][4]; acc_zero(ag);
            gemm_core<0>(ag, ar, (const bf16_t*)(c.ws + WS_EG) + ((size_t)e * 256 + n0) * DM, DM, DM, lds);
            ACC_FOREACH(ag, { if (p0 + r_ < pend) store_bf4(c.HID + (size_t)(p0 + r_) * 256 + n0 + c_, (f32x4){v_[0] * sigmoidf_(v_[0]), v_[1] * sigmoidf_(v_[1]), v_[2] * sigmoidf_(v_[2]), v_[3] * sigmoidf_(v_[3])}); });
        }
        f32x4 au[4][4]; acc_zero(au);
        gemm_core<0>(au, ar, (const bf16_t*)(c.ws + WS_EU) + ((size_t)e * 256 + n0) * DM, DM, DM, lds);
        ACC_FOREACH(au, { if (p0 + r_ < pend) { bf16_t* q = c.HID + (size_t)(p0 + r_) * 256 + n0 + c_; const u32x2 sv = *(const u32x2*)q;
            store_bf4(q, (f32x4){bflo(sv.x) * v_[0], bfhi(sv.x) * v_[1], bflo(sv.y) * v_[2], bfhi(sv.y) * v_[3]}); } });
    }
}
DI void phase_moe_down(const Ctx& c, unsigned char* lds) {
    int* soff = (int*)(lds + 2 * G_STAGE); int* stile = soff + 64;
    moe_tables(c, soff, stile, 8);
    const int total = stile[32];
    for (int item = blockIdx.x; item < total; item += gridDim.x) {
        int e = 0;
        for (int q = 1; q < 32; ++q) if (stile[q] <= item) e = q;
        const int loc = item - stile[e], tm = loc >> 3, tn = loc & 7, n0 = tn * 128;
        const int p0 = soff[e] + tm * 256, pend = soff[e + 1];
        ARows ar; ar.mu = nullptr; ar.ltype = 0; ar.first = 0;
#pragma unroll
        for (int i = 0; i < 4; ++i) { const int pr = p0 + (TID() >> 3) + 64 * i; ar.p[i] = (pr < pend) ? c.HID + (size_t)pr * 256 : nullptr; }
        f32x4 acc[4][4]; acc_zero(acc);
        gemm_core<0>(acc, ar, (const bf16_t*)(c.ws + WS_ED) + ((size_t)e * DM + n0) * 256, 256, 256, lds);
        ACC_FOREACH(acc, { if (p0 + r_ < pend) { const float w = ((const float*)c.ENT)[((size_t)e * NT + (p0 + r_ - soff[e])) * 2 + 1];
            store_bf4(c.Y + (size_t)(p0 + r_) * DM + n0 + c_, (f32x4){v_[0] * w, v_[1] * w, v_[2] * w, v_[3] * w}); } });
    }
}
DI void phase_final(const Ctx& c, unsigned char* lds) {
    const int tid = TID(), lane = tid & 63, wave = tid >> 6;
    const float* gain = c.in(I_NFIN);
    int* soff = (int*)(lds + 65536);
    moe_offsets(c, DEPTH - 1, soff);
    for (int row = blockIdx.x * 8 + wave; row < NT; row += gridDim.x * 8) {
        f32x4 v[4];
#pragma unroll
        for (int i = 0; i < 4; ++i) v[i] = *(const f32x4*)(c.out + (size_t)row * DM + i * 256 + lane * 4);
        add_moe_rows(c, row, lane, v, soff);
        float ss = 0.f;
#pragma unroll
        for (int i = 0; i < 4; ++i) ss += v[i][0] * v[i][0] + v[i][1] * v[i][1] + v[i][2] * v[i][2] + v[i][3] * v[i][3];
        ss = wave_sum_dpp(ss);
        const float rs = rsqrtf(ss * (1.0f / DM) + 1e-6f);
#pragma unroll
        for (int i = 0; i < 4; ++i) {
            const f32x4 g = *(const f32x4*)(gain + i * 256 + lane * 4);
            *(f32x4*)(c.out + (size_t)row * DM + i * 256 + lane * 4) = (f32x4){v[i][0] * rs * g[0], v[i][1] * rs * g[1], v[i][2] * rs * g[2], v[i][3] * rs * g[3]};
        }
    }
}

constexpr int PH_PER_LAYER = 11, N_PHASES = DEPTH * PH_PER_LAYER + 1;
__global__ void __launch_bounds__(NTHREADS, 2) fwd_kernel(Params P) {
    extern __shared__ __attribute__((aligned(16))) unsigned char lds[];
    const int lo = P.ph_lo, hi = P.ph_hi;
    LAS unsigned* xbw = (LAS unsigned*)(lds + LDS_BYTES - 16);
    if (threadIdx.x == 0) { xbw[0] = 0u; xbw[1] = 0u; xbw[2] = 0u; xbw[3] = 0u; }
    __syncthreads();
    Ctx c; c.P = &P; c.ws = P.ws; c.out = P.out; c.l = 0;
    c.ctl = (unsigned*)(P.ws + WS_CTL);
    c.H = (bf16_t*)(P.ws + WS_H); c.PROJ = (bf16_t*)(P.ws + WS_PROJ); c.F = (bf16_t*)(P.ws + WS_F); c.POOLED = (bf16_t*)(P.ws + WS_POOLED);
    c.MERGED = (bf16_t*)(P.ws + WS_F); c.CMPH = (bf16_t*)(P.ws + WS_CMPH); c.CMPO = (float*)(P.ws + WS_CMPO); c.POSB = (float*)(P.ws + WS_POSB);
    c.ROUTE = (int*)(P.ws + WS_ROUTE); c.ENT = (int*)(P.ws + WS_ENT); c.HID = (bf16_t*)(P.ws + WS_HID); c.Y = (bf16_t*)(P.ws + WS_Y);
    c.VT = (bf16_t*)(P.ws + WS_VT); c.KC = (bf16_t*)(P.ws + WS_KC); c.VCT = (bf16_t*)(P.ws + WS_VCT); c.YRAW = (bf16_t*)(P.ws + WS_YRAW); c.BON = (float*)(P.ws + WS_BON);
    XcdBarrier bar; bar.bar = c.ctl + CW_BAR; bar.x = 0; bar.st = (volatile LAS unsigned*)xbw;
    if (hi - lo > 1) bar = xcd_barrier_post(c.ctl + CW_BAR, (volatile LAS unsigned*)xbw);
#define IN(k) (lo <= (k) && (k) < hi)
#define SEAM(k) do { if (IN(k) && IN((k) + 1)) xcd_barrier(bar); } while (0)
#pragma unroll 1
    for (int l = 0; l < DEPTH; ++l) {
        c.l = l; const int pb = l * PH_PER_LAYER;
        if (IN(pb + 0)) phase_norm1(c, lds);
        SEAM(pb + 0);
        if (IN(pb + 1)) phase_gemm1(c, lds);
        SEAM(pb + 1);
        if (IN(pb + 2)) phase_prep(c, lds);
        SEAM(pb + 2);
        if (IN(pb + 3)) phase_poolgemm(c, lds);
        SEAM(pb + 3);
        if (IN(pb + 4)) phase_mix(c, lds);
        SEAM(pb + 4);
        if (IN(pb + 5)) phase_rwkv_post(c, lds);
        SEAM(pb + 5);
        if (IN(pb + 6)) phase_merge(c, lds);
        SEAM(pb + 6);
        if (IN(pb + 7)) phase_outp(c, lds);
        SEAM(pb + 7);
        if (IN(pb + 8)) phase_norm2(c, lds);
        SEAM(pb + 8);
        if (IN(pb + 9)) phase_moe_up(c, lds);
        SEAM(pb + 9);
        if (IN(pb + 10)) phase_moe_down(c, lds);
        SEAM(pb + 10);
    }
    if (IN(N_PHASES - 1)) phase_final(c, lds);
}

#ifndef MK_N_LAUNCHES
#define MK_N_LAUNCHES 1
#endif
extern "C" void kernel_launch(void* const* d_in, const int* in_sizes, int n_in, void* d_out, int out_size, void* d_ws, size_t ws_size, hipStream_t stream) {
    static int grid = 0;
    if (grid == 0) {
        if (n_in != N_IN || out_size != NT * DM || ws_size < WS_END) { fprintf(stderr, "kernel_launch: unexpected shapes n_in %d out %d ws %zu (need %zu)\n", n_in, out_size, ws_size, (size_t)WS_END); grid = -1; return; }
        int dev = 0, cus = 0, per_cu = 0;
        if (hipGetDevice(&dev) != hipSuccess || hipDeviceGetAttribute(&cus, hipDeviceAttributeMultiprocessorCount, dev) != hipSuccess) { grid = -1; return; }
        if (hipFuncSetAttribute((const void*)fwd_kernel, hipFuncAttributeMaxDynamicSharedMemorySize, LDS_BYTES) != hipSuccess) { fprintf(stderr, "kernel_launch: hipFuncSetAttribute failed\n"); grid = -1; return; }
        if (hipOccupancyMaxActiveBlocksPerMultiprocessor(&per_cu, (const void*)fwd_kernel, NTHREADS, LDS_BYTES) != hipSuccess || per_cu < 1) { fprintf(stderr, "kernel_launch: occupancy query says %d\n", per_cu); }
        (void)hipGetLastError();
        grid = cus;
    }
    if (grid < 0) return;
    if (hipMemsetAsync((char*)d_ws + WS_CTL, 0, CTL_BYTES, stream) != hipSuccess) return;
    Params p{};
    for (int i = 0; i < N_IN; ++i) p.in[i] = (const float*)d_in[i];
    p.out = (float*)d_out; p.ws = (unsigned char*)d_ws;
    if (MK_N_LAUNCHES == 1) {
        p.ph_lo = 0; p.ph_hi = N_PHASES;
        hipLaunchKernelGGL(fwd_kernel, dim3(grid), dim3(NTHREADS), LDS_BYTES, stream, p);
    } else {
        for (int k = 0; k < N_PHASES; ++k) { p.ph_lo = k; p.ph_hi = k + 1; hipLaunchKernelGGL(fwd_kernel, dim3(grid), dim3(NTHREADS), LDS_BYTES, stream, p); }
    }
}
```

```cpp
#include <hip/hip_runtime.h>
#include <cstdio>
#include <cstdint>

#define DI __device__ __forceinline__
typedef unsigned short bf16_t;
typedef short bf16x8 __attribute__((ext_vector_type(8)));
typedef float f32x4 __attribute__((ext_vector_type(4)));
typedef unsigned u32x4 __attribute__((ext_vector_type(4)));
typedef unsigned u32x2 __attribute__((ext_vector_type(2)));

constexpr int NB = 4, SEQ = 4096, DM = 1024, NT = NB * SEQ, DEPTH = 2;
constexpr int IN_COLS = 4816;
constexpr int C_POOL = 0, C_RW = 512, C_R = 512, C_K = 1024, C_V = 1536, C_WD = 2048, C_AD = 2080, C_GD = 2112;
constexpr int C_Q = 2208, C_KC = 3232, C_VC = 3488, C_KS = 3744, C_VS = 4000, C_KW = 4256, C_VW = 4512, C_GATE = 4768;
constexpr int RWC = 1696;
constexpr int NCMP = 255;
constexpr int NTHREADS = 512;
constexpr int LDS_BYTES = 155648;

enum { I_X = 0, I_RELB, I_NMIX, I_WIN, I_POOLW, I_POOLS, I_MU, I_W0, I_WUP, I_A0, I_AUP, I_GUP, I_KK, I_KA, I_RK, I_GNW, I_GNB,
       I_CPK, I_CW1K, I_CW2K, I_CPV, I_CW1V, I_CW2V, I_WBR, I_WMG, I_BMG, I_WOUT, I_NFFN, I_WRG, I_BRG, I_WRE, I_BRE, I_EG, I_EU, I_ED, I_NFIN, N_IN };

constexpr size_t WS_CTL = 0;
constexpr size_t CTL_BYTES = 65536;
constexpr size_t WS_H = CTL_BYTES;
constexpr size_t WS_PROJ = WS_H + (size_t)NT * DM * 2;
constexpr size_t WS_F = WS_PROJ + (size_t)NT * IN_COLS * 2;
constexpr size_t PLANE = (size_t)NT * 512 * 2;
constexpr size_t WS_POOLED = WS_F + 6 * PLANE;
constexpr size_t WS_CMPH = WS_POOLED + PLANE;
constexpr size_t WS_CMPO = WS_CMPH + (size_t)2 * 4096 * 256 * 2;
constexpr size_t WS_POSB = WS_CMPO + (size_t)2 * 4096 * 64 * 4;
constexpr size_t WS_ROUTE = WS_POSB + 4096;
constexpr size_t WS_ENT = WS_ROUTE + (size_t)NT * 32;
constexpr size_t WS_VT = WS_ENT + (size_t)32 * NT * 8;
constexpr size_t WS_KC = WS_VT + (size_t)2 * 16 * 64 * SEQ * 2;
constexpr size_t WS_VCT = WS_KC + (size_t)16 * 256 * 64 * 2;
constexpr size_t WS_YRAW = WS_VCT + (size_t)16 * 64 * 256 * 2;
constexpr size_t WS_BON = WS_YRAW + (size_t)NT * 512 * 2;
constexpr size_t WS_SMALLW = WS_BON + (size_t)NT * 8 * 16;
constexpr size_t WS_WT_LORA = WS_SMALLW + 262144;
constexpr size_t WS_END = WS_WT_LORA + (size_t)1536 * 128 * 2;
constexpr size_t WS_WT_IN = WS_F;
constexpr size_t WS_WT_C1 = WS_CMPO;
constexpr size_t WS_WT_C2 = WS_SMALLW;
constexpr size_t WS_WT_POOL = WS_SMALLW + 131072;
constexpr size_t WS_WT_MG = WS_VT;
constexpr size_t WS_WT_BR = WS_VT + (size_t)3072 * 1024 * 2;
constexpr size_t WS_WT_OUT = WS_CMPH;
constexpr size_t WS_EG = WS_F + 2 * PLANE;
constexpr size_t WS_EU = WS_EG + (size_t)32 * 256 * 1024 * 2;
constexpr size_t WS_ED = WS_EU + (size_t)32 * 256 * 1024 * 2;
static_assert(WS_ED + (size_t)32 * 1024 * 256 * 2 <= WS_F + 6 * PLANE, "expert alias");
static_assert(WS_WT_BR + (size_t)2048 * 1024 * 2 <= WS_VT + (size_t)2 * 16 * 64 * SEQ * 2, "merge alias");
static_assert((size_t)4864 * 1024 * 2 <= 6 * PLANE, "w_in alias");
constexpr size_t WS_HID = WS_PROJ;
constexpr size_t WS_Y = WS_PROJ + (size_t)2 * NT * 256 * 2;
static_assert(WS_Y + (size_t)2 * NT * 1024 * 2 <= WS_F, "alias");
constexpr int CW_BAR = 0;
constexpr int CW_CNT = 4096;
constexpr int CW_CUR = 4096 + 64;
constexpr int CW_Q = 4096 + 128;

#define XB_TMO      128
#define XB_XCNT(j)  (256  + 64 * (j))
#define XB_XSUB(j)  (1280 + 64 * (j))
#define XB_XGEN(j)  (2304 + 64 * (j))
#define XB_TOP      3328
#define XB_TOPGEN   3392
#define XCD_BAR_WORDS 3456
#define XB_SPIN_CAP (1u << 18)
#define LAS __attribute__((address_space(3)))

__device__ __forceinline__ unsigned xb_ld(unsigned* p)              { return __hip_atomic_load(p, __ATOMIC_RELAXED, __HIP_MEMORY_SCOPE_AGENT); }
__device__ __forceinline__ unsigned xb_add(unsigned* p, unsigned v) { return __hip_atomic_fetch_add(p, v, __ATOMIC_RELAXED, __HIP_MEMORY_SCOPE_AGENT); }
__device__ __forceinline__ unsigned xb_xcc_id() { return (unsigned)__builtin_amdgcn_s_getreg((3 << 11) | 20) & 0xFu; }
#define XB_SPIN(cond, bar) do { unsigned _sp = 0; while (cond) { __builtin_amdgcn_s_sleep(1); \
    if ((++_sp & 255u) == 0u) { if (xb_ld(&(bar)[XB_TMO])) break; if (_sp > XB_SPIN_CAP) { atomicAdd(&(bar)[XB_TMO], 1u); break; } } } } while (0)

struct XcdBarrier { unsigned* bar; unsigned x; volatile LAS unsigned* st; };

__device__ __forceinline__ XcdBarrier xcd_barrier_post(unsigned* bar, volatile LAS unsigned* st) {
    XcdBarrier b; b.bar = bar; b.x = xb_xcc_id(); b.st = st;
    if (threadIdx.x == 0) (void)xb_add(&bar[XB_XCNT(b.x)], 1u);
    return b;
}
__device__ __forceinline__ void xcd_barrier_complete(unsigned* bar, unsigned x, unsigned& nloc, unsigned& nx) {
    const unsigned G = gridDim.x * gridDim.y * gridDim.z;
    unsigned sum, cnt, mine, sp = 0u;
    for (;;) {
        sum = 0u; cnt = 0u; mine = 0u;
#pragma unroll
        for (unsigned j = 0; j < 16; ++j) { const unsigned c = xb_ld(&bar[XB_XCNT(j)]); sum += c; cnt += (c > 0u) ? 1u : 0u; mine = (j == x) ? c : mine; }
        if (sum == G) break;
        __builtin_amdgcn_s_sleep(1);
        if ((++sp & 255u) == 0u) { if (xb_ld(&bar[XB_TMO])) break; if (sp > XB_SPIN_CAP) { atomicAdd(&bar[XB_TMO], 1u); break; } }
    }
    nloc = mine > 0u ? mine : 1u; nx = cnt > 0u ? cnt : 1u;
}
__device__ __forceinline__ void xcd_barrier(const XcdBarrier& b) {
    asm volatile("s_waitcnt vmcnt(0)" ::: "memory");
    __syncthreads();
    if (threadIdx.x == 0) {
        unsigned* bar = b.bar;
        __builtin_amdgcn_s_waitcnt(0);
        unsigned nloc = b.st[0], nx = b.st[1];
        if (nloc == 0u) { xcd_barrier_complete(bar, b.x, nloc, nx); b.st[0] = nloc; b.st[1] = nx; }
        const unsigned old = xb_add(&bar[XB_XSUB(b.x)], 1u);
        const unsigned gen = old / nloc;
        if (old + 1u == (gen + 1u) * nloc) {
            __builtin_amdgcn_fence(__ATOMIC_RELEASE, "agent");
            asm volatile("s_waitcnt vmcnt(0)" ::: "memory");
            const unsigned og = xb_add(&bar[XB_TOP], 1u);
            const unsigned tg = og / nx;
            if (og + 1u == (tg + 1u) * nx) xb_add(&bar[XB_TOPGEN], 1u);
            else XB_SPIN(xb_ld(&bar[XB_TOPGEN]) == tg, bar);
            __builtin_amdgcn_fence(__ATOMIC_ACQUIRE, "agent");
            xb_add(&bar[XB_XGEN(b.x)], 1u);
            asm volatile("s_waitcnt vmcnt(0)" ::: "memory");
        } else {
            XB_SPIN(xb_ld(&bar[XB_XGEN(b.x)]) == gen, bar);
            __builtin_amdgcn_fence(__ATOMIC_ACQUIRE, "agent");
            asm volatile("s_waitcnt vmcnt(0)" ::: "memory");
        }
    }
    __syncthreads();
}

DI bf16_t f2bf(float x) { unsigned u = __float_as_uint(x); u += 0x7fffu + ((u >> 16) & 1u); return (bf16_t)(u >> 16); }
DI float bf2f(bf16_t b) { return __uint_as_float((unsigned)b << 16); }
typedef __bf16 bf16v2_t __attribute__((ext_vector_type(2)));
typedef float f32v2_t __attribute__((ext_vector_type(2)));
DI unsigned pack2(float lo, float hi) { const f32v2_t v = {lo, hi}; const bf16v2_t b = __builtin_convertvector(v, bf16v2_t); return __builtin_bit_cast(unsigned, b); }
DI float bflo(unsigned w) { return __uint_as_float(w << 16); }
DI float bfhi(unsigned w) { return __uint_as_float(w & 0xffff0000u); }
DI float wave_sum(float v) {
#pragma unroll
    for (int o = 32; o >= 1; o >>= 1) v += __shfl_xor(v, o);
    return v;
}
DI float wave_max(float v) {
#pragma unroll
    for (int o = 32; o >= 1; o >>= 1) v = fmaxf(v, __shfl_xor(v, o));
    return v;
}
DI float sigmoidf_(float x) { return __builtin_amdgcn_rcpf(1.0f + __expf(-x)); }
DI int TID() { int t = threadIdx.x; asm volatile("" : "+v"(t)); return t; }
#define LDS_WAVE_SYNC() asm volatile("s_waitcnt lgkmcnt(0)" ::: "memory")

#define DPP_MOV(v, ctrl) __builtin_bit_cast(float, __builtin_amdgcn_update_dpp(0, __builtin_bit_cast(int, (v)), (ctrl), 0xF, 0xF, true))
DI float wave_sum_dpp(float v) {
    v += DPP_MOV(v, 0xB1); v += DPP_MOV(v, 0x4E); v += DPP_MOV(v, 0x141); v += DPP_MOV(v, 0x140);
    return __builtin_bit_cast(float, __builtin_amdgcn_readlane(__builtin_bit_cast(int, v), 0)) + __builtin_bit_cast(float, __builtin_amdgcn_readlane(__builtin_bit_cast(int, v), 16)) +
        (__builtin_bit_cast(float, __builtin_amdgcn_readlane(__builtin_bit_cast(int, v), 32)) + __builtin_bit_cast(float, __builtin_amdgcn_readlane(__builtin_bit_cast(int, v), 48)));
}
struct Params { const float* in[N_IN]; float* out; unsigned char* ws; int ph_lo, ph_hi; };

DI int t5_bucket(int n) {
    if (n < 16) return n;
    if (n >= 128) return 31;
    int b = 16;
    b += (n >= 19) + (n >= 21) + (n >= 24) + (n >= 27) + (n >= 31) + (n >= 35) + (n >= 40) + (n >= 46) + (n >= 52) + (n >= 59) + (n >= 67) + (n >= 77) + (n >= 87) + (n >= 99) + (n >= 113);
    return b;
}

constexpr int G_A = 0, G_B = 256 * 64 * 2, G_STAGE = (256 + 128) * 64 * 2;
static_assert(2 * G_STAGE <= LDS_BYTES - 64, "gemm lds");
DI int g_off(int r, int c) { return ((r >> 4) * 2 + (c >> 5)) * 1024 + ((((r & 15) * 64) + (c & 31) * 2) ^ ((((r & 15) >> 3) & 1) << 5)); }
struct ARows { const bf16_t* p[4]; const float* mu; int ltype; int first; };
DI float tanhf_fast(float x) { const float e = __expf(2.0f * x); return 1.0f - 2.0f * __builtin_amdgcn_rcpf(e + 1.0f); }
DI u32x4 lora_chunk(const bf16_t* prow, bool first, const float* mu, int ltype, int k) {
    const int lim = (ltype == 2) ? 96 : 32;
    if (k >= lim) return (u32x4){0u, 0u, 0u, 0u};
    const int col = C_WD + ltype * 32 + k;
    const u32x4 cu = *(const u32x4*)(prow + col);
    u32x4 pu = (u32x4){0u, 0u, 0u, 0u};
    if (!first) pu = *(const u32x4*)(prow - IN_COLS + col);
    const f32x4 m0 = *(const f32x4*)(mu + col - C_RW), m1 = *(const f32x4*)(mu + col - C_RW + 4);
    float u[8] = {bflo(cu.x), bfhi(cu.x), bflo(cu.y), bfhi(cu.y), bflo(cu.z), bfhi(cu.z), bflo(cu.w), bfhi(cu.w)};
    const float p[8] = {bflo(pu.x), bfhi(pu.x), bflo(pu.y), bfhi(pu.y), bflo(pu.z), bfhi(pu.z), bflo(pu.w), bfhi(pu.w)};
    const float mm[8] = {m0[0], m0[1], m0[2], m0[3], m1[0], m1[1], m1[2], m1[3]};
#pragma unroll
    for (int j = 0; j < 8; ++j) { const float us = u[j] + (p[j] - u[j]) * mm[j]; u[j] = (ltype == 0) ? tanhf_fast(us) : ((ltype == 1) ? us : __builtin_amdgcn_rcpf(1.0f + __expf(-us))); }
    u32x4 w; w.x = pack2(u[0], u[1]); w.y = pack2(u[2], u[3]); w.z = pack2(u[4], u[5]); w.w = pack2(u[6], u[7]);
    return w;
}
template <int AMODE>
DI void g_load(u32x4 (&ra)[4], u32x4 (&rb)[2], const ARows& ar, const bf16_t* bt, int ldb, int k0, int tid) {
    const int kseg = (tid & 7) * 8;
#pragma unroll
    for (int i = 0; i < 4; ++i) {
        ra[i] = (u32x4){0u, 0u, 0u, 0u};
        if (AMODE == 2) ra[i] = lora_chunk(ar.p[i], (ar.first >> i) & 1, ar.mu, ar.ltype, k0 + kseg);
        else if (ar.p[i] != nullptr) ra[i] = *(const u32x4*)((AMODE == 0) ? (ar.p[i] + k0 + kseg) : (ar.p[i] + (size_t)(k0 >> 6) * IN_COLS + kseg));
    }
#pragma unroll
    for (int i = 0; i < 2; ++i) rb[i] = *(const u32x4*)(bt + (size_t)((tid >> 3) + 64 * i) * ldb + k0 + kseg);
}
DI void g_store(unsigned char* st, const u32x4 (&ra)[4], const u32x4 (&rb)[2], int tid) {
    const int off = g_off(tid >> 3, (tid & 7) * 8);
#pragma unroll
    for (int i = 0; i < 4; ++i) *(u32x4*)(st + G_A + off + i * 8192) = ra[i];
#pragma unroll
    for (int i = 0; i < 2; ++i) *(u32x4*)(st + G_B + off + i * 8192) = rb[i];
}
DI void g_compute(f32x4 (&acc)[4][4], const unsigned char* st, int lane, int wm, int wn) {
    const int lo = ((lane & 15) * 64 + (lane >> 4) * 16) ^ ((((lane & 15) >> 3) & 1) << 5);
    const unsigned char* sA = st + G_A + wm * 8192 + lo;
    const unsigned char* sB = st + G_B + wn * 8192 + lo;
    bf16x8 bcur[4], bnxt[4], a0, a1, a2;
#pragma unroll
    for (int i = 0; i < 4; ++i) bcur[i] = *(const bf16x8*)(sB + i * 2048);
    a0 = *(const bf16x8*)(sA);
    a1 = *(const bf16x8*)(sA + 2048);
#define G_AFRAG(s) (*(const bf16x8*)(sA + ((s) & 3) * 2048 + ((s) >> 2) * 1024))
#define G_GROUP(s, acur, anew) do { \
        if ((s) + 2 < 8) anew = G_AFRAG((s) + 2); \
        if ((s) < 4) bnxt[(s) & 3] = *(const bf16x8*)(sB + ((s) & 3) * 2048 + 1024); \
        __builtin_amdgcn_sched_barrier(0); \
        _Pragma("unroll") for (int ni = 0; ni < 4; ++ni) acc[(s) & 3][ni] = __builtin_amdgcn_mfma_f32_16x16x32_bf16(((s) < 4 ? bcur[ni] : bnxt[ni]), acur, acc[(s) & 3][ni], 0, 0, 0); \
        __builtin_amdgcn_sched_barrier(0); } while (0)
    G_GROUP(0, a0, a2); G_GROUP(1, a1, a0); G_GROUP(2, a2, a1); G_GROUP(3, a0, a2);
    G_GROUP(4, a1, a0); G_GROUP(5, a2, a1); G_GROUP(6, a0, a2); G_GROUP(7, a1, a0);
#undef G_GROUP
#undef G_AFRAG
}
#define LDS_BARRIER() do { asm volatile("s_waitcnt lgkmcnt(0)" ::: "memory"); __builtin_amdgcn_s_barrier(); asm volatile("" ::: "memory"); } while (0)
template <int AMODE>
DI void gemm_core(f32x4 (&acc)[4][4], const ARows& ar, const bf16_t* bt  , int ldb, int K, unsigned char* lds) {
    const int tid = TID(), lane = tid & 63, wave = tid >> 6, wm = wave >> 1, wn = wave & 1;
    const int nk = K >> 6;
    unsigned char* s0 = lds; unsigned char* s1 = lds + G_STAGE;
    u32x4 ra0[4], rb0[2], ra1[4], rb1[2];
    g_load<AMODE>(ra0, rb0, ar, bt, ldb, 0, tid);
    g_load<AMODE>(ra1, rb1, ar, bt, ldb, 64, tid);
    __syncthreads();
    g_store(s0, ra0, rb0, tid);
    g_load<AMODE>(ra0, rb0, ar, bt, ldb, (nk > 2 ? 2 : nk - 1) * 64, tid);
    LDS_BARRIER();
    for (int kt = 0; kt < nk; kt += 2) {
        g_store(s1, ra1, rb1, tid);
        { const int kn = (kt + 3 < nk) ? kt + 3 : nk - 1; g_load<AMODE>(ra1, rb1, ar, bt, ldb, kn * 64, tid); }
        g_compute(acc, s0, lane, wm, wn);
        LDS_BARRIER();
        g_store(s0, ra0, rb0, tid);
        { const int kn = (kt + 4 < nk) ? kt + 4 : nk - 1; g_load<AMODE>(ra0, rb0, ar, bt, ldb, kn * 64, tid); }
        g_compute(acc, s1, lane, wm, wn);
        LDS_BARRIER();
    }
}
static_assert(3 * G_STAGE <= LDS_BYTES - 64, "dma ring");
DI void gemm_core_dma(f32x4 (&acc)[4][4], const bf16_t* A, size_t lda, const bf16_t* bt, size_t ldb, int K, unsigned char* lds) {
    const int tid = TID(), lane = tid & 63, wave = __builtin_amdgcn_readfirstlane(tid >> 6), wm = wave >> 1, wn = wave & 1;
    const int nk = K >> 6;
    const int srow = lane >> 2, skof = ((lane & 3) * 8) ^ ((lane >> 5) << 4);
    const char* gp[6]; int loff[6];
#pragma unroll
    for (int j = 0; j < 6; ++j) {
        const int sid = wave * 6 + j;
        if (sid < 32) { gp[j] = (const char*)(A + (size_t)((sid >> 1) * 16 + srow) * lda + (sid & 1) * 32 + skof); loff[j] = G_A + sid * 1024; }
        else { const int s2 = sid - 32; gp[j] = (const char*)(bt + (size_t)((s2 >> 1) * 16 + srow) * ldb + (s2 & 1) * 32 + skof); loff[j] = G_B + s2 * 1024; }
    }
#define DMA_ISSUE(kt_, st_) do { const int _k = ((kt_) < nk ? (kt_) : nk - 1) * 128; \
        _Pragma("unroll") for (int j = 0; j < 6; ++j) __builtin_amdgcn_global_load_lds((const unsigned*)(gp[j] + _k), (LAS unsigned*)(lds + (st_) * G_STAGE + loff[j]), 16, 0, 0); } while (0)
    asm volatile("s_waitcnt vmcnt(0)" ::: "memory");
    __syncthreads();
    DMA_ISSUE(0, 0); DMA_ISSUE(1, 1);
    int st = 0;
    for (int kt = 0; kt < nk; ++kt) {
        asm volatile("s_waitcnt vmcnt(6)" ::: "memory");
        __builtin_amdgcn_s_barrier();
        asm volatile("" ::: "memory");
        const int sn = (st == 0) ? 2 : st - 1;
        DMA_ISSUE(kt + 2, sn);
        g_compute(acc, lds + st * G_STAGE, lane, wm, wn);
        st = (st == 2) ? 0 : st + 1;
    }
    asm volatile("s_waitcnt vmcnt(0)" ::: "memory");
    __syncthreads();
#undef DMA_ISSUE
}
DI void store_bf4(bf16_t* p, f32x4 v) { u32x2 w; w.x = pack2(v[0], v[1]); w.y = pack2(v[2], v[3]); *(u32x2*)p = w; }
constexpr int H_A = 0, H_B = 256 * 64 * 2, H_STAGE = 2 * 256 * 64 * 2;
static_assert(2 * H_STAGE <= LDS_BYTES - 64, "gemm256 lds");
DI void h_compute(f32x4 (&acc)[8][4], const unsigned char* st, int lane, int wm, int wn) {
    const int lo = ((lane & 15) * 64 + (lane >> 4) * 16) ^ ((((lane & 15) >> 3) & 1) << 5);
    const unsigned char* sA = st + H_A + wm * 16384 + lo;
    const unsigned char* sB = st + H_B + wn * 8192 + lo;
#pragma unroll
    for (int ks = 0; ks < 2; ++ks) {
        bf16x8 bf[4], a0, a1, a2;
#pragma unroll
        for (int i = 0; i < 4; ++i) bf[i] = *(const bf16x8*)(sB + i * 2048 + ks * 1024);
        a0 = *(const bf16x8*)(sA + ks * 1024);
        a1 = *(const bf16x8*)(sA + 2048 + ks * 1024);
#define H_GROUP(s, acur, anew) do { \
        if ((s) + 2 < 8) anew = *(const bf16x8*)(sA + ((s) + 2) * 2048 + ks * 1024); \
        __builtin_amdgcn_sched_barrier(0); \
        _Pragma("unroll") for (int ni = 0; ni < 4; ++ni) acc[(s)][ni] = __builtin_amdgcn_mfma_f32_16x16x32_bf16(bf[ni], acur, acc[(s)][ni], 0, 0, 0); \
        __builtin_amdgcn_sched_barrier(0); } while (0)
        H_GROUP(0, a0, a2); H_GROUP(1, a1, a0); H_GROUP(2, a2, a1); H_GROUP(3, a0, a2);
        H_GROUP(4, a1, a0); H_GROUP(5, a2, a1); H_GROUP(6, a0, a2); H_GROUP(7, a1, a0);
#undef H_GROUP
    }
}
struct GatherRows { const int* ent; int n; };
DI void gemm256_dma(f32x4 (&acc)[8][4], const bf16_t* A, size_t lda, const bf16_t* bt, size_t ldb, int K, unsigned char* lds, const GatherRows* gr = nullptr) {
    const int tid = TID(), lane = tid & 63, wave = __builtin_amdgcn_readfirstlane(tid >> 6), wm = wave >> 2, wn = wave & 3;
    const int nk = K >> 6;
    const int srow = lane >> 2, skof = ((lane & 3) * 8) ^ ((lane >> 5) << 4);
    const char* gp[8]; int loff[8];
#pragma unroll
    for (int j = 0; j < 8; ++j) {
        const int sid = wave * 8 + j;
        if (sid < 32) { size_t rowoff = (size_t)((sid >> 1) * 16 + srow) * lda;
            if (gr != nullptr) { const int r = (sid >> 1) * 16 + srow; rowoff = (size_t)((r < gr->n) ? gr->ent[2 * r] : 0) * lda; }
            gp[j] = (const char*)(A + rowoff + (sid & 1) * 32 + skof); loff[j] = H_A + sid * 1024; }
        else { const int s2 = sid - 32; gp[j] = (const char*)(bt + (size_t)((s2 >> 1) * 16 + srow) * ldb + (s2 & 1) * 32 + skof); loff[j] = H_B + s2 * 1024; }
    }
#define H_ISSUE(kt_, st_) do { const int _k = ((kt_) < nk ? (kt_) : nk - 1) * 128; \
        _Pragma("unroll") for (int j = 0; j < 8; ++j) __builtin_amdgcn_global_load_lds((const unsigned*)(gp[j] + _k), (LAS unsigned*)(lds + (st_) * H_STAGE + loff[j]), 16, 0, 0); } while (0)
    asm volatile("s_waitcnt vmcnt(0)" ::: "memory");
    __syncthreads();
    H_ISSUE(0, 0);
    for (int kt = 0; kt < nk; ++kt) {
        asm volatile("s_waitcnt vmcnt(0)" ::: "memory");
        __builtin_amdgcn_s_barrier();
        asm volatile("" ::: "memory");
        H_ISSUE(kt + 1, (kt + 1) & 1);
        h_compute(acc, lds + (kt & 1) * H_STAGE, lane, wm, wn);
    }
    asm volatile("s_waitcnt vmcnt(0)" ::: "memory");
    __syncthreads();
#undef H_ISSUE
}
DI void tile256_store_bf16(f32x4 (&acc)[8][4], bf16_t* out, size_t ld, int ncols, unsigned char* lds) {
    bf16_t* T = (bf16_t*)lds;
    const int tid = TID(), lane = tid & 63, wave = tid >> 6, wm = wave >> 2, wn = wave & 3;
    __syncthreads();
#pragma unroll
    for (int mi = 0; mi < 8; ++mi)
#pragma unroll
        for (int ni = 0; ni < 4; ++ni) store_bf4(T + (wm * 128 + mi * 16 + (lane & 15)) * 264 + wn * 64 + ni * 16 + (lane >> 4) * 4, acc[mi][ni]);
    __syncthreads();
#pragma unroll
    for (int i = 0; i < 16; ++i) {
        const int ch = tid + i * NTHREADS, r = ch >> 5, cc = (ch & 31) * 8;
        if (cc < ncols) *(u32x4*)(out + (size_t)r * ld + cc) = *(const u32x4*)(T + r * 264 + cc);
    }
}
DI void acc_zero(f32x4 (&acc)[4][4]) {
#pragma unroll
    for (int i = 0; i < 4; ++i)
#pragma unroll
        for (int j = 0; j < 4; ++j) acc[i][j] = (f32x4){0.f, 0.f, 0.f, 0.f};
}
#define ACC_FOREACH(acc, body) do { const int _l = TID() & 63, _w = TID() >> 6; \
    _Pragma("unroll") for (int _mi = 0; _mi < 4; ++_mi) _Pragma("unroll") for (int _ni = 0; _ni < 4; ++_ni) { \
        const int r_ = (_w >> 1) * 64 + _mi * 16 + (_l & 15), c_ = (_w & 1) * 64 + _ni * 16 + (_l >> 4) * 4; f32x4& v_ = acc[_mi][_ni]; body } } while (0)
DI ARows plain_rows(const bf16_t* base, size_t ld, int m0, int tid) { ARows a; a.mu = nullptr; a.ltype = 0; a.first = 0;
#pragma unroll
    for (int i = 0; i < 4; ++i) a.p[i] = base + (size_t)(m0 + (tid >> 3) + 64 * i) * ld;
    return a; }


DI void convert_tile4(const float* src, int ld, int N, int K, bf16_t* dst, int tile0, unsigned char* lds, int Kvalid = 1 << 30) {
    const int tid = TID();
    const int nkt = K >> 6;
    const int r = tid >> 3, seg = (tid & 7) * 8;
    f32x4 a[4], b[4];
#pragma unroll
    for (int u = 0; u < 4; ++u) {
        const int tile = tile0 + u, k0 = (tile % nkt) * 64, n0 = (tile / nkt) * 64;
        a[u] = (f32x4){0.f, 0.f, 0.f, 0.f}; b[u] = a[u];
        if (n0 + seg < N && k0 + r < Kvalid) { const float* q = src + (size_t)(k0 + r) * ld + n0 + seg; a[u] = *(const f32x4*)q; b[u] = *(const f32x4*)(q + 4); }
    }
    __syncthreads();
#pragma unroll
    for (int u = 0; u < 4; ++u) { bf16_t* T = (bf16_t*)lds + u * 64 * 72;
        u32x4 w; w.x = pack2(a[u][0], a[u][1]); w.y = pack2(a[u][2], a[u][3]); w.z = pack2(b[u][0], b[u][1]); w.w = pack2(b[u][2], b[u][3]); *(u32x4*)(T + r * 72 + seg) = w; }
    __syncthreads();
#pragma unroll
    for (int u = 0; u < 4; ++u) { const bf16_t* T = (const bf16_t*)lds + u * 64 * 72;
        const int tile = tile0 + u, k0 = (tile % nkt) * 64, n0 = (tile / nkt) * 64;
        u32x4 o;
        o.x = (unsigned)T[(seg + 0) * 72 + r] | ((unsigned)T[(seg + 1) * 72 + r] << 16); o.y = (unsigned)T[(seg + 2) * 72 + r] | ((unsigned)T[(seg + 3) * 72 + r] << 16);
        o.z = (unsigned)T[(seg + 4) * 72 + r] | ((unsigned)T[(seg + 5) * 72 + r] << 16); o.w = (unsigned)T[(seg + 6) * 72 + r] | ((unsigned)T[(seg + 7) * 72 + r] << 16);
        *(u32x4*)(dst + (size_t)(n0 + r) * K + k0 + seg) = o; }
}
struct Ctx {
    const Params* P; unsigned char* ws; float* out; int l;
    bf16_t* H; bf16_t* PROJ; bf16_t* F; bf16_t* POOLED; bf16_t* MERGED; bf16_t* CMPH; float* CMPO; float* POSB; int* ROUTE; int* ENT; bf16_t* HID; bf16_t* Y; bf16_t* VT; bf16_t* KC; bf16_t* VCT; bf16_t* YRAW; float* BON; unsigned* ctl;
    DI const float* in(int i) const { return P->in[i]; }
};

DI void moe_offsets(const Ctx& c, int layer, int* soff) {
    const unsigned* cnt = c.ctl + CW_CNT + layer * 32;
    __syncthreads();
    if (TID() == 0) { int s = 0; for (int e = 0; e < 32; ++e) { soff[e] = s; s += (int)cnt[e]; } soff[32] = s; }
    __syncthreads();
}
DI void add_moe_rows(const Ctx& c, int row, int lane, f32x4 (&v)[4], const int* soff) {
    const int* rt = c.ROUTE + (size_t)row * 8;
    const int p0 = soff[rt[0]] + rt[4], p1 = soff[rt[1]] + rt[5];
    const bf16_t* y0 = c.Y + (size_t)p0 * DM; const bf16_t* y1 = c.Y + (size_t)p1 * DM;
#pragma unroll
    for (int i = 0; i < 4; ++i) {
        const u32x2 a = *(const u32x2*)(y0 + i * 256 + lane * 4), b = *(const u32x2*)(y1 + i * 256 + lane * 4);
        v[i][0] += bflo(a.x) + bflo(b.x); v[i][1] += bfhi(a.x) + bfhi(b.x); v[i][2] += bflo(a.y) + bflo(b.y); v[i][3] += bfhi(a.y) + bfhi(b.y);
    }
}
DI void phase_norm1(const Ctx& c, unsigned char* lds) {
    const int tid = TID(), lane = tid & 63, wave = tid >> 6;
    const float* gain = c.in(I_NMIX) + c.l * DM;
    const float* src = (c.l == 0) ? c.in(I_X) : c.out;
    int* soff = (int*)(lds + 65536);
    if (c.l > 0) moe_offsets(c, c.l - 1, soff);
    for (int row = blockIdx.x * 8 + wave; row < NT; row += gridDim.x * 8) {
        f32x4 v[4];
#pragma unroll
        for (int i = 0; i < 4; ++i) v[i] = *(const f32x4*)(src + (size_t)row * DM + i * 256 + lane * 4);
        if (c.l > 0) {
            add_moe_rows(c, row, lane, v, soff);
#pragma unroll
            for (int i = 0; i < 4; ++i) *(f32x4*)(c.out + (size_t)row * DM + i * 256 + lane * 4) = v[i];
        }
        float ss = 0.f;
#pragma unroll
        for (int i = 0; i < 4; ++i) ss += v[i][0] * v[i][0] + v[i][1] * v[i][1] + v[i][2] * v[i][2] + v[i][3] * v[i][3];
        ss = wave_sum_dpp(ss);
        const float rs = rsqrtf(ss * (1.0f / DM) + 1e-6f);
#pragma unroll
        for (int i = 0; i < 4; ++i) {
            const f32x4 g = *(const f32x4*)(gain + i * 256 + lane * 4);
            store_bf4(c.H + (size_t)row * DM + i * 256 + lane * 4, (f32x4){v[i][0] * rs * g[0], v[i][1] * rs * g[1], v[i][2] * rs * g[2], v[i][3] * rs * g[3]});
        }
    }
    for (int idx = blockIdx.x * 8 + wave; idx < 512; idx += gridDim.x * 8) {
        const int kv = idx >> 8, n = idx & 255;
        const float* pos = c.in(kv ? I_CPV : I_CPK) + (size_t)c.l * 2048;
        const float* w1 = c.in(kv ? I_CW1V : I_CW1K) + (size_t)c.l * 2048 * 256;
        float s = 0.f;
        for (int k = lane; k < 2048; k += 64) s += pos[k] * w1[(size_t)k * 256 + n];
        s = wave_sum_dpp(s);
        if (lane == 0) c.POSB[kv * 256 + n] = s;
    }
    for (int it = blockIdx.x * 4; it < 1216 + 256 + 16 + 16 + 48; it += gridDim.x * 4) {
        if (it < 1216) convert_tile4(c.in(I_WIN) + (size_t)c.l * DM * IN_COLS, IN_COLS, IN_COLS, DM, (bf16_t*)(c.ws + WS_WT_IN), it, lds);
        else if (it < 1216 + 256) { const int j = it - 1216, kv = j >> 7; convert_tile4(c.in(kv ? I_CW1V : I_CW1K) + (size_t)c.l * 2048 * 256, 256, 256, 2048, (bf16_t*)(c.ws + WS_WT_C1) + (size_t)kv * 256 * 2048, j & 127, lds); }
        else if (it < 1216 + 256 + 16) { const int j = it - 1472, kv = j >> 3; convert_tile4(c.in(kv ? I_CW2V : I_CW2K) + (size_t)c.l * 256 * 64, 64, 64, 256, (bf16_t*)(c.ws + WS_WT_C2) + (size_t)kv * 128 * 256, j & 7, lds); }
        else if (it < 1504) { const int j = it - 1488, gi = j >> 2; convert_tile4(c.in(I_POOLW) + ((size_t)c.l * 4 + gi) * 128 * 128, 128, 128, 128, (bf16_t*)(c.ws + WS_WT_POOL) + (size_t)gi * 128 * 128, 0, lds); }
        else { const int j = it - 1504, ty = j >> 4; bf16_t* dst = (bf16_t*)(c.ws + WS_WT_LORA) + (size_t)ty * 512 * 128;
            if (ty == 0) convert_tile4(c.in(I_WUP) + (size_t)c.l * 32 * 512, 512, 512, 128, dst, j & 15, lds, 32);
            else if (ty == 1) convert_tile4(c.in(I_AUP) + (size_t)c.l * 32 * 512, 512, 512, 128, dst, j & 15, lds, 32);
            else convert_tile4(c.in(I_GUP) + (size_t)c.l * 96 * 512, 512, 512, 128, dst, j & 15, lds, 96); }
    }
}

constexpr int EPS = 136;
DI void tile_store_bf16(f32x4 (&acc)[4][4], bf16_t* out, size_t ld, int nrows, int ncols, unsigned char* lds) {
    bf16_t* T = (bf16_t*)lds;
    const int tid = TID();
    __syncthreads();
    ACC_FOREACH(acc, { store_bf4(T + r_ * EPS + c_, v_); });
    __syncthreads();
#pragma unroll
    for (int i = 0; i < 8; ++i) {
        const int ch = tid + i * NTHREADS, r = ch >> 4, cc = (ch & 15) * 8;
        if (r < nrows && cc < ncols) *(u32x4*)(out + (size_t)r * ld + cc) = *(const u32x4*)(T + r * EPS + cc);
    }
}
DI bool xcd_unit(int it, int nN, int& tm, int& tn) {
    const int G = gridDim.x;
    if ((G & 7) != 0 || G < 8) { const int u = it * G + blockIdx.x; if (u >= 64 * nN) return false; tm = u % 64; tn = u / 64; return true; }
    const int x = blockIdx.x & 7, i = blockIdx.x >> 3, per = G >> 3;
    const int u = it * per + i;
    if (u >= 8 * nN) return false;
    tm = x * 8 + (u & 7); tn = u >> 3; return true;
}
DI void phase_gemm1(const Ctx& c, unsigned char* lds) {
    const int nN = (IN_COLS + 255) / 256;
    const bf16_t* WT = (const bf16_t*)(c.ws + WS_WT_IN);
    for (int it = 0;; ++it) {
        int tm, tn; if (!xcd_unit(it, nN, tm, tn)) break;
        const int m0 = tm * 256, n0 = tn * 256;
        f32x4 acc[8][4];
#pragma unroll
        for (int i = 0; i < 8; ++i)
#pragma unroll
            for (int j = 0; j < 4; ++j) acc[i][j] = (f32x4){0.f, 0.f, 0.f, 0.f};
        gemm256_dma(acc, c.H + (size_t)m0 * DM, DM, WT + (size_t)n0 * DM, DM, DM, lds);
        tile256_store_bf16(acc, c.PROJ + (size_t)m0 * IN_COLS + n0, IN_COLS, (IN_COLS - n0 < 256) ? IN_COLS - n0 : 256, lds);
    }
}

DI float gelu_tanh(float x) { const float u = 0.7978845608028654f * (x + 0.044715f * x * x * x); const float e = __expf(2.0f * u); return x * (1.0f - __builtin_amdgcn_rcpf(e + 1.0f)); }
DI float softplusf_(float x) { return (x > 20.f) ? x : __logf(1.0f + __expf(x)); }
DI float tanhf_(float x) { const float e = __expf(2.0f * x); return 1.0f - 2.0f * __builtin_amdgcn_rcpf(e + 1.0f); }
constexpr int TKP = 8;
template <int WIN>
DI void pool_emit(const Ctx& c, const float (&pv)[31], int t0, int s0, int ch) {
#pragma unroll
    for (int k = 0; k < 16; ++k) {
        float sum = 0.f;
#pragma unroll
        for (int j = 0; j < WIN; ++j) sum += pv[15 + k - j];
        const int s = s0 + k, cnt = (s + 1 < WIN) ? s + 1 : WIN;
        c.POOLED[(size_t)(t0 + k) * 512 + ch] = f2bf(sum / (float)cnt - pv[15 + k]);
    }
}
DI void phase_prep(const Ctx& c, unsigned char* lds) {
    const int n_cmp_items = 2 * 16 * 2;
    for (int item = (int)gridDim.x - 1 - (int)blockIdx.x; item < n_cmp_items; item += gridDim.x) {
        const int tid = TID();
        const int kv = item >> 5, bgi = (item >> 1) & 15, tn = item & 1, m0 = bgi * 256, n0 = tn * 128;
        ARows ar; ar.mu = nullptr; ar.ltype = 0; ar.first = 0;
#pragma unroll
        for (int i = 0; i < 4; ++i) { const int cb = (tid >> 3) + 64 * i;
            ar.p[i] = (cb < NCMP) ? c.PROJ + ((size_t)(bgi >> 2) * SEQ + 16 * cb) * IN_COLS + (kv ? C_VC : C_KC) + (bgi & 3) * 64 : nullptr; }
        f32x4 acc[4][4]; acc_zero(acc);
        gemm_core<1>(acc, ar, (const bf16_t*)(c.ws + WS_WT_C1) + ((size_t)kv * 256 + n0) * 2048, 2048, 2048, lds);
        const float* pb = c.POSB + kv * 256;
        ACC_FOREACH(acc, {
            const f32x4 bb = *(const f32x4*)(pb + n0 + c_);
            store_bf4(c.CMPH + ((size_t)kv * 4096 + m0 + r_) * 256 + n0 + c_, (f32x4){gelu_tanh(v_[0] + bb[0]), gelu_tanh(v_[1] + bb[1]), gelu_tanh(v_[2] + bb[2]), gelu_tanh(v_[3] + bb[3])}); });
    }
    {
        const float* mu = c.in(I_MU) + (size_t)c.l * RWC;
        const bf16_t* WL = (const bf16_t*)(c.ws + WS_WT_LORA);
        for (int unit = blockIdx.x; unit < 64 * 12; unit += gridDim.x) {
            const int tid = TID();
            const int tm = unit & 63, tn = unit >> 6, m0 = tm * 256, n0 = tn * 128, ltype = tn >> 2, ch0 = n0 & 511;
            ARows ar; ar.mu = mu; ar.ltype = ltype; ar.first = 0;
#pragma unroll
            for (int i = 0; i < 4; ++i) { const int t = m0 + (tid >> 3) + 64 * i; ar.p[i] = c.PROJ + (size_t)t * IN_COLS; if ((t & (SEQ - 1)) == 0) ar.first |= 1 << i; }
            f32x4 acc[4][4]; acc_zero(acc);
            gemm_core<2>(acc, ar, WL + (size_t)n0 * 128, 128, 128, lds);
            if (ltype == 0) { const float* w0 = c.in(I_W0) + c.l * 512 + ch0;
                ACC_FOREACH(acc, { const f32x4 b4 = *(const f32x4*)(w0 + c_);
                    for (int j = 0; j < 4; ++j) v_[j] = __expf(-softplusf_(-(b4[j] + v_[j])) - 0.5f); }); }
            else if (ltype == 1) { const float* a0 = c.in(I_A0) + c.l * 512 + ch0;
                ACC_FOREACH(acc, { const f32x4 b4 = *(const f32x4*)(a0 + c_);
                    for (int j = 0; j < 4; ++j) v_[j] = sigmoidf_(b4[j] + v_[j]); }); }
            tile_store_bf16(acc, c.F + (size_t)(3 + ltype) * NT * 512 + (size_t)m0 * 512 + ch0, 512, 256, 128, lds);
        }
    }
    const int tid = TID();
    const int n_pool_items = NT / 16, n_items = n_pool_items + 512;
    for (int item = blockIdx.x; item < n_items; item += gridDim.x) {
        if (item >= n_pool_items) {
            const int idx0 = (item - n_pool_items) * 4;
            const int r = tid >> 3, seg = (tid & 7) * 8;
            u32x4 w[4];
#pragma unroll
            for (int u = 0; u < 4; ++u) { const int idx = idx0 + u, kind = idx >> 10, bgi = (idx >> 6) & 15, s0 = (idx & 63) * 64;
                w[u] = *(const u32x4*)(c.PROJ + ((size_t)(bgi >> 2) * SEQ + s0 + r) * IN_COLS + (kind ? C_VW : C_VS) + (bgi & 3) * 64 + seg); }
            __syncthreads();
#pragma unroll
            for (int u = 0; u < 4; ++u) *(u32x4*)((bf16_t*)lds + u * 64 * 72 + r * 72 + seg) = w[u];
            __syncthreads();
#pragma unroll
            for (int u = 0; u < 4; ++u) { const int idx = idx0 + u, kind = idx >> 10, bgi = (idx >> 6) & 15, s0 = (idx & 63) * 64;
                const bf16_t* T = (const bf16_t*)lds + u * 64 * 72;
                u32x4 o;
                o.x = (unsigned)T[(seg + 0) * 72 + r] | ((unsigned)T[(seg + 1) * 72 + r] << 16); o.y = (unsigned)T[(seg + 2) * 72 + r] | ((unsigned)T[(seg + 3) * 72 + r] << 16);
                o.z = (unsigned)T[(seg + 4) * 72 + r] | ((unsigned)T[(seg + 5) * 72 + r] << 16); o.w = (unsigned)T[(seg + 6) * 72 + r] | ((unsigned)T[(seg + 7) * 72 + r] << 16);
                *(u32x4*)(c.VT + (((size_t)kind * 16 + bgi) * 64 + r) * SEQ + s0 + seg) = o; }
        } else {
            const int t0 = item * 16, ch = tid, gi = ch >> 7, s0 = t0 & (SEQ - 1);
            float pv[31];
#pragma unroll
            for (int i = 0; i < 31; ++i) pv[i] = (s0 - 15 + i >= 0) ? bf2f(c.PROJ[(size_t)(t0 - 15 + i) * IN_COLS + C_POOL + ch]) : 0.f;
            if (gi == 0) pool_emit<2>(c, pv, t0, s0, ch);
            else if (gi == 1) pool_emit<4>(c, pv, t0, s0, ch);
            else if (gi == 2) pool_emit<8>(c, pv, t0, s0, ch);
            else pool_emit<16>(c, pv, t0, s0, ch);
        }
    }
}

DI void rwkv_finalize_item(const Ctx& c, int item) {
    const int tid = TID(), ch = tid, t0 = item * 8;
    const float* mu = c.in(I_MU) + (size_t)c.l * RWC;
    const float kkw_ = c.in(I_KK)[c.l * 512 + ch], kaw_ = c.in(I_KA)[c.l * 512 + ch], rkw_ = c.in(I_RK)[c.l * 512 + ch];
    const float mur = mu[ch], muk = mu[512 + ch], muv = mu[1024 + ch];
    bf16_t ur[9], uk[9], uv[9], ua[8];
    const bool has_prev = (t0 & (SEQ - 1)) != 0;
#pragma unroll
    for (int k = 0; k < 9; ++k) {
        ur[k] = 0; uk[k] = 0; uv[k] = 0;
        if (k > 0 || has_prev) { const bf16_t* q = c.PROJ + (size_t)(t0 - 1 + k) * IN_COLS; ur[k] = q[C_R + ch]; uk[k] = q[C_K + ch]; uv[k] = q[C_V + ch]; }
    }
#pragma unroll
    for (int k = 0; k < 8; ++k) ua[k] = c.F[(size_t)4 * NT * 512 + (size_t)(t0 + k) * 512 + ch];
#pragma unroll
    for (int k = 0; k < 8; ++k) {
        const int t = t0 + k;
        const float cr = bf2f(ur[k + 1]), ck = bf2f(uk[k + 1]), cv = bf2f(uv[k + 1]);
        const float r = cr + (bf2f(ur[k]) - cr) * mur, kx = ck + (bf2f(uk[k]) - ck) * muk, vx = cv + (bf2f(uv[k]) - cv) * muv;
        const float a = bf2f(ua[k]);
        const float kxn = kx * kkw_, kp = kx * (1.0f + (a - 1.0f) * kaw_);
        const float ss = wave_sum_dpp(kxn * kxn);
        const float inv = __builtin_amdgcn_rsqf(fmaxf(ss, 1e-24f));
        const float br = wave_sum_dpp(kxn * inv * a * r), kr = wave_sum_dpp(kp * r), bon = wave_sum_dpp(r * kp * rkw_);
        if ((tid & 63) == 0) *(f32x4*)(c.BON + ((size_t)t * 8 + (tid >> 6)) * 4) = (f32x4){inv, br, kr, bon};
        const size_t o = (size_t)t * 512 + ch;
        c.F[o] = f2bf(r); c.F[o + (size_t)NT * 512] = f2bf(kx); c.F[o + (size_t)2 * NT * 512] = f2bf(vx);
    }
}

DI void phase_poolgemm(const Ctx& c, unsigned char* lds) {
    for (int item = blockIdx.x; item < NT / 8; item += gridDim.x) rwkv_finalize_item(c, item);
    const int n_pool = (NT / 256) * 4, n_items = n_pool + 32;
    for (int item = blockIdx.x; item < n_items; item += gridDim.x) {
        f32x4 acc[4][4]; acc_zero(acc);
        if (item < n_pool) {
            const int tm = item >> 2, gi = item & 3, m0 = tm * 256;
            const ARows ar = plain_rows(c.POOLED + gi * 128, 512, m0, TID());
            gemm_core<0>(acc, ar, (const bf16_t*)(c.ws + WS_WT_POOL) + (size_t)gi * 128 * 128, 128, 128, lds);
            const float* sc = c.in(I_POOLS) + c.l * 512 + gi * 128;
            ACC_FOREACH(acc, { const f32x4 s = *(const f32x4*)(sc + c_);
                store_bf4(c.POOLED + (size_t)(m0 + r_) * 512 + gi * 128 + c_, (f32x4){v_[0] * s[0], v_[1] * s[1], v_[2] * s[2], v_[3] * s[3]}); });
        } else {
            const int it = item - n_pool, kv = it >> 4, tm = it & 15, m0 = tm * 256;
            const ARows ar = plain_rows(c.CMPH + (size_t)kv * 4096 * 256, 256, m0, TID());
            gemm_core<0>(acc, ar, (const bf16_t*)(c.ws + WS_WT_C2) + (size_t)kv * 128 * 256, 256, 256, lds);
            ACC_FOREACH(acc, { if (c_ < 64) { const int R = m0 + r_;
                if (kv == 0) store_bf4(c.KC + (size_t)R * 64 + c_, v_);
                else { bf16_t* q = c.VCT + ((size_t)(R >> 8) * 64 + c_) * 256 + (R & 255); q[0] = f2bf(v_[0]); q[256] = f2bf(v_[1]); q[512] = f2bf(v_[2]); q[768] = f2bf(v_[3]); } } });
        }
    }
}

constexpr int SCH = 32;
constexpr int SB_AN = 0, SB_WR = SCH * 64 * 4, SB_W = 2 * SCH * 64 * 4, SB_BB = 3 * SCH * 64 * 4, SB_KP = 4 * SCH * 64 * 4;
constexpr int SB_V = 5 * SCH * 64 * 4;
constexpr int SB_SC = SB_V + SCH * 16 * 4;
constexpr int SB_Y = SB_SC + SCH * 2 * 4;
constexpr int SB_BYTES = SB_Y + SCH * 16 * 4;
static_assert(2 * SB_BYTES <= LDS_BYTES - 64, "scan lds");
typedef float f32x2 __attribute__((ext_vector_type(2)));
DI float row8_sum(float v) { v += DPP_MOV(v, 0xB1); v += DPP_MOV(v, 0x4E); v += DPP_MOV(v, 0x141); return v; }

constexpr int NPW = 6, NJ = (SCH + NPW - 1) / NPW;
struct PrepRegs { bf16_t r[NJ], k[NJ], v[NJ], e[NJ], a[NJ]; float s0[NJ], s1[NJ], s2[NJ]; };
DI void prep_load(PrepRegs& R, const Ctx& c, int b, int h, int ck, int pw, int lane) {
    const size_t PL = (size_t)NT * 512;
    const size_t tb = (size_t)b * SEQ + ck * SCH;
    const size_t o0 = tb * 512 + h * 64 + lane;
#pragma unroll
    for (int j = 0; j < NJ; ++j) {
        const int st = pw + NPW * j;
        if (st < SCH) { const size_t o = o0 + (size_t)st * 512; R.r[j] = c.F[o]; R.k[j] = c.F[o + PL]; R.v[j] = c.F[o + 2 * PL]; R.e[j] = c.F[o + 3 * PL]; R.a[j] = c.F[o + 4 * PL];
            const float* sp = c.BON + ((tb + st) * 8 + h) * 4; R.s0[j] = sp[0]; R.s1[j] = sp[1]; R.s2[j] = sp[2]; }
    }
}
DI void prep_store(const PrepRegs& R, unsigned char* sb, int rq, int pw, int lane, float kkw, float kaw) {
    float* an = (float*)(sb + SB_AN); float* wr = (float*)(sb + SB_WR); float* w_ = (float*)(sb + SB_W); float* bb_ = (float*)(sb + SB_BB); float* kp_ = (float*)(sb + SB_KP);
    float* vv = (float*)(sb + SB_V); float* sc = (float*)(sb + SB_SC);
#pragma unroll
    for (int j = 0; j < NJ; ++j) {
        const int st = pw + NPW * j;
        if (st < SCH) {
            const float r = bf2f(R.r[j]), k = bf2f(R.k[j]), v = bf2f(R.v[j]), e = bf2f(R.e[j]), a = bf2f(R.a[j]);
            const float w = __expf(-e);
            const float kk = k * kkw * R.s0[j];
            const float kp = k * (1.0f + (a - 1.0f) * kaw);
            an[st * 64 + lane] = -kk; wr[st * 64 + lane] = w * r; w_[st * 64 + lane] = w; bb_[st * 64 + lane] = kk * a; kp_[st * 64 + lane] = kp;
            if ((lane >> 4) == rq) vv[st * 16 + (lane & 15)] = v;
            if (lane == 0) { sc[st * 2] = R.s1[j]; sc[st * 2 + 1] = R.s2[j]; }
        }
    }
}
DI void scan_item(const Ctx& c, int item, unsigned char* lds) {
    const int tid = TID(), lane = tid & 63, wave = tid >> 6;
    const int b = item >> 5, h = (item >> 2) & 7, rq = item & 3;
    const int chn = h * 64 + lane;
    const float kkw = c.in(I_KK)[c.l * 512 + chn], kaw = c.in(I_KA)[c.l * 512 + chn];
    const int rowl = (tid & 127) >> 3, cg = tid & 7;
    f32x2 st[4];
#pragma unroll
    for (int i = 0; i < 4; ++i) st[i] = (f32x2){0.f, 0.f};
    constexpr int NCK = SEQ / SCH;
    PrepRegs R;
    __syncthreads();
    if (wave >= 2) { prep_load(R, c, b, h, 0, wave - 2, lane); prep_store(R, lds, rq, wave - 2, lane, kkw, kaw); prep_load(R, c, b, h, 1, wave - 2, lane); }
    __syncthreads();
    for (int ck = 0; ck < NCK; ++ck) {
        unsigned char* sb = lds + (ck & 1) * SB_BYTES;
        if (wave < 2) {
            const float* an = (const float*)(sb + SB_AN) + cg * 8; const float* wr = (const float*)(sb + SB_WR) + cg * 8; const float* w_ = (const float*)(sb + SB_W) + cg * 8;
            const float* bb_ = (const float*)(sb + SB_BB) + cg * 8; const float* kp_ = (const float*)(sb + SB_KP) + cg * 8;
            const float* vv = (const float*)(sb + SB_V) + rowl; const float* sc = (const float*)(sb + SB_SC); float* yb = (float*)(sb + SB_Y) + rowl;
            f32x4 a0 = *(const f32x4*)(an), a1 = *(const f32x4*)(an + 4), r0 = *(const f32x4*)(wr), r1 = *(const f32x4*)(wr + 4);
            f32x4 w0 = *(const f32x4*)(w_), w1 = *(const f32x4*)(w_ + 4), b0 = *(const f32x4*)(bb_), b1 = *(const f32x4*)(bb_ + 4);
            f32x4 k0 = *(const f32x4*)(kp_), k1 = *(const f32x4*)(kp_ + 4);
            float v = vv[0]; f32x2 bk = *(const f32x2*)(sc);
#pragma unroll 2
            for (int s = 0; s < SCH; ++s) {
                const int sn = (s + 1 < SCH) ? s + 1 : s;
                const f32x4 na0 = *(const f32x4*)(an + sn * 64), na1 = *(const f32x4*)(an + sn * 64 + 4), nr0 = *(const f32x4*)(wr + sn * 64), nr1 = *(const f32x4*)(wr + sn * 64 + 4);
                const f32x4 nw0 = *(const f32x4*)(w_ + sn * 64), nw1 = *(const f32x4*)(w_ + sn * 64 + 4), nb0 = *(const f32x4*)(bb_ + sn * 64), nb1 = *(const f32x4*)(bb_ + sn * 64 + 4);
                const f32x4 nk0 = *(const f32x4*)(kp_ + sn * 64), nk1 = *(const f32x4*)(kp_ + sn * 64 + 4);
                const float nv = vv[sn * 16]; const f32x2 nbk = *(const f32x2*)(sc + sn * 2);
                f32x2 da = st[0] * (f32x2){a0[0], a0[1]}; f32x2 dr = st[0] * (f32x2){r0[0], r0[1]};
                da += st[1] * (f32x2){a0[2], a0[3]}; dr += st[1] * (f32x2){r0[2], r0[3]};
                da += st[2] * (f32x2){a1[0], a1[1]}; dr += st[2] * (f32x2){r1[0], r1[1]};
                da += st[3] * (f32x2){a1[2], a1[3]}; dr += st[3] * (f32x2){r1[2], r1[3]};
                float sa = da[0] + da[1], sr = dr[0] + dr[1];
                sa += DPP_MOV(sa, 0xB1); sr += DPP_MOV(sr, 0xB1);
                sa += DPP_MOV(sa, 0x4E); sr += DPP_MOV(sr, 0x4E);
                sa += DPP_MOV(sa, 0x141); sr += DPP_MOV(sr, 0x141);
                const f32x2 sa2 = (f32x2){sa, sa}, v2 = (f32x2){v, v};
                st[0] = st[0] * (f32x2){w0[0], w0[1]} + sa2 * (f32x2){b0[0], b0[1]} + v2 * (f32x2){k0[0], k0[1]};
                st[1] = st[1] * (f32x2){w0[2], w0[3]} + sa2 * (f32x2){b0[2], b0[3]} + v2 * (f32x2){k0[2], k0[3]};
                st[2] = st[2] * (f32x2){w1[0], w1[1]} + sa2 * (f32x2){b1[0], b1[1]} + v2 * (f32x2){k1[0], k1[1]};
                st[3] = st[3] * (f32x2){w1[2], w1[3]} + sa2 * (f32x2){b1[2], b1[3]} + v2 * (f32x2){k1[2], k1[3]};
                yb[s * 16] = sr + sa * bk[0] + v * bk[1];
                a0 = na0; a1 = na1; r0 = nr0; r1 = nr1; w0 = nw0; w1 = nw1; b0 = nb0; b1 = nb1; k0 = nk0; k1 = nk1; v = nv; bk = nbk;
            }
        } else {
            const int pt = tid - 128;
            if (ck + 1 < NCK) prep_store(R, lds + ((ck + 1) & 1) * SB_BYTES, rq, wave - 2, lane, kkw, kaw);
            if (ck + 2 < NCK) prep_load(R, c, b, h, ck + 2, wave - 2, lane);
            if (ck > 0) {
                const float* yb = (const float*)(lds + ((ck - 1) & 1) * SB_BYTES + SB_Y);
                for (int idx = pt; idx < SCH * 16; idx += 384) {
                    const int s = idx >> 4, j = idx & 15;
                    c.YRAW[((size_t)b * SEQ + (ck - 1) * SCH + s) * 512 + h * 64 + rq * 16 + j] = f2bf(yb[idx]);
                }
            }
        }
        asm volatile("s_waitcnt lgkmcnt(0)" ::: "memory"); __builtin_amdgcn_s_barrier(); asm volatile("" ::: "memory");
    }
    {
        const float* yb = (const float*)(lds + ((NCK - 1) & 1) * SB_BYTES + SB_Y);
        for (int idx = tid; idx < SCH * 16; idx += NTHREADS) {
            const int s = idx >> 4, j = idx & 15;
            c.YRAW[((size_t)b * SEQ + (NCK - 1) * SCH + s) * 512 + h * 64 + rq * 16 + j] = f2bf(yb[idx]);
        }
    }
    __syncthreads();
}
DI void phase_rwkv_post(const Ctx& c, unsigned char* lds) {
    const int tid = TID(), lane = tid & 63, wave = tid >> 6;
    const size_t PL = (size_t)NT * 512;
    for (int t = blockIdx.x * 8 + wave; t < NT; t += gridDim.x * 8) {
        bf16_t ry[8], rv[8], rg[8]; float bon[8], gw[8], gb[8];
#pragma unroll
        for (int h = 0; h < 8; ++h) { const size_t o = (size_t)t * 512 + h * 64 + lane; ry[h] = c.YRAW[o]; rv[h] = c.F[o + 2 * PL]; rg[h] = c.F[o + 5 * PL]; bon[h] = c.BON[((size_t)t * 8 + h) * 4 + 3];
            gw[h] = c.in(I_GNW)[c.l * 512 + h * 64 + lane]; gb[h] = c.in(I_GNB)[c.l * 512 + h * 64 + lane]; }
#pragma unroll
        for (int h = 0; h < 8; ++h) {
            const float y = bf2f(ry[h]);
            const float mean = wave_sum_dpp(y) * (1.0f / 64.0f);
            const float d = y - mean;
            const float var = wave_sum_dpp(d * d) * (1.0f / 64.0f);
            const float yn = d * rsqrtf(var + 64e-5f) * gw[h] + gb[h];
            c.F[(size_t)t * 512 + h * 64 + lane + 5 * PL] = f2bf((yn + bon[h] * bf2f(rv[h])) * bf2f(rg[h]));
        }
    }
    for (int it = blockIdx.x * 4; it < 768 + 128 + 128 + 256 + 256; it += gridDim.x * 4) {
        const float* WB = c.in(I_WBR) + (size_t)c.l * 2048 * DM; bf16_t* BR = (bf16_t*)(c.ws + WS_WT_BR);
        if (it < 768) convert_tile4(c.in(I_WMG) + (size_t)c.l * DM * 3 * DM, 3 * DM, 3 * DM, DM, (bf16_t*)(c.ws + WS_WT_MG), it, lds);
        else if (it < 896) convert_tile4(WB, DM, DM, 512, BR, it - 768, lds);
        else if (it < 1024) convert_tile4(WB + (size_t)512 * DM, DM, DM, 512, BR + (size_t)1024 * 512, it - 896, lds);
        else if (it < 1280) convert_tile4(WB + (size_t)1024 * DM, DM, DM, 1024, BR + (size_t)2048 * 512, it - 1024, lds);
        else convert_tile4(c.in(I_WOUT) + (size_t)c.l * DM * DM, DM, DM, DM, (bf16_t*)(c.ws + WS_WT_OUT), it - 1280, lds);
    }
}
constexpr int TS = 72;
constexpr int NSA_BIAS = 0;
constexpr int NSA_SELM = 2112;
constexpr int NSA_SCR = 2624;
constexpr int NSA_K0 = 4672;
constexpr int NSA_V0 = NSA_K0 + 2 * 64 * TS * 2;
constexpr int NSA_A = NSA_V0 + 2 * 64 * TS * 2;
constexpr int NSA_B = NSA_A + 16384;
constexpr int NSA_END = NSA_B + 16384;
static_assert(NSA_END <= LDS_BYTES - 16, "nsa lds");
static_assert(NSA_K0 % 16 == 0, "align");

struct NsaLane { int tq[2]; int h; float cbias; float m[2], l[2]; };

DI void nsa_prefetch(u32x4& rk, u32x4& rv, const bf16_t* kbase, int kstride, const bf16_t* vtbase, int vstride, int pos0, int tid) {
    const int r = tid >> 3, seg = (tid & 7) * 8;
    rk = *(const u32x4*)(kbase + (size_t)(pos0 + r) * kstride + seg);
    rv = *(const u32x4*)(vtbase + (size_t)r * vstride + pos0 + seg);
}
DI void nsa_store(unsigned char* lds, int buf, const u32x4& rk, const u32x4& rv, int tid) {
    const int r = tid >> 3, seg = (tid & 7) * 8;
    *(u32x4*)((bf16_t*)(lds + NSA_K0) + buf * 64 * TS + r * TS + seg) = rk;
    *(u32x4*)((bf16_t*)(lds + NSA_V0) + buf * 64 * TS + r * TS + seg) = rv;
}
template <int QM = 3>
DI void nsa_qk(f32x4 (&s)[2][4], const bf16_t* sK, const bf16x8 (&qf)[2][2], int lane) {
#pragma unroll
    for (int kt = 0; kt < 4; ++kt) {
#pragma unroll
        for (int ks = 0; ks < 2; ++ks) {
            const bf16x8 kf = *(const bf16x8*)(sK + (16 * kt + (lane & 15)) * TS + 32 * ks + (lane >> 4) * 8);
#pragma unroll
            for (int qi = 0; qi < 2; ++qi) if ((QM >> qi) & 1) s[qi][kt] = __builtin_amdgcn_mfma_f32_16x16x32_bf16(kf, qf[qi][ks], (ks == 0) ? (f32x4){0.f, 0.f, 0.f, 0.f} : s[qi][kt], 0, 0, 0);
        }
    }
}
template <int MODE>
DI void nsa_logits(float (&x)[4][4], const f32x4 (&s)[4], int tq, int h, float cbias, bool rowsel, int pos0, int qd, const float* biasT) {
#pragma unroll
    for (int kt = 0; kt < 4; ++kt)
#pragma unroll
        for (int i = 0; i < 4; ++i) {
            const int kk = pos0 + 16 * kt + 4 * qd + i;
            if (MODE == 1) { x[kt][i] = rowsel ? s[kt][i] + cbias : -INFINITY; }
            else {
                const int dist = (MODE == 0) ? (tq - 16 * kk - 31) : (tq - kk);
                bool ok = dist >= 0;
                if (MODE == 2) ok = ok && rowsel;
                if (MODE == 3) ok = ok && (dist < 512);
                const int di = dist < 0 ? 0 : (dist > 128 ? 128 : dist);
                float bias = biasT[di * 4 + h];
                asm volatile("" : "+v"(bias));
                x[kt][i] = ok ? s[kt][i] + bias : -INFINITY;
            }
        }
}
DI float quad16_max(float v) { v = fmaxf(v, __shfl_xor(v, 16)); v = fmaxf(v, __shfl_xor(v, 32)); return v; }
DI float quad16_sum(float v) { v += __shfl_xor(v, 16); v += __shfl_xor(v, 32); return v; }
DI void nsa_softmax(const float (&x)[4][4], float& m, float& l, f32x4 (&O)[4], bf16x8 (&pf)[2]) {
    float mx = -INFINITY;
#pragma unroll
    for (int kt = 0; kt < 4; ++kt)
#pragma unroll
        for (int i = 0; i < 4; ++i) mx = fmaxf(mx, x[kt][i]);
    mx = quad16_max(mx);
    const float mn = fmaxf(m, mx);
    const float mu = (mn == -INFINITY) ? 0.f : mn;
    const float mu2 = mu * 1.4426950408889634f;
    const float sc = __builtin_amdgcn_exp2f(__builtin_fmaf(m, 1.4426950408889634f, -mu2));
    float p[4][4]; float ps = 0.f;
#pragma unroll
    for (int kt = 0; kt < 4; ++kt)
#pragma unroll
        for (int i = 0; i < 4; ++i) { p[kt][i] = __builtin_amdgcn_exp2f(__builtin_fmaf(x[kt][i], 1.4426950408889634f, -mu2)); ps += p[kt][i]; }
    l = l * sc + ps; m = mn;
#pragma unroll
    for (int dt = 0; dt < 4; ++dt) O[dt] = O[dt] * sc;
#pragma unroll
    for (int ks = 0; ks < 2; ++ks) {
        u32x4 w; w.x = pack2(p[2 * ks][0], p[2 * ks][1]); w.y = pack2(p[2 * ks][2], p[2 * ks][3]); w.z = pack2(p[2 * ks + 1][0], p[2 * ks + 1][1]); w.w = pack2(p[2 * ks + 1][2], p[2 * ks + 1][3]);
        pf[ks] = __builtin_bit_cast(bf16x8, w);
    }
}
template <int QM = 3>
DI void nsa_pv(f32x4 (&O)[2][4], const bf16_t* sV, const bf16x8 (&pf)[2][2], int lane) {
    const int qd = lane >> 4;
#pragma unroll
    for (int dt = 0; dt < 4; ++dt)
#pragma unroll
        for (int ks = 0; ks < 2; ++ks) {
            const bf16_t* vp = sV + (16 * dt + (lane & 15)) * TS + 32 * ks + 4 * qd;
            const u32x2 a = *(const u32x2*)vp, b = *(const u32x2*)(vp + 16);
            u32x4 w; w.x = a.x; w.y = a.y; w.z = b.x; w.w = b.y;
            const bf16x8 vf = __builtin_bit_cast(bf16x8, w);
#pragma unroll
            for (int qi = 0; qi < 2; ++qi) if ((QM >> qi) & 1) O[qi][dt] = __builtin_amdgcn_mfma_f32_16x16x32_bf16(vf, pf[qi][ks], O[qi][dt], 0, 0, 0);
        }
}
template <int MODE, int QM = 3>
DI void nsa_tile(f32x4 (&O)[2][4], NsaLane& L, const bf16x8 (&qf)[2][2], const unsigned char* lds, int buf, int pos0, bool sel0, bool sel1, int lane) {
    const bf16_t* sK = (const bf16_t*)(lds + NSA_K0) + buf * 64 * TS;
    const bf16_t* sV = (const bf16_t*)(lds + NSA_V0) + buf * 64 * TS;
    const float* biasT = (const float*)(lds + NSA_BIAS);
    f32x4 s[2][4];
    nsa_qk<QM>(s, sK, qf, lane);
    bf16x8 pf[2][2];
#pragma unroll
    for (int qi = 0; qi < 2; ++qi) if ((QM >> qi) & 1) {
        float x[4][4];
        nsa_logits<MODE>(x, s[qi], L.tq[qi], L.h, L.cbias, qi ? sel1 : sel0, pos0, lane >> 4, biasT);
        nsa_softmax(x, L.m[qi], L.l[qi], O[qi], pf[qi]);
    }
    nsa_pv<QM>(O, sV, pf, lane);
}
template <int MODE>
DI void nsa_tile_sel(f32x4 (&O)[2][4], NsaLane& L, const bf16x8 (&qf)[2][2], const unsigned char* lds, int buf, int pos0, bool sel0, bool sel1, int lane) {
    const bool a0 = __ballot(sel0) != 0ull, a1 = __ballot(sel1) != 0ull;
    if (a0 && a1) nsa_tile<MODE, 3>(O, L, qf, lds, buf, pos0, sel0, sel1, lane);
    else if (a0) nsa_tile<MODE, 1>(O, L, qf, lds, buf, pos0, sel0, sel1, lane);
    else if (a1) nsa_tile<MODE, 2>(O, L, qf, lds, buf, pos0, sel0, sel1, lane);
}
DI void nsa_flush(f32x4 (&Y)[2][4], f32x4 (&O)[2][4], NsaLane& L, const float (&gate)[2]) {
#pragma unroll
    for (int qi = 0; qi < 2; ++qi) {
        const float lt = quad16_sum(L.l[qi]);
        const float f = (lt > 0.f) ? gate[qi] * __builtin_amdgcn_rcpf(lt) : 0.f;
#pragma unroll
        for (int dt = 0; dt < 4; ++dt) { Y[qi][dt] += O[qi][dt] * f; O[qi][dt] = (f32x4){0.f, 0.f, 0.f, 0.f}; }
    }
}
DI void nsa_item(const Ctx& c, int item, unsigned char* lds) {
    const int tid = TID(), lane = tid & 63, wave = tid >> 6, qd = lane >> 4;
    const int b = item >> 8, g = (item >> 6) & 3, qt = item & 63, t0 = qt * 64, cur = qt, bg = b * 4 + g;
    float* biasT = (float*)(lds + NSA_BIAS);
    unsigned long long* selm = (unsigned long long*)(lds + NSA_SELM);
    float* scr = (float*)(lds + NSA_SCR) + wave * 64;
    float* impA = (float*)(lds + NSA_A); float* impB = (float*)(lds + NSA_B);
    __syncthreads();
    for (int i = tid; i < 129 * 4; i += NTHREADS) { const int d = i >> 2, h = i & 3; biasT[i] = c.in(I_RELB)[t5_bucket(d) * 16 + g * 4 + h]; }
    for (int i = tid; i < 2 * 4096; i += NTHREADS) impA[i] = 0.f;
    NsaLane L; L.h = lane & 3;
    bf16x8 qf[2][2]; float gates[2][3];
    const bf16_t* pbat = c.PROJ + (size_t)b * SEQ * IN_COLS;
#pragma unroll
    for (int qi = 0; qi < 2; ++qi) {
        const int tl = 8 * wave + 4 * qi + ((lane & 15) >> 2);
        L.tq[qi] = t0 + tl;
        const bf16_t* prow = pbat + (size_t)L.tq[qi] * IN_COLS;
#pragma unroll
        for (int ks = 0; ks < 2; ++ks) {
            u32x4 w = *(const u32x4*)(prow + C_Q + (g * 4 + L.h) * 64 + 32 * ks + qd * 8);
            w.x = pack2(bflo(w.x) * 0.125f, bfhi(w.x) * 0.125f); w.y = pack2(bflo(w.y) * 0.125f, bfhi(w.y) * 0.125f);
            w.z = pack2(bflo(w.z) * 0.125f, bfhi(w.z) * 0.125f); w.w = pack2(bflo(w.w) * 0.125f, bfhi(w.w) * 0.125f);
            qf[qi][ks] = __builtin_bit_cast(bf16x8, w);
        }
#pragma unroll
        for (int br = 0; br < 3; ++br) gates[qi][br] = sigmoidf_(bf2f(prow[C_GATE + g * 12 + L.h * 3 + br]));
    }
    __syncthreads();
    L.cbias = biasT[128 * 4 + L.h];
    f32x4 O[2][4], Y[2][4];
#pragma unroll
    for (int qi = 0; qi < 2; ++qi)
#pragma unroll
        for (int dt = 0; dt < 4; ++dt) { O[qi][dt] = (f32x4){0.f, 0.f, 0.f, 0.f}; Y[qi][dt] = (f32x4){0.f, 0.f, 0.f, 0.f}; }
    u32x4 rk, rv;
    const int nvis_max = (t0 + 63 >= 31) ? ((t0 + 63 - 31) >> 4) + 1 : 0;
    const int ncb = (nvis_max + 63) >> 6;
    const bf16_t* kcb = c.KC + (size_t)bg * 256 * 64; const bf16_t* vcb = c.VCT + (size_t)bg * 64 * 256;
    L.m[0] = L.m[1] = -INFINITY; L.l[0] = L.l[1] = 0.f;
    if (ncb > 0) nsa_prefetch(rk, rv, kcb, 64, vcb, 256, 0, tid);
    for (int cb = 0; cb < ncb; ++cb) {
        nsa_store(lds, cb & 1, rk, rv, tid);
        __syncthreads();
        if (cb + 1 < ncb) nsa_prefetch(rk, rv, kcb, 64, vcb, 256, (cb + 1) * 64, tid);
        if (16 * (cb * 64 + 63) + 31 + 128 <= t0) nsa_tile<1>(O, L, qf, lds, cb & 1, cb * 64, true, true, lane);
        else nsa_tile<0>(O, L, qf, lds, cb & 1, cb * 64, true, true, lane);
    }
    if (ncb > 0) nsa_prefetch(rk, rv, kcb, 64, vcb, 256, 0, tid);
    float mfin[2], linv[2];
#pragma unroll
    for (int qi = 0; qi < 2; ++qi) { mfin[qi] = L.m[qi]; const float lt = quad16_sum(L.l[qi]); linv[qi] = (lt > 0.f) ? __builtin_amdgcn_rcpf(lt) : 0.f; }
    { const float gg[2] = {gates[0][0], gates[1][0]}; nsa_flush(Y, O, L, gg); }
    __syncthreads();
    for (int cb = 0; cb < ncb; ++cb) {
        nsa_store(lds, cb & 1, rk, rv, tid);
        __syncthreads();
        if (cb + 1 < ncb) nsa_prefetch(rk, rv, kcb, 64, vcb, 256, (cb + 1) * 64, tid);
        const bf16_t* sK = (const bf16_t*)(lds + NSA_K0) + (cb & 1) * 64 * TS;
        f32x4 s[2][4];
        nsa_qk(s, sK, qf, lane);
#pragma unroll
        for (int qi = 0; qi < 2; ++qi) {
            float x[4][4];
            nsa_logits<0>(x, s[qi], L.tq[qi], L.h, L.cbias, true, cb * 64, qd, biasT);
            const float mu = (mfin[qi] == -INFINITY) ? 0.f : mfin[qi];
#pragma unroll
            for (int kt = 0; kt < 4; ++kt) {
                float p3 = __expf(x[kt][3] - mu) * linv[qi];
                float pa = (__expf(x[kt][0] - mu) + __expf(x[kt][1] - mu) + __expf(x[kt][2] - mu)) * linv[qi] + p3;
                pa += __shfl_xor(pa, 1); p3 += __shfl_xor(p3, 1);
                pa += __shfl_xor(pa, 2); p3 += __shfl_xor(p3, 2);
                if (L.h == 0) { const int tl = 8 * wave + 4 * qi + ((lane & 15) >> 2), mi = 16 * cb + 4 * kt + qd; impA[tl * 64 + mi] = pa; impB[tl * 64 + mi] = p3; }
            }
        }
    }
    const bf16_t* ksb = pbat + C_KS + g * 64; const bf16_t* vsb = c.VT + ((size_t)0 * 16 + bg) * 64 * SEQ;
    nsa_prefetch(rk, rv, ksb, IN_COLS, vsb, SEQ, 0, tid);
    __syncthreads();
    for (int tl8 = 0; tl8 < 8; ++tl8) {
        const int tl = 8 * wave + tl8, n = lane;
        const bool cand = (n >= 1) && (n <= cur - 2);
        const float imp = cand ? impA[tl * 64 + n] + impB[tl * 64 + n - 1] : -1.0f;
        LDS_WAVE_SYNC();
        scr[n] = imp;
        LDS_WAVE_SYNC();
        int rank = 0;
#pragma unroll 4
        for (int q4 = 0; q4 < 16; ++q4) {
            const f32x4 o = *(const f32x4*)(scr + q4 * 4);
#pragma unroll
            for (int j = 0; j < 4; ++j) { const int n2 = q4 * 4 + j; rank += (o[j] > imp || (o[j] == imp && n2 < n)) ? 1 : 0; }
        }
        const bool forced = (n <= cur) && (n == 0 || n == cur || n == cur - 1);
        const unsigned long long msk = __ballot((cand && rank < 5) || forced);
        if (lane == 0) selm[tl] = msk;
    }
    __syncthreads();
    unsigned long long uni = selm[lane];
#pragma unroll
    for (int o = 32; o >= 1; o >>= 1) { const unsigned lo_ = __shfl_xor((unsigned)uni, o), hi_ = __shfl_xor((unsigned)(uni >> 32), o); uni |= ((unsigned long long)hi_ << 32) | lo_; }
    uni = ((unsigned long long)__builtin_amdgcn_readfirstlane((unsigned)(uni >> 32)) << 32) | (unsigned)__builtin_amdgcn_readfirstlane((unsigned)uni);
    unsigned long long sm[2];
#pragma unroll
    for (int qi = 0; qi < 2; ++qi) sm[qi] = selm[8 * wave + 4 * qi + ((lane & 15) >> 2)];
    L.m[0] = L.m[1] = -INFINITY; L.l[0] = L.l[1] = 0.f;
    {
        unsigned long long rem = uni; int it = 0;
        int j = (int)__builtin_ctzll(rem); rem &= rem - 1;
        for (;;) {
            nsa_store(lds, it & 1, rk, rv, tid);
            __syncthreads();
            const int jn = rem ? (int)__builtin_ctzll(rem) : -1;
            if (jn >= 0) { rem &= rem - 1; nsa_prefetch(rk, rv, ksb, IN_COLS, vsb, SEQ, jn * 64, tid); }
            const bool s0 = (sm[0] >> j) & 1ull, s1 = (sm[1] >> j) & 1ull;
            if (j <= cur - 3) nsa_tile_sel<1>(O, L, qf, lds, it & 1, j * 64, s0, s1, lane);
            else nsa_tile_sel<2>(O, L, qf, lds, it & 1, j * 64, s0, s1, lane);
            if (jn < 0) break;
            j = jn; ++it;
        }
    }
    const bf16_t* kwb = pbat + C_KW + g * 64; const bf16_t* vwb = c.VT + ((size_t)1 * 16 + bg) * 64 * SEQ;
    const int j0 = (cur - 8 > 0) ? cur - 8 : 0;
    nsa_prefetch(rk, rv, kwb, IN_COLS, vwb, SEQ, j0 * 64, tid);
    { const float gg[2] = {gates[0][1], gates[1][1]}; nsa_flush(Y, O, L, gg); }
    L.m[0] = L.m[1] = -INFINITY; L.l[0] = L.l[1] = 0.f;
    {
        __syncthreads();
        for (int j = j0; j <= cur; ++j) {
            nsa_store(lds, (j - j0) & 1, rk, rv, tid);
            __syncthreads();
            if (j + 1 <= cur) nsa_prefetch(rk, rv, kwb, IN_COLS, vwb, SEQ, (j + 1) * 64, tid);
            if (cur - j >= 3 && cur - j <= 7) nsa_tile<1>(O, L, qf, lds, (j - j0) & 1, j * 64, true, true, lane);
            else nsa_tile<3>(O, L, qf, lds, (j - j0) & 1, j * 64, true, true, lane);
        }
    }
    { const float gg[2] = {gates[0][2], gates[1][2]}; nsa_flush(Y, O, L, gg); }
#pragma unroll
    for (int qi = 0; qi < 2; ++qi) {
        bf16_t* yrow = c.PROJ + ((size_t)b * SEQ + L.tq[qi]) * IN_COLS + C_Q + (g * 4 + L.h) * 64;
#pragma unroll
        for (int dt = 0; dt < 4; ++dt) store_bf4(yrow + 16 * dt + 4 * qd, Y[qi][dt]);
    }
}
DI void phase_mix(const Ctx& c, unsigned char* lds) {
    const int G = gridDim.x, bid = blockIdx.x;
    const int n_nsa = NB * 4 * (SEQ / 64), n_scan = NB * 8 * 4;
    const bool split = G >= 2 * n_scan;
    if (split) { if (bid < n_scan) scan_item(c, bid, lds); }
    else for (int item = bid; item < n_scan; item += G) scan_item(c, item, lds);
    unsigned* ctr = c.ctl + CW_Q + c.l;
    volatile int* sitem = (volatile int*)(lds + LDS_BYTES - 32);
    for (;;) {
        __syncthreads();
        if (TID() == 0) *sitem = (int)atomicAdd(ctr, 1u);
        __syncthreads();
        const int k = *sitem;
        if (k >= n_nsa) break;
        const int qt = 63 - (k >> 4), bgi = k & 15;
        nsa_item(c, (bgi << 6) | qt, lds);
    }
}

DI void phase_merge(const Ctx& c, unsigned char* lds) {
    const int nN = DM / 256;
    const bf16_t* WM = (const bf16_t*)(c.ws + WS_WT_MG);
    const bf16_t* BR = (const bf16_t*)(c.ws + WS_WT_BR);
    const float* BM_ = c.in(I_BMG) + (size_t)c.l * 3 * DM;
    bf16_t* TMP = c.F + (size_t)2 * NT * 512 + (size_t)blockIdx.x * 256 * 256;
    for (int it = 0;; ++it) {
        int tm, tn; if (!xcd_unit(it, nN, tm, tn)) break;
        const int m0 = tm * 256, n0 = tn * 256;
#pragma unroll 1
        for (int i = 0; i < 3; ++i) {
            f32x4 acc[8][4];
#pragma unroll
            for (int a_ = 0; a_ < 8; ++a_)
#pragma unroll
                for (int b_ = 0; b_ < 4; ++b_) acc[a_][b_] = (f32x4){0.f, 0.f, 0.f, 0.f};
            gemm256_dma(acc, c.H + (size_t)m0 * DM, DM, WM + (size_t)(i * DM + n0) * DM, DM, DM, lds);
            tile256_store_bf16(acc, TMP, 256, 256, lds);
#pragma unroll
            for (int a_ = 0; a_ < 8; ++a_)
#pragma unroll
                for (int b_ = 0; b_ < 4; ++b_) acc[a_][b_] = (f32x4){0.f, 0.f, 0.f, 0.f};
            {
                const bf16_t* Ab = (i == 0) ? c.POOLED + (size_t)m0 * 512 : ((i == 1) ? c.F + (size_t)5 * NT * 512 + (size_t)m0 * 512 : c.PROJ + C_Q + (size_t)m0 * IN_COLS);
                const size_t la = (i == 2) ? (size_t)IN_COLS : (size_t)512;
                const int Kb = (i == 2) ? 1024 : 512;
                gemm256_dma(acc, Ab, la, BR + (size_t)i * 1024 * 512 + (size_t)n0 * Kb, (size_t)Kb, Kb, lds);
            }
            const int lane = TID() & 63, wave = TID() >> 6, wm = wave >> 2, wn = wave & 3;
            const float* bias = BM_ + i * DM + n0 + wn * 64 + (lane >> 4) * 4;
#pragma unroll
            for (int mi = 0; mi < 8; ++mi) {
#pragma unroll
                for (int ni = 0; ni < 4; ++ni) {
                    const int r = wm * 128 + mi * 16 + (lane & 15), cc = wn * 64 + ni * 16 + (lane >> 4) * 4;
                    bf16_t* q = c.MERGED + (size_t)(m0 + r) * DM + n0 + cc;
                    const u32x2 gv = *(const u32x2*)(TMP + r * 256 + cc);
                    const f32x4 bb = *(const f32x4*)(bias + ni * 16);
                    f32x4 m4 = (f32x4){0.f, 0.f, 0.f, 0.f};
                    if (i > 0) { const u32x2 pv = *(const u32x2*)q; m4 = (f32x4){bflo(pv.x), bfhi(pv.x), bflo(pv.y), bfhi(pv.y)}; }
                    m4[0] += sigmoidf_(bflo(gv.x) + bb[0]) * acc[mi][ni][0]; m4[1] += sigmoidf_(bfhi(gv.x) + bb[1]) * acc[mi][ni][1];
                    m4[2] += sigmoidf_(bflo(gv.y) + bb[2]) * acc[mi][ni][2]; m4[3] += sigmoidf_(bfhi(gv.y) + bb[3]) * acc[mi][ni][3];
                    store_bf4(q, m4);
                }
                asm volatile("" ::: "memory"); __builtin_amdgcn_sched_barrier(0);
            }
        }
    }
}

DI void phase_outp(const Ctx& c, unsigned char* lds) {
    const int nN = DM / 256;
    const bf16_t* W = (const bf16_t*)(c.ws + WS_WT_OUT);
    const float* xin = (c.l == 0) ? c.in(I_X) : c.out;
    for (int it = 0;; ++it) {
        int tm, tn; if (!xcd_unit(it, nN, tm, tn)) break;
        const int m0 = tm * 256, n0 = tn * 256;
        f32x4 acc[8][4];
#pragma unroll
        for (int i = 0; i < 8; ++i)
#pragma unroll
            for (int j = 0; j < 4; ++j) acc[i][j] = (f32x4){0.f, 0.f, 0.f, 0.f};
        gemm256_dma(acc, c.MERGED + (size_t)m0 * DM, DM, W + (size_t)n0 * DM, DM, DM, lds);
        const int lane = TID() & 63, wave = TID() >> 6, wm = wave >> 2, wn = wave & 3;
#pragma unroll
        for (int mi = 0; mi < 8; ++mi)
#pragma unroll
            for (int ni = 0; ni < 4; ++ni) {
                const size_t o = (size_t)(m0 + wm * 128 + mi * 16 + (lane & 15)) * DM + n0 + wn * 64 + ni * 16 + (lane >> 4) * 4;
                const f32x4 x = *(const f32x4*)(xin + o); *(f32x4*)(c.out + o) = x + acc[mi][ni];
            }
    }
    for (int it = blockIdx.x * 4; it < 3 * 32 * 64; it += gridDim.x * 4) {
        const int mat = it / 2048, e = (it >> 6) & 31, tl = it & 63;
        if (mat == 0) convert_tile4(c.in(I_EG) + ((size_t)c.l * 32 + e) * DM * 256, 256, 256, DM, (bf16_t*)(c.ws + WS_EG) + (size_t)e * 256 * DM, tl, lds);
        else if (mat == 1) convert_tile4(c.in(I_EU) + ((size_t)c.l * 32 + e) * DM * 256, 256, 256, DM, (bf16_t*)(c.ws + WS_EU) + (size_t)e * 256 * DM, tl, lds);
        else convert_tile4(c.in(I_ED) + ((size_t)c.l * 32 + e) * 256 * DM, DM, DM, 256, (bf16_t*)(c.ws + WS_ED) + (size_t)e * DM * 256, tl, lds);
    }
}

DI void phase_norm2(const Ctx& c, unsigned char* lds) {
    const int tid = TID(), lane = tid & 63, wave = tid >> 6;
    const float* gain = c.in(I_NFFN) + c.l * DM;
    const float* wrg = c.in(I_WRG) + (size_t)c.l * DM * 4; const float* brg = c.in(I_BRG) + c.l * 4;
    const float* wre = c.in(I_WRE) + (size_t)c.l * DM * 32; const float* bre = c.in(I_BRE) + c.l * 32;
    unsigned* cnt = c.ctl + CW_CNT + c.l * 32;
    float* lg = (float*)lds + wave * 16 * 48;
    if (wave < 4)
    for (int rt = blockIdx.x * 4 + wave; rt < NT / 16; rt += gridDim.x * 4) {
        const int r0 = rt * 16;
        float my_rs = 0.f;
#pragma unroll 2
        for (int rr = 0; rr < 16; ++rr) {
            const size_t ro = (size_t)(r0 + rr) * DM;
            f32x4 v[4]; float ss = 0.f;
#pragma unroll
            for (int i = 0; i < 4; ++i) { v[i] = *(const f32x4*)(c.out + ro + i * 256 + lane * 4); ss += v[i][0] * v[i][0] + v[i][1] * v[i][1] + v[i][2] * v[i][2] + v[i][3] * v[i][3]; }
            ss = wave_sum_dpp(ss);
            const float rs = rsqrtf(ss * (1.0f / DM) + 1e-6f);
            if ((lane & 15) == rr) my_rs = rs;
#pragma unroll
            for (int i = 0; i < 4; ++i) {
                const f32x4 g = *(const f32x4*)(gain + i * 256 + lane * 4);
                store_bf4(c.H + ro + i * 256 + lane * 4, (f32x4){v[i][0] * rs * g[0], v[i][1] * rs * g[1], v[i][2] * rs * g[2], v[i][3] * rs * g[3]});
            }
        }
        f32x4 acc0 = (f32x4){0.f, 0.f, 0.f, 0.f}, acc1 = acc0, acc2 = acc0;
        const float* xr = c.out + (size_t)(r0 + (lane & 15)) * DM + 4 * (lane >> 4);
        const int cl = lane & 15;
#pragma unroll 2
        for (int kb = 0; kb < 64; ++kb) {
            const f32x4 xa = *(const f32x4*)(xr + kb * 16);
            const f32x4 ga = *(const f32x4*)(gain + kb * 16 + 4 * (lane >> 4));
            const int k0 = kb * 16 + 4 * (lane >> 4);
            float b0[4], b1[4], b2[4];
#pragma unroll
            for (int m = 0; m < 4; ++m) { b0[m] = wre[(size_t)(k0 + m) * 32 + cl]; b1[m] = wre[(size_t)(k0 + m) * 32 + 16 + cl]; b2[m] = (cl < 4) ? wrg[(size_t)(k0 + m) * 4 + cl] : 0.f; }
#pragma unroll
            for (int m = 0; m < 4; ++m) {
                const float am = xa[m] * ga[m] * my_rs;
                acc0 = __builtin_amdgcn_mfma_f32_16x16x4f32(am, b0[m], acc0, 0, 0, 0);
                acc1 = __builtin_amdgcn_mfma_f32_16x16x4f32(am, b1[m], acc1, 0, 0, 0);
                acc2 = __builtin_amdgcn_mfma_f32_16x16x4f32(am, b2[m], acc2, 0, 0, 0);
            }
        }
        LDS_WAVE_SYNC();
#pragma unroll
        for (int i = 0; i < 4; ++i) { const int row = 4 * (lane >> 4) + i; lg[row * 48 + cl] = acc0[i]; lg[row * 48 + 16 + cl] = acc1[i]; lg[row * 48 + 32 + cl] = acc2[i]; }
        LDS_WAVE_SYNC();
        if (lane < 16) {
            const float* L = lg + lane * 48;
            float lgp[4];
#pragma unroll
            for (int o = 0; o < 4; ++o) lgp[o] = L[32 + o] + brg[o];
            int grp = 0; float gm = lgp[0];
#pragma unroll
            for (int o = 1; o < 4; ++o) if (lgp[o] > gm) { gm = lgp[o]; grp = o; }
            float gs = 0.f;
#pragma unroll
            for (int o = 0; o < 4; ++o) gs += __expf(lgp[o] - gm);
            const float ptop = 1.0f / gs;
            int i0 = 0; float v0 = -INFINITY; int i1 = 0; float v1 = -INFINITY;
            for (int o = 0; o < 8; ++o) { const float le = L[grp * 8 + o] + bre[grp * 8 + o]; if (le > v0) { v1 = v0; i1 = i0; v0 = le; i0 = o; } else if (le > v1) { v1 = le; i1 = o; } }
            const float e1 = __expf(v1 - v0), inv = 1.0f / (1.0f + e1);
            int* rt_ = c.ROUTE + (size_t)(r0 + lane) * 8;
            const int ex0 = grp * 8 + i0, ex1 = grp * 8 + i1;
            const float w0_ = inv * ptop, w1_ = e1 * inv * ptop;
            const int q0 = (int)atomicAdd(cnt + ex0, 1u), q1 = (int)atomicAdd(cnt + ex1, 1u);
            rt_[0] = ex0; rt_[1] = ex1; ((float*)rt_)[2] = w0_; ((float*)rt_)[3] = w1_; rt_[4] = q0; rt_[5] = q1;
            int* e0p = c.ENT + ((size_t)ex0 * NT + q0) * 2; e0p[0] = r0 + lane; ((float*)e0p)[1] = w0_;
            int* e1p = c.ENT + ((size_t)ex1 * NT + q1) * 2; e1p[0] = r0 + lane; ((float*)e1p)[1] = w1_;
        }
    }
}
DI void moe_tables(const Ctx& c, int* soff, int* stile, int ncol) {
    const unsigned* cnt = c.ctl + CW_CNT + c.l * 32;
    __syncthreads();
    if (TID() == 0) { int s = 0, tt = 0; for (int e = 0; e < 32; ++e) { soff[e] = s; stile[e] = tt; s += (int)cnt[e]; tt += (((int)cnt[e] + 255) >> 8) * ncol; } soff[32] = s; stile[32] = tt; }
    __syncthreads();
}
DI void phase_moe_up(const Ctx& c, unsigned char* lds) {
    int* soff = (int*)(lds + LDS_BYTES - 1024); int* stile = soff + 64;
    moe_tables(c, soff, stile, 1);
    const int total = stile[32];
    const int lane = TID() & 63, wave = TID() >> 6, wm = wave >> 2, wn = wave & 3;
    for (int item = blockIdx.x; item < total; item += gridDim.x) {
        int e = 0;
        for (int q = 1; q < 32; ++q) if (stile[q] <= item) e = q;
        const int tm = item - stile[e];
        const int p0 = soff[e] + tm * 256, pend = soff[e + 1];
        GatherRows gr; gr.ent = c.ENT + ((size_t)e * NT + (p0 - soff[e])) * 2; gr.n = pend - p0;
        f32x4 acc[8][4];
#pragma unroll
        for (int a_ = 0; a_ < 8; ++a_)
#pragma unroll
            for (int b_ = 0; b_ < 4; ++b_) acc[a_][b_] = (f32x4){0.f, 0.f, 0.f, 0.f};
        gemm256_dma(acc, c.H, DM, (const bf16_t*)(c.ws + WS_EG) + (size_t)e * 256 * DM, DM, DM, lds, &gr);
#pragma unroll
        for (int mi = 0; mi < 8; ++mi)
#pragma unroll
            for (int ni = 0; ni < 4; ++ni) {
                const int r = wm * 128 + mi * 16 + (lane & 15), cc = wn * 64 + ni * 16 + (lane >> 4) * 4;
                const f32x4 g4 = acc[mi][ni];
                if (p0 + r < pend) store_bf4(c.HID + (size_t)(p0 + r) * 256 + cc, (f32x4){g4[0] * sigmoidf_(g4[0]), g4[1] * sigmoidf_(g4[1]), g4[2] * sigmoidf_(g4[2]), g4[3] * sigmoidf_(g4[3])});
                acc[mi][ni] = (f32x4){0.f, 0.f, 0.f, 0.f};
            }
        gemm256_dma(acc, c.H, DM, (const bf16_t*)(c.ws + WS_EU) + (size_t)e * 256 * DM, DM, DM, lds, &gr);
#pragma unroll
        for (int mi = 0; mi < 8; ++mi) {
#pragma unroll
            for (int ni = 0; ni < 4; ++ni) {
                const int r = wm * 128 + mi * 16 + (lane & 15), cc = wn * 64 + ni * 16 + (lane >> 4) * 4;
                if (p0 + r < pend) { bf16_t* q = c.HID + (size_t)(p0 + r) * 256 + cc; const u32x2 sv = *(const u32x2*)q;
                    store_bf4(q, (f32x4){bflo(sv.x) * acc[mi][ni][0], bfhi(sv.x) * acc[mi][ni][1], bflo(sv.y) * acc[mi][ni][2], bfhi(sv.y) * acc[mi][ni][3]}); }
            }
            asm volatile("" ::: "memory"); __builtin_amdgcn_sched_barrier(0);
        }
    }
}
DI void phase_moe_down(const Ctx& c, unsigned char* lds) {
    int* soff = (int*)(lds + LDS_BYTES - 1024); int* stile = soff + 64;
    moe_tables(c, soff, stile, 4);
    const int total = stile[32];
    const int lane = TID() & 63, wave = TID() >> 6, wm = wave >> 2, wn = wave & 3;
    for (int item = blockIdx.x; item < total; item += gridDim.x) {
        int e = 0;
        for (int q = 1; q < 32; ++q) if (stile[q] <= item) e = q;
        const int loc = item - stile[e], tm = loc >> 2, tn = loc & 3, n0 = tn * 256;
        const int p0 = soff[e] + tm * 256, pend = soff[e + 1];
        f32x4 acc[8][4];
#pragma unroll
        for (int a_ = 0; a_ < 8; ++a_)
#pragma unroll
            for (int b_ = 0; b_ < 4; ++b_) acc[a_][b_] = (f32x4){0.f, 0.f, 0.f, 0.f};
        gemm256_dma(acc, c.HID + (size_t)p0 * 256, 256, (const bf16_t*)(c.ws + WS_ED) + ((size_t)e * DM + n0) * 256, 256, 256, lds);
        const float* wl = (const float*)c.ENT + ((size_t)e * NT + (p0 - soff[e])) * 2 + 1;
#pragma unroll
        for (int mi = 0; mi < 8; ++mi)
#pragma unroll
            for (int ni = 0; ni < 4; ++ni) {
                const int r = wm * 128 + mi * 16 + (lane & 15), cc = wn * 64 + ni * 16 + (lane >> 4) * 4;
                if (p0 + r < pend) { const float w = wl[2 * r];
                    store_bf4(c.Y + (size_t)(p0 + r) * DM + n0 + cc, (f32x4){acc[mi][ni][0] * w, acc[mi][ni][1] * w, acc[mi][ni][2] * w, acc[mi][ni][3] * w}); }
            }
    }
}
DI void phase_final(const Ctx& c, unsigned char* lds) {
    const int tid = TID(), lane = tid & 63, wave = tid >> 6;
    const float* gain = c.in(I_NFIN);
    int* soff = (int*)(lds + 65536);
    moe_offsets(c, DEPTH - 1, soff);
    for (int row = blockIdx.x * 8 + wave; row < NT; row += gridDim.x * 8) {
        f32x4 v[4];
#pragma unroll
        for (int i = 0; i < 4; ++i) v[i] = *(const f32x4*)(c.out + (size_t)row * DM + i * 256 + lane * 4);
        add_moe_rows(c, row, lane, v, soff);
        float ss = 0.f;
#pragma unroll
        for (int i = 0; i < 4; ++i) ss += v[i][0] * v[i][0] + v[i][1] * v[i][1] + v[i][2] * v[i][2] + v[i][3] * v[i][3];
        ss = wave_sum_dpp(ss);
        const float rs = rsqrtf(ss * (1.0f / DM) + 1e-6f);
#pragma unroll
        for (int i = 0; i < 4; ++i) {
            const f32x4 g = *(const f32x4*)(gain + i * 256 + lane * 4);
            *(f32x4*)(c.out + (size_t)row * DM + i * 256 + lane * 4) = (f32x4){v[i][0] * rs * g[0], v[i][1] * rs * g[1], v[i][2] * rs * g[2], v[i][3] * rs * g[3]};
        }
    }
}

constexpr int PH_PER_LAYER = 11, N_PHASES = DEPTH * PH_PER_LAYER + 1;
__global__ void __launch_bounds__(NTHREADS, 2) fwd_kernel(Params P) {
    extern __shared__ __attribute__((aligned(16))) unsigned char lds[];
    const int lo = P.ph_lo, hi = P.ph_hi;
    LAS unsigned* xbw = (LAS unsigned*)(lds + LDS_BYTES - 16);
    if (threadIdx.x == 0) { xbw[0] = 0u; xbw[1] = 0u; xbw[2] = 0u; xbw[3] = 0u; }
    __syncthreads();
    Ctx c; c.P = &P; c.ws = P.ws; c.out = P.out; c.l = 0;
    c.ctl = (unsigned*)(P.ws + WS_CTL);
    c.H = (bf16_t*)(P.ws + WS_H); c.PROJ = (bf16_t*)(P.ws + WS_PROJ); c.F = (bf16_t*)(P.ws + WS_F); c.POOLED = (bf16_t*)(P.ws + WS_POOLED);
    c.MERGED = (bf16_t*)(P.ws + WS_F); c.CMPH = (bf16_t*)(P.ws + WS_CMPH); c.CMPO = (float*)(P.ws + WS_CMPO); c.POSB = (float*)(P.ws + WS_POSB);
    c.ROUTE = (int*)(P.ws + WS_ROUTE); c.ENT = (int*)(P.ws + WS_ENT); c.HID = (bf16_t*)(P.ws + WS_HID); c.Y = (bf16_t*)(P.ws + WS_Y);
    c.VT = (bf16_t*)(P.ws + WS_VT); c.KC = (bf16_t*)(P.ws + WS_KC); c.VCT = (bf16_t*)(P.ws + WS_VCT); c.YRAW = (bf16_t*)(P.ws + WS_YRAW); c.BON = (float*)(P.ws + WS_BON);
    XcdBarrier bar; bar.bar = c.ctl + CW_BAR; bar.x = 0; bar.st = (volatile LAS unsigned*)xbw;
    if (hi - lo > 1) bar = xcd_barrier_post(c.ctl + CW_BAR, (volatile LAS unsigned*)xbw);
#define IN(k) (lo <= (k) && (k) < hi)
#define SEAM(k) do { if (IN(k) && IN((k) + 1)) xcd_barrier(bar); } while (0)
#pragma unroll 1
    for (int l = 0; l < DEPTH; ++l) {
        c.l = l; const int pb = l * PH_PER_LAYER;
        if (IN(pb + 0)) phase_norm1(c, lds);
        SEAM(pb + 0);
        if (IN(pb + 1)) phase_gemm1(c, lds);
        SEAM(pb + 1);
        if (IN(pb + 2)) phase_prep(c, lds);
        SEAM(pb + 2);
        if (IN(pb + 3)) phase_poolgemm(c, lds);
        SEAM(pb + 3);
        if (IN(pb + 4)) phase_mix(c, lds);
        SEAM(pb + 4);
        if (IN(pb + 5)) phase_rwkv_post(c, lds);
        SEAM(pb + 5);
        if (IN(pb + 6)) phase_merge(c, lds);
        SEAM(pb + 6);
        if (IN(pb + 7)) phase_outp(c, lds);
        SEAM(pb + 7);
        if (IN(pb + 8)) phase_norm2(c, lds);
        SEAM(pb + 8);
        if (IN(pb + 9)) phase_moe_up(c, lds);
        SEAM(pb + 9);
        if (IN(pb + 10)) phase_moe_down(c, lds);
        SEAM(pb + 10);
    }
    if (IN(N_PHASES - 1)) phase_final(c, lds);
}

#ifndef MK_N_LAUNCHES
#define MK_N_LAUNCHES 1
#endif
extern "C" void kernel_launch(void* const* d_in, const int* in_sizes, int n_in, void* d_out, int out_size, void* d_ws, size_t ws_size, hipStream_t stream) {
    static int grid = 0;
    if (grid == 0) {
        if (n_in != N_IN || out_size != NT * DM || ws_size < WS_END) { fprintf(stderr, "kernel_launch: unexpected shapes n_in %d out %d ws %zu (need %zu)\n", n_in, out_size, ws_size, (size_t)WS_END); grid = -1; return; }
        int dev = 0, cus = 0, per_cu = 0;
        if (hipGetDevice(&dev) != hipSuccess || hipDeviceGetAttribute(&cus, hipDeviceAttributeMultiprocessorCount, dev) != hipSuccess) { grid = -1; return; }
        if (hipFuncSetAttribute((const void*)fwd_kernel, hipFuncAttributeMaxDynamicSharedMemorySize, LDS_BYTES) != hipSuccess) { fprintf(stderr, "kernel_launch: hipFuncSetAttribute failed\n"); grid = -1; return; }
        if (hipOccupancyMaxActiveBlocksPerMultiprocessor(&per_cu, (const void*)fwd_kernel, NTHREADS, LDS_BYTES) != hipSuccess || per_cu < 1) { fprintf(stderr, "kernel_launch: occupancy query says %d\n", per_cu); }
        (void)hipGetLastError();
        grid = cus;
    }
    if (grid < 0) return;
    if (hipMemsetAsync((char*)d_ws + WS_CTL, 0, CTL_BYTES, stream) != hipSuccess) return;
    Params p{};
    for (int i = 0; i < N_IN; ++i) p.in[i] = (const float*)d_in[i];
    p.out = (float*)d_out; p.ws = (unsigned char*)d_ws;
    if (MK_N_LAUNCHES == 1) {
        p.ph_lo = 0; p.ph_hi = N_PHASES;
        hipLaunchKernelGGL(fwd_kernel, dim3(grid), dim3(NTHREADS), LDS_BYTES, stream, p);
    } else {
        for (int k = 0; k < N_PHASES; ++k) { p.ph_lo = k; p.ph_hi = k + 1; hipLaunchKernelGGL(fwd_kernel, dim3(grid), dim3(NTHREADS), LDS_BYTES, stream, p); }
    }
}
```

```cpp
#include <hip/hip_runtime.h>
#include <cstdio>
#include <cstdint>

#define DI __device__ __forceinline__
typedef unsigned short bf16_t;
typedef short bf16x8 __attribute__((ext_vector_type(8)));
typedef float f32x4 __attribute__((ext_vector_type(4)));
typedef unsigned u32x4 __attribute__((ext_vector_type(4)));
typedef unsigned u32x2 __attribute__((ext_vector_type(2)));

constexpr int NB = 4, SEQ = 4096, DM = 1024, NT = NB * SEQ, DEPTH = 2;
constexpr int IN_COLS = 4816;
constexpr int C_POOL = 0, C_RW = 512, C_R = 512, C_K = 1024, C_V = 1536, C_WD = 2048, C_AD = 2080, C_GD = 2112;
constexpr int C_Q = 2208, C_KC = 3232, C_VC = 3488, C_KS = 3744, C_VS = 4000, C_KW = 4256, C_VW = 4512, C_GATE = 4768;
constexpr int RWC = 1696;
constexpr int NCMP = 255;
constexpr int NTHREADS = 512;
constexpr int LDS_BYTES = 155648;

enum { I_X = 0, I_RELB, I_NMIX, I_WIN, I_POOLW, I_POOLS, I_MU, I_W0, I_WUP, I_A0, I_AUP, I_GUP, I_KK, I_KA, I_RK, I_GNW, I_GNB,
       I_CPK, I_CW1K, I_CW2K, I_CPV, I_CW1V, I_CW2V, I_WBR, I_WMG, I_BMG, I_WOUT, I_NFFN, I_WRG, I_BRG, I_WRE, I_BRE, I_EG, I_EU, I_ED, I_NFIN, N_IN };

constexpr size_t WS_CTL = 0;
constexpr size_t CTL_BYTES = 65536;
constexpr size_t WS_H = CTL_BYTES;
constexpr size_t WS_PROJ = WS_H + (size_t)NT * DM * 2;
constexpr size_t WS_F = WS_PROJ + (size_t)NT * IN_COLS * 2;
constexpr size_t PLANE = (size_t)NT * 512 * 2;
constexpr size_t WS_POOLED = WS_F + 6 * PLANE;
constexpr size_t WS_CMPH = WS_POOLED + PLANE;
constexpr size_t WS_CMPO = WS_CMPH + (size_t)2 * 4096 * 256 * 2;
constexpr size_t WS_POSB = WS_CMPO + (size_t)2 * 4096 * 64 * 4;
constexpr size_t WS_ROUTE = WS_POSB + 4096;
constexpr size_t WS_ENT = WS_ROUTE + (size_t)NT * 32;
constexpr size_t WS_VT = WS_ENT + (size_t)32 * NT * 8;
constexpr size_t WS_KC = WS_VT + (size_t)2 * 16 * 64 * SEQ * 2;
constexpr size_t WS_VCT = WS_KC + (size_t)16 * 256 * 64 * 2;
constexpr size_t WS_YRAW = WS_VCT + (size_t)16 * 64 * 256 * 2;
constexpr size_t WS_BON = WS_YRAW + (size_t)NT * 512 * 2;
constexpr size_t WS_SMALLW = WS_BON + (size_t)NT * 8 * 16;
constexpr size_t WS_WT_LORA = WS_SMALLW + 262144;
constexpr size_t WS_END = WS_WT_LORA + (size_t)1536 * 128 * 2;
constexpr size_t WS_WT_IN = WS_F;
constexpr size_t WS_WT_C1 = WS_CMPO;
constexpr size_t WS_WT_C2 = WS_SMALLW;
constexpr size_t WS_WT_POOL = WS_SMALLW + 131072;
constexpr size_t WS_WT_MG = WS_VT;
constexpr size_t WS_WT_BR = WS_VT + (size_t)3072 * 1024 * 2;
constexpr size_t WS_WT_OUT = WS_CMPH;
constexpr size_t WS_EG = WS_F + 2 * PLANE;
constexpr size_t WS_EU = WS_EG + (size_t)32 * 256 * 1024 * 2;
constexpr size_t WS_ED = WS_EU + (size_t)32 * 256 * 1024 * 2;
static_assert(WS_ED + (size_t)32 * 1024 * 256 * 2 <= WS_F + 6 * PLANE, "expert alias");
static_assert(WS_WT_BR + (size_t)2048 * 1024 * 2 <= WS_VT + (size_t)2 * 16 * 64 * SEQ * 2, "merge alias");
static_assert((size_t)4864 * 1024 * 2 <= 6 * PLANE, "w_in alias");
constexpr size_t WS_HID = WS_PROJ;
constexpr size_t WS_Y = WS_PROJ + (size_t)2 * NT * 256 * 2;
static_assert(WS_Y + (size_t)2 * NT * 1024 * 2 <= WS_F, "alias");
constexpr int CW_BAR = 0;
constexpr int CW_CNT = 4096;
constexpr int CW_CUR = 4096 + 64;
constexpr int CW_Q = 4096 + 128;

#define XB_TMO      128
#define XB_XCNT(j)  (256  + 64 * (j))
#define XB_XSUB(j)  (1280 + 64 * (j))
#define XB_XGEN(j)  (2304 + 64 * (j))
#define XB_TOP      3328
#define XB_TOPGEN   3392
#define XCD_BAR_WORDS 3456
#define XB_SPIN_CAP (1u << 18)
#define LAS __attribute__((address_space(3)))

__device__ __forceinline__ unsigned xb_ld(unsigned* p)              { return __hip_atomic_load(p, __ATOMIC_RELAXED, __HIP_MEMORY_SCOPE_AGENT); }
__device__ __forceinline__ unsigned xb_add(unsigned* p, unsigned v) { return __hip_atomic_fetch_add(p, v, __ATOMIC_RELAXED, __HIP_MEMORY_SCOPE_AGENT); }
__device__ __forceinline__ unsigned xb_xcc_id() { return (unsigned)__builtin_amdgcn_s_getreg((3 << 11) | 20) & 0xFu; }
#define XB_SPIN(cond, bar) do { unsigned _sp = 0; while (cond) { __builtin_amdgcn_s_sleep(1); \
    if ((++_sp & 255u) == 0u) { if (xb_ld(&(bar)[XB_TMO])) break; if (_sp > XB_SPIN_CAP) { atomicAdd(&(bar)[XB_TMO], 1u); break; } } } } while (0)

struct XcdBarrier { unsigned* bar; unsigned x; volatile LAS unsigned* st; };

__device__ __forceinline__ XcdBarrier xcd_barrier_post(unsigned* bar, volatile LAS unsigned* st) {
    XcdBarrier b; b.bar = bar; b.x = xb_xcc_id(); b.st = st;
    if (threadIdx.x == 0) (void)xb_add(&bar[XB_XCNT(b.x)], 1u);
    return b;
}
__device__ __forceinline__ void xcd_barrier_complete(unsigned* bar, unsigned x, unsigned& nloc, unsigned& nx) {
    const unsigned G = gridDim.x * gridDim.y * gridDim.z;
    unsigned sum, cnt, mine, sp = 0u;
    for (;;) {
        sum = 0u; cnt = 0u; mine = 0u;
#pragma unroll
        for (unsigned j = 0; j < 16; ++j) { const unsigned c = xb_ld(&bar[XB_XCNT(j)]); sum += c; cnt += (c > 0u) ? 1u : 0u; mine = (j == x) ? c : mine; }
        if (sum == G) break;
        __builtin_amdgcn_s_sleep(1);
        if ((++sp & 255u) == 0u) { if (xb_ld(&bar[XB_TMO])) break; if (sp > XB_SPIN_CAP) { atomicAdd(&bar[XB_TMO], 1u); break; } }
    }
    nloc = mine > 0u ? mine : 1u; nx = cnt > 0u ? cnt : 1u;
}
__device__ __forceinline__ void xcd_barrier(const XcdBarrier& b) {
    asm volatile("s_waitcnt vmcnt(0)" ::: "memory");
    __syncthreads();
    if (threadIdx.x == 0) {
        unsigned* bar = b.bar;
        __builtin_amdgcn_s_waitcnt(0);
        unsigned nloc = b.st[0], nx = b.st[1];
        if (nloc == 0u) { xcd_barrier_complete(bar, b.x, nloc, nx); b.st[0] = nloc; b.st[1] = nx; }
        const unsigned old = xb_add(&bar[XB_XSUB(b.x)], 1u);
        const unsigned gen = old / nloc;
        if (old + 1u == (gen + 1u) * nloc) {
            __builtin_amdgcn_fence(__ATOMIC_RELEASE, "agent");
            asm volatile("s_waitcnt vmcnt(0)" ::: "memory");
            const unsigned og = xb_add(&bar[XB_TOP], 1u);
            const unsigned tg = og / nx;
            if (og + 1u == (tg + 1u) * nx) xb_add(&bar[XB_TOPGEN], 1u);
            else XB_SPIN(xb_ld(&bar[XB_TOPGEN]) == tg, bar);
            __builtin_amdgcn_fence(__ATOMIC_ACQUIRE, "agent");
            xb_add(&bar[XB_XGEN(b.x)], 1u);
            asm volatile("s_waitcnt vmcnt(0)" ::: "memory");
        } else {
            XB_SPIN(xb_ld(&bar[XB_XGEN(b.x)]) == gen, bar);
            __builtin_amdgcn_fence(__ATOMIC_ACQUIRE, "agent");
            asm volatile("s_waitcnt vmcnt(0)" ::: "memory");
        }
    }
    __syncthreads();
}

DI bf16_t f2bf(float x) { unsigned u = __float_as_uint(x); u += 0x7fffu + ((u >> 16) & 1u); return (bf16_t)(u >> 16); }
DI float bf2f(bf16_t b) { return __uint_as_float((unsigned)b << 16); }
typedef __bf16 bf16v2_t __attribute__((ext_vector_type(2)));
typedef float f32v2_t __attribute__((ext_vector_type(2)));
DI unsigned pack2(float lo, float hi) { const f32v2_t v = {lo, hi}; const bf16v2_t b = __builtin_convertvector(v, bf16v2_t); return __builtin_bit_cast(unsigned, b); }
DI float bflo(unsigned w) { return __uint_as_float(w << 16); }
DI float bfhi(unsigned w) { return __uint_as_float(w & 0xffff0000u); }
DI float wave_sum(float v) {
#pragma unroll
    for (int o = 32; o >= 1; o >>= 1) v += __shfl_xor(v, o);
    return v;
}
DI float wave_max(float v) {
#pragma unroll
    for (int o = 32; o >= 1; o >>= 1) v = fmaxf(v, __shfl_xor(v, o));
    return v;
}
DI float sigmoidf_(float x) { return __builtin_amdgcn_rcpf(1.0f + __expf(-x)); }
DI int TID() { int t = threadIdx.x; asm volatile("" : "+v"(t)); return t; }
#define LDS_WAVE_SYNC() asm volatile("s_waitcnt lgkmcnt(0)" ::: "memory")

#define DPP_MOV(v, ctrl) __builtin_bit_cast(float, __builtin_amdgcn_update_dpp(0, __builtin_bit_cast(int, (v)), (ctrl), 0xF, 0xF, true))
DI float wave_sum_dpp(float v) {
    v += DPP_MOV(v, 0xB1); v += DPP_MOV(v, 0x4E); v += DPP_MOV(v, 0x141); v += DPP_MOV(v, 0x140);
    return __builtin_bit_cast(float, __builtin_amdgcn_readlane(__builtin_bit_cast(int, v), 0)) + __builtin_bit_cast(float, __builtin_amdgcn_readlane(__builtin_bit_cast(int, v), 16)) +
        (__builtin_bit_cast(float, __builtin_amdgcn_readlane(__builtin_bit_cast(int, v), 32)) + __builtin_bit_cast(float, __builtin_amdgcn_readlane(__builtin_bit_cast(int, v), 48)));
}
struct Params { const float* in[N_IN]; float* out; unsigned char* ws; int ph_lo, ph_hi; };

DI int t5_bucket(int n) {
    if (n < 16) return n;
    if (n >= 128) return 31;
    int b = 16;
    b += (n >= 19) + (n >= 21) + (n >= 24) + (n >= 27) + (n >= 31) + (n >= 35) + (n >= 40) + (n >= 46) + (n >= 52) + (n >= 59) + (n >= 67) + (n >= 77) + (n >= 87) + (n >= 99) + (n >= 113);
    return b;
}

constexpr int G_A = 0, G_B = 256 * 64 * 2, G_STAGE = (256 + 128) * 64 * 2;
static_assert(2 * G_STAGE <= LDS_BYTES - 64, "gemm lds");
DI int g_off(int r, int c) { return ((r >> 4) * 2 + (c >> 5)) * 1024 + ((((r & 15) * 64) + (c & 31) * 2) ^ ((((r & 15) >> 3) & 1) << 5)); }
struct ARows { const bf16_t* p[4]; const float* mu; int ltype; int first; };
DI float tanhf_fast(float x) { const float e = __expf(2.0f * x); return 1.0f - 2.0f * __builtin_amdgcn_rcpf(e + 1.0f); }
DI u32x4 lora_chunk(const bf16_t* prow, bool first, const float* mu, int ltype, int k) {
    const int lim = (ltype == 2) ? 96 : 32;
    if (k >= lim) return (u32x4){0u, 0u, 0u, 0u};
    const int col = C_WD + ltype * 32 + k;
    const u32x4 cu = *(const u32x4*)(prow + col);
    u32x4 pu = (u32x4){0u, 0u, 0u, 0u};
    if (!first) pu = *(const u32x4*)(prow - IN_COLS + col);
    const f32x4 m0 = *(const f32x4*)(mu + col - C_RW), m1 = *(const f32x4*)(mu + col - C_RW + 4);
    float u[8] = {bflo(cu.x), bfhi(cu.x), bflo(cu.y), bfhi(cu.y), bflo(cu.z), bfhi(cu.z), bflo(cu.w), bfhi(cu.w)};
    const float p[8] = {bflo(pu.x), bfhi(pu.x), bflo(pu.y), bfhi(pu.y), bflo(pu.z), bfhi(pu.z), bflo(pu.w), bfhi(pu.w)};
    const float mm[8] = {m0[0], m0[1], m0[2], m0[3], m1[0], m1[1], m1[2], m1[3]};
#pragma unroll
    for (int j = 0; j < 8; ++j) { const float us = u[j] + (p[j] - u[j]) * mm[j]; u[j] = (ltype == 0) ? tanhf_fast(us) : ((ltype == 1) ? us : __builtin_amdgcn_rcpf(1.0f + __expf(-us))); }
    u32x4 w; w.x = pack2(u[0], u[1]); w.y = pack2(u[2], u[3]); w.z = pack2(u[4], u[5]); w.w = pack2(u[6], u[7]);
    return w;
}
template <int AMODE>
DI void g_load(u32x4 (&ra)[4], u32x4 (&rb)[2], const ARows& ar, const bf16_t* bt, int ldb, int k0, int tid) {
    const int kseg = (tid & 7) * 8;
#pragma unroll
    for (int i = 0; i < 4; ++i) {
        ra[i] = (u32x4){0u, 0u, 0u, 0u};
        if (AMODE == 2) ra[i] = lora_chunk(ar.p[i], (ar.first >> i) & 1, ar.mu, ar.ltype, k0 + kseg);
        else if (ar.p[i] != nullptr) ra[i] = *(const u32x4*)((AMODE == 0) ? (ar.p[i] + k0 + kseg) : (ar.p[i] + (size_t)(k0 >> 6) * IN_COLS + kseg));
    }
#pragma unroll
    for (int i = 0; i < 2; ++i) rb[i] = *(const u32x4*)(bt + (size_t)((tid >> 3) + 64 * i) * ldb + k0 + kseg);
}
DI void g_store(unsigned char* st, const u32x4 (&ra)[4], const u32x4 (&rb)[2], int tid) {
    const int off = g_off(tid >> 3, (tid & 7) * 8);
#pragma unroll
    for (int i = 0; i < 4; ++i) *(u32x4*)(st + G_A + off + i * 8192) = ra[i];
#pragma unroll
    for (int i = 0; i < 2; ++i) *(u32x4*)(st + G_B + off + i * 8192) = rb[i];
}
DI void g_compute(f32x4 (&acc)[4][4], const unsigned char* st, int lane, int wm, int wn) {
    const int lo = ((lane & 15) * 64 + (lane >> 4) * 16) ^ ((((lane & 15) >> 3) & 1) << 5);
    const unsigned char* sA = st + G_A + wm * 8192 + lo;
    const unsigned char* sB = st + G_B + wn * 8192 + lo;
    bf16x8 bcur[4], bnxt[4], a0, a1, a2;
#pragma unroll
    for (int i = 0; i < 4; ++i) bcur[i] = *(const bf16x8*)(sB + i * 2048);
    a0 = *(const bf16x8*)(sA);
    a1 = *(const bf16x8*)(sA + 2048);
#define G_AFRAG(s) (*(const bf16x8*)(sA + ((s) & 3) * 2048 + ((s) >> 2) * 1024))
#define G_GROUP(s, acur, anew) do { \
        if ((s) + 2 < 8) anew = G_AFRAG((s) + 2); \
        if ((s) < 4) bnxt[(s) & 3] = *(const bf16x8*)(sB + ((s) & 3) * 2048 + 1024); \
        __builtin_amdgcn_sched_barrier(0); \
        _Pragma("unroll") for (int ni = 0; ni < 4; ++ni) acc[(s) & 3][ni] = __builtin_amdgcn_mfma_f32_16x16x32_bf16(((s) < 4 ? bcur[ni] : bnxt[ni]), acur, acc[(s) & 3][ni], 0, 0, 0); \
        __builtin_amdgcn_sched_barrier(0); } while (0)
    G_GROUP(0, a0, a2); G_GROUP(1, a1, a0); G_GROUP(2, a2, a1); G_GROUP(3, a0, a2);
    G_GROUP(4, a1, a0); G_GROUP(5, a2, a1); G_GROUP(6, a0, a2); G_GROUP(7, a1, a0);
#undef G_GROUP
#undef G_AFRAG
}
#define LDS_BARRIER() do { asm volatile("s_waitcnt lgkmcnt(0)" ::: "memory"); __builtin_amdgcn_s_barrier(); asm volatile("" ::: "memory"); } while (0)
template <int AMODE>
DI void gemm_core(f32x4 (&acc)[4][4], const ARows& ar, const bf16_t* bt  , int ldb, int K, unsigned char* lds) {
    const int tid = TID(), lane = tid & 63, wave = tid >> 6, wm = wave >> 1, wn = wave & 1;
    const int nk = K >> 6;
    unsigned char* s0 = lds; unsigned char* s1 = lds + G_STAGE;
    u32x4 ra0[4], rb0[2], ra1[4], rb1[2];
    g_load<AMODE>(ra0, rb0, ar, bt, ldb, 0, tid);
    g_load<AMODE>(ra1, rb1, ar, bt, ldb, 64, tid);
    __syncthreads();
    g_store(s0, ra0, rb0, tid);
    g_load<AMODE>(ra0, rb0, ar, bt, ldb, (nk > 2 ? 2 : nk - 1) * 64, tid);
    LDS_BARRIER();
    for (int kt = 0; kt < nk; kt += 2) {
        g_store(s1, ra1, rb1, tid);
        { const int kn = (kt + 3 < nk) ? kt + 3 : nk - 1; g_load<AMODE>(ra1, rb1, ar, bt, ldb, kn * 64, tid); }
        g_compute(acc, s0, lane, wm, wn);
        LDS_BARRIER();
        g_store(s0, ra0, rb0, tid);
        { const int kn = (kt + 4 < nk) ? kt + 4 : nk - 1; g_load<AMODE>(ra0, rb0, ar, bt, ldb, kn * 64, tid); }
        g_compute(acc, s1, lane, wm, wn);
        LDS_BARRIER();
    }
}
static_assert(3 * G_STAGE <= LDS_BYTES - 64, "dma ring");
DI void gemm_core_dma(f32x4 (&acc)[4][4], const bf16_t* A, size_t lda, const bf16_t* bt, size_t ldb, int K, unsigned char* lds) {
    const int tid = TID(), lane = tid & 63, wave = __builtin_amdgcn_readfirstlane(tid >> 6), wm = wave >> 1, wn = wave & 1;
    const int nk = K >> 6;
    const int srow = lane >> 2, skof = ((lane & 3) * 8) ^ ((lane >> 5) << 4);
    const char* gp[6]; int loff[6];
#pragma unroll
    for (int j = 0; j < 6; ++j) {
        const int sid = wave * 6 + j;
        if (sid < 32) { gp[j] = (const char*)(A + (size_t)((sid >> 1) * 16 + srow) * lda + (sid & 1) * 32 + skof); loff[j] = G_A + sid * 1024; }
        else { const int s2 = sid - 32; gp[j] = (const char*)(bt + (size_t)((s2 >> 1) * 16 + srow) * ldb + (s2 & 1) * 32 + skof); loff[j] = G_B + s2 * 1024; }
    }
#define DMA_ISSUE(kt_, st_) do { const int _k = ((kt_) < nk ? (kt_) : nk - 1) * 128; \
        _Pragma("unroll") for (int j = 0; j < 6; ++j) __builtin_amdgcn_global_load_lds((const unsigned*)(gp[j] + _k), (LAS unsigned*)(lds + (st_) * G_STAGE + loff[j]), 16, 0, 0); } while (0)
    asm volatile("s_waitcnt vmcnt(0)" ::: "memory");
    __syncthreads();
    DMA_ISSUE(0, 0); DMA_ISSUE(1, 1);
    int st = 0;
    for (int kt = 0; kt < nk; ++kt) {
        asm volatile("s_waitcnt vmcnt(6)" ::: "memory");
        __builtin_amdgcn_s_barrier();
        asm volatile("" ::: "memory");
        const int sn = (st == 0) ? 2 : st - 1;
        DMA_ISSUE(kt + 2, sn);
        g_compute(acc, lds + st * G_STAGE, lane, wm, wn);
        st = (st == 2) ? 0 : st + 1;
    }
    asm volatile("s_waitcnt vmcnt(0)" ::: "memory");
    __syncthreads();
#undef DMA_ISSUE
}
DI void store_bf4(bf16_t* p, f32x4 v) { u32x2 w; w.x = pack2(v[0], v[1]); w.y = pack2(v[2], v[3]); *(u32x2*)p = w; }
constexpr int H_A = 0, H_B = 256 * 64 * 2, H_STAGE = 2 * 256 * 64 * 2;
static_assert(2 * H_STAGE <= LDS_BYTES - 64, "gemm256 lds");
DI void h_compute(f32x4 (&acc)[8][4], const unsigned char* st, int lane, int wm, int wn) {
    const int lo = ((lane & 15) * 64 + (lane >> 4) * 16) ^ ((((lane & 15) >> 3) & 1) << 5);
    const unsigned char* sA = st + H_A + wm * 16384 + lo;
    const unsigned char* sB = st + H_B + wn * 8192 + lo;
#pragma unroll
    for (int ks = 0; ks < 2; ++ks) {
        bf16x8 bf[4], a0, a1, a2;
#pragma unroll
        for (int i = 0; i < 4; ++i) bf[i] = *(const bf16x8*)(sB + i * 2048 + ks * 1024);
        a0 = *(const bf16x8*)(sA + ks * 1024);
        a1 = *(const bf16x8*)(sA + 2048 + ks * 1024);
#define H_GROUP(s, acur, anew) do { \
        if ((s) + 2 < 8) anew = *(const bf16x8*)(sA + ((s) + 2) * 2048 + ks * 1024); \
        __builtin_amdgcn_sched_barrier(0); \
        _Pragma("unroll") for (int ni = 0; ni < 4; ++ni) acc[(s)][ni] = __builtin_amdgcn_mfma_f32_16x16x32_bf16(bf[ni], acur, acc[(s)][ni], 0, 0, 0); \
        __builtin_amdgcn_sched_barrier(0); } while (0)
        H_GROUP(0, a0, a2); H_GROUP(1, a1, a0); H_GROUP(2, a2, a1); H_GROUP(3, a0, a2);
        H_GROUP(4, a1, a0); H_GROUP(5, a2, a1); H_GROUP(6, a0, a2); H_GROUP(7, a1, a0);
#undef H_GROUP
    }
}
struct GatherRows { const int* ent; int n; };
DI void gemm256_dma(f32x4 (&acc)[8][4], const bf16_t* A, size_t lda, const bf16_t* bt, size_t ldb, int K, unsigned char* lds, const GatherRows* gr = nullptr) {
    const int tid = TID(), lane = tid & 63, wave = __builtin_amdgcn_readfirstlane(tid >> 6), wm = wave >> 2, wn = wave & 3;
    const int nk = K >> 6;
    const int srow = lane >> 2, skof = ((lane & 3) * 8) ^ ((lane >> 5) << 4);
    const char* gp[8]; int loff[8];
#pragma unroll
    for (int j = 0; j < 8; ++j) {
        const int sid = wave * 8 + j;
        if (sid < 32) { size_t rowoff = (size_t)((sid >> 1) * 16 + srow) * lda;
            if (gr != nullptr) { const int r = (sid >> 1) * 16 + srow; rowoff = (size_t)((r < gr->n) ? gr->ent[2 * r] : 0) * lda; }
            gp[j] = (const char*)(A + rowoff + (sid & 1) * 32 + skof); loff[j] = H_A + sid * 1024; }
        else { const int s2 = sid - 32; gp[j] = (const char*)(bt + (size_t)((s2 >> 1) * 16 + srow) * ldb + (s2 & 1) * 32 + skof); loff[j] = H_B + s2 * 1024; }
    }
#define H_ISSUE(kt_, st_) do { const int _k = ((kt_) < nk ? (kt_) : nk - 1) * 128; \
        _Pragma("unroll") for (int j = 0; j < 8; ++j) __builtin_amdgcn_global_load_lds((const unsigned*)(gp[j] + _k), (LAS unsigned*)(lds + (st_) * H_STAGE + loff[j]), 16, 0, 0); } while (0)
    asm volatile("s_waitcnt vmcnt(0)" ::: "memory");
    __syncthreads();
    H_ISSUE(0, 0);
    for (int kt = 0; kt < nk; ++kt) {
        asm volatile("s_waitcnt vmcnt(0)" ::: "memory");
        __builtin_amdgcn_s_barrier();
        asm volatile("" ::: "memory");
        H_ISSUE(kt + 1, (kt + 1) & 1);
        h_compute(acc, lds + (kt & 1) * H_STAGE, lane, wm, wn);
    }
    asm volatile("s_waitcnt vmcnt(0)" ::: "memory");
    __syncthreads();
#undef H_ISSUE
}
DI void tile256_store_bf16(f32x4 (&acc)[8][4], bf16_t* out, size_t ld, int ncols, unsigned char* lds) {
    bf16_t* T = (bf16_t*)lds;
    const int tid = TID(), lane = tid & 63, wave = tid >> 6, wm = wave >> 2, wn = wave & 3;
    __syncthreads();
#pragma unroll
    for (int mi = 0; mi < 8; ++mi)
#pragma unroll
        for (int ni = 0; ni < 4; ++ni) store_bf4(T + (wm * 128 + mi * 16 + (lane & 15)) * 264 + wn * 64 + ni * 16 + (lane >> 4) * 4, acc[mi][ni]);
    __syncthreads();
#pragma unroll
    for (int i = 0; i < 16; ++i) {
        const int ch = tid + i * NTHREADS, r = ch >> 5, cc = (ch & 31) * 8;
        if (cc < ncols) *(u32x4*)(out + (size_t)r * ld + cc) = *(const u32x4*)(T + r * 264 + cc);
    }
}
DI void acc_zero(f32x4 (&acc)[4][4]) {
#pragma unroll
    for (int i = 0; i < 4; ++i)
#pragma unroll
        for (int j = 0; j < 4; ++j) acc[i][j] = (f32x4){0.f, 0.f, 0.f, 0.f};
}
#define ACC_FOREACH(acc, body) do { const int _l = TID() & 63, _w = TID() >> 6; \
    _Pragma("unroll") for (int _mi = 0; _mi < 4; ++_mi) _Pragma("unroll") for (int _ni = 0; _ni < 4; ++_ni) { \
        const int r_ = (_w >> 1) * 64 + _mi * 16 + (_l & 15), c_ = (_w & 1) * 64 + _ni * 16 + (_l >> 4) * 4; f32x4& v_ = acc[_mi][_ni]; body } } while (0)
DI ARows plain_rows(const bf16_t* base, size_t ld, int m0, int tid) { ARows a; a.mu = nullptr; a.ltype = 0; a.first = 0;
#pragma unroll
    for (int i = 0; i < 4; ++i) a.p[i] = base + (size_t)(m0 + (tid >> 3) + 64 * i) * ld;
    return a; }


DI void convert_tile4(const float* src, int ld, int N, int K, bf16_t* dst, int tile0, unsigned char* lds, int Kvalid = 1 << 30) {
    const int tid = TID();
    const int nkt = K >> 6;
    const int r = tid >> 3, seg = (tid & 7) * 8;
    f32x4 a[4], b[4];
#pragma unroll
    for (int u = 0; u < 4; ++u) {
        const int tile = tile0 + u, k0 = (tile % nkt) * 64, n0 = (tile / nkt) * 64;
        a[u] = (f32x4){0.f, 0.f, 0.f, 0.f}; b[u] = a[u];
        if (n0 + seg < N && k0 + r < Kvalid) { const float* q = src + (size_t)(k0 + r) * ld + n0 + seg; a[u] = *(const f32x4*)q; b[u] = *(const f32x4*)(q + 4); }
    }
    __syncthreads();
#pragma unroll
    for (int u = 0; u < 4; ++u) { bf16_t* T = (bf16_t*)lds + u * 64 * 72;
        u32x4 w; w.x = pack2(a[u][0], a[u][1]); w.y = pack2(a[u][2], a[u][3]); w.z = pack2(b[u][0], b[u][1]); w.w = pack2(b[u][2], b[u][3]); *(u32x4*)(T + r * 72 + seg) = w; }
    __syncthreads();
#pragma unroll
    for (int u = 0; u < 4; ++u) { const bf16_t* T = (const bf16_t*)lds + u * 64 * 72;
        const int tile = tile0 + u, k0 = (tile % nkt) * 64, n0 = (tile / nkt) * 64;
        u32x4 o;
        o.x = (unsigned)T[(seg + 0) * 72 + r] | ((unsigned)T[(seg + 1) * 72 + r] << 16); o.y = (unsigned)T[(seg + 2) * 72 + r] | ((unsigned)T[(seg + 3) * 72 + r] << 16);
        o.z = (unsigned)T[(seg + 4) * 72 + r] | ((unsigned)T[(seg + 5) * 72 + r] << 16); o.w = (unsigned)T[(seg + 6) * 72 + r] | ((unsigned)T[(seg + 7) * 72 + r] << 16);
        *(u32x4*)(dst + (size_t)(n0 + r) * K + k0 + seg) = o; }
}
struct Ctx {
    const Params* P; unsigned char* ws; float* out; int l;
    bf16_t* H; bf16_t* PROJ; bf16_t* F; bf16_t* POOLED; bf16_t* MERGED; bf16_t* CMPH; float* CMPO; float* POSB; int* ROUTE; int* ENT; bf16_t* HID; bf16_t* Y; bf16_t* VT; bf16_t* KC; bf16_t* VCT; bf16_t* YRAW; float* BON; unsigned* ctl;
    DI const float* in(int i) const { return P->in[i]; }
};

DI void moe_offsets(const Ctx& c, int layer, int* soff) {
    const unsigned* cnt = c.ctl + CW_CNT + layer * 32;
    __syncthreads();
    if (TID() == 0) { int s = 0; for (int e = 0; e < 32; ++e) { soff[e] = s; s += (int)cnt[e]; } soff[32] = s; }
    __syncthreads();
}
DI void add_moe_rows(const Ctx& c, int row, int lane, f32x4 (&v)[4], const int* soff) {
    const int* rt = c.ROUTE + (size_t)row * 8;
    const int p0 = soff[rt[0]] + rt[4], p1 = soff[rt[1]] + rt[5];
    const bf16_t* y0 = c.Y + (size_t)p0 * DM; const bf16_t* y1 = c.Y + (size_t)p1 * DM;
#pragma unroll
    for (int i = 0; i < 4; ++i) {
        const u32x2 a = *(const u32x2*)(y0 + i * 256 + lane * 4), b = *(const u32x2*)(y1 + i * 256 + lane * 4);
        v[i][0] += bflo(a.x) + bflo(b.x); v[i][1] += bfhi(a.x) + bfhi(b.x); v[i][2] += bflo(a.y) + bflo(b.y); v[i][3] += bfhi(a.y) + bfhi(b.y);
    }
}
DI void phase_norm1(const Ctx& c, unsigned char* lds) {
    const int tid = TID(), lane = tid & 63, wave = tid >> 6;
    const float* gain = c.in(I_NMIX) + c.l * DM;
    const float* src = (c.l == 0) ? c.in(I_X) : c.out;
    int* soff = (int*)(lds + 65536);
    if (c.l > 0) moe_offsets(c, c.l - 1, soff);
    for (int row = blockIdx.x * 8 + wave; row < NT; row += gridDim.x * 8) {
        f32x4 v[4];
#pragma unroll
        for (int i = 0; i < 4; ++i) v[i] = *(const f32x4*)(src + (size_t)row * DM + i * 256 + lane * 4);
        if (c.l > 0) {
            add_moe_rows(c, row, lane, v, soff);
#pragma unroll
            for (int i = 0; i < 4; ++i) *(f32x4*)(c.out + (size_t)row * DM + i * 256 + lane * 4) = v[i];
        }
        float ss = 0.f;
#pragma unroll
        for (int i = 0; i < 4; ++i) ss += v[i][0] * v[i][0] + v[i][1] * v[i][1] + v[i][2] * v[i][2] + v[i][3] * v[i][3];
        ss = wave_sum_dpp(ss);
        const float rs = rsqrtf(ss * (1.0f / DM) + 1e-6f);
#pragma unroll
        for (int i = 0; i < 4; ++i) {
            const f32x4 g = *(const f32x4*)(gain + i * 256 + lane * 4);
            store_bf4(c.H + (size_t)row * DM + i * 256 + lane * 4, (f32x4){v[i][0] * rs * g[0], v[i][1] * rs * g[1], v[i][2] * rs * g[2], v[i][3] * rs * g[3]});
        }
    }
    for (int idx = blockIdx.x * 8 + wave; idx < 512; idx += gridDim.x * 8) {
        const int kv = idx >> 8, n = idx & 255;
        const float* pos = c.in(kv ? I_CPV : I_CPK) + (size_t)c.l * 2048;
        const float* w1 = c.in(kv ? I_CW1V : I_CW1K) + (size_t)c.l * 2048 * 256;
        float s = 0.f;
        for (int k = lane; k < 2048; k += 64) s += pos[k] * w1[(size_t)k * 256 + n];
        s = wave_sum_dpp(s);
        if (lane == 0) c.POSB[kv * 256 + n] = s;
    }
    for (int it = blockIdx.x * 4; it < 1216 + 256 + 16 + 16 + 48; it += gridDim.x * 4) {
        if (it < 1216) convert_tile4(c.in(I_WIN) + (size_t)c.l * DM * IN_COLS, IN_COLS, IN_COLS, DM, (bf16_t*)(c.ws + WS_WT_IN), it, lds);
        else if (it < 1216 + 256) { const int j = it - 1216, kv = j >> 7; convert_tile4(c.in(kv ? I_CW1V : I_CW1K) + (size_t)c.l * 2048 * 256, 256, 256, 2048, (bf16_t*)(c.ws + WS_WT_C1) + (size_t)kv * 256 * 2048, j & 127, lds); }
        else if (it < 1216 + 256 + 16) { const int j = it - 1472, kv = j >> 3; convert_tile4(c.in(kv ? I_CW2V : I_CW2K) + (size_t)c.l * 256 * 64, 64, 64, 256, (bf16_t*)(c.ws + WS_WT_C2) + (size_t)kv * 128 * 256, j & 7, lds); }
        else if (it < 1504) { const int j = it - 1488, gi = j >> 2; convert_tile4(c.in(I_POOLW) + ((size_t)c.l * 4 + gi) * 128 * 128, 128, 128, 128, (bf16_t*)(c.ws + WS_WT_POOL) + (size_t)gi * 128 * 128, 0, lds); }
        else { const int j = it - 1504, ty = j >> 4; bf16_t* dst = (bf16_t*)(c.ws + WS_WT_LORA) + (size_t)ty * 512 * 128;
            if (ty == 0) convert_tile4(c.in(I_WUP) + (size_t)c.l * 32 * 512, 512, 512, 128, dst, j & 15, lds, 32);
            else if (ty == 1) convert_tile4(c.in(I_AUP) + (size_t)c.l * 32 * 512, 512, 512, 128, dst, j & 15, lds, 32);
            else convert_tile4(c.in(I_GUP) + (size_t)c.l * 96 * 512, 512, 512, 128, dst, j & 15, lds, 96); }
    }
}

constexpr int EPS = 136;
DI void tile_store_bf16(f32x4 (&acc)[4][4], bf16_t* out, size_t ld, int nrows, int ncols, unsigned char* lds) {
    bf16_t* T = (bf16_t*)lds;
    const int tid = TID();
    __syncthreads();
    ACC_FOREACH(acc, { store_bf4(T + r_ * EPS + c_, v_); });
    __syncthreads();
#pragma unroll
    for (int i = 0; i < 8; ++i) {
        const int ch = tid + i * NTHREADS, r = ch >> 4, cc = (ch & 15) * 8;
        if (r < nrows && cc < ncols) *(u32x4*)(out + (size_t)r * ld + cc) = *(const u32x4*)(T + r * EPS + cc);
    }
}
DI bool xcd_unit(int it, int nN, int& tm, int& tn) {
    const int G = gridDim.x;
    if ((G & 7) != 0 || G < 8) { const int u = it * G + blockIdx.x; if (u >= 64 * nN) return false; tm = u % 64; tn = u / 64; return true; }
    const int x = blockIdx.x & 7, i = blockIdx.x >> 3, per = G >> 3;
    const int u = it * per + i;
    if (u >= 8 * nN) return false;
    tm = x * 8 + (u & 7); tn = u >> 3; return true;
}
DI void phase_gemm1(const Ctx& c, unsigned char* lds) {
    const int nN = (IN_COLS + 255) / 256;
    const bf16_t* WT = (const bf16_t*)(c.ws + WS_WT_IN);
    for (int it = 0;; ++it) {
        int tm, tn; if (!xcd_unit(it, nN, tm, tn)) break;
        const int m0 = tm * 256, n0 = tn * 256;
        f32x4 acc[8][4];
#pragma unroll
        for (int i = 0; i < 8; ++i)
#pragma unroll
            for (int j = 0; j < 4; ++j) acc[i][j] = (f32x4){0.f, 0.f, 0.f, 0.f};
        gemm256_dma(acc, c.H + (size_t)m0 * DM, DM, WT + (size_t)n0 * DM, DM, DM, lds);
        tile256_store_bf16(acc, c.PROJ + (size_t)m0 * IN_COLS + n0, IN_COLS, (IN_COLS - n0 < 256) ? IN_COLS - n0 : 256, lds);
    }
}

DI float gelu_tanh(float x) { const float u = 0.7978845608028654f * (x + 0.044715f * x * x * x); const float e = __expf(2.0f * u); return x * (1.0f - __builtin_amdgcn_rcpf(e + 1.0f)); }
DI float softplusf_(float x) { return (x > 20.f) ? x : __logf(1.0f + __expf(x)); }
DI float tanhf_(float x) { const float e = __expf(2.0f * x); return 1.0f - 2.0f * __builtin_amdgcn_rcpf(e + 1.0f); }
constexpr int TKP = 8;
template <int WIN>
DI void pool_emit(const Ctx& c, const float (&pv)[31], int t0, int s0, int ch) {
#pragma unroll
    for (int k = 0; k < 16; ++k) {
        float sum = 0.f;
#pragma unroll
        for (int j = 0; j < WIN; ++j) sum += pv[15 + k - j];
        const int s = s0 + k, cnt = (s + 1 < WIN) ? s + 1 : WIN;
        c.POOLED[(size_t)(t0 + k) * 512 + ch] = f2bf(sum / (float)cnt - pv[15 + k]);
    }
}
DI void phase_prep(const Ctx& c, unsigned char* lds) {
    const int n_cmp_items = 2 * 16 * 2;
    for (int item = (int)gridDim.x - 1 - (int)blockIdx.x; item < n_cmp_items; item += gridDim.x) {
        const int tid = TID();
        const int kv = item >> 5, bgi = (item >> 1) & 15, tn = item & 1, m0 = bgi * 256, n0 = tn * 128;
        ARows ar; ar.mu = nullptr; ar.ltype = 0; ar.first = 0;
#pragma unroll
        for (int i = 0; i < 4; ++i) { const int cb = (tid >> 3) + 64 * i;
            ar.p[i] = (cb < NCMP) ? c.PROJ + ((size_t)(bgi >> 2) * SEQ + 16 * cb) * IN_COLS + (kv ? C_VC : C_KC) + (bgi & 3) * 64 : nullptr; }
        f32x4 acc[4][4]; acc_zero(acc);
        gemm_core<1>(acc, ar, (const bf16_t*)(c.ws + WS_WT_C1) + ((size_t)kv * 256 + n0) * 2048, 2048, 2048, lds);
        const float* pb = c.POSB + kv * 256;
        ACC_FOREACH(acc, {
            const f32x4 bb = *(const f32x4*)(pb + n0 + c_);
            store_bf4(c.CMPH + ((size_t)kv * 4096 + m0 + r_) * 256 + n0 + c_, (f32x4){gelu_tanh(v_[0] + bb[0]), gelu_tanh(v_[1] + bb[1]), gelu_tanh(v_[2] + bb[2]), gelu_tanh(v_[3] + bb[3])}); });
    }
    {
        const float* mu = c.in(I_MU) + (size_t)c.l * RWC;
        const bf16_t* WL = (const bf16_t*)(c.ws + WS_WT_LORA);
        for (int unit = blockIdx.x; unit < 64 * 12; unit += gridDim.x) {
            const int tid = TID();
            const int tm = unit & 63, tn = unit >> 6, m0 = tm * 256, n0 = tn * 128, ltype = tn >> 2, ch0 = n0 & 511;
            ARows ar; ar.mu = mu; ar.ltype = ltype; ar.first = 0;
#pragma unroll
            for (int i = 0; i < 4; ++i) { const int t = m0 + (tid >> 3) + 64 * i; ar.p[i] = c.PROJ + (size_t)t * IN_COLS; if ((t & (SEQ - 1)) == 0) ar.first |= 1 << i; }
            f32x4 acc[4][4]; acc_zero(acc);
            gemm_core<2>(acc, ar, WL + (size_t)n0 * 128, 128, 128, lds);
            if (ltype == 0) { const float* w0 = c.in(I_W0) + c.l * 512 + ch0;
                ACC_FOREACH(acc, { const f32x4 b4 = *(const f32x4*)(w0 + c_);
                    for (int j = 0; j < 4; ++j) v_[j] = __expf(-softplusf_(-(b4[j] + v_[j])) - 0.5f); }); }
            else if (ltype == 1) { const float* a0 = c.in(I_A0) + c.l * 512 + ch0;
                ACC_FOREACH(acc, { const f32x4 b4 = *(const f32x4*)(a0 + c_);
                    for (int j = 0; j < 4; ++j) v_[j] = sigmoidf_(b4[j] + v_[j]); }); }
            tile_store_bf16(acc, c.F + (size_t)(3 + ltype) * NT * 512 + (size_t)m0 * 512 + ch0, 512, 256, 128, lds);
        }
    }
    const int tid = TID();
    const int n_pool_items = NT / 16, n_items = n_pool_items + 512;
    for (int item = blockIdx.x; item < n_items; item += gridDim.x) {
        if (item >= n_pool_items) {
            const int idx0 = (item - n_pool_items) * 4;
            const int r = tid >> 3, seg = (tid & 7) * 8;
            u32x4 w[4];
#pragma unroll
            for (int u = 0; u < 4; ++u) { const int idx = idx0 + u, kind = idx >> 10, bgi = (idx >> 6) & 15, s0 = (idx & 63) * 64;
                w[u] = *(const u32x4*)(c.PROJ + ((size_t)(bgi >> 2) * SEQ + s0 + r) * IN_COLS + (kind ? C_VW : C_VS) + (bgi & 3) * 64 + seg); }
            __syncthreads();
#pragma unroll
            for (int u = 0; u < 4; ++u) *(u32x4*)((bf16_t*)lds + u * 64 * 72 + r * 72 + seg) = w[u];
            __syncthreads();
#pragma unroll
            for (int u = 0; u < 4; ++u) { const int idx = idx0 + u, kind = idx >> 10, bgi = (idx >> 6) & 15, s0 = (idx & 63) * 64;
                const bf16_t* T = (const bf16_t*)lds + u * 64 * 72;
                u32x4 o;
                o.x = (unsigned)T[(seg + 0) * 72 + r] | ((unsigned)T[(seg + 1) * 72 + r] << 16); o.y = (unsigned)T[(seg + 2) * 72 + r] | ((unsigned)T[(seg + 3) * 72 + r] << 16);
                o.z = (unsigned)T[(seg + 4) * 72 + r] | ((unsigned)T[(seg + 5) * 72 + r] << 16); o.w = (unsigned)T[(seg + 6) * 72 + r] | ((unsigned)T[(seg + 7) * 72 + r] << 16);
                *(u32x4*)(c.VT + (((size_t)kind * 16 + bgi) * 64 + r) * SEQ + s0 + seg) = o; }
        } else {
            const int t0 = item * 16, ch = tid, gi = ch >> 7, s0 = t0 & (SEQ - 1);
            float pv[31];
#pragma unroll
            for (int i = 0; i < 31; ++i) pv[i] = (s0 - 15 + i >= 0) ? bf2f(c.PROJ[(size_t)(t0 - 15 + i) * IN_COLS + C_POOL + ch]) : 0.f;
            if (gi == 0) pool_emit<2>(c, pv, t0, s0, ch);
            else if (gi == 1) pool_emit<4>(c, pv, t0, s0, ch);
            else if (gi == 2) pool_emit<8>(c, pv, t0, s0, ch);
            else pool_emit<16>(c, pv, t0, s0, ch);
        }
    }
}

DI void rwkv_finalize_item(const Ctx& c, int item) {
    const int tid = TID(), ch = tid, t0 = item * 8;
    const float* mu = c.in(I_MU) + (size_t)c.l * RWC;
    const float kkw_ = c.in(I_KK)[c.l * 512 + ch], kaw_ = c.in(I_KA)[c.l * 512 + ch], rkw_ = c.in(I_RK)[c.l * 512 + ch];
    const float mur = mu[ch], muk = mu[512 + ch], muv = mu[1024 + ch];
    bf16_t ur[9], uk[9], uv[9], ua[8];
    const bool has_prev = (t0 & (SEQ - 1)) != 0;
#pragma unroll
    for (int k = 0; k < 9; ++k) {
        ur[k] = 0; uk[k] = 0; uv[k] = 0;
        if (k > 0 || has_prev) { const bf16_t* q = c.PROJ + (size_t)(t0 - 1 + k) * IN_COLS; ur[k] = q[C_R + ch]; uk[k] = q[C_K + ch]; uv[k] = q[C_V + ch]; }
    }
#pragma unroll
    for (int k = 0; k < 8; ++k) ua[k] = c.F[(size_t)4 * NT * 512 + (size_t)(t0 + k) * 512 + ch];
#pragma unroll
    for (int k = 0; k < 8; ++k) {
        const int t = t0 + k;
        const float cr = bf2f(ur[k + 1]), ck = bf2f(uk[k + 1]), cv = bf2f(uv[k + 1]);
        const float r = cr + (bf2f(ur[k]) - cr) * mur, kx = ck + (bf2f(uk[k]) - ck) * muk, vx = cv + (bf2f(uv[k]) - cv) * muv;
        const float a = bf2f(ua[k]);
        const float kxn = kx * kkw_, kp = kx * (1.0f + (a - 1.0f) * kaw_);
        const float ss = wave_sum_dpp(kxn * kxn);
        const float inv = __builtin_amdgcn_rsqf(fmaxf(ss, 1e-24f));
        const float br = wave_sum_dpp(kxn * inv * a * r), kr = wave_sum_dpp(kp * r), bon = wave_sum_dpp(r * kp * rkw_);
        if ((tid & 63) == 0) *(f32x4*)(c.BON + ((size_t)t * 8 + (tid >> 6)) * 4) = (f32x4){inv, br, kr, bon};
        const size_t o = (size_t)t * 512 + ch;
        c.F[o] = f2bf(r); c.F[o + (size_t)NT * 512] = f2bf(kx); c.F[o + (size_t)2 * NT * 512] = f2bf(vx);
    }
}

DI void phase_poolgemm(const Ctx& c, unsigned char* lds) {
    for (int item = blockIdx.x; item < NT / 8; item += gridDim.x) rwkv_finalize_item(c, item);
    const int n_pool = (NT / 256) * 4, n_items = n_pool + 32;
    for (int item = blockIdx.x; item < n_items; item += gridDim.x) {
        f32x4 acc[4][4]; acc_zero(acc);
        if (item < n_pool) {
            const int tm = item >> 2, gi = item & 3, m0 = tm * 256;
            const ARows ar = plain_rows(c.POOLED + gi * 128, 512, m0, TID());
            gemm_core<0>(acc, ar, (const bf16_t*)(c.ws + WS_WT_POOL) + (size_t)gi * 128 * 128, 128, 128, lds);
            const float* sc = c.in(I_POOLS) + c.l * 512 + gi * 128;
            ACC_FOREACH(acc, { const f32x4 s = *(const f32x4*)(sc + c_);
                store_bf4(c.POOLED + (size_t)(m0 + r_) * 512 + gi * 128 + c_, (f32x4){v_[0] * s[0], v_[1] * s[1], v_[2] * s[2], v_[3] * s[3]}); });
        } else {
            const int it = item - n_pool, kv = it >> 4, tm = it & 15, m0 = tm * 256;
            const ARows ar = plain_rows(c.CMPH + (size_t)kv * 4096 * 256, 256, m0, TID());
            gemm_core<0>(acc, ar, (const bf16_t*)(c.ws + WS_WT_C2) + (size_t)kv * 128 * 256, 256, 256, lds);
            ACC_FOREACH(acc, { if (c_ < 64) { const int R = m0 + r_;
                if (kv == 0) store_bf4(c.KC + (size_t)R * 64 + c_, v_);
                else { bf16_t* q = c.VCT + ((size_t)(R >> 8) * 64 + c_) * 256 + (R & 255); q[0] = f2bf(v_[0]); q[256] = f2bf(v_[1]); q[512] = f2bf(v_[2]); q[768] = f2bf(v_[3]); } } });
        }
    }
}

constexpr int SCH = 32;
constexpr int SB_AN = 0, SB_WR = SCH * 64 * 4, SB_W = 2 * SCH * 64 * 4, SB_BB = 3 * SCH * 64 * 4, SB_KP = 4 * SCH * 64 * 4;
constexpr int SB_V = 5 * SCH * 64 * 4;
constexpr int SB_SC = SB_V + SCH * 16 * 4;
constexpr int SB_Y = SB_SC + SCH * 2 * 4;
constexpr int SB_BYTES = SB_Y + SCH * 16 * 4;
static_assert(2 * SB_BYTES <= LDS_BYTES - 64, "scan lds");
typedef float f32x2 __attribute__((ext_vector_type(2)));
DI float row8_sum(float v) { v += DPP_MOV(v, 0xB1); v += DPP_MOV(v, 0x4E); v += DPP_MOV(v, 0x141); return v; }

constexpr int NPW = 6, NJ = (SCH + NPW - 1) / NPW;
struct PrepRegs { bf16_t r[NJ], k[NJ], v[NJ], e[NJ], a[NJ]; float s0[NJ], s1[NJ], s2[NJ]; };
DI void prep_load(PrepRegs& R, const Ctx& c, int b, int h, int ck, int pw, int lane) {
    const size_t PL = (size_t)NT * 512;
    const size_t tb = (size_t)b * SEQ + ck * SCH;
    const size_t o0 = tb * 512 + h * 64 + lane;
#pragma unroll
    for (int j = 0; j < NJ; ++j) {
        const int st = pw + NPW * j;
        if (st < SCH) { const size_t o = o0 + (size_t)st * 512; R.r[j] = c.F[o]; R.k[j] = c.F[o + PL]; R.v[j] = c.F[o + 2 * PL]; R.e[j] = c.F[o + 3 * PL]; R.a[j] = c.F[o + 4 * PL];
            const float* sp = c.BON + ((tb + st) * 8 + h) * 4; R.s0[j] = sp[0]; R.s1[j] = sp[1]; R.s2[j] = sp[2]; }
    }
}
DI void prep_store(const PrepRegs& R, unsigned char* sb, int rq, int pw, int lane, float kkw, float kaw) {
    float* an = (float*)(sb + SB_AN); float* wr = (float*)(sb + SB_WR); float* w_ = (float*)(sb + SB_W); float* bb_ = (float*)(sb + SB_BB); float* kp_ = (float*)(sb + SB_KP);
    float* vv = (float*)(sb + SB_V); float* sc = (float*)(sb + SB_SC);
#pragma unroll
    for (int j = 0; j < NJ; ++j) {
        const int st = pw + NPW * j;
        if (st < SCH) {
            const float r = bf2f(R.r[j]), k = bf2f(R.k[j]), v = bf2f(R.v[j]), e = bf2f(R.e[j]), a = bf2f(R.a[j]);
            const float w = __expf(-e);
            const float kk = k * kkw * R.s0[j];
            const float kp = k * (1.0f + (a - 1.0f) * kaw);
            an[st * 64 + lane] = -kk; wr[st * 64 + lane] = w * r; w_[st * 64 + lane] = w; bb_[st * 64 + lane] = kk * a; kp_[st * 64 + lane] = kp;
            if ((lane >> 4) == rq) vv[st * 16 + (lane & 15)] = v;
            if (lane == 0) { sc[st * 2] = R.s1[j]; sc[st * 2 + 1] = R.s2[j]; }
        }
    }
}
DI void scan_item(const Ctx& c, int item, unsigned char* lds) {
    const int tid = TID(), lane = tid & 63, wave = tid >> 6;
    const int b = item >> 5, h = (item >> 2) & 7, rq = item & 3;
    const int chn = h * 64 + lane;
    const float kkw = c.in(I_KK)[c.l * 512 + chn], kaw = c.in(I_KA)[c.l * 512 + chn];
    const int rowl = (tid & 127) >> 3, cg = tid & 7;
    f32x2 st[4];
#pragma unroll
    for (int i = 0; i < 4; ++i) st[i] = (f32x2){0.f, 0.f};
    constexpr int NCK = SEQ / SCH;
    PrepRegs R;
    __syncthreads();
    if (wave >= 2) { prep_load(R, c, b, h, 0, wave - 2, lane); prep_store(R, lds, rq, wave - 2, lane, kkw, kaw); prep_load(R, c, b, h, 1, wave - 2, lane); }
    __syncthreads();
    for (int ck = 0; ck < NCK; ++ck) {
        unsigned char* sb = lds + (ck & 1) * SB_BYTES;
        if (wave < 2) {
            const float* an = (const float*)(sb + SB_AN) + cg * 8; const float* wr = (const float*)(sb + SB_WR) + cg * 8; const float* w_ = (const float*)(sb + SB_W) + cg * 8;
            const float* bb_ = (const float*)(sb + SB_BB) + cg * 8; const float* kp_ = (const float*)(sb + SB_KP) + cg * 8;
            const float* vv = (const float*)(sb + SB_V) + rowl; const float* sc = (const float*)(sb + SB_SC); float* yb = (float*)(sb + SB_Y) + rowl;
            f32x4 a0 = *(const f32x4*)(an), a1 = *(const f32x4*)(an + 4), r0 = *(const f32x4*)(wr), r1 = *(const f32x4*)(wr + 4);
            f32x4 w0 = *(const f32x4*)(w_), w1 = *(const f32x4*)(w_ + 4), b0 = *(const f32x4*)(bb_), b1 = *(const f32x4*)(bb_ + 4);
            f32x4 k0 = *(const f32x4*)(kp_), k1 = *(const f32x4*)(kp_ + 4);
            float v = vv[0]; f32x2 bk = *(const f32x2*)(sc);
#pragma unroll 2
            for (int s = 0; s < SCH; ++s) {
                const int sn = (s + 1 < SCH) ? s + 1 : s;
                const f32x4 na0 = *(const f32x4*)(an + sn * 64), na1 = *(const f32x4*)(an + sn * 64 + 4), nr0 = *(const f32x4*)(wr + sn * 64), nr1 = *(const f32x4*)(wr + sn * 64 + 4);
                const f32x4 nw0 = *(const f32x4*)(w_ + sn * 64), nw1 = *(const f32x4*)(w_ + sn * 64 + 4), nb0 = *(const f32x4*)(bb_ + sn * 64), nb1 = *(const f32x4*)(bb_ + sn * 64 + 4);
                const f32x4 nk0 = *(const f32x4*)(kp_ + sn * 64), nk1 = *(const f32x4*)(kp_ + sn * 64 + 4);
                const float nv = vv[sn * 16]; const f32x2 nbk = *(const f32x2*)(sc + sn * 2);
                f32x2 da = st[0] * (f32x2){a0[0], a0[1]}; f32x2 dr = st[0] * (f32x2){r0[0], r0[1]};
                da += st[1] * (f32x2){a0[2], a0[3]}; dr += st[1] * (f32x2){r0[2], r0[3]};
                da += st[2] * (f32x2){a1[0], a1[1]}; dr += st[2] * (f32x2){r1[0], r1[1]};
                da += st[3] * (f32x2){a1[2], a1[3]}; dr += st[3] * (f32x2){r1[2], r1[3]};
                float sa = da[0] + da[1], sr = dr[0] + dr[1];
                sa += DPP_MOV(sa, 0xB1); sr += DPP_MOV(sr, 0xB1);
                sa += DPP_MOV(sa, 0x4E); sr += DPP_MOV(sr, 0x4E);
                sa += DPP_MOV(sa, 0x141); sr += DPP_MOV(sr, 0x141);
                const f32x2 sa2 = (f32x2){sa, sa}, v2 = (f32x2){v, v};
                st[0] = st[0] * (f32x2){w0[0], w0[1]} + sa2 * (f32x2){b0[0], b0[1]} + v2 * (f32x2){k0[0], k0[1]};
                st[1] = st[1] * (f32x2){w0[2], w0[3]} + sa2 * (f32x2){b0[2], b0[3]} + v2 * (f32x2){k0[2], k0[3]};
                st[2] = st[2] * (f32x2){w1[0], w1[1]} + sa2 * (f32x2){b1[0], b1[1]} + v2 * (f32x2){k1[0], k1[1]};
                st[3] = st[3] * (f32x2){w1[2], w1[3]} + sa2 * (f32x2){b1[2], b1[3]} + v2 * (f32x2){k1[2], k1[3]};
                yb[s * 16] = sr + sa * bk[0] + v * bk[1];
                a0 = na0; a1 = na1; r0 = nr0; r1 = nr1; w0 = nw0; w1 = nw1; b0 = nb0; b1 = nb1; k0 = nk0; k1 = nk1; v = nv; bk = nbk;
            }
        } else {
            const int pt = tid - 128;
            if (ck + 1 < NCK) prep_store(R, lds + ((ck + 1) & 1) * SB_BYTES, rq, wave - 2, lane, kkw, kaw);
            if (ck + 2 < NCK) prep_load(R, c, b, h, ck + 2, wave - 2, lane);
            if (ck > 0) {
                const float* yb = (const float*)(lds + ((ck - 1) & 1) * SB_BYTES + SB_Y);
                for (int idx = pt; idx < SCH * 16; idx += 384) {
                    const int s = idx >> 4, j = idx & 15;
                    c.YRAW[((size_t)b * SEQ + (ck - 1) * SCH + s) * 512 + h * 64 + rq * 16 + j] = f2bf(yb[idx]);
                }
            }
        }
        asm volatile("s_waitcnt lgkmcnt(0)" ::: "memory"); __builtin_amdgcn_s_barrier(); asm volatile("" ::: "memory");
    }
    {
        const float* yb = (const float*)(lds + ((NCK - 1) & 1) * SB_BYTES + SB_Y);
        for (int idx = tid; idx < SCH * 16; idx += NTHREADS) {
            const int s = idx >> 4, j = idx & 15;
            c.YRAW[((size_t)b * SEQ + (NCK - 1) * SCH + s) * 512 + h * 64 + rq * 16 + j] = f2bf(yb[idx]);
        }
    }
    __syncthreads();
}
constexpr int CS64 = 72, CS32 = 40;
constexpr int CK_AH = 0, CK_BH = CK_AH + 32 * CS64 * 2, CK_KH = CK_BH + 32 * CS64 * 2, CK_RH = CK_KH + 32 * CS64 * 2, CK_W = CK_RH + 32 * CS64 * 2;
constexpr int CK_AHT = CK_W + 32 * CS64 * 2, CK_BHT = CK_AHT + 64 * CS32 * 2, CK_KHT = CK_BHT + 64 * CS32 * 2, CK_VT = CK_KHT + 64 * CS32 * 2, CK_XT = CK_VT + 64 * CS32 * 2, CK_UT = CK_XT + 64 * CS32 * 2;
constexpr int CK_S0B = CK_UT + 64 * CS32 * 2;
constexpr int CK_LAK = CK_S0B + 2 * 64 * CS64 * 2, CK_MRB = CK_LAK + 32 * CS32 * 2, CK_MRK = CK_MRB + 32 * CS32 * 2;
constexpr int CK_PA = CK_MRK + 32 * CS32 * 2, CK_PT = CK_PA + 2 * 32 * CS32 * 2, CK_TT = CK_PT + 2 * 32 * CS32 * 2;
constexpr int CK_CUM = CK_TT + 2 * 32 * CS32 * 2;
constexpr int CK_GC = CK_CUM + 32 * 64 * 4;
constexpr int CK_END = CK_GC + 256;
static_assert(CK_END <= LDS_BYTES - 64, "chunk scan lds");
template <int K>
DI f32x4 mm16(const bf16_t* A, int lda, const bf16_t* Bt, int ldb, f32x4 acc, int lane) {
#pragma unroll
    for (int k0 = 0; k0 < K; k0 += 32) {
        const bf16x8 a = *(const bf16x8*)(A + (lane & 15) * lda + k0 + (lane >> 4) * 8), b = *(const bf16x8*)(Bt + (lane & 15) * ldb + k0 + (lane >> 4) * 8);
        acc = __builtin_amdgcn_mfma_f32_16x16x32_bf16(a, b, acc, 0, 0, 0);
    }
    return acc;
}
template <int K>
DI f32x4 mm16t(const bf16_t* A, int lda, const bf16_t* Bt, int ldb, f32x4 acc, int lane) {
#pragma unroll
    for (int k0 = 0; k0 < K; k0 += 32) {
        const bf16x8 a = *(const bf16x8*)(A + (lane & 15) * lda + k0 + (lane >> 4) * 8), b = *(const bf16x8*)(Bt + (lane & 15) * ldb + k0 + (lane >> 4) * 8);
        acc = __builtin_amdgcn_mfma_f32_16x16x32_bf16(b, a, acc, 0, 0, 0);
    }
    return acc;
}
struct ChunkRaw { u32x2 r, k, v, e, a; float inv; };
DI void chunk_load(ChunkRaw& R, const Ctx& c, int b, int h, int ck, int tid) {
    const size_t PL = (size_t)NT * 512;
    const int t = tid >> 4, c4 = (tid & 15) * 4;
    const size_t tok = (size_t)b * SEQ + ck * 32 + t, o = tok * 512 + h * 64 + c4;
    R.r = *(const u32x2*)(c.F + o); R.k = *(const u32x2*)(c.F + o + PL); R.v = *(const u32x2*)(c.F + o + 2 * PL); R.e = *(const u32x2*)(c.F + o + 3 * PL); R.a = *(const u32x2*)(c.F + o + 4 * PL);
    R.inv = c.BON[(tok * 8 + h) * 4];
}
DI void scan_chunked_item(const Ctx& c, int item, unsigned char* lds) {
    const int tid = TID(), lane = tid & 63, wave = tid >> 6, qd = lane >> 4, l15 = lane & 15;
    const int b = item >> 3, h = item & 7;
    bf16_t* AH = (bf16_t*)(lds + CK_AH); bf16_t* BH = (bf16_t*)(lds + CK_BH); bf16_t* KH = (bf16_t*)(lds + CK_KH); bf16_t* RH = (bf16_t*)(lds + CK_RH); bf16_t* Wm = (bf16_t*)(lds + CK_W);
    bf16_t* AHT = (bf16_t*)(lds + CK_AHT); bf16_t* BHT = (bf16_t*)(lds + CK_BHT); bf16_t* KHT = (bf16_t*)(lds + CK_KHT); bf16_t* VT = (bf16_t*)(lds + CK_VT); bf16_t* XT = (bf16_t*)(lds + CK_XT); bf16_t* UT = (bf16_t*)(lds + CK_UT);
    bf16_t* S0B = (bf16_t*)(lds + CK_S0B); bf16_t* LAK = (bf16_t*)(lds + CK_LAK); bf16_t* MRB = (bf16_t*)(lds + CK_MRB); bf16_t* MRK = (bf16_t*)(lds + CK_MRK);
    bf16_t* PA = (bf16_t*)(lds + CK_PA); bf16_t* PT = (bf16_t*)(lds + CK_PT); bf16_t* TT = (bf16_t*)(lds + CK_TT);
    float* CUM = (float*)(lds + CK_CUM); float* GC = (float*)(lds + CK_GC);
    const f32x4 Z4 = (f32x4){0.f, 0.f, 0.f, 0.f};
    f32x4 Sreg[2] = {Z4, Z4};
    const int svt = wave >> 1, skt0 = 2 * (wave & 1);
    __syncthreads();
    for (int i = tid; i < 2 * 64 * CS64 / 2; i += NTHREADS) ((unsigned*)S0B)[i] = 0u;
    const int pt = tid >> 4, pc = (tid & 15) * 4;
    float kkw4[4], kaw4[4];
#pragma unroll
    for (int j = 0; j < 4; ++j) { kkw4[j] = c.in(I_KK)[c.l * 512 + h * 64 + pc + j]; kaw4[j] = c.in(I_KA)[c.l * 512 + h * 64 + pc + j]; }
    ChunkRaw R; chunk_load(R, c, b, h, 0, tid);
    constexpr int NCK = SEQ / 32;
    for (int ck = 0; ck < NCK; ++ck) {
        const bf16_t* S0c = S0B + (ck & 1) * 64 * CS64; bf16_t* S0n = S0B + ((ck + 1) & 1) * 64 * CS64;
        float r4[4], k4[4], v4[4], e4[4], a4[4];
        { const unsigned rw[2] = {R.r.x, R.r.y}, kw[2] = {R.k.x, R.k.y}, vw[2] = {R.v.x, R.v.y}, ew[2] = {R.e.x, R.e.y}, aw[2] = {R.a.x, R.a.y};
#pragma unroll
          for (int j = 0; j < 2; ++j) { r4[2 * j] = bflo(rw[j]); r4[2 * j + 1] = bfhi(rw[j]); k4[2 * j] = bflo(kw[j]); k4[2 * j + 1] = bfhi(kw[j]); v4[2 * j] = bflo(vw[j]); v4[2 * j + 1] = bfhi(vw[j]);
              e4[2 * j] = bflo(ew[j]); e4[2 * j + 1] = bfhi(ew[j]); a4[2 * j] = bflo(aw[j]); a4[2 * j + 1] = bfhi(aw[j]); } }
        const float inv = R.inv;
        *(f32x4*)(CUM + pt * 64 + pc) = (f32x4){e4[0], e4[1], e4[2], e4[3]};
        __syncthreads();
        if (ck + 1 < NCK) chunk_load(R, c, b, h, ck + 1, tid);
        if (tid < 64) { float s = 0.f;
#pragma unroll 8
            for (int t = 0; t < 32; ++t) { s += CUM[t * 64 + tid]; CUM[t * 64 + tid] = s; } }
        __syncthreads();
        {
            const f32x4 cs = *(const f32x4*)(CUM + pt * 64 + pc);
            f32x4 cp = Z4; if (pt > 0) cp = *(const f32x4*)(CUM + (pt - 1) * 64 + pc);
            float ah[4], bh[4], kh[4], rh[4];
#pragma unroll
            for (int j = 0; j < 4; ++j) {
                const float g = __expf(-cs[j]), gi = __expf(cs[j]), gm1 = __expf(-cp[j]);
                const float kk = k4[j] * kkw4[j] * inv, kp = k4[j] * (1.0f + (a4[j] - 1.0f) * kaw4[j]);
                ah[j] = -kk * gm1; bh[j] = kk * a4[j] * gi; kh[j] = kp * gi; rh[j] = r4[j] * g;
                if (pt == 31) GC[pc + j] = g;
            }
            store_bf4(AH + pt * CS64 + pc, (f32x4){ah[0], ah[1], ah[2], ah[3]}); store_bf4(BH + pt * CS64 + pc, (f32x4){bh[0], bh[1], bh[2], bh[3]});
            store_bf4(KH + pt * CS64 + pc, (f32x4){kh[0], kh[1], kh[2], kh[3]}); store_bf4(RH + pt * CS64 + pc, (f32x4){rh[0], rh[1], rh[2], rh[3]});
#pragma unroll
            for (int j = 0; j < 4; ++j) { AHT[(pc + j) * CS32 + pt] = f2bf(ah[j]); BHT[(pc + j) * CS32 + pt] = f2bf(bh[j]); KHT[(pc + j) * CS32 + pt] = f2bf(kh[j]); VT[(pc + j) * CS32 + pt] = f2bf(v4[j]); }
        }
        __syncthreads();
        {
            const int q = wave >> 1, mt = wave & 1;
            const bf16_t* A = (q < 2) ? AH : RH; const bf16_t* Bt = (q & 1) ? KH : BH;
#pragma unroll
            for (int nt = 0; nt < 2; ++nt) {
                f32x4 acc = mm16t<64>(A + mt * 16 * CS64, CS64, Bt + nt * 16 * CS64, CS64, Z4, lane);
                const int m = mt * 16 + l15, n0 = nt * 16 + 4 * qd;
#pragma unroll
                for (int i = 0; i < 4; ++i) { const bool keep = (q < 2) ? (n0 + i < m) : (n0 + i <= m); if (!keep) acc[i] = 0.f; }
                if (q == 0) {
                    store_bf4(PA + m * CS32 + n0, acc);
#pragma unroll
                    for (int i = 0; i < 4; ++i) PT[(n0 + i) * CS32 + m] = f2bf(acc[i]);
                    f32x4 t0 = acc;
#pragma unroll
                    for (int i = 0; i < 4; ++i) if (n0 + i == m) t0[i] += 1.0f;
                    store_bf4(TT + m * CS32 + n0, t0);
                } else store_bf4(((q == 1) ? LAK : ((q == 2) ? MRB : MRK)) + m * CS32 + n0, acc);
            }
        }
        __syncthreads();
        int pcur = 0, tcur = 0;
#pragma unroll 1
        for (int itn = 0; itn < 5; ++itn) {
            const int mt = (wave >> 1) & 1, nt = wave & 1, m = mt * 16 + l15, n0 = nt * 16 + 4 * qd;
            if (wave < 4) {
                if (itn < 4) {
                    const f32x4 acc = mm16t<32>(PA + pcur * 32 * CS32 + mt * 16 * CS32, CS32, PT + pcur * 32 * CS32 + nt * 16 * CS32, CS32, Z4, lane);
                    store_bf4(PA + (pcur ^ 1) * 32 * CS32 + m * CS32 + n0, acc);
#pragma unroll
                    for (int i = 0; i < 4; ++i) PT[(pcur ^ 1) * 32 * CS32 + (n0 + i) * CS32 + m] = f2bf(acc[i]);
                }
            } else if (itn > 0) {
                const u32x2 told = *(const u32x2*)(TT + tcur * 32 * CS32 + m * CS32 + n0);
                f32x4 acc = (f32x4){bflo(told.x), bfhi(told.x), bflo(told.y), bfhi(told.y)};
                acc = mm16t<32>(TT + tcur * 32 * CS32 + mt * 16 * CS32, CS32, PT + pcur * 32 * CS32 + nt * 16 * CS32, CS32, acc, lane);
                store_bf4(TT + (tcur ^ 1) * 32 * CS32 + m * CS32 + n0, acc);
            }
            __syncthreads();
            if (itn < 4) pcur ^= 1;
            if (itn > 0) tcur ^= 1;
        }
        const bf16_t* Tm = TT + tcur * 32 * CS32;
        const int mt8 = wave >> 2, nt8 = wave & 3;
        {
            const f32x4 wacc = mm16t<32>(Tm + mt8 * 16 * CS32, CS32, AHT + nt8 * 16 * CS32, CS32, Z4, lane);
            store_bf4(Wm + (mt8 * 16 + l15) * CS64 + nt8 * 16 + 4 * qd, wacc);
            const f32x4 xacc = mm16<32>(LAK + mt8 * 16 * CS32, CS32, VT + nt8 * 16 * CS32, CS32, Z4, lane);
            store_bf4(XT + (nt8 * 16 + l15) * CS32 + mt8 * 16 + 4 * qd, xacc);
        }
        __syncthreads();
        {
            f32x4 uacc = mm16<32>(Tm + mt8 * 16 * CS32, CS32, XT + nt8 * 16 * CS32, CS32, Z4, lane);
            uacc = mm16<64>(Wm + mt8 * 16 * CS64, CS64, S0c + nt8 * 16 * CS64, CS64, uacc, lane);
            store_bf4(UT + (nt8 * 16 + l15) * CS32 + mt8 * 16 + 4 * qd, uacc);
        }
        __syncthreads();
        {
            f32x4 y = mm16t<64>(RH + mt8 * 16 * CS64, CS64, S0c + nt8 * 16 * CS64, CS64, Z4, lane);
            y = mm16t<32>(MRB + mt8 * 16 * CS32, CS32, UT + nt8 * 16 * CS32, CS32, y, lane);
            y = mm16t<32>(MRK + mt8 * 16 * CS32, CS32, VT + nt8 * 16 * CS32, CS32, y, lane);
            store_bf4(c.YRAW + ((size_t)b * SEQ + ck * 32 + mt8 * 16 + l15) * 512 + h * 64 + nt8 * 16 + 4 * qd, y);
#pragma unroll
            for (int j = 0; j < 2; ++j) {
                const int kt = skt0 + j;
                f32x4 s = Sreg[j];
                s = mm16t<32>(UT + svt * 16 * CS32, CS32, BHT + kt * 16 * CS32, CS32, s, lane);
                s = mm16t<32>(VT + svt * 16 * CS32, CS32, KHT + kt * 16 * CS32, CS32, s, lane);
                const f32x4 gc = *(const f32x4*)(GC + kt * 16 + 4 * qd);
                s = s * gc;
                Sreg[j] = s;
                store_bf4(S0n + (svt * 16 + l15) * CS64 + kt * 16 + 4 * qd, s);
            }
        }
        __syncthreads();
    }
}
DI void phase_rwkv_post(const Ctx& c, unsigned char* lds) {
    const int tid = TID(), lane = tid & 63, wave = tid >> 6;
    const size_t PL = (size_t)NT * 512;
    for (int t = blockIdx.x * 8 + wave; t < NT; t += gridDim.x * 8) {
        bf16_t ry[8], rv[8], rg[8]; float bon[8], gw[8], gb[8];
#pragma unroll
        for (int h = 0; h < 8; ++h) { const size_t o = (size_t)t * 512 + h * 64 + lane; ry[h] = c.YRAW[o]; rv[h] = c.F[o + 2 * PL]; rg[h] = c.F[o + 5 * PL]; bon[h] = c.BON[((size_t)t * 8 + h) * 4 + 3];
            gw[h] = c.in(I_GNW)[c.l * 512 + h * 64 + lane]; gb[h] = c.in(I_GNB)[c.l * 512 + h * 64 + lane]; }
#pragma unroll
        for (int h = 0; h < 8; ++h) {
            const float y = bf2f(ry[h]);
            const float mean = wave_sum_dpp(y) * (1.0f / 64.0f);
            const float d = y - mean;
            const float var = wave_sum_dpp(d * d) * (1.0f / 64.0f);
            const float yn = d * rsqrtf(var + 64e-5f) * gw[h] + gb[h];
            c.F[(size_t)t * 512 + h * 64 + lane + 5 * PL] = f2bf((yn + bon[h] * bf2f(rv[h])) * bf2f(rg[h]));
        }
    }
    for (int it = blockIdx.x * 4; it < 768 + 128 + 128 + 256 + 256; it += gridDim.x * 4) {
        const float* WB = c.in(I_WBR) + (size_t)c.l * 2048 * DM; bf16_t* BR = (bf16_t*)(c.ws + WS_WT_BR);
        if (it < 768) convert_tile4(c.in(I_WMG) + (size_t)c.l * DM * 3 * DM, 3 * DM, 3 * DM, DM, (bf16_t*)(c.ws + WS_WT_MG), it, lds);
        else if (it < 896) convert_tile4(WB, DM, DM, 512, BR, it - 768, lds);
        else if (it < 1024) convert_tile4(WB + (size_t)512 * DM, DM, DM, 512, BR + (size_t)1024 * 512, it - 896, lds);
        else if (it < 1280) convert_tile4(WB + (size_t)1024 * DM, DM, DM, 1024, BR + (size_t)2048 * 512, it - 1024, lds);
        else convert_tile4(c.in(I_WOUT) + (size_t)c.l * DM * DM, DM, DM, DM, (bf16_t*)(c.ws + WS_WT_OUT), it - 1280, lds);
    }
}
constexpr int TS = 72;
constexpr int NSA_BIAS = 0;
constexpr int NSA_SELM = 2112;
constexpr int NSA_SCR = 2624;
constexpr int NSA_K0 = 4672;
constexpr int NSA_V0 = NSA_K0 + 2 * 64 * TS * 2;
constexpr int NSA_A = NSA_V0 + 2 * 64 * TS * 2;
constexpr int NSA_B = NSA_A + 16384;
constexpr int NSA_END = NSA_B + 16384;
static_assert(NSA_END <= LDS_BYTES - 16, "nsa lds");
static_assert(NSA_K0 % 16 == 0, "align");

struct NsaLane { int tq[2]; int h; float cbias; float m[2], l[2]; };

DI void nsa_prefetch(u32x4& rk, u32x4& rv, const bf16_t* kbase, int kstride, const bf16_t* vtbase, int vstride, int pos0, int tid) {
    const int r = tid >> 3, seg = (tid & 7) * 8;
    rk = *(const u32x4*)(kbase + (size_t)(pos0 + r) * kstride + seg);
    rv = *(const u32x4*)(vtbase + (size_t)r * vstride + pos0 + seg);
}
DI void nsa_store(unsigned char* lds, int buf, const u32x4& rk, const u32x4& rv, int tid) {
    const int r = tid >> 3, seg = (tid & 7) * 8;
    *(u32x4*)((bf16_t*)(lds + NSA_K0) + buf * 64 * TS + r * TS + seg) = rk;
    *(u32x4*)((bf16_t*)(lds + NSA_V0) + buf * 64 * TS + r * TS + seg) = rv;
}
template <int QM = 3>
DI void nsa_qk(f32x4 (&s)[2][4], const bf16_t* sK, const bf16x8 (&qf)[2][2], int lane) {
#pragma unroll
    for (int kt = 0; kt < 4; ++kt) {
#pragma unroll
        for (int ks = 0; ks < 2; ++ks) {
            const bf16x8 kf = *(const bf16x8*)(sK + (16 * kt + (lane & 15)) * TS + 32 * ks + (lane >> 4) * 8);
#pragma unroll
            for (int qi = 0; qi < 2; ++qi) if ((QM >> qi) & 1) s[qi][kt] = __builtin_amdgcn_mfma_f32_16x16x32_bf16(kf, qf[qi][ks], (ks == 0) ? (f32x4){0.f, 0.f, 0.f, 0.f} : s[qi][kt], 0, 0, 0);
        }
    }
}
template <int MODE>
DI void nsa_logits(float (&x)[4][4], const f32x4 (&s)[4], int tq, int h, float cbias, bool rowsel, int pos0, int qd, const float* biasT) {
#pragma unroll
    for (int kt = 0; kt < 4; ++kt)
#pragma unroll
        for (int i = 0; i < 4; ++i) {
            const int kk = pos0 + 16 * kt + 4 * qd + i;
            if (MODE == 1) { x[kt][i] = rowsel ? s[kt][i] + cbias : -INFINITY; }
            else {
                const int dist = (MODE == 0) ? (tq - 16 * kk - 31) : (tq - kk);
                bool ok = dist >= 0;
                if (MODE == 2) ok = ok && rowsel;
                if (MODE == 3) ok = ok && (dist < 512);
                const int di = dist < 0 ? 0 : (dist > 128 ? 128 : dist);
                float bias = biasT[di * 4 + h];
                asm volatile("" : "+v"(bias));
                x[kt][i] = ok ? s[kt][i] + bias : -INFINITY;
            }
        }
}
DI float quad16_max(float v) { v = fmaxf(v, __shfl_xor(v, 16)); v = fmaxf(v, __shfl_xor(v, 32)); return v; }
DI float quad16_sum(float v) { v += __shfl_xor(v, 16); v += __shfl_xor(v, 32); return v; }
DI void nsa_softmax(const float (&x)[4][4], float& m, float& l, f32x4 (&O)[4], bf16x8 (&pf)[2]) {
    float mx = -INFINITY;
#pragma unroll
    for (int kt = 0; kt < 4; ++kt)
#pragma unroll
        for (int i = 0; i < 4; ++i) mx = fmaxf(mx, x[kt][i]);
    mx = quad16_max(mx);
    const float mn = fmaxf(m, mx);
    const float mu = (mn == -INFINITY) ? 0.f : mn;
    const float mu2 = mu * 1.4426950408889634f;
    const float sc = __builtin_amdgcn_exp2f(__builtin_fmaf(m, 1.4426950408889634f, -mu2));
    float p[4][4]; float ps = 0.f;
#pragma unroll
    for (int kt = 0; kt < 4; ++kt)
#pragma unroll
        for (int i = 0; i < 4; ++i) { p[kt][i] = __builtin_amdgcn_exp2f(__builtin_fmaf(x[kt][i], 1.4426950408889634f, -mu2)); ps += p[kt][i]; }
    l = l * sc + ps; m = mn;
#pragma unroll
    for (int dt = 0; dt < 4; ++dt) O[dt] = O[dt] * sc;
#pragma unroll
    for (int ks = 0; ks < 2; ++ks) {
        u32x4 w; w.x = pack2(p[2 * ks][0], p[2 * ks][1]); w.y = pack2(p[2 * ks][2], p[2 * ks][3]); w.z = pack2(p[2 * ks + 1][0], p[2 * ks + 1][1]); w.w = pack2(p[2 * ks + 1][2], p[2 * ks + 1][3]);
        pf[ks] = __builtin_bit_cast(bf16x8, w);
    }
}
template <int QM = 3>
DI void nsa_pv(f32x4 (&O)[2][4], const bf16_t* sV, const bf16x8 (&pf)[2][2], int lane) {
    const int qd = lane >> 4;
#pragma unroll
    for (int dt = 0; dt < 4; ++dt)
#pragma unroll
        for (int ks = 0; ks < 2; ++ks) {
            const bf16_t* vp = sV + (16 * dt + (lane & 15)) * TS + 32 * ks + 4 * qd;
            const u32x2 a = *(const u32x2*)vp, b = *(const u32x2*)(vp + 16);
            u32x4 w; w.x = a.x; w.y = a.y; w.z = b.x; w.w = b.y;
            const bf16x8 vf = __builtin_bit_cast(bf16x8, w);
#pragma unroll
            for (int qi = 0; qi < 2; ++qi) if ((QM >> qi) & 1) O[qi][dt] = __builtin_amdgcn_mfma_f32_16x16x32_bf16(vf, pf[qi][ks], O[qi][dt], 0, 0, 0);
        }
}
template <int MODE, int QM = 3>
DI void nsa_tile(f32x4 (&O)[2][4], NsaLane& L, const bf16x8 (&qf)[2][2], const unsigned char* lds, int buf, int pos0, bool sel0, bool sel1, int lane) {
    const bf16_t* sK = (const bf16_t*)(lds + NSA_K0) + buf * 64 * TS;
    const bf16_t* sV = (const bf16_t*)(lds + NSA_V0) + buf * 64 * TS;
    const float* biasT = (const float*)(lds + NSA_BIAS);
    f32x4 s[2][4];
    nsa_qk<QM>(s, sK, qf, lane);
    bf16x8 pf[2][2];
#pragma unroll
    for (int qi = 0; qi < 2; ++qi) if ((QM >> qi) & 1) {
        float x[4][4];
        nsa_logits<MODE>(x, s[qi], L.tq[qi], L.h, L.cbias, qi ? sel1 : sel0, pos0, lane >> 4, biasT);
        nsa_softmax(x, L.m[qi], L.l[qi], O[qi], pf[qi]);
    }
    nsa_pv<QM>(O, sV, pf, lane);
}
template <int MODE>
DI void nsa_tile_sel(f32x4 (&O)[2][4], NsaLane& L, const bf16x8 (&qf)[2][2], const unsigned char* lds, int buf, int pos0, bool sel0, bool sel1, int lane) {
    const bool a0 = __ballot(sel0) != 0ull, a1 = __ballot(sel1) != 0ull;
    if (a0 && a1) nsa_tile<MODE, 3>(O, L, qf, lds, buf, pos0, sel0, sel1, lane);
    else if (a0) nsa_tile<MODE, 1>(O, L, qf, lds, buf, pos0, sel0, sel1, lane);
    else if (a1) nsa_tile<MODE, 2>(O, L, qf, lds, buf, pos0, sel0, sel1, lane);
}
DI void nsa_flush(f32x4 (&Y)[2][4], f32x4 (&O)[2][4], NsaLane& L, const float (&gate)[2]) {
#pragma unroll
    for (int qi = 0; qi < 2; ++qi) {
        const float lt = quad16_sum(L.l[qi]);
        const float f = (lt > 0.f) ? gate[qi] * __builtin_amdgcn_rcpf(lt) : 0.f;
#pragma unroll
        for (int dt = 0; dt < 4; ++dt) { Y[qi][dt] += O[qi][dt] * f; O[qi][dt] = (f32x4){0.f, 0.f, 0.f, 0.f}; }
    }
}
DI void nsa_item(const Ctx& c, int item, unsigned char* lds) {
    const int tid = TID(), lane = tid & 63, wave = tid >> 6, qd = lane >> 4;
    const int b = item >> 8, g = (item >> 6) & 3, qt = item & 63, t0 = qt * 64, cur = qt, bg = b * 4 + g;
    float* biasT = (float*)(lds + NSA_BIAS);
    unsigned long long* selm = (unsigned long long*)(lds + NSA_SELM);
    float* scr = (float*)(lds + NSA_SCR) + wave * 64;
    float* impA = (float*)(lds + NSA_A); float* impB = (float*)(lds + NSA_B);
    __syncthreads();
    for (int i = tid; i < 129 * 4; i += NTHREADS) { const int d = i >> 2, h = i & 3; biasT[i] = c.in(I_RELB)[t5_bucket(d) * 16 + g * 4 + h]; }
    for (int i = tid; i < 2 * 4096; i += NTHREADS) impA[i] = 0.f;
    NsaLane L; L.h = lane & 3;
    bf16x8 qf[2][2]; float gates[2][3];
    const bf16_t* pbat = c.PROJ + (size_t)b * SEQ * IN_COLS;
#pragma unroll
    for (int qi = 0; qi < 2; ++qi) {
        const int tl = 8 * wave + 4 * qi + ((lane & 15) >> 2);
        L.tq[qi] = t0 + tl;
        const bf16_t* prow = pbat + (size_t)L.tq[qi] * IN_COLS;
#pragma unroll
        for (int ks = 0; ks < 2; ++ks) {
            u32x4 w = *(const u32x4*)(prow + C_Q + (g * 4 + L.h) * 64 + 32 * ks + qd * 8);
            w.x = pack2(bflo(w.x) * 0.125f, bfhi(w.x) * 0.125f); w.y = pack2(bflo(w.y) * 0.125f, bfhi(w.y) * 0.125f);
            w.z = pack2(bflo(w.z) * 0.125f, bfhi(w.z) * 0.125f); w.w = pack2(bflo(w.w) * 0.125f, bfhi(w.w) * 0.125f);
            qf[qi][ks] = __builtin_bit_cast(bf16x8, w);
        }
#pragma unroll
        for (int br = 0; br < 3; ++br) gates[qi][br] = sigmoidf_(bf2f(prow[C_GATE + g * 12 + L.h * 3 + br]));
    }
    __syncthreads();
    L.cbias = biasT[128 * 4 + L.h];
    f32x4 O[2][4], Y[2][4];
#pragma unroll
    for (int qi = 0; qi < 2; ++qi)
#pragma unroll
        for (int dt = 0; dt < 4; ++dt) { O[qi][dt] = (f32x4){0.f, 0.f, 0.f, 0.f}; Y[qi][dt] = (f32x4){0.f, 0.f, 0.f, 0.f}; }
    u32x4 rk, rv;
    const int nvis_max = (t0 + 63 >= 31) ? ((t0 + 63 - 31) >> 4) + 1 : 0;
    const int ncb = (nvis_max + 63) >> 6;
    const bf16_t* kcb = c.KC + (size_t)bg * 256 * 64; const bf16_t* vcb = c.VCT + (size_t)bg * 64 * 256;
    L.m[0] = L.m[1] = -INFINITY; L.l[0] = L.l[1] = 0.f;
    if (ncb > 0) nsa_prefetch(rk, rv, kcb, 64, vcb, 256, 0, tid);
    for (int cb = 0; cb < ncb; ++cb) {
        nsa_store(lds, cb & 1, rk, rv, tid);
        __syncthreads();
        if (cb + 1 < ncb) nsa_prefetch(rk, rv, kcb, 64, vcb, 256, (cb + 1) * 64, tid);
        if (16 * (cb * 64 + 63) + 31 + 128 <= t0) nsa_tile<1>(O, L, qf, lds, cb & 1, cb * 64, true, true, lane);
        else nsa_tile<0>(O, L, qf, lds, cb & 1, cb * 64, true, true, lane);
    }
    if (ncb > 0) nsa_prefetch(rk, rv, kcb, 64, vcb, 256, 0, tid);
    float mfin[2], linv[2];
#pragma unroll
    for (int qi = 0; qi < 2; ++qi) { mfin[qi] = L.m[qi]; const float lt = quad16_sum(L.l[qi]); linv[qi] = (lt > 0.f) ? __builtin_amdgcn_rcpf(lt) : 0.f; }
    { const float gg[2] = {gates[0][0], gates[1][0]}; nsa_flush(Y, O, L, gg); }
    __syncthreads();
    for (int cb = 0; cb < ncb; ++cb) {
        nsa_store(lds, cb & 1, rk, rv, tid);
        __syncthreads();
        if (cb + 1 < ncb) nsa_prefetch(rk, rv, kcb, 64, vcb, 256, (cb + 1) * 64, tid);
        const bf16_t* sK = (const bf16_t*)(lds + NSA_K0) + (cb & 1) * 64 * TS;
        f32x4 s[2][4];
        nsa_qk(s, sK, qf, lane);
#pragma unroll
        for (int qi = 0; qi < 2; ++qi) {
            float x[4][4];
            nsa_logits<0>(x, s[qi], L.tq[qi], L.h, L.cbias, true, cb * 64, qd, biasT);
            const float mu = (mfin[qi] == -INFINITY) ? 0.f : mfin[qi];
#pragma unroll
            for (int kt = 0; kt < 4; ++kt) {
                float p3 = __expf(x[kt][3] - mu) * linv[qi];
                float pa = (__expf(x[kt][0] - mu) + __expf(x[kt][1] - mu) + __expf(x[kt][2] - mu)) * linv[qi] + p3;
                pa += __shfl_xor(pa, 1); p3 += __shfl_xor(p3, 1);
                pa += __shfl_xor(pa, 2); p3 += __shfl_xor(p3, 2);
                if (L.h == 0) { const int tl = 8 * wave + 4 * qi + ((lane & 15) >> 2), mi = 16 * cb + 4 * kt + qd; impA[tl * 64 + mi] = pa; impB[tl * 64 + mi] = p3; }
            }
        }
    }
    const bf16_t* ksb = pbat + C_KS + g * 64; const bf16_t* vsb = c.VT + ((size_t)0 * 16 + bg) * 64 * SEQ;
    nsa_prefetch(rk, rv, ksb, IN_COLS, vsb, SEQ, 0, tid);
    __syncthreads();
    for (int tl8 = 0; tl8 < 8; ++tl8) {
        const int tl = 8 * wave + tl8, n = lane;
        const bool cand = (n >= 1) && (n <= cur - 2);
        const float imp = cand ? impA[tl * 64 + n] + impB[tl * 64 + n - 1] : -1.0f;
        LDS_WAVE_SYNC();
        scr[n] = imp;
        LDS_WAVE_SYNC();
        int rank = 0;
#pragma unroll 4
        for (int q4 = 0; q4 < 16; ++q4) {
            const f32x4 o = *(const f32x4*)(scr + q4 * 4);
#pragma unroll
            for (int j = 0; j < 4; ++j) { const int n2 = q4 * 4 + j; rank += (o[j] > imp || (o[j] == imp && n2 < n)) ? 1 : 0; }
        }
        const bool forced = (n <= cur) && (n == 0 || n == cur || n == cur - 1);
        const unsigned long long msk = __ballot((cand && rank < 5) || forced);
        if (lane == 0) selm[tl] = msk;
    }
    __syncthreads();
    unsigned long long uni = selm[lane];
#pragma unroll
    for (int o = 32; o >= 1; o >>= 1) { const unsigned lo_ = __shfl_xor((unsigned)uni, o), hi_ = __shfl_xor((unsigned)(uni >> 32), o); uni |= ((unsigned long long)hi_ << 32) | lo_; }
    uni = ((unsigned long long)__builtin_amdgcn_readfirstlane((unsigned)(uni >> 32)) << 32) | (unsigned)__builtin_amdgcn_readfirstlane((unsigned)uni);
    unsigned long long sm[2];
#pragma unroll
    for (int qi = 0; qi < 2; ++qi) sm[qi] = selm[8 * wave + 4 * qi + ((lane & 15) >> 2)];
    L.m[0] = L.m[1] = -INFINITY; L.l[0] = L.l[1] = 0.f;
    {
        unsigned long long rem = uni; int it = 0;
        int j = (int)__builtin_ctzll(rem); rem &= rem - 1;
        for (;;) {
            nsa_store(lds, it & 1, rk, rv, tid);
            __syncthreads();
            const int jn = rem ? (int)__builtin_ctzll(rem) : -1;
            if (jn >= 0) { rem &= rem - 1; nsa_prefetch(rk, rv, ksb, IN_COLS, vsb, SEQ, jn * 64, tid); }
            const bool s0 = (sm[0] >> j) & 1ull, s1 = (sm[1] >> j) & 1ull;
            if (j <= cur - 3) nsa_tile_sel<1>(O, L, qf, lds, it & 1, j * 64, s0, s1, lane);
            else nsa_tile_sel<2>(O, L, qf, lds, it & 1, j * 64, s0, s1, lane);
            if (jn < 0) break;
            j = jn; ++it;
        }
    }
    const bf16_t* kwb = pbat + C_KW + g * 64; const bf16_t* vwb = c.VT + ((size_t)1 * 16 + bg) * 64 * SEQ;
    const int j0 = (cur - 8 > 0) ? cur - 8 : 0;
    nsa_prefetch(rk, rv, kwb, IN_COLS, vwb, SEQ, j0 * 64, tid);
    { const float gg[2] = {gates[0][1], gates[1][1]}; nsa_flush(Y, O, L, gg); }
    L.m[0] = L.m[1] = -INFINITY; L.l[0] = L.l[1] = 0.f;
    {
        __syncthreads();
        for (int j = j0; j <= cur; ++j) {
            nsa_store(lds, (j - j0) & 1, rk, rv, tid);
            __syncthreads();
            if (j + 1 <= cur) nsa_prefetch(rk, rv, kwb, IN_COLS, vwb, SEQ, (j + 1) * 64, tid);
            if (cur - j >= 3 && cur - j <= 7) nsa_tile<1>(O, L, qf, lds, (j - j0) & 1, j * 64, true, true, lane);
            else nsa_tile<3>(O, L, qf, lds, (j - j0) & 1, j * 64, true, true, lane);
        }
    }
    { const float gg[2] = {gates[0][2], gates[1][2]}; nsa_flush(Y, O, L, gg); }
#pragma unroll
    for (int qi = 0; qi < 2; ++qi) {
        bf16_t* yrow = c.PROJ + ((size_t)b * SEQ + L.tq[qi]) * IN_COLS + C_Q + (g * 4 + L.h) * 64;
#pragma unroll
        for (int dt = 0; dt < 4; ++dt) store_bf4(yrow + 16 * dt + 4 * qd, Y[qi][dt]);
    }
}
DI void phase_mix(const Ctx& c, unsigned char* lds) {
    const int G = gridDim.x, bid = blockIdx.x;
    const int n_nsa = NB * 4 * (SEQ / 64), n_scan = NB * 8;
    for (int item = bid; item < n_scan; item += G) scan_chunked_item(c, item, lds);
    unsigned* ctr = c.ctl + CW_Q + c.l;
    volatile int* sitem = (volatile int*)(lds + LDS_BYTES - 32);
    for (;;) {
        __syncthreads();
        if (TID() == 0) *sitem = (int)atomicAdd(ctr, 1u);
        __syncthreads();
        const int k = *sitem;
        if (k >= n_nsa) break;
        const int qt = 63 - (k >> 4), bgi = k & 15;
        nsa_item(c, (bgi << 6) | qt, lds);
    }
}

DI void phase_merge(const Ctx& c, unsigned char* lds) {
    const int nN = DM / 256;
    const bf16_t* WM = (const bf16_t*)(c.ws + WS_WT_MG);
    const bf16_t* BR = (const bf16_t*)(c.ws + WS_WT_BR);
    const float* BM_ = c.in(I_BMG) + (size_t)c.l * 3 * DM;
    bf16_t* TMP = c.F + (size_t)2 * NT * 512 + (size_t)blockIdx.x * 256 * 256;
    for (int it = 0;; ++it) {
        int tm, tn; if (!xcd_unit(it, nN, tm, tn)) break;
        const int m0 = tm * 256, n0 = tn * 256;
#pragma unroll 1
        for (int i = 0; i < 3; ++i) {
            f32x4 acc[8][4];
#pragma unroll
            for (int a_ = 0; a_ < 8; ++a_)
#pragma unroll
                for (int b_ = 0; b_ < 4; ++b_) acc[a_][b_] = (f32x4){0.f, 0.f, 0.f, 0.f};
            gemm256_dma(acc, c.H + (size_t)m0 * DM, DM, WM + (size_t)(i * DM + n0) * DM, DM, DM, lds);
            tile256_store_bf16(acc, TMP, 256, 256, lds);
#pragma unroll
            for (int a_ = 0; a_ < 8; ++a_)
#pragma unroll
                for (int b_ = 0; b_ < 4; ++b_) acc[a_][b_] = (f32x4){0.f, 0.f, 0.f, 0.f};
            {
                const bf16_t* Ab = (i == 0) ? c.POOLED + (size_t)m0 * 512 : ((i == 1) ? c.F + (size_t)5 * NT * 512 + (size_t)m0 * 512 : c.PROJ + C_Q + (size_t)m0 * IN_COLS);
                const size_t la = (i == 2) ? (size_t)IN_COLS : (size_t)512;
                const int Kb = (i == 2) ? 1024 : 512;
                gemm256_dma(acc, Ab, la, BR + (size_t)i * 1024 * 512 + (size_t)n0 * Kb, (size_t)Kb, Kb, lds);
            }
            const int lane = TID() & 63, wave = TID() >> 6, wm = wave >> 2, wn = wave & 3;
            const float* bias = BM_ + i * DM + n0 + wn * 64 + (lane >> 4) * 4;
#pragma unroll
            for (int mi = 0; mi < 8; ++mi) {
#pragma unroll
                for (int ni = 0; ni < 4; ++ni) {
                    const int r = wm * 128 + mi * 16 + (lane & 15), cc = wn * 64 + ni * 16 + (lane >> 4) * 4;
                    bf16_t* q = c.MERGED + (size_t)(m0 + r) * DM + n0 + cc;
                    const u32x2 gv = *(const u32x2*)(TMP + r * 256 + cc);
                    const f32x4 bb = *(const f32x4*)(bias + ni * 16);
                    f32x4 m4 = (f32x4){0.f, 0.f, 0.f, 0.f};
                    if (i > 0) { const u32x2 pv = *(const u32x2*)q; m4 = (f32x4){bflo(pv.x), bfhi(pv.x), bflo(pv.y), bfhi(pv.y)}; }
                    m4[0] += sigmoidf_(bflo(gv.x) + bb[0]) * acc[mi][ni][0]; m4[1] += sigmoidf_(bfhi(gv.x) + bb[1]) * acc[mi][ni][1];
                    m4[2] += sigmoidf_(bflo(gv.y) + bb[2]) * acc[mi][ni][2]; m4[3] += sigmoidf_(bfhi(gv.y) + bb[3]) * acc[mi][ni][3];
                    store_bf4(q, m4);
                }
                asm volatile("" ::: "memory"); __builtin_amdgcn_sched_barrier(0);
            }
        }
    }
}

DI void phase_outp(const Ctx& c, unsigned char* lds) {
    const int nN = DM / 256;
    const bf16_t* W = (const bf16_t*)(c.ws + WS_WT_OUT);
    const float* xin = (c.l == 0) ? c.in(I_X) : c.out;
    for (int it = 0;; ++it) {
        int tm, tn; if (!xcd_unit(it, nN, tm, tn)) break;
        const int m0 = tm * 256, n0 = tn * 256;
        f32x4 acc[8][4];
#pragma unroll
        for (int i = 0; i < 8; ++i)
#pragma unroll
            for (int j = 0; j < 4; ++j) acc[i][j] = (f32x4){0.f, 0.f, 0.f, 0.f};
        gemm256_dma(acc, c.MERGED + (size_t)m0 * DM, DM, W + (size_t)n0 * DM, DM, DM, lds);
        const int lane = TID() & 63, wave = TID() >> 6, wm = wave >> 2, wn = wave & 3;
#pragma unroll
        for (int mi = 0; mi < 8; ++mi)
#pragma unroll
            for (int ni = 0; ni < 4; ++ni) {
                const size_t o = (size_t)(m0 + wm * 128 + mi * 16 + (lane & 15)) * DM + n0 + wn * 64 + ni * 16 + (lane >> 4) * 4;
                const f32x4 x = *(const f32x4*)(xin + o); *(f32x4*)(c.out + o) = x + acc[mi][ni];
            }
    }
    for (int it = blockIdx.x * 4; it < 3 * 32 * 64; it += gridDim.x * 4) {
        const int mat = it / 2048, e = (it >> 6) & 31, tl = it & 63;
        if (mat == 0) convert_tile4(c.in(I_EG) + ((size_t)c.l * 32 + e) * DM * 256, 256, 256, DM, (bf16_t*)(c.ws + WS_EG) + (size_t)e * 256 * DM, tl, lds);
        else if (mat == 1) convert_tile4(c.in(I_EU) + ((size_t)c.l * 32 + e) * DM * 256, 256, 256, DM, (bf16_t*)(c.ws + WS_EU) + (size_t)e * 256 * DM, tl, lds);
        else convert_tile4(c.in(I_ED) + ((size_t)c.l * 32 + e) * 256 * DM, DM, DM, 256, (bf16_t*)(c.ws + WS_ED) + (size_t)e * DM * 256, tl, lds);
    }
}

DI void phase_norm2(const Ctx& c, unsigned char* lds) {
    const int tid = TID(), lane = tid & 63, wave = tid >> 6;
    const float* gain = c.in(I_NFFN) + c.l * DM;
    const float* wrg = c.in(I_WRG) + (size_t)c.l * DM * 4; const float* brg = c.in(I_BRG) + c.l * 4;
    const float* wre = c.in(I_WRE) + (size_t)c.l * DM * 32; const float* bre = c.in(I_BRE) + c.l * 32;
    unsigned* cnt = c.ctl + CW_CNT + c.l * 32;
    float* lg = (float*)lds + wave * 16 * 48;
    if (wave < 4)
    for (int rt = blockIdx.x * 4 + wave; rt < NT / 16; rt += gridDim.x * 4) {
        const int r0 = rt * 16;
        float my_rs = 0.f;
#pragma unroll 2
        for (int rr = 0; rr < 16; ++rr) {
            const size_t ro = (size_t)(r0 + rr) * DM;
            f32x4 v[4]; float ss = 0.f;
#pragma unroll
            for (int i = 0; i < 4; ++i) { v[i] = *(const f32x4*)(c.out + ro + i * 256 + lane * 4); ss += v[i][0] * v[i][0] + v[i][1] * v[i][1] + v[i][2] * v[i][2] + v[i][3] * v[i][3]; }
            ss = wave_sum_dpp(ss);
            const float rs = rsqrtf(ss * (1.0f / DM) + 1e-6f);
            if ((lane & 15) == rr) my_rs = rs;
#pragma unroll
            for (int i = 0; i < 4; ++i) {
                const f32x4 g = *(const f32x4*)(gain + i * 256 + lane * 4);
                store_bf4(c.H + ro + i * 256 + lane * 4, (f32x4){v[i][0] * rs * g[0], v[i][1] * rs * g[1], v[i][2] * rs * g[2], v[i][3] * rs * g[3]});
            }
        }
        f32x4 acc0 = (f32x4){0.f, 0.f, 0.f, 0.f}, acc1 = acc0, acc2 = acc0;
        const float* xr = c.out + (size_t)(r0 + (lane & 15)) * DM + 4 * (lane >> 4);
        const int cl = lane & 15;
#pragma unroll 2
        for (int kb = 0; kb < 64; ++kb) {
            const f32x4 xa = *(const f32x4*)(xr + kb * 16);
            const f32x4 ga = *(const f32x4*)(gain + kb * 16 + 4 * (lane >> 4));
            const int k0 = kb * 16 + 4 * (lane >> 4);
            float b0[4], b1[4], b2[4];
#pragma unroll
            for (int m = 0; m < 4; ++m) { b0[m] = wre[(size_t)(k0 + m) * 32 + cl]; b1[m] = wre[(size_t)(k0 + m) * 32 + 16 + cl]; b2[m] = (cl < 4) ? wrg[(size_t)(k0 + m) * 4 + cl] : 0.f; }
#pragma unroll
            for (int m = 0; m < 4; ++m) {
                const float am = xa[m] * ga[m] * my_rs;
                acc0 = __builtin_amdgcn_mfma_f32_16x16x4f32(am, b0[m], acc0, 0, 0, 0);
                acc1 = __builtin_amdgcn_mfma_f32_16x16x4f32(am, b1[m], acc1, 0, 0, 0);
                acc2 = __builtin_amdgcn_mfma_f32_16x16x4f32(am, b2[m], acc2, 0, 0, 0);
            }
        }
        LDS_WAVE_SYNC();
#pragma unroll
        for (int i = 0; i < 4; ++i) { const int row = 4 * (lane >> 4) + i; lg[row * 48 + cl] = acc0[i]; lg[row * 48 + 16 + cl] = acc1[i]; lg[row * 48 + 32 + cl] = acc2[i]; }
        LDS_WAVE_SYNC();
        if (lane < 16) {
            const float* L = lg + lane * 48;
            float lgp[4];
#pragma unroll
            for (int o = 0; o < 4; ++o) lgp[o] = L[32 + o] + brg[o];
            int grp = 0; float gm = lgp[0];
#pragma unroll
            for (int o = 1; o < 4; ++o) if (lgp[o] > gm) { gm = lgp[o]; grp = o; }
            float gs = 0.f;
#pragma unroll
            for (int o = 0; o < 4; ++o) gs += __expf(lgp[o] - gm);
            const float ptop = 1.0f / gs;
            int i0 = 0; float v0 = -INFINITY; int i1 = 0; float v1 = -INFINITY;
            for (int o = 0; o < 8; ++o) { const float le = L[grp * 8 + o] + bre[grp * 8 + o]; if (le > v0) { v1 = v0; i1 = i0; v0 = le; i0 = o; } else if (le > v1) { v1 = le; i1 = o; } }
            const float e1 = __expf(v1 - v0), inv = 1.0f / (1.0f + e1);
            int* rt_ = c.ROUTE + (size_t)(r0 + lane) * 8;
            const int ex0 = grp * 8 + i0, ex1 = grp * 8 + i1;
            const float w0_ = inv * ptop, w1_ = e1 * inv * ptop;
            const int q0 = (int)atomicAdd(cnt + ex0, 1u), q1 = (int)atomicAdd(cnt + ex1, 1u);
            rt_[0] = ex0; rt_[1] = ex1; ((float*)rt_)[2] = w0_; ((float*)rt_)[3] = w1_; rt_[4] = q0; rt_[5] = q1;
            int* e0p = c.ENT + ((size_t)ex0 * NT + q0) * 2; e0p[0] = r0 + lane; ((float*)e0p)[1] = w0_;
            int* e1p = c.ENT + ((size_t)ex1 * NT + q1) * 2; e1p[0] = r0 + lane; ((float*)e1p)[1] = w1_;
        }
    }
}
DI void moe_tables(const Ctx& c, int* soff, int* stile, int ncol) {
    const unsigned* cnt = c.ctl + CW_CNT + c.l * 32;
    __syncthreads();
    if (TID() == 0) { int s = 0, tt = 0; for (int e = 0; e < 32; ++e) { soff[e] = s; stile[e] = tt; s += (int)cnt[e]; tt += (((int)cnt[e] + 255) >> 8) * ncol; } soff[32] = s; stile[32] = tt; }
    __syncthreads();
}
DI void phase_moe_up(const Ctx& c, unsigned char* lds) {
    int* soff = (int*)(lds + LDS_BYTES - 1024); int* stile = soff + 64;
    moe_tables(c, soff, stile, 1);
    const int total = stile[32];
    const int lane = TID() & 63, wave = TID() >> 6, wm = wave >> 2, wn = wave & 3;
    for (int item = blockIdx.x; item < total; item += gridDim.x) {
        int e = 0;
        for (int q = 1; q < 32; ++q) if (stile[q] <= item) e = q;
        const int tm = item - stile[e];
        const int p0 = soff[e] + tm * 256, pend = soff[e + 1];
        GatherRows gr; gr.ent = c.ENT + ((size_t)e * NT + (p0 - soff[e])) * 2; gr.n = pend - p0;
        f32x4 acc[8][4];
#pragma unroll
        for (int a_ = 0; a_ < 8; ++a_)
#pragma unroll
            for (int b_ = 0; b_ < 4; ++b_) acc[a_][b_] = (f32x4){0.f, 0.f, 0.f, 0.f};
        gemm256_dma(acc, c.H, DM, (const bf16_t*)(c.ws + WS_EG) + (size_t)e * 256 * DM, DM, DM, lds, &gr);
#pragma unroll
        for (int mi = 0; mi < 8; ++mi)
#pragma unroll
            for (int ni = 0; ni < 4; ++ni) {
                const int r = wm * 128 + mi * 16 + (lane & 15), cc = wn * 64 + ni * 16 + (lane >> 4) * 4;
                const f32x4 g4 = acc[mi][ni];
                if (p0 + r < pend) store_bf4(c.HID + (size_t)(p0 + r) * 256 + cc, (f32x4){g4[0] * sigmoidf_(g4[0]), g4[1] * sigmoidf_(g4[1]), g4[2] * sigmoidf_(g4[2]), g4[3] * sigmoidf_(g4[3])});
                acc[mi][ni] = (f32x4){0.f, 0.f, 0.f, 0.f};
            }
        gemm256_dma(acc, c.H, DM, (const bf16_t*)(c.ws + WS_EU) + (size_t)e * 256 * DM, DM, DM, lds, &gr);
#pragma unroll
        for (int mi = 0; mi < 8; ++mi) {
#pragma unroll
            for (int ni = 0; ni < 4; ++ni) {
                const int r = wm * 128 + mi * 16 + (lane & 15), cc = wn * 64 + ni * 16 + (lane >> 4) * 4;
                if (p0 + r < pend) { bf16_t* q = c.HID + (size_t)(p0 + r) * 256 + cc; const u32x2 sv = *(const u32x2*)q;
                    store_bf4(q, (f32x4){bflo(sv.x) * acc[mi][ni][0], bfhi(sv.x) * acc[mi][ni][1], bflo(sv.y) * acc[mi][ni][2], bfhi(sv.y) * acc[mi][ni][3]}); }
            }
            asm volatile("" ::: "memory"); __builtin_amdgcn_sched_barrier(0);
        }
    }
}
DI void phase_moe_down(const Ctx& c, unsigned char* lds) {
    int* soff = (int*)(lds + LDS_BYTES - 1024); int* stile = soff + 64;
    moe_tables(c, soff, stile, 4);
    const int total = stile[32];
    const int lane = TID() & 63, wave = TID() >> 6, wm = wave >> 2, wn = wave & 3;
    for (int item = blockIdx.x; item < total; item += gridDim.x) {
        int e = 0;
        for (int q = 1; q < 32; ++q) if (stile[q] <= item) e = q;
        const int loc = item - stile[e], tm = loc >> 2, tn = loc & 3, n0 = tn * 256;
        const int p0 = soff[e] + tm * 256, pend = soff[e + 1];
        f32x4 acc[8][4];
#pragma unroll
        for (int a_ = 0; a_ < 8; ++a_)
#pragma unroll
            for (int b_ = 0; b_ < 4; ++b_) acc[a_][b_] = (f32x4){0.f, 0.f, 0.f, 0.f};
        gemm256_dma(acc, c.HID + (size_t)p0 * 256, 256, (const bf16_t*)(c.ws + WS_ED) + ((size_t)e * DM + n0) * 256, 256, 256, lds);
        const float* wl = (const float*)c.ENT + ((size_t)e * NT + (p0 - soff[e])) * 2 + 1;
#pragma unroll
        for (int mi = 0; mi < 8; ++mi)
#pragma unroll
            for (int ni = 0; ni < 4; ++ni) {
                const int r = wm * 128 + mi * 16 + (lane & 15), cc = wn * 64 + ni * 16 + (lane >> 4) * 4;
                if (p0 + r < pend) { const float w = wl[2 * r];
                    store_bf4(c.Y + (size_t)(p0 + r) * DM + n0 + cc, (f32x4){acc[mi][ni][0] * w, acc[mi][ni][1] * w, acc[mi][ni][2] * w, acc[mi][ni][3] * w}); }
            }
    }
}
DI void phase_final(const Ctx& c, unsigned char* lds) {
    const int tid = TID(), lane = tid & 63, wave = tid >> 6;
    const float* gain = c.in(I_NFIN);
    int* soff = (int*)(lds + 65536);
    moe_offsets(c, DEPTH - 1, soff);
    for (int row = blockIdx.x * 8 + wave; row < NT; row += gridDim.x * 8) {
        f32x4 v[4];
#pragma unroll
        for (int i = 0; i < 4; ++i) v[i] = *(const f32x4*)(c.out + (size_t)row * DM + i * 256 + lane * 4);
        add_moe_rows(c, row, lane, v, soff);
        float ss = 0.f;
#pragma unroll
        for (int i = 0; i < 4; ++i) ss += v[i][0] * v[i][0] + v[i][1] * v[i][1] + v[i][2] * v[i][2] + v[i][3] * v[i][3];
        ss = wave_sum_dpp(ss);
        const float rs = rsqrtf(ss * (1.0f / DM) + 1e-6f);
#pragma unroll
        for (int i = 0; i < 4; ++i) {
            const f32x4 g = *(const f32x4*)(gain + i * 256 + lane * 4);
            *(f32x4*)(c.out + (size_t)row * DM + i * 256 + lane * 4) = (f32x4){v[i][0] * rs * g[0], v[i][1] * rs * g[1], v[i][2] * rs * g[2], v[i][3] * rs * g[3]};
        }
    }
}

constexpr int PH_PER_LAYER = 11, N_PHASES = DEPTH * PH_PER_LAYER + 1;
__global__ void __launch_bounds__(NTHREADS, 2) fwd_kernel(Params P) {
    extern __shared__ __attribute__((aligned(16))) unsigned char lds[];
    const int lo = P.ph_lo, hi = P.ph_hi;
    LAS unsigned* xbw = (LAS unsigned*)(lds + LDS_BYTES - 16);
    if (threadIdx.x == 0) { xbw[0] = 0u; xbw[1] = 0u; xbw[2] = 0u; xbw[3] = 0u; }
    __syncthreads();
    Ctx c; c.P = &P; c.ws = P.ws; c.out = P.out; c.l = 0;
    c.ctl = (unsigned*)(P.ws + WS_CTL);
    c.H = (bf16_t*)(P.ws + WS_H); c.PROJ = (bf16_t*)(P.ws + WS_PROJ); c.F = (bf16_t*)(P.ws + WS_F); c.POOLED = (bf16_t*)(P.ws + WS_POOLED);
    c.MERGED = (bf16_t*)(P.ws + WS_F); c.CMPH = (bf16_t*)(P.ws + WS_CMPH); c.CMPO = (float*)(P.ws + WS_CMPO); c.POSB = (float*)(P.ws + WS_POSB);
    c.ROUTE = (int*)(P.ws + WS_ROUTE); c.ENT = (int*)(P.ws + WS_ENT); c.HID = (bf16_t*)(P.ws + WS_HID); c.Y = (bf16_t*)(P.ws + WS_Y);
    c.VT = (bf16_t*)(P.ws + WS_VT); c.KC = (bf16_t*)(P.ws + WS_KC); c.VCT = (bf16_t*)(P.ws + WS_VCT); c.YRAW = (bf16_t*)(P.ws + WS_YRAW); c.BON = (float*)(P.ws + WS_BON);
    XcdBarrier bar; bar.bar = c.ctl + CW_BAR; bar.x = 0; bar.st = (volatile LAS unsigned*)xbw;
    if (hi - lo > 1) bar = xcd_barrier_post(c.ctl + CW_BAR, (volatile LAS unsigned*)xbw);
#define IN(k) (lo <= (k) && (k) < hi)
#define SEAM(k) do { if (IN(k) && IN((k) + 1)) xcd_barrier(bar); } while (0)
#pragma unroll 1
    for (int l = 0; l < DEPTH; ++l) {
        c.l = l; const int pb = l * PH_PER_LAYER;
        if (IN(pb + 0)) phase_norm1(c, lds);
        SEAM(pb + 0);
        if (IN(pb + 1)) phase_gemm1(c, lds);
        SEAM(pb + 1);
        if (IN(pb + 2)) phase_prep(c, lds);
        SEAM(pb + 2);
        if (IN(pb + 3)) phase_poolgemm(c, lds);
        SEAM(pb + 3);
        if (IN(pb + 4)) phase_mix(c, lds);
        SEAM(pb + 4);
        if (IN(pb + 5)) phase_rwkv_post(c, lds);
        SEAM(pb + 5);
        if (IN(pb + 6)) phase_merge(c, lds);
        SEAM(pb + 6);
        if (IN(pb + 7)) phase_outp(c, lds);
        SEAM(pb + 7);
        if (IN(pb + 8)) phase_norm2(c, lds);
        SEAM(pb + 8);
        if (IN(pb + 9)) phase_moe_up(c, lds);
        SEAM(pb + 9);
        if (IN(pb + 10)) phase_moe_down(c, lds);
        SEAM(pb + 10);
    }
    if (IN(N_PHASES - 1)) phase_final(c, lds);
}

#ifndef MK_N_LAUNCHES
#define MK_N_LAUNCHES 1
#endif
extern "C" void kernel_launch(void* const* d_in, const int* in_sizes, int n_in, void* d_out, int out_size, void* d_ws, size_t ws_size, hipStream_t stream) {
    static int grid = 0;
    if (grid == 0) {
        if (n_in != N_IN || out_size != NT * DM || ws_size < WS_END) { fprintf(stderr, "kernel_launch: unexpected shapes n_in %d out %d ws %zu (need %zu)\n", n_in, out_size, ws_size, (size_t)WS_END); grid = -1; return; }
        int dev = 0, cus = 0, per_cu = 0;
        if (hipGetDevice(&dev) != hipSuccess || hipDeviceGetAttribute(&cus, hipDeviceAttributeMultiprocessorCount, dev) != hipSuccess) { grid = -1; return; }
        if (hipFuncSetAttribute((const void*)fwd_kernel, hipFuncAttributeMaxDynamicSharedMemorySize, LDS_BYTES) != hipSuccess) { fprintf(stderr, "kernel_launch: hipFuncSetAttribute failed\n"); grid = -1; return; }
        if (hipOccupancyMaxActiveBlocksPerMultiprocessor(&per_cu, (const void*)fwd_kernel, NTHREADS, LDS_BYTES) != hipSuccess || per_cu < 1) { fprintf(stderr, "kernel_launch: occupancy query says %d\n", per_cu); }
        (void)hipGetLastError();
        grid = cus;
    }
    if (grid < 0) return;
    if (hipMemsetAsync((char*)d_ws + WS_CTL, 0, CTL_BYTES, stream) != hipSuccess) return;
    Params p{};
    for (int i = 0; i < N_IN; ++i) p.in[i] = (const float*)d_in[i];
    p.out = (float*)d_out; p.ws = (unsigned char*)d_ws;
    if (MK_N_LAUNCHES == 1) {
        p.ph_lo = 0; p.ph_hi = N_PHASES;
        hipLaunchKernelGGL(fwd_kernel, dim3(grid), dim3(NTHREADS), LDS_BYTES, stream, p);
    } else {
        for (int k = 0; k < N_PHASES; ++k) { p.ph_lo = k; p.ph_hi = k + 1; hipLaunchKernelGGL(fwd_kernel, dim3(grid), dim3(NTHREADS), LDS_BYTES, stream, p); }
    }
}
```

```cpp
#include <hip/hip_runtime.h>
#include <cstdio>
#include <cstdint>

#define DI __device__ __forceinline__
typedef unsigned short bf16_t;
typedef short bf16x8 __attribute__((ext_vector_type(8)));
typedef float f32x4 __attribute__((ext_vector_type(4)));
typedef unsigned u32x4 __attribute__((ext_vector_type(4)));
typedef unsigned u32x2 __attribute__((ext_vector_type(2)));

constexpr int NB = 4, SEQ = 4096, DM = 1024, NT = NB * SEQ, DEPTH = 2;
constexpr int IN_COLS = 4816;
constexpr int C_POOL = 0, C_RW = 512, C_R = 512, C_K = 1024, C_V = 1536, C_WD = 2048, C_AD = 2080, C_GD = 2112;
constexpr int C_Q = 2208, C_KC = 3232, C_VC = 3488, C_KS = 3744, C_VS = 4000, C_KW = 4256, C_VW = 4512, C_GATE = 4768;
constexpr int RWC = 1696;
constexpr int NCMP = 255;
constexpr int NTHREADS = 512;
constexpr int LDS_BYTES = 155648;

enum { I_X = 0, I_RELB, I_NMIX, I_WIN, I_POOLW, I_POOLS, I_MU, I_W0, I_WUP, I_A0, I_AUP, I_GUP, I_KK, I_KA, I_RK, I_GNW, I_GNB,
       I_CPK, I_CW1K, I_CW2K, I_CPV, I_CW1V, I_CW2V, I_WBR, I_WMG, I_BMG, I_WOUT, I_NFFN, I_WRG, I_BRG, I_WRE, I_BRE, I_EG, I_EU, I_ED, I_NFIN, N_IN };

constexpr size_t WS_CTL = 0;
constexpr size_t CTL_BYTES = 65536;
constexpr size_t WS_H = CTL_BYTES;
constexpr size_t WS_PROJ = WS_H + (size_t)NT * DM * 2;
constexpr size_t WS_F = WS_PROJ + (size_t)NT * IN_COLS * 2;
constexpr size_t PLANE = (size_t)NT * 512 * 2;
constexpr size_t WS_POOLED = WS_F + 6 * PLANE;
constexpr size_t WS_CMPH = WS_POOLED + PLANE;
constexpr size_t WS_CMPO = WS_CMPH + (size_t)2 * 4096 * 256 * 2;
constexpr size_t WS_POSB = WS_CMPO + (size_t)2 * 4096 * 64 * 4;
constexpr size_t WS_ROUTE = WS_POSB + 4096;
constexpr size_t WS_ENT = WS_ROUTE + (size_t)NT * 32;
constexpr size_t WS_VT = WS_ENT + (size_t)32 * NT * 8;
constexpr size_t WS_KC = WS_VT + (size_t)2 * 16 * 64 * SEQ * 2;
constexpr size_t WS_VCT = WS_KC + (size_t)16 * 256 * 64 * 2;
constexpr size_t WS_YRAW = WS_VCT + (size_t)16 * 64 * 256 * 2;
constexpr size_t WS_BON = WS_YRAW + (size_t)NT * 512 * 2;
constexpr size_t WS_SMALLW = WS_BON + (size_t)NT * 8 * 16;
constexpr size_t WS_WT_LORA = WS_SMALLW + 262144;
constexpr size_t WS_END = WS_WT_LORA + (size_t)1536 * 128 * 2;
constexpr size_t WS_WT_IN = WS_F;
constexpr size_t WS_WT_C1 = WS_CMPO;
constexpr size_t WS_WT_C2 = WS_SMALLW;
constexpr size_t WS_WT_POOL = WS_SMALLW + 131072;
constexpr size_t WS_WT_MG = WS_VT;
constexpr size_t WS_WT_BR = WS_VT + (size_t)3072 * 1024 * 2;
constexpr size_t WS_WT_OUT = WS_CMPH;
constexpr size_t WS_EG = WS_F + 2 * PLANE;
constexpr size_t WS_EU = WS_EG + (size_t)32 * 256 * 1024 * 2;
constexpr size_t WS_ED = WS_EU + (size_t)32 * 256 * 1024 * 2;
static_assert(WS_ED + (size_t)32 * 1024 * 256 * 2 <= WS_F + 6 * PLANE, "expert alias");
static_assert(WS_WT_BR + (size_t)2048 * 1024 * 2 <= WS_VT + (size_t)2 * 16 * 64 * SEQ * 2, "merge alias");
static_assert((size_t)4864 * 1024 * 2 <= 6 * PLANE, "w_in alias");
constexpr size_t WS_HID = WS_PROJ;
constexpr size_t WS_Y = WS_PROJ + (size_t)2 * NT * 256 * 2;
static_assert(WS_Y + (size_t)2 * NT * 1024 * 2 <= WS_F, "alias");
constexpr int CW_BAR = 0;
constexpr int CW_CNT = 4096;
constexpr int CW_CUR = 4096 + 64;
constexpr int CW_Q = 4096 + 128;

#define XB_TMO      128
#define XB_XCNT(j)  (256  + 64 * (j))
#define XB_XSUB(j)  (1280 + 64 * (j))
#define XB_XGEN(j)  (2304 + 64 * (j))
#define XB_TOP      3328
#define XB_TOPGEN   3392
#define XCD_BAR_WORDS 3456
#define XB_SPIN_CAP (1u << 18)
#define LAS __attribute__((address_space(3)))

__device__ __forceinline__ unsigned xb_ld(unsigned* p)              { return __hip_atomic_load(p, __ATOMIC_RELAXED, __HIP_MEMORY_SCOPE_AGENT); }
__device__ __forceinline__ unsigned xb_add(unsigned* p, unsigned v) { return __hip_atomic_fetch_add(p, v, __ATOMIC_RELAXED, __HIP_MEMORY_SCOPE_AGENT); }
__device__ __forceinline__ unsigned xb_xcc_id() { return (unsigned)__builtin_amdgcn_s_getreg((3 << 11) | 20) & 0xFu; }
#define XB_SPIN(cond, bar) do { unsigned _sp = 0; while (cond) { __builtin_amdgcn_s_sleep(1); \
    if ((++_sp & 255u) == 0u) { if (xb_ld(&(bar)[XB_TMO])) break; if (_sp > XB_SPIN_CAP) { atomicAdd(&(bar)[XB_TMO], 1u); break; } } } } while (0)

struct XcdBarrier { unsigned* bar; unsigned x; volatile LAS unsigned* st; };

__device__ __forceinline__ XcdBarrier xcd_barrier_post(unsigned* bar, volatile LAS unsigned* st) {
    XcdBarrier b; b.bar = bar; b.x = xb_xcc_id(); b.st = st;
    if (threadIdx.x == 0) (void)xb_add(&bar[XB_XCNT(b.x)], 1u);
    return b;
}
__device__ __forceinline__ void xcd_barrier_complete(unsigned* bar, unsigned x, unsigned& nloc, unsigned& nx) {
    const unsigned G = gridDim.x * gridDim.y * gridDim.z;
    unsigned sum, cnt, mine, sp = 0u;
    for (;;) {
        sum = 0u; cnt = 0u; mine = 0u;
#pragma unroll
        for (unsigned j = 0; j < 16; ++j) { const unsigned c = xb_ld(&bar[XB_XCNT(j)]); sum += c; cnt += (c > 0u) ? 1u : 0u; mine = (j == x) ? c : mine; }
        if (sum == G) break;
        __builtin_amdgcn_s_sleep(1);
        if ((++sp & 255u) == 0u) { if (xb_ld(&bar[XB_TMO])) break; if (sp > XB_SPIN_CAP) { atomicAdd(&bar[XB_TMO], 1u); break; } }
    }
    nloc = mine > 0u ? mine : 1u; nx = cnt > 0u ? cnt : 1u;
}
__device__ __forceinline__ void xcd_barrier(const XcdBarrier& b) {
    asm volatile("s_waitcnt vmcnt(0)" ::: "memory");
    __syncthreads();
    if (threadIdx.x == 0) {
        unsigned* bar = b.bar;
        __builtin_amdgcn_s_waitcnt(0);
        unsigned nloc = b.st[0], nx = b.st[1];
        if (nloc == 0u) { xcd_barrier_complete(bar, b.x, nloc, nx); b.st[0] = nloc; b.st[1] = nx; }
        const unsigned old = xb_add(&bar[XB_XSUB(b.x)], 1u);
        const unsigned gen = old / nloc;
        if (old + 1u == (gen + 1u) * nloc) {
            __builtin_amdgcn_fence(__ATOMIC_RELEASE, "agent");
            asm volatile("s_waitcnt vmcnt(0)" ::: "memory");
            const unsigned og = xb_add(&bar[XB_TOP], 1u);
            const unsigned tg = og / nx;
            if (og + 1u == (tg + 1u) * nx) xb_add(&bar[XB_TOPGEN], 1u);
            else XB_SPIN(xb_ld(&bar[XB_TOPGEN]) == tg, bar);
            __builtin_amdgcn_fence(__ATOMIC_ACQUIRE, "agent");
            xb_add(&bar[XB_XGEN(b.x)], 1u);
            asm volatile("s_waitcnt vmcnt(0)" ::: "memory");
        } else {
            XB_SPIN(xb_ld(&bar[XB_XGEN(b.x)]) == gen, bar);
            __builtin_amdgcn_fence(__ATOMIC_ACQUIRE, "agent");
            asm volatile("s_waitcnt vmcnt(0)" ::: "memory");
        }
    }
    __syncthreads();
}

DI bf16_t f2bf(float x) { unsigned u = __float_as_uint(x); u += 0x7fffu + ((u >> 16) & 1u); return (bf16_t)(u >> 16); }
DI float bf2f(bf16_t b) { return __uint_as_float((unsigned)b << 16); }
typedef __bf16 bf16v2_t __attribute__((ext_vector_type(2)));
typedef float f32v2_t __attribute__((ext_vector_type(2)));
DI unsigned pack2(float lo, float hi) { const f32v2_t v = {lo, hi}; const bf16v2_t b = __builtin_convertvector(v, bf16v2_t); return __builtin_bit_cast(unsigned, b); }
DI float bflo(unsigned w) { return __uint_as_float(w << 16); }
DI float bfhi(unsigned w) { return __uint_as_float(w & 0xffff0000u); }
DI float wave_sum(float v) {
#pragma unroll
    for (int o = 32; o >= 1; o >>= 1) v += __shfl_xor(v, o);
    return v;
}
DI float wave_max(float v) {
#pragma unroll
    for (int o = 32; o >= 1; o >>= 1) v = fmaxf(v, __shfl_xor(v, o));
    return v;
}
DI float sigmoidf_(float x) { return __builtin_amdgcn_rcpf(1.0f + __expf(-x)); }
DI int TID() { int t = threadIdx.x; asm volatile("" : "+v"(t)); return t; }
#define LDS_WAVE_SYNC() asm volatile("s_waitcnt lgkmcnt(0)" ::: "memory")

#define DPP_MOV(v, ctrl) __builtin_bit_cast(float, __builtin_amdgcn_update_dpp(0, __builtin_bit_cast(int, (v)), (ctrl), 0xF, 0xF, true))
DI float wave_sum_dpp(float v) {
    v += DPP_MOV(v, 0xB1); v += DPP_MOV(v, 0x4E); v += DPP_MOV(v, 0x141); v += DPP_MOV(v, 0x140);
    return __builtin_bit_cast(float, __builtin_amdgcn_readlane(__builtin_bit_cast(int, v), 0)) + __builtin_bit_cast(float, __builtin_amdgcn_readlane(__builtin_bit_cast(int, v), 16)) +
        (__builtin_bit_cast(float, __builtin_amdgcn_readlane(__builtin_bit_cast(int, v), 32)) + __builtin_bit_cast(float, __builtin_amdgcn_readlane(__builtin_bit_cast(int, v), 48)));
}
struct Params { const float* in[N_IN]; float* out; unsigned char* ws; int ph_lo, ph_hi; };

DI int t5_bucket(int n) {
    if (n < 16) return n;
    if (n >= 128) return 31;
    int b = 16;
    b += (n >= 19) + (n >= 21) + (n >= 24) + (n >= 27) + (n >= 31) + (n >= 35) + (n >= 40) + (n >= 46) + (n >= 52) + (n >= 59) + (n >= 67) + (n >= 77) + (n >= 87) + (n >= 99) + (n >= 113);
    return b;
}

constexpr int G_A = 0, G_B = 256 * 64 * 2, G_STAGE = (256 + 128) * 64 * 2;
static_assert(2 * G_STAGE <= LDS_BYTES - 64, "gemm lds");
DI int g_off(int r, int c) { return ((r >> 4) * 2 + (c >> 5)) * 1024 + ((((r & 15) * 64) + (c & 31) * 2) ^ ((((r & 15) >> 3) & 1) << 5)); }
struct ARows { const bf16_t* p[4]; const float* mu; int ltype; int first; };
DI float tanhf_fast(float x) { const float e = __expf(2.0f * x); return 1.0f - 2.0f * __builtin_amdgcn_rcpf(e + 1.0f); }
DI u32x4 lora_chunk(const bf16_t* prow, bool first, const float* mu, int ltype, int k) {
    const int lim = (ltype == 2) ? 96 : 32;
    if (k >= lim) return (u32x4){0u, 0u, 0u, 0u};
    const int col = C_WD + ltype * 32 + k;
    const u32x4 cu = *(const u32x4*)(prow + col);
    u32x4 pu = (u32x4){0u, 0u, 0u, 0u};
    if (!first) pu = *(const u32x4*)(prow - IN_COLS + col);
    const f32x4 m0 = *(const f32x4*)(mu + col - C_RW), m1 = *(const f32x4*)(mu + col - C_RW + 4);
    float u[8] = {bflo(cu.x), bfhi(cu.x), bflo(cu.y), bfhi(cu.y), bflo(cu.z), bfhi(cu.z), bflo(cu.w), bfhi(cu.w)};
    const float p[8] = {bflo(pu.x), bfhi(pu.x), bflo(pu.y), bfhi(pu.y), bflo(pu.z), bfhi(pu.z), bflo(pu.w), bfhi(pu.w)};
    const float mm[8] = {m0[0], m0[1], m0[2], m0[3], m1[0], m1[1], m1[2], m1[3]};
#pragma unroll
    for (int j = 0; j < 8; ++j) { const float us = u[j] + (p[j] - u[j]) * mm[j]; u[j] = (ltype == 0) ? tanhf_fast(us) : ((ltype == 1) ? us : __builtin_amdgcn_rcpf(1.0f + __expf(-us))); }
    u32x4 w; w.x = pack2(u[0], u[1]); w.y = pack2(u[2], u[3]); w.z = pack2(u[4], u[5]); w.w = pack2(u[6], u[7]);
    return w;
}
template <int AMODE>
DI void g_load(u32x4 (&ra)[4], u32x4 (&rb)[2], const ARows& ar, const bf16_t* bt, int ldb, int k0, int tid) {
    const int kseg = (tid & 7) * 8;
#pragma unroll
    for (int i = 0; i < 4; ++i) {
        ra[i] = (u32x4){0u, 0u, 0u, 0u};
        if (AMODE == 2) ra[i] = lora_chunk(ar.p[i], (ar.first >> i) & 1, ar.mu, ar.ltype, k0 + kseg);
        else if (ar.p[i] != nullptr) ra[i] = *(const u32x4*)((AMODE == 0) ? (ar.p[i] + k0 + kseg) : (ar.p[i] + (size_t)(k0 >> 6) * IN_COLS + kseg));
    }
#pragma unroll
    for (int i = 0; i < 2; ++i) rb[i] = *(const u32x4*)(bt + (size_t)((tid >> 3) + 64 * i) * ldb + k0 + kseg);
}
DI void g_store(unsigned char* st, const u32x4 (&ra)[4], const u32x4 (&rb)[2], int tid) {
    const int off = g_off(tid >> 3, (tid & 7) * 8);
#pragma unroll
    for (int i = 0; i < 4; ++i) *(u32x4*)(st + G_A + off + i * 8192) = ra[i];
#pragma unroll
    for (int i = 0; i < 2; ++i) *(u32x4*)(st + G_B + off + i * 8192) = rb[i];
}
DI void g_compute(f32x4 (&acc)[4][4], const unsigned char* st, int lane, int wm, int wn) {
    const int lo = ((lane & 15) * 64 + (lane >> 4) * 16) ^ ((((lane & 15) >> 3) & 1) << 5);
    const unsigned char* sA = st + G_A + wm * 8192 + lo;
    const unsigned char* sB = st + G_B + wn * 8192 + lo;
    bf16x8 bcur[4], bnxt[4], a0, a1, a2;
#pragma unroll
    for (int i = 0; i < 4; ++i) bcur[i] = *(const bf16x8*)(sB + i * 2048);
    a0 = *(const bf16x8*)(sA);
    a1 = *(const bf16x8*)(sA + 2048);
#define G_AFRAG(s) (*(const bf16x8*)(sA + ((s) & 3) * 2048 + ((s) >> 2) * 1024))
#define G_GROUP(s, acur, anew) do { \
        if ((s) + 2 < 8) anew = G_AFRAG((s) + 2); \
        if ((s) < 4) bnxt[(s) & 3] = *(const bf16x8*)(sB + ((s) & 3) * 2048 + 1024); \
        __builtin_amdgcn_sched_barrier(0); \
        _Pragma("unroll") for (int ni = 0; ni < 4; ++ni) acc[(s) & 3][ni] = __builtin_amdgcn_mfma_f32_16x16x32_bf16(((s) < 4 ? bcur[ni] : bnxt[ni]), acur, acc[(s) & 3][ni], 0, 0, 0); \
        __builtin_amdgcn_sched_barrier(0); } while (0)
    G_GROUP(0, a0, a2); G_GROUP(1, a1, a0); G_GROUP(2, a2, a1); G_GROUP(3, a0, a2);
    G_GROUP(4, a1, a0); G_GROUP(5, a2, a1); G_GROUP(6, a0, a2); G_GROUP(7, a1, a0);
#undef G_GROUP
#undef G_AFRAG
}
#define LDS_BARRIER() do { asm volatile("s_waitcnt lgkmcnt(0)" ::: "memory"); __builtin_amdgcn_s_barrier(); asm volatile("" ::: "memory"); } while (0)
template <int AMODE>
DI void gemm_core(f32x4 (&acc)[4][4], const ARows& ar, const bf16_t* bt  , int ldb, int K, unsigned char* lds) {
    const int tid = TID(), lane = tid & 63, wave = tid >> 6, wm = wave >> 1, wn = wave & 1;
    const int nk = K >> 6;
    unsigned char* s0 = lds; unsigned char* s1 = lds + G_STAGE;
    u32x4 ra0[4], rb0[2], ra1[4], rb1[2];
    g_load<AMODE>(ra0, rb0, ar, bt, ldb, 0, tid);
    g_load<AMODE>(ra1, rb1, ar, bt, ldb, 64, tid);
    __syncthreads();
    g_store(s0, ra0, rb0, tid);
    g_load<AMODE>(ra0, rb0, ar, bt, ldb, (nk > 2 ? 2 : nk - 1) * 64, tid);
    LDS_BARRIER();
    for (int kt = 0; kt < nk; kt += 2) {
        g_store(s1, ra1, rb1, tid);
        { const int kn = (kt + 3 < nk) ? kt + 3 : nk - 1; g_load<AMODE>(ra1, rb1, ar, bt, ldb, kn * 64, tid); }
        g_compute(acc, s0, lane, wm, wn);
        LDS_BARRIER();
        g_store(s0, ra0, rb0, tid);
        { const int kn = (kt + 4 < nk) ? kt + 4 : nk - 1; g_load<AMODE>(ra0, rb0, ar, bt, ldb, kn * 64, tid); }
        g_compute(acc, s1, lane, wm, wn);
        LDS_BARRIER();
    }
}
static_assert(3 * G_STAGE <= LDS_BYTES - 64, "dma ring");
DI void gemm_core_dma(f32x4 (&acc)[4][4], const bf16_t* A, size_t lda, const bf16_t* bt, size_t ldb, int K, unsigned char* lds) {
    const int tid = TID(), lane = tid & 63, wave = __builtin_amdgcn_readfirstlane(tid >> 6), wm = wave >> 1, wn = wave & 1;
    const int nk = K >> 6;
    const int srow = lane >> 2, skof = ((lane & 3) * 8) ^ ((lane >> 5) << 4);
    const char* gp[6]; int loff[6];
#pragma unroll
    for (int j = 0; j < 6; ++j) {
        const int sid = wave * 6 + j;
        if (sid < 32) { gp[j] = (const char*)(A + (size_t)((sid >> 1) * 16 + srow) * lda + (sid & 1) * 32 + skof); loff[j] = G_A + sid * 1024; }
        else { const int s2 = sid - 32; gp[j] = (const char*)(bt + (size_t)((s2 >> 1) * 16 + srow) * ldb + (s2 & 1) * 32 + skof); loff[j] = G_B + s2 * 1024; }
    }
#define DMA_ISSUE(kt_, st_) do { const int _k = ((kt_) < nk ? (kt_) : nk - 1) * 128; \
        _Pragma("unroll") for (int j = 0; j < 6; ++j) __builtin_amdgcn_global_load_lds((const unsigned*)(gp[j] + _k), (LAS unsigned*)(lds + (st_) * G_STAGE + loff[j]), 16, 0, 0); } while (0)
    asm volatile("s_waitcnt vmcnt(0)" ::: "memory");
    __syncthreads();
    DMA_ISSUE(0, 0); DMA_ISSUE(1, 1);
    int st = 0;
    for (int kt = 0; kt < nk; ++kt) {
        asm volatile("s_waitcnt vmcnt(6)" ::: "memory");
        __builtin_amdgcn_s_barrier();
        asm volatile("" ::: "memory");
        const int sn = (st == 0) ? 2 : st - 1;
        DMA_ISSUE(kt + 2, sn);
        g_compute(acc, lds + st * G_STAGE, lane, wm, wn);
        st = (st == 2) ? 0 : st + 1;
    }
    asm volatile("s_waitcnt vmcnt(0)" ::: "memory");
    __syncthreads();
#undef DMA_ISSUE
}
DI void store_bf4(bf16_t* p, f32x4 v) { u32x2 w; w.x = pack2(v[0], v[1]); w.y = pack2(v[2], v[3]); *(u32x2*)p = w; }
constexpr int H_A = 0, H_B = 256 * 64 * 2, H_STAGE = 2 * 256 * 64 * 2;
static_assert(2 * H_STAGE <= LDS_BYTES - 64, "gemm256 lds");
DI void h_compute(f32x4 (&acc)[8][4], const unsigned char* st, int lane, int wm, int wn) {
    const int lo = ((lane & 15) * 64 + (lane >> 4) * 16) ^ ((((lane & 15) >> 3) & 1) << 5);
    const unsigned char* sA = st + H_A + wm * 16384 + lo;
    const unsigned char* sB = st + H_B + wn * 8192 + lo;
#pragma unroll
    for (int ks = 0; ks < 2; ++ks) {
        bf16x8 bf[4], a0, a1, a2;
#pragma unroll
        for (int i = 0; i < 4; ++i) bf[i] = *(const bf16x8*)(sB + i * 2048 + ks * 1024);
        a0 = *(const bf16x8*)(sA + ks * 1024);
        a1 = *(const bf16x8*)(sA + 2048 + ks * 1024);
#define H_GROUP(s, acur, anew) do { \
        if ((s) + 2 < 8) anew = *(const bf16x8*)(sA + ((s) + 2) * 2048 + ks * 1024); \
        __builtin_amdgcn_sched_barrier(0); \
        _Pragma("unroll") for (int ni = 0; ni < 4; ++ni) acc[(s)][ni] = __builtin_amdgcn_mfma_f32_16x16x32_bf16(bf[ni], acur, acc[(s)][ni], 0, 0, 0); \
        __builtin_amdgcn_sched_barrier(0); } while (0)
        H_GROUP(0, a0, a2); H_GROUP(1, a1, a0); H_GROUP(2, a2, a1); H_GROUP(3, a0, a2);
        H_GROUP(4, a1, a0); H_GROUP(5, a2, a1); H_GROUP(6, a0, a2); H_GROUP(7, a1, a0);
#undef H_GROUP
    }
}
struct GatherRows { const int* ent; int n; };
DI void gemm256_dma(f32x4 (&acc)[8][4], const bf16_t* A, size_t lda, const bf16_t* bt, size_t ldb, int K, unsigned char* lds, const GatherRows* gr = nullptr) {
    const int tid = TID(), lane = tid & 63, wave = __builtin_amdgcn_readfirstlane(tid >> 6), wm = wave >> 2, wn = wave & 3;
    const int nk = K >> 6;
    const int srow = lane >> 2, skof = ((lane & 3) * 8) ^ ((lane >> 5) << 4);
    const char* gp[8]; int loff[8];
#pragma unroll
    for (int j = 0; j < 8; ++j) {
        const int sid = wave * 8 + j;
        if (sid < 32) { size_t rowoff = (size_t)((sid >> 1) * 16 + srow) * lda;
            if (gr != nullptr) { const int r = (sid >> 1) * 16 + srow; rowoff = (size_t)((r < gr->n) ? gr->ent[2 * r] : 0) * lda; }
            gp[j] = (const char*)(A + rowoff + (sid & 1) * 32 + skof); loff[j] = H_A + sid * 1024; }
        else { const int s2 = sid - 32; gp[j] = (const char*)(bt + (size_t)((s2 >> 1) * 16 + srow) * ldb + (s2 & 1) * 32 + skof); loff[j] = H_B + s2 * 1024; }
    }
#define H_ISSUE(kt_, st_) do { const int _k = ((kt_) < nk ? (kt_) : nk - 1) * 128; \
        _Pragma("unroll") for (int j = 0; j < 8; ++j) __builtin_amdgcn_global_load_lds((const unsigned*)(gp[j] + _k), (LAS unsigned*)(lds + (st_) * H_STAGE + loff[j]), 16, 0, 0); } while (0)
    asm volatile("s_waitcnt vmcnt(0)" ::: "memory");
    __syncthreads();
    H_ISSUE(0, 0);
    for (int kt = 0; kt < nk; ++kt) {
        asm volatile("s_waitcnt vmcnt(0)" ::: "memory");
        __builtin_amdgcn_s_barrier();
        asm volatile("" ::: "memory");
        H_ISSUE(kt + 1, (kt + 1) & 1);
        h_compute(acc, lds + (kt & 1) * H_STAGE, lane, wm, wn);
    }
    asm volatile("s_waitcnt vmcnt(0)" ::: "memory");
    __syncthreads();
#undef H_ISSUE
}
DI void tile256_store_bf16(f32x4 (&acc)[8][4], bf16_t* out, size_t ld, int ncols, unsigned char* lds) {
    bf16_t* T = (bf16_t*)lds;
    const int tid = TID(), lane = tid & 63, wave = tid >> 6, wm = wave >> 2, wn = wave & 3;
    __syncthreads();
#pragma unroll
    for (int mi = 0; mi < 8; ++mi)
#pragma unroll
        for (int ni = 0; ni < 4; ++ni) store_bf4(T + (wm * 128 + mi * 16 + (lane & 15)) * 264 + wn * 64 + ni * 16 + (lane >> 4) * 4, acc[mi][ni]);
    __syncthreads();
#pragma unroll
    for (int i = 0; i < 16; ++i) {
        const int ch = tid + i * NTHREADS, r = ch >> 5, cc = (ch & 31) * 8;
        if (cc < ncols) *(u32x4*)(out + (size_t)r * ld + cc) = *(const u32x4*)(T + r * 264 + cc);
    }
}
DI void acc_zero(f32x4 (&acc)[4][4]) {
#pragma unroll
    for (int i = 0; i < 4; ++i)
#pragma unroll
        for (int j = 0; j < 4; ++j) acc[i][j] = (f32x4){0.f, 0.f, 0.f, 0.f};
}
#define ACC_FOREACH(acc, body) do { const int _l = TID() & 63, _w = TID() >> 6; \
    _Pragma("unroll") for (int _mi = 0; _mi < 4; ++_mi) _Pragma("unroll") for (int _ni = 0; _ni < 4; ++_ni) { \
        const int r_ = (_w >> 1) * 64 + _mi * 16 + (_l & 15), c_ = (_w & 1) * 64 + _ni * 16 + (_l >> 4) * 4; f32x4& v_ = acc[_mi][_ni]; body } } while (0)
DI ARows plain_rows(const bf16_t* base, size_t ld, int m0, int tid) { ARows a; a.mu = nullptr; a.ltype = 0; a.first = 0;
#pragma unroll
    for (int i = 0; i < 4; ++i) a.p[i] = base + (size_t)(m0 + (tid >> 3) + 64 * i) * ld;
    return a; }


DI void convert_tile4(const float* src, int ld, int N, int K, bf16_t* dst, int tile0, unsigned char* lds, int Kvalid = 1 << 30) {
    const int tid = TID();
    const int nkt = K >> 6;
    const int r = tid >> 3, seg = (tid & 7) * 8;
    f32x4 a[4], b[4];
#pragma unroll
    for (int u = 0; u < 4; ++u) {
        const int tile = tile0 + u, k0 = (tile % nkt) * 64, n0 = (tile / nkt) * 64;
        a[u] = (f32x4){0.f, 0.f, 0.f, 0.f}; b[u] = a[u];
        if (n0 + seg < N && k0 + r < Kvalid) { const float* q = src + (size_t)(k0 + r) * ld + n0 + seg; a[u] = *(const f32x4*)q; b[u] = *(const f32x4*)(q + 4); }
    }
    __syncthreads();
#pragma unroll
    for (int u = 0; u < 4; ++u) { bf16_t* T = (bf16_t*)lds + u * 64 * 72;
        u32x4 w; w.x = pack2(a[u][0], a[u][1]); w.y = pack2(a[u][2], a[u][3]); w.z = pack2(b[u][0], b[u][1]); w.w = pack2(b[u][2], b[u][3]); *(u32x4*)(T + r * 72 + seg) = w; }
    __syncthreads();
#pragma unroll
    for (int u = 0; u < 4; ++u) { const bf16_t* T = (const bf16_t*)lds + u * 64 * 72;
        const int tile = tile0 + u, k0 = (tile % nkt) * 64, n0 = (tile / nkt) * 64;
        u32x4 o;
        o.x = (unsigned)T[(seg + 0) * 72 + r] | ((unsigned)T[(seg + 1) * 72 + r] << 16); o.y = (unsigned)T[(seg + 2) * 72 + r] | ((unsigned)T[(seg + 3) * 72 + r] << 16);
        o.z = (unsigned)T[(seg + 4) * 72 + r] | ((unsigned)T[(seg + 5) * 72 + r] << 16); o.w = (unsigned)T[(seg + 6) * 72 + r] | ((unsigned)T[(seg + 7) * 72 + r] << 16);
        *(u32x4*)(dst + (size_t)(n0 + r) * K + k0 + seg) = o; }
}
struct Ctx {
    const Params* P; unsigned char* ws; float* out; int l;
    bf16_t* H; bf16_t* PROJ; bf16_t* F; bf16_t* POOLED; bf16_t* MERGED; bf16_t* CMPH; float* CMPO; float* POSB; int* ROUTE; int* ENT; bf16_t* HID; bf16_t* Y; bf16_t* VT; bf16_t* KC; bf16_t* VCT; bf16_t* YRAW; float* BON; unsigned* ctl;
    DI const float* in(int i) const { return P->in[i]; }
};

DI void moe_offsets(const Ctx& c, int layer, int* soff) {
    const unsigned* cnt = c.ctl + CW_CNT + layer * 32;
    __syncthreads();
    if (TID() == 0) { int s = 0; for (int e = 0; e < 32; ++e) { soff[e] = s; s += (int)cnt[e]; } soff[32] = s; }
    __syncthreads();
}
DI void add_moe_rows(const Ctx& c, int row, int lane, f32x4 (&v)[4], const int* soff) {
    const int* rt = c.ROUTE + (size_t)row * 8;
    const int p0 = soff[rt[0]] + rt[4], p1 = soff[rt[1]] + rt[5];
    const bf16_t* y0 = c.Y + (size_t)p0 * DM; const bf16_t* y1 = c.Y + (size_t)p1 * DM;
#pragma unroll
    for (int i = 0; i < 4; ++i) {
        const u32x2 a = *(const u32x2*)(y0 + i * 256 + lane * 4), b = *(const u32x2*)(y1 + i * 256 + lane * 4);
        v[i][0] += bflo(a.x) + bflo(b.x); v[i][1] += bfhi(a.x) + bfhi(b.x); v[i][2] += bflo(a.y) + bflo(b.y); v[i][3] += bfhi(a.y) + bfhi(b.y);
    }
}
DI void phase_norm1(const Ctx& c, unsigned char* lds) {
    const int tid = TID(), lane = tid & 63, wave = tid >> 6;
    const float* gain = c.in(I_NMIX) + c.l * DM;
    const float* src = (c.l == 0) ? c.in(I_X) : c.out;
    int* soff = (int*)(lds + 65536);
    if (c.l > 0) moe_offsets(c, c.l - 1, soff);
    for (int row = blockIdx.x * 8 + wave; row < NT; row += gridDim.x * 8) {
        f32x4 v[4];
#pragma unroll
        for (int i = 0; i < 4; ++i) v[i] = *(const f32x4*)(src + (size_t)row * DM + i * 256 + lane * 4);
        if (c.l > 0) {
            add_moe_rows(c, row, lane, v, soff);
#pragma unroll
            for (int i = 0; i < 4; ++i) *(f32x4*)(c.out + (size_t)row * DM + i * 256 + lane * 4) = v[i];
        }
        float ss = 0.f;
#pragma unroll
        for (int i = 0; i < 4; ++i) ss += v[i][0] * v[i][0] + v[i][1] * v[i][1] + v[i][2] * v[i][2] + v[i][3] * v[i][3];
        ss = wave_sum_dpp(ss);
        const float rs = rsqrtf(ss * (1.0f / DM) + 1e-6f);
#pragma unroll
        for (int i = 0; i < 4; ++i) {
            const f32x4 g = *(const f32x4*)(gain + i * 256 + lane * 4);
            store_bf4(c.H + (size_t)row * DM + i * 256 + lane * 4, (f32x4){v[i][0] * rs * g[0], v[i][1] * rs * g[1], v[i][2] * rs * g[2], v[i][3] * rs * g[3]});
        }
    }
    for (int idx = blockIdx.x * 8 + wave; idx < 512; idx += gridDim.x * 8) {
        const int kv = idx >> 8, n = idx & 255;
        const float* pos = c.in(kv ? I_CPV : I_CPK) + (size_t)c.l * 2048;
        const float* w1 = c.in(kv ? I_CW1V : I_CW1K) + (size_t)c.l * 2048 * 256;
        float s = 0.f;
        for (int k = lane; k < 2048; k += 64) s += pos[k] * w1[(size_t)k * 256 + n];
        s = wave_sum_dpp(s);
        if (lane == 0) c.POSB[kv * 256 + n] = s;
    }
    for (int it = blockIdx.x * 4; it < 1216 + 256 + 16 + 16 + 48; it += gridDim.x * 4) {
        if (it < 1216) convert_tile4(c.in(I_WIN) + (size_t)c.l * DM * IN_COLS, IN_COLS, IN_COLS, DM, (bf16_t*)(c.ws + WS_WT_IN), it, lds);
        else if (it < 1216 + 256) { const int j = it - 1216, kv = j >> 7; convert_tile4(c.in(kv ? I_CW1V : I_CW1K) + (size_t)c.l * 2048 * 256, 256, 256, 2048, (bf16_t*)(c.ws + WS_WT_C1) + (size_t)kv * 256 * 2048, j & 127, lds); }
        else if (it < 1216 + 256 + 16) { const int j = it - 1472, kv = j >> 3; convert_tile4(c.in(kv ? I_CW2V : I_CW2K) + (size_t)c.l * 256 * 64, 64, 64, 256, (bf16_t*)(c.ws + WS_WT_C2) + (size_t)kv * 128 * 256, j & 7, lds); }
        else if (it < 1504) { const int j = it - 1488, gi = j >> 2; convert_tile4(c.in(I_POOLW) + ((size_t)c.l * 4 + gi) * 128 * 128, 128, 128, 128, (bf16_t*)(c.ws + WS_WT_POOL) + (size_t)gi * 128 * 128, 0, lds); }
        else { const int j = it - 1504, ty = j >> 4; bf16_t* dst = (bf16_t*)(c.ws + WS_WT_LORA) + (size_t)ty * 512 * 128;
            if (ty == 0) convert_tile4(c.in(I_WUP) + (size_t)c.l * 32 * 512, 512, 512, 128, dst, j & 15, lds, 32);
            else if (ty == 1) convert_tile4(c.in(I_AUP) + (size_t)c.l * 32 * 512, 512, 512, 128, dst, j & 15, lds, 32);
            else convert_tile4(c.in(I_GUP) + (size_t)c.l * 96 * 512, 512, 512, 128, dst, j & 15, lds, 96); }
    }
}

constexpr int EPS = 136;
DI void tile_store_bf16(f32x4 (&acc)[4][4], bf16_t* out, size_t ld, int nrows, int ncols, unsigned char* lds) {
    bf16_t* T = (bf16_t*)lds;
    const int tid = TID();
    __syncthreads();
    ACC_FOREACH(acc, { store_bf4(T + r_ * EPS + c_, v_); });
    __syncthreads();
#pragma unroll
    for (int i = 0; i < 8; ++i) {
        const int ch = tid + i * NTHREADS, r = ch >> 4, cc = (ch & 15) * 8;
        if (r < nrows && cc < ncols) *(u32x4*)(out + (size_t)r * ld + cc) = *(const u32x4*)(T + r * EPS + cc);
    }
}
DI bool xcd_unit(int it, int nN, int& tm, int& tn) {
    const int G = gridDim.x;
    if ((G & 7) != 0 || G < 8) { const int u = it * G + blockIdx.x; if (u >= 64 * nN) return false; tm = u % 64; tn = u / 64; return true; }
    const int x = blockIdx.x & 7, i = blockIdx.x >> 3, per = G >> 3;
    const int u = it * per + i;
    if (u >= 8 * nN) return false;
    tm = x * 8 + (u & 7); tn = u >> 3; return true;
}
DI void phase_gemm1(const Ctx& c, unsigned char* lds) {
    const int nN = (IN_COLS + 255) / 256;
    const bf16_t* WT = (const bf16_t*)(c.ws + WS_WT_IN);
    for (int it = 0;; ++it) {
        int tm, tn; if (!xcd_unit(it, nN, tm, tn)) break;
        const int m0 = tm * 256, n0 = tn * 256;
        f32x4 acc[8][4];
#pragma unroll
        for (int i = 0; i < 8; ++i)
#pragma unroll
            for (int j = 0; j < 4; ++j) acc[i][j] = (f32x4){0.f, 0.f, 0.f, 0.f};
        gemm256_dma(acc, c.H + (size_t)m0 * DM, DM, WT + (size_t)n0 * DM, DM, DM, lds);
        tile256_store_bf16(acc, c.PROJ + (size_t)m0 * IN_COLS + n0, IN_COLS, (IN_COLS - n0 < 256) ? IN_COLS - n0 : 256, lds);
    }
}

DI float gelu_tanh(float x) { const float u = 0.7978845608028654f * (x + 0.044715f * x * x * x); const float e = __expf(2.0f * u); return x * (1.0f - __builtin_amdgcn_rcpf(e + 1.0f)); }
DI float softplusf_(float x) { return (x > 20.f) ? x : __logf(1.0f + __expf(x)); }
DI float tanhf_(float x) { const float e = __expf(2.0f * x); return 1.0f - 2.0f * __builtin_amdgcn_rcpf(e + 1.0f); }
constexpr int TKP = 8;
template <int WIN>
DI void pool_emit(const Ctx& c, const float (&pv)[31], int t0, int s0, int ch) {
#pragma unroll
    for (int k = 0; k < 16; ++k) {
        float sum = 0.f;
#pragma unroll
        for (int j = 0; j < WIN; ++j) sum += pv[15 + k - j];
        const int s = s0 + k, cnt = (s + 1 < WIN) ? s + 1 : WIN;
        c.POOLED[(size_t)(t0 + k) * 512 + ch] = f2bf(sum / (float)cnt - pv[15 + k]);
    }
}
DI void phase_prep(const Ctx& c, unsigned char* lds) {
    const int n_cmp_items = 2 * 16 * 2;
    for (int item = (int)gridDim.x - 1 - (int)blockIdx.x; item < n_cmp_items; item += gridDim.x) {
        const int tid = TID();
        const int kv = item >> 5, bgi = (item >> 1) & 15, tn = item & 1, m0 = bgi * 256, n0 = tn * 128;
        ARows ar; ar.mu = nullptr; ar.ltype = 0; ar.first = 0;
#pragma unroll
        for (int i = 0; i < 4; ++i) { const int cb = (tid >> 3) + 64 * i;
            ar.p[i] = (cb < NCMP) ? c.PROJ + ((size_t)(bgi >> 2) * SEQ + 16 * cb) * IN_COLS + (kv ? C_VC : C_KC) + (bgi & 3) * 64 : nullptr; }
        f32x4 acc[4][4]; acc_zero(acc);
        gemm_core<1>(acc, ar, (const bf16_t*)(c.ws + WS_WT_C1) + ((size_t)kv * 256 + n0) * 2048, 2048, 2048, lds);
        const float* pb = c.POSB + kv * 256;
        ACC_FOREACH(acc, {
            const f32x4 bb = *(const f32x4*)(pb + n0 + c_);
            store_bf4(c.CMPH + ((size_t)kv * 4096 + m0 + r_) * 256 + n0 + c_, (f32x4){gelu_tanh(v_[0] + bb[0]), gelu_tanh(v_[1] + bb[1]), gelu_tanh(v_[2] + bb[2]), gelu_tanh(v_[3] + bb[3])}); });
    }
    {
        const float* mu = c.in(I_MU) + (size_t)c.l * RWC;
        const bf16_t* WL = (const bf16_t*)(c.ws + WS_WT_LORA);
        for (int unit = blockIdx.x; unit < 64 * 12; unit += gridDim.x) {
            const int tid = TID();
            const int tm = unit & 63, tn = unit >> 6, m0 = tm * 256, n0 = tn * 128, ltype = tn >> 2, ch0 = n0 & 511;
            ARows ar; ar.mu = mu; ar.ltype = ltype; ar.first = 0;
#pragma unroll
            for (int i = 0; i < 4; ++i) { const int t = m0 + (tid >> 3) + 64 * i; ar.p[i] = c.PROJ + (size_t)t * IN_COLS; if ((t & (SEQ - 1)) == 0) ar.first |= 1 << i; }
            f32x4 acc[4][4]; acc_zero(acc);
            gemm_core<2>(acc, ar, WL + (size_t)n0 * 128, 128, 128, lds);
            if (ltype == 0) { const float* w0 = c.in(I_W0) + c.l * 512 + ch0;
                ACC_FOREACH(acc, { const f32x4 b4 = *(const f32x4*)(w0 + c_);
                    for (int j = 0; j < 4; ++j) v_[j] = __expf(-softplusf_(-(b4[j] + v_[j])) - 0.5f); }); }
            else if (ltype == 1) { const float* a0 = c.in(I_A0) + c.l * 512 + ch0;
                ACC_FOREACH(acc, { const f32x4 b4 = *(const f32x4*)(a0 + c_);
                    for (int j = 0; j < 4; ++j) v_[j] = sigmoidf_(b4[j] + v_[j]); }); }
            tile_store_bf16(acc, c.F + (size_t)(3 + ltype) * NT * 512 + (size_t)m0 * 512 + ch0, 512, 256, 128, lds);
        }
    }
    const int tid = TID();
    const int n_pool_items = NT / 16, n_items = n_pool_items + 512;
    for (int item = blockIdx.x; item < n_items; item += gridDim.x) {
        if (item >= n_pool_items) {
            const int idx0 = (item - n_pool_items) * 4;
            const int r = tid >> 3, seg = (tid & 7) * 8;
            u32x4 w[4];
#pragma unroll
            for (int u = 0; u < 4; ++u) { const int idx = idx0 + u, kind = idx >> 10, bgi = (idx >> 6) & 15, s0 = (idx & 63) * 64;
                w[u] = *(const u32x4*)(c.PROJ + ((size_t)(bgi >> 2) * SEQ + s0 + r) * IN_COLS + (kind ? C_VW : C_VS) + (bgi & 3) * 64 + seg); }
            __syncthreads();
#pragma unroll
            for (int u = 0; u < 4; ++u) *(u32x4*)((bf16_t*)lds + u * 64 * 72 + r * 72 + seg) = w[u];
            __syncthreads();
#pragma unroll
            for (int u = 0; u < 4; ++u) { const int idx = idx0 + u, kind = idx >> 10, bgi = (idx >> 6) & 15, s0 = (idx & 63) * 64;
                const bf16_t* T = (const bf16_t*)lds + u * 64 * 72;
                u32x4 o;
                o.x = (unsigned)T[(seg + 0) * 72 + r] | ((unsigned)T[(seg + 1) * 72 + r] << 16); o.y = (unsigned)T[(seg + 2) * 72 + r] | ((unsigned)T[(seg + 3) * 72 + r] << 16);
                o.z = (unsigned)T[(seg + 4) * 72 + r] | ((unsigned)T[(seg + 5) * 72 + r] << 16); o.w = (unsigned)T[(seg + 6) * 72 + r] | ((unsigned)T[(seg + 7) * 72 + r] << 16);
                *(u32x4*)(c.VT + (((size_t)kind * 16 + bgi) * 64 + r) * SEQ + s0 + seg) = o; }
        } else {
            const int t0 = item * 16, ch = tid, gi = ch >> 7, s0 = t0 & (SEQ - 1);
            float pv[31];
#pragma unroll
            for (int i = 0; i < 31; ++i) pv[i] = (s0 - 15 + i >= 0) ? bf2f(c.PROJ[(size_t)(t0 - 15 + i) * IN_COLS + C_POOL + ch]) : 0.f;
            if (gi == 0) pool_emit<2>(c, pv, t0, s0, ch);
            else if (gi == 1) pool_emit<4>(c, pv, t0, s0, ch);
            else if (gi == 2) pool_emit<8>(c, pv, t0, s0, ch);
            else pool_emit<16>(c, pv, t0, s0, ch);
        }
    }
}

DI void rwkv_finalize_item(const Ctx& c, int item) {
    const int tid = TID(), ch = tid, t0 = item * 8;
    const float* mu = c.in(I_MU) + (size_t)c.l * RWC;
    const float kkw_ = c.in(I_KK)[c.l * 512 + ch], kaw_ = c.in(I_KA)[c.l * 512 + ch], rkw_ = c.in(I_RK)[c.l * 512 + ch];
    const float mur = mu[ch], muk = mu[512 + ch], muv = mu[1024 + ch];
    bf16_t ur[9], uk[9], uv[9], ua[8];
    const bool has_prev = (t0 & (SEQ - 1)) != 0;
#pragma unroll
    for (int k = 0; k < 9; ++k) {
        ur[k] = 0; uk[k] = 0; uv[k] = 0;
        if (k > 0 || has_prev) { const bf16_t* q = c.PROJ + (size_t)(t0 - 1 + k) * IN_COLS; ur[k] = q[C_R + ch]; uk[k] = q[C_K + ch]; uv[k] = q[C_V + ch]; }
    }
#pragma unroll
    for (int k = 0; k < 8; ++k) ua[k] = c.F[(size_t)4 * NT * 512 + (size_t)(t0 + k) * 512 + ch];
#pragma unroll
    for (int k = 0; k < 8; ++k) {
        const int t = t0 + k;
        const float cr = bf2f(ur[k + 1]), ck = bf2f(uk[k + 1]), cv = bf2f(uv[k + 1]);
        const float r = cr + (bf2f(ur[k]) - cr) * mur, kx = ck + (bf2f(uk[k]) - ck) * muk, vx = cv + (bf2f(uv[k]) - cv) * muv;
        const float a = bf2f(ua[k]);
        const float kxn = kx * kkw_, kp = kx * (1.0f + (a - 1.0f) * kaw_);
        const float ss = wave_sum_dpp(kxn * kxn);
        const float inv = __builtin_amdgcn_rsqf(fmaxf(ss, 1e-24f));
        const float br = wave_sum_dpp(kxn * inv * a * r), kr = wave_sum_dpp(kp * r), bon = wave_sum_dpp(r * kp * rkw_);
        if ((tid & 63) == 0) *(f32x4*)(c.BON + ((size_t)t * 8 + (tid >> 6)) * 4) = (f32x4){inv, br, kr, bon};
        const size_t o = (size_t)t * 512 + ch;
        c.F[o] = f2bf(r); c.F[o + (size_t)NT * 512] = f2bf(kx); c.F[o + (size_t)2 * NT * 512] = f2bf(vx);
    }
}

DI void phase_poolgemm(const Ctx& c, unsigned char* lds) {
    for (int item = blockIdx.x; item < NT / 8; item += gridDim.x) rwkv_finalize_item(c, item);
    const int n_pool = (NT / 256) * 4, n_items = n_pool + 32;
    for (int item = blockIdx.x; item < n_items; item += gridDim.x) {
        f32x4 acc[4][4]; acc_zero(acc);
        if (item < n_pool) {
            const int tm = item >> 2, gi = item & 3, m0 = tm * 256;
            const ARows ar = plain_rows(c.POOLED + gi * 128, 512, m0, TID());
            gemm_core<0>(acc, ar, (const bf16_t*)(c.ws + WS_WT_POOL) + (size_t)gi * 128 * 128, 128, 128, lds);
            const float* sc = c.in(I_POOLS) + c.l * 512 + gi * 128;
            ACC_FOREACH(acc, { const f32x4 s = *(const f32x4*)(sc + c_);
                store_bf4(c.POOLED + (size_t)(m0 + r_) * 512 + gi * 128 + c_, (f32x4){v_[0] * s[0], v_[1] * s[1], v_[2] * s[2], v_[3] * s[3]}); });
        } else {
            const int it = item - n_pool, kv = it >> 4, tm = it & 15, m0 = tm * 256;
            const ARows ar = plain_rows(c.CMPH + (size_t)kv * 4096 * 256, 256, m0, TID());
            gemm_core<0>(acc, ar, (const bf16_t*)(c.ws + WS_WT_C2) + (size_t)kv * 128 * 256, 256, 256, lds);
            ACC_FOREACH(acc, { if (c_ < 64) { const int R = m0 + r_;
                if (kv == 0) store_bf4(c.KC + (size_t)R * 64 + c_, v_);
                else { bf16_t* q = c.VCT + ((size_t)(R >> 8) * 64 + c_) * 256 + (R & 255); q[0] = f2bf(v_[0]); q[256] = f2bf(v_[1]); q[512] = f2bf(v_[2]); q[768] = f2bf(v_[3]); } } });
        }
    }
}

constexpr int SCH = 32;
constexpr int SB_AN = 0, SB_WR = SCH * 64 * 4, SB_W = 2 * SCH * 64 * 4, SB_BB = 3 * SCH * 64 * 4, SB_KP = 4 * SCH * 64 * 4;
constexpr int SB_V = 5 * SCH * 64 * 4;
constexpr int SB_SC = SB_V + SCH * 16 * 4;
constexpr int SB_Y = SB_SC + SCH * 2 * 4;
constexpr int SB_BYTES = SB_Y + SCH * 16 * 4;
static_assert(2 * SB_BYTES <= LDS_BYTES - 64, "scan lds");
typedef float f32x2 __attribute__((ext_vector_type(2)));
DI float row8_sum(float v) { v += DPP_MOV(v, 0xB1); v += DPP_MOV(v, 0x4E); v += DPP_MOV(v, 0x141); return v; }

constexpr int NPW = 6, NJ = (SCH + NPW - 1) / NPW;
struct PrepRegs { bf16_t r[NJ], k[NJ], v[NJ], e[NJ], a[NJ]; float s0[NJ], s1[NJ], s2[NJ]; };
DI void prep_load(PrepRegs& R, const Ctx& c, int b, int h, int ck, int pw, int lane) {
    const size_t PL = (size_t)NT * 512;
    const size_t tb = (size_t)b * SEQ + ck * SCH;
    const size_t o0 = tb * 512 + h * 64 + lane;
#pragma unroll
    for (int j = 0; j < NJ; ++j) {
        const int st = pw + NPW * j;
        if (st < SCH) { const size_t o = o0 + (size_t)st * 512; R.r[j] = c.F[o]; R.k[j] = c.F[o + PL]; R.v[j] = c.F[o + 2 * PL]; R.e[j] = c.F[o + 3 * PL]; R.a[j] = c.F[o + 4 * PL];
            const float* sp = c.BON + ((tb + st) * 8 + h) * 4; R.s0[j] = sp[0]; R.s1[j] = sp[1]; R.s2[j] = sp[2]; }
    }
}
DI void prep_store(const PrepRegs& R, unsigned char* sb, int rq, int pw, int lane, float kkw, float kaw) {
    float* an = (float*)(sb + SB_AN); float* wr = (float*)(sb + SB_WR); float* w_ = (float*)(sb + SB_W); float* bb_ = (float*)(sb + SB_BB); float* kp_ = (float*)(sb + SB_KP);
    float* vv = (float*)(sb + SB_V); float* sc = (float*)(sb + SB_SC);
#pragma unroll
    for (int j = 0; j < NJ; ++j) {
        const int st = pw + NPW * j;
        if (st < SCH) {
            const float r = bf2f(R.r[j]), k = bf2f(R.k[j]), v = bf2f(R.v[j]), e = bf2f(R.e[j]), a = bf2f(R.a[j]);
            const float w = __expf(-e);
            const float kk = k * kkw * R.s0[j];
            const float kp = k * (1.0f + (a - 1.0f) * kaw);
            an[st * 64 + lane] = -kk; wr[st * 64 + lane] = w * r; w_[st * 64 + lane] = w; bb_[st * 64 + lane] = kk * a; kp_[st * 64 + lane] = kp;
            if ((lane >> 4) == rq) vv[st * 16 + (lane & 15)] = v;
            if (lane == 0) { sc[st * 2] = R.s1[j]; sc[st * 2 + 1] = R.s2[j]; }
        }
    }
}
DI void scan_item(const Ctx& c, int item, unsigned char* lds) {
    const int tid = TID(), lane = tid & 63, wave = tid >> 6;
    const int b = item >> 5, h = (item >> 2) & 7, rq = item & 3;
    const int chn = h * 64 + lane;
    const float kkw = c.in(I_KK)[c.l * 512 + chn], kaw = c.in(I_KA)[c.l * 512 + chn];
    const int rowl = (tid & 127) >> 3, cg = tid & 7;
    f32x2 st[4];
#pragma unroll
    for (int i = 0; i < 4; ++i) st[i] = (f32x2){0.f, 0.f};
    constexpr int NCK = SEQ / SCH;
    PrepRegs R;
    __syncthreads();
    if (wave >= 2) { prep_load(R, c, b, h, 0, wave - 2, lane); prep_store(R, lds, rq, wave - 2, lane, kkw, kaw); prep_load(R, c, b, h, 1, wave - 2, lane); }
    __syncthreads();
    for (int ck = 0; ck < NCK; ++ck) {
        unsigned char* sb = lds + (ck & 1) * SB_BYTES;
        if (wave < 2) {
            const float* an = (const float*)(sb + SB_AN) + cg * 8; const float* wr = (const float*)(sb + SB_WR) + cg * 8; const float* w_ = (const float*)(sb + SB_W) + cg * 8;
            const float* bb_ = (const float*)(sb + SB_BB) + cg * 8; const float* kp_ = (const float*)(sb + SB_KP) + cg * 8;
            const float* vv = (const float*)(sb + SB_V) + rowl; const float* sc = (const float*)(sb + SB_SC); float* yb = (float*)(sb + SB_Y) + rowl;
            f32x4 a0 = *(const f32x4*)(an), a1 = *(const f32x4*)(an + 4), r0 = *(const f32x4*)(wr), r1 = *(const f32x4*)(wr + 4);
            f32x4 w0 = *(const f32x4*)(w_), w1 = *(const f32x4*)(w_ + 4), b0 = *(const f32x4*)(bb_), b1 = *(const f32x4*)(bb_ + 4);
            f32x4 k0 = *(const f32x4*)(kp_), k1 = *(const f32x4*)(kp_ + 4);
            float v = vv[0]; f32x2 bk = *(const f32x2*)(sc);
#pragma unroll 2
            for (int s = 0; s < SCH; ++s) {
                const int sn = (s + 1 < SCH) ? s + 1 : s;
                const f32x4 na0 = *(const f32x4*)(an + sn * 64), na1 = *(const f32x4*)(an + sn * 64 + 4), nr0 = *(const f32x4*)(wr + sn * 64), nr1 = *(const f32x4*)(wr + sn * 64 + 4);
                const f32x4 nw0 = *(const f32x4*)(w_ + sn * 64), nw1 = *(const f32x4*)(w_ + sn * 64 + 4), nb0 = *(const f32x4*)(bb_ + sn * 64), nb1 = *(const f32x4*)(bb_ + sn * 64 + 4);
                const f32x4 nk0 = *(const f32x4*)(kp_ + sn * 64), nk1 = *(const f32x4*)(kp_ + sn * 64 + 4);
                const float nv = vv[sn * 16]; const f32x2 nbk = *(const f32x2*)(sc + sn * 2);
                f32x2 da = st[0] * (f32x2){a0[0], a0[1]}; f32x2 dr = st[0] * (f32x2){r0[0], r0[1]};
                da += st[1] * (f32x2){a0[2], a0[3]}; dr += st[1] * (f32x2){r0[2], r0[3]};
                da += st[2] * (f32x2){a1[0], a1[1]}; dr += st[2] * (f32x2){r1[0], r1[1]};
                da += st[3] * (f32x2){a1[2], a1[3]}; dr += st[3] * (f32x2){r1[2], r1[3]};
                float sa = da[0] + da[1], sr = dr[0] + dr[1];
                sa += DPP_MOV(sa, 0xB1); sr += DPP_MOV(sr, 0xB1);
                sa += DPP_MOV(sa, 0x4E); sr += DPP_MOV(sr, 0x4E);
                sa += DPP_MOV(sa, 0x141); sr += DPP_MOV(sr, 0x141);
                const f32x2 sa2 = (f32x2){sa, sa}, v2 = (f32x2){v, v};
                st[0] = st[0] * (f32x2){w0[0], w0[1]} + sa2 * (f32x2){b0[0], b0[1]} + v2 * (f32x2){k0[0], k0[1]};
                st[1] = st[1] * (f32x2){w0[2], w0[3]} + sa2 * (f32x2){b0[2], b0[3]} + v2 * (f32x2){k0[2], k0[3]};
                st[2] = st[2] * (f32x2){w1[0], w1[1]} + sa2 * (f32x2){b1[0], b1[1]} + v2 * (f32x2){k1[0], k1[1]};
                st[3] = st[3] * (f32x2){w1[2], w1[3]} + sa2 * (f32x2){b1[2], b1[3]} + v2 * (f32x2){k1[2], k1[3]};
                yb[s * 16] = sr + sa * bk[0] + v * bk[1];
                a0 = na0; a1 = na1; r0 = nr0; r1 = nr1; w0 = nw0; w1 = nw1; b0 = nb0; b1 = nb1; k0 = nk0; k1 = nk1; v = nv; bk = nbk;
            }
        } else {
            const int pt = tid - 128;
            if (ck + 1 < NCK) prep_store(R, lds + ((ck + 1) & 1) * SB_BYTES, rq, wave - 2, lane, kkw, kaw);
            if (ck + 2 < NCK) prep_load(R, c, b, h, ck + 2, wave - 2, lane);
            if (ck > 0) {
                const float* yb = (const float*)(lds + ((ck - 1) & 1) * SB_BYTES + SB_Y);
                for (int idx = pt; idx < SCH * 16; idx += 384) {
                    const int s = idx >> 4, j = idx & 15;
                    c.YRAW[((size_t)b * SEQ + (ck - 1) * SCH + s) * 512 + h * 64 + rq * 16 + j] = f2bf(yb[idx]);
                }
            }
        }
        asm volatile("s_waitcnt lgkmcnt(0)" ::: "memory"); __builtin_amdgcn_s_barrier(); asm volatile("" ::: "memory");
    }
    {
        const float* yb = (const float*)(lds + ((NCK - 1) & 1) * SB_BYTES + SB_Y);
        for (int idx = tid; idx < SCH * 16; idx += NTHREADS) {
            const int s = idx >> 4, j = idx & 15;
            c.YRAW[((size_t)b * SEQ + (NCK - 1) * SCH + s) * 512 + h * 64 + rq * 16 + j] = f2bf(yb[idx]);
        }
    }
    __syncthreads();
}
constexpr int CS64 = 72, CS32 = 40;
constexpr int CK_AH = 0, CK_BH = CK_AH + 32 * CS64 * 2, CK_KH = CK_BH + 32 * CS64 * 2, CK_RH = CK_KH + 32 * CS64 * 2;
constexpr int CK_BHT = CK_RH + 32 * CS64 * 2, CK_KHT = CK_BHT + 64 * CS32 * 2, CK_VT = CK_KHT + 64 * CS32 * 2, CK_ZT = CK_VT + 64 * CS32 * 2, CK_UT = CK_ZT + 64 * CS32 * 2;
constexpr int CK_S0B = CK_UT + 64 * CS32 * 2;
constexpr int CK_LAK = CK_S0B + 2 * 64 * CS64 * 2, CK_MRB = CK_LAK + 32 * CS32 * 2, CK_MRK = CK_MRB + 32 * CS32 * 2;
constexpr int CK_PA = CK_MRK + 32 * CS32 * 2, CK_PT = CK_PA + 2 * 32 * CS32 * 2, CK_TT = CK_PT + 2 * 32 * CS32 * 2;
constexpr int CK_TOT = CK_TT + 2 * 32 * CS32 * 2;
constexpr int CK_GC = CK_TOT + 8 * 64 * 4;
constexpr int CK_END = CK_GC + 256;
static_assert(CK_END <= LDS_BYTES - 64, "chunk scan lds");
template <int K>
DI f32x4 mm16(const bf16_t* A, int lda, const bf16_t* Bt, int ldb, f32x4 acc, int lane) {
#pragma unroll
    for (int k0 = 0; k0 < K; k0 += 32) {
        const bf16x8 a = *(const bf16x8*)(A + (lane & 15) * lda + k0 + (lane >> 4) * 8), b = *(const bf16x8*)(Bt + (lane & 15) * ldb + k0 + (lane >> 4) * 8);
        acc = __builtin_amdgcn_mfma_f32_16x16x32_bf16(a, b, acc, 0, 0, 0);
    }
    return acc;
}
template <int K>
DI f32x4 mm16t(const bf16_t* A, int lda, const bf16_t* Bt, int ldb, f32x4 acc, int lane) {
#pragma unroll
    for (int k0 = 0; k0 < K; k0 += 32) {
        const bf16x8 a = *(const bf16x8*)(A + (lane & 15) * lda + k0 + (lane >> 4) * 8), b = *(const bf16x8*)(Bt + (lane & 15) * ldb + k0 + (lane >> 4) * 8);
        acc = __builtin_amdgcn_mfma_f32_16x16x32_bf16(b, a, acc, 0, 0, 0);
    }
    return acc;
}
DI void mm16_both(const bf16_t* A, int lda, const bf16_t* Bt, int ldb, f32x4& cn, f32x4& ct, int lane) {
    const bf16x8 a = *(const bf16x8*)(A + (lane & 15) * lda + (lane >> 4) * 8), b = *(const bf16x8*)(Bt + (lane & 15) * ldb + (lane >> 4) * 8);
    cn = __builtin_amdgcn_mfma_f32_16x16x32_bf16(a, b, cn, 0, 0, 0); ct = __builtin_amdgcn_mfma_f32_16x16x32_bf16(b, a, ct, 0, 0, 0);
}
struct ChunkRaw { bf16_t r[4], k[4], v[4], e[4], a[4]; float inv[4]; };
DI void chunk_load(ChunkRaw& R, const Ctx& c, int b, int h, int ck, int wave, int lane) {
    const size_t PL = (size_t)NT * 512;
    const size_t tok0 = (size_t)b * SEQ + ck * 32 + wave * 4;
#pragma unroll
    for (int s = 0; s < 4; ++s) {
        const size_t o = (tok0 + s) * 512 + h * 64 + lane;
        R.r[s] = c.F[o]; R.k[s] = c.F[o + PL]; R.v[s] = c.F[o + 2 * PL]; R.e[s] = c.F[o + 3 * PL]; R.a[s] = c.F[o + 4 * PL];
        R.inv[s] = c.BON[((tok0 + s) * 8 + h) * 4];
    }
}
DI void scan_chunked_item(const Ctx& c, int item, unsigned char* lds) {
    const int tid = TID(), lane = tid & 63, wave = tid >> 6, qd = lane >> 4, l15 = lane & 15;
    const int b = item >> 3, h = item & 7;
    bf16_t* AH = (bf16_t*)(lds + CK_AH); bf16_t* BH = (bf16_t*)(lds + CK_BH); bf16_t* KH = (bf16_t*)(lds + CK_KH); bf16_t* RH = (bf16_t*)(lds + CK_RH);
    bf16_t* BHT = (bf16_t*)(lds + CK_BHT); bf16_t* KHT = (bf16_t*)(lds + CK_KHT); bf16_t* VT = (bf16_t*)(lds + CK_VT); bf16_t* ZT = (bf16_t*)(lds + CK_ZT); bf16_t* UT = (bf16_t*)(lds + CK_UT);
    bf16_t* S0B = (bf16_t*)(lds + CK_S0B); bf16_t* LAK = (bf16_t*)(lds + CK_LAK); bf16_t* MRB = (bf16_t*)(lds + CK_MRB); bf16_t* MRK = (bf16_t*)(lds + CK_MRK);
    bf16_t* PA = (bf16_t*)(lds + CK_PA); bf16_t* PT = (bf16_t*)(lds + CK_PT); bf16_t* TT = (bf16_t*)(lds + CK_TT);
    float* TOT = (float*)(lds + CK_TOT); float* GC = (float*)(lds + CK_GC);
    const f32x4 Z4 = (f32x4){0.f, 0.f, 0.f, 0.f};
    f32x4 Sreg[2] = {Z4, Z4};
    const int svt = wave >> 1, skt0 = 2 * (wave & 1);
    const int mt8 = wave >> 2, nt8 = wave & 3;
    const int mt4 = (wave >> 1) & 1, nt4 = wave & 1;
    __syncthreads();
    for (int i = tid; i < 2 * 64 * CS64 / 2; i += NTHREADS) ((unsigned*)S0B)[i] = 0u;
    const float kkw = c.in(I_KK)[c.l * 512 + h * 64 + lane], kaw = c.in(I_KA)[c.l * 512 + h * 64 + lane];
    ChunkRaw R; chunk_load(R, c, b, h, 0, wave, lane);
    constexpr int NCK = SEQ / 32;
    for (int ck = 0; ck < NCK; ++ck) {
        const bf16_t* S0c = S0B + (ck & 1) * 64 * CS64; bf16_t* S0n = S0B + ((ck + 1) & 1) * 64 * CS64;
        float r4[4], k4[4], v4[4], e4[4], a4[4], inv4[4], ce[4];
#pragma unroll
        for (int s = 0; s < 4; ++s) { r4[s] = bf2f(R.r[s]); k4[s] = bf2f(R.k[s]); v4[s] = bf2f(R.v[s]); e4[s] = bf2f(R.e[s]); a4[s] = bf2f(R.a[s]); inv4[s] = R.inv[s]; }
        ce[0] = e4[0]; ce[1] = ce[0] + e4[1]; ce[2] = ce[1] + e4[2]; ce[3] = ce[2] + e4[3];
        TOT[wave * 64 + lane] = ce[3];
        LDS_BARRIER();
        { const int ckn = (ck + 1 < NCK) ? ck + 1 : ck; chunk_load(R, c, b, h, ckn, wave, lane); }
        {
            float off = 0.f;
#pragma unroll
            for (int w = 0; w < 7; ++w) { const float tw = TOT[w * 64 + lane]; if (w < wave) off += tw; }
            float ah[4], bh[4], kh[4], rh[4];
#pragma unroll
            for (int s = 0; s < 4; ++s) {
                const float cs = off + ce[s];
                const float g = __expf(-cs), gi = __expf(cs), gm1 = __expf(e4[s] - cs);
                const float kk = k4[s] * kkw * inv4[s], kp = k4[s] * (1.0f + (a4[s] - 1.0f) * kaw);
                ah[s] = -kk * gm1; bh[s] = kk * a4[s] * gi; kh[s] = kp * gi; rh[s] = r4[s] * g;
                const int t = wave * 4 + s;
                AH[t * CS64 + lane] = f2bf(ah[s]); BH[t * CS64 + lane] = f2bf(bh[s]); KH[t * CS64 + lane] = f2bf(kh[s]); RH[t * CS64 + lane] = f2bf(rh[s]);
                if (wave == 7 && s == 3) GC[lane] = g;
            }
            store_bf4(BHT + lane * CS32 + wave * 4, (f32x4){bh[0], bh[1], bh[2], bh[3]});
            store_bf4(KHT + lane * CS32 + wave * 4, (f32x4){kh[0], kh[1], kh[2], kh[3]});
            store_bf4(VT + lane * CS32 + wave * 4, (f32x4){v4[0], v4[1], v4[2], v4[3]});
        }
        LDS_BARRIER();
        {
            const int q = wave >> 1, mt = wave & 1;
            const bf16_t* A = (q < 2) ? AH : RH; const bf16_t* Bt = (q & 1) ? KH : BH;
#pragma unroll
            for (int nt = 0; nt < 2; ++nt) {
                f32x4 acc = mm16t<64>(A + mt * 16 * CS64, CS64, Bt + nt * 16 * CS64, CS64, Z4, lane);
                const int m = mt * 16 + l15, n0 = nt * 16 + 4 * qd;
#pragma unroll
                for (int i = 0; i < 4; ++i) { const bool keep = (q < 2) ? (n0 + i < m) : (n0 + i <= m); if (!keep) acc[i] = 0.f; }
                if (q == 0) {
                    store_bf4(PA + m * CS32 + n0, acc);
                    f32x4 t0 = acc;
#pragma unroll
                    for (int i = 0; i < 4; ++i) if (n0 + i == m) t0[i] += 1.0f;
                    store_bf4(TT + m * CS32 + n0, t0);
                    f32x4 accn = mm16<64>(A + mt * 16 * CS64, CS64, Bt + nt * 16 * CS64, CS64, Z4, lane);
                    const int mm0 = mt * 16 + 4 * qd, nn = nt * 16 + l15;
#pragma unroll
                    for (int i = 0; i < 4; ++i) if (!(nn < mm0 + i)) accn[i] = 0.f;
                    store_bf4(PT + nn * CS32 + mm0, accn);
                } else store_bf4(((q == 1) ? LAK : ((q == 2) ? MRB : MRK)) + m * CS32 + n0, acc);
            }
        }
        LDS_BARRIER();
        f32x4 y = Z4;
        int pcur = 0, tcur = 0;
#pragma unroll
        for (int itn = 0; itn < 5; ++itn) {
            const int m = mt4 * 16 + l15, n0 = nt4 * 16 + 4 * qd;
            if (wave < 4) {
                if (itn < 4) {
                    f32x4 cn = Z4, ct = Z4;
                    mm16_both(PA + pcur * 32 * CS32 + mt4 * 16 * CS32, CS32, PT + pcur * 32 * CS32 + nt4 * 16 * CS32, CS32, cn, ct, lane);
                    store_bf4(PA + (pcur ^ 1) * 32 * CS32 + m * CS32 + n0, ct);
                    store_bf4(PT + (pcur ^ 1) * 32 * CS32 + (nt4 * 16 + l15) * CS32 + mt4 * 16 + 4 * qd, cn);
                }
            } else if (itn > 0) {
                const u32x2 told = *(const u32x2*)(TT + tcur * 32 * CS32 + m * CS32 + n0);
                f32x4 acc = (f32x4){bflo(told.x), bfhi(told.x), bflo(told.y), bfhi(told.y)};
                acc = mm16t<32>(TT + tcur * 32 * CS32 + mt4 * 16 * CS32, CS32, PT + pcur * 32 * CS32 + nt4 * 16 * CS32, CS32, acc, lane);
                store_bf4(TT + (tcur ^ 1) * 32 * CS32 + m * CS32 + n0, acc);
            }
            if (itn == 0) {
                f32x4 z = mm16<64>(AH + mt8 * 16 * CS64, CS64, S0c + nt8 * 16 * CS64, CS64, Z4, lane);
                z = mm16<32>(LAK + mt8 * 16 * CS32, CS32, VT + nt8 * 16 * CS32, CS32, z, lane);
                store_bf4(ZT + (nt8 * 16 + l15) * CS32 + mt8 * 16 + 4 * qd, z);
            } else if (itn == 1) {
                y = mm16t<64>(RH + mt8 * 16 * CS64, CS64, S0c + nt8 * 16 * CS64, CS64, Z4, lane);
                y = mm16t<32>(MRK + mt8 * 16 * CS32, CS32, VT + nt8 * 16 * CS32, CS32, y, lane);
            } else if (itn == 2) {
#pragma unroll
                for (int j = 0; j < 2; ++j) Sreg[j] = mm16t<32>(VT + svt * 16 * CS32, CS32, KHT + (skt0 + j) * 16 * CS32, CS32, Sreg[j], lane);
            }
            LDS_BARRIER();
            if (itn < 4) pcur ^= 1;
            if (itn > 0) tcur ^= 1;
        }
        const bf16_t* Tm = TT + tcur * 32 * CS32;
        {
            const f32x4 uacc = mm16<32>(Tm + mt8 * 16 * CS32, CS32, ZT + nt8 * 16 * CS32, CS32, Z4, lane);
            store_bf4(UT + (nt8 * 16 + l15) * CS32 + mt8 * 16 + 4 * qd, uacc);
        }
        LDS_BARRIER();
        {
            y = mm16t<32>(MRB + mt8 * 16 * CS32, CS32, UT + nt8 * 16 * CS32, CS32, y, lane);
            store_bf4(c.YRAW + ((size_t)b * SEQ + ck * 32 + mt8 * 16 + l15) * 512 + h * 64 + nt8 * 16 + 4 * qd, y);
#pragma unroll
            for (int j = 0; j < 2; ++j) {
                const int kt = skt0 + j;
                f32x4 s = mm16t<32>(UT + svt * 16 * CS32, CS32, BHT + kt * 16 * CS32, CS32, Sreg[j], lane);
                const f32x4 gc = *(const f32x4*)(GC + kt * 16 + 4 * qd);
                s = s * gc;
                Sreg[j] = s;
                store_bf4(S0n + (svt * 16 + l15) * CS64 + kt * 16 + 4 * qd, s);
            }
        }
        LDS_BARRIER();
    }
    __syncthreads();
}
DI void phase_rwkv_post(const Ctx& c, unsigned char* lds) {
    const int tid = TID(), lane = tid & 63, wave = tid >> 6;
    const size_t PL = (size_t)NT * 512;
    for (int t = blockIdx.x * 8 + wave; t < NT; t += gridDim.x * 8) {
        bf16_t ry[8], rv[8], rg[8]; float bon[8], gw[8], gb[8];
#pragma unroll
        for (int h = 0; h < 8; ++h) { const size_t o = (size_t)t * 512 + h * 64 + lane; ry[h] = c.YRAW[o]; rv[h] = c.F[o + 2 * PL]; rg[h] = c.F[o + 5 * PL]; bon[h] = c.BON[((size_t)t * 8 + h) * 4 + 3];
            gw[h] = c.in(I_GNW)[c.l * 512 + h * 64 + lane]; gb[h] = c.in(I_GNB)[c.l * 512 + h * 64 + lane]; }
#pragma unroll
        for (int h = 0; h < 8; ++h) {
            const float y = bf2f(ry[h]);
            const float mean = wave_sum_dpp(y) * (1.0f / 64.0f);
            const float d = y - mean;
            const float var = wave_sum_dpp(d * d) * (1.0f / 64.0f);
            const float yn = d * rsqrtf(var + 64e-5f) * gw[h] + gb[h];
            c.F[(size_t)t * 512 + h * 64 + lane + 5 * PL] = f2bf((yn + bon[h] * bf2f(rv[h])) * bf2f(rg[h]));
        }
    }
    for (int it = blockIdx.x * 4; it < 768 + 128 + 128 + 256 + 256; it += gridDim.x * 4) {
        const float* WB = c.in(I_WBR) + (size_t)c.l * 2048 * DM; bf16_t* BR = (bf16_t*)(c.ws + WS_WT_BR);
        if (it < 768) convert_tile4(c.in(I_WMG) + (size_t)c.l * DM * 3 * DM, 3 * DM, 3 * DM, DM, (bf16_t*)(c.ws + WS_WT_MG), it, lds);
        else if (it < 896) convert_tile4(WB, DM, DM, 512, BR, it - 768, lds);
        else if (it < 1024) convert_tile4(WB + (size_t)512 * DM, DM, DM, 512, BR + (size_t)1024 * 512, it - 896, lds);
        else if (it < 1280) convert_tile4(WB + (size_t)1024 * DM, DM, DM, 1024, BR + (size_t)2048 * 512, it - 1024, lds);
        else convert_tile4(c.in(I_WOUT) + (size_t)c.l * DM * DM, DM, DM, DM, (bf16_t*)(c.ws + WS_WT_OUT), it - 1280, lds);
    }
}
constexpr int TS = 72;
constexpr int NSA_BIAS = 0;
constexpr int NSA_SELM = 2112;
constexpr int NSA_SCR = 2624;
constexpr int NSA_K0 = 4672;
constexpr int NSA_V0 = NSA_K0 + 2 * 64 * TS * 2;
constexpr int NSA_A = NSA_V0 + 2 * 64 * TS * 2;
constexpr int NSA_B = NSA_A + 16384;
constexpr int NSA_END = NSA_B + 16384;
static_assert(NSA_END <= LDS_BYTES - 16, "nsa lds");
static_assert(NSA_K0 % 16 == 0, "align");

struct NsaLane { int tq[2]; int h; float cbias; float m[2], l[2]; };

DI void nsa_prefetch(u32x4& rk, u32x4& rv, const bf16_t* kbase, int kstride, const bf16_t* vtbase, int vstride, int pos0, int tid) {
    const int r = tid >> 3, seg = (tid & 7) * 8;
    rk = *(const u32x4*)(kbase + (size_t)(pos0 + r) * kstride + seg);
    rv = *(const u32x4*)(vtbase + (size_t)r * vstride + pos0 + seg);
}
DI void nsa_store(unsigned char* lds, int buf, const u32x4& rk, const u32x4& rv, int tid) {
    const int r = tid >> 3, seg = (tid & 7) * 8;
    *(u32x4*)((bf16_t*)(lds + NSA_K0) + buf * 64 * TS + r * TS + seg) = rk;
    *(u32x4*)((bf16_t*)(lds + NSA_V0) + buf * 64 * TS + r * TS + seg) = rv;
}
template <int QM = 3>
DI void nsa_qk(f32x4 (&s)[2][4], const bf16_t* sK, const bf16x8 (&qf)[2][2], int lane) {
#pragma unroll
    for (int kt = 0; kt < 4; ++kt) {
#pragma unroll
        for (int ks = 0; ks < 2; ++ks) {
            const bf16x8 kf = *(const bf16x8*)(sK + (16 * kt + (lane & 15)) * TS + 32 * ks + (lane >> 4) * 8);
#pragma unroll
            for (int qi = 0; qi < 2; ++qi) if ((QM >> qi) & 1) s[qi][kt] = __builtin_amdgcn_mfma_f32_16x16x32_bf16(kf, qf[qi][ks], (ks == 0) ? (f32x4){0.f, 0.f, 0.f, 0.f} : s[qi][kt], 0, 0, 0);
        }
    }
}
template <int MODE>
DI void nsa_logits(float (&x)[4][4], const f32x4 (&s)[4], int tq, int h, float cbias, bool rowsel, int pos0, int qd, const float* biasT) {
#pragma unroll
    for (int kt = 0; kt < 4; ++kt)
#pragma unroll
        for (int i = 0; i < 4; ++i) {
            const int kk = pos0 + 16 * kt + 4 * qd + i;
            if (MODE == 1) { x[kt][i] = rowsel ? s[kt][i] + cbias : -INFINITY; }
            else {
                const int dist = (MODE == 0) ? (tq - 16 * kk - 31) : (tq - kk);
                bool ok = dist >= 0;
                if (MODE == 2) ok = ok && rowsel;
                if (MODE == 3) ok = ok && (dist < 512);
                const int di = dist < 0 ? 0 : (dist > 128 ? 128 : dist);
                float bias = biasT[di * 4 + h];
                asm volatile("" : "+v"(bias));
                x[kt][i] = ok ? s[kt][i] + bias : -INFINITY;
            }
        }
}
DI float quad16_max(float v) { v = fmaxf(v, __shfl_xor(v, 16)); v = fmaxf(v, __shfl_xor(v, 32)); return v; }
DI float quad16_sum(float v) { v += __shfl_xor(v, 16); v += __shfl_xor(v, 32); return v; }
DI void nsa_softmax(const float (&x)[4][4], float& m, float& l, f32x4 (&O)[4], bf16x8 (&pf)[2]) {
    float mx = -INFINITY;
#pragma unroll
    for (int kt = 0; kt < 4; ++kt)
#pragma unroll
        for (int i = 0; i < 4; ++i) mx = fmaxf(mx, x[kt][i]);
    mx = quad16_max(mx);
    const float mn = fmaxf(m, mx);
    const float mu = (mn == -INFINITY) ? 0.f : mn;
    const float mu2 = mu * 1.4426950408889634f;
    const float sc = __builtin_amdgcn_exp2f(__builtin_fmaf(m, 1.4426950408889634f, -mu2));
    float p[4][4]; float ps = 0.f;
#pragma unroll
    for (int kt = 0; kt < 4; ++kt)
#pragma unroll
        for (int i = 0; i < 4; ++i) { p[kt][i] = __builtin_amdgcn_exp2f(__builtin_fmaf(x[kt][i], 1.4426950408889634f, -mu2)); ps += p[kt][i]; }
    l = l * sc + ps; m = mn;
#pragma unroll
    for (int dt = 0; dt < 4; ++dt) O[dt] = O[dt] * sc;
#pragma unroll
    for (int ks = 0; ks < 2; ++ks) {
        u32x4 w; w.x = pack2(p[2 * ks][0], p[2 * ks][1]); w.y = pack2(p[2 * ks][2], p[2 * ks][3]); w.z = pack2(p[2 * ks + 1][0], p[2 * ks + 1][1]); w.w = pack2(p[2 * ks + 1][2], p[2 * ks + 1][3]);
        pf[ks] = __builtin_bit_cast(bf16x8, w);
    }
}
template <int QM = 3>
DI void nsa_pv(f32x4 (&O)[2][4], const bf16_t* sV, const bf16x8 (&pf)[2][2], int lane) {
    const int qd = lane >> 4;
#pragma unroll
    for (int dt = 0; dt < 4; ++dt)
#pragma unroll
        for (int ks = 0; ks < 2; ++ks) {
            const bf16_t* vp = sV + (16 * dt + (lane & 15)) * TS + 32 * ks + 4 * qd;
            const u32x2 a = *(const u32x2*)vp, b = *(const u32x2*)(vp + 16);
            u32x4 w; w.x = a.x; w.y = a.y; w.z = b.x; w.w = b.y;
            const bf16x8 vf = __builtin_bit_cast(bf16x8, w);
#pragma unroll
            for (int qi = 0; qi < 2; ++qi) if ((QM >> qi) & 1) O[qi][dt] = __builtin_amdgcn_mfma_f32_16x16x32_bf16(vf, pf[qi][ks], O[qi][dt], 0, 0, 0);
        }
}
template <int MODE, int QM = 3>
DI void nsa_tile(f32x4 (&O)[2][4], NsaLane& L, const bf16x8 (&qf)[2][2], const unsigned char* lds, int buf, int pos0, bool sel0, bool sel1, int lane) {
    const bf16_t* sK = (const bf16_t*)(lds + NSA_K0) + buf * 64 * TS;
    const bf16_t* sV = (const bf16_t*)(lds + NSA_V0) + buf * 64 * TS;
    const float* biasT = (const float*)(lds + NSA_BIAS);
    f32x4 s[2][4];
    nsa_qk<QM>(s, sK, qf, lane);
    bf16x8 pf[2][2];
#pragma unroll
    for (int qi = 0; qi < 2; ++qi) if ((QM >> qi) & 1) {
        float x[4][4];
        nsa_logits<MODE>(x, s[qi], L.tq[qi], L.h, L.cbias, qi ? sel1 : sel0, pos0, lane >> 4, biasT);
        nsa_softmax(x, L.m[qi], L.l[qi], O[qi], pf[qi]);
    }
    nsa_pv<QM>(O, sV, pf, lane);
}
template <int MODE>
DI void nsa_tile_sel(f32x4 (&O)[2][4], NsaLane& L, const bf16x8 (&qf)[2][2], const unsigned char* lds, int buf, int pos0, bool sel0, bool sel1, int lane) {
    const bool a0 = __ballot(sel0) != 0ull, a1 = __ballot(sel1) != 0ull;
    if (a0 && a1) nsa_tile<MODE, 3>(O, L, qf, lds, buf, pos0, sel0, sel1, lane);
    else if (a0) nsa_tile<MODE, 1>(O, L, qf, lds, buf, pos0, sel0, sel1, lane);
    else if (a1) nsa_tile<MODE, 2>(O, L, qf, lds, buf, pos0, sel0, sel1, lane);
}
DI void nsa_flush(f32x4 (&Y)[2][4], f32x4 (&O)[2][4], NsaLane& L, const float (&gate)[2]) {
#pragma unroll
    for (int qi = 0; qi < 2; ++qi) {
        const float lt = quad16_sum(L.l[qi]);
        const float f = (lt > 0.f) ? gate[qi] * __builtin_amdgcn_rcpf(lt) : 0.f;
#pragma unroll
        for (int dt = 0; dt < 4; ++dt) { Y[qi][dt] += O[qi][dt] * f; O[qi][dt] = (f32x4){0.f, 0.f, 0.f, 0.f}; }
    }
}
DI void nsa_item(const Ctx& c, int item, unsigned char* lds) {
    const int tid = TID(), lane = tid & 63, wave = tid >> 6, qd = lane >> 4;
    const int b = item >> 8, g = (item >> 6) & 3, qt = item & 63, t0 = qt * 64, cur = qt, bg = b * 4 + g;
    float* biasT = (float*)(lds + NSA_BIAS);
    unsigned long long* selm = (unsigned long long*)(lds + NSA_SELM);
    float* scr = (float*)(lds + NSA_SCR) + wave * 64;
    float* impA = (float*)(lds + NSA_A); float* impB = (float*)(lds + NSA_B);
    __syncthreads();
    for (int i = tid; i < 129 * 4; i += NTHREADS) { const int d = i >> 2, h = i & 3; biasT[i] = c.in(I_RELB)[t5_bucket(d) * 16 + g * 4 + h]; }
    for (int i = tid; i < 2 * 4096; i += NTHREADS) impA[i] = 0.f;
    NsaLane L; L.h = lane & 3;
    bf16x8 qf[2][2]; float gates[2][3];
    const bf16_t* pbat = c.PROJ + (size_t)b * SEQ * IN_COLS;
#pragma unroll
    for (int qi = 0; qi < 2; ++qi) {
        const int tl = 8 * wave + 4 * qi + ((lane & 15) >> 2);
        L.tq[qi] = t0 + tl;
        const bf16_t* prow = pbat + (size_t)L.tq[qi] * IN_COLS;
#pragma unroll
        for (int ks = 0; ks < 2; ++ks) {
            u32x4 w = *(const u32x4*)(prow + C_Q + (g * 4 + L.h) * 64 + 32 * ks + qd * 8);
            w.x = pack2(bflo(w.x) * 0.125f, bfhi(w.x) * 0.125f); w.y = pack2(bflo(w.y) * 0.125f, bfhi(w.y) * 0.125f);
            w.z = pack2(bflo(w.z) * 0.125f, bfhi(w.z) * 0.125f); w.w = pack2(bflo(w.w) * 0.125f, bfhi(w.w) * 0.125f);
            qf[qi][ks] = __builtin_bit_cast(bf16x8, w);
        }
#pragma unroll
        for (int br = 0; br < 3; ++br) gates[qi][br] = sigmoidf_(bf2f(prow[C_GATE + g * 12 + L.h * 3 + br]));
    }
    __syncthreads();
    L.cbias = biasT[128 * 4 + L.h];
    f32x4 O[2][4], Y[2][4];
#pragma unroll
    for (int qi = 0; qi < 2; ++qi)
#pragma unroll
        for (int dt = 0; dt < 4; ++dt) { O[qi][dt] = (f32x4){0.f, 0.f, 0.f, 0.f}; Y[qi][dt] = (f32x4){0.f, 0.f, 0.f, 0.f}; }
    u32x4 rk, rv;
    const int nvis_max = (t0 + 63 >= 31) ? ((t0 + 63 - 31) >> 4) + 1 : 0;
    const int ncb = (nvis_max + 63) >> 6;
    const bf16_t* kcb = c.KC + (size_t)bg * 256 * 64; const bf16_t* vcb = c.VCT + (size_t)bg * 64 * 256;
    L.m[0] = L.m[1] = -INFINITY; L.l[0] = L.l[1] = 0.f;
    if (ncb > 0) nsa_prefetch(rk, rv, kcb, 64, vcb, 256, 0, tid);
    for (int cb = 0; cb < ncb; ++cb) {
        nsa_store(lds, cb & 1, rk, rv, tid);
        __syncthreads();
        if (cb + 1 < ncb) nsa_prefetch(rk, rv, kcb, 64, vcb, 256, (cb + 1) * 64, tid);
        if (16 * (cb * 64 + 63) + 31 + 128 <= t0) nsa_tile<1>(O, L, qf, lds, cb & 1, cb * 64, true, true, lane);
        else nsa_tile<0>(O, L, qf, lds, cb & 1, cb * 64, true, true, lane);
    }
    if (ncb > 0) nsa_prefetch(rk, rv, kcb, 64, vcb, 256, 0, tid);
    float mfin[2], linv[2];
#pragma unroll
    for (int qi = 0; qi < 2; ++qi) { mfin[qi] = L.m[qi]; const float lt = quad16_sum(L.l[qi]); linv[qi] = (lt > 0.f) ? __builtin_amdgcn_rcpf(lt) : 0.f; }
    { const float gg[2] = {gates[0][0], gates[1][0]}; nsa_flush(Y, O, L, gg); }
    __syncthreads();
    for (int cb = 0; cb < ncb; ++cb) {
        nsa_store(lds, cb & 1, rk, rv, tid);
        __syncthreads();
        if (cb + 1 < ncb) nsa_prefetch(rk, rv, kcb, 64, vcb, 256, (cb + 1) * 64, tid);
        const bf16_t* sK = (const bf16_t*)(lds + NSA_K0) + (cb & 1) * 64 * TS;
        f32x4 s[2][4];
        nsa_qk(s, sK, qf, lane);
#pragma unroll
        for (int qi = 0; qi < 2; ++qi) {
            float x[4][4];
            nsa_logits<0>(x, s[qi], L.tq[qi], L.h, L.cbias, true, cb * 64, qd, biasT);
            const float mu = (mfin[qi] == -INFINITY) ? 0.f : mfin[qi];
#pragma unroll
            for (int kt = 0; kt < 4; ++kt) {
                float p3 = __expf(x[kt][3] - mu) * linv[qi];
                float pa = (__expf(x[kt][0] - mu) + __expf(x[kt][1] - mu) + __expf(x[kt][2] - mu)) * linv[qi] + p3;
                pa += __shfl_xor(pa, 1); p3 += __shfl_xor(p3, 1);
                pa += __shfl_xor(pa, 2); p3 += __shfl_xor(p3, 2);
                if (L.h == 0) { const int tl = 8 * wave + 4 * qi + ((lane & 15) >> 2), mi = 16 * cb + 4 * kt + qd; impA[tl * 64 + mi] = pa; impB[tl * 64 + mi] = p3; }
            }
        }
    }
    const bf16_t* ksb = pbat + C_KS + g * 64; const bf16_t* vsb = c.VT + ((size_t)0 * 16 + bg) * 64 * SEQ;
    nsa_prefetch(rk, rv, ksb, IN_COLS, vsb, SEQ, 0, tid);
    __syncthreads();
    for (int tl8 = 0; tl8 < 8; ++tl8) {
        const int tl = 8 * wave + tl8, n = lane;
        const bool cand = (n >= 1) && (n <= cur - 2);
        const float imp = cand ? impA[tl * 64 + n] + impB[tl * 64 + n - 1] : -1.0f;
        LDS_WAVE_SYNC();
        scr[n] = imp;
        LDS_WAVE_SYNC();
        int rank = 0;
#pragma unroll 4
        for (int q4 = 0; q4 < 16; ++q4) {
            const f32x4 o = *(const f32x4*)(scr + q4 * 4);
#pragma unroll
            for (int j = 0; j < 4; ++j) { const int n2 = q4 * 4 + j; rank += (o[j] > imp || (o[j] == imp && n2 < n)) ? 1 : 0; }
        }
        const bool forced = (n <= cur) && (n == 0 || n == cur || n == cur - 1);
        const unsigned long long msk = __ballot((cand && rank < 5) || forced);
        if (lane == 0) selm[tl] = msk;
    }
    __syncthreads();
    unsigned long long uni = selm[lane];
#pragma unroll
    for (int o = 32; o >= 1; o >>= 1) { const unsigned lo_ = __shfl_xor((unsigned)uni, o), hi_ = __shfl_xor((unsigned)(uni >> 32), o); uni |= ((unsigned long long)hi_ << 32) | lo_; }
    uni = ((unsigned long long)__builtin_amdgcn_readfirstlane((unsigned)(uni >> 32)) << 32) | (unsigned)__builtin_amdgcn_readfirstlane((unsigned)uni);
    unsigned long long sm[2];
#pragma unroll
    for (int qi = 0; qi < 2; ++qi) sm[qi] = selm[8 * wave + 4 * qi + ((lane & 15) >> 2)];
    L.m[0] = L.m[1] = -INFINITY; L.l[0] = L.l[1] = 0.f;
    {
        unsigned long long rem = uni; int it = 0;
        int j = (int)__builtin_ctzll(rem); rem &= rem - 1;
        for (;;) {
            nsa_store(lds, it & 1, rk, rv, tid);
            __syncthreads();
            const int jn = rem ? (int)__builtin_ctzll(rem) : -1;
            if (jn >= 0) { rem &= rem - 1; nsa_prefetch(rk, rv, ksb, IN_COLS, vsb, SEQ, jn * 64, tid); }
            const bool s0 = (sm[0] >> j) & 1ull, s1 = (sm[1] >> j) & 1ull;
            if (j <= cur - 3) nsa_tile_sel<1>(O, L, qf, lds, it & 1, j * 64, s0, s1, lane);
            else nsa_tile_sel<2>(O, L, qf, lds, it & 1, j * 64, s0, s1, lane);
            if (jn < 0) break;
            j = jn; ++it;
        }
    }
    const bf16_t* kwb = pbat + C_KW + g * 64; const bf16_t* vwb = c.VT + ((size_t)1 * 16 + bg) * 64 * SEQ;
    const int j0 = (cur - 8 > 0) ? cur - 8 : 0;
    nsa_prefetch(rk, rv, kwb, IN_COLS, vwb, SEQ, j0 * 64, tid);
    { const float gg[2] = {gates[0][1], gates[1][1]}; nsa_flush(Y, O, L, gg); }
    L.m[0] = L.m[1] = -INFINITY; L.l[0] = L.l[1] = 0.f;
    {
        __syncthreads();
        for (int j = j0; j <= cur; ++j) {
            nsa_store(lds, (j - j0) & 1, rk, rv, tid);
            __syncthreads();
            if (j + 1 <= cur) nsa_prefetch(rk, rv, kwb, IN_COLS, vwb, SEQ, (j + 1) * 64, tid);
            if (cur - j >= 3 && cur - j <= 7) nsa_tile<1>(O, L, qf, lds, (j - j0) & 1, j * 64, true, true, lane);
            else nsa_tile<3>(O, L, qf, lds, (j - j0) & 1, j * 64, true, true, lane);
        }
    }
    { const float gg[2] = {gates[0][2], gates[1][2]}; nsa_flush(Y, O, L, gg); }
#pragma unroll
    for (int qi = 0; qi < 2; ++qi) {
        bf16_t* yrow = c.PROJ + ((size_t)b * SEQ + L.tq[qi]) * IN_COLS + C_Q + (g * 4 + L.h) * 64;
#pragma unroll
        for (int dt = 0; dt < 4; ++dt) store_bf4(yrow + 16 * dt + 4 * qd, Y[qi][dt]);
    }
}
DI void phase_mix(const Ctx& c, unsigned char* lds) {
    const int G = gridDim.x, bid = blockIdx.x;
    const int n_nsa = NB * 4 * (SEQ / 64), n_scan = NB * 8;
    for (int item = bid; item < n_scan; item += G) scan_chunked_item(c, item, lds);
    unsigned* ctr = c.ctl + CW_Q + c.l;
    volatile int* sitem = (volatile int*)(lds + LDS_BYTES - 32);
    for (;;) {
        __syncthreads();
        if (TID() == 0) *sitem = (int)atomicAdd(ctr, 1u);
        __syncthreads();
        const int k = *sitem;
        if (k >= n_nsa) break;
        const int qt = 63 - (k >> 4), bgi = k & 15;
        nsa_item(c, (bgi << 6) | qt, lds);
    }
}

DI void phase_merge(const Ctx& c, unsigned char* lds) {
    const int nN = DM / 256;
    const bf16_t* WM = (const bf16_t*)(c.ws + WS_WT_MG);
    const bf16_t* BR = (const bf16_t*)(c.ws + WS_WT_BR);
    const float* BM_ = c.in(I_BMG) + (size_t)c.l * 3 * DM;
    bf16_t* TMP = c.F + (size_t)2 * NT * 512 + (size_t)blockIdx.x * 256 * 256;
    for (int it = 0;; ++it) {
        int tm, tn; if (!xcd_unit(it, nN, tm, tn)) break;
        const int m0 = tm * 256, n0 = tn * 256;
#pragma unroll 1
        for (int i = 0; i < 3; ++i) {
            f32x4 acc[8][4];
#pragma unroll
            for (int a_ = 0; a_ < 8; ++a_)
#pragma unroll
                for (int b_ = 0; b_ < 4; ++b_) acc[a_][b_] = (f32x4){0.f, 0.f, 0.f, 0.f};
            gemm256_dma(acc, c.H + (size_t)m0 * DM, DM, WM + (size_t)(i * DM + n0) * DM, DM, DM, lds);
            tile256_store_bf16(acc, TMP, 256, 256, lds);
#pragma unroll
            for (int a_ = 0; a_ < 8; ++a_)
#pragma unroll
                for (int b_ = 0; b_ < 4; ++b_) acc[a_][b_] = (f32x4){0.f, 0.f, 0.f, 0.f};
            {
                const bf16_t* Ab = (i == 0) ? c.POOLED + (size_t)m0 * 512 : ((i == 1) ? c.F + (size_t)5 * NT * 512 + (size_t)m0 * 512 : c.PROJ + C_Q + (size_t)m0 * IN_COLS);
                const size_t la = (i == 2) ? (size_t)IN_COLS : (size_t)512;
                const int Kb = (i == 2) ? 1024 : 512;
                gemm256_dma(acc, Ab, la, BR + (size_t)i * 1024 * 512 + (size_t)n0 * Kb, (size_t)Kb, Kb, lds);
            }
            const int lane = TID() & 63, wave = TID() >> 6, wm = wave >> 2, wn = wave & 3;
            const float* bias = BM_ + i * DM + n0 + wn * 64 + (lane >> 4) * 4;
#pragma unroll
            for (int mi = 0; mi < 8; ++mi) {
#pragma unroll
                for (int ni = 0; ni < 4; ++ni) {
                    const int r = wm * 128 + mi * 16 + (lane & 15), cc = wn * 64 + ni * 16 + (lane >> 4) * 4;
                    bf16_t* q = c.MERGED + (size_t)(m0 + r) * DM + n0 + cc;
                    const u32x2 gv = *(const u32x2*)(TMP + r * 256 + cc);
                    const f32x4 bb = *(const f32x4*)(bias + ni * 16);
                    f32x4 m4 = (f32x4){0.f, 0.f, 0.f, 0.f};
                    if (i > 0) { const u32x2 pv = *(const u32x2*)q; m4 = (f32x4){bflo(pv.x), bfhi(pv.x), bflo(pv.y), bfhi(pv.y)}; }
                    m4[0] += sigmoidf_(bflo(gv.x) + bb[0]) * acc[mi][ni][0]; m4[1] += sigmoidf_(bfhi(gv.x) + bb[1]) * acc[mi][ni][1];
                    m4[2] += sigmoidf_(bflo(gv.y) + bb[2]) * acc[mi][ni][2]; m4[3] += sigmoidf_(bfhi(gv.y) + bb[3]) * acc[mi][ni][3];
                    store_bf4(q, m4);
                }
                asm volatile("" ::: "memory"); __builtin_amdgcn_sched_barrier(0);
            }
        }
    }
}

DI void phase_outp(const Ctx& c, unsigned char* lds) {
    const int nN = DM / 256;
    const bf16_t* W = (const bf16_t*)(c.ws + WS_WT_OUT);
    const float* xin = (c.l == 0) ? c.in(I_X) : c.out;
    for (int it = 0;; ++it) {
        int tm, tn; if (!xcd_unit(it, nN, tm, tn)) break;
        const int m0 = tm * 256, n0 = tn * 256;
        f32x4 acc[8][4];
#pragma unroll
        for (int i = 0; i < 8; ++i)
#pragma unroll
            for (int j = 0; j < 4; ++j) acc[i][j] = (f32x4){0.f, 0.f, 0.f, 0.f};
        gemm256_dma(acc, c.MERGED + (size_t)m0 * DM, DM, W + (size_t)n0 * DM, DM, DM, lds);
        const int lane = TID() & 63, wave = TID() >> 6, wm = wave >> 2, wn = wave & 3;
#pragma unroll
        for (int mi = 0; mi < 8; ++mi)
#pragma unroll
            for (int ni = 0; ni < 4; ++ni) {
                const size_t o = (size_t)(m0 + wm * 128 + mi * 16 + (lane & 15)) * DM + n0 + wn * 64 + ni * 16 + (lane >> 4) * 4;
                const f32x4 x = *(const f32x4*)(xin + o); *(f32x4*)(c.out + o) = x + acc[mi][ni];
            }
    }
    for (int it = blockIdx.x * 4; it < 3 * 32 * 64; it += gridDim.x * 4) {
        const int mat = it / 2048, e = (it >> 6) & 31, tl = it & 63;
        if (mat == 0) convert_tile4(c.in(I_EG) + ((size_t)c.l * 32 + e) * DM * 256, 256, 256, DM, (bf16_t*)(c.ws + WS_EG) + (size_t)e * 256 * DM, tl, lds);
        else if (mat == 1) convert_tile4(c.in(I_EU) + ((size_t)c.l * 32 + e) * DM * 256, 256, 256, DM, (bf16_t*)(c.ws + WS_EU) + (size_t)e * 256 * DM, tl, lds);
        else convert_tile4(c.in(I_ED) + ((size_t)c.l * 32 + e) * 256 * DM, DM, DM, 256, (bf16_t*)(c.ws + WS_ED) + (size_t)e * DM * 256, tl, lds);
    }
}

DI void phase_norm2(const Ctx& c, unsigned char* lds) {
    const int tid = TID(), lane = tid & 63, wave = tid >> 6;
    const float* gain = c.in(I_NFFN) + c.l * DM;
    const float* wrg = c.in(I_WRG) + (size_t)c.l * DM * 4; const float* brg = c.in(I_BRG) + c.l * 4;
    const float* wre = c.in(I_WRE) + (size_t)c.l * DM * 32; const float* bre = c.in(I_BRE) + c.l * 32;
    unsigned* cnt = c.ctl + CW_CNT + c.l * 32;
    float* lg = (float*)lds + wave * 16 * 48;
    if (wave < 4)
    for (int rt = blockIdx.x * 4 + wave; rt < NT / 16; rt += gridDim.x * 4) {
        const int r0 = rt * 16;
        float my_rs = 0.f;
#pragma unroll 2
        for (int rr = 0; rr < 16; ++rr) {
            const size_t ro = (size_t)(r0 + rr) * DM;
            f32x4 v[4]; float ss = 0.f;
#pragma unroll
            for (int i = 0; i < 4; ++i) { v[i] = *(const f32x4*)(c.out + ro + i * 256 + lane * 4); ss += v[i][0] * v[i][0] + v[i][1] * v[i][1] + v[i][2] * v[i][2] + v[i][3] * v[i][3]; }
            ss = wave_sum_dpp(ss);
            const float rs = rsqrtf(ss * (1.0f / DM) + 1e-6f);
            if ((lane & 15) == rr) my_rs = rs;
#pragma unroll
            for (int i = 0; i < 4; ++i) {
                const f32x4 g = *(const f32x4*)(gain + i * 256 + lane * 4);
                store_bf4(c.H + ro + i * 256 + lane * 4, (f32x4){v[i][0] * rs * g[0], v[i][1] * rs * g[1], v[i][2] * rs * g[2], v[i][3] * rs * g[3]});
            }
        }
        f32x4 acc0 = (f32x4){0.f, 0.f, 0.f, 0.f}, acc1 = acc0, acc2 = acc0;
        const float* xr = c.out + (size_t)(r0 + (lane & 15)) * DM + 4 * (lane >> 4);
        const int cl = lane & 15;
#pragma unroll 2
        for (int kb = 0; kb < 64; ++kb) {
            const f32x4 xa = *(const f32x4*)(xr + kb * 16);
            const f32x4 ga = *(const f32x4*)(gain + kb * 16 + 4 * (lane >> 4));
            const int k0 = kb * 16 + 4 * (lane >> 4);
            float b0[4], b1[4], b2[4];
#pragma unroll
            for (int m = 0; m < 4; ++m) { b0[m] = wre[(size_t)(k0 + m) * 32 + cl]; b1[m] = wre[(size_t)(k0 + m) * 32 + 16 + cl]; b2[m] = (cl < 4) ? wrg[(size_t)(k0 + m) * 4 + cl] : 0.f; }
#pragma unroll
            for (int m = 0; m < 4; ++m) {
                const float am = xa[m] * ga[m] * my_rs;
                acc0 = __builtin_amdgcn_mfma_f32_16x16x4f32(am, b0[m], acc0, 0, 0, 0);
                acc1 = __builtin_amdgcn_mfma_f32_16x16x4f32(am, b1[m], acc1, 0, 0, 0);
                acc2 = __builtin_amdgcn_mfma_f32_16x16x4f32(am, b2[m], acc2, 0, 0, 0);
            }
        }
        LDS_WAVE_SYNC();
#pragma unroll
        for (int i = 0; i < 4; ++i) { const int row = 4 * (lane >> 4) + i; lg[row * 48 + cl] = acc0[i]; lg[row * 48 + 16 + cl] = acc1[i]; lg[row * 48 + 32 + cl] = acc2[i]; }
        LDS_WAVE_SYNC();
        if (lane < 16) {
            const float* L = lg + lane * 48;
            float lgp[4];
#pragma unroll
            for (int o = 0; o < 4; ++o) lgp[o] = L[32 + o] + brg[o];
            int grp = 0; float gm = lgp[0];
#pragma unroll
            for (int o = 1; o < 4; ++o) if (lgp[o] > gm) { gm = lgp[o]; grp = o; }
            float gs = 0.f;
#pragma unroll
            for (int o = 0; o < 4; ++o) gs += __expf(lgp[o] - gm);
            const float ptop = 1.0f / gs;
            int i0 = 0; float v0 = -INFINITY; int i1 = 0; float v1 = -INFINITY;
            for (int o = 0; o < 8; ++o) { const float le = L[grp * 8 + o] + bre[grp * 8 + o]; if (le > v0) { v1 = v0; i1 = i0; v0 = le; i0 = o; } else if (le > v1) { v1 = le; i1 = o; } }
            const float e1 = __expf(v1 - v0), inv = 1.0f / (1.0f + e1);
            int* rt_ = c.ROUTE + (size_t)(r0 + lane) * 8;
            const int ex0 = grp * 8 + i0, ex1 = grp * 8 + i1;
            const float w0_ = inv * ptop, w1_ = e1 * inv * ptop;
            const int q0 = (int)atomicAdd(cnt + ex0, 1u), q1 = (int)atomicAdd(cnt + ex1, 1u);
            rt_[0] = ex0; rt_[1] = ex1; ((float*)rt_)[2] = w0_; ((float*)rt_)[3] = w1_; rt_[4] = q0; rt_[5] = q1;
            int* e0p = c.ENT + ((size_t)ex0 * NT + q0) * 2; e0p[0] = r0 + lane; ((float*)e0p)[1] = w0_;
            int* e1p = c.ENT + ((size_t)ex1 * NT + q1) * 2; e1p[0] = r0 + lane; ((float*)e1p)[1] = w1_;
        }
    }
}
DI void moe_tables(const Ctx& c, int* soff, int* stile, int ncol) {
    const unsigned* cnt = c.ctl + CW_CNT + c.l * 32;
    __syncthreads();
    if (TID() == 0) { int s = 0, tt = 0; for (int e = 0; e < 32; ++e) { soff[e] = s; stile[e] = tt; s += (int)cnt[e]; tt += (((int)cnt[e] + 255) >> 8) * ncol; } soff[32] = s; stile[32] = tt; }
    __syncthreads();
}
DI void phase_moe_up(const Ctx& c, unsigned char* lds) {
    int* soff = (int*)(lds + LDS_BYTES - 1024); int* stile = soff + 64;
    moe_tables(c, soff, stile, 1);
    const int total = stile[32];
    const int lane = TID() & 63, wave = TID() >> 6, wm = wave >> 2, wn = wave & 3;
    for (int item = blockIdx.x; item < total; item += gridDim.x) {
        int e = 0;
        for (int q = 1; q < 32; ++q) if (stile[q] <= item) e = q;
        const int tm = item - stile[e];
        const int p0 = soff[e] + tm * 256, pend = soff[e + 1];
        GatherRows gr; gr.ent = c.ENT + ((size_t)e * NT + (p0 - soff[e])) * 2; gr.n = pend - p0;
        f32x4 acc[8][4];
#pragma unroll
        for (int a_ = 0; a_ < 8; ++a_)
#pragma unroll
            for (int b_ = 0; b_ < 4; ++b_) acc[a_][b_] = (f32x4){0.f, 0.f, 0.f, 0.f};
        gemm256_dma(acc, c.H, DM, (const bf16_t*)(c.ws + WS_EG) + (size_t)e * 256 * DM, DM, DM, lds, &gr);
#pragma unroll
        for (int mi = 0; mi < 8; ++mi)
#pragma unroll
            for (int ni = 0; ni < 4; ++ni) {
                const int r = wm * 128 + mi * 16 + (lane & 15), cc = wn * 64 + ni * 16 + (lane >> 4) * 4;
                const f32x4 g4 = acc[mi][ni];
                if (p0 + r < pend) store_bf4(c.HID + (size_t)(p0 + r) * 256 + cc, (f32x4){g4[0] * sigmoidf_(g4[0]), g4[1] * sigmoidf_(g4[1]), g4[2] * sigmoidf_(g4[2]), g4[3] * sigmoidf_(g4[3])});
                acc[mi][ni] = (f32x4){0.f, 0.f, 0.f, 0.f};
            }
        gemm256_dma(acc, c.H, DM, (const bf16_t*)(c.ws + WS_EU) + (size_t)e * 256 * DM, DM, DM, lds, &gr);
#pragma unroll
        for (int mi = 0; mi < 8; ++mi) {
#pragma unroll
            for (int ni = 0; ni < 4; ++ni) {
                const int r = wm * 128 + mi * 16 + (lane & 15), cc = wn * 64 + ni * 16 + (lane >> 4) * 4;
                if (p0 + r < pend) { bf16_t* q = c.HID + (size_t)(p0 + r) * 256 + cc; const u32x2 sv = *(const u32x2*)q;
                    store_bf4(q, (f32x4){bflo(sv.x) * acc[mi][ni][0], bfhi(sv.x) * acc[mi][ni][1], bflo(sv.y) * acc[mi][ni][2], bfhi(sv.y) * acc[mi][ni][3]}); }
            }
            asm volatile("" ::: "memory"); __builtin_amdgcn_sched_barrier(0);
        }
    }
}
DI void phase_moe_down(const Ctx& c, unsigned char* lds) {
    int* soff = (int*)(lds + LDS_BYTES - 1024); int* stile = soff + 64;
    moe_tables(c, soff, stile, 4);
    const int total = stile[32];
    const int lane = TID() & 63, wave = TID() >> 6, wm = wave >> 2, wn = wave & 3;
    for (int item = blockIdx.x; item < total; item += gridDim.x) {
        int e = 0;
        for (int q = 1; q < 32; ++q) if (stile[q] <= item) e = q;
        const int loc = item - stile[e], tm = loc >> 2, tn = loc & 3, n0 = tn * 256;
        const int p0 = soff[e] + tm * 256, pend = soff[e + 1];
        f32x4 acc[8][4];
#pragma unroll
        for (int a_ = 0; a_ < 8; ++a_)
#pragma unroll
            for (int b_ = 0; b_ < 4; ++b_) acc[a_][b_] = (f32x4){0.f, 0.f, 0.f, 0.f};
        gemm256_dma(acc, c.HID + (size_t)p0 * 256, 256, (const bf16_t*)(c.ws + WS_ED) + ((size_t)e * DM + n0) * 256, 256, 256, lds);
        const float* wl = (const float*)c.ENT + ((size_t)e * NT + (p0 - soff[e])) * 2 + 1;
#pragma unroll
        for (int mi = 0; mi < 8; ++mi)
#pragma unroll
            for (int ni = 0; ni < 4; ++ni) {
                const int r = wm * 128 + mi * 16 + (lane & 15), cc = wn * 64 + ni * 16 + (lane >> 4) * 4;
                if (p0 + r < pend) { const float w = wl[2 * r];
                    store_bf4(c.Y + (size_t)(p0 + r) * DM + n0 + cc, (f32x4){acc[mi][ni][0] * w, acc[mi][ni][1] * w, acc[mi][ni][2] * w, acc[mi][ni][3] * w}); }
            }
    }
}
DI void phase_final(const Ctx& c, unsigned char* lds) {
    const int tid = TID(), lane = tid & 63, wave = tid >> 6;
    const float* gain = c.in(I_NFIN);
    int* soff = (int*)(lds + 65536);
    moe_offsets(c, DEPTH - 1, soff);
    for (int row = blockIdx.x * 8 + wave; row < NT; row += gridDim.x * 8) {
        f32x4 v[4];
#pragma unroll
        for (int i = 0; i < 4; ++i) v[i] = *(const f32x4*)(c.out + (size_t)row * DM + i * 256 + lane * 4);
        add_moe_rows(c, row, lane, v, soff);
        float ss = 0.f;
#pragma unroll
        for (int i = 0; i < 4; ++i) ss += v[i][0] * v[i][0] + v[i][1] * v[i][1] + v[i][2] * v[i][2] + v[i][3] * v[i][3];
        ss = wave_sum_dpp(ss);
        const float rs = rsqrtf(ss * (1.0f / DM) + 1e-6f);
#pragma unroll
        for (int i = 0; i < 4; ++i) {
            const f32x4 g = *(const f32x4*)(gain + i * 256 + lane * 4);
            *(f32x4*)(c.out + (size_t)row * DM + i * 256 + lane * 4) = (f32x4){v[i][0] * rs * g[0], v[i][1] * rs * g[1], v[i][2] * rs * g[2], v[i][3] * rs * g[3]};
        }
    }
}

constexpr int PH_PER_LAYER = 11, N_PHASES = DEPTH * PH_PER_LAYER + 1;
__global__ void __launch_bounds__(NTHREADS, 2) fwd_kernel(Params P) {
    extern __shared__ __attribute__((aligned(16))) unsigned char lds[];
    const int lo = P.ph_lo, hi = P.ph_hi;
    LAS unsigned* xbw = (LAS unsigned*)(lds + LDS_BYTES - 16);
    if (threadIdx.x == 0) { xbw[0] = 0u; xbw[1] = 0u; xbw[2] = 0u; xbw[3] = 0u; }
    __syncthreads();
    Ctx c; c.P = &P; c.ws = P.ws; c.out = P.out; c.l = 0;
    c.ctl = (unsigned*)(P.ws + WS_CTL);
    c.H = (bf16_t*)(P.ws + WS_H); c.PROJ = (bf16_t*)(P.ws + WS_PROJ); c.F = (bf16_t*)(P.ws + WS_F); c.POOLED = (bf16_t*)(P.ws + WS_POOLED);
    c.MERGED = (bf16_t*)(P.ws + WS_F); c.CMPH = (bf16_t*)(P.ws + WS_CMPH); c.CMPO = (float*)(P.ws + WS_CMPO); c.POSB = (float*)(P.ws + WS_POSB);
    c.ROUTE = (int*)(P.ws + WS_ROUTE); c.ENT = (int*)(P.ws + WS_ENT); c.HID = (bf16_t*)(P.ws + WS_HID); c.Y = (bf16_t*)(P.ws + WS_Y);
    c.VT = (bf16_t*)(P.ws + WS_VT); c.KC = (bf16_t*)(P.ws + WS_KC); c.VCT = (bf16_t*)(P.ws + WS_VCT); c.YRAW = (bf16_t*)(P.ws + WS_YRAW); c.BON = (float*)(P.ws + WS_BON);
    XcdBarrier bar; bar.bar = c.ctl + CW_BAR; bar.x = 0; bar.st = (volatile LAS unsigned*)xbw;
    if (hi - lo > 1) bar = xcd_barrier_post(c.ctl + CW_BAR, (volatile LAS unsigned*)xbw);
#define IN(k) (lo <= (k) && (k) < hi)
#define SEAM(k) do { if (IN(k) && IN((k) + 1)) xcd_barrier(bar); } while (0)
#pragma unroll 1
    for (int l = 0; l < DEPTH; ++l) {
        c.l = l; const int pb = l * PH_PER_LAYER;
        if (IN(pb + 0)) phase_norm1(c, lds);
        SEAM(pb + 0);
        if (IN(pb + 1)) phase_gemm1(c, lds);
        SEAM(pb + 1);
        if (IN(pb + 2)) phase_prep(c, lds);
        SEAM(pb + 2);
        if (IN(pb + 3)) phase_poolgemm(c, lds);
        SEAM(pb + 3);
        if (IN(pb + 4)) phase_mix(c, lds);
        SEAM(pb + 4);
        if (IN(pb + 5)) phase_rwkv_post(c, lds);
        SEAM(pb + 5);
        if (IN(pb + 6)) phase_merge(c, lds);
        SEAM(pb + 6);
        if (IN(pb + 7)) phase_outp(c, lds);
        SEAM(pb + 7);
        if (IN(pb + 8)) phase_norm2(c, lds);
        SEAM(pb + 8);
        if (IN(pb + 9)) phase_moe_up(c, lds);
        SEAM(pb + 9);
        if (IN(pb + 10)) phase_moe_down(c, lds);
        SEAM(pb + 10);
    }
    if (IN(N_PHASES - 1)) phase_final(c, lds);
}

#ifndef MK_N_LAUNCHES
#define MK_N_LAUNCHES 1
#endif
extern "C" void kernel_launch(void* const* d_in, const int* in_sizes, int n_in, void* d_out, int out_size, void* d_ws, size_t ws_size, hipStream_t stream) {
    static int grid = 0;
    if (grid == 0) {
        if (n_in != N_IN || out_size != NT * DM || ws_size < WS_END) { fprintf(stderr, "kernel_launch: unexpected shapes n_in %d out %d ws %zu (need %zu)\n", n_in, out_size, ws_size, (size_t)WS_END); grid = -1; return; }
        int dev = 0, cus = 0, per_cu = 0;
        if (hipGetDevice(&dev) != hipSuccess || hipDeviceGetAttribute(&cus, hipDeviceAttributeMultiprocessorCount, dev) != hipSuccess) { grid = -1; return; }
        if (hipFuncSetAttribute((const void*)fwd_kernel, hipFuncAttributeMaxDynamicSharedMemorySize, LDS_BYTES) != hipSuccess) { fprintf(stderr, "kernel_launch: hipFuncSetAttribute failed\n"); grid = -1; return; }
        if (hipOccupancyMaxActiveBlocksPerMultiprocessor(&per_cu, (const void*)fwd_kernel, NTHREADS, LDS_BYTES) != hipSuccess || per_cu < 1) { fprintf(stderr, "kernel_launch: occupancy query says %d\n", per_cu); }
        (void)hipGetLastError();
        grid = cus;
    }
    if (grid < 0) return;
    if (hipMemsetAsync((char*)d_ws + WS_CTL, 0, CTL_BYTES, stream) != hipSuccess) return;
    Params p{};
    for (int i = 0; i < N_IN; ++i) p.in[i] = (const float*)d_in[i];
    p.out = (float*)d_out; p.ws = (unsigned char*)d_ws;
    if (MK_N_LAUNCHES == 1) {
        p.ph_lo = 0; p.ph_hi = N_PHASES;
        hipLaunchKernelGGL(fwd_kernel, dim3(grid), dim3(NTHREADS), LDS_BYTES, stream, p);
    } else {
        for (int k = 0; k < N_PHASES; ++k) { p.ph_lo = k; p.ph_hi = k + 1; hipLaunchKernelGGL(fwd_kernel, dim3(grid), dim3(NTHREADS), LDS_BYTES, stream, p); }
    }
}
```

```cpp
#include <hip/hip_runtime.h>
#include <cstdio>
#include <cstdint>

#define DI __device__ __forceinline__
typedef unsigned short bf16_t;
typedef short bf16x8 __attribute__((ext_vector_type(8)));
typedef float f32x4 __attribute__((ext_vector_type(4)));
typedef unsigned u32x4 __attribute__((ext_vector_type(4)));
typedef unsigned u32x2 __attribute__((ext_vector_type(2)));

constexpr int NB = 4, SEQ = 4096, DM = 1024, NT = NB * SEQ, DEPTH = 2;
constexpr int IN_COLS = 4816;
constexpr int C_POOL = 0, C_RW = 512, C_R = 512, C_K = 1024, C_V = 1536, C_WD = 2048, C_AD = 2080, C_GD = 2112;
constexpr int C_Q = 2208, C_KC = 3232, C_VC = 3488, C_KS = 3744, C_VS = 4000, C_KW = 4256, C_VW = 4512, C_GATE = 4768;
constexpr int RWC = 1696;
constexpr int NCMP = 255;
constexpr int NTHREADS = 512;
constexpr int LDS_BYTES = 155648;

enum { I_X = 0, I_RELB, I_NMIX, I_WIN, I_POOLW, I_POOLS, I_MU, I_W0, I_WUP, I_A0, I_AUP, I_GUP, I_KK, I_KA, I_RK, I_GNW, I_GNB,
       I_CPK, I_CW1K, I_CW2K, I_CPV, I_CW1V, I_CW2V, I_WBR, I_WMG, I_BMG, I_WOUT, I_NFFN, I_WRG, I_BRG, I_WRE, I_BRE, I_EG, I_EU, I_ED, I_NFIN, N_IN };

constexpr size_t WS_CTL = 0;
constexpr size_t CTL_BYTES = 65536;
constexpr size_t WS_H = CTL_BYTES;
constexpr size_t WS_PROJ = WS_H + (size_t)NT * DM * 2;
constexpr size_t WS_F = WS_PROJ + (size_t)NT * IN_COLS * 2;
constexpr size_t PLANE = (size_t)NT * 512 * 2;
constexpr size_t WS_POOLED = WS_F + 6 * PLANE;
constexpr size_t WS_CMPH = WS_POOLED + PLANE;
constexpr size_t WS_CMPO = WS_CMPH + (size_t)2 * 4096 * 256 * 2;
constexpr size_t WS_POSB = WS_CMPO + (size_t)2 * 4096 * 64 * 4;
constexpr size_t WS_ROUTE = WS_POSB + 4096;
constexpr size_t WS_ENT = WS_ROUTE + (size_t)NT * 32;
constexpr size_t WS_VT = WS_ENT + (size_t)32 * NT * 8;
constexpr size_t WS_KC = WS_VT + (size_t)2 * 16 * 64 * SEQ * 2;
constexpr size_t WS_VCT = WS_KC + (size_t)16 * 256 * 64 * 2;
constexpr size_t WS_YRAW = WS_VCT + (size_t)16 * 64 * 256 * 2;
constexpr size_t WS_BON = WS_YRAW + (size_t)NT * 512 * 2;
constexpr size_t WS_SMALLW = WS_BON + (size_t)NT * 8 * 16;
constexpr size_t WS_WT_LORA = WS_SMALLW + 262144;
constexpr size_t WS_END = WS_WT_LORA + (size_t)1536 * 128 * 2;
constexpr size_t WS_WT_IN = WS_F;
constexpr size_t WS_WT_C1 = WS_CMPO;
constexpr size_t WS_WT_C2 = WS_SMALLW;
constexpr size_t WS_WT_POOL = WS_SMALLW + 131072;
constexpr size_t WS_WT_MG = WS_VT;
constexpr size_t WS_WT_BR = WS_VT + (size_t)3072 * 1024 * 2;
constexpr size_t WS_WT_OUT = WS_CMPH;
constexpr size_t WS_EG = WS_F + 2 * PLANE;
constexpr size_t WS_EU = WS_EG + (size_t)32 * 256 * 1024 * 2;
constexpr size_t WS_ED = WS_EU + (size_t)32 * 256 * 1024 * 2;
static_assert(WS_ED + (size_t)32 * 1024 * 256 * 2 <= WS_F + 6 * PLANE, "expert alias");
static_assert(WS_WT_BR + (size_t)2048 * 1024 * 2 <= WS_VT + (size_t)2 * 16 * 64 * SEQ * 2, "merge alias");
static_assert((size_t)4864 * 1024 * 2 <= 6 * PLANE, "w_in alias");
constexpr size_t WS_HID = WS_PROJ;
constexpr size_t WS_Y = WS_PROJ + (size_t)2 * NT * 256 * 2;
static_assert(WS_Y + (size_t)2 * NT * 1024 * 2 <= WS_F, "alias");
constexpr int CW_BAR = 0;
constexpr int CW_CNT = 4096;
constexpr int CW_CUR = 4096 + 64;
constexpr int CW_Q = 4096 + 128;

#define XB_TMO      128
#define XB_XCNT(j)  (256  + 64 * (j))
#define XB_XSUB(j)  (1280 + 64 * (j))
#define XB_XGEN(j)  (2304 + 64 * (j))
#define XB_TOP      3328
#define XB_TOPGEN   3392
#define XCD_BAR_WORDS 3456
#define XB_SPIN_CAP (1u << 18)
#define LAS __attribute__((address_space(3)))

__device__ __forceinline__ unsigned xb_ld(unsigned* p)              { return __hip_atomic_load(p, __ATOMIC_RELAXED, __HIP_MEMORY_SCOPE_AGENT); }
__device__ __forceinline__ unsigned xb_add(unsigned* p, unsigned v) { return __hip_atomic_fetch_add(p, v, __ATOMIC_RELAXED, __HIP_MEMORY_SCOPE_AGENT); }
__device__ __forceinline__ unsigned xb_xcc_id() { return (unsigned)__builtin_amdgcn_s_getreg((3 << 11) | 20) & 0xFu; }
#define XB_SPIN(cond, bar) do { unsigned _sp = 0; while (cond) { __builtin_amdgcn_s_sleep(1); \
    if ((++_sp & 255u) == 0u) { if (xb_ld(&(bar)[XB_TMO])) break; if (_sp > XB_SPIN_CAP) { atomicAdd(&(bar)[XB_TMO], 1u); break; } } } } while (0)

struct XcdBarrier { unsigned* bar; unsigned x; volatile LAS unsigned* st; };

__device__ __forceinline__ XcdBarrier xcd_barrier_post(unsigned* bar, volatile LAS unsigned* st) {
    XcdBarrier b; b.bar = bar; b.x = xb_xcc_id(); b.st = st;
    if (threadIdx.x == 0) (void)xb_add(&bar[XB_XCNT(b.x)], 1u);
    return b;
}
__device__ __forceinline__ void xcd_barrier_complete(unsigned* bar, unsigned x, unsigned& nloc, unsigned& nx) {
    const unsigned G = gridDim.x * gridDim.y * gridDim.z;
    unsigned sum, cnt, mine, sp = 0u;
    for (;;) {
        sum = 0u; cnt = 0u; mine = 0u;
#pragma unroll
        for (unsigned j = 0; j < 16; ++j) { const unsigned c = xb_ld(&bar[XB_XCNT(j)]); sum += c; cnt += (c > 0u) ? 1u : 0u; mine = (j == x) ? c : mine; }
        if (sum == G) break;
        __builtin_amdgcn_s_sleep(1);
        if ((++sp & 255u) == 0u) { if (xb_ld(&bar[XB_TMO])) break; if (sp > XB_SPIN_CAP) { atomicAdd(&bar[XB_TMO], 1u); break; } }
    }
    nloc = mine > 0u ? mine : 1u; nx = cnt > 0u ? cnt : 1u;
}
__device__ __forceinline__ void xcd_barrier(const XcdBarrier& b) {
    asm volatile("s_waitcnt vmcnt(0)" ::: "memory");
    __syncthreads();
    if (threadIdx.x == 0) {
        unsigned* bar = b.bar;
        __builtin_amdgcn_s_waitcnt(0);
        unsigned nloc = b.st[0], nx = b.st[1];
        if (nloc == 0u) { xcd_barrier_complete(bar, b.x, nloc, nx); b.st[0] = nloc; b.st[1] = nx; }
        const unsigned old = xb_add(&bar[XB_XSUB(b.x)], 1u);
        const unsigned gen = old / nloc;
        if (old + 1u == (gen + 1u) * nloc) {
            __builtin_amdgcn_fence(__ATOMIC_RELEASE, "agent");
            asm volatile("s_waitcnt vmcnt(0)" ::: "memory");
            const unsigned og = xb_add(&bar[XB_TOP], 1u);
            const unsigned tg = og / nx;
            if (og + 1u == (tg + 1u) * nx) xb_add(&bar[XB_TOPGEN], 1u);
            else XB_SPIN(xb_ld(&bar[XB_TOPGEN]) == tg, bar);
            __builtin_amdgcn_fence(__ATOMIC_ACQUIRE, "agent");
            xb_add(&bar[XB_XGEN(b.x)], 1u);
            asm volatile("s_waitcnt vmcnt(0)" ::: "memory");
        } else {
            XB_SPIN(xb_ld(&bar[XB_XGEN(b.x)]) == gen, bar);
            __builtin_amdgcn_fence(__ATOMIC_ACQUIRE, "agent");
            asm volatile("s_waitcnt vmcnt(0)" ::: "memory");
        }
    }
    __syncthreads();
}

DI bf16_t f2bf(float x) { unsigned u = __float_as_uint(x); u += 0x7fffu + ((u >> 16) & 1u); return (bf16_t)(u >> 16); }
DI float bf2f(bf16_t b) { return __uint_as_float((unsigned)b << 16); }
typedef __bf16 bf16v2_t __attribute__((ext_vector_type(2)));
typedef float f32v2_t __attribute__((ext_vector_type(2)));
DI unsigned pack2(float lo, float hi) { const f32v2_t v = {lo, hi}; const bf16v2_t b = __builtin_convertvector(v, bf16v2_t); return __builtin_bit_cast(unsigned, b); }
DI float bflo(unsigned w) { return __uint_as_float(w << 16); }
DI float bfhi(unsigned w) { return __uint_as_float(w & 0xffff0000u); }
DI float wave_sum(float v) {
#pragma unroll
    for (int o = 32; o >= 1; o >>= 1) v += __shfl_xor(v, o);
    return v;
}
DI float wave_max(float v) {
#pragma unroll
    for (int o = 32; o >= 1; o >>= 1) v = fmaxf(v, __shfl_xor(v, o));
    return v;
}
DI float sigmoidf_(float x) { return __builtin_amdgcn_rcpf(1.0f + __expf(-x)); }
DI int TID() { int t = threadIdx.x; asm volatile("" : "+v"(t)); return t; }
#define LDS_WAVE_SYNC() asm volatile("s_waitcnt lgkmcnt(0)" ::: "memory")

#define DPP_MOV(v, ctrl) __builtin_bit_cast(float, __builtin_amdgcn_update_dpp(0, __builtin_bit_cast(int, (v)), (ctrl), 0xF, 0xF, true))
DI float wave_sum_dpp(float v) {
    v += DPP_MOV(v, 0xB1); v += DPP_MOV(v, 0x4E); v += DPP_MOV(v, 0x141); v += DPP_MOV(v, 0x140);
    return __builtin_bit_cast(float, __builtin_amdgcn_readlane(__builtin_bit_cast(int, v), 0)) + __builtin_bit_cast(float, __builtin_amdgcn_readlane(__builtin_bit_cast(int, v), 16)) +
        (__builtin_bit_cast(float, __builtin_amdgcn_readlane(__builtin_bit_cast(int, v), 32)) + __builtin_bit_cast(float, __builtin_amdgcn_readlane(__builtin_bit_cast(int, v), 48)));
}
struct Params { const float* in[N_IN]; float* out; unsigned char* ws; int ph_lo, ph_hi; };

DI int t5_bucket(int n) {
    if (n < 16) return n;
    if (n >= 128) return 31;
    int b = 16;
    b += (n >= 19) + (n >= 21) + (n >= 24) + (n >= 27) + (n >= 31) + (n >= 35) + (n >= 40) + (n >= 46) + (n >= 52) + (n >= 59) + (n >= 67) + (n >= 77) + (n >= 87) + (n >= 99) + (n >= 113);
    return b;
}

constexpr int G_A = 0, G_B = 256 * 64 * 2, G_STAGE = (256 + 128) * 64 * 2;
static_assert(2 * G_STAGE <= LDS_BYTES - 64, "gemm lds");
DI int g_off(int r, int c) { return ((r >> 4) * 2 + (c >> 5)) * 1024 + ((((r & 15) * 64) + (c & 31) * 2) ^ ((((r & 15) >> 3) & 1) << 5)); }
struct ARows { const bf16_t* p[4]; const float* mu; int ltype; int first; };
DI float tanhf_fast(float x) { const float e = __expf(2.0f * x); return 1.0f - 2.0f * __builtin_amdgcn_rcpf(e + 1.0f); }
DI u32x4 lora_chunk(const bf16_t* prow, bool first, const float* mu, int ltype, int k) {
    const int lim = (ltype == 2) ? 96 : 32;
    if (k >= lim) return (u32x4){0u, 0u, 0u, 0u};
    const int col = C_WD + ltype * 32 + k;
    const u32x4 cu = *(const u32x4*)(prow + col);
    u32x4 pu = (u32x4){0u, 0u, 0u, 0u};
    if (!first) pu = *(const u32x4*)(prow - IN_COLS + col);
    const f32x4 m0 = *(const f32x4*)(mu + col - C_RW), m1 = *(const f32x4*)(mu + col - C_RW + 4);
    float u[8] = {bflo(cu.x), bfhi(cu.x), bflo(cu.y), bfhi(cu.y), bflo(cu.z), bfhi(cu.z), bflo(cu.w), bfhi(cu.w)};
    const float p[8] = {bflo(pu.x), bfhi(pu.x), bflo(pu.y), bfhi(pu.y), bflo(pu.z), bfhi(pu.z), bflo(pu.w), bfhi(pu.w)};
    const float mm[8] = {m0[0], m0[1], m0[2], m0[3], m1[0], m1[1], m1[2], m1[3]};
#pragma unroll
    for (int j = 0; j < 8; ++j) { const float us = u[j] + (p[j] - u[j]) * mm[j]; u[j] = (ltype == 0) ? tanhf_fast(us) : ((ltype == 1) ? us : __builtin_amdgcn_rcpf(1.0f + __expf(-us))); }
    u32x4 w; w.x = pack2(u[0], u[1]); w.y = pack2(u[2], u[3]); w.z = pack2(u[4], u[5]); w.w = pack2(u[6], u[7]);
    return w;
}
template <int AMODE>
DI void g_load(u32x4 (&ra)[4], u32x4 (&rb)[2], const ARows& ar, const bf16_t* bt, int ldb, int k0, int tid) {
    const int kseg = (tid & 7) * 8;
#pragma unroll
    for (int i = 0; i < 4; ++i) {
        ra[i] = (u32x4){0u, 0u, 0u, 0u};
        if (AMODE == 2) ra[i] = lora_chunk(ar.p[i], (ar.first >> i) & 1, ar.mu, ar.ltype, k0 + kseg);
        else if (ar.p[i] != nullptr) ra[i] = *(const u32x4*)((AMODE == 0) ? (ar.p[i] + k0 + kseg) : (ar.p[i] + (size_t)(k0 >> 6) * IN_COLS + kseg));
    }
#pragma unroll
    for (int i = 0; i < 2; ++i) rb[i] = *(const u32x4*)(bt + (size_t)((tid >> 3) + 64 * i) * ldb + k0 + kseg);
}
DI void g_store(unsigned char* st, const u32x4 (&ra)[4], const u32x4 (&rb)[2], int tid) {
    const int off = g_off(tid >> 3, (tid & 7) * 8);
#pragma unroll
    for (int i = 0; i < 4; ++i) *(u32x4*)(st + G_A + off + i * 8192) = ra[i];
#pragma unroll
    for (int i = 0; i < 2; ++i) *(u32x4*)(st + G_B + off + i * 8192) = rb[i];
}
DI void g_compute(f32x4 (&acc)[4][4], const unsigned char* st, int lane, int wm, int wn) {
    const int lo = ((lane & 15) * 64 + (lane >> 4) * 16) ^ ((((lane & 15) >> 3) & 1) << 5);
    const unsigned char* sA = st + G_A + wm * 8192 + lo;
    const unsigned char* sB = st + G_B + wn * 8192 + lo;
    bf16x8 bcur[4], bnxt[4], a0, a1, a2;
#pragma unroll
    for (int i = 0; i < 4; ++i) bcur[i] = *(const bf16x8*)(sB + i * 2048);
    a0 = *(const bf16x8*)(sA);
    a1 = *(const bf16x8*)(sA + 2048);
#define G_AFRAG(s) (*(const bf16x8*)(sA + ((s) & 3) * 2048 + ((s) >> 2) * 1024))
#define G_GROUP(s, acur, anew) do { \
        if ((s) + 2 < 8) anew = G_AFRAG((s) + 2); \
        if ((s) < 4) bnxt[(s) & 3] = *(const bf16x8*)(sB + ((s) & 3) * 2048 + 1024); \
        __builtin_amdgcn_sched_barrier(0); \
        _Pragma("unroll") for (int ni = 0; ni < 4; ++ni) acc[(s) & 3][ni] = __builtin_amdgcn_mfma_f32_16x16x32_bf16(((s) < 4 ? bcur[ni] : bnxt[ni]), acur, acc[(s) & 3][ni], 0, 0, 0); \
        __builtin_amdgcn_sched_barrier(0); } while (0)
    G_GROUP(0, a0, a2); G_GROUP(1, a1, a0); G_GROUP(2, a2, a1); G_GROUP(3, a0, a2);
    G_GROUP(4, a1, a0); G_GROUP(5, a2, a1); G_GROUP(6, a0, a2); G_GROUP(7, a1, a0);
#undef G_GROUP
#undef G_AFRAG
}
#define LDS_BARRIER() do { asm volatile("s_waitcnt lgkmcnt(0)" ::: "memory"); __builtin_amdgcn_s_barrier(); asm volatile("" ::: "memory"); } while (0)
template <int AMODE>
DI void gemm_core(f32x4 (&acc)[4][4], const ARows& ar, const bf16_t* bt  , int ldb, int K, unsigned char* lds) {
    const int tid = TID(), lane = tid & 63, wave = tid >> 6, wm = wave >> 1, wn = wave & 1;
    const int nk = K >> 6;
    unsigned char* s0 = lds; unsigned char* s1 = lds + G_STAGE;
    u32x4 ra0[4], rb0[2], ra1[4], rb1[2];
    g_load<AMODE>(ra0, rb0, ar, bt, ldb, 0, tid);
    g_load<AMODE>(ra1, rb1, ar, bt, ldb, 64, tid);
    __syncthreads();
    g_store(s0, ra0, rb0, tid);
    g_load<AMODE>(ra0, rb0, ar, bt, ldb, (nk > 2 ? 2 : nk - 1) * 64, tid);
    LDS_BARRIER();
    for (int kt = 0; kt < nk; kt += 2) {
        g_store(s1, ra1, rb1, tid);
        { const int kn = (kt + 3 < nk) ? kt + 3 : nk - 1; g_load<AMODE>(ra1, rb1, ar, bt, ldb, kn * 64, tid); }
        g_compute(acc, s0, lane, wm, wn);
        LDS_BARRIER();
        g_store(s0, ra0, rb0, tid);
        { const int kn = (kt + 4 < nk) ? kt + 4 : nk - 1; g_load<AMODE>(ra0, rb0, ar, bt, ldb, kn * 64, tid); }
        g_compute(acc, s1, lane, wm, wn);
        LDS_BARRIER();
    }
}
static_assert(3 * G_STAGE <= LDS_BYTES - 64, "dma ring");
DI void gemm_core_dma(f32x4 (&acc)[4][4], const bf16_t* A, size_t lda, const bf16_t* bt, size_t ldb, int K, unsigned char* lds) {
    const int tid = TID(), lane = tid & 63, wave = __builtin_amdgcn_readfirstlane(tid >> 6), wm = wave >> 1, wn = wave & 1;
    const int nk = K >> 6;
    const int srow = lane >> 2, skof = ((lane & 3) * 8) ^ ((lane >> 5) << 4);
    const char* gp[6]; int loff[6];
#pragma unroll
    for (int j = 0; j < 6; ++j) {
        const int sid = wave * 6 + j;
        if (sid < 32) { gp[j] = (const char*)(A + (size_t)((sid >> 1) * 16 + srow) * lda + (sid & 1) * 32 + skof); loff[j] = G_A + sid * 1024; }
        else { const int s2 = sid - 32; gp[j] = (const char*)(bt + (size_t)((s2 >> 1) * 16 + srow) * ldb + (s2 & 1) * 32 + skof); loff[j] = G_B + s2 * 1024; }
    }
#define DMA_ISSUE(kt_, st_) do { const int _k = ((kt_) < nk ? (kt_) : nk - 1) * 128; \
        _Pragma("unroll") for (int j = 0; j < 6; ++j) __builtin_amdgcn_global_load_lds((const unsigned*)(gp[j] + _k), (LAS unsigned*)(lds + (st_) * G_STAGE + loff[j]), 16, 0, 0); } while (0)
    asm volatile("s_waitcnt vmcnt(0)" ::: "memory");
    __syncthreads();
    DMA_ISSUE(0, 0); DMA_ISSUE(1, 1);
    int st = 0;
    for (int kt = 0; kt < nk; ++kt) {
        asm volatile("s_waitcnt vmcnt(6)" ::: "memory");
        __builtin_amdgcn_s_barrier();
        asm volatile("" ::: "memory");
        const int sn = (st == 0) ? 2 : st - 1;
        DMA_ISSUE(kt + 2, sn);
        g_compute(acc, lds + st * G_STAGE, lane, wm, wn);
        st = (st == 2) ? 0 : st + 1;
    }
    asm volatile("s_waitcnt vmcnt(0)" ::: "memory");
    __syncthreads();
#undef DMA_ISSUE
}
DI void store_bf4(bf16_t* p, f32x4 v) { u32x2 w; w.x = pack2(v[0], v[1]); w.y = pack2(v[2], v[3]); *(u32x2*)p = w; }
#define R256(mi) ((((mi) >> 2) * 128) + wm * 64 + (((mi) & 3) * 16) + (lane & 15))
#define C256(ni) ((((ni) >> 1) * 128) + wn * 32 + (((ni) & 1) * 16) + ((lane >> 4) * 4))
constexpr int HTB = 128 * 64 * 2;
static_assert(8 * HTB <= LDS_BYTES - 1024, "gemm256 lds");
DI int lds_byte(int r, int c) { const int st = (r >> 4) * 2 + (c >> 5), rr = r & 15, cc = c & 31, ob = rr * 64 + cc * 2; return st * 1024 + (ob ^ (((ob >> 9) & 1) << 5)); }
DI void stage_rc(int b, int& R, int& C) { const int st = b / 1024, sb = b % 1024, swz = sb ^ (((sb >> 9) & 1) << 5); R = (st >> 1) * 16 + swz / 64; C = (st & 1) * 32 + (swz % 64) / 2; }
struct GatherRows { const int* ent; int n; };
DI void gemm256_dma(f32x4 (&acc)[8][4], const bf16_t* A, size_t lda, const bf16_t* bt, size_t ldb, int K, unsigned char* lds_, const GatherRows* gr = nullptr) {
    LAS unsigned char* lds = (LAS unsigned char*)lds_;
    const int tid = TID(), wid = __builtin_amdgcn_readfirstlane(tid >> 6), lane = tid & 63, wr = wid >> 2, wc = wid & 3, fr = lane & 15, fq = lane >> 4;
    const int nt = K >> 6;
    unsigned voffA[2][2], voffB[2][2];
#pragma unroll
    for (int i = 0; i < 2; ++i) { int R, C; stage_rc(tid * 16 + i * 8192, R, C);
#pragma unroll
        for (int h = 0; h < 2; ++h) { const int row = h * 128 + R;
            size_t ra = (size_t)row;
            if (gr != nullptr) ra = (size_t)((row < gr->n) ? gr->ent[2 * row] : 0);
            voffA[h][i] = (unsigned)((ra * lda + C) * 2); voffB[h][i] = (unsigned)(((size_t)row * ldb + C) * 2); } }
    const unsigned ldsw = (unsigned)wid * 1024u;
    const int aoff = lds_byte(wr * 64 + fr, fq * 8), boff = lds_byte(wc * 32 + fr, fq * 8);
#define PG8_SA(b, h) (((b) * 2 + (h)) * HTB)
#define PG8_SB(b, h) ((4 + (b) * 2 + (h)) * HTB)
#define PG8_STAGE(bufoff, gbase, voff) do { _Pragma("unroll") for (int _i = 0; _i < 2; ++_i) \
        __builtin_amdgcn_global_load_lds((const unsigned*)((const char*)(gbase) + (voff)[_i]), (LAS unsigned*)(lds + (bufoff) + ldsw + _i * 8192), 16, 0, 0); } while (0)
#define PG8_LDA(dst, b, h) do { _Pragma("unroll") for (int m = 0; m < 4; ++m) _Pragma("unroll") for (int k = 0; k < 2; ++k) dst[m][k] = *(const LAS bf16x8*)(lds + PG8_SA(b, h) + aoff + m * 2048 + k * 1024); } while (0)
#define PG8_LDB(dst, b, h) do { _Pragma("unroll") for (int n = 0; n < 2; ++n) _Pragma("unroll") for (int k = 0; k < 2; ++k) dst[n][k] = *(const LAS bf16x8*)(lds + PG8_SB(b, h) + boff + n * 2048 + k * 1024); } while (0)
#define PG8_MMA(ai, bj, At, Bt) do { __builtin_amdgcn_s_setprio(1); _Pragma("unroll") for (int m = 0; m < 4; ++m) _Pragma("unroll") for (int n = 0; n < 2; ++n) _Pragma("unroll") for (int k = 0; k < 2; ++k) \
        acc[(ai) * 4 + m][(bj) * 2 + n] = __builtin_amdgcn_mfma_f32_16x16x32_bf16(Bt[n][k], At[m][k], acc[(ai) * 4 + m][(bj) * 2 + n], 0, 0, 0); __builtin_amdgcn_s_setprio(0); } while (0)
#define PG8_WAIT_V(n) asm volatile("s_waitcnt vmcnt(" #n ")" ::: "memory")
#define PG8_WAIT_L(n) asm volatile("s_waitcnt lgkmcnt(" #n ")" ::: "memory")
#define PG8_BAR __builtin_amdgcn_s_barrier()
#define PG8_SCHED __builtin_amdgcn_sched_barrier(0)
    bf16x8 At[4][2], B0[2][2], B1[2][2];
    const char* cA = (const char*)A; const char* cB = (const char*)bt;
    const size_t kstep = 128;
    asm volatile("s_waitcnt vmcnt(0)" ::: "memory");
    __syncthreads();
    PG8_STAGE(PG8_SB(0, 0), cB, voffB[0]); PG8_STAGE(PG8_SA(0, 0), cA, voffA[0]); PG8_STAGE(PG8_SB(0, 1), cB, voffB[1]); PG8_STAGE(PG8_SA(0, 1), cA, voffA[1]);
    if (wr == 1) PG8_BAR;
    PG8_WAIT_V(4); PG8_BAR;
    PG8_STAGE(PG8_SB(1, 0), cB + kstep, voffB[0]); PG8_STAGE(PG8_SA(1, 0), cA + kstep, voffA[0]); PG8_STAGE(PG8_SB(1, 1), cB + kstep, voffB[1]);
    PG8_WAIT_V(6); PG8_BAR;
    for (int t = 0; t < nt; t += 2) {
        const bool last = (t == nt - 2);
        const char* a1 = cA + (size_t)(t + 1) * kstep;
        const char* a2 = last ? cA : cA + (size_t)(t + 2) * kstep; const char* b2 = last ? cB : cB + (size_t)(t + 2) * kstep;
        const char* a3 = a2 + kstep; const char* b3 = b2 + kstep;
        PG8_LDB(B0, 0, 0); PG8_SCHED; PG8_LDA(At, 0, 0); PG8_STAGE(PG8_SA(1, 1), a1, voffA[1]);
        PG8_WAIT_L(8); PG8_BAR; PG8_WAIT_L(0); PG8_MMA(0, 0, At, B0); PG8_BAR; PG8_SCHED;
        PG8_LDB(B1, 0, 1); PG8_STAGE(PG8_SB(0, 0), b2, voffB[0]);
        PG8_BAR; PG8_WAIT_L(0); PG8_MMA(0, 1, At, B1); PG8_BAR;
        PG8_LDA(At, 0, 1); PG8_STAGE(PG8_SA(0, 0), a2, voffA[0]);
        PG8_BAR; PG8_WAIT_L(0); PG8_MMA(1, 0, At, B0); PG8_BAR; PG8_SCHED;
        PG8_STAGE(PG8_SB(0, 1), b2, voffB[1]);
        PG8_WAIT_V(6); PG8_BAR; PG8_MMA(1, 1, At, B1); PG8_BAR;
        PG8_LDB(B0, 1, 0); PG8_SCHED; PG8_LDA(At, 1, 0); PG8_STAGE(PG8_SA(0, 1), a2, voffA[1]);
        PG8_WAIT_L(8); PG8_BAR; PG8_WAIT_L(0); PG8_MMA(0, 0, At, B0); PG8_BAR; PG8_SCHED;
        PG8_LDB(B1, 1, 1); PG8_STAGE(PG8_SB(1, 0), b3, voffB[0]);
        PG8_BAR; PG8_WAIT_L(0); PG8_MMA(0, 1, At, B1); PG8_BAR;
        PG8_LDA(At, 1, 1); PG8_STAGE(PG8_SA(1, 0), a3, voffA[0]);
        PG8_BAR; PG8_WAIT_L(0); PG8_MMA(1, 0, At, B0); PG8_BAR; PG8_SCHED;
        PG8_STAGE(PG8_SB(1, 1), b3, voffB[1]);
        PG8_WAIT_V(6); PG8_BAR; PG8_MMA(1, 1, At, B1); PG8_BAR;
    }
    PG8_WAIT_V(0);
    if (wr == 0) PG8_BAR;
    PG8_BAR;
    asm volatile("" ::: "memory");
#undef PG8_SA
#undef PG8_SB
#undef PG8_STAGE
#undef PG8_LDA
#undef PG8_LDB
#undef PG8_MMA
#undef PG8_WAIT_V
#undef PG8_WAIT_L
#undef PG8_BAR
#undef PG8_SCHED
}
DI void tile256_store_bf16(f32x4 (&acc)[8][4], bf16_t* out, size_t ld, int ncols, unsigned char* lds) {
    bf16_t* T = (bf16_t*)lds;
    const int tid = TID(), lane = tid & 63, wave = tid >> 6, wm = wave >> 2, wn = wave & 3;
    __syncthreads();
#pragma unroll
    for (int mi = 0; mi < 8; ++mi)
#pragma unroll
        for (int ni = 0; ni < 4; ++ni) store_bf4(T + R256(mi) * 264 + C256(ni), acc[mi][ni]);
    __syncthreads();
#pragma unroll
    for (int i = 0; i < 16; ++i) {
        const int ch = tid + i * NTHREADS, r = ch >> 5, cc = (ch & 31) * 8;
        if (cc < ncols) *(u32x4*)(out + (size_t)r * ld + cc) = *(const u32x4*)(T + r * 264 + cc);
    }
}
DI void acc_zero(f32x4 (&acc)[4][4]) {
#pragma unroll
    for (int i = 0; i < 4; ++i)
#pragma unroll
        for (int j = 0; j < 4; ++j) acc[i][j] = (f32x4){0.f, 0.f, 0.f, 0.f};
}
#define ACC_FOREACH(acc, body) do { const int _l = TID() & 63, _w = TID() >> 6; \
    _Pragma("unroll") for (int _mi = 0; _mi < 4; ++_mi) _Pragma("unroll") for (int _ni = 0; _ni < 4; ++_ni) { \
        const int r_ = (_w >> 1) * 64 + _mi * 16 + (_l & 15), c_ = (_w & 1) * 64 + _ni * 16 + (_l >> 4) * 4; f32x4& v_ = acc[_mi][_ni]; body } } while (0)
DI ARows plain_rows(const bf16_t* base, size_t ld, int m0, int tid) { ARows a; a.mu = nullptr; a.ltype = 0; a.first = 0;
#pragma unroll
    for (int i = 0; i < 4; ++i) a.p[i] = base + (size_t)(m0 + (tid >> 3) + 64 * i) * ld;
    return a; }


DI void convert_tile4(const float* src, int ld, int N, int K, bf16_t* dst, int tile0, unsigned char* lds, int Kvalid = 1 << 30) {
    const int tid = TID();
    const int nkt = K >> 6;
    const int r = tid >> 3, seg = (tid & 7) * 8;
    f32x4 a[4], b[4];
#pragma unroll
    for (int u = 0; u < 4; ++u) {
        const int tile = tile0 + u, k0 = (tile % nkt) * 64, n0 = (tile / nkt) * 64;
        a[u] = (f32x4){0.f, 0.f, 0.f, 0.f}; b[u] = a[u];
        if (n0 + seg < N && k0 + r < Kvalid) { const float* q = src + (size_t)(k0 + r) * ld + n0 + seg; a[u] = *(const f32x4*)q; b[u] = *(const f32x4*)(q + 4); }
    }
    __syncthreads();
#pragma unroll
    for (int u = 0; u < 4; ++u) { bf16_t* T = (bf16_t*)lds + u * 64 * 72;
        u32x4 w; w.x = pack2(a[u][0], a[u][1]); w.y = pack2(a[u][2], a[u][3]); w.z = pack2(b[u][0], b[u][1]); w.w = pack2(b[u][2], b[u][3]); *(u32x4*)(T + r * 72 + seg) = w; }
    __syncthreads();
#pragma unroll
    for (int u = 0; u < 4; ++u) { const bf16_t* T = (const bf16_t*)lds + u * 64 * 72;
        const int tile = tile0 + u, k0 = (tile % nkt) * 64, n0 = (tile / nkt) * 64;
        u32x4 o;
        o.x = (unsigned)T[(seg + 0) * 72 + r] | ((unsigned)T[(seg + 1) * 72 + r] << 16); o.y = (unsigned)T[(seg + 2) * 72 + r] | ((unsigned)T[(seg + 3) * 72 + r] << 16);
        o.z = (unsigned)T[(seg + 4) * 72 + r] | ((unsigned)T[(seg + 5) * 72 + r] << 16); o.w = (unsigned)T[(seg + 6) * 72 + r] | ((unsigned)T[(seg + 7) * 72 + r] << 16);
        *(u32x4*)(dst + (size_t)(n0 + r) * K + k0 + seg) = o; }
}
struct Ctx {
    const Params* P; unsigned char* ws; float* out; int l;
    bf16_t* H; bf16_t* PROJ; bf16_t* F; bf16_t* POOLED; bf16_t* MERGED; bf16_t* CMPH; float* CMPO; float* POSB; int* ROUTE; int* ENT; bf16_t* HID; bf16_t* Y; bf16_t* VT; bf16_t* KC; bf16_t* VCT; bf16_t* YRAW; float* BON; unsigned* ctl;
    DI const float* in(int i) const { return P->in[i]; }
};

DI void moe_offsets(const Ctx& c, int layer, int* soff) {
    const unsigned* cnt = c.ctl + CW_CNT + layer * 32;
    __syncthreads();
    if (TID() == 0) { int s = 0; for (int e = 0; e < 32; ++e) { soff[e] = s; s += (int)cnt[e]; } soff[32] = s; }
    __syncthreads();
}
DI void add_moe_rows(const Ctx& c, int row, int lane, f32x4 (&v)[4], const int* soff) {
    const int* rt = c.ROUTE + (size_t)row * 8;
    const int p0 = soff[rt[0]] + rt[4], p1 = soff[rt[1]] + rt[5];
    const bf16_t* y0 = c.Y + (size_t)p0 * DM; const bf16_t* y1 = c.Y + (size_t)p1 * DM;
#pragma unroll
    for (int i = 0; i < 4; ++i) {
        const u32x2 a = *(const u32x2*)(y0 + i * 256 + lane * 4), b = *(const u32x2*)(y1 + i * 256 + lane * 4);
        v[i][0] += bflo(a.x) + bflo(b.x); v[i][1] += bfhi(a.x) + bfhi(b.x); v[i][2] += bflo(a.y) + bflo(b.y); v[i][3] += bfhi(a.y) + bfhi(b.y);
    }
}
DI void phase_norm1(const Ctx& c, unsigned char* lds) {
    const int tid = TID(), lane = tid & 63, wave = tid >> 6;
    const float* gain = c.in(I_NMIX) + c.l * DM;
    const float* src = (c.l == 0) ? c.in(I_X) : c.out;
    int* soff = (int*)(lds + 65536);
    if (c.l > 0) moe_offsets(c, c.l - 1, soff);
    for (int row = blockIdx.x * 8 + wave; row < NT; row += gridDim.x * 8) {
        f32x4 v[4];
#pragma unroll
        for (int i = 0; i < 4; ++i) v[i] = *(const f32x4*)(src + (size_t)row * DM + i * 256 + lane * 4);
        if (c.l > 0) {
            add_moe_rows(c, row, lane, v, soff);
#pragma unroll
            for (int i = 0; i < 4; ++i) *(f32x4*)(c.out + (size_t)row * DM + i * 256 + lane * 4) = v[i];
        }
        float ss = 0.f;
#pragma unroll
        for (int i = 0; i < 4; ++i) ss += v[i][0] * v[i][0] + v[i][1] * v[i][1] + v[i][2] * v[i][2] + v[i][3] * v[i][3];
        ss = wave_sum_dpp(ss);
        const float rs = rsqrtf(ss * (1.0f / DM) + 1e-6f);
#pragma unroll
        for (int i = 0; i < 4; ++i) {
            const f32x4 g = *(const f32x4*)(gain + i * 256 + lane * 4);
            store_bf4(c.H + (size_t)row * DM + i * 256 + lane * 4, (f32x4){v[i][0] * rs * g[0], v[i][1] * rs * g[1], v[i][2] * rs * g[2], v[i][3] * rs * g[3]});
        }
    }
    for (int idx = blockIdx.x * 8 + wave; idx < 512; idx += gridDim.x * 8) {
        const int kv = idx >> 8, n = idx & 255;
        const float* pos = c.in(kv ? I_CPV : I_CPK) + (size_t)c.l * 2048;
        const float* w1 = c.in(kv ? I_CW1V : I_CW1K) + (size_t)c.l * 2048 * 256;
        float s = 0.f;
        for (int k = lane; k < 2048; k += 64) s += pos[k] * w1[(size_t)k * 256 + n];
        s = wave_sum_dpp(s);
        if (lane == 0) c.POSB[kv * 256 + n] = s;
    }
    for (int it = blockIdx.x * 4; it < 1216 + 256 + 16 + 16 + 48; it += gridDim.x * 4) {
        if (it < 1216) convert_tile4(c.in(I_WIN) + (size_t)c.l * DM * IN_COLS, IN_COLS, IN_COLS, DM, (bf16_t*)(c.ws + WS_WT_IN), it, lds);
        else if (it < 1216 + 256) { const int j = it - 1216, kv = j >> 7; convert_tile4(c.in(kv ? I_CW1V : I_CW1K) + (size_t)c.l * 2048 * 256, 256, 256, 2048, (bf16_t*)(c.ws + WS_WT_C1) + (size_t)kv * 256 * 2048, j & 127, lds); }
        else if (it < 1216 + 256 + 16) { const int j = it - 1472, kv = j >> 3; convert_tile4(c.in(kv ? I_CW2V : I_CW2K) + (size_t)c.l * 256 * 64, 64, 64, 256, (bf16_t*)(c.ws + WS_WT_C2) + (size_t)kv * 128 * 256, j & 7, lds); }
        else if (it < 1504) { const int j = it - 1488, gi = j >> 2; convert_tile4(c.in(I_POOLW) + ((size_t)c.l * 4 + gi) * 128 * 128, 128, 128, 128, (bf16_t*)(c.ws + WS_WT_POOL) + (size_t)gi * 128 * 128, 0, lds); }
        else { const int j = it - 1504, ty = j >> 4; bf16_t* dst = (bf16_t*)(c.ws + WS_WT_LORA) + (size_t)ty * 512 * 128;
            if (ty == 0) convert_tile4(c.in(I_WUP) + (size_t)c.l * 32 * 512, 512, 512, 128, dst, j & 15, lds, 32);
            else if (ty == 1) convert_tile4(c.in(I_AUP) + (size_t)c.l * 32 * 512, 512, 512, 128, dst, j & 15, lds, 32);
            else convert_tile4(c.in(I_GUP) + (size_t)c.l * 96 * 512, 512, 512, 128, dst, j & 15, lds, 96); }
    }
}

constexpr int EPS = 136;
DI void tile_store_bf16(f32x4 (&acc)[4][4], bf16_t* out, size_t ld, int nrows, int ncols, unsigned char* lds) {
    bf16_t* T = (bf16_t*)lds;
    const int tid = TID();
    __syncthreads();
    ACC_FOREACH(acc, { store_bf4(T + r_ * EPS + c_, v_); });
    __syncthreads();
#pragma unroll
    for (int i = 0; i < 8; ++i) {
        const int ch = tid + i * NTHREADS, r = ch >> 4, cc = (ch & 15) * 8;
        if (r < nrows && cc < ncols) *(u32x4*)(out + (size_t)r * ld + cc) = *(const u32x4*)(T + r * EPS + cc);
    }
}
DI bool xcd_unit(int it, int nN, int& tm, int& tn) {
    const int G = gridDim.x;
    if ((G & 7) != 0 || G < 8) { const int u = it * G + blockIdx.x; if (u >= 64 * nN) return false; tm = u % 64; tn = u / 64; return true; }
    const int x = blockIdx.x & 7, i = blockIdx.x >> 3, per = G >> 3;
    const int u = it * per + i;
    if (u >= 8 * nN) return false;
    tm = x * 8 + (u & 7); tn = u >> 3; return true;
}
DI void phase_gemm1(const Ctx& c, unsigned char* lds) {
    const int nN = (IN_COLS + 255) / 256;
    const bf16_t* WT = (const bf16_t*)(c.ws + WS_WT_IN);
    for (int it = 0;; ++it) {
        int tm, tn; if (!xcd_unit(it, nN, tm, tn)) break;
        const int m0 = tm * 256, n0 = tn * 256;
        f32x4 acc[8][4];
#pragma unroll
        for (int i = 0; i < 8; ++i)
#pragma unroll
            for (int j = 0; j < 4; ++j) acc[i][j] = (f32x4){0.f, 0.f, 0.f, 0.f};
        gemm256_dma(acc, c.H + (size_t)m0 * DM, DM, WT + (size_t)n0 * DM, DM, DM, lds);
        tile256_store_bf16(acc, c.PROJ + (size_t)m0 * IN_COLS + n0, IN_COLS, (IN_COLS - n0 < 256) ? IN_COLS - n0 : 256, lds);
    }
}

DI float gelu_tanh(float x) { const float u = 0.7978845608028654f * (x + 0.044715f * x * x * x); const float e = __expf(2.0f * u); return x * (1.0f - __builtin_amdgcn_rcpf(e + 1.0f)); }
DI float softplusf_(float x) { return (x > 20.f) ? x : __logf(1.0f + __expf(x)); }
DI float tanhf_(float x) { const float e = __expf(2.0f * x); return 1.0f - 2.0f * __builtin_amdgcn_rcpf(e + 1.0f); }
constexpr int TKP = 8;
template <int WIN>
DI void pool_emit(const Ctx& c, const float (&pv)[31], int t0, int s0, int ch) {
#pragma unroll
    for (int k = 0; k < 16; ++k) {
        float sum = 0.f;
#pragma unroll
        for (int j = 0; j < WIN; ++j) sum += pv[15 + k - j];
        const int s = s0 + k, cnt = (s + 1 < WIN) ? s + 1 : WIN;
        c.POOLED[(size_t)(t0 + k) * 512 + ch] = f2bf(sum / (float)cnt - pv[15 + k]);
    }
}
DI void phase_prep(const Ctx& c, unsigned char* lds) {
    const int n_cmp_items = 2 * 16 * 2;
    for (int item = (int)gridDim.x - 1 - (int)blockIdx.x; item < n_cmp_items; item += gridDim.x) {
        const int tid = TID();
        const int kv = item >> 5, bgi = (item >> 1) & 15, tn = item & 1, m0 = bgi * 256, n0 = tn * 128;
        ARows ar; ar.mu = nullptr; ar.ltype = 0; ar.first = 0;
#pragma unroll
        for (int i = 0; i < 4; ++i) { const int cb = (tid >> 3) + 64 * i;
            ar.p[i] = (cb < NCMP) ? c.PROJ + ((size_t)(bgi >> 2) * SEQ + 16 * cb) * IN_COLS + (kv ? C_VC : C_KC) + (bgi & 3) * 64 : nullptr; }
        f32x4 acc[4][4]; acc_zero(acc);
        gemm_core<1>(acc, ar, (const bf16_t*)(c.ws + WS_WT_C1) + ((size_t)kv * 256 + n0) * 2048, 2048, 2048, lds);
        const float* pb = c.POSB + kv * 256;
        ACC_FOREACH(acc, {
            const f32x4 bb = *(const f32x4*)(pb + n0 + c_);
            store_bf4(c.CMPH + ((size_t)kv * 4096 + m0 + r_) * 256 + n0 + c_, (f32x4){gelu_tanh(v_[0] + bb[0]), gelu_tanh(v_[1] + bb[1]), gelu_tanh(v_[2] + bb[2]), gelu_tanh(v_[3] + bb[3])}); });
    }
    {
        const float* mu = c.in(I_MU) + (size_t)c.l * RWC;
        const bf16_t* WL = (const bf16_t*)(c.ws + WS_WT_LORA);
        for (int unit = blockIdx.x; unit < 64 * 12; unit += gridDim.x) {
            const int tid = TID();
            const int tm = unit & 63, tn = unit >> 6, m0 = tm * 256, n0 = tn * 128, ltype = tn >> 2, ch0 = n0 & 511;
            ARows ar; ar.mu = mu; ar.ltype = ltype; ar.first = 0;
#pragma unroll
            for (int i = 0; i < 4; ++i) { const int t = m0 + (tid >> 3) + 64 * i; ar.p[i] = c.PROJ + (size_t)t * IN_COLS; if ((t & (SEQ - 1)) == 0) ar.first |= 1 << i; }
            f32x4 acc[4][4]; acc_zero(acc);
            gemm_core<2>(acc, ar, WL + (size_t)n0 * 128, 128, 128, lds);
            if (ltype == 0) { const float* w0 = c.in(I_W0) + c.l * 512 + ch0;
                ACC_FOREACH(acc, { const f32x4 b4 = *(const f32x4*)(w0 + c_);
                    for (int j = 0; j < 4; ++j) v_[j] = __expf(-softplusf_(-(b4[j] + v_[j])) - 0.5f); }); }
            else if (ltype == 1) { const float* a0 = c.in(I_A0) + c.l * 512 + ch0;
                ACC_FOREACH(acc, { const f32x4 b4 = *(const f32x4*)(a0 + c_);
                    for (int j = 0; j < 4; ++j) v_[j] = sigmoidf_(b4[j] + v_[j]); }); }
            tile_store_bf16(acc, c.F + (size_t)(3 + ltype) * NT * 512 + (size_t)m0 * 512 + ch0, 512, 256, 128, lds);
        }
    }
    const int tid = TID();
    const int n_pool_items = NT / 16, n_items = n_pool_items + 512;
    for (int item = blockIdx.x; item < n_items; item += gridDim.x) {
        if (item >= n_pool_items) {
            const int idx0 = (item - n_pool_items) * 4;
            const int r = tid >> 3, seg = (tid & 7) * 8;
            u32x4 w[4];
#pragma unroll
            for (int u = 0; u < 4; ++u) { const int idx = idx0 + u, kind = idx >> 10, bgi = (idx >> 6) & 15, s0 = (idx & 63) * 64;
                w[u] = *(const u32x4*)(c.PROJ + ((size_t)(bgi >> 2) * SEQ + s0 + r) * IN_COLS + (kind ? C_VW : C_VS) + (bgi & 3) * 64 + seg); }
            __syncthreads();
#pragma unroll
            for (int u = 0; u < 4; ++u) *(u32x4*)((bf16_t*)lds + u * 64 * 72 + r * 72 + seg) = w[u];
            __syncthreads();
#pragma unroll
            for (int u = 0; u < 4; ++u) { const int idx = idx0 + u, kind = idx >> 10, bgi = (idx >> 6) & 15, s0 = (idx & 63) * 64;
                const bf16_t* T = (const bf16_t*)lds + u * 64 * 72;
                u32x4 o;
                o.x = (unsigned)T[(seg + 0) * 72 + r] | ((unsigned)T[(seg + 1) * 72 + r] << 16); o.y = (unsigned)T[(seg + 2) * 72 + r] | ((unsigned)T[(seg + 3) * 72 + r] << 16);
                o.z = (unsigned)T[(seg + 4) * 72 + r] | ((unsigned)T[(seg + 5) * 72 + r] << 16); o.w = (unsigned)T[(seg + 6) * 72 + r] | ((unsigned)T[(seg + 7) * 72 + r] << 16);
                *(u32x4*)(c.VT + (((size_t)kind * 16 + bgi) * 64 + r) * SEQ + s0 + seg) = o; }
        } else {
            const int t0 = item * 16, ch = tid, gi = ch >> 7, s0 = t0 & (SEQ - 1);
            float pv[31];
#pragma unroll
            for (int i = 0; i < 31; ++i) pv[i] = (s0 - 15 + i >= 0) ? bf2f(c.PROJ[(size_t)(t0 - 15 + i) * IN_COLS + C_POOL + ch]) : 0.f;
            if (gi == 0) pool_emit<2>(c, pv, t0, s0, ch);
            else if (gi == 1) pool_emit<4>(c, pv, t0, s0, ch);
            else if (gi == 2) pool_emit<8>(c, pv, t0, s0, ch);
            else pool_emit<16>(c, pv, t0, s0, ch);
        }
    }
}

DI void rwkv_finalize_item(const Ctx& c, int item) {
    const int tid = TID(), ch = tid, t0 = item * 8;
    const float* mu = c.in(I_MU) + (size_t)c.l * RWC;
    const float kkw_ = c.in(I_KK)[c.l * 512 + ch], kaw_ = c.in(I_KA)[c.l * 512 + ch], rkw_ = c.in(I_RK)[c.l * 512 + ch];
    const float mur = mu[ch], muk = mu[512 + ch], muv = mu[1024 + ch];
    bf16_t ur[9], uk[9], uv[9], ua[8];
    const bool has_prev = (t0 & (SEQ - 1)) != 0;
#pragma unroll
    for (int k = 0; k < 9; ++k) {
        ur[k] = 0; uk[k] = 0; uv[k] = 0;
        if (k > 0 || has_prev) { const bf16_t* q = c.PROJ + (size_t)(t0 - 1 + k) * IN_COLS; ur[k] = q[C_R + ch]; uk[k] = q[C_K + ch]; uv[k] = q[C_V + ch]; }
    }
#pragma unroll
    for (int k = 0; k < 8; ++k) ua[k] = c.F[(size_t)4 * NT * 512 + (size_t)(t0 + k) * 512 + ch];
#pragma unroll
    for (int k = 0; k < 8; ++k) {
        const int t = t0 + k;
        const float cr = bf2f(ur[k + 1]), ck = bf2f(uk[k + 1]), cv = bf2f(uv[k + 1]);
        const float r = cr + (bf2f(ur[k]) - cr) * mur, kx = ck + (bf2f(uk[k]) - ck) * muk, vx = cv + (bf2f(uv[k]) - cv) * muv;
        const float a = bf2f(ua[k]);
        const float kxn = kx * kkw_, kp = kx * (1.0f + (a - 1.0f) * kaw_);
        const float ss = wave_sum_dpp(kxn * kxn);
        const float inv = __builtin_amdgcn_rsqf(fmaxf(ss, 1e-24f));
        const float br = wave_sum_dpp(kxn * inv * a * r), kr = wave_sum_dpp(kp * r), bon = wave_sum_dpp(r * kp * rkw_);
        if ((tid & 63) == 0) *(f32x4*)(c.BON + ((size_t)t * 8 + (tid >> 6)) * 4) = (f32x4){inv, br, kr, bon};
        const size_t o = (size_t)t * 512 + ch;
        c.F[o] = f2bf(r); c.F[o + (size_t)NT * 512] = f2bf(kx); c.F[o + (size_t)2 * NT * 512] = f2bf(vx);
    }
}

DI void phase_poolgemm(const Ctx& c, unsigned char* lds) {
    for (int item = blockIdx.x; item < NT / 8; item += gridDim.x) rwkv_finalize_item(c, item);
    const int n_pool = (NT / 256) * 4, n_items = n_pool + 32;
    for (int item = blockIdx.x; item < n_items; item += gridDim.x) {
        f32x4 acc[4][4]; acc_zero(acc);
        if (item < n_pool) {
            const int tm = item >> 2, gi = item & 3, m0 = tm * 256;
            const ARows ar = plain_rows(c.POOLED + gi * 128, 512, m0, TID());
            gemm_core<0>(acc, ar, (const bf16_t*)(c.ws + WS_WT_POOL) + (size_t)gi * 128 * 128, 128, 128, lds);
            const float* sc = c.in(I_POOLS) + c.l * 512 + gi * 128;
            ACC_FOREACH(acc, { const f32x4 s = *(const f32x4*)(sc + c_);
                store_bf4(c.POOLED + (size_t)(m0 + r_) * 512 + gi * 128 + c_, (f32x4){v_[0] * s[0], v_[1] * s[1], v_[2] * s[2], v_[3] * s[3]}); });
        } else {
            const int it = item - n_pool, kv = it >> 4, tm = it & 15, m0 = tm * 256;
            const ARows ar = plain_rows(c.CMPH + (size_t)kv * 4096 * 256, 256, m0, TID());
            gemm_core<0>(acc, ar, (const bf16_t*)(c.ws + WS_WT_C2) + (size_t)kv * 128 * 256, 256, 256, lds);
            ACC_FOREACH(acc, { if (c_ < 64) { const int R = m0 + r_;
                if (kv == 0) store_bf4(c.KC + (size_t)R * 64 + c_, v_);
                else { bf16_t* q = c.VCT + ((size_t)(R >> 8) * 64 + c_) * 256 + (R & 255); q[0] = f2bf(v_[0]); q[256] = f2bf(v_[1]); q[512] = f2bf(v_[2]); q[768] = f2bf(v_[3]); } } });
        }
    }
}

constexpr int SCH = 32;
constexpr int SB_AN = 0, SB_WR = SCH * 64 * 4, SB_W = 2 * SCH * 64 * 4, SB_BB = 3 * SCH * 64 * 4, SB_KP = 4 * SCH * 64 * 4;
constexpr int SB_V = 5 * SCH * 64 * 4;
constexpr int SB_SC = SB_V + SCH * 16 * 4;
constexpr int SB_Y = SB_SC + SCH * 2 * 4;
constexpr int SB_BYTES = SB_Y + SCH * 16 * 4;
static_assert(2 * SB_BYTES <= LDS_BYTES - 64, "scan lds");
typedef float f32x2 __attribute__((ext_vector_type(2)));
DI float row8_sum(float v) { v += DPP_MOV(v, 0xB1); v += DPP_MOV(v, 0x4E); v += DPP_MOV(v, 0x141); return v; }

constexpr int NPW = 6, NJ = (SCH + NPW - 1) / NPW;
struct PrepRegs { bf16_t r[NJ], k[NJ], v[NJ], e[NJ], a[NJ]; float s0[NJ], s1[NJ], s2[NJ]; };
DI void prep_load(PrepRegs& R, const Ctx& c, int b, int h, int ck, int pw, int lane) {
    const size_t PL = (size_t)NT * 512;
    const size_t tb = (size_t)b * SEQ + ck * SCH;
    const size_t o0 = tb * 512 + h * 64 + lane;
#pragma unroll
    for (int j = 0; j < NJ; ++j) {
        const int st = pw + NPW * j;
        if (st < SCH) { const size_t o = o0 + (size_t)st * 512; R.r[j] = c.F[o]; R.k[j] = c.F[o + PL]; R.v[j] = c.F[o + 2 * PL]; R.e[j] = c.F[o + 3 * PL]; R.a[j] = c.F[o + 4 * PL];
            const float* sp = c.BON + ((tb + st) * 8 + h) * 4; R.s0[j] = sp[0]; R.s1[j] = sp[1]; R.s2[j] = sp[2]; }
    }
}
DI void prep_store(const PrepRegs& R, unsigned char* sb, int rq, int pw, int lane, float kkw, float kaw) {
    float* an = (float*)(sb + SB_AN); float* wr = (float*)(sb + SB_WR); float* w_ = (float*)(sb + SB_W); float* bb_ = (float*)(sb + SB_BB); float* kp_ = (float*)(sb + SB_KP);
    float* vv = (float*)(sb + SB_V); float* sc = (float*)(sb + SB_SC);
#pragma unroll
    for (int j = 0; j < NJ; ++j) {
        const int st = pw + NPW * j;
        if (st < SCH) {
            const float r = bf2f(R.r[j]), k = bf2f(R.k[j]), v = bf2f(R.v[j]), e = bf2f(R.e[j]), a = bf2f(R.a[j]);
            const float w = __expf(-e);
            const float kk = k * kkw * R.s0[j];
            const float kp = k * (1.0f + (a - 1.0f) * kaw);
            an[st * 64 + lane] = -kk; wr[st * 64 + lane] = w * r; w_[st * 64 + lane] = w; bb_[st * 64 + lane] = kk * a; kp_[st * 64 + lane] = kp;
            if ((lane >> 4) == rq) vv[st * 16 + (lane & 15)] = v;
            if (lane == 0) { sc[st * 2] = R.s1[j]; sc[st * 2 + 1] = R.s2[j]; }
        }
    }
}
DI void scan_item(const Ctx& c, int item, unsigned char* lds) {
    const int tid = TID(), lane = tid & 63, wave = tid >> 6;
    const int b = item >> 5, h = (item >> 2) & 7, rq = item & 3;
    const int chn = h * 64 + lane;
    const float kkw = c.in(I_KK)[c.l * 512 + chn], kaw = c.in(I_KA)[c.l * 512 + chn];
    const int rowl = (tid & 127) >> 3, cg = tid & 7;
    f32x2 st[4];
#pragma unroll
    for (int i = 0; i < 4; ++i) st[i] = (f32x2){0.f, 0.f};
    constexpr int NCK = SEQ / SCH;
    PrepRegs R;
    __syncthreads();
    if (wave >= 2) { prep_load(R, c, b, h, 0, wave - 2, lane); prep_store(R, lds, rq, wave - 2, lane, kkw, kaw); prep_load(R, c, b, h, 1, wave - 2, lane); }
    __syncthreads();
    for (int ck = 0; ck < NCK; ++ck) {
        unsigned char* sb = lds + (ck & 1) * SB_BYTES;
        if (wave < 2) {
            const float* an = (const float*)(sb + SB_AN) + cg * 8; const float* wr = (const float*)(sb + SB_WR) + cg * 8; const float* w_ = (const float*)(sb + SB_W) + cg * 8;
            const float* bb_ = (const float*)(sb + SB_BB) + cg * 8; const float* kp_ = (const float*)(sb + SB_KP) + cg * 8;
            const float* vv = (const float*)(sb + SB_V) + rowl; const float* sc = (const float*)(sb + SB_SC); float* yb = (float*)(sb + SB_Y) + rowl;
            f32x4 a0 = *(const f32x4*)(an), a1 = *(const f32x4*)(an + 4), r0 = *(const f32x4*)(wr), r1 = *(const f32x4*)(wr + 4);
            f32x4 w0 = *(const f32x4*)(w_), w1 = *(const f32x4*)(w_ + 4), b0 = *(const f32x4*)(bb_), b1 = *(const f32x4*)(bb_ + 4);
            f32x4 k0 = *(const f32x4*)(kp_), k1 = *(const f32x4*)(kp_ + 4);
            float v = vv[0]; f32x2 bk = *(const f32x2*)(sc);
#pragma unroll 2
            for (int s = 0; s < SCH; ++s) {
                const int sn = (s + 1 < SCH) ? s + 1 : s;
                const f32x4 na0 = *(const f32x4*)(an + sn * 64), na1 = *(const f32x4*)(an + sn * 64 + 4), nr0 = *(const f32x4*)(wr + sn * 64), nr1 = *(const f32x4*)(wr + sn * 64 + 4);
                const f32x4 nw0 = *(const f32x4*)(w_ + sn * 64), nw1 = *(const f32x4*)(w_ + sn * 64 + 4), nb0 = *(const f32x4*)(bb_ + sn * 64), nb1 = *(const f32x4*)(bb_ + sn * 64 + 4);
                const f32x4 nk0 = *(const f32x4*)(kp_ + sn * 64), nk1 = *(const f32x4*)(kp_ + sn * 64 + 4);
                const float nv = vv[sn * 16]; const f32x2 nbk = *(const f32x2*)(sc + sn * 2);
                f32x2 da = st[0] * (f32x2){a0[0], a0[1]}; f32x2 dr = st[0] * (f32x2){r0[0], r0[1]};
                da += st[1] * (f32x2){a0[2], a0[3]}; dr += st[1] * (f32x2){r0[2], r0[3]};
                da += st[2] * (f32x2){a1[0], a1[1]}; dr += st[2] * (f32x2){r1[0], r1[1]};
                da += st[3] * (f32x2){a1[2], a1[3]}; dr += st[3] * (f32x2){r1[2], r1[3]};
                float sa = da[0] + da[1], sr = dr[0] + dr[1];
                sa += DPP_MOV(sa, 0xB1); sr += DPP_MOV(sr, 0xB1);
                sa += DPP_MOV(sa, 0x4E); sr += DPP_MOV(sr, 0x4E);
                sa += DPP_MOV(sa, 0x141); sr += DPP_MOV(sr, 0x141);
                const f32x2 sa2 = (f32x2){sa, sa}, v2 = (f32x2){v, v};
                st[0] = st[0] * (f32x2){w0[0], w0[1]} + sa2 * (f32x2){b0[0], b0[1]} + v2 * (f32x2){k0[0], k0[1]};
                st[1] = st[1] * (f32x2){w0[2], w0[3]} + sa2 * (f32x2){b0[2], b0[3]} + v2 * (f32x2){k0[2], k0[3]};
                st[2] = st[2] * (f32x2){w1[0], w1[1]} + sa2 * (f32x2){b1[0], b1[1]} + v2 * (f32x2){k1[0], k1[1]};
                st[3] = st[3] * (f32x2){w1[2], w1[3]} + sa2 * (f32x2){b1[2], b1[3]} + v2 * (f32x2){k1[2], k1[3]};
                yb[s * 16] = sr + sa * bk[0] + v * bk[1];
                a0 = na0; a1 = na1; r0 = nr0; r1 = nr1; w0 = nw0; w1 = nw1; b0 = nb0; b1 = nb1; k0 = nk0; k1 = nk1; v = nv; bk = nbk;
            }
        } else {
            const int pt = tid - 128;
            if (ck + 1 < NCK) prep_store(R, lds + ((ck + 1) & 1) * SB_BYTES, rq, wave - 2, lane, kkw, kaw);
            if (ck + 2 < NCK) prep_load(R, c, b, h, ck + 2, wave - 2, lane);
            if (ck > 0) {
                const float* yb = (const float*)(lds + ((ck - 1) & 1) * SB_BYTES + SB_Y);
                for (int idx = pt; idx < SCH * 16; idx += 384) {
                    const int s = idx >> 4, j = idx & 15;
                    c.YRAW[((size_t)b * SEQ + (ck - 1) * SCH + s) * 512 + h * 64 + rq * 16 + j] = f2bf(yb[idx]);
                }
            }
        }
        asm volatile("s_waitcnt lgkmcnt(0)" ::: "memory"); __builtin_amdgcn_s_barrier(); asm volatile("" ::: "memory");
    }
    {
        const float* yb = (const float*)(lds + ((NCK - 1) & 1) * SB_BYTES + SB_Y);
        for (int idx = tid; idx < SCH * 16; idx += NTHREADS) {
            const int s = idx >> 4, j = idx & 15;
            c.YRAW[((size_t)b * SEQ + (NCK - 1) * SCH + s) * 512 + h * 64 + rq * 16 + j] = f2bf(yb[idx]);
        }
    }
    __syncthreads();
}
constexpr int CS64 = 72, CS32 = 40;
constexpr int CK_AH = 0, CK_BH = CK_AH + 32 * CS64 * 2, CK_KH = CK_BH + 32 * CS64 * 2, CK_RH = CK_KH + 32 * CS64 * 2;
constexpr int CK_BHT = CK_RH + 32 * CS64 * 2, CK_KHT = CK_BHT + 64 * CS32 * 2, CK_VT = CK_KHT + 64 * CS32 * 2, CK_ZT = CK_VT + 64 * CS32 * 2, CK_UT = CK_ZT + 64 * CS32 * 2;
constexpr int CK_S0B = CK_UT + 64 * CS32 * 2;
constexpr int CK_LAK = CK_S0B + 2 * 64 * CS64 * 2, CK_MRB = CK_LAK + 32 * CS32 * 2, CK_MRK = CK_MRB + 32 * CS32 * 2;
constexpr int CK_PA = CK_MRK + 32 * CS32 * 2, CK_PT = CK_PA + 2 * 32 * CS32 * 2, CK_TT = CK_PT + 2 * 32 * CS32 * 2;
constexpr int CK_TOT = CK_TT + 2 * 32 * CS32 * 2;
constexpr int CK_GC = CK_TOT + 8 * 64 * 4;
constexpr int CK_END = CK_GC + 256;
static_assert(CK_END <= LDS_BYTES - 64, "chunk scan lds");
template <int K>
DI f32x4 mm16(const bf16_t* A, int lda, const bf16_t* Bt, int ldb, f32x4 acc, int lane) {
#pragma unroll
    for (int k0 = 0; k0 < K; k0 += 32) {
        const bf16x8 a = *(const bf16x8*)(A + (lane & 15) * lda + k0 + (lane >> 4) * 8), b = *(const bf16x8*)(Bt + (lane & 15) * ldb + k0 + (lane >> 4) * 8);
        acc = __builtin_amdgcn_mfma_f32_16x16x32_bf16(a, b, acc, 0, 0, 0);
    }
    return acc;
}
template <int K>
DI f32x4 mm16t(const bf16_t* A, int lda, const bf16_t* Bt, int ldb, f32x4 acc, int lane) {
#pragma unroll
    for (int k0 = 0; k0 < K; k0 += 32) {
        const bf16x8 a = *(const bf16x8*)(A + (lane & 15) * lda + k0 + (lane >> 4) * 8), b = *(const bf16x8*)(Bt + (lane & 15) * ldb + k0 + (lane >> 4) * 8);
        acc = __builtin_amdgcn_mfma_f32_16x16x32_bf16(b, a, acc, 0, 0, 0);
    }
    return acc;
}
DI void mm16_both(const bf16_t* A, int lda, const bf16_t* Bt, int ldb, f32x4& cn, f32x4& ct, int lane) {
    const bf16x8 a = *(const bf16x8*)(A + (lane & 15) * lda + (lane >> 4) * 8), b = *(const bf16x8*)(Bt + (lane & 15) * ldb + (lane >> 4) * 8);
    cn = __builtin_amdgcn_mfma_f32_16x16x32_bf16(a, b, cn, 0, 0, 0); ct = __builtin_amdgcn_mfma_f32_16x16x32_bf16(b, a, ct, 0, 0, 0);
}
struct ChunkRaw { bf16_t r[4], k[4], v[4], e[4], a[4]; float inv[4]; };
DI void chunk_load(ChunkRaw& R, const Ctx& c, int b, int h, int ck, int wave, int lane) {
    const size_t PL = (size_t)NT * 512;
    const size_t tok0 = (size_t)b * SEQ + ck * 32 + wave * 4;
#pragma unroll
    for (int s = 0; s < 4; ++s) {
        const size_t o = (tok0 + s) * 512 + h * 64 + lane;
        R.r[s] = c.F[o]; R.k[s] = c.F[o + PL]; R.v[s] = c.F[o + 2 * PL]; R.e[s] = c.F[o + 3 * PL]; R.a[s] = c.F[o + 4 * PL];
        R.inv[s] = c.BON[((tok0 + s) * 8 + h) * 4];
    }
}
DI void scan_chunked_item(const Ctx& c, int item, unsigned char* lds) {
    const int tid = TID(), lane = tid & 63, wave = tid >> 6, qd = lane >> 4, l15 = lane & 15;
    const int b = item >> 3, h = item & 7;
    bf16_t* AH = (bf16_t*)(lds + CK_AH); bf16_t* BH = (bf16_t*)(lds + CK_BH); bf16_t* KH = (bf16_t*)(lds + CK_KH); bf16_t* RH = (bf16_t*)(lds + CK_RH);
    bf16_t* BHT = (bf16_t*)(lds + CK_BHT); bf16_t* KHT = (bf16_t*)(lds + CK_KHT); bf16_t* VT = (bf16_t*)(lds + CK_VT); bf16_t* ZT = (bf16_t*)(lds + CK_ZT); bf16_t* UT = (bf16_t*)(lds + CK_UT);
    bf16_t* S0B = (bf16_t*)(lds + CK_S0B); bf16_t* LAK = (bf16_t*)(lds + CK_LAK); bf16_t* MRB = (bf16_t*)(lds + CK_MRB); bf16_t* MRK = (bf16_t*)(lds + CK_MRK);
    bf16_t* PA = (bf16_t*)(lds + CK_PA); bf16_t* PT = (bf16_t*)(lds + CK_PT); bf16_t* TT = (bf16_t*)(lds + CK_TT);
    float* TOT = (float*)(lds + CK_TOT); float* GC = (float*)(lds + CK_GC);
    const f32x4 Z4 = (f32x4){0.f, 0.f, 0.f, 0.f};
    f32x4 Sreg[2] = {Z4, Z4};
    const int svt = wave >> 1, skt0 = 2 * (wave & 1);
    const int mt8 = wave >> 2, nt8 = wave & 3;
    const int mt4 = (wave >> 1) & 1, nt4 = wave & 1;
    __syncthreads();
    for (int i = tid; i < 2 * 64 * CS64 / 2; i += NTHREADS) ((unsigned*)S0B)[i] = 0u;
    const float kkw = c.in(I_KK)[c.l * 512 + h * 64 + lane], kaw = c.in(I_KA)[c.l * 512 + h * 64 + lane];
    ChunkRaw R; chunk_load(R, c, b, h, 0, wave, lane);
    constexpr int NCK = SEQ / 32;
    for (int ck = 0; ck < NCK; ++ck) {
        const bf16_t* S0c = S0B + (ck & 1) * 64 * CS64; bf16_t* S0n = S0B + ((ck + 1) & 1) * 64 * CS64;
        float r4[4], k4[4], v4[4], e4[4], a4[4], inv4[4], ce[4];
#pragma unroll
        for (int s = 0; s < 4; ++s) { r4[s] = bf2f(R.r[s]); k4[s] = bf2f(R.k[s]); v4[s] = bf2f(R.v[s]); e4[s] = bf2f(R.e[s]); a4[s] = bf2f(R.a[s]); inv4[s] = R.inv[s]; }
        ce[0] = e4[0]; ce[1] = ce[0] + e4[1]; ce[2] = ce[1] + e4[2]; ce[3] = ce[2] + e4[3];
        TOT[wave * 64 + lane] = ce[3];
        LDS_BARRIER();
        { const int ckn = (ck + 1 < NCK) ? ck + 1 : ck; chunk_load(R, c, b, h, ckn, wave, lane); }
        {
            float off = 0.f;
#pragma unroll
            for (int w = 0; w < 7; ++w) { const float tw = TOT[w * 64 + lane]; if (w < wave) off += tw; }
            float ah[4], bh[4], kh[4], rh[4];
#pragma unroll
            for (int s = 0; s < 4; ++s) {
                const float cs = off + ce[s];
                const float g = __expf(-cs), gi = __expf(cs), gm1 = __expf(e4[s] - cs);
                const float kk = k4[s] * kkw * inv4[s], kp = k4[s] * (1.0f + (a4[s] - 1.0f) * kaw);
                ah[s] = -kk * gm1; bh[s] = kk * a4[s] * gi; kh[s] = kp * gi; rh[s] = r4[s] * g;
                const int t = wave * 4 + s;
                AH[t * CS64 + lane] = f2bf(ah[s]); BH[t * CS64 + lane] = f2bf(bh[s]); KH[t * CS64 + lane] = f2bf(kh[s]); RH[t * CS64 + lane] = f2bf(rh[s]);
                if (wave == 7 && s == 3) GC[lane] = g;
            }
            store_bf4(BHT + lane * CS32 + wave * 4, (f32x4){bh[0], bh[1], bh[2], bh[3]});
            store_bf4(KHT + lane * CS32 + wave * 4, (f32x4){kh[0], kh[1], kh[2], kh[3]});
            store_bf4(VT + lane * CS32 + wave * 4, (f32x4){v4[0], v4[1], v4[2], v4[3]});
        }
        LDS_BARRIER();
        {
            const int q = wave >> 1, mt = wave & 1;
            const bf16_t* A = (q < 2) ? AH : RH; const bf16_t* Bt = (q & 1) ? KH : BH;
#pragma unroll
            for (int nt = 0; nt < 2; ++nt) {
                f32x4 acc = mm16t<64>(A + mt * 16 * CS64, CS64, Bt + nt * 16 * CS64, CS64, Z4, lane);
                const int m = mt * 16 + l15, n0 = nt * 16 + 4 * qd;
#pragma unroll
                for (int i = 0; i < 4; ++i) { const bool keep = (q < 2) ? (n0 + i < m) : (n0 + i <= m); if (!keep) acc[i] = 0.f; }
                if (q == 0) {
                    store_bf4(PA + m * CS32 + n0, acc);
                    f32x4 t0 = acc;
#pragma unroll
                    for (int i = 0; i < 4; ++i) if (n0 + i == m) t0[i] += 1.0f;
                    store_bf4(TT + m * CS32 + n0, t0);
                    f32x4 accn = mm16<64>(A + mt * 16 * CS64, CS64, Bt + nt * 16 * CS64, CS64, Z4, lane);
                    const int mm0 = mt * 16 + 4 * qd, nn = nt * 16 + l15;
#pragma unroll
                    for (int i = 0; i < 4; ++i) if (!(nn < mm0 + i)) accn[i] = 0.f;
                    store_bf4(PT + nn * CS32 + mm0, accn);
                } else store_bf4(((q == 1) ? LAK : ((q == 2) ? MRB : MRK)) + m * CS32 + n0, acc);
            }
        }
        LDS_BARRIER();
        f32x4 y = Z4;
        int pcur = 0, tcur = 0;
#pragma unroll
        for (int itn = 0; itn < 5; ++itn) {
            const int m = mt4 * 16 + l15, n0 = nt4 * 16 + 4 * qd;
            if (wave < 4) {
                if (itn < 4) {
                    f32x4 cn = Z4, ct = Z4;
                    mm16_both(PA + pcur * 32 * CS32 + mt4 * 16 * CS32, CS32, PT + pcur * 32 * CS32 + nt4 * 16 * CS32, CS32, cn, ct, lane);
                    store_bf4(PA + (pcur ^ 1) * 32 * CS32 + m * CS32 + n0, ct);
                    store_bf4(PT + (pcur ^ 1) * 32 * CS32 + (nt4 * 16 + l15) * CS32 + mt4 * 16 + 4 * qd, cn);
                }
            } else if (itn > 0) {
                const u32x2 told = *(const u32x2*)(TT + tcur * 32 * CS32 + m * CS32 + n0);
                f32x4 acc = (f32x4){bflo(told.x), bfhi(told.x), bflo(told.y), bfhi(told.y)};
                acc = mm16t<32>(TT + tcur * 32 * CS32 + mt4 * 16 * CS32, CS32, PT + pcur * 32 * CS32 + nt4 * 16 * CS32, CS32, acc, lane);
                store_bf4(TT + (tcur ^ 1) * 32 * CS32 + m * CS32 + n0, acc);
            }
            if (itn == 0) {
                f32x4 z = mm16<64>(AH + mt8 * 16 * CS64, CS64, S0c + nt8 * 16 * CS64, CS64, Z4, lane);
                z = mm16<32>(LAK + mt8 * 16 * CS32, CS32, VT + nt8 * 16 * CS32, CS32, z, lane);
                store_bf4(ZT + (nt8 * 16 + l15) * CS32 + mt8 * 16 + 4 * qd, z);
            } else if (itn == 1) {
                y = mm16t<64>(RH + mt8 * 16 * CS64, CS64, S0c + nt8 * 16 * CS64, CS64, Z4, lane);
                y = mm16t<32>(MRK + mt8 * 16 * CS32, CS32, VT + nt8 * 16 * CS32, CS32, y, lane);
            } else if (itn == 2) {
#pragma unroll
                for (int j = 0; j < 2; ++j) Sreg[j] = mm16t<32>(VT + svt * 16 * CS32, CS32, KHT + (skt0 + j) * 16 * CS32, CS32, Sreg[j], lane);
            }
            LDS_BARRIER();
            if (itn < 4) pcur ^= 1;
            if (itn > 0) tcur ^= 1;
        }
        const bf16_t* Tm = TT + tcur * 32 * CS32;
        {
            const f32x4 uacc = mm16<32>(Tm + mt8 * 16 * CS32, CS32, ZT + nt8 * 16 * CS32, CS32, Z4, lane);
            store_bf4(UT + (nt8 * 16 + l15) * CS32 + mt8 * 16 + 4 * qd, uacc);
        }
        LDS_BARRIER();
        {
            y = mm16t<32>(MRB + mt8 * 16 * CS32, CS32, UT + nt8 * 16 * CS32, CS32, y, lane);
            store_bf4(c.YRAW + ((size_t)b * SEQ + ck * 32 + mt8 * 16 + l15) * 512 + h * 64 + nt8 * 16 + 4 * qd, y);
#pragma unroll
            for (int j = 0; j < 2; ++j) {
                const int kt = skt0 + j;
                f32x4 s = mm16t<32>(UT + svt * 16 * CS32, CS32, BHT + kt * 16 * CS32, CS32, Sreg[j], lane);
                const f32x4 gc = *(const f32x4*)(GC + kt * 16 + 4 * qd);
                s = s * gc;
                Sreg[j] = s;
                store_bf4(S0n + (svt * 16 + l15) * CS64 + kt * 16 + 4 * qd, s);
            }
        }
        LDS_BARRIER();
    }
    __syncthreads();
}
DI void phase_rwkv_post(const Ctx& c, unsigned char* lds) {
    const int tid = TID(), lane = tid & 63, wave = tid >> 6;
    const size_t PL = (size_t)NT * 512;
    for (int t = blockIdx.x * 8 + wave; t < NT; t += gridDim.x * 8) {
        bf16_t ry[8], rv[8], rg[8]; float bon[8], gw[8], gb[8];
#pragma unroll
        for (int h = 0; h < 8; ++h) { const size_t o = (size_t)t * 512 + h * 64 + lane; ry[h] = c.YRAW[o]; rv[h] = c.F[o + 2 * PL]; rg[h] = c.F[o + 5 * PL]; bon[h] = c.BON[((size_t)t * 8 + h) * 4 + 3];
            gw[h] = c.in(I_GNW)[c.l * 512 + h * 64 + lane]; gb[h] = c.in(I_GNB)[c.l * 512 + h * 64 + lane]; }
#pragma unroll
        for (int h = 0; h < 8; ++h) {
            const float y = bf2f(ry[h]);
            const float mean = wave_sum_dpp(y) * (1.0f / 64.0f);
            const float d = y - mean;
            const float var = wave_sum_dpp(d * d) * (1.0f / 64.0f);
            const float yn = d * rsqrtf(var + 64e-5f) * gw[h] + gb[h];
            c.F[(size_t)t * 512 + h * 64 + lane + 5 * PL] = f2bf((yn + bon[h] * bf2f(rv[h])) * bf2f(rg[h]));
        }
    }
    for (int it = blockIdx.x * 4; it < 768 + 128 + 128 + 256 + 256; it += gridDim.x * 4) {
        const float* WB = c.in(I_WBR) + (size_t)c.l * 2048 * DM; bf16_t* BR = (bf16_t*)(c.ws + WS_WT_BR);
        if (it < 768) convert_tile4(c.in(I_WMG) + (size_t)c.l * DM * 3 * DM, 3 * DM, 3 * DM, DM, (bf16_t*)(c.ws + WS_WT_MG), it, lds);
        else if (it < 896) convert_tile4(WB, DM, DM, 512, BR, it - 768, lds);
        else if (it < 1024) convert_tile4(WB + (size_t)512 * DM, DM, DM, 512, BR + (size_t)1024 * 512, it - 896, lds);
        else if (it < 1280) convert_tile4(WB + (size_t)1024 * DM, DM, DM, 1024, BR + (size_t)2048 * 512, it - 1024, lds);
        else convert_tile4(c.in(I_WOUT) + (size_t)c.l * DM * DM, DM, DM, DM, (bf16_t*)(c.ws + WS_WT_OUT), it - 1280, lds);
    }
}
constexpr int TS = 72;
constexpr int NSA_BIAS = 0;
constexpr int NSA_SELM = 2112;
constexpr int NSA_SCR = 2624;
constexpr int NSA_K0 = 4672;
constexpr int NSA_V0 = NSA_K0 + 2 * 64 * TS * 2;
constexpr int NSA_A = NSA_V0 + 2 * 64 * TS * 2;
constexpr int NSA_B = NSA_A + 16384;
constexpr int NSA_END = NSA_B + 16384;
static_assert(NSA_END <= LDS_BYTES - 16, "nsa lds");
static_assert(NSA_K0 % 16 == 0, "align");

struct NsaLane { int tq[2]; int h; float cbias; float m[2], l[2]; };

DI void nsa_prefetch(u32x4& rk, u32x4& rv, const bf16_t* kbase, int kstride, const bf16_t* vtbase, int vstride, int pos0, int tid) {
    const int r = tid >> 3, seg = (tid & 7) * 8;
    rk = *(const u32x4*)(kbase + (size_t)(pos0 + r) * kstride + seg);
    rv = *(const u32x4*)(vtbase + (size_t)r * vstride + pos0 + seg);
}
DI void nsa_store(unsigned char* lds, int buf, const u32x4& rk, const u32x4& rv, int tid) {
    const int r = tid >> 3, seg = (tid & 7) * 8;
    *(u32x4*)((bf16_t*)(lds + NSA_K0) + buf * 64 * TS + r * TS + seg) = rk;
    *(u32x4*)((bf16_t*)(lds + NSA_V0) + buf * 64 * TS + r * TS + seg) = rv;
}
template <int QM = 3>
DI void nsa_qk(f32x4 (&s)[2][4], const bf16_t* sK, const bf16x8 (&qf)[2][2], int lane) {
#pragma unroll
    for (int kt = 0; kt < 4; ++kt) {
#pragma unroll
        for (int ks = 0; ks < 2; ++ks) {
            const bf16x8 kf = *(const bf16x8*)(sK + (16 * kt + (lane & 15)) * TS + 32 * ks + (lane >> 4) * 8);
#pragma unroll
            for (int qi = 0; qi < 2; ++qi) if ((QM >> qi) & 1) s[qi][kt] = __builtin_amdgcn_mfma_f32_16x16x32_bf16(kf, qf[qi][ks], (ks == 0) ? (f32x4){0.f, 0.f, 0.f, 0.f} : s[qi][kt], 0, 0, 0);
        }
    }
}
template <int MODE>
DI void nsa_logits(float (&x)[4][4], const f32x4 (&s)[4], int tq, int h, float cbias, bool rowsel, int pos0, int qd, const float* biasT) {
#pragma unroll
    for (int kt = 0; kt < 4; ++kt)
#pragma unroll
        for (int i = 0; i < 4; ++i) {
            const int kk = pos0 + 16 * kt + 4 * qd + i;
            if (MODE == 1) { x[kt][i] = rowsel ? s[kt][i] + cbias : -INFINITY; }
            else {
                const int dist = (MODE == 0) ? (tq - 16 * kk - 31) : (tq - kk);
                bool ok = dist >= 0;
                if (MODE == 2) ok = ok && rowsel;
                if (MODE == 3) ok = ok && (dist < 512);
                const int di = dist < 0 ? 0 : (dist > 128 ? 128 : dist);
                float bias = biasT[di * 4 + h];
                asm volatile("" : "+v"(bias));
                x[kt][i] = ok ? s[kt][i] + bias : -INFINITY;
            }
        }
}
DI float quad16_max(float v) { v = fmaxf(v, __shfl_xor(v, 16)); v = fmaxf(v, __shfl_xor(v, 32)); return v; }
DI float quad16_sum(float v) { v += __shfl_xor(v, 16); v += __shfl_xor(v, 32); return v; }
DI void nsa_softmax(const float (&x)[4][4], float& m, float& l, f32x4 (&O)[4], bf16x8 (&pf)[2]) {
    float mx = -INFINITY;
#pragma unroll
    for (int kt = 0; kt < 4; ++kt)
#pragma unroll
        for (int i = 0; i < 4; ++i) mx = fmaxf(mx, x[kt][i]);
    mx = quad16_max(mx);
    const float mn = fmaxf(m, mx);
    const float mu = (mn == -INFINITY) ? 0.f : mn;
    const float mu2 = mu * 1.4426950408889634f;
    const float sc = __builtin_amdgcn_exp2f(__builtin_fmaf(m, 1.4426950408889634f, -mu2));
    float p[4][4]; float ps = 0.f;
#pragma unroll
    for (int kt = 0; kt < 4; ++kt)
#pragma unroll
        for (int i = 0; i < 4; ++i) { p[kt][i] = __builtin_amdgcn_exp2f(__builtin_fmaf(x[kt][i], 1.4426950408889634f, -mu2)); ps += p[kt][i]; }
    l = l * sc + ps; m = mn;
#pragma unroll
    for (int dt = 0; dt < 4; ++dt) O[dt] = O[dt] * sc;
#pragma unroll
    for (int ks = 0; ks < 2; ++ks) {
        u32x4 w; w.x = pack2(p[2 * ks][0], p[2 * ks][1]); w.y = pack2(p[2 * ks][2], p[2 * ks][3]); w.z = pack2(p[2 * ks + 1][0], p[2 * ks + 1][1]); w.w = pack2(p[2 * ks + 1][2], p[2 * ks + 1][3]);
        pf[ks] = __builtin_bit_cast(bf16x8, w);
    }
}
template <int QM = 3>
DI void nsa_pv(f32x4 (&O)[2][4], const bf16_t* sV, const bf16x8 (&pf)[2][2], int lane) {
    const int qd = lane >> 4;
#pragma unroll
    for (int dt = 0; dt < 4; ++dt)
#pragma unroll
        for (int ks = 0; ks < 2; ++ks) {
            const bf16_t* vp = sV + (16 * dt + (lane & 15)) * TS + 32 * ks + 4 * qd;
            const u32x2 a = *(const u32x2*)vp, b = *(const u32x2*)(vp + 16);
            u32x4 w; w.x = a.x; w.y = a.y; w.z = b.x; w.w = b.y;
            const bf16x8 vf = __builtin_bit_cast(bf16x8, w);
#pragma unroll
            for (int qi = 0; qi < 2; ++qi) if ((QM >> qi) & 1) O[qi][dt] = __builtin_amdgcn_mfma_f32_16x16x32_bf16(vf, pf[qi][ks], O[qi][dt], 0, 0, 0);
        }
}
template <int MODE, int QM = 3>
DI void nsa_tile(f32x4 (&O)[2][4], NsaLane& L, const bf16x8 (&qf)[2][2], const unsigned char* lds, int buf, int pos0, bool sel0, bool sel1, int lane) {
    const bf16_t* sK = (const bf16_t*)(lds + NSA_K0) + buf * 64 * TS;
    const bf16_t* sV = (const bf16_t*)(lds + NSA_V0) + buf * 64 * TS;
    const float* biasT = (const float*)(lds + NSA_BIAS);
    f32x4 s[2][4];
    nsa_qk<QM>(s, sK, qf, lane);
    bf16x8 pf[2][2];
#pragma unroll
    for (int qi = 0; qi < 2; ++qi) if ((QM >> qi) & 1) {
        float x[4][4];
        nsa_logits<MODE>(x, s[qi], L.tq[qi], L.h, L.cbias, qi ? sel1 : sel0, pos0, lane >> 4, biasT);
        nsa_softmax(x, L.m[qi], L.l[qi], O[qi], pf[qi]);
    }
    nsa_pv<QM>(O, sV, pf, lane);
}
template <int MODE>
DI void nsa_tile_sel(f32x4 (&O)[2][4], NsaLane& L, const bf16x8 (&qf)[2][2], const unsigned char* lds, int buf, int pos0, bool sel0, bool sel1, int lane) {
    const bool a0 = __ballot(sel0) != 0ull, a1 = __ballot(sel1) != 0ull;
    if (a0 && a1) nsa_tile<MODE, 3>(O, L, qf, lds, buf, pos0, sel0, sel1, lane);
    else if (a0) nsa_tile<MODE, 1>(O, L, qf, lds, buf, pos0, sel0, sel1, lane);
    else if (a1) nsa_tile<MODE, 2>(O, L, qf, lds, buf, pos0, sel0, sel1, lane);
}
DI void nsa_flush(f32x4 (&Y)[2][4], f32x4 (&O)[2][4], NsaLane& L, const float (&gate)[2]) {
#pragma unroll
    for (int qi = 0; qi < 2; ++qi) {
        const float lt = quad16_sum(L.l[qi]);
        const float f = (lt > 0.f) ? gate[qi] * __builtin_amdgcn_rcpf(lt) : 0.f;
#pragma unroll
        for (int dt = 0; dt < 4; ++dt) { Y[qi][dt] += O[qi][dt] * f; O[qi][dt] = (f32x4){0.f, 0.f, 0.f, 0.f}; }
    }
}
DI void nsa_item(const Ctx& c, int item, unsigned char* lds) {
    const int tid = TID(), lane = tid & 63, wave = tid >> 6, qd = lane >> 4;
    const int b = item >> 8, g = (item >> 6) & 3, qt = item & 63, t0 = qt * 64, cur = qt, bg = b * 4 + g;
    float* biasT = (float*)(lds + NSA_BIAS);
    unsigned long long* selm = (unsigned long long*)(lds + NSA_SELM);
    float* scr = (float*)(lds + NSA_SCR) + wave * 64;
    float* impA = (float*)(lds + NSA_A); float* impB = (float*)(lds + NSA_B);
    __syncthreads();
    for (int i = tid; i < 129 * 4; i += NTHREADS) { const int d = i >> 2, h = i & 3; biasT[i] = c.in(I_RELB)[t5_bucket(d) * 16 + g * 4 + h]; }
    for (int i = tid; i < 2 * 4096; i += NTHREADS) impA[i] = 0.f;
    NsaLane L; L.h = lane & 3;
    bf16x8 qf[2][2]; float gates[2][3];
    const bf16_t* pbat = c.PROJ + (size_t)b * SEQ * IN_COLS;
#pragma unroll
    for (int qi = 0; qi < 2; ++qi) {
        const int tl = 8 * wave + 4 * qi + ((lane & 15) >> 2);
        L.tq[qi] = t0 + tl;
        const bf16_t* prow = pbat + (size_t)L.tq[qi] * IN_COLS;
#pragma unroll
        for (int ks = 0; ks < 2; ++ks) {
            u32x4 w = *(const u32x4*)(prow + C_Q + (g * 4 + L.h) * 64 + 32 * ks + qd * 8);
            w.x = pack2(bflo(w.x) * 0.125f, bfhi(w.x) * 0.125f); w.y = pack2(bflo(w.y) * 0.125f, bfhi(w.y) * 0.125f);
            w.z = pack2(bflo(w.z) * 0.125f, bfhi(w.z) * 0.125f); w.w = pack2(bflo(w.w) * 0.125f, bfhi(w.w) * 0.125f);
            qf[qi][ks] = __builtin_bit_cast(bf16x8, w);
        }
#pragma unroll
        for (int br = 0; br < 3; ++br) gates[qi][br] = sigmoidf_(bf2f(prow[C_GATE + g * 12 + L.h * 3 + br]));
    }
    __syncthreads();
    L.cbias = biasT[128 * 4 + L.h];
    f32x4 O[2][4], Y[2][4];
#pragma unroll
    for (int qi = 0; qi < 2; ++qi)
#pragma unroll
        for (int dt = 0; dt < 4; ++dt) { O[qi][dt] = (f32x4){0.f, 0.f, 0.f, 0.f}; Y[qi][dt] = (f32x4){0.f, 0.f, 0.f, 0.f}; }
    u32x4 rk, rv;
    const int nvis_max = (t0 + 63 >= 31) ? ((t0 + 63 - 31) >> 4) + 1 : 0;
    const int ncb = (nvis_max + 63) >> 6;
    const bf16_t* kcb = c.KC + (size_t)bg * 256 * 64; const bf16_t* vcb = c.VCT + (size_t)bg * 64 * 256;
    L.m[0] = L.m[1] = -INFINITY; L.l[0] = L.l[1] = 0.f;
    if (ncb > 0) nsa_prefetch(rk, rv, kcb, 64, vcb, 256, 0, tid);
    for (int cb = 0; cb < ncb; ++cb) {
        nsa_store(lds, cb & 1, rk, rv, tid);
        __syncthreads();
        if (cb + 1 < ncb) nsa_prefetch(rk, rv, kcb, 64, vcb, 256, (cb + 1) * 64, tid);
        if (16 * (cb * 64 + 63) + 31 + 128 <= t0) nsa_tile<1>(O, L, qf, lds, cb & 1, cb * 64, true, true, lane);
        else nsa_tile<0>(O, L, qf, lds, cb & 1, cb * 64, true, true, lane);
    }
    if (ncb > 0) nsa_prefetch(rk, rv, kcb, 64, vcb, 256, 0, tid);
    float mfin[2], linv[2];
#pragma unroll
    for (int qi = 0; qi < 2; ++qi) { mfin[qi] = L.m[qi]; const float lt = quad16_sum(L.l[qi]); linv[qi] = (lt > 0.f) ? __builtin_amdgcn_rcpf(lt) : 0.f; }
    { const float gg[2] = {gates[0][0], gates[1][0]}; nsa_flush(Y, O, L, gg); }
    __syncthreads();
    for (int cb = 0; cb < ncb; ++cb) {
        nsa_store(lds, cb & 1, rk, rv, tid);
        __syncthreads();
        if (cb + 1 < ncb) nsa_prefetch(rk, rv, kcb, 64, vcb, 256, (cb + 1) * 64, tid);
        const bf16_t* sK = (const bf16_t*)(lds + NSA_K0) + (cb & 1) * 64 * TS;
        f32x4 s[2][4];
        nsa_qk(s, sK, qf, lane);
#pragma unroll
        for (int qi = 0; qi < 2; ++qi) {
            float x[4][4];
            nsa_logits<0>(x, s[qi], L.tq[qi], L.h, L.cbias, true, cb * 64, qd, biasT);
            const float mu = (mfin[qi] == -INFINITY) ? 0.f : mfin[qi];
#pragma unroll
            for (int kt = 0; kt < 4; ++kt) {
                float p3 = __expf(x[kt][3] - mu) * linv[qi];
                float pa = (__expf(x[kt][0] - mu) + __expf(x[kt][1] - mu) + __expf(x[kt][2] - mu)) * linv[qi] + p3;
                pa += __shfl_xor(pa, 1); p3 += __shfl_xor(p3, 1);
                pa += __shfl_xor(pa, 2); p3 += __shfl_xor(p3, 2);
                if (L.h == 0) { const int tl = 8 * wave + 4 * qi + ((lane & 15) >> 2), mi = 16 * cb + 4 * kt + qd; impA[tl * 64 + mi] = pa; impB[tl * 64 + mi] = p3; }
            }
        }
    }
    const bf16_t* ksb = pbat + C_KS + g * 64; const bf16_t* vsb = c.VT + ((size_t)0 * 16 + bg) * 64 * SEQ;
    nsa_prefetch(rk, rv, ksb, IN_COLS, vsb, SEQ, 0, tid);
    __syncthreads();
    for (int tl8 = 0; tl8 < 8; ++tl8) {
        const int tl = 8 * wave + tl8, n = lane;
        const bool cand = (n >= 1) && (n <= cur - 2);
        const float imp = cand ? impA[tl * 64 + n] + impB[tl * 64 + n - 1] : -1.0f;
        LDS_WAVE_SYNC();
        scr[n] = imp;
        LDS_WAVE_SYNC();
        int rank = 0;
#pragma unroll 4
        for (int q4 = 0; q4 < 16; ++q4) {
            const f32x4 o = *(const f32x4*)(scr + q4 * 4);
#pragma unroll
            for (int j = 0; j < 4; ++j) { const int n2 = q4 * 4 + j; rank += (o[j] > imp || (o[j] == imp && n2 < n)) ? 1 : 0; }
        }
        const bool forced = (n <= cur) && (n == 0 || n == cur || n == cur - 1);
        const unsigned long long msk = __ballot((cand && rank < 5) || forced);
        if (lane == 0) selm[tl] = msk;
    }
    __syncthreads();
    unsigned long long uni = selm[lane];
#pragma unroll
    for (int o = 32; o >= 1; o >>= 1) { const unsigned lo_ = __shfl_xor((unsigned)uni, o), hi_ = __shfl_xor((unsigned)(uni >> 32), o); uni |= ((unsigned long long)hi_ << 32) | lo_; }
    uni = ((unsigned long long)__builtin_amdgcn_readfirstlane((unsigned)(uni >> 32)) << 32) | (unsigned)__builtin_amdgcn_readfirstlane((unsigned)uni);
    unsigned long long sm[2];
#pragma unroll
    for (int qi = 0; qi < 2; ++qi) sm[qi] = selm[8 * wave + 4 * qi + ((lane & 15) >> 2)];
    L.m[0] = L.m[1] = -INFINITY; L.l[0] = L.l[1] = 0.f;
    {
        unsigned long long rem = uni; int it = 0;
        int j = (int)__builtin_ctzll(rem); rem &= rem - 1;
        for (;;) {
            nsa_store(lds, it & 1, rk, rv, tid);
            __syncthreads();
            const int jn = rem ? (int)__builtin_ctzll(rem) : -1;
            if (jn >= 0) { rem &= rem - 1; nsa_prefetch(rk, rv, ksb, IN_COLS, vsb, SEQ, jn * 64, tid); }
            const bool s0 = (sm[0] >> j) & 1ull, s1 = (sm[1] >> j) & 1ull;
            if (j <= cur - 3) nsa_tile_sel<1>(O, L, qf, lds, it & 1, j * 64, s0, s1, lane);
            else nsa_tile_sel<2>(O, L, qf, lds, it & 1, j * 64, s0, s1, lane);
            if (jn < 0) break;
            j = jn; ++it;
        }
    }
    const bf16_t* kwb = pbat + C_KW + g * 64; const bf16_t* vwb = c.VT + ((size_t)1 * 16 + bg) * 64 * SEQ;
    const int j0 = (cur - 8 > 0) ? cur - 8 : 0;
    nsa_prefetch(rk, rv, kwb, IN_COLS, vwb, SEQ, j0 * 64, tid);
    { const float gg[2] = {gates[0][1], gates[1][1]}; nsa_flush(Y, O, L, gg); }
    L.m[0] = L.m[1] = -INFINITY; L.l[0] = L.l[1] = 0.f;
    {
        __syncthreads();
        for (int j = j0; j <= cur; ++j) {
            nsa_store(lds, (j - j0) & 1, rk, rv, tid);
            __syncthreads();
            if (j + 1 <= cur) nsa_prefetch(rk, rv, kwb, IN_COLS, vwb, SEQ, (j + 1) * 64, tid);
            if (cur - j >= 3 && cur - j <= 7) nsa_tile<1>(O, L, qf, lds, (j - j0) & 1, j * 64, true, true, lane);
            else nsa_tile<3>(O, L, qf, lds, (j - j0) & 1, j * 64, true, true, lane);
        }
    }
    { const float gg[2] = {gates[0][2], gates[1][2]}; nsa_flush(Y, O, L, gg); }
#pragma unroll
    for (int qi = 0; qi < 2; ++qi) {
        bf16_t* yrow = c.PROJ + ((size_t)b * SEQ + L.tq[qi]) * IN_COLS + C_Q + (g * 4 + L.h) * 64;
#pragma unroll
        for (int dt = 0; dt < 4; ++dt) store_bf4(yrow + 16 * dt + 4 * qd, Y[qi][dt]);
    }
}
DI void phase_mix(const Ctx& c, unsigned char* lds) {
    const int G = gridDim.x, bid = blockIdx.x;
    const int n_nsa = NB * 4 * (SEQ / 64), n_scan = NB * 8;
    for (int item = bid; item < n_scan; item += G) scan_chunked_item(c, item, lds);
    unsigned* ctr = c.ctl + CW_Q + c.l;
    volatile int* sitem = (volatile int*)(lds + LDS_BYTES - 32);
    for (;;) {
        __syncthreads();
        if (TID() == 0) *sitem = (int)atomicAdd(ctr, 1u);
        __syncthreads();
        const int k = *sitem;
        if (k >= n_nsa) break;
        const int qt = 63 - (k >> 4), bgi = k & 15;
        nsa_item(c, (bgi << 6) | qt, lds);
    }
}

DI void phase_merge(const Ctx& c, unsigned char* lds) {
    const int nN = DM / 256;
    const bf16_t* WM = (const bf16_t*)(c.ws + WS_WT_MG);
    const bf16_t* BR = (const bf16_t*)(c.ws + WS_WT_BR);
    const float* BM_ = c.in(I_BMG) + (size_t)c.l * 3 * DM;
    bf16_t* TMP = c.F + (size_t)2 * NT * 512 + (size_t)blockIdx.x * 256 * 256;
    for (int it = 0;; ++it) {
        int tm, tn; if (!xcd_unit(it, nN, tm, tn)) break;
        const int m0 = tm * 256, n0 = tn * 256;
#pragma unroll 1
        for (int i = 0; i < 3; ++i) {
            f32x4 acc[8][4];
#pragma unroll
            for (int a_ = 0; a_ < 8; ++a_)
#pragma unroll
                for (int b_ = 0; b_ < 4; ++b_) acc[a_][b_] = (f32x4){0.f, 0.f, 0.f, 0.f};
            gemm256_dma(acc, c.H + (size_t)m0 * DM, DM, WM + (size_t)(i * DM + n0) * DM, DM, DM, lds);
            tile256_store_bf16(acc, TMP, 256, 256, lds);
#pragma unroll
            for (int a_ = 0; a_ < 8; ++a_)
#pragma unroll
                for (int b_ = 0; b_ < 4; ++b_) acc[a_][b_] = (f32x4){0.f, 0.f, 0.f, 0.f};
            {
                const bf16_t* Ab = (i == 0) ? c.POOLED + (size_t)m0 * 512 : ((i == 1) ? c.F + (size_t)5 * NT * 512 + (size_t)m0 * 512 : c.PROJ + C_Q + (size_t)m0 * IN_COLS);
                const size_t la = (i == 2) ? (size_t)IN_COLS : (size_t)512;
                const int Kb = (i == 2) ? 1024 : 512;
                gemm256_dma(acc, Ab, la, BR + (size_t)i * 1024 * 512 + (size_t)n0 * Kb, (size_t)Kb, Kb, lds);
            }
            const int lane = TID() & 63, wave = TID() >> 6, wm = wave >> 2, wn = wave & 3;
            const float* bias = BM_ + i * DM + n0;
#pragma unroll
            for (int mi = 0; mi < 8; ++mi) {
#pragma unroll
                for (int ni = 0; ni < 4; ++ni) {
                    const int r = R256(mi), cc = C256(ni);
                    bf16_t* q = c.MERGED + (size_t)(m0 + r) * DM + n0 + cc;
                    const u32x2 gv = *(const u32x2*)(TMP + r * 256 + cc);
                    const f32x4 bb = *(const f32x4*)(bias + cc);
                    f32x4 m4 = (f32x4){0.f, 0.f, 0.f, 0.f};
                    if (i > 0) { const u32x2 pv = *(const u32x2*)q; m4 = (f32x4){bflo(pv.x), bfhi(pv.x), bflo(pv.y), bfhi(pv.y)}; }
                    m4[0] += sigmoidf_(bflo(gv.x) + bb[0]) * acc[mi][ni][0]; m4[1] += sigmoidf_(bfhi(gv.x) + bb[1]) * acc[mi][ni][1];
                    m4[2] += sigmoidf_(bflo(gv.y) + bb[2]) * acc[mi][ni][2]; m4[3] += sigmoidf_(bfhi(gv.y) + bb[3]) * acc[mi][ni][3];
                    store_bf4(q, m4);
                }
                asm volatile("" ::: "memory"); __builtin_amdgcn_sched_barrier(0);
            }
        }
    }
}

DI void phase_outp(const Ctx& c, unsigned char* lds) {
    const int nN = DM / 256;
    const bf16_t* W = (const bf16_t*)(c.ws + WS_WT_OUT);
    const float* xin = (c.l == 0) ? c.in(I_X) : c.out;
    for (int it = 0;; ++it) {
        int tm, tn; if (!xcd_unit(it, nN, tm, tn)) break;
        const int m0 = tm * 256, n0 = tn * 256;
        f32x4 acc[8][4];
#pragma unroll
        for (int i = 0; i < 8; ++i)
#pragma unroll
            for (int j = 0; j < 4; ++j) acc[i][j] = (f32x4){0.f, 0.f, 0.f, 0.f};
        gemm256_dma(acc, c.MERGED + (size_t)m0 * DM, DM, W + (size_t)n0 * DM, DM, DM, lds);
        const int lane = TID() & 63, wave = TID() >> 6, wm = wave >> 2, wn = wave & 3;
#pragma unroll
        for (int mi = 0; mi < 8; ++mi)
#pragma unroll
            for (int ni = 0; ni < 4; ++ni) {
                const size_t o = (size_t)(m0 + R256(mi)) * DM + n0 + C256(ni);
                const f32x4 x = *(const f32x4*)(xin + o); *(f32x4*)(c.out + o) = x + acc[mi][ni];
            }
    }
    for (int it = blockIdx.x * 4; it < 3 * 32 * 64; it += gridDim.x * 4) {
        const int mat = it / 2048, e = (it >> 6) & 31, tl = it & 63;
        if (mat == 0) convert_tile4(c.in(I_EG) + ((size_t)c.l * 32 + e) * DM * 256, 256, 256, DM, (bf16_t*)(c.ws + WS_EG) + (size_t)e * 256 * DM, tl, lds);
        else if (mat == 1) convert_tile4(c.in(I_EU) + ((size_t)c.l * 32 + e) * DM * 256, 256, 256, DM, (bf16_t*)(c.ws + WS_EU) + (size_t)e * 256 * DM, tl, lds);
        else convert_tile4(c.in(I_ED) + ((size_t)c.l * 32 + e) * 256 * DM, DM, DM, 256, (bf16_t*)(c.ws + WS_ED) + (size_t)e * DM * 256, tl, lds);
    }
}

DI void phase_norm2(const Ctx& c, unsigned char* lds) {
    const int tid = TID(), lane = tid & 63, wave = tid >> 6;
    const float* gain = c.in(I_NFFN) + c.l * DM;
    const float* wrg = c.in(I_WRG) + (size_t)c.l * DM * 4; const float* brg = c.in(I_BRG) + c.l * 4;
    const float* wre = c.in(I_WRE) + (size_t)c.l * DM * 32; const float* bre = c.in(I_BRE) + c.l * 32;
    unsigned* cnt = c.ctl + CW_CNT + c.l * 32;
    float* lg = (float*)lds + wave * 16 * 48;
    if (wave < 4)
    for (int rt = blockIdx.x * 4 + wave; rt < NT / 16; rt += gridDim.x * 4) {
        const int r0 = rt * 16;
        float my_rs = 0.f;
#pragma unroll 2
        for (int rr = 0; rr < 16; ++rr) {
            const size_t ro = (size_t)(r0 + rr) * DM;
            f32x4 v[4]; float ss = 0.f;
#pragma unroll
            for (int i = 0; i < 4; ++i) { v[i] = *(const f32x4*)(c.out + ro + i * 256 + lane * 4); ss += v[i][0] * v[i][0] + v[i][1] * v[i][1] + v[i][2] * v[i][2] + v[i][3] * v[i][3]; }
            ss = wave_sum_dpp(ss);
            const float rs = rsqrtf(ss * (1.0f / DM) + 1e-6f);
            if ((lane & 15) == rr) my_rs = rs;
#pragma unroll
            for (int i = 0; i < 4; ++i) {
                const f32x4 g = *(const f32x4*)(gain + i * 256 + lane * 4);
                store_bf4(c.H + ro + i * 256 + lane * 4, (f32x4){v[i][0] * rs * g[0], v[i][1] * rs * g[1], v[i][2] * rs * g[2], v[i][3] * rs * g[3]});
            }
        }
        f32x4 acc0 = (f32x4){0.f, 0.f, 0.f, 0.f}, acc1 = acc0, acc2 = acc0;
        const float* xr = c.out + (size_t)(r0 + (lane & 15)) * DM + 4 * (lane >> 4);
        const int cl = lane & 15;
#pragma unroll 2
        for (int kb = 0; kb < 64; ++kb) {
            const f32x4 xa = *(const f32x4*)(xr + kb * 16);
            const f32x4 ga = *(const f32x4*)(gain + kb * 16 + 4 * (lane >> 4));
            const int k0 = kb * 16 + 4 * (lane >> 4);
            float b0[4], b1[4], b2[4];
#pragma unroll
            for (int m = 0; m < 4; ++m) { b0[m] = wre[(size_t)(k0 + m) * 32 + cl]; b1[m] = wre[(size_t)(k0 + m) * 32 + 16 + cl]; b2[m] = (cl < 4) ? wrg[(size_t)(k0 + m) * 4 + cl] : 0.f; }
#pragma unroll
            for (int m = 0; m < 4; ++m) {
                const float am = xa[m] * ga[m] * my_rs;
                acc0 = __builtin_amdgcn_mfma_f32_16x16x4f32(am, b0[m], acc0, 0, 0, 0);
                acc1 = __builtin_amdgcn_mfma_f32_16x16x4f32(am, b1[m], acc1, 0, 0, 0);
                acc2 = __builtin_amdgcn_mfma_f32_16x16x4f32(am, b2[m], acc2, 0, 0, 0);
            }
        }
        LDS_WAVE_SYNC();
#pragma unroll
        for (int i = 0; i < 4; ++i) { const int row = 4 * (lane >> 4) + i; lg[row * 48 + cl] = acc0[i]; lg[row * 48 + 16 + cl] = acc1[i]; lg[row * 48 + 32 + cl] = acc2[i]; }
        LDS_WAVE_SYNC();
        if (lane < 16) {
            const float* L = lg + lane * 48;
            float lgp[4];
#pragma unroll
            for (int o = 0; o < 4; ++o) lgp[o] = L[32 + o] + brg[o];
            int grp = 0; float gm = lgp[0];
#pragma unroll
            for (int o = 1; o < 4; ++o) if (lgp[o] > gm) { gm = lgp[o]; grp = o; }
            float gs = 0.f;
#pragma unroll
            for (int o = 0; o < 4; ++o) gs += __expf(lgp[o] - gm);
            const float ptop = 1.0f / gs;
            int i0 = 0; float v0 = -INFINITY; int i1 = 0; float v1 = -INFINITY;
            for (int o = 0; o < 8; ++o) { const float le = L[grp * 8 + o] + bre[grp * 8 + o]; if (le > v0) { v1 = v0; i1 = i0; v0 = le; i0 = o; } else if (le > v1) { v1 = le; i1 = o; } }
            const float e1 = __expf(v1 - v0), inv = 1.0f / (1.0f + e1);
            int* rt_ = c.ROUTE + (size_t)(r0 + lane) * 8;
            const int ex0 = grp * 8 + i0, ex1 = grp * 8 + i1;
            const float w0_ = inv * ptop, w1_ = e1 * inv * ptop;
            const int q0 = (int)atomicAdd(cnt + ex0, 1u), q1 = (int)atomicAdd(cnt + ex1, 1u);
            rt_[0] = ex0; rt_[1] = ex1; ((float*)rt_)[2] = w0_; ((float*)rt_)[3] = w1_; rt_[4] = q0; rt_[5] = q1;
            int* e0p = c.ENT + ((size_t)ex0 * NT + q0) * 2; e0p[0] = r0 + lane; ((float*)e0p)[1] = w0_;
            int* e1p = c.ENT + ((size_t)ex1 * NT + q1) * 2; e1p[0] = r0 + lane; ((float*)e1p)[1] = w1_;
        }
    }
}
DI void moe_tables(const Ctx& c, int* soff, int* stile, int ncol) {
    const unsigned* cnt = c.ctl + CW_CNT + c.l * 32;
    __syncthreads();
    if (TID() == 0) { int s = 0, tt = 0; for (int e = 0; e < 32; ++e) { soff[e] = s; stile[e] = tt; s += (int)cnt[e]; tt += (((int)cnt[e] + 255) >> 8) * ncol; } soff[32] = s; stile[32] = tt; }
    __syncthreads();
}
DI void phase_moe_up(const Ctx& c, unsigned char* lds) {
    int* soff = (int*)(lds + LDS_BYTES - 1024); int* stile = soff + 64;
    moe_tables(c, soff, stile, 1);
    const int total = __builtin_amdgcn_readfirstlane(stile[32]);
    for (int item = blockIdx.x; item < total; item += gridDim.x) {
        int e = 0;
        for (int q = 1; q < 32; ++q) if (stile[q] <= item) e = q;
        e = __builtin_amdgcn_readfirstlane(e);
        const int tm = __builtin_amdgcn_readfirstlane(item - stile[e]);
        const int p0 = __builtin_amdgcn_readfirstlane(soff[e] + tm * 256), pend = __builtin_amdgcn_readfirstlane(soff[e + 1]);
        GatherRows gr; gr.ent = c.ENT + ((size_t)e * NT + (p0 - soff[e])) * 2; gr.n = pend - p0;
        f32x4 acc[8][4];
#pragma unroll
        for (int a_ = 0; a_ < 8; ++a_)
#pragma unroll
            for (int b_ = 0; b_ < 4; ++b_) acc[a_][b_] = (f32x4){0.f, 0.f, 0.f, 0.f};
        gemm256_dma(acc, c.H, DM, (const bf16_t*)(c.ws + WS_EG) + (size_t)e * 256 * DM, DM, DM, lds, &gr);
        { const int lane = TID() & 63, wave = TID() >> 6, wm = wave >> 2, wn = wave & 3;
#pragma unroll
        for (int mi = 0; mi < 8; ++mi)
#pragma unroll
            for (int ni = 0; ni < 4; ++ni) {
                const int r = R256(mi), cc = C256(ni);
                const f32x4 g4 = acc[mi][ni];
                if (p0 + r < pend) store_bf4(c.HID + (size_t)(p0 + r) * 256 + cc, (f32x4){g4[0] * sigmoidf_(g4[0]), g4[1] * sigmoidf_(g4[1]), g4[2] * sigmoidf_(g4[2]), g4[3] * sigmoidf_(g4[3])});
                acc[mi][ni] = (f32x4){0.f, 0.f, 0.f, 0.f};
            }
        }
        gemm256_dma(acc, c.H, DM, (const bf16_t*)(c.ws + WS_EU) + (size_t)e * 256 * DM, DM, DM, lds, &gr);
        const int lane = TID() & 63, wave = TID() >> 6, wm = wave >> 2, wn = wave & 3;
#pragma unroll
        for (int mi = 0; mi < 8; ++mi) {
#pragma unroll
            for (int ni = 0; ni < 4; ++ni) {
                const int r = R256(mi), cc = C256(ni);
                if (p0 + r < pend) { bf16_t* q = c.HID + (size_t)(p0 + r) * 256 + cc; const u32x2 sv = *(const u32x2*)q;
                    store_bf4(q, (f32x4){bflo(sv.x) * acc[mi][ni][0], bfhi(sv.x) * acc[mi][ni][1], bflo(sv.y) * acc[mi][ni][2], bfhi(sv.y) * acc[mi][ni][3]}); }
            }
            asm volatile("" ::: "memory"); __builtin_amdgcn_sched_barrier(0);
        }
    }
}
DI void phase_moe_down(const Ctx& c, unsigned char* lds) {
    int* soff = (int*)(lds + LDS_BYTES - 1024); int* stile = soff + 64;
    moe_tables(c, soff, stile, 4);
    const int total = __builtin_amdgcn_readfirstlane(stile[32]);
    for (int item = blockIdx.x; item < total; item += gridDim.x) {
        int e = 0;
        for (int q = 1; q < 32; ++q) if (stile[q] <= item) e = q;
        e = __builtin_amdgcn_readfirstlane(e);
        const int loc = __builtin_amdgcn_readfirstlane(item - stile[e]), tm = loc >> 2, tn = loc & 3, n0 = tn * 256;
        const int p0 = __builtin_amdgcn_readfirstlane(soff[e] + tm * 256), pend = __builtin_amdgcn_readfirstlane(soff[e + 1]);
        f32x4 acc[8][4];
#pragma unroll
        for (int a_ = 0; a_ < 8; ++a_)
#pragma unroll
            for (int b_ = 0; b_ < 4; ++b_) acc[a_][b_] = (f32x4){0.f, 0.f, 0.f, 0.f};
        gemm256_dma(acc, c.HID + (size_t)p0 * 256, 256, (const bf16_t*)(c.ws + WS_ED) + ((size_t)e * DM + n0) * 256, 256, 256, lds);
        const int lane = TID() & 63, wave = TID() >> 6, wm = wave >> 2, wn = wave & 3;
        const float* wl = (const float*)c.ENT + ((size_t)e * NT + (p0 - soff[e])) * 2 + 1;
#pragma unroll
        for (int mi = 0; mi < 8; ++mi)
#pragma unroll
            for (int ni = 0; ni < 4; ++ni) {
                const int r = R256(mi), cc = C256(ni);
                if (p0 + r < pend) { const float w = wl[2 * r];
                    store_bf4(c.Y + (size_t)(p0 + r) * DM + n0 + cc, (f32x4){acc[mi][ni][0] * w, acc[mi][ni][1] * w, acc[mi][ni][2] * w, acc[mi][ni][3] * w}); }
            }
    }
}
DI void phase_final(const Ctx& c, unsigned char* lds) {
    const int tid = TID(), lane = tid & 63, wave = tid >> 6;
    const float* gain = c.in(I_NFIN);
    int* soff = (int*)(lds + 65536);
    moe_offsets(c, DEPTH - 1, soff);
    for (int row = blockIdx.x * 8 + wave; row < NT; row += gridDim.x * 8) {
        f32x4 v[4];
#pragma unroll
        for (int i = 0; i < 4; ++i) v[i] = *(const f32x4*)(c.out + (size_t)row * DM + i * 256 + lane * 4);
        add_moe_rows(c, row, lane, v, soff);
        float ss = 0.f;
#pragma unroll
        for (int i = 0; i < 4; ++i) ss += v[i][0] * v[i][0] + v[i][1] * v[i][1] + v[i][2] * v[i][2] + v[i][3] * v[i][3];
        ss = wave_sum_dpp(ss);
        const float rs = rsqrtf(ss * (1.0f / DM) + 1e-6f);
#pragma unroll
        for (int i = 0; i < 4; ++i) {
            const f32x4 g = *(const f32x4*)(gain + i * 256 + lane * 4);
            *(f32x4*)(c.out + (size_t)row * DM + i * 256 + lane * 4) = (f32x4){v[i][0] * rs * g[0], v[i][1] * rs * g[1], v[i][2] * rs * g[2], v[i][3] * rs * g[3]};
        }
    }
}

constexpr int PH_PER_LAYER = 11, N_PHASES = DEPTH * PH_PER_LAYER + 1;
__global__ void __launch_bounds__(NTHREADS, 2) fwd_kernel(Params P) {
    extern __shared__ __attribute__((aligned(16))) unsigned char lds[];
    const int lo = P.ph_lo, hi = P.ph_hi;
    LAS unsigned* xbw = (LAS unsigned*)(lds + LDS_BYTES - 16);
    if (threadIdx.x == 0) { xbw[0] = 0u; xbw[1] = 0u; xbw[2] = 0u; xbw[3] = 0u; }
    __syncthreads();
    Ctx c; c.P = &P; c.ws = P.ws; c.out = P.out; c.l = 0;
    c.ctl = (unsigned*)(P.ws + WS_CTL);
    c.H = (bf16_t*)(P.ws + WS_H); c.PROJ = (bf16_t*)(P.ws + WS_PROJ); c.F = (bf16_t*)(P.ws + WS_F); c.POOLED = (bf16_t*)(P.ws + WS_POOLED);
    c.MERGED = (bf16_t*)(P.ws + WS_F); c.CMPH = (bf16_t*)(P.ws + WS_CMPH); c.CMPO = (float*)(P.ws + WS_CMPO); c.POSB = (float*)(P.ws + WS_POSB);
    c.ROUTE = (int*)(P.ws + WS_ROUTE); c.ENT = (int*)(P.ws + WS_ENT); c.HID = (bf16_t*)(P.ws + WS_HID); c.Y = (bf16_t*)(P.ws + WS_Y);
    c.VT = (bf16_t*)(P.ws + WS_VT); c.KC = (bf16_t*)(P.ws + WS_KC); c.VCT = (bf16_t*)(P.ws + WS_VCT); c.YRAW = (bf16_t*)(P.ws + WS_YRAW); c.BON = (float*)(P.ws + WS_BON);
    XcdBarrier bar; bar.bar = c.ctl + CW_BAR; bar.x = 0; bar.st = (volatile LAS unsigned*)xbw;
    if (hi - lo > 1) bar = xcd_barrier_post(c.ctl + CW_BAR, (volatile LAS unsigned*)xbw);
#define IN(k) (lo <= (k) && (k) < hi)
#define SEAM(k) do { if (IN(k) && IN((k) + 1)) xcd_barrier(bar); } while (0)
#pragma unroll 1
    for (int l = 0; l < DEPTH; ++l) {
        c.l = l; const int pb = l * PH_PER_LAYER;
        if (IN(pb + 0)) phase_norm1(c, lds);
        SEAM(pb + 0);
        if (IN(pb + 1)) phase_gemm1(c, lds);
        SEAM(pb + 1);
        if (IN(pb + 2)) phase_prep(c, lds);
        SEAM(pb + 2);
        if (IN(pb + 3)) phase_poolgemm(c, lds);
        SEAM(pb + 3);
        if (IN(pb + 4)) phase_mix(c, lds);
        SEAM(pb + 4);
        if (IN(pb + 5)) phase_rwkv_post(c, lds);
        SEAM(pb + 5);
        if (IN(pb + 6)) phase_merge(c, lds);
        SEAM(pb + 6);
        if (IN(pb + 7)) phase_outp(c, lds);
        SEAM(pb + 7);
        if (IN(pb + 8)) phase_norm2(c, lds);
        SEAM(pb + 8);
        if (IN(pb + 9)) phase_moe_up(c, lds);
        SEAM(pb + 9);
        if (IN(pb + 10)) phase_moe_down(c, lds);
        SEAM(pb + 10);
    }
    if (IN(N_PHASES - 1)) phase_final(c, lds);
}

#ifndef MK_N_LAUNCHES
#define MK_N_LAUNCHES 1
#endif
extern "C" void kernel_launch(void* const* d_in, const int* in_sizes, int n_in, void* d_out, int out_size, void* d_ws, size_t ws_size, hipStream_t stream) {
    static int grid = 0;
    if (grid == 0) {
        if (n_in != N_IN || out_size != NT * DM || ws_size < WS_END) { fprintf(stderr, "kernel_launch: unexpected shapes n_in %d out %d ws %zu (need %zu)\n", n_in, out_size, ws_size, (size_t)WS_END); grid = -1; return; }
        int dev = 0, cus = 0, per_cu = 0;
        if (hipGetDevice(&dev) != hipSuccess || hipDeviceGetAttribute(&cus, hipDeviceAttributeMultiprocessorCount, dev) != hipSuccess) { grid = -1; return; }
        if (hipFuncSetAttribute((const void*)fwd_kernel, hipFuncAttributeMaxDynamicSharedMemorySize, LDS_BYTES) != hipSuccess) { fprintf(stderr, "kernel_launch: hipFuncSetAttribute failed\n"); grid = -1; return; }
        if (hipOccupancyMaxActiveBlocksPerMultiprocessor(&per_cu, (const void*)fwd_kernel, NTHREADS, LDS_BYTES) != hipSuccess || per_cu < 1) { fprintf(stderr, "kernel_launch: occupancy query says %d\n", per_cu); }
        (void)hipGetLastError();
        grid = cus;
    }
    if (grid < 0) return;
    if (hipMemsetAsync((char*)d_ws + WS_CTL, 0, CTL_BYTES, stream) != hipSuccess) return;
    Params p{};
    for (int i = 0; i < N_IN; ++i) p.in[i] = (const float*)d_in[i];
    p.out = (float*)d_out; p.ws = (unsigned char*)d_ws;
    if (MK_N_LAUNCHES == 1) {
        p.ph_lo = 0; p.ph_hi = N_PHASES;
        hipLaunchKernelGGL(fwd_kernel, dim3(grid), dim3(NTHREADS), LDS_BYTES, stream, p);
    } else {
        for (int k = 0; k < N_PHASES; ++k) { p.ph_lo = k; p.ph_hi = k + 1; hipLaunchKernelGGL(fwd_kernel, dim3(grid), dim3(NTHREADS), LDS_BYTES, stream, p); }
    }
}
```

```cpp
#include <hip/hip_runtime.h>
#include <cstdio>
#include <cstdint>

#define DI __device__ __forceinline__
typedef unsigned short bf16_t;
typedef short bf16x8 __attribute__((ext_vector_type(8)));
typedef float f32x4 __attribute__((ext_vector_type(4)));
typedef unsigned u32x4 __attribute__((ext_vector_type(4)));
typedef unsigned u32x2 __attribute__((ext_vector_type(2)));

constexpr int NB = 4, SEQ = 4096, DM = 1024, NT = NB * SEQ, DEPTH = 2;
constexpr int IN_COLS = 4816;
constexpr int C_POOL = 0, C_RW = 512, C_R = 512, C_K = 1024, C_V = 1536, C_WD = 2048, C_AD = 2080, C_GD = 2112;
constexpr int C_Q = 2208, C_KC = 3232, C_VC = 3488, C_KS = 3744, C_VS = 4000, C_KW = 4256, C_VW = 4512, C_GATE = 4768;
constexpr int RWC = 1696;
constexpr int NCMP = 255;
constexpr int NTHREADS = 512;
constexpr int LDS_BYTES = 155648;

enum { I_X = 0, I_RELB, I_NMIX, I_WIN, I_POOLW, I_POOLS, I_MU, I_W0, I_WUP, I_A0, I_AUP, I_GUP, I_KK, I_KA, I_RK, I_GNW, I_GNB,
       I_CPK, I_CW1K, I_CW2K, I_CPV, I_CW1V, I_CW2V, I_WBR, I_WMG, I_BMG, I_WOUT, I_NFFN, I_WRG, I_BRG, I_WRE, I_BRE, I_EG, I_EU, I_ED, I_NFIN, N_IN };

constexpr size_t WS_CTL = 0;
constexpr size_t CTL_BYTES = 65536;
constexpr size_t WS_H = CTL_BYTES;
constexpr size_t WS_PROJ = WS_H + (size_t)NT * DM * 2;
constexpr size_t WS_F = WS_PROJ + (size_t)NT * IN_COLS * 2;
constexpr size_t PLANE = (size_t)NT * 512 * 2;
constexpr size_t WS_POOLED = WS_F + 6 * PLANE;
constexpr size_t WS_CMPH = WS_POOLED + PLANE;
constexpr size_t WS_CMPO = WS_CMPH + (size_t)2 * 4096 * 256 * 2;
constexpr size_t WS_POSB = WS_CMPO + (size_t)2 * 4096 * 64 * 4;
constexpr size_t WS_ROUTE = WS_POSB + 4096;
constexpr size_t WS_ENT = WS_ROUTE + (size_t)NT * 32;
constexpr size_t WS_VT = WS_ENT + (size_t)32 * NT * 8;
constexpr size_t WS_KC = WS_VT + (size_t)2 * 16 * 64 * SEQ * 2;
constexpr size_t WS_VCT = WS_KC + (size_t)16 * 256 * 64 * 2;
constexpr size_t WS_YRAW = WS_VCT + (size_t)16 * 64 * 256 * 2;
constexpr size_t WS_BON = WS_YRAW + (size_t)NT * 512 * 2;
constexpr size_t WS_SMALLW = WS_BON + (size_t)NT * 8 * 16;
constexpr size_t WS_WT_LORA = WS_SMALLW + 262144;
constexpr size_t WS_END = WS_WT_LORA + (size_t)1536 * 128 * 2;
constexpr size_t WS_WT_IN = WS_F;
constexpr size_t WS_WT_C1 = WS_CMPO;
constexpr size_t WS_WT_C2 = WS_SMALLW;
constexpr size_t WS_WT_POOL = WS_SMALLW + 131072;
constexpr size_t WS_WT_MG = WS_VT;
constexpr size_t WS_WT_BR = WS_VT + (size_t)3072 * 1024 * 2;
constexpr size_t WS_WT_OUT = WS_CMPH;
constexpr size_t WS_EG = WS_F + 2 * PLANE;
constexpr size_t WS_EU = WS_EG + (size_t)32 * 256 * 1024 * 2;
constexpr size_t WS_ED = WS_EU + (size_t)32 * 256 * 1024 * 2;
static_assert(WS_ED + (size_t)32 * 1024 * 256 * 2 <= WS_F + 6 * PLANE, "expert alias");
static_assert(WS_WT_BR + (size_t)2048 * 1024 * 2 <= WS_VT + (size_t)2 * 16 * 64 * SEQ * 2, "merge alias");
static_assert((size_t)4864 * 1024 * 2 <= 6 * PLANE, "w_in alias");
constexpr size_t WS_HID = WS_PROJ;
constexpr size_t WS_Y = WS_PROJ + (size_t)2 * NT * 256 * 2;
static_assert(WS_Y + (size_t)2 * NT * 1024 * 2 <= WS_F, "alias");
constexpr int CW_BAR = 0;
constexpr int CW_CNT = 4096;
constexpr int CW_CUR = 4096 + 64;
constexpr int CW_Q = 4096 + 128;

#define XB_TMO      128
#define XB_XCNT(j)  (256  + 64 * (j))
#define XB_XSUB(j)  (1280 + 64 * (j))
#define XB_XGEN(j)  (2304 + 64 * (j))
#define XB_TOP      3328
#define XB_TOPGEN   3392
#define XCD_BAR_WORDS 3456
#define XB_SPIN_CAP (1u << 18)
#define LAS __attribute__((address_space(3)))

__device__ __forceinline__ unsigned xb_ld(unsigned* p)              { return __hip_atomic_load(p, __ATOMIC_RELAXED, __HIP_MEMORY_SCOPE_AGENT); }
__device__ __forceinline__ unsigned xb_add(unsigned* p, unsigned v) { return __hip_atomic_fetch_add(p, v, __ATOMIC_RELAXED, __HIP_MEMORY_SCOPE_AGENT); }
__device__ __forceinline__ unsigned xb_xcc_id() { return (unsigned)__builtin_amdgcn_s_getreg((3 << 11) | 20) & 0xFu; }
#define XB_SPIN(cond, bar) do { unsigned _sp = 0; while (cond) { __builtin_amdgcn_s_sleep(1); \
    if ((++_sp & 255u) == 0u) { if (xb_ld(&(bar)[XB_TMO])) break; if (_sp > XB_SPIN_CAP) { atomicAdd(&(bar)[XB_TMO], 1u); break; } } } } while (0)

struct XcdBarrier { unsigned* bar; unsigned x; volatile LAS unsigned* st; };

__device__ __forceinline__ XcdBarrier xcd_barrier_post(unsigned* bar, volatile LAS unsigned* st) {
    XcdBarrier b; b.bar = bar; b.x = xb_xcc_id(); b.st = st;
    if (threadIdx.x == 0) (void)xb_add(&bar[XB_XCNT(b.x)], 1u);
    return b;
}
__device__ __forceinline__ void xcd_barrier_complete(unsigned* bar, unsigned x, unsigned& nloc, unsigned& nx) {
    const unsigned G = gridDim.x * gridDim.y * gridDim.z;
    unsigned sum, cnt, mine, sp = 0u;
    for (;;) {
        sum = 0u; cnt = 0u; mine = 0u;
#pragma unroll
        for (unsigned j = 0; j < 16; ++j) { const unsigned c = xb_ld(&bar[XB_XCNT(j)]); sum += c; cnt += (c > 0u) ? 1u : 0u; mine = (j == x) ? c : mine; }
        if (sum == G) break;
        __builtin_amdgcn_s_sleep(1);
        if ((++sp & 255u) == 0u) { if (xb_ld(&bar[XB_TMO])) break; if (sp > XB_SPIN_CAP) { atomicAdd(&bar[XB_TMO], 1u); break; } }
    }
    nloc = mine > 0u ? mine : 1u; nx = cnt > 0u ? cnt : 1u;
}
__device__ __forceinline__ void xcd_barrier(const XcdBarrier& b) {
    asm volatile("s_waitcnt vmcnt(0)" ::: "memory");
    __syncthreads();
    if (threadIdx.x == 0) {
        unsigned* bar = b.bar;
        __builtin_amdgcn_s_waitcnt(0);
        unsigned nloc = b.st[0], nx = b.st[1];
        if (nloc == 0u) { xcd_barrier_complete(bar, b.x, nloc, nx); b.st[0] = nloc; b.st[1] = nx; }
        const unsigned old = xb_add(&bar[XB_XSUB(b.x)], 1u);
        const unsigned gen = old / nloc;
        if (old + 1u == (gen + 1u) * nloc) {
            __builtin_amdgcn_fence(__ATOMIC_RELEASE, "agent");
            asm volatile("s_waitcnt vmcnt(0)" ::: "memory");
            const unsigned og = xb_add(&bar[XB_TOP], 1u);
            const unsigned tg = og / nx;
            if (og + 1u == (tg + 1u) * nx) xb_add(&bar[XB_TOPGEN], 1u);
            else XB_SPIN(xb_ld(&bar[XB_TOPGEN]) == tg, bar);
            __builtin_amdgcn_fence(__ATOMIC_ACQUIRE, "agent");
            xb_add(&bar[XB_XGEN(b.x)], 1u);
            asm volatile("s_waitcnt vmcnt(0)" ::: "memory");
        } else {
            XB_SPIN(xb_ld(&bar[XB_XGEN(b.x)]) == gen, bar);
            __builtin_amdgcn_fence(__ATOMIC_ACQUIRE, "agent");
            asm volatile("s_waitcnt vmcnt(0)" ::: "memory");
        }
    }
    __syncthreads();
}

DI bf16_t f2bf(float x) { unsigned u = __float_as_uint(x); u += 0x7fffu + ((u >> 16) & 1u); return (bf16_t)(u >> 16); }
DI float bf2f(bf16_t b) { return __uint_as_float((unsigned)b << 16); }
typedef __bf16 bf16v2_t __attribute__((ext_vector_type(2)));
typedef float f32v2_t __attribute__((ext_vector_type(2)));
DI unsigned pack2(float lo, float hi) { const f32v2_t v = {lo, hi}; const bf16v2_t b = __builtin_convertvector(v, bf16v2_t); return __builtin_bit_cast(unsigned, b); }
DI float bflo(unsigned w) { return __uint_as_float(w << 16); }
DI float bfhi(unsigned w) { return __uint_as_float(w & 0xffff0000u); }
DI float wave_sum(float v) {
#pragma unroll
    for (int o = 32; o >= 1; o >>= 1) v += __shfl_xor(v, o);
    return v;
}
DI float wave_max(float v) {
#pragma unroll
    for (int o = 32; o >= 1; o >>= 1) v = fmaxf(v, __shfl_xor(v, o));
    return v;
}
DI float sigmoidf_(float x) { return __builtin_amdgcn_rcpf(1.0f + __expf(-x)); }
DI int TID() { int t = threadIdx.x; asm volatile("" : "+v"(t)); return t; }
#define LDS_WAVE_SYNC() asm volatile("s_waitcnt lgkmcnt(0)" ::: "memory")

#define DPP_MOV(v, ctrl) __builtin_bit_cast(float, __builtin_amdgcn_update_dpp(0, __builtin_bit_cast(int, (v)), (ctrl), 0xF, 0xF, true))
DI float wave_sum_dpp(float v) {
    v += DPP_MOV(v, 0xB1); v += DPP_MOV(v, 0x4E); v += DPP_MOV(v, 0x141); v += DPP_MOV(v, 0x140);
    return __builtin_bit_cast(float, __builtin_amdgcn_readlane(__builtin_bit_cast(int, v), 0)) + __builtin_bit_cast(float, __builtin_amdgcn_readlane(__builtin_bit_cast(int, v), 16)) +
        (__builtin_bit_cast(float, __builtin_amdgcn_readlane(__builtin_bit_cast(int, v), 32)) + __builtin_bit_cast(float, __builtin_amdgcn_readlane(__builtin_bit_cast(int, v), 48)));
}
struct Params { const float* in[N_IN]; float* out; unsigned char* ws; int ph_lo, ph_hi; };

DI int t5_bucket(int n) {
    if (n < 16) return n;
    if (n >= 128) return 31;
    int b = 16;
    b += (n >= 19) + (n >= 21) + (n >= 24) + (n >= 27) + (n >= 31) + (n >= 35) + (n >= 40) + (n >= 46) + (n >= 52) + (n >= 59) + (n >= 67) + (n >= 77) + (n >= 87) + (n >= 99) + (n >= 113);
    return b;
}

constexpr int G_A = 0, G_B = 256 * 64 * 2, G_STAGE = (256 + 128) * 64 * 2;
static_assert(2 * G_STAGE <= LDS_BYTES - 64, "gemm lds");
DI int g_off(int r, int c) { return ((r >> 4) * 2 + (c >> 5)) * 1024 + ((((r & 15) * 64) + (c & 31) * 2) ^ ((((r & 15) >> 3) & 1) << 5)); }
struct ARows { const bf16_t* p[4]; const float* mu; int ltype; int first; };
DI float tanhf_fast(float x) { const float e = __expf(2.0f * x); return 1.0f - 2.0f * __builtin_amdgcn_rcpf(e + 1.0f); }
DI u32x4 lora_chunk(const bf16_t* prow, bool first, const float* mu, int ltype, int k) {
    const int lim = (ltype == 2) ? 96 : 32;
    if (k >= lim) return (u32x4){0u, 0u, 0u, 0u};
    const int col = C_WD + ltype * 32 + k;
    const u32x4 cu = *(const u32x4*)(prow + col);
    u32x4 pu = (u32x4){0u, 0u, 0u, 0u};
    if (!first) pu = *(const u32x4*)(prow - IN_COLS + col);
    const f32x4 m0 = *(const f32x4*)(mu + col - C_RW), m1 = *(const f32x4*)(mu + col - C_RW + 4);
    float u[8] = {bflo(cu.x), bfhi(cu.x), bflo(cu.y), bfhi(cu.y), bflo(cu.z), bfhi(cu.z), bflo(cu.w), bfhi(cu.w)};
    const float p[8] = {bflo(pu.x), bfhi(pu.x), bflo(pu.y), bfhi(pu.y), bflo(pu.z), bfhi(pu.z), bflo(pu.w), bfhi(pu.w)};
    const float mm[8] = {m0[0], m0[1], m0[2], m0[3], m1[0], m1[1], m1[2], m1[3]};
#pragma unroll
    for (int j = 0; j < 8; ++j) { const float us = u[j] + (p[j] - u[j]) * mm[j]; u[j] = (ltype == 0) ? tanhf_fast(us) : ((ltype == 1) ? us : __builtin_amdgcn_rcpf(1.0f + __expf(-us))); }
    u32x4 w; w.x = pack2(u[0], u[1]); w.y = pack2(u[2], u[3]); w.z = pack2(u[4], u[5]); w.w = pack2(u[6], u[7]);
    return w;
}
template <int AMODE>
DI void g_load(u32x4 (&ra)[4], u32x4 (&rb)[2], const ARows& ar, const bf16_t* bt, int ldb, int k0, int tid) {
    const int kseg = (tid & 7) * 8;
#pragma unroll
    for (int i = 0; i < 4; ++i) {
        ra[i] = (u32x4){0u, 0u, 0u, 0u};
        if (AMODE == 2) ra[i] = lora_chunk(ar.p[i], (ar.first >> i) & 1, ar.mu, ar.ltype, k0 + kseg);
        else if (ar.p[i] != nullptr) ra[i] = *(const u32x4*)((AMODE == 0) ? (ar.p[i] + k0 + kseg) : (ar.p[i] + (size_t)(k0 >> 6) * IN_COLS + kseg));
    }
#pragma unroll
    for (int i = 0; i < 2; ++i) rb[i] = *(const u32x4*)(bt + (size_t)((tid >> 3) + 64 * i) * ldb + k0 + kseg);
}
DI void g_store(unsigned char* st, const u32x4 (&ra)[4], const u32x4 (&rb)[2], int tid) {
    const int off = g_off(tid >> 3, (tid & 7) * 8);
#pragma unroll
    for (int i = 0; i < 4; ++i) *(u32x4*)(st + G_A + off + i * 8192) = ra[i];
#pragma unroll
    for (int i = 0; i < 2; ++i) *(u32x4*)(st + G_B + off + i * 8192) = rb[i];
}
DI void g_compute(f32x4 (&acc)[4][4], const unsigned char* st, int lane, int wm, int wn) {
    const int lo = ((lane & 15) * 64 + (lane >> 4) * 16) ^ ((((lane & 15) >> 3) & 1) << 5);
    const unsigned char* sA = st + G_A + wm * 8192 + lo;
    const unsigned char* sB = st + G_B + wn * 8192 + lo;
    bf16x8 bcur[4], bnxt[4], a0, a1, a2;
#pragma unroll
    for (int i = 0; i < 4; ++i) bcur[i] = *(const bf16x8*)(sB + i * 2048);
    a0 = *(const bf16x8*)(sA);
    a1 = *(const bf16x8*)(sA + 2048);
#define G_AFRAG(s) (*(const bf16x8*)(sA + ((s) & 3) * 2048 + ((s) >> 2) * 1024))
#define G_GROUP(s, acur, anew) do { \
        if ((s) + 2 < 8) anew = G_AFRAG((s) + 2); \
        if ((s) < 4) bnxt[(s) & 3] = *(const bf16x8*)(sB + ((s) & 3) * 2048 + 1024); \
        __builtin_amdgcn_sched_barrier(0); \
        _Pragma("unroll") for (int ni = 0; ni < 4; ++ni) acc[(s) & 3][ni] = __builtin_amdgcn_mfma_f32_16x16x32_bf16(((s) < 4 ? bcur[ni] : bnxt[ni]), acur, acc[(s) & 3][ni], 0, 0, 0); \
        __builtin_amdgcn_sched_barrier(0); } while (0)
    G_GROUP(0, a0, a2); G_GROUP(1, a1, a0); G_GROUP(2, a2, a1); G_GROUP(3, a0, a2);
    G_GROUP(4, a1, a0); G_GROUP(5, a2, a1); G_GROUP(6, a0, a2); G_GROUP(7, a1, a0);
#undef G_GROUP
#undef G_AFRAG
}
#define LDS_BARRIER() do { asm volatile("s_waitcnt lgkmcnt(0)" ::: "memory"); __builtin_amdgcn_s_barrier(); asm volatile("" ::: "memory"); } while (0)
template <int AMODE>
DI void gemm_core(f32x4 (&acc)[4][4], const ARows& ar, const bf16_t* bt  , int ldb, int K, unsigned char* lds) {
    const int tid = TID(), lane = tid & 63, wave = tid >> 6, wm = wave >> 1, wn = wave & 1;
    const int nk = K >> 6;
    unsigned char* s0 = lds; unsigned char* s1 = lds + G_STAGE;
    u32x4 ra0[4], rb0[2], ra1[4], rb1[2];
    g_load<AMODE>(ra0, rb0, ar, bt, ldb, 0, tid);
    g_load<AMODE>(ra1, rb1, ar, bt, ldb, 64, tid);
    __syncthreads();
    g_store(s0, ra0, rb0, tid);
    g_load<AMODE>(ra0, rb0, ar, bt, ldb, (nk > 2 ? 2 : nk - 1) * 64, tid);
    LDS_BARRIER();
    for (int kt = 0; kt < nk; kt += 2) {
        g_store(s1, ra1, rb1, tid);
        { const int kn = (kt + 3 < nk) ? kt + 3 : nk - 1; g_load<AMODE>(ra1, rb1, ar, bt, ldb, kn * 64, tid); }
        g_compute(acc, s0, lane, wm, wn);
        LDS_BARRIER();
        g_store(s0, ra0, rb0, tid);
        { const int kn = (kt + 4 < nk) ? kt + 4 : nk - 1; g_load<AMODE>(ra0, rb0, ar, bt, ldb, kn * 64, tid); }
        g_compute(acc, s1, lane, wm, wn);
        LDS_BARRIER();
    }
}
static_assert(3 * G_STAGE <= LDS_BYTES - 64, "dma ring");
DI void gemm_core_dma(f32x4 (&acc)[4][4], const bf16_t* A, size_t lda, const bf16_t* bt, size_t ldb, int K, unsigned char* lds) {
    const int tid = TID(), lane = tid & 63, wave = __builtin_amdgcn_readfirstlane(tid >> 6), wm = wave >> 1, wn = wave & 1;
    const int nk = K >> 6;
    const int srow = lane >> 2, skof = ((lane & 3) * 8) ^ ((lane >> 5) << 4);
    const char* gp[6]; int loff[6];
#pragma unroll
    for (int j = 0; j < 6; ++j) {
        const int sid = wave * 6 + j;
        if (sid < 32) { gp[j] = (const char*)(A + (size_t)((sid >> 1) * 16 + srow) * lda + (sid & 1) * 32 + skof); loff[j] = G_A + sid * 1024; }
        else { const int s2 = sid - 32; gp[j] = (const char*)(bt + (size_t)((s2 >> 1) * 16 + srow) * ldb + (s2 & 1) * 32 + skof); loff[j] = G_B + s2 * 1024; }
    }
#define DMA_ISSUE(kt_, st_) do { const int _k = ((kt_) < nk ? (kt_) : nk - 1) * 128; \
        _Pragma("unroll") for (int j = 0; j < 6; ++j) __builtin_amdgcn_global_load_lds((const unsigned*)(gp[j] + _k), (LAS unsigned*)(lds + (st_) * G_STAGE + loff[j]), 16, 0, 0); } while (0)
    asm volatile("s_waitcnt vmcnt(0)" ::: "memory");
    __syncthreads();
    DMA_ISSUE(0, 0); DMA_ISSUE(1, 1);
    int st = 0;
    for (int kt = 0; kt < nk; ++kt) {
        asm volatile("s_waitcnt vmcnt(6)" ::: "memory");
        __builtin_amdgcn_s_barrier();
        asm volatile("" ::: "memory");
        const int sn = (st == 0) ? 2 : st - 1;
        DMA_ISSUE(kt + 2, sn);
        g_compute(acc, lds + st * G_STAGE, lane, wm, wn);
        st = (st == 2) ? 0 : st + 1;
    }
    asm volatile("s_waitcnt vmcnt(0)" ::: "memory");
    __syncthreads();
#undef DMA_ISSUE
}
DI void store_bf4(bf16_t* p, f32x4 v) { u32x2 w; w.x = pack2(v[0], v[1]); w.y = pack2(v[2], v[3]); *(u32x2*)p = w; }
#define R256(mi) ((((mi) >> 2) * 128) + wm * 64 + (((mi) & 3) * 16) + (lane & 15))
#define C256(ni) ((((ni) >> 1) * 128) + wn * 32 + (((ni) & 1) * 16) + ((lane >> 4) * 4))
constexpr int HTB = 128 * 64 * 2;
static_assert(8 * HTB <= LDS_BYTES - 1024, "gemm256 lds");
DI int lds_byte(int r, int c) { const int st = (r >> 4) * 2 + (c >> 5), rr = r & 15, cc = c & 31, ob = rr * 64 + cc * 2; return st * 1024 + (ob ^ (((ob >> 9) & 1) << 5)); }
DI void stage_rc(int b, int& R, int& C) { const int st = b / 1024, sb = b % 1024, swz = sb ^ (((sb >> 9) & 1) << 5); R = (st >> 1) * 16 + swz / 64; C = (st & 1) * 32 + (swz % 64) / 2; }
struct GatherRows { const int* ent; int n; };
DI void gemm256_dma(f32x4 (&acc)[8][4], const bf16_t* A, size_t lda, const bf16_t* bt, size_t ldb, int K, unsigned char* lds_, const GatherRows* gr = nullptr) {
    LAS unsigned char* lds = (LAS unsigned char*)lds_;
    const int tid = TID(), wid = __builtin_amdgcn_readfirstlane(tid >> 6), lane = tid & 63, wr = wid >> 2, wc = wid & 3, fr = lane & 15, fq = lane >> 4;
    const int nt = K >> 6;
    unsigned voffA[2][2], voffB[2][2];
#pragma unroll
    for (int i = 0; i < 2; ++i) { int R, C; stage_rc(tid * 16 + i * 8192, R, C);
#pragma unroll
        for (int h = 0; h < 2; ++h) { const int row = h * 128 + R;
            size_t ra = (size_t)row;
            if (gr != nullptr) ra = (size_t)((row < gr->n) ? gr->ent[2 * row] : 0);
            voffA[h][i] = (unsigned)((ra * lda + C) * 2); voffB[h][i] = (unsigned)(((size_t)row * ldb + C) * 2); } }
    const unsigned ldsw = (unsigned)wid * 1024u;
    const int aoff = lds_byte(wr * 64 + fr, fq * 8), boff = lds_byte(wc * 32 + fr, fq * 8);
#define PG8_SA(b, h) (((b) * 2 + (h)) * HTB)
#define PG8_SB(b, h) ((4 + (b) * 2 + (h)) * HTB)
#define PG8_STAGE(bufoff, gbase, voff) do { _Pragma("unroll") for (int _i = 0; _i < 2; ++_i) \
        __builtin_amdgcn_global_load_lds((const unsigned*)((const char*)(gbase) + (voff)[_i]), (LAS unsigned*)(lds + (bufoff) + ldsw + _i * 8192), 16, 0, 0); } while (0)
#define PG8_LDA(dst, b, h) do { _Pragma("unroll") for (int m = 0; m < 4; ++m) _Pragma("unroll") for (int k = 0; k < 2; ++k) dst[m][k] = *(const LAS bf16x8*)(lds + PG8_SA(b, h) + aoff + m * 2048 + k * 1024); } while (0)
#define PG8_LDB(dst, b, h) do { _Pragma("unroll") for (int n = 0; n < 2; ++n) _Pragma("unroll") for (int k = 0; k < 2; ++k) dst[n][k] = *(const LAS bf16x8*)(lds + PG8_SB(b, h) + boff + n * 2048 + k * 1024); } while (0)
#define PG8_MMA(ai, bj, At, Bt) do { __builtin_amdgcn_s_setprio(1); _Pragma("unroll") for (int m = 0; m < 4; ++m) _Pragma("unroll") for (int n = 0; n < 2; ++n) _Pragma("unroll") for (int k = 0; k < 2; ++k) \
        acc[(ai) * 4 + m][(bj) * 2 + n] = __builtin_amdgcn_mfma_f32_16x16x32_bf16(Bt[n][k], At[m][k], acc[(ai) * 4 + m][(bj) * 2 + n], 0, 0, 0); __builtin_amdgcn_s_setprio(0); } while (0)
#define PG8_WAIT_V(n) asm volatile("s_waitcnt vmcnt(" #n ")" ::: "memory")
#define PG8_WAIT_L(n) asm volatile("s_waitcnt lgkmcnt(" #n ")" ::: "memory")
#define PG8_BAR __builtin_amdgcn_s_barrier()
#define PG8_SCHED __builtin_amdgcn_sched_barrier(0)
    bf16x8 At[4][2], B0[2][2], B1[2][2];
    const char* cA = (const char*)A; const char* cB = (const char*)bt;
    const size_t kstep = 128;
    asm volatile("s_waitcnt vmcnt(0)" ::: "memory");
    __syncthreads();
    PG8_STAGE(PG8_SB(0, 0), cB, voffB[0]); PG8_STAGE(PG8_SA(0, 0), cA, voffA[0]); PG8_STAGE(PG8_SB(0, 1), cB, voffB[1]); PG8_STAGE(PG8_SA(0, 1), cA, voffA[1]);
    if (wr == 1) PG8_BAR;
    PG8_WAIT_V(4); PG8_BAR;
    PG8_STAGE(PG8_SB(1, 0), cB + kstep, voffB[0]); PG8_STAGE(PG8_SA(1, 0), cA + kstep, voffA[0]); PG8_STAGE(PG8_SB(1, 1), cB + kstep, voffB[1]);
    PG8_WAIT_V(6); PG8_BAR;
    for (int t = 0; t < nt; t += 2) {
        const bool last = (t == nt - 2);
        const char* a1 = cA + (size_t)(t + 1) * kstep;
        const char* a2 = last ? cA : cA + (size_t)(t + 2) * kstep; const char* b2 = last ? cB : cB + (size_t)(t + 2) * kstep;
        const char* a3 = a2 + kstep; const char* b3 = b2 + kstep;
        PG8_LDB(B0, 0, 0); PG8_SCHED; PG8_LDA(At, 0, 0); PG8_STAGE(PG8_SA(1, 1), a1, voffA[1]);
        PG8_WAIT_L(8); PG8_BAR; PG8_WAIT_L(0); PG8_MMA(0, 0, At, B0); PG8_BAR; PG8_SCHED;
        PG8_LDB(B1, 0, 1); PG8_STAGE(PG8_SB(0, 0), b2, voffB[0]);
        PG8_BAR; PG8_WAIT_L(0); PG8_MMA(0, 1, At, B1); PG8_BAR;
        PG8_LDA(At, 0, 1); PG8_STAGE(PG8_SA(0, 0), a2, voffA[0]);
        PG8_BAR; PG8_WAIT_L(0); PG8_MMA(1, 0, At, B0); PG8_BAR; PG8_SCHED;
        PG8_STAGE(PG8_SB(0, 1), b2, voffB[1]);
        PG8_WAIT_V(6); PG8_BAR; PG8_MMA(1, 1, At, B1); PG8_BAR;
        PG8_LDB(B0, 1, 0); PG8_SCHED; PG8_LDA(At, 1, 0); PG8_STAGE(PG8_SA(0, 1), a2, voffA[1]);
        PG8_WAIT_L(8); PG8_BAR; PG8_WAIT_L(0); PG8_MMA(0, 0, At, B0); PG8_BAR; PG8_SCHED;
        PG8_LDB(B1, 1, 1); PG8_STAGE(PG8_SB(1, 0), b3, voffB[0]);
        PG8_BAR; PG8_WAIT_L(0); PG8_MMA(0, 1, At, B1); PG8_BAR;
        PG8_LDA(At, 1, 1); PG8_STAGE(PG8_SA(1, 0), a3, voffA[0]);
        PG8_BAR; PG8_WAIT_L(0); PG8_MMA(1, 0, At, B0); PG8_BAR; PG8_SCHED;
        PG8_STAGE(PG8_SB(1, 1), b3, voffB[1]);
        PG8_WAIT_V(6); PG8_BAR; PG8_MMA(1, 1, At, B1); PG8_BAR;
    }
    PG8_WAIT_V(0);
    if (wr == 0) PG8_BAR;
    PG8_BAR;
    asm volatile("" ::: "memory");
#undef PG8_SA
#undef PG8_SB
#undef PG8_STAGE
#undef PG8_LDA
#undef PG8_LDB
#undef PG8_MMA
#undef PG8_WAIT_V
#undef PG8_WAIT_L
#undef PG8_BAR
#undef PG8_SCHED
}
DI void tile256_store_bf16(f32x4 (&acc)[8][4], bf16_t* out, size_t ld, int ncols, unsigned char* lds) {
    bf16_t* T = (bf16_t*)lds;
    const int tid = TID(), lane = tid & 63, wave = tid >> 6, wm = wave >> 2, wn = wave & 3;
    __syncthreads();
#pragma unroll
    for (int mi = 0; mi < 8; ++mi)
#pragma unroll
        for (int ni = 0; ni < 4; ++ni) store_bf4(T + R256(mi) * 264 + C256(ni), acc[mi][ni]);
    __syncthreads();
#pragma unroll
    for (int i = 0; i < 16; ++i) {
        const int ch = tid + i * NTHREADS, r = ch >> 5, cc = (ch & 31) * 8;
        if (cc < ncols) *(u32x4*)(out + (size_t)r * ld + cc) = *(const u32x4*)(T + r * 264 + cc);
    }
}
DI void acc_zero(f32x4 (&acc)[4][4]) {
#pragma unroll
    for (int i = 0; i < 4; ++i)
#pragma unroll
        for (int j = 0; j < 4; ++j) acc[i][j] = (f32x4){0.f, 0.f, 0.f, 0.f};
}
#define ACC_FOREACH(acc, body) do { const int _l = TID() & 63, _w = TID() >> 6; \
    _Pragma("unroll") for (int _mi = 0; _mi < 4; ++_mi) _Pragma("unroll") for (int _ni = 0; _ni < 4; ++_ni) { \
        const int r_ = (_w >> 1) * 64 + _mi * 16 + (_l & 15), c_ = (_w & 1) * 64 + _ni * 16 + (_l >> 4) * 4; f32x4& v_ = acc[_mi][_ni]; body } } while (0)
DI ARows plain_rows(const bf16_t* base, size_t ld, int m0, int tid) { ARows a; a.mu = nullptr; a.ltype = 0; a.first = 0;
#pragma unroll
    for (int i = 0; i < 4; ++i) a.p[i] = base + (size_t)(m0 + (tid >> 3) + 64 * i) * ld;
    return a; }


DI void convert_tile4(const float* src, int ld, int N, int K, bf16_t* dst, int tile0, unsigned char* lds, int Kvalid = 1 << 30) {
    const int tid = TID();
    const int nkt = K >> 6;
    const int r = tid >> 3, seg = (tid & 7) * 8;
    f32x4 a[4], b[4];
#pragma unroll
    for (int u = 0; u < 4; ++u) {
        const int tile = tile0 + u, k0 = (tile % nkt) * 64, n0 = (tile / nkt) * 64;
        a[u] = (f32x4){0.f, 0.f, 0.f, 0.f}; b[u] = a[u];
        if (n0 + seg < N && k0 + r < Kvalid) { const float* q = src + (size_t)(k0 + r) * ld + n0 + seg; a[u] = *(const f32x4*)q; b[u] = *(const f32x4*)(q + 4); }
    }
    __syncthreads();
#pragma unroll
    for (int u = 0; u < 4; ++u) { bf16_t* T = (bf16_t*)lds + u * 64 * 72;
        u32x4 w; w.x = pack2(a[u][0], a[u][1]); w.y = pack2(a[u][2], a[u][3]); w.z = pack2(b[u][0], b[u][1]); w.w = pack2(b[u][2], b[u][3]); *(u32x4*)(T + r * 72 + seg) = w; }
    __syncthreads();
#pragma unroll
    for (int u = 0; u < 4; ++u) { const bf16_t* T = (const bf16_t*)lds + u * 64 * 72;
        const int tile = tile0 + u, k0 = (tile % nkt) * 64, n0 = (tile / nkt) * 64;
        u32x4 o;
        o.x = (unsigned)T[(seg + 0) * 72 + r] | ((unsigned)T[(seg + 1) * 72 + r] << 16); o.y = (unsigned)T[(seg + 2) * 72 + r] | ((unsigned)T[(seg + 3) * 72 + r] << 16);
        o.z = (unsigned)T[(seg + 4) * 72 + r] | ((unsigned)T[(seg + 5) * 72 + r] << 16); o.w = (unsigned)T[(seg + 6) * 72 + r] | ((unsigned)T[(seg + 7) * 72 + r] << 16);
        *(u32x4*)(dst + (size_t)(n0 + r) * K + k0 + seg) = o; }
}
struct Ctx {
    const Params* P; unsigned char* ws; float* out; int l;
    bf16_t* H; bf16_t* PROJ; bf16_t* F; bf16_t* POOLED; bf16_t* MERGED; bf16_t* CMPH; float* CMPO; float* POSB; int* ROUTE; int* ENT; bf16_t* HID; bf16_t* Y; bf16_t* VT; bf16_t* KC; bf16_t* VCT; bf16_t* YRAW; float* BON; unsigned* ctl;
    DI const float* in(int i) const { return P->in[i]; }
};

DI void moe_offsets(const Ctx& c, int layer, int* soff) {
    const unsigned* cnt = c.ctl + CW_CNT + layer * 32;
    __syncthreads();
    if (TID() == 0) { int s = 0; for (int e = 0; e < 32; ++e) { soff[e] = s; s += (int)cnt[e]; } soff[32] = s; }
    __syncthreads();
}
DI void add_moe_rows(const Ctx& c, int row, int lane, f32x4 (&v)[4], const int* soff) {
    const int* rt = c.ROUTE + (size_t)row * 8;
    const int p0 = soff[rt[0]] + rt[4], p1 = soff[rt[1]] + rt[5];
    const bf16_t* y0 = c.Y + (size_t)p0 * DM; const bf16_t* y1 = c.Y + (size_t)p1 * DM;
#pragma unroll
    for (int i = 0; i < 4; ++i) {
        const u32x2 a = *(const u32x2*)(y0 + i * 256 + lane * 4), b = *(const u32x2*)(y1 + i * 256 + lane * 4);
        v[i][0] += bflo(a.x) + bflo(b.x); v[i][1] += bfhi(a.x) + bfhi(b.x); v[i][2] += bflo(a.y) + bflo(b.y); v[i][3] += bfhi(a.y) + bfhi(b.y);
    }
}
DI void phase_norm1(const Ctx& c, unsigned char* lds) {
    const int tid = TID(), lane = tid & 63, wave = tid >> 6;
    const float* gain = c.in(I_NMIX) + c.l * DM;
    const float* src = (c.l == 0) ? c.in(I_X) : c.out;
    int* soff = (int*)(lds + 65536);
    if (c.l > 0) moe_offsets(c, c.l - 1, soff);
    for (int row = blockIdx.x * 8 + wave; row < NT; row += gridDim.x * 8) {
        f32x4 v[4];
#pragma unroll
        for (int i = 0; i < 4; ++i) v[i] = *(const f32x4*)(src + (size_t)row * DM + i * 256 + lane * 4);
        if (c.l > 0) {
            add_moe_rows(c, row, lane, v, soff);
#pragma unroll
            for (int i = 0; i < 4; ++i) *(f32x4*)(c.out + (size_t)row * DM + i * 256 + lane * 4) = v[i];
        }
        float ss = 0.f;
#pragma unroll
        for (int i = 0; i < 4; ++i) ss += v[i][0] * v[i][0] + v[i][1] * v[i][1] + v[i][2] * v[i][2] + v[i][3] * v[i][3];
        ss = wave_sum_dpp(ss);
        const float rs = rsqrtf(ss * (1.0f / DM) + 1e-6f);
#pragma unroll
        for (int i = 0; i < 4; ++i) {
            const f32x4 g = *(const f32x4*)(gain + i * 256 + lane * 4);
            store_bf4(c.H + (size_t)row * DM + i * 256 + lane * 4, (f32x4){v[i][0] * rs * g[0], v[i][1] * rs * g[1], v[i][2] * rs * g[2], v[i][3] * rs * g[3]});
        }
    }
    for (int idx = blockIdx.x * 8 + wave; idx < 512; idx += gridDim.x * 8) {
        const int kv = idx >> 8, n = idx & 255;
        const float* pos = c.in(kv ? I_CPV : I_CPK) + (size_t)c.l * 2048;
        const float* w1 = c.in(kv ? I_CW1V : I_CW1K) + (size_t)c.l * 2048 * 256;
        float s = 0.f;
        for (int k = lane; k < 2048; k += 64) s += pos[k] * w1[(size_t)k * 256 + n];
        s = wave_sum_dpp(s);
        if (lane == 0) c.POSB[kv * 256 + n] = s;
    }
    for (int it = blockIdx.x * 4; it < 1216 + 256 + 16 + 16 + 48; it += gridDim.x * 4) {
        if (it < 1216) convert_tile4(c.in(I_WIN) + (size_t)c.l * DM * IN_COLS, IN_COLS, IN_COLS, DM, (bf16_t*)(c.ws + WS_WT_IN), it, lds);
        else if (it < 1216 + 256) { const int j = it - 1216, kv = j >> 7; convert_tile4(c.in(kv ? I_CW1V : I_CW1K) + (size_t)c.l * 2048 * 256, 256, 256, 2048, (bf16_t*)(c.ws + WS_WT_C1) + (size_t)kv * 256 * 2048, j & 127, lds); }
        else if (it < 1216 + 256 + 16) { const int j = it - 1472, kv = j >> 3; convert_tile4(c.in(kv ? I_CW2V : I_CW2K) + (size_t)c.l * 256 * 64, 64, 64, 256, (bf16_t*)(c.ws + WS_WT_C2) + (size_t)kv * 128 * 256, j & 7, lds); }
        else if (it < 1504) { const int j = it - 1488, gi = j >> 2; convert_tile4(c.in(I_POOLW) + ((size_t)c.l * 4 + gi) * 128 * 128, 128, 128, 128, (bf16_t*)(c.ws + WS_WT_POOL) + (size_t)gi * 128 * 128, 0, lds); }
        else { const int j = it - 1504, ty = j >> 4; bf16_t* dst = (bf16_t*)(c.ws + WS_WT_LORA) + (size_t)ty * 512 * 128;
            if (ty == 0) convert_tile4(c.in(I_WUP) + (size_t)c.l * 32 * 512, 512, 512, 128, dst, j & 15, lds, 32);
            else if (ty == 1) convert_tile4(c.in(I_AUP) + (size_t)c.l * 32 * 512, 512, 512, 128, dst, j & 15, lds, 32);
            else convert_tile4(c.in(I_GUP) + (size_t)c.l * 96 * 512, 512, 512, 128, dst, j & 15, lds, 96); }
    }
}

constexpr int EPS = 136;
DI void tile_store_bf16(f32x4 (&acc)[4][4], bf16_t* out, size_t ld, int nrows, int ncols, unsigned char* lds) {
    bf16_t* T = (bf16_t*)lds;
    const int tid = TID();
    __syncthreads();
    ACC_FOREACH(acc, { store_bf4(T + r_ * EPS + c_, v_); });
    __syncthreads();
#pragma unroll
    for (int i = 0; i < 8; ++i) {
        const int ch = tid + i * NTHREADS, r = ch >> 4, cc = (ch & 15) * 8;
        if (r < nrows && cc < ncols) *(u32x4*)(out + (size_t)r * ld + cc) = *(const u32x4*)(T + r * EPS + cc);
    }
}
DI bool xcd_unit(int it, int nN, int& tm, int& tn) {
    const int G = gridDim.x;
    if ((G & 7) != 0 || G < 8) { const int u = it * G + blockIdx.x; if (u >= 64 * nN) return false; tm = u % 64; tn = u / 64; return true; }
    const int x = blockIdx.x & 7, i = blockIdx.x >> 3, per = G >> 3;
    const int u = it * per + i;
    if (u >= 8 * nN) return false;
    tm = x * 8 + (u & 7); tn = u >> 3; return true;
}
DI void phase_gemm1(const Ctx& c, unsigned char* lds) {
    const int nN = (IN_COLS + 255) / 256;
    const bf16_t* WT = (const bf16_t*)(c.ws + WS_WT_IN);
    for (int it = 0;; ++it) {
        int tm, tn; if (!xcd_unit(it, nN, tm, tn)) break;
        const int m0 = tm * 256, n0 = tn * 256;
        f32x4 acc[8][4];
#pragma unroll
        for (int i = 0; i < 8; ++i)
#pragma unroll
            for (int j = 0; j < 4; ++j) acc[i][j] = (f32x4){0.f, 0.f, 0.f, 0.f};
        gemm256_dma(acc, c.H + (size_t)m0 * DM, DM, WT + (size_t)n0 * DM, DM, DM, lds);
        tile256_store_bf16(acc, c.PROJ + (size_t)m0 * IN_COLS + n0, IN_COLS, (IN_COLS - n0 < 256) ? IN_COLS - n0 : 256, lds);
    }
}

DI float gelu_tanh(float x) { const float u = 0.7978845608028654f * (x + 0.044715f * x * x * x); const float e = __expf(2.0f * u); return x * (1.0f - __builtin_amdgcn_rcpf(e + 1.0f)); }
DI float softplusf_(float x) { return (x > 20.f) ? x : __logf(1.0f + __expf(x)); }
DI float tanhf_(float x) { const float e = __expf(2.0f * x); return 1.0f - 2.0f * __builtin_amdgcn_rcpf(e + 1.0f); }
constexpr int TKP = 8;
template <int WIN>
DI void pool_emit(const Ctx& c, const float (&pv)[31], int t0, int s0, int ch) {
#pragma unroll
    for (int k = 0; k < 16; ++k) {
        float sum = 0.f;
#pragma unroll
        for (int j = 0; j < WIN; ++j) sum += pv[15 + k - j];
        const int s = s0 + k, cnt = (s + 1 < WIN) ? s + 1 : WIN;
        c.POOLED[(size_t)(t0 + k) * 512 + ch] = f2bf(sum / (float)cnt - pv[15 + k]);
    }
}
DI void phase_prep(const Ctx& c, unsigned char* lds) {
    const int n_cmp_items = 2 * 16 * 2;
    for (int item = (int)gridDim.x - 1 - (int)blockIdx.x; item < n_cmp_items; item += gridDim.x) {
        const int tid = TID();
        const int kv = item >> 5, bgi = (item >> 1) & 15, tn = item & 1, m0 = bgi * 256, n0 = tn * 128;
        ARows ar; ar.mu = nullptr; ar.ltype = 0; ar.first = 0;
#pragma unroll
        for (int i = 0; i < 4; ++i) { const int cb = (tid >> 3) + 64 * i;
            ar.p[i] = (cb < NCMP) ? c.PROJ + ((size_t)(bgi >> 2) * SEQ + 16 * cb) * IN_COLS + (kv ? C_VC : C_KC) + (bgi & 3) * 64 : nullptr; }
        f32x4 acc[4][4]; acc_zero(acc);
        gemm_core<1>(acc, ar, (const bf16_t*)(c.ws + WS_WT_C1) + ((size_t)kv * 256 + n0) * 2048, 2048, 2048, lds);
        const float* pb = c.POSB + kv * 256;
        ACC_FOREACH(acc, {
            const f32x4 bb = *(const f32x4*)(pb + n0 + c_);
            store_bf4(c.CMPH + ((size_t)kv * 4096 + m0 + r_) * 256 + n0 + c_, (f32x4){gelu_tanh(v_[0] + bb[0]), gelu_tanh(v_[1] + bb[1]), gelu_tanh(v_[2] + bb[2]), gelu_tanh(v_[3] + bb[3])}); });
    }
    {
        const float* mu = c.in(I_MU) + (size_t)c.l * RWC;
        const bf16_t* WL = (const bf16_t*)(c.ws + WS_WT_LORA);
        for (int unit = blockIdx.x; unit < 64 * 12; unit += gridDim.x) {
            const int tid = TID();
            const int tm = unit & 63, tn = unit >> 6, m0 = tm * 256, n0 = tn * 128, ltype = tn >> 2, ch0 = n0 & 511;
            ARows ar; ar.mu = mu; ar.ltype = ltype; ar.first = 0;
#pragma unroll
            for (int i = 0; i < 4; ++i) { const int t = m0 + (tid >> 3) + 64 * i; ar.p[i] = c.PROJ + (size_t)t * IN_COLS; if ((t & (SEQ - 1)) == 0) ar.first |= 1 << i; }
            f32x4 acc[4][4]; acc_zero(acc);
            gemm_core<2>(acc, ar, WL + (size_t)n0 * 128, 128, 128, lds);
            if (ltype == 0) { const float* w0 = c.in(I_W0) + c.l * 512 + ch0;
                ACC_FOREACH(acc, { const f32x4 b4 = *(const f32x4*)(w0 + c_);
                    for (int j = 0; j < 4; ++j) v_[j] = __expf(-softplusf_(-(b4[j] + v_[j])) - 0.5f); }); }
            else if (ltype == 1) { const float* a0 = c.in(I_A0) + c.l * 512 + ch0;
                ACC_FOREACH(acc, { const f32x4 b4 = *(const f32x4*)(a0 + c_);
                    for (int j = 0; j < 4; ++j) v_[j] = sigmoidf_(b4[j] + v_[j]); }); }
            tile_store_bf16(acc, c.F + (size_t)(3 + ltype) * NT * 512 + (size_t)m0 * 512 + ch0, 512, 256, 128, lds);
        }
    }
    const int tid = TID();
    const int n_pool_items = NT / 16, n_items = n_pool_items + 512;
    for (int item = blockIdx.x; item < n_items; item += gridDim.x) {
        if (item >= n_pool_items) {
            const int idx0 = (item - n_pool_items) * 4;
            const int r = tid >> 3, seg = (tid & 7) * 8;
            u32x4 w[4];
#pragma unroll
            for (int u = 0; u < 4; ++u) { const int idx = idx0 + u, kind = idx >> 10, bgi = (idx >> 6) & 15, s0 = (idx & 63) * 64;
                w[u] = *(const u32x4*)(c.PROJ + ((size_t)(bgi >> 2) * SEQ + s0 + r) * IN_COLS + (kind ? C_VW : C_VS) + (bgi & 3) * 64 + seg); }
            __syncthreads();
#pragma unroll
            for (int u = 0; u < 4; ++u) *(u32x4*)((bf16_t*)lds + u * 64 * 72 + r * 72 + seg) = w[u];
            __syncthreads();
#pragma unroll
            for (int u = 0; u < 4; ++u) { const int idx = idx0 + u, kind = idx >> 10, bgi = (idx >> 6) & 15, s0 = (idx & 63) * 64;
                const bf16_t* T = (const bf16_t*)lds + u * 64 * 72;
                u32x4 o;
                o.x = (unsigned)T[(seg + 0) * 72 + r] | ((unsigned)T[(seg + 1) * 72 + r] << 16); o.y = (unsigned)T[(seg + 2) * 72 + r] | ((unsigned)T[(seg + 3) * 72 + r] << 16);
                o.z = (unsigned)T[(seg + 4) * 72 + r] | ((unsigned)T[(seg + 5) * 72 + r] << 16); o.w = (unsigned)T[(seg + 6) * 72 + r] | ((unsigned)T[(seg + 7) * 72 + r] << 16);
                *(u32x4*)(c.VT + (((size_t)kind * 16 + bgi) * 64 + r) * SEQ + s0 + seg) = o; }
        } else {
            const int t0 = item * 16, ch = tid, gi = ch >> 7, s0 = t0 & (SEQ - 1);
            float pv[31];
#pragma unroll
            for (int i = 0; i < 31; ++i) pv[i] = (s0 - 15 + i >= 0) ? bf2f(c.PROJ[(size_t)(t0 - 15 + i) * IN_COLS + C_POOL + ch]) : 0.f;
            if (gi == 0) pool_emit<2>(c, pv, t0, s0, ch);
            else if (gi == 1) pool_emit<4>(c, pv, t0, s0, ch);
            else if (gi == 2) pool_emit<8>(c, pv, t0, s0, ch);
            else pool_emit<16>(c, pv, t0, s0, ch);
        }
    }
}

DI void rwkv_finalize_item(const Ctx& c, int item) {
    const int tid = TID(), ch = tid, t0 = item * 8;
    const float* mu = c.in(I_MU) + (size_t)c.l * RWC;
    const float kkw_ = c.in(I_KK)[c.l * 512 + ch], kaw_ = c.in(I_KA)[c.l * 512 + ch], rkw_ = c.in(I_RK)[c.l * 512 + ch];
    const float mur = mu[ch], muk = mu[512 + ch], muv = mu[1024 + ch];
    bf16_t ur[9], uk[9], uv[9], ua[8];
    const bool has_prev = (t0 & (SEQ - 1)) != 0;
#pragma unroll
    for (int k = 0; k < 9; ++k) {
        ur[k] = 0; uk[k] = 0; uv[k] = 0;
        if (k > 0 || has_prev) { const bf16_t* q = c.PROJ + (size_t)(t0 - 1 + k) * IN_COLS; ur[k] = q[C_R + ch]; uk[k] = q[C_K + ch]; uv[k] = q[C_V + ch]; }
    }
#pragma unroll
    for (int k = 0; k < 8; ++k) ua[k] = c.F[(size_t)4 * NT * 512 + (size_t)(t0 + k) * 512 + ch];
#pragma unroll
    for (int k = 0; k < 8; ++k) {
        const int t = t0 + k;
        const float cr = bf2f(ur[k + 1]), ck = bf2f(uk[k + 1]), cv = bf2f(uv[k + 1]);
        const float r = cr + (bf2f(ur[k]) - cr) * mur, kx = ck + (bf2f(uk[k]) - ck) * muk, vx = cv + (bf2f(uv[k]) - cv) * muv;
        const float a = bf2f(ua[k]);
        const float kxn = kx * kkw_, kp = kx * (1.0f + (a - 1.0f) * kaw_);
        const float ss = wave_sum_dpp(kxn * kxn);
        const float inv = __builtin_amdgcn_rsqf(fmaxf(ss, 1e-24f));
        const float br = wave_sum_dpp(kxn * inv * a * r), kr = wave_sum_dpp(kp * r), bon = wave_sum_dpp(r * kp * rkw_);
        if ((tid & 63) == 0) *(f32x4*)(c.BON + ((size_t)t * 8 + (tid >> 6)) * 4) = (f32x4){inv, br, kr, bon};
        const size_t o = (size_t)t * 512 + ch;
        c.F[o] = f2bf(r); c.F[o + (size_t)NT * 512] = f2bf(kx); c.F[o + (size_t)2 * NT * 512] = f2bf(vx);
    }
}

DI void phase_poolgemm(const Ctx& c, unsigned char* lds) {
    for (int item = blockIdx.x; item < NT / 8; item += gridDim.x) rwkv_finalize_item(c, item);
    const int n_pool = (NT / 256) * 4, n_items = n_pool + 32;
    for (int item = blockIdx.x; item < n_items; item += gridDim.x) {
        f32x4 acc[4][4]; acc_zero(acc);
        if (item < n_pool) {
            const int tm = item >> 2, gi = item & 3, m0 = tm * 256;
            const ARows ar = plain_rows(c.POOLED + gi * 128, 512, m0, TID());
            gemm_core<0>(acc, ar, (const bf16_t*)(c.ws + WS_WT_POOL) + (size_t)gi * 128 * 128, 128, 128, lds);
            const float* sc = c.in(I_POOLS) + c.l * 512 + gi * 128;
            ACC_FOREACH(acc, { const f32x4 s = *(const f32x4*)(sc + c_);
                store_bf4(c.POOLED + (size_t)(m0 + r_) * 512 + gi * 128 + c_, (f32x4){v_[0] * s[0], v_[1] * s[1], v_[2] * s[2], v_[3] * s[3]}); });
        } else {
            const int it = item - n_pool, kv = it >> 4, tm = it & 15, m0 = tm * 256;
            const ARows ar = plain_rows(c.CMPH + (size_t)kv * 4096 * 256, 256, m0, TID());
            gemm_core<0>(acc, ar, (const bf16_t*)(c.ws + WS_WT_C2) + (size_t)kv * 128 * 256, 256, 256, lds);
            ACC_FOREACH(acc, { if (c_ < 64) { const int R = m0 + r_;
                if (kv == 0) store_bf4(c.KC + (size_t)R * 64 + c_, v_);
                else { bf16_t* q = c.VCT + ((size_t)(R >> 8) * 64 + c_) * 256 + (R & 255); q[0] = f2bf(v_[0]); q[256] = f2bf(v_[1]); q[512] = f2bf(v_[2]); q[768] = f2bf(v_[3]); } } });
        }
    }
}

constexpr int SCH = 32;
constexpr int SB_AN = 0, SB_WR = SCH * 64 * 4, SB_W = 2 * SCH * 64 * 4, SB_BB = 3 * SCH * 64 * 4, SB_KP = 4 * SCH * 64 * 4;
constexpr int SB_V = 5 * SCH * 64 * 4;
constexpr int SB_SC = SB_V + SCH * 16 * 4;
constexpr int SB_Y = SB_SC + SCH * 2 * 4;
constexpr int SB_BYTES = SB_Y + SCH * 16 * 4;
static_assert(2 * SB_BYTES <= LDS_BYTES - 64, "scan lds");
typedef float f32x2 __attribute__((ext_vector_type(2)));
DI float row8_sum(float v) { v += DPP_MOV(v, 0xB1); v += DPP_MOV(v, 0x4E); v += DPP_MOV(v, 0x141); return v; }

constexpr int NPW = 6, NJ = (SCH + NPW - 1) / NPW;
struct PrepRegs { bf16_t r[NJ], k[NJ], v[NJ], e[NJ], a[NJ]; float s0[NJ], s1[NJ], s2[NJ]; };
DI void prep_load(PrepRegs& R, const Ctx& c, int b, int h, int ck, int pw, int lane) {
    const size_t PL = (size_t)NT * 512;
    const size_t tb = (size_t)b * SEQ + ck * SCH;
    const size_t o0 = tb * 512 + h * 64 + lane;
#pragma unroll
    for (int j = 0; j < NJ; ++j) {
        const int st = pw + NPW * j;
        if (st < SCH) { const size_t o = o0 + (size_t)st * 512; R.r[j] = c.F[o]; R.k[j] = c.F[o + PL]; R.v[j] = c.F[o + 2 * PL]; R.e[j] = c.F[o + 3 * PL]; R.a[j] = c.F[o + 4 * PL];
            const float* sp = c.BON + ((tb + st) * 8 + h) * 4; R.s0[j] = sp[0]; R.s1[j] = sp[1]; R.s2[j] = sp[2]; }
    }
}
DI void prep_store(const PrepRegs& R, unsigned char* sb, int rq, int pw, int lane, float kkw, float kaw) {
    float* an = (float*)(sb + SB_AN); float* wr = (float*)(sb + SB_WR); float* w_ = (float*)(sb + SB_W); float* bb_ = (float*)(sb + SB_BB); float* kp_ = (float*)(sb + SB_KP);
    float* vv = (float*)(sb + SB_V); float* sc = (float*)(sb + SB_SC);
#pragma unroll
    for (int j = 0; j < NJ; ++j) {
        const int st = pw + NPW * j;
        if (st < SCH) {
            const float r = bf2f(R.r[j]), k = bf2f(R.k[j]), v = bf2f(R.v[j]), e = bf2f(R.e[j]), a = bf2f(R.a[j]);
            const float w = __expf(-e);
            const float kk = k * kkw * R.s0[j];
            const float kp = k * (1.0f + (a - 1.0f) * kaw);
            an[st * 64 + lane] = -kk; wr[st * 64 + lane] = w * r; w_[st * 64 + lane] = w; bb_[st * 64 + lane] = kk * a; kp_[st * 64 + lane] = kp;
            if ((lane >> 4) == rq) vv[st * 16 + (lane & 15)] = v;
            if (lane == 0) { sc[st * 2] = R.s1[j]; sc[st * 2 + 1] = R.s2[j]; }
        }
    }
}
DI void scan_item(const Ctx& c, int item, unsigned char* lds) {
    const int tid = TID(), lane = tid & 63, wave = tid >> 6;
    const int b = item >> 5, h = (item >> 2) & 7, rq = item & 3;
    const int chn = h * 64 + lane;
    const float kkw = c.in(I_KK)[c.l * 512 + chn], kaw = c.in(I_KA)[c.l * 512 + chn];
    const int rowl = (tid & 127) >> 3, cg = tid & 7;
    f32x2 st[4];
#pragma unroll
    for (int i = 0; i < 4; ++i) st[i] = (f32x2){0.f, 0.f};
    constexpr int NCK = SEQ / SCH;
    PrepRegs R;
    __syncthreads();
    if (wave >= 2) { prep_load(R, c, b, h, 0, wave - 2, lane); prep_store(R, lds, rq, wave - 2, lane, kkw, kaw); prep_load(R, c, b, h, 1, wave - 2, lane); }
    __syncthreads();
    for (int ck = 0; ck < NCK; ++ck) {
        unsigned char* sb = lds + (ck & 1) * SB_BYTES;
        if (wave < 2) {
            const float* an = (const float*)(sb + SB_AN) + cg * 8; const float* wr = (const float*)(sb + SB_WR) + cg * 8; const float* w_ = (const float*)(sb + SB_W) + cg * 8;
            const float* bb_ = (const float*)(sb + SB_BB) + cg * 8; const float* kp_ = (const float*)(sb + SB_KP) + cg * 8;
            const float* vv = (const float*)(sb + SB_V) + rowl; const float* sc = (const float*)(sb + SB_SC); float* yb = (float*)(sb + SB_Y) + rowl;
            f32x4 a0 = *(const f32x4*)(an), a1 = *(const f32x4*)(an + 4), r0 = *(const f32x4*)(wr), r1 = *(const f32x4*)(wr + 4);
            f32x4 w0 = *(const f32x4*)(w_), w1 = *(const f32x4*)(w_ + 4), b0 = *(const f32x4*)(bb_), b1 = *(const f32x4*)(bb_ + 4);
            f32x4 k0 = *(const f32x4*)(kp_), k1 = *(const f32x4*)(kp_ + 4);
            float v = vv[0]; f32x2 bk = *(const f32x2*)(sc);
#pragma unroll 2
            for (int s = 0; s < SCH; ++s) {
                const int sn = (s + 1 < SCH) ? s + 1 : s;
                const f32x4 na0 = *(const f32x4*)(an + sn * 64), na1 = *(const f32x4*)(an + sn * 64 + 4), nr0 = *(const f32x4*)(wr + sn * 64), nr1 = *(const f32x4*)(wr + sn * 64 + 4);
                const f32x4 nw0 = *(const f32x4*)(w_ + sn * 64), nw1 = *(const f32x4*)(w_ + sn * 64 + 4), nb0 = *(const f32x4*)(bb_ + sn * 64), nb1 = *(const f32x4*)(bb_ + sn * 64 + 4);
                const f32x4 nk0 = *(const f32x4*)(kp_ + sn * 64), nk1 = *(const f32x4*)(kp_ + sn * 64 + 4);
                const float nv = vv[sn * 16]; const f32x2 nbk = *(const f32x2*)(sc + sn * 2);
                f32x2 da = st[0] * (f32x2){a0[0], a0[1]}; f32x2 dr = st[0] * (f32x2){r0[0], r0[1]};
                da += st[1] * (f32x2){a0[2], a0[3]}; dr += st[1] * (f32x2){r0[2], r0[3]};
                da += st[2] * (f32x2){a1[0], a1[1]}; dr += st[2] * (f32x2){r1[0], r1[1]};
                da += st[3] * (f32x2){a1[2], a1[3]}; dr += st[3] * (f32x2){r1[2], r1[3]};
                float sa = da[0] + da[1], sr = dr[0] + dr[1];
                sa += DPP_MOV(sa, 0xB1); sr += DPP_MOV(sr, 0xB1);
                sa += DPP_MOV(sa, 0x4E); sr += DPP_MOV(sr, 0x4E);
                sa += DPP_MOV(sa, 0x141); sr += DPP_MOV(sr, 0x141);
                const f32x2 sa2 = (f32x2){sa, sa}, v2 = (f32x2){v, v};
                st[0] = st[0] * (f32x2){w0[0], w0[1]} + sa2 * (f32x2){b0[0], b0[1]} + v2 * (f32x2){k0[0], k0[1]};
                st[1] = st[1] * (f32x2){w0[2], w0[3]} + sa2 * (f32x2){b0[2], b0[3]} + v2 * (f32x2){k0[2], k0[3]};
                st[2] = st[2] * (f32x2){w1[0], w1[1]} + sa2 * (f32x2){b1[0], b1[1]} + v2 * (f32x2){k1[0], k1[1]};
                st[3] = st[3] * (f32x2){w1[2], w1[3]} + sa2 * (f32x2){b1[2], b1[3]} + v2 * (f32x2){k1[2], k1[3]};
                yb[s * 16] = sr + sa * bk[0] + v * bk[1];
                a0 = na0; a1 = na1; r0 = nr0; r1 = nr1; w0 = nw0; w1 = nw1; b0 = nb0; b1 = nb1; k0 = nk0; k1 = nk1; v = nv; bk = nbk;
            }
        } else {
            const int pt = tid - 128;
            if (ck + 1 < NCK) prep_store(R, lds + ((ck + 1) & 1) * SB_BYTES, rq, wave - 2, lane, kkw, kaw);
            if (ck + 2 < NCK) prep_load(R, c, b, h, ck + 2, wave - 2, lane);
            if (ck > 0) {
                const float* yb = (const float*)(lds + ((ck - 1) & 1) * SB_BYTES + SB_Y);
                for (int idx = pt; idx < SCH * 16; idx += 384) {
                    const int s = idx >> 4, j = idx & 15;
                    c.YRAW[((size_t)b * SEQ + (ck - 1) * SCH + s) * 512 + h * 64 + rq * 16 + j] = f2bf(yb[idx]);
                }
            }
        }
        asm volatile("s_waitcnt lgkmcnt(0)" ::: "memory"); __builtin_amdgcn_s_barrier(); asm volatile("" ::: "memory");
    }
    {
        const float* yb = (const float*)(lds + ((NCK - 1) & 1) * SB_BYTES + SB_Y);
        for (int idx = tid; idx < SCH * 16; idx += NTHREADS) {
            const int s = idx >> 4, j = idx & 15;
            c.YRAW[((size_t)b * SEQ + (NCK - 1) * SCH + s) * 512 + h * 64 + rq * 16 + j] = f2bf(yb[idx]);
        }
    }
    __syncthreads();
}
constexpr int CS64 = 72, CS32 = 40;
constexpr int CK_AH = 0, CK_BH = CK_AH + 32 * CS64 * 2, CK_KH = CK_BH + 32 * CS64 * 2, CK_RH = CK_KH + 32 * CS64 * 2;
constexpr int CK_BHT = CK_RH + 32 * CS64 * 2, CK_KHT = CK_BHT + 64 * CS32 * 2, CK_VT = CK_KHT + 64 * CS32 * 2, CK_ZT = CK_VT + 64 * CS32 * 2, CK_UT = CK_ZT + 64 * CS32 * 2;
constexpr int CK_S0B = CK_UT + 64 * CS32 * 2;
constexpr int CK_LAK = CK_S0B + 2 * 64 * CS64 * 2, CK_MRB = CK_LAK + 32 * CS32 * 2, CK_MRK = CK_MRB + 32 * CS32 * 2;
constexpr int CK_PA = CK_MRK + 32 * CS32 * 2, CK_PT = CK_PA + 2 * 32 * CS32 * 2, CK_TT = CK_PT + 2 * 32 * CS32 * 2;
constexpr int CK_TOT = CK_TT + 2 * 32 * CS32 * 2;
constexpr int CK_GC = CK_TOT + 8 * 64 * 4;
constexpr int CK_END = CK_GC + 256;
static_assert(CK_END <= LDS_BYTES - 64, "chunk scan lds");
template <int K>
DI f32x4 mm16(const bf16_t* A, int lda, const bf16_t* Bt, int ldb, f32x4 acc, int lane) {
#pragma unroll
    for (int k0 = 0; k0 < K; k0 += 32) {
        const bf16x8 a = *(const bf16x8*)(A + (lane & 15) * lda + k0 + (lane >> 4) * 8), b = *(const bf16x8*)(Bt + (lane & 15) * ldb + k0 + (lane >> 4) * 8);
        acc = __builtin_amdgcn_mfma_f32_16x16x32_bf16(a, b, acc, 0, 0, 0);
    }
    return acc;
}
template <int K>
DI f32x4 mm16t(const bf16_t* A, int lda, const bf16_t* Bt, int ldb, f32x4 acc, int lane) {
#pragma unroll
    for (int k0 = 0; k0 < K; k0 += 32) {
        const bf16x8 a = *(const bf16x8*)(A + (lane & 15) * lda + k0 + (lane >> 4) * 8), b = *(const bf16x8*)(Bt + (lane & 15) * ldb + k0 + (lane >> 4) * 8);
        acc = __builtin_amdgcn_mfma_f32_16x16x32_bf16(b, a, acc, 0, 0, 0);
    }
    return acc;
}
DI void mm16_both(const bf16_t* A, int lda, const bf16_t* Bt, int ldb, f32x4& cn, f32x4& ct, int lane) {
    const bf16x8 a = *(const bf16x8*)(A + (lane & 15) * lda + (lane >> 4) * 8), b = *(const bf16x8*)(Bt + (lane & 15) * ldb + (lane >> 4) * 8);
    cn = __builtin_amdgcn_mfma_f32_16x16x32_bf16(a, b, cn, 0, 0, 0); ct = __builtin_amdgcn_mfma_f32_16x16x32_bf16(b, a, ct, 0, 0, 0);
}
struct ChunkRaw { bf16_t r[4], k[4], v[4], e[4], a[4]; float inv[4]; };
DI void chunk_load(ChunkRaw& R, const Ctx& c, int b, int h, int ck, int wave, int lane) {
    const size_t PL = (size_t)NT * 512;
    const size_t tok0 = (size_t)b * SEQ + ck * 32 + wave * 4;
#pragma unroll
    for (int s = 0; s < 4; ++s) {
        const size_t o = (tok0 + s) * 512 + h * 64 + lane;
        R.r[s] = c.F[o]; R.k[s] = c.F[o + PL]; R.v[s] = c.F[o + 2 * PL]; R.e[s] = c.F[o + 3 * PL]; R.a[s] = c.F[o + 4 * PL];
        R.inv[s] = c.BON[((tok0 + s) * 8 + h) * 4];
    }
}
DI void scan_chunked_item(const Ctx& c, int item, unsigned char* lds) {
    const int tid = TID(), lane = tid & 63, wave = tid >> 6, qd = lane >> 4, l15 = lane & 15;
    const int b = item >> 3, h = item & 7;
    bf16_t* AH = (bf16_t*)(lds + CK_AH); bf16_t* BH = (bf16_t*)(lds + CK_BH); bf16_t* KH = (bf16_t*)(lds + CK_KH); bf16_t* RH = (bf16_t*)(lds + CK_RH);
    bf16_t* BHT = (bf16_t*)(lds + CK_BHT); bf16_t* KHT = (bf16_t*)(lds + CK_KHT); bf16_t* VT = (bf16_t*)(lds + CK_VT); bf16_t* ZT = (bf16_t*)(lds + CK_ZT); bf16_t* UT = (bf16_t*)(lds + CK_UT);
    bf16_t* S0B = (bf16_t*)(lds + CK_S0B); bf16_t* LAK = (bf16_t*)(lds + CK_LAK); bf16_t* MRB = (bf16_t*)(lds + CK_MRB); bf16_t* MRK = (bf16_t*)(lds + CK_MRK);
    bf16_t* PA = (bf16_t*)(lds + CK_PA); bf16_t* PT = (bf16_t*)(lds + CK_PT); bf16_t* TT = (bf16_t*)(lds + CK_TT);
    float* TOT = (float*)(lds + CK_TOT); float* GC = (float*)(lds + CK_GC);
    const f32x4 Z4 = (f32x4){0.f, 0.f, 0.f, 0.f};
    f32x4 Sreg[2] = {Z4, Z4};
    const int svt = wave >> 1, skt0 = 2 * (wave & 1);
    const int mt8 = wave >> 2, nt8 = wave & 3;
    const int mt4 = (wave >> 1) & 1, nt4 = wave & 1;
    __syncthreads();
    for (int i = tid; i < 2 * 64 * CS64 / 2; i += NTHREADS) ((unsigned*)S0B)[i] = 0u;
    const float kkw = c.in(I_KK)[c.l * 512 + h * 64 + lane], kaw = c.in(I_KA)[c.l * 512 + h * 64 + lane];
    ChunkRaw R; chunk_load(R, c, b, h, 0, wave, lane);
    constexpr int NCK = SEQ / 32;
    for (int ck = 0; ck < NCK; ++ck) {
        const bf16_t* S0c = S0B + (ck & 1) * 64 * CS64; bf16_t* S0n = S0B + ((ck + 1) & 1) * 64 * CS64;
        float r4[4], k4[4], v4[4], e4[4], a4[4], inv4[4], ce[4];
#pragma unroll
        for (int s = 0; s < 4; ++s) { r4[s] = bf2f(R.r[s]); k4[s] = bf2f(R.k[s]); v4[s] = bf2f(R.v[s]); e4[s] = bf2f(R.e[s]); a4[s] = bf2f(R.a[s]); inv4[s] = R.inv[s]; }
        ce[0] = e4[0]; ce[1] = ce[0] + e4[1]; ce[2] = ce[1] + e4[2]; ce[3] = ce[2] + e4[3];
        TOT[wave * 64 + lane] = ce[3];
        LDS_BARRIER();
        { const int ckn = (ck + 1 < NCK) ? ck + 1 : ck; chunk_load(R, c, b, h, ckn, wave, lane); }
        {
            float off = 0.f;
#pragma unroll
            for (int w = 0; w < 7; ++w) { const float tw = TOT[w * 64 + lane]; if (w < wave) off += tw; }
            float ah[4], bh[4], kh[4], rh[4];
#pragma unroll
            for (int s = 0; s < 4; ++s) {
                const float cs = off + ce[s];
                const float g = __expf(-cs), gi = __expf(cs), gm1 = __expf(e4[s] - cs);
                const float kk = k4[s] * kkw * inv4[s], kp = k4[s] * (1.0f + (a4[s] - 1.0f) * kaw);
                ah[s] = -kk * gm1; bh[s] = kk * a4[s] * gi; kh[s] = kp * gi; rh[s] = r4[s] * g;
                const int t = wave * 4 + s;
                AH[t * CS64 + lane] = f2bf(ah[s]); BH[t * CS64 + lane] = f2bf(bh[s]); KH[t * CS64 + lane] = f2bf(kh[s]); RH[t * CS64 + lane] = f2bf(rh[s]);
                if (wave == 7 && s == 3) GC[lane] = g;
            }
            store_bf4(BHT + lane * CS32 + wave * 4, (f32x4){bh[0], bh[1], bh[2], bh[3]});
            store_bf4(KHT + lane * CS32 + wave * 4, (f32x4){kh[0], kh[1], kh[2], kh[3]});
            store_bf4(VT + lane * CS32 + wave * 4, (f32x4){v4[0], v4[1], v4[2], v4[3]});
        }
        LDS_BARRIER();
        {
            const int q = wave >> 1, mt = wave & 1;
            const bf16_t* A = (q < 2) ? AH : RH; const bf16_t* Bt = (q & 1) ? KH : BH;
#pragma unroll
            for (int nt = 0; nt < 2; ++nt) {
                f32x4 acc = mm16t<64>(A + mt * 16 * CS64, CS64, Bt + nt * 16 * CS64, CS64, Z4, lane);
                const int m = mt * 16 + l15, n0 = nt * 16 + 4 * qd;
#pragma unroll
                for (int i = 0; i < 4; ++i) { const bool keep = (q < 2) ? (n0 + i < m) : (n0 + i <= m); if (!keep) acc[i] = 0.f; }
                if (q == 0) {
                    store_bf4(PA + m * CS32 + n0, acc);
                    f32x4 t0 = acc;
#pragma unroll
                    for (int i = 0; i < 4; ++i) if (n0 + i == m) t0[i] += 1.0f;
                    store_bf4(TT + m * CS32 + n0, t0);
                    f32x4 accn = mm16<64>(A + mt * 16 * CS64, CS64, Bt + nt * 16 * CS64, CS64, Z4, lane);
                    const int mm0 = mt * 16 + 4 * qd, nn = nt * 16 + l15;
#pragma unroll
                    for (int i = 0; i < 4; ++i) if (!(nn < mm0 + i)) accn[i] = 0.f;
                    store_bf4(PT + nn * CS32 + mm0, accn);
                } else store_bf4(((q == 1) ? LAK : ((q == 2) ? MRB : MRK)) + m * CS32 + n0, acc);
            }
        }
        LDS_BARRIER();
        f32x4 y = Z4;
        int pcur = 0, tcur = 0;
#pragma unroll
        for (int itn = 0; itn < 5; ++itn) {
            const int m = mt4 * 16 + l15, n0 = nt4 * 16 + 4 * qd;
            if (wave < 4) {
                if (itn < 4) {
                    f32x4 cn = Z4, ct = Z4;
                    mm16_both(PA + pcur * 32 * CS32 + mt4 * 16 * CS32, CS32, PT + pcur * 32 * CS32 + nt4 * 16 * CS32, CS32, cn, ct, lane);
                    store_bf4(PA + (pcur ^ 1) * 32 * CS32 + m * CS32 + n0, ct);
                    store_bf4(PT + (pcur ^ 1) * 32 * CS32 + (nt4 * 16 + l15) * CS32 + mt4 * 16 + 4 * qd, cn);
                }
            } else if (itn > 0) {
                const u32x2 told = *(const u32x2*)(TT + tcur * 32 * CS32 + m * CS32 + n0);
                f32x4 acc = (f32x4){bflo(told.x), bfhi(told.x), bflo(told.y), bfhi(told.y)};
                acc = mm16t<32>(TT + tcur * 32 * CS32 + mt4 * 16 * CS32, CS32, PT + pcur * 32 * CS32 + nt4 * 16 * CS32, CS32, acc, lane);
                store_bf4(TT + (tcur ^ 1) * 32 * CS32 + m * CS32 + n0, acc);
            }
            if (itn == 0) {
                f32x4 z = mm16<64>(AH + mt8 * 16 * CS64, CS64, S0c + nt8 * 16 * CS64, CS64, Z4, lane);
                z = mm16<32>(LAK + mt8 * 16 * CS32, CS32, VT + nt8 * 16 * CS32, CS32, z, lane);
                store_bf4(ZT + (nt8 * 16 + l15) * CS32 + mt8 * 16 + 4 * qd, z);
            } else if (itn == 1) {
                y = mm16t<64>(RH + mt8 * 16 * CS64, CS64, S0c + nt8 * 16 * CS64, CS64, Z4, lane);
                y = mm16t<32>(MRK + mt8 * 16 * CS32, CS32, VT + nt8 * 16 * CS32, CS32, y, lane);
            } else if (itn == 2) {
#pragma unroll
                for (int j = 0; j < 2; ++j) Sreg[j] = mm16t<32>(VT + svt * 16 * CS32, CS32, KHT + (skt0 + j) * 16 * CS32, CS32, Sreg[j], lane);
            }
            LDS_BARRIER();
            if (itn < 4) pcur ^= 1;
            if (itn > 0) tcur ^= 1;
        }
        const bf16_t* Tm = TT + tcur * 32 * CS32;
        {
            const f32x4 uacc = mm16<32>(Tm + mt8 * 16 * CS32, CS32, ZT + nt8 * 16 * CS32, CS32, Z4, lane);
            store_bf4(UT + (nt8 * 16 + l15) * CS32 + mt8 * 16 + 4 * qd, uacc);
        }
        LDS_BARRIER();
        {
            y = mm16t<32>(MRB + mt8 * 16 * CS32, CS32, UT + nt8 * 16 * CS32, CS32, y, lane);
            store_bf4(c.YRAW + ((size_t)b * SEQ + ck * 32 + mt8 * 16 + l15) * 512 + h * 64 + nt8 * 16 + 4 * qd, y);
#pragma unroll
            for (int j = 0; j < 2; ++j) {
                const int kt = skt0 + j;
                f32x4 s = mm16t<32>(UT + svt * 16 * CS32, CS32, BHT + kt * 16 * CS32, CS32, Sreg[j], lane);
                const f32x4 gc = *(const f32x4*)(GC + kt * 16 + 4 * qd);
                s = s * gc;
                Sreg[j] = s;
                store_bf4(S0n + (svt * 16 + l15) * CS64 + kt * 16 + 4 * qd, s);
            }
        }
        LDS_BARRIER();
    }
    __syncthreads();
}
DI void phase_rwkv_post(const Ctx& c, unsigned char* lds) {
    const int tid = TID(), lane = tid & 63, wave = tid >> 6;
    const size_t PL = (size_t)NT * 512;
    for (int t = blockIdx.x * 8 + wave; t < NT; t += gridDim.x * 8) {
        bf16_t ry[8], rv[8], rg[8]; float bon[8], gw[8], gb[8];
#pragma unroll
        for (int h = 0; h < 8; ++h) { const size_t o = (size_t)t * 512 + h * 64 + lane; ry[h] = c.YRAW[o]; rv[h] = c.F[o + 2 * PL]; rg[h] = c.F[o + 5 * PL]; bon[h] = c.BON[((size_t)t * 8 + h) * 4 + 3];
            gw[h] = c.in(I_GNW)[c.l * 512 + h * 64 + lane]; gb[h] = c.in(I_GNB)[c.l * 512 + h * 64 + lane]; }
#pragma unroll
        for (int h = 0; h < 8; ++h) {
            const float y = bf2f(ry[h]);
            const float mean = wave_sum_dpp(y) * (1.0f / 64.0f);
            const float d = y - mean;
            const float var = wave_sum_dpp(d * d) * (1.0f / 64.0f);
            const float yn = d * rsqrtf(var + 64e-5f) * gw[h] + gb[h];
            c.F[(size_t)t * 512 + h * 64 + lane + 5 * PL] = f2bf((yn + bon[h] * bf2f(rv[h])) * bf2f(rg[h]));
        }
    }
    for (int it = blockIdx.x * 4; it < 768 + 128 + 128 + 256 + 256; it += gridDim.x * 4) {
        const float* WB = c.in(I_WBR) + (size_t)c.l * 2048 * DM; bf16_t* BR = (bf16_t*)(c.ws + WS_WT_BR);
        if (it < 768) convert_tile4(c.in(I_WMG) + (size_t)c.l * DM * 3 * DM, 3 * DM, 3 * DM, DM, (bf16_t*)(c.ws + WS_WT_MG), it, lds);
        else if (it < 896) convert_tile4(WB, DM, DM, 512, BR, it - 768, lds);
        else if (it < 1024) convert_tile4(WB + (size_t)512 * DM, DM, DM, 512, BR + (size_t)1024 * 512, it - 896, lds);
        else if (it < 1280) convert_tile4(WB + (size_t)1024 * DM, DM, DM, 1024, BR + (size_t)2048 * 512, it - 1024, lds);
        else convert_tile4(c.in(I_WOUT) + (size_t)c.l * DM * DM, DM, DM, DM, (bf16_t*)(c.ws + WS_WT_OUT), it - 1280, lds);
    }
}
constexpr int TS = 72;
constexpr int NSA_BIAS = 0;
constexpr int NSA_SELM = 2112;
constexpr int NSA_SCR = 2624;
constexpr int NSA_K0 = 4672;
constexpr int NSA_V0 = NSA_K0 + 2 * 64 * TS * 2;
constexpr int NSA_A = NSA_V0 + 2 * 64 * TS * 2;
constexpr int NSA_B = NSA_A + 16384;
constexpr int NSA_END = NSA_B + 16384;
static_assert(NSA_END <= LDS_BYTES - 16, "nsa lds");
static_assert(NSA_K0 % 16 == 0, "align");

struct NsaLane { int tq[2]; int h; float cbias; float m[2], l[2]; };

DI void nsa_prefetch(u32x4& rk, u32x4& rv, const bf16_t* kbase, int kstride, const bf16_t* vtbase, int vstride, int pos0, int tid) {
    const int r = tid >> 3, seg = (tid & 7) * 8;
    rk = *(const u32x4*)(kbase + (size_t)(pos0 + r) * kstride + seg);
    rv = *(const u32x4*)(vtbase + (size_t)r * vstride + pos0 + seg);
}
DI void nsa_store(unsigned char* lds, int buf, const u32x4& rk, const u32x4& rv, int tid) {
    const int r = tid >> 3, seg = (tid & 7) * 8;
    *(u32x4*)((bf16_t*)(lds + NSA_K0) + buf * 64 * TS + r * TS + seg) = rk;
    *(u32x4*)((bf16_t*)(lds + NSA_V0) + buf * 64 * TS + r * TS + seg) = rv;
}
template <int QM = 3>
DI void nsa_qk(f32x4 (&s)[2][4], const bf16_t* sK, const bf16x8 (&qf)[2][2], int lane) {
#pragma unroll
    for (int kt = 0; kt < 4; ++kt) {
#pragma unroll
        for (int ks = 0; ks < 2; ++ks) {
            const bf16x8 kf = *(const bf16x8*)(sK + (16 * kt + (lane & 15)) * TS + 32 * ks + (lane >> 4) * 8);
#pragma unroll
            for (int qi = 0; qi < 2; ++qi) if ((QM >> qi) & 1) s[qi][kt] = __builtin_amdgcn_mfma_f32_16x16x32_bf16(kf, qf[qi][ks], (ks == 0) ? (f32x4){0.f, 0.f, 0.f, 0.f} : s[qi][kt], 0, 0, 0);
        }
    }
}
template <int MODE>
DI void nsa_logits(float (&x)[4][4], const f32x4 (&s)[4], int tq, int h, float cbias, bool rowsel, int pos0, int qd, const float* biasT) {
#pragma unroll
    for (int kt = 0; kt < 4; ++kt)
#pragma unroll
        for (int i = 0; i < 4; ++i) {
            const int kk = pos0 + 16 * kt + 4 * qd + i;
            if (MODE == 1) { x[kt][i] = rowsel ? s[kt][i] + cbias : -INFINITY; }
            else {
                const int dist = (MODE == 0) ? (tq - 16 * kk - 31) : (tq - kk);
                bool ok = dist >= 0;
                if (MODE == 2) ok = ok && rowsel;
                if (MODE == 3) ok = ok && (dist < 512);
                const int di = dist < 0 ? 0 : (dist > 128 ? 128 : dist);
                float bias = biasT[di * 4 + h];
                asm volatile("" : "+v"(bias));
                x[kt][i] = ok ? s[kt][i] + bias : -INFINITY;
            }
        }
}
DI float quad16_max(float v) { v = fmaxf(v, __shfl_xor(v, 16)); v = fmaxf(v, __shfl_xor(v, 32)); return v; }
DI float quad16_sum(float v) { v += __shfl_xor(v, 16); v += __shfl_xor(v, 32); return v; }
DI void nsa_softmax(const float (&x)[4][4], float& m, float& l, f32x4 (&O)[4], bf16x8 (&pf)[2]) {
    float mx = -INFINITY;
#pragma unroll
    for (int kt = 0; kt < 4; ++kt)
#pragma unroll
        for (int i = 0; i < 4; ++i) mx = fmaxf(mx, x[kt][i]);
    mx = quad16_max(mx);
    const float mn = fmaxf(m, mx);
    const float mu = (mn == -INFINITY) ? 0.f : mn;
    const float mu2 = mu * 1.4426950408889634f;
    const float sc = __builtin_amdgcn_exp2f(__builtin_fmaf(m, 1.4426950408889634f, -mu2));
    float p[4][4]; float ps = 0.f;
#pragma unroll
    for (int kt = 0; kt < 4; ++kt)
#pragma unroll
        for (int i = 0; i < 4; ++i) { p[kt][i] = __builtin_amdgcn_exp2f(__builtin_fmaf(x[kt][i], 1.4426950408889634f, -mu2)); ps += p[kt][i]; }
    l = l * sc + ps; m = mn;
#pragma unroll
    for (int dt = 0; dt < 4; ++dt) O[dt] = O[dt] * sc;
#pragma unroll
    for (int ks = 0; ks < 2; ++ks) {
        u32x4 w; w.x = pack2(p[2 * ks][0], p[2 * ks][1]); w.y = pack2(p[2 * ks][2], p[2 * ks][3]); w.z = pack2(p[2 * ks + 1][0], p[2 * ks + 1][1]); w.w = pack2(p[2 * ks + 1][2], p[2 * ks + 1][3]);
        pf[ks] = __builtin_bit_cast(bf16x8, w);
    }
}
template <int QM = 3>
DI void nsa_pv(f32x4 (&O)[2][4], const bf16_t* sV, const bf16x8 (&pf)[2][2], int lane) {
    const int qd = lane >> 4;
#pragma unroll
    for (int dt = 0; dt < 4; ++dt)
#pragma unroll
        for (int ks = 0; ks < 2; ++ks) {
            const bf16_t* vp = sV + (16 * dt + (lane & 15)) * TS + 32 * ks + 4 * qd;
            const u32x2 a = *(const u32x2*)vp, b = *(const u32x2*)(vp + 16);
            u32x4 w; w.x = a.x; w.y = a.y; w.z = b.x; w.w = b.y;
            const bf16x8 vf = __builtin_bit_cast(bf16x8, w);
#pragma unroll
            for (int qi = 0; qi < 2; ++qi) if ((QM >> qi) & 1) O[qi][dt] = __builtin_amdgcn_mfma_f32_16x16x32_bf16(vf, pf[qi][ks], O[qi][dt], 0, 0, 0);
        }
}
template <int MODE, int QM = 3>
DI void nsa_tile(f32x4 (&O)[2][4], NsaLane& L, const bf16x8 (&qf)[2][2], const unsigned char* lds, int buf, int pos0, bool sel0, bool sel1, int lane) {
    const bf16_t* sK = (const bf16_t*)(lds + NSA_K0) + buf * 64 * TS;
    const bf16_t* sV = (const bf16_t*)(lds + NSA_V0) + buf * 64 * TS;
    const float* biasT = (const float*)(lds + NSA_BIAS);
    f32x4 s[2][4];
    nsa_qk<QM>(s, sK, qf, lane);
    bf16x8 pf[2][2];
#pragma unroll
    for (int qi = 0; qi < 2; ++qi) if ((QM >> qi) & 1) {
        float x[4][4];
        nsa_logits<MODE>(x, s[qi], L.tq[qi], L.h, L.cbias, qi ? sel1 : sel0, pos0, lane >> 4, biasT);
        nsa_softmax(x, L.m[qi], L.l[qi], O[qi], pf[qi]);
    }
    nsa_pv<QM>(O, sV, pf, lane);
}
template <int MODE>
DI void nsa_tile_sel(f32x4 (&O)[2][4], NsaLane& L, const bf16x8 (&qf)[2][2], const unsigned char* lds, int buf, int pos0, bool sel0, bool sel1, int lane) {
    const bool a0 = __ballot(sel0) != 0ull, a1 = __ballot(sel1) != 0ull;
    if (a0 && a1) nsa_tile<MODE, 3>(O, L, qf, lds, buf, pos0, sel0, sel1, lane);
    else if (a0) nsa_tile<MODE, 1>(O, L, qf, lds, buf, pos0, sel0, sel1, lane);
    else if (a1) nsa_tile<MODE, 2>(O, L, qf, lds, buf, pos0, sel0, sel1, lane);
}
DI void nsa_flush(f32x4 (&Y)[2][4], f32x4 (&O)[2][4], NsaLane& L, const float (&gate)[2]) {
#pragma unroll
    for (int qi = 0; qi < 2; ++qi) {
        const float lt = quad16_sum(L.l[qi]);
        const float f = (lt > 0.f) ? gate[qi] * __builtin_amdgcn_rcpf(lt) : 0.f;
#pragma unroll
        for (int dt = 0; dt < 4; ++dt) { Y[qi][dt] += O[qi][dt] * f; O[qi][dt] = (f32x4){0.f, 0.f, 0.f, 0.f}; }
    }
}
DI void nsa_item(const Ctx& c, int item, unsigned char* lds) {
    const int tid = TID(), lane = tid & 63, wave = tid >> 6, qd = lane >> 4;
    const int b = item >> 8, g = (item >> 6) & 3, qt = item & 63, t0 = qt * 64, cur = qt, bg = b * 4 + g;
    float* biasT = (float*)(lds + NSA_BIAS);
    unsigned long long* selm = (unsigned long long*)(lds + NSA_SELM);
    float* scr = (float*)(lds + NSA_SCR) + wave * 64;
    float* impA = (float*)(lds + NSA_A); float* impB = (float*)(lds + NSA_B);
    __syncthreads();
    for (int i = tid; i < 129 * 4; i += NTHREADS) { const int d = i >> 2, h = i & 3; biasT[i] = c.in(I_RELB)[t5_bucket(d) * 16 + g * 4 + h]; }
    for (int i = tid; i < 2 * 4096; i += NTHREADS) impA[i] = 0.f;
    NsaLane L; L.h = lane & 3;
    bf16x8 qf[2][2]; float gates[2][3];
    const bf16_t* pbat = c.PROJ + (size_t)b * SEQ * IN_COLS;
#pragma unroll
    for (int qi = 0; qi < 2; ++qi) {
        const int tl = 8 * wave + 4 * qi + ((lane & 15) >> 2);
        L.tq[qi] = t0 + tl;
        const bf16_t* prow = pbat + (size_t)L.tq[qi] * IN_COLS;
#pragma unroll
        for (int ks = 0; ks < 2; ++ks) {
            u32x4 w = *(const u32x4*)(prow + C_Q + (g * 4 + L.h) * 64 + 32 * ks + qd * 8);
            w.x = pack2(bflo(w.x) * 0.125f, bfhi(w.x) * 0.125f); w.y = pack2(bflo(w.y) * 0.125f, bfhi(w.y) * 0.125f);
            w.z = pack2(bflo(w.z) * 0.125f, bfhi(w.z) * 0.125f); w.w = pack2(bflo(w.w) * 0.125f, bfhi(w.w) * 0.125f);
            qf[qi][ks] = __builtin_bit_cast(bf16x8, w);
        }
#pragma unroll
        for (int br = 0; br < 3; ++br) gates[qi][br] = sigmoidf_(bf2f(prow[C_GATE + g * 12 + L.h * 3 + br]));
    }
    __syncthreads();
    L.cbias = biasT[128 * 4 + L.h];
    f32x4 O[2][4], Y[2][4];
#pragma unroll
    for (int qi = 0; qi < 2; ++qi)
#pragma unroll
        for (int dt = 0; dt < 4; ++dt) { O[qi][dt] = (f32x4){0.f, 0.f, 0.f, 0.f}; Y[qi][dt] = (f32x4){0.f, 0.f, 0.f, 0.f}; }
    u32x4 rk, rv;
    const int nvis_max = (t0 + 63 >= 31) ? ((t0 + 63 - 31) >> 4) + 1 : 0;
    const int ncb = (nvis_max + 63) >> 6;
    const bf16_t* kcb = c.KC + (size_t)bg * 256 * 64; const bf16_t* vcb = c.VCT + (size_t)bg * 64 * 256;
    L.m[0] = L.m[1] = -INFINITY; L.l[0] = L.l[1] = 0.f;
    if (ncb > 0) nsa_prefetch(rk, rv, kcb, 64, vcb, 256, 0, tid);
    for (int cb = 0; cb < ncb; ++cb) {
        nsa_store(lds, cb & 1, rk, rv, tid);
        __syncthreads();
        if (cb + 1 < ncb) nsa_prefetch(rk, rv, kcb, 64, vcb, 256, (cb + 1) * 64, tid);
        if (16 * (cb * 64 + 63) + 31 + 128 <= t0) nsa_tile<1>(O, L, qf, lds, cb & 1, cb * 64, true, true, lane);
        else nsa_tile<0>(O, L, qf, lds, cb & 1, cb * 64, true, true, lane);
    }
    if (ncb > 0) nsa_prefetch(rk, rv, kcb, 64, vcb, 256, 0, tid);
    float mfin[2], linv[2];
#pragma unroll
    for (int qi = 0; qi < 2; ++qi) { mfin[qi] = L.m[qi]; const float lt = quad16_sum(L.l[qi]); linv[qi] = (lt > 0.f) ? __builtin_amdgcn_rcpf(lt) : 0.f; }
    { const float gg[2] = {gates[0][0], gates[1][0]}; nsa_flush(Y, O, L, gg); }
    __syncthreads();
    for (int cb = 0; cb < ncb; ++cb) {
        nsa_store(lds, cb & 1, rk, rv, tid);
        __syncthreads();
        if (cb + 1 < ncb) nsa_prefetch(rk, rv, kcb, 64, vcb, 256, (cb + 1) * 64, tid);
        const bf16_t* sK = (const bf16_t*)(lds + NSA_K0) + (cb & 1) * 64 * TS;
        f32x4 s[2][4];
        nsa_qk(s, sK, qf, lane);
#pragma unroll
        for (int qi = 0; qi < 2; ++qi) {
            float x[4][4];
            nsa_logits<0>(x, s[qi], L.tq[qi], L.h, L.cbias, true, cb * 64, qd, biasT);
            const float mu = (mfin[qi] == -INFINITY) ? 0.f : mfin[qi];
#pragma unroll
            for (int kt = 0; kt < 4; ++kt) {
                float p3 = __expf(x[kt][3] - mu) * linv[qi];
                float pa = (__expf(x[kt][0] - mu) + __expf(x[kt][1] - mu) + __expf(x[kt][2] - mu)) * linv[qi] + p3;
                pa += __shfl_xor(pa, 1); p3 += __shfl_xor(p3, 1);
                pa += __shfl_xor(pa, 2); p3 += __shfl_xor(p3, 2);
                if (L.h == 0) { const int tl = 8 * wave + 4 * qi + ((lane & 15) >> 2), mi = 16 * cb + 4 * kt + qd; impA[tl * 64 + mi] = pa; impB[tl * 64 + mi] = p3; }
            }
        }
    }
    const bf16_t* ksb = pbat + C_KS + g * 64; const bf16_t* vsb = c.VT + ((size_t)0 * 16 + bg) * 64 * SEQ;
    nsa_prefetch(rk, rv, ksb, IN_COLS, vsb, SEQ, 0, tid);
    __syncthreads();
    for (int tl8 = 0; tl8 < 8; ++tl8) {
        const int tl = 8 * wave + tl8, n = lane;
        const bool cand = (n >= 1) && (n <= cur - 2);
        const float imp = cand ? impA[tl * 64 + n] + impB[tl * 64 + n - 1] : -1.0f;
        LDS_WAVE_SYNC();
        scr[n] = imp;
        LDS_WAVE_SYNC();
        int rank = 0;
#pragma unroll 4
        for (int q4 = 0; q4 < 16; ++q4) {
            const f32x4 o = *(const f32x4*)(scr + q4 * 4);
#pragma unroll
            for (int j = 0; j < 4; ++j) { const int n2 = q4 * 4 + j; rank += (o[j] > imp || (o[j] == imp && n2 < n)) ? 1 : 0; }
        }
        const bool forced = (n <= cur) && (n == 0 || n == cur || n == cur - 1);
        const unsigned long long msk = __ballot((cand && rank < 5) || forced);
        if (lane == 0) selm[tl] = msk;
    }
    __syncthreads();
    unsigned long long uni = selm[lane];
#pragma unroll
    for (int o = 32; o >= 1; o >>= 1) { const unsigned lo_ = __shfl_xor((unsigned)uni, o), hi_ = __shfl_xor((unsigned)(uni >> 32), o); uni |= ((unsigned long long)hi_ << 32) | lo_; }
    uni = ((unsigned long long)__builtin_amdgcn_readfirstlane((unsigned)(uni >> 32)) << 32) | (unsigned)__builtin_amdgcn_readfirstlane((unsigned)uni);
    unsigned long long sm[2];
#pragma unroll
    for (int qi = 0; qi < 2; ++qi) sm[qi] = selm[8 * wave + 4 * qi + ((lane & 15) >> 2)];
    L.m[0] = L.m[1] = -INFINITY; L.l[0] = L.l[1] = 0.f;
    {
        unsigned long long rem = uni; int it = 0;
        int j = (int)__builtin_ctzll(rem); rem &= rem - 1;
        for (;;) {
            nsa_store(lds, it & 1, rk, rv, tid);
            __syncthreads();
            const int jn = rem ? (int)__builtin_ctzll(rem) : -1;
            if (jn >= 0) { rem &= rem - 1; nsa_prefetch(rk, rv, ksb, IN_COLS, vsb, SEQ, jn * 64, tid); }
            const bool s0 = (sm[0] >> j) & 1ull, s1 = (sm[1] >> j) & 1ull;
            if (j <= cur - 3) nsa_tile_sel<1>(O, L, qf, lds, it & 1, j * 64, s0, s1, lane);
            else nsa_tile_sel<2>(O, L, qf, lds, it & 1, j * 64, s0, s1, lane);
            if (jn < 0) break;
            j = jn; ++it;
        }
    }
    const bf16_t* kwb = pbat + C_KW + g * 64; const bf16_t* vwb = c.VT + ((size_t)1 * 16 + bg) * 64 * SEQ;
    const int j0 = (cur - 8 > 0) ? cur - 8 : 0;
    nsa_prefetch(rk, rv, kwb, IN_COLS, vwb, SEQ, j0 * 64, tid);
    { const float gg[2] = {gates[0][1], gates[1][1]}; nsa_flush(Y, O, L, gg); }
    L.m[0] = L.m[1] = -INFINITY; L.l[0] = L.l[1] = 0.f;
    {
        __syncthreads();
        for (int j = j0; j <= cur; ++j) {
            nsa_store(lds, (j - j0) & 1, rk, rv, tid);
            __syncthreads();
            if (j + 1 <= cur) nsa_prefetch(rk, rv, kwb, IN_COLS, vwb, SEQ, (j + 1) * 64, tid);
            if (cur - j >= 3 && cur - j <= 7) nsa_tile<1>(O, L, qf, lds, (j - j0) & 1, j * 64, true, true, lane);
            else nsa_tile<3>(O, L, qf, lds, (j - j0) & 1, j * 64, true, true, lane);
        }
    }
    { const float gg[2] = {gates[0][2], gates[1][2]}; nsa_flush(Y, O, L, gg); }
#pragma unroll
    for (int qi = 0; qi < 2; ++qi) {
        bf16_t* yrow = c.PROJ + ((size_t)b * SEQ + L.tq[qi]) * IN_COLS + C_Q + (g * 4 + L.h) * 64;
#pragma unroll
        for (int dt = 0; dt < 4; ++dt) store_bf4(yrow + 16 * dt + 4 * qd, Y[qi][dt]);
    }
}
DI void phase_mix(const Ctx& c, unsigned char* lds) {
    const int G = gridDim.x, bid = blockIdx.x;
    const int n_nsa = NB * 4 * (SEQ / 64), n_scan = NB * 8;
    for (int item = bid; item < n_scan; item += G) scan_chunked_item(c, item, lds);
    unsigned* ctr = c.ctl + CW_Q + c.l;
    volatile int* sitem = (volatile int*)(lds + LDS_BYTES - 32);
    for (;;) {
        __syncthreads();
        if (TID() == 0) *sitem = (int)atomicAdd(ctr, 1u);
        __syncthreads();
        const int k = *sitem;
        if (k >= n_nsa) break;
        const int qt = 63 - (k >> 4), bgi = k & 15;
        nsa_item(c, (bgi << 6) | qt, lds);
    }
}

DI void phase_merge(const Ctx& c, unsigned char* lds) {
    const int nN = DM / 256;
    const bf16_t* WM = (const bf16_t*)(c.ws + WS_WT_MG);
    const bf16_t* BR = (const bf16_t*)(c.ws + WS_WT_BR);
    const float* BM_ = c.in(I_BMG) + (size_t)c.l * 3 * DM;
    bf16_t* TMP = c.F + (size_t)2 * NT * 512 + (size_t)blockIdx.x * 256 * 256;
    for (int it = 0;; ++it) {
        int tm, tn; if (!xcd_unit(it, nN, tm, tn)) break;
        const int m0 = tm * 256, n0 = tn * 256;
#pragma unroll 1
        for (int i = 0; i < 3; ++i) {
            f32x4 acc[8][4];
#pragma unroll
            for (int a_ = 0; a_ < 8; ++a_)
#pragma unroll
                for (int b_ = 0; b_ < 4; ++b_) acc[a_][b_] = (f32x4){0.f, 0.f, 0.f, 0.f};
            gemm256_dma(acc, c.H + (size_t)m0 * DM, DM, WM + (size_t)(i * DM + n0) * DM, DM, DM, lds);
            tile256_store_bf16(acc, TMP, 256, 256, lds);
#pragma unroll
            for (int a_ = 0; a_ < 8; ++a_)
#pragma unroll
                for (int b_ = 0; b_ < 4; ++b_) acc[a_][b_] = (f32x4){0.f, 0.f, 0.f, 0.f};
            {
                const bf16_t* Ab = (i == 0) ? c.POOLED + (size_t)m0 * 512 : ((i == 1) ? c.F + (size_t)5 * NT * 512 + (size_t)m0 * 512 : c.PROJ + C_Q + (size_t)m0 * IN_COLS);
                const size_t la = (i == 2) ? (size_t)IN_COLS : (size_t)512;
                const int Kb = (i == 2) ? 1024 : 512;
                gemm256_dma(acc, Ab, la, BR + (size_t)i * 1024 * 512 + (size_t)n0 * Kb, (size_t)Kb, Kb, lds);
            }
            const int lane = TID() & 63, wave = TID() >> 6, wm = wave >> 2, wn = wave & 3;
            const float* bias = BM_ + i * DM + n0;
#pragma unroll
            for (int mi = 0; mi < 8; ++mi) {
#pragma unroll
                for (int ni = 0; ni < 4; ++ni) {
                    const int r = R256(mi), cc = C256(ni);
                    bf16_t* q = c.MERGED + (size_t)(m0 + r) * DM + n0 + cc;
                    const u32x2 gv = *(const u32x2*)(TMP + r * 256 + cc);
                    const f32x4 bb = *(const f32x4*)(bias + cc);
                    f32x4 m4 = (f32x4){0.f, 0.f, 0.f, 0.f};
                    if (i > 0) { const u32x2 pv = *(const u32x2*)q; m4 = (f32x4){bflo(pv.x), bfhi(pv.x), bflo(pv.y), bfhi(pv.y)}; }
                    m4[0] += sigmoidf_(bflo(gv.x) + bb[0]) * acc[mi][ni][0]; m4[1] += sigmoidf_(bfhi(gv.x) + bb[1]) * acc[mi][ni][1];
                    m4[2] += sigmoidf_(bflo(gv.y) + bb[2]) * acc[mi][ni][2]; m4[3] += sigmoidf_(bfhi(gv.y) + bb[3]) * acc[mi][ni][3];
                    store_bf4(q, m4);
                }
                asm volatile("" ::: "memory"); __builtin_amdgcn_sched_barrier(0);
            }
        }
    }
}

DI void phase_outp(const Ctx& c, unsigned char* lds) {
    const int nN = DM / 256;
    const bf16_t* W = (const bf16_t*)(c.ws + WS_WT_OUT);
    const float* xin = (c.l == 0) ? c.in(I_X) : c.out;
    for (int it = 0;; ++it) {
        int tm, tn; if (!xcd_unit(it, nN, tm, tn)) break;
        const int m0 = tm * 256, n0 = tn * 256;
        f32x4 acc[8][4];
#pragma unroll
        for (int i = 0; i < 8; ++i)
#pragma unroll
            for (int j = 0; j < 4; ++j) acc[i][j] = (f32x4){0.f, 0.f, 0.f, 0.f};
        gemm256_dma(acc, c.MERGED + (size_t)m0 * DM, DM, W + (size_t)n0 * DM, DM, DM, lds);
        const int lane = TID() & 63, wave = TID() >> 6, wm = wave >> 2, wn = wave & 3;
#pragma unroll
        for (int mi = 0; mi < 8; ++mi)
#pragma unroll
            for (int ni = 0; ni < 4; ++ni) {
                const size_t o = (size_t)(m0 + R256(mi)) * DM + n0 + C256(ni);
                const f32x4 x = *(const f32x4*)(xin + o); *(f32x4*)(c.out + o) = x + acc[mi][ni];
            }
    }
    for (int it = blockIdx.x * 4; it < 3 * 32 * 64; it += gridDim.x * 4) {
        const int mat = it / 2048, e = (it >> 6) & 31, tl = it & 63;
        if (mat == 0) convert_tile4(c.in(I_EG) + ((size_t)c.l * 32 + e) * DM * 256, 256, 256, DM, (bf16_t*)(c.ws + WS_EG) + (size_t)e * 256 * DM, tl, lds);
        else if (mat == 1) convert_tile4(c.in(I_EU) + ((size_t)c.l * 32 + e) * DM * 256, 256, 256, DM, (bf16_t*)(c.ws + WS_EU) + (size_t)e * 256 * DM, tl, lds);
        else convert_tile4(c.in(I_ED) + ((size_t)c.l * 32 + e) * 256 * DM, DM, DM, 256, (bf16_t*)(c.ws + WS_ED) + (size_t)e * DM * 256, tl, lds);
    }
}

DI void phase_norm2(const Ctx& c, unsigned char* lds) {
    const int tid = TID(), lane = tid & 63, wave = tid >> 6;
    const float* gain = c.in(I_NFFN) + c.l * DM;
    const float* wrg = c.in(I_WRG) + (size_t)c.l * DM * 4; const float* brg = c.in(I_BRG) + c.l * 4;
    const float* wre = c.in(I_WRE) + (size_t)c.l * DM * 32; const float* bre = c.in(I_BRE) + c.l * 32;
    unsigned* cnt = c.ctl + CW_CNT + c.l * 32;
    constexpr int N2_B01 = 0, N2_B2 = 131072, N2_RS = 147456, N2_LCNT = N2_RS + 256, N2_LG = 0, N2_PART = 16384;
    float* B01 = (float*)(lds + N2_B01); float* B2 = (float*)(lds + N2_B2); float* RS = (float*)(lds + N2_RS);
    unsigned* lcnt = (unsigned*)(lds + N2_LCNT); unsigned* lbase = lcnt + 32;
    for (int rb = blockIdx.x; rb < NT / 64; rb += gridDim.x) {
        const int r0b = rb * 64;
        __syncthreads();
#pragma unroll 4
        for (int p = tid; p < 8192; p += NTHREADS) {
            const f32x4 w = *(const f32x4*)(wre + (size_t)p * 4);
            const int k = p >> 3, c4 = (p & 7) * 4, kb = k >> 4, kq = (k >> 2) & 3, m = k & 3, jj = c4 >> 4, cl = c4 & 15;
            float* d = B01 + (((kb * 2 + jj) * 64 + kq * 16 + cl) * 4) + m;
            d[0] = w[0]; d[4] = w[1]; d[8] = w[2]; d[12] = w[3];
        }
#pragma unroll
        for (int p = tid; p < 1024; p += NTHREADS) {
            const f32x4 w = *(const f32x4*)(wrg + (size_t)p * 4);
            const int kb = p >> 4, kq = (p >> 2) & 3, m = p & 3;
            float* d = B2 + ((kb * 4 + kq) * 4) * 4 + m;
            d[0] = w[0]; d[4] = w[1]; d[8] = w[2]; d[12] = w[3];
        }
        if (tid < 32) lcnt[tid] = 0u;
#pragma unroll
        for (int hb = 0; hb < 2; ++hb) {
            f32x4 v[4][4];
#pragma unroll
            for (int rr = 0; rr < 4; ++rr)
#pragma unroll
                for (int i = 0; i < 4; ++i) v[rr][i] = *(const f32x4*)(c.out + (size_t)(r0b + wave * 8 + hb * 4 + rr) * DM + i * 256 + lane * 4);
#pragma unroll
            for (int rr = 0; rr < 4; ++rr) {
                float ss = 0.f;
#pragma unroll
                for (int i = 0; i < 4; ++i) ss += v[rr][i][0] * v[rr][i][0] + v[rr][i][1] * v[rr][i][1] + v[rr][i][2] * v[rr][i][2] + v[rr][i][3] * v[rr][i][3];
                ss = wave_sum_dpp(ss);
                const float rs = rsqrtf(ss * (1.0f / DM) + 1e-6f);
                if (lane == 0) RS[wave * 8 + hb * 4 + rr] = rs;
#pragma unroll
                for (int i = 0; i < 4; ++i) {
                    const f32x4 g = *(const f32x4*)(gain + i * 256 + lane * 4);
                    store_bf4(c.H + (size_t)(r0b + wave * 8 + hb * 4 + rr) * DM + i * 256 + lane * 4, (f32x4){v[rr][i][0] * rs * g[0], v[rr][i][1] * rs * g[1], v[rr][i][2] * rs * g[2], v[rr][i][3] * rs * g[3]});
                }
            }
        }
        __syncthreads();
        const int tile = wave & 3, kh = wave >> 2, cl = lane & 15, kq = lane >> 4;
        f32x4 acc0 = (f32x4){0.f, 0.f, 0.f, 0.f}, acc1 = acc0, acc2 = acc0;
        {
            const float my_rs = RS[tile * 16 + cl];
            const float* xr = c.out + (size_t)(r0b + tile * 16 + cl) * DM + 4 * kq + kh * 512;
            const float* gr_ = gain + 4 * kq + kh * 512;
            f32x4 xa[4], ga[4];
#pragma unroll
            for (int u = 0; u < 4; ++u) { xa[u] = *(const f32x4*)(xr + u * 16); ga[u] = *(const f32x4*)(gr_ + u * 16); }
#pragma unroll 1
            for (int kb0 = 0; kb0 < 32; kb0 += 4) {
                f32x4 xn[4], gn[4];
                const int kn = (kb0 + 4 < 32) ? kb0 + 4 : kb0;
#pragma unroll
                for (int u = 0; u < 4; ++u) { xn[u] = *(const f32x4*)(xr + (kn + u) * 16); gn[u] = *(const f32x4*)(gr_ + (kn + u) * 16); }
#pragma unroll
                for (int u = 0; u < 4; ++u) {
                    const int kb = kh * 32 + kb0 + u;
                    const f32x4 b0 = *(const f32x4*)(B01 + ((kb * 2 + 0) * 64 + lane) * 4), b1 = *(const f32x4*)(B01 + ((kb * 2 + 1) * 64 + lane) * 4);
                    f32x4 b2 = (f32x4){0.f, 0.f, 0.f, 0.f};
                    if (cl < 4) b2 = *(const f32x4*)(B2 + ((kb * 4 + kq) * 4 + cl) * 4);
#pragma unroll
                    for (int m = 0; m < 4; ++m) {
                        const float am = xa[u][m] * ga[u][m] * my_rs;
                        acc0 = __builtin_amdgcn_mfma_f32_16x16x4f32(am, b0[m], acc0, 0, 0, 0);
                        acc1 = __builtin_amdgcn_mfma_f32_16x16x4f32(am, b1[m], acc1, 0, 0, 0);
                        acc2 = __builtin_amdgcn_mfma_f32_16x16x4f32(am, b2[m], acc2, 0, 0, 0);
                    }
                }
#pragma unroll
                for (int u = 0; u < 4; ++u) { xa[u] = xn[u]; ga[u] = gn[u]; }
            }
        }
        __syncthreads();
        if (kh == 1) { f32x4* pp = (f32x4*)(lds + N2_PART) + (tile * 3) * 64 + lane; pp[0] = acc0; pp[64] = acc1; pp[128] = acc2; }
        __syncthreads();
        int ex0 = 0, ex1 = 0, lr0 = 0, lr1 = 0; float w0_ = 0.f, w1_ = 0.f;
        if (kh == 0) {
            const f32x4* pp = (const f32x4*)(lds + N2_PART) + (tile * 3) * 64 + lane;
            acc0 += pp[0]; acc1 += pp[64]; acc2 += pp[128];
            float* lg = (float*)(lds + N2_LG) + tile * 16 * 36;
#pragma unroll
            for (int i = 0; i < 4; ++i) { const int row = 4 * kq + i; lg[row * 36 + cl] = acc0[i]; lg[row * 36 + 16 + cl] = acc1[i]; if (cl < 4) lg[row * 36 + 32 + cl] = acc2[i]; }
            LDS_WAVE_SYNC();
            if (lane < 16) {
                const float* L = lg + lane * 36;
                float lgp[4];
#pragma unroll
                for (int o = 0; o < 4; ++o) lgp[o] = L[32 + o] + brg[o];
                int grp = 0; float gm = lgp[0];
#pragma unroll
                for (int o = 1; o < 4; ++o) if (lgp[o] > gm) { gm = lgp[o]; grp = o; }
                float gs = 0.f;
#pragma unroll
                for (int o = 0; o < 4; ++o) gs += __expf(lgp[o] - gm);
                const float ptop = 1.0f / gs;
                int i0 = 0; float v0 = -INFINITY; int i1 = 0; float v1 = -INFINITY;
                for (int o = 0; o < 8; ++o) { const float le = L[grp * 8 + o] + bre[grp * 8 + o]; if (le > v0) { v1 = v0; i1 = i0; v0 = le; i0 = o; } else if (le > v1) { v1 = le; i1 = o; } }
                const float e1 = __expf(v1 - v0), inv = 1.0f / (1.0f + e1);
                ex0 = grp * 8 + i0; ex1 = grp * 8 + i1;
                w0_ = inv * ptop; w1_ = e1 * inv * ptop;
                lr0 = (int)atomicAdd(lcnt + ex0, 1u); lr1 = (int)atomicAdd(lcnt + ex1, 1u);
            }
        }
        __syncthreads();
        if (tid < 32) { const unsigned n = lcnt[tid]; lbase[tid] = n ? atomicAdd(cnt + tid, n) : 0u; }
        __syncthreads();
        if (kh == 0 && lane < 16) {
            const int row = r0b + tile * 16 + lane;
            const int q0 = (int)lbase[ex0] + lr0, q1 = (int)lbase[ex1] + lr1;
            int* rt_ = c.ROUTE + (size_t)row * 8;
            rt_[0] = ex0; rt_[1] = ex1; ((float*)rt_)[2] = w0_; ((float*)rt_)[3] = w1_; rt_[4] = q0; rt_[5] = q1;
            int* e0p = c.ENT + ((size_t)ex0 * NT + q0) * 2; e0p[0] = row; ((float*)e0p)[1] = w0_;
            int* e1p = c.ENT + ((size_t)ex1 * NT + q1) * 2; e1p[0] = row; ((float*)e1p)[1] = w1_;
        }
    }
}
DI void moe_tables(const Ctx& c, int* soff, int* stile, int ncol) {
    const unsigned* cnt = c.ctl + CW_CNT + c.l * 32;
    __syncthreads();
    if (TID() == 0) { int s = 0, tt = 0; for (int e = 0; e < 32; ++e) { soff[e] = s; stile[e] = tt; s += (int)cnt[e]; tt += (((int)cnt[e] + 255) >> 8) * ncol; } soff[32] = s; stile[32] = tt; }
    __syncthreads();
}
DI void phase_moe_up(const Ctx& c, unsigned char* lds) {
    int* soff = (int*)(lds + LDS_BYTES - 1024); int* stile = soff + 64;
    moe_tables(c, soff, stile, 1);
    const int total = __builtin_amdgcn_readfirstlane(stile[32]);
    for (int item = blockIdx.x; item < total; item += gridDim.x) {
        int e = 0;
        for (int q = 1; q < 32; ++q) if (stile[q] <= item) e = q;
        e = __builtin_amdgcn_readfirstlane(e);
        const int tm = __builtin_amdgcn_readfirstlane(item - stile[e]);
        const int p0 = __builtin_amdgcn_readfirstlane(soff[e] + tm * 256), pend = __builtin_amdgcn_readfirstlane(soff[e + 1]);
        GatherRows gr; gr.ent = c.ENT + ((size_t)e * NT + (p0 - soff[e])) * 2; gr.n = pend - p0;
        f32x4 acc[8][4];
#pragma unroll
        for (int a_ = 0; a_ < 8; ++a_)
#pragma unroll
            for (int b_ = 0; b_ < 4; ++b_) acc[a_][b_] = (f32x4){0.f, 0.f, 0.f, 0.f};
        gemm256_dma(acc, c.H, DM, (const bf16_t*)(c.ws + WS_EG) + (size_t)e * 256 * DM, DM, DM, lds, &gr);
        { const int lane = TID() & 63, wave = TID() >> 6, wm = wave >> 2, wn = wave & 3;
#pragma unroll
        for (int mi = 0; mi < 8; ++mi)
#pragma unroll
            for (int ni = 0; ni < 4; ++ni) {
                const int r = R256(mi), cc = C256(ni);
                const f32x4 g4 = acc[mi][ni];
                if (p0 + r < pend) store_bf4(c.HID + (size_t)(p0 + r) * 256 + cc, (f32x4){g4[0] * sigmoidf_(g4[0]), g4[1] * sigmoidf_(g4[1]), g4[2] * sigmoidf_(g4[2]), g4[3] * sigmoidf_(g4[3])});
                acc[mi][ni] = (f32x4){0.f, 0.f, 0.f, 0.f};
            }
        }
        gemm256_dma(acc, c.H, DM, (const bf16_t*)(c.ws + WS_EU) + (size_t)e * 256 * DM, DM, DM, lds, &gr);
        const int lane = TID() & 63, wave = TID() >> 6, wm = wave >> 2, wn = wave & 3;
#pragma unroll
        for (int mi = 0; mi < 8; ++mi) {
#pragma unroll
            for (int ni = 0; ni < 4; ++ni) {
                const int r = R256(mi), cc = C256(ni);
                if (p0 + r < pend) { bf16_t* q = c.HID + (size_t)(p0 + r) * 256 + cc; const u32x2 sv = *(const u32x2*)q;
                    store_bf4(q, (f32x4){bflo(sv.x) * acc[mi][ni][0], bfhi(sv.x) * acc[mi][ni][1], bflo(sv.y) * acc[mi][ni][2], bfhi(sv.y) * acc[mi][ni][3]}); }
            }
            asm volatile("" ::: "memory"); __builtin_amdgcn_sched_barrier(0);
        }
    }
}
DI void phase_moe_down(const Ctx& c, unsigned char* lds) {
    int* soff = (int*)(lds + LDS_BYTES - 1024); int* stile = soff + 64;
    moe_tables(c, soff, stile, 4);
    const int total = __builtin_amdgcn_readfirstlane(stile[32]);
    for (int item = blockIdx.x; item < total; item += gridDim.x) {
        int e = 0;
        for (int q = 1; q < 32; ++q) if (stile[q] <= item) e = q;
        e = __builtin_amdgcn_readfirstlane(e);
        const int loc = __builtin_amdgcn_readfirstlane(item - stile[e]), tm = loc >> 2, tn = loc & 3, n0 = tn * 256;
        const int p0 = __builtin_amdgcn_readfirstlane(soff[e] + tm * 256), pend = __builtin_amdgcn_readfirstlane(soff[e + 1]);
        f32x4 acc[8][4];
#pragma unroll
        for (int a_ = 0; a_ < 8; ++a_)
#pragma unroll
            for (int b_ = 0; b_ < 4; ++b_) acc[a_][b_] = (f32x4){0.f, 0.f, 0.f, 0.f};
        gemm256_dma(acc, c.HID + (size_t)p0 * 256, 256, (const bf16_t*)(c.ws + WS_ED) + ((size_t)e * DM + n0) * 256, 256, 256, lds);
        const int lane = TID() & 63, wave = TID() >> 6, wm = wave >> 2, wn = wave & 3;
        const float* wl = (const float*)c.ENT + ((size_t)e * NT + (p0 - soff[e])) * 2 + 1;
#pragma unroll
        for (int mi = 0; mi < 8; ++mi)
#pragma unroll
            for (int ni = 0; ni < 4; ++ni) {
                const int r = R256(mi), cc = C256(ni);
                if (p0 + r < pend) { const float w = wl[2 * r];
                    store_bf4(c.Y + (size_t)(p0 + r) * DM + n0 + cc, (f32x4){acc[mi][ni][0] * w, acc[mi][ni][1] * w, acc[mi][ni][2] * w, acc[mi][ni][3] * w}); }
            }
    }
}
DI void phase_final(const Ctx& c, unsigned char* lds) {
    const int tid = TID(), lane = tid & 63, wave = tid >> 6;
    const float* gain = c.in(I_NFIN);
    int* soff = (int*)(lds + 65536);
    moe_offsets(c, DEPTH - 1, soff);
    for (int row = blockIdx.x * 8 + wave; row < NT; row += gridDim.x * 8) {
        f32x4 v[4];
#pragma unroll
        for (int i = 0; i < 4; ++i) v[i] = *(const f32x4*)(c.out + (size_t)row * DM + i * 256 + lane * 4);
        add_moe_rows(c, row, lane, v, soff);
        float ss = 0.f;
#pragma unroll
        for (int i = 0; i < 4; ++i) ss += v[i][0] * v[i][0] + v[i][1] * v[i][1] + v[i][2] * v[i][2] + v[i][3] * v[i][3];
        ss = wave_sum_dpp(ss);
        const float rs = rsqrtf(ss * (1.0f / DM) + 1e-6f);
#pragma unroll
        for (int i = 0; i < 4; ++i) {
            const f32x4 g = *(const f32x4*)(gain + i * 256 + lane * 4);
            *(f32x4*)(c.out + (size_t)row * DM + i * 256 + lane * 4) = (f32x4){v[i][0] * rs * g[0], v[i][1] * rs * g[1], v[i][2] * rs * g[2], v[i][3] * rs * g[3]};
        }
    }
}

constexpr int PH_PER_LAYER = 11, N_PHASES = DEPTH * PH_PER_LAYER + 1;
__global__ void __launch_bounds__(NTHREADS, 2) fwd_kernel(Params P) {
    extern __shared__ __attribute__((aligned(16))) unsigned char lds[];
    const int lo = P.ph_lo, hi = P.ph_hi;
    LAS unsigned* xbw = (LAS unsigned*)(lds + LDS_BYTES - 16);
    if (threadIdx.x == 0) { xbw[0] = 0u; xbw[1] = 0u; xbw[2] = 0u; xbw[3] = 0u; }
    __syncthreads();
    Ctx c; c.P = &P; c.ws = P.ws; c.out = P.out; c.l = 0;
    c.ctl = (unsigned*)(P.ws + WS_CTL);
    c.H = (bf16_t*)(P.ws + WS_H); c.PROJ = (bf16_t*)(P.ws + WS_PROJ); c.F = (bf16_t*)(P.ws + WS_F); c.POOLED = (bf16_t*)(P.ws + WS_POOLED);
    c.MERGED = (bf16_t*)(P.ws + WS_F); c.CMPH = (bf16_t*)(P.ws + WS_CMPH); c.CMPO = (float*)(P.ws + WS_CMPO); c.POSB = (float*)(P.ws + WS_POSB);
    c.ROUTE = (int*)(P.ws + WS_ROUTE); c.ENT = (int*)(P.ws + WS_ENT); c.HID = (bf16_t*)(P.ws + WS_HID); c.Y = (bf16_t*)(P.ws + WS_Y);
    c.VT = (bf16_t*)(P.ws + WS_VT); c.KC = (bf16_t*)(P.ws + WS_KC); c.VCT = (bf16_t*)(P.ws + WS_VCT); c.YRAW = (bf16_t*)(P.ws + WS_YRAW); c.BON = (float*)(P.ws + WS_BON);
    XcdBarrier bar; bar.bar = c.ctl + CW_BAR; bar.x = 0; bar.st = (volatile LAS unsigned*)xbw;
    if (hi - lo > 1) bar = xcd_barrier_post(c.ctl + CW_BAR, (volatile LAS unsigned*)xbw);
#define IN(k) (lo <= (k) && (k) < hi)
#define SEAM(k) do { if (IN(k) && IN((k) + 1)) xcd_barrier(bar); } while (0)
#pragma unroll 1
    for (int l = 0; l < DEPTH; ++l) {
        c.l = l; const int pb = l * PH_PER_LAYER;
        if (IN(pb + 0)) phase_norm1(c, lds);
        SEAM(pb + 0);
        if (IN(pb + 1)) phase_gemm1(c, lds);
        SEAM(pb + 1);
        if (IN(pb + 2)) phase_prep(c, lds);
        SEAM(pb + 2);
        if (IN(pb + 3)) phase_poolgemm(c, lds);
        SEAM(pb + 3);
        if (IN(pb + 4)) phase_mix(c, lds);
        SEAM(pb + 4);
        if (IN(pb + 5)) phase_rwkv_post(c, lds);
        SEAM(pb + 5);
        if (IN(pb + 6)) phase_merge(c, lds);
        SEAM(pb + 6);
        if (IN(pb + 7)) phase_outp(c, lds);
        SEAM(pb + 7);
        if (IN(pb + 8)) phase_norm2(c, lds);
        SEAM(pb + 8);
        if (IN(pb + 9)) phase_moe_up(c, lds);
        SEAM(pb + 9);
        if (IN(pb + 10)) phase_moe_down(c, lds);
        SEAM(pb + 10);
    }
    if (IN(N_PHASES - 1)) phase_final(c, lds);
}

#ifndef MK_N_LAUNCHES
#define MK_N_LAUNCHES 1
#endif
extern "C" void kernel_launch(void* const* d_in, const int* in_sizes, int n_in, void* d_out, int out_size, void* d_ws, size_t ws_size, hipStream_t stream) {
    static int grid = 0;
    if (grid == 0) {
        if (n_in != N_IN || out_size != NT * DM || ws_size < WS_END) { fprintf(stderr, "kernel_launch: unexpected shapes n_in %d out %d ws %zu (need %zu)\n", n_in, out_size, ws_size, (size_t)WS_END); grid = -1; return; }
        int dev = 0, cus = 0, per_cu = 0;
        if (hipGetDevice(&dev) != hipSuccess || hipDeviceGetAttribute(&cus, hipDeviceAttributeMultiprocessorCount, dev) != hipSuccess) { grid = -1; return; }
        if (hipFuncSetAttribute((const void*)fwd_kernel, hipFuncAttributeMaxDynamicSharedMemorySize, LDS_BYTES) != hipSuccess) { fprintf(stderr, "kernel_launch: hipFuncSetAttribute failed\n"); grid = -1; return; }
        if (hipOccupancyMaxActiveBlocksPerMultiprocessor(&per_cu, (const void*)fwd_kernel, NTHREADS, LDS_BYTES) != hipSuccess || per_cu < 1) { fprintf(stderr, "kernel_launch: occupancy query says %d\n", per_cu); }
        (void)hipGetLastError();
        grid = cus;
    }
    if (grid < 0) return;
    if (hipMemsetAsync((char*)d_ws + WS_CTL, 0, CTL_BYTES, stream) != hipSuccess) return;
    Params p{};
    for (int i = 0; i < N_IN; ++i) p.in[i] = (const float*)d_in[i];
    p.out = (float*)d_out; p.ws = (unsigned char*)d_ws;
    if (MK_N_LAUNCHES == 1) {
        p.ph_lo = 0; p.ph_hi = N_PHASES;
        hipLaunchKernelGGL(fwd_kernel, dim3(grid), dim3(NTHREADS), LDS_BYTES, stream, p);
    } else {
        for (int k = 0; k < N_PHASES; ++k) { p.ph_lo = k; p.ph_hi = k + 1; hipLaunchKernelGGL(fwd_kernel, dim3(grid), dim3(NTHREADS), LDS_BYTES, stream, p); }
    }
}
```

```cpp
#include <hip/hip_runtime.h>
#include <cstdio>
#include <cstdint>

#define DI __device__ __forceinline__
typedef unsigned short bf16_t;
typedef short bf16x8 __attribute__((ext_vector_type(8)));
typedef float f32x4 __attribute__((ext_vector_type(4)));
typedef unsigned u32x4 __attribute__((ext_vector_type(4)));
typedef unsigned u32x2 __attribute__((ext_vector_type(2)));

constexpr int NB = 4, SEQ = 4096, DM = 1024, NT = NB * SEQ, DEPTH = 2;
constexpr int IN_COLS = 4816;
constexpr int C_POOL = 0, C_RW = 512, C_R = 512, C_K = 1024, C_V = 1536, C_WD = 2048, C_AD = 2080, C_GD = 2112;
constexpr int C_Q = 2208, C_KC = 3232, C_VC = 3488, C_KS = 3744, C_VS = 4000, C_KW = 4256, C_VW = 4512, C_GATE = 4768;
constexpr int RWC = 1696;
constexpr int NCMP = 255;
constexpr int NTHREADS = 512;
constexpr int LDS_BYTES = 155648;

enum { I_X = 0, I_RELB, I_NMIX, I_WIN, I_POOLW, I_POOLS, I_MU, I_W0, I_WUP, I_A0, I_AUP, I_GUP, I_KK, I_KA, I_RK, I_GNW, I_GNB,
       I_CPK, I_CW1K, I_CW2K, I_CPV, I_CW1V, I_CW2V, I_WBR, I_WMG, I_BMG, I_WOUT, I_NFFN, I_WRG, I_BRG, I_WRE, I_BRE, I_EG, I_EU, I_ED, I_NFIN, N_IN };

constexpr size_t WS_CTL = 0;
constexpr size_t CTL_BYTES = 65536;
constexpr size_t WS_H = CTL_BYTES;
constexpr size_t WS_PROJ = WS_H + (size_t)NT * DM * 2;
constexpr size_t WS_F = WS_PROJ + (size_t)NT * IN_COLS * 2;
constexpr size_t PLANE = (size_t)NT * 512 * 2;
constexpr size_t WS_POOLED = WS_F + 6 * PLANE;
constexpr size_t WS_CMPH = WS_POOLED + PLANE;
constexpr size_t WS_CMPO = WS_CMPH + (size_t)2 * 4096 * 256 * 2;
constexpr size_t WS_POSB = WS_CMPO + (size_t)2 * 4096 * 64 * 4;
constexpr size_t WS_ROUTE = WS_POSB + 4096;
constexpr size_t WS_ENT = WS_ROUTE + (size_t)NT * 32;
constexpr size_t WS_VT = WS_ENT + (size_t)32 * NT * 8;
constexpr size_t WS_KC = WS_VT + (size_t)2 * 16 * 64 * SEQ * 2;
constexpr size_t WS_VCT = WS_KC + (size_t)16 * 256 * 64 * 2;
constexpr size_t WS_YRAW = WS_VCT + (size_t)16 * 64 * 256 * 2;
constexpr size_t WS_BON = WS_YRAW + (size_t)NT * 512 * 2;
constexpr size_t WS_SMALLW = WS_BON + (size_t)NT * 8 * 16;
constexpr size_t WS_WT_LORA = WS_SMALLW + 262144;
constexpr size_t WS_END = WS_WT_LORA + (size_t)1536 * 128 * 2;
constexpr size_t WS_WT_IN = WS_F;
constexpr size_t WS_WT_C1 = WS_CMPO;
constexpr size_t WS_WT_C2 = WS_SMALLW;
constexpr size_t WS_WT_POOL = WS_SMALLW + 131072;
constexpr size_t WS_WT_MG = WS_VT;
constexpr size_t WS_WT_BR = WS_VT + (size_t)3072 * 1024 * 2;
constexpr size_t WS_WT_OUT = WS_CMPH;
constexpr size_t WS_EG = WS_F + 2 * PLANE;
constexpr size_t WS_EU = WS_EG + (size_t)32 * 256 * 1024 * 2;
constexpr size_t WS_ED = WS_EU + (size_t)32 * 256 * 1024 * 2;
static_assert(WS_ED + (size_t)32 * 1024 * 256 * 2 <= WS_F + 6 * PLANE, "expert alias");
static_assert(WS_WT_BR + (size_t)2048 * 1024 * 2 <= WS_VT + (size_t)2 * 16 * 64 * SEQ * 2, "merge alias");
static_assert((size_t)4864 * 1024 * 2 <= 6 * PLANE, "w_in alias");
constexpr size_t WS_HID = WS_PROJ;
constexpr size_t WS_Y = WS_PROJ + (size_t)2 * NT * 256 * 2;
static_assert(WS_Y + (size_t)2 * NT * 1024 * 2 <= WS_F, "alias");
constexpr int CW_BAR = 0;
constexpr int CW_CNT = 4096;
constexpr int CW_CUR = 4096 + 64;
constexpr int CW_Q = 4096 + 128;

#define XB_TMO      128
#define XB_XCNT(j)  (256  + 64 * (j))
#define XB_XSUB(j)  (1280 + 64 * (j))
#define XB_XGEN(j)  (2304 + 64 * (j))
#define XB_TOP      3328
#define XB_TOPGEN   3392
#define XCD_BAR_WORDS 3456
#define XB_SPIN_CAP (1u << 18)
#define LAS __attribute__((address_space(3)))

__device__ __forceinline__ unsigned xb_ld(unsigned* p)              { return __hip_atomic_load(p, __ATOMIC_RELAXED, __HIP_MEMORY_SCOPE_AGENT); }
__device__ __forceinline__ unsigned xb_add(unsigned* p, unsigned v) { return __hip_atomic_fetch_add(p, v, __ATOMIC_RELAXED, __HIP_MEMORY_SCOPE_AGENT); }
__device__ __forceinline__ unsigned xb_xcc_id() { return (unsigned)__builtin_amdgcn_s_getreg((3 << 11) | 20) & 0xFu; }
#define XB_SPIN(cond, bar) do { unsigned _sp = 0; while (cond) { __builtin_amdgcn_s_sleep(1); \
    if ((++_sp & 255u) == 0u) { if (xb_ld(&(bar)[XB_TMO])) break; if (_sp > XB_SPIN_CAP) { atomicAdd(&(bar)[XB_TMO], 1u); break; } } } } while (0)

struct XcdBarrier { unsigned* bar; unsigned x; volatile LAS unsigned* st; };

__device__ __forceinline__ XcdBarrier xcd_barrier_post(unsigned* bar, volatile LAS unsigned* st) {
    XcdBarrier b; b.bar = bar; b.x = xb_xcc_id(); b.st = st;
    if (threadIdx.x == 0) (void)xb_add(&bar[XB_XCNT(b.x)], 1u);
    return b;
}
__device__ __forceinline__ void xcd_barrier_complete(unsigned* bar, unsigned x, unsigned& nloc, unsigned& nx) {
    const unsigned G = gridDim.x * gridDim.y * gridDim.z;
    unsigned sum, cnt, mine, sp = 0u;
    for (;;) {
        sum = 0u; cnt = 0u; mine = 0u;
#pragma unroll
        for (unsigned j = 0; j < 16; ++j) { const unsigned c = xb_ld(&bar[XB_XCNT(j)]); sum += c; cnt += (c > 0u) ? 1u : 0u; mine = (j == x) ? c : mine; }
        if (sum == G) break;
        __builtin_amdgcn_s_sleep(1);
        if ((++sp & 255u) == 0u) { if (xb_ld(&bar[XB_TMO])) break; if (sp > XB_SPIN_CAP) { atomicAdd(&bar[XB_TMO], 1u); break; } }
    }
    nloc = mine > 0u ? mine : 1u; nx = cnt > 0u ? cnt : 1u;
}
__device__ __forceinline__ void xcd_barrier(const XcdBarrier& b) {
    asm volatile("s_waitcnt vmcnt(0)" ::: "memory");
    __syncthreads();
    if (threadIdx.x == 0) {
        unsigned* bar = b.bar;
        __builtin_amdgcn_s_waitcnt(0);
        unsigned nloc = b.st[0], nx = b.st[1];
        if (nloc == 0u) { xcd_barrier_complete(bar, b.x, nloc, nx); b.st[0] = nloc; b.st[1] = nx; }
        const unsigned old = xb_add(&bar[XB_XSUB(b.x)], 1u);
        const unsigned gen = old / nloc;
        if (old + 1u == (gen + 1u) * nloc) {
            __builtin_amdgcn_fence(__ATOMIC_RELEASE, "agent");
            asm volatile("s_waitcnt vmcnt(0)" ::: "memory");
            const unsigned og = xb_add(&bar[XB_TOP], 1u);
            const unsigned tg = og / nx;
            if (og + 1u == (tg + 1u) * nx) xb_add(&bar[XB_TOPGEN], 1u);
            else XB_SPIN(xb_ld(&bar[XB_TOPGEN]) == tg, bar);
            __builtin_amdgcn_fence(__ATOMIC_ACQUIRE, "agent");
            xb_add(&bar[XB_XGEN(b.x)], 1u);
            asm volatile("s_waitcnt vmcnt(0)" ::: "memory");
        } else {
            XB_SPIN(xb_ld(&bar[XB_XGEN(b.x)]) == gen, bar);
            __builtin_amdgcn_fence(__ATOMIC_ACQUIRE, "agent");
            asm volatile("s_waitcnt vmcnt(0)" ::: "memory");
        }
    }
    __syncthreads();
}

DI bf16_t f2bf(float x) { unsigned u = __float_as_uint(x); u += 0x7fffu + ((u >> 16) & 1u); return (bf16_t)(u >> 16); }
DI float bf2f(bf16_t b) { return __uint_as_float((unsigned)b << 16); }
typedef __bf16 bf16v2_t __attribute__((ext_vector_type(2)));
typedef float f32v2_t __attribute__((ext_vector_type(2)));
DI unsigned pack2(float lo, float hi) { const f32v2_t v = {lo, hi}; const bf16v2_t b = __builtin_convertvector(v, bf16v2_t); return __builtin_bit_cast(unsigned, b); }
DI float bflo(unsigned w) { return __uint_as_float(w << 16); }
DI float bfhi(unsigned w) { return __uint_as_float(w & 0xffff0000u); }
DI float wave_sum(float v) {
#pragma unroll
    for (int o = 32; o >= 1; o >>= 1) v += __shfl_xor(v, o);
    return v;
}
DI float wave_max(float v) {
#pragma unroll
    for (int o = 32; o >= 1; o >>= 1) v = fmaxf(v, __shfl_xor(v, o));
    return v;
}
DI float sigmoidf_(float x) { return __builtin_amdgcn_rcpf(1.0f + __expf(-x)); }
DI int TID() { int t = threadIdx.x; asm volatile("" : "+v"(t)); return t; }
#define LDS_WAVE_SYNC() asm volatile("s_waitcnt lgkmcnt(0)" ::: "memory")

#define DPP_MOV(v, ctrl) __builtin_bit_cast(float, __builtin_amdgcn_update_dpp(0, __builtin_bit_cast(int, (v)), (ctrl), 0xF, 0xF, true))
DI float wave_sum_dpp(float v) {
    v += DPP_MOV(v, 0xB1); v += DPP_MOV(v, 0x4E); v += DPP_MOV(v, 0x141); v += DPP_MOV(v, 0x140);
    return __builtin_bit_cast(float, __builtin_amdgcn_readlane(__builtin_bit_cast(int, v), 0)) + __builtin_bit_cast(float, __builtin_amdgcn_readlane(__builtin_bit_cast(int, v), 16)) +
        (__builtin_bit_cast(float, __builtin_amdgcn_readlane(__builtin_bit_cast(int, v), 32)) + __builtin_bit_cast(float, __builtin_amdgcn_readlane(__builtin_bit_cast(int, v), 48)));
}
struct Params { const float* in[N_IN]; float* out; unsigned char* ws; int ph_lo, ph_hi; };

DI int t5_bucket(int n) {
    if (n < 16) return n;
    if (n >= 128) return 31;
    int b = 16;
    b += (n >= 19) + (n >= 21) + (n >= 24) + (n >= 27) + (n >= 31) + (n >= 35) + (n >= 40) + (n >= 46) + (n >= 52) + (n >= 59) + (n >= 67) + (n >= 77) + (n >= 87) + (n >= 99) + (n >= 113);
    return b;
}

constexpr int G_A = 0, G_B = 256 * 64 * 2, G_STAGE = (256 + 128) * 64 * 2;
static_assert(2 * G_STAGE <= LDS_BYTES - 64, "gemm lds");
DI int g_off(int r, int c) { return ((r >> 4) * 2 + (c >> 5)) * 1024 + ((((r & 15) * 64) + (c & 31) * 2) ^ ((((r & 15) >> 3) & 1) << 5)); }
struct ARows { const bf16_t* p[4]; const float* mu; int ltype; int first; };
DI float tanhf_fast(float x) { const float e = __expf(2.0f * x); return 1.0f - 2.0f * __builtin_amdgcn_rcpf(e + 1.0f); }
DI u32x4 lora_chunk(const bf16_t* prow, bool first, const float* mu, int ltype, int k) {
    const int lim = (ltype == 2) ? 96 : 32;
    if (k >= lim) return (u32x4){0u, 0u, 0u, 0u};
    const int col = C_WD + ltype * 32 + k;
    const u32x4 cu = *(const u32x4*)(prow + col);
    u32x4 pu = (u32x4){0u, 0u, 0u, 0u};
    if (!first) pu = *(const u32x4*)(prow - IN_COLS + col);
    const f32x4 m0 = *(const f32x4*)(mu + col - C_RW), m1 = *(const f32x4*)(mu + col - C_RW + 4);
    float u[8] = {bflo(cu.x), bfhi(cu.x), bflo(cu.y), bfhi(cu.y), bflo(cu.z), bfhi(cu.z), bflo(cu.w), bfhi(cu.w)};
    const float p[8] = {bflo(pu.x), bfhi(pu.x), bflo(pu.y), bfhi(pu.y), bflo(pu.z), bfhi(pu.z), bflo(pu.w), bfhi(pu.w)};
    const float mm[8] = {m0[0], m0[1], m0[2], m0[3], m1[0], m1[1], m1[2], m1[3]};
#pragma unroll
    for (int j = 0; j < 8; ++j) { const float us = u[j] + (p[j] - u[j]) * mm[j]; u[j] = (ltype == 0) ? tanhf_fast(us) : ((ltype == 1) ? us : __builtin_amdgcn_rcpf(1.0f + __expf(-us))); }
    u32x4 w; w.x = pack2(u[0], u[1]); w.y = pack2(u[2], u[3]); w.z = pack2(u[4], u[5]); w.w = pack2(u[6], u[7]);
    return w;
}
template <int AMODE>
DI void g_load(u32x4 (&ra)[4], u32x4 (&rb)[2], const ARows& ar, const bf16_t* bt, int ldb, int k0, int tid) {
    const int kseg = (tid & 7) * 8;
#pragma unroll
    for (int i = 0; i < 4; ++i) {
        ra[i] = (u32x4){0u, 0u, 0u, 0u};
        if (AMODE == 2) ra[i] = lora_chunk(ar.p[i], (ar.first >> i) & 1, ar.mu, ar.ltype, k0 + kseg);
        else if (ar.p[i] != nullptr) ra[i] = *(const u32x4*)((AMODE == 0) ? (ar.p[i] + k0 + kseg) : (ar.p[i] + (size_t)(k0 >> 6) * IN_COLS + kseg));
    }
#pragma unroll
    for (int i = 0; i < 2; ++i) rb[i] = *(const u32x4*)(bt + (size_t)((tid >> 3) + 64 * i) * ldb + k0 + kseg);
}
DI void g_store(unsigned char* st, const u32x4 (&ra)[4], const u32x4 (&rb)[2], int tid) {
    const int off = g_off(tid >> 3, (tid & 7) * 8);
#pragma unroll
    for (int i = 0; i < 4; ++i) *(u32x4*)(st + G_A + off + i * 8192) = ra[i];
#pragma unroll
    for (int i = 0; i < 2; ++i) *(u32x4*)(st + G_B + off + i * 8192) = rb[i];
}
DI void g_compute(f32x4 (&acc)[4][4], const unsigned char* st, int lane, int wm, int wn) {
    const int lo = ((lane & 15) * 64 + (lane >> 4) * 16) ^ ((((lane & 15) >> 3) & 1) << 5);
    const unsigned char* sA = st + G_A + wm * 8192 + lo;
    const unsigned char* sB = st + G_B + wn * 8192 + lo;
    bf16x8 bcur[4], bnxt[4], a0, a1, a2;
#pragma unroll
    for (int i = 0; i < 4; ++i) bcur[i] = *(const bf16x8*)(sB + i * 2048);
    a0 = *(const bf16x8*)(sA);
    a1 = *(const bf16x8*)(sA + 2048);
#define G_AFRAG(s) (*(const bf16x8*)(sA + ((s) & 3) * 2048 + ((s) >> 2) * 1024))
#define G_GROUP(s, acur, anew) do { \
        if ((s) + 2 < 8) anew = G_AFRAG((s) + 2); \
        if ((s) < 4) bnxt[(s) & 3] = *(const bf16x8*)(sB + ((s) & 3) * 2048 + 1024); \
        __builtin_amdgcn_sched_barrier(0); \
        _Pragma("unroll") for (int ni = 0; ni < 4; ++ni) acc[(s) & 3][ni] = __builtin_amdgcn_mfma_f32_16x16x32_bf16(((s) < 4 ? bcur[ni] : bnxt[ni]), acur, acc[(s) & 3][ni], 0, 0, 0); \
        __builtin_amdgcn_sched_barrier(0); } while (0)
    G_GROUP(0, a0, a2); G_GROUP(1, a1, a0); G_GROUP(2, a2, a1); G_GROUP(3, a0, a2);
    G_GROUP(4, a1, a0); G_GROUP(5, a2, a1); G_GROUP(6, a0, a2); G_GROUP(7, a1, a0);
#undef G_GROUP
#undef G_AFRAG
}
#define LDS_BARRIER() do { asm volatile("s_waitcnt lgkmcnt(0)" ::: "memory"); __builtin_amdgcn_s_barrier(); asm volatile("" ::: "memory"); } while (0)
template <int AMODE>
DI void gemm_core(f32x4 (&acc)[4][4], const ARows& ar, const bf16_t* bt  , int ldb, int K, unsigned char* lds) {
    const int tid = TID(), lane = tid & 63, wave = tid >> 6, wm = wave >> 1, wn = wave & 1;
    const int nk = K >> 6;
    unsigned char* s0 = lds; unsigned char* s1 = lds + G_STAGE;
    u32x4 ra0[4], rb0[2], ra1[4], rb1[2];
    g_load<AMODE>(ra0, rb0, ar, bt, ldb, 0, tid);
    g_load<AMODE>(ra1, rb1, ar, bt, ldb, 64, tid);
    __syncthreads();
    g_store(s0, ra0, rb0, tid);
    g_load<AMODE>(ra0, rb0, ar, bt, ldb, (nk > 2 ? 2 : nk - 1) * 64, tid);
    LDS_BARRIER();
    for (int kt = 0; kt < nk; kt += 2) {
        g_store(s1, ra1, rb1, tid);
        { const int kn = (kt + 3 < nk) ? kt + 3 : nk - 1; g_load<AMODE>(ra1, rb1, ar, bt, ldb, kn * 64, tid); }
        g_compute(acc, s0, lane, wm, wn);
        LDS_BARRIER();
        g_store(s0, ra0, rb0, tid);
        { const int kn = (kt + 4 < nk) ? kt + 4 : nk - 1; g_load<AMODE>(ra0, rb0, ar, bt, ldb, kn * 64, tid); }
        g_compute(acc, s1, lane, wm, wn);
        LDS_BARRIER();
    }
}
static_assert(3 * G_STAGE <= LDS_BYTES - 64, "dma ring");
DI void gemm_core_dma(f32x4 (&acc)[4][4], const bf16_t* A, size_t lda, const bf16_t* bt, size_t ldb, int K, unsigned char* lds) {
    const int tid = TID(), lane = tid & 63, wave = __builtin_amdgcn_readfirstlane(tid >> 6), wm = wave >> 1, wn = wave & 1;
    const int nk = K >> 6;
    const int srow = lane >> 2, skof = ((lane & 3) * 8) ^ ((lane >> 5) << 4);
    const char* gp[6]; int loff[6];
#pragma unroll
    for (int j = 0; j < 6; ++j) {
        const int sid = wave * 6 + j;
        if (sid < 32) { gp[j] = (const char*)(A + (size_t)((sid >> 1) * 16 + srow) * lda + (sid & 1) * 32 + skof); loff[j] = G_A + sid * 1024; }
        else { const int s2 = sid - 32; gp[j] = (const char*)(bt + (size_t)((s2 >> 1) * 16 + srow) * ldb + (s2 & 1) * 32 + skof); loff[j] = G_B + s2 * 1024; }
    }
#define DMA_ISSUE(kt_, st_) do { const int _k = ((kt_) < nk ? (kt_) : nk - 1) * 128; \
        _Pragma("unroll") for (int j = 0; j < 6; ++j) __builtin_amdgcn_global_load_lds((const unsigned*)(gp[j] + _k), (LAS unsigned*)(lds + (st_) * G_STAGE + loff[j]), 16, 0, 0); } while (0)
    asm volatile("s_waitcnt vmcnt(0)" ::: "memory");
    __syncthreads();
    DMA_ISSUE(0, 0); DMA_ISSUE(1, 1);
    int st = 0;
    for (int kt = 0; kt < nk; ++kt) {
        asm volatile("s_waitcnt vmcnt(6)" ::: "memory");
        __builtin_amdgcn_s_barrier();
        asm volatile("" ::: "memory");
        const int sn = (st == 0) ? 2 : st - 1;
        DMA_ISSUE(kt + 2, sn);
        g_compute(acc, lds + st * G_STAGE, lane, wm, wn);
        st = (st == 2) ? 0 : st + 1;
    }
    asm volatile("s_waitcnt vmcnt(0)" ::: "memory");
    __syncthreads();
#undef DMA_ISSUE
}
DI void store_bf4(bf16_t* p, f32x4 v) { u32x2 w; w.x = pack2(v[0], v[1]); w.y = pack2(v[2], v[3]); *(u32x2*)p = w; }
#define R256(mi) ((((mi) >> 2) * 128) + wm * 64 + (((mi) & 3) * 16) + (lane & 15))
#define C256(ni) ((((ni) >> 1) * 128) + wn * 32 + (((ni) & 1) * 16) + ((lane >> 4) * 4))
constexpr int HTB = 128 * 64 * 2;
static_assert(8 * HTB <= LDS_BYTES - 1024, "gemm256 lds");
DI int lds_byte(int r, int c) { const int st = (r >> 4) * 2 + (c >> 5), rr = r & 15, cc = c & 31, ob = rr * 64 + cc * 2; return st * 1024 + (ob ^ (((ob >> 9) & 1) << 5)); }
DI void stage_rc(int b, int& R, int& C) { const int st = b / 1024, sb = b % 1024, swz = sb ^ (((sb >> 9) & 1) << 5); R = (st >> 1) * 16 + swz / 64; C = (st & 1) * 32 + (swz % 64) / 2; }
struct GatherRows { const int* ent; int n; };
DI void gemm256_dma(f32x4 (&acc)[8][4], const bf16_t* A, size_t lda, const bf16_t* bt, size_t ldb, int K, unsigned char* lds_, const GatherRows* gr = nullptr) {
    LAS unsigned char* lds = (LAS unsigned char*)lds_;
    const int tid = TID(), wid = __builtin_amdgcn_readfirstlane(tid >> 6), lane = tid & 63, wr = wid >> 2, wc = wid & 3, fr = lane & 15, fq = lane >> 4;
    const int nt = K >> 6;
    unsigned voffA[2][2], voffB[2][2];
#pragma unroll
    for (int i = 0; i < 2; ++i) { int R, C; stage_rc(tid * 16 + i * 8192, R, C);
#pragma unroll
        for (int h = 0; h < 2; ++h) { const int row = h * 128 + R;
            size_t ra = (size_t)row;
            if (gr != nullptr) ra = (size_t)((row < gr->n) ? gr->ent[2 * row] : 0);
            voffA[h][i] = (unsigned)((ra * lda + C) * 2); voffB[h][i] = (unsigned)(((size_t)row * ldb + C) * 2); } }
    const unsigned ldsw = (unsigned)wid * 1024u;
    const int aoff = lds_byte(wr * 64 + fr, fq * 8), boff = lds_byte(wc * 32 + fr, fq * 8);
#define PG8_SA(b, h) (((b) * 2 + (h)) * HTB)
#define PG8_SB(b, h) ((4 + (b) * 2 + (h)) * HTB)
#define PG8_STAGE(bufoff, gbase, voff) do { _Pragma("unroll") for (int _i = 0; _i < 2; ++_i) \
        __builtin_amdgcn_global_load_lds((const unsigned*)((const char*)(gbase) + (voff)[_i]), (LAS unsigned*)(lds + (bufoff) + ldsw + _i * 8192), 16, 0, 0); } while (0)
#define PG8_LDA(dst, b, h) do { _Pragma("unroll") for (int m = 0; m < 4; ++m) _Pragma("unroll") for (int k = 0; k < 2; ++k) dst[m][k] = *(const LAS bf16x8*)(lds + PG8_SA(b, h) + aoff + m * 2048 + k * 1024); } while (0)
#define PG8_LDB(dst, b, h) do { _Pragma("unroll") for (int n = 0; n < 2; ++n) _Pragma("unroll") for (int k = 0; k < 2; ++k) dst[n][k] = *(const LAS bf16x8*)(lds + PG8_SB(b, h) + boff + n * 2048 + k * 1024); } while (0)
#define PG8_MMA(ai, bj, At, Bt) do { __builtin_amdgcn_s_setprio(1); _Pragma("unroll") for (int m = 0; m < 4; ++m) _Pragma("unroll") for (int n = 0; n < 2; ++n) _Pragma("unroll") for (int k = 0; k < 2; ++k) \
        acc[(ai) * 4 + m][(bj) * 2 + n] = __builtin_amdgcn_mfma_f32_16x16x32_bf16(Bt[n][k], At[m][k], acc[(ai) * 4 + m][(bj) * 2 + n], 0, 0, 0); __builtin_amdgcn_s_setprio(0); } while (0)
#define PG8_WAIT_V(n) asm volatile("s_waitcnt vmcnt(" #n ")" ::: "memory")
#define PG8_WAIT_L(n) asm volatile("s_waitcnt lgkmcnt(" #n ")" ::: "memory")
#define PG8_BAR __builtin_amdgcn_s_barrier()
#define PG8_SCHED __builtin_amdgcn_sched_barrier(0)
    bf16x8 At[4][2], B0[2][2], B1[2][2];
    const char* cA = (const char*)A; const char* cB = (const char*)bt;
    const size_t kstep = 128;
    asm volatile("s_waitcnt vmcnt(0)" ::: "memory");
    __syncthreads();
    PG8_STAGE(PG8_SB(0, 0), cB, voffB[0]); PG8_STAGE(PG8_SA(0, 0), cA, voffA[0]); PG8_STAGE(PG8_SB(0, 1), cB, voffB[1]); PG8_STAGE(PG8_SA(0, 1), cA, voffA[1]);
    if (wr == 1) PG8_BAR;
    PG8_WAIT_V(4); PG8_BAR;
    PG8_STAGE(PG8_SB(1, 0), cB + kstep, voffB[0]); PG8_STAGE(PG8_SA(1, 0), cA + kstep, voffA[0]); PG8_STAGE(PG8_SB(1, 1), cB + kstep, voffB[1]);
    PG8_WAIT_V(6); PG8_BAR;
    for (int t = 0; t < nt; t += 2) {
        const bool last = (t == nt - 2);
        const char* a1 = cA + (size_t)(t + 1) * kstep;
        const char* a2 = last ? cA : cA + (size_t)(t + 2) * kstep; const char* b2 = last ? cB : cB + (size_t)(t + 2) * kstep;
        const char* a3 = a2 + kstep; const char* b3 = b2 + kstep;
        PG8_LDB(B0, 0, 0); PG8_SCHED; PG8_LDA(At, 0, 0); PG8_STAGE(PG8_SA(1, 1), a1, voffA[1]);
        PG8_WAIT_L(8); PG8_BAR; PG8_WAIT_L(0); PG8_MMA(0, 0, At, B0); PG8_BAR; PG8_SCHED;
        PG8_LDB(B1, 0, 1); PG8_STAGE(PG8_SB(0, 0), b2, voffB[0]);
        PG8_BAR; PG8_WAIT_L(0); PG8_MMA(0, 1, At, B1); PG8_BAR;
        PG8_LDA(At, 0, 1); PG8_STAGE(PG8_SA(0, 0), a2, voffA[0]);
        PG8_BAR; PG8_WAIT_L(0); PG8_MMA(1, 0, At, B0); PG8_BAR; PG8_SCHED;
        PG8_STAGE(PG8_SB(0, 1), b2, voffB[1]);
        PG8_WAIT_V(6); PG8_BAR; PG8_MMA(1, 1, At, B1); PG8_BAR;
        PG8_LDB(B0, 1, 0); PG8_SCHED; PG8_LDA(At, 1, 0); PG8_STAGE(PG8_SA(0, 1), a2, voffA[1]);
        PG8_WAIT_L(8); PG8_BAR; PG8_WAIT_L(0); PG8_MMA(0, 0, At, B0); PG8_BAR; PG8_SCHED;
        PG8_LDB(B1, 1, 1); PG8_STAGE(PG8_SB(1, 0), b3, voffB[0]);
        PG8_BAR; PG8_WAIT_L(0); PG8_MMA(0, 1, At, B1); PG8_BAR;
        PG8_LDA(At, 1, 1); PG8_STAGE(PG8_SA(1, 0), a3, voffA[0]);
        PG8_BAR; PG8_WAIT_L(0); PG8_MMA(1, 0, At, B0); PG8_BAR; PG8_SCHED;
        PG8_STAGE(PG8_SB(1, 1), b3, voffB[1]);
        PG8_WAIT_V(6); PG8_BAR; PG8_MMA(1, 1, At, B1); PG8_BAR;
    }
    PG8_WAIT_V(0);
    if (wr == 0) PG8_BAR;
    PG8_BAR;
    asm volatile("" ::: "memory");
#undef PG8_SA
#undef PG8_SB
#undef PG8_STAGE
#undef PG8_LDA
#undef PG8_LDB
#undef PG8_MMA
#undef PG8_WAIT_V
#undef PG8_WAIT_L
#undef PG8_BAR
#undef PG8_SCHED
}
DI void tile256_store_bf16(f32x4 (&acc)[8][4], bf16_t* out, size_t ld, int ncols, unsigned char* lds) {
    bf16_t* T = (bf16_t*)lds;
    const int tid = TID(), lane = tid & 63, wave = tid >> 6, wm = wave >> 2, wn = wave & 3;
    __syncthreads();
#pragma unroll
    for (int mi = 0; mi < 8; ++mi)
#pragma unroll
        for (int ni = 0; ni < 4; ++ni) store_bf4(T + R256(mi) * 264 + C256(ni), acc[mi][ni]);
    __syncthreads();
#pragma unroll
    for (int i = 0; i < 16; ++i) {
        const int ch = tid + i * NTHREADS, r = ch >> 5, cc = (ch & 31) * 8;
        if (cc < ncols) *(u32x4*)(out + (size_t)r * ld + cc) = *(const u32x4*)(T + r * 264 + cc);
    }
}
DI void acc_zero(f32x4 (&acc)[4][4]) {
#pragma unroll
    for (int i = 0; i < 4; ++i)
#pragma unroll
        for (int j = 0; j < 4; ++j) acc[i][j] = (f32x4){0.f, 0.f, 0.f, 0.f};
}
#define ACC_FOREACH(acc, body) do { const int _l = TID() & 63, _w = TID() >> 6; \
    _Pragma("unroll") for (int _mi = 0; _mi < 4; ++_mi) _Pragma("unroll") for (int _ni = 0; _ni < 4; ++_ni) { \
        const int r_ = (_w >> 1) * 64 + _mi * 16 + (_l & 15), c_ = (_w & 1) * 64 + _ni * 16 + (_l >> 4) * 4; f32x4& v_ = acc[_mi][_ni]; body } } while (0)
DI ARows plain_rows(const bf16_t* base, size_t ld, int m0, int tid) { ARows a; a.mu = nullptr; a.ltype = 0; a.first = 0;
#pragma unroll
    for (int i = 0; i < 4; ++i) a.p[i] = base + (size_t)(m0 + (tid >> 3) + 64 * i) * ld;
    return a; }


DI void convert_tile4(const float* src, int ld, int N, int K, bf16_t* dst, int tile0, unsigned char* lds, int Kvalid = 1 << 30) {
    const int tid = TID();
    const int nkt = K >> 6;
    const int r = tid >> 3, seg = (tid & 7) * 8;
    f32x4 a[4], b[4];
#pragma unroll
    for (int u = 0; u < 4; ++u) {
        const int tile = tile0 + u, k0 = (tile % nkt) * 64, n0 = (tile / nkt) * 64;
        a[u] = (f32x4){0.f, 0.f, 0.f, 0.f}; b[u] = a[u];
        if (n0 + seg < N && k0 + r < Kvalid) { const float* q = src + (size_t)(k0 + r) * ld + n0 + seg; a[u] = *(const f32x4*)q; b[u] = *(const f32x4*)(q + 4); }
    }
    __syncthreads();
#pragma unroll
    for (int u = 0; u < 4; ++u) { bf16_t* T = (bf16_t*)lds + u * 64 * 72;
        u32x4 w; w.x = pack2(a[u][0], a[u][1]); w.y = pack2(a[u][2], a[u][3]); w.z = pack2(b[u][0], b[u][1]); w.w = pack2(b[u][2], b[u][3]); *(u32x4*)(T + r * 72 + seg) = w; }
    __syncthreads();
#pragma unroll
    for (int u = 0; u < 4; ++u) { const bf16_t* T = (const bf16_t*)lds + u * 64 * 72;
        const int tile = tile0 + u, k0 = (tile % nkt) * 64, n0 = (tile / nkt) * 64;
        u32x4 o;
        o.x = (unsigned)T[(seg + 0) * 72 + r] | ((unsigned)T[(seg + 1) * 72 + r] << 16); o.y = (unsigned)T[(seg + 2) * 72 + r] | ((unsigned)T[(seg + 3) * 72 + r] << 16);
        o.z = (unsigned)T[(seg + 4) * 72 + r] | ((unsigned)T[(seg + 5) * 72 + r] << 16); o.w = (unsigned)T[(seg + 6) * 72 + r] | ((unsigned)T[(seg + 7) * 72 + r] << 16);
        *(u32x4*)(dst + (size_t)(n0 + r) * K + k0 + seg) = o; }
}
struct Ctx {
    const Params* P; unsigned char* ws; float* out; int l;
    bf16_t* H; bf16_t* PROJ; bf16_t* F; bf16_t* POOLED; bf16_t* MERGED; bf16_t* CMPH; float* CMPO; float* POSB; int* ROUTE; int* ENT; bf16_t* HID; bf16_t* Y; bf16_t* VT; bf16_t* KC; bf16_t* VCT; bf16_t* YRAW; float* BON; unsigned* ctl;
    DI const float* in(int i) const { return P->in[i]; }
};

DI void moe_offsets(const Ctx& c, int layer, int* soff) {
    const unsigned* cnt = c.ctl + CW_CNT + layer * 32;
    __syncthreads();
    if (TID() == 0) { int s = 0; for (int e = 0; e < 32; ++e) { soff[e] = s; s += (int)cnt[e]; } soff[32] = s; }
    __syncthreads();
}
DI void add_moe_rows(const Ctx& c, int row, int lane, f32x4 (&v)[4], const int* soff) {
    const int* rt = c.ROUTE + (size_t)row * 8;
    const int p0 = soff[rt[0]] + rt[4], p1 = soff[rt[1]] + rt[5];
    const bf16_t* y0 = c.Y + (size_t)p0 * DM; const bf16_t* y1 = c.Y + (size_t)p1 * DM;
#pragma unroll
    for (int i = 0; i < 4; ++i) {
        const u32x2 a = *(const u32x2*)(y0 + i * 256 + lane * 4), b = *(const u32x2*)(y1 + i * 256 + lane * 4);
        v[i][0] += bflo(a.x) + bflo(b.x); v[i][1] += bfhi(a.x) + bfhi(b.x); v[i][2] += bflo(a.y) + bflo(b.y); v[i][3] += bfhi(a.y) + bfhi(b.y);
    }
}
DI void phase_norm1(const Ctx& c, unsigned char* lds) {
    const int tid = TID(), lane = tid & 63, wave = tid >> 6;
    const float* gain = c.in(I_NMIX) + c.l * DM;
    const float* src = (c.l == 0) ? c.in(I_X) : c.out;
    int* soff = (int*)(lds + 65536);
    if (c.l > 0) moe_offsets(c, c.l - 1, soff);
    for (int row = blockIdx.x * 8 + wave; row < NT; row += gridDim.x * 8) {
        f32x4 v[4];
#pragma unroll
        for (int i = 0; i < 4; ++i) v[i] = *(const f32x4*)(src + (size_t)row * DM + i * 256 + lane * 4);
        if (c.l > 0) {
            add_moe_rows(c, row, lane, v, soff);
#pragma unroll
            for (int i = 0; i < 4; ++i) *(f32x4*)(c.out + (size_t)row * DM + i * 256 + lane * 4) = v[i];
        }
        float ss = 0.f;
#pragma unroll
        for (int i = 0; i < 4; ++i) ss += v[i][0] * v[i][0] + v[i][1] * v[i][1] + v[i][2] * v[i][2] + v[i][3] * v[i][3];
        ss = wave_sum_dpp(ss);
        const float rs = rsqrtf(ss * (1.0f / DM) + 1e-6f);
#pragma unroll
        for (int i = 0; i < 4; ++i) {
            const f32x4 g = *(const f32x4*)(gain + i * 256 + lane * 4);
            store_bf4(c.H + (size_t)row * DM + i * 256 + lane * 4, (f32x4){v[i][0] * rs * g[0], v[i][1] * rs * g[1], v[i][2] * rs * g[2], v[i][3] * rs * g[3]});
        }
    }
    for (int idx = blockIdx.x * 8 + wave; idx < 512; idx += gridDim.x * 8) {
        const int kv = idx >> 8, n = idx & 255;
        const float* pos = c.in(kv ? I_CPV : I_CPK) + (size_t)c.l * 2048;
        const float* w1 = c.in(kv ? I_CW1V : I_CW1K) + (size_t)c.l * 2048 * 256;
        float s = 0.f;
        for (int k = lane; k < 2048; k += 64) s += pos[k] * w1[(size_t)k * 256 + n];
        s = wave_sum_dpp(s);
        if (lane == 0) c.POSB[kv * 256 + n] = s;
    }
    for (int it = blockIdx.x * 4; it < 1216 + 256 + 16 + 16 + 48; it += gridDim.x * 4) {
        if (it < 1216) convert_tile4(c.in(I_WIN) + (size_t)c.l * DM * IN_COLS, IN_COLS, IN_COLS, DM, (bf16_t*)(c.ws + WS_WT_IN), it, lds);
        else if (it < 1216 + 256) { const int j = it - 1216, kv = j >> 7; convert_tile4(c.in(kv ? I_CW1V : I_CW1K) + (size_t)c.l * 2048 * 256, 256, 256, 2048, (bf16_t*)(c.ws + WS_WT_C1) + (size_t)kv * 256 * 2048, j & 127, lds); }
        else if (it < 1216 + 256 + 16) { const int j = it - 1472, kv = j >> 3; convert_tile4(c.in(kv ? I_CW2V : I_CW2K) + (size_t)c.l * 256 * 64, 64, 64, 256, (bf16_t*)(c.ws + WS_WT_C2) + (size_t)kv * 128 * 256, j & 7, lds); }
        else if (it < 1504) { const int j = it - 1488, gi = j >> 2; convert_tile4(c.in(I_POOLW) + ((size_t)c.l * 4 + gi) * 128 * 128, 128, 128, 128, (bf16_t*)(c.ws + WS_WT_POOL) + (size_t)gi * 128 * 128, 0, lds); }
        else { const int j = it - 1504, ty = j >> 4; bf16_t* dst = (bf16_t*)(c.ws + WS_WT_LORA) + (size_t)ty * 512 * 128;
            if (ty == 0) convert_tile4(c.in(I_WUP) + (size_t)c.l * 32 * 512, 512, 512, 128, dst, j & 15, lds, 32);
            else if (ty == 1) convert_tile4(c.in(I_AUP) + (size_t)c.l * 32 * 512, 512, 512, 128, dst, j & 15, lds, 32);
            else convert_tile4(c.in(I_GUP) + (size_t)c.l * 96 * 512, 512, 512, 128, dst, j & 15, lds, 96); }
    }
}

constexpr int EPS = 136;
DI void tile_store_bf16(f32x4 (&acc)[4][4], bf16_t* out, size_t ld, int nrows, int ncols, unsigned char* lds) {
    bf16_t* T = (bf16_t*)lds;
    const int tid = TID();
    __syncthreads();
    ACC_FOREACH(acc, { store_bf4(T + r_ * EPS + c_, v_); });
    __syncthreads();
#pragma unroll
    for (int i = 0; i < 8; ++i) {
        const int ch = tid + i * NTHREADS, r = ch >> 4, cc = (ch & 15) * 8;
        if (r < nrows && cc < ncols) *(u32x4*)(out + (size_t)r * ld + cc) = *(const u32x4*)(T + r * EPS + cc);
    }
}
DI bool xcd_unit(int it, int nN, int& tm, int& tn) {
    const int G = gridDim.x;
    if ((G & 7) != 0 || G < 8) { const int u = it * G + blockIdx.x; if (u >= 64 * nN) return false; tm = u % 64; tn = u / 64; return true; }
    const int x = blockIdx.x & 7, i = blockIdx.x >> 3, per = G >> 3;
    const int u = it * per + i;
    if (u >= 8 * nN) return false;
    tm = x * 8 + (u & 7); tn = u >> 3; return true;
}
DI void phase_gemm1(const Ctx& c, unsigned char* lds) {
    const int nN = (IN_COLS + 255) / 256;
    const bf16_t* WT = (const bf16_t*)(c.ws + WS_WT_IN);
    for (int it = 0;; ++it) {
        int tm, tn; if (!xcd_unit(it, nN, tm, tn)) break;
        const int m0 = tm * 256, n0 = tn * 256;
        f32x4 acc[8][4];
#pragma unroll
        for (int i = 0; i < 8; ++i)
#pragma unroll
            for (int j = 0; j < 4; ++j) acc[i][j] = (f32x4){0.f, 0.f, 0.f, 0.f};
        gemm256_dma(acc, c.H + (size_t)m0 * DM, DM, WT + (size_t)n0 * DM, DM, DM, lds);
        tile256_store_bf16(acc, c.PROJ + (size_t)m0 * IN_COLS + n0, IN_COLS, (IN_COLS - n0 < 256) ? IN_COLS - n0 : 256, lds);
    }
}

DI float gelu_tanh(float x) { const float u = 0.7978845608028654f * (x + 0.044715f * x * x * x); const float e = __expf(2.0f * u); return x * (1.0f - __builtin_amdgcn_rcpf(e + 1.0f)); }
DI float softplusf_(float x) { return (x > 20.f) ? x : __logf(1.0f + __expf(x)); }
DI float tanhf_(float x) { const float e = __expf(2.0f * x); return 1.0f - 2.0f * __builtin_amdgcn_rcpf(e + 1.0f); }
constexpr int TKP = 8;
template <int WIN>
DI void pool_emit(const Ctx& c, const float (&pv)[31], int t0, int s0, int ch) {
#pragma unroll
    for (int k = 0; k < 16; ++k) {
        float sum = 0.f;
#pragma unroll
        for (int j = 0; j < WIN; ++j) sum += pv[15 + k - j];
        const int s = s0 + k, cnt = (s + 1 < WIN) ? s + 1 : WIN;
        c.POOLED[(size_t)(t0 + k) * 512 + ch] = f2bf(sum / (float)cnt - pv[15 + k]);
    }
}
DI void phase_prep(const Ctx& c, unsigned char* lds) {
    const int n_cmp_items = 2 * 16 * 2;
    for (int item = (int)gridDim.x - 1 - (int)blockIdx.x; item < n_cmp_items; item += gridDim.x) {
        const int tid = TID();
        const int kv = item >> 5, bgi = (item >> 1) & 15, tn = item & 1, m0 = bgi * 256, n0 = tn * 128;
        ARows ar; ar.mu = nullptr; ar.ltype = 0; ar.first = 0;
#pragma unroll
        for (int i = 0; i < 4; ++i) { const int cb = (tid >> 3) + 64 * i;
            ar.p[i] = (cb < NCMP) ? c.PROJ + ((size_t)(bgi >> 2) * SEQ + 16 * cb) * IN_COLS + (kv ? C_VC : C_KC) + (bgi & 3) * 64 : nullptr; }
        f32x4 acc[4][4]; acc_zero(acc);
        gemm_core<1>(acc, ar, (const bf16_t*)(c.ws + WS_WT_C1) + ((size_t)kv * 256 + n0) * 2048, 2048, 2048, lds);
        const float* pb = c.POSB + kv * 256;
        ACC_FOREACH(acc, {
            const f32x4 bb = *(const f32x4*)(pb + n0 + c_);
            store_bf4(c.CMPH + ((size_t)kv * 4096 + m0 + r_) * 256 + n0 + c_, (f32x4){gelu_tanh(v_[0] + bb[0]), gelu_tanh(v_[1] + bb[1]), gelu_tanh(v_[2] + bb[2]), gelu_tanh(v_[3] + bb[3])}); });
    }
    {
        const float* mu = c.in(I_MU) + (size_t)c.l * RWC;
        const bf16_t* WL = (const bf16_t*)(c.ws + WS_WT_LORA);
        const int G_ = gridDim.x, bid_ = blockIdx.x;
        const bool bal = (G_ == 256);
        const bool cmpb = bal && bid_ >= 192;
        for (int ui = 0;; ++ui) {
            int unit;
            if (!bal) { unit = bid_ + ui * G_; if (unit >= 768) break; }
            else if (cmpb) { if (ui >= 2) break; unit = (bid_ - 192) * 2 + ui; }
            else { unit = 128 + bid_ + 192 * ui; if (unit >= 768) break; }
            const int tid = TID();
            const int tm = unit & 63, tn = unit >> 6, m0 = tm * 256, n0 = tn * 128, ltype = tn >> 2, ch0 = n0 & 511;
            ARows ar; ar.mu = mu; ar.ltype = ltype; ar.first = 0;
#pragma unroll
            for (int i = 0; i < 4; ++i) { const int t = m0 + (tid >> 3) + 64 * i; ar.p[i] = c.PROJ + (size_t)t * IN_COLS; if ((t & (SEQ - 1)) == 0) ar.first |= 1 << i; }
            f32x4 acc[4][4]; acc_zero(acc);
            gemm_core<2>(acc, ar, WL + (size_t)n0 * 128, 128, 128, lds);
            if (ltype == 0) { const float* w0 = c.in(I_W0) + c.l * 512 + ch0;
                ACC_FOREACH(acc, { const f32x4 b4 = *(const f32x4*)(w0 + c_);
                    for (int j = 0; j < 4; ++j) v_[j] = __expf(-softplusf_(-(b4[j] + v_[j])) - 0.5f); }); }
            else if (ltype == 1) { const float* a0 = c.in(I_A0) + c.l * 512 + ch0;
                ACC_FOREACH(acc, { const f32x4 b4 = *(const f32x4*)(a0 + c_);
                    for (int j = 0; j < 4; ++j) v_[j] = sigmoidf_(b4[j] + v_[j]); }); }
            tile_store_bf16(acc, c.F + (size_t)(3 + ltype) * NT * 512 + (size_t)m0 * 512 + ch0, 512, 256, 128, lds);
        }
    }
    const int tid = TID();
    const int n_pool_items = NT / 16, n_items = n_pool_items + 512;
    const bool bal2 = (gridDim.x == 256);
    const int istep = bal2 ? 192 : (int)gridDim.x;
    for (int item = (bal2 && blockIdx.x >= 192) ? n_items : (int)blockIdx.x; item < n_items; item += istep) {
        if (item >= n_pool_items) {
            const int idx0 = (item - n_pool_items) * 4;
            const int r = tid >> 3, seg = (tid & 7) * 8;
            u32x4 w[4];
#pragma unroll
            for (int u = 0; u < 4; ++u) { const int idx = idx0 + u, kind = idx >> 10, bgi = (idx >> 6) & 15, s0 = (idx & 63) * 64;
                w[u] = *(const u32x4*)(c.PROJ + ((size_t)(bgi >> 2) * SEQ + s0 + r) * IN_COLS + (kind ? C_VW : C_VS) + (bgi & 3) * 64 + seg); }
            __syncthreads();
#pragma unroll
            for (int u = 0; u < 4; ++u) *(u32x4*)((bf16_t*)lds + u * 64 * 72 + r * 72 + seg) = w[u];
            __syncthreads();
#pragma unroll
            for (int u = 0; u < 4; ++u) { const int idx = idx0 + u, kind = idx >> 10, bgi = (idx >> 6) & 15, s0 = (idx & 63) * 64;
                const bf16_t* T = (const bf16_t*)lds + u * 64 * 72;
                u32x4 o;
                o.x = (unsigned)T[(seg + 0) * 72 + r] | ((unsigned)T[(seg + 1) * 72 + r] << 16); o.y = (unsigned)T[(seg + 2) * 72 + r] | ((unsigned)T[(seg + 3) * 72 + r] << 16);
                o.z = (unsigned)T[(seg + 4) * 72 + r] | ((unsigned)T[(seg + 5) * 72 + r] << 16); o.w = (unsigned)T[(seg + 6) * 72 + r] | ((unsigned)T[(seg + 7) * 72 + r] << 16);
                *(u32x4*)(c.VT + (((size_t)kind * 16 + bgi) * 64 + r) * SEQ + s0 + seg) = o; }
        } else {
            const int t0 = item * 16, ch = tid, gi = ch >> 7, s0 = t0 & (SEQ - 1);
            float pv[31];
#pragma unroll
            for (int i = 0; i < 31; ++i) pv[i] = (s0 - 15 + i >= 0) ? bf2f(c.PROJ[(size_t)(t0 - 15 + i) * IN_COLS + C_POOL + ch]) : 0.f;
            if (gi == 0) pool_emit<2>(c, pv, t0, s0, ch);
            else if (gi == 1) pool_emit<4>(c, pv, t0, s0, ch);
            else if (gi == 2) pool_emit<8>(c, pv, t0, s0, ch);
            else pool_emit<16>(c, pv, t0, s0, ch);
        }
    }
}

DI void rwkv_finalize_item(const Ctx& c, int item) {
    const int tid = TID(), ch = tid, t0 = item * 8;
    const float* mu = c.in(I_MU) + (size_t)c.l * RWC;
    const float kkw_ = c.in(I_KK)[c.l * 512 + ch], kaw_ = c.in(I_KA)[c.l * 512 + ch], rkw_ = c.in(I_RK)[c.l * 512 + ch];
    const float mur = mu[ch], muk = mu[512 + ch], muv = mu[1024 + ch];
    bf16_t ur[9], uk[9], uv[9], ua[8];
    const bool has_prev = (t0 & (SEQ - 1)) != 0;
#pragma unroll
    for (int k = 0; k < 9; ++k) {
        ur[k] = 0; uk[k] = 0; uv[k] = 0;
        if (k > 0 || has_prev) { const bf16_t* q = c.PROJ + (size_t)(t0 - 1 + k) * IN_COLS; ur[k] = q[C_R + ch]; uk[k] = q[C_K + ch]; uv[k] = q[C_V + ch]; }
    }
#pragma unroll
    for (int k = 0; k < 8; ++k) ua[k] = c.F[(size_t)4 * NT * 512 + (size_t)(t0 + k) * 512 + ch];
#pragma unroll
    for (int k = 0; k < 8; ++k) {
        const int t = t0 + k;
        const float cr = bf2f(ur[k + 1]), ck = bf2f(uk[k + 1]), cv = bf2f(uv[k + 1]);
        const float r = cr + (bf2f(ur[k]) - cr) * mur, kx = ck + (bf2f(uk[k]) - ck) * muk, vx = cv + (bf2f(uv[k]) - cv) * muv;
        const float a = bf2f(ua[k]);
        const float kxn = kx * kkw_, kp = kx * (1.0f + (a - 1.0f) * kaw_);
        const float ss = wave_sum_dpp(kxn * kxn);
        const float inv = __builtin_amdgcn_rsqf(fmaxf(ss, 1e-24f));
        const float br = wave_sum_dpp(kxn * inv * a * r), kr = wave_sum_dpp(kp * r), bon = wave_sum_dpp(r * kp * rkw_);
        if ((tid & 63) == 0) *(f32x4*)(c.BON + ((size_t)t * 8 + (tid >> 6)) * 4) = (f32x4){inv, br, kr, bon};
        const size_t o = (size_t)t * 512 + ch;
        c.F[o] = f2bf(r); c.F[o + (size_t)NT * 512] = f2bf(kx); c.F[o + (size_t)2 * NT * 512] = f2bf(vx);
    }
}

DI void phase_poolgemm(const Ctx& c, unsigned char* lds) {
    for (int item = blockIdx.x; item < NT / 8; item += gridDim.x) rwkv_finalize_item(c, item);
    const int n_pool = (NT / 256) * 4, n_items = n_pool + 32;
    for (int item = blockIdx.x; item < n_items; item += gridDim.x) {
        f32x4 acc[4][4]; acc_zero(acc);
        if (item < n_pool) {
            const int tm = item >> 2, gi = item & 3, m0 = tm * 256;
            const ARows ar = plain_rows(c.POOLED + gi * 128, 512, m0, TID());
            gemm_core<0>(acc, ar, (const bf16_t*)(c.ws + WS_WT_POOL) + (size_t)gi * 128 * 128, 128, 128, lds);
            const float* sc = c.in(I_POOLS) + c.l * 512 + gi * 128;
            ACC_FOREACH(acc, { const f32x4 s = *(const f32x4*)(sc + c_);
                store_bf4(c.POOLED + (size_t)(m0 + r_) * 512 + gi * 128 + c_, (f32x4){v_[0] * s[0], v_[1] * s[1], v_[2] * s[2], v_[3] * s[3]}); });
        } else {
            const int it = item - n_pool, kv = it >> 4, tm = it & 15, m0 = tm * 256;
            const ARows ar = plain_rows(c.CMPH + (size_t)kv * 4096 * 256, 256, m0, TID());
            gemm_core<0>(acc, ar, (const bf16_t*)(c.ws + WS_WT_C2) + (size_t)kv * 128 * 256, 256, 256, lds);
            ACC_FOREACH(acc, { if (c_ < 64) { const int R = m0 + r_;
                if (kv == 0) store_bf4(c.KC + (size_t)R * 64 + c_, v_);
                else { bf16_t* q = c.VCT + ((size_t)(R >> 8) * 64 + c_) * 256 + (R & 255); q[0] = f2bf(v_[0]); q[256] = f2bf(v_[1]); q[512] = f2bf(v_[2]); q[768] = f2bf(v_[3]); } } });
        }
    }
}

constexpr int SCH = 32;
constexpr int SB_AN = 0, SB_WR = SCH * 64 * 4, SB_W = 2 * SCH * 64 * 4, SB_BB = 3 * SCH * 64 * 4, SB_KP = 4 * SCH * 64 * 4;
constexpr int SB_V = 5 * SCH * 64 * 4;
constexpr int SB_SC = SB_V + SCH * 16 * 4;
constexpr int SB_Y = SB_SC + SCH * 2 * 4;
constexpr int SB_BYTES = SB_Y + SCH * 16 * 4;
static_assert(2 * SB_BYTES <= LDS_BYTES - 64, "scan lds");
typedef float f32x2 __attribute__((ext_vector_type(2)));
DI float row8_sum(float v) { v += DPP_MOV(v, 0xB1); v += DPP_MOV(v, 0x4E); v += DPP_MOV(v, 0x141); return v; }

constexpr int NPW = 6, NJ = (SCH + NPW - 1) / NPW;
struct PrepRegs { bf16_t r[NJ], k[NJ], v[NJ], e[NJ], a[NJ]; float s0[NJ], s1[NJ], s2[NJ]; };
DI void prep_load(PrepRegs& R, const Ctx& c, int b, int h, int ck, int pw, int lane) {
    const size_t PL = (size_t)NT * 512;
    const size_t tb = (size_t)b * SEQ + ck * SCH;
    const size_t o0 = tb * 512 + h * 64 + lane;
#pragma unroll
    for (int j = 0; j < NJ; ++j) {
        const int st = pw + NPW * j;
        if (st < SCH) { const size_t o = o0 + (size_t)st * 512; R.r[j] = c.F[o]; R.k[j] = c.F[o + PL]; R.v[j] = c.F[o + 2 * PL]; R.e[j] = c.F[o + 3 * PL]; R.a[j] = c.F[o + 4 * PL];
            const float* sp = c.BON + ((tb + st) * 8 + h) * 4; R.s0[j] = sp[0]; R.s1[j] = sp[1]; R.s2[j] = sp[2]; }
    }
}
DI void prep_store(const PrepRegs& R, unsigned char* sb, int rq, int pw, int lane, float kkw, float kaw) {
    float* an = (float*)(sb + SB_AN); float* wr = (float*)(sb + SB_WR); float* w_ = (float*)(sb + SB_W); float* bb_ = (float*)(sb + SB_BB); float* kp_ = (float*)(sb + SB_KP);
    float* vv = (float*)(sb + SB_V); float* sc = (float*)(sb + SB_SC);
#pragma unroll
    for (int j = 0; j < NJ; ++j) {
        const int st = pw + NPW * j;
        if (st < SCH) {
            const float r = bf2f(R.r[j]), k = bf2f(R.k[j]), v = bf2f(R.v[j]), e = bf2f(R.e[j]), a = bf2f(R.a[j]);
            const float w = __expf(-e);
            const float kk = k * kkw * R.s0[j];
            const float kp = k * (1.0f + (a - 1.0f) * kaw);
            an[st * 64 + lane] = -kk; wr[st * 64 + lane] = w * r; w_[st * 64 + lane] = w; bb_[st * 64 + lane] = kk * a; kp_[st * 64 + lane] = kp;
            if ((lane >> 4) == rq) vv[st * 16 + (lane & 15)] = v;
            if (lane == 0) { sc[st * 2] = R.s1[j]; sc[st * 2 + 1] = R.s2[j]; }
        }
    }
}
DI void scan_item(const Ctx& c, int item, unsigned char* lds) {
    const int tid = TID(), lane = tid & 63, wave = tid >> 6;
    const int b = item >> 5, h = (item >> 2) & 7, rq = item & 3;
    const int chn = h * 64 + lane;
    const float kkw = c.in(I_KK)[c.l * 512 + chn], kaw = c.in(I_KA)[c.l * 512 + chn];
    const int rowl = (tid & 127) >> 3, cg = tid & 7;
    f32x2 st[4];
#pragma unroll
    for (int i = 0; i < 4; ++i) st[i] = (f32x2){0.f, 0.f};
    constexpr int NCK = SEQ / SCH;
    PrepRegs R;
    __syncthreads();
    if (wave >= 2) { prep_load(R, c, b, h, 0, wave - 2, lane); prep_store(R, lds, rq, wave - 2, lane, kkw, kaw); prep_load(R, c, b, h, 1, wave - 2, lane); }
    __syncthreads();
    for (int ck = 0; ck < NCK; ++ck) {
        unsigned char* sb = lds + (ck & 1) * SB_BYTES;
        if (wave < 2) {
            const float* an = (const float*)(sb + SB_AN) + cg * 8; const float* wr = (const float*)(sb + SB_WR) + cg * 8; const float* w_ = (const float*)(sb + SB_W) + cg * 8;
            const float* bb_ = (const float*)(sb + SB_BB) + cg * 8; const float* kp_ = (const float*)(sb + SB_KP) + cg * 8;
            const float* vv = (const float*)(sb + SB_V) + rowl; const float* sc = (const float*)(sb + SB_SC); float* yb = (float*)(sb + SB_Y) + rowl;
            f32x4 a0 = *(const f32x4*)(an), a1 = *(const f32x4*)(an + 4), r0 = *(const f32x4*)(wr), r1 = *(const f32x4*)(wr + 4);
            f32x4 w0 = *(const f32x4*)(w_), w1 = *(const f32x4*)(w_ + 4), b0 = *(const f32x4*)(bb_), b1 = *(const f32x4*)(bb_ + 4);
            f32x4 k0 = *(const f32x4*)(kp_), k1 = *(const f32x4*)(kp_ + 4);
            float v = vv[0]; f32x2 bk = *(const f32x2*)(sc);
#pragma unroll 2
            for (int s = 0; s < SCH; ++s) {
                const int sn = (s + 1 < SCH) ? s + 1 : s;
                const f32x4 na0 = *(const f32x4*)(an + sn * 64), na1 = *(const f32x4*)(an + sn * 64 + 4), nr0 = *(const f32x4*)(wr + sn * 64), nr1 = *(const f32x4*)(wr + sn * 64 + 4);
                const f32x4 nw0 = *(const f32x4*)(w_ + sn * 64), nw1 = *(const f32x4*)(w_ + sn * 64 + 4), nb0 = *(const f32x4*)(bb_ + sn * 64), nb1 = *(const f32x4*)(bb_ + sn * 64 + 4);
                const f32x4 nk0 = *(const f32x4*)(kp_ + sn * 64), nk1 = *(const f32x4*)(kp_ + sn * 64 + 4);
                const float nv = vv[sn * 16]; const f32x2 nbk = *(const f32x2*)(sc + sn * 2);
                f32x2 da = st[0] * (f32x2){a0[0], a0[1]}; f32x2 dr = st[0] * (f32x2){r0[0], r0[1]};
                da += st[1] * (f32x2){a0[2], a0[3]}; dr += st[1] * (f32x2){r0[2], r0[3]};
                da += st[2] * (f32x2){a1[0], a1[1]}; dr += st[2] * (f32x2){r1[0], r1[1]};
                da += st[3] * (f32x2){a1[2], a1[3]}; dr += st[3] * (f32x2){r1[2], r1[3]};
                float sa = da[0] + da[1], sr = dr[0] + dr[1];
                sa += DPP_MOV(sa, 0xB1); sr += DPP_MOV(sr, 0xB1);
                sa += DPP_MOV(sa, 0x4E); sr += DPP_MOV(sr, 0x4E);
                sa += DPP_MOV(sa, 0x141); sr += DPP_MOV(sr, 0x141);
                const f32x2 sa2 = (f32x2){sa, sa}, v2 = (f32x2){v, v};
                st[0] = st[0] * (f32x2){w0[0], w0[1]} + sa2 * (f32x2){b0[0], b0[1]} + v2 * (f32x2){k0[0], k0[1]};
                st[1] = st[1] * (f32x2){w0[2], w0[3]} + sa2 * (f32x2){b0[2], b0[3]} + v2 * (f32x2){k0[2], k0[3]};
                st[2] = st[2] * (f32x2){w1[0], w1[1]} + sa2 * (f32x2){b1[0], b1[1]} + v2 * (f32x2){k1[0], k1[1]};
                st[3] = st[3] * (f32x2){w1[2], w1[3]} + sa2 * (f32x2){b1[2], b1[3]} + v2 * (f32x2){k1[2], k1[3]};
                yb[s * 16] = sr + sa * bk[0] + v * bk[1];
                a0 = na0; a1 = na1; r0 = nr0; r1 = nr1; w0 = nw0; w1 = nw1; b0 = nb0; b1 = nb1; k0 = nk0; k1 = nk1; v = nv; bk = nbk;
            }
        } else {
            const int pt = tid - 128;
            if (ck + 1 < NCK) prep_store(R, lds + ((ck + 1) & 1) * SB_BYTES, rq, wave - 2, lane, kkw, kaw);
            if (ck + 2 < NCK) prep_load(R, c, b, h, ck + 2, wave - 2, lane);
            if (ck > 0) {
                const float* yb = (const float*)(lds + ((ck - 1) & 1) * SB_BYTES + SB_Y);
                for (int idx = pt; idx < SCH * 16; idx += 384) {
                    const int s = idx >> 4, j = idx & 15;
                    c.YRAW[((size_t)b * SEQ + (ck - 1) * SCH + s) * 512 + h * 64 + rq * 16 + j] = f2bf(yb[idx]);
                }
            }
        }
        asm volatile("s_waitcnt lgkmcnt(0)" ::: "memory"); __builtin_amdgcn_s_barrier(); asm volatile("" ::: "memory");
    }
    {
        const float* yb = (const float*)(lds + ((NCK - 1) & 1) * SB_BYTES + SB_Y);
        for (int idx = tid; idx < SCH * 16; idx += NTHREADS) {
            const int s = idx >> 4, j = idx & 15;
            c.YRAW[((size_t)b * SEQ + (NCK - 1) * SCH + s) * 512 + h * 64 + rq * 16 + j] = f2bf(yb[idx]);
        }
    }
    __syncthreads();
}
constexpr int CS64 = 72, CS32 = 40;
constexpr int CK_AH = 0, CK_BH = CK_AH + 32 * CS64 * 2, CK_KH = CK_BH + 32 * CS64 * 2, CK_RH = CK_KH + 32 * CS64 * 2;
constexpr int CK_BHT = CK_RH + 32 * CS64 * 2, CK_KHT = CK_BHT + 64 * CS32 * 2, CK_VT = CK_KHT + 64 * CS32 * 2, CK_ZT = CK_VT + 64 * CS32 * 2, CK_UT = CK_ZT + 64 * CS32 * 2;
constexpr int CK_S0B = CK_UT + 64 * CS32 * 2;
constexpr int CK_LAK = CK_S0B + 2 * 64 * CS64 * 2, CK_MRB = CK_LAK + 32 * CS32 * 2, CK_MRK = CK_MRB + 32 * CS32 * 2;
constexpr int CK_PA = CK_MRK + 32 * CS32 * 2, CK_PT = CK_PA + 2 * 32 * CS32 * 2, CK_TT = CK_PT + 2 * 32 * CS32 * 2;
constexpr int CK_TOT = CK_TT + 2 * 32 * CS32 * 2;
constexpr int CK_GC = CK_TOT + 8 * 64 * 4;
constexpr int CK_END = CK_GC + 256;
static_assert(CK_END <= LDS_BYTES - 64, "chunk scan lds");
template <int K>
DI f32x4 mm16(const bf16_t* A, int lda, const bf16_t* Bt, int ldb, f32x4 acc, int lane) {
#pragma unroll
    for (int k0 = 0; k0 < K; k0 += 32) {
        const bf16x8 a = *(const bf16x8*)(A + (lane & 15) * lda + k0 + (lane >> 4) * 8), b = *(const bf16x8*)(Bt + (lane & 15) * ldb + k0 + (lane >> 4) * 8);
        acc = __builtin_amdgcn_mfma_f32_16x16x32_bf16(a, b, acc, 0, 0, 0);
    }
    return acc;
}
template <int K>
DI f32x4 mm16t(const bf16_t* A, int lda, const bf16_t* Bt, int ldb, f32x4 acc, int lane) {
#pragma unroll
    for (int k0 = 0; k0 < K; k0 += 32) {
        const bf16x8 a = *(const bf16x8*)(A + (lane & 15) * lda + k0 + (lane >> 4) * 8), b = *(const bf16x8*)(Bt + (lane & 15) * ldb + k0 + (lane >> 4) * 8);
        acc = __builtin_amdgcn_mfma_f32_16x16x32_bf16(b, a, acc, 0, 0, 0);
    }
    return acc;
}
DI void mm16_both(const bf16_t* A, int lda, const bf16_t* Bt, int ldb, f32x4& cn, f32x4& ct, int lane) {
    const bf16x8 a = *(const bf16x8*)(A + (lane & 15) * lda + (lane >> 4) * 8), b = *(const bf16x8*)(Bt + (lane & 15) * ldb + (lane >> 4) * 8);
    cn = __builtin_amdgcn_mfma_f32_16x16x32_bf16(a, b, cn, 0, 0, 0); ct = __builtin_amdgcn_mfma_f32_16x16x32_bf16(b, a, ct, 0, 0, 0);
}
struct ChunkRaw { bf16_t r[4], k[4], v[4], e[4], a[4]; float inv[4]; };
DI void chunk_load(ChunkRaw& R, const Ctx& c, int b, int h, int ck, int wave, int lane) {
    const size_t PL = (size_t)NT * 512;
    const size_t tok0 = (size_t)b * SEQ + ck * 32 + wave * 4;
#pragma unroll
    for (int s = 0; s < 4; ++s) {
        const size_t o = (tok0 + s) * 512 + h * 64 + lane;
        R.r[s] = c.F[o]; R.k[s] = c.F[o + PL]; R.v[s] = c.F[o + 2 * PL]; R.e[s] = c.F[o + 3 * PL]; R.a[s] = c.F[o + 4 * PL];
        R.inv[s] = c.BON[((tok0 + s) * 8 + h) * 4];
    }
}
DI void scan_chunked_item(const Ctx& c, int item, unsigned char* lds) {
    const int tid = TID(), lane = tid & 63, wave = tid >> 6, qd = lane >> 4, l15 = lane & 15;
    const int b = item >> 3, h = item & 7;
    bf16_t* AH = (bf16_t*)(lds + CK_AH); bf16_t* BH = (bf16_t*)(lds + CK_BH); bf16_t* KH = (bf16_t*)(lds + CK_KH); bf16_t* RH = (bf16_t*)(lds + CK_RH);
    bf16_t* BHT = (bf16_t*)(lds + CK_BHT); bf16_t* KHT = (bf16_t*)(lds + CK_KHT); bf16_t* VT = (bf16_t*)(lds + CK_VT); bf16_t* ZT = (bf16_t*)(lds + CK_ZT); bf16_t* UT = (bf16_t*)(lds + CK_UT);
    bf16_t* S0B = (bf16_t*)(lds + CK_S0B); bf16_t* LAK = (bf16_t*)(lds + CK_LAK); bf16_t* MRB = (bf16_t*)(lds + CK_MRB); bf16_t* MRK = (bf16_t*)(lds + CK_MRK);
    bf16_t* PA = (bf16_t*)(lds + CK_PA); bf16_t* PT = (bf16_t*)(lds + CK_PT); bf16_t* TT = (bf16_t*)(lds + CK_TT);
    float* TOT = (float*)(lds + CK_TOT); float* GC = (float*)(lds + CK_GC);
    const f32x4 Z4 = (f32x4){0.f, 0.f, 0.f, 0.f};
    f32x4 Sreg[2] = {Z4, Z4};
    const int svt = wave >> 1, skt0 = 2 * (wave & 1);
    const int mt8 = wave >> 2, nt8 = wave & 3;
    const int mt4 = (wave >> 1) & 1, nt4 = wave & 1;
    __syncthreads();
    for (int i = tid; i < 2 * 64 * CS64 / 2; i += NTHREADS) ((unsigned*)S0B)[i] = 0u;
    const float kkw = c.in(I_KK)[c.l * 512 + h * 64 + lane], kaw = c.in(I_KA)[c.l * 512 + h * 64 + lane];
    constexpr int NCK = SEQ / 32;
    ChunkRaw RA, RB; chunk_load(RA, c, b, h, 0, wave, lane); chunk_load(RB, c, b, h, 1, wave, lane);
    auto body = [&](const int ck, ChunkRaw& R) __attribute__((always_inline)) {
        const bf16_t* S0c = S0B + (ck & 1) * 64 * CS64; bf16_t* S0n = S0B + ((ck + 1) & 1) * 64 * CS64;
        float r4[4], k4[4], v4[4], e4[4], a4[4], inv4[4], ce[4];
#pragma unroll
        for (int s = 0; s < 4; ++s) { r4[s] = bf2f(R.r[s]); k4[s] = bf2f(R.k[s]); v4[s] = bf2f(R.v[s]); e4[s] = bf2f(R.e[s]); a4[s] = bf2f(R.a[s]); inv4[s] = R.inv[s]; }
        ce[0] = e4[0]; ce[1] = ce[0] + e4[1]; ce[2] = ce[1] + e4[2]; ce[3] = ce[2] + e4[3];
        TOT[wave * 64 + lane] = ce[3];
        LDS_BARRIER();
        { const int ckn = (ck + 2 < NCK) ? ck + 2 : NCK - 1; chunk_load(R, c, b, h, ckn, wave, lane); }
        {
            float off = 0.f;
#pragma unroll
            for (int w = 0; w < 7; ++w) { const float tw = TOT[w * 64 + lane]; if (w < wave) off += tw; }
            float ah[4], bh[4], kh[4], rh[4];
#pragma unroll
            for (int s = 0; s < 4; ++s) {
                const float cs = off + ce[s];
                const float g = __expf(-cs), gi = __expf(cs), gm1 = __expf(e4[s] - cs);
                const float kk = k4[s] * kkw * inv4[s], kp = k4[s] * (1.0f + (a4[s] - 1.0f) * kaw);
                ah[s] = -kk * gm1; bh[s] = kk * a4[s] * gi; kh[s] = kp * gi; rh[s] = r4[s] * g;
                const int t = wave * 4 + s;
                AH[t * CS64 + lane] = f2bf(ah[s]); BH[t * CS64 + lane] = f2bf(bh[s]); KH[t * CS64 + lane] = f2bf(kh[s]); RH[t * CS64 + lane] = f2bf(rh[s]);
                if (wave == 7 && s == 3) GC[lane] = g;
            }
            store_bf4(BHT + lane * CS32 + wave * 4, (f32x4){bh[0], bh[1], bh[2], bh[3]});
            store_bf4(KHT + lane * CS32 + wave * 4, (f32x4){kh[0], kh[1], kh[2], kh[3]});
            store_bf4(VT + lane * CS32 + wave * 4, (f32x4){v4[0], v4[1], v4[2], v4[3]});
        }
        LDS_BARRIER();
        {
            const int q = wave >> 1, mt = wave & 1;
            const bf16_t* A = (q < 2) ? AH : RH; const bf16_t* Bt = (q & 1) ? KH : BH;
#pragma unroll
            for (int nt = 0; nt < 2; ++nt) {
                f32x4 acc = mm16t<64>(A + mt * 16 * CS64, CS64, Bt + nt * 16 * CS64, CS64, Z4, lane);
                const int m = mt * 16 + l15, n0 = nt * 16 + 4 * qd;
#pragma unroll
                for (int i = 0; i < 4; ++i) { const bool keep = (q < 2) ? (n0 + i < m) : (n0 + i <= m); if (!keep) acc[i] = 0.f; }
                if (q == 0) {
                    store_bf4(PA + m * CS32 + n0, acc);
                    f32x4 t0 = acc;
#pragma unroll
                    for (int i = 0; i < 4; ++i) if (n0 + i == m) t0[i] += 1.0f;
                    store_bf4(TT + m * CS32 + n0, t0);
                    f32x4 accn = mm16<64>(A + mt * 16 * CS64, CS64, Bt + nt * 16 * CS64, CS64, Z4, lane);
                    const int mm0 = mt * 16 + 4 * qd, nn = nt * 16 + l15;
#pragma unroll
                    for (int i = 0; i < 4; ++i) if (!(nn < mm0 + i)) accn[i] = 0.f;
                    store_bf4(PT + nn * CS32 + mm0, accn);
                } else store_bf4(((q == 1) ? LAK : ((q == 2) ? MRB : MRK)) + m * CS32 + n0, acc);
            }
        }
        LDS_BARRIER();
        f32x4 y = Z4;
        int pcur = 0, tcur = 0;
#pragma unroll
        for (int itn = 0; itn < 5; ++itn) {
            const int m = mt4 * 16 + l15, n0 = nt4 * 16 + 4 * qd;
            if (wave < 4) {
                if (itn < 4) {
                    f32x4 cn = Z4, ct = Z4;
                    mm16_both(PA + pcur * 32 * CS32 + mt4 * 16 * CS32, CS32, PT + pcur * 32 * CS32 + nt4 * 16 * CS32, CS32, cn, ct, lane);
                    store_bf4(PA + (pcur ^ 1) * 32 * CS32 + m * CS32 + n0, ct);
                    store_bf4(PT + (pcur ^ 1) * 32 * CS32 + (nt4 * 16 + l15) * CS32 + mt4 * 16 + 4 * qd, cn);
                }
            } else if (itn > 0) {
                const u32x2 told = *(const u32x2*)(TT + tcur * 32 * CS32 + m * CS32 + n0);
                f32x4 acc = (f32x4){bflo(told.x), bfhi(told.x), bflo(told.y), bfhi(told.y)};
                acc = mm16t<32>(TT + tcur * 32 * CS32 + mt4 * 16 * CS32, CS32, PT + pcur * 32 * CS32 + nt4 * 16 * CS32, CS32, acc, lane);
                store_bf4(TT + (tcur ^ 1) * 32 * CS32 + m * CS32 + n0, acc);
            }
            if (itn == 0) {
                f32x4 z = mm16<64>(AH + mt8 * 16 * CS64, CS64, S0c + nt8 * 16 * CS64, CS64, Z4, lane);
                z = mm16<32>(LAK + mt8 * 16 * CS32, CS32, VT + nt8 * 16 * CS32, CS32, z, lane);
                store_bf4(ZT + (nt8 * 16 + l15) * CS32 + mt8 * 16 + 4 * qd, z);
            } else if (itn == 1) {
                y = mm16t<64>(RH + mt8 * 16 * CS64, CS64, S0c + nt8 * 16 * CS64, CS64, Z4, lane);
                y = mm16t<32>(MRK + mt8 * 16 * CS32, CS32, VT + nt8 * 16 * CS32, CS32, y, lane);
            } else if (itn == 2) {
#pragma unroll
                for (int j = 0; j < 2; ++j) Sreg[j] = mm16t<32>(VT + svt * 16 * CS32, CS32, KHT + (skt0 + j) * 16 * CS32, CS32, Sreg[j], lane);
            }
            LDS_BARRIER();
            if (itn < 4) pcur ^= 1;
            if (itn > 0) tcur ^= 1;
        }
        const bf16_t* Tm = TT + tcur * 32 * CS32;
        {
            const f32x4 uacc = mm16<32>(Tm + mt8 * 16 * CS32, CS32, ZT + nt8 * 16 * CS32, CS32, Z4, lane);
            store_bf4(UT + (nt8 * 16 + l15) * CS32 + mt8 * 16 + 4 * qd, uacc);
        }
        LDS_BARRIER();
        {
            y = mm16t<32>(MRB + mt8 * 16 * CS32, CS32, UT + nt8 * 16 * CS32, CS32, y, lane);
            store_bf4(c.YRAW + ((size_t)b * SEQ + ck * 32 + mt8 * 16 + l15) * 512 + h * 64 + nt8 * 16 + 4 * qd, y);
#pragma unroll
            for (int j = 0; j < 2; ++j) {
                const int kt = skt0 + j;
                f32x4 s = mm16t<32>(UT + svt * 16 * CS32, CS32, BHT + kt * 16 * CS32, CS32, Sreg[j], lane);
                const f32x4 gc = *(const f32x4*)(GC + kt * 16 + 4 * qd);
                s = s * gc;
                Sreg[j] = s;
                store_bf4(S0n + (svt * 16 + l15) * CS64 + kt * 16 + 4 * qd, s);
            }
        }
        LDS_BARRIER();
    };
#pragma unroll 1
    for (int ck = 0; ck < NCK; ck += 2) { body(ck, RA); body(ck + 1, RB); }
    __syncthreads();
}
DI void phase_rwkv_post(const Ctx& c, unsigned char* lds) {
    const int tid = TID(), lane = tid & 63, wave = tid >> 6;
    const size_t PL = (size_t)NT * 512;
    for (int t = blockIdx.x * 8 + wave; t < NT; t += gridDim.x * 8) {
        bf16_t ry[8], rv[8], rg[8]; float bon[8], gw[8], gb[8];
#pragma unroll
        for (int h = 0; h < 8; ++h) { const size_t o = (size_t)t * 512 + h * 64 + lane; ry[h] = c.YRAW[o]; rv[h] = c.F[o + 2 * PL]; rg[h] = c.F[o + 5 * PL]; bon[h] = c.BON[((size_t)t * 8 + h) * 4 + 3];
            gw[h] = c.in(I_GNW)[c.l * 512 + h * 64 + lane]; gb[h] = c.in(I_GNB)[c.l * 512 + h * 64 + lane]; }
#pragma unroll
        for (int h = 0; h < 8; ++h) {
            const float y = bf2f(ry[h]);
            const float mean = wave_sum_dpp(y) * (1.0f / 64.0f);
            const float d = y - mean;
            const float var = wave_sum_dpp(d * d) * (1.0f / 64.0f);
            const float yn = d * rsqrtf(var + 64e-5f) * gw[h] + gb[h];
            c.F[(size_t)t * 512 + h * 64 + lane + 5 * PL] = f2bf((yn + bon[h] * bf2f(rv[h])) * bf2f(rg[h]));
        }
    }
    for (int it = blockIdx.x * 4; it < 768 + 128 + 128 + 256 + 256; it += gridDim.x * 4) {
        const float* WB = c.in(I_WBR) + (size_t)c.l * 2048 * DM; bf16_t* BR = (bf16_t*)(c.ws + WS_WT_BR);
        if (it < 768) convert_tile4(c.in(I_WMG) + (size_t)c.l * DM * 3 * DM, 3 * DM, 3 * DM, DM, (bf16_t*)(c.ws + WS_WT_MG), it, lds);
        else if (it < 896) convert_tile4(WB, DM, DM, 512, BR, it - 768, lds);
        else if (it < 1024) convert_tile4(WB + (size_t)512 * DM, DM, DM, 512, BR + (size_t)1024 * 512, it - 896, lds);
        else if (it < 1280) convert_tile4(WB + (size_t)1024 * DM, DM, DM, 1024, BR + (size_t)2048 * 512, it - 1024, lds);
        else convert_tile4(c.in(I_WOUT) + (size_t)c.l * DM * DM, DM, DM, DM, (bf16_t*)(c.ws + WS_WT_OUT), it - 1280, lds);
    }
}
constexpr int TS = 72;
constexpr int NSA_BIAS = 0;
constexpr int NSA_SELM = 2112;
constexpr int NSA_SCR = 2624;
constexpr int NSA_K0 = 4672;
constexpr int NSA_V0 = NSA_K0 + 2 * 64 * TS * 2;
constexpr int NSA_A = NSA_V0 + 2 * 64 * TS * 2;
constexpr int NSA_B = NSA_A + 16384;
constexpr int NSA_END = NSA_B + 16384;
static_assert(NSA_END <= LDS_BYTES - 16, "nsa lds");
static_assert(NSA_K0 % 16 == 0, "align");

struct NsaLane { int tq[2]; int h; float cbias; float m[2], l[2]; };

DI void nsa_prefetch(u32x4& rk, u32x4& rv, const bf16_t* kbase, int kstride, const bf16_t* vtbase, int vstride, int pos0, int tid) {
    const int r = tid >> 3, seg = (tid & 7) * 8;
    rk = *(const u32x4*)(kbase + (size_t)(pos0 + r) * kstride + seg);
    rv = *(const u32x4*)(vtbase + (size_t)r * vstride + pos0 + seg);
}
DI void nsa_store(unsigned char* lds, int buf, const u32x4& rk, const u32x4& rv, int tid) {
    const int r = tid >> 3, seg = (tid & 7) * 8;
    *(u32x4*)((bf16_t*)(lds + NSA_K0) + buf * 64 * TS + r * TS + seg) = rk;
    *(u32x4*)((bf16_t*)(lds + NSA_V0) + buf * 64 * TS + r * TS + seg) = rv;
}
template <int QM = 3>
DI void nsa_qk(f32x4 (&s)[2][4], const bf16_t* sK, const bf16x8 (&qf)[2][2], int lane) {
#pragma unroll
    for (int kt = 0; kt < 4; ++kt) {
#pragma unroll
        for (int ks = 0; ks < 2; ++ks) {
            const bf16x8 kf = *(const bf16x8*)(sK + (16 * kt + (lane & 15)) * TS + 32 * ks + (lane >> 4) * 8);
#pragma unroll
            for (int qi = 0; qi < 2; ++qi) if ((QM >> qi) & 1) s[qi][kt] = __builtin_amdgcn_mfma_f32_16x16x32_bf16(kf, qf[qi][ks], (ks == 0) ? (f32x4){0.f, 0.f, 0.f, 0.f} : s[qi][kt], 0, 0, 0);
        }
    }
}
template <int MODE>
DI void nsa_logits(float (&x)[4][4], const f32x4 (&s)[4], int tq, int h, float cbias, bool rowsel, int pos0, int qd, const float* biasT) {
#pragma unroll
    for (int kt = 0; kt < 4; ++kt)
#pragma unroll
        for (int i = 0; i < 4; ++i) {
            const int kk = pos0 + 16 * kt + 4 * qd + i;
            if (MODE == 1) { x[kt][i] = rowsel ? s[kt][i] + cbias : -INFINITY; }
            else {
                const int dist = (MODE == 0) ? (tq - 16 * kk - 31) : (tq - kk);
                bool ok = dist >= 0;
                if (MODE == 2) ok = ok && rowsel;
                if (MODE == 3) ok = ok && (dist < 512);
                const int di = dist < 0 ? 0 : (dist > 128 ? 128 : dist);
                float bias = biasT[di * 4 + h];
                asm volatile("" : "+v"(bias));
                x[kt][i] = ok ? s[kt][i] + bias : -INFINITY;
            }
        }
}
DI float quad16_max(float v) {
    { const auto r = __builtin_amdgcn_permlane16_swap(__float_as_uint(v), __float_as_uint(v), false, false); v = fmaxf(__uint_as_float(r[0]), __uint_as_float(r[1])); }
    { const auto r = __builtin_amdgcn_permlane32_swap(__float_as_uint(v), __float_as_uint(v), false, false); v = fmaxf(__uint_as_float(r[0]), __uint_as_float(r[1])); }
    return v; }
DI float quad16_sum(float v) {
    { const auto r = __builtin_amdgcn_permlane16_swap(__float_as_uint(v), __float_as_uint(v), false, false); v = __uint_as_float(r[0]) + __uint_as_float(r[1]); }
    { const auto r = __builtin_amdgcn_permlane32_swap(__float_as_uint(v), __float_as_uint(v), false, false); v = __uint_as_float(r[0]) + __uint_as_float(r[1]); }
    return v; }
DI void nsa_softmax(const float (&x)[4][4], float& m, float& l, f32x4 (&O)[4], bf16x8 (&pf)[2]) {
    float mx = -INFINITY;
#pragma unroll
    for (int kt = 0; kt < 4; ++kt)
#pragma unroll
        for (int i = 0; i < 4; ++i) mx = fmaxf(mx, x[kt][i]);
    mx = quad16_max(mx);
    const float mn = fmaxf(m, mx);
    const float mu = (mn == -INFINITY) ? 0.f : mn;
    const float mu2 = mu * 1.4426950408889634f;
    const bool changed = mn != m;
    const float sc = changed ? __builtin_amdgcn_exp2f(__builtin_fmaf(m, 1.4426950408889634f, -mu2)) : 1.0f;
    float p[4][4]; float ps = 0.f;
#pragma unroll
    for (int kt = 0; kt < 4; ++kt)
#pragma unroll
        for (int i = 0; i < 4; ++i) { p[kt][i] = __builtin_amdgcn_exp2f(__builtin_fmaf(x[kt][i], 1.4426950408889634f, -mu2)); ps += p[kt][i]; }
    l = l * sc + ps; m = mn;
    if (__ballot(changed) != 0ull) {
#pragma unroll
        for (int dt = 0; dt < 4; ++dt) O[dt] = O[dt] * sc;
    }
#pragma unroll
    for (int ks = 0; ks < 2; ++ks) {
        u32x4 w; w.x = pack2(p[2 * ks][0], p[2 * ks][1]); w.y = pack2(p[2 * ks][2], p[2 * ks][3]); w.z = pack2(p[2 * ks + 1][0], p[2 * ks + 1][1]); w.w = pack2(p[2 * ks + 1][2], p[2 * ks + 1][3]);
        pf[ks] = __builtin_bit_cast(bf16x8, w);
    }
}
DI void nsa_softmax_far(const f32x4 (&s)[4], float cbias, bool rs, float& m, float& l, f32x4 (&O)[4], bf16x8 (&pf)[2]) {
    constexpr float LOG2E = 1.4426950408889634f;
    float mx = fmaxf(fmaxf(s[0][0], s[0][1]), fmaxf(s[0][2], s[0][3]));
#pragma unroll
    for (int kt = 1; kt < 4; ++kt) mx = fmaxf(mx, fmaxf(fmaxf(s[kt][0], s[kt][1]), fmaxf(s[kt][2], s[kt][3])));
    mx = quad16_max(mx) + cbias;
    const float mn = rs ? fmaxf(m, mx) : m;
    const float mu2 = ((mn == -INFINITY) ? 0.f : mn) * LOG2E;
    const bool changed = mn != m;
    const float sc = changed ? __builtin_amdgcn_exp2f(__builtin_fmaf(m, LOG2E, -mu2)) : 1.0f;
    const float c0 = rs ? __builtin_fmaf(cbias, LOG2E, -mu2) : -INFINITY;
    const f32x2 c2 = (f32x2){c0, c0};
    f32x2 p[4][2]; f32x2 ps2 = (f32x2){0.f, 0.f};
#pragma unroll
    for (int kt = 0; kt < 4; ++kt)
#pragma unroll
        for (int hh = 0; hh < 2; ++hh) {
            const f32x2 t = (f32x2){s[kt][2 * hh], s[kt][2 * hh + 1]} * LOG2E + c2;
            p[kt][hh] = (f32x2){__builtin_amdgcn_exp2f(t[0]), __builtin_amdgcn_exp2f(t[1])};
            ps2 += p[kt][hh];
        }
    l = l * sc + (ps2[0] + ps2[1]); m = mn;
    if (__ballot(changed) != 0ull) {
#pragma unroll
        for (int dt = 0; dt < 4; ++dt) O[dt] = O[dt] * sc;
    }
#pragma unroll
    for (int ks = 0; ks < 2; ++ks) {
        u32x4 w; w.x = pack2(p[2 * ks][0][0], p[2 * ks][0][1]); w.y = pack2(p[2 * ks][1][0], p[2 * ks][1][1]); w.z = pack2(p[2 * ks + 1][0][0], p[2 * ks + 1][0][1]); w.w = pack2(p[2 * ks + 1][1][0], p[2 * ks + 1][1][1]);
        pf[ks] = __builtin_bit_cast(bf16x8, w);
    }
}
template <int QM = 3>
DI void nsa_pv(f32x4 (&O)[2][4], const bf16_t* sV, const bf16x8 (&pf)[2][2], int lane) {
    const int qd = lane >> 4;
#pragma unroll
    for (int dt = 0; dt < 4; ++dt)
#pragma unroll
        for (int ks = 0; ks < 2; ++ks) {
            const bf16_t* vp = sV + (16 * dt + (lane & 15)) * TS + 32 * ks + 4 * qd;
            const u32x2 a = *(const u32x2*)vp, b = *(const u32x2*)(vp + 16);
            u32x4 w; w.x = a.x; w.y = a.y; w.z = b.x; w.w = b.y;
            const bf16x8 vf = __builtin_bit_cast(bf16x8, w);
#pragma unroll
            for (int qi = 0; qi < 2; ++qi) if ((QM >> qi) & 1) O[qi][dt] = __builtin_amdgcn_mfma_f32_16x16x32_bf16(vf, pf[qi][ks], O[qi][dt], 0, 0, 0);
        }
}
template <int MODE, int QM = 3>
DI void nsa_tile(f32x4 (&O)[2][4], NsaLane& L, const bf16x8 (&qf)[2][2], const unsigned char* lds, int buf, int pos0, bool sel0, bool sel1, int lane) {
    const bf16_t* sK = (const bf16_t*)(lds + NSA_K0) + buf * 64 * TS;
    const bf16_t* sV = (const bf16_t*)(lds + NSA_V0) + buf * 64 * TS;
    const float* biasT = (const float*)(lds + NSA_BIAS);
    f32x4 s[2][4];
    nsa_qk<QM>(s, sK, qf, lane);
    bf16x8 pf[2][2];
#pragma unroll
    for (int qi = 0; qi < 2; ++qi) if ((QM >> qi) & 1) {
        if (MODE == 1) nsa_softmax_far(s[qi], L.cbias, qi ? sel1 : sel0, L.m[qi], L.l[qi], O[qi], pf[qi]);
        else {
            float x[4][4];
            nsa_logits<MODE>(x, s[qi], L.tq[qi], L.h, L.cbias, qi ? sel1 : sel0, pos0, lane >> 4, biasT);
            nsa_softmax(x, L.m[qi], L.l[qi], O[qi], pf[qi]);
        }
    }
    nsa_pv<QM>(O, sV, pf, lane);
}
template <int MODE>
DI void nsa_tile_sel(f32x4 (&O)[2][4], NsaLane& L, const bf16x8 (&qf)[2][2], const unsigned char* lds, int buf, int pos0, bool sel0, bool sel1, int lane) {
    const bool a0 = __ballot(sel0) != 0ull, a1 = __ballot(sel1) != 0ull;
    if (a0 && a1) nsa_tile<MODE, 3>(O, L, qf, lds, buf, pos0, sel0, sel1, lane);
    else if (a0) nsa_tile<MODE, 1>(O, L, qf, lds, buf, pos0, sel0, sel1, lane);
    else if (a1) nsa_tile<MODE, 2>(O, L, qf, lds, buf, pos0, sel0, sel1, lane);
}
DI void nsa_flush(f32x4 (&Y)[2][4], f32x4 (&O)[2][4], NsaLane& L, const float (&gate)[2]) {
#pragma unroll
    for (int qi = 0; qi < 2; ++qi) {
        const float lt = quad16_sum(L.l[qi]);
        const float f = (lt > 0.f) ? gate[qi] * __builtin_amdgcn_rcpf(lt) : 0.f;
#pragma unroll
        for (int dt = 0; dt < 4; ++dt) { Y[qi][dt] += O[qi][dt] * f; O[qi][dt] = (f32x4){0.f, 0.f, 0.f, 0.f}; }
    }
}
DI void nsa_item(const Ctx& c, int item, unsigned char* lds) {
    const int tid = TID(), lane = tid & 63, wave = tid >> 6, qd = lane >> 4;
    const int b = item >> 8, g = (item >> 6) & 3, qt = item & 63, t0 = qt * 64, cur = qt, bg = b * 4 + g;
    float* biasT = (float*)(lds + NSA_BIAS);
    unsigned long long* selm = (unsigned long long*)(lds + NSA_SELM);
    float* scr = (float*)(lds + NSA_SCR) + wave * 64;
    float* impA = (float*)(lds + NSA_A); float* impB = (float*)(lds + NSA_B);
    __syncthreads();
    for (int i = tid; i < 129 * 4; i += NTHREADS) { const int d = i >> 2, h = i & 3; biasT[i] = c.in(I_RELB)[t5_bucket(d) * 16 + g * 4 + h]; }
    for (int i = tid; i < 2 * 4096; i += NTHREADS) impA[i] = 0.f;
    NsaLane L; L.h = lane & 3;
    bf16x8 qf[2][2]; float gates[2][3];
    const bf16_t* pbat = c.PROJ + (size_t)b * SEQ * IN_COLS;
#pragma unroll
    for (int qi = 0; qi < 2; ++qi) {
        const int tl = 8 * wave + 4 * qi + ((lane & 15) >> 2);
        L.tq[qi] = t0 + tl;
        const bf16_t* prow = pbat + (size_t)L.tq[qi] * IN_COLS;
#pragma unroll
        for (int ks = 0; ks < 2; ++ks) {
            u32x4 w = *(const u32x4*)(prow + C_Q + (g * 4 + L.h) * 64 + 32 * ks + qd * 8);
            w.x = pack2(bflo(w.x) * 0.125f, bfhi(w.x) * 0.125f); w.y = pack2(bflo(w.y) * 0.125f, bfhi(w.y) * 0.125f);
            w.z = pack2(bflo(w.z) * 0.125f, bfhi(w.z) * 0.125f); w.w = pack2(bflo(w.w) * 0.125f, bfhi(w.w) * 0.125f);
            qf[qi][ks] = __builtin_bit_cast(bf16x8, w);
        }
#pragma unroll
        for (int br = 0; br < 3; ++br) gates[qi][br] = sigmoidf_(bf2f(prow[C_GATE + g * 12 + L.h * 3 + br]));
    }
    __syncthreads();
    L.cbias = biasT[128 * 4 + L.h];
    f32x4 O[2][4], Y[2][4];
#pragma unroll
    for (int qi = 0; qi < 2; ++qi)
#pragma unroll
        for (int dt = 0; dt < 4; ++dt) { O[qi][dt] = (f32x4){0.f, 0.f, 0.f, 0.f}; Y[qi][dt] = (f32x4){0.f, 0.f, 0.f, 0.f}; }
    u32x4 rk, rv;
    const int nvis_max = (t0 + 63 >= 31) ? ((t0 + 63 - 31) >> 4) + 1 : 0;
    const int ncb = (nvis_max + 63) >> 6;
    const bf16_t* kcb = c.KC + (size_t)bg * 256 * 64; const bf16_t* vcb = c.VCT + (size_t)bg * 64 * 256;
    L.m[0] = L.m[1] = -INFINITY; L.l[0] = L.l[1] = 0.f;
    if (ncb > 0) nsa_prefetch(rk, rv, kcb, 64, vcb, 256, 0, tid);
    for (int cb = 0; cb < ncb; ++cb) {
        nsa_store(lds, cb & 1, rk, rv, tid);
        __syncthreads();
        if (cb + 1 < ncb) nsa_prefetch(rk, rv, kcb, 64, vcb, 256, (cb + 1) * 64, tid);
        if (16 * (cb * 64 + 63) + 31 + 128 <= t0) nsa_tile<1>(O, L, qf, lds, cb & 1, cb * 64, true, true, lane);
        else nsa_tile<0>(O, L, qf, lds, cb & 1, cb * 64, true, true, lane);
    }
    if (ncb > 0) nsa_prefetch(rk, rv, kcb, 64, vcb, 256, 0, tid);
    float mfin[2], linv[2];
#pragma unroll
    for (int qi = 0; qi < 2; ++qi) { mfin[qi] = L.m[qi]; const float lt = quad16_sum(L.l[qi]); linv[qi] = (lt > 0.f) ? __builtin_amdgcn_rcpf(lt) : 0.f; }
    { const float gg[2] = {gates[0][0], gates[1][0]}; nsa_flush(Y, O, L, gg); }
    __syncthreads();
    for (int cb = 0; cb < ncb; ++cb) {
        nsa_store(lds, cb & 1, rk, rv, tid);
        __syncthreads();
        if (cb + 1 < ncb) nsa_prefetch(rk, rv, kcb, 64, vcb, 256, (cb + 1) * 64, tid);
        const bf16_t* sK = (const bf16_t*)(lds + NSA_K0) + (cb & 1) * 64 * TS;
        f32x4 s[2][4];
        nsa_qk(s, sK, qf, lane);
#pragma unroll
        for (int qi = 0; qi < 2; ++qi) {
            float x[4][4];
            nsa_logits<0>(x, s[qi], L.tq[qi], L.h, L.cbias, true, cb * 64, qd, biasT);
            const float mu2 = ((mfin[qi] == -INFINITY) ? 0.f : mfin[qi]) * 1.4426950408889634f;
#pragma unroll
            for (int kt = 0; kt < 4; ++kt) {
#define E2_(v) __builtin_amdgcn_exp2f(__builtin_fmaf((v), 1.4426950408889634f, -mu2))
                float p3 = E2_(x[kt][3]) * linv[qi];
                float pa = (E2_(x[kt][0]) + E2_(x[kt][1]) + E2_(x[kt][2])) * linv[qi] + p3;
#undef E2_
                pa += DPP_MOV(pa, 0xB1); p3 += DPP_MOV(p3, 0xB1);
                pa += DPP_MOV(pa, 0x4E); p3 += DPP_MOV(p3, 0x4E);
                if (L.h == 0) { const int tl = 8 * wave + 4 * qi + ((lane & 15) >> 2), mi = 16 * cb + 4 * kt + qd; impA[tl * 64 + mi] = pa; impB[tl * 64 + mi] = p3; }
            }
        }
    }
    const bf16_t* ksb = pbat + C_KS + g * 64; const bf16_t* vsb = c.VT + ((size_t)0 * 16 + bg) * 64 * SEQ;
    nsa_prefetch(rk, rv, ksb, IN_COLS, vsb, SEQ, 0, tid);
    __syncthreads();
    for (int tl8 = 0; tl8 < 8; ++tl8) {
        const int tl = 8 * wave + tl8, n = lane;
        const bool cand = (n >= 1) && (n <= cur - 2);
        const float imp = cand ? impA[tl * 64 + n] + impB[tl * 64 + n - 1] : -1.0f;
        LDS_WAVE_SYNC();
        scr[n] = imp;
        LDS_WAVE_SYNC();
        int rank = 0;
#pragma unroll 4
        for (int q4 = 0; q4 < 16; ++q4) {
            const f32x4 o = *(const f32x4*)(scr + q4 * 4);
#pragma unroll
            for (int j = 0; j < 4; ++j) { const int n2 = q4 * 4 + j; rank += (o[j] > imp || (o[j] == imp && n2 < n)) ? 1 : 0; }
        }
        const bool forced = (n <= cur) && (n == 0 || n == cur || n == cur - 1);
        const unsigned long long msk = __ballot((cand && rank < 5) || forced);
        if (lane == 0) selm[tl] = msk;
    }
    __syncthreads();
    unsigned long long uni = selm[lane];
#pragma unroll
    for (int o = 32; o >= 1; o >>= 1) { const unsigned lo_ = __shfl_xor((unsigned)uni, o), hi_ = __shfl_xor((unsigned)(uni >> 32), o); uni |= ((unsigned long long)hi_ << 32) | lo_; }
    uni = ((unsigned long long)__builtin_amdgcn_readfirstlane((unsigned)(uni >> 32)) << 32) | (unsigned)__builtin_amdgcn_readfirstlane((unsigned)uni);
    unsigned long long sm[2];
#pragma unroll
    for (int qi = 0; qi < 2; ++qi) sm[qi] = selm[8 * wave + 4 * qi + ((lane & 15) >> 2)];
    L.m[0] = L.m[1] = -INFINITY; L.l[0] = L.l[1] = 0.f;
    {
        unsigned long long rem = uni; int it = 0;
        int j = (int)__builtin_ctzll(rem); rem &= rem - 1;
        for (;;) {
            nsa_store(lds, it & 1, rk, rv, tid);
            __syncthreads();
            const int jn = rem ? (int)__builtin_ctzll(rem) : -1;
            if (jn >= 0) { rem &= rem - 1; nsa_prefetch(rk, rv, ksb, IN_COLS, vsb, SEQ, jn * 64, tid); }
            const bool s0 = (sm[0] >> j) & 1ull, s1 = (sm[1] >> j) & 1ull;
            if (j <= cur - 3) nsa_tile_sel<1>(O, L, qf, lds, it & 1, j * 64, s0, s1, lane);
            else nsa_tile_sel<2>(O, L, qf, lds, it & 1, j * 64, s0, s1, lane);
            if (jn < 0) break;
            j = jn; ++it;
        }
    }
    const bf16_t* kwb = pbat + C_KW + g * 64; const bf16_t* vwb = c.VT + ((size_t)1 * 16 + bg) * 64 * SEQ;
    const int j0 = (cur - 8 > 0) ? cur - 8 : 0;
    nsa_prefetch(rk, rv, kwb, IN_COLS, vwb, SEQ, j0 * 64, tid);
    { const float gg[2] = {gates[0][1], gates[1][1]}; nsa_flush(Y, O, L, gg); }
    L.m[0] = L.m[1] = -INFINITY; L.l[0] = L.l[1] = 0.f;
    {
        __syncthreads();
        for (int j = j0; j <= cur; ++j) {
            nsa_store(lds, (j - j0) & 1, rk, rv, tid);
            __syncthreads();
            if (j + 1 <= cur) nsa_prefetch(rk, rv, kwb, IN_COLS, vwb, SEQ, (j + 1) * 64, tid);
            if (cur - j >= 3 && cur - j <= 7) nsa_tile<1>(O, L, qf, lds, (j - j0) & 1, j * 64, true, true, lane);
            else nsa_tile<3>(O, L, qf, lds, (j - j0) & 1, j * 64, true, true, lane);
        }
    }
    { const float gg[2] = {gates[0][2], gates[1][2]}; nsa_flush(Y, O, L, gg); }
#pragma unroll
    for (int qi = 0; qi < 2; ++qi) {
        bf16_t* yrow = c.PROJ + ((size_t)b * SEQ + L.tq[qi]) * IN_COLS + C_Q + (g * 4 + L.h) * 64;
#pragma unroll
        for (int dt = 0; dt < 4; ++dt) store_bf4(yrow + 16 * dt + 4 * qd, Y[qi][dt]);
    }
}
DI void phase_mix(const Ctx& c, unsigned char* lds) {
    const int G = gridDim.x, bid = blockIdx.x;
    const int n_nsa = NB * 4 * (SEQ / 64), n_scan = NB * 8;
    for (int item = bid; item < n_scan; item += G) scan_chunked_item(c, item, lds);
    unsigned* ctr = c.ctl + CW_Q + c.l;
    volatile int* sitem = (volatile int*)(lds + LDS_BYTES - 32);
    for (;;) {
        __syncthreads();
        if (TID() == 0) *sitem = (int)atomicAdd(ctr, 1u);
        __syncthreads();
        const int k = *sitem;
        if (k >= n_nsa) break;
        const int qt = 63 - (k >> 4), bgi = k & 15;
        nsa_item(c, (bgi << 6) | qt, lds);
    }
}

DI void phase_merge(const Ctx& c, unsigned char* lds) {
    const int nN = DM / 256;
    const bf16_t* WM = (const bf16_t*)(c.ws + WS_WT_MG);
    const bf16_t* BR = (const bf16_t*)(c.ws + WS_WT_BR);
    const float* BM_ = c.in(I_BMG) + (size_t)c.l * 3 * DM;
    bf16_t* TMP = c.F + (size_t)2 * NT * 512 + (size_t)blockIdx.x * 256 * 256;
    for (int it = 0;; ++it) {
        int tm, tn; if (!xcd_unit(it, nN, tm, tn)) break;
        const int m0 = tm * 256, n0 = tn * 256;
#pragma unroll 1
        for (int i = 0; i < 3; ++i) {
            f32x4 acc[8][4];
#pragma unroll
            for (int a_ = 0; a_ < 8; ++a_)
#pragma unroll
                for (int b_ = 0; b_ < 4; ++b_) acc[a_][b_] = (f32x4){0.f, 0.f, 0.f, 0.f};
            gemm256_dma(acc, c.H + (size_t)m0 * DM, DM, WM + (size_t)(i * DM + n0) * DM, DM, DM, lds);
            tile256_store_bf16(acc, TMP, 256, 256, lds);
#pragma unroll
            for (int a_ = 0; a_ < 8; ++a_)
#pragma unroll
                for (int b_ = 0; b_ < 4; ++b_) acc[a_][b_] = (f32x4){0.f, 0.f, 0.f, 0.f};
            {
                const bf16_t* Ab = (i == 0) ? c.POOLED + (size_t)m0 * 512 : ((i == 1) ? c.F + (size_t)5 * NT * 512 + (size_t)m0 * 512 : c.PROJ + C_Q + (size_t)m0 * IN_COLS);
                const size_t la = (i == 2) ? (size_t)IN_COLS : (size_t)512;
                const int Kb = (i == 2) ? 1024 : 512;
                gemm256_dma(acc, Ab, la, BR + (size_t)i * 1024 * 512 + (size_t)n0 * Kb, (size_t)Kb, Kb, lds);
            }
            const int lane = TID() & 63, wave = TID() >> 6, wm = wave >> 2, wn = wave & 3;
            const float* bias = BM_ + i * DM + n0;
#pragma unroll
            for (int mi = 0; mi < 8; ++mi) {
#pragma unroll
                for (int ni = 0; ni < 4; ++ni) {
                    const int r = R256(mi), cc = C256(ni);
                    bf16_t* q = c.MERGED + (size_t)(m0 + r) * DM + n0 + cc;
                    const u32x2 gv = *(const u32x2*)(TMP + r * 256 + cc);
                    const f32x4 bb = *(const f32x4*)(bias + cc);
                    f32x4 m4 = (f32x4){0.f, 0.f, 0.f, 0.f};
                    if (i > 0) { const u32x2 pv = *(const u32x2*)q; m4 = (f32x4){bflo(pv.x), bfhi(pv.x), bflo(pv.y), bfhi(pv.y)}; }
                    m4[0] += sigmoidf_(bflo(gv.x) + bb[0]) * acc[mi][ni][0]; m4[1] += sigmoidf_(bfhi(gv.x) + bb[1]) * acc[mi][ni][1];
                    m4[2] += sigmoidf_(bflo(gv.y) + bb[2]) * acc[mi][ni][2]; m4[3] += sigmoidf_(bfhi(gv.y) + bb[3]) * acc[mi][ni][3];
                    store_bf4(q, m4);
                }
                asm volatile("" ::: "memory"); __builtin_amdgcn_sched_barrier(0);
            }
        }
    }
}

DI void phase_outp(const Ctx& c, unsigned char* lds) {
    const int nN = DM / 256;
    const bf16_t* W = (const bf16_t*)(c.ws + WS_WT_OUT);
    const float* xin = (c.l == 0) ? c.in(I_X) : c.out;
    for (int it = 0;; ++it) {
        int tm, tn; if (!xcd_unit(it, nN, tm, tn)) break;
        const int m0 = tm * 256, n0 = tn * 256;
        f32x4 acc[8][4];
#pragma unroll
        for (int i = 0; i < 8; ++i)
#pragma unroll
            for (int j = 0; j < 4; ++j) acc[i][j] = (f32x4){0.f, 0.f, 0.f, 0.f};
        gemm256_dma(acc, c.MERGED + (size_t)m0 * DM, DM, W + (size_t)n0 * DM, DM, DM, lds);
        const int lane = TID() & 63, wave = TID() >> 6, wm = wave >> 2, wn = wave & 3;
#pragma unroll
        for (int mi = 0; mi < 8; ++mi)
#pragma unroll
            for (int ni = 0; ni < 4; ++ni) {
                const size_t o = (size_t)(m0 + R256(mi)) * DM + n0 + C256(ni);
                const f32x4 x = *(const f32x4*)(xin + o); *(f32x4*)(c.out + o) = x + acc[mi][ni];
            }
    }
    for (int it = blockIdx.x * 4; it < 3 * 32 * 64; it += gridDim.x * 4) {
        const int mat = it / 2048, e = (it >> 6) & 31, tl = it & 63;
        if (mat == 0) convert_tile4(c.in(I_EG) + ((size_t)c.l * 32 + e) * DM * 256, 256, 256, DM, (bf16_t*)(c.ws + WS_EG) + (size_t)e * 256 * DM, tl, lds);
        else if (mat == 1) convert_tile4(c.in(I_EU) + ((size_t)c.l * 32 + e) * DM * 256, 256, 256, DM, (bf16_t*)(c.ws + WS_EU) + (size_t)e * 256 * DM, tl, lds);
        else convert_tile4(c.in(I_ED) + ((size_t)c.l * 32 + e) * 256 * DM, DM, DM, 256, (bf16_t*)(c.ws + WS_ED) + (size_t)e * DM * 256, tl, lds);
    }
}

DI void phase_norm2(const Ctx& c, unsigned char* lds) {
    const int tid = TID(), lane = tid & 63, wave = tid >> 6;
    const float* gain = c.in(I_NFFN) + c.l * DM;
    const float* wrg = c.in(I_WRG) + (size_t)c.l * DM * 4; const float* brg = c.in(I_BRG) + c.l * 4;
    const float* wre = c.in(I_WRE) + (size_t)c.l * DM * 32; const float* bre = c.in(I_BRE) + c.l * 32;
    unsigned* cnt = c.ctl + CW_CNT + c.l * 32;
    constexpr int N2_B01 = 0, N2_B2 = 131072, N2_RS = 147456, N2_LCNT = N2_RS + 256, N2_LG = 0, N2_PART = 16384;
    float* B01 = (float*)(lds + N2_B01); float* B2 = (float*)(lds + N2_B2); float* RS = (float*)(lds + N2_RS);
    unsigned* lcnt = (unsigned*)(lds + N2_LCNT); unsigned* lbase = lcnt + 32;
    for (int rb = blockIdx.x; rb < NT / 64; rb += gridDim.x) {
        const int r0b = rb * 64;
        __syncthreads();
#pragma unroll 4
        for (int p = tid; p < 8192; p += NTHREADS) {
            const f32x4 w = *(const f32x4*)(wre + (size_t)p * 4);
            const int k = p >> 3, c4 = (p & 7) * 4, kb = k >> 4, kq = (k >> 2) & 3, m = k & 3, jj = c4 >> 4, cl = c4 & 15;
            float* d = B01 + (((kb * 2 + jj) * 64 + kq * 16 + cl) * 4) + m;
            d[0] = w[0]; d[4] = w[1]; d[8] = w[2]; d[12] = w[3];
        }
#pragma unroll
        for (int p = tid; p < 1024; p += NTHREADS) {
            const f32x4 w = *(const f32x4*)(wrg + (size_t)p * 4);
            const int kb = p >> 4, kq = (p >> 2) & 3, m = p & 3;
            float* d = B2 + ((kb * 4 + kq) * 4) * 4 + m;
            d[0] = w[0]; d[4] = w[1]; d[8] = w[2]; d[12] = w[3];
        }
        if (tid < 32) lcnt[tid] = 0u;
#pragma unroll
        for (int hb = 0; hb < 2; ++hb) {
            f32x4 v[4][4];
#pragma unroll
            for (int rr = 0; rr < 4; ++rr)
#pragma unroll
                for (int i = 0; i < 4; ++i) v[rr][i] = *(const f32x4*)(c.out + (size_t)(r0b + wave * 8 + hb * 4 + rr) * DM + i * 256 + lane * 4);
#pragma unroll
            for (int rr = 0; rr < 4; ++rr) {
                float ss = 0.f;
#pragma unroll
                for (int i = 0; i < 4; ++i) ss += v[rr][i][0] * v[rr][i][0] + v[rr][i][1] * v[rr][i][1] + v[rr][i][2] * v[rr][i][2] + v[rr][i][3] * v[rr][i][3];
                ss = wave_sum_dpp(ss);
                const float rs = rsqrtf(ss * (1.0f / DM) + 1e-6f);
                if (lane == 0) RS[wave * 8 + hb * 4 + rr] = rs;
#pragma unroll
                for (int i = 0; i < 4; ++i) {
                    const f32x4 g = *(const f32x4*)(gain + i * 256 + lane * 4);
                    store_bf4(c.H + (size_t)(r0b + wave * 8 + hb * 4 + rr) * DM + i * 256 + lane * 4, (f32x4){v[rr][i][0] * rs * g[0], v[rr][i][1] * rs * g[1], v[rr][i][2] * rs * g[2], v[rr][i][3] * rs * g[3]});
                }
            }
        }
        __syncthreads();
        const int tile = wave & 3, kh = wave >> 2, cl = lane & 15, kq = lane >> 4;
        f32x4 acc0 = (f32x4){0.f, 0.f, 0.f, 0.f}, acc1 = acc0, acc2 = acc0;
        {
            const float my_rs = RS[tile * 16 + cl];
            const float* xr = c.out + (size_t)(r0b + tile * 16 + cl) * DM + 4 * kq + kh * 512;
            const float* gr_ = gain + 4 * kq + kh * 512;
            f32x4 xa[4], ga[4];
#pragma unroll
            for (int u = 0; u < 4; ++u) { xa[u] = *(const f32x4*)(xr + u * 16); ga[u] = *(const f32x4*)(gr_ + u * 16); }
#pragma unroll 1
            for (int kb0 = 0; kb0 < 32; kb0 += 4) {
                f32x4 xn[4], gn[4];
                const int kn = (kb0 + 4 < 32) ? kb0 + 4 : kb0;
#pragma unroll
                for (int u = 0; u < 4; ++u) { xn[u] = *(const f32x4*)(xr + (kn + u) * 16); gn[u] = *(const f32x4*)(gr_ + (kn + u) * 16); }
#pragma unroll
                for (int u = 0; u < 4; ++u) {
                    const int kb = kh * 32 + kb0 + u;
                    const f32x4 b0 = *(const f32x4*)(B01 + ((kb * 2 + 0) * 64 + lane) * 4), b1 = *(const f32x4*)(B01 + ((kb * 2 + 1) * 64 + lane) * 4);
                    f32x4 b2 = (f32x4){0.f, 0.f, 0.f, 0.f};
                    if (cl < 4) b2 = *(const f32x4*)(B2 + ((kb * 4 + kq) * 4 + cl) * 4);
#pragma unroll
                    for (int m = 0; m < 4; ++m) {
                        const float am = xa[u][m] * ga[u][m] * my_rs;
                        acc0 = __builtin_amdgcn_mfma_f32_16x16x4f32(am, b0[m], acc0, 0, 0, 0);
                        acc1 = __builtin_amdgcn_mfma_f32_16x16x4f32(am, b1[m], acc1, 0, 0, 0);
                        acc2 = __builtin_amdgcn_mfma_f32_16x16x4f32(am, b2[m], acc2, 0, 0, 0);
                    }
                }
#pragma unroll
                for (int u = 0; u < 4; ++u) { xa[u] = xn[u]; ga[u] = gn[u]; }
            }
        }
        __syncthreads();
        if (kh == 1) { f32x4* pp = (f32x4*)(lds + N2_PART) + (tile * 3) * 64 + lane; pp[0] = acc0; pp[64] = acc1; pp[128] = acc2; }
        __syncthreads();
        int ex0 = 0, ex1 = 0, lr0 = 0, lr1 = 0; float w0_ = 0.f, w1_ = 0.f;
        if (kh == 0) {
            const f32x4* pp = (const f32x4*)(lds + N2_PART) + (tile * 3) * 64 + lane;
            acc0 += pp[0]; acc1 += pp[64]; acc2 += pp[128];
            float* lg = (float*)(lds + N2_LG) + tile * 16 * 36;
#pragma unroll
            for (int i = 0; i < 4; ++i) { const int row = 4 * kq + i; lg[row * 36 + cl] = acc0[i]; lg[row * 36 + 16 + cl] = acc1[i]; if (cl < 4) lg[row * 36 + 32 + cl] = acc2[i]; }
            LDS_WAVE_SYNC();
            if (lane < 16) {
                const float* L = lg + lane * 36;
                float lgp[4];
#pragma unroll
                for (int o = 0; o < 4; ++o) lgp[o] = L[32 + o] + brg[o];
                int grp = 0; float gm = lgp[0];
#pragma unroll
                for (int o = 1; o < 4; ++o) if (lgp[o] > gm) { gm = lgp[o]; grp = o; }
                float gs = 0.f;
#pragma unroll
                for (int o = 0; o < 4; ++o) gs += __expf(lgp[o] - gm);
                const float ptop = 1.0f / gs;
                int i0 = 0; float v0 = -INFINITY; int i1 = 0; float v1 = -INFINITY;
                for (int o = 0; o < 8; ++o) { const float le = L[grp * 8 + o] + bre[grp * 8 + o]; if (le > v0) { v1 = v0; i1 = i0; v0 = le; i0 = o; } else if (le > v1) { v1 = le; i1 = o; } }
                const float e1 = __expf(v1 - v0), inv = 1.0f / (1.0f + e1);
                ex0 = grp * 8 + i0; ex1 = grp * 8 + i1;
                w0_ = inv * ptop; w1_ = e1 * inv * ptop;
                lr0 = (int)atomicAdd(lcnt + ex0, 1u); lr1 = (int)atomicAdd(lcnt + ex1, 1u);
            }
        }
        __syncthreads();
        if (tid < 32) { const unsigned n = lcnt[tid]; lbase[tid] = n ? atomicAdd(cnt + tid, n) : 0u; }
        __syncthreads();
        if (kh == 0 && lane < 16) {
            const int row = r0b + tile * 16 + lane;
            const int q0 = (int)lbase[ex0] + lr0, q1 = (int)lbase[ex1] + lr1;
            int* rt_ = c.ROUTE + (size_t)row * 8;
            rt_[0] = ex0; rt_[1] = ex1; ((float*)rt_)[2] = w0_; ((float*)rt_)[3] = w1_; rt_[4] = q0; rt_[5] = q1;
            int* e0p = c.ENT + ((size_t)ex0 * NT + q0) * 2; e0p[0] = row; ((float*)e0p)[1] = w0_;
            int* e1p = c.ENT + ((size_t)ex1 * NT + q1) * 2; e1p[0] = row; ((float*)e1p)[1] = w1_;
        }
    }
}
DI void moe_tables(const Ctx& c, int* soff, int* stile, int ncol) {
    const unsigned* cnt = c.ctl + CW_CNT + c.l * 32;
    __syncthreads();
    if (TID() == 0) { int s = 0, tt = 0; for (int e = 0; e < 32; ++e) { soff[e] = s; stile[e] = tt; s += (int)cnt[e]; tt += (((int)cnt[e] + 255) >> 8) * ncol; } soff[32] = s; stile[32] = tt; }
    __syncthreads();
}
DI void phase_moe_up(const Ctx& c, unsigned char* lds) {
    int* soff = (int*)(lds + LDS_BYTES - 1024); int* stile = soff + 64;
    moe_tables(c, soff, stile, 1);
    const int total = __builtin_amdgcn_readfirstlane(stile[32]);
    for (int item = blockIdx.x; item < total; item += gridDim.x) {
        int e = 0;
        for (int q = 1; q < 32; ++q) if (stile[q] <= item) e = q;
        e = __builtin_amdgcn_readfirstlane(e);
        const int tm = __builtin_amdgcn_readfirstlane(item - stile[e]);
        const int p0 = __builtin_amdgcn_readfirstlane(soff[e] + tm * 256), pend = __builtin_amdgcn_readfirstlane(soff[e + 1]);
        GatherRows gr; gr.ent = c.ENT + ((size_t)e * NT + (p0 - soff[e])) * 2; gr.n = pend - p0;
        f32x4 acc[8][4];
#pragma unroll
        for (int a_ = 0; a_ < 8; ++a_)
#pragma unroll
            for (int b_ = 0; b_ < 4; ++b_) acc[a_][b_] = (f32x4){0.f, 0.f, 0.f, 0.f};
        gemm256_dma(acc, c.H, DM, (const bf16_t*)(c.ws + WS_EG) + (size_t)e * 256 * DM, DM, DM, lds, &gr);
        { const int lane = TID() & 63, wave = TID() >> 6, wm = wave >> 2, wn = wave & 3;
#pragma unroll
        for (int mi = 0; mi < 8; ++mi)
#pragma unroll
            for (int ni = 0; ni < 4; ++ni) {
                const int r = R256(mi), cc = C256(ni);
                const f32x4 g4 = acc[mi][ni];
                if (p0 + r < pend) store_bf4(c.HID + (size_t)(p0 + r) * 256 + cc, (f32x4){g4[0] * sigmoidf_(g4[0]), g4[1] * sigmoidf_(g4[1]), g4[2] * sigmoidf_(g4[2]), g4[3] * sigmoidf_(g4[3])});
                acc[mi][ni] = (f32x4){0.f, 0.f, 0.f, 0.f};
            }
        }
        gemm256_dma(acc, c.H, DM, (const bf16_t*)(c.ws + WS_EU) + (size_t)e * 256 * DM, DM, DM, lds, &gr);
        const int lane = TID() & 63, wave = TID() >> 6, wm = wave >> 2, wn = wave & 3;
#pragma unroll
        for (int mi = 0; mi < 8; ++mi) {
#pragma unroll
            for (int ni = 0; ni < 4; ++ni) {
                const int r = R256(mi), cc = C256(ni);
                if (p0 + r < pend) { bf16_t* q = c.HID + (size_t)(p0 + r) * 256 + cc; const u32x2 sv = *(const u32x2*)q;
                    store_bf4(q, (f32x4){bflo(sv.x) * acc[mi][ni][0], bfhi(sv.x) * acc[mi][ni][1], bflo(sv.y) * acc[mi][ni][2], bfhi(sv.y) * acc[mi][ni][3]}); }
            }
            asm volatile("" ::: "memory"); __builtin_amdgcn_sched_barrier(0);
        }
    }
}
DI void phase_moe_down(const Ctx& c, unsigned char* lds) {
    int* soff = (int*)(lds + LDS_BYTES - 1024); int* stile = soff + 64;
    moe_tables(c, soff, stile, 4);
    const int total = __builtin_amdgcn_readfirstlane(stile[32]);
    for (int item = blockIdx.x; item < total; item += gridDim.x) {
        int e = 0;
        for (int q = 1; q < 32; ++q) if (stile[q] <= item) e = q;
        e = __builtin_amdgcn_readfirstlane(e);
        const int loc = __builtin_amdgcn_readfirstlane(item - stile[e]), tm = loc >> 2, tn = loc & 3, n0 = tn * 256;
        const int p0 = __builtin_amdgcn_readfirstlane(soff[e] + tm * 256), pend = __builtin_amdgcn_readfirstlane(soff[e + 1]);
        f32x4 acc[8][4];
#pragma unroll
        for (int a_ = 0; a_ < 8; ++a_)
#pragma unroll
            for (int b_ = 0; b_ < 4; ++b_) acc[a_][b_] = (f32x4){0.f, 0.f, 0.f, 0.f};
        gemm256_dma(acc, c.HID + (size_t)p0 * 256, 256, (const bf16_t*)(c.ws + WS_ED) + ((size_t)e * DM + n0) * 256, 256, 256, lds);
        const int lane = TID() & 63, wave = TID() >> 6, wm = wave >> 2, wn = wave & 3;
        const float* wl = (const float*)c.ENT + ((size_t)e * NT + (p0 - soff[e])) * 2 + 1;
#pragma unroll
        for (int mi = 0; mi < 8; ++mi)
#pragma unroll
            for (int ni = 0; ni < 4; ++ni) {
                const int r = R256(mi), cc = C256(ni);
                if (p0 + r < pend) { const float w = wl[2 * r];
                    store_bf4(c.Y + (size_t)(p0 + r) * DM + n0 + cc, (f32x4){acc[mi][ni][0] * w, acc[mi][ni][1] * w, acc[mi][ni][2] * w, acc[mi][ni][3] * w}); }
            }
    }
}
DI void phase_final(const Ctx& c, unsigned char* lds) {
    const int tid = TID(), lane = tid & 63, wave = tid >> 6;
    const float* gain = c.in(I_NFIN);
    int* soff = (int*)(lds + 65536);
    moe_offsets(c, DEPTH - 1, soff);
    for (int row = blockIdx.x * 8 + wave; row < NT; row += gridDim.x * 8) {
        f32x4 v[4];
#pragma unroll
        for (int i = 0; i < 4; ++i) v[i] = *(const f32x4*)(c.out + (size_t)row * DM + i * 256 + lane * 4);
        add_moe_rows(c, row, lane, v, soff);
        float ss = 0.f;
#pragma unroll
        for (int i = 0; i < 4; ++i) ss += v[i][0] * v[i][0] + v[i][1] * v[i][1] + v[i][2] * v[i][2] + v[i][3] * v[i][3];
        ss = wave_sum_dpp(ss);
        const float rs = rsqrtf(ss * (1.0f / DM) + 1e-6f);
#pragma unroll
        for (int i = 0; i < 4; ++i) {
            const f32x4 g = *(const f32x4*)(gain + i * 256 + lane * 4);
            *(f32x4*)(c.out + (size_t)row * DM + i * 256 + lane * 4) = (f32x4){v[i][0] * rs * g[0], v[i][1] * rs * g[1], v[i][2] * rs * g[2], v[i][3] * rs * g[3]};
        }
    }
}

constexpr int PH_PER_LAYER = 11, N_PHASES = DEPTH * PH_PER_LAYER + 1;
__global__ void __launch_bounds__(NTHREADS, 2) fwd_kernel(Params P) {
    extern __shared__ __attribute__((aligned(16))) unsigned char lds[];
    const int lo = P.ph_lo, hi = P.ph_hi;
    LAS unsigned* xbw = (LAS unsigned*)(lds + LDS_BYTES - 16);
    if (threadIdx.x == 0) { xbw[0] = 0u; xbw[1] = 0u; xbw[2] = 0u; xbw[3] = 0u; }
    __syncthreads();
    Ctx c; c.P = &P; c.ws = P.ws; c.out = P.out; c.l = 0;
    c.ctl = (unsigned*)(P.ws + WS_CTL);
    c.H = (bf16_t*)(P.ws + WS_H); c.PROJ = (bf16_t*)(P.ws + WS_PROJ); c.F = (bf16_t*)(P.ws + WS_F); c.POOLED = (bf16_t*)(P.ws + WS_POOLED);
    c.MERGED = (bf16_t*)(P.ws + WS_F); c.CMPH = (bf16_t*)(P.ws + WS_CMPH); c.CMPO = (float*)(P.ws + WS_CMPO); c.POSB = (float*)(P.ws + WS_POSB);
    c.ROUTE = (int*)(P.ws + WS_ROUTE); c.ENT = (int*)(P.ws + WS_ENT); c.HID = (bf16_t*)(P.ws + WS_HID); c.Y = (bf16_t*)(P.ws + WS_Y);
    c.VT = (bf16_t*)(P.ws + WS_VT); c.KC = (bf16_t*)(P.ws + WS_KC); c.VCT = (bf16_t*)(P.ws + WS_VCT); c.YRAW = (bf16_t*)(P.ws + WS_YRAW); c.BON = (float*)(P.ws + WS_BON);
    XcdBarrier bar; bar.bar = c.ctl + CW_BAR; bar.x = 0; bar.st = (volatile LAS unsigned*)xbw;
    if (hi - lo > 1) bar = xcd_barrier_post(c.ctl + CW_BAR, (volatile LAS unsigned*)xbw);
#define IN(k) (lo <= (k) && (k) < hi)
#define SEAM(k) do { if (IN(k) && IN((k) + 1)) xcd_barrier(bar); } while (0)
#pragma unroll 1
    for (int l = 0; l < DEPTH; ++l) {
        c.l = l; const int pb = l * PH_PER_LAYER;
        if (IN(pb + 0)) phase_norm1(c, lds);
        SEAM(pb + 0);
        if (IN(pb + 1)) phase_gemm1(c, lds);
        SEAM(pb + 1);
        if (IN(pb + 2)) phase_prep(c, lds);
        SEAM(pb + 2);
        if (IN(pb + 3)) phase_poolgemm(c, lds);
        SEAM(pb + 3);
        if (IN(pb + 4)) phase_mix(c, lds);
        SEAM(pb + 4);
        if (IN(pb + 5)) phase_rwkv_post(c, lds);
        SEAM(pb + 5);
        if (IN(pb + 6)) phase_merge(c, lds);
        SEAM(pb + 6);
        if (IN(pb + 7)) phase_outp(c, lds);
        SEAM(pb + 7);
        if (IN(pb + 8)) phase_norm2(c, lds);
        SEAM(pb + 8);
        if (IN(pb + 9)) phase_moe_up(c, lds);
        SEAM(pb + 9);
        if (IN(pb + 10)) phase_moe_down(c, lds);
        SEAM(pb + 10);
    }
    if (IN(N_PHASES - 1)) phase_final(c, lds);
}

#ifndef MK_N_LAUNCHES
#define MK_N_LAUNCHES 1
#endif
extern "C" void kernel_launch(void* const* d_in, const int* in_sizes, int n_in, void* d_out, int out_size, void* d_ws, size_t ws_size, hipStream_t stream) {
    static int grid = 0;
    if (grid == 0) {
        if (n_in != N_IN || out_size != NT * DM || ws_size < WS_END) { fprintf(stderr, "kernel_launch: unexpected shapes n_in %d out %d ws %zu (need %zu)\n", n_in, out_size, ws_size, (size_t)WS_END); grid = -1; return; }
        int dev = 0, cus = 0, per_cu = 0;
        if (hipGetDevice(&dev) != hipSuccess || hipDeviceGetAttribute(&cus, hipDeviceAttributeMultiprocessorCount, dev) != hipSuccess) { grid = -1; return; }
        if (hipFuncSetAttribute((const void*)fwd_kernel, hipFuncAttributeMaxDynamicSharedMemorySize, LDS_BYTES) != hipSuccess) { fprintf(stderr, "kernel_launch: hipFuncSetAttribute failed\n"); grid = -1; return; }
        if (hipOccupancyMaxActiveBlocksPerMultiprocessor(&per_cu, (const void*)fwd_kernel, NTHREADS, LDS_BYTES) != hipSuccess || per_cu < 1) { fprintf(stderr, "kernel_launch: occupancy query says %d\n", per_cu); }
        (void)hipGetLastError();
        grid = cus;
    }
    if (grid < 0) return;
    if (hipMemsetAsync((char*)d_ws + WS_CTL, 0, CTL_BYTES, stream) != hipSuccess) return;
    Params p{};
    for (int i = 0; i < N_IN; ++i) p.in[i] = (const float*)d_in[i];
    p.out = (float*)d_out; p.ws = (unsigned char*)d_ws;
    if (MK_N_LAUNCHES == 1) {
        p.ph_lo = 0; p.ph_hi = N_PHASES;
        hipLaunchKernelGGL(fwd_kernel, dim3(grid), dim3(NTHREADS), LDS_BYTES, stream, p);
    } else {
        for (int k = 0; k < N_PHASES; ++k) { p.ph_lo = k; p.ph_hi = k + 1; hipLaunchKernelGGL(fwd_kernel, dim3(grid), dim3(NTHREADS), LDS_BYTES, stream, p); }
    }
}
```

```cpp
#include <hip/hip_runtime.h>
#include <cstdio>
#include <cstdint>

#define DI __device__ __forceinline__
typedef unsigned short bf16_t;
typedef short bf16x8 __attribute__((ext_vector_type(8)));
typedef float f32x4 __attribute__((ext_vector_type(4)));
typedef unsigned u32x4 __attribute__((ext_vector_type(4)));
typedef unsigned u32x2 __attribute__((ext_vector_type(2)));

constexpr int NB = 4, SEQ = 4096, DM = 1024, NT = NB * SEQ, DEPTH = 2;
constexpr int IN_COLS = 4816;
constexpr int C_POOL = 0, C_RW = 512, C_R = 512, C_K = 1024, C_V = 1536, C_WD = 2048, C_AD = 2080, C_GD = 2112;
constexpr int C_Q = 2208, C_KC = 3232, C_VC = 3488, C_KS = 3744, C_VS = 4000, C_KW = 4256, C_VW = 4512, C_GATE = 4768;
constexpr int RWC = 1696;
constexpr int NCMP = 255;
constexpr int NTHREADS = 512;
constexpr int LDS_BYTES = 155648;

enum { I_X = 0, I_RELB, I_NMIX, I_WIN, I_POOLW, I_POOLS, I_MU, I_W0, I_WUP, I_A0, I_AUP, I_GUP, I_KK, I_KA, I_RK, I_GNW, I_GNB,
       I_CPK, I_CW1K, I_CW2K, I_CPV, I_CW1V, I_CW2V, I_WBR, I_WMG, I_BMG, I_WOUT, I_NFFN, I_WRG, I_BRG, I_WRE, I_BRE, I_EG, I_EU, I_ED, I_NFIN, N_IN };

constexpr size_t WS_CTL = 0;
constexpr size_t CTL_BYTES = 65536;
constexpr size_t WS_H = CTL_BYTES;
constexpr size_t WS_PROJ = WS_H + (size_t)NT * DM * 2;
constexpr size_t WS_F = WS_PROJ + (size_t)NT * IN_COLS * 2;
constexpr size_t PLANE = (size_t)NT * 512 * 2;
constexpr size_t WS_POOLED = WS_F + 6 * PLANE;
constexpr size_t WS_CMPH = WS_POOLED + PLANE;
constexpr size_t WS_CMPO = WS_CMPH + (size_t)2 * 4096 * 256 * 2;
constexpr size_t WS_POSB = WS_CMPO + (size_t)2 * 4096 * 64 * 4;
constexpr size_t WS_ROUTE = WS_POSB + 4096;
constexpr size_t WS_ENT = WS_ROUTE + (size_t)NT * 32;
constexpr size_t WS_VT = WS_ENT + (size_t)32 * NT * 8;
constexpr size_t WS_KC = WS_VT + (size_t)2 * 16 * 64 * SEQ * 2;
constexpr size_t WS_VCT = WS_KC + (size_t)16 * 256 * 64 * 2;
constexpr size_t WS_YRAW = WS_VCT + (size_t)16 * 64 * 256 * 2;
constexpr size_t WS_BON = WS_YRAW + (size_t)NT * 512 * 2;
constexpr size_t WS_SMALLW = WS_BON + (size_t)NT * 8 * 16;
constexpr size_t WS_WT_LORA = WS_SMALLW + 262144;
constexpr size_t WS_END = WS_WT_LORA + (size_t)1536 * 128 * 2;
constexpr size_t WS_WT_IN = WS_F;
constexpr size_t WS_WT_C1 = WS_CMPO;
constexpr size_t WS_WT_C2 = WS_SMALLW;
constexpr size_t WS_WT_POOL = WS_SMALLW + 131072;
constexpr size_t WS_WT_MG = WS_VT;
constexpr size_t WS_WT_BR = WS_VT + (size_t)3072 * 1024 * 2;
constexpr size_t WS_WT_OUT = WS_CMPH;
constexpr size_t WS_EG = WS_F + 2 * PLANE;
constexpr size_t WS_EU = WS_EG + (size_t)32 * 256 * 1024 * 2;
constexpr size_t WS_ED = WS_EU + (size_t)32 * 256 * 1024 * 2;
static_assert(WS_ED + (size_t)32 * 1024 * 256 * 2 <= WS_F + 6 * PLANE, "expert alias");
static_assert(WS_WT_BR + (size_t)2048 * 1024 * 2 <= WS_VT + (size_t)2 * 16 * 64 * SEQ * 2, "merge alias");
static_assert((size_t)4864 * 1024 * 2 <= 6 * PLANE, "w_in alias");
constexpr size_t WS_HID = WS_PROJ;
constexpr size_t WS_Y = WS_PROJ + (size_t)2 * NT * 256 * 2;
static_assert(WS_Y + (size_t)2 * NT * 1024 * 2 <= WS_F, "alias");
constexpr int CW_BAR = 0;
constexpr int CW_CNT = 4096;
constexpr int CW_CUR = 4096 + 64;
constexpr int CW_Q = 4096 + 128;

#define XB_TMO      128
#define XB_XCNT(j)  (256  + 64 * (j))
#define XB_XSUB(j)  (1280 + 64 * (j))
#define XB_XGEN(j)  (2304 + 64 * (j))
#define XB_TOP      3328
#define XB_TOPGEN   3392
#define XCD_BAR_WORDS 3456
#define XB_SPIN_CAP (1u << 18)
#define LAS __attribute__((address_space(3)))

__device__ __forceinline__ unsigned xb_ld(unsigned* p)              { return __hip_atomic_load(p, __ATOMIC_RELAXED, __HIP_MEMORY_SCOPE_AGENT); }
__device__ __forceinline__ unsigned xb_add(unsigned* p, unsigned v) { return __hip_atomic_fetch_add(p, v, __ATOMIC_RELAXED, __HIP_MEMORY_SCOPE_AGENT); }
__device__ __forceinline__ unsigned xb_xcc_id() { return (unsigned)__builtin_amdgcn_s_getreg((3 << 11) | 20) & 0xFu; }
#define XB_SPIN(cond, bar) do { unsigned _sp = 0; while (cond) { __builtin_amdgcn_s_sleep(1); \
    if ((++_sp & 255u) == 0u) { if (xb_ld(&(bar)[XB_TMO])) break; if (_sp > XB_SPIN_CAP) { atomicAdd(&(bar)[XB_TMO], 1u); break; } } } } while (0)

struct XcdBarrier { unsigned* bar; unsigned x; volatile LAS unsigned* st; };

__device__ __forceinline__ XcdBarrier xcd_barrier_post(unsigned* bar, volatile LAS unsigned* st) {
    XcdBarrier b; b.bar = bar; b.x = xb_xcc_id(); b.st = st;
    if (threadIdx.x == 0) (void)xb_add(&bar[XB_XCNT(b.x)], 1u);
    return b;
}
__device__ __forceinline__ void xcd_barrier_complete(unsigned* bar, unsigned x, unsigned& nloc, unsigned& nx) {
    const unsigned G = gridDim.x * gridDim.y * gridDim.z;
    unsigned sum, cnt, mine, sp = 0u;
    for (;;) {
        sum = 0u; cnt = 0u; mine = 0u;
#pragma unroll
        for (unsigned j = 0; j < 16; ++j) { const unsigned c = xb_ld(&bar[XB_XCNT(j)]); sum += c; cnt += (c > 0u) ? 1u : 0u; mine = (j == x) ? c : mine; }
        if (sum == G) break;
        __builtin_amdgcn_s_sleep(1);
        if ((++sp & 255u) == 0u) { if (xb_ld(&bar[XB_TMO])) break; if (sp > XB_SPIN_CAP) { atomicAdd(&bar[XB_TMO], 1u); break; } }
    }
    nloc = mine > 0u ? mine : 1u; nx = cnt > 0u ? cnt : 1u;
}
__device__ __forceinline__ void xcd_barrier(const XcdBarrier& b) {
    asm volatile("s_waitcnt vmcnt(0)" ::: "memory");
    __syncthreads();
    if (threadIdx.x == 0) {
        unsigned* bar = b.bar;
        __builtin_amdgcn_s_waitcnt(0);
        unsigned nloc = b.st[0], nx = b.st[1];
        if (nloc == 0u) { xcd_barrier_complete(bar, b.x, nloc, nx); b.st[0] = nloc; b.st[1] = nx; }
        const unsigned old = xb_add(&bar[XB_XSUB(b.x)], 1u);
        const unsigned gen = old / nloc;
        if (old + 1u == (gen + 1u) * nloc) {
            __builtin_amdgcn_fence(__ATOMIC_RELEASE, "agent");
            asm volatile("s_waitcnt vmcnt(0)" ::: "memory");
            const unsigned og = xb_add(&bar[XB_TOP], 1u);
            const unsigned tg = og / nx;
            if (og + 1u == (tg + 1u) * nx) xb_add(&bar[XB_TOPGEN], 1u);
            else XB_SPIN(xb_ld(&bar[XB_TOPGEN]) == tg, bar);
            __builtin_amdgcn_fence(__ATOMIC_ACQUIRE, "agent");
            xb_add(&bar[XB_XGEN(b.x)], 1u);
            asm volatile("s_waitcnt vmcnt(0)" ::: "memory");
        } else {
            XB_SPIN(xb_ld(&bar[XB_XGEN(b.x)]) == gen, bar);
            __builtin_amdgcn_fence(__ATOMIC_ACQUIRE, "agent");
            asm volatile("s_waitcnt vmcnt(0)" ::: "memory");
        }
    }
    __syncthreads();
}

DI bf16_t f2bf(float x) { unsigned u = __float_as_uint(x); u += 0x7fffu + ((u >> 16) & 1u); return (bf16_t)(u >> 16); }
DI float bf2f(bf16_t b) { return __uint_as_float((unsigned)b << 16); }
typedef __bf16 bf16v2_t __attribute__((ext_vector_type(2)));
typedef float f32v2_t __attribute__((ext_vector_type(2)));
DI unsigned pack2(float lo, float hi) { const f32v2_t v = {lo, hi}; const bf16v2_t b = __builtin_convertvector(v, bf16v2_t); return __builtin_bit_cast(unsigned, b); }
DI float bflo(unsigned w) { return __uint_as_float(w << 16); }
DI float bfhi(unsigned w) { return __uint_as_float(w & 0xffff0000u); }
DI float wave_sum(float v) {
#pragma unroll
    for (int o = 32; o >= 1; o >>= 1) v += __shfl_xor(v, o);
    return v;
}
DI float wave_max(float v) {
#pragma unroll
    for (int o = 32; o >= 1; o >>= 1) v = fmaxf(v, __shfl_xor(v, o));
    return v;
}
DI float sigmoidf_(float x) { return __builtin_amdgcn_rcpf(1.0f + __expf(-x)); }
DI int TID() { int t = threadIdx.x; asm volatile("" : "+v"(t)); return t; }
#define LDS_WAVE_SYNC() asm volatile("s_waitcnt lgkmcnt(0)" ::: "memory")

#define DPP_MOV(v, ctrl) __builtin_bit_cast(float, __builtin_amdgcn_update_dpp(0, __builtin_bit_cast(int, (v)), (ctrl), 0xF, 0xF, true))
DI float wave_sum_dpp(float v) {
    v += DPP_MOV(v, 0xB1); v += DPP_MOV(v, 0x4E); v += DPP_MOV(v, 0x141); v += DPP_MOV(v, 0x140);
    return __builtin_bit_cast(float, __builtin_amdgcn_readlane(__builtin_bit_cast(int, v), 0)) + __builtin_bit_cast(float, __builtin_amdgcn_readlane(__builtin_bit_cast(int, v), 16)) +
        (__builtin_bit_cast(float, __builtin_amdgcn_readlane(__builtin_bit_cast(int, v), 32)) + __builtin_bit_cast(float, __builtin_amdgcn_readlane(__builtin_bit_cast(int, v), 48)));
}
struct Params { const float* in[N_IN]; float* out; unsigned char* ws; int ph_lo, ph_hi; };

DI int t5_bucket(int n) {
    if (n < 16) return n;
    if (n >= 128) return 31;
    int b = 16;
    b += (n >= 19) + (n >= 21) + (n >= 24) + (n >= 27) + (n >= 31) + (n >= 35) + (n >= 40) + (n >= 46) + (n >= 52) + (n >= 59) + (n >= 67) + (n >= 77) + (n >= 87) + (n >= 99) + (n >= 113);
    return b;
}

constexpr int G_A = 0, G_B = 256 * 64 * 2, G_STAGE = (256 + 128) * 64 * 2;
static_assert(2 * G_STAGE <= LDS_BYTES - 64, "gemm lds");
DI int g_off(int r, int c) { return ((r >> 4) * 2 + (c >> 5)) * 1024 + ((((r & 15) * 64) + (c & 31) * 2) ^ ((((r & 15) >> 3) & 1) << 5)); }
struct ARows { const bf16_t* p[4]; const float* mu; int ltype; int first; };
DI float tanhf_fast(float x) { const float e = __expf(2.0f * x); return 1.0f - 2.0f * __builtin_amdgcn_rcpf(e + 1.0f); }
DI u32x4 lora_chunk(const bf16_t* prow, bool first, const float* mu, int ltype, int k) {
    const int lim = (ltype == 2) ? 96 : 32;
    if (k >= lim) return (u32x4){0u, 0u, 0u, 0u};
    const int col = C_WD + ltype * 32 + k;
    const u32x4 cu = *(const u32x4*)(prow + col);
    u32x4 pu = (u32x4){0u, 0u, 0u, 0u};
    if (!first) pu = *(const u32x4*)(prow - IN_COLS + col);
    const f32x4 m0 = *(const f32x4*)(mu + col - C_RW), m1 = *(const f32x4*)(mu + col - C_RW + 4);
    float u[8] = {bflo(cu.x), bfhi(cu.x), bflo(cu.y), bfhi(cu.y), bflo(cu.z), bfhi(cu.z), bflo(cu.w), bfhi(cu.w)};
    const float p[8] = {bflo(pu.x), bfhi(pu.x), bflo(pu.y), bfhi(pu.y), bflo(pu.z), bfhi(pu.z), bflo(pu.w), bfhi(pu.w)};
    const float mm[8] = {m0[0], m0[1], m0[2], m0[3], m1[0], m1[1], m1[2], m1[3]};
#pragma unroll
    for (int j = 0; j < 8; ++j) { const float us = u[j] + (p[j] - u[j]) * mm[j]; u[j] = (ltype == 0) ? tanhf_fast(us) : ((ltype == 1) ? us : __builtin_amdgcn_rcpf(1.0f + __expf(-us))); }
    u32x4 w; w.x = pack2(u[0], u[1]); w.y = pack2(u[2], u[3]); w.z = pack2(u[4], u[5]); w.w = pack2(u[6], u[7]);
    return w;
}
template <int AMODE>
DI void g_load(u32x4 (&ra)[4], u32x4 (&rb)[2], const ARows& ar, const bf16_t* bt, int ldb, int k0, int tid) {
    const int kseg = (tid & 7) * 8;
#pragma unroll
    for (int i = 0; i < 4; ++i) {
        ra[i] = (u32x4){0u, 0u, 0u, 0u};
        if (AMODE == 2) ra[i] = lora_chunk(ar.p[i], (ar.first >> i) & 1, ar.mu, ar.ltype, k0 + kseg);
        else if (ar.p[i] != nullptr) ra[i] = *(const u32x4*)((AMODE == 0) ? (ar.p[i] + k0 + kseg) : (ar.p[i] + (size_t)(k0 >> 6) * IN_COLS + kseg));
    }
#pragma unroll
    for (int i = 0; i < 2; ++i) rb[i] = *(const u32x4*)(bt + (size_t)((tid >> 3) + 64 * i) * ldb + k0 + kseg);
}
DI void g_store(unsigned char* st, const u32x4 (&ra)[4], const u32x4 (&rb)[2], int tid) {
    const int off = g_off(tid >> 3, (tid & 7) * 8);
#pragma unroll
    for (int i = 0; i < 4; ++i) *(u32x4*)(st + G_A + off + i * 8192) = ra[i];
#pragma unroll
    for (int i = 0; i < 2; ++i) *(u32x4*)(st + G_B + off + i * 8192) = rb[i];
}
DI void g_compute(f32x4 (&acc)[4][4], const unsigned char* st, int lane, int wm, int wn) {
    const int lo = ((lane & 15) * 64 + (lane >> 4) * 16) ^ ((((lane & 15) >> 3) & 1) << 5);
    const unsigned char* sA = st + G_A + wm * 8192 + lo;
    const unsigned char* sB = st + G_B + wn * 8192 + lo;
    bf16x8 bcur[4], bnxt[4], a0, a1, a2;
#pragma unroll
    for (int i = 0; i < 4; ++i) bcur[i] = *(const bf16x8*)(sB + i * 2048);
    a0 = *(const bf16x8*)(sA);
    a1 = *(const bf16x8*)(sA + 2048);
#define G_AFRAG(s) (*(const bf16x8*)(sA + ((s) & 3) * 2048 + ((s) >> 2) * 1024))
#define G_GROUP(s, acur, anew) do { \
        if ((s) + 2 < 8) anew = G_AFRAG((s) + 2); \
        if ((s) < 4) bnxt[(s) & 3] = *(const bf16x8*)(sB + ((s) & 3) * 2048 + 1024); \
        __builtin_amdgcn_sched_barrier(0); \
        _Pragma("unroll") for (int ni = 0; ni < 4; ++ni) acc[(s) & 3][ni] = __builtin_amdgcn_mfma_f32_16x16x32_bf16(((s) < 4 ? bcur[ni] : bnxt[ni]), acur, acc[(s) & 3][ni], 0, 0, 0); \
        __builtin_amdgcn_sched_barrier(0); } while (0)
    G_GROUP(0, a0, a2); G_GROUP(1, a1, a0); G_GROUP(2, a2, a1); G_GROUP(3, a0, a2);
    G_GROUP(4, a1, a0); G_GROUP(5, a2, a1); G_GROUP(6, a0, a2); G_GROUP(7, a1, a0);
#undef G_GROUP
#undef G_AFRAG
}
#define LDS_BARRIER() do { asm volatile("s_waitcnt lgkmcnt(0)" ::: "memory"); __builtin_amdgcn_s_barrier(); asm volatile("" ::: "memory"); } while (0)
template <int AMODE>
DI void gemm_core(f32x4 (&acc)[4][4], const ARows& ar, const bf16_t* bt  , int ldb, int K, unsigned char* lds) {
    const int tid = TID(), lane = tid & 63, wave = tid >> 6, wm = wave >> 1, wn = wave & 1;
    const int nk = K >> 6;
    unsigned char* s0 = lds; unsigned char* s1 = lds + G_STAGE;
    u32x4 ra0[4], rb0[2], ra1[4], rb1[2];
    g_load<AMODE>(ra0, rb0, ar, bt, ldb, 0, tid);
    g_load<AMODE>(ra1, rb1, ar, bt, ldb, 64, tid);
    __syncthreads();
    g_store(s0, ra0, rb0, tid);
    g_load<AMODE>(ra0, rb0, ar, bt, ldb, (nk > 2 ? 2 : nk - 1) * 64, tid);
    LDS_BARRIER();
    for (int kt = 0; kt < nk; kt += 2) {
        g_store(s1, ra1, rb1, tid);
        { const int kn = (kt + 3 < nk) ? kt + 3 : nk - 1; g_load<AMODE>(ra1, rb1, ar, bt, ldb, kn * 64, tid); }
        g_compute(acc, s0, lane, wm, wn);
        LDS_BARRIER();
        g_store(s0, ra0, rb0, tid);
        { const int kn = (kt + 4 < nk) ? kt + 4 : nk - 1; g_load<AMODE>(ra0, rb0, ar, bt, ldb, kn * 64, tid); }
        g_compute(acc, s1, lane, wm, wn);
        LDS_BARRIER();
    }
}
static_assert(3 * G_STAGE <= LDS_BYTES - 64, "dma ring");
DI void gemm_core_dma(f32x4 (&acc)[4][4], const bf16_t* A, size_t lda, const bf16_t* bt, size_t ldb, int K, unsigned char* lds) {
    const int tid = TID(), lane = tid & 63, wave = __builtin_amdgcn_readfirstlane(tid >> 6), wm = wave >> 1, wn = wave & 1;
    const int nk = K >> 6;
    const int srow = lane >> 2, skof = ((lane & 3) * 8) ^ ((lane >> 5) << 4);
    const char* gp[6]; int loff[6];
#pragma unroll
    for (int j = 0; j < 6; ++j) {
        const int sid = wave * 6 + j;
        if (sid < 32) { gp[j] = (const char*)(A + (size_t)((sid >> 1) * 16 + srow) * lda + (sid & 1) * 32 + skof); loff[j] = G_A + sid * 1024; }
        else { const int s2 = sid - 32; gp[j] = (const char*)(bt + (size_t)((s2 >> 1) * 16 + srow) * ldb + (s2 & 1) * 32 + skof); loff[j] = G_B + s2 * 1024; }
    }
#define DMA_ISSUE(kt_, st_) do { const int _k = ((kt_) < nk ? (kt_) : nk - 1) * 128; \
        _Pragma("unroll") for (int j = 0; j < 6; ++j) __builtin_amdgcn_global_load_lds((const unsigned*)(gp[j] + _k), (LAS unsigned*)(lds + (st_) * G_STAGE + loff[j]), 16, 0, 0); } while (0)
    asm volatile("s_waitcnt vmcnt(0)" ::: "memory");
    __syncthreads();
    DMA_ISSUE(0, 0); DMA_ISSUE(1, 1);
    int st = 0;
    for (int kt = 0; kt < nk; ++kt) {
        asm volatile("s_waitcnt vmcnt(6)" ::: "memory");
        __builtin_amdgcn_s_barrier();
        asm volatile("" ::: "memory");
        const int sn = (st == 0) ? 2 : st - 1;
        DMA_ISSUE(kt + 2, sn);
        g_compute(acc, lds + st * G_STAGE, lane, wm, wn);
        st = (st == 2) ? 0 : st + 1;
    }
    asm volatile("s_waitcnt vmcnt(0)" ::: "memory");
    __syncthreads();
#undef DMA_ISSUE
}
DI void store_bf4(bf16_t* p, f32x4 v) { u32x2 w; w.x = pack2(v[0], v[1]); w.y = pack2(v[2], v[3]); *(u32x2*)p = w; }
#define R256(mi) ((((mi) >> 2) * 128) + wm * 64 + (((mi) & 3) * 16) + (lane & 15))
#define C256(ni) ((((ni) >> 1) * 128) + wn * 32 + (((ni) & 1) * 16) + ((lane >> 4) * 4))
constexpr int HTB = 128 * 64 * 2;
static_assert(8 * HTB <= LDS_BYTES - 1024, "gemm256 lds");
DI int lds_byte(int r, int c) { const int st = (r >> 4) * 2 + (c >> 5), rr = r & 15, cc = c & 31, ob = rr * 64 + cc * 2; return st * 1024 + (ob ^ (((ob >> 9) & 1) << 5)); }
DI void stage_rc(int b, int& R, int& C) { const int st = b / 1024, sb = b % 1024, swz = sb ^ (((sb >> 9) & 1) << 5); R = (st >> 1) * 16 + swz / 64; C = (st & 1) * 32 + (swz % 64) / 2; }
struct GatherRows { const int* ent; int n; };
DI void gemm256_dma(f32x4 (&acc)[8][4], const bf16_t* A, size_t lda, const bf16_t* bt, size_t ldb, int K, unsigned char* lds_, const GatherRows* gr = nullptr, unsigned bhalf_extra = 0u) {
    LAS unsigned char* lds = (LAS unsigned char*)lds_;
    const int tid = TID(), wid = __builtin_amdgcn_readfirstlane(tid >> 6), lane = tid & 63, wr = wid >> 2, wc = wid & 3, fr = lane & 15, fq = lane >> 4;
    const int nt = K >> 6;
    unsigned voffA[2][2], voffB[2][2];
#pragma unroll
    for (int i = 0; i < 2; ++i) { int R, C; stage_rc(tid * 16 + i * 8192, R, C);
#pragma unroll
        for (int h = 0; h < 2; ++h) { const int row = h * 128 + R;
            size_t ra = (size_t)row;
            if (gr != nullptr) ra = (size_t)((row < gr->n) ? gr->ent[2 * row] : 0);
            voffA[h][i] = (unsigned)((ra * lda + C) * 2); voffB[h][i] = (unsigned)(((size_t)row * ldb + C) * 2) + (h ? bhalf_extra : 0u); } }
    const unsigned ldsw = (unsigned)wid * 1024u;
    const int aoff = lds_byte(wr * 64 + fr, fq * 8), boff = lds_byte(wc * 32 + fr, fq * 8);
#define PG8_SA(b, h) (((b) * 2 + (h)) * HTB)
#define PG8_SB(b, h) ((4 + (b) * 2 + (h)) * HTB)
#define PG8_STAGE(bufoff, gbase, voff) do { _Pragma("unroll") for (int _i = 0; _i < 2; ++_i) \
        __builtin_amdgcn_global_load_lds((const unsigned*)((const char*)(gbase) + (voff)[_i]), (LAS unsigned*)(lds + (bufoff) + ldsw + _i * 8192), 16, 0, 0); } while (0)
#define PG8_LDA(dst, b, h) do { _Pragma("unroll") for (int m = 0; m < 4; ++m) _Pragma("unroll") for (int k = 0; k < 2; ++k) dst[m][k] = *(const LAS bf16x8*)(lds + PG8_SA(b, h) + aoff + m * 2048 + k * 1024); } while (0)
#define PG8_LDB(dst, b, h) do { _Pragma("unroll") for (int n = 0; n < 2; ++n) _Pragma("unroll") for (int k = 0; k < 2; ++k) dst[n][k] = *(const LAS bf16x8*)(lds + PG8_SB(b, h) + boff + n * 2048 + k * 1024); } while (0)
#define PG8_MMA(ai, bj, At, Bt) do { __builtin_amdgcn_s_setprio(1); _Pragma("unroll") for (int m = 0; m < 4; ++m) _Pragma("unroll") for (int n = 0; n < 2; ++n) _Pragma("unroll") for (int k = 0; k < 2; ++k) \
        acc[(ai) * 4 + m][(bj) * 2 + n] = __builtin_amdgcn_mfma_f32_16x16x32_bf16(Bt[n][k], At[m][k], acc[(ai) * 4 + m][(bj) * 2 + n], 0, 0, 0); __builtin_amdgcn_s_setprio(0); } while (0)
#define PG8_WAIT_V(n) asm volatile("s_waitcnt vmcnt(" #n ")" ::: "memory")
#define PG8_WAIT_L(n) asm volatile("s_waitcnt lgkmcnt(" #n ")" ::: "memory")
#define PG8_BAR __builtin_amdgcn_s_barrier()
#define PG8_SCHED __builtin_amdgcn_sched_barrier(0)
    bf16x8 At[4][2], B0[2][2], B1[2][2];
    const char* cA = (const char*)A; const char* cB = (const char*)bt;
    const size_t kstep = 128;
    asm volatile("s_waitcnt vmcnt(0)" ::: "memory");
    __syncthreads();
    PG8_STAGE(PG8_SB(0, 0), cB, voffB[0]); PG8_STAGE(PG8_SA(0, 0), cA, voffA[0]); PG8_STAGE(PG8_SB(0, 1), cB, voffB[1]); PG8_STAGE(PG8_SA(0, 1), cA, voffA[1]);
    if (wr == 1) PG8_BAR;
    PG8_WAIT_V(4); PG8_BAR;
    PG8_STAGE(PG8_SB(1, 0), cB + kstep, voffB[0]); PG8_STAGE(PG8_SA(1, 0), cA + kstep, voffA[0]); PG8_STAGE(PG8_SB(1, 1), cB + kstep, voffB[1]);
    PG8_WAIT_V(6); PG8_BAR;
    for (int t = 0; t < nt; t += 2) {
        const bool last = (t == nt - 2);
        const char* a1 = cA + (size_t)(t + 1) * kstep;
        const char* a2 = last ? cA : cA + (size_t)(t + 2) * kstep; const char* b2 = last ? cB : cB + (size_t)(t + 2) * kstep;
        const char* a3 = a2 + kstep; const char* b3 = b2 + kstep;
        PG8_LDB(B0, 0, 0); PG8_SCHED; PG8_LDA(At, 0, 0); PG8_STAGE(PG8_SA(1, 1), a1, voffA[1]);
        PG8_WAIT_L(8); PG8_BAR; PG8_WAIT_L(0); PG8_MMA(0, 0, At, B0); PG8_BAR; PG8_SCHED;
        PG8_LDB(B1, 0, 1); PG8_STAGE(PG8_SB(0, 0), b2, voffB[0]);
        PG8_BAR; PG8_WAIT_L(0); PG8_MMA(0, 1, At, B1); PG8_BAR;
        PG8_LDA(At, 0, 1); PG8_STAGE(PG8_SA(0, 0), a2, voffA[0]);
        PG8_BAR; PG8_WAIT_L(0); PG8_MMA(1, 0, At, B0); PG8_BAR; PG8_SCHED;
        PG8_STAGE(PG8_SB(0, 1), b2, voffB[1]);
        PG8_WAIT_V(6); PG8_BAR; PG8_MMA(1, 1, At, B1); PG8_BAR;
        PG8_LDB(B0, 1, 0); PG8_SCHED; PG8_LDA(At, 1, 0); PG8_STAGE(PG8_SA(0, 1), a2, voffA[1]);
        PG8_WAIT_L(8); PG8_BAR; PG8_WAIT_L(0); PG8_MMA(0, 0, At, B0); PG8_BAR; PG8_SCHED;
        PG8_LDB(B1, 1, 1); PG8_STAGE(PG8_SB(1, 0), b3, voffB[0]);
        PG8_BAR; PG8_WAIT_L(0); PG8_MMA(0, 1, At, B1); PG8_BAR;
        PG8_LDA(At, 1, 1); PG8_STAGE(PG8_SA(1, 0), a3, voffA[0]);
        PG8_BAR; PG8_WAIT_L(0); PG8_MMA(1, 0, At, B0); PG8_BAR; PG8_SCHED;
        PG8_STAGE(PG8_SB(1, 1), b3, voffB[1]);
        PG8_WAIT_V(6); PG8_BAR; PG8_MMA(1, 1, At, B1); PG8_BAR;
    }
    PG8_WAIT_V(0);
    if (wr == 0) PG8_BAR;
    PG8_BAR;
    asm volatile("" ::: "memory");
#undef PG8_SA
#undef PG8_SB
#undef PG8_STAGE
#undef PG8_LDA
#undef PG8_LDB
#undef PG8_MMA
#undef PG8_WAIT_V
#undef PG8_WAIT_L
#undef PG8_BAR
#undef PG8_SCHED
}
DI void tile256_store_bf16(f32x4 (&acc)[8][4], bf16_t* out, size_t ld, int ncols, unsigned char* lds) {
    bf16_t* T = (bf16_t*)lds;
    const int tid = TID(), lane = tid & 63, wave = tid >> 6, wm = wave >> 2, wn = wave & 3;
    __syncthreads();
#pragma unroll
    for (int mi = 0; mi < 8; ++mi)
#pragma unroll
        for (int ni = 0; ni < 4; ++ni) store_bf4(T + R256(mi) * 264 + C256(ni), acc[mi][ni]);
    __syncthreads();
#pragma unroll
    for (int i = 0; i < 16; ++i) {
        const int ch = tid + i * NTHREADS, r = ch >> 5, cc = (ch & 31) * 8;
        if (cc < ncols) *(u32x4*)(out + (size_t)r * ld + cc) = *(const u32x4*)(T + r * 264 + cc);
    }
}
DI void acc_zero(f32x4 (&acc)[4][4]) {
#pragma unroll
    for (int i = 0; i < 4; ++i)
#pragma unroll
        for (int j = 0; j < 4; ++j) acc[i][j] = (f32x4){0.f, 0.f, 0.f, 0.f};
}
#define ACC_FOREACH(acc, body) do { const int _l = TID() & 63, _w = TID() >> 6; \
    _Pragma("unroll") for (int _mi = 0; _mi < 4; ++_mi) _Pragma("unroll") for (int _ni = 0; _ni < 4; ++_ni) { \
        const int r_ = (_w >> 1) * 64 + _mi * 16 + (_l & 15), c_ = (_w & 1) * 64 + _ni * 16 + (_l >> 4) * 4; f32x4& v_ = acc[_mi][_ni]; body } } while (0)
DI ARows plain_rows(const bf16_t* base, size_t ld, int m0, int tid) { ARows a; a.mu = nullptr; a.ltype = 0; a.first = 0;
#pragma unroll
    for (int i = 0; i < 4; ++i) a.p[i] = base + (size_t)(m0 + (tid >> 3) + 64 * i) * ld;
    return a; }


DI void convert_tile4(const float* src, int ld, int N, int K, bf16_t* dst, int tile0, unsigned char* lds, int Kvalid = 1 << 30) {
    const int tid = TID();
    const int nkt = K >> 6;
    const int r = tid >> 3, seg = (tid & 7) * 8;
    f32x4 a[4], b[4];
#pragma unroll
    for (int u = 0; u < 4; ++u) {
        const int tile = tile0 + u, k0 = (tile % nkt) * 64, n0 = (tile / nkt) * 64;
        a[u] = (f32x4){0.f, 0.f, 0.f, 0.f}; b[u] = a[u];
        if (n0 + seg < N && k0 + r < Kvalid) { const float* q = src + (size_t)(k0 + r) * ld + n0 + seg; a[u] = *(const f32x4*)q; b[u] = *(const f32x4*)(q + 4); }
    }
    __syncthreads();
#pragma unroll
    for (int u = 0; u < 4; ++u) { bf16_t* T = (bf16_t*)lds + u * 64 * 72;
        u32x4 w; w.x = pack2(a[u][0], a[u][1]); w.y = pack2(a[u][2], a[u][3]); w.z = pack2(b[u][0], b[u][1]); w.w = pack2(b[u][2], b[u][3]); *(u32x4*)(T + r * 72 + seg) = w; }
    __syncthreads();
#pragma unroll
    for (int u = 0; u < 4; ++u) { const bf16_t* T = (const bf16_t*)lds + u * 64 * 72;
        const int tile = tile0 + u, k0 = (tile % nkt) * 64, n0 = (tile / nkt) * 64;
        u32x4 o;
        o.x = (unsigned)T[(seg + 0) * 72 + r] | ((unsigned)T[(seg + 1) * 72 + r] << 16); o.y = (unsigned)T[(seg + 2) * 72 + r] | ((unsigned)T[(seg + 3) * 72 + r] << 16);
        o.z = (unsigned)T[(seg + 4) * 72 + r] | ((unsigned)T[(seg + 5) * 72 + r] << 16); o.w = (unsigned)T[(seg + 6) * 72 + r] | ((unsigned)T[(seg + 7) * 72 + r] << 16);
        *(u32x4*)(dst + (size_t)(n0 + r) * K + k0 + seg) = o; }
}
struct Ctx {
    const Params* P; unsigned char* ws; float* out; int l;
    bf16_t* H; bf16_t* PROJ; bf16_t* F; bf16_t* POOLED; bf16_t* MERGED; bf16_t* CMPH; float* CMPO; float* POSB; int* ROUTE; int* ENT; bf16_t* HID; bf16_t* Y; bf16_t* VT; bf16_t* KC; bf16_t* VCT; bf16_t* YRAW; float* BON; unsigned* ctl;
    DI const float* in(int i) const { return P->in[i]; }
};

DI void moe_offsets(const Ctx& c, int layer, int* soff) {
    const unsigned* cnt = c.ctl + CW_CNT + layer * 32;
    __syncthreads();
    if (TID() == 0) { int s = 0; for (int e = 0; e < 32; ++e) { soff[e] = s; s += (int)cnt[e]; } soff[32] = s; }
    __syncthreads();
}
DI void add_moe_rows(const Ctx& c, int row, int lane, f32x4 (&v)[4], const int* soff) {
    const int* rt = c.ROUTE + (size_t)row * 8;
    const int p0 = soff[rt[0]] + rt[4], p1 = soff[rt[1]] + rt[5];
    const bf16_t* y0 = c.Y + (size_t)p0 * DM; const bf16_t* y1 = c.Y + (size_t)p1 * DM;
#pragma unroll
    for (int i = 0; i < 4; ++i) {
        const u32x2 a = *(const u32x2*)(y0 + i * 256 + lane * 4), b = *(const u32x2*)(y1 + i * 256 + lane * 4);
        v[i][0] += bflo(a.x) + bflo(b.x); v[i][1] += bfhi(a.x) + bfhi(b.x); v[i][2] += bflo(a.y) + bflo(b.y); v[i][3] += bfhi(a.y) + bfhi(b.y);
    }
}
DI void phase_norm1(const Ctx& c, unsigned char* lds) {
    const int tid = TID(), lane = tid & 63, wave = tid >> 6;
    const float* gain = c.in(I_NMIX) + c.l * DM;
    const float* src = (c.l == 0) ? c.in(I_X) : c.out;
    int* soff = (int*)(lds + 65536);
    if (c.l > 0) moe_offsets(c, c.l - 1, soff);
    for (int row = blockIdx.x * 8 + wave; row < NT; row += gridDim.x * 8) {
        f32x4 v[4];
#pragma unroll
        for (int i = 0; i < 4; ++i) v[i] = *(const f32x4*)(src + (size_t)row * DM + i * 256 + lane * 4);
        if (c.l > 0) {
            add_moe_rows(c, row, lane, v, soff);
#pragma unroll
            for (int i = 0; i < 4; ++i) *(f32x4*)(c.out + (size_t)row * DM + i * 256 + lane * 4) = v[i];
        }
        float ss = 0.f;
#pragma unroll
        for (int i = 0; i < 4; ++i) ss += v[i][0] * v[i][0] + v[i][1] * v[i][1] + v[i][2] * v[i][2] + v[i][3] * v[i][3];
        ss = wave_sum_dpp(ss);
        const float rs = rsqrtf(ss * (1.0f / DM) + 1e-6f);
#pragma unroll
        for (int i = 0; i < 4; ++i) {
            const f32x4 g = *(const f32x4*)(gain + i * 256 + lane * 4);
            store_bf4(c.H + (size_t)row * DM + i * 256 + lane * 4, (f32x4){v[i][0] * rs * g[0], v[i][1] * rs * g[1], v[i][2] * rs * g[2], v[i][3] * rs * g[3]});
        }
    }
    for (int idx = blockIdx.x * 8 + wave; idx < 512; idx += gridDim.x * 8) {
        const int kv = idx >> 8, n = idx & 255;
        const float* pos = c.in(kv ? I_CPV : I_CPK) + (size_t)c.l * 2048;
        const float* w1 = c.in(kv ? I_CW1V : I_CW1K) + (size_t)c.l * 2048 * 256;
        float s = 0.f;
        for (int k = lane; k < 2048; k += 64) s += pos[k] * w1[(size_t)k * 256 + n];
        s = wave_sum_dpp(s);
        if (lane == 0) c.POSB[kv * 256 + n] = s;
    }
    for (int it = blockIdx.x * 4; it < 1216 + 256 + 16 + 16 + 48; it += gridDim.x * 4) {
        if (it < 1216) convert_tile4(c.in(I_WIN) + (size_t)c.l * DM * IN_COLS, IN_COLS, IN_COLS, DM, (bf16_t*)(c.ws + WS_WT_IN), it, lds);
        else if (it < 1216 + 256) { const int j = it - 1216, kv = j >> 7; convert_tile4(c.in(kv ? I_CW1V : I_CW1K) + (size_t)c.l * 2048 * 256, 256, 256, 2048, (bf16_t*)(c.ws + WS_WT_C1) + (size_t)kv * 256 * 2048, j & 127, lds); }
        else if (it < 1216 + 256 + 16) { const int j = it - 1472, kv = j >> 3; convert_tile4(c.in(kv ? I_CW2V : I_CW2K) + (size_t)c.l * 256 * 64, 64, 64, 256, (bf16_t*)(c.ws + WS_WT_C2) + (size_t)kv * 128 * 256, j & 7, lds); }
        else if (it < 1504) { const int j = it - 1488, gi = j >> 2; convert_tile4(c.in(I_POOLW) + ((size_t)c.l * 4 + gi) * 128 * 128, 128, 128, 128, (bf16_t*)(c.ws + WS_WT_POOL) + (size_t)gi * 128 * 128, 0, lds); }
        else { const int j = it - 1504, ty = j >> 4; bf16_t* dst = (bf16_t*)(c.ws + WS_WT_LORA) + (size_t)ty * 512 * 128;
            if (ty == 0) convert_tile4(c.in(I_WUP) + (size_t)c.l * 32 * 512, 512, 512, 128, dst, j & 15, lds, 32);
            else if (ty == 1) convert_tile4(c.in(I_AUP) + (size_t)c.l * 32 * 512, 512, 512, 128, dst, j & 15, lds, 32);
            else convert_tile4(c.in(I_GUP) + (size_t)c.l * 96 * 512, 512, 512, 128, dst, j & 15, lds, 96); }
    }
}

constexpr int EPS = 136;
DI void tile_store_bf16(f32x4 (&acc)[4][4], bf16_t* out, size_t ld, int nrows, int ncols, unsigned char* lds) {
    bf16_t* T = (bf16_t*)lds;
    const int tid = TID();
    __syncthreads();
    ACC_FOREACH(acc, { store_bf4(T + r_ * EPS + c_, v_); });
    __syncthreads();
#pragma unroll
    for (int i = 0; i < 8; ++i) {
        const int ch = tid + i * NTHREADS, r = ch >> 4, cc = (ch & 15) * 8;
        if (r < nrows && cc < ncols) *(u32x4*)(out + (size_t)r * ld + cc) = *(const u32x4*)(T + r * EPS + cc);
    }
}
DI bool xcd_unit(int it, int nN, int& tm, int& tn) {
    const int G = gridDim.x;
    if ((G & 7) != 0 || G < 8) { const int u = it * G + blockIdx.x; if (u >= 64 * nN) return false; tm = u % 64; tn = u / 64; return true; }
    const int x = blockIdx.x & 7, i = blockIdx.x >> 3, per = G >> 3;
    const int u = it * per + i;
    if (u >= 8 * nN) return false;
    tm = x * 8 + (u & 7); tn = u >> 3; return true;
}
DI void phase_gemm1(const Ctx& c, unsigned char* lds) {
    const int nN = (IN_COLS + 255) / 256;
    const bf16_t* WT = (const bf16_t*)(c.ws + WS_WT_IN);
    for (int it = 0;; ++it) {
        int tm, tn; if (!xcd_unit(it, nN, tm, tn)) break;
        const int m0 = tm * 256, n0 = tn * 256;
        f32x4 acc[8][4];
#pragma unroll
        for (int i = 0; i < 8; ++i)
#pragma unroll
            for (int j = 0; j < 4; ++j) acc[i][j] = (f32x4){0.f, 0.f, 0.f, 0.f};
        gemm256_dma(acc, c.H + (size_t)m0 * DM, DM, WT + (size_t)n0 * DM, DM, DM, lds);
        tile256_store_bf16(acc, c.PROJ + (size_t)m0 * IN_COLS + n0, IN_COLS, (IN_COLS - n0 < 256) ? IN_COLS - n0 : 256, lds);
    }
}

DI float gelu_tanh(float x) { const float u = 0.7978845608028654f * (x + 0.044715f * x * x * x); const float e = __expf(2.0f * u); return x * (1.0f - __builtin_amdgcn_rcpf(e + 1.0f)); }
DI float softplusf_(float x) { return (x > 20.f) ? x : __logf(1.0f + __expf(x)); }
DI float tanhf_(float x) { const float e = __expf(2.0f * x); return 1.0f - 2.0f * __builtin_amdgcn_rcpf(e + 1.0f); }
constexpr int TKP = 8;
template <int WIN>
DI void pool_emit(const Ctx& c, const float (&pv)[31], int t0, int s0, int ch) {
#pragma unroll
    for (int k = 0; k < 16; ++k) {
        float sum = 0.f;
#pragma unroll
        for (int j = 0; j < WIN; ++j) sum += pv[15 + k - j];
        const int s = s0 + k, cnt = (s + 1 < WIN) ? s + 1 : WIN;
        c.POOLED[(size_t)(t0 + k) * 512 + ch] = f2bf(sum / (float)cnt - pv[15 + k]);
    }
}
DI void phase_prep(const Ctx& c, unsigned char* lds) {
    const int n_cmp_items = 2 * 16 * 2;
    for (int item = (int)gridDim.x - 1 - (int)blockIdx.x; item < n_cmp_items; item += gridDim.x) {
        const int tid = TID();
        const int kv = item >> 5, bgi = (item >> 1) & 15, tn = item & 1, m0 = bgi * 256, n0 = tn * 128;
        ARows ar; ar.mu = nullptr; ar.ltype = 0; ar.first = 0;
#pragma unroll
        for (int i = 0; i < 4; ++i) { const int cb = (tid >> 3) + 64 * i;
            ar.p[i] = (cb < NCMP) ? c.PROJ + ((size_t)(bgi >> 2) * SEQ + 16 * cb) * IN_COLS + (kv ? C_VC : C_KC) + (bgi & 3) * 64 : nullptr; }
        f32x4 acc[4][4]; acc_zero(acc);
        gemm_core<1>(acc, ar, (const bf16_t*)(c.ws + WS_WT_C1) + ((size_t)kv * 256 + n0) * 2048, 2048, 2048, lds);
        const float* pb = c.POSB + kv * 256;
        ACC_FOREACH(acc, {
            const f32x4 bb = *(const f32x4*)(pb + n0 + c_);
            store_bf4(c.CMPH + ((size_t)kv * 4096 + m0 + r_) * 256 + n0 + c_, (f32x4){gelu_tanh(v_[0] + bb[0]), gelu_tanh(v_[1] + bb[1]), gelu_tanh(v_[2] + bb[2]), gelu_tanh(v_[3] + bb[3])}); });
    }
    {
        const float* mu = c.in(I_MU) + (size_t)c.l * RWC;
        const bf16_t* WL = (const bf16_t*)(c.ws + WS_WT_LORA);
        const int G_ = gridDim.x, bid_ = blockIdx.x;
        const bool bal = (G_ == 256);
        const bool cmpb = bal && bid_ >= 192;
        for (int ui = 0;; ++ui) {
            int unit;
            if (!bal) { unit = bid_ + ui * G_; if (unit >= 768) break; }
            else if (cmpb) { if (ui >= 2) break; unit = (bid_ - 192) * 2 + ui; }
            else { unit = 128 + bid_ + 192 * ui; if (unit >= 768) break; }
            const int tid = TID();
            const int tm = unit & 63, tn = unit >> 6, m0 = tm * 256, n0 = tn * 128, ltype = tn >> 2, ch0 = n0 & 511;
            ARows ar; ar.mu = mu; ar.ltype = ltype; ar.first = 0;
#pragma unroll
            for (int i = 0; i < 4; ++i) { const int t = m0 + (tid >> 3) + 64 * i; ar.p[i] = c.PROJ + (size_t)t * IN_COLS; if ((t & (SEQ - 1)) == 0) ar.first |= 1 << i; }
            f32x4 acc[4][4]; acc_zero(acc);
            gemm_core<2>(acc, ar, WL + (size_t)n0 * 128, 128, 128, lds);
            if (ltype == 0) { const float* w0 = c.in(I_W0) + c.l * 512 + ch0;
                ACC_FOREACH(acc, { const f32x4 b4 = *(const f32x4*)(w0 + c_);
                    for (int j = 0; j < 4; ++j) v_[j] = __expf(-softplusf_(-(b4[j] + v_[j])) - 0.5f); }); }
            else if (ltype == 1) { const float* a0 = c.in(I_A0) + c.l * 512 + ch0;
                ACC_FOREACH(acc, { const f32x4 b4 = *(const f32x4*)(a0 + c_);
                    for (int j = 0; j < 4; ++j) v_[j] = sigmoidf_(b4[j] + v_[j]); }); }
            tile_store_bf16(acc, c.F + (size_t)(3 + ltype) * NT * 512 + (size_t)m0 * 512 + ch0, 512, 256, 128, lds);
        }
    }
    const int tid = TID();
    const int n_pool_items = NT / 16, n_items = n_pool_items + 512;
    const bool bal2 = (gridDim.x == 256);
    const int istep = bal2 ? 192 : (int)gridDim.x;
    for (int item = (bal2 && blockIdx.x >= 192) ? n_items : (int)blockIdx.x; item < n_items; item += istep) {
        if (item >= n_pool_items) {
            const int idx0 = (item - n_pool_items) * 4;
            const int r = tid >> 3, seg = (tid & 7) * 8;
            u32x4 w[4];
#pragma unroll
            for (int u = 0; u < 4; ++u) { const int idx = idx0 + u, kind = idx >> 10, bgi = (idx >> 6) & 15, s0 = (idx & 63) * 64;
                w[u] = *(const u32x4*)(c.PROJ + ((size_t)(bgi >> 2) * SEQ + s0 + r) * IN_COLS + (kind ? C_VW : C_VS) + (bgi & 3) * 64 + seg); }
            __syncthreads();
#pragma unroll
            for (int u = 0; u < 4; ++u) *(u32x4*)((bf16_t*)lds + u * 64 * 72 + r * 72 + seg) = w[u];
            __syncthreads();
#pragma unroll
            for (int u = 0; u < 4; ++u) { const int idx = idx0 + u, kind = idx >> 10, bgi = (idx >> 6) & 15, s0 = (idx & 63) * 64;
                const bf16_t* T = (const bf16_t*)lds + u * 64 * 72;
                u32x4 o;
                o.x = (unsigned)T[(seg + 0) * 72 + r] | ((unsigned)T[(seg + 1) * 72 + r] << 16); o.y = (unsigned)T[(seg + 2) * 72 + r] | ((unsigned)T[(seg + 3) * 72 + r] << 16);
                o.z = (unsigned)T[(seg + 4) * 72 + r] | ((unsigned)T[(seg + 5) * 72 + r] << 16); o.w = (unsigned)T[(seg + 6) * 72 + r] | ((unsigned)T[(seg + 7) * 72 + r] << 16);
                *(u32x4*)(c.VT + (((size_t)kind * 16 + bgi) * 64 + r) * SEQ + s0 + seg) = o; }
        } else {
            const int t0 = item * 16, ch = tid, gi = ch >> 7, s0 = t0 & (SEQ - 1);
            float pv[31];
#pragma unroll
            for (int i = 0; i < 31; ++i) pv[i] = (s0 - 15 + i >= 0) ? bf2f(c.PROJ[(size_t)(t0 - 15 + i) * IN_COLS + C_POOL + ch]) : 0.f;
            if (gi == 0) pool_emit<2>(c, pv, t0, s0, ch);
            else if (gi == 1) pool_emit<4>(c, pv, t0, s0, ch);
            else if (gi == 2) pool_emit<8>(c, pv, t0, s0, ch);
            else pool_emit<16>(c, pv, t0, s0, ch);
        }
    }
}

DI void rwkv_finalize_item(const Ctx& c, int item) {
    const int tid = TID(), ch = tid, t0 = item * 8;
    const float* mu = c.in(I_MU) + (size_t)c.l * RWC;
    const float kkw_ = c.in(I_KK)[c.l * 512 + ch], kaw_ = c.in(I_KA)[c.l * 512 + ch], rkw_ = c.in(I_RK)[c.l * 512 + ch];
    const float mur = mu[ch], muk = mu[512 + ch], muv = mu[1024 + ch];
    bf16_t ur[9], uk[9], uv[9], ua[8];
    const bool has_prev = (t0 & (SEQ - 1)) != 0;
#pragma unroll
    for (int k = 0; k < 9; ++k) {
        ur[k] = 0; uk[k] = 0; uv[k] = 0;
        if (k > 0 || has_prev) { const bf16_t* q = c.PROJ + (size_t)(t0 - 1 + k) * IN_COLS; ur[k] = q[C_R + ch]; uk[k] = q[C_K + ch]; uv[k] = q[C_V + ch]; }
    }
#pragma unroll
    for (int k = 0; k < 8; ++k) ua[k] = c.F[(size_t)4 * NT * 512 + (size_t)(t0 + k) * 512 + ch];
#pragma unroll
    for (int k = 0; k < 8; ++k) {
        const int t = t0 + k;
        const float cr = bf2f(ur[k + 1]), ck = bf2f(uk[k + 1]), cv = bf2f(uv[k + 1]);
        const float r = cr + (bf2f(ur[k]) - cr) * mur, kx = ck + (bf2f(uk[k]) - ck) * muk, vx = cv + (bf2f(uv[k]) - cv) * muv;
        const float a = bf2f(ua[k]);
        const float kxn = kx * kkw_, kp = kx * (1.0f + (a - 1.0f) * kaw_);
        const float ss = wave_sum_dpp(kxn * kxn);
        const float inv = __builtin_amdgcn_rsqf(fmaxf(ss, 1e-24f));
        const float br = wave_sum_dpp(kxn * inv * a * r), kr = wave_sum_dpp(kp * r), bon = wave_sum_dpp(r * kp * rkw_);
        if ((tid & 63) == 0) *(f32x4*)(c.BON + ((size_t)t * 8 + (tid >> 6)) * 4) = (f32x4){inv, br, kr, bon};
        const size_t o = (size_t)t * 512 + ch;
        c.F[o] = f2bf(r); c.F[o + (size_t)NT * 512] = f2bf(kx); c.F[o + (size_t)2 * NT * 512] = f2bf(vx);
    }
}

DI void phase_poolgemm(const Ctx& c, unsigned char* lds) {
    for (int item = blockIdx.x; item < NT / 8; item += gridDim.x) rwkv_finalize_item(c, item);
    const int n_pool = (NT / 256) * 4, n_items = n_pool + 32;
    for (int item = blockIdx.x; item < n_items; item += gridDim.x) {
        f32x4 acc[4][4]; acc_zero(acc);
        if (item < n_pool) {
            const int tm = item >> 2, gi = item & 3, m0 = tm * 256;
            const ARows ar = plain_rows(c.POOLED + gi * 128, 512, m0, TID());
            gemm_core<0>(acc, ar, (const bf16_t*)(c.ws + WS_WT_POOL) + (size_t)gi * 128 * 128, 128, 128, lds);
            const float* sc = c.in(I_POOLS) + c.l * 512 + gi * 128;
            ACC_FOREACH(acc, { const f32x4 s = *(const f32x4*)(sc + c_);
                store_bf4(c.POOLED + (size_t)(m0 + r_) * 512 + gi * 128 + c_, (f32x4){v_[0] * s[0], v_[1] * s[1], v_[2] * s[2], v_[3] * s[3]}); });
        } else {
            const int it = item - n_pool, kv = it >> 4, tm = it & 15, m0 = tm * 256;
            const ARows ar = plain_rows(c.CMPH + (size_t)kv * 4096 * 256, 256, m0, TID());
            gemm_core<0>(acc, ar, (const bf16_t*)(c.ws + WS_WT_C2) + (size_t)kv * 128 * 256, 256, 256, lds);
            ACC_FOREACH(acc, { if (c_ < 64) { const int R = m0 + r_;
                if (kv == 0) store_bf4(c.KC + (size_t)R * 64 + c_, v_);
                else { bf16_t* q = c.VCT + ((size_t)(R >> 8) * 64 + c_) * 256 + (R & 255); q[0] = f2bf(v_[0]); q[256] = f2bf(v_[1]); q[512] = f2bf(v_[2]); q[768] = f2bf(v_[3]); } } });
        }
    }
}

constexpr int SCH = 32;
constexpr int SB_AN = 0, SB_WR = SCH * 64 * 4, SB_W = 2 * SCH * 64 * 4, SB_BB = 3 * SCH * 64 * 4, SB_KP = 4 * SCH * 64 * 4;
constexpr int SB_V = 5 * SCH * 64 * 4;
constexpr int SB_SC = SB_V + SCH * 16 * 4;
constexpr int SB_Y = SB_SC + SCH * 2 * 4;
constexpr int SB_BYTES = SB_Y + SCH * 16 * 4;
static_assert(2 * SB_BYTES <= LDS_BYTES - 64, "scan lds");
typedef float f32x2 __attribute__((ext_vector_type(2)));
DI float row8_sum(float v) { v += DPP_MOV(v, 0xB1); v += DPP_MOV(v, 0x4E); v += DPP_MOV(v, 0x141); return v; }

constexpr int NPW = 6, NJ = (SCH + NPW - 1) / NPW;
struct PrepRegs { bf16_t r[NJ], k[NJ], v[NJ], e[NJ], a[NJ]; float s0[NJ], s1[NJ], s2[NJ]; };
DI void prep_load(PrepRegs& R, const Ctx& c, int b, int h, int ck, int pw, int lane) {
    const size_t PL = (size_t)NT * 512;
    const size_t tb = (size_t)b * SEQ + ck * SCH;
    const size_t o0 = tb * 512 + h * 64 + lane;
#pragma unroll
    for (int j = 0; j < NJ; ++j) {
        const int st = pw + NPW * j;
        if (st < SCH) { const size_t o = o0 + (size_t)st * 512; R.r[j] = c.F[o]; R.k[j] = c.F[o + PL]; R.v[j] = c.F[o + 2 * PL]; R.e[j] = c.F[o + 3 * PL]; R.a[j] = c.F[o + 4 * PL];
            const float* sp = c.BON + ((tb + st) * 8 + h) * 4; R.s0[j] = sp[0]; R.s1[j] = sp[1]; R.s2[j] = sp[2]; }
    }
}
DI void prep_store(const PrepRegs& R, unsigned char* sb, int rq, int pw, int lane, float kkw, float kaw) {
    float* an = (float*)(sb + SB_AN); float* wr = (float*)(sb + SB_WR); float* w_ = (float*)(sb + SB_W); float* bb_ = (float*)(sb + SB_BB); float* kp_ = (float*)(sb + SB_KP);
    float* vv = (float*)(sb + SB_V); float* sc = (float*)(sb + SB_SC);
#pragma unroll
    for (int j = 0; j < NJ; ++j) {
        const int st = pw + NPW * j;
        if (st < SCH) {
            const float r = bf2f(R.r[j]), k = bf2f(R.k[j]), v = bf2f(R.v[j]), e = bf2f(R.e[j]), a = bf2f(R.a[j]);
            const float w = __expf(-e);
            const float kk = k * kkw * R.s0[j];
            const float kp = k * (1.0f + (a - 1.0f) * kaw);
            an[st * 64 + lane] = -kk; wr[st * 64 + lane] = w * r; w_[st * 64 + lane] = w; bb_[st * 64 + lane] = kk * a; kp_[st * 64 + lane] = kp;
            if ((lane >> 4) == rq) vv[st * 16 + (lane & 15)] = v;
            if (lane == 0) { sc[st * 2] = R.s1[j]; sc[st * 2 + 1] = R.s2[j]; }
        }
    }
}
DI void scan_item(const Ctx& c, int item, unsigned char* lds) {
    const int tid = TID(), lane = tid & 63, wave = tid >> 6;
    const int b = item >> 5, h = (item >> 2) & 7, rq = item & 3;
    const int chn = h * 64 + lane;
    const float kkw = c.in(I_KK)[c.l * 512 + chn], kaw = c.in(I_KA)[c.l * 512 + chn];
    const int rowl = (tid & 127) >> 3, cg = tid & 7;
    f32x2 st[4];
#pragma unroll
    for (int i = 0; i < 4; ++i) st[i] = (f32x2){0.f, 0.f};
    constexpr int NCK = SEQ / SCH;
    PrepRegs R;
    __syncthreads();
    if (wave >= 2) { prep_load(R, c, b, h, 0, wave - 2, lane); prep_store(R, lds, rq, wave - 2, lane, kkw, kaw); prep_load(R, c, b, h, 1, wave - 2, lane); }
    __syncthreads();
    for (int ck = 0; ck < NCK; ++ck) {
        unsigned char* sb = lds + (ck & 1) * SB_BYTES;
        if (wave < 2) {
            const float* an = (const float*)(sb + SB_AN) + cg * 8; const float* wr = (const float*)(sb + SB_WR) + cg * 8; const float* w_ = (const float*)(sb + SB_W) + cg * 8;
            const float* bb_ = (const float*)(sb + SB_BB) + cg * 8; const float* kp_ = (const float*)(sb + SB_KP) + cg * 8;
            const float* vv = (const float*)(sb + SB_V) + rowl; const float* sc = (const float*)(sb + SB_SC); float* yb = (float*)(sb + SB_Y) + rowl;
            f32x4 a0 = *(const f32x4*)(an), a1 = *(const f32x4*)(an + 4), r0 = *(const f32x4*)(wr), r1 = *(const f32x4*)(wr + 4);
            f32x4 w0 = *(const f32x4*)(w_), w1 = *(const f32x4*)(w_ + 4), b0 = *(const f32x4*)(bb_), b1 = *(const f32x4*)(bb_ + 4);
            f32x4 k0 = *(const f32x4*)(kp_), k1 = *(const f32x4*)(kp_ + 4);
            float v = vv[0]; f32x2 bk = *(const f32x2*)(sc);
#pragma unroll 2
            for (int s = 0; s < SCH; ++s) {
                const int sn = (s + 1 < SCH) ? s + 1 : s;
                const f32x4 na0 = *(const f32x4*)(an + sn * 64), na1 = *(const f32x4*)(an + sn * 64 + 4), nr0 = *(const f32x4*)(wr + sn * 64), nr1 = *(const f32x4*)(wr + sn * 64 + 4);
                const f32x4 nw0 = *(const f32x4*)(w_ + sn * 64), nw1 = *(const f32x4*)(w_ + sn * 64 + 4), nb0 = *(const f32x4*)(bb_ + sn * 64), nb1 = *(const f32x4*)(bb_ + sn * 64 + 4);
                const f32x4 nk0 = *(const f32x4*)(kp_ + sn * 64), nk1 = *(const f32x4*)(kp_ + sn * 64 + 4);
                const float nv = vv[sn * 16]; const f32x2 nbk = *(const f32x2*)(sc + sn * 2);
                f32x2 da = st[0] * (f32x2){a0[0], a0[1]}; f32x2 dr = st[0] * (f32x2){r0[0], r0[1]};
                da += st[1] * (f32x2){a0[2], a0[3]}; dr += st[1] * (f32x2){r0[2], r0[3]};
                da += st[2] * (f32x2){a1[0], a1[1]}; dr += st[2] * (f32x2){r1[0], r1[1]};
                da += st[3] * (f32x2){a1[2], a1[3]}; dr += st[3] * (f32x2){r1[2], r1[3]};
                float sa = da[0] + da[1], sr = dr[0] + dr[1];
                sa += DPP_MOV(sa, 0xB1); sr += DPP_MOV(sr, 0xB1);
                sa += DPP_MOV(sa, 0x4E); sr += DPP_MOV(sr, 0x4E);
                sa += DPP_MOV(sa, 0x141); sr += DPP_MOV(sr, 0x141);
                const f32x2 sa2 = (f32x2){sa, sa}, v2 = (f32x2){v, v};
                st[0] = st[0] * (f32x2){w0[0], w0[1]} + sa2 * (f32x2){b0[0], b0[1]} + v2 * (f32x2){k0[0], k0[1]};
                st[1] = st[1] * (f32x2){w0[2], w0[3]} + sa2 * (f32x2){b0[2], b0[3]} + v2 * (f32x2){k0[2], k0[3]};
                st[2] = st[2] * (f32x2){w1[0], w1[1]} + sa2 * (f32x2){b1[0], b1[1]} + v2 * (f32x2){k1[0], k1[1]};
                st[3] = st[3] * (f32x2){w1[2], w1[3]} + sa2 * (f32x2){b1[2], b1[3]} + v2 * (f32x2){k1[2], k1[3]};
                yb[s * 16] = sr + sa * bk[0] + v * bk[1];
                a0 = na0; a1 = na1; r0 = nr0; r1 = nr1; w0 = nw0; w1 = nw1; b0 = nb0; b1 = nb1; k0 = nk0; k1 = nk1; v = nv; bk = nbk;
            }
        } else {
            const int pt = tid - 128;
            if (ck + 1 < NCK) prep_store(R, lds + ((ck + 1) & 1) * SB_BYTES, rq, wave - 2, lane, kkw, kaw);
            if (ck + 2 < NCK) prep_load(R, c, b, h, ck + 2, wave - 2, lane);
            if (ck > 0) {
                const float* yb = (const float*)(lds + ((ck - 1) & 1) * SB_BYTES + SB_Y);
                for (int idx = pt; idx < SCH * 16; idx += 384) {
                    const int s = idx >> 4, j = idx & 15;
                    c.YRAW[((size_t)b * SEQ + (ck - 1) * SCH + s) * 512 + h * 64 + rq * 16 + j] = f2bf(yb[idx]);
                }
            }
        }
        asm volatile("s_waitcnt lgkmcnt(0)" ::: "memory"); __builtin_amdgcn_s_barrier(); asm volatile("" ::: "memory");
    }
    {
        const float* yb = (const float*)(lds + ((NCK - 1) & 1) * SB_BYTES + SB_Y);
        for (int idx = tid; idx < SCH * 16; idx += NTHREADS) {
            const int s = idx >> 4, j = idx & 15;
            c.YRAW[((size_t)b * SEQ + (NCK - 1) * SCH + s) * 512 + h * 64 + rq * 16 + j] = f2bf(yb[idx]);
        }
    }
    __syncthreads();
}
constexpr int CS64 = 72, CS32 = 40;
constexpr int CK_AH = 0, CK_BH = CK_AH + 32 * CS64 * 2, CK_KH = CK_BH + 32 * CS64 * 2, CK_RH = CK_KH + 32 * CS64 * 2;
constexpr int CK_BHT = CK_RH + 32 * CS64 * 2, CK_KHT = CK_BHT + 64 * CS32 * 2, CK_VT = CK_KHT + 64 * CS32 * 2, CK_GC = CK_VT + 64 * CS32 * 2, CK_MRB = CK_GC + 256;
constexpr int CK_SET = CK_MRB + 32 * CS32 * 2;
constexpr int CK_ZT = 2 * CK_SET, CK_UT = CK_ZT + 64 * CS32 * 2;
constexpr int CK_S0B = CK_UT + 64 * CS32 * 2;
constexpr int CK_LAK = CK_S0B + 2 * 64 * CS64 * 2, CK_MRK = CK_LAK + 32 * CS32 * 2;
constexpr int CK_PA = CK_MRK + 32 * CS32 * 2, CK_PT = CK_PA + 2 * 32 * CS32 * 2, CK_TT = CK_PT + 2 * 32 * CS32 * 2;
constexpr int CK_TOT = CK_TT + 2 * 32 * CS32 * 2;
constexpr int CK_END = CK_TOT + 8 * 64 * 4;
static_assert(CK_END <= LDS_BYTES - 64, "chunk scan lds");
template <int K>
DI f32x4 mm16(const bf16_t* A, int lda, const bf16_t* Bt, int ldb, f32x4 acc, int lane) {
#pragma unroll
    for (int k0 = 0; k0 < K; k0 += 32) {
        const bf16x8 a = *(const bf16x8*)(A + (lane & 15) * lda + k0 + (lane >> 4) * 8), b = *(const bf16x8*)(Bt + (lane & 15) * ldb + k0 + (lane >> 4) * 8);
        acc = __builtin_amdgcn_mfma_f32_16x16x32_bf16(a, b, acc, 0, 0, 0);
    }
    return acc;
}
template <int K>
DI f32x4 mm16t(const bf16_t* A, int lda, const bf16_t* Bt, int ldb, f32x4 acc, int lane) {
#pragma unroll
    for (int k0 = 0; k0 < K; k0 += 32) {
        const bf16x8 a = *(const bf16x8*)(A + (lane & 15) * lda + k0 + (lane >> 4) * 8), b = *(const bf16x8*)(Bt + (lane & 15) * ldb + k0 + (lane >> 4) * 8);
        acc = __builtin_amdgcn_mfma_f32_16x16x32_bf16(b, a, acc, 0, 0, 0);
    }
    return acc;
}
DI void mm16_both(const bf16_t* A, int lda, const bf16_t* Bt, int ldb, f32x4& cn, f32x4& ct, int lane) {
    const bf16x8 a = *(const bf16x8*)(A + (lane & 15) * lda + (lane >> 4) * 8), b = *(const bf16x8*)(Bt + (lane & 15) * ldb + (lane >> 4) * 8);
    cn = __builtin_amdgcn_mfma_f32_16x16x32_bf16(a, b, cn, 0, 0, 0); ct = __builtin_amdgcn_mfma_f32_16x16x32_bf16(b, a, ct, 0, 0, 0);
}
struct ChunkRaw { bf16_t r[4], k[4], v[4], e[4], a[4]; float inv[4]; };
DI void chunk_load(ChunkRaw& R, const Ctx& c, int b, int h, int ck, int wave, int lane) {
    const size_t PL = (size_t)NT * 512;
    const size_t tok0 = (size_t)b * SEQ + ck * 32 + wave * 4;
#pragma unroll
    for (int s = 0; s < 4; ++s) {
        const size_t o = (tok0 + s) * 512 + h * 64 + lane;
        R.r[s] = c.F[o]; R.k[s] = c.F[o + PL]; R.v[s] = c.F[o + 2 * PL]; R.e[s] = c.F[o + 3 * PL]; R.a[s] = c.F[o + 4 * PL];
        R.inv[s] = c.BON[((tok0 + s) * 8 + h) * 4];
    }
}
DI void scan_chunked_item(const Ctx& c, int item, unsigned char* lds) {
    const int tid = TID(), lane = tid & 63, wave = tid >> 6, qd = lane >> 4, l15 = lane & 15;
    const int b = item >> 3, h = item & 7;
    bf16_t* ZT = (bf16_t*)(lds + CK_ZT); bf16_t* UT = (bf16_t*)(lds + CK_UT);
    bf16_t* S0B = (bf16_t*)(lds + CK_S0B); bf16_t* LAK = (bf16_t*)(lds + CK_LAK); bf16_t* MRK = (bf16_t*)(lds + CK_MRK);
    bf16_t* PA = (bf16_t*)(lds + CK_PA); bf16_t* PT = (bf16_t*)(lds + CK_PT); bf16_t* TT = (bf16_t*)(lds + CK_TT);
    float* TOT = (float*)(lds + CK_TOT);
    const f32x4 Z4 = (f32x4){0.f, 0.f, 0.f, 0.f};
    f32x4 Sreg[2] = {Z4, Z4};
    const int svt = wave >> 1, skt0 = 2 * (wave & 1);
    const int mt8 = wave >> 2, nt8 = wave & 3;
    const int mt4 = (wave >> 1) & 1, nt4 = wave & 1;
    __syncthreads();
    for (int i = tid; i < 2 * 64 * CS64 / 2; i += NTHREADS) ((unsigned*)S0B)[i] = 0u;
    const float kkw = c.in(I_KK)[c.l * 512 + h * 64 + lane], kaw = c.in(I_KA)[c.l * 512 + h * 64 + lane];
    constexpr int NCK = SEQ / 32;
    ChunkRaw RA, RB; chunk_load(RA, c, b, h, 0, wave, lane); chunk_load(RB, c, b, h, 1, wave, lane);
    float r4[4], k4[4], v4[4], e4[4], a4[4], inv4[4], ce[4];
    auto stepA = [&](ChunkRaw& R) __attribute__((always_inline)) {
#pragma unroll
        for (int s = 0; s < 4; ++s) { r4[s] = bf2f(R.r[s]); k4[s] = bf2f(R.k[s]); v4[s] = bf2f(R.v[s]); e4[s] = bf2f(R.e[s]); a4[s] = bf2f(R.a[s]); inv4[s] = R.inv[s]; }
        ce[0] = e4[0]; ce[1] = ce[0] + e4[1]; ce[2] = ce[1] + e4[2]; ce[3] = ce[2] + e4[3];
        TOT[wave * 64 + lane] = ce[3];
    };
    auto stepB = [&](const int q) __attribute__((always_inline)) {
        unsigned char* set = lds + q * CK_SET;
        bf16_t* AH = (bf16_t*)(set + CK_AH); bf16_t* BH = (bf16_t*)(set + CK_BH); bf16_t* KH = (bf16_t*)(set + CK_KH); bf16_t* RH = (bf16_t*)(set + CK_RH);
        bf16_t* BHT = (bf16_t*)(set + CK_BHT); bf16_t* KHT = (bf16_t*)(set + CK_KHT); bf16_t* VT = (bf16_t*)(set + CK_VT); float* GC = (float*)(set + CK_GC);
        float off = 0.f;
#pragma unroll
        for (int w = 0; w < 7; ++w) { const float tw = TOT[w * 64 + lane]; if (w < wave) off += tw; }
        float bh[4], kh[4];
#pragma unroll
        for (int s = 0; s < 4; ++s) {
            const float cs = off + ce[s];
            const float g = __expf(-cs), gi = __expf(cs), gm1 = __expf(e4[s] - cs);
            const float kk = k4[s] * kkw * inv4[s], kp = k4[s] * (1.0f + (a4[s] - 1.0f) * kaw);
            bh[s] = kk * a4[s] * gi; kh[s] = kp * gi;
            const int t = wave * 4 + s;
            AH[t * CS64 + lane] = f2bf(-kk * gm1); BH[t * CS64 + lane] = f2bf(bh[s]); KH[t * CS64 + lane] = f2bf(kh[s]); RH[t * CS64 + lane] = f2bf(r4[s] * g);
            if (wave == 7 && s == 3) GC[lane] = g;
        }
        store_bf4(BHT + lane * CS32 + wave * 4, (f32x4){bh[0], bh[1], bh[2], bh[3]});
        store_bf4(KHT + lane * CS32 + wave * 4, (f32x4){kh[0], kh[1], kh[2], kh[3]});
        store_bf4(VT + lane * CS32 + wave * 4, (f32x4){v4[0], v4[1], v4[2], v4[3]});
    };
    auto stepC = [&](const int q) __attribute__((always_inline)) {
        unsigned char* set = lds + q * CK_SET;
        const bf16_t* AH = (const bf16_t*)(set + CK_AH); const bf16_t* BH = (const bf16_t*)(set + CK_BH); const bf16_t* KH = (const bf16_t*)(set + CK_KH); const bf16_t* RH = (const bf16_t*)(set + CK_RH);
        bf16_t* MRB = (bf16_t*)(set + CK_MRB);
        const int mq = wave >> 1, mt = wave & 1;
        const bf16_t* A = (mq < 2) ? AH : RH; const bf16_t* Bt = (mq & 1) ? KH : BH;
#pragma unroll
        for (int nt = 0; nt < 2; ++nt) {
            f32x4 acc = mm16t<64>(A + mt * 16 * CS64, CS64, Bt + nt * 16 * CS64, CS64, Z4, lane);
            const int m = mt * 16 + l15, n0 = nt * 16 + 4 * qd;
#pragma unroll
            for (int i = 0; i < 4; ++i) { const bool keep = (mq < 2) ? (n0 + i < m) : (n0 + i <= m); if (!keep) acc[i] = 0.f; }
            if (mq == 0) {
                store_bf4(PA + m * CS32 + n0, acc);
                f32x4 t0 = acc;
#pragma unroll
                for (int i = 0; i < 4; ++i) if (n0 + i == m) t0[i] += 1.0f;
                store_bf4(TT + q * 32 * CS32 + m * CS32 + n0, t0);
                f32x4 accn = mm16<64>(A + mt * 16 * CS64, CS64, Bt + nt * 16 * CS64, CS64, Z4, lane);
                const int mm0 = mt * 16 + 4 * qd, nn = nt * 16 + l15;
#pragma unroll
                for (int i = 0; i < 4; ++i) if (!(nn < mm0 + i)) accn[i] = 0.f;
                store_bf4(PT + nn * CS32 + mm0, accn);
            } else store_bf4(((mq == 1) ? LAK : ((mq == 2) ? MRB : MRK)) + m * CS32 + n0, acc);
        }
    };
    stepA(RA); LDS_BARRIER();
    chunk_load(RA, c, b, h, 2, wave, lane);
    stepB(0); LDS_BARRIER();
    stepC(0); LDS_BARRIER();
    auto body = [&](const int ck, const int p, ChunkRaw& Rn) __attribute__((always_inline)) {
        const int q = p ^ 1;
        const bf16_t* S0c = S0B + p * 64 * CS64; bf16_t* S0n = S0B + q * 64 * CS64;
        unsigned char* set = lds + p * CK_SET;
        const bf16_t* AH = (const bf16_t*)(set + CK_AH); const bf16_t* RH = (const bf16_t*)(set + CK_RH);
        const bf16_t* BHT = (const bf16_t*)(set + CK_BHT); const bf16_t* KHT = (const bf16_t*)(set + CK_KHT); const bf16_t* VT = (const bf16_t*)(set + CK_VT);
        const float* GC = (const float*)(set + CK_GC); const bf16_t* MRB = (const bf16_t*)(set + CK_MRB);
        f32x4 y = Z4;
        int pcur = 0, tcur = p;
#pragma unroll
        for (int itn = 0; itn < 5; ++itn) {
            const int m = mt4 * 16 + l15, n0 = nt4 * 16 + 4 * qd;
            if (wave < 4) {
                if (itn < 4) {
                    f32x4 cn = Z4, ct = Z4;
                    mm16_both(PA + pcur * 32 * CS32 + mt4 * 16 * CS32, CS32, PT + pcur * 32 * CS32 + nt4 * 16 * CS32, CS32, cn, ct, lane);
                    store_bf4(PA + (pcur ^ 1) * 32 * CS32 + m * CS32 + n0, ct);
                    store_bf4(PT + (pcur ^ 1) * 32 * CS32 + (nt4 * 16 + l15) * CS32 + mt4 * 16 + 4 * qd, cn);
                }
            } else if (itn > 0) {
                const u32x2 told = *(const u32x2*)(TT + tcur * 32 * CS32 + m * CS32 + n0);
                f32x4 acc = (f32x4){bflo(told.x), bfhi(told.x), bflo(told.y), bfhi(told.y)};
                acc = mm16t<32>(TT + tcur * 32 * CS32 + mt4 * 16 * CS32, CS32, PT + pcur * 32 * CS32 + nt4 * 16 * CS32, CS32, acc, lane);
                store_bf4(TT + (tcur ^ 1) * 32 * CS32 + m * CS32 + n0, acc);
            }
            if (itn == 0) {
                f32x4 z = mm16<64>(AH + mt8 * 16 * CS64, CS64, S0c + nt8 * 16 * CS64, CS64, Z4, lane);
                z = mm16<32>(LAK + mt8 * 16 * CS32, CS32, VT + nt8 * 16 * CS32, CS32, z, lane);
                store_bf4(ZT + (nt8 * 16 + l15) * CS32 + mt8 * 16 + 4 * qd, z);
            } else if (itn == 1) {
                y = mm16t<64>(RH + mt8 * 16 * CS64, CS64, S0c + nt8 * 16 * CS64, CS64, Z4, lane);
                y = mm16t<32>(MRK + mt8 * 16 * CS32, CS32, VT + nt8 * 16 * CS32, CS32, y, lane);
            } else if (itn == 2) {
#pragma unroll
                for (int j = 0; j < 2; ++j) Sreg[j] = mm16t<32>(VT + svt * 16 * CS32, CS32, KHT + (skt0 + j) * 16 * CS32, CS32, Sreg[j], lane);
            } else if (itn == 3) {
                stepA(Rn);
            } else {
                { const int ckn = (ck + 3 < NCK) ? ck + 3 : NCK - 1; chunk_load(Rn, c, b, h, ckn, wave, lane); }
                stepB(q);
            }
            LDS_BARRIER();
            if (itn < 4) pcur ^= 1;
            if (itn > 0) tcur ^= 1;
        }
        const bf16_t* Tm = TT + p * 32 * CS32;
        {
            const f32x4 uacc = mm16<32>(Tm + mt8 * 16 * CS32, CS32, ZT + nt8 * 16 * CS32, CS32, Z4, lane);
            store_bf4(UT + (nt8 * 16 + l15) * CS32 + mt8 * 16 + 4 * qd, uacc);
            stepC(q);
        }
        LDS_BARRIER();
        {
            y = mm16t<32>(MRB + mt8 * 16 * CS32, CS32, UT + nt8 * 16 * CS32, CS32, y, lane);
            store_bf4(c.YRAW + ((size_t)b * SEQ + ck * 32 + mt8 * 16 + l15) * 512 + h * 64 + nt8 * 16 + 4 * qd, y);
#pragma unroll
            for (int j = 0; j < 2; ++j) {
                const int kt = skt0 + j;
                f32x4 s = mm16t<32>(UT + svt * 16 * CS32, CS32, BHT + kt * 16 * CS32, CS32, Sreg[j], lane);
                const f32x4 gc = *(const f32x4*)(GC + kt * 16 + 4 * qd);
                s = s * gc;
                Sreg[j] = s;
                store_bf4(S0n + (svt * 16 + l15) * CS64 + kt * 16 + 4 * qd, s);
            }
        }
        LDS_BARRIER();
    };
#pragma unroll 1
    for (int ck = 0; ck < NCK; ck += 2) { body(ck, 0, RB); body(ck + 1, 1, RA); }
    __syncthreads();
}
DI void phase_rwkv_post(const Ctx& c, unsigned char* lds) {
    const int tid = TID(), lane = tid & 63, wave = tid >> 6;
    const size_t PL = (size_t)NT * 512;
    for (int t = blockIdx.x * 8 + wave; t < NT; t += gridDim.x * 8) {
        bf16_t ry[8], rv[8], rg[8]; float bon[8], gw[8], gb[8];
#pragma unroll
        for (int h = 0; h < 8; ++h) { const size_t o = (size_t)t * 512 + h * 64 + lane; ry[h] = c.YRAW[o]; rv[h] = c.F[o + 2 * PL]; rg[h] = c.F[o + 5 * PL]; bon[h] = c.BON[((size_t)t * 8 + h) * 4 + 3];
            gw[h] = c.in(I_GNW)[c.l * 512 + h * 64 + lane]; gb[h] = c.in(I_GNB)[c.l * 512 + h * 64 + lane]; }
#pragma unroll
        for (int h = 0; h < 8; ++h) {
            const float y = bf2f(ry[h]);
            const float mean = wave_sum_dpp(y) * (1.0f / 64.0f);
            const float d = y - mean;
            const float var = wave_sum_dpp(d * d) * (1.0f / 64.0f);
            const float yn = d * rsqrtf(var + 64e-5f) * gw[h] + gb[h];
            c.F[(size_t)t * 512 + h * 64 + lane + 5 * PL] = f2bf((yn + bon[h] * bf2f(rv[h])) * bf2f(rg[h]));
        }
    }
    for (int it = blockIdx.x * 4; it < 768 + 128 + 128 + 256 + 256; it += gridDim.x * 4) {
        const float* WB = c.in(I_WBR) + (size_t)c.l * 2048 * DM; bf16_t* BR = (bf16_t*)(c.ws + WS_WT_BR);
        if (it < 768) convert_tile4(c.in(I_WMG) + (size_t)c.l * DM * 3 * DM, 3 * DM, 3 * DM, DM, (bf16_t*)(c.ws + WS_WT_MG), it, lds);
        else if (it < 896) convert_tile4(WB, DM, DM, 512, BR, it - 768, lds);
        else if (it < 1024) convert_tile4(WB + (size_t)512 * DM, DM, DM, 512, BR + (size_t)1024 * 512, it - 896, lds);
        else if (it < 1280) convert_tile4(WB + (size_t)1024 * DM, DM, DM, 1024, BR + (size_t)2048 * 512, it - 1024, lds);
        else convert_tile4(c.in(I_WOUT) + (size_t)c.l * DM * DM, DM, DM, DM, (bf16_t*)(c.ws + WS_WT_OUT), it - 1280, lds);
    }
}
constexpr int TS = 72;
constexpr int NSA_BIAS = 0;
constexpr int NSA_SELM = 2112;
constexpr int NSA_SCR = 2624;
constexpr int NSA_K0 = 4672;
constexpr int NSA_V0 = NSA_K0 + 2 * 64 * TS * 2;
constexpr int NSA_A = NSA_V0 + 2 * 64 * TS * 2;
constexpr int NSA_B = NSA_A + 16384;
constexpr int NSA_END = NSA_B + 16384;
static_assert(NSA_END <= LDS_BYTES - 16, "nsa lds");
static_assert(NSA_K0 % 16 == 0, "align");

struct NsaLane { int tq[2]; int h; float cbias; float m[2], l[2]; };

DI void nsa_prefetch(u32x4& rk, u32x4& rv, const bf16_t* kbase, int kstride, const bf16_t* vtbase, int vstride, int pos0, int tid) {
    const int r = tid >> 3, seg = (tid & 7) * 8;
    rk = *(const u32x4*)(kbase + (size_t)(pos0 + r) * kstride + seg);
    rv = *(const u32x4*)(vtbase + (size_t)r * vstride + pos0 + seg);
}
DI void nsa_store(unsigned char* lds, int buf, const u32x4& rk, const u32x4& rv, int tid) {
    const int r = tid >> 3, seg = (tid & 7) * 8;
    *(u32x4*)((bf16_t*)(lds + NSA_K0) + buf * 64 * TS + r * TS + seg) = rk;
    *(u32x4*)((bf16_t*)(lds + NSA_V0) + buf * 64 * TS + r * TS + seg) = rv;
}
template <int QM = 3>
DI void nsa_qk(f32x4 (&s)[2][4], const bf16_t* sK, const bf16x8 (&qf)[2][2], int lane) {
#pragma unroll
    for (int kt = 0; kt < 4; ++kt) {
#pragma unroll
        for (int ks = 0; ks < 2; ++ks) {
            const bf16x8 kf = *(const bf16x8*)(sK + (16 * kt + (lane & 15)) * TS + 32 * ks + (lane >> 4) * 8);
#pragma unroll
            for (int qi = 0; qi < 2; ++qi) if ((QM >> qi) & 1) s[qi][kt] = __builtin_amdgcn_mfma_f32_16x16x32_bf16(kf, qf[qi][ks], (ks == 0) ? (f32x4){0.f, 0.f, 0.f, 0.f} : s[qi][kt], 0, 0, 0);
        }
    }
}
template <int MODE>
DI void nsa_logits(float (&x)[4][4], const f32x4 (&s)[4], int tq, int h, float cbias, bool rowsel, int pos0, int qd, const float* biasT) {
#pragma unroll
    for (int kt = 0; kt < 4; ++kt)
#pragma unroll
        for (int i = 0; i < 4; ++i) {
            const int kk = pos0 + 16 * kt + 4 * qd + i;
            if (MODE == 1) { x[kt][i] = rowsel ? s[kt][i] + cbias : -INFINITY; }
            else {
                const int dist = (MODE == 0) ? (tq - 16 * kk - 31) : (tq - kk);
                bool ok = dist >= 0;
                if (MODE == 2) ok = ok && rowsel;
                if (MODE == 3) ok = ok && (dist < 512);
                const int di = dist < 0 ? 0 : (dist > 128 ? 128 : dist);
                float bias = biasT[di * 4 + h];
                asm volatile("" : "+v"(bias));
                x[kt][i] = ok ? s[kt][i] + bias : -INFINITY;
            }
        }
}
DI float quad16_max(float v) {
    { const auto r = __builtin_amdgcn_permlane16_swap(__float_as_uint(v), __float_as_uint(v), false, false); v = fmaxf(__uint_as_float(r[0]), __uint_as_float(r[1])); }
    { const auto r = __builtin_amdgcn_permlane32_swap(__float_as_uint(v), __float_as_uint(v), false, false); v = fmaxf(__uint_as_float(r[0]), __uint_as_float(r[1])); }
    return v; }
DI float quad16_sum(float v) {
    { const auto r = __builtin_amdgcn_permlane16_swap(__float_as_uint(v), __float_as_uint(v), false, false); v = __uint_as_float(r[0]) + __uint_as_float(r[1]); }
    { const auto r = __builtin_amdgcn_permlane32_swap(__float_as_uint(v), __float_as_uint(v), false, false); v = __uint_as_float(r[0]) + __uint_as_float(r[1]); }
    return v; }
DI void nsa_softmax(const float (&x)[4][4], float& m, float& l, f32x4 (&O)[4], bf16x8 (&pf)[2]) {
    float mx = -INFINITY;
#pragma unroll
    for (int kt = 0; kt < 4; ++kt)
#pragma unroll
        for (int i = 0; i < 4; ++i) mx = fmaxf(mx, x[kt][i]);
    mx = quad16_max(mx);
    const float mn = fmaxf(m, mx);
    const float mu = (mn == -INFINITY) ? 0.f : mn;
    const float mu2 = mu * 1.4426950408889634f;
    const bool changed = mn != m;
    const float sc = changed ? __builtin_amdgcn_exp2f(__builtin_fmaf(m, 1.4426950408889634f, -mu2)) : 1.0f;
    float p[4][4]; float ps = 0.f;
#pragma unroll
    for (int kt = 0; kt < 4; ++kt)
#pragma unroll
        for (int i = 0; i < 4; ++i) { p[kt][i] = __builtin_amdgcn_exp2f(__builtin_fmaf(x[kt][i], 1.4426950408889634f, -mu2)); ps += p[kt][i]; }
    l = l * sc + ps; m = mn;
    if (__ballot(changed) != 0ull) {
#pragma unroll
        for (int dt = 0; dt < 4; ++dt) O[dt] = O[dt] * sc;
    }
#pragma unroll
    for (int ks = 0; ks < 2; ++ks) {
        u32x4 w; w.x = pack2(p[2 * ks][0], p[2 * ks][1]); w.y = pack2(p[2 * ks][2], p[2 * ks][3]); w.z = pack2(p[2 * ks + 1][0], p[2 * ks + 1][1]); w.w = pack2(p[2 * ks + 1][2], p[2 * ks + 1][3]);
        pf[ks] = __builtin_bit_cast(bf16x8, w);
    }
}
DI void nsa_softmax_far(const f32x4 (&s)[4], float cbias, bool rs, float& m, float& l, f32x4 (&O)[4], bf16x8 (&pf)[2]) {
    constexpr float LOG2E = 1.4426950408889634f;
    float mx = fmaxf(fmaxf(s[0][0], s[0][1]), fmaxf(s[0][2], s[0][3]));
#pragma unroll
    for (int kt = 1; kt < 4; ++kt) mx = fmaxf(mx, fmaxf(fmaxf(s[kt][0], s[kt][1]), fmaxf(s[kt][2], s[kt][3])));
    mx = quad16_max(mx) + cbias;
    const float mn = rs ? fmaxf(m, mx) : m;
    const float mu2 = ((mn == -INFINITY) ? 0.f : mn) * LOG2E;
    const bool changed = mn != m;
    const float sc = changed ? __builtin_amdgcn_exp2f(__builtin_fmaf(m, LOG2E, -mu2)) : 1.0f;
    const float c0 = rs ? __builtin_fmaf(cbias, LOG2E, -mu2) : -INFINITY;
    const f32x2 c2 = (f32x2){c0, c0};
    f32x2 p[4][2]; f32x2 ps2 = (f32x2){0.f, 0.f};
#pragma unroll
    for (int kt = 0; kt < 4; ++kt)
#pragma unroll
        for (int hh = 0; hh < 2; ++hh) {
            const f32x2 t = (f32x2){s[kt][2 * hh], s[kt][2 * hh + 1]} * LOG2E + c2;
            p[kt][hh] = (f32x2){__builtin_amdgcn_exp2f(t[0]), __builtin_amdgcn_exp2f(t[1])};
            ps2 += p[kt][hh];
        }
    l = l * sc + (ps2[0] + ps2[1]); m = mn;
    if (__ballot(changed) != 0ull) {
#pragma unroll
        for (int dt = 0; dt < 4; ++dt) O[dt] = O[dt] * sc;
    }
#pragma unroll
    for (int ks = 0; ks < 2; ++ks) {
        u32x4 w; w.x = pack2(p[2 * ks][0][0], p[2 * ks][0][1]); w.y = pack2(p[2 * ks][1][0], p[2 * ks][1][1]); w.z = pack2(p[2 * ks + 1][0][0], p[2 * ks + 1][0][1]); w.w = pack2(p[2 * ks + 1][1][0], p[2 * ks + 1][1][1]);
        pf[ks] = __builtin_bit_cast(bf16x8, w);
    }
}
template <int QM = 3>
DI void nsa_pv(f32x4 (&O)[2][4], const bf16_t* sV, const bf16x8 (&pf)[2][2], int lane) {
    const int qd = lane >> 4;
#pragma unroll
    for (int dt = 0; dt < 4; ++dt)
#pragma unroll
        for (int ks = 0; ks < 2; ++ks) {
            const bf16_t* vp = sV + (16 * dt + (lane & 15)) * TS + 32 * ks + 4 * qd;
            const u32x2 a = *(const u32x2*)vp, b = *(const u32x2*)(vp + 16);
            u32x4 w; w.x = a.x; w.y = a.y; w.z = b.x; w.w = b.y;
            const bf16x8 vf = __builtin_bit_cast(bf16x8, w);
#pragma unroll
            for (int qi = 0; qi < 2; ++qi) if ((QM >> qi) & 1) O[qi][dt] = __builtin_amdgcn_mfma_f32_16x16x32_bf16(vf, pf[qi][ks], O[qi][dt], 0, 0, 0);
        }
}
template <int MODE, int QM = 3>
DI void nsa_tile(f32x4 (&O)[2][4], NsaLane& L, const bf16x8 (&qf)[2][2], const unsigned char* lds, int buf, int pos0, bool sel0, bool sel1, int lane) {
    const bf16_t* sK = (const bf16_t*)(lds + NSA_K0) + buf * 64 * TS;
    const bf16_t* sV = (const bf16_t*)(lds + NSA_V0) + buf * 64 * TS;
    const float* biasT = (const float*)(lds + NSA_BIAS);
    f32x4 s[2][4];
    nsa_qk<QM>(s, sK, qf, lane);
    bf16x8 pf[2][2];
#pragma unroll
    for (int qi = 0; qi < 2; ++qi) if ((QM >> qi) & 1) {
        if (MODE == 1) nsa_softmax_far(s[qi], L.cbias, qi ? sel1 : sel0, L.m[qi], L.l[qi], O[qi], pf[qi]);
        else {
            float x[4][4];
            nsa_logits<MODE>(x, s[qi], L.tq[qi], L.h, L.cbias, qi ? sel1 : sel0, pos0, lane >> 4, biasT);
            nsa_softmax(x, L.m[qi], L.l[qi], O[qi], pf[qi]);
        }
    }
    nsa_pv<QM>(O, sV, pf, lane);
}
template <int MODE>
DI void nsa_tile_sel(f32x4 (&O)[2][4], NsaLane& L, const bf16x8 (&qf)[2][2], const unsigned char* lds, int buf, int pos0, bool sel0, bool sel1, int lane) {
    const bool a0 = __ballot(sel0) != 0ull, a1 = __ballot(sel1) != 0ull;
    if (a0 && a1) nsa_tile<MODE, 3>(O, L, qf, lds, buf, pos0, sel0, sel1, lane);
    else if (a0) nsa_tile<MODE, 1>(O, L, qf, lds, buf, pos0, sel0, sel1, lane);
    else if (a1) nsa_tile<MODE, 2>(O, L, qf, lds, buf, pos0, sel0, sel1, lane);
}
DI void nsa_flush(f32x4 (&Y)[2][4], f32x4 (&O)[2][4], NsaLane& L, const float (&gate)[2]) {
#pragma unroll
    for (int qi = 0; qi < 2; ++qi) {
        const float lt = quad16_sum(L.l[qi]);
        const float f = (lt > 0.f) ? gate[qi] * __builtin_amdgcn_rcpf(lt) : 0.f;
#pragma unroll
        for (int dt = 0; dt < 4; ++dt) { Y[qi][dt] += O[qi][dt] * f; O[qi][dt] = (f32x4){0.f, 0.f, 0.f, 0.f}; }
    }
}
DI void nsa_item(const Ctx& c, int item, unsigned char* lds) {
    const int tid = TID(), lane = tid & 63, wave = tid >> 6, qd = lane >> 4;
    const int b = item >> 8, g = (item >> 6) & 3, qt = item & 63, t0 = qt * 64, cur = qt, bg = b * 4 + g;
    float* biasT = (float*)(lds + NSA_BIAS);
    unsigned long long* selm = (unsigned long long*)(lds + NSA_SELM);
    float* scr = (float*)(lds + NSA_SCR) + wave * 64;
    float* impA = (float*)(lds + NSA_A); float* impB = (float*)(lds + NSA_B);
    __syncthreads();
    for (int i = tid; i < 129 * 4; i += NTHREADS) { const int d = i >> 2, h = i & 3; biasT[i] = c.in(I_RELB)[t5_bucket(d) * 16 + g * 4 + h]; }
    for (int i = tid; i < 2 * 4096; i += NTHREADS) impA[i] = 0.f;
    NsaLane L; L.h = lane & 3;
    bf16x8 qf[2][2]; float gates[2][3];
    const bf16_t* pbat = c.PROJ + (size_t)b * SEQ * IN_COLS;
#pragma unroll
    for (int qi = 0; qi < 2; ++qi) {
        const int tl = 8 * wave + 4 * qi + ((lane & 15) >> 2);
        L.tq[qi] = t0 + tl;
        const bf16_t* prow = pbat + (size_t)L.tq[qi] * IN_COLS;
#pragma unroll
        for (int ks = 0; ks < 2; ++ks) {
            u32x4 w = *(const u32x4*)(prow + C_Q + (g * 4 + L.h) * 64 + 32 * ks + qd * 8);
            w.x = pack2(bflo(w.x) * 0.125f, bfhi(w.x) * 0.125f); w.y = pack2(bflo(w.y) * 0.125f, bfhi(w.y) * 0.125f);
            w.z = pack2(bflo(w.z) * 0.125f, bfhi(w.z) * 0.125f); w.w = pack2(bflo(w.w) * 0.125f, bfhi(w.w) * 0.125f);
            qf[qi][ks] = __builtin_bit_cast(bf16x8, w);
        }
#pragma unroll
        for (int br = 0; br < 3; ++br) gates[qi][br] = sigmoidf_(bf2f(prow[C_GATE + g * 12 + L.h * 3 + br]));
    }
    __syncthreads();
    L.cbias = biasT[128 * 4 + L.h];
    f32x4 O[2][4], Y[2][4];
#pragma unroll
    for (int qi = 0; qi < 2; ++qi)
#pragma unroll
        for (int dt = 0; dt < 4; ++dt) { O[qi][dt] = (f32x4){0.f, 0.f, 0.f, 0.f}; Y[qi][dt] = (f32x4){0.f, 0.f, 0.f, 0.f}; }
    u32x4 rk, rv;
    const int nvis_max = (t0 + 63 >= 31) ? ((t0 + 63 - 31) >> 4) + 1 : 0;
    const int ncb = (nvis_max + 63) >> 6;
    const bf16_t* kcb = c.KC + (size_t)bg * 256 * 64; const bf16_t* vcb = c.VCT + (size_t)bg * 64 * 256;
    L.m[0] = L.m[1] = -INFINITY; L.l[0] = L.l[1] = 0.f;
    if (ncb > 0) nsa_prefetch(rk, rv, kcb, 64, vcb, 256, 0, tid);
    for (int cb = 0; cb < ncb; ++cb) {
        nsa_store(lds, cb & 1, rk, rv, tid);
        __syncthreads();
        if (cb + 1 < ncb) nsa_prefetch(rk, rv, kcb, 64, vcb, 256, (cb + 1) * 64, tid);
        if (16 * (cb * 64 + 63) + 31 + 128 <= t0) nsa_tile<1>(O, L, qf, lds, cb & 1, cb * 64, true, true, lane);
        else nsa_tile<0>(O, L, qf, lds, cb & 1, cb * 64, true, true, lane);
    }
    if (ncb > 0) nsa_prefetch(rk, rv, kcb, 64, vcb, 256, 0, tid);
    float mfin[2], linv[2];
#pragma unroll
    for (int qi = 0; qi < 2; ++qi) { mfin[qi] = L.m[qi]; const float lt = quad16_sum(L.l[qi]); linv[qi] = (lt > 0.f) ? __builtin_amdgcn_rcpf(lt) : 0.f; }
    { const float gg[2] = {gates[0][0], gates[1][0]}; nsa_flush(Y, O, L, gg); }
    __syncthreads();
    for (int cb = 0; cb < ncb; ++cb) {
        nsa_store(lds, cb & 1, rk, rv, tid);
        __syncthreads();
        if (cb + 1 < ncb) nsa_prefetch(rk, rv, kcb, 64, vcb, 256, (cb + 1) * 64, tid);
        const bf16_t* sK = (const bf16_t*)(lds + NSA_K0) + (cb & 1) * 64 * TS;
        f32x4 s[2][4];
        nsa_qk(s, sK, qf, lane);
#pragma unroll
        for (int qi = 0; qi < 2; ++qi) {
            float x[4][4];
            nsa_logits<0>(x, s[qi], L.tq[qi], L.h, L.cbias, true, cb * 64, qd, biasT);
            const float mu2 = ((mfin[qi] == -INFINITY) ? 0.f : mfin[qi]) * 1.4426950408889634f;
#pragma unroll
            for (int kt = 0; kt < 4; ++kt) {
#define E2_(v) __builtin_amdgcn_exp2f(__builtin_fmaf((v), 1.4426950408889634f, -mu2))
                float p3 = E2_(x[kt][3]) * linv[qi];
                float pa = (E2_(x[kt][0]) + E2_(x[kt][1]) + E2_(x[kt][2])) * linv[qi] + p3;
#undef E2_
                pa += DPP_MOV(pa, 0xB1); p3 += DPP_MOV(p3, 0xB1);
                pa += DPP_MOV(pa, 0x4E); p3 += DPP_MOV(p3, 0x4E);
                if (L.h == 0) { const int tl = 8 * wave + 4 * qi + ((lane & 15) >> 2), mi = 16 * cb + 4 * kt + qd; impA[tl * 64 + mi] = pa; impB[tl * 64 + mi] = p3; }
            }
        }
    }
    const bf16_t* ksb = pbat + C_KS + g * 64; const bf16_t* vsb = c.VT + ((size_t)0 * 16 + bg) * 64 * SEQ;
    nsa_prefetch(rk, rv, ksb, IN_COLS, vsb, SEQ, 0, tid);
    __syncthreads();
    for (int tl8 = 0; tl8 < 8; ++tl8) {
        const int tl = 8 * wave + tl8, n = lane;
        const bool cand = (n >= 1) && (n <= cur - 2);
        const float imp = cand ? impA[tl * 64 + n] + impB[tl * 64 + n - 1] : -1.0f;
        LDS_WAVE_SYNC();
        scr[n] = imp;
        LDS_WAVE_SYNC();
        int rank = 0;
#pragma unroll 4
        for (int q4 = 0; q4 < 16; ++q4) {
            const f32x4 o = *(const f32x4*)(scr + q4 * 4);
#pragma unroll
            for (int j = 0; j < 4; ++j) { const int n2 = q4 * 4 + j; rank += (o[j] > imp || (o[j] == imp && n2 < n)) ? 1 : 0; }
        }
        const bool forced = (n <= cur) && (n == 0 || n == cur || n == cur - 1);
        const unsigned long long msk = __ballot((cand && rank < 5) || forced);
        if (lane == 0) selm[tl] = msk;
    }
    __syncthreads();
    unsigned long long uni = selm[lane];
#pragma unroll
    for (int o = 32; o >= 1; o >>= 1) { const unsigned lo_ = __shfl_xor((unsigned)uni, o), hi_ = __shfl_xor((unsigned)(uni >> 32), o); uni |= ((unsigned long long)hi_ << 32) | lo_; }
    uni = ((unsigned long long)__builtin_amdgcn_readfirstlane((unsigned)(uni >> 32)) << 32) | (unsigned)__builtin_amdgcn_readfirstlane((unsigned)uni);
    unsigned long long sm[2];
#pragma unroll
    for (int qi = 0; qi < 2; ++qi) sm[qi] = selm[8 * wave + 4 * qi + ((lane & 15) >> 2)];
    L.m[0] = L.m[1] = -INFINITY; L.l[0] = L.l[1] = 0.f;
    {
        unsigned long long rem = uni; int it = 0;
        int j = (int)__builtin_ctzll(rem); rem &= rem - 1;
        for (;;) {
            nsa_store(lds, it & 1, rk, rv, tid);
            __syncthreads();
            const int jn = rem ? (int)__builtin_ctzll(rem) : -1;
            if (jn >= 0) { rem &= rem - 1; nsa_prefetch(rk, rv, ksb, IN_COLS, vsb, SEQ, jn * 64, tid); }
            const bool s0 = (sm[0] >> j) & 1ull, s1 = (sm[1] >> j) & 1ull;
            if (j <= cur - 3) nsa_tile_sel<1>(O, L, qf, lds, it & 1, j * 64, s0, s1, lane);
            else nsa_tile_sel<2>(O, L, qf, lds, it & 1, j * 64, s0, s1, lane);
            if (jn < 0) break;
            j = jn; ++it;
        }
    }
    const bf16_t* kwb = pbat + C_KW + g * 64; const bf16_t* vwb = c.VT + ((size_t)1 * 16 + bg) * 64 * SEQ;
    const int j0 = (cur - 8 > 0) ? cur - 8 : 0;
    nsa_prefetch(rk, rv, kwb, IN_COLS, vwb, SEQ, j0 * 64, tid);
    { const float gg[2] = {gates[0][1], gates[1][1]}; nsa_flush(Y, O, L, gg); }
    L.m[0] = L.m[1] = -INFINITY; L.l[0] = L.l[1] = 0.f;
    {
        __syncthreads();
        for (int j = j0; j <= cur; ++j) {
            nsa_store(lds, (j - j0) & 1, rk, rv, tid);
            __syncthreads();
            if (j + 1 <= cur) nsa_prefetch(rk, rv, kwb, IN_COLS, vwb, SEQ, (j + 1) * 64, tid);
            if (cur - j >= 3 && cur - j <= 7) nsa_tile<1>(O, L, qf, lds, (j - j0) & 1, j * 64, true, true, lane);
            else nsa_tile<3>(O, L, qf, lds, (j - j0) & 1, j * 64, true, true, lane);
        }
    }
    { const float gg[2] = {gates[0][2], gates[1][2]}; nsa_flush(Y, O, L, gg); }
#pragma unroll
    for (int qi = 0; qi < 2; ++qi) {
        bf16_t* yrow = c.PROJ + ((size_t)b * SEQ + L.tq[qi]) * IN_COLS + C_Q + (g * 4 + L.h) * 64;
#pragma unroll
        for (int dt = 0; dt < 4; ++dt) store_bf4(yrow + 16 * dt + 4 * qd, Y[qi][dt]);
    }
}
DI void phase_mix(const Ctx& c, unsigned char* lds) {
    const int G = gridDim.x, bid = blockIdx.x;
    const int n_nsa = NB * 4 * (SEQ / 64), n_scan = NB * 8;
    for (int item = bid; item < n_scan; item += G) scan_chunked_item(c, item, lds);
    unsigned* ctr = c.ctl + CW_Q + c.l;
    volatile int* sitem = (volatile int*)(lds + LDS_BYTES - 32);
    for (;;) {
        __syncthreads();
        if (TID() == 0) *sitem = (int)atomicAdd(ctr, 1u);
        __syncthreads();
        const int k = *sitem;
        if (k >= n_nsa) break;
        const int qt = 63 - (k >> 4), bgi = k & 15;
        nsa_item(c, (bgi << 6) | qt, lds);
    }
}

DI void phase_merge(const Ctx& c, unsigned char* lds) {
    const int nN = DM / 256;
    const bf16_t* WM = (const bf16_t*)(c.ws + WS_WT_MG);
    const bf16_t* BR = (const bf16_t*)(c.ws + WS_WT_BR);
    const float* BM_ = c.in(I_BMG) + (size_t)c.l * 3 * DM;
    bf16_t* TMP = c.F + (size_t)2 * NT * 512 + (size_t)blockIdx.x * 256 * 256;
    for (int it = 0;; ++it) {
        int tm, tn; if (!xcd_unit(it, nN, tm, tn)) break;
        const int m0 = tm * 256, n0 = tn * 256;
#pragma unroll 1
        for (int i = 0; i < 3; ++i) {
            f32x4 acc[8][4];
#pragma unroll
            for (int a_ = 0; a_ < 8; ++a_)
#pragma unroll
                for (int b_ = 0; b_ < 4; ++b_) acc[a_][b_] = (f32x4){0.f, 0.f, 0.f, 0.f};
            gemm256_dma(acc, c.H + (size_t)m0 * DM, DM, WM + (size_t)(i * DM + n0) * DM, DM, DM, lds);
            tile256_store_bf16(acc, TMP, 256, 256, lds);
#pragma unroll
            for (int a_ = 0; a_ < 8; ++a_)
#pragma unroll
                for (int b_ = 0; b_ < 4; ++b_) acc[a_][b_] = (f32x4){0.f, 0.f, 0.f, 0.f};
            {
                const bf16_t* Ab = (i == 0) ? c.POOLED + (size_t)m0 * 512 : ((i == 1) ? c.F + (size_t)5 * NT * 512 + (size_t)m0 * 512 : c.PROJ + C_Q + (size_t)m0 * IN_COLS);
                const size_t la = (i == 2) ? (size_t)IN_COLS : (size_t)512;
                const int Kb = (i == 2) ? 1024 : 512;
                gemm256_dma(acc, Ab, la, BR + (size_t)i * 1024 * 512 + (size_t)n0 * Kb, (size_t)Kb, Kb, lds);
            }
            const int lane = TID() & 63, wave = TID() >> 6, wm = wave >> 2, wn = wave & 3;
            const float* bias = BM_ + i * DM + n0;
#pragma unroll
            for (int mi = 0; mi < 8; ++mi) {
#pragma unroll
                for (int ni = 0; ni < 4; ++ni) {
                    const int r = R256(mi), cc = C256(ni);
                    bf16_t* q = c.MERGED + (size_t)(m0 + r) * DM + n0 + cc;
                    const u32x2 gv = *(const u32x2*)(TMP + r * 256 + cc);
                    const f32x4 bb = *(const f32x4*)(bias + cc);
                    f32x4 m4 = (f32x4){0.f, 0.f, 0.f, 0.f};
                    if (i > 0) { const u32x2 pv = *(const u32x2*)q; m4 = (f32x4){bflo(pv.x), bfhi(pv.x), bflo(pv.y), bfhi(pv.y)}; }
                    m4[0] += sigmoidf_(bflo(gv.x) + bb[0]) * acc[mi][ni][0]; m4[1] += sigmoidf_(bfhi(gv.x) + bb[1]) * acc[mi][ni][1];
                    m4[2] += sigmoidf_(bflo(gv.y) + bb[2]) * acc[mi][ni][2]; m4[3] += sigmoidf_(bfhi(gv.y) + bb[3]) * acc[mi][ni][3];
                    store_bf4(q, m4);
                }
                asm volatile("" ::: "memory"); __builtin_amdgcn_sched_barrier(0);
            }
        }
    }
}

DI void phase_outp(const Ctx& c, unsigned char* lds) {
    const int nN = DM / 256;
    const bf16_t* W = (const bf16_t*)(c.ws + WS_WT_OUT);
    const float* xin = (c.l == 0) ? c.in(I_X) : c.out;
    for (int it = 0;; ++it) {
        int tm, tn; if (!xcd_unit(it, nN, tm, tn)) break;
        const int m0 = tm * 256, n0 = tn * 256;
        f32x4 acc[8][4];
#pragma unroll
        for (int i = 0; i < 8; ++i)
#pragma unroll
            for (int j = 0; j < 4; ++j) acc[i][j] = (f32x4){0.f, 0.f, 0.f, 0.f};
        gemm256_dma(acc, c.MERGED + (size_t)m0 * DM, DM, W + (size_t)n0 * DM, DM, DM, lds);
        const int lane = TID() & 63, wave = TID() >> 6, wm = wave >> 2, wn = wave & 3;
#pragma unroll
        for (int mi = 0; mi < 8; ++mi)
#pragma unroll
            for (int ni = 0; ni < 4; ++ni) {
                const size_t o = (size_t)(m0 + R256(mi)) * DM + n0 + C256(ni);
                const f32x4 x = *(const f32x4*)(xin + o); *(f32x4*)(c.out + o) = x + acc[mi][ni];
            }
    }
    for (int it = blockIdx.x * 4; it < 3 * 32 * 64; it += gridDim.x * 4) {
        const int mat = it / 2048, e = (it >> 6) & 31, tl = it & 63;
        if (mat == 0) convert_tile4(c.in(I_EG) + ((size_t)c.l * 32 + e) * DM * 256, 256, 256, DM, (bf16_t*)(c.ws + WS_EG) + (size_t)e * 256 * DM, tl, lds);
        else if (mat == 1) convert_tile4(c.in(I_EU) + ((size_t)c.l * 32 + e) * DM * 256, 256, 256, DM, (bf16_t*)(c.ws + WS_EU) + (size_t)e * 256 * DM, tl, lds);
        else convert_tile4(c.in(I_ED) + ((size_t)c.l * 32 + e) * 256 * DM, DM, DM, 256, (bf16_t*)(c.ws + WS_ED) + (size_t)e * DM * 256, tl, lds);
    }
}

DI void phase_norm2(const Ctx& c, unsigned char* lds) {
    const int tid = TID(), lane = tid & 63, wave = tid >> 6;
    const float* gain = c.in(I_NFFN) + c.l * DM;
    const float* wrg = c.in(I_WRG) + (size_t)c.l * DM * 4; const float* brg = c.in(I_BRG) + c.l * 4;
    const float* wre = c.in(I_WRE) + (size_t)c.l * DM * 32; const float* bre = c.in(I_BRE) + c.l * 32;
    unsigned* cnt = c.ctl + CW_CNT + c.l * 32;
    constexpr int N2_B01 = 0, N2_B2 = 131072, N2_RS = 147456, N2_LCNT = N2_RS + 256, N2_LG = 0, N2_PART = 16384;
    float* B01 = (float*)(lds + N2_B01); float* B2 = (float*)(lds + N2_B2); float* RS = (float*)(lds + N2_RS);
    unsigned* lcnt = (unsigned*)(lds + N2_LCNT); unsigned* lbase = lcnt + 32;
    for (int rb = blockIdx.x; rb < NT / 64; rb += gridDim.x) {
        const int r0b = rb * 64;
        __syncthreads();
#pragma unroll 4
        for (int p = tid; p < 8192; p += NTHREADS) {
            const f32x4 w = *(const f32x4*)(wre + (size_t)p * 4);
            const int k = p >> 3, c4 = (p & 7) * 4, kb = k >> 4, kq = (k >> 2) & 3, m = k & 3, jj = c4 >> 4, cl = c4 & 15;
            float* d = B01 + (((kb * 2 + jj) * 64 + kq * 16 + cl) * 4) + m;
            d[0] = w[0]; d[4] = w[1]; d[8] = w[2]; d[12] = w[3];
        }
#pragma unroll
        for (int p = tid; p < 1024; p += NTHREADS) {
            const f32x4 w = *(const f32x4*)(wrg + (size_t)p * 4);
            const int kb = p >> 4, kq = (p >> 2) & 3, m = p & 3;
            float* d = B2 + ((kb * 4 + kq) * 4) * 4 + m;
            d[0] = w[0]; d[4] = w[1]; d[8] = w[2]; d[12] = w[3];
        }
        if (tid < 32) lcnt[tid] = 0u;
#pragma unroll
        for (int hb = 0; hb < 2; ++hb) {
            f32x4 v[4][4];
#pragma unroll
            for (int rr = 0; rr < 4; ++rr)
#pragma unroll
                for (int i = 0; i < 4; ++i) v[rr][i] = *(const f32x4*)(c.out + (size_t)(r0b + wave * 8 + hb * 4 + rr) * DM + i * 256 + lane * 4);
#pragma unroll
            for (int rr = 0; rr < 4; ++rr) {
                float ss = 0.f;
#pragma unroll
                for (int i = 0; i < 4; ++i) ss += v[rr][i][0] * v[rr][i][0] + v[rr][i][1] * v[rr][i][1] + v[rr][i][2] * v[rr][i][2] + v[rr][i][3] * v[rr][i][3];
                ss = wave_sum_dpp(ss);
                const float rs = rsqrtf(ss * (1.0f / DM) + 1e-6f);
                if (lane == 0) RS[wave * 8 + hb * 4 + rr] = rs;
#pragma unroll
                for (int i = 0; i < 4; ++i) {
                    const f32x4 g = *(const f32x4*)(gain + i * 256 + lane * 4);
                    store_bf4(c.H + (size_t)(r0b + wave * 8 + hb * 4 + rr) * DM + i * 256 + lane * 4, (f32x4){v[rr][i][0] * rs * g[0], v[rr][i][1] * rs * g[1], v[rr][i][2] * rs * g[2], v[rr][i][3] * rs * g[3]});
                }
            }
        }
        __syncthreads();
        const int tile = wave & 3, kh = wave >> 2, cl = lane & 15, kq = lane >> 4;
        f32x4 acc0 = (f32x4){0.f, 0.f, 0.f, 0.f}, acc1 = acc0, acc2 = acc0;
        {
            const float my_rs = RS[tile * 16 + cl];
            const float* xr = c.out + (size_t)(r0b + tile * 16 + cl) * DM + 4 * kq + kh * 512;
            const float* gr_ = gain + 4 * kq + kh * 512;
            f32x4 xa[4], ga[4];
#pragma unroll
            for (int u = 0; u < 4; ++u) { xa[u] = *(const f32x4*)(xr + u * 16); ga[u] = *(const f32x4*)(gr_ + u * 16); }
#pragma unroll 1
            for (int kb0 = 0; kb0 < 32; kb0 += 4) {
                f32x4 xn[4], gn[4];
                const int kn = (kb0 + 4 < 32) ? kb0 + 4 : kb0;
#pragma unroll
                for (int u = 0; u < 4; ++u) { xn[u] = *(const f32x4*)(xr + (kn + u) * 16); gn[u] = *(const f32x4*)(gr_ + (kn + u) * 16); }
#pragma unroll
                for (int u = 0; u < 4; ++u) {
                    const int kb = kh * 32 + kb0 + u;
                    const f32x4 b0 = *(const f32x4*)(B01 + ((kb * 2 + 0) * 64 + lane) * 4), b1 = *(const f32x4*)(B01 + ((kb * 2 + 1) * 64 + lane) * 4);
                    f32x4 b2 = (f32x4){0.f, 0.f, 0.f, 0.f};
                    if (cl < 4) b2 = *(const f32x4*)(B2 + ((kb * 4 + kq) * 4 + cl) * 4);
#pragma unroll
                    for (int m = 0; m < 4; ++m) {
                        const float am = xa[u][m] * ga[u][m] * my_rs;
                        acc0 = __builtin_amdgcn_mfma_f32_16x16x4f32(am, b0[m], acc0, 0, 0, 0);
                        acc1 = __builtin_amdgcn_mfma_f32_16x16x4f32(am, b1[m], acc1, 0, 0, 0);
                        acc2 = __builtin_amdgcn_mfma_f32_16x16x4f32(am, b2[m], acc2, 0, 0, 0);
                    }
                }
#pragma unroll
                for (int u = 0; u < 4; ++u) { xa[u] = xn[u]; ga[u] = gn[u]; }
            }
        }
        __syncthreads();
        if (kh == 1) { f32x4* pp = (f32x4*)(lds + N2_PART) + (tile * 3) * 64 + lane; pp[0] = acc0; pp[64] = acc1; pp[128] = acc2; }
        __syncthreads();
        int ex0 = 0, ex1 = 0, lr0 = 0, lr1 = 0; float w0_ = 0.f, w1_ = 0.f;
        if (kh == 0) {
            const f32x4* pp = (const f32x4*)(lds + N2_PART) + (tile * 3) * 64 + lane;
            acc0 += pp[0]; acc1 += pp[64]; acc2 += pp[128];
            float* lg = (float*)(lds + N2_LG) + tile * 16 * 36;
#pragma unroll
            for (int i = 0; i < 4; ++i) { const int row = 4 * kq + i; lg[row * 36 + cl] = acc0[i]; lg[row * 36 + 16 + cl] = acc1[i]; if (cl < 4) lg[row * 36 + 32 + cl] = acc2[i]; }
            LDS_WAVE_SYNC();
            if (lane < 16) {
                const float* L = lg + lane * 36;
                float lgp[4];
#pragma unroll
                for (int o = 0; o < 4; ++o) lgp[o] = L[32 + o] + brg[o];
                int grp = 0; float gm = lgp[0];
#pragma unroll
                for (int o = 1; o < 4; ++o) if (lgp[o] > gm) { gm = lgp[o]; grp = o; }
                float gs = 0.f;
#pragma unroll
                for (int o = 0; o < 4; ++o) gs += __expf(lgp[o] - gm);
                const float ptop = 1.0f / gs;
                int i0 = 0; float v0 = -INFINITY; int i1 = 0; float v1 = -INFINITY;
                for (int o = 0; o < 8; ++o) { const float le = L[grp * 8 + o] + bre[grp * 8 + o]; if (le > v0) { v1 = v0; i1 = i0; v0 = le; i0 = o; } else if (le > v1) { v1 = le; i1 = o; } }
                const float e1 = __expf(v1 - v0), inv = 1.0f / (1.0f + e1);
                ex0 = grp * 8 + i0; ex1 = grp * 8 + i1;
                w0_ = inv * ptop; w1_ = e1 * inv * ptop;
                lr0 = (int)atomicAdd(lcnt + ex0, 1u); lr1 = (int)atomicAdd(lcnt + ex1, 1u);
            }
        }
        __syncthreads();
        if (tid < 32) { const unsigned n = lcnt[tid]; lbase[tid] = n ? atomicAdd(cnt + tid, n) : 0u; }
        __syncthreads();
        if (kh == 0 && lane < 16) {
            const int row = r0b + tile * 16 + lane;
            const int q0 = (int)lbase[ex0] + lr0, q1 = (int)lbase[ex1] + lr1;
            int* rt_ = c.ROUTE + (size_t)row * 8;
            rt_[0] = ex0; rt_[1] = ex1; ((float*)rt_)[2] = w0_; ((float*)rt_)[3] = w1_; rt_[4] = q0; rt_[5] = q1;
            int* e0p = c.ENT + ((size_t)ex0 * NT + q0) * 2; e0p[0] = row; ((float*)e0p)[1] = w0_;
            int* e1p = c.ENT + ((size_t)ex1 * NT + q1) * 2; e1p[0] = row; ((float*)e1p)[1] = w1_;
        }
    }
}
DI void moe_tables(const Ctx& c, int* soff, int* stile, int ncol) {
    const unsigned* cnt = c.ctl + CW_CNT + c.l * 32;
    __syncthreads();
    if (TID() == 0) { int s = 0, tt = 0; for (int e = 0; e < 32; ++e) { soff[e] = s; stile[e] = tt; s += (int)cnt[e]; tt += (((int)cnt[e] + 255) >> 8) * ncol; } soff[32] = s; stile[32] = tt; }
    __syncthreads();
}
DI void phase_moe_up(const Ctx& c, unsigned char* lds) {
    int* soff = (int*)(lds + LDS_BYTES - 1024); int* stile = soff + 64;
    moe_tables(c, soff, stile, 2);
    const int total = __builtin_amdgcn_readfirstlane(stile[32]);
    for (int item = blockIdx.x; item < total; item += gridDim.x) {
        int e = 0;
        for (int q = 1; q < 32; ++q) if (stile[q] <= item) e = q;
        e = __builtin_amdgcn_readfirstlane(e);
        const int loc = __builtin_amdgcn_readfirstlane(item - stile[e]), tm = loc >> 1, chf = loc & 1;
        const int p0 = __builtin_amdgcn_readfirstlane(soff[e] + tm * 256), pend = __builtin_amdgcn_readfirstlane(soff[e + 1]);
        GatherRows gr; gr.ent = c.ENT + ((size_t)e * NT + (p0 - soff[e])) * 2; gr.n = pend - p0;
        f32x4 acc[8][4];
#pragma unroll
        for (int a_ = 0; a_ < 8; ++a_)
#pragma unroll
            for (int b_ = 0; b_ < 4; ++b_) acc[a_][b_] = (f32x4){0.f, 0.f, 0.f, 0.f};
        gemm256_dma(acc, c.H, DM, (const bf16_t*)(c.ws + WS_EG) + ((size_t)e * 256 + chf * 128) * DM, DM, DM, lds, &gr, (unsigned)((WS_EU - WS_EG) - (size_t)128 * DM * 2));
        const int lane = TID() & 63, wave = TID() >> 6, wm = wave >> 2, wn = wave & 3;
#pragma unroll
        for (int mi = 0; mi < 8; ++mi)
#pragma unroll
            for (int ni = 0; ni < 2; ++ni) {
                const int r = R256(mi), cc = C256(ni);
                const f32x4 g4 = acc[mi][ni], u4 = acc[mi][ni + 2];
                if (p0 + r < pend) store_bf4(c.HID + (size_t)(p0 + r) * 256 + chf * 128 + cc,
                    (f32x4){g4[0] * sigmoidf_(g4[0]) * u4[0], g4[1] * sigmoidf_(g4[1]) * u4[1], g4[2] * sigmoidf_(g4[2]) * u4[2], g4[3] * sigmoidf_(g4[3]) * u4[3]});
            }
    }
}
DI void phase_moe_down(const Ctx& c, unsigned char* lds) {
    int* soff = (int*)(lds + LDS_BYTES - 1024); int* stile = soff + 64;
    moe_tables(c, soff, stile, 4);
    const int total = __builtin_amdgcn_readfirstlane(stile[32]);
    for (int item = blockIdx.x; item < total; item += gridDim.x) {
        int e = 0;
        for (int q = 1; q < 32; ++q) if (stile[q] <= item) e = q;
        e = __builtin_amdgcn_readfirstlane(e);
        const int loc = __builtin_amdgcn_readfirstlane(item - stile[e]), tm = loc >> 2, tn = loc & 3, n0 = tn * 256;
        const int p0 = __builtin_amdgcn_readfirstlane(soff[e] + tm * 256), pend = __builtin_amdgcn_readfirstlane(soff[e + 1]);
        f32x4 acc[8][4];
#pragma unroll
        for (int a_ = 0; a_ < 8; ++a_)
#pragma unroll
            for (int b_ = 0; b_ < 4; ++b_) acc[a_][b_] = (f32x4){0.f, 0.f, 0.f, 0.f};
        gemm256_dma(acc, c.HID + (size_t)p0 * 256, 256, (const bf16_t*)(c.ws + WS_ED) + ((size_t)e * DM + n0) * 256, 256, 256, lds);
        const int lane = TID() & 63, wave = TID() >> 6, wm = wave >> 2, wn = wave & 3;
        const float* wl = (const float*)c.ENT + ((size_t)e * NT + (p0 - soff[e])) * 2 + 1;
#pragma unroll
        for (int mi = 0; mi < 8; ++mi)
#pragma unroll
            for (int ni = 0; ni < 4; ++ni) {
                const int r = R256(mi), cc = C256(ni);
                if (p0 + r < pend) { const float w = wl[2 * r];
                    store_bf4(c.Y + (size_t)(p0 + r) * DM + n0 + cc, (f32x4){acc[mi][ni][0] * w, acc[mi][ni][1] * w, acc[mi][ni][2] * w, acc[mi][ni][3] * w}); }
            }
    }
}
DI void phase_final(const Ctx& c, unsigned char* lds) {
    const int tid = TID(), lane = tid & 63, wave = tid >> 6;
    const float* gain = c.in(I_NFIN);
    int* soff = (int*)(lds + 65536);
    moe_offsets(c, DEPTH - 1, soff);
    for (int row = blockIdx.x * 8 + wave; row < NT; row += gridDim.x * 8) {
        f32x4 v[4];
#pragma unroll
        for (int i = 0; i < 4; ++i) v[i] = *(const f32x4*)(c.out + (size_t)row * DM + i * 256 + lane * 4);
        add_moe_rows(c, row, lane, v, soff);
        float ss = 0.f;
#pragma unroll
        for (int i = 0; i < 4; ++i) ss += v[i][0] * v[i][0] + v[i][1] * v[i][1] + v[i][2] * v[i][2] + v[i][3] * v[i][3];
        ss = wave_sum_dpp(ss);
        const float rs = rsqrtf(ss * (1.0f / DM) + 1e-6f);
#pragma unroll
        for (int i = 0; i < 4; ++i) {
            const f32x4 g = *(const f32x4*)(gain + i * 256 + lane * 4);
            *(f32x4*)(c.out + (size_t)row * DM + i * 256 + lane * 4) = (f32x4){v[i][0] * rs * g[0], v[i][1] * rs * g[1], v[i][2] * rs * g[2], v[i][3] * rs * g[3]};
        }
    }
}

constexpr int PH_PER_LAYER = 11, N_PHASES = DEPTH * PH_PER_LAYER + 1;
__global__ void __launch_bounds__(NTHREADS, 2) fwd_kernel(Params P) {
    extern __shared__ __attribute__((aligned(16))) unsigned char lds[];
    const int lo = P.ph_lo, hi = P.ph_hi;
    LAS unsigned* xbw = (LAS unsigned*)(lds + LDS_BYTES - 16);
    if (threadIdx.x == 0) { xbw[0] = 0u; xbw[1] = 0u; xbw[2] = 0u; xbw[3] = 0u; }
    __syncthreads();
    Ctx c; c.P = &P; c.ws = P.ws; c.out = P.out; c.l = 0;
    c.ctl = (unsigned*)(P.ws + WS_CTL);
    c.H = (bf16_t*)(P.ws + WS_H); c.PROJ = (bf16_t*)(P.ws + WS_PROJ); c.F = (bf16_t*)(P.ws + WS_F); c.POOLED = (bf16_t*)(P.ws + WS_POOLED);
    c.MERGED = (bf16_t*)(P.ws + WS_F); c.CMPH = (bf16_t*)(P.ws + WS_CMPH); c.CMPO = (float*)(P.ws + WS_CMPO); c.POSB = (float*)(P.ws + WS_POSB);
    c.ROUTE = (int*)(P.ws + WS_ROUTE); c.ENT = (int*)(P.ws + WS_ENT); c.HID = (bf16_t*)(P.ws + WS_HID); c.Y = (bf16_t*)(P.ws + WS_Y);
    c.VT = (bf16_t*)(P.ws + WS_VT); c.KC = (bf16_t*)(P.ws + WS_KC); c.VCT = (bf16_t*)(P.ws + WS_VCT); c.YRAW = (bf16_t*)(P.ws + WS_YRAW); c.BON = (float*)(P.ws + WS_BON);
    XcdBarrier bar; bar.bar = c.ctl + CW_BAR; bar.x = 0; bar.st = (volatile LAS unsigned*)xbw;
    if (hi - lo > 1) bar = xcd_barrier_post(c.ctl + CW_BAR, (volatile LAS unsigned*)xbw);
#define IN(k) (lo <= (k) && (k) < hi)
#define SEAM(k) do { if (IN(k) && IN((k) + 1)) xcd_barrier(bar); } while (0)
#pragma unroll 1
    for (int l = 0; l < DEPTH; ++l) {
        c.l = l; const int pb = l * PH_PER_LAYER;
        if (IN(pb + 0)) phase_norm1(c, lds);
        SEAM(pb + 0);
        if (IN(pb + 1)) phase_gemm1(c, lds);
        SEAM(pb + 1);
        if (IN(pb + 2)) phase_prep(c, lds);
        SEAM(pb + 2);
        if (IN(pb + 3)) phase_poolgemm(c, lds);
        SEAM(pb + 3);
        if (IN(pb + 4)) phase_mix(c, lds);
        SEAM(pb + 4);
        if (IN(pb + 5)) phase_rwkv_post(c, lds);
        SEAM(pb + 5);
        if (IN(pb + 6)) phase_merge(c, lds);
        SEAM(pb + 6);
        if (IN(pb + 7)) phase_outp(c, lds);
        SEAM(pb + 7);
        if (IN(pb + 8)) phase_norm2(c, lds);
        SEAM(pb + 8);
        if (IN(pb + 9)) phase_moe_up(c, lds);
        SEAM(pb + 9);
        if (IN(pb + 10)) phase_moe_down(c, lds);
        SEAM(pb + 10);
    }
    if (IN(N_PHASES - 1)) phase_final(c, lds);
}

#ifndef MK_N_LAUNCHES
#define MK_N_LAUNCHES 1
#endif
extern "C" void kernel_launch(void* const* d_in, const int* in_sizes, int n_in, void* d_out, int out_size, void* d_ws, size_t ws_size, hipStream_t stream) {
    static int grid = 0;
    if (grid == 0) {
        if (n_in != N_IN || out_size != NT * DM || ws_size < WS_END) { fprintf(stderr, "kernel_launch: unexpected shapes n_in %d out %d ws %zu (need %zu)\n", n_in, out_size, ws_size, (size_t)WS_END); grid = -1; return; }
        int dev = 0, cus = 0, per_cu = 0;
        if (hipGetDevice(&dev) != hipSuccess || hipDeviceGetAttribute(&cus, hipDeviceAttributeMultiprocessorCount, dev) != hipSuccess) { grid = -1; return; }
        if (hipFuncSetAttribute((const void*)fwd_kernel, hipFuncAttributeMaxDynamicSharedMemorySize, LDS_BYTES) != hipSuccess) { fprintf(stderr, "kernel_launch: hipFuncSetAttribute failed\n"); grid = -1; return; }
        if (hipOccupancyMaxActiveBlocksPerMultiprocessor(&per_cu, (const void*)fwd_kernel, NTHREADS, LDS_BYTES) != hipSuccess || per_cu < 1) { fprintf(stderr, "kernel_launch: occupancy query says %d\n", per_cu); }
        (void)hipGetLastError();
        grid = cus;
    }
    if (grid < 0) return;
    if (hipMemsetAsync((char*)d_ws + WS_CTL, 0, CTL_BYTES, stream) != hipSuccess) return;
    Params p{};
    for (int i = 0; i < N_IN; ++i) p.in[i] = (const float*)d_in[i];
    p.out = (float*)d_out; p.ws = (unsigned char*)d_ws;
    if (MK_N_LAUNCHES == 1) {
        p.ph_lo = 0; p.ph_hi = N_PHASES;
        hipLaunchKernelGGL(fwd_kernel, dim3(grid), dim3(NTHREADS), LDS_BYTES, stream, p);
    } else {
        for (int k = 0; k < N_PHASES; ++k) { p.ph_lo = k; p.ph_hi = k + 1; hipLaunchKernelGGL(fwd_kernel, dim3(grid), dim3(NTHREADS), LDS_BYTES, stream, p); }
    }
}
```

```cpp
#include <hip/hip_runtime.h>
#include <cstdio>
#include <cstdint>

#define DI __device__ __forceinline__
typedef unsigned short bf16_t;
typedef short bf16x8 __attribute__((ext_vector_type(8)));
typedef float f32x4 __attribute__((ext_vector_type(4)));
typedef unsigned u32x4 __attribute__((ext_vector_type(4)));
typedef unsigned u32x2 __attribute__((ext_vector_type(2)));

constexpr int NB = 4, SEQ = 4096, DM = 1024, NT = NB * SEQ, DEPTH = 2;
constexpr int IN_COLS = 4816;
constexpr int C_POOL = 0, C_RW = 512, C_R = 512, C_K = 1024, C_V = 1536, C_WD = 2048, C_AD = 2080, C_GD = 2112;
constexpr int C_Q = 2208, C_KC = 3232, C_VC = 3488, C_KS = 3744, C_VS = 4000, C_KW = 4256, C_VW = 4512, C_GATE = 4768;
constexpr int RWC = 1696;
constexpr int NCMP = 255;
constexpr int NTHREADS = 512;
constexpr int LDS_BYTES = 155648;

enum { I_X = 0, I_RELB, I_NMIX, I_WIN, I_POOLW, I_POOLS, I_MU, I_W0, I_WUP, I_A0, I_AUP, I_GUP, I_KK, I_KA, I_RK, I_GNW, I_GNB,
       I_CPK, I_CW1K, I_CW2K, I_CPV, I_CW1V, I_CW2V, I_WBR, I_WMG, I_BMG, I_WOUT, I_NFFN, I_WRG, I_BRG, I_WRE, I_BRE, I_EG, I_EU, I_ED, I_NFIN, N_IN };

constexpr size_t WS_CTL = 0;
constexpr size_t CTL_BYTES = 65536;
constexpr size_t WS_H = CTL_BYTES;
constexpr size_t WS_PROJ = WS_H + (size_t)NT * DM * 2;
constexpr size_t WS_F = WS_PROJ + (size_t)NT * IN_COLS * 2;
constexpr size_t PLANE = (size_t)NT * 512 * 2;
constexpr size_t WS_POOLED = WS_F + 6 * PLANE;
constexpr size_t WS_CMPH = WS_POOLED + PLANE;
constexpr size_t WS_CMPO = WS_CMPH + (size_t)2 * 4096 * 256 * 2;
constexpr size_t WS_POSB = WS_CMPO + (size_t)2 * 4096 * 64 * 4;
constexpr size_t WS_ROUTE = WS_POSB + 4096;
constexpr size_t WS_ENT = WS_ROUTE + (size_t)NT * 32;
constexpr size_t WS_VT = WS_ENT + (size_t)32 * NT * 8;
constexpr size_t WS_KC = WS_VT + (size_t)2 * 16 * 64 * SEQ * 2;
constexpr size_t WS_VCT = WS_KC + (size_t)16 * 256 * 64 * 2;
constexpr size_t WS_YRAW = WS_VCT + (size_t)16 * 64 * 256 * 2;
constexpr size_t WS_BON = WS_YRAW + (size_t)NT * 512 * 2;
constexpr size_t WS_SMALLW = WS_BON + (size_t)NT * 8 * 16;
constexpr size_t WS_WT_LORA = WS_SMALLW + 262144;
constexpr size_t WS_END = WS_WT_LORA + (size_t)1536 * 128 * 2;
constexpr size_t WS_WT_IN = WS_F;
constexpr size_t WS_WT_C1 = WS_CMPO;
constexpr size_t WS_WT_C2 = WS_SMALLW;
constexpr size_t WS_WT_POOL = WS_SMALLW + 131072;
constexpr size_t WS_WT_MG = WS_VT;
constexpr size_t WS_WT_BR = WS_VT + (size_t)3072 * 1024 * 2;
constexpr size_t WS_WT_OUT = WS_CMPH;
constexpr size_t WS_EG = WS_F + 2 * PLANE;
constexpr size_t WS_EU = WS_EG + (size_t)32 * 256 * 1024 * 2;
constexpr size_t WS_ED = WS_EU + (size_t)32 * 256 * 1024 * 2;
static_assert(WS_ED + (size_t)32 * 1024 * 256 * 2 <= WS_F + 6 * PLANE, "expert alias");
static_assert(WS_WT_BR + (size_t)2048 * 1024 * 2 <= WS_VT + (size_t)2 * 16 * 64 * SEQ * 2, "merge alias");
static_assert((size_t)4864 * 1024 * 2 <= 6 * PLANE, "w_in alias");
constexpr size_t WS_HID = WS_PROJ;
constexpr size_t WS_Y = WS_PROJ + (size_t)2 * NT * 256 * 2;
static_assert(WS_Y + (size_t)2 * NT * 1024 * 2 <= WS_F, "alias");
constexpr int CW_BAR = 0;
constexpr int CW_CNT = 4096;
constexpr int CW_CUR = 4096 + 64;
constexpr int CW_Q = 4096 + 128;

#define XB_TMO      128
#define XB_XCNT(j)  (256  + 64 * (j))
#define XB_XSUB(j)  (1280 + 64 * (j))
#define XB_XGEN(j)  (2304 + 64 * (j))
#define XB_TOP      3328
#define XB_TOPGEN   3392
#define XCD_BAR_WORDS 3456
#define XB_SPIN_CAP (1u << 18)
#define LAS __attribute__((address_space(3)))

__device__ __forceinline__ unsigned xb_ld(unsigned* p)              { return __hip_atomic_load(p, __ATOMIC_RELAXED, __HIP_MEMORY_SCOPE_AGENT); }
__device__ __forceinline__ unsigned xb_add(unsigned* p, unsigned v) { return __hip_atomic_fetch_add(p, v, __ATOMIC_RELAXED, __HIP_MEMORY_SCOPE_AGENT); }
__device__ __forceinline__ unsigned xb_xcc_id() { return (unsigned)__builtin_amdgcn_s_getreg((3 << 11) | 20) & 0xFu; }
#define XB_SPIN(cond, bar) do { unsigned _sp = 0; while (cond) { __builtin_amdgcn_s_sleep(1); \
    if ((++_sp & 255u) == 0u) { if (xb_ld(&(bar)[XB_TMO])) break; if (_sp > XB_SPIN_CAP) { atomicAdd(&(bar)[XB_TMO], 1u); break; } } } } while (0)

struct XcdBarrier { unsigned* bar; unsigned x; volatile LAS unsigned* st; };

__device__ __forceinline__ XcdBarrier xcd_barrier_post(unsigned* bar, volatile LAS unsigned* st) {
    XcdBarrier b; b.bar = bar; b.x = xb_xcc_id(); b.st = st;
    if (threadIdx.x == 0) (void)xb_add(&bar[XB_XCNT(b.x)], 1u);
    return b;
}
__device__ __forceinline__ void xcd_barrier_complete(unsigned* bar, unsigned x, unsigned& nloc, unsigned& nx) {
    const unsigned G = gridDim.x * gridDim.y * gridDim.z;
    unsigned sum, cnt, mine, sp = 0u;
    for (;;) {
        sum = 0u; cnt = 0u; mine = 0u;
#pragma unroll
        for (unsigned j = 0; j < 16; ++j) { const unsigned c = xb_ld(&bar[XB_XCNT(j)]); sum += c; cnt += (c > 0u) ? 1u : 0u; mine = (j == x) ? c : mine; }
        if (sum == G) break;
        __builtin_amdgcn_s_sleep(1);
        if ((++sp & 255u) == 0u) { if (xb_ld(&bar[XB_TMO])) break; if (sp > XB_SPIN_CAP) { atomicAdd(&bar[XB_TMO], 1u); break; } }
    }
    nloc = mine > 0u ? mine : 1u; nx = cnt > 0u ? cnt : 1u;
}
__device__ __forceinline__ void xcd_barrier(const XcdBarrier& b) {
    asm volatile("s_waitcnt vmcnt(0)" ::: "memory");
    __syncthreads();
    if (threadIdx.x == 0) {
        unsigned* bar = b.bar;
        __builtin_amdgcn_s_waitcnt(0);
        unsigned nloc = b.st[0], nx = b.st[1];
        if (nloc == 0u) { xcd_barrier_complete(bar, b.x, nloc, nx); b.st[0] = nloc; b.st[1] = nx; }
        const unsigned old = xb_add(&bar[XB_XSUB(b.x)], 1u);
        const unsigned gen = old / nloc;
        if (old + 1u == (gen + 1u) * nloc) {
            __builtin_amdgcn_fence(__ATOMIC_RELEASE, "agent");
            asm volatile("s_waitcnt vmcnt(0)" ::: "memory");
            const unsigned og = xb_add(&bar[XB_TOP], 1u);
            const unsigned tg = og / nx;
            if (og + 1u == (tg + 1u) * nx) xb_add(&bar[XB_TOPGEN], 1u);
            else XB_SPIN(xb_ld(&bar[XB_TOPGEN]) == tg, bar);
            __builtin_amdgcn_fence(__ATOMIC_ACQUIRE, "agent");
            xb_add(&bar[XB_XGEN(b.x)], 1u);
            asm volatile("s_waitcnt vmcnt(0)" ::: "memory");
        } else {
            XB_SPIN(xb_ld(&bar[XB_XGEN(b.x)]) == gen, bar);
            __builtin_amdgcn_fence(__ATOMIC_ACQUIRE, "agent");
            asm volatile("s_waitcnt vmcnt(0)" ::: "memory");
        }
    }
    __syncthreads();
}

DI bf16_t f2bf(float x) { unsigned u = __float_as_uint(x); u += 0x7fffu + ((u >> 16) & 1u); return (bf16_t)(u >> 16); }
DI float bf2f(bf16_t b) { return __uint_as_float((unsigned)b << 16); }
typedef __bf16 bf16v2_t __attribute__((ext_vector_type(2)));
typedef float f32v2_t __attribute__((ext_vector_type(2)));
DI unsigned pack2(float lo, float hi) { const f32v2_t v = {lo, hi}; const bf16v2_t b = __builtin_convertvector(v, bf16v2_t); return __builtin_bit_cast(unsigned, b); }
DI float bflo(unsigned w) { return __uint_as_float(w << 16); }
DI float bfhi(unsigned w) { return __uint_as_float(w & 0xffff0000u); }
DI float wave_sum(float v) {
#pragma unroll
    for (int o = 32; o >= 1; o >>= 1) v += __shfl_xor(v, o);
    return v;
}
DI float wave_max(float v) {
#pragma unroll
    for (int o = 32; o >= 1; o >>= 1) v = fmaxf(v, __shfl_xor(v, o));
    return v;
}
DI float sigmoidf_(float x) { return __builtin_amdgcn_rcpf(1.0f + __expf(-x)); }
DI int TID() { int t = threadIdx.x; asm volatile("" : "+v"(t)); return t; }
#define LDS_WAVE_SYNC() asm volatile("s_waitcnt lgkmcnt(0)" ::: "memory")

#define DPP_MOV(v, ctrl) __builtin_bit_cast(float, __builtin_amdgcn_update_dpp(0, __builtin_bit_cast(int, (v)), (ctrl), 0xF, 0xF, true))
DI float wave_sum_dpp(float v) {
    v += DPP_MOV(v, 0xB1); v += DPP_MOV(v, 0x4E); v += DPP_MOV(v, 0x141); v += DPP_MOV(v, 0x140);
    return __builtin_bit_cast(float, __builtin_amdgcn_readlane(__builtin_bit_cast(int, v), 0)) + __builtin_bit_cast(float, __builtin_amdgcn_readlane(__builtin_bit_cast(int, v), 16)) +
        (__builtin_bit_cast(float, __builtin_amdgcn_readlane(__builtin_bit_cast(int, v), 32)) + __builtin_bit_cast(float, __builtin_amdgcn_readlane(__builtin_bit_cast(int, v), 48)));
}
struct Params { const float* in[N_IN]; float* out; unsigned char* ws; int ph_lo, ph_hi; };

DI int t5_bucket(int n) {
    if (n < 16) return n;
    if (n >= 128) return 31;
    int b = 16;
    b += (n >= 19) + (n >= 21) + (n >= 24) + (n >= 27) + (n >= 31) + (n >= 35) + (n >= 40) + (n >= 46) + (n >= 52) + (n >= 59) + (n >= 67) + (n >= 77) + (n >= 87) + (n >= 99) + (n >= 113);
    return b;
}

constexpr int G_A = 0, G_B = 256 * 64 * 2, G_STAGE = (256 + 128) * 64 * 2;
static_assert(2 * G_STAGE <= LDS_BYTES - 64, "gemm lds");
DI int g_off(int r, int c) { return ((r >> 4) * 2 + (c >> 5)) * 1024 + ((((r & 15) * 64) + (c & 31) * 2) ^ ((((r & 15) >> 3) & 1) << 5)); }
struct ARows { const bf16_t* p[4]; const float* mu; int ltype; int first; };
DI float tanhf_fast(float x) { const float e = __expf(2.0f * x); return 1.0f - 2.0f * __builtin_amdgcn_rcpf(e + 1.0f); }
DI u32x4 lora_chunk(const bf16_t* prow, bool first, const float* mu, int ltype, int k) {
    const int lim = (ltype == 2) ? 96 : 32;
    if (k >= lim) return (u32x4){0u, 0u, 0u, 0u};
    const int col = C_WD + ltype * 32 + k;
    const u32x4 cu = *(const u32x4*)(prow + col);
    u32x4 pu = (u32x4){0u, 0u, 0u, 0u};
    if (!first) pu = *(const u32x4*)(prow - IN_COLS + col);
    const f32x4 m0 = *(const f32x4*)(mu + col - C_RW), m1 = *(const f32x4*)(mu + col - C_RW + 4);
    float u[8] = {bflo(cu.x), bfhi(cu.x), bflo(cu.y), bfhi(cu.y), bflo(cu.z), bfhi(cu.z), bflo(cu.w), bfhi(cu.w)};
    const float p[8] = {bflo(pu.x), bfhi(pu.x), bflo(pu.y), bfhi(pu.y), bflo(pu.z), bfhi(pu.z), bflo(pu.w), bfhi(pu.w)};
    const float mm[8] = {m0[0], m0[1], m0[2], m0[3], m1[0], m1[1], m1[2], m1[3]};
#pragma unroll
    for (int j = 0; j < 8; ++j) { const float us = u[j] + (p[j] - u[j]) * mm[j]; u[j] = (ltype == 0) ? tanhf_fast(us) : ((ltype == 1) ? us : __builtin_amdgcn_rcpf(1.0f + __expf(-us))); }
    u32x4 w; w.x = pack2(u[0], u[1]); w.y = pack2(u[2], u[3]); w.z = pack2(u[4], u[5]); w.w = pack2(u[6], u[7]);
    return w;
}
template <int AMODE>
DI void g_load(u32x4 (&ra)[4], u32x4 (&rb)[2], const ARows& ar, const bf16_t* bt, int ldb, int k0, int tid) {
    const int kseg = (tid & 7) * 8;
#pragma unroll
    for (int i = 0; i < 4; ++i) {
        ra[i] = (u32x4){0u, 0u, 0u, 0u};
        if (AMODE == 2) ra[i] = lora_chunk(ar.p[i], (ar.first >> i) & 1, ar.mu, ar.ltype, k0 + kseg);
        else if (ar.p[i] != nullptr) ra[i] = *(const u32x4*)((AMODE == 0) ? (ar.p[i] + k0 + kseg) : (ar.p[i] + (size_t)(k0 >> 6) * IN_COLS + kseg));
    }
#pragma unroll
    for (int i = 0; i < 2; ++i) rb[i] = *(const u32x4*)(bt + (size_t)((tid >> 3) + 64 * i) * ldb + k0 + kseg);
}
DI void g_store(unsigned char* st, const u32x4 (&ra)[4], const u32x4 (&rb)[2], int tid) {
    const int off = g_off(tid >> 3, (tid & 7) * 8);
#pragma unroll
    for (int i = 0; i < 4; ++i) *(u32x4*)(st + G_A + off + i * 8192) = ra[i];
#pragma unroll
    for (int i = 0; i < 2; ++i) *(u32x4*)(st + G_B + off + i * 8192) = rb[i];
}
DI void g_compute(f32x4 (&acc)[4][4], const unsigned char* st, int lane, int wm, int wn) {
    const int lo = ((lane & 15) * 64 + (lane >> 4) * 16) ^ ((((lane & 15) >> 3) & 1) << 5);
    const unsigned char* sA = st + G_A + wm * 8192 + lo;
    const unsigned char* sB = st + G_B + wn * 8192 + lo;
    bf16x8 bcur[4], bnxt[4], a0, a1, a2;
#pragma unroll
    for (int i = 0; i < 4; ++i) bcur[i] = *(const bf16x8*)(sB + i * 2048);
    a0 = *(const bf16x8*)(sA);
    a1 = *(const bf16x8*)(sA + 2048);
#define G_AFRAG(s) (*(const bf16x8*)(sA + ((s) & 3) * 2048 + ((s) >> 2) * 1024))
#define G_GROUP(s, acur, anew) do { \
        if ((s) + 2 < 8) anew = G_AFRAG((s) + 2); \
        if ((s) < 4) bnxt[(s) & 3] = *(const bf16x8*)(sB + ((s) & 3) * 2048 + 1024); \
        __builtin_amdgcn_sched_barrier(0); \
        _Pragma("unroll") for (int ni = 0; ni < 4; ++ni) acc[(s) & 3][ni] = __builtin_amdgcn_mfma_f32_16x16x32_bf16(((s) < 4 ? bcur[ni] : bnxt[ni]), acur, acc[(s) & 3][ni], 0, 0, 0); \
        __builtin_amdgcn_sched_barrier(0); } while (0)
    G_GROUP(0, a0, a2); G_GROUP(1, a1, a0); G_GROUP(2, a2, a1); G_GROUP(3, a0, a2);
    G_GROUP(4, a1, a0); G_GROUP(5, a2, a1); G_GROUP(6, a0, a2); G_GROUP(7, a1, a0);
#undef G_GROUP
#undef G_AFRAG
}
#define LDS_BARRIER() do { asm volatile("s_waitcnt lgkmcnt(0)" ::: "memory"); __builtin_amdgcn_s_barrier(); asm volatile("" ::: "memory"); } while (0)
template <int AMODE>
DI void gemm_core(f32x4 (&acc)[4][4], const ARows& ar, const bf16_t* bt  , int ldb, int K, unsigned char* lds) {
    const int tid = TID(), lane = tid & 63, wave = tid >> 6, wm = wave >> 1, wn = wave & 1;
    const int nk = K >> 6;
    unsigned char* s0 = lds; unsigned char* s1 = lds + G_STAGE;
    u32x4 ra0[4], rb0[2], ra1[4], rb1[2];
    g_load<AMODE>(ra0, rb0, ar, bt, ldb, 0, tid);
    g_load<AMODE>(ra1, rb1, ar, bt, ldb, 64, tid);
    __syncthreads();
    g_store(s0, ra0, rb0, tid);
    g_load<AMODE>(ra0, rb0, ar, bt, ldb, (nk > 2 ? 2 : nk - 1) * 64, tid);
    LDS_BARRIER();
    for (int kt = 0; kt < nk; kt += 2) {
        g_store(s1, ra1, rb1, tid);
        { const int kn = (kt + 3 < nk) ? kt + 3 : nk - 1; g_load<AMODE>(ra1, rb1, ar, bt, ldb, kn * 64, tid); }
        g_compute(acc, s0, lane, wm, wn);
        LDS_BARRIER();
        g_store(s0, ra0, rb0, tid);
        { const int kn = (kt + 4 < nk) ? kt + 4 : nk - 1; g_load<AMODE>(ra0, rb0, ar, bt, ldb, kn * 64, tid); }
        g_compute(acc, s1, lane, wm, wn);
        LDS_BARRIER();
    }
}
static_assert(3 * G_STAGE <= LDS_BYTES - 64, "dma ring");
DI void gemm_core_dma(f32x4 (&acc)[4][4], const bf16_t* A, size_t lda, const bf16_t* bt, size_t ldb, int K, unsigned char* lds) {
    const int tid = TID(), lane = tid & 63, wave = __builtin_amdgcn_readfirstlane(tid >> 6), wm = wave >> 1, wn = wave & 1;
    const int nk = K >> 6;
    const int srow = lane >> 2, skof = ((lane & 3) * 8) ^ ((lane >> 5) << 4);
    const char* gp[6]; int loff[6];
#pragma unroll
    for (int j = 0; j < 6; ++j) {
        const int sid = wave * 6 + j;
        if (sid < 32) { gp[j] = (const char*)(A + (size_t)((sid >> 1) * 16 + srow) * lda + (sid & 1) * 32 + skof); loff[j] = G_A + sid * 1024; }
        else { const int s2 = sid - 32; gp[j] = (const char*)(bt + (size_t)((s2 >> 1) * 16 + srow) * ldb + (s2 & 1) * 32 + skof); loff[j] = G_B + s2 * 1024; }
    }
#define DMA_ISSUE(kt_, st_) do { const int _k = ((kt_) < nk ? (kt_) : nk - 1) * 128; \
        _Pragma("unroll") for (int j = 0; j < 6; ++j) __builtin_amdgcn_global_load_lds((const unsigned*)(gp[j] + _k), (LAS unsigned*)(lds + (st_) * G_STAGE + loff[j]), 16, 0, 0); } while (0)
    asm volatile("s_waitcnt vmcnt(0)" ::: "memory");
    __syncthreads();
    DMA_ISSUE(0, 0); DMA_ISSUE(1, 1);
    int st = 0;
    for (int kt = 0; kt < nk; ++kt) {
        asm volatile("s_waitcnt vmcnt(6)" ::: "memory");
        __builtin_amdgcn_s_barrier();
        asm volatile("" ::: "memory");
        const int sn = (st == 0) ? 2 : st - 1;
        DMA_ISSUE(kt + 2, sn);
        g_compute(acc, lds + st * G_STAGE, lane, wm, wn);
        st = (st == 2) ? 0 : st + 1;
    }
    asm volatile("s_waitcnt vmcnt(0)" ::: "memory");
    __syncthreads();
#undef DMA_ISSUE
}
DI void store_bf4(bf16_t* p, f32x4 v) { u32x2 w; w.x = pack2(v[0], v[1]); w.y = pack2(v[2], v[3]); *(u32x2*)p = w; }
#define R256(mi) ((((mi) >> 2) * 128) + wm * 64 + (((mi) & 3) * 16) + (lane & 15))
#define C256(ni) ((((ni) >> 1) * 128) + wn * 32 + (((ni) & 1) * 16) + ((lane >> 4) * 4))
constexpr int HTB = 128 * 64 * 2;
static_assert(8 * HTB <= LDS_BYTES - 1024, "gemm256 lds");
DI int lds_byte(int r, int c) { const int st = (r >> 4) * 2 + (c >> 5), rr = r & 15, cc = c & 31, ob = rr * 64 + cc * 2; return st * 1024 + (ob ^ (((ob >> 9) & 1) << 5)); }
DI void stage_rc(int b, int& R, int& C) { const int st = b / 1024, sb = b % 1024, swz = sb ^ (((sb >> 9) & 1) << 5); R = (st >> 1) * 16 + swz / 64; C = (st & 1) * 32 + (swz % 64) / 2; }
struct GatherRows { const int* ent; int n; };
DI void gemm256_dma(f32x4 (&acc)[8][4], const bf16_t* A, size_t lda, const bf16_t* bt, size_t ldb, int K, unsigned char* lds_, const GatherRows* gr = nullptr, unsigned bhalf_extra = 0u) {
    LAS unsigned char* lds = (LAS unsigned char*)lds_;
    const int tid = TID(), wid = __builtin_amdgcn_readfirstlane(tid >> 6), lane = tid & 63, wr = wid >> 2, wc = wid & 3, fr = lane & 15, fq = lane >> 4;
    const int nt = K >> 6;
    unsigned voffA[2][2], voffB[2][2];
#pragma unroll
    for (int i = 0; i < 2; ++i) { int R, C; stage_rc(tid * 16 + i * 8192, R, C);
#pragma unroll
        for (int h = 0; h < 2; ++h) { const int row = h * 128 + R;
            size_t ra = (size_t)row;
            if (gr != nullptr) ra = (size_t)((row < gr->n) ? gr->ent[2 * row] : 0);
            voffA[h][i] = (unsigned)((ra * lda + C) * 2); voffB[h][i] = (unsigned)(((size_t)row * ldb + C) * 2) + (h ? bhalf_extra : 0u); } }
    const unsigned ldsw = (unsigned)wid * 1024u;
    const int aoff = lds_byte(wr * 64 + fr, fq * 8), boff = lds_byte(wc * 32 + fr, fq * 8);
#define PG8_SA(b, h) (((b) * 2 + (h)) * HTB)
#define PG8_SB(b, h) ((4 + (b) * 2 + (h)) * HTB)
#define PG8_STAGE(bufoff, gbase, voff) do { _Pragma("unroll") for (int _i = 0; _i < 2; ++_i) \
        __builtin_amdgcn_global_load_lds((const unsigned*)((const char*)(gbase) + (voff)[_i]), (LAS unsigned*)(lds + (bufoff) + ldsw + _i * 8192), 16, 0, 0); } while (0)
#define PG8_LDA(dst, b, h) do { _Pragma("unroll") for (int m = 0; m < 4; ++m) _Pragma("unroll") for (int k = 0; k < 2; ++k) dst[m][k] = *(const LAS bf16x8*)(lds + PG8_SA(b, h) + aoff + m * 2048 + k * 1024); } while (0)
#define PG8_LDB(dst, b, h) do { _Pragma("unroll") for (int n = 0; n < 2; ++n) _Pragma("unroll") for (int k = 0; k < 2; ++k) dst[n][k] = *(const LAS bf16x8*)(lds + PG8_SB(b, h) + boff + n * 2048 + k * 1024); } while (0)
#define PG8_MMA(ai, bj, At, Bt) do { __builtin_amdgcn_s_setprio(1); _Pragma("unroll") for (int m = 0; m < 4; ++m) _Pragma("unroll") for (int n = 0; n < 2; ++n) _Pragma("unroll") for (int k = 0; k < 2; ++k) \
        acc[(ai) * 4 + m][(bj) * 2 + n] = __builtin_amdgcn_mfma_f32_16x16x32_bf16(Bt[n][k], At[m][k], acc[(ai) * 4 + m][(bj) * 2 + n], 0, 0, 0); __builtin_amdgcn_s_setprio(0); } while (0)
#define PG8_WAIT_V(n) asm volatile("s_waitcnt vmcnt(" #n ")" ::: "memory")
#define PG8_WAIT_L(n) asm volatile("s_waitcnt lgkmcnt(" #n ")" ::: "memory")
#define PG8_BAR __builtin_amdgcn_s_barrier()
#define PG8_SCHED __builtin_amdgcn_sched_barrier(0)
    bf16x8 At[4][2], B0[2][2], B1[2][2];
    const char* cA = (const char*)A; const char* cB = (const char*)bt;
    const size_t kstep = 128;
    asm volatile("s_waitcnt vmcnt(0)" ::: "memory");
    __syncthreads();
    PG8_STAGE(PG8_SB(0, 0), cB, voffB[0]); PG8_STAGE(PG8_SA(0, 0), cA, voffA[0]); PG8_STAGE(PG8_SB(0, 1), cB, voffB[1]); PG8_STAGE(PG8_SA(0, 1), cA, voffA[1]);
    if (wr == 1) PG8_BAR;
    PG8_WAIT_V(4); PG8_BAR;
    PG8_STAGE(PG8_SB(1, 0), cB + kstep, voffB[0]); PG8_STAGE(PG8_SA(1, 0), cA + kstep, voffA[0]); PG8_STAGE(PG8_SB(1, 1), cB + kstep, voffB[1]);
    PG8_WAIT_V(6); PG8_BAR;
    for (int t = 0; t < nt; t += 2) {
        const bool last = (t == nt - 2);
        const char* a1 = cA + (size_t)(t + 1) * kstep;
        const char* a2 = last ? cA : cA + (size_t)(t + 2) * kstep; const char* b2 = last ? cB : cB + (size_t)(t + 2) * kstep;
        const char* a3 = a2 + kstep; const char* b3 = b2 + kstep;
        PG8_LDB(B0, 0, 0); PG8_SCHED; PG8_LDA(At, 0, 0); PG8_STAGE(PG8_SA(1, 1), a1, voffA[1]);
        PG8_WAIT_L(8); PG8_BAR; PG8_WAIT_L(0); PG8_MMA(0, 0, At, B0); PG8_BAR; PG8_SCHED;
        PG8_LDB(B1, 0, 1); PG8_STAGE(PG8_SB(0, 0), b2, voffB[0]);
        PG8_BAR; PG8_WAIT_L(0); PG8_MMA(0, 1, At, B1); PG8_BAR;
        PG8_LDA(At, 0, 1); PG8_STAGE(PG8_SA(0, 0), a2, voffA[0]);
        PG8_BAR; PG8_WAIT_L(0); PG8_MMA(1, 0, At, B0); PG8_BAR; PG8_SCHED;
        PG8_STAGE(PG8_SB(0, 1), b2, voffB[1]);
        PG8_WAIT_V(6); PG8_BAR; PG8_MMA(1, 1, At, B1); PG8_BAR;
        PG8_LDB(B0, 1, 0); PG8_SCHED; PG8_LDA(At, 1, 0); PG8_STAGE(PG8_SA(0, 1), a2, voffA[1]);
        PG8_WAIT_L(8); PG8_BAR; PG8_WAIT_L(0); PG8_MMA(0, 0, At, B0); PG8_BAR; PG8_SCHED;
        PG8_LDB(B1, 1, 1); PG8_STAGE(PG8_SB(1, 0), b3, voffB[0]);
        PG8_BAR; PG8_WAIT_L(0); PG8_MMA(0, 1, At, B1); PG8_BAR;
        PG8_LDA(At, 1, 1); PG8_STAGE(PG8_SA(1, 0), a3, voffA[0]);
        PG8_BAR; PG8_WAIT_L(0); PG8_MMA(1, 0, At, B0); PG8_BAR; PG8_SCHED;
        PG8_STAGE(PG8_SB(1, 1), b3, voffB[1]);
        PG8_WAIT_V(6); PG8_BAR; PG8_MMA(1, 1, At, B1); PG8_BAR;
    }
    PG8_WAIT_V(0);
    if (wr == 0) PG8_BAR;
    PG8_BAR;
    asm volatile("" ::: "memory");
#undef PG8_SA
#undef PG8_SB
#undef PG8_STAGE
#undef PG8_LDA
#undef PG8_LDB
#undef PG8_MMA
#undef PG8_WAIT_V
#undef PG8_WAIT_L
#undef PG8_BAR
#undef PG8_SCHED
}
DI void tile256_store_bf16(f32x4 (&acc)[8][4], bf16_t* out, size_t ld, int ncols, unsigned char* lds) {
    bf16_t* T = (bf16_t*)lds;
    const int tid = TID(), lane = tid & 63, wave = tid >> 6, wm = wave >> 2, wn = wave & 3;
    __syncthreads();
#pragma unroll
    for (int mi = 0; mi < 8; ++mi)
#pragma unroll
        for (int ni = 0; ni < 4; ++ni) store_bf4(T + R256(mi) * 264 + C256(ni), acc[mi][ni]);
    __syncthreads();
#pragma unroll
    for (int i = 0; i < 16; ++i) {
        const int ch = tid + i * NTHREADS, r = ch >> 5, cc = (ch & 31) * 8;
        if (cc < ncols) *(u32x4*)(out + (size_t)r * ld + cc) = *(const u32x4*)(T + r * 264 + cc);
    }
}
DI void acc_zero(f32x4 (&acc)[4][4]) {
#pragma unroll
    for (int i = 0; i < 4; ++i)
#pragma unroll
        for (int j = 0; j < 4; ++j) acc[i][j] = (f32x4){0.f, 0.f, 0.f, 0.f};
}
#define ACC_FOREACH(acc, body) do { const int _l = TID() & 63, _w = TID() >> 6; \
    _Pragma("unroll") for (int _mi = 0; _mi < 4; ++_mi) _Pragma("unroll") for (int _ni = 0; _ni < 4; ++_ni) { \
        const int r_ = (_w >> 1) * 64 + _mi * 16 + (_l & 15), c_ = (_w & 1) * 64 + _ni * 16 + (_l >> 4) * 4; f32x4& v_ = acc[_mi][_ni]; body } } while (0)
DI ARows plain_rows(const bf16_t* base, size_t ld, int m0, int tid) { ARows a; a.mu = nullptr; a.ltype = 0; a.first = 0;
#pragma unroll
    for (int i = 0; i < 4; ++i) a.p[i] = base + (size_t)(m0 + (tid >> 3) + 64 * i) * ld;
    return a; }


DI void convert_tile4(const float* src, int ld, int N, int K, bf16_t* dst, int tile0, unsigned char* lds, int Kvalid = 1 << 30) {
    const int tid = TID();
    const int nkt = K >> 6;
    const int r = tid >> 3, seg = (tid & 7) * 8;
    f32x4 a[4], b[4];
#pragma unroll
    for (int u = 0; u < 4; ++u) {
        const int tile = tile0 + u, k0 = (tile % nkt) * 64, n0 = (tile / nkt) * 64;
        a[u] = (f32x4){0.f, 0.f, 0.f, 0.f}; b[u] = a[u];
        if (n0 + seg < N && k0 + r < Kvalid) { const float* q = src + (size_t)(k0 + r) * ld + n0 + seg; a[u] = *(const f32x4*)q; b[u] = *(const f32x4*)(q + 4); }
    }
    __syncthreads();
#pragma unroll
    for (int u = 0; u < 4; ++u) { bf16_t* T = (bf16_t*)lds + u * 64 * 72;
        u32x4 w; w.x = pack2(a[u][0], a[u][1]); w.y = pack2(a[u][2], a[u][3]); w.z = pack2(b[u][0], b[u][1]); w.w = pack2(b[u][2], b[u][3]); *(u32x4*)(T + r * 72 + seg) = w; }
    __syncthreads();
#pragma unroll
    for (int u = 0; u < 4; ++u) { const bf16_t* T = (const bf16_t*)lds + u * 64 * 72;
        const int tile = tile0 + u, k0 = (tile % nkt) * 64, n0 = (tile / nkt) * 64;
        u32x4 o;
        o.x = (unsigned)T[(seg + 0) * 72 + r] | ((unsigned)T[(seg + 1) * 72 + r] << 16); o.y = (unsigned)T[(seg + 2) * 72 + r] | ((unsigned)T[(seg + 3) * 72 + r] << 16);
        o.z = (unsigned)T[(seg + 4) * 72 + r] | ((unsigned)T[(seg + 5) * 72 + r] << 16); o.w = (unsigned)T[(seg + 6) * 72 + r] | ((unsigned)T[(seg + 7) * 72 + r] << 16);
        *(u32x4*)(dst + (size_t)(n0 + r) * K + k0 + seg) = o; }
}
struct Ctx {
    const Params* P; unsigned char* ws; float* out; int l;
    bf16_t* H; bf16_t* PROJ; bf16_t* F; bf16_t* POOLED; bf16_t* MERGED; bf16_t* CMPH; float* CMPO; float* POSB; int* ROUTE; int* ENT; bf16_t* HID; bf16_t* Y; bf16_t* VT; bf16_t* KC; bf16_t* VCT; bf16_t* YRAW; float* BON; unsigned* ctl;
    DI const float* in(int i) const { return P->in[i]; }
};

DI void moe_offsets(const Ctx& c, int layer, int* soff) {
    const unsigned* cnt = c.ctl + CW_CNT + layer * 32;
    __syncthreads();
    if (TID() == 0) { int s = 0; for (int e = 0; e < 32; ++e) { soff[e] = s; s += (int)cnt[e]; } soff[32] = s; }
    __syncthreads();
}
DI void add_moe_rows(const Ctx& c, int row, int lane, f32x4 (&v)[4], const int* soff) {
    const int* rt = c.ROUTE + (size_t)row * 8;
    const int p0 = soff[rt[0]] + rt[4], p1 = soff[rt[1]] + rt[5];
    const bf16_t* y0 = c.Y + (size_t)p0 * DM; const bf16_t* y1 = c.Y + (size_t)p1 * DM;
#pragma unroll
    for (int i = 0; i < 4; ++i) {
        const u32x2 a = *(const u32x2*)(y0 + i * 256 + lane * 4), b = *(const u32x2*)(y1 + i * 256 + lane * 4);
        v[i][0] += bflo(a.x) + bflo(b.x); v[i][1] += bfhi(a.x) + bfhi(b.x); v[i][2] += bflo(a.y) + bflo(b.y); v[i][3] += bfhi(a.y) + bfhi(b.y);
    }
}
DI void phase_norm1(const Ctx& c, unsigned char* lds) {
    const int tid = TID(), lane = tid & 63, wave = tid >> 6;
    const float* gain = c.in(I_NMIX) + c.l * DM;
    const float* src = (c.l == 0) ? c.in(I_X) : c.out;
    int* soff = (int*)(lds + 65536);
    if (c.l > 0) moe_offsets(c, c.l - 1, soff);
    for (int row = blockIdx.x * 8 + wave; row < NT; row += gridDim.x * 8) {
        f32x4 v[4];
#pragma unroll
        for (int i = 0; i < 4; ++i) v[i] = *(const f32x4*)(src + (size_t)row * DM + i * 256 + lane * 4);
        if (c.l > 0) {
            add_moe_rows(c, row, lane, v, soff);
#pragma unroll
            for (int i = 0; i < 4; ++i) *(f32x4*)(c.out + (size_t)row * DM + i * 256 + lane * 4) = v[i];
        }
        float ss = 0.f;
#pragma unroll
        for (int i = 0; i < 4; ++i) ss += v[i][0] * v[i][0] + v[i][1] * v[i][1] + v[i][2] * v[i][2] + v[i][3] * v[i][3];
        ss = wave_sum_dpp(ss);
        const float rs = rsqrtf(ss * (1.0f / DM) + 1e-6f);
#pragma unroll
        for (int i = 0; i < 4; ++i) {
            const f32x4 g = *(const f32x4*)(gain + i * 256 + lane * 4);
            store_bf4(c.H + (size_t)row * DM + i * 256 + lane * 4, (f32x4){v[i][0] * rs * g[0], v[i][1] * rs * g[1], v[i][2] * rs * g[2], v[i][3] * rs * g[3]});
        }
    }
    for (int idx = blockIdx.x * 8 + wave; idx < 512; idx += gridDim.x * 8) {
        const int kv = idx >> 8, n = idx & 255;
        const float* pos = c.in(kv ? I_CPV : I_CPK) + (size_t)c.l * 2048;
        const float* w1 = c.in(kv ? I_CW1V : I_CW1K) + (size_t)c.l * 2048 * 256;
        float s = 0.f;
        for (int k = lane; k < 2048; k += 64) s += pos[k] * w1[(size_t)k * 256 + n];
        s = wave_sum_dpp(s);
        if (lane == 0) c.POSB[kv * 256 + n] = s;
    }
    for (int it = blockIdx.x * 4; it < 1216 + 256 + 16 + 16 + 48; it += gridDim.x * 4) {
        if (it < 1216) convert_tile4(c.in(I_WIN) + (size_t)c.l * DM * IN_COLS, IN_COLS, IN_COLS, DM, (bf16_t*)(c.ws + WS_WT_IN), it, lds);
        else if (it < 1216 + 256) { const int j = it - 1216, kv = j >> 7; convert_tile4(c.in(kv ? I_CW1V : I_CW1K) + (size_t)c.l * 2048 * 256, 256, 256, 2048, (bf16_t*)(c.ws + WS_WT_C1) + (size_t)kv * 256 * 2048, j & 127, lds); }
        else if (it < 1216 + 256 + 16) { const int j = it - 1472, kv = j >> 3; convert_tile4(c.in(kv ? I_CW2V : I_CW2K) + (size_t)c.l * 256 * 64, 64, 64, 256, (bf16_t*)(c.ws + WS_WT_C2) + (size_t)kv * 128 * 256, j & 7, lds); }
        else if (it < 1504) { const int j = it - 1488, gi = j >> 2; convert_tile4(c.in(I_POOLW) + ((size_t)c.l * 4 + gi) * 128 * 128, 128, 128, 128, (bf16_t*)(c.ws + WS_WT_POOL) + (size_t)gi * 128 * 128, 0, lds); }
        else { const int j = it - 1504, ty = j >> 4; bf16_t* dst = (bf16_t*)(c.ws + WS_WT_LORA) + (size_t)ty * 512 * 128;
            if (ty == 0) convert_tile4(c.in(I_WUP) + (size_t)c.l * 32 * 512, 512, 512, 128, dst, j & 15, lds, 32);
            else if (ty == 1) convert_tile4(c.in(I_AUP) + (size_t)c.l * 32 * 512, 512, 512, 128, dst, j & 15, lds, 32);
            else convert_tile4(c.in(I_GUP) + (size_t)c.l * 96 * 512, 512, 512, 128, dst, j & 15, lds, 96); }
    }
}

constexpr int EPS = 136;
DI void tile_store_bf16(f32x4 (&acc)[4][4], bf16_t* out, size_t ld, int nrows, int ncols, unsigned char* lds) {
    bf16_t* T = (bf16_t*)lds;
    const int tid = TID();
    __syncthreads();
    ACC_FOREACH(acc, { store_bf4(T + r_ * EPS + c_, v_); });
    __syncthreads();
#pragma unroll
    for (int i = 0; i < 8; ++i) {
        const int ch = tid + i * NTHREADS, r = ch >> 4, cc = (ch & 15) * 8;
        if (r < nrows && cc < ncols) *(u32x4*)(out + (size_t)r * ld + cc) = *(const u32x4*)(T + r * EPS + cc);
    }
}
DI bool xcd_unit(int it, int nN, int& tm, int& tn) {
    const int G = gridDim.x;
    if ((G & 7) != 0 || G < 8) { const int u = it * G + blockIdx.x; if (u >= 64 * nN) return false; tm = u % 64; tn = u / 64; return true; }
    const int x = blockIdx.x & 7, i = blockIdx.x >> 3, per = G >> 3;
    const int u = it * per + i;
    if (u >= 8 * nN) return false;
    tm = x * 8 + (u & 7); tn = u >> 3; return true;
}
DI void phase_gemm1(const Ctx& c, unsigned char* lds) {
    const int nN = (IN_COLS + 255) / 256;
    const bf16_t* WT = (const bf16_t*)(c.ws + WS_WT_IN);
    for (int it = 0;; ++it) {
        int tm, tn; if (!xcd_unit(it, nN, tm, tn)) break;
        const int m0 = tm * 256, n0 = tn * 256;
        f32x4 acc[8][4];
#pragma unroll
        for (int i = 0; i < 8; ++i)
#pragma unroll
            for (int j = 0; j < 4; ++j) acc[i][j] = (f32x4){0.f, 0.f, 0.f, 0.f};
        gemm256_dma(acc, c.H + (size_t)m0 * DM, DM, WT + (size_t)n0 * DM, DM, DM, lds);
        tile256_store_bf16(acc, c.PROJ + (size_t)m0 * IN_COLS + n0, IN_COLS, (IN_COLS - n0 < 256) ? IN_COLS - n0 : 256, lds);
    }
}

DI float gelu_tanh(float x) { const float u = 0.7978845608028654f * (x + 0.044715f * x * x * x); const float e = __expf(2.0f * u); return x * (1.0f - __builtin_amdgcn_rcpf(e + 1.0f)); }
DI float softplusf_(float x) { return (x > 20.f) ? x : __logf(1.0f + __expf(x)); }
DI float tanhf_(float x) { const float e = __expf(2.0f * x); return 1.0f - 2.0f * __builtin_amdgcn_rcpf(e + 1.0f); }
constexpr int TKP = 8;
template <int WIN>
DI void pool_emit(const Ctx& c, const float (&pv)[31], int t0, int s0, int ch) {
#pragma unroll
    for (int k = 0; k < 16; ++k) {
        float sum = 0.f;
#pragma unroll
        for (int j = 0; j < WIN; ++j) sum += pv[15 + k - j];
        const int s = s0 + k, cnt = (s + 1 < WIN) ? s + 1 : WIN;
        c.POOLED[(size_t)(t0 + k) * 512 + ch] = f2bf(sum / (float)cnt - pv[15 + k]);
    }
}
DI void phase_prep(const Ctx& c, unsigned char* lds) {
    const int n_cmp_items = 2 * 16 * 2;
    for (int item = (int)gridDim.x - 1 - (int)blockIdx.x; item < n_cmp_items; item += gridDim.x) {
        const int tid = TID();
        const int kv = item >> 5, bgi = (item >> 1) & 15, tn = item & 1, m0 = bgi * 256, n0 = tn * 128;
        ARows ar; ar.mu = nullptr; ar.ltype = 0; ar.first = 0;
#pragma unroll
        for (int i = 0; i < 4; ++i) { const int cb = (tid >> 3) + 64 * i;
            ar.p[i] = (cb < NCMP) ? c.PROJ + ((size_t)(bgi >> 2) * SEQ + 16 * cb) * IN_COLS + (kv ? C_VC : C_KC) + (bgi & 3) * 64 : nullptr; }
        f32x4 acc[4][4]; acc_zero(acc);
        gemm_core<1>(acc, ar, (const bf16_t*)(c.ws + WS_WT_C1) + ((size_t)kv * 256 + n0) * 2048, 2048, 2048, lds);
        const float* pb = c.POSB + kv * 256;
        ACC_FOREACH(acc, {
            const f32x4 bb = *(const f32x4*)(pb + n0 + c_);
            store_bf4(c.CMPH + ((size_t)kv * 4096 + m0 + r_) * 256 + n0 + c_, (f32x4){gelu_tanh(v_[0] + bb[0]), gelu_tanh(v_[1] + bb[1]), gelu_tanh(v_[2] + bb[2]), gelu_tanh(v_[3] + bb[3])}); });
    }
    {
        const float* mu = c.in(I_MU) + (size_t)c.l * RWC;
        const bf16_t* WL = (const bf16_t*)(c.ws + WS_WT_LORA);
        const int G_ = gridDim.x, bid_ = blockIdx.x;
        const bool bal = (G_ == 256);
        const bool cmpb = bal && bid_ >= 192;
        for (int ui = 0;; ++ui) {
            int unit;
            if (!bal) { unit = bid_ + ui * G_; if (unit >= 768) break; }
            else if (cmpb) { if (ui >= 2) break; unit = (bid_ - 192) * 2 + ui; }
            else { unit = 128 + bid_ + 192 * ui; if (unit >= 768) break; }
            const int tid = TID();
            const int tm = unit & 63, tn = unit >> 6, m0 = tm * 256, n0 = tn * 128, ltype = tn >> 2, ch0 = n0 & 511;
            ARows ar; ar.mu = mu; ar.ltype = ltype; ar.first = 0;
#pragma unroll
            for (int i = 0; i < 4; ++i) { const int t = m0 + (tid >> 3) + 64 * i; ar.p[i] = c.PROJ + (size_t)t * IN_COLS; if ((t & (SEQ - 1)) == 0) ar.first |= 1 << i; }
            f32x4 acc[4][4]; acc_zero(acc);
            gemm_core<2>(acc, ar, WL + (size_t)n0 * 128, 128, 128, lds);
            if (ltype == 0) { const float* w0 = c.in(I_W0) + c.l * 512 + ch0;
                ACC_FOREACH(acc, { const f32x4 b4 = *(const f32x4*)(w0 + c_);
                    for (int j = 0; j < 4; ++j) v_[j] = __expf(-softplusf_(-(b4[j] + v_[j])) - 0.5f); }); }
            else if (ltype == 1) { const float* a0 = c.in(I_A0) + c.l * 512 + ch0;
                ACC_FOREACH(acc, { const f32x4 b4 = *(const f32x4*)(a0 + c_);
                    for (int j = 0; j < 4; ++j) v_[j] = sigmoidf_(b4[j] + v_[j]); }); }
            tile_store_bf16(acc, c.F + (size_t)(3 + ltype) * NT * 512 + (size_t)m0 * 512 + ch0, 512, 256, 128, lds);
        }
    }
    const int tid = TID();
    const int n_pool_items = NT / 16, n_items = n_pool_items + 512;
    const bool bal2 = (gridDim.x == 256);
    const int istep = bal2 ? 192 : (int)gridDim.x;
    for (int item = (bal2 && blockIdx.x >= 192) ? n_items : (int)blockIdx.x; item < n_items; item += istep) {
        if (item >= n_pool_items) {
            const int idx0 = (item - n_pool_items) * 4;
            const int r = tid >> 3, seg = (tid & 7) * 8;
            u32x4 w[4];
#pragma unroll
            for (int u = 0; u < 4; ++u) { const int idx = idx0 + u, kind = idx >> 10, bgi = (idx >> 6) & 15, s0 = (idx & 63) * 64;
                w[u] = *(const u32x4*)(c.PROJ + ((size_t)(bgi >> 2) * SEQ + s0 + r) * IN_COLS + (kind ? C_VW : C_VS) + (bgi & 3) * 64 + seg); }
            __syncthreads();
#pragma unroll
            for (int u = 0; u < 4; ++u) *(u32x4*)((bf16_t*)lds + u * 64 * 72 + r * 72 + seg) = w[u];
            __syncthreads();
#pragma unroll
            for (int u = 0; u < 4; ++u) { const int idx = idx0 + u, kind = idx >> 10, bgi = (idx >> 6) & 15, s0 = (idx & 63) * 64;
                const bf16_t* T = (const bf16_t*)lds + u * 64 * 72;
                u32x4 o;
                o.x = (unsigned)T[(seg + 0) * 72 + r] | ((unsigned)T[(seg + 1) * 72 + r] << 16); o.y = (unsigned)T[(seg + 2) * 72 + r] | ((unsigned)T[(seg + 3) * 72 + r] << 16);
                o.z = (unsigned)T[(seg + 4) * 72 + r] | ((unsigned)T[(seg + 5) * 72 + r] << 16); o.w = (unsigned)T[(seg + 6) * 72 + r] | ((unsigned)T[(seg + 7) * 72 + r] << 16);
                *(u32x4*)(c.VT + (((size_t)kind * 16 + bgi) * 64 + r) * SEQ + s0 + seg) = o; }
        } else {
            const int t0 = item * 16, ch = tid, gi = ch >> 7, s0 = t0 & (SEQ - 1);
            float pv[31];
#pragma unroll
            for (int i = 0; i < 31; ++i) pv[i] = (s0 - 15 + i >= 0) ? bf2f(c.PROJ[(size_t)(t0 - 15 + i) * IN_COLS + C_POOL + ch]) : 0.f;
            if (gi == 0) pool_emit<2>(c, pv, t0, s0, ch);
            else if (gi == 1) pool_emit<4>(c, pv, t0, s0, ch);
            else if (gi == 2) pool_emit<8>(c, pv, t0, s0, ch);
            else pool_emit<16>(c, pv, t0, s0, ch);
        }
    }
}

DI void rwkv_finalize_item(const Ctx& c, int item) {
    const int tid = TID(), ch = tid, t0 = item * 8;
    const float* mu = c.in(I_MU) + (size_t)c.l * RWC;
    const float kkw_ = c.in(I_KK)[c.l * 512 + ch], kaw_ = c.in(I_KA)[c.l * 512 + ch], rkw_ = c.in(I_RK)[c.l * 512 + ch];
    const float mur = mu[ch], muk = mu[512 + ch], muv = mu[1024 + ch];
    bf16_t ur[9], uk[9], uv[9], ua[8];
    const bool has_prev = (t0 & (SEQ - 1)) != 0;
#pragma unroll
    for (int k = 0; k < 9; ++k) {
        ur[k] = 0; uk[k] = 0; uv[k] = 0;
        if (k > 0 || has_prev) { const bf16_t* q = c.PROJ + (size_t)(t0 - 1 + k) * IN_COLS; ur[k] = q[C_R + ch]; uk[k] = q[C_K + ch]; uv[k] = q[C_V + ch]; }
    }
#pragma unroll
    for (int k = 0; k < 8; ++k) ua[k] = c.F[(size_t)4 * NT * 512 + (size_t)(t0 + k) * 512 + ch];
#pragma unroll
    for (int k = 0; k < 8; ++k) {
        const int t = t0 + k;
        const float cr = bf2f(ur[k + 1]), ck = bf2f(uk[k + 1]), cv = bf2f(uv[k + 1]);
        const float r = cr + (bf2f(ur[k]) - cr) * mur, kx = ck + (bf2f(uk[k]) - ck) * muk, vx = cv + (bf2f(uv[k]) - cv) * muv;
        const float a = bf2f(ua[k]);
        const float kxn = kx * kkw_, kp = kx * (1.0f + (a - 1.0f) * kaw_);
        const float ss = wave_sum_dpp(kxn * kxn);
        const float inv = __builtin_amdgcn_rsqf(fmaxf(ss, 1e-24f));
        const float br = wave_sum_dpp(kxn * inv * a * r), kr = wave_sum_dpp(kp * r), bon = wave_sum_dpp(r * kp * rkw_);
        if ((tid & 63) == 0) *(f32x4*)(c.BON + ((size_t)t * 8 + (tid >> 6)) * 4) = (f32x4){inv, br, kr, bon};
        const size_t o = (size_t)t * 512 + ch;
        c.F[o] = f2bf(r); c.F[o + (size_t)NT * 512] = f2bf(kx); c.F[o + (size_t)2 * NT * 512] = f2bf(vx);
    }
}

DI void phase_poolgemm(const Ctx& c, unsigned char* lds) {
    for (int item = blockIdx.x; item < NT / 8; item += gridDim.x) rwkv_finalize_item(c, item);
    const int n_pool = (NT / 256) * 4, n_items = n_pool + 32;
    for (int item = blockIdx.x; item < n_items; item += gridDim.x) {
        f32x4 acc[4][4]; acc_zero(acc);
        if (item < n_pool) {
            const int tm = item >> 2, gi = item & 3, m0 = tm * 256;
            const ARows ar = plain_rows(c.POOLED + gi * 128, 512, m0, TID());
            gemm_core<0>(acc, ar, (const bf16_t*)(c.ws + WS_WT_POOL) + (size_t)gi * 128 * 128, 128, 128, lds);
            const float* sc = c.in(I_POOLS) + c.l * 512 + gi * 128;
            ACC_FOREACH(acc, { const f32x4 s = *(const f32x4*)(sc + c_);
                store_bf4(c.POOLED + (size_t)(m0 + r_) * 512 + gi * 128 + c_, (f32x4){v_[0] * s[0], v_[1] * s[1], v_[2] * s[2], v_[3] * s[3]}); });
        } else {
            const int it = item - n_pool, kv = it >> 4, tm = it & 15, m0 = tm * 256;
            const ARows ar = plain_rows(c.CMPH + (size_t)kv * 4096 * 256, 256, m0, TID());
            gemm_core<0>(acc, ar, (const bf16_t*)(c.ws + WS_WT_C2) + (size_t)kv * 128 * 256, 256, 256, lds);
            ACC_FOREACH(acc, { if (c_ < 64) { const int R = m0 + r_;
                if (kv == 0) store_bf4(c.KC + (size_t)R * 64 + c_, v_);
                else { bf16_t* q = c.VCT + ((size_t)(R >> 8) * 64 + c_) * 256 + (R & 255); q[0] = f2bf(v_[0]); q[256] = f2bf(v_[1]); q[512] = f2bf(v_[2]); q[768] = f2bf(v_[3]); } } });
        }
    }
}

constexpr int SCH = 32;
constexpr int SB_AN = 0, SB_WR = SCH * 64 * 4, SB_W = 2 * SCH * 64 * 4, SB_BB = 3 * SCH * 64 * 4, SB_KP = 4 * SCH * 64 * 4;
constexpr int SB_V = 5 * SCH * 64 * 4;
constexpr int SB_SC = SB_V + SCH * 16 * 4;
constexpr int SB_Y = SB_SC + SCH * 2 * 4;
constexpr int SB_BYTES = SB_Y + SCH * 16 * 4;
static_assert(2 * SB_BYTES <= LDS_BYTES - 64, "scan lds");
typedef float f32x2 __attribute__((ext_vector_type(2)));
DI float row8_sum(float v) { v += DPP_MOV(v, 0xB1); v += DPP_MOV(v, 0x4E); v += DPP_MOV(v, 0x141); return v; }

constexpr int NPW = 6, NJ = (SCH + NPW - 1) / NPW;
struct PrepRegs { bf16_t r[NJ], k[NJ], v[NJ], e[NJ], a[NJ]; float s0[NJ], s1[NJ], s2[NJ]; };
DI void prep_load(PrepRegs& R, const Ctx& c, int b, int h, int ck, int pw, int lane) {
    const size_t PL = (size_t)NT * 512;
    const size_t tb = (size_t)b * SEQ + ck * SCH;
    const size_t o0 = tb * 512 + h * 64 + lane;
#pragma unroll
    for (int j = 0; j < NJ; ++j) {
        const int st = pw + NPW * j;
        if (st < SCH) { const size_t o = o0 + (size_t)st * 512; R.r[j] = c.F[o]; R.k[j] = c.F[o + PL]; R.v[j] = c.F[o + 2 * PL]; R.e[j] = c.F[o + 3 * PL]; R.a[j] = c.F[o + 4 * PL];
            const float* sp = c.BON + ((tb + st) * 8 + h) * 4; R.s0[j] = sp[0]; R.s1[j] = sp[1]; R.s2[j] = sp[2]; }
    }
}
DI void prep_store(const PrepRegs& R, unsigned char* sb, int rq, int pw, int lane, float kkw, float kaw) {
    float* an = (float*)(sb + SB_AN); float* wr = (float*)(sb + SB_WR); float* w_ = (float*)(sb + SB_W); float* bb_ = (float*)(sb + SB_BB); float* kp_ = (float*)(sb + SB_KP);
    float* vv = (float*)(sb + SB_V); float* sc = (float*)(sb + SB_SC);
#pragma unroll
    for (int j = 0; j < NJ; ++j) {
        const int st = pw + NPW * j;
        if (st < SCH) {
            const float r = bf2f(R.r[j]), k = bf2f(R.k[j]), v = bf2f(R.v[j]), e = bf2f(R.e[j]), a = bf2f(R.a[j]);
            const float w = __expf(-e);
            const float kk = k * kkw * R.s0[j];
            const float kp = k * (1.0f + (a - 1.0f) * kaw);
            an[st * 64 + lane] = -kk; wr[st * 64 + lane] = w * r; w_[st * 64 + lane] = w; bb_[st * 64 + lane] = kk * a; kp_[st * 64 + lane] = kp;
            if ((lane >> 4) == rq) vv[st * 16 + (lane & 15)] = v;
            if (lane == 0) { sc[st * 2] = R.s1[j]; sc[st * 2 + 1] = R.s2[j]; }
        }
    }
}
DI void scan_item(const Ctx& c, int item, unsigned char* lds) {
    const int tid = TID(), lane = tid & 63, wave = tid >> 6;
    const int b = item >> 5, h = (item >> 2) & 7, rq = item & 3;
    const int chn = h * 64 + lane;
    const float kkw = c.in(I_KK)[c.l * 512 + chn], kaw = c.in(I_KA)[c.l * 512 + chn];
    const int rowl = (tid & 127) >> 3, cg = tid & 7;
    f32x2 st[4];
#pragma unroll
    for (int i = 0; i < 4; ++i) st[i] = (f32x2){0.f, 0.f};
    constexpr int NCK = SEQ / SCH;
    PrepRegs R;
    __syncthreads();
    if (wave >= 2) { prep_load(R, c, b, h, 0, wave - 2, lane); prep_store(R, lds, rq, wave - 2, lane, kkw, kaw); prep_load(R, c, b, h, 1, wave - 2, lane); }
    __syncthreads();
    for (int ck = 0; ck < NCK; ++ck) {
        unsigned char* sb = lds + (ck & 1) * SB_BYTES;
        if (wave < 2) {
            const float* an = (const float*)(sb + SB_AN) + cg * 8; const float* wr = (const float*)(sb + SB_WR) + cg * 8; const float* w_ = (const float*)(sb + SB_W) + cg * 8;
            const float* bb_ = (const float*)(sb + SB_BB) + cg * 8; const float* kp_ = (const float*)(sb + SB_KP) + cg * 8;
            const float* vv = (const float*)(sb + SB_V) + rowl; const float* sc = (const float*)(sb + SB_SC); float* yb = (float*)(sb + SB_Y) + rowl;
            f32x4 a0 = *(const f32x4*)(an), a1 = *(const f32x4*)(an + 4), r0 = *(const f32x4*)(wr), r1 = *(const f32x4*)(wr + 4);
            f32x4 w0 = *(const f32x4*)(w_), w1 = *(const f32x4*)(w_ + 4), b0 = *(const f32x4*)(bb_), b1 = *(const f32x4*)(bb_ + 4);
            f32x4 k0 = *(const f32x4*)(kp_), k1 = *(const f32x4*)(kp_ + 4);
            float v = vv[0]; f32x2 bk = *(const f32x2*)(sc);
#pragma unroll 2
            for (int s = 0; s < SCH; ++s) {
                const int sn = (s + 1 < SCH) ? s + 1 : s;
                const f32x4 na0 = *(const f32x4*)(an + sn * 64), na1 = *(const f32x4*)(an + sn * 64 + 4), nr0 = *(const f32x4*)(wr + sn * 64), nr1 = *(const f32x4*)(wr + sn * 64 + 4);
                const f32x4 nw0 = *(const f32x4*)(w_ + sn * 64), nw1 = *(const f32x4*)(w_ + sn * 64 + 4), nb0 = *(const f32x4*)(bb_ + sn * 64), nb1 = *(const f32x4*)(bb_ + sn * 64 + 4);
                const f32x4 nk0 = *(const f32x4*)(kp_ + sn * 64), nk1 = *(const f32x4*)(kp_ + sn * 64 + 4);
                const float nv = vv[sn * 16]; const f32x2 nbk = *(const f32x2*)(sc + sn * 2);
                f32x2 da = st[0] * (f32x2){a0[0], a0[1]}; f32x2 dr = st[0] * (f32x2){r0[0], r0[1]};
                da += st[1] * (f32x2){a0[2], a0[3]}; dr += st[1] * (f32x2){r0[2], r0[3]};
                da += st[2] * (f32x2){a1[0], a1[1]}; dr += st[2] * (f32x2){r1[0], r1[1]};
                da += st[3] * (f32x2){a1[2], a1[3]}; dr += st[3] * (f32x2){r1[2], r1[3]};
                float sa = da[0] + da[1], sr = dr[0] + dr[1];
                sa += DPP_MOV(sa, 0xB1); sr += DPP_MOV(sr, 0xB1);
                sa += DPP_MOV(sa, 0x4E); sr += DPP_MOV(sr, 0x4E);
                sa += DPP_MOV(sa, 0x141); sr += DPP_MOV(sr, 0x141);
                const f32x2 sa2 = (f32x2){sa, sa}, v2 = (f32x2){v, v};
                st[0] = st[0] * (f32x2){w0[0], w0[1]} + sa2 * (f32x2){b0[0], b0[1]} + v2 * (f32x2){k0[0], k0[1]};
                st[1] = st[1] * (f32x2){w0[2], w0[3]} + sa2 * (f32x2){b0[2], b0[3]} + v2 * (f32x2){k0[2], k0[3]};
                st[2] = st[2] * (f32x2){w1[0], w1[1]} + sa2 * (f32x2){b1[0], b1[1]} + v2 * (f32x2){k1[0], k1[1]};
                st[3] = st[3] * (f32x2){w1[2], w1[3]} + sa2 * (f32x2){b1[2], b1[3]} + v2 * (f32x2){k1[2], k1[3]};
                yb[s * 16] = sr + sa * bk[0] + v * bk[1];
                a0 = na0; a1 = na1; r0 = nr0; r1 = nr1; w0 = nw0; w1 = nw1; b0 = nb0; b1 = nb1; k0 = nk0; k1 = nk1; v = nv; bk = nbk;
            }
        } else {
            const int pt = tid - 128;
            if (ck + 1 < NCK) prep_store(R, lds + ((ck + 1) & 1) * SB_BYTES, rq, wave - 2, lane, kkw, kaw);
            if (ck + 2 < NCK) prep_load(R, c, b, h, ck + 2, wave - 2, lane);
            if (ck > 0) {
                const float* yb = (const float*)(lds + ((ck - 1) & 1) * SB_BYTES + SB_Y);
                for (int idx = pt; idx < SCH * 16; idx += 384) {
                    const int s = idx >> 4, j = idx & 15;
                    c.YRAW[((size_t)b * SEQ + (ck - 1) * SCH + s) * 512 + h * 64 + rq * 16 + j] = f2bf(yb[idx]);
                }
            }
        }
        asm volatile("s_waitcnt lgkmcnt(0)" ::: "memory"); __builtin_amdgcn_s_barrier(); asm volatile("" ::: "memory");
    }
    {
        const float* yb = (const float*)(lds + ((NCK - 1) & 1) * SB_BYTES + SB_Y);
        for (int idx = tid; idx < SCH * 16; idx += NTHREADS) {
            const int s = idx >> 4, j = idx & 15;
            c.YRAW[((size_t)b * SEQ + (NCK - 1) * SCH + s) * 512 + h * 64 + rq * 16 + j] = f2bf(yb[idx]);
        }
    }
    __syncthreads();
}
constexpr int CS64 = 72, CS32 = 40;
constexpr int CK_AH = 0, CK_BH = CK_AH + 32 * CS64 * 2, CK_KH = CK_BH + 32 * CS64 * 2, CK_RH = CK_KH + 32 * CS64 * 2;
constexpr int CK_BHT = CK_RH + 32 * CS64 * 2, CK_KHT = CK_BHT + 64 * CS32 * 2, CK_VT = CK_KHT + 64 * CS32 * 2, CK_GC = CK_VT + 64 * CS32 * 2, CK_MRB = CK_GC + 256;
constexpr int CK_SET = CK_MRB + 32 * CS32 * 2;
constexpr int CK_ZT = 2 * CK_SET, CK_UT = CK_ZT + 64 * CS32 * 2;
constexpr int CK_S0B = CK_UT + 64 * CS32 * 2;
constexpr int CK_LAK = CK_S0B + 2 * 64 * CS64 * 2, CK_MRK = CK_LAK + 32 * CS32 * 2;
constexpr int CK_PA = CK_MRK + 32 * CS32 * 2, CK_PT = CK_PA + 2 * 32 * CS32 * 2, CK_TT = CK_PT + 2 * 32 * CS32 * 2;
constexpr int CK_TOT = CK_TT + 2 * 32 * CS32 * 2;
constexpr int CK_END = CK_TOT + 8 * 64 * 4;
static_assert(CK_END <= LDS_BYTES - 64, "chunk scan lds");
template <int K>
DI f32x4 mm16(const bf16_t* A, int lda, const bf16_t* Bt, int ldb, f32x4 acc, int lane) {
#pragma unroll
    for (int k0 = 0; k0 < K; k0 += 32) {
        const bf16x8 a = *(const bf16x8*)(A + (lane & 15) * lda + k0 + (lane >> 4) * 8), b = *(const bf16x8*)(Bt + (lane & 15) * ldb + k0 + (lane >> 4) * 8);
        acc = __builtin_amdgcn_mfma_f32_16x16x32_bf16(a, b, acc, 0, 0, 0);
    }
    return acc;
}
template <int K>
DI f32x4 mm16t(const bf16_t* A, int lda, const bf16_t* Bt, int ldb, f32x4 acc, int lane) {
#pragma unroll
    for (int k0 = 0; k0 < K; k0 += 32) {
        const bf16x8 a = *(const bf16x8*)(A + (lane & 15) * lda + k0 + (lane >> 4) * 8), b = *(const bf16x8*)(Bt + (lane & 15) * ldb + k0 + (lane >> 4) * 8);
        acc = __builtin_amdgcn_mfma_f32_16x16x32_bf16(b, a, acc, 0, 0, 0);
    }
    return acc;
}
DI void mm16_both(const bf16_t* A, int lda, const bf16_t* Bt, int ldb, f32x4& cn, f32x4& ct, int lane) {
    const bf16x8 a = *(const bf16x8*)(A + (lane & 15) * lda + (lane >> 4) * 8), b = *(const bf16x8*)(Bt + (lane & 15) * ldb + (lane >> 4) * 8);
    cn = __builtin_amdgcn_mfma_f32_16x16x32_bf16(a, b, cn, 0, 0, 0); ct = __builtin_amdgcn_mfma_f32_16x16x32_bf16(b, a, ct, 0, 0, 0);
}
struct ChunkRaw { bf16_t r[4], k[4], v[4], e[4], a[4]; float inv[4]; };
DI void chunk_load(ChunkRaw& R, const Ctx& c, int b, int h, int ck, int wave, int lane) {
    const size_t PL = (size_t)NT * 512;
    const size_t tok0 = (size_t)b * SEQ + ck * 32 + wave * 4;
#pragma unroll
    for (int s = 0; s < 4; ++s) {
        const size_t o = (tok0 + s) * 512 + h * 64 + lane;
        R.r[s] = c.F[o]; R.k[s] = c.F[o + PL]; R.v[s] = c.F[o + 2 * PL]; R.e[s] = c.F[o + 3 * PL]; R.a[s] = c.F[o + 4 * PL];
        R.inv[s] = c.BON[((tok0 + s) * 8 + h) * 4];
    }
}
DI void scan_chunked_item(const Ctx& c, int item, unsigned char* lds) {
    const int tid = TID(), lane = tid & 63, wave = tid >> 6, qd = lane >> 4, l15 = lane & 15;
    const int b = item >> 3, h = item & 7;
    bf16_t* ZT = (bf16_t*)(lds + CK_ZT); bf16_t* UT = (bf16_t*)(lds + CK_UT);
    bf16_t* S0B = (bf16_t*)(lds + CK_S0B); bf16_t* LAK = (bf16_t*)(lds + CK_LAK); bf16_t* MRK = (bf16_t*)(lds + CK_MRK);
    bf16_t* PA = (bf16_t*)(lds + CK_PA); bf16_t* PT = (bf16_t*)(lds + CK_PT); bf16_t* TT = (bf16_t*)(lds + CK_TT);
    float* TOT = (float*)(lds + CK_TOT);
    const f32x4 Z4 = (f32x4){0.f, 0.f, 0.f, 0.f};
    f32x4 Sreg[2] = {Z4, Z4};
    const int svt = wave >> 1, skt0 = 2 * (wave & 1);
    const int mt8 = wave >> 2, nt8 = wave & 3;
    const int mt4 = (wave >> 1) & 1, nt4 = wave & 1;
    __syncthreads();
    for (int i = tid; i < 2 * 64 * CS64 / 2; i += NTHREADS) ((unsigned*)S0B)[i] = 0u;
    const float kkw = c.in(I_KK)[c.l * 512 + h * 64 + lane], kaw = c.in(I_KA)[c.l * 512 + h * 64 + lane];
    constexpr int NCK = SEQ / 32;
    ChunkRaw RA, RB; chunk_load(RA, c, b, h, 0, wave, lane); chunk_load(RB, c, b, h, 1, wave, lane);
    float r4[4], k4[4], v4[4], e4[4], a4[4], inv4[4], ce[4];
    auto stepA = [&](ChunkRaw& R) __attribute__((always_inline)) {
#pragma unroll
        for (int s = 0; s < 4; ++s) { r4[s] = bf2f(R.r[s]); k4[s] = bf2f(R.k[s]); v4[s] = bf2f(R.v[s]); e4[s] = bf2f(R.e[s]); a4[s] = bf2f(R.a[s]); inv4[s] = R.inv[s]; }
        ce[0] = e4[0]; ce[1] = ce[0] + e4[1]; ce[2] = ce[1] + e4[2]; ce[3] = ce[2] + e4[3];
        TOT[wave * 64 + lane] = ce[3];
    };
    auto stepB = [&](const int q) __attribute__((always_inline)) {
        unsigned char* set = lds + q * CK_SET;
        bf16_t* AH = (bf16_t*)(set + CK_AH); bf16_t* BH = (bf16_t*)(set + CK_BH); bf16_t* KH = (bf16_t*)(set + CK_KH); bf16_t* RH = (bf16_t*)(set + CK_RH);
        bf16_t* BHT = (bf16_t*)(set + CK_BHT); bf16_t* KHT = (bf16_t*)(set + CK_KHT); bf16_t* VT = (bf16_t*)(set + CK_VT); float* GC = (float*)(set + CK_GC);
        float off = 0.f;
#pragma unroll
        for (int w = 0; w < 7; ++w) { const float tw = TOT[w * 64 + lane]; if (w < wave) off += tw; }
        float bh[4], kh[4];
#pragma unroll
        for (int s = 0; s < 4; ++s) {
            const float cs = off + ce[s];
            const float g = __expf(-cs), gi = __expf(cs), gm1 = __expf(e4[s] - cs);
            const float kk = k4[s] * kkw * inv4[s], kp = k4[s] * (1.0f + (a4[s] - 1.0f) * kaw);
            bh[s] = kk * a4[s] * gi; kh[s] = kp * gi;
            const int t = wave * 4 + s;
            AH[t * CS64 + lane] = f2bf(-kk * gm1); BH[t * CS64 + lane] = f2bf(bh[s]); KH[t * CS64 + lane] = f2bf(kh[s]); RH[t * CS64 + lane] = f2bf(r4[s] * g);
            if (wave == 7 && s == 3) GC[lane] = g;
        }
        store_bf4(BHT + lane * CS32 + wave * 4, (f32x4){bh[0], bh[1], bh[2], bh[3]});
        store_bf4(KHT + lane * CS32 + wave * 4, (f32x4){kh[0], kh[1], kh[2], kh[3]});
        store_bf4(VT + lane * CS32 + wave * 4, (f32x4){v4[0], v4[1], v4[2], v4[3]});
    };
    auto stepC = [&](const int q) __attribute__((always_inline)) {
        unsigned char* set = lds + q * CK_SET;
        const bf16_t* AH = (const bf16_t*)(set + CK_AH); const bf16_t* BH = (const bf16_t*)(set + CK_BH); const bf16_t* KH = (const bf16_t*)(set + CK_KH); const bf16_t* RH = (const bf16_t*)(set + CK_RH);
        bf16_t* MRB = (bf16_t*)(set + CK_MRB);
        const int mq = wave >> 1, mt = wave & 1;
        const bf16_t* A = (mq < 2) ? AH : RH; const bf16_t* Bt = (mq & 1) ? KH : BH;
#pragma unroll
        for (int nt = 0; nt < 2; ++nt) {
            f32x4 acc = mm16t<64>(A + mt * 16 * CS64, CS64, Bt + nt * 16 * CS64, CS64, Z4, lane);
            const int m = mt * 16 + l15, n0 = nt * 16 + 4 * qd;
#pragma unroll
            for (int i = 0; i < 4; ++i) { const bool keep = (mq < 2) ? (n0 + i < m) : (n0 + i <= m); if (!keep) acc[i] = 0.f; }
            if (mq == 0) {
                store_bf4(PA + m * CS32 + n0, acc);
                f32x4 t0 = acc;
#pragma unroll
                for (int i = 0; i < 4; ++i) if (n0 + i == m) t0[i] += 1.0f;
                store_bf4(TT + q * 32 * CS32 + m * CS32 + n0, t0);
                f32x4 accn = mm16<64>(A + mt * 16 * CS64, CS64, Bt + nt * 16 * CS64, CS64, Z4, lane);
                const int mm0 = mt * 16 + 4 * qd, nn = nt * 16 + l15;
#pragma unroll
                for (int i = 0; i < 4; ++i) if (!(nn < mm0 + i)) accn[i] = 0.f;
                store_bf4(PT + nn * CS32 + mm0, accn);
            } else store_bf4(((mq == 1) ? LAK : ((mq == 2) ? MRB : MRK)) + m * CS32 + n0, acc);
        }
    };
    stepA(RA); LDS_BARRIER();
    chunk_load(RA, c, b, h, 2, wave, lane);
    stepB(0); LDS_BARRIER();
    stepC(0); LDS_BARRIER();
    auto body = [&](const int ck, const int p, ChunkRaw& Rn) __attribute__((always_inline)) {
        const int q = p ^ 1;
        const bf16_t* S0c = S0B + p * 64 * CS64; bf16_t* S0n = S0B + q * 64 * CS64;
        unsigned char* set = lds + p * CK_SET;
        const bf16_t* AH = (const bf16_t*)(set + CK_AH); const bf16_t* RH = (const bf16_t*)(set + CK_RH);
        const bf16_t* BHT = (const bf16_t*)(set + CK_BHT); const bf16_t* KHT = (const bf16_t*)(set + CK_KHT); const bf16_t* VT = (const bf16_t*)(set + CK_VT);
        const float* GC = (const float*)(set + CK_GC); const bf16_t* MRB = (const bf16_t*)(set + CK_MRB);
        f32x4 y = Z4;
        int pcur = 0, tcur = p;
#pragma unroll
        for (int itn = 0; itn < 5; ++itn) {
            const int m = mt4 * 16 + l15, n0 = nt4 * 16 + 4 * qd;
            if (wave < 4) {
                if (itn < 4) {
                    f32x4 cn = Z4, ct = Z4;
                    mm16_both(PA + pcur * 32 * CS32 + mt4 * 16 * CS32, CS32, PT + pcur * 32 * CS32 + nt4 * 16 * CS32, CS32, cn, ct, lane);
                    store_bf4(PA + (pcur ^ 1) * 32 * CS32 + m * CS32 + n0, ct);
                    store_bf4(PT + (pcur ^ 1) * 32 * CS32 + (nt4 * 16 + l15) * CS32 + mt4 * 16 + 4 * qd, cn);
                }
            } else if (itn > 0) {
                const u32x2 told = *(const u32x2*)(TT + tcur * 32 * CS32 + m * CS32 + n0);
                f32x4 acc = (f32x4){bflo(told.x), bfhi(told.x), bflo(told.y), bfhi(told.y)};
                acc = mm16t<32>(TT + tcur * 32 * CS32 + mt4 * 16 * CS32, CS32, PT + pcur * 32 * CS32 + nt4 * 16 * CS32, CS32, acc, lane);
                store_bf4(TT + (tcur ^ 1) * 32 * CS32 + m * CS32 + n0, acc);
            }
            if (itn == 0) {
                f32x4 z = mm16<64>(AH + mt8 * 16 * CS64, CS64, S0c + nt8 * 16 * CS64, CS64, Z4, lane);
                z = mm16<32>(LAK + mt8 * 16 * CS32, CS32, VT + nt8 * 16 * CS32, CS32, z, lane);
                store_bf4(ZT + (nt8 * 16 + l15) * CS32 + mt8 * 16 + 4 * qd, z);
            } else if (itn == 1) {
                y = mm16t<64>(RH + mt8 * 16 * CS64, CS64, S0c + nt8 * 16 * CS64, CS64, Z4, lane);
                y = mm16t<32>(MRK + mt8 * 16 * CS32, CS32, VT + nt8 * 16 * CS32, CS32, y, lane);
            } else if (itn == 2) {
#pragma unroll
                for (int j = 0; j < 2; ++j) Sreg[j] = mm16t<32>(VT + svt * 16 * CS32, CS32, KHT + (skt0 + j) * 16 * CS32, CS32, Sreg[j], lane);
            } else if (itn == 3) {
                stepA(Rn);
            } else {
                { const int ckn = (ck + 3 < NCK) ? ck + 3 : NCK - 1; chunk_load(Rn, c, b, h, ckn, wave, lane); }
                stepB(q);
            }
            LDS_BARRIER();
            if (itn < 4) pcur ^= 1;
            if (itn > 0) tcur ^= 1;
        }
        const bf16_t* Tm = TT + p * 32 * CS32;
        {
            const f32x4 uacc = mm16<32>(Tm + mt8 * 16 * CS32, CS32, ZT + nt8 * 16 * CS32, CS32, Z4, lane);
            store_bf4(UT + (nt8 * 16 + l15) * CS32 + mt8 * 16 + 4 * qd, uacc);
            stepC(q);
        }
        LDS_BARRIER();
        {
            y = mm16t<32>(MRB + mt8 * 16 * CS32, CS32, UT + nt8 * 16 * CS32, CS32, y, lane);
            store_bf4(c.YRAW + ((size_t)b * SEQ + ck * 32 + mt8 * 16 + l15) * 512 + h * 64 + nt8 * 16 + 4 * qd, y);
#pragma unroll
            for (int j = 0; j < 2; ++j) {
                const int kt = skt0 + j;
                f32x4 s = mm16t<32>(UT + svt * 16 * CS32, CS32, BHT + kt * 16 * CS32, CS32, Sreg[j], lane);
                const f32x4 gc = *(const f32x4*)(GC + kt * 16 + 4 * qd);
                s = s * gc;
                Sreg[j] = s;
                store_bf4(S0n + (svt * 16 + l15) * CS64 + kt * 16 + 4 * qd, s);
            }
        }
        LDS_BARRIER();
    };
#pragma unroll 1
    for (int ck = 0; ck < NCK; ck += 2) { body(ck, 0, RB); body(ck + 1, 1, RA); }
    __syncthreads();
}
DI void phase_rwkv_post(const Ctx& c, unsigned char* lds) {
    const int tid = TID(), lane = tid & 63, wave = tid >> 6;
    const size_t PL = (size_t)NT * 512;
    for (int t = blockIdx.x * 8 + wave; t < NT; t += gridDim.x * 8) {
        bf16_t ry[8], rv[8], rg[8]; float bon[8], gw[8], gb[8];
#pragma unroll
        for (int h = 0; h < 8; ++h) { const size_t o = (size_t)t * 512 + h * 64 + lane; ry[h] = c.YRAW[o]; rv[h] = c.F[o + 2 * PL]; rg[h] = c.F[o + 5 * PL]; bon[h] = c.BON[((size_t)t * 8 + h) * 4 + 3];
            gw[h] = c.in(I_GNW)[c.l * 512 + h * 64 + lane]; gb[h] = c.in(I_GNB)[c.l * 512 + h * 64 + lane]; }
#pragma unroll
        for (int h = 0; h < 8; ++h) {
            const float y = bf2f(ry[h]);
            const float mean = wave_sum_dpp(y) * (1.0f / 64.0f);
            const float d = y - mean;
            const float var = wave_sum_dpp(d * d) * (1.0f / 64.0f);
            const float yn = d * rsqrtf(var + 64e-5f) * gw[h] + gb[h];
            c.F[(size_t)t * 512 + h * 64 + lane + 5 * PL] = f2bf((yn + bon[h] * bf2f(rv[h])) * bf2f(rg[h]));
        }
    }
    for (int it = blockIdx.x * 4; it < 768 + 128 + 128 + 256 + 256; it += gridDim.x * 4) {
        const float* WB = c.in(I_WBR) + (size_t)c.l * 2048 * DM; bf16_t* BR = (bf16_t*)(c.ws + WS_WT_BR);
        if (it < 768) convert_tile4(c.in(I_WMG) + (size_t)c.l * DM * 3 * DM, 3 * DM, 3 * DM, DM, (bf16_t*)(c.ws + WS_WT_MG), it, lds);
        else if (it < 896) convert_tile4(WB, DM, DM, 512, BR, it - 768, lds);
        else if (it < 1024) convert_tile4(WB + (size_t)512 * DM, DM, DM, 512, BR + (size_t)1024 * 512, it - 896, lds);
        else if (it < 1280) convert_tile4(WB + (size_t)1024 * DM, DM, DM, 1024, BR + (size_t)2048 * 512, it - 1024, lds);
        else convert_tile4(c.in(I_WOUT) + (size_t)c.l * DM * DM, DM, DM, DM, (bf16_t*)(c.ws + WS_WT_OUT), it - 1280, lds);
    }
}
constexpr int TS = 72;
constexpr int NSA_BIAS = 0;
constexpr int NSA_SELM = 2112;
constexpr int NSA_SCR = 2624;
constexpr int NSA_K0 = 4672;
constexpr int NSA_V0 = NSA_K0 + 2 * 64 * TS * 2;
constexpr int NSA_A = NSA_V0 + 2 * 64 * TS * 2;
constexpr int NSA_B = NSA_A + 16384;
constexpr int NSA_END = NSA_B + 16384;
static_assert(NSA_END <= LDS_BYTES - 16, "nsa lds");
static_assert(NSA_K0 % 16 == 0, "align");

struct NsaLane { int tq[2]; int h; float cbias; float m[2], l[2]; };

DI void nsa_prefetch(u32x4& rk, u32x4& rv, const bf16_t* kbase, int kstride, const bf16_t* vtbase, int vstride, int pos0, int tid) {
    const int r = tid >> 3, seg = (tid & 7) * 8;
    rk = *(const u32x4*)(kbase + (size_t)(pos0 + r) * kstride + seg);
    rv = *(const u32x4*)(vtbase + (size_t)r * vstride + pos0 + seg);
}
DI void nsa_store(unsigned char* lds, int buf, const u32x4& rk, const u32x4& rv, int tid) {
    const int r = tid >> 3, seg = (tid & 7) * 8;
    *(u32x4*)((bf16_t*)(lds + NSA_K0) + buf * 64 * TS + r * TS + seg) = rk;
    *(u32x4*)((bf16_t*)(lds + NSA_V0) + buf * 64 * TS + r * TS + seg) = rv;
}
template <int QM = 3>
DI void nsa_qk(f32x4 (&s)[2][4], const bf16_t* sK, const bf16x8 (&qf)[2][2], int lane) {
#pragma unroll
    for (int kt = 0; kt < 4; ++kt) {
#pragma unroll
        for (int ks = 0; ks < 2; ++ks) {
            const bf16x8 kf = *(const bf16x8*)(sK + (16 * kt + (lane & 15)) * TS + 32 * ks + (lane >> 4) * 8);
#pragma unroll
            for (int qi = 0; qi < 2; ++qi) if ((QM >> qi) & 1) s[qi][kt] = __builtin_amdgcn_mfma_f32_16x16x32_bf16(kf, qf[qi][ks], (ks == 0) ? (f32x4){0.f, 0.f, 0.f, 0.f} : s[qi][kt], 0, 0, 0);
        }
    }
}
template <int MODE>
DI void nsa_logits(float (&x)[4][4], const f32x4 (&s)[4], int tq, int h, float cbias, bool rowsel, int pos0, int qd, const float* biasT) {
#pragma unroll
    for (int kt = 0; kt < 4; ++kt)
#pragma unroll
        for (int i = 0; i < 4; ++i) {
            const int kk = pos0 + 16 * kt + 4 * qd + i;
            if (MODE == 1) { x[kt][i] = rowsel ? s[kt][i] + cbias : -INFINITY; }
            else {
                const int dist = (MODE == 0) ? (tq - 16 * kk - 31) : (tq - kk);
                bool ok = dist >= 0;
                if (MODE == 2) ok = ok && rowsel;
                if (MODE == 3) ok = ok && (dist < 512);
                const int di = dist < 0 ? 0 : (dist > 128 ? 128 : dist);
                float bias = biasT[di * 4 + h];
                asm volatile("" : "+v"(bias));
                x[kt][i] = ok ? s[kt][i] + bias : -INFINITY;
            }
        }
}
DI float quad16_max(float v) {
    { const auto r = __builtin_amdgcn_permlane16_swap(__float_as_uint(v), __float_as_uint(v), false, false); v = fmaxf(__uint_as_float(r[0]), __uint_as_float(r[1])); }
    { const auto r = __builtin_amdgcn_permlane32_swap(__float_as_uint(v), __float_as_uint(v), false, false); v = fmaxf(__uint_as_float(r[0]), __uint_as_float(r[1])); }
    return v; }
DI float quad16_sum(float v) {
    { const auto r = __builtin_amdgcn_permlane16_swap(__float_as_uint(v), __float_as_uint(v), false, false); v = __uint_as_float(r[0]) + __uint_as_float(r[1]); }
    { const auto r = __builtin_amdgcn_permlane32_swap(__float_as_uint(v), __float_as_uint(v), false, false); v = __uint_as_float(r[0]) + __uint_as_float(r[1]); }
    return v; }
DI void nsa_softmax(const float (&x)[4][4], float& m, float& l, f32x4 (&O)[4], bf16x8 (&pf)[2]) {
    float mx = -INFINITY;
#pragma unroll
    for (int kt = 0; kt < 4; ++kt)
#pragma unroll
        for (int i = 0; i < 4; ++i) mx = fmaxf(mx, x[kt][i]);
    mx = quad16_max(mx);
    const float mn = fmaxf(m, mx);
    const float mu = (mn == -INFINITY) ? 0.f : mn;
    const float mu2 = mu * 1.4426950408889634f;
    const bool changed = mn != m;
    const float sc = changed ? __builtin_amdgcn_exp2f(__builtin_fmaf(m, 1.4426950408889634f, -mu2)) : 1.0f;
    float p[4][4]; float ps = 0.f;
#pragma unroll
    for (int kt = 0; kt < 4; ++kt)
#pragma unroll
        for (int i = 0; i < 4; ++i) { p[kt][i] = __builtin_amdgcn_exp2f(__builtin_fmaf(x[kt][i], 1.4426950408889634f, -mu2)); ps += p[kt][i]; }
    l = l * sc + ps; m = mn;
    if (__ballot(changed) != 0ull) {
#pragma unroll
        for (int dt = 0; dt < 4; ++dt) O[dt] = O[dt] * sc;
    }
#pragma unroll
    for (int ks = 0; ks < 2; ++ks) {
        u32x4 w; w.x = pack2(p[2 * ks][0], p[2 * ks][1]); w.y = pack2(p[2 * ks][2], p[2 * ks][3]); w.z = pack2(p[2 * ks + 1][0], p[2 * ks + 1][1]); w.w = pack2(p[2 * ks + 1][2], p[2 * ks + 1][3]);
        pf[ks] = __builtin_bit_cast(bf16x8, w);
    }
}
DI void nsa_softmax_far(const f32x4 (&s)[4], float cbias, bool rs, float& m, float& l, f32x4 (&O)[4], bf16x8 (&pf)[2]) {
    constexpr float LOG2E = 1.4426950408889634f;
    float mx = fmaxf(fmaxf(s[0][0], s[0][1]), fmaxf(s[0][2], s[0][3]));
#pragma unroll
    for (int kt = 1; kt < 4; ++kt) mx = fmaxf(mx, fmaxf(fmaxf(s[kt][0], s[kt][1]), fmaxf(s[kt][2], s[kt][3])));
    mx = quad16_max(mx) + cbias;
    const float mn = rs ? fmaxf(m, mx) : m;
    const float mu2 = ((mn == -INFINITY) ? 0.f : mn) * LOG2E;
    const bool changed = mn != m;
    const float sc = changed ? __builtin_amdgcn_exp2f(__builtin_fmaf(m, LOG2E, -mu2)) : 1.0f;
    const float c0 = rs ? __builtin_fmaf(cbias, LOG2E, -mu2) : -INFINITY;
    const f32x2 c2 = (f32x2){c0, c0};
    f32x2 p[4][2]; f32x2 ps2 = (f32x2){0.f, 0.f};
#pragma unroll
    for (int kt = 0; kt < 4; ++kt)
#pragma unroll
        for (int hh = 0; hh < 2; ++hh) {
            const f32x2 t = (f32x2){s[kt][2 * hh], s[kt][2 * hh + 1]} * LOG2E + c2;
            p[kt][hh] = (f32x2){__builtin_amdgcn_exp2f(t[0]), __builtin_amdgcn_exp2f(t[1])};
            ps2 += p[kt][hh];
        }
    l = l * sc + (ps2[0] + ps2[1]); m = mn;
    if (__ballot(changed) != 0ull) {
#pragma unroll
        for (int dt = 0; dt < 4; ++dt) O[dt] = O[dt] * sc;
    }
#pragma unroll
    for (int ks = 0; ks < 2; ++ks) {
        u32x4 w; w.x = pack2(p[2 * ks][0][0], p[2 * ks][0][1]); w.y = pack2(p[2 * ks][1][0], p[2 * ks][1][1]); w.z = pack2(p[2 * ks + 1][0][0], p[2 * ks + 1][0][1]); w.w = pack2(p[2 * ks + 1][1][0], p[2 * ks + 1][1][1]);
        pf[ks] = __builtin_bit_cast(bf16x8, w);
    }
}
template <int QM = 3>
DI void nsa_pv(f32x4 (&O)[2][4], const bf16_t* sV, const bf16x8 (&pf)[2][2], int lane) {
    const int qd = lane >> 4;
#pragma unroll
    for (int dt = 0; dt < 4; ++dt)
#pragma unroll
        for (int ks = 0; ks < 2; ++ks) {
            const bf16_t* vp = sV + (16 * dt + (lane & 15)) * TS + 32 * ks + 4 * qd;
            const u32x2 a = *(const u32x2*)vp, b = *(const u32x2*)(vp + 16);
            u32x4 w; w.x = a.x; w.y = a.y; w.z = b.x; w.w = b.y;
            const bf16x8 vf = __builtin_bit_cast(bf16x8, w);
#pragma unroll
            for (int qi = 0; qi < 2; ++qi) if ((QM >> qi) & 1) O[qi][dt] = __builtin_amdgcn_mfma_f32_16x16x32_bf16(vf, pf[qi][ks], O[qi][dt], 0, 0, 0);
        }
}
template <int MODE, int QM = 3>
DI void nsa_tile(f32x4 (&O)[2][4], NsaLane& L, const bf16x8 (&qf)[2][2], const unsigned char* lds, int buf, int pos0, bool sel0, bool sel1, int lane) {
    const bf16_t* sK = (const bf16_t*)(lds + NSA_K0) + buf * 64 * TS;
    const bf16_t* sV = (const bf16_t*)(lds + NSA_V0) + buf * 64 * TS;
    const float* biasT = (const float*)(lds + NSA_BIAS);
    f32x4 s[2][4];
    nsa_qk<QM>(s, sK, qf, lane);
    bf16x8 pf[2][2];
#pragma unroll
    for (int qi = 0; qi < 2; ++qi) if ((QM >> qi) & 1) {
        if (MODE == 1) nsa_softmax_far(s[qi], L.cbias, qi ? sel1 : sel0, L.m[qi], L.l[qi], O[qi], pf[qi]);
        else {
            float x[4][4];
            nsa_logits<MODE>(x, s[qi], L.tq[qi], L.h, L.cbias, qi ? sel1 : sel0, pos0, lane >> 4, biasT);
            nsa_softmax(x, L.m[qi], L.l[qi], O[qi], pf[qi]);
        }
    }
    nsa_pv<QM>(O, sV, pf, lane);
}
template <int MODE>
DI void nsa_tile_sel(f32x4 (&O)[2][4], NsaLane& L, const bf16x8 (&qf)[2][2], const unsigned char* lds, int buf, int pos0, bool sel0, bool sel1, int lane) {
    const bool a0 = __ballot(sel0) != 0ull, a1 = __ballot(sel1) != 0ull;
    if (a0 && a1) nsa_tile<MODE, 3>(O, L, qf, lds, buf, pos0, sel0, sel1, lane);
    else if (a0) nsa_tile<MODE, 1>(O, L, qf, lds, buf, pos0, sel0, sel1, lane);
    else if (a1) nsa_tile<MODE, 2>(O, L, qf, lds, buf, pos0, sel0, sel1, lane);
}
DI void nsa_flush(f32x4 (&Y)[2][4], f32x4 (&O)[2][4], NsaLane& L, const float (&gate)[2]) {
#pragma unroll
    for (int qi = 0; qi < 2; ++qi) {
        const float lt = quad16_sum(L.l[qi]);
        const float f = (lt > 0.f) ? gate[qi] * __builtin_amdgcn_rcpf(lt) : 0.f;
#pragma unroll
        for (int dt = 0; dt < 4; ++dt) { Y[qi][dt] += O[qi][dt] * f; O[qi][dt] = (f32x4){0.f, 0.f, 0.f, 0.f}; }
    }
}
DI void nsa_item(const Ctx& c, int item, unsigned char* lds) {
    const int tid = TID(), lane = tid & 63, wave = tid >> 6, qd = lane >> 4;
    const int b = item >> 8, g = (item >> 6) & 3, qt = item & 63, t0 = qt * 64, cur = qt, bg = b * 4 + g;
    float* biasT = (float*)(lds + NSA_BIAS);
    unsigned long long* selm = (unsigned long long*)(lds + NSA_SELM);
    float* scr = (float*)(lds + NSA_SCR) + wave * 64;
    float* impA = (float*)(lds + NSA_A); float* impB = (float*)(lds + NSA_B);
    __syncthreads();
    for (int i = tid; i < 129 * 4; i += NTHREADS) { const int d = i >> 2, h = i & 3; biasT[i] = c.in(I_RELB)[t5_bucket(d) * 16 + g * 4 + h]; }
    for (int i = tid; i < 2 * 4096; i += NTHREADS) impA[i] = 0.f;
    NsaLane L; L.h = lane & 3;
    bf16x8 qf[2][2]; float gates[2][3];
    const bf16_t* pbat = c.PROJ + (size_t)b * SEQ * IN_COLS;
#pragma unroll
    for (int qi = 0; qi < 2; ++qi) {
        const int tl = 8 * wave + 4 * qi + ((lane & 15) >> 2);
        L.tq[qi] = t0 + tl;
        const bf16_t* prow = pbat + (size_t)L.tq[qi] * IN_COLS;
#pragma unroll
        for (int ks = 0; ks < 2; ++ks) {
            u32x4 w = *(const u32x4*)(prow + C_Q + (g * 4 + L.h) * 64 + 32 * ks + qd * 8);
            w.x = pack2(bflo(w.x) * 0.125f, bfhi(w.x) * 0.125f); w.y = pack2(bflo(w.y) * 0.125f, bfhi(w.y) * 0.125f);
            w.z = pack2(bflo(w.z) * 0.125f, bfhi(w.z) * 0.125f); w.w = pack2(bflo(w.w) * 0.125f, bfhi(w.w) * 0.125f);
            qf[qi][ks] = __builtin_bit_cast(bf16x8, w);
        }
#pragma unroll
        for (int br = 0; br < 3; ++br) gates[qi][br] = sigmoidf_(bf2f(prow[C_GATE + g * 12 + L.h * 3 + br]));
    }
    __syncthreads();
    L.cbias = biasT[128 * 4 + L.h];
    f32x4 O[2][4], Y[2][4];
#pragma unroll
    for (int qi = 0; qi < 2; ++qi)
#pragma unroll
        for (int dt = 0; dt < 4; ++dt) { O[qi][dt] = (f32x4){0.f, 0.f, 0.f, 0.f}; Y[qi][dt] = (f32x4){0.f, 0.f, 0.f, 0.f}; }
    u32x4 rk, rv;
    const int nvis_max = (t0 + 63 >= 31) ? ((t0 + 63 - 31) >> 4) + 1 : 0;
    const int ncb = (nvis_max + 63) >> 6;
    const bf16_t* kcb = c.KC + (size_t)bg * 256 * 64; const bf16_t* vcb = c.VCT + (size_t)bg * 64 * 256;
    L.m[0] = L.m[1] = -INFINITY; L.l[0] = L.l[1] = 0.f;
    if (ncb > 0) nsa_prefetch(rk, rv, kcb, 64, vcb, 256, 0, tid);
    for (int cb = 0; cb < ncb; ++cb) {
        nsa_store(lds, cb & 1, rk, rv, tid);
        __syncthreads();
        if (cb + 1 < ncb) nsa_prefetch(rk, rv, kcb, 64, vcb, 256, (cb + 1) * 64, tid);
        if (16 * (cb * 64 + 63) + 31 + 128 <= t0) nsa_tile<1>(O, L, qf, lds, cb & 1, cb * 64, true, true, lane);
        else nsa_tile<0>(O, L, qf, lds, cb & 1, cb * 64, true, true, lane);
    }
    if (ncb > 0) nsa_prefetch(rk, rv, kcb, 64, vcb, 256, 0, tid);
    float mfin[2], linv[2];
#pragma unroll
    for (int qi = 0; qi < 2; ++qi) { mfin[qi] = L.m[qi]; const float lt = quad16_sum(L.l[qi]); linv[qi] = (lt > 0.f) ? __builtin_amdgcn_rcpf(lt) : 0.f; }
    { const float gg[2] = {gates[0][0], gates[1][0]}; nsa_flush(Y, O, L, gg); }
    __syncthreads();
    for (int cb = 0; cb < ncb; ++cb) {
        nsa_store(lds, cb & 1, rk, rv, tid);
        __syncthreads();
        if (cb + 1 < ncb) nsa_prefetch(rk, rv, kcb, 64, vcb, 256, (cb + 1) * 64, tid);
        const bf16_t* sK = (const bf16_t*)(lds + NSA_K0) + (cb & 1) * 64 * TS;
        f32x4 s[2][4];
        nsa_qk(s, sK, qf, lane);
#pragma unroll
        for (int qi = 0; qi < 2; ++qi) {
            float x[4][4];
            nsa_logits<0>(x, s[qi], L.tq[qi], L.h, L.cbias, true, cb * 64, qd, biasT);
            const float mu2 = ((mfin[qi] == -INFINITY) ? 0.f : mfin[qi]) * 1.4426950408889634f;
#pragma unroll
            for (int kt = 0; kt < 4; ++kt) {
#define E2_(v) __builtin_amdgcn_exp2f(__builtin_fmaf((v), 1.4426950408889634f, -mu2))
                float p3 = E2_(x[kt][3]) * linv[qi];
                float pa = (E2_(x[kt][0]) + E2_(x[kt][1]) + E2_(x[kt][2])) * linv[qi] + p3;
#undef E2_
                pa += DPP_MOV(pa, 0xB1); p3 += DPP_MOV(p3, 0xB1);
                pa += DPP_MOV(pa, 0x4E); p3 += DPP_MOV(p3, 0x4E);
                if (L.h == 0) { const int tl = 8 * wave + 4 * qi + ((lane & 15) >> 2), mi = 16 * cb + 4 * kt + qd; impA[tl * 64 + mi] = pa; impB[tl * 64 + mi] = p3; }
            }
        }
    }
    const bf16_t* ksb = pbat + C_KS + g * 64; const bf16_t* vsb = c.VT + ((size_t)0 * 16 + bg) * 64 * SEQ;
    nsa_prefetch(rk, rv, ksb, IN_COLS, vsb, SEQ, 0, tid);
    __syncthreads();
    for (int tl8 = 0; tl8 < 8; ++tl8) {
        const int tl = 8 * wave + tl8, n = lane;
        const bool cand = (n >= 1) && (n <= cur - 2);
        const float imp = cand ? impA[tl * 64 + n] + impB[tl * 64 + n - 1] : -1.0f;
        LDS_WAVE_SYNC();
        scr[n] = imp;
        LDS_WAVE_SYNC();
        int rank = 0;
#pragma unroll 4
        for (int q4 = 0; q4 < 16; ++q4) {
            const f32x4 o = *(const f32x4*)(scr + q4 * 4);
#pragma unroll
            for (int j = 0; j < 4; ++j) { const int n2 = q4 * 4 + j; rank += (o[j] > imp || (o[j] == imp && n2 < n)) ? 1 : 0; }
        }
        const bool forced = (n <= cur) && (n == 0 || n == cur || n == cur - 1);
        const unsigned long long msk = __ballot((cand && rank < 5) || forced);
        if (lane == 0) selm[tl] = msk;
    }
    __syncthreads();
    unsigned long long uni = selm[lane];
#pragma unroll
    for (int o = 32; o >= 1; o >>= 1) { const unsigned lo_ = __shfl_xor((unsigned)uni, o), hi_ = __shfl_xor((unsigned)(uni >> 32), o); uni |= ((unsigned long long)hi_ << 32) | lo_; }
    uni = ((unsigned long long)__builtin_amdgcn_readfirstlane((unsigned)(uni >> 32)) << 32) | (unsigned)__builtin_amdgcn_readfirstlane((unsigned)uni);
    unsigned long long sm[2];
#pragma unroll
    for (int qi = 0; qi < 2; ++qi) sm[qi] = selm[8 * wave + 4 * qi + ((lane & 15) >> 2)];
    L.m[0] = L.m[1] = -INFINITY; L.l[0] = L.l[1] = 0.f;
    {
        unsigned long long rem = uni; int it = 0;
        int j = (int)__builtin_ctzll(rem); rem &= rem - 1;
        for (;;) {
            nsa_store(lds, it & 1, rk, rv, tid);
            __syncthreads();
            const int jn = rem ? (int)__builtin_ctzll(rem) : -1;
            if (jn >= 0) { rem &= rem - 1; nsa_prefetch(rk, rv, ksb, IN_COLS, vsb, SEQ, jn * 64, tid); }
            const bool s0 = (sm[0] >> j) & 1ull, s1 = (sm[1] >> j) & 1ull;
            if (j <= cur - 3) nsa_tile_sel<1>(O, L, qf, lds, it & 1, j * 64, s0, s1, lane);
            else nsa_tile_sel<2>(O, L, qf, lds, it & 1, j * 64, s0, s1, lane);
            if (jn < 0) break;
            j = jn; ++it;
        }
    }
    const bf16_t* kwb = pbat + C_KW + g * 64; const bf16_t* vwb = c.VT + ((size_t)1 * 16 + bg) * 64 * SEQ;
    const int j0 = (cur - 8 > 0) ? cur - 8 : 0;
    nsa_prefetch(rk, rv, kwb, IN_COLS, vwb, SEQ, j0 * 64, tid);
    { const float gg[2] = {gates[0][1], gates[1][1]}; nsa_flush(Y, O, L, gg); }
    L.m[0] = L.m[1] = -INFINITY; L.l[0] = L.l[1] = 0.f;
    {
        __syncthreads();
        for (int j = j0; j <= cur; ++j) {
            nsa_store(lds, (j - j0) & 1, rk, rv, tid);
            __syncthreads();
            if (j + 1 <= cur) nsa_prefetch(rk, rv, kwb, IN_COLS, vwb, SEQ, (j + 1) * 64, tid);
            if (cur - j >= 3 && cur - j <= 7) nsa_tile<1>(O, L, qf, lds, (j - j0) & 1, j * 64, true, true, lane);
            else nsa_tile<3>(O, L, qf, lds, (j - j0) & 1, j * 64, true, true, lane);
        }
    }
    { const float gg[2] = {gates[0][2], gates[1][2]}; nsa_flush(Y, O, L, gg); }
#pragma unroll
    for (int qi = 0; qi < 2; ++qi) {
        bf16_t* yrow = c.PROJ + ((size_t)b * SEQ + L.tq[qi]) * IN_COLS + C_Q + (g * 4 + L.h) * 64;
#pragma unroll
        for (int dt = 0; dt < 4; ++dt) store_bf4(yrow + 16 * dt + 4 * qd, Y[qi][dt]);
    }
}
DI void phase_mix(const Ctx& c, unsigned char* lds) {
    const int G = gridDim.x, bid = blockIdx.x;
    const int n_nsa = NB * 4 * (SEQ / 64), n_scan = NB * 8;
    for (int item = bid; item < n_scan; item += G) scan_chunked_item(c, item, lds);
    unsigned* ctr = c.ctl + CW_Q + c.l;
    volatile int* sitem = (volatile int*)(lds + LDS_BYTES - 32);
    for (;;) {
        __syncthreads();
        if (TID() == 0) *sitem = (int)atomicAdd(ctr, 1u);
        __syncthreads();
        const int k = *sitem;
        if (k >= n_nsa) break;
        const int qt = 63 - (k >> 4), bgi = k & 15;
        nsa_item(c, (bgi << 6) | qt, lds);
    }
}

DI void phase_merge(const Ctx& c, unsigned char* lds) {
    const int nN = DM / 256;
    const bf16_t* WM = (const bf16_t*)(c.ws + WS_WT_MG);
    const bf16_t* BR = (const bf16_t*)(c.ws + WS_WT_BR);
    const float* BM_ = c.in(I_BMG) + (size_t)c.l * 3 * DM;
    bf16_t* TMP = c.F + (size_t)2 * NT * 512 + (size_t)blockIdx.x * 256 * 256;
    for (int it = 0;; ++it) {
        int tm, tn; if (!xcd_unit(it, nN, tm, tn)) break;
        const int m0 = tm * 256, n0 = tn * 256;
#pragma unroll 1
        for (int i = 0; i < 3; ++i) {
            f32x4 acc[8][4];
#pragma unroll
            for (int a_ = 0; a_ < 8; ++a_)
#pragma unroll
                for (int b_ = 0; b_ < 4; ++b_) acc[a_][b_] = (f32x4){0.f, 0.f, 0.f, 0.f};
            gemm256_dma(acc, c.H + (size_t)m0 * DM, DM, WM + (size_t)(i * DM + n0) * DM, DM, DM, lds);
            tile256_store_bf16(acc, TMP, 256, 256, lds);
#pragma unroll
            for (int a_ = 0; a_ < 8; ++a_)
#pragma unroll
                for (int b_ = 0; b_ < 4; ++b_) acc[a_][b_] = (f32x4){0.f, 0.f, 0.f, 0.f};
            {
                const bf16_t* Ab = (i == 0) ? c.POOLED + (size_t)m0 * 512 : ((i == 1) ? c.F + (size_t)5 * NT * 512 + (size_t)m0 * 512 : c.PROJ + C_Q + (size_t)m0 * IN_COLS);
                const size_t la = (i == 2) ? (size_t)IN_COLS : (size_t)512;
                const int Kb = (i == 2) ? 1024 : 512;
                gemm256_dma(acc, Ab, la, BR + (size_t)i * 1024 * 512 + (size_t)n0 * Kb, (size_t)Kb, Kb, lds);
            }
            const int lane = TID() & 63, wave = TID() >> 6, wm = wave >> 2, wn = wave & 3;
            const float* bias = BM_ + i * DM + n0;
#pragma unroll
            for (int mi = 0; mi < 8; ++mi) {
#pragma unroll
                for (int ni = 0; ni < 4; ++ni) {
                    const int r = R256(mi), cc = C256(ni);
                    bf16_t* q = c.MERGED + (size_t)(m0 + r) * DM + n0 + cc;
                    const u32x2 gv = *(const u32x2*)(TMP + r * 256 + cc);
                    const f32x4 bb = *(const f32x4*)(bias + cc);
                    f32x4 m4 = (f32x4){0.f, 0.f, 0.f, 0.f};
                    if (i > 0) { const u32x2 pv = *(const u32x2*)q; m4 = (f32x4){bflo(pv.x), bfhi(pv.x), bflo(pv.y), bfhi(pv.y)}; }
                    m4[0] += sigmoidf_(bflo(gv.x) + bb[0]) * acc[mi][ni][0]; m4[1] += sigmoidf_(bfhi(gv.x) + bb[1]) * acc[mi][ni][1];
                    m4[2] += sigmoidf_(bflo(gv.y) + bb[2]) * acc[mi][ni][2]; m4[3] += sigmoidf_(bfhi(gv.y) + bb[3]) * acc[mi][ni][3];
                    store_bf4(q, m4);
                }
                asm volatile("" ::: "memory"); __builtin_amdgcn_sched_barrier(0);
            }
        }
    }
}

DI void phase_outp(const Ctx& c, unsigned char* lds) {
    const int nN = DM / 256;
    const bf16_t* W = (const bf16_t*)(c.ws + WS_WT_OUT);
    const float* xin = (c.l == 0) ? c.in(I_X) : c.out;
    for (int it = 0;; ++it) {
        int tm, tn; if (!xcd_unit(it, nN, tm, tn)) break;
        const int m0 = tm * 256, n0 = tn * 256;
        f32x4 acc[8][4];
#pragma unroll
        for (int i = 0; i < 8; ++i)
#pragma unroll
            for (int j = 0; j < 4; ++j) acc[i][j] = (f32x4){0.f, 0.f, 0.f, 0.f};
        gemm256_dma(acc, c.MERGED + (size_t)m0 * DM, DM, W + (size_t)n0 * DM, DM, DM, lds);
        const int lane = TID() & 63, wave = TID() >> 6, wm = wave >> 2, wn = wave & 3;
#pragma unroll
        for (int mi = 0; mi < 8; ++mi)
#pragma unroll
            for (int ni = 0; ni < 4; ++ni) {
                const size_t o = (size_t)(m0 + R256(mi)) * DM + n0 + C256(ni);
                const f32x4 x = *(const f32x4*)(xin + o); *(f32x4*)(c.out + o) = x + acc[mi][ni];
            }
    }
    for (int it = blockIdx.x * 4; it < 2 * 32 * 64; it += gridDim.x * 4) {
        const int mat = it / 2048, e = (it >> 6) & 31, tl = it & 63;
        if (mat == 0) convert_tile4(c.in(I_EG) + ((size_t)c.l * 32 + e) * DM * 256, 256, 256, DM, (bf16_t*)(c.ws + WS_EG) + (size_t)e * 256 * DM, tl, lds);
        else convert_tile4(c.in(I_EU) + ((size_t)c.l * 32 + e) * DM * 256, 256, 256, DM, (bf16_t*)(c.ws + WS_EU) + (size_t)e * 256 * DM, tl, lds);
    }
}

DI void phase_norm2(const Ctx& c, unsigned char* lds) {
    const int tid = TID(), lane = tid & 63, wave = tid >> 6;
    const float* gain = c.in(I_NFFN) + c.l * DM;
    const float* wrg = c.in(I_WRG) + (size_t)c.l * DM * 4; const float* brg = c.in(I_BRG) + c.l * 4;
    const float* wre = c.in(I_WRE) + (size_t)c.l * DM * 32; const float* bre = c.in(I_BRE) + c.l * 32;
    unsigned* cnt = c.ctl + CW_CNT + c.l * 32;
    constexpr int N2_B01 = 0, N2_B2 = 131072, N2_RS = 147456, N2_LCNT = N2_RS + 256, N2_LG = 0, N2_PART = 16384;
    float* B01 = (float*)(lds + N2_B01); float* B2 = (float*)(lds + N2_B2); float* RS = (float*)(lds + N2_RS);
    unsigned* lcnt = (unsigned*)(lds + N2_LCNT); unsigned* lbase = lcnt + 32;
    for (int rb = blockIdx.x; rb < NT / 64; rb += gridDim.x) {
        const int r0b = rb * 64;
        __syncthreads();
#pragma unroll 4
        for (int p = tid; p < 8192; p += NTHREADS) {
            const f32x4 w = *(const f32x4*)(wre + (size_t)p * 4);
            const int k = p >> 3, c4 = (p & 7) * 4, kb = k >> 4, kq = (k >> 2) & 3, m = k & 3, jj = c4 >> 4, cl = c4 & 15;
            float* d = B01 + (((kb * 2 + jj) * 64 + kq * 16 + cl) * 4) + m;
            d[0] = w[0]; d[4] = w[1]; d[8] = w[2]; d[12] = w[3];
        }
#pragma unroll
        for (int p = tid; p < 1024; p += NTHREADS) {
            const f32x4 w = *(const f32x4*)(wrg + (size_t)p * 4);
            const int kb = p >> 4, kq = (p >> 2) & 3, m = p & 3;
            float* d = B2 + ((kb * 4 + kq) * 4) * 4 + m;
            d[0] = w[0]; d[4] = w[1]; d[8] = w[2]; d[12] = w[3];
        }
        if (tid < 32) lcnt[tid] = 0u;
#pragma unroll
        for (int hb = 0; hb < 2; ++hb) {
            f32x4 v[4][4];
#pragma unroll
            for (int rr = 0; rr < 4; ++rr)
#pragma unroll
                for (int i = 0; i < 4; ++i) v[rr][i] = *(const f32x4*)(c.out + (size_t)(r0b + wave * 8 + hb * 4 + rr) * DM + i * 256 + lane * 4);
#pragma unroll
            for (int rr = 0; rr < 4; ++rr) {
                float ss = 0.f;
#pragma unroll
                for (int i = 0; i < 4; ++i) ss += v[rr][i][0] * v[rr][i][0] + v[rr][i][1] * v[rr][i][1] + v[rr][i][2] * v[rr][i][2] + v[rr][i][3] * v[rr][i][3];
                ss = wave_sum_dpp(ss);
                const float rs = rsqrtf(ss * (1.0f / DM) + 1e-6f);
                if (lane == 0) RS[wave * 8 + hb * 4 + rr] = rs;
#pragma unroll
                for (int i = 0; i < 4; ++i) {
                    const f32x4 g = *(const f32x4*)(gain + i * 256 + lane * 4);
                    store_bf4(c.H + (size_t)(r0b + wave * 8 + hb * 4 + rr) * DM + i * 256 + lane * 4, (f32x4){v[rr][i][0] * rs * g[0], v[rr][i][1] * rs * g[1], v[rr][i][2] * rs * g[2], v[rr][i][3] * rs * g[3]});
                }
            }
        }
        __syncthreads();
        const int tile = wave & 3, kh = wave >> 2, cl = lane & 15, kq = lane >> 4;
        f32x4 acc0 = (f32x4){0.f, 0.f, 0.f, 0.f}, acc1 = acc0, acc2 = acc0;
        {
            const float my_rs = RS[tile * 16 + cl];
            const float* xr = c.out + (size_t)(r0b + tile * 16 + cl) * DM + 4 * kq + kh * 512;
            const float* gr_ = gain + 4 * kq + kh * 512;
            f32x4 xa[4], ga[4];
#pragma unroll
            for (int u = 0; u < 4; ++u) { xa[u] = *(const f32x4*)(xr + u * 16); ga[u] = *(const f32x4*)(gr_ + u * 16); }
#pragma unroll 1
            for (int kb0 = 0; kb0 < 32; kb0 += 4) {
                f32x4 xn[4], gn[4];
                const int kn = (kb0 + 4 < 32) ? kb0 + 4 : kb0;
#pragma unroll
                for (int u = 0; u < 4; ++u) { xn[u] = *(const f32x4*)(xr + (kn + u) * 16); gn[u] = *(const f32x4*)(gr_ + (kn + u) * 16); }
#pragma unroll
                for (int u = 0; u < 4; ++u) {
                    const int kb = kh * 32 + kb0 + u;
                    const f32x4 b0 = *(const f32x4*)(B01 + ((kb * 2 + 0) * 64 + lane) * 4), b1 = *(const f32x4*)(B01 + ((kb * 2 + 1) * 64 + lane) * 4);
                    f32x4 b2 = (f32x4){0.f, 0.f, 0.f, 0.f};
                    if (cl < 4) b2 = *(const f32x4*)(B2 + ((kb * 4 + kq) * 4 + cl) * 4);
#pragma unroll
                    for (int m = 0; m < 4; ++m) {
                        const float am = xa[u][m] * ga[u][m] * my_rs;
                        acc0 = __builtin_amdgcn_mfma_f32_16x16x4f32(am, b0[m], acc0, 0, 0, 0);
                        acc1 = __builtin_amdgcn_mfma_f32_16x16x4f32(am, b1[m], acc1, 0, 0, 0);
                        acc2 = __builtin_amdgcn_mfma_f32_16x16x4f32(am, b2[m], acc2, 0, 0, 0);
                    }
                }
#pragma unroll
                for (int u = 0; u < 4; ++u) { xa[u] = xn[u]; ga[u] = gn[u]; }
            }
        }
        __syncthreads();
        if (kh == 1) { f32x4* pp = (f32x4*)(lds + N2_PART) + (tile * 3) * 64 + lane; pp[0] = acc0; pp[64] = acc1; pp[128] = acc2; }
        __syncthreads();
        int ex0 = 0, ex1 = 0, lr0 = 0, lr1 = 0; float w0_ = 0.f, w1_ = 0.f;
        if (kh == 0) {
            const f32x4* pp = (const f32x4*)(lds + N2_PART) + (tile * 3) * 64 + lane;
            acc0 += pp[0]; acc1 += pp[64]; acc2 += pp[128];
            float* lg = (float*)(lds + N2_LG) + tile * 16 * 36;
#pragma unroll
            for (int i = 0; i < 4; ++i) { const int row = 4 * kq + i; lg[row * 36 + cl] = acc0[i]; lg[row * 36 + 16 + cl] = acc1[i]; if (cl < 4) lg[row * 36 + 32 + cl] = acc2[i]; }
            LDS_WAVE_SYNC();
            if (lane < 16) {
                const float* L = lg + lane * 36;
                float lgp[4];
#pragma unroll
                for (int o = 0; o < 4; ++o) lgp[o] = L[32 + o] + brg[o];
                int grp = 0; float gm = lgp[0];
#pragma unroll
                for (int o = 1; o < 4; ++o) if (lgp[o] > gm) { gm = lgp[o]; grp = o; }
                float gs = 0.f;
#pragma unroll
                for (int o = 0; o < 4; ++o) gs += __expf(lgp[o] - gm);
                const float ptop = 1.0f / gs;
                int i0 = 0; float v0 = -INFINITY; int i1 = 0; float v1 = -INFINITY;
                for (int o = 0; o < 8; ++o) { const float le = L[grp * 8 + o] + bre[grp * 8 + o]; if (le > v0) { v1 = v0; i1 = i0; v0 = le; i0 = o; } else if (le > v1) { v1 = le; i1 = o; } }
                const float e1 = __expf(v1 - v0), inv = 1.0f / (1.0f + e1);
                ex0 = grp * 8 + i0; ex1 = grp * 8 + i1;
                w0_ = inv * ptop; w1_ = e1 * inv * ptop;
                lr0 = (int)atomicAdd(lcnt + ex0, 1u); lr1 = (int)atomicAdd(lcnt + ex1, 1u);
            }
        }
        __syncthreads();
        if (tid < 32) { const unsigned n = lcnt[tid]; lbase[tid] = n ? atomicAdd(cnt + tid, n) : 0u; }
        __syncthreads();
        if (kh == 0 && lane < 16) {
            const int row = r0b + tile * 16 + lane;
            const int q0 = (int)lbase[ex0] + lr0, q1 = (int)lbase[ex1] + lr1;
            int* rt_ = c.ROUTE + (size_t)row * 8;
            rt_[0] = ex0; rt_[1] = ex1; ((float*)rt_)[2] = w0_; ((float*)rt_)[3] = w1_; rt_[4] = q0; rt_[5] = q1;
            int* e0p = c.ENT + ((size_t)ex0 * NT + q0) * 2; e0p[0] = row; ((float*)e0p)[1] = w0_;
            int* e1p = c.ENT + ((size_t)ex1 * NT + q1) * 2; e1p[0] = row; ((float*)e1p)[1] = w1_;
        }
    }
}
DI void moe_tables(const Ctx& c, int* soff, int* stile, int ncol) {
    const unsigned* cnt = c.ctl + CW_CNT + c.l * 32;
    __syncthreads();
    if (TID() == 0) { int s = 0, tt = 0; for (int e = 0; e < 32; ++e) { soff[e] = s; stile[e] = tt; s += (int)cnt[e]; tt += (((int)cnt[e] + 255) >> 8) * ncol; } soff[32] = s; stile[32] = tt; }
    __syncthreads();
}
DI void phase_moe_up(const Ctx& c, unsigned char* lds) {
    int* soff = (int*)(lds + LDS_BYTES - 1024); int* stile = soff + 64;
    moe_tables(c, soff, stile, 2);
    const int total = __builtin_amdgcn_readfirstlane(stile[32]);
    for (int item = blockIdx.x; item < total; item += gridDim.x) {
        int e = 0;
        for (int q = 1; q < 32; ++q) if (stile[q] <= item) e = q;
        e = __builtin_amdgcn_readfirstlane(e);
        const int loc = __builtin_amdgcn_readfirstlane(item - stile[e]), tm = loc >> 1, chf = loc & 1;
        const int p0 = __builtin_amdgcn_readfirstlane(soff[e] + tm * 256), pend = __builtin_amdgcn_readfirstlane(soff[e + 1]);
        GatherRows gr; gr.ent = c.ENT + ((size_t)e * NT + (p0 - soff[e])) * 2; gr.n = pend - p0;
        f32x4 acc[8][4];
#pragma unroll
        for (int a_ = 0; a_ < 8; ++a_)
#pragma unroll
            for (int b_ = 0; b_ < 4; ++b_) acc[a_][b_] = (f32x4){0.f, 0.f, 0.f, 0.f};
        gemm256_dma(acc, c.H, DM, (const bf16_t*)(c.ws + WS_EG) + ((size_t)e * 256 + chf * 128) * DM, DM, DM, lds, &gr, (unsigned)((WS_EU - WS_EG) - (size_t)128 * DM * 2));
        const int lane = TID() & 63, wave = TID() >> 6, wm = wave >> 2, wn = wave & 3;
#pragma unroll
        for (int mi = 0; mi < 8; ++mi)
#pragma unroll
            for (int ni = 0; ni < 2; ++ni) {
                const int r = R256(mi), cc = C256(ni);
                const f32x4 g4 = acc[mi][ni], u4 = acc[mi][ni + 2];
                if (p0 + r < pend) store_bf4(c.HID + (size_t)(p0 + r) * 256 + chf * 128 + cc,
                    (f32x4){g4[0] * sigmoidf_(g4[0]) * u4[0], g4[1] * sigmoidf_(g4[1]) * u4[1], g4[2] * sigmoidf_(g4[2]) * u4[2], g4[3] * sigmoidf_(g4[3]) * u4[3]});
            }
    }
    {
        const int G = gridDim.x, first = (total > G && total <= 2 * G) ? total - G : 0;
        const int li = (int)blockIdx.x - first, nl = G - first;
        if (li >= 0) for (int it = li * 4; it < 2048; it += nl * 4) { const int e = (it >> 6) & 31, tl = it & 63;
            convert_tile4(c.in(I_ED) + ((size_t)c.l * 32 + e) * 256 * DM, DM, DM, 256, (bf16_t*)(c.ws + WS_ED) + (size_t)e * DM * 256, tl, lds); }
    }
}
DI void phase_moe_down(const Ctx& c, unsigned char* lds) {
    int* soff = (int*)(lds + LDS_BYTES - 1024); int* stile = soff + 64;
    moe_tables(c, soff, stile, 4);
    const int total = __builtin_amdgcn_readfirstlane(stile[32]);
    for (int item = blockIdx.x; item < total; item += gridDim.x) {
        int e = 0;
        for (int q = 1; q < 32; ++q) if (stile[q] <= item) e = q;
        e = __builtin_amdgcn_readfirstlane(e);
        const int loc = __builtin_amdgcn_readfirstlane(item - stile[e]), tm = loc >> 2, tn = loc & 3, n0 = tn * 256;
        const int p0 = __builtin_amdgcn_readfirstlane(soff[e] + tm * 256), pend = __builtin_amdgcn_readfirstlane(soff[e + 1]);
        f32x4 acc[8][4];
#pragma unroll
        for (int a_ = 0; a_ < 8; ++a_)
#pragma unroll
            for (int b_ = 0; b_ < 4; ++b_) acc[a_][b_] = (f32x4){0.f, 0.f, 0.f, 0.f};
        gemm256_dma(acc, c.HID + (size_t)p0 * 256, 256, (const bf16_t*)(c.ws + WS_ED) + ((size_t)e * DM + n0) * 256, 256, 256, lds);
        const int lane = TID() & 63, wave = TID() >> 6, wm = wave >> 2, wn = wave & 3;
        const float* wl = (const float*)c.ENT + ((size_t)e * NT + (p0 - soff[e])) * 2 + 1;
#pragma unroll
        for (int mi = 0; mi < 8; ++mi)
#pragma unroll
            for (int ni = 0; ni < 4; ++ni) {
                const int r = R256(mi), cc = C256(ni);
                if (p0 + r < pend) { const float w = wl[2 * r];
                    store_bf4(c.Y + (size_t)(p0 + r) * DM + n0 + cc, (f32x4){acc[mi][ni][0] * w, acc[mi][ni][1] * w, acc[mi][ni][2] * w, acc[mi][ni][3] * w}); }
            }
    }
}
DI void phase_final(const Ctx& c, unsigned char* lds) {
    const int tid = TID(), lane = tid & 63, wave = tid >> 6;
    const float* gain = c.in(I_NFIN);
    int* soff = (int*)(lds + 65536);
    moe_offsets(c, DEPTH - 1, soff);
    for (int row = blockIdx.x * 8 + wave; row < NT; row += gridDim.x * 8) {
        f32x4 v[4];
#pragma unroll
        for (int i = 0; i < 4; ++i) v[i] = *(const f32x4*)(c.out + (size_t)row * DM + i * 256 + lane * 4);
        add_moe_rows(c, row, lane, v, soff);
        float ss = 0.f;
#pragma unroll
        for (int i = 0; i < 4; ++i) ss += v[i][0] * v[i][0] + v[i][1] * v[i][1] + v[i][2] * v[i][2] + v[i][3] * v[i][3];
        ss = wave_sum_dpp(ss);
        const float rs = rsqrtf(ss * (1.0f / DM) + 1e-6f);
#pragma unroll
        for (int i = 0; i < 4; ++i) {
            const f32x4 g = *(const f32x4*)(gain + i * 256 + lane * 4);
            *(f32x4*)(c.out + (size_t)row * DM + i * 256 + lane * 4) = (f32x4){v[i][0] * rs * g[0], v[i][1] * rs * g[1], v[i][2] * rs * g[2], v[i][3] * rs * g[3]};
        }
    }
}

constexpr int PH_PER_LAYER = 11, N_PHASES = DEPTH * PH_PER_LAYER + 1;
__global__ void __launch_bounds__(NTHREADS, 2) fwd_kernel(Params P) {
    extern __shared__ __attribute__((aligned(16))) unsigned char lds[];
    const int lo = P.ph_lo, hi = P.ph_hi;
    LAS unsigned* xbw = (LAS unsigned*)(lds + LDS_BYTES - 16);
    if (threadIdx.x == 0) { xbw[0] = 0u; xbw[1] = 0u; xbw[2] = 0u; xbw[3] = 0u; }
    __syncthreads();
    Ctx c; c.P = &P; c.ws = P.ws; c.out = P.out; c.l = 0;
    c.ctl = (unsigned*)(P.ws + WS_CTL);
    c.H = (bf16_t*)(P.ws + WS_H); c.PROJ = (bf16_t*)(P.ws + WS_PROJ); c.F = (bf16_t*)(P.ws + WS_F); c.POOLED = (bf16_t*)(P.ws + WS_POOLED);
    c.MERGED = (bf16_t*)(P.ws + WS_F); c.CMPH = (bf16_t*)(P.ws + WS_CMPH); c.CMPO = (float*)(P.ws + WS_CMPO); c.POSB = (float*)(P.ws + WS_POSB);
    c.ROUTE = (int*)(P.ws + WS_ROUTE); c.ENT = (int*)(P.ws + WS_ENT); c.HID = (bf16_t*)(P.ws + WS_HID); c.Y = (bf16_t*)(P.ws + WS_Y);
    c.VT = (bf16_t*)(P.ws + WS_VT); c.KC = (bf16_t*)(P.ws + WS_KC); c.VCT = (bf16_t*)(P.ws + WS_VCT); c.YRAW = (bf16_t*)(P.ws + WS_YRAW); c.BON = (float*)(P.ws + WS_BON);
    XcdBarrier bar; bar.bar = c.ctl + CW_BAR; bar.x = 0; bar.st = (volatile LAS unsigned*)xbw;
    if (hi - lo > 1) bar = xcd_barrier_post(c.ctl + CW_BAR, (volatile LAS unsigned*)xbw);
#define IN(k) (lo <= (k) && (k) < hi)
#define SEAM(k) do { if (IN(k) && IN((k) + 1)) xcd_barrier(bar); } while (0)
#pragma unroll 1
    for (int l = 0; l < DEPTH; ++l) {
        c.l = l; const int pb = l * PH_PER_LAYER;
        if (IN(pb + 0)) phase_norm1(c, lds);
        SEAM(pb + 0);
        if (IN(pb + 1)) phase_gemm1(c, lds);
        SEAM(pb + 1);
        if (IN(pb + 2)) phase_prep(c, lds);
        SEAM(pb + 2);
        if (IN(pb + 3)) phase_poolgemm(c, lds);
        SEAM(pb + 3);
        if (IN(pb + 4)) phase_mix(c, lds);
        SEAM(pb + 4);
        if (IN(pb + 5)) phase_rwkv_post(c, lds);
        SEAM(pb + 5);
        if (IN(pb + 6)) phase_merge(c, lds);
        SEAM(pb + 6);
        if (IN(pb + 7)) phase_outp(c, lds);
        SEAM(pb + 7);
        if (IN(pb + 8)) phase_norm2(c, lds);
        SEAM(pb + 8);
        if (IN(pb + 9)) phase_moe_up(c, lds);
        SEAM(pb + 9);
        if (IN(pb + 10)) phase_moe_down(c, lds);
        SEAM(pb + 10);
    }
    if (IN(N_PHASES - 1)) phase_final(c, lds);
}

#ifndef MK_N_LAUNCHES
#define MK_N_LAUNCHES 1
#endif
extern "C" void kernel_launch(void* const* d_in, const int* in_sizes, int n_in, void* d_out, int out_size, void* d_ws, size_t ws_size, hipStream_t stream) {
    static int grid = 0;
    if (grid == 0) {
        if (n_in != N_IN || out_size != NT * DM || ws_size < WS_END) { fprintf(stderr, "kernel_launch: unexpected shapes n_in %d out %d ws %zu (need %zu)\n", n_in, out_size, ws_size, (size_t)WS_END); grid = -1; return; }
        int dev = 0, cus = 0, per_cu = 0;
        if (hipGetDevice(&dev) != hipSuccess || hipDeviceGetAttribute(&cus, hipDeviceAttributeMultiprocessorCount, dev) != hipSuccess) { grid = -1; return; }
        if (hipFuncSetAttribute((const void*)fwd_kernel, hipFuncAttributeMaxDynamicSharedMemorySize, LDS_BYTES) != hipSuccess) { fprintf(stderr, "kernel_launch: hipFuncSetAttribute failed\n"); grid = -1; return; }
        if (hipOccupancyMaxActiveBlocksPerMultiprocessor(&per_cu, (const void*)fwd_kernel, NTHREADS, LDS_BYTES) != hipSuccess || per_cu < 1) { fprintf(stderr, "kernel_launch: occupancy query says %d\n", per_cu); }
        (void)hipGetLastError();
        grid = cus;
    }
    if (grid < 0) return;
    if (hipMemsetAsync((char*)d_ws + WS_CTL, 0, CTL_BYTES, stream) != hipSuccess) return;
    Params p{};
    for (int i = 0; i < N_IN; ++i) p.in[i] = (const float*)d_in[i];
    p.out = (float*)d_out; p.ws = (unsigned char*)d_ws;
    if (MK_N_LAUNCHES == 1) {
        p.ph_lo = 0; p.ph_hi = N_PHASES;
        hipLaunchKernelGGL(fwd_kernel, dim3(grid), dim3(NTHREADS), LDS_BYTES, stream, p);
    } else {
        for (int k = 0; k < N_PHASES; ++k) { p.ph_lo = k; p.ph_hi = k + 1; hipLaunchKernelGGL(fwd_kernel, dim3(grid), dim3(NTHREADS), LDS_BYTES, stream, p); }
    }
}
```

```cpp
#include <hip/hip_runtime.h>
#include <cstdio>
#include <cstdint>

#define DI __device__ __forceinline__
typedef unsigned short bf16_t;
typedef short bf16x8 __attribute__((ext_vector_type(8)));
typedef float f32x4 __attribute__((ext_vector_type(4)));
typedef unsigned u32x4 __attribute__((ext_vector_type(4)));
typedef unsigned u32x2 __attribute__((ext_vector_type(2)));

constexpr int NB = 4, SEQ = 4096, DM = 1024, NT = NB * SEQ, DEPTH = 2;
constexpr int IN_COLS = 4816;
constexpr int C_POOL = 0, C_RW = 512, C_R = 512, C_K = 1024, C_V = 1536, C_WD = 2048, C_AD = 2080, C_GD = 2112;
constexpr int C_Q = 2208, C_KC = 3232, C_VC = 3488, C_KS = 3744, C_VS = 4000, C_KW = 4256, C_VW = 4512, C_GATE = 4768;
constexpr int RWC = 1696;
constexpr int NCMP = 255;
constexpr int NTHREADS = 512;
constexpr int LDS_BYTES = 155648;

enum { I_X = 0, I_RELB, I_NMIX, I_WIN, I_POOLW, I_POOLS, I_MU, I_W0, I_WUP, I_A0, I_AUP, I_GUP, I_KK, I_KA, I_RK, I_GNW, I_GNB,
       I_CPK, I_CW1K, I_CW2K, I_CPV, I_CW1V, I_CW2V, I_WBR, I_WMG, I_BMG, I_WOUT, I_NFFN, I_WRG, I_BRG, I_WRE, I_BRE, I_EG, I_EU, I_ED, I_NFIN, N_IN };

constexpr size_t WS_CTL = 0;
constexpr size_t CTL_BYTES = 65536;
constexpr size_t WS_H = CTL_BYTES;
constexpr size_t WS_PROJ = WS_H + (size_t)NT * DM * 2;
constexpr size_t WS_F = WS_PROJ + (size_t)NT * IN_COLS * 2;
constexpr size_t PLANE = (size_t)NT * 512 * 2;
constexpr size_t WS_POOLED = WS_F + 6 * PLANE;
constexpr size_t WS_CMPH = WS_POOLED + PLANE;
constexpr size_t WS_CMPO = WS_CMPH + (size_t)2 * 4096 * 256 * 2;
constexpr size_t WS_POSB = WS_CMPO + (size_t)2 * 4096 * 64 * 4;
constexpr size_t WS_ROUTE = WS_POSB + 4096;
constexpr size_t WS_ENT = WS_ROUTE + (size_t)NT * 32;
constexpr size_t WS_VT = WS_ENT + (size_t)32 * NT * 8;
constexpr size_t WS_KC = WS_VT + (size_t)2 * 16 * 64 * SEQ * 2;
constexpr size_t WS_VCT = WS_KC + (size_t)16 * 256 * 64 * 2;
constexpr size_t WS_YRAW = WS_VCT + (size_t)16 * 64 * 256 * 2;
constexpr size_t WS_BON = WS_YRAW + (size_t)NT * 512 * 2;
constexpr size_t WS_SMALLW = WS_BON + (size_t)NT * 8 * 16;
constexpr size_t WS_WT_LORA = WS_SMALLW + 262144;
constexpr size_t WS_TG = WS_WT_LORA + (size_t)1536 * 128 * 2;
constexpr size_t WS_END = WS_TG + (size_t)NB * 8 * 128 * 32 * 32 * 2;
constexpr size_t WS_WT_IN = WS_F;
constexpr size_t WS_WT_C1 = WS_CMPO;
constexpr size_t WS_WT_C2 = WS_SMALLW;
constexpr size_t WS_WT_POOL = WS_SMALLW + 131072;
constexpr size_t WS_WT_MG = WS_VT;
constexpr size_t WS_WT_BR = WS_VT + (size_t)3072 * 1024 * 2;
constexpr size_t WS_WT_OUT = WS_CMPH;
constexpr size_t WS_EG = WS_F + 2 * PLANE;
constexpr size_t WS_EU = WS_EG + (size_t)32 * 256 * 1024 * 2;
constexpr size_t WS_ED = WS_EU + (size_t)32 * 256 * 1024 * 2;
static_assert(WS_ED + (size_t)32 * 1024 * 256 * 2 <= WS_F + 6 * PLANE, "expert alias");
static_assert(WS_WT_BR + (size_t)2048 * 1024 * 2 <= WS_VT + (size_t)2 * 16 * 64 * SEQ * 2, "merge alias");
static_assert((size_t)4864 * 1024 * 2 <= 6 * PLANE, "w_in alias");
constexpr size_t WS_HID = WS_PROJ;
constexpr size_t WS_Y = WS_PROJ + (size_t)2 * NT * 256 * 2;
static_assert(WS_Y + (size_t)2 * NT * 1024 * 2 <= WS_F, "alias");
constexpr int CW_BAR = 0;
constexpr int CW_CNT = 4096;
constexpr int CW_CUR = 4096 + 64;
constexpr int CW_Q = 4096 + 128;

#define XB_TMO      128
#define XB_XCNT(j)  (256  + 64 * (j))
#define XB_XSUB(j)  (1280 + 64 * (j))
#define XB_XGEN(j)  (2304 + 64 * (j))
#define XB_TOP      3328
#define XB_TOPGEN   3392
#define XCD_BAR_WORDS 3456
#define XB_SPIN_CAP (1u << 18)
#define LAS __attribute__((address_space(3)))

__device__ __forceinline__ unsigned xb_ld(unsigned* p)              { return __hip_atomic_load(p, __ATOMIC_RELAXED, __HIP_MEMORY_SCOPE_AGENT); }
__device__ __forceinline__ unsigned xb_add(unsigned* p, unsigned v) { return __hip_atomic_fetch_add(p, v, __ATOMIC_RELAXED, __HIP_MEMORY_SCOPE_AGENT); }
__device__ __forceinline__ unsigned xb_xcc_id() { return (unsigned)__builtin_amdgcn_s_getreg((3 << 11) | 20) & 0xFu; }
#define XB_SPIN(cond, bar) do { unsigned _sp = 0; while (cond) { __builtin_amdgcn_s_sleep(1); \
    if ((++_sp & 255u) == 0u) { if (xb_ld(&(bar)[XB_TMO])) break; if (_sp > XB_SPIN_CAP) { atomicAdd(&(bar)[XB_TMO], 1u); break; } } } } while (0)

struct XcdBarrier { unsigned* bar; unsigned x; volatile LAS unsigned* st; };

__device__ __forceinline__ XcdBarrier xcd_barrier_post(unsigned* bar, volatile LAS unsigned* st) {
    XcdBarrier b; b.bar = bar; b.x = xb_xcc_id(); b.st = st;
    if (threadIdx.x == 0) (void)xb_add(&bar[XB_XCNT(b.x)], 1u);
    return b;
}
__device__ __forceinline__ void xcd_barrier_complete(unsigned* bar, unsigned x, unsigned& nloc, unsigned& nx) {
    const unsigned G = gridDim.x * gridDim.y * gridDim.z;
    unsigned sum, cnt, mine, sp = 0u;
    for (;;) {
        sum = 0u; cnt = 0u; mine = 0u;
#pragma unroll
        for (unsigned j = 0; j < 16; ++j) { const unsigned c = xb_ld(&bar[XB_XCNT(j)]); sum += c; cnt += (c > 0u) ? 1u : 0u; mine = (j == x) ? c : mine; }
        if (sum == G) break;
        __builtin_amdgcn_s_sleep(1);
        if ((++sp & 255u) == 0u) { if (xb_ld(&bar[XB_TMO])) break; if (sp > XB_SPIN_CAP) { atomicAdd(&bar[XB_TMO], 1u); break; } }
    }
    nloc = mine > 0u ? mine : 1u; nx = cnt > 0u ? cnt : 1u;
}
__device__ __forceinline__ void xcd_barrier(const XcdBarrier& b) {
    asm volatile("s_waitcnt vmcnt(0)" ::: "memory");
    __syncthreads();
    if (threadIdx.x == 0) {
        unsigned* bar = b.bar;
        __builtin_amdgcn_s_waitcnt(0);
        unsigned nloc = b.st[0], nx = b.st[1];
        if (nloc == 0u) { xcd_barrier_complete(bar, b.x, nloc, nx); b.st[0] = nloc; b.st[1] = nx; }
        const unsigned old = xb_add(&bar[XB_XSUB(b.x)], 1u);
        const unsigned gen = old / nloc;
        if (old + 1u == (gen + 1u) * nloc) {
            __builtin_amdgcn_fence(__ATOMIC_RELEASE, "agent");
            asm volatile("s_waitcnt vmcnt(0)" ::: "memory");
            const unsigned og = xb_add(&bar[XB_TOP], 1u);
            const unsigned tg = og / nx;
            if (og + 1u == (tg + 1u) * nx) xb_add(&bar[XB_TOPGEN], 1u);
            else XB_SPIN(xb_ld(&bar[XB_TOPGEN]) == tg, bar);
            __builtin_amdgcn_fence(__ATOMIC_ACQUIRE, "agent");
            xb_add(&bar[XB_XGEN(b.x)], 1u);
            asm volatile("s_waitcnt vmcnt(0)" ::: "memory");
        } else {
            XB_SPIN(xb_ld(&bar[XB_XGEN(b.x)]) == gen, bar);
            __builtin_amdgcn_fence(__ATOMIC_ACQUIRE, "agent");
            asm volatile("s_waitcnt vmcnt(0)" ::: "memory");
        }
    }
    __syncthreads();
}

DI float bf2f(bf16_t b) { return __uint_as_float((unsigned)b << 16); }
typedef __bf16 bf16v2_t __attribute__((ext_vector_type(2)));
typedef float f32v2_t __attribute__((ext_vector_type(2)));
DI unsigned pack2(float lo, float hi) { const f32v2_t v = {lo, hi}; const bf16v2_t b = __builtin_convertvector(v, bf16v2_t); return __builtin_bit_cast(unsigned, b); }
DI bf16_t f2bf(float x) { return (bf16_t)pack2(x, x); }
DI float bflo(unsigned w) { return __uint_as_float(w << 16); }
DI float bfhi(unsigned w) { return __uint_as_float(w & 0xffff0000u); }
DI float wave_sum(float v) {
#pragma unroll
    for (int o = 32; o >= 1; o >>= 1) v += __shfl_xor(v, o);
    return v;
}
DI float wave_max(float v) {
#pragma unroll
    for (int o = 32; o >= 1; o >>= 1) v = fmaxf(v, __shfl_xor(v, o));
    return v;
}
DI float sigmoidf_(float x) { return __builtin_amdgcn_rcpf(1.0f + __expf(-x)); }
DI int TID() { int t = threadIdx.x; asm volatile("" : "+v"(t)); return t; }
#define LDS_WAVE_SYNC() asm volatile("s_waitcnt lgkmcnt(0)" ::: "memory")

#define DPP_MOV(v, ctrl) __builtin_bit_cast(float, __builtin_amdgcn_update_dpp(0, __builtin_bit_cast(int, (v)), (ctrl), 0xF, 0xF, true))
DI float wave_sum_dpp(float v) {
    v += DPP_MOV(v, 0xB1); v += DPP_MOV(v, 0x4E); v += DPP_MOV(v, 0x141); v += DPP_MOV(v, 0x140);
    return __builtin_bit_cast(float, __builtin_amdgcn_readlane(__builtin_bit_cast(int, v), 0)) + __builtin_bit_cast(float, __builtin_amdgcn_readlane(__builtin_bit_cast(int, v), 16)) +
        (__builtin_bit_cast(float, __builtin_amdgcn_readlane(__builtin_bit_cast(int, v), 32)) + __builtin_bit_cast(float, __builtin_amdgcn_readlane(__builtin_bit_cast(int, v), 48)));
}
DI float wave_max_dpp(float v) {
    v = fmaxf(v, DPP_MOV(v, 0xB1)); v = fmaxf(v, DPP_MOV(v, 0x4E)); v = fmaxf(v, DPP_MOV(v, 0x141)); v = fmaxf(v, DPP_MOV(v, 0x140));
    return fmaxf(fmaxf(__builtin_bit_cast(float, __builtin_amdgcn_readlane(__builtin_bit_cast(int, v), 0)), __builtin_bit_cast(float, __builtin_amdgcn_readlane(__builtin_bit_cast(int, v), 16))),
                 fmaxf(__builtin_bit_cast(float, __builtin_amdgcn_readlane(__builtin_bit_cast(int, v), 32)), __builtin_bit_cast(float, __builtin_amdgcn_readlane(__builtin_bit_cast(int, v), 48))));
}
struct Params { const float* in[N_IN]; float* out; unsigned char* ws; int ph_lo, ph_hi; };

DI int t5_bucket(int n) {
    if (n < 16) return n;
    if (n >= 128) return 31;
    int b = 16;
    b += (n >= 19) + (n >= 21) + (n >= 24) + (n >= 27) + (n >= 31) + (n >= 35) + (n >= 40) + (n >= 46) + (n >= 52) + (n >= 59) + (n >= 67) + (n >= 77) + (n >= 87) + (n >= 99) + (n >= 113);
    return b;
}

constexpr int G_A = 0, G_B = 256 * 64 * 2, G_STAGE = (256 + 128) * 64 * 2;
static_assert(2 * G_STAGE <= LDS_BYTES - 64, "gemm lds");
DI int g_off(int r, int c) { return ((r >> 4) * 2 + (c >> 5)) * 1024 + ((((r & 15) * 64) + (c & 31) * 2) ^ ((((r & 15) >> 3) & 1) << 5)); }
struct ARows { const bf16_t* p[4]; const float* mu; int ltype; int first; };
DI float tanhf_fast(float x) { const float e = __expf(2.0f * x); return 1.0f - 2.0f * __builtin_amdgcn_rcpf(e + 1.0f); }
DI u32x4 lora_chunk(const bf16_t* prow, bool first, const float* mu, int ltype, int k) {
    const int lim = (ltype == 2) ? 96 : 32;
    if (k >= lim) return (u32x4){0u, 0u, 0u, 0u};
    const int col = C_WD + ltype * 32 + k;
    const u32x4 cu = *(const u32x4*)(prow + col);
    u32x4 pu = (u32x4){0u, 0u, 0u, 0u};
    if (!first) pu = *(const u32x4*)(prow - IN_COLS + col);
    const f32x4 m0 = *(const f32x4*)(mu + col - C_RW), m1 = *(const f32x4*)(mu + col - C_RW + 4);
    float u[8] = {bflo(cu.x), bfhi(cu.x), bflo(cu.y), bfhi(cu.y), bflo(cu.z), bfhi(cu.z), bflo(cu.w), bfhi(cu.w)};
    const float p[8] = {bflo(pu.x), bfhi(pu.x), bflo(pu.y), bfhi(pu.y), bflo(pu.z), bfhi(pu.z), bflo(pu.w), bfhi(pu.w)};
    const float mm[8] = {m0[0], m0[1], m0[2], m0[3], m1[0], m1[1], m1[2], m1[3]};
#pragma unroll
    for (int j = 0; j < 8; ++j) { const float us = u[j] + (p[j] - u[j]) * mm[j]; u[j] = (ltype == 0) ? tanhf_fast(us) : ((ltype == 1) ? us : __builtin_amdgcn_rcpf(1.0f + __expf(-us))); }
    u32x4 w; w.x = pack2(u[0], u[1]); w.y = pack2(u[2], u[3]); w.z = pack2(u[4], u[5]); w.w = pack2(u[6], u[7]);
    return w;
}
template <int AMODE>
DI void g_load(u32x4 (&ra)[4], u32x4 (&rb)[2], const ARows& ar, const bf16_t* bt, int ldb, int k0, int tid) {
    const int kseg = (tid & 7) * 8;
#pragma unroll
    for (int i = 0; i < 4; ++i) {
        ra[i] = (u32x4){0u, 0u, 0u, 0u};
        if (AMODE == 2) ra[i] = lora_chunk(ar.p[i], (ar.first >> i) & 1, ar.mu, ar.ltype, k0 + kseg);
        else if (ar.p[i] != nullptr) ra[i] = *(const u32x4*)((AMODE == 0) ? (ar.p[i] + k0 + kseg) : (ar.p[i] + (size_t)(k0 >> 6) * IN_COLS + kseg));
    }
#pragma unroll
    for (int i = 0; i < 2; ++i) rb[i] = *(const u32x4*)(bt + (size_t)((tid >> 3) + 64 * i) * ldb + k0 + kseg);
}
DI void g_store(unsigned char* st, const u32x4 (&ra)[4], const u32x4 (&rb)[2], int tid) {
    const int off = g_off(tid >> 3, (tid & 7) * 8);
#pragma unroll
    for (int i = 0; i < 4; ++i) *(u32x4*)(st + G_A + off + i * 8192) = ra[i];
#pragma unroll
    for (int i = 0; i < 2; ++i) *(u32x4*)(st + G_B + off + i * 8192) = rb[i];
}
DI void g_compute(f32x4 (&acc)[4][4], const unsigned char* st, int lane, int wm, int wn) {
    const int lo = ((lane & 15) * 64 + (lane >> 4) * 16) ^ ((((lane & 15) >> 3) & 1) << 5);
    const unsigned char* sA = st + G_A + wm * 8192 + lo;
    const unsigned char* sB = st + G_B + wn * 8192 + lo;
    bf16x8 bcur[4], bnxt[4], a0, a1, a2;
#pragma unroll
    for (int i = 0; i < 4; ++i) bcur[i] = *(const bf16x8*)(sB + i * 2048);
    a0 = *(const bf16x8*)(sA);
    a1 = *(const bf16x8*)(sA + 2048);
#define G_AFRAG(s) (*(const bf16x8*)(sA + ((s) & 3) * 2048 + ((s) >> 2) * 1024))
#define G_GROUP(s, acur, anew) do { \
        if ((s) + 2 < 8) anew = G_AFRAG((s) + 2); \
        if ((s) < 4) bnxt[(s) & 3] = *(const bf16x8*)(sB + ((s) & 3) * 2048 + 1024); \
        __builtin_amdgcn_sched_barrier(0); \
        _Pragma("unroll") for (int ni = 0; ni < 4; ++ni) acc[(s) & 3][ni] = __builtin_amdgcn_mfma_f32_16x16x32_bf16(((s) < 4 ? bcur[ni] : bnxt[ni]), acur, acc[(s) & 3][ni], 0, 0, 0); \
        __builtin_amdgcn_sched_barrier(0); } while (0)
    G_GROUP(0, a0, a2); G_GROUP(1, a1, a0); G_GROUP(2, a2, a1); G_GROUP(3, a0, a2);
    G_GROUP(4, a1, a0); G_GROUP(5, a2, a1); G_GROUP(6, a0, a2); G_GROUP(7, a1, a0);
#undef G_GROUP
#undef G_AFRAG
}
#define LDS_BARRIER() do { asm volatile("s_waitcnt lgkmcnt(0)" ::: "memory"); __builtin_amdgcn_s_barrier(); asm volatile("" ::: "memory"); } while (0)
template <int AMODE>
DI void gemm_core(f32x4 (&acc)[4][4], const ARows& ar, const bf16_t* bt  , int ldb, int K, unsigned char* lds) {
    const int tid = TID(), lane = tid & 63, wave = tid >> 6, wm = wave >> 1, wn = wave & 1;
    const int nk = K >> 6;
    unsigned char* s0 = lds; unsigned char* s1 = lds + G_STAGE;
    u32x4 ra0[4], rb0[2], ra1[4], rb1[2];
    g_load<AMODE>(ra0, rb0, ar, bt, ldb, 0, tid);
    g_load<AMODE>(ra1, rb1, ar, bt, ldb, 64, tid);
    __syncthreads();
    g_store(s0, ra0, rb0, tid);
    g_load<AMODE>(ra0, rb0, ar, bt, ldb, (nk > 2 ? 2 : nk - 1) * 64, tid);
    LDS_BARRIER();
    for (int kt = 0; kt < nk; kt += 2) {
        g_store(s1, ra1, rb1, tid);
        { const int kn = (kt + 3 < nk) ? kt + 3 : nk - 1; g_load<AMODE>(ra1, rb1, ar, bt, ldb, kn * 64, tid); }
        g_compute(acc, s0, lane, wm, wn);
        LDS_BARRIER();
        g_store(s0, ra0, rb0, tid);
        { const int kn = (kt + 4 < nk) ? kt + 4 : nk - 1; g_load<AMODE>(ra0, rb0, ar, bt, ldb, kn * 64, tid); }
        g_compute(acc, s1, lane, wm, wn);
        LDS_BARRIER();
    }
}
static_assert(3 * G_STAGE <= LDS_BYTES - 64, "dma ring");
DI void gemm_core_dma(f32x4 (&acc)[4][4], const bf16_t* A, size_t lda, const bf16_t* bt, size_t ldb, int K, unsigned char* lds) {
    const int tid = TID(), lane = tid & 63, wave = __builtin_amdgcn_readfirstlane(tid >> 6), wm = wave >> 1, wn = wave & 1;
    const int nk = K >> 6;
    const int srow = lane >> 2, skof = ((lane & 3) * 8) ^ ((lane >> 5) << 4);
    const char* gp[6]; int loff[6];
#pragma unroll
    for (int j = 0; j < 6; ++j) {
        const int sid = wave * 6 + j;
        if (sid < 32) { gp[j] = (const char*)(A + (size_t)((sid >> 1) * 16 + srow) * lda + (sid & 1) * 32 + skof); loff[j] = G_A + sid * 1024; }
        else { const int s2 = sid - 32; gp[j] = (const char*)(bt + (size_t)((s2 >> 1) * 16 + srow) * ldb + (s2 & 1) * 32 + skof); loff[j] = G_B + s2 * 1024; }
    }
#define DMA_ISSUE(kt_, st_) do { const int _k = ((kt_) < nk ? (kt_) : nk - 1) * 128; \
        _Pragma("unroll") for (int j = 0; j < 6; ++j) __builtin_amdgcn_global_load_lds((const unsigned*)(gp[j] + _k), (LAS unsigned*)(lds + (st_) * G_STAGE + loff[j]), 16, 0, 0); } while (0)
    asm volatile("s_waitcnt vmcnt(0)" ::: "memory");
    __syncthreads();
    DMA_ISSUE(0, 0); DMA_ISSUE(1, 1);
    int st = 0;
    for (int kt = 0; kt < nk; ++kt) {
        asm volatile("s_waitcnt vmcnt(6)" ::: "memory");
        __builtin_amdgcn_s_barrier();
        asm volatile("" ::: "memory");
        const int sn = (st == 0) ? 2 : st - 1;
        DMA_ISSUE(kt + 2, sn);
        g_compute(acc, lds + st * G_STAGE, lane, wm, wn);
        st = (st == 2) ? 0 : st + 1;
    }
    asm volatile("s_waitcnt vmcnt(0)" ::: "memory");
    __syncthreads();
#undef DMA_ISSUE
}
DI void store_bf4(bf16_t* p, f32x4 v) { u32x2 w; w.x = pack2(v[0], v[1]); w.y = pack2(v[2], v[3]); *(u32x2*)p = w; }
#define R256(mi) ((((mi) >> 2) * 128) + wm * 64 + (((mi) & 3) * 16) + (lane & 15))
#define C256(ni) ((((ni) >> 1) * 128) + wn * 32 + (((ni) & 1) * 16) + ((lane >> 4) * 4))
#define C256P(ni) ((((ni) >> 1) * 128) + wn * 32 + (((ni) & 1) * 4) + ((lane >> 4) * 8))
constexpr int HTB = 128 * 64 * 2;
static_assert(8 * HTB <= LDS_BYTES - 1024, "gemm256 lds");
DI int lds_byte(int r, int c) { const int st = (r >> 4) * 2 + (c >> 5), rr = r & 15, cc = c & 31, ob = rr * 64 + cc * 2; return st * 1024 + (ob ^ (((ob >> 9) & 1) << 5)); }
DI void stage_rc(int b, int& R, int& C) { const int st = b / 1024, sb = b % 1024, swz = sb ^ (((sb >> 9) & 1) << 5); R = (st >> 1) * 16 + swz / 64; C = (st & 1) * 32 + (swz % 64) / 2; }
struct GatherRows { const int* ent; int n; };
DI void gemm256_dma(f32x4 (&acc)[8][4], const bf16_t* A, size_t lda, const bf16_t* bt, size_t ldb, int K, unsigned char* lds_, const GatherRows* gr = nullptr, unsigned bhalf_extra = 0u, bool perm = false,
                    int stream = 0  , const bf16_t* nA = nullptr, const bf16_t* nB = nullptr  ) {
    LAS unsigned char* lds = (LAS unsigned char*)lds_;
    const int tid = TID(), wid = __builtin_amdgcn_readfirstlane(tid >> 6), lane = tid & 63, wr = wid >> 2, wc = wid & 3, fr = lane & 15, fq = lane >> 4;
    const int nt = K >> 6;
    unsigned voffA[2][2], voffB[2][2];
#pragma unroll
    for (int i = 0; i < 2; ++i) { int R, C; stage_rc(tid * 16 + i * 8192, R, C);
#pragma unroll
        for (int h = 0; h < 2; ++h) { const int row = h * 128 + R;
            size_t ra = (size_t)row;
            if (gr != nullptr) ra = (size_t)((row < gr->n) ? gr->ent[2 * row] : 0);
            const int rb = perm ? ((row & ~31) + 8 * ((row & 15) >> 2) + 4 * ((row >> 4) & 1) + (row & 3)) : row;
            voffA[h][i] = (unsigned)((ra * lda + C) * 2); voffB[h][i] = (unsigned)(((size_t)rb * ldb + C) * 2) + (h ? bhalf_extra : 0u); } }
    const unsigned ldsw = (unsigned)wid * 1024u;
    const int aoff = lds_byte(wr * 64 + fr, fq * 8), boff = lds_byte(wc * 32 + fr, fq * 8);
#define PG8_SA(b, h) (((b) * 2 + (h)) * HTB)
#define PG8_SB(b, h) ((4 + (b) * 2 + (h)) * HTB)
#define PG8_STAGE(bufoff, gbase, voff) do { _Pragma("unroll") for (int _i = 0; _i < 2; ++_i) \
        __builtin_amdgcn_global_load_lds((const unsigned*)((const char*)(gbase) + (voff)[_i]), (LAS unsigned*)(lds + (bufoff) + ldsw + _i * 8192), 16, 0, 0); } while (0)
#define PG8_LDA(dst, b, h) do { _Pragma("unroll") for (int m = 0; m < 4; ++m) _Pragma("unroll") for (int k = 0; k < 2; ++k) dst[m][k] = *(const LAS bf16x8*)(lds + PG8_SA(b, h) + aoff + m * 2048 + k * 1024); } while (0)
#define PG8_LDB(dst, b, h) do { _Pragma("unroll") for (int n = 0; n < 2; ++n) _Pragma("unroll") for (int k = 0; k < 2; ++k) dst[n][k] = *(const LAS bf16x8*)(lds + PG8_SB(b, h) + boff + n * 2048 + k * 1024); } while (0)
#define PG8_MMA(ai, bj, At, Bt) do { __builtin_amdgcn_s_setprio(1); _Pragma("unroll") for (int m = 0; m < 4; ++m) _Pragma("unroll") for (int n = 0; n < 2; ++n) _Pragma("unroll") for (int k = 0; k < 2; ++k) \
        acc[(ai) * 4 + m][(bj) * 2 + n] = __builtin_amdgcn_mfma_f32_16x16x32_bf16(Bt[n][k], At[m][k], acc[(ai) * 4 + m][(bj) * 2 + n], 0, 0, 0); __builtin_amdgcn_s_setprio(0); } while (0)
#define PG8_WAIT_V(n) asm volatile("s_waitcnt vmcnt(" #n ")" ::: "memory")
#define PG8_WAIT_L(n) asm volatile("s_waitcnt lgkmcnt(" #n ")" ::: "memory")
#define PG8_BAR __builtin_amdgcn_s_barrier()
#define PG8_SCHED __builtin_amdgcn_sched_barrier(0)
    bf16x8 At[4][2], B0[2][2], B1[2][2];
    const char* cA = (const char*)A; const char* cB = (const char*)bt;
    const size_t kstep = 128;
    if (!(stream & 1)) {
    asm volatile("s_waitcnt vmcnt(0)" ::: "memory");
    __syncthreads();
    PG8_STAGE(PG8_SB(0, 0), cB, voffB[0]); PG8_STAGE(PG8_SA(0, 0), cA, voffA[0]); PG8_STAGE(PG8_SB(0, 1), cB, voffB[1]); PG8_STAGE(PG8_SA(0, 1), cA, voffA[1]);
    if (wr == 1) PG8_BAR;
    PG8_WAIT_V(4); PG8_BAR;
    PG8_STAGE(PG8_SB(1, 0), cB + kstep, voffB[0]); PG8_STAGE(PG8_SA(1, 0), cA + kstep, voffA[0]); PG8_STAGE(PG8_SB(1, 1), cB + kstep, voffB[1]);
    PG8_WAIT_V(6); PG8_BAR;
    }
    const char* xA = (stream & 2) ? (const char*)nA : cA; const char* xB = (stream & 2) ? (const char*)nB : cB;
    for (int t = 0; t < nt; t += 2) {
        const bool last = (t == nt - 2);
        const char* a1 = cA + (size_t)(t + 1) * kstep;
        const char* a2 = last ? xA : cA + (size_t)(t + 2) * kstep; const char* b2 = last ? xB : cB + (size_t)(t + 2) * kstep;
        const char* a3 = a2 + kstep; const char* b3 = b2 + kstep;
        PG8_LDB(B0, 0, 0); PG8_SCHED; PG8_LDA(At, 0, 0); PG8_STAGE(PG8_SA(1, 1), a1, voffA[1]);
        PG8_WAIT_L(8); PG8_BAR; PG8_WAIT_L(0); PG8_MMA(0, 0, At, B0); PG8_BAR; PG8_SCHED;
        PG8_LDB(B1, 0, 1); PG8_STAGE(PG8_SB(0, 0), b2, voffB[0]);
        PG8_BAR; PG8_WAIT_L(0); PG8_MMA(0, 1, At, B1); PG8_BAR;
        PG8_LDA(At, 0, 1); PG8_STAGE(PG8_SA(0, 0), a2, voffA[0]);
        PG8_BAR; PG8_WAIT_L(0); PG8_MMA(1, 0, At, B0); PG8_BAR; PG8_SCHED;
        PG8_STAGE(PG8_SB(0, 1), b2, voffB[1]);
        PG8_WAIT_V(6); PG8_BAR; PG8_MMA(1, 1, At, B1); PG8_BAR;
        PG8_LDB(B0, 1, 0); PG8_SCHED; PG8_LDA(At, 1, 0); PG8_STAGE(PG8_SA(0, 1), a2, voffA[1]);
        PG8_WAIT_L(8); PG8_BAR; PG8_WAIT_L(0); PG8_MMA(0, 0, At, B0); PG8_BAR; PG8_SCHED;
        PG8_LDB(B1, 1, 1); PG8_STAGE(PG8_SB(1, 0), b3, voffB[0]);
        PG8_BAR; PG8_WAIT_L(0); PG8_MMA(0, 1, At, B1); PG8_BAR;
        PG8_LDA(At, 1, 1); PG8_STAGE(PG8_SA(1, 0), a3, voffA[0]);
        PG8_BAR; PG8_WAIT_L(0); PG8_MMA(1, 0, At, B0); PG8_BAR; PG8_SCHED;
        PG8_STAGE(PG8_SB(1, 1), b3, voffB[1]);
        PG8_WAIT_V(6); PG8_BAR; PG8_MMA(1, 1, At, B1); PG8_BAR;
    }
    if (!(stream & 2)) {
    PG8_WAIT_V(0);
    if (wr == 0) PG8_BAR;
    PG8_BAR;
    }
    asm volatile("" ::: "memory");
#undef PG8_SA
#undef PG8_SB
#undef PG8_STAGE
#undef PG8_LDA
#undef PG8_LDB
#undef PG8_MMA
#undef PG8_WAIT_V
#undef PG8_WAIT_L
#undef PG8_BAR
#undef PG8_SCHED
}
DI void tile256_store_bf16(f32x4 (&acc)[8][4], bf16_t* out, size_t ld, int ncols, unsigned char* lds, int nrows = 256, bool perm = false) {
    bf16_t* T = (bf16_t*)lds;
    const int tid = TID(), lane = tid & 63, wave = tid >> 6, wm = wave >> 2, wn = wave & 3;
    __syncthreads();
#pragma unroll
    for (int mi = 0; mi < 8; ++mi)
#pragma unroll
        for (int ni = 0; ni < 4; ++ni) store_bf4(T + R256(mi) * 264 + (perm ? C256P(ni) : C256(ni)), acc[mi][ni]);
    __syncthreads();
#pragma unroll
    for (int i = 0; i < 16; ++i) {
        const int ch = tid + i * NTHREADS, r = ch >> 5, cc = (ch & 31) * 8;
        if (cc < ncols && r < nrows) *(u32x4*)(out + (size_t)r * ld + cc) = *(const u32x4*)(T + r * 264 + cc);
    }
}
DI void acc_zero(f32x4 (&acc)[4][4]) {
#pragma unroll
    for (int i = 0; i < 4; ++i)
#pragma unroll
        for (int j = 0; j < 4; ++j) acc[i][j] = (f32x4){0.f, 0.f, 0.f, 0.f};
}
#define ACC_FOREACH(acc, body) do { const int _l = TID() & 63, _w = TID() >> 6; \
    _Pragma("unroll") for (int _mi = 0; _mi < 4; ++_mi) _Pragma("unroll") for (int _ni = 0; _ni < 4; ++_ni) { \
        const int r_ = (_w >> 1) * 64 + _mi * 16 + (_l & 15), c_ = (_w & 1) * 64 + _ni * 16 + (_l >> 4) * 4; f32x4& v_ = acc[_mi][_ni]; body } } while (0)
DI ARows plain_rows(const bf16_t* base, size_t ld, int m0, int tid) { ARows a; a.mu = nullptr; a.ltype = 0; a.first = 0;
#pragma unroll
    for (int i = 0; i < 4; ++i) a.p[i] = base + (size_t)(m0 + (tid >> 3) + 64 * i) * ld;
    return a; }


template <int NTL>
DI void convert_tiles(const float* src, int ld, int N, int K, bf16_t* dst, int tile0, unsigned char* lds, int Kvalid = 1 << 30) {
    const int tid = TID();
    const int nkt = K >> 6;
    const int r = tid >> 3, seg = (tid & 7) * 8;
    f32x4 a[NTL], b[NTL];
#pragma unroll
    for (int u = 0; u < NTL; ++u) {
        const int tile = tile0 + u, k0 = (tile % nkt) * 64, n0 = (tile / nkt) * 64;
        a[u] = (f32x4){0.f, 0.f, 0.f, 0.f}; b[u] = a[u];
        if (n0 + seg < N && k0 + r < Kvalid) { const float* q = src + (size_t)(k0 + r) * ld + n0 + seg; a[u] = *(const f32x4*)q; b[u] = *(const f32x4*)(q + 4); }
    }
    __syncthreads();
#pragma unroll
    for (int u = 0; u < NTL; ++u) { bf16_t* T = (bf16_t*)lds + u * 64 * 72;
        u32x4 w; w.x = pack2(a[u][0], a[u][1]); w.y = pack2(a[u][2], a[u][3]); w.z = pack2(b[u][0], b[u][1]); w.w = pack2(b[u][2], b[u][3]); *(u32x4*)(T + r * 72 + seg) = w; }
    __syncthreads();
#pragma unroll
    for (int u = 0; u < NTL; ++u) { const bf16_t* T = (const bf16_t*)lds + u * 64 * 72;
        const int tile = tile0 + u, k0 = (tile % nkt) * 64, n0 = (tile / nkt) * 64;
        unsigned hh[8];
#pragma unroll
        for (int j = 0; j < 8; ++j) hh[j] = (unsigned)T[(seg + j) * 72 + r];
        asm volatile("" : "+v"(hh[0]), "+v"(hh[1]), "+v"(hh[2]), "+v"(hh[3]), "+v"(hh[4]), "+v"(hh[5]), "+v"(hh[6]), "+v"(hh[7]));
        u32x4 o;
        o.x = hh[0] | (hh[1] << 16); o.y = hh[2] | (hh[3] << 16); o.z = hh[4] | (hh[5] << 16); o.w = hh[6] | (hh[7] << 16);
        *(u32x4*)(dst + (size_t)(n0 + r) * K + k0 + seg) = o; }
}
DI void convert_tile4(const float* src, int ld, int N, int K, bf16_t* dst, int tile0, unsigned char* lds, int Kvalid = 1 << 30) { convert_tiles<4>(src, ld, N, K, dst, tile0, lds, Kvalid); }
struct Ctx {
    const Params* P; unsigned char* ws; float* out; int l;
    bf16_t* H; bf16_t* PROJ; bf16_t* F; bf16_t* POOLED; bf16_t* MERGED; bf16_t* CMPH; float* CMPO; float* POSB; int* ROUTE; int* ENT; bf16_t* HID; bf16_t* Y; bf16_t* VT; bf16_t* KC; bf16_t* VCT; bf16_t* YRAW; float* BON; bf16_t* TG; unsigned* ctl;
    DI const float* in(int i) const { return P->in[i]; }
};

DI void moe_offsets(const Ctx& c, int layer, int* soff) {
    const unsigned* cnt = c.ctl + CW_CNT + layer * 32;
    __syncthreads();
    if (TID() == 0) { int s = 0; for (int e = 0; e < 32; ++e) { soff[e] = s; s += (int)cnt[e]; } soff[32] = s; }
    __syncthreads();
}
DI void add_moe_rows(const Ctx& c, int row, int lane, f32x4 (&v)[4], const int* soff) {
    const int* rt = c.ROUTE + (size_t)row * 8;
    const int p0 = soff[rt[0]] + rt[4], p1 = soff[rt[1]] + rt[5];
    const bf16_t* y0 = c.Y + (size_t)p0 * DM; const bf16_t* y1 = c.Y + (size_t)p1 * DM;
#pragma unroll
    for (int i = 0; i < 4; ++i) {
        const u32x2 a = *(const u32x2*)(y0 + i * 256 + lane * 4), b = *(const u32x2*)(y1 + i * 256 + lane * 4);
        v[i][0] += bflo(a.x) + bflo(b.x); v[i][1] += bfhi(a.x) + bfhi(b.x); v[i][2] += bflo(a.y) + bflo(b.y); v[i][3] += bfhi(a.y) + bfhi(b.y);
    }
}
DI void posb_task(const Ctx& c, int task, unsigned char* lds) {
    const int tid = TID(), lane = tid & 63, wave = tid >> 6;
    const int kv = task >> 2, ng = task & 3;
    const float* pos = c.in(kv ? I_CPV : I_CPK) + (size_t)c.l * 2048;
    const float* w1 = c.in(kv ? I_CW1V : I_CW1K) + (size_t)c.l * 2048 * 256 + ng * 64 + lane;
    float s = 0.f;
#pragma unroll 1
    for (int k0 = wave * 256; k0 < wave * 256 + 256; k0 += 32) {
        float pk_[32], wk_[32];
#pragma unroll
        for (int j = 0; j < 32; ++j) { pk_[j] = pos[k0 + j]; wk_[j] = w1[(size_t)(k0 + j) * 256]; }
#pragma unroll
        for (int j = 0; j < 32; ++j) s += pk_[j] * wk_[j];
    }
    float* red = (float*)(lds + 66560);
    __syncthreads();
    red[wave * 64 + lane] = s;
    __syncthreads();
    if (wave == 0) { float t = 0.f;
#pragma unroll
        for (int w = 0; w < 8; ++w) t += red[w * 64 + lane];
        c.POSB[kv * 256 + ng * 64 + lane] = t; }
}
DI void n1_conv_call(const Ctx& c, int jc, unsigned char* lds) {
    const int it = jc * 4;
    if (it < 1216) convert_tile4(c.in(I_WIN) + (size_t)c.l * DM * IN_COLS, IN_COLS, IN_COLS, DM, (bf16_t*)(c.ws + WS_WT_IN), it, lds);
    else if (it < 1216 + 256) { const int j = it - 1216, kv = j >> 7; convert_tile4(c.in(kv ? I_CW1V : I_CW1K) + (size_t)c.l * 2048 * 256, 256, 256, 2048, (bf16_t*)(c.ws + WS_WT_C1) + (size_t)kv * 256 * 2048, j & 127, lds); }
    else if (it < 1216 + 256 + 16) { const int j = it - 1472, kv = j >> 3; convert_tile4(c.in(kv ? I_CW2V : I_CW2K) + (size_t)c.l * 256 * 64, 64, 64, 256, (bf16_t*)(c.ws + WS_WT_C2) + (size_t)kv * 128 * 256, j & 7, lds); }
    else if (it < 1504) { const int j = it - 1488, gi = j >> 2; convert_tile4(c.in(I_POOLW) + ((size_t)c.l * 4 + gi) * 128 * 128, 128, 128, 128, (bf16_t*)(c.ws + WS_WT_POOL) + (size_t)gi * 128 * 128, 0, lds); }
    else { const int j = it - 1504, ty = j >> 4; bf16_t* dst = (bf16_t*)(c.ws + WS_WT_LORA) + (size_t)ty * 512 * 128;
        if (ty == 0) convert_tile4(c.in(I_WUP) + (size_t)c.l * 32 * 512, 512, 512, 128, dst, j & 15, lds, 32);
        else if (ty == 1) convert_tile4(c.in(I_AUP) + (size_t)c.l * 32 * 512, 512, 512, 128, dst, j & 15, lds, 32);
        else convert_tile4(c.in(I_GUP) + (size_t)c.l * 96 * 512, 512, 512, 128, dst, j & 15, lds, 96); }
}
template <bool FINAL_>
DI void norm_rows4(const Ctx& c, const float* srcx, const f32x4 (&g4)[4], int r0, int lane, const int* soff, bool moe) {
    f32x4 v[4][4];
#pragma unroll
    for (int rr = 0; rr < 4; ++rr)
#pragma unroll
        for (int i = 0; i < 4; ++i) v[rr][i] = *(const f32x4*)(srcx + (size_t)(r0 + rr) * DM + i * 256 + lane * 4);
    if (moe) {
        int e0[4], e1[4], q0[4], q1[4];
#pragma unroll
        for (int rr = 0; rr < 4; ++rr) { const int* rt = c.ROUTE + (size_t)(r0 + rr) * 8; e0[rr] = rt[0]; e1[rr] = rt[1]; q0[rr] = rt[4]; q1[rr] = rt[5]; }
        u32x2 a[4][4], b[4][4];
#pragma unroll
        for (int rr = 0; rr < 4; ++rr) {
            const bf16_t* y0 = c.Y + (size_t)(soff[e0[rr]] + q0[rr]) * DM; const bf16_t* y1 = c.Y + (size_t)(soff[e1[rr]] + q1[rr]) * DM;
#pragma unroll
            for (int i = 0; i < 4; ++i) { a[rr][i] = *(const u32x2*)(y0 + i * 256 + lane * 4); b[rr][i] = *(const u32x2*)(y1 + i * 256 + lane * 4); }
        }
#pragma unroll
        for (int rr = 0; rr < 4; ++rr)
#pragma unroll
            for (int i = 0; i < 4; ++i) {
                v[rr][i][0] += bflo(a[rr][i].x) + bflo(b[rr][i].x); v[rr][i][1] += bfhi(a[rr][i].x) + bfhi(b[rr][i].x);
                v[rr][i][2] += bflo(a[rr][i].y) + bflo(b[rr][i].y); v[rr][i][3] += bfhi(a[rr][i].y) + bfhi(b[rr][i].y);
                if (!FINAL_) *(f32x4*)(c.out + (size_t)(r0 + rr) * DM + i * 256 + lane * 4) = v[rr][i];
            }
    }
#pragma unroll
    for (int rr = 0; rr < 4; ++rr) {
        float ss = 0.f;
#pragma unroll
        for (int i = 0; i < 4; ++i) ss += v[rr][i][0] * v[rr][i][0] + v[rr][i][1] * v[rr][i][1] + v[rr][i][2] * v[rr][i][2] + v[rr][i][3] * v[rr][i][3];
        ss = wave_sum_dpp(ss);
        const float rs = rsqrtf(ss * (1.0f / DM) + 1e-6f);
#pragma unroll
        for (int i = 0; i < 4; ++i) {
            const f32x4 o = (f32x4){v[rr][i][0] * rs * g4[i][0], v[rr][i][1] * rs * g4[i][1], v[rr][i][2] * rs * g4[i][2], v[rr][i][3] * rs * g4[i][3]};
            if (FINAL_) *(f32x4*)(c.out + (size_t)(r0 + rr) * DM + i * 256 + lane * 4) = o;
            else store_bf4(c.H + (size_t)(r0 + rr) * DM + i * 256 + lane * 4, o);
        }
    }
}
DI void phase_norm1(const Ctx& c, unsigned char* lds) {
    const int tid = TID(), lane = tid & 63, wave = tid >> 6;
    const float* gain = c.in(I_NMIX) + c.l * DM;
    const float* src = (c.l == 0) ? c.in(I_X) : c.out;
    int* soff = (int*)(lds + 65536);
    if (c.l > 0) moe_offsets(c, c.l - 1, soff);
    {
        f32x4 g4[4];
#pragma unroll
        for (int i = 0; i < 4; ++i) g4[i] = *(const f32x4*)(gain + i * 256 + lane * 4);
        for (int r0 = (blockIdx.x * 8 + wave) * 4; r0 < NT; r0 += gridDim.x * 32) norm_rows4<false>(c, src, g4, r0, lane, soff, c.l > 0);
    }
    if (gridDim.x == 256) {
        if (blockIdx.x < 152) convert_tiles<8>(c.in(I_WIN) + (size_t)c.l * DM * IN_COLS, IN_COLS, IN_COLS, DM, (bf16_t*)(c.ws + WS_WT_IN), (int)blockIdx.x * 8, lds);
    } else {
        if (blockIdx.x == 0) for (int task = 0; task < 8; ++task) posb_task(c, task, lds);
        for (int jc = blockIdx.x; jc < 388; jc += gridDim.x) n1_conv_call(c, jc, lds);
    }
}

constexpr int EPS = 136;
DI void tile_store_bf16(f32x4 (&acc)[4][4], bf16_t* out, size_t ld, int nrows, int ncols, unsigned char* lds) {
    bf16_t* T = (bf16_t*)lds;
    const int tid = TID();
    __syncthreads();
    ACC_FOREACH(acc, { store_bf4(T + r_ * EPS + c_, v_); });
    __syncthreads();
#pragma unroll
    for (int i = 0; i < 8; ++i) {
        const int ch = tid + i * NTHREADS, r = ch >> 4, cc = (ch & 15) * 8;
        if (r < nrows && cc < ncols) *(u32x4*)(out + (size_t)r * ld + cc) = *(const u32x4*)(T + r * EPS + cc);
    }
}
DI bool xcd_unit(int it, int nN, int& tm, int& tn) {
    const int G = gridDim.x;
    if ((G & 7) != 0 || G < 8) { const int u = it * G + blockIdx.x; if (u >= 64 * nN) return false; tm = u % 64; tn = u / 64; return true; }
    const int x = blockIdx.x & 7, i = blockIdx.x >> 3, per = G >> 3;
    const int u = it * per + i;
    if (u >= 8 * nN) return false;
    tm = x * 8 + (u & 7); tn = u >> 3; return true;
}
DI void phase_gemm1(const Ctx& c, unsigned char* lds) {
    const int nN = (IN_COLS + 255) / 256;
    const bf16_t* WT = (const bf16_t*)(c.ws + WS_WT_IN);
    int tm, tn; bool have = xcd_unit(0, nN, tm, tn);
    for (int it = 0; have; ++it) {
        const int m0 = tm * 256, n0 = tn * 256;
        int tm2 = 0, tn2 = 0; const bool more = xcd_unit(it + 1, nN, tm2, tn2);
        f32x4 acc[8][4];
#pragma unroll
        for (int i = 0; i < 8; ++i)
#pragma unroll
            for (int j = 0; j < 4; ++j) acc[i][j] = (f32x4){0.f, 0.f, 0.f, 0.f};
        gemm256_dma(acc, c.H + (size_t)m0 * DM, DM, WT + (size_t)n0 * DM, DM, DM, lds, nullptr, 0u, true, (it > 0 ? 1 : 0) | (more ? 2 : 0),
                    c.H + (size_t)tm2 * 256 * DM, WT + (size_t)tn2 * 256 * DM);
        const int lane = TID() & 63, wave = TID() >> 6, wm = wave >> 2, wn = wave & 3;
        const int ncols = (IN_COLS - n0 < 256) ? IN_COLS - n0 : 256;
#pragma unroll
        for (int mi = 0; mi < 8; ++mi)
#pragma unroll
            for (int bj = 0; bj < 2; ++bj) {
                const int cc = C256P(2 * bj);
                u32x4 o; o.x = pack2(acc[mi][2 * bj][0], acc[mi][2 * bj][1]); o.y = pack2(acc[mi][2 * bj][2], acc[mi][2 * bj][3]);
                o.z = pack2(acc[mi][2 * bj + 1][0], acc[mi][2 * bj + 1][1]); o.w = pack2(acc[mi][2 * bj + 1][2], acc[mi][2 * bj + 1][3]);
                if (cc < ncols) *(u32x4*)(c.PROJ + (size_t)(m0 + R256(mi)) * IN_COLS + n0 + cc) = o;
            }
        have = more; tm = tm2; tn = tn2;
    }
    if (gridDim.x == 256 && blockIdx.x >= 192) {
        const int t = (int)blockIdx.x - 192;
        if (t < 8) posb_task(c, t, lds); else n1_conv_call(c, 304 + (t - 8), lds);
        if (t < 28) n1_conv_call(c, 360 + t, lds);
    }
}

DI float gelu_tanh(float x) { const float u = 0.7978845608028654f * (x + 0.044715f * x * x * x); const float e = __expf(2.0f * u); return x * (1.0f - __builtin_amdgcn_rcpf(e + 1.0f)); }
DI float softplusf_(float x) { return (x > 20.f) ? x : __logf(1.0f + __expf(x)); }
DI float tanhf_(float x) { const float e = __expf(2.0f * x); return 1.0f - 2.0f * __builtin_amdgcn_rcpf(e + 1.0f); }
constexpr int TKP = 8;
template <int WIN>
DI void pool_emit(const Ctx& c, const float (&pv)[31], int t0, int s0, int ch) {
    float sum = 0.f;
#pragma unroll
    for (int j = 0; j < WIN; ++j) sum += pv[15 - j];
#pragma unroll
    for (int k = 0; k < 16; ++k) {
        if (k > 0) sum += pv[15 + k] - pv[15 + k - WIN];
        const int s = s0 + k;
        const float rc = (s + 1 < WIN) ? __builtin_amdgcn_rcpf((float)(s + 1)) : (1.0f / (float)WIN);
        c.POOLED[(size_t)(t0 + k) * 512 + ch] = f2bf(sum * rc - pv[15 + k]);
    }
}
DI void phase_prep(const Ctx& c, unsigned char* lds) {
    const int n_cmp_items = 2 * 16 * 2;
    for (int item = (int)gridDim.x - 1 - (int)blockIdx.x; item < n_cmp_items; item += gridDim.x) {
        const int tid = TID();
        const int kv = item >> 5, bgi = (item >> 1) & 15, tn = item & 1, m0 = bgi * 256, n0 = tn * 128;
        ARows ar; ar.mu = nullptr; ar.ltype = 0; ar.first = 0;
#pragma unroll
        for (int i = 0; i < 4; ++i) { const int cb = (tid >> 3) + 64 * i;
            ar.p[i] = (cb < NCMP) ? c.PROJ + ((size_t)(bgi >> 2) * SEQ + 16 * cb) * IN_COLS + (kv ? C_VC : C_KC) + (bgi & 3) * 64 : nullptr; }
        f32x4 acc[4][4]; acc_zero(acc);
        gemm_core<1>(acc, ar, (const bf16_t*)(c.ws + WS_WT_C1) + ((size_t)kv * 256 + n0) * 2048, 2048, 2048, lds);
        const float* pb = c.POSB + kv * 256;
        ACC_FOREACH(acc, {
            const f32x4 bb = *(const f32x4*)(pb + n0 + c_);
            store_bf4(c.CMPH + ((size_t)kv * 4096 + m0 + r_) * 256 + n0 + c_, (f32x4){gelu_tanh(v_[0] + bb[0]), gelu_tanh(v_[1] + bb[1]), gelu_tanh(v_[2] + bb[2]), gelu_tanh(v_[3] + bb[3])}); });
    }
    {
        const float* mu = c.in(I_MU) + (size_t)c.l * RWC;
        const bf16_t* WL = (const bf16_t*)(c.ws + WS_WT_LORA);
        const int G_ = gridDim.x, bid_ = blockIdx.x;
        const bool bal = (G_ == 256);
        const bool cmpb = bal && bid_ >= 192;
        for (int ui = 0;; ++ui) {
            int unit;
            if (!bal) { unit = bid_ + ui * G_; if (unit >= 768) break; }
            else if (cmpb) { if (ui >= 2) break; unit = 640 + (bid_ - 192) * 2 + ui; }
            else { if (ui < 3) unit = bid_ + 192 * ui; else if (ui == 3 && bid_ < 64) unit = 576 + bid_; else break; }
            const int tid = TID();
            const int tm = unit & 63, tn = unit >> 6, m0 = tm * 256, n0 = tn * 128, ltype = tn >> 2, ch0 = n0 & 511;
            ARows ar; ar.mu = mu; ar.ltype = ltype; ar.first = 0;
#pragma unroll
            for (int i = 0; i < 4; ++i) { const int t = m0 + (tid >> 3) + 64 * i; ar.p[i] = c.PROJ + (size_t)t * IN_COLS; if ((t & (SEQ - 1)) == 0) ar.first |= 1 << i; }
            f32x4 acc[4][4]; acc_zero(acc);
            gemm_core<2>(acc, ar, WL + (size_t)n0 * 128, 128, 128, lds);
            if (ltype == 0) { const float* w0 = c.in(I_W0) + c.l * 512 + ch0;
                ACC_FOREACH(acc, { const f32x4 b4 = *(const f32x4*)(w0 + c_);
                    for (int j = 0; j < 4; ++j) v_[j] = __expf(-softplusf_(-(b4[j] + v_[j])) - 0.5f); }); }
            else if (ltype == 1) { const float* a0 = c.in(I_A0) + c.l * 512 + ch0;
                ACC_FOREACH(acc, { const f32x4 b4 = *(const f32x4*)(a0 + c_);
                    for (int j = 0; j < 4; ++j) v_[j] = sigmoidf_(b4[j] + v_[j]); }); }
            tile_store_bf16(acc, c.F + (size_t)(3 + ltype) * NT * 512 + (size_t)m0 * 512 + ch0, 512, 256, 128, lds);
        }
    }
    const int tid = TID();
    const int n_pool_items = NT / 16, n_items = n_pool_items + 512;
    const bool bal2 = (gridDim.x == 256);
    const int istep = bal2 ? 192 : (int)gridDim.x;
    auto vt_item = [&](const int item) __attribute__((always_inline)) {
        const int idx0 = (item - n_pool_items) * 4;
        const int r = tid >> 3, seg = (tid & 7) * 8;
        u32x4 w[4];
#pragma unroll
        for (int u = 0; u < 4; ++u) { const int idx = idx0 + u, kind = idx >> 10, bgi = (idx >> 6) & 15, s0 = (idx & 63) * 64;
            w[u] = *(const u32x4*)(c.PROJ + ((size_t)(bgi >> 2) * SEQ + s0 + r) * IN_COLS + (kind ? C_VW : C_VS) + (bgi & 3) * 64 + seg); }
        __syncthreads();
#pragma unroll
        for (int u = 0; u < 4; ++u) *(u32x4*)((bf16_t*)lds + u * 64 * 72 + r * 72 + seg) = w[u];
        __syncthreads();
#pragma unroll
        for (int u = 0; u < 4; ++u) { const int idx = idx0 + u, kind = idx >> 10, bgi = (idx >> 6) & 15, s0 = (idx & 63) * 64;
            const bf16_t* T = (const bf16_t*)lds + u * 64 * 72;
            unsigned hh[8];
#pragma unroll
            for (int j = 0; j < 8; ++j) hh[j] = (unsigned)T[(seg + j) * 72 + r];
            asm volatile("" : "+v"(hh[0]), "+v"(hh[1]), "+v"(hh[2]), "+v"(hh[3]), "+v"(hh[4]), "+v"(hh[5]), "+v"(hh[6]), "+v"(hh[7]));
            u32x4 o;
            o.x = hh[0] | (hh[1] << 16); o.y = hh[2] | (hh[3] << 16); o.z = hh[4] | (hh[5] << 16); o.w = hh[6] | (hh[7] << 16);
            *(u32x4*)(c.VT + (((size_t)kind * 16 + bgi) * 64 + r) * SEQ + s0 + seg) = o; }
    };
    struct PoolRaw { bf16_t v[31]; };
    auto pool_load = [&](PoolRaw& R, const int item) __attribute__((always_inline)) {
        const int t0 = item * 16, s0 = t0 & (SEQ - 1);
#pragma unroll
        for (int i = 0; i < 31; ++i) { R.v[i] = 0; if (s0 - 15 + i >= 0) R.v[i] = c.PROJ[(size_t)(t0 - 15 + i) * IN_COLS + C_POOL + tid]; }
    };
    auto pool_compute = [&](const PoolRaw& R, const int item) __attribute__((always_inline)) {
        const int t0 = item * 16, ch = tid, gi = ch >> 7, s0 = t0 & (SEQ - 1);
        float pv[31];
#pragma unroll
        for (int i = 0; i < 31; ++i) pv[i] = bf2f(R.v[i]);
        if (gi == 0) pool_emit<2>(c, pv, t0, s0, ch);
        else if (gi == 1) pool_emit<4>(c, pv, t0, s0, ch);
        else if (gi == 2) pool_emit<8>(c, pv, t0, s0, ch);
        else pool_emit<16>(c, pv, t0, s0, ch);
    };
    {
        const int bid3 = blockIdx.x;
        auto item_of = [&](const int li) __attribute__((always_inline)) {
            if (!bal2) { const int it = bid3 + li * istep; return it < n_items ? it : n_items; }
            if (bid3 >= 192) return n_items;
            if (li < 6) return bid3 + 192 * li;
            if (bid3 >= 64 && li < 9) return 1152 + (bid3 - 64) * 3 + (li - 6);
            return n_items;
        };
        int li = 0, item = item_of(0);
        PoolRaw RA, RB;
        if (item < n_pool_items) pool_load(RA, item);
        while (item < n_items) {
            int nx = item_of(++li);
            if (nx < n_pool_items) pool_load(RB, nx);
            if (item < n_pool_items) pool_compute(RA, item); else vt_item(item);
            item = nx; if (item >= n_items) break;
            nx = item_of(++li);
            if (nx < n_pool_items) pool_load(RA, nx);
            if (item < n_pool_items) pool_compute(RB, item); else vt_item(item);
            item = nx;
        }
    }
}

struct FinRaw { bf16_t ur[9], uk[9], uv[9], ua[8]; };
DI void fin_load(FinRaw& R, const Ctx& c, int item) {
    const int ch = TID(), t0 = item * 8;
    const bool has_prev = (t0 & (SEQ - 1)) != 0;
#pragma unroll
    for (int k = 0; k < 9; ++k) {
        R.ur[k] = 0; R.uk[k] = 0; R.uv[k] = 0;
        if (k > 0 || has_prev) { const bf16_t* q = c.PROJ + (size_t)(t0 - 1 + k) * IN_COLS; R.ur[k] = q[C_R + ch]; R.uk[k] = q[C_K + ch]; R.uv[k] = q[C_V + ch]; }
    }
#pragma unroll
    for (int k = 0; k < 8; ++k) R.ua[k] = c.F[(size_t)4 * NT * 512 + (size_t)(t0 + k) * 512 + ch];
}
DI void fin_compute(const FinRaw& R, const Ctx& c, int item) {
    const int tid = TID(), ch = tid, t0 = item * 8;
    const float* mu = c.in(I_MU) + (size_t)c.l * RWC;
    const float kkw_ = c.in(I_KK)[c.l * 512 + ch], kaw_ = c.in(I_KA)[c.l * 512 + ch], rkw_ = c.in(I_RK)[c.l * 512 + ch];
    const float mur = mu[ch], muk = mu[512 + ch], muv = mu[1024 + ch];
#pragma unroll
    for (int k = 0; k < 8; ++k) {
        const int t = t0 + k;
        const float cr = bf2f(R.ur[k + 1]), ck = bf2f(R.uk[k + 1]), cv = bf2f(R.uv[k + 1]);
        const float r = cr + (bf2f(R.ur[k]) - cr) * mur, kx = ck + (bf2f(R.uk[k]) - ck) * muk, vx = cv + (bf2f(R.uv[k]) - cv) * muv;
        const float a = bf2f(R.ua[k]);
        const float kxn = kx * kkw_, kp = kx * (1.0f + (a - 1.0f) * kaw_);
        const float ss = wave_sum_dpp(kxn * kxn);
        const float inv = __builtin_amdgcn_rsqf(fmaxf(ss, 1e-24f));
        const float br = wave_sum_dpp(kxn * inv * a * r), kr = wave_sum_dpp(kp * r), bon = wave_sum_dpp(r * kp * rkw_);
        if ((tid & 63) == 0) *(f32x4*)(c.BON + ((size_t)t * 8 + (tid >> 6)) * 4) = (f32x4){inv, br, kr, bon};
        const size_t o = (size_t)t * 512 + ch;
        c.F[o] = f2bf(r); c.F[o + (size_t)NT * 512] = f2bf(kx); c.F[o + (size_t)2 * NT * 512] = f2bf(vx);
    }
}

DI void tpre_all(const Ctx& c, unsigned char* lds);
DI void phase_poolgemm(const Ctx& c, unsigned char* lds) {
    {
        const int G_ = gridDim.x, nit = NT / 8, bidf = blockIdx.x;
        auto fitem = [&](const int li) __attribute__((always_inline)) {
            if (G_ != 256) { const int it = bidf + li * G_; return it < nit ? it : nit; }
            if (li < 6) return bidf + 256 * li;
            if (bidf < 32) return nit;
            if (li < 8) return 1536 + (bidf - 32) * 2 + (li - 6);
            if (li == 8 && bidf < 96) return 1984 + (bidf - 32);
            return nit;
        };
        FinRaw RA, RB;
        int li = 0, item = fitem(0);
        if (item < nit) fin_load(RA, c, item);
        while (item < nit) {
            int nx = fitem(++li);
            if (nx < nit) fin_load(RB, c, nx);
            fin_compute(RA, c, item);
            item = nx; if (item >= nit) break;
            nx = fitem(++li);
            if (nx < nit) fin_load(RA, c, nx);
            fin_compute(RB, c, item);
            item = nx;
        }
    }
    tpre_all(c, lds);
    const int n_pool = (NT / 256) * 4, n_items = n_pool + 32;
    for (int item = blockIdx.x; item < n_items; item += gridDim.x) {
        f32x4 acc[4][4]; acc_zero(acc);
        if (item < n_pool) {
            const int tm = item >> 2, gi = item & 3, m0 = tm * 256;
            const ARows ar = plain_rows(c.POOLED + gi * 128, 512, m0, TID());
            gemm_core<0>(acc, ar, (const bf16_t*)(c.ws + WS_WT_POOL) + (size_t)gi * 128 * 128, 128, 128, lds);
            const float* sc = c.in(I_POOLS) + c.l * 512 + gi * 128;
            ACC_FOREACH(acc, { const f32x4 s = *(const f32x4*)(sc + c_);
                store_bf4(c.POOLED + (size_t)(m0 + r_) * 512 + gi * 128 + c_, (f32x4){v_[0] * s[0], v_[1] * s[1], v_[2] * s[2], v_[3] * s[3]}); });
        } else {
            const int it = item - n_pool, kv = it >> 4, tm = it & 15, m0 = tm * 256;
            const ARows ar = plain_rows(c.CMPH + (size_t)kv * 4096 * 256, 256, m0, TID());
            gemm_core<0>(acc, ar, (const bf16_t*)(c.ws + WS_WT_C2) + (size_t)kv * 128 * 256, 256, 256, lds);
            ACC_FOREACH(acc, { if (c_ < 64) { const int R = m0 + r_;
                if (kv == 0) store_bf4(c.KC + (size_t)R * 64 + c_, v_);
                else { bf16_t* q = c.VCT + ((size_t)(R >> 8) * 64 + c_) * 256 + (R & 255); q[0] = f2bf(v_[0]); q[256] = f2bf(v_[1]); q[512] = f2bf(v_[2]); q[768] = f2bf(v_[3]); } } });
        }
    }
}

constexpr int SCH = 32;
constexpr int SB_AN = 0, SB_WR = SCH * 64 * 4, SB_W = 2 * SCH * 64 * 4, SB_BB = 3 * SCH * 64 * 4, SB_KP = 4 * SCH * 64 * 4;
constexpr int SB_V = 5 * SCH * 64 * 4;
constexpr int SB_SC = SB_V + SCH * 16 * 4;
constexpr int SB_Y = SB_SC + SCH * 2 * 4;
constexpr int SB_BYTES = SB_Y + SCH * 16 * 4;
static_assert(2 * SB_BYTES <= LDS_BYTES - 64, "scan lds");
typedef float f32x2 __attribute__((ext_vector_type(2)));
DI float row8_sum(float v) { v += DPP_MOV(v, 0xB1); v += DPP_MOV(v, 0x4E); v += DPP_MOV(v, 0x141); return v; }

constexpr int NPW = 6, NJ = (SCH + NPW - 1) / NPW;
struct PrepRegs { bf16_t r[NJ], k[NJ], v[NJ], e[NJ], a[NJ]; float s0[NJ], s1[NJ], s2[NJ]; };
DI void prep_load(PrepRegs& R, const Ctx& c, int b, int h, int ck, int pw, int lane) {
    const size_t PL = (size_t)NT * 512;
    const size_t tb = (size_t)b * SEQ + ck * SCH;
    const size_t o0 = tb * 512 + h * 64 + lane;
#pragma unroll
    for (int j = 0; j < NJ; ++j) {
        const int st = pw + NPW * j;
        if (st < SCH) { const size_t o = o0 + (size_t)st * 512; R.r[j] = c.F[o]; R.k[j] = c.F[o + PL]; R.v[j] = c.F[o + 2 * PL]; R.e[j] = c.F[o + 3 * PL]; R.a[j] = c.F[o + 4 * PL];
            const float* sp = c.BON + ((tb + st) * 8 + h) * 4; R.s0[j] = sp[0]; R.s1[j] = sp[1]; R.s2[j] = sp[2]; }
    }
}
DI void prep_store(const PrepRegs& R, unsigned char* sb, int rq, int pw, int lane, float kkw, float kaw) {
    float* an = (float*)(sb + SB_AN); float* wr = (float*)(sb + SB_WR); float* w_ = (float*)(sb + SB_W); float* bb_ = (float*)(sb + SB_BB); float* kp_ = (float*)(sb + SB_KP);
    float* vv = (float*)(sb + SB_V); float* sc = (float*)(sb + SB_SC);
#pragma unroll
    for (int j = 0; j < NJ; ++j) {
        const int st = pw + NPW * j;
        if (st < SCH) {
            const float r = bf2f(R.r[j]), k = bf2f(R.k[j]), v = bf2f(R.v[j]), e = bf2f(R.e[j]), a = bf2f(R.a[j]);
            const float w = __expf(-e);
            const float kk = k * kkw * R.s0[j];
            const float kp = k * (1.0f + (a - 1.0f) * kaw);
            an[st * 64 + lane] = -kk; wr[st * 64 + lane] = w * r; w_[st * 64 + lane] = w; bb_[st * 64 + lane] = kk * a; kp_[st * 64 + lane] = kp;
            if ((lane >> 4) == rq) vv[st * 16 + (lane & 15)] = v;
            if (lane == 0) { sc[st * 2] = R.s1[j]; sc[st * 2 + 1] = R.s2[j]; }
        }
    }
}
DI void scan_item(const Ctx& c, int item, unsigned char* lds) {
    const int tid = TID(), lane = tid & 63, wave = tid >> 6;
    const int b = item >> 5, h = (item >> 2) & 7, rq = item & 3;
    const int chn = h * 64 + lane;
    const float kkw = c.in(I_KK)[c.l * 512 + chn], kaw = c.in(I_KA)[c.l * 512 + chn];
    const int rowl = (tid & 127) >> 3, cg = tid & 7;
    f32x2 st[4];
#pragma unroll
    for (int i = 0; i < 4; ++i) st[i] = (f32x2){0.f, 0.f};
    constexpr int NCK = SEQ / SCH;
    PrepRegs R;
    __syncthreads();
    if (wave >= 2) { prep_load(R, c, b, h, 0, wave - 2, lane); prep_store(R, lds, rq, wave - 2, lane, kkw, kaw); prep_load(R, c, b, h, 1, wave - 2, lane); }
    __syncthreads();
    for (int ck = 0; ck < NCK; ++ck) {
        unsigned char* sb = lds + (ck & 1) * SB_BYTES;
        if (wave < 2) {
            const float* an = (const float*)(sb + SB_AN) + cg * 8; const float* wr = (const float*)(sb + SB_WR) + cg * 8; const float* w_ = (const float*)(sb + SB_W) + cg * 8;
            const float* bb_ = (const float*)(sb + SB_BB) + cg * 8; const float* kp_ = (const float*)(sb + SB_KP) + cg * 8;
            const float* vv = (const float*)(sb + SB_V) + rowl; const float* sc = (const float*)(sb + SB_SC); float* yb = (float*)(sb + SB_Y) + rowl;
            f32x4 a0 = *(const f32x4*)(an), a1 = *(const f32x4*)(an + 4), r0 = *(const f32x4*)(wr), r1 = *(const f32x4*)(wr + 4);
            f32x4 w0 = *(const f32x4*)(w_), w1 = *(const f32x4*)(w_ + 4), b0 = *(const f32x4*)(bb_), b1 = *(const f32x4*)(bb_ + 4);
            f32x4 k0 = *(const f32x4*)(kp_), k1 = *(const f32x4*)(kp_ + 4);
            float v = vv[0]; f32x2 bk = *(const f32x2*)(sc);
#pragma unroll 2
            for (int s = 0; s < SCH; ++s) {
                const int sn = (s + 1 < SCH) ? s + 1 : s;
                const f32x4 na0 = *(const f32x4*)(an + sn * 64), na1 = *(const f32x4*)(an + sn * 64 + 4), nr0 = *(const f32x4*)(wr + sn * 64), nr1 = *(const f32x4*)(wr + sn * 64 + 4);
                const f32x4 nw0 = *(const f32x4*)(w_ + sn * 64), nw1 = *(const f32x4*)(w_ + sn * 64 + 4), nb0 = *(const f32x4*)(bb_ + sn * 64), nb1 = *(const f32x4*)(bb_ + sn * 64 + 4);
                const f32x4 nk0 = *(const f32x4*)(kp_ + sn * 64), nk1 = *(const f32x4*)(kp_ + sn * 64 + 4);
                const float nv = vv[sn * 16]; const f32x2 nbk = *(const f32x2*)(sc + sn * 2);
                f32x2 da = st[0] * (f32x2){a0[0], a0[1]}; f32x2 dr = st[0] * (f32x2){r0[0], r0[1]};
                da += st[1] * (f32x2){a0[2], a0[3]}; dr += st[1] * (f32x2){r0[2], r0[3]};
                da += st[2] * (f32x2){a1[0], a1[1]}; dr += st[2] * (f32x2){r1[0], r1[1]};
                da += st[3] * (f32x2){a1[2], a1[3]}; dr += st[3] * (f32x2){r1[2], r1[3]};
                float sa = da[0] + da[1], sr = dr[0] + dr[1];
                sa += DPP_MOV(sa, 0xB1); sr += DPP_MOV(sr, 0xB1);
                sa += DPP_MOV(sa, 0x4E); sr += DPP_MOV(sr, 0x4E);
                sa += DPP_MOV(sa, 0x141); sr += DPP_MOV(sr, 0x141);
                const f32x2 sa2 = (f32x2){sa, sa}, v2 = (f32x2){v, v};
                st[0] = st[0] * (f32x2){w0[0], w0[1]} + sa2 * (f32x2){b0[0], b0[1]} + v2 * (f32x2){k0[0], k0[1]};
                st[1] = st[1] * (f32x2){w0[2], w0[3]} + sa2 * (f32x2){b0[2], b0[3]} + v2 * (f32x2){k0[2], k0[3]};
                st[2] = st[2] * (f32x2){w1[0], w1[1]} + sa2 * (f32x2){b1[0], b1[1]} + v2 * (f32x2){k1[0], k1[1]};
                st[3] = st[3] * (f32x2){w1[2], w1[3]} + sa2 * (f32x2){b1[2], b1[3]} + v2 * (f32x2){k1[2], k1[3]};
                yb[s * 16] = sr + sa * bk[0] + v * bk[1];
                a0 = na0; a1 = na1; r0 = nr0; r1 = nr1; w0 = nw0; w1 = nw1; b0 = nb0; b1 = nb1; k0 = nk0; k1 = nk1; v = nv; bk = nbk;
            }
        } else {
            const int pt = tid - 128;
            if (ck + 1 < NCK) prep_store(R, lds + ((ck + 1) & 1) * SB_BYTES, rq, wave - 2, lane, kkw, kaw);
            if (ck + 2 < NCK) prep_load(R, c, b, h, ck + 2, wave - 2, lane);
            if (ck > 0) {
                const float* yb = (const float*)(lds + ((ck - 1) & 1) * SB_BYTES + SB_Y);
                for (int idx = pt; idx < SCH * 16; idx += 384) {
                    const int s = idx >> 4, j = idx & 15;
                    c.YRAW[((size_t)b * SEQ + (ck - 1) * SCH + s) * 512 + h * 64 + rq * 16 + j] = f2bf(yb[idx]);
                }
            }
        }
        asm volatile("s_waitcnt lgkmcnt(0)" ::: "memory"); __builtin_amdgcn_s_barrier(); asm volatile("" ::: "memory");
    }
    {
        const float* yb = (const float*)(lds + ((NCK - 1) & 1) * SB_BYTES + SB_Y);
        for (int idx = tid; idx < SCH * 16; idx += NTHREADS) {
            const int s = idx >> 4, j = idx & 15;
            c.YRAW[((size_t)b * SEQ + (NCK - 1) * SCH + s) * 512 + h * 64 + rq * 16 + j] = f2bf(yb[idx]);
        }
    }
    __syncthreads();
}
constexpr int CS64 = 72, CS32 = 40;
constexpr int CK_AH = 0, CK_BH = CK_AH + 32 * CS64 * 2, CK_KH = CK_BH + 32 * CS64 * 2, CK_RH = CK_KH + 32 * CS64 * 2;
constexpr int CK_BHT = CK_RH + 32 * CS64 * 2, CK_KHT = CK_BHT + 64 * CS32 * 2, CK_VT = CK_KHT + 64 * CS32 * 2, CK_GC = CK_VT + 64 * CS32 * 2, CK_MRB = CK_GC + 256;
constexpr int CK_SET = CK_MRB + 32 * CS32 * 2;
constexpr int CK_ZT = 2 * CK_SET, CK_UT = CK_ZT + 64 * CS32 * 2;
constexpr int CK_S0B = CK_UT + 64 * CS32 * 2;
constexpr int CK_LAK = CK_S0B + 2 * 64 * CS64 * 2, CK_MRK = CK_LAK + 32 * CS32 * 2;
constexpr int CK_PA = CK_MRK + 32 * CS32 * 2, CK_PT = CK_PA + 2 * 32 * CS32 * 2, CK_TT = CK_PT + 2 * 32 * CS32 * 2;
constexpr int CK_TOT = CK_TT + 2 * 32 * CS32 * 2;
constexpr int CK_END = CK_TOT + 8 * 64 * 4;
static_assert(CK_END <= LDS_BYTES - 64, "chunk scan lds");
template <int K>
DI f32x4 mm16(const bf16_t* A, int lda, const bf16_t* Bt, int ldb, f32x4 acc, int lane) {
#pragma unroll
    for (int k0 = 0; k0 < K; k0 += 32) {
        const bf16x8 a = *(const bf16x8*)(A + (lane & 15) * lda + k0 + (lane >> 4) * 8), b = *(const bf16x8*)(Bt + (lane & 15) * ldb + k0 + (lane >> 4) * 8);
        acc = __builtin_amdgcn_mfma_f32_16x16x32_bf16(a, b, acc, 0, 0, 0);
    }
    return acc;
}
template <int K>
DI f32x4 mm16t(const bf16_t* A, int lda, const bf16_t* Bt, int ldb, f32x4 acc, int lane) {
#pragma unroll
    for (int k0 = 0; k0 < K; k0 += 32) {
        const bf16x8 a = *(const bf16x8*)(A + (lane & 15) * lda + k0 + (lane >> 4) * 8), b = *(const bf16x8*)(Bt + (lane & 15) * ldb + k0 + (lane >> 4) * 8);
        acc = __builtin_amdgcn_mfma_f32_16x16x32_bf16(b, a, acc, 0, 0, 0);
    }
    return acc;
}
DI bf16x8 ldf(const bf16_t* M, int ld, int lane, int k0) { return *(const bf16x8*)(M + (lane & 15) * ld + k0 + (lane >> 4) * 8); }
#define MFMA_BF(a, b, c) __builtin_amdgcn_mfma_f32_16x16x32_bf16((a), (b), (c), 0, 0, 0)
DI void mm16_both(const bf16_t* A, int lda, const bf16_t* Bt, int ldb, f32x4& cn, f32x4& ct, int lane) {
    const bf16x8 a = *(const bf16x8*)(A + (lane & 15) * lda + (lane >> 4) * 8), b = *(const bf16x8*)(Bt + (lane & 15) * ldb + (lane >> 4) * 8);
    cn = __builtin_amdgcn_mfma_f32_16x16x32_bf16(a, b, cn, 0, 0, 0); ct = __builtin_amdgcn_mfma_f32_16x16x32_bf16(b, a, ct, 0, 0, 0);
}
constexpr int TU_AH = 0, TU_BH = 32 * CS64 * 2, TU_PA = 2 * 32 * CS64 * 2, TU_PT = TU_PA + 2 * 32 * CS32 * 2, TU_TT = TU_PT + 2 * 32 * CS32 * 2, TU_BYTES = TU_TT + 2 * 32 * CS32 * 2;
constexpr int TU_TOT = 4 * TU_BYTES;
static_assert(TU_TOT + 4 * 8 * 64 * 4 <= LDS_BYTES - 64, "tpre lds");
struct TpreRaw { bf16_t k[4][5], a[4][4], e[4][4]; };
DI void tpre_load(TpreRaw& R, const Ctx& c, int pass, int wave, int lane) {
    const int ck = pass & 127, hq = (pass >> 7) & 1, b = pass >> 8;
    const size_t PL = (size_t)NT * 512;
    const size_t tok0 = (size_t)b * SEQ + ck * 32 + wave * 4;
    const bool has_prev = (ck | wave) != 0;
#pragma unroll
    for (int u = 0; u < 4; ++u) {
        const int ch = (hq * 4 + u) * 64 + lane;
        R.k[u][0] = 0;
        if (has_prev) R.k[u][0] = c.PROJ[(tok0 - 1) * IN_COLS + C_K + ch];
#pragma unroll
        for (int s = 0; s < 4; ++s) { R.k[u][s + 1] = c.PROJ[(tok0 + s) * IN_COLS + C_K + ch]; R.a[u][s] = c.F[(tok0 + s) * 512 + ch + 4 * PL]; R.e[u][s] = c.F[(tok0 + s) * 512 + ch + 3 * PL]; }
    }
}
DI void tpre_pass(const Ctx& c, int pass, int next_pass, TpreRaw& R, unsigned char* lds) {
    const int tid = TID(), lane = tid & 63, wave = tid >> 6, qd = lane >> 4, l15 = lane & 15;
    const int ck = pass & 127, hq = (pass >> 7) & 1, b = pass >> 8;
    const float* mu = c.in(I_MU) + (size_t)c.l * RWC;
    float* TOT = (float*)(lds + TU_TOT);
    const f32x4 Z4 = (f32x4){0.f, 0.f, 0.f, 0.f};
    __syncthreads();
    float kk4[4][4], al4[4][4], e4[4][4], ce[4][4];
#pragma unroll
    for (int u = 0; u < 4; ++u) {
        const int ch = (hq * 4 + u) * 64 + lane;
        const float kkw = c.in(I_KK)[c.l * 512 + ch], muk = mu[512 + ch];
#pragma unroll
        for (int s = 0; s < 4; ++s) {
            const float cur = bf2f(R.k[u][s + 1]);
            const float kx = cur + (bf2f(R.k[u][s]) - cur) * muk;
            const float kxn = kx * kkw;
            const float ss = wave_sum_dpp(kxn * kxn);
            const float inv = __builtin_amdgcn_rsqf(fmaxf(ss, 1e-24f));
            kk4[u][s] = bf2f(f2bf(kx)) * kkw * inv; al4[u][s] = bf2f(R.a[u][s]); e4[u][s] = bf2f(R.e[u][s]);
        }
        ce[u][0] = e4[u][0]; ce[u][1] = ce[u][0] + e4[u][1]; ce[u][2] = ce[u][1] + e4[u][2]; ce[u][3] = ce[u][2] + e4[u][3];
        TOT[(u * 8 + wave) * 64 + lane] = ce[u][3];
    }
    tpre_load(R, c, next_pass, wave, lane);
    LDS_BARRIER();
#pragma unroll
    for (int u = 0; u < 4; ++u) {
        bf16_t* AH = (bf16_t*)(lds + u * TU_BYTES + TU_AH); bf16_t* BH = (bf16_t*)(lds + u * TU_BYTES + TU_BH);
        float off = 0.f;
#pragma unroll
        for (int w = 0; w < 7; ++w) { const float tw = TOT[(u * 8 + w) * 64 + lane]; if (w < wave) off += tw; }
#pragma unroll
        for (int s = 0; s < 4; ++s) {
            const float cs = off + ce[u][s];
            const float gi = __expf(cs), gm1 = __expf(e4[u][s] - cs);
            const int t = wave * 4 + s;
            AH[t * CS64 + lane] = f2bf(-kk4[u][s] * gm1); BH[t * CS64 + lane] = f2bf(kk4[u][s] * al4[u][s] * gi);
        }
    }
    LDS_BARRIER();
    {
        const int u = wave >> 1, mt = wave & 1;
        const bf16_t* AH = (const bf16_t*)(lds + u * TU_BYTES + TU_AH); const bf16_t* BH = (const bf16_t*)(lds + u * TU_BYTES + TU_BH);
        bf16_t* PA = (bf16_t*)(lds + u * TU_BYTES + TU_PA); bf16_t* PT = (bf16_t*)(lds + u * TU_BYTES + TU_PT); bf16_t* TT = (bf16_t*)(lds + u * TU_BYTES + TU_TT);
#pragma unroll
        for (int nt = 0; nt < 2; ++nt) {
            f32x4 acc = mm16t<64>(AH + mt * 16 * CS64, CS64, BH + nt * 16 * CS64, CS64, Z4, lane);
            const int m = mt * 16 + l15, n0 = nt * 16 + 4 * qd;
#pragma unroll
            for (int i = 0; i < 4; ++i) if (!(n0 + i < m)) acc[i] = 0.f;
            store_bf4(PA + m * CS32 + n0, acc);
            f32x4 t0 = acc;
#pragma unroll
            for (int i = 0; i < 4; ++i) if (n0 + i == m) t0[i] += 1.0f;
            store_bf4(TT + m * CS32 + n0, t0);
            f32x4 accn = mm16<64>(AH + mt * 16 * CS64, CS64, BH + nt * 16 * CS64, CS64, Z4, lane);
            const int mm0 = mt * 16 + 4 * qd, nn = nt * 16 + l15;
#pragma unroll
            for (int i = 0; i < 4; ++i) if (!(nn < mm0 + i)) accn[i] = 0.f;
            store_bf4(PT + nn * CS32 + mm0, accn);
        }
    }
    LDS_BARRIER();
    const int mt4 = (wave >> 1) & 1, nt4 = wave & 1;
    int pcur = 0, tcur = 0;
#pragma unroll
    for (int itn = 0; itn < 5; ++itn) {
        const int m = mt4 * 16 + l15, n0 = nt4 * 16 + 4 * qd;
#pragma unroll
        for (int u = 0; u < 4; ++u) {
            bf16_t* PA = (bf16_t*)(lds + u * TU_BYTES + TU_PA); bf16_t* PT = (bf16_t*)(lds + u * TU_BYTES + TU_PT); bf16_t* TT = (bf16_t*)(lds + u * TU_BYTES + TU_TT);
            if (wave < 4) {
                if (itn < 4) {
                    f32x4 cn = Z4, ct = Z4;
                    mm16_both(PA + pcur * 32 * CS32 + mt4 * 16 * CS32, CS32, PT + pcur * 32 * CS32 + nt4 * 16 * CS32, CS32, cn, ct, lane);
                    store_bf4(PA + (pcur ^ 1) * 32 * CS32 + m * CS32 + n0, ct);
                    store_bf4(PT + (pcur ^ 1) * 32 * CS32 + (nt4 * 16 + l15) * CS32 + mt4 * 16 + 4 * qd, cn);
                }
            } else if (itn > 0) {
                const u32x2 told = *(const u32x2*)(TT + tcur * 32 * CS32 + m * CS32 + n0);
                f32x4 acc = (f32x4){bflo(told.x), bfhi(told.x), bflo(told.y), bfhi(told.y)};
                acc = mm16t<32>(TT + tcur * 32 * CS32 + mt4 * 16 * CS32, CS32, PT + pcur * 32 * CS32 + nt4 * 16 * CS32, CS32, acc, lane);
                if (itn < 4) store_bf4(TT + (tcur ^ 1) * 32 * CS32 + m * CS32 + n0, acc);
                else store_bf4(c.TG + ((((size_t)b * 8 + hq * 4 + u) * 128 + ck) * 32 + m) * 32 + n0, acc);
            }
        }
        if (itn < 4) LDS_BARRIER();
        if (itn < 4) pcur ^= 1;
        if (itn > 0) tcur ^= 1;
    }
}
DI void tpre_all(const Ctx& c, unsigned char* lds) {
    const int np = NB * 2 * 128, G = gridDim.x;
    if ((int)blockIdx.x < np) {
        TpreRaw R; tpre_load(R, c, blockIdx.x, TID() >> 6, TID() & 63);
#pragma unroll 1
        for (int pass = blockIdx.x; pass < np; pass += G) tpre_pass(c, pass, (pass + G < np) ? pass + G : pass, R, lds);
    }
    __syncthreads();
}
struct ChunkRaw { bf16_t r[4], k[4], v[4], e[4], a[4]; float inv[4]; unsigned tw; };
DI void chunk_load(ChunkRaw& R, const Ctx& c, int b, int h, int ck, int wave, int lane) {
    const size_t PL = (size_t)NT * 512;
    const size_t tok0 = (size_t)b * SEQ + ck * 32 + wave * 4;
#pragma unroll
    for (int s = 0; s < 4; ++s) {
        const size_t o = (tok0 + s) * 512 + h * 64 + lane;
        R.r[s] = c.F[o]; R.k[s] = c.F[o + PL]; R.v[s] = c.F[o + 2 * PL]; R.e[s] = c.F[o + 3 * PL]; R.a[s] = c.F[o + 4 * PL];
        R.inv[s] = c.BON[((tok0 + s) * 8 + h) * 4];
    }
    R.tw = ((const unsigned*)(c.TG + (((size_t)b * 8 + h) * 128 + ck) * 1024))[wave * 64 + lane];
}
DI void scan_chunked_item(const Ctx& c, int item, unsigned char* lds) {
    const int tid = TID(), lane = tid & 63, wave = tid >> 6, qd = lane >> 4, l15 = lane & 15;
    const int b = item >> 3, h = item & 7;
    bf16_t* ZT = (bf16_t*)(lds + CK_ZT); bf16_t* UT = (bf16_t*)(lds + CK_UT);
    bf16_t* S0B = (bf16_t*)(lds + CK_S0B); bf16_t* LAK = (bf16_t*)(lds + CK_LAK); bf16_t* MRK = (bf16_t*)(lds + CK_MRK);
    bf16_t* PA = (bf16_t*)(lds + CK_PA); bf16_t* PT = (bf16_t*)(lds + CK_PT); bf16_t* TT = (bf16_t*)(lds + CK_TT);
    float* TOT = (float*)(lds + CK_TOT);
    const f32x4 Z4 = (f32x4){0.f, 0.f, 0.f, 0.f};
    f32x4 Sreg[2] = {Z4, Z4};
    const int svt = wave >> 1, skt0 = 2 * (wave & 1);
    const int mt8 = wave >> 2, nt8 = wave & 3;
    const int mt4 = (wave >> 1) & 1, nt4 = wave & 1;
    __syncthreads();
    for (int i = tid; i < 2 * 64 * CS64 / 2; i += NTHREADS) ((unsigned*)S0B)[i] = 0u;
    const float kkw = c.in(I_KK)[c.l * 512 + h * 64 + lane], kaw = c.in(I_KA)[c.l * 512 + h * 64 + lane];
    constexpr int NCK = SEQ / 32;
    ChunkRaw RA, RB; chunk_load(RA, c, b, h, 0, wave, lane); chunk_load(RB, c, b, h, 1, wave, lane);
    float r4[4], k4[4], v4[4], e4[4], a4[4], inv4[4], ce[4]; unsigned twn = 0u;
    auto stepA = [&](ChunkRaw& R) __attribute__((always_inline)) {
#pragma unroll
        for (int s = 0; s < 4; ++s) { r4[s] = bf2f(R.r[s]); k4[s] = bf2f(R.k[s]); v4[s] = bf2f(R.v[s]); e4[s] = bf2f(R.e[s]); a4[s] = bf2f(R.a[s]); inv4[s] = R.inv[s]; }
        ce[0] = e4[0]; ce[1] = ce[0] + e4[1]; ce[2] = ce[1] + e4[2]; ce[3] = ce[2] + e4[3];
        TOT[wave * 64 + lane] = ce[3];
        twn = R.tw;
    };
    auto stepB = [&](const int q) __attribute__((always_inline)) {
        unsigned char* set = lds + q * CK_SET;
        bf16_t* AH = (bf16_t*)(set + CK_AH); bf16_t* BH = (bf16_t*)(set + CK_BH); bf16_t* KH = (bf16_t*)(set + CK_KH); bf16_t* RH = (bf16_t*)(set + CK_RH);
        bf16_t* BHT = (bf16_t*)(set + CK_BHT); bf16_t* KHT = (bf16_t*)(set + CK_KHT); bf16_t* VT = (bf16_t*)(set + CK_VT); float* GC = (float*)(set + CK_GC);
        float off = 0.f;
        float tws[7];
#pragma unroll
        for (int w = 0; w < 7; ++w) tws[w] = TOT[w * 64 + lane];
        asm volatile("" : "+v"(tws[0]), "+v"(tws[1]), "+v"(tws[2]), "+v"(tws[3]), "+v"(tws[4]), "+v"(tws[5]), "+v"(tws[6]));
#pragma unroll
        for (int w = 0; w < 7; ++w) off += (w < wave) ? tws[w] : 0.f;
        float bh[4], kh[4];
#pragma unroll
        for (int s = 0; s < 4; ++s) {
            const float cs = off + ce[s];
            const float g = __expf(-cs), gi = __expf(cs), gm1 = __expf(e4[s] - cs);
            const float kk = k4[s] * kkw * inv4[s], kp = k4[s] * (1.0f + (a4[s] - 1.0f) * kaw);
            bh[s] = kk * a4[s] * gi; kh[s] = kp * gi;
            const int t = wave * 4 + s;
            AH[t * CS64 + lane] = f2bf(-kk * gm1); BH[t * CS64 + lane] = f2bf(bh[s]); KH[t * CS64 + lane] = f2bf(kh[s]); RH[t * CS64 + lane] = f2bf(r4[s] * g);
            if (wave == 7 && s == 3) GC[lane] = g;
        }
        store_bf4(BHT + lane * CS32 + wave * 4, (f32x4){bh[0], bh[1], bh[2], bh[3]});
        store_bf4(KHT + lane * CS32 + wave * 4, (f32x4){kh[0], kh[1], kh[2], kh[3]});
        store_bf4(VT + lane * CS32 + wave * 4, (f32x4){v4[0], v4[1], v4[2], v4[3]});
        *(unsigned*)(TT + q * 32 * CS32 + (tid >> 4) * CS32 + (tid & 15) * 2) = twn;
    };
    auto stepC = [&](const int q) __attribute__((always_inline)) {
        if (wave < 2) return;
        unsigned char* set = lds + q * CK_SET;
        const bf16_t* AH = (const bf16_t*)(set + CK_AH); const bf16_t* BH = (const bf16_t*)(set + CK_BH); const bf16_t* KH = (const bf16_t*)(set + CK_KH); const bf16_t* RH = (const bf16_t*)(set + CK_RH);
        bf16_t* MRB = (bf16_t*)(set + CK_MRB);
        const int mq = wave >> 1, mt = wave & 1;
        const bf16_t* A = ((mq < 2) ? AH : RH) + mt * 16 * CS64; const bf16_t* Bt = (mq & 1) ? KH : BH;
        const bf16x8 a0 = ldf(A, CS64, lane, 0), a1 = ldf(A, CS64, lane, 32);
        const bf16x8 b00 = ldf(Bt, CS64, lane, 0), b01 = ldf(Bt, CS64, lane, 32), b10 = ldf(Bt + 16 * CS64, CS64, lane, 0), b11 = ldf(Bt + 16 * CS64, CS64, lane, 32);
        __builtin_amdgcn_sched_barrier(0);
#pragma unroll
        for (int nt = 0; nt < 2; ++nt) {
            const bf16x8 bk0 = nt ? b10 : b00, bk1 = nt ? b11 : b01;
            f32x4 acc = MFMA_BF(bk0, a0, Z4); acc = MFMA_BF(bk1, a1, acc);
            const int m = mt * 16 + l15, n0 = nt * 16 + 4 * qd;
#pragma unroll
            for (int i = 0; i < 4; ++i) { const bool keep = (mq < 2) ? (n0 + i < m) : (n0 + i <= m); if (!keep) acc[i] = 0.f; }
            store_bf4(((mq == 1) ? LAK : ((mq == 2) ? MRB : MRK)) + m * CS32 + n0, acc);
        }
    };
    stepA(RA); LDS_BARRIER();
    chunk_load(RA, c, b, h, 2, wave, lane);
    stepB(0); LDS_BARRIER();
    stepC(0); LDS_BARRIER();
    auto body = [&](const int ck, const int p, ChunkRaw& Rn) __attribute__((always_inline)) {
        const int q = p ^ 1;
        const bf16_t* S0c = S0B + p * 64 * CS64; bf16_t* S0n = S0B + q * 64 * CS64;
        unsigned char* set = lds + p * CK_SET;
        const bf16_t* AH = (const bf16_t*)(set + CK_AH); const bf16_t* RH = (const bf16_t*)(set + CK_RH);
        const bf16_t* BHT = (const bf16_t*)(set + CK_BHT); const bf16_t* KHT = (const bf16_t*)(set + CK_KHT); const bf16_t* VT = (const bf16_t*)(set + CK_VT);
        const float* GC = (const float*)(set + CK_GC); const bf16_t* MRB = (const bf16_t*)(set + CK_MRB);
        f32x4 y;
        {
            const bf16x8 r0 = ldf(AH + mt8 * 16 * CS64, CS64, lane, 0), r1 = ldf(AH + mt8 * 16 * CS64, CS64, lane, 32), r2 = ldf(S0c + nt8 * 16 * CS64, CS64, lane, 0), r3 = ldf(S0c + nt8 * 16 * CS64, CS64, lane, 32);
            const bf16x8 r4 = ldf(LAK + mt8 * 16 * CS32, CS32, lane, 0), r5 = ldf(VT + nt8 * 16 * CS32, CS32, lane, 0);
            const bf16x8 h0 = ldf(RH + mt8 * 16 * CS64, CS64, lane, 0), h1 = ldf(RH + mt8 * 16 * CS64, CS64, lane, 32), h4 = ldf(MRK + mt8 * 16 * CS32, CS32, lane, 0);
            const bf16x8 s0 = ldf(VT + svt * 16 * CS32, CS32, lane, 0), s1 = ldf(KHT + skt0 * 16 * CS32, CS32, lane, 0), s2 = ldf(KHT + (skt0 + 1) * 16 * CS32, CS32, lane, 0);
            __builtin_amdgcn_sched_barrier(0);
            f32x4 z = MFMA_BF(r0, r2, Z4); z = MFMA_BF(r1, r3, z); z = MFMA_BF(r4, r5, z);
            store_bf4(ZT + (nt8 * 16 + l15) * CS32 + mt8 * 16 + 4 * qd, z);
            y = MFMA_BF(r2, h0, Z4); y = MFMA_BF(r3, h1, y); y = MFMA_BF(r5, h4, y);
            Sreg[0] = MFMA_BF(s1, s0, Sreg[0]); Sreg[1] = MFMA_BF(s2, s0, Sreg[1]);
            stepA(Rn);
        }
        LDS_BARRIER();
        {
            const bf16x8 ua = ldf(TT + p * 32 * CS32 + mt8 * 16 * CS32, CS32, lane, 0), ub = ldf(ZT + nt8 * 16 * CS32, CS32, lane, 0);
            __builtin_amdgcn_sched_barrier(0);
            const f32x4 uacc = MFMA_BF(ua, ub, Z4);
            store_bf4(UT + (nt8 * 16 + l15) * CS32 + mt8 * 16 + 4 * qd, uacc);
            { const int ckn = (ck + 3 < NCK) ? ck + 3 : NCK - 1; chunk_load(Rn, c, b, h, ckn, wave, lane); }
            stepB(q);
        }
        LDS_BARRIER();
        {
            const bf16x8 ya = ldf(MRB + mt8 * 16 * CS32, CS32, lane, 0), yb = ldf(UT + nt8 * 16 * CS32, CS32, lane, 0);
            const bf16x8 sa = ldf(UT + svt * 16 * CS32, CS32, lane, 0), sb0 = ldf(BHT + skt0 * 16 * CS32, CS32, lane, 0), sb1 = ldf(BHT + (skt0 + 1) * 16 * CS32, CS32, lane, 0);
            const f32x4 gc0 = *(const f32x4*)(GC + skt0 * 16 + 4 * qd), gc1 = *(const f32x4*)(GC + (skt0 + 1) * 16 + 4 * qd);
            __builtin_amdgcn_sched_barrier(0);
            y = MFMA_BF(yb, ya, y);
            store_bf4(c.YRAW + ((size_t)b * SEQ + ck * 32 + mt8 * 16 + l15) * 512 + h * 64 + nt8 * 16 + 4 * qd, y);
            f32x4 s0 = MFMA_BF(sb0, sa, Sreg[0]), s1 = MFMA_BF(sb1, sa, Sreg[1]);
            s0 = s0 * gc0; s1 = s1 * gc1;
            Sreg[0] = s0; Sreg[1] = s1;
            store_bf4(S0n + (svt * 16 + l15) * CS64 + skt0 * 16 + 4 * qd, s0);
            store_bf4(S0n + (svt * 16 + l15) * CS64 + (skt0 + 1) * 16 + 4 * qd, s1);
            stepC(q);
        }
        LDS_BARRIER();
    };
#pragma unroll 1
    for (int ck = 0; ck < NCK; ck += 2) { body(ck, 0, RB); body(ck + 1, 1, RA); }
    __syncthreads();
}
DI void phase_rwkv_post(const Ctx& c, unsigned char* lds) {
    const int tid = TID(), lane = tid & 63, wave = tid >> 6;
    const size_t PL = (size_t)NT * 512;
    const bool balp = (gridDim.x == 256);
    const int nstep = balp ? ((blockIdx.x < 128) ? 7 : 9) : (NT / (int)(gridDim.x * 8) + 1);
    for (int sidx = 0; sidx < nstep; ++sidx) {
        int t;
        if (!balp) { t = blockIdx.x * 8 + wave + sidx * gridDim.x * 8; if (t >= NT) break; }
        else if (sidx < 8) t = sidx * 2048 + blockIdx.x * 8 + wave;
        else t = 7 * 2048 + (blockIdx.x - 128) * 8 + wave;
        bf16_t ry[8], rv[8], rg[8]; float bon[8], gw[8], gb[8];
#pragma unroll
        for (int h = 0; h < 8; ++h) { const size_t o = (size_t)t * 512 + h * 64 + lane; ry[h] = c.YRAW[o]; rv[h] = c.F[o + 2 * PL]; rg[h] = c.F[o + 5 * PL]; bon[h] = c.BON[((size_t)t * 8 + h) * 4 + 3];
            gw[h] = c.in(I_GNW)[c.l * 512 + h * 64 + lane]; gb[h] = c.in(I_GNB)[c.l * 512 + h * 64 + lane]; }
#pragma unroll
        for (int h = 0; h < 8; ++h) {
            const float y = bf2f(ry[h]);
            const float mean = wave_sum_dpp(y) * (1.0f / 64.0f);
            const float d = y - mean;
            const float var = wave_sum_dpp(d * d) * (1.0f / 64.0f);
            const float yn = d * rsqrtf(var + 64e-5f) * gw[h] + gb[h];
            c.F[(size_t)t * 512 + h * 64 + lane + 5 * PL] = f2bf((yn + bon[h] * bf2f(rv[h])) * bf2f(rg[h]));
        }
    }
    for (int it = blockIdx.x * 4; it < 768 + 128 + 128 + 256 + 256; it += gridDim.x * 4) {
        const float* WB = c.in(I_WBR) + (size_t)c.l * 2048 * DM; bf16_t* BR = (bf16_t*)(c.ws + WS_WT_BR);
        if (it < 768) convert_tile4(c.in(I_WMG) + (size_t)c.l * DM * 3 * DM, 3 * DM, 3 * DM, DM, (bf16_t*)(c.ws + WS_WT_MG), it, lds);
        else if (it < 896) convert_tile4(WB, DM, DM, 512, BR, it - 768, lds);
        else if (it < 1024) convert_tile4(WB + (size_t)512 * DM, DM, DM, 512, BR + (size_t)1024 * 512, it - 896, lds);
        else if (it < 1280) convert_tile4(WB + (size_t)1024 * DM, DM, DM, 1024, BR + (size_t)2048 * 512, it - 1024, lds);
        else convert_tile4(c.in(I_WOUT) + (size_t)c.l * DM * DM, DM, DM, DM, (bf16_t*)(c.ws + WS_WT_OUT), it - 1280, lds);
    }
}
constexpr int TS = 72;
constexpr int NSA_BIAS = 0;
constexpr int NSA_SELM = 2112;
constexpr int NSA_SCR = 2624;
constexpr int NSA_SLOTS = 8;
constexpr int NSA_K0 = 4672;
constexpr int NSA_V0 = NSA_K0 + NSA_SLOTS * 64 * TS * 2;
constexpr int NSA_A = NSA_K0 + 2 * 64 * TS * 2;
constexpr int NSA_B = NSA_A + 16384;
constexpr int NSA_END = NSA_V0 + NSA_SLOTS * 64 * TS * 2;
static_assert(NSA_B + 16384 <= NSA_V0, "nsa imp overlay");
static_assert(NSA_END <= LDS_BYTES - 48, "nsa lds");
static_assert(NSA_K0 % 16 == 0, "align");

struct NsaLane { int tq[2]; int h; float cbias; float m[2], l[2]; };

DI void nsa_prefetch(u32x4& rk, u32x4& rv, const bf16_t* kbase, int kstride, const bf16_t* vtbase, int vstride, int pos0, int tid) {
    const int r = tid >> 3, seg = (tid & 7) * 8;
    rk = *(const u32x4*)(kbase + (size_t)(pos0 + r) * kstride + seg);
    rv = *(const u32x4*)(vtbase + (size_t)r * vstride + pos0 + seg);
}
DI void nsa_store(unsigned char* lds, int buf, const u32x4& rk, const u32x4& rv, int tid) {
    const int r = tid >> 3, seg = (tid & 7) * 8;
    *(u32x4*)((bf16_t*)(lds + NSA_K0) + buf * 64 * TS + r * TS + seg) = rk;
    *(u32x4*)((bf16_t*)(lds + NSA_V0) + buf * 64 * TS + r * TS + seg) = rv;
}
template <int QM = 3>
DI void nsa_qk(f32x4 (&s)[2][4], const bf16_t* sK, const bf16x8 (&qf)[2][2], int lane) {
    const bf16_t* kp = sK + (lane & 15) * TS + (lane >> 4) * 8;
#define NSA_LDK(f) (*(const bf16x8*)(kp + ((f) >> 1) * 16 * TS + ((f) & 1) * 32))
#define NSA_QK_STEP(f, cur, nxt) do { if ((f) + 2 < 8) nxt = NSA_LDK((f) + 2); __builtin_amdgcn_sched_barrier(0); \
        _Pragma("unroll") for (int qi = 0; qi < 2; ++qi) if ((QM >> qi) & 1) s[qi][(f) >> 1] = __builtin_amdgcn_mfma_f32_16x16x32_bf16(cur, qf[qi][(f) & 1], (((f) & 1) == 0) ? (f32x4){0.f, 0.f, 0.f, 0.f} : s[qi][(f) >> 1], 0, 0, 0); \
        __builtin_amdgcn_sched_barrier(0); } while (0)
    bf16x8 k0 = NSA_LDK(0), k1 = NSA_LDK(1), k2;
    NSA_QK_STEP(0, k0, k2); NSA_QK_STEP(1, k1, k0); NSA_QK_STEP(2, k2, k1); NSA_QK_STEP(3, k0, k2);
    NSA_QK_STEP(4, k1, k0); NSA_QK_STEP(5, k2, k1); NSA_QK_STEP(6, k0, k2); NSA_QK_STEP(7, k1, k0);
#undef NSA_QK_STEP
#undef NSA_LDK
}
template <int MODE>
DI void nsa_logits(float (&x)[4][4], const f32x4 (&s)[4], int tq, int h, float cbias, bool rowsel, int pos0, int qd, const float* biasT) {
    if (MODE == 1) {
#pragma unroll
        for (int kt = 0; kt < 4; ++kt)
#pragma unroll
            for (int i = 0; i < 4; ++i) x[kt][i] = rowsel ? s[kt][i] + cbias : -INFINITY;
        return;
    }
    if (MODE == 4) {
#pragma unroll
        for (int kt = 0; kt < 4; ++kt)
#pragma unroll
            for (int i = 0; i < 4; ++i) { const int kk = pos0 + 16 * kt + 4 * qd + i; x[kt][i] = (tq - kk < 512) ? s[kt][i] + cbias : -INFINITY; }
        return;
    }
#pragma unroll
    for (int hb = 0; hb < 2; ++hb) {
        float bias[2][4];
#pragma unroll
        for (int k2 = 0; k2 < 2; ++k2)
#pragma unroll
            for (int i = 0; i < 4; ++i) {
                const int kk = pos0 + 16 * (2 * hb + k2) + 4 * qd + i;
                const int dist = (MODE == 0) ? (tq - 16 * kk - 31) : (tq - kk);
                const int di = dist < 0 ? 0 : (dist > 128 ? 128 : dist);
                bias[k2][i] = biasT[di * 4 + h];
            }
        asm volatile("" : "+v"(bias[0][0]), "+v"(bias[0][1]), "+v"(bias[0][2]), "+v"(bias[0][3]), "+v"(bias[1][0]), "+v"(bias[1][1]), "+v"(bias[1][2]), "+v"(bias[1][3]));
#pragma unroll
        for (int k2 = 0; k2 < 2; ++k2)
#pragma unroll
            for (int i = 0; i < 4; ++i) {
                const int kt = 2 * hb + k2;
                const int kk = pos0 + 16 * kt + 4 * qd + i;
                const int dist = (MODE == 0) ? (tq - 16 * kk - 31) : (tq - kk);
                bool ok = dist >= 0;
                if (MODE == 2) ok = ok && rowsel;
                if (MODE == 3) ok = ok && (dist < 512);
                x[kt][i] = ok ? s[kt][i] + bias[k2][i] : -INFINITY;
            }
    }
}
DI float quad16_max(float v) {
    { const auto r = __builtin_amdgcn_permlane16_swap(__float_as_uint(v), __float_as_uint(v), false, false); v = fmaxf(__uint_as_float(r[0]), __uint_as_float(r[1])); }
    { const auto r = __builtin_amdgcn_permlane32_swap(__float_as_uint(v), __float_as_uint(v), false, false); v = fmaxf(__uint_as_float(r[0]), __uint_as_float(r[1])); }
    return v; }
DI float quad16_sum(float v) {
    { const auto r = __builtin_amdgcn_permlane16_swap(__float_as_uint(v), __float_as_uint(v), false, false); v = __uint_as_float(r[0]) + __uint_as_float(r[1]); }
    { const auto r = __builtin_amdgcn_permlane32_swap(__float_as_uint(v), __float_as_uint(v), false, false); v = __uint_as_float(r[0]) + __uint_as_float(r[1]); }
    return v; }
DI void nsa_softmax(const float (&x)[4][4], float& m, float& l, f32x4 (&O)[4], bf16x8 (&pf)[2]) {
    float mx = -INFINITY;
#pragma unroll
    for (int kt = 0; kt < 4; ++kt)
#pragma unroll
        for (int i = 0; i < 4; ++i) mx = fmaxf(mx, x[kt][i]);
    mx = quad16_max(mx);
    const float mn = fmaxf(m, mx);
    const float mu = (mn == -INFINITY) ? 0.f : mn;
    const float mu2 = mu * 1.4426950408889634f;
    const bool changed = mn != m;
    const float sc = changed ? __builtin_amdgcn_exp2f(__builtin_fmaf(m, 1.4426950408889634f, -mu2)) : 1.0f;
    float p[4][4]; float ps = 0.f;
#pragma unroll
    for (int kt = 0; kt < 4; ++kt)
#pragma unroll
        for (int i = 0; i < 4; ++i) { p[kt][i] = __builtin_amdgcn_exp2f(__builtin_fmaf(x[kt][i], 1.4426950408889634f, -mu2)); ps += p[kt][i]; }
    l = l * sc + ps; m = mn;
    if (__ballot(changed) != 0ull) {
#pragma unroll
        for (int dt = 0; dt < 4; ++dt) O[dt] = O[dt] * sc;
    }
#pragma unroll
    for (int ks = 0; ks < 2; ++ks) {
        u32x4 w; w.x = pack2(p[2 * ks][0], p[2 * ks][1]); w.y = pack2(p[2 * ks][2], p[2 * ks][3]); w.z = pack2(p[2 * ks + 1][0], p[2 * ks + 1][1]); w.w = pack2(p[2 * ks + 1][2], p[2 * ks + 1][3]);
        pf[ks] = __builtin_bit_cast(bf16x8, w);
    }
}
DI void nsa_softmax_far(const f32x4 (&s)[4], float cbias, bool rs, float& m, float& l, f32x4 (&O)[4], bf16x8 (&pf)[2]) {
    constexpr float LOG2E = 1.4426950408889634f;
    float mx = fmaxf(fmaxf(s[0][0], s[0][1]), fmaxf(s[0][2], s[0][3]));
#pragma unroll
    for (int kt = 1; kt < 4; ++kt) mx = fmaxf(mx, fmaxf(fmaxf(s[kt][0], s[kt][1]), fmaxf(s[kt][2], s[kt][3])));
    mx = quad16_max(mx) + cbias;
    const float mn = rs ? fmaxf(m, mx) : m;
    const float mu2 = ((mn == -INFINITY) ? 0.f : mn) * LOG2E;
    const bool changed = mn != m;
    const float sc = changed ? __builtin_amdgcn_exp2f(__builtin_fmaf(m, LOG2E, -mu2)) : 1.0f;
    const float c0 = rs ? __builtin_fmaf(cbias, LOG2E, -mu2) : -INFINITY;
    const f32x2 c2 = (f32x2){c0, c0};
    f32x2 p[4][2]; f32x2 ps2 = (f32x2){0.f, 0.f};
#pragma unroll
    for (int kt = 0; kt < 4; ++kt)
#pragma unroll
        for (int hh = 0; hh < 2; ++hh) {
            const f32x2 t = (f32x2){s[kt][2 * hh], s[kt][2 * hh + 1]} * LOG2E + c2;
            p[kt][hh] = (f32x2){__builtin_amdgcn_exp2f(t[0]), __builtin_amdgcn_exp2f(t[1])};
            ps2 += p[kt][hh];
        }
    l = l * sc + (ps2[0] + ps2[1]); m = mn;
    if (__ballot(changed) != 0ull) {
#pragma unroll
        for (int dt = 0; dt < 4; ++dt) O[dt] = O[dt] * sc;
    }
#pragma unroll
    for (int ks = 0; ks < 2; ++ks) {
        u32x4 w; w.x = pack2(p[2 * ks][0][0], p[2 * ks][0][1]); w.y = pack2(p[2 * ks][1][0], p[2 * ks][1][1]); w.z = pack2(p[2 * ks + 1][0][0], p[2 * ks + 1][0][1]); w.w = pack2(p[2 * ks + 1][1][0], p[2 * ks + 1][1][1]);
        pf[ks] = __builtin_bit_cast(bf16x8, w);
    }
}
template <int QM = 3>
DI void nsa_pv(f32x4 (&O)[2][4], const bf16_t* sV, const bf16x8 (&pf)[2][2], int lane) {
    const bf16_t* vp0 = sV + (lane & 15) * TS + 4 * (lane >> 4);
    u32x2 a0, b0, a1, b1, a2, b2;
#define NSA_LDV(f, a, b) do { const bf16_t* vp = vp0 + ((f) >> 1) * 16 * TS + ((f) & 1) * 32; a = *(const u32x2*)vp; b = *(const u32x2*)(vp + 16); } while (0)
#define NSA_PV_STEP(f, ca, cb, na, nb) do { if ((f) + 2 < 8) NSA_LDV((f) + 2, na, nb); __builtin_amdgcn_sched_barrier(0); \
        { u32x4 w; w.x = ca.x; w.y = ca.y; w.z = cb.x; w.w = cb.y; const bf16x8 vf = __builtin_bit_cast(bf16x8, w); \
          _Pragma("unroll") for (int qi = 0; qi < 2; ++qi) if ((QM >> qi) & 1) O[qi][(f) >> 1] = __builtin_amdgcn_mfma_f32_16x16x32_bf16(vf, pf[qi][(f) & 1], O[qi][(f) >> 1], 0, 0, 0); } \
        __builtin_amdgcn_sched_barrier(0); } while (0)
    NSA_LDV(0, a0, b0); NSA_LDV(1, a1, b1);
    NSA_PV_STEP(0, a0, b0, a2, b2); NSA_PV_STEP(1, a1, b1, a0, b0); NSA_PV_STEP(2, a2, b2, a1, b1); NSA_PV_STEP(3, a0, b0, a2, b2);
    NSA_PV_STEP(4, a1, b1, a0, b0); NSA_PV_STEP(5, a2, b2, a1, b1); NSA_PV_STEP(6, a0, b0, a2, b2); NSA_PV_STEP(7, a1, b1, a0, b0);
#undef NSA_PV_STEP
#undef NSA_LDV
}
template <int MODE, int QM = 3>
DI void nsa_tile(f32x4 (&O)[2][4], NsaLane& L, const bf16x8 (&qf)[2][2], const unsigned char* lds, int buf, int pos0, bool sel0, bool sel1, int lane) {
    const bf16_t* sK = (const bf16_t*)(lds + NSA_K0) + buf * 64 * TS;
    const bf16_t* sV = (const bf16_t*)(lds + NSA_V0) + buf * 64 * TS;
    const float* biasT = (const float*)(lds + NSA_BIAS);
    f32x4 s[2][4];
    nsa_qk<QM>(s, sK, qf, lane);
    bf16x8 pf[2][2];
#pragma unroll
    for (int qi = 0; qi < 2; ++qi) if ((QM >> qi) & 1) {
        if (MODE == 1) nsa_softmax_far(s[qi], L.cbias, qi ? sel1 : sel0, L.m[qi], L.l[qi], O[qi], pf[qi]);
        else {
            float x[4][4];
            nsa_logits<MODE>(x, s[qi], L.tq[qi], L.h, L.cbias, qi ? sel1 : sel0, pos0, lane >> 4, biasT);
            nsa_softmax(x, L.m[qi], L.l[qi], O[qi], pf[qi]);
        }
    }
    nsa_pv<QM>(O, sV, pf, lane);
}
template <int MODE>
DI void nsa_tile_sel(f32x4 (&O)[2][4], NsaLane& L, const bf16x8 (&qf)[2][2], const unsigned char* lds, int buf, int pos0, bool sel0, bool sel1, int lane) {
    const bool a0 = __ballot(sel0) != 0ull, a1 = __ballot(sel1) != 0ull;
    if (a0 && a1) nsa_tile<MODE, 3>(O, L, qf, lds, buf, pos0, sel0, sel1, lane);
    else if (a0) nsa_tile<MODE, 1>(O, L, qf, lds, buf, pos0, sel0, sel1, lane);
    else if (a1) nsa_tile<MODE, 2>(O, L, qf, lds, buf, pos0, sel0, sel1, lane);
}
DI void nsa_flush(f32x4 (&Y)[2][4], f32x4 (&O)[2][4], NsaLane& L, const float (&gate)[2]) {
#pragma unroll
    for (int qi = 0; qi < 2; ++qi) {
        const float lt = quad16_sum(L.l[qi]);
        const float f = (lt > 0.f) ? gate[qi] * __builtin_amdgcn_rcpf(lt) : 0.f;
#pragma unroll
        for (int dt = 0; dt < 4; ++dt) { Y[qi][dt] += O[qi][dt] * f; O[qi][dt] = (f32x4){0.f, 0.f, 0.f, 0.f}; }
    }
}
DI void nsa_item(const Ctx& c, int item, unsigned char* lds) {
    const int tid = TID(), lane = tid & 63, wave = tid >> 6, qd = lane >> 4;
    const int b = item >> 8, g = (item >> 6) & 3, qt = item & 63, t0 = qt * 64, cur = qt, bg = b * 4 + g;
    float* biasT = (float*)(lds + NSA_BIAS);
    unsigned long long* selm = (unsigned long long*)(lds + NSA_SELM);
    float* scr = (float*)(lds + NSA_SCR) + wave * 64;
    float* impA = (float*)(lds + NSA_A); float* impB = (float*)(lds + NSA_B);
    __syncthreads();
    for (int i = tid; i < 129 * 4; i += NTHREADS) { const int d = i >> 2, h = i & 3; biasT[i] = c.in(I_RELB)[t5_bucket(d) * 16 + g * 4 + h]; }
    for (int i = tid; i < 2 * 4096; i += NTHREADS) impA[i] = 0.f;
    NsaLane L; L.h = lane & 3;
    bf16x8 qf[2][2]; float gates[2][3];
    const bf16_t* pbat = c.PROJ + (size_t)b * SEQ * IN_COLS;
#pragma unroll
    for (int qi = 0; qi < 2; ++qi) {
        const int tl = 8 * wave + 4 * qi + ((lane & 15) >> 2);
        L.tq[qi] = t0 + tl;
        const bf16_t* prow = pbat + (size_t)L.tq[qi] * IN_COLS;
#pragma unroll
        for (int ks = 0; ks < 2; ++ks) {
            u32x4 w = *(const u32x4*)(prow + C_Q + (g * 4 + L.h) * 64 + 32 * ks + qd * 8);
            w.x = pack2(bflo(w.x) * 0.125f, bfhi(w.x) * 0.125f); w.y = pack2(bflo(w.y) * 0.125f, bfhi(w.y) * 0.125f);
            w.z = pack2(bflo(w.z) * 0.125f, bfhi(w.z) * 0.125f); w.w = pack2(bflo(w.w) * 0.125f, bfhi(w.w) * 0.125f);
            qf[qi][ks] = __builtin_bit_cast(bf16x8, w);
        }
#pragma unroll
        for (int br = 0; br < 3; ++br) gates[qi][br] = sigmoidf_(bf2f(prow[C_GATE + g * 12 + L.h * 3 + br]));
    }
    __syncthreads();
    L.cbias = biasT[128 * 4 + L.h];
    f32x4 O[2][4], Y[2][4];
#pragma unroll
    for (int qi = 0; qi < 2; ++qi)
#pragma unroll
        for (int dt = 0; dt < 4; ++dt) { O[qi][dt] = (f32x4){0.f, 0.f, 0.f, 0.f}; Y[qi][dt] = (f32x4){0.f, 0.f, 0.f, 0.f}; }
    u32x4 rk, rv;
    const int nvis_max = (t0 + 63 >= 31) ? ((t0 + 63 - 31) >> 4) + 1 : 0;
    const int ncb = (nvis_max + 63) >> 6;
    const bf16_t* kcb = c.KC + (size_t)bg * 256 * 64; const bf16_t* vcb = c.VCT + (size_t)bg * 64 * 256;
    L.m[0] = L.m[1] = -INFINITY; L.l[0] = L.l[1] = 0.f;
    if (ncb > 0) nsa_prefetch(rk, rv, kcb, 64, vcb, 256, 0, tid);
    for (int cb = 0; cb < ncb; ++cb) {
        nsa_store(lds, cb & 1, rk, rv, tid);
        __syncthreads();
        if (cb + 1 < ncb) nsa_prefetch(rk, rv, kcb, 64, vcb, 256, (cb + 1) * 64, tid);
        if (16 * (cb * 64 + 63) + 31 + 128 <= t0) nsa_tile<1>(O, L, qf, lds, cb & 1, cb * 64, true, true, lane);
        else nsa_tile<0>(O, L, qf, lds, cb & 1, cb * 64, true, true, lane);
    }
    if (ncb > 0) nsa_prefetch(rk, rv, kcb, 64, vcb, 256, 0, tid);
    float mfin[2], linv[2];
#pragma unroll
    for (int qi = 0; qi < 2; ++qi) { mfin[qi] = L.m[qi]; const float lt = quad16_sum(L.l[qi]); linv[qi] = (lt > 0.f) ? __builtin_amdgcn_rcpf(lt) : 0.f; }
    { const float gg[2] = {gates[0][0], gates[1][0]}; nsa_flush(Y, O, L, gg); }
    __syncthreads();
    for (int cb = 0; cb < ncb; ++cb) {
        nsa_store(lds, cb & 1, rk, rv, tid);
        __syncthreads();
        if (cb + 1 < ncb) nsa_prefetch(rk, rv, kcb, 64, vcb, 256, (cb + 1) * 64, tid);
        const bf16_t* sK = (const bf16_t*)(lds + NSA_K0) + (cb & 1) * 64 * TS;
        f32x4 s[2][4];
        nsa_qk(s, sK, qf, lane);
#pragma unroll
        for (int qi = 0; qi < 2; ++qi) {
            float x[4][4];
            if (16 * (cb * 64 + 63) + 31 + 128 <= t0) nsa_logits<1>(x, s[qi], L.tq[qi], L.h, L.cbias, true, cb * 64, qd, biasT);
            else nsa_logits<0>(x, s[qi], L.tq[qi], L.h, L.cbias, true, cb * 64, qd, biasT);
            const float mu2 = ((mfin[qi] == -INFINITY) ? 0.f : mfin[qi]) * 1.4426950408889634f;
#pragma unroll
            for (int kt = 0; kt < 4; ++kt) {
#define E2_(v) __builtin_amdgcn_exp2f(__builtin_fmaf((v), 1.4426950408889634f, -mu2))
                float p3 = E2_(x[kt][3]) * linv[qi];
                float pa = (E2_(x[kt][0]) + E2_(x[kt][1]) + E2_(x[kt][2])) * linv[qi] + p3;
#undef E2_
                pa += DPP_MOV(pa, 0xB1); p3 += DPP_MOV(p3, 0xB1);
                pa += DPP_MOV(pa, 0x4E); p3 += DPP_MOV(p3, 0x4E);
                if (L.h == 0) { const int tl = 8 * wave + 4 * qi + ((lane & 15) >> 2), mi = 16 * cb + 4 * kt + qd; impA[tl * 64 + mi] = pa; impB[tl * 64 + mi] = p3; }
            }
        }
    }
    const bf16_t* ksb = pbat + C_KS + g * 64; const bf16_t* vsb = c.VT + ((size_t)0 * 16 + bg) * 64 * SEQ;
    nsa_prefetch(rk, rv, ksb, IN_COLS, vsb, SEQ, 0, tid);
    __syncthreads();
    {
        float impv[8];
#pragma unroll
        for (int tl8 = 0; tl8 < 8; ++tl8) {
            const int tl = 8 * wave + tl8, n = lane;
            const bool cand = (n >= 1) && (n <= cur - 2);
            impv[tl8] = cand ? impA[tl * 64 + n] + impB[tl * 64 + n - 1] : -1.0f;
        }
#pragma unroll
        for (int tl8 = 0; tl8 < 8; ++tl8) {
            const int n = lane;
            float v = impv[tl8];
            unsigned long long msk = 0ull;
#pragma unroll
            for (int r = 0; r < 5; ++r) {
                const float mx = wave_max_dpp(v);
                const unsigned long long eq = __ballot(v == mx);
                if (mx >= 0.f) { const int idx = (int)__builtin_ctzll(eq); msk |= 1ull << idx; if (n == idx) v = -2.0f; }
            }
            const bool forced = (n <= cur) && (n == 0 || n == cur || n == cur - 1);
            msk |= __ballot(forced);
            if (lane == 0) selm[8 * wave + tl8] = msk;
        }
    }
    __syncthreads();
    unsigned long long uni = selm[lane];
#pragma unroll
    for (int o = 32; o >= 1; o >>= 1) { const unsigned lo_ = __shfl_xor((unsigned)uni, o), hi_ = __shfl_xor((unsigned)(uni >> 32), o); uni |= ((unsigned long long)hi_ << 32) | lo_; }
    uni = ((unsigned long long)__builtin_amdgcn_readfirstlane((unsigned)(uni >> 32)) << 32) | (unsigned)__builtin_amdgcn_readfirstlane((unsigned)uni);
    unsigned long long sm[2];
#pragma unroll
    for (int qi = 0; qi < 2; ++qi) sm[qi] = selm[8 * wave + 4 * qi + ((lane & 15) >> 2)];
    L.m[0] = L.m[1] = -INFINITY; L.l[0] = L.l[1] = 0.f;
    {
        unsigned long long rem = uni;
        int jg[4]; int ng = 0;
        u32x4 gk[4], gv[4];
#pragma unroll
        for (int t = 0; t < 4; ++t) { jg[t] = -1; if (rem) { jg[t] = (int)__builtin_ctzll(rem); rem &= rem - 1; ++ng; } }
        gk[0] = rk; gv[0] = rv;
#pragma unroll
        for (int t = 1; t < 4; ++t) if (jg[t] >= 0) nsa_prefetch(gk[t], gv[t], ksb, IN_COLS, vsb, SEQ, jg[t] * 64, tid);
#pragma unroll
        for (int t = 0; t < 4; ++t) if (jg[t] >= 0) nsa_store(lds, t, gk[t], gv[t], tid);
        __syncthreads();
        int gp = 0;
        for (;;) {
            int jn[4];
#pragma unroll
            for (int t = 0; t < 4; ++t) { jn[t] = -1; if (rem) { jn[t] = (int)__builtin_ctzll(rem); rem &= rem - 1; } }
#pragma unroll
            for (int t = 0; t < 4; ++t) if (jn[t] >= 0) nsa_prefetch(gk[t], gv[t], ksb, IN_COLS, vsb, SEQ, jn[t] * 64, tid);
#pragma unroll 1
            for (int t = 0; t < 4; ++t) {
                const int j = jg[t];
                if (j < 0) break;
                const bool s0 = (sm[0] >> j) & 1ull, s1 = (sm[1] >> j) & 1ull;
                if (j <= cur - 3) nsa_tile_sel<1>(O, L, qf, lds, gp * 4 + t, j * 64, s0, s1, lane);
                else nsa_tile_sel<2>(O, L, qf, lds, gp * 4 + t, j * 64, s0, s1, lane);
            }
            if (jn[0] < 0) break;
            gp ^= 1;
#pragma unroll
            for (int t = 0; t < 4; ++t) if (jn[t] >= 0) nsa_store(lds, gp * 4 + t, gk[t], gv[t], tid);
            __syncthreads();
#pragma unroll
            for (int t = 0; t < 4; ++t) jg[t] = jn[t];
        }
    }
    const bf16_t* kwb = pbat + C_KW + g * 64; const bf16_t* vwb = c.VT + ((size_t)1 * 16 + bg) * 64 * SEQ;
    const int j0 = (cur - 8 > 0) ? cur - 8 : 0;
    nsa_prefetch(rk, rv, kwb, IN_COLS, vwb, SEQ, j0 * 64, tid);
    { const float gg[2] = {gates[0][1], gates[1][1]}; nsa_flush(Y, O, L, gg); }
    L.m[0] = L.m[1] = -INFINITY; L.l[0] = L.l[1] = 0.f;
    {
        __syncthreads();
        for (int j = j0; j <= cur; ++j) {
            nsa_store(lds, (j - j0) & 1, rk, rv, tid);
            __syncthreads();
            if (j + 1 <= cur) nsa_prefetch(rk, rv, kwb, IN_COLS, vwb, SEQ, (j + 1) * 64, tid);
            if (cur - j >= 3 && cur - j <= 7) nsa_tile<1>(O, L, qf, lds, (j - j0) & 1, j * 64, true, true, lane);
            else if (cur - j == 8) nsa_tile<4>(O, L, qf, lds, (j - j0) & 1, j * 64, true, true, lane);
            else nsa_tile<3>(O, L, qf, lds, (j - j0) & 1, j * 64, true, true, lane);
        }
    }
    { const float gg[2] = {gates[0][2], gates[1][2]}; nsa_flush(Y, O, L, gg); }
#pragma unroll
    for (int qi = 0; qi < 2; ++qi) {
        bf16_t* yrow = c.PROJ + ((size_t)b * SEQ + L.tq[qi]) * IN_COLS + C_Q + (g * 4 + L.h) * 64;
#pragma unroll
        for (int dt = 0; dt < 4; ++dt) store_bf4(yrow + 16 * dt + 4 * qd, Y[qi][dt]);
    }
}
DI void phase_mix(const Ctx& c, unsigned char* lds) {
    const int G = gridDim.x, bid = blockIdx.x;
    const int n_nsa = NB * 4 * (SEQ / 64), n_scan = NB * 8;
    for (int item = bid; item < n_scan; item += G) scan_chunked_item(c, item, lds);
    unsigned* ctr = c.ctl + CW_Q + c.l;
    volatile int* sitem = (volatile int*)(lds + LDS_BYTES - 32);
    for (;;) {
        __syncthreads();
        if (TID() == 0) *sitem = (int)atomicAdd(ctr, 1u);
        __syncthreads();
        const int k = *sitem;
        if (k >= n_nsa) break;
        const int qt = 63 - (k >> 4), bgi = k & 15;
        nsa_item(c, (bgi << 6) | qt, lds);
    }
}

DI void phase_merge(const Ctx& c, unsigned char* lds) {
    const int nN = DM / 256;
    const bf16_t* WM = (const bf16_t*)(c.ws + WS_WT_MG);
    const bf16_t* BR = (const bf16_t*)(c.ws + WS_WT_BR);
    const float* BM_ = c.in(I_BMG) + (size_t)c.l * 3 * DM;
    bf16_t* TMP = c.F + (size_t)2 * NT * 512 + (size_t)blockIdx.x * 256 * 256;
    for (int it = 0;; ++it) {
        int tm, tn; if (!xcd_unit(it, nN, tm, tn)) break;
        const int m0 = tm * 256, n0 = tn * 256;
#pragma unroll 1
        for (int i = 0; i < 3; ++i) {
            f32x4 acc[8][4];
#pragma unroll
            for (int a_ = 0; a_ < 8; ++a_)
#pragma unroll
                for (int b_ = 0; b_ < 4; ++b_) acc[a_][b_] = (f32x4){0.f, 0.f, 0.f, 0.f};
            gemm256_dma(acc, c.H + (size_t)m0 * DM, DM, WM + (size_t)(i * DM + n0) * DM, DM, DM, lds, nullptr, 0u, true);
            tile256_store_bf16(acc, TMP, 256, 256, lds, 256, true);
#pragma unroll
            for (int a_ = 0; a_ < 8; ++a_)
#pragma unroll
                for (int b_ = 0; b_ < 4; ++b_) acc[a_][b_] = (f32x4){0.f, 0.f, 0.f, 0.f};
            {
                const bf16_t* Ab = (i == 0) ? c.POOLED + (size_t)m0 * 512 : ((i == 1) ? c.F + (size_t)5 * NT * 512 + (size_t)m0 * 512 : c.PROJ + C_Q + (size_t)m0 * IN_COLS);
                const size_t la = (i == 2) ? (size_t)IN_COLS : (size_t)512;
                const int Kb = (i == 2) ? 1024 : 512;
                gemm256_dma(acc, Ab, la, BR + (size_t)i * 1024 * 512 + (size_t)n0 * Kb, (size_t)Kb, Kb, lds, nullptr, 0u, true);
            }
            const int lane = TID() & 63, wave = TID() >> 6, wm = wave >> 2, wn = wave & 3;
            const float* bias = BM_ + i * DM + n0;
            f32x4 bb[2][2];
#pragma unroll
            for (int bj = 0; bj < 2; ++bj) { bb[bj][0] = *(const f32x4*)(bias + C256P(2 * bj)); bb[bj][1] = *(const f32x4*)(bias + C256P(2 * bj) + 4); }
            u32x4 gvc, pvc = (u32x4){0u, 0u, 0u, 0u}, gvn, pvn = (u32x4){0u, 0u, 0u, 0u};
            gvc = *(const u32x4*)(TMP + R256(0) * 256 + C256P(0));
            if (i > 0) pvc = *(const u32x4*)(c.MERGED + (size_t)(m0 + R256(0)) * DM + n0 + C256P(0));
#pragma unroll
            for (int st = 0; st < 16; ++st) {
                const int mi = st >> 1, bj = st & 1;
                if (st + 1 < 16) { const int mn = (st + 1) >> 1, bn = (st + 1) & 1;
                    gvn = *(const u32x4*)(TMP + R256(mn) * 256 + C256P(2 * bn));
                    if (i > 0) pvn = *(const u32x4*)(c.MERGED + (size_t)(m0 + R256(mn)) * DM + n0 + C256P(2 * bn)); }
                __builtin_amdgcn_sched_barrier(0);
                const u32x4 gv = gvc, pv = pvc;
                const f32x4 b0 = bb[bj][0], b1 = bb[bj][1];
                const f32x4 a0 = acc[mi][2 * bj], a1 = acc[mi][2 * bj + 1];
                u32x4 o;
                o.x = pack2(bflo(pv.x) + sigmoidf_(bflo(gv.x) + b0[0]) * a0[0], bfhi(pv.x) + sigmoidf_(bfhi(gv.x) + b0[1]) * a0[1]);
                o.y = pack2(bflo(pv.y) + sigmoidf_(bflo(gv.y) + b0[2]) * a0[2], bfhi(pv.y) + sigmoidf_(bfhi(gv.y) + b0[3]) * a0[3]);
                o.z = pack2(bflo(pv.z) + sigmoidf_(bflo(gv.z) + b1[0]) * a1[0], bfhi(pv.z) + sigmoidf_(bfhi(gv.z) + b1[1]) * a1[1]);
                o.w = pack2(bflo(pv.w) + sigmoidf_(bflo(gv.w) + b1[2]) * a1[2], bfhi(pv.w) + sigmoidf_(bfhi(gv.w) + b1[3]) * a1[3]);
                *(u32x4*)(c.MERGED + (size_t)(m0 + R256(mi)) * DM + n0 + C256P(2 * bj)) = o;
                gvc = gvn; pvc = pvn;
                __builtin_amdgcn_sched_barrier(0);
            }
        }
    }
}

DI void phase_outp(const Ctx& c, unsigned char* lds) {
    const int nN = DM / 256;
    const bf16_t* W = (const bf16_t*)(c.ws + WS_WT_OUT);
    const float* xin = (c.l == 0) ? c.in(I_X) : c.out;
    for (int it = 0;; ++it) {
        int tm, tn; if (!xcd_unit(it, nN, tm, tn)) break;
        const int m0 = tm * 256, n0 = tn * 256;
        f32x4 acc[8][4];
#pragma unroll
        for (int i = 0; i < 8; ++i)
#pragma unroll
            for (int j = 0; j < 4; ++j) acc[i][j] = (f32x4){0.f, 0.f, 0.f, 0.f};
        gemm256_dma(acc, c.MERGED + (size_t)m0 * DM, DM, W + (size_t)n0 * DM, DM, DM, lds);
        const int lane = TID() & 63, wave = TID() >> 6, wm = wave >> 2, wn = wave & 3;
#pragma unroll
        for (int mi = 0; mi < 8; ++mi)
#pragma unroll
            for (int ni = 0; ni < 4; ++ni) {
                const size_t o = (size_t)(m0 + R256(mi)) * DM + n0 + C256(ni);
                const f32x4 x = *(const f32x4*)(xin + o); *(f32x4*)(c.out + o) = x + acc[mi][ni];
            }
    }
    for (int it = blockIdx.x * 8; it < 2 * 32 * 64; it += gridDim.x * 8) {
        const int mat = it / 2048, e = (it >> 6) & 31, tl = it & 63;
        if (mat == 0) convert_tiles<8>(c.in(I_EG) + ((size_t)c.l * 32 + e) * DM * 256, 256, 256, DM, (bf16_t*)(c.ws + WS_EG) + (size_t)e * 256 * DM, tl, lds);
        else convert_tiles<8>(c.in(I_EU) + ((size_t)c.l * 32 + e) * DM * 256, 256, 256, DM, (bf16_t*)(c.ws + WS_EU) + (size_t)e * 256 * DM, tl, lds);
    }
}

DI void phase_norm2(const Ctx& c, unsigned char* lds) {
    const int tid = TID(), lane = tid & 63, wave = tid >> 6;
    const float* gain = c.in(I_NFFN) + c.l * DM;
    const float* wrg = c.in(I_WRG) + (size_t)c.l * DM * 4; const float* brg = c.in(I_BRG) + c.l * 4;
    const float* wre = c.in(I_WRE) + (size_t)c.l * DM * 32; const float* bre = c.in(I_BRE) + c.l * 32;
    unsigned* cnt = c.ctl + CW_CNT + c.l * 32;
    constexpr int N2_B01 = 0, N2_B2 = 131072, N2_RS = 147456, N2_LCNT = N2_RS + 256, N2_LG = 0, N2_PART = 16384;
    float* B01 = (float*)(lds + N2_B01); float* B2 = (float*)(lds + N2_B2); float* RS = (float*)(lds + N2_RS);
    unsigned* lcnt = (unsigned*)(lds + N2_LCNT); unsigned* lbase = lcnt + 32;
    for (int rb = blockIdx.x; rb < NT / 64; rb += gridDim.x) {
        const int r0b = rb * 64;
        __syncthreads();
#pragma unroll 4
        for (int p = tid; p < 8192; p += NTHREADS) {
            const f32x4 w = *(const f32x4*)(wre + (size_t)p * 4);
            const int k = p >> 3, c4 = (p & 7) * 4, kb = k >> 4, kq = (k >> 2) & 3, m = k & 3, jj = c4 >> 4, cl = c4 & 15;
            float* d = B01 + (((kb * 2 + jj) * 64 + kq * 16 + cl) * 4) + m;
            d[0] = w[0]; d[4] = w[1]; d[8] = w[2]; d[12] = w[3];
        }
#pragma unroll
        for (int p = tid; p < 1024; p += NTHREADS) {
            const f32x4 w = *(const f32x4*)(wrg + (size_t)p * 4);
            const int kb = p >> 4, kq = (p >> 2) & 3, m = p & 3;
            float* d = B2 + ((kb * 4 + kq) * 4) * 4 + m;
            d[0] = w[0]; d[4] = w[1]; d[8] = w[2]; d[12] = w[3];
        }
        if (tid < 32) lcnt[tid] = 0u;
#pragma unroll
        for (int hb = 0; hb < 2; ++hb) {
            f32x4 v[4][4];
#pragma unroll
            for (int rr = 0; rr < 4; ++rr)
#pragma unroll
                for (int i = 0; i < 4; ++i) v[rr][i] = *(const f32x4*)(c.out + (size_t)(r0b + wave * 8 + hb * 4 + rr) * DM + i * 256 + lane * 4);
#pragma unroll
            for (int rr = 0; rr < 4; ++rr) {
                float ss = 0.f;
#pragma unroll
                for (int i = 0; i < 4; ++i) ss += v[rr][i][0] * v[rr][i][0] + v[rr][i][1] * v[rr][i][1] + v[rr][i][2] * v[rr][i][2] + v[rr][i][3] * v[rr][i][3];
                ss = wave_sum_dpp(ss);
                const float rs = rsqrtf(ss * (1.0f / DM) + 1e-6f);
                if (lane == 0) RS[wave * 8 + hb * 4 + rr] = rs;
#pragma unroll
                for (int i = 0; i < 4; ++i) {
                    const f32x4 g = *(const f32x4*)(gain + i * 256 + lane * 4);
                    store_bf4(c.H + (size_t)(r0b + wave * 8 + hb * 4 + rr) * DM + i * 256 + lane * 4, (f32x4){v[rr][i][0] * rs * g[0], v[rr][i][1] * rs * g[1], v[rr][i][2] * rs * g[2], v[rr][i][3] * rs * g[3]});
                }
            }
        }
        __syncthreads();
        const int tile = wave & 3, kh = wave >> 2, cl = lane & 15, kq = lane >> 4;
        f32x4 acc0 = (f32x4){0.f, 0.f, 0.f, 0.f}, acc1 = acc0, acc2 = acc0;
        {
            const float my_rs = RS[tile * 16 + cl];
            const float* xr = c.out + (size_t)(r0b + tile * 16 + cl) * DM + 4 * kq + kh * 512;
            const float* gr_ = gain + 4 * kq + kh * 512;
            f32x4 xa[4], ga[4];
#pragma unroll
            for (int u = 0; u < 4; ++u) { xa[u] = *(const f32x4*)(xr + u * 16); ga[u] = *(const f32x4*)(gr_ + u * 16); }
#pragma unroll 1
            for (int kb0 = 0; kb0 < 32; kb0 += 4) {
                f32x4 xn[4], gn[4];
                const int kn = (kb0 + 4 < 32) ? kb0 + 4 : kb0;
#pragma unroll
                for (int u = 0; u < 4; ++u) { xn[u] = *(const f32x4*)(xr + (kn + u) * 16); gn[u] = *(const f32x4*)(gr_ + (kn + u) * 16); }
#pragma unroll
                for (int u = 0; u < 4; ++u) {
                    const int kb = kh * 32 + kb0 + u;
                    const f32x4 b0 = *(const f32x4*)(B01 + ((kb * 2 + 0) * 64 + lane) * 4), b1 = *(const f32x4*)(B01 + ((kb * 2 + 1) * 64 + lane) * 4);
                    f32x4 b2 = (f32x4){0.f, 0.f, 0.f, 0.f};
                    if (cl < 4) b2 = *(const f32x4*)(B2 + ((kb * 4 + kq) * 4 + cl) * 4);
#pragma unroll
                    for (int m = 0; m < 4; ++m) {
                        const float am = xa[u][m] * ga[u][m] * my_rs;
                        acc0 = __builtin_amdgcn_mfma_f32_16x16x4f32(am, b0[m], acc0, 0, 0, 0);
                        acc1 = __builtin_amdgcn_mfma_f32_16x16x4f32(am, b1[m], acc1, 0, 0, 0);
                        acc2 = __builtin_amdgcn_mfma_f32_16x16x4f32(am, b2[m], acc2, 0, 0, 0);
                    }
                }
#pragma unroll
                for (int u = 0; u < 4; ++u) { xa[u] = xn[u]; ga[u] = gn[u]; }
            }
        }
        __syncthreads();
        if (kh == 1) { f32x4* pp = (f32x4*)(lds + N2_PART) + (tile * 3) * 64 + lane; pp[0] = acc0; pp[64] = acc1; pp[128] = acc2; }
        __syncthreads();
        int ex0 = 0, ex1 = 0, lr0 = 0, lr1 = 0; float w0_ = 0.f, w1_ = 0.f;
        if (kh == 0) {
            const f32x4* pp = (const f32x4*)(lds + N2_PART) + (tile * 3) * 64 + lane;
            acc0 += pp[0]; acc1 += pp[64]; acc2 += pp[128];
            float* lg = (float*)(lds + N2_LG) + tile * 16 * 36;
#pragma unroll
            for (int i = 0; i < 4; ++i) { const int row = 4 * kq + i; lg[row * 36 + cl] = acc0[i]; lg[row * 36 + 16 + cl] = acc1[i]; if (cl < 4) lg[row * 36 + 32 + cl] = acc2[i]; }
            LDS_WAVE_SYNC();
            if (lane < 16) {
                const float* L = lg + lane * 36;
                float lgp[4];
#pragma unroll
                for (int o = 0; o < 4; ++o) lgp[o] = L[32 + o] + brg[o];
                int grp = 0; float gm = lgp[0];
#pragma unroll
                for (int o = 1; o < 4; ++o) if (lgp[o] > gm) { gm = lgp[o]; grp = o; }
                float gs = 0.f;
#pragma unroll
                for (int o = 0; o < 4; ++o) gs += __expf(lgp[o] - gm);
                const float ptop = 1.0f / gs;
                int i0 = 0; float v0 = -INFINITY; int i1 = 0; float v1 = -INFINITY;
                for (int o = 0; o < 8; ++o) { const float le = L[grp * 8 + o] + bre[grp * 8 + o]; if (le > v0) { v1 = v0; i1 = i0; v0 = le; i0 = o; } else if (le > v1) { v1 = le; i1 = o; } }
                const float e1 = __expf(v1 - v0), inv = 1.0f / (1.0f + e1);
                ex0 = grp * 8 + i0; ex1 = grp * 8 + i1;
                w0_ = inv * ptop; w1_ = e1 * inv * ptop;
                lr0 = (int)atomicAdd(lcnt + ex0, 1u); lr1 = (int)atomicAdd(lcnt + ex1, 1u);
            }
        }
        __syncthreads();
        if (tid < 32) { const unsigned n = lcnt[tid]; lbase[tid] = n ? atomicAdd(cnt + tid, n) : 0u; }
        __syncthreads();
        if (kh == 0 && lane < 16) {
            const int row = r0b + tile * 16 + lane;
            const int q0 = (int)lbase[ex0] + lr0, q1 = (int)lbase[ex1] + lr1;
            int* rt_ = c.ROUTE + (size_t)row * 8;
            rt_[0] = ex0; rt_[1] = ex1; ((float*)rt_)[2] = w0_; ((float*)rt_)[3] = w1_; rt_[4] = q0; rt_[5] = q1;
            int* e0p = c.ENT + ((size_t)ex0 * NT + q0) * 2; e0p[0] = row; ((float*)e0p)[1] = w0_;
            int* e1p = c.ENT + ((size_t)ex1 * NT + q1) * 2; e1p[0] = row; ((float*)e1p)[1] = w1_;
        }
    }
}
DI void moe_tables(const Ctx& c, int* soff, int* stile, int ncol) {
    const unsigned* cnt = c.ctl + CW_CNT + c.l * 32;
    __syncthreads();
    if (TID() == 0) { int s = 0, tt = 0; for (int e = 0; e < 32; ++e) { soff[e] = s; stile[e] = tt; s += (int)cnt[e]; tt += (((int)cnt[e] + 255) >> 8) * ncol; } soff[32] = s; stile[32] = tt; }
    __syncthreads();
}
DI void phase_moe_up(const Ctx& c, unsigned char* lds) {
    int* soff = (int*)(lds + LDS_BYTES - 1024); int* stile = soff + 64;
    moe_tables(c, soff, stile, 2);
    const int total = __builtin_amdgcn_readfirstlane(stile[32]);
    for (int item = blockIdx.x; item < total; item += gridDim.x) {
        int e = 0;
        for (int q = 1; q < 32; ++q) if (stile[q] <= item) e = q;
        e = __builtin_amdgcn_readfirstlane(e);
        const int loc = __builtin_amdgcn_readfirstlane(item - stile[e]), tm = loc >> 1, chf = loc & 1;
        const int p0 = __builtin_amdgcn_readfirstlane(soff[e] + tm * 256), pend = __builtin_amdgcn_readfirstlane(soff[e + 1]);
        GatherRows gr; gr.ent = c.ENT + ((size_t)e * NT + (p0 - soff[e])) * 2; gr.n = pend - p0;
        f32x4 acc[8][4];
#pragma unroll
        for (int a_ = 0; a_ < 8; ++a_)
#pragma unroll
            for (int b_ = 0; b_ < 4; ++b_) acc[a_][b_] = (f32x4){0.f, 0.f, 0.f, 0.f};
        gemm256_dma(acc, c.H, DM, (const bf16_t*)(c.ws + WS_EG) + ((size_t)e * 256 + chf * 128) * DM, DM, DM, lds, &gr, (unsigned)((WS_EU - WS_EG) - (size_t)128 * DM * 2));
        const int lane = TID() & 63, wave = TID() >> 6, wm = wave >> 2, wn = wave & 3;
#pragma unroll
        for (int mi = 0; mi < 8; ++mi)
#pragma unroll
            for (int ni = 0; ni < 2; ++ni) {
                const int r = R256(mi), cc = C256(ni);
                const f32x4 g4 = acc[mi][ni], u4 = acc[mi][ni + 2];
                if (p0 + r < pend) store_bf4(c.HID + (size_t)(p0 + r) * 256 + chf * 128 + cc,
                    (f32x4){g4[0] * sigmoidf_(g4[0]) * u4[0], g4[1] * sigmoidf_(g4[1]) * u4[1], g4[2] * sigmoidf_(g4[2]) * u4[2], g4[3] * sigmoidf_(g4[3]) * u4[3]});
            }
    }
    {
        const int G = gridDim.x, first = (total > G && total <= 2 * G) ? total - G : 0;
        const int li = (int)blockIdx.x - first, nl = G - first;
        if (li >= 0) for (int it = li * 8; it < 2048; it += nl * 8) { const int e = (it >> 6) & 31, tl = it & 63;
            convert_tiles<8>(c.in(I_ED) + ((size_t)c.l * 32 + e) * 256 * DM, DM, DM, 256, (bf16_t*)(c.ws + WS_ED) + (size_t)e * DM * 256, tl, lds); }
    }
}
DI void phase_moe_down(const Ctx& c, unsigned char* lds) {
    int* soff = (int*)(lds + LDS_BYTES - 1024); int* stile = soff + 64;
    moe_tables(c, soff, stile, 4);
    const int total = __builtin_amdgcn_readfirstlane(stile[32]);
    for (int item = blockIdx.x; item < total; item += gridDim.x) {
        int e = 0;
        for (int q = 1; q < 32; ++q) if (stile[q] <= item) e = q;
        e = __builtin_amdgcn_readfirstlane(e);
        const int loc = __builtin_amdgcn_readfirstlane(item - stile[e]), tm = loc >> 2, tn = loc & 3, n0 = tn * 256;
        const int p0 = __builtin_amdgcn_readfirstlane(soff[e] + tm * 256), pend = __builtin_amdgcn_readfirstlane(soff[e + 1]);
        f32x4 acc[8][4];
#pragma unroll
        for (int a_ = 0; a_ < 8; ++a_)
#pragma unroll
            for (int b_ = 0; b_ < 4; ++b_) acc[a_][b_] = (f32x4){0.f, 0.f, 0.f, 0.f};
        gemm256_dma(acc, c.HID + (size_t)p0 * 256, 256, (const bf16_t*)(c.ws + WS_ED) + ((size_t)e * DM + n0) * 256, 256, 256, lds);
        const int lane = TID() & 63, wave = TID() >> 6, wm = wave >> 2, wn = wave & 3;
        const float* wl = (const float*)c.ENT + ((size_t)e * NT + (p0 - soff[e])) * 2 + 1;
#pragma unroll
        for (int mi = 0; mi < 8; ++mi) {
            const int r = R256(mi);
            const float w = (p0 + r < pend) ? wl[2 * r] : 0.f;
#pragma unroll
            for (int ni = 0; ni < 4; ++ni) acc[mi][ni] = acc[mi][ni] * w;
        }
        tile256_store_bf16(acc, c.Y + (size_t)p0 * DM + n0, DM, 256, lds, pend - p0);
    }
}
DI void phase_final(const Ctx& c, unsigned char* lds) {
    const int tid = TID(), lane = tid & 63, wave = tid >> 6;
    const float* gain = c.in(I_NFIN);
    int* soff = (int*)(lds + 65536);
    moe_offsets(c, DEPTH - 1, soff);
    f32x4 g4[4];
#pragma unroll
    for (int i = 0; i < 4; ++i) g4[i] = *(const f32x4*)(gain + i * 256 + lane * 4);
    for (int r0 = (blockIdx.x * 8 + wave) * 4; r0 < NT; r0 += gridDim.x * 32) norm_rows4<true>(c, c.out, g4, r0, lane, soff, true);
}

constexpr int PH_PER_LAYER = 11, N_PHASES = DEPTH * PH_PER_LAYER + 1;
__global__ void __launch_bounds__(NTHREADS, 2) fwd_kernel(Params P) {
    extern __shared__ __attribute__((aligned(16))) unsigned char lds[];
    const int lo = P.ph_lo, hi = P.ph_hi;
    LAS unsigned* xbw = (LAS unsigned*)(lds + LDS_BYTES - 16);
    if (threadIdx.x == 0) { xbw[0] = 0u; xbw[1] = 0u; xbw[2] = 0u; xbw[3] = 0u; }
    __syncthreads();
    Ctx c; c.P = &P; c.ws = P.ws; c.out = P.out; c.l = 0;
    c.ctl = (unsigned*)(P.ws + WS_CTL);
    c.H = (bf16_t*)(P.ws + WS_H); c.PROJ = (bf16_t*)(P.ws + WS_PROJ); c.F = (bf16_t*)(P.ws + WS_F); c.POOLED = (bf16_t*)(P.ws + WS_POOLED);
    c.MERGED = (bf16_t*)(P.ws + WS_F); c.CMPH = (bf16_t*)(P.ws + WS_CMPH); c.CMPO = (float*)(P.ws + WS_CMPO); c.POSB = (float*)(P.ws + WS_POSB);
    c.ROUTE = (int*)(P.ws + WS_ROUTE); c.ENT = (int*)(P.ws + WS_ENT); c.HID = (bf16_t*)(P.ws + WS_HID); c.Y = (bf16_t*)(P.ws + WS_Y);
    c.VT = (bf16_t*)(P.ws + WS_VT); c.KC = (bf16_t*)(P.ws + WS_KC); c.VCT = (bf16_t*)(P.ws + WS_VCT); c.YRAW = (bf16_t*)(P.ws + WS_YRAW); c.BON = (float*)(P.ws + WS_BON); c.TG = (bf16_t*)(P.ws + WS_TG);
    XcdBarrier bar; bar.bar = c.ctl + CW_BAR; bar.x = 0; bar.st = (volatile LAS unsigned*)xbw;
    if (hi - lo > 1) bar = xcd_barrier_post(c.ctl + CW_BAR, (volatile LAS unsigned*)xbw);
#define IN(k) (lo <= (k) && (k) < hi)
#define SEAM(k) do { if (IN(k) && IN((k) + 1)) xcd_barrier(bar); } while (0)
#pragma unroll 1
    for (int l = 0; l < DEPTH; ++l) {
        c.l = l; const int pb = l * PH_PER_LAYER;
        if (IN(pb + 0)) phase_norm1(c, lds);
        SEAM(pb + 0);
        if (IN(pb + 1)) phase_gemm1(c, lds);
        SEAM(pb + 1);
        if (IN(pb + 2)) phase_prep(c, lds);
        SEAM(pb + 2);
        if (IN(pb + 3)) phase_poolgemm(c, lds);
        SEAM(pb + 3);
        if (IN(pb + 4)) phase_mix(c, lds);
        SEAM(pb + 4);
        if (IN(pb + 5)) phase_rwkv_post(c, lds);
        SEAM(pb + 5);
        if (IN(pb + 6)) phase_merge(c, lds);
        SEAM(pb + 6);
        if (IN(pb + 7)) phase_outp(c, lds);
        SEAM(pb + 7);
        if (IN(pb + 8)) phase_norm2(c, lds);
        SEAM(pb + 8);
        if (IN(pb + 9)) phase_moe_up(c, lds);
        SEAM(pb + 9);
        if (IN(pb + 10)) phase_moe_down(c, lds);
        SEAM(pb + 10);
    }
    if (IN(N_PHASES - 1)) phase_final(c, lds);
}

#ifndef MK_N_LAUNCHES
#define MK_N_LAUNCHES 1
#endif
extern "C" void kernel_launch(void* const* d_in, const int* in_sizes, int n_in, void* d_out, int out_size, void* d_ws, size_t ws_size, hipStream_t stream) {
    static int grid = 0;
    if (grid == 0) {
        if (n_in != N_IN || out_size != NT * DM || ws_size < WS_END) { fprintf(stderr, "kernel_launch: unexpected shapes n_in %d out %d ws %zu (need %zu)\n", n_in, out_size, ws_size, (size_t)WS_END); grid = -1; return; }
        int dev = 0, cus = 0, per_cu = 0;
        if (hipGetDevice(&dev) != hipSuccess || hipDeviceGetAttribute(&cus, hipDeviceAttributeMultiprocessorCount, dev) != hipSuccess) { grid = -1; return; }
        if (hipFuncSetAttribute((const void*)fwd_kernel, hipFuncAttributeMaxDynamicSharedMemorySize, LDS_BYTES) != hipSuccess) { fprintf(stderr, "kernel_launch: hipFuncSetAttribute failed\n"); grid = -1; return; }
        if (hipOccupancyMaxActiveBlocksPerMultiprocessor(&per_cu, (const void*)fwd_kernel, NTHREADS, LDS_BYTES) != hipSuccess || per_cu < 1) { fprintf(stderr, "kernel_launch: occupancy query says %d\n", per_cu); }
        (void)hipGetLastError();
        grid = cus;
    }
    if (grid < 0) return;
    if (hipMemsetAsync((char*)d_ws + WS_CTL, 0, CTL_BYTES, stream) != hipSuccess) return;
    Params p{};
    for (int i = 0; i < N_IN; ++i) p.in[i] = (const float*)d_in[i];
    p.out = (float*)d_out; p.ws = (unsigned char*)d_ws;
    if (MK_N_LAUNCHES == 1) {
        p.ph_lo = 0; p.ph_hi = N_PHASES;
        hipLaunchKernelGGL(fwd_kernel, dim3(grid), dim3(NTHREADS), LDS_BYTES, stream, p);
    } else {
        for (int k = 0; k < N_PHASES; ++k) { p.ph_lo = k; p.ph_hi = k + 1; hipLaunchKernelGGL(fwd_kernel, dim3(grid), dim3(NTHREADS), LDS_BYTES, stream, p); }
    }
}
```
